# Optimizing an MI355X kernel written in HIP

```python
import jax, jax.numpy as jnp
from jax import lax
import numpy as np

D_MODEL = 1024
BATCH = 8
SEQ = 2048
DEPTH = 4
DEC_BATCH = 128
DEC_SEQ = 8
PAST_LEN = 16384
PAGE_SIZE = 128

N_PAIRS = DEPTH // 2
A_WIDTH = D_MODEL // 2
CONV_WIDTH = 3
B_WIDTH = D_MODEL // 2
HEAD_SIZE = 64
B_HEADS = B_WIDTH // HEAD_SIZE
DECAY_LORA = 64
AAA_LORA = 64
C_WIDTH = D_MODEL // 2
POOL_WINDOWS = (2, 4, 8, 16)
POOL_GROUPS = len(POOL_WINDOWS)
POOL_GROUP_DIM = C_WIDTH // POOL_GROUPS
POOL_HIST = max(POOL_WINDOWS) - 1
D_WIDTH = D_MODEL // 2
CHUNK = 128
D_GROUPS = 4
D_GROUP_DIM = D_WIDTH // D_GROUPS
SHIFT_COLS = 3 * B_WIDTH + DECAY_LORA + AAA_LORA
EVEN_COLS = 4 * A_WIDTH + SHIFT_COLS + B_WIDTH
ODD_COLS = 2 * C_WIDTH + 3 * D_WIDTH
RMS_EPS = 1e-6
LN_EPS = 1e-5
GN_EPS = 64e-5

kernel_name = "hybrid_conv_rwkv7_pool_chunkmlp_step"


def rmsnorm(x, g):
    x32 = x.astype(jnp.float32)
    y = x32 * lax.rsqrt(jnp.mean(x32 * x32, axis=-1, keepdims=True) + RMS_EPS)
    return (y * g.astype(jnp.float32)).astype(x.dtype)


def short_conv(u, hist, w):
    T = u.shape[1]
    ext = jnp.concatenate([hist.astype(u.dtype), u], axis=1)
    y = w[0] * ext[:, 0:T] + w[1] * ext[:, 1:T + 1] + w[2] * ext[:, 2:T + 2]
    return y, ext[:, T:]


def token_shift(q, prev, mu):
    prev_seq = jnp.concatenate([prev[:, None].astype(q.dtype), q[:, :-1]], axis=1)
    return q + mu * (prev_seq - q), q[:, -1]


def wkv7_scan(r, decay, k, v, kk, a, S0):
    def step(S, inp):
        r_t, w_t, k_t, v_t, kk_t, a_t = inp
        sa = jnp.einsum('bhij,bhj->bhi', S, -kk_t)
        S = (S * w_t[:, :, None, :] + sa[..., None] * (kk_t * a_t)[:, :, None, :]
             + v_t[..., None] * k_t[:, :, None, :])
        return S, jnp.einsum('bhij,bhj->bhi', S, r_t)
    xs = tuple(jnp.moveaxis(t.astype(jnp.float32), 1, 0) for t in (r, decay, k, v, kk, a))
    S, ys = lax.scan(step, S0.astype(jnp.float32), xs)
    return jnp.moveaxis(ys, 0, 1), S


def pool_mix(p, hist, past_len):
    T = p.shape[1]
    ext = jnp.concatenate([hist.astype(p.dtype), p], axis=1).astype(jnp.float32)
    cs = jnp.cumsum(ext, axis=1)
    cs = jnp.concatenate([jnp.zeros_like(cs[:, :1]), cs], axis=1)
    end = POOL_HIST + 1
    pos = past_len + jnp.arange(T, dtype=jnp.float32)
    outs = []
    for g, w in enumerate(POOL_WINDOWS):
        sl = slice(g * POOL_GROUP_DIM, (g + 1) * POOL_GROUP_DIM)
        win = cs[:, end:end + T, sl] - cs[:, end - w:end - w + T, sl]
        cnt = jnp.minimum(jnp.float32(w), pos + 1.0)[None, :, None]
        outs.append(win / cnt - ext[:, POOL_HIST:, sl])
    return jnp.concatenate(outs, axis=-1).astype(p.dtype), ext[:, T:].astype(p.dtype)


def even_layer(h, conv_hist, shift_prev, wkv_state, w_in, conv_w, shift_mu, w0, w2, a0, a2,
               k_k, k_a, r_k, gn_g, gn_b, w_out):
    Bsz, T, _ = h.shape
    proj = h @ w_in
    a_h, a_b, a_c, a_z, shift_in, b_z = jnp.split(
        proj, [A_WIDTH, 2 * A_WIDTH, 3 * A_WIDTH, 4 * A_WIDTH, 4 * A_WIDTH + SHIFT_COLS], axis=-1)
    conv_out, new_conv = short_conv(a_c * a_h, conv_hist, conv_w)
    y_a = a_b * conv_out * jax.nn.silu(a_z)
    shifted, new_shift = token_shift(shift_in, shift_prev, shift_mu)
    r, k, v, wl, al = jnp.split(
        shifted, [B_WIDTH, 2 * B_WIDTH, 3 * B_WIDTH, 3 * B_WIDTH + DECAY_LORA], axis=-1)
    w_log = (-jax.nn.softplus(-(w0 + jnp.tanh(wl) @ w2)) - 0.5).astype(jnp.float32)
    decay = jnp.exp(-jnp.exp(w_log))
    a = jax.nn.sigmoid(a0 + al @ a2)
    heads = lambda t: t.reshape(Bsz, T, B_HEADS, HEAD_SIZE)
    kk = heads(k * k_k).astype(jnp.float32)
    kk = kk / jnp.maximum(jnp.sqrt(jnp.sum(kk * kk, axis=-1, keepdims=True)), 1e-12)
    k = k * (1 + (a - 1) * k_a)
    rh, kh, vh, ah = heads(r), heads(k), heads(v), heads(a)
    y, new_wkv = wkv7_scan(rh, heads(decay), kh, vh, kk, ah, wkv_state)
    mean = jnp.mean(y, axis=-1, keepdims=True)
    var = jnp.mean(jnp.square(y - mean), axis=-1, keepdims=True)
    y = (y - mean) * lax.rsqrt(var + GN_EPS)
    y = y.reshape(Bsz, T, B_WIDTH) * gn_g.astype(jnp.float32) + gn_b.astype(jnp.float32)
    bonus = jnp.sum((rh * kh * r_k).astype(jnp.float32), axis=-1, keepdims=True) * vh.astype(jnp.float32)
    y = (y + bonus.reshape(Bsz, T, B_WIDTH)).astype(h.dtype)
    y_b = y * jax.nn.silu(b_z)
    out = jnp.concatenate([y_a, y_b], axis=-1) @ w_out
    return out, new_conv, new_shift, new_wkv


def odd_layer(h, pool_hist, past_len, w_in, pool_w, pool_scale, v_ln_g, v_ln_b,
              spatial_w, spatial_b, w_out):
    Bsz, T, _ = h.shape
    proj = h @ w_in
    p, c_z, u, v, d_z = jnp.split(
        proj, [C_WIDTH, 2 * C_WIDTH, 2 * C_WIDTH + D_WIDTH, 2 * C_WIDTH + 2 * D_WIDTH], axis=-1)
    pooled, new_pool = pool_mix(p, pool_hist, past_len)
    pooled = pooled.reshape(Bsz, T, POOL_GROUPS, POOL_GROUP_DIM)
    y_c = jnp.einsum('btgc,gcd->btgd', pooled, pool_w).reshape(Bsz, T, C_WIDTH)
    y_c = y_c * pool_scale * jax.nn.silu(c_z)
    v32 = v.astype(jnp.float32)
    mu = jnp.mean(v32, axis=-1, keepdims=True)
    var = jnp.mean(jnp.square(v32 - mu), axis=-1, keepdims=True)
    vn = ((v32 - mu) * lax.rsqrt(var + LN_EPS) * v_ln_g.astype(jnp.float32)
          + v_ln_b.astype(jnp.float32)).astype(h.dtype)
    L = min(T, CHUNK)
    n_chunks = T // L
    mask = jnp.tril(jnp.ones((L, L), dtype=bool))
    w_s = jnp.where(mask[None], spatial_w[:, :L, :L], 0)
    vc = vn.reshape(Bsz, n_chunks, L, D_GROUPS, D_GROUP_DIM)
    mixed = jnp.einsum('gts,bnsgc->bntgc', w_s, vc) + spatial_b[:, :L].T[:, :, None]
    y_d = u * mixed.reshape(Bsz, T, D_WIDTH) * jax.nn.silu(d_z)
    out = jnp.concatenate([y_c, y_d], axis=-1) @ w_out
    return out, new_pool, vn


def setup_inputs(seed: int = 0) -> dict:
    key = jax.random.key(seed)
    ks = jax.random.split(key, 32)
    nrm = lambda i, shape, s=1.0: s * jax.random.normal(ks[i], shape, jnp.float32)
    return {
        "x_prompt": nrm(0, (BATCH, SEQ, D_MODEL)),
        "x_sample": nrm(1, (DEC_BATCH, DEC_SEQ, D_MODEL)),
        "state_conv": nrm(2, (N_PAIRS, DEC_BATCH, CONV_WIDTH - 1, A_WIDTH)),
        "state_shift": nrm(3, (N_PAIRS, DEC_BATCH, SHIFT_COLS)),
        "state_wkv": nrm(4, (N_PAIRS, DEC_BATCH, B_HEADS, HEAD_SIZE, HEAD_SIZE), 0.3),
        "state_pool": nrm(5, (N_PAIRS, DEC_BATCH, POOL_HIST, C_WIDTH)),
        "norm_w": 1.0 + nrm(6, (DEPTH, D_MODEL), 0.1),
        "final_norm_w": 1.0 + nrm(7, (D_MODEL,), 0.1),
        "w_in_even": nrm(8, (N_PAIRS, D_MODEL, EVEN_COLS), D_MODEL ** -0.5),
        "conv_w": nrm(9, (N_PAIRS, CONV_WIDTH, A_WIDTH), CONV_WIDTH ** -0.5),
        "shift_mu": jax.random.uniform(ks[10], (N_PAIRS, SHIFT_COLS), jnp.float32),
        "w0": 0.5 + nrm(11, (N_PAIRS, B_WIDTH), 0.5),
        "w2": nrm(12, (N_PAIRS, DECAY_LORA, B_WIDTH), 0.5 * DECAY_LORA ** -0.5),
        "a0": nrm(13, (N_PAIRS, B_WIDTH), 0.1),
        "a2": nrm(14, (N_PAIRS, AAA_LORA, B_WIDTH), 0.5 * AAA_LORA ** -0.5),
        "k_k": 0.85 + nrm(15, (N_PAIRS, B_WIDTH), 0.1),
        "k_a": 1.0 + nrm(16, (N_PAIRS, B_WIDTH), 0.1),
        "r_k": nrm(17, (N_PAIRS, B_HEADS, HEAD_SIZE), 0.1),
        "gn_g": 1.0 + nrm(18, (N_PAIRS, B_WIDTH), 0.1),
        "gn_b": nrm(19, (N_PAIRS, B_WIDTH), 0.01),
        "w_out_even": nrm(20, (N_PAIRS, A_WIDTH + B_WIDTH, D_MODEL), (A_WIDTH + B_WIDTH) ** -0.5),
        "w_in_odd": nrm(21, (N_PAIRS, D_MODEL, ODD_COLS), D_MODEL ** -0.5),
        "pool_w": nrm(22, (N_PAIRS, POOL_GROUPS, POOL_GROUP_DIM, POOL_GROUP_DIM), POOL_GROUP_DIM ** -0.5),
        "pool_scale": 1.0 + nrm(23, (N_PAIRS, C_WIDTH), 0.1),
        "v_ln_g": 1.0 + nrm(24, (N_PAIRS, D_WIDTH), 0.1),
        "v_ln_b": nrm(25, (N_PAIRS, D_WIDTH), 0.01),
        "spatial_w": nrm(26, (N_PAIRS, D_GROUPS, CHUNK, CHUNK), CHUNK ** -0.5),
        "spatial_b": 1.0 + nrm(27, (N_PAIRS, D_GROUPS, CHUNK), 0.1),
        "w_out_odd": nrm(28, (N_PAIRS, C_WIDTH + D_WIDTH, D_MODEL), (C_WIDTH + D_WIDTH) ** -0.5),
    }


def reference(x_prompt, x_sample, state_conv, state_shift, state_wkv, state_pool,
              norm_w, final_norm_w, w_in_even, conv_w, shift_mu, w0, w2, a0, a2, k_k, k_a, r_k,
              gn_g, gn_b, w_out_even, w_in_odd, pool_w, pool_scale, v_ln_g, v_ln_b,
              spatial_w, spatial_b, w_out_odd):
    xp, xs = x_prompt, x_sample
    conv_p, conv_s, shift_p, shift_s, wkv_p, wkv_s = [], [], [], [], [], []
    pool_p, pool_s, chunkv_s = [], [], []
    for layer in range(DEPTH):
        i = layer // 2
        hp = rmsnorm(xp, norm_w[layer])
        hs = rmsnorm(xs, norm_w[layer])
        if layer % 2 == 0:
            ew = (w_in_even[i], conv_w[i], shift_mu[i], w0[i], w2[i], a0[i], a2[i],
                  k_k[i], k_a[i], r_k[i], gn_g[i], gn_b[i], w_out_even[i])
            z_conv = jnp.zeros((BATCH, CONV_WIDTH - 1, A_WIDTH), xp.dtype)
            z_shift = jnp.zeros((BATCH, SHIFT_COLS), xp.dtype)
            z_wkv = jnp.zeros((BATCH, B_HEADS, HEAD_SIZE, HEAD_SIZE), jnp.float32)
            op, c1, s1, w1 = even_layer(hp, z_conv, z_shift, z_wkv, *ew)
            osm, c2, s2, w2_ = even_layer(hs, state_conv[i], state_shift[i], state_wkv[i], *ew)
            conv_p.append(c1); conv_s.append(c2)
            shift_p.append(s1); shift_s.append(s2)
            wkv_p.append(w1); wkv_s.append(w2_)
        else:
            ow = (w_in_odd[i], pool_w[i], pool_scale[i], v_ln_g[i], v_ln_b[i],
                  spatial_w[i], spatial_b[i], w_out_odd[i])
            z_pool = jnp.zeros((BATCH, POOL_HIST, C_WIDTH), xp.dtype)
            op, p1, _ = odd_layer(hp, z_pool, 0, *ow)
            osm, p2, v2 = odd_layer(hs, state_pool[i], PAST_LEN, *ow)
            pool_p.append(p1); pool_s.append(p2)
            chunkv_s.append(v2)
        xp = xp + op
        xs = xs + osm
    y_prompt = rmsnorm(xp, final_norm_w)
    y_sample = rmsnorm(xs, final_norm_w)
    return (y_prompt, y_sample,
            jnp.stack(conv_p), jnp.stack(conv_s),
            jnp.stack(shift_p), jnp.stack(shift_s),
            jnp.stack(wkv_p), jnp.stack(wkv_s),
            jnp.stack(pool_p), jnp.stack(pool_s),
            jnp.stack(chunkv_s))
```

```cpp
#include <hip/hip_runtime.h>
#include <hip/hip_cooperative_groups.h>
#include <cstdio>
namespace cg = cooperative_groups;

#ifndef ONE_LAUNCH
#define ONE_LAUNCH 1
#endif

#define LAS __attribute__((address_space(3)))
typedef unsigned short bf16_t;
typedef short bf16x8 __attribute__((ext_vector_type(8)));
typedef float f32x4 __attribute__((ext_vector_type(4)));
typedef unsigned u32x4 __attribute__((ext_vector_type(4)));
typedef unsigned u32x2 __attribute__((ext_vector_type(2)));

constexpr int NTOK = 17408, NTP = 16384;
constexpr int LDB = 1792;
constexpr int LDA = 2560;
constexpr size_t O_CONVP = 17825792, O_CONVS = 17842176, O_SHIFTP = 18104320, O_SHIFTS = 18130944, O_WKVP = 18556928, O_WKVS = 19081216,
                 O_POOLP = 27469824, O_POOLS = 27592704, O_CHUNKV = 29558784;
constexpr size_t WS_WINE = 0;
constexpr size_t WS_WOUTE = WS_WINE + 2ull * 4352 * 1024 * 2;
constexpr size_t WS_WINO = WS_WOUTE + 2ull * 1024 * 1024 * 2;
constexpr size_t WS_WOUTO = WS_WINO + 2ull * 2560 * 1024 * 2;
constexpr size_t WS_W2T = WS_WOUTO + 2ull * 1024 * 1024 * 2;
constexpr size_t WS_A2T = WS_W2T + 2ull * 512 * 64 * 2;
constexpr size_t WS_POOLWT = WS_A2T + 2ull * 512 * 64 * 2;
constexpr size_t WS_SPW = WS_POOLWT + 8ull * 128 * 128 * 2;
constexpr size_t WS_XB = WS_SPW + 8ull * 128 * 128 * 2;
constexpr size_t WS_YCAT = WS_XB + (size_t)NTOK * 1024 * 2;
constexpr size_t WS_SSQ = WS_YCAT + (size_t)NTOK * 1024 * 2;
constexpr size_t WS_Y = WS_SSQ + 5ull * NTOK * 4;
constexpr size_t WS_R1 = WS_Y + (size_t)NTOK * 512 * 4;
constexpr size_t WS_PROJB = WS_R1;
constexpr size_t WS_WDEC = WS_PROJB + (size_t)NTOK * LDB * 2;
constexpr size_t WS_AA = WS_WDEC + (size_t)NTOK * 512 * 4;
constexpr size_t WS_END = WS_AA + (size_t)NTOK * 512 * 2;
constexpr int LDS_BYTES = 131072;

struct Params {
    const void* ptr[32];
    int ph_lo, ph_hi;
};
struct Ctx { int tid, bid, nblk, z; };
#define PIN(i) ((const float*)p.ptr[(i) + cx.z])
#define POUT ((float*)p.ptr[29 + cx.z])
#define PWS ((unsigned char*)p.ptr[30 + cx.z])
enum { I_XP = 0, I_XS, I_SCONV, I_SSHIFT, I_SWKV, I_SPOOL, I_NORMW, I_FNORMW, I_WINE, I_CONVW, I_MU, I_W0, I_W2, I_A0, I_A2, I_KK, I_KA, I_RK, I_GNG, I_GNB,
       I_WOUTE, I_WINO, I_POOLW, I_PSCALE, I_LNG, I_LNB, I_SPW, I_SPB, I_WOUTO };

__device__ __forceinline__ unsigned cvt_pk_bf16(float lo, float hi) { unsigned r; asm("v_cvt_pk_bf16_f32 %0, %1, %2" : "=v"(r) : "v"(lo), "v"(hi)); return r; }
__device__ __forceinline__ float bf_lo(unsigned u) { return __uint_as_float(u << 16); }
__device__ __forceinline__ float bf_hi(unsigned u) { return __uint_as_float(u & 0xffff0000u); }
__device__ __forceinline__ float bf2f(bf16_t b) { return __uint_as_float(((unsigned)b) << 16); }
__device__ __forceinline__ f32x4 cvt4(u32x2 u) { return (f32x4){bf_lo(u.x), bf_hi(u.x), bf_lo(u.y), bf_hi(u.y)}; }
__device__ __forceinline__ f32x4 ld_bf4(const bf16_t* p) { return cvt4(*(const u32x2*)p); }
__device__ __forceinline__ void st_bf4(bf16_t* p, f32x4 v) { u32x2 u; u.x = cvt_pk_bf16(v[0], v[1]); u.y = cvt_pk_bf16(v[2], v[3]); *(u32x2*)p = u; }
__device__ __forceinline__ float sigmoidf_(float x) { return 1.0f / (1.0f + __expf(-x)); }
__device__ __forceinline__ float siluf_(float x) { return x / (1.0f + __expf(-x)); }
template <int CTRL> __device__ __forceinline__ float dpp_f(float x) { return __builtin_bit_cast(float, __builtin_amdgcn_mov_dpp(__builtin_bit_cast(int, x), CTRL, 0xf, 0xf, true)); }
__device__ __forceinline__ float allsum16(float x) { x += dpp_f<0xB1>(x); x += dpp_f<0x4E>(x); x += dpp_f<0x141>(x); x += dpp_f<0x128>(x); return x; }
__device__ __forceinline__ float allsum4(float x) { x += dpp_f<0xB1>(x); x += dpp_f<0x4E>(x); return x; }
__device__ __forceinline__ float dot4(f32x4 a, f32x4 b) { return a[0] * b[0] + a[1] * b[1] + a[2] * b[2] + a[3] * b[3]; }

namespace pg8 {
constexpr int BM = 256, BK = 64, HALF = 128, HTB = HALF * BK * 2, NXCD = 8, WGM = 8;
__device__ __forceinline__ int lds_byte(int r, int c) { const int st = (r >> 4) * 2 + (c >> 5), rr = r & 15, cc = c & 31, ob = rr * 64 + cc * 2; return st * 1024 + (ob ^ (((ob >> 9) & 1) << 5)); }
__device__ __forceinline__ void stage_rc(int b, int& R, int& C) { const int st = b / 1024, sb = b % 1024, swz = sb ^ (((sb >> 9) & 1) << 5); R = (st >> 1) * 16 + swz / 64; C = (st & 1) * 32 + (swz % 64) / 2; }
__device__ __forceinline__ int perm32(int rho) { const int n = rho >> 4, i = rho & 15; return 8 * (i >> 2) + 4 * n + (i & 3); }
struct Unit { int pm, pn; };
struct Gemm { const bf16_t* A; const bf16_t* Bt; int M, N, K; };
struct StaticOrder {
    int nM, nN, nwg, G, c;
    __device__ void init(int M, int N, int G_, int c_) { nM = M / BM; nN = N / BM; nwg = nM * nN; G = G_; c = c_; }
    __device__ bool next(int i, Unit& u) const {
        const long L = (long)i * G + c; if (L >= nwg) return false;
        int wgid = (int)L; { const int q = nwg / NXCD, r = nwg % NXCD, xcd = wgid % NXCD, off = wgid / NXCD; wgid = (xcd < r ? xcd * (q + 1) : r * (q + 1) + (xcd - r) * q) + off; }
        const int nig = WGM * nN, gid = wgid / nig, fm = gid * WGM, gsz = (nM - fm) < WGM ? (nM - fm) : WGM;
        u.pm = fm + ((wgid % nig) % gsz); u.pn = (wgid % nig) / gsz; return true;
    }
};

template <class Epi>
__device__ __forceinline__ void gemm_phase(const Ctx cx, LAS unsigned char* lds, const Gemm g, const StaticOrder& S, const Epi& E) {
    const int tid = cx.tid, wid = __builtin_amdgcn_readfirstlane(tid >> 6), lane = tid & 63, wr = wid >> 2, wc = wid & 3, fr = lane & 15, fq = lane >> 4;
    const int K = g.K, nt = K / BK;
    unsigned voffA[2], voffB[2];
#pragma unroll
    for (int i = 0; i < 2; ++i) { int R, C; stage_rc(tid * 16 + i * 8192, R, C); const int Rb = Epi::PERM ? ((R & ~31) + perm32(R & 31)) : R;
        voffA[i] = (unsigned)(R * K + C) * 2u; voffB[i] = (unsigned)(Rb * K + C) * 2u; }
    const size_t kstep = (size_t)(BK * 2);
    const size_t hstep = (size_t)HALF * K * 2;
    const size_t tstep = 2 * hstep;
    const unsigned ldsw = (unsigned)wid * 1024u;
    const int aoff = lds_byte(wr * 64 + fr, fq * 8), boff = lds_byte(wc * 32 + fr, fq * 8);
#define PG8_SA(b, h) (((b) * 2 + (h)) * HTB)
#define PG8_SB(b, h) ((4 + (b) * 2 + (h)) * HTB)
#define PG8_STAGE(bufoff, gbase, voff) do { _Pragma("unroll") for (int _i = 0; _i < 2; ++_i) \
        __builtin_amdgcn_global_load_lds((const unsigned*)((const char*)(gbase) + (voff)[_i]), (LAS unsigned*)(lds + (bufoff) + ldsw + _i * 8192), 16, 0, 0); } while (0)
#define PG8_LDA(dst, b, h) do { _Pragma("unroll") for (int m = 0; m < 4; ++m) _Pragma("unroll") for (int k = 0; k < 2; ++k) dst[m][k] = *(const LAS bf16x8*)(lds + PG8_SA(b, h) + aoff + m * 2048 + k * 1024); } while (0)
#define PG8_LDB(dst, b, h) do { _Pragma("unroll") for (int n = 0; n < 2; ++n) _Pragma("unroll") for (int k = 0; k < 2; ++k) dst[n][k] = *(const LAS bf16x8*)(lds + PG8_SB(b, h) + boff + n * 2048 + k * 1024); } while (0)
#define PG8_MMA(ai, bj, At, Bt) do { __builtin_amdgcn_s_setprio(1); _Pragma("unroll") for (int m = 0; m < 4; ++m) _Pragma("unroll") for (int n = 0; n < 2; ++n) _Pragma("unroll") for (int k = 0; k < 2; ++k) \
        acc[ai][bj][m][n] = __builtin_amdgcn_mfma_f32_16x16x32_bf16(Bt[n][k], At[m][k], acc[ai][bj][m][n], 0, 0, 0); __builtin_amdgcn_s_setprio(0); } while (0)
#define PG8_WAIT_V(n) asm volatile("s_waitcnt vmcnt(" #n ")" ::: "memory")
#define PG8_WAIT_L(n) asm volatile("s_waitcnt lgkmcnt(" #n ")" ::: "memory")
#define PG8_BAR __builtin_amdgcn_s_barrier()
#define PG8_SCHED __builtin_amdgcn_sched_barrier(0)
    Unit cur, nxt; int ui = 0;
    if (!S.next(0, cur)) return;
    f32x4 acc[2][2][4][2];
#pragma unroll
    for (int a = 0; a < 2; ++a)
#pragma unroll
        for (int b = 0; b < 2; ++b)
#pragma unroll
            for (int m = 0; m < 4; ++m)
#pragma unroll
                for (int n = 0; n < 2; ++n) acc[a][b][m][n] = (f32x4){0.f, 0.f, 0.f, 0.f};
    bf16x8 At[4][2], B0[2][2], B1[2][2];
    const char* cA = (const char*)g.A + (size_t)cur.pm * tstep; const char* cB = (const char*)g.Bt + (size_t)cur.pn * tstep;
    PG8_STAGE(PG8_SB(0, 0), cB, voffB); PG8_STAGE(PG8_SA(0, 0), cA, voffA); PG8_STAGE(PG8_SB(0, 1), cB + hstep, voffB); PG8_STAGE(PG8_SA(0, 1), cA + hstep, voffA);
    if (wr == 1) PG8_BAR;
    PG8_WAIT_V(4); PG8_BAR;
    PG8_STAGE(PG8_SB(1, 0), cB + kstep, voffB); PG8_STAGE(PG8_SA(1, 0), cA + kstep, voffA); PG8_STAGE(PG8_SB(1, 1), cB + hstep + kstep, voffB);
    PG8_WAIT_V(6); PG8_BAR;
    for (;;) {
        const bool has_next = S.next(ui + 1, nxt);
        const char* nA = has_next ? (const char*)g.A + (size_t)nxt.pm * tstep : cA; const char* nB = has_next ? (const char*)g.Bt + (size_t)nxt.pn * tstep : cB;
        for (int t = 0; t < nt; t += 2) {
            const bool last = (t == nt - 2);
            const char* a1 = cA + (size_t)(t + 1) * kstep;
            const char* a2 = last ? nA : cA + (size_t)(t + 2) * kstep; const char* b2 = last ? nB : cB + (size_t)(t + 2) * kstep;
            const char* a3 = a2 + kstep; const char* b3 = b2 + kstep;
            PG8_LDB(B0, 0, 0); PG8_SCHED; PG8_LDA(At, 0, 0); PG8_STAGE(PG8_SA(1, 1), a1 + hstep, voffA);
            PG8_WAIT_L(8); PG8_BAR; PG8_WAIT_L(0); PG8_MMA(0, 0, At, B0); PG8_BAR; PG8_SCHED;
            PG8_LDB(B1, 0, 1); PG8_STAGE(PG8_SB(0, 0), b2, voffB);
            PG8_BAR; PG8_WAIT_L(0); PG8_MMA(0, 1, At, B1); PG8_BAR;
            PG8_LDA(At, 0, 1); PG8_STAGE(PG8_SA(0, 0), a2, voffA);
            PG8_BAR; PG8_WAIT_L(0); PG8_MMA(1, 0, At, B0); PG8_BAR; PG8_SCHED;
            PG8_STAGE(PG8_SB(0, 1), b2 + hstep, voffB);
            PG8_WAIT_V(6); PG8_BAR; PG8_MMA(1, 1, At, B1); PG8_BAR;
            PG8_LDB(B0, 1, 0); PG8_SCHED; PG8_LDA(At, 1, 0); PG8_STAGE(PG8_SA(0, 1), a2 + hstep, voffA);
            PG8_WAIT_L(8); PG8_BAR; PG8_WAIT_L(0); PG8_MMA(0, 0, At, B0); PG8_BAR; PG8_SCHED;
            PG8_LDB(B1, 1, 1); PG8_STAGE(PG8_SB(1, 0), b3, voffB);
            PG8_BAR; PG8_WAIT_L(0); PG8_MMA(0, 1, At, B1); PG8_BAR;
            PG8_LDA(At, 1, 1); PG8_STAGE(PG8_SA(1, 0), a3, voffA);
            PG8_BAR; PG8_WAIT_L(0); PG8_MMA(1, 0, At, B0); PG8_BAR; PG8_SCHED;
            PG8_STAGE(PG8_SB(1, 1), b3 + hstep, voffB);
            PG8_WAIT_V(6); PG8_BAR; PG8_MMA(1, 1, At, B1); PG8_BAR;
        }
        E(acc, cur, wr, wc, fr, fq);
        if (!has_next) break;
#pragma unroll
        for (int a = 0; a < 2; ++a)
#pragma unroll
            for (int b = 0; b < 2; ++b)
#pragma unroll
                for (int m = 0; m < 4; ++m)
#pragma unroll
                    for (int n = 0; n < 2; ++n) acc[a][b][m][n] = (f32x4){0.f, 0.f, 0.f, 0.f};
        cur = nxt; cA = nA; cB = nB; ++ui;
    }
    PG8_WAIT_V(0);
    if (wr == 0) PG8_BAR;
    PG8_BAR;
#undef PG8_SA
#undef PG8_SB
#undef PG8_STAGE
#undef PG8_LDA
#undef PG8_LDB
#undef PG8_MMA
#undef PG8_WAIT_V
#undef PG8_WAIT_L
#undef PG8_BAR
#undef PG8_SCHED
}
}

struct EpiProj {
    static constexpr bool PERM = true;
    bf16_t* O; int ldc; const float* ssq;
    __device__ __forceinline__ void operator()(const f32x4 (&acc)[2][2][4][2], const pg8::Unit& u, int wr, int wc, int fr, int fq) const {
        const int row0 = u.pm * 256 + wr * 64 + fr, col0 = u.pn * 256 + wc * 32 + 8 * fq;
#pragma unroll
        for (int ai = 0; ai < 2; ++ai)
#pragma unroll
            for (int m = 0; m < 4; ++m) {
                const int row = row0 + ai * 128 + m * 16;
                const float rstd = rsqrtf(ssq[row] * (1.0f / 1024.0f) + 1e-6f);
                bf16_t* rowp = O + (size_t)row * ldc + col0;
#pragma unroll
                for (int bj = 0; bj < 2; ++bj) {
                    const f32x4 v0 = acc[ai][bj][m][0] * rstd, v1 = acc[ai][bj][m][1] * rstd;
                    u32x4 w; w.x = cvt_pk_bf16(v0[0], v0[1]); w.y = cvt_pk_bf16(v0[2], v0[3]); w.z = cvt_pk_bf16(v1[0], v1[1]); w.w = cvt_pk_bf16(v1[2], v1[3]);
                    *(u32x4*)(rowp + bj * 128) = w;
                }
            }
    }
};
struct EpiRes {
    static constexpr bool PERM = false;
    const float* xp; const float* xs; float* Xf; bf16_t* Xb; float* ssq_next;
    __device__ __forceinline__ void operator()(const f32x4 (&acc)[2][2][4][2], const pg8::Unit& u, int wr, int wc, int fr, int fq) const {
        const int row0 = u.pm * 256 + wr * 64 + fr, col0 = u.pn * 256 + wc * 32 + 4 * fq;
#pragma unroll
        for (int ai = 0; ai < 2; ++ai)
#pragma unroll
            for (int m = 0; m < 4; ++m) {
                const int row = row0 + ai * 128 + m * 16;
                const float* src = xp ? (row < NTP ? xp + (size_t)row * 1024 : xs + (size_t)(row - NTP) * 1024) : Xf + (size_t)row * 1024;
                float part = 0.f;
#pragma unroll
                for (int bj = 0; bj < 2; ++bj)
#pragma unroll
                    for (int n = 0; n < 2; ++n) {
                        const int col = col0 + bj * 128 + n * 16;
                        const f32x4 x = *(const f32x4*)(src + col) + acc[ai][bj][m][n];
                        *(f32x4*)(Xf + (size_t)row * 1024 + col) = x;
                        st_bf4(Xb + (size_t)row * 1024 + col, x);
                        part += dot4(x, x);
                    }
                part += __shfl_xor(part, 16); part += __shfl_xor(part, 32);
                if (fq == 0) atomicAdd(ssq_next + row, part);
            }
    }
};

__device__ __forceinline__ void tr_tile(const Ctx cx, LAS float* T, const float* src, int ld, int col0, int k0, bf16_t* dst, int Ktot, int drow0, const float* scale, bool zero) {
    const int tid = cx.tid;
    if (zero) {
        const int n = tid >> 3, kc = (tid & 7) * 8;
        *(u32x4*)(dst + (size_t)(drow0 + n) * Ktot + k0 + kc) = (u32x4){0u, 0u, 0u, 0u};
        return;
    }
#pragma unroll
    for (int pass = 0; pass < 2; ++pass) {
        const int kk = (tid >> 4) + pass * 32, nn = (tid & 15) * 4;
        f32x4 v = *(const f32x4*)(src + (size_t)(k0 + kk) * ld + col0 + nn);
        if (scale) v = v * scale[k0 + kk];
        T[kk * 65 + nn] = v[0]; T[kk * 65 + nn + 1] = v[1]; T[kk * 65 + nn + 2] = v[2]; T[kk * 65 + nn + 3] = v[3];
    }
    __syncthreads();
    {
        const int n = tid >> 3, kc = (tid & 7) * 8;
        u32x4 w;
        w.x = cvt_pk_bf16(T[(kc + 0) * 65 + n], T[(kc + 1) * 65 + n]); w.y = cvt_pk_bf16(T[(kc + 2) * 65 + n], T[(kc + 3) * 65 + n]);
        w.z = cvt_pk_bf16(T[(kc + 4) * 65 + n], T[(kc + 5) * 65 + n]); w.w = cvt_pk_bf16(T[(kc + 6) * 65 + n], T[(kc + 7) * 65 + n]);
        *(u32x4*)(dst + (size_t)(drow0 + n) * Ktot + k0 + kc) = w;
    }
    __syncthreads();
}

__device__ void phase_prepass(const Params& p, const Ctx cx, LAS unsigned char* lds) {
    LAS float* T = (LAS float*)lds;
    const int tid = cx.tid;
    for (int job = cx.bid; job < 4544; job += cx.nblk) {
        int j = job;
        if (j < 2176) {
            const int i = j / 1088, r = j % 1088, nt = r / 16, kt = r % 16;
            const int n0 = nt * 64;
            int col0; bool zero = false;
            if (n0 < 2048) col0 = n0; else if (n0 < 2560) col0 = 3712 + (n0 - 2048); else if (n0 < 4224) col0 = 2048 + (n0 - 2560); else { col0 = 0; zero = true; }
            tr_tile(cx, T, PIN(I_WINE) + (size_t)i * 1024 * 4224, 4224, col0, kt * 64, (bf16_t*)(PWS + WS_WINE) + (size_t)i * 4352 * 1024, 1024, n0, PIN(I_NORMW) + (2 * i) * 1024, zero);
            continue;
        }
        j -= 2176;
        if (j < 512) { const int i = j / 256, r = j % 256, nt = r / 16, kt = r % 16;
            tr_tile(cx, T, PIN(I_WOUTE) + (size_t)i * 1024 * 1024, 1024, nt * 64, kt * 64, (bf16_t*)(PWS + WS_WOUTE) + (size_t)i * 1024 * 1024, 1024, nt * 64, nullptr, false); continue; }
        j -= 512;
        if (j < 1280) { const int i = j / 640, r = j % 640, nt = r / 16, kt = r % 16;
            tr_tile(cx, T, PIN(I_WINO) + (size_t)i * 1024 * 2560, 2560, nt * 64, kt * 64, (bf16_t*)(PWS + WS_WINO) + (size_t)i * 2560 * 1024, 1024, nt * 64, PIN(I_NORMW) + (2 * i + 1) * 1024, false); continue; }
        j -= 1280;
        if (j < 512) { const int i = j / 256, r = j % 256, nt = r / 16, kt = r % 16;
            tr_tile(cx, T, PIN(I_WOUTO) + (size_t)i * 1024 * 1024, 1024, nt * 64, kt * 64, (bf16_t*)(PWS + WS_WOUTO) + (size_t)i * 1024 * 1024, 1024, nt * 64, nullptr, false); continue; }
        j -= 512;
        if (j < 16) { const int i = j / 8, nt = j % 8;
            tr_tile(cx, T, PIN(I_W2) + (size_t)i * 64 * 512, 512, nt * 64, 0, (bf16_t*)(PWS + WS_W2T) + (size_t)i * 512 * 64, 64, nt * 64, nullptr, false); continue; }
        j -= 16;
        if (j < 16) { const int i = j / 8, nt = j % 8;
            tr_tile(cx, T, PIN(I_A2) + (size_t)i * 64 * 512, 512, nt * 64, 0, (bf16_t*)(PWS + WS_A2T) + (size_t)i * 512 * 64, 64, nt * 64, nullptr, false); continue; }
        j -= 16;
        { const int ig = j / 4, r = j % 4, nt = r / 2, kt = r % 2;
            tr_tile(cx, T, PIN(I_POOLW) + (size_t)ig * 128 * 128, 128, nt * 64, kt * 64, (bf16_t*)(PWS + WS_POOLWT) + (size_t)ig * 128 * 128, 128, nt * 64, nullptr, false); }
    }
    const int gtid = cx.bid * 512 + tid, gthreads = cx.nblk * 512;
    for (int e = gtid; e < 8 * 128 * 128; e += gthreads) {
        const int s = e & 127, t = (e >> 7) & 127;
        ((bf16_t*)(PWS + WS_SPW))[e] = (s <= t) ? (bf16_t)(cvt_pk_bf16(PIN(I_SPW)[e], 0.f) & 0xffffu) : (bf16_t)0;
    }
    for (int e = gtid; e < 4 * NTOK; e += gthreads) ((float*)(PWS + WS_SSQ))[NTOK + e] = 0.f;
    const int wid = tid >> 6, lane = tid & 63;
    for (int row = cx.bid * 8 + wid; row < NTOK; row += cx.nblk * 8) {
        const float* src = row < NTP ? PIN(I_XP) + (size_t)row * 1024 : PIN(I_XS) + (size_t)(row - NTP) * 1024;
        bf16_t* dst = (bf16_t*)(PWS + WS_XB) + (size_t)row * 1024;
        float ss = 0.f;
#pragma unroll
        for (int i = 0; i < 4; ++i) { const f32x4 v = *(const f32x4*)(src + i * 256 + lane * 4); ss += dot4(v, v); st_bf4(dst + i * 256 + lane * 4, v); }
#pragma unroll
        for (int o = 32; o >= 1; o >>= 1) ss += __shfl_xor(ss, o);
        if (lane == 0) ((float*)(PWS + WS_SSQ))[row] = ss;
    }
}

__device__ __forceinline__ f32x4 shift4(const bf16_t* cur, bool hp, const float* st, int col, const float* mu) {
    const f32x4 q = ld_bf4(cur + col);
    f32x4 pv;
    if (hp) pv = ld_bf4(cur - LDB + col); else if (st) pv = *(const f32x4*)(st + col); else pv = (f32x4){0.f, 0.f, 0.f, 0.f};
    const f32x4 m = *(const f32x4*)(mu + col);
    return q + m * (pv - q);
}

__device__ void phase_even_prep(const Params& p, const Ctx cx, int pair) {
    const int tid = cx.tid, wid = tid >> 6, lane = tid & 63, fr = lane & 15, fq = lane >> 4;
    const bf16_t* PB = (const bf16_t*)(PWS + WS_PROJB);
    float* Wdec = (float*)(PWS + WS_WDEC);
    bf16_t* Aa = (bf16_t*)(PWS + WS_AA);
    bf16_t* Ycat = (bf16_t*)(PWS + WS_YCAT);
    const float* mu = PIN(I_MU) + pair * 1664;
    const bf16_t* W2T = (const bf16_t*)(PWS + WS_W2T) + (size_t)pair * 512 * 64;
    const bf16_t* A2T = (const bf16_t*)(PWS + WS_A2T) + (size_t)pair * 512 * 64;
    const float* w0 = PIN(I_W0) + pair * 512; const float* a0 = PIN(I_A0) + pair * 512;
    const float* k_a = PIN(I_KA) + pair * 512; const float* r_k = PIN(I_RK) + pair * 512;
    for (int unit = cx.bid * 8 + wid; unit < NTOK / 16; unit += cx.nblk * 8) {
        const int row = unit * 16 + fr;
        const bool samp = row >= NTP;
        int b, t; if (!samp) { b = row >> 11; t = row & 2047; } else { const int q = row - NTP; b = q >> 3; t = q & 7; }
        const bf16_t* cur = PB + (size_t)row * LDB;
        const bool hp = t > 0;
        const float* st = samp ? PIN(I_SSHIFT) + ((size_t)pair * 128 + b) * 1664 : nullptr;
        bf16x8 Aw[2], Al[2];
#pragma unroll
        for (int ks = 0; ks < 2; ++ks) {
            const int cw = 1536 + ks * 32 + fq * 8, ca = 1600 + ks * 32 + fq * 8;
            const f32x4 w_lo = shift4(cur, hp, st, cw, mu), w_hi = shift4(cur, hp, st, cw + 4, mu);
            const f32x4 a_lo = shift4(cur, hp, st, ca, mu), a_hi = shift4(cur, hp, st, ca + 4, mu);
            u32x4 pw, pa;
            float th[8];
#pragma unroll
            for (int j = 0; j < 4; ++j) { th[j] = 2.0f * sigmoidf_(2.0f * w_lo[j]) - 1.0f; th[4 + j] = 2.0f * sigmoidf_(2.0f * w_hi[j]) - 1.0f; }
            pw.x = cvt_pk_bf16(th[0], th[1]); pw.y = cvt_pk_bf16(th[2], th[3]); pw.z = cvt_pk_bf16(th[4], th[5]); pw.w = cvt_pk_bf16(th[6], th[7]);
            pa.x = cvt_pk_bf16(a_lo[0], a_lo[1]); pa.y = cvt_pk_bf16(a_lo[2], a_lo[3]); pa.z = cvt_pk_bf16(a_hi[0], a_hi[1]); pa.w = cvt_pk_bf16(a_hi[2], a_hi[3]);
            Aw[ks] = __builtin_bit_cast(bf16x8, pw); Al[ks] = __builtin_bit_cast(bf16x8, pa);
        }
#pragma unroll 1
        for (int h = 0; h < 8; ++h) {
            float bon = 0.f;
#pragma unroll 1
            for (int nt = 0; nt < 4; ++nt) {
                const int n0 = h * 64 + nt * 16;
                f32x4 lw = (f32x4){0.f, 0.f, 0.f, 0.f}, la = (f32x4){0.f, 0.f, 0.f, 0.f};
#pragma unroll
                for (int ks = 0; ks < 2; ++ks) {
                    const bf16x8 wf = *(const bf16x8*)(W2T + (size_t)(n0 + fr) * 64 + ks * 32 + fq * 8);
                    const bf16x8 af = *(const bf16x8*)(A2T + (size_t)(n0 + fr) * 64 + ks * 32 + fq * 8);
                    lw = __builtin_amdgcn_mfma_f32_16x16x32_bf16(wf, Aw[ks], lw, 0, 0, 0);
                    la = __builtin_amdgcn_mfma_f32_16x16x32_bf16(af, Al[ks], la, 0, 0, 0);
                }
                const int ch = n0 + fq * 4;
                const f32x4 r4 = shift4(cur, hp, st, ch, mu), k4 = shift4(cur, hp, st, 512 + ch, mu);
                const f32x4 w04 = *(const f32x4*)(w0 + ch), a04 = *(const f32x4*)(a0 + ch), ka4 = *(const f32x4*)(k_a + ch), rk4 = *(const f32x4*)(r_k + ch);
                f32x4 dec, av;
#pragma unroll
                for (int j = 0; j < 4; ++j) {
                    const float z_ = -(w04[j] + lw[j]);
                    const float wlog = -__logf(1.0f + __expf(z_)) - 0.5f;
                    dec[j] = __expf(-__expf(wlog));
                    av[j] = sigmoidf_(a04[j] + la[j]);
                    const float kp = k4[j] * (1.0f + (av[j] - 1.0f) * ka4[j]);
                    bon += r4[j] * kp * rk4[j];
                }
                *(f32x4*)(Wdec + (size_t)row * 512 + ch) = dec;
                st_bf4(Aa + (size_t)row * 512 + ch, av);
            }
            bon += __shfl_xor(bon, 16); bon += __shfl_xor(bon, 32);
#pragma unroll 1
            for (int nt = 0; nt < 4; ++nt) {
                const int ch = h * 64 + nt * 16 + fq * 4;
                st_bf4(Ycat + (size_t)row * 1024 + 512 + ch, shift4(cur, hp, st, 1024 + ch, mu) * bon);
            }
        }
    }
    const int gtid = cx.bid * 512 + tid, gthreads = cx.nblk * 512;
    for (int e = gtid; e < 136 * 1664; e += gthreads) {
        const int sr = e / 1664, c = e % 1664;
        if (sr < 8) POUT[O_SHIFTP + ((size_t)pair * 8 + sr) * 1664 + c] = bf2f(PB[(size_t)(sr * 2048 + 2047) * LDB + c]);
        else { const int b = sr - 8; POUT[O_SHIFTS + ((size_t)pair * 128 + b) * 1664 + c] = bf2f(PB[(size_t)(NTP + b * 8 + 7) * LDB + c]); }
    }
}

__device__ __forceinline__ void scan_step(f32x4& S, const f32x4 w, const f32x4 k, const f32x4 kk, const f32x4 bb, const f32x4 r, const float v, float& y) {
    float pd = dot4(S, kk);
    const f32x4 tmp = S * w + k * v;
    pd = allsum16(pd);
    S = tmp - bb * pd;
    y = allsum16(dot4(S, r));
}

__device__ void phase_scan(const Params& p, const Ctx cx, int pair, LAS unsigned char* lds) {
    const int tid = cx.tid, wid = tid >> 6, lane = tid & 63, rs = lane >> 4, cgi = lane & 15;
    const bf16_t* PB = (const bf16_t*)(PWS + WS_PROJB);
    const float* Wdec = (const float*)(PWS + WS_WDEC);
    const bf16_t* Aa = (const bf16_t*)(PWS + WS_AA);
    float* Y = (float*)(PWS + WS_Y);
    const float* mu = PIN(I_MU) + pair * 1664;
    const float* k_k = PIN(I_KK) + pair * 512; const float* k_a = PIN(I_KA) + pair * 512;
    {
        LAS float* vb = (LAS float*)lds + wid * 3072;
        for (int st = cx.bid * 8 + wid; st < 2048; st += cx.nblk * 8) {
            const int bh = st >> 1, half = st & 1, b = bh >> 3, h = bh & 7, ch = h * 64 + cgi * 4;
            const float* stp = PIN(I_SSHIFT) + ((size_t)pair * 128 + b) * 1664;
            const f32x4 kkc = *(const f32x4*)(k_k + ch), kac = *(const f32x4*)(k_a + ch);
            {
#pragma unroll
                for (int tt = 0; tt < 2; ++tt) {
                    const int t = rs + tt * 4;
                    const size_t row = NTP + b * 8 + t;
                    const bf16_t* cur = PB + row * LDB;
                    const f32x4 r = shift4(cur, t > 0, stp, ch, mu), k = shift4(cur, t > 0, stp, 512 + ch, mu), v = shift4(cur, t > 0, stp, 1024 + ch, mu);
                    const f32x4 a = ld_bf4(Aa + row * 512 + ch);
                    const f32x4 w = *(const f32x4*)(Wdec + row * 512 + ch);
                    const f32x4 kkv = k * kkc;
                    const float ss = allsum16(dot4(kkv, kkv));
                    const float inv = 1.0f / fmaxf(sqrtf(ss), 1e-12f);
                    const f32x4 kkn = kkv * inv;
                    LAS float* o = vb + t * 384 + cgi * 4;
                    *(LAS f32x4*)(o) = w; *(LAS f32x4*)(o + 64) = k * (1.0f + (a - 1.0f) * kac); *(LAS f32x4*)(o + 128) = kkn; *(LAS f32x4*)(o + 192) = kkn * a;
                    *(LAS f32x4*)(o + 256) = r; *(LAS f32x4*)(o + 320) = v;
                }
            }
            asm volatile("s_waitcnt lgkmcnt(0)" ::: "memory");
            __builtin_amdgcn_wave_barrier();
#pragma unroll 1
            for (int rq = 0; rq < 8; ++rq) {
                const int ri = half * 32 + rq * 4 + rs;
                const size_t so = ((((size_t)pair * 128 + b) * 8 + h) * 64 + ri) * 64 + cgi * 4;
                f32x4 S = *(const f32x4*)(PIN(I_SWKV) + so);
#pragma unroll
                for (int t = 0; t < 8; ++t) {
                    LAS const float* r0 = vb + t * 384 + cgi * 4;
                    float y; scan_step(S, *(LAS const f32x4*)(r0), *(LAS const f32x4*)(r0 + 64), *(LAS const f32x4*)(r0 + 128), *(LAS const f32x4*)(r0 + 192), *(LAS const f32x4*)(r0 + 256), vb[t * 384 + 320 + ri], y);
                    if (cgi == 0) Y[(size_t)(NTP + b * 8 + t) * 512 + h * 64 + ri] = y;
                }
                *(f32x4*)(POUT + O_WKVS + so) = S;
            }
            asm volatile("s_waitcnt lgkmcnt(0)" ::: "memory");
            __builtin_amdgcn_wave_barrier();
        }
    }
    __syncthreads();
    LAS float* rec = (LAS float*)lds;
    for (int pt = cx.bid; pt < 256; pt += cx.nblk) {
        const int xcd = pt & 7, slot = pt >> 3, bh = xcd * 8 + (slot >> 2), rg = slot & 3, b = bh >> 3, h = bh & 7;
        const int lt = tid - 256, ls = (lt >> 4) & 15, lcg = lt & 15, lch = h * 64 + lcg * 4;
        u32x2 qr = {0u, 0u}, qk = {0u, 0u}, qv = {0u, 0u}, pr = {0u, 0u}, pk = {0u, 0u}, pv = {0u, 0u}, qa = {0u, 0u};
        f32x4 qw = (f32x4){0.f, 0.f, 0.f, 0.f};
        f32x4 mur, muk, muv, kkc, kac;
        const int ri = rg * 16 + (wid & 3) * 4 + rs;
        f32x4 S = (f32x4){0.f, 0.f, 0.f, 0.f};
#define SCAN_ISSUE(c) do { const int t_ = (c) * 16 + ls; const size_t row_ = (size_t)b * 2048 + t_; const bf16_t* cur_ = PB + row_ * LDB; \
            qr = *(const u32x2*)(cur_ + lch); qk = *(const u32x2*)(cur_ + 512 + lch); qv = *(const u32x2*)(cur_ + 1024 + lch); \
            if (t_ > 0) { pr = *(const u32x2*)(cur_ - LDB + lch); pk = *(const u32x2*)(cur_ - LDB + 512 + lch); pv = *(const u32x2*)(cur_ - LDB + 1024 + lch); } \
            else { pr = (u32x2){0u, 0u}; pk = pr; pv = pr; } \
            qw = *(const f32x4*)(Wdec + row_ * 512 + lch); qa = *(const u32x2*)(Aa + row_ * 512 + lch); } while (0)
#define SCAN_PROCESS(buf) do { const f32x4 r0_ = cvt4(qr), k0_ = cvt4(qk), v0_ = cvt4(qv); \
            const f32x4 r_ = r0_ + mur * (cvt4(pr) - r0_), k_ = k0_ + muk * (cvt4(pk) - k0_), v_ = v0_ + muv * (cvt4(pv) - v0_), a_ = cvt4(qa); \
            const f32x4 kkv_ = k_ * kkc; const float ss_ = allsum16(dot4(kkv_, kkv_)); const float inv_ = 1.0f / fmaxf(sqrtf(ss_), 1e-12f); \
            const f32x4 kkn_ = kkv_ * inv_; \
            LAS float* o_ = rec + (buf) * 6144 + ls * 384 + lcg * 4; \
            *(LAS f32x4*)(o_) = qw; *(LAS f32x4*)(o_ + 64) = k_ * (1.0f + (a_ - 1.0f) * kac); *(LAS f32x4*)(o_ + 128) = kkn_; *(LAS f32x4*)(o_ + 192) = kkn_ * a_; \
            *(LAS f32x4*)(o_ + 256) = r_; *(LAS f32x4*)(o_ + 320) = v_; } while (0)
        if (wid >= 4) {
            mur = *(const f32x4*)(mu + lch); muk = *(const f32x4*)(mu + 512 + lch); muv = *(const f32x4*)(mu + 1024 + lch);
            kkc = *(const f32x4*)(k_k + lch); kac = *(const f32x4*)(k_a + lch);
            SCAN_ISSUE(0); SCAN_PROCESS(0); SCAN_ISSUE(1);
        }
        __syncthreads();
        for (int c = 0; c < 128; ++c) {
            if (wid < 4) {
                LAS const float* rb = rec + (c & 1) * 6144 + cgi * 4;
                float* yp = Y + ((size_t)b * 2048 + c * 16) * 512 + h * 64 + ri;
#pragma unroll 4
                for (int s = 0; s < 16; ++s) {
                    LAS const float* r0 = rb + s * 384;
                    float y;
                    scan_step(S, *(LAS const f32x4*)(r0), *(LAS const f32x4*)(r0 + 64), *(LAS const f32x4*)(r0 + 128), *(LAS const f32x4*)(r0 + 192), *(LAS const f32x4*)(r0 + 256),
                              rec[(c & 1) * 6144 + s * 384 + 320 + ri], y);
                    if (cgi == 0) yp[(size_t)s * 512] = y;
                }
            } else {
                if (c + 1 < 128) { SCAN_PROCESS((c + 1) & 1); if (c + 2 < 128) SCAN_ISSUE(c + 2); }
            }
            __syncthreads();
        }
        if (wid < 4) *(f32x4*)(POUT + O_WKVP + ((((size_t)pair * 8 + b) * 8 + h) * 64 + ri) * 64 + cgi * 4) = S;
#undef SCAN_ISSUE
#undef SCAN_PROCESS
    }
}

__device__ void phase_even_post(const Params& p, const Ctx cx, int pair) {
    const int gtid = cx.bid * 512 + cx.tid, gthreads = cx.nblk * 512;
    const bf16_t* PA = (const bf16_t*)(PWS + WS_R1);
    bf16_t* Ycat = (bf16_t*)(PWS + WS_YCAT);
    const float* Y = (const float*)(PWS + WS_Y);
    const float* gn_g = PIN(I_GNG) + pair * 512; const float* gn_b = PIN(I_GNB) + pair * 512;
    for (int e = gtid; e < NTOK * 128; e += gthreads) {
        const int row = e >> 7, ch = (e & 127) * 4;
        const f32x4 y = *(const f32x4*)(Y + (size_t)row * 512 + ch);
        const float mean = allsum16(y[0] + y[1] + y[2] + y[3]) * (1.0f / 64.0f);
        const f32x4 d = y - mean;
        const float var = allsum16(dot4(d, d)) * (1.0f / 64.0f);
        const float rstd = rsqrtf(var + 64e-5f);
        const f32x4 g = *(const f32x4*)(gn_g + ch), bb = *(const f32x4*)(gn_b + ch);
        bf16_t* yo = Ycat + (size_t)row * 1024 + 512 + ch;
        const f32x4 bv = ld_bf4(yo);
        const f32x4 bz = ld_bf4(PA + (size_t)row * LDA + 2048 + ch);
        f32x4 o;
#pragma unroll
        for (int j = 0; j < 4; ++j) o[j] = (d[j] * rstd * g[j] + bb[j] + bv[j]) * siluf_(bz[j]);
        st_bf4(yo, o);
    }
    const float* cw = PIN(I_CONVW) + pair * 3 * 512;
    for (int e = gtid; e < NTOK * 128; e += gthreads) {
        const int row = e >> 7, ch = (e & 127) * 4;
        const bool samp = row >= NTP;
        int b, t, T; if (!samp) { b = row >> 11; t = row & 2047; T = 2048; } else { const int q = row - NTP; b = q >> 3; t = q & 7; T = 8; }
        const bf16_t* cur = PA + (size_t)row * LDA;
        const f32x4 u0 = ld_bf4(cur + 1024 + ch) * ld_bf4(cur + ch);
        f32x4 u1, u2;
        const float* hist = PIN(I_SCONV) + ((size_t)pair * 128 + b) * 2 * 512 + ch;
        if (t >= 1) u1 = ld_bf4(cur - LDA + 1024 + ch) * ld_bf4(cur - LDA + ch);
        else if (samp) u1 = *(const f32x4*)(hist + 512); else u1 = (f32x4){0.f, 0.f, 0.f, 0.f};
        if (t >= 2) u2 = ld_bf4(cur - 2 * LDA + 1024 + ch) * ld_bf4(cur - 2 * LDA + ch);
        else if (samp) u2 = *(const f32x4*)(hist + (t == 1 ? 512 : 0)); else u2 = (f32x4){0.f, 0.f, 0.f, 0.f};
        const f32x4 c0 = *(const f32x4*)(cw + ch), c1 = *(const f32x4*)(cw + 512 + ch), c2 = *(const f32x4*)(cw + 1024 + ch);
        const f32x4 conv = c0 * u2 + c1 * u1 + c2 * u0;
        const f32x4 ab = ld_bf4(cur + 512 + ch), az = ld_bf4(cur + 1536 + ch);
        f32x4 o;
#pragma unroll
        for (int j = 0; j < 4; ++j) o[j] = ab[j] * conv[j] * siluf_(az[j]);
        st_bf4(Ycat + (size_t)row * 1024 + ch, o);
        if (t >= T - 2) {
            float* dst = samp ? POUT + O_CONVS + (((size_t)pair * 128 + b) * 2 + (t - (T - 2))) * 512 + ch : POUT + O_CONVP + (((size_t)pair * 8 + b) * 2 + (t - (T - 2))) * 512 + ch;
            *(f32x4*)dst = u0;
        }
    }
}

__device__ void phase_odd_mixer(const Params& p, const Ctx cx, int pair, LAS unsigned char* lds) {
    const int tid = cx.tid, wid = tid >> 6, lane = tid & 63, fr = lane & 15, fq = lane >> 4;
    const bf16_t* PO = (const bf16_t*)(PWS + WS_R1);
    bf16_t* Ycat = (bf16_t*)(PWS + WS_YCAT);
    LAS bf16_t* LA = (LAS bf16_t*)lds;
    LAS bf16_t* LB = (LAS bf16_t*)(lds + 128 * 136 * 2);
    LAS float* stat = (LAS float*)(lds + 2 * 128 * 136 * 2);
    for (int it = cx.bid; it < 1088; it += cx.nblk) {
        const int tile = it >> 3, kind = (it >> 2) & 1, g = it & 3;
        const int r0 = tile * 128;
        const bool samp = r0 >= NTP;
        if (kind == 0) {
            const int w = 2 << g;
            for (int e = tid; e < 128 * 32; e += 512) {
                const int tl = e >> 5, c = (e & 31) * 4, row = r0 + tl;
                int b, t; if (!samp) { b = row >> 11; t = row & 2047; } else { const int q = row - NTP; b = q >> 3; t = q & 7; }
                const bf16_t* cur = PO + (size_t)row * LDA + g * 128 + c;
                const f32x4 pt = ld_bf4(cur);
                f32x4 sum = pt;
                for (int d = 1; d < w; ++d) {
                    const int tt = t - d;
                    if (tt >= 0) sum += ld_bf4(cur - (size_t)d * LDA);
                    else if (samp) sum += *(const f32x4*)(PIN(I_SPOOL) + (((size_t)pair * 128 + b) * 15 + (15 + tt)) * 512 + g * 128 + c);
                }
                const float cnt = samp ? (float)w : fminf((float)w, (float)(t + 1));
                const f32x4 pooled = sum * (1.0f / cnt) - pt;
                u32x2 u; u.x = cvt_pk_bf16(pooled[0], pooled[1]); u.y = cvt_pk_bf16(pooled[2], pooled[3]);
                *(LAS u32x2*)(LA + tl * 136 + c) = u;
            }
            __syncthreads();
            const bf16_t* Bw = (const bf16_t*)(PWS + WS_POOLWT) + ((size_t)pair * 4 + g) * 128 * 128;
            const int row = r0 + wid * 16 + fr;
            bf16x8 af[4];
#pragma unroll
            for (int ks = 0; ks < 4; ++ks) af[ks] = *(const LAS bf16x8*)(LA + (wid * 16 + fr) * 136 + ks * 32 + fq * 8);
#pragma unroll
            for (int nt = 0; nt < 8; ++nt) {
                f32x4 acc = (f32x4){0.f, 0.f, 0.f, 0.f};
#pragma unroll
                for (int ks = 0; ks < 4; ++ks) {
                    const bf16x8 bf = *(const bf16x8*)(Bw + (size_t)(nt * 16 + fr) * 128 + ks * 32 + fq * 8);
                    acc = __builtin_amdgcn_mfma_f32_16x16x32_bf16(bf, af[ks], acc, 0, 0, 0);
                }
                const int d = g * 128 + nt * 16 + fq * 4;
                const f32x4 cz = ld_bf4(PO + (size_t)row * LDA + 512 + d), ps = *(const f32x4*)(PIN(I_PSCALE) + pair * 512 + d);
                f32x4 o;
#pragma unroll
                for (int j = 0; j < 4; ++j) o[j] = acc[j] * ps[j] * siluf_(cz[j]);
                st_bf4(Ycat + (size_t)row * 1024 + d, o);
            }
            __syncthreads();
        } else {
            {
                const int tl = tid >> 2, q = tid & 3;
                const bf16_t* vr = PO + (size_t)(r0 + tl) * LDA + 1536 + q * 128;
                float s = 0.f, ss = 0.f;
#pragma unroll
                for (int i = 0; i < 32; ++i) { const f32x4 v = ld_bf4(vr + i * 4); s += v[0] + v[1] + v[2] + v[3]; ss += dot4(v, v); }
                s = allsum4(s); ss = allsum4(ss);
                const float mean = s * (1.0f / 512.0f);
                const float var = fmaxf(ss * (1.0f / 512.0f) - mean * mean, 0.f);
                if (q == 0) { stat[tl * 2] = mean; stat[tl * 2 + 1] = rsqrtf(var + 1e-5f); }
            }
            __syncthreads();
            {
                const int tl = tid >> 2, q = tid & 3, row = r0 + tl;
                const float mean = stat[tl * 2], rstd = stat[tl * 2 + 1];
                const bf16_t* vr = PO + (size_t)row * LDA + 1536 + g * 128 + q * 32;
                const float* lg = PIN(I_LNG) + pair * 512 + g * 128 + q * 32; const float* lb = PIN(I_LNB) + pair * 512 + g * 128 + q * 32;
#pragma unroll
                for (int i = 0; i < 8; ++i) {
                    const f32x4 v = ld_bf4(vr + i * 4);
                    const f32x4 vn = (v - mean) * rstd * *(const f32x4*)(lg + i * 4) + *(const f32x4*)(lb + i * 4);
                    if (samp) *(f32x4*)(POUT + O_CHUNKV + ((size_t)pair * 1024 + (row - NTP)) * 512 + g * 128 + q * 32 + i * 4) = vn;
#pragma unroll
                    for (int j = 0; j < 4; ++j) LB[(q * 32 + i * 4 + j) * 136 + tl] = (bf16_t)(cvt_pk_bf16(vn[j], 0.f) & 0xffffu);
                }
            }
            if (!samp) {
                const bf16_t* Wsrc = (const bf16_t*)(PWS + WS_SPW) + ((size_t)pair * 4 + g) * 128 * 128;
                for (int e = tid; e < 128 * 16; e += 512) { const int t = e >> 4, s8 = (e & 15) * 8; *(LAS u32x4*)(LA + t * 136 + s8) = *(const u32x4*)(Wsrc + t * 128 + s8); }
            } else {
                const float* Wsrc = PIN(I_SPW) + ((size_t)pair * 4 + g) * 128 * 128;
                for (int e = tid; e < 128 * 128; e += 512) { const int t = e >> 7, s = e & 127;
                    const float v = ((t >> 3) == (s >> 3) && (s & 7) <= (t & 7)) ? Wsrc[(t & 7) * 128 + (s & 7)] : 0.f;
                    LA[t * 136 + s] = (bf16_t)(cvt_pk_bf16(v, 0.f) & 0xffffu); }
            }
            __syncthreads();
            {
                const int tl = wid * 16 + fr, row = r0 + tl;
                const float bias = PIN(I_SPB)[((size_t)pair * 4 + g) * 128 + (samp ? (tl & 7) : tl)];
                bf16x8 wf[4];
#pragma unroll
                for (int ks = 0; ks < 4; ++ks) wf[ks] = *(const LAS bf16x8*)(LA + tl * 136 + ks * 32 + fq * 8);
#pragma unroll
                for (int nt = 0; nt < 8; ++nt) {
                    f32x4 acc = (f32x4){0.f, 0.f, 0.f, 0.f};
#pragma unroll
                    for (int ks = 0; ks < 4; ++ks) {
                        if (ks * 32 <= wid * 16 + 15) {
                            const bf16x8 vf = *(const LAS bf16x8*)(LB + (nt * 16 + fr) * 136 + ks * 32 + fq * 8);
                            acc = __builtin_amdgcn_mfma_f32_16x16x32_bf16(vf, wf[ks], acc, 0, 0, 0);
                        }
                    }
                    const int c = g * 128 + nt * 16 + fq * 4;
                    const f32x4 u = ld_bf4(PO + (size_t)row * LDA + 1024 + c), dz = ld_bf4(PO + (size_t)row * LDA + 2048 + c);
                    f32x4 o;
#pragma unroll
                    for (int j = 0; j < 4; ++j) o[j] = u[j] * (acc[j] + bias) * siluf_(dz[j]);
                    st_bf4(Ycat + (size_t)row * 1024 + 512 + c, o);
                }
            }
            __syncthreads();
        }
    }
    const int gtid = cx.bid * 512 + tid, gthreads = cx.nblk * 512;
    for (int e = gtid; e < 136 * 15 * 512; e += gthreads) {
        const int c = e & 511, q = e >> 9, sr = q / 15, k = q % 15;
        if (sr < 8) POUT[O_POOLP + (((size_t)pair * 8 + sr) * 15 + k) * 512 + c] = bf2f(PO[(size_t)(sr * 2048 + 2033 + k) * LDA + c]);
        else { const int b = sr - 8;
            POUT[O_POOLS + (((size_t)pair * 128 + b) * 15 + k) * 512 + c] = (k < 7) ? PIN(I_SPOOL)[(((size_t)pair * 128 + b) * 15 + 8 + k) * 512 + c] : bf2f(PO[(size_t)(NTP + b * 8 + (k - 7)) * LDA + c]); }
    }
}

__device__ void phase_final(const Params& p, const Ctx cx) {
    const int gtid = cx.bid * 512 + cx.tid, gthreads = cx.nblk * 512;
    const float* ssq = (const float*)(PWS + WS_SSQ) + 4 * NTOK;
    for (int e = gtid; e < NTOK * 256; e += gthreads) {
        const int row = e >> 8, c = (e & 255) * 4;
        const float rstd = rsqrtf(ssq[row] * (1.0f / 1024.0f) + 1e-6f);
        f32x4* px = (f32x4*)(POUT + (size_t)row * 1024 + c);
        *px = *px * rstd * *(const f32x4*)(PIN(I_FNORMW) + c);
    }
}

__device__ void run_gemm_proj(const Params& p, const Ctx cx, LAS unsigned char* lds, const bf16_t* Bt, int N, bf16_t* O, int ldc, int layer) {
    pg8::Gemm g{(const bf16_t*)(PWS + WS_XB), Bt, NTOK, N, 1024};
    pg8::StaticOrder S; S.init(NTOK, N, (int)cx.nblk, (int)cx.bid);
    EpiProj E{O, ldc, (const float*)(PWS + WS_SSQ) + (size_t)layer * NTOK};
    pg8::gemm_phase<EpiProj>(cx, lds, g, S, E);
}
__device__ void run_gemm_res(const Params& p, const Ctx cx, LAS unsigned char* lds, const bf16_t* Bt, int layer) {
    pg8::Gemm g{(const bf16_t*)(PWS + WS_YCAT), Bt, NTOK, 1024, 1024};
    pg8::StaticOrder S; S.init(NTOK, 1024, (int)cx.nblk, (int)cx.bid);
    EpiRes E{layer == 0 ? PIN(I_XP) : nullptr, PIN(I_XS), POUT, (bf16_t*)(PWS + WS_XB), (float*)(PWS + WS_SSQ) + (size_t)(layer + 1) * NTOK};
    pg8::gemm_phase<EpiRes>(cx, lds, g, S, E);
}

constexpr int N_PHASES = 20;
#ifndef PHMASK
#define PHMASK 0xffff
#endif
#define PHON(n) ((PHMASK >> ((n) % 16)) & 1)
__global__ void __launch_bounds__(512, 2) fwd_kernel(Params p) {
    extern __shared__ __attribute__((aligned(16))) unsigned char lds_raw[];
    LAS unsigned char* lds = (LAS unsigned char*)lds_raw;
    for (int ph = p.ph_lo; ph < p.ph_hi; ++ph) {
        if (ph > p.ph_lo) cg::this_grid().sync();
        Ctx cx; cx.tid = threadIdx.x; cx.bid = blockIdx.x; cx.nblk = gridDim.x;
        asm volatile("s_mov_b32 %0, 0" : "=s"(cx.z));
        asm volatile("" : "+v"(cx.tid)); asm volatile("" : "+s"(cx.bid)); asm volatile("" : "+s"(cx.nblk));
        const int pair = (ph - 1) / 9, s = (ph == 0) ? 100 : (ph == N_PHASES - 1 ? 101 : (ph - 1) % 9);
        if (s == 0 || s == 3 || s == 6) {
#if PHON(0)
            const bf16_t* WinE = (const bf16_t*)(PWS + WS_WINE) + (size_t)pair * 4352 * 1024;
            const bf16_t* Bt = s == 0 ? WinE + (size_t)2560 * 1024 : (s == 3 ? WinE : (const bf16_t*)(PWS + WS_WINO) + (size_t)pair * 2560 * 1024);
            const int N = s == 0 ? 1792 : 2560;
            run_gemm_proj(p, cx, lds, Bt, N, (bf16_t*)(PWS + WS_R1), N, 2 * pair + (s == 6 ? 1 : 0));
#endif
        } else if (s == 5 || s == 8) {
#if PHON(5)
            const bf16_t* Bt = (const bf16_t*)(PWS + (s == 5 ? WS_WOUTE : WS_WOUTO)) + (size_t)pair * 1024 * 1024;
            run_gemm_res(p, cx, lds, Bt, 2 * pair + (s == 8 ? 1 : 0));
#endif
        } else if (s == 1) {
#if PHON(1)
            phase_even_prep(p, cx, pair);
#endif
        } else if (s == 2) {
#if PHON(2)
            phase_scan(p, cx, pair, lds);
#endif
        } else if (s == 4) {
#if PHON(4)
            phase_even_post(p, cx, pair);
#endif
        } else if (s == 7) {
#if PHON(7)
            phase_odd_mixer(p, cx, pair, lds);
#endif
        } else if (s == 100) {
#if PHON(10)
            phase_prepass(p, cx, lds);
#endif
        } else {
#if PHON(11)
            phase_final(p, cx);
#endif
        }
    }
}

extern "C" void kernel_launch(void* const* d_in, const int* in_sizes, int n_in, void* d_out, int out_size, void* d_ws, size_t ws_size, hipStream_t stream) {
    static int grid = 0;
    if (grid == 0) {
        if (n_in != 29 || ws_size < WS_END) { fprintf(stderr, "kernel_launch: unexpected n_in %d / ws_size %zu (need %zu)\n", n_in, ws_size, (size_t)WS_END); grid = -1; return; }
        int dev = 0, cus = 0, per_cu = 0;
        hipGetDevice(&dev);
        hipDeviceGetAttribute(&cus, hipDeviceAttributeMultiprocessorCount, dev);
        if (hipFuncSetAttribute((const void*)fwd_kernel, hipFuncAttributeMaxDynamicSharedMemorySize, LDS_BYTES) != hipSuccess) { fprintf(stderr, "kernel_launch: hipFuncSetAttribute failed\n"); grid = -1; return; }
        if (hipOccupancyMaxActiveBlocksPerMultiprocessor(&per_cu, (const void*)fwd_kernel, 512, LDS_BYTES) != hipSuccess || per_cu < 1) { fprintf(stderr, "kernel_launch: occupancy query gave %d\n", per_cu); per_cu = 1; }
        (void)hipGetLastError();
        grid = cus * per_cu;
        if (grid > 256) grid = 256;
    }
    if (grid < 0) return;
    Params p{};
    for (int i = 0; i < 29; ++i) p.ptr[i] = d_in[i];
    p.ptr[29] = d_out; p.ptr[30] = d_ws; p.ptr[31] = nullptr;
#if ONE_LAUNCH
    p.ph_lo = 0; p.ph_hi = N_PHASES;
    void* args[] = {&p};
    hipError_t e = hipLaunchCooperativeKernel((const void*)fwd_kernel, dim3(grid), dim3(512), args, LDS_BYTES, stream);
    if (e != hipSuccess) fprintf(stderr, "cooperative launch failed: %s (grid %d)\n", hipGetErrorString(e), grid);
#else
    for (int ph = 0; ph < N_PHASES; ++ph) {
        p.ph_lo = ph; p.ph_hi = ph + 1;
        hipLaunchKernelGGL(fwd_kernel, dim3(grid), dim3(512), LDS_BYTES, stream, p);
    }
#endif
}
```

```cpp
#include <hip/hip_runtime.h>
#include <hip/hip_cooperative_groups.h>
#include <cstdio>
namespace cg = cooperative_groups;

#ifndef ONE_LAUNCH
#define ONE_LAUNCH 1
#endif

#define LAS __attribute__((address_space(3)))
typedef unsigned short bf16_t;
typedef short bf16x8 __attribute__((ext_vector_type(8)));
typedef float f32x4 __attribute__((ext_vector_type(4)));
typedef unsigned u32x4 __attribute__((ext_vector_type(4)));
typedef unsigned u32x2 __attribute__((ext_vector_type(2)));

constexpr int NTOK = 17408, NTP = 16384;
constexpr int LDB = 1792;
constexpr int LDA = 2560;
constexpr size_t O_CONVP = 17825792, O_CONVS = 17842176, O_SHIFTP = 18104320, O_SHIFTS = 18130944, O_WKVP = 18556928, O_WKVS = 19081216,
                 O_POOLP = 27469824, O_POOLS = 27592704, O_CHUNKV = 29558784;
constexpr size_t WS_WINE = 0;
constexpr size_t WS_WOUTE = WS_WINE + 2ull * 4352 * 1024 * 2;
constexpr size_t WS_WINO = WS_WOUTE + 2ull * 1024 * 1024 * 2;
constexpr size_t WS_WOUTO = WS_WINO + 2ull * 2560 * 1024 * 2;
constexpr size_t WS_W2T = WS_WOUTO + 2ull * 1024 * 1024 * 2;
constexpr size_t WS_A2T = WS_W2T + 2ull * 512 * 64 * 2;
constexpr size_t WS_POOLWT = WS_A2T + 2ull * 512 * 64 * 2;
constexpr size_t WS_SPW = WS_POOLWT + 8ull * 128 * 128 * 2;
constexpr size_t WS_XB = WS_SPW + 8ull * 128 * 128 * 2;
constexpr size_t WS_YCAT = WS_XB + (size_t)NTOK * 1024 * 2;
constexpr size_t WS_SSQ = WS_YCAT + (size_t)NTOK * 1024 * 2;
constexpr size_t WS_Y = WS_SSQ + 5ull * NTOK * 4;
constexpr size_t WS_R1 = WS_Y + (size_t)NTOK * 512 * 4;
constexpr size_t WS_PROJB = WS_R1;
constexpr size_t WS_WDEC = WS_PROJB + (size_t)NTOK * LDB * 2;
constexpr size_t WS_AA = WS_WDEC + (size_t)NTOK * 512 * 4;
constexpr size_t WS_BAR = WS_AA + (size_t)NTOK * 512 * 2;
constexpr size_t WS_END = WS_BAR + 16384;
constexpr int LDS_BYTES = 131072 + 16;

struct Params {
    const void* ptr[32];
    int ph_lo, ph_hi;
};
struct Ctx { int tid, bid, nblk, z; };
#define PIN(i) ((const float*)p.ptr[(i) + cx.z])
#define POUT ((float*)p.ptr[29 + cx.z])
#define PWS ((unsigned char*)p.ptr[30 + cx.z])
enum { I_XP = 0, I_XS, I_SCONV, I_SSHIFT, I_SWKV, I_SPOOL, I_NORMW, I_FNORMW, I_WINE, I_CONVW, I_MU, I_W0, I_W2, I_A0, I_A2, I_KK, I_KA, I_RK, I_GNG, I_GNB,
       I_WOUTE, I_WINO, I_POOLW, I_PSCALE, I_LNG, I_LNB, I_SPW, I_SPB, I_WOUTO };

__device__ __forceinline__ unsigned cvt_pk_bf16(float lo, float hi) { unsigned r; asm("v_cvt_pk_bf16_f32 %0, %1, %2" : "=v"(r) : "v"(lo), "v"(hi)); return r; }
__device__ __forceinline__ float bf_lo(unsigned u) { return __uint_as_float(u << 16); }
__device__ __forceinline__ float bf_hi(unsigned u) { return __uint_as_float(u & 0xffff0000u); }
__device__ __forceinline__ float bf2f(bf16_t b) { return __uint_as_float(((unsigned)b) << 16); }
__device__ __forceinline__ f32x4 cvt4(u32x2 u) { return (f32x4){bf_lo(u.x), bf_hi(u.x), bf_lo(u.y), bf_hi(u.y)}; }
__device__ __forceinline__ f32x4 ld_bf4(const bf16_t* p) { return cvt4(*(const u32x2*)p); }
__device__ __forceinline__ void st_bf4(bf16_t* p, f32x4 v) { u32x2 u; u.x = cvt_pk_bf16(v[0], v[1]); u.y = cvt_pk_bf16(v[2], v[3]); *(u32x2*)p = u; }
__device__ __forceinline__ float sigmoidf_(float x) { return 1.0f / (1.0f + __expf(-x)); }
__device__ __forceinline__ float siluf_(float x) { return x / (1.0f + __expf(-x)); }
template <int CTRL> __device__ __forceinline__ float dpp_f(float x) { return __builtin_bit_cast(float, __builtin_amdgcn_mov_dpp(__builtin_bit_cast(int, x), CTRL, 0xf, 0xf, true)); }
__device__ __forceinline__ float allsum16(float x) { x += dpp_f<0xB1>(x); x += dpp_f<0x4E>(x); x += dpp_f<0x141>(x); x += dpp_f<0x128>(x); return x; }
__device__ __forceinline__ float allsum4(float x) { x += dpp_f<0xB1>(x); x += dpp_f<0x4E>(x); return x; }
__device__ __forceinline__ float dot4(f32x4 a, f32x4 b) { return a[0] * b[0] + a[1] * b[1] + a[2] * b[2] + a[3] * b[3]; }

namespace pg8 {
constexpr int BM = 256, BK = 64, HALF = 128, HTB = HALF * BK * 2, NXCD = 8, WGM = 8;
__device__ __forceinline__ int lds_byte(int r, int c) { const int st = (r >> 4) * 2 + (c >> 5), rr = r & 15, cc = c & 31, ob = rr * 64 + cc * 2; return st * 1024 + (ob ^ (((ob >> 9) & 1) << 5)); }
__device__ __forceinline__ void stage_rc(int b, int& R, int& C) { const int st = b / 1024, sb = b % 1024, swz = sb ^ (((sb >> 9) & 1) << 5); R = (st >> 1) * 16 + swz / 64; C = (st & 1) * 32 + (swz % 64) / 2; }
__device__ __forceinline__ int perm32(int rho) { const int n = rho >> 4, i = rho & 15; return 8 * (i >> 2) + 4 * n + (i & 3); }
struct Unit { int pm, pn; };
struct Gemm { const bf16_t* A; const bf16_t* Bt; int M, N, K; };
struct StaticOrder {
    int nM, nN, nwg, G, c;
    __device__ void init(int M, int N, int G_, int c_) { nM = M / BM; nN = N / BM; nwg = nM * nN; G = G_; c = c_; }
    __device__ bool next(int i, Unit& u) const {
        const long L = (long)i * G + c; if (L >= nwg) return false;
        int wgid = (int)L; { const int q = nwg / NXCD, r = nwg % NXCD, xcd = wgid % NXCD, off = wgid / NXCD; wgid = (xcd < r ? xcd * (q + 1) : r * (q + 1) + (xcd - r) * q) + off; }
        const int nig = WGM * nN, gid = wgid / nig, fm = gid * WGM, gsz = (nM - fm) < WGM ? (nM - fm) : WGM;
        u.pm = fm + ((wgid % nig) % gsz); u.pn = (wgid % nig) / gsz; return true;
    }
};

template <class Epi>
__device__ __forceinline__ void gemm_phase(const Ctx cx, LAS unsigned char* lds, const Gemm g, const StaticOrder& S, const Epi& E) {
    const int tid = cx.tid, wid = __builtin_amdgcn_readfirstlane(tid >> 6), lane = tid & 63, wr = wid >> 2, wc = wid & 3, fr = lane & 15, fq = lane >> 4;
    const int K = g.K, nt = K / BK;
    unsigned voffA[2], voffB[2];
#pragma unroll
    for (int i = 0; i < 2; ++i) { int R, C; stage_rc(tid * 16 + i * 8192, R, C); const int Rb = Epi::PERM ? ((R & ~31) + perm32(R & 31)) : R;
        voffA[i] = (unsigned)(R * K + C) * 2u; voffB[i] = (unsigned)(Rb * K + C) * 2u; }
    const size_t kstep = (size_t)(BK * 2);
    const size_t hstep = (size_t)HALF * K * 2;
    const size_t tstep = 2 * hstep;
    const unsigned ldsw = (unsigned)wid * 1024u;
    const int aoff = lds_byte(wr * 64 + fr, fq * 8), boff = lds_byte(wc * 32 + fr, fq * 8);
#define PG8_SA(b, h) (((b) * 2 + (h)) * HTB)
#define PG8_SB(b, h) ((4 + (b) * 2 + (h)) * HTB)
#define PG8_STAGE(bufoff, gbase, voff) do { _Pragma("unroll") for (int _i = 0; _i < 2; ++_i) \
        __builtin_amdgcn_global_load_lds((const unsigned*)((const char*)(gbase) + (voff)[_i]), (LAS unsigned*)(lds + (bufoff) + ldsw + _i * 8192), 16, 0, 0); } while (0)
#define PG8_LDA(dst, b, h) do { _Pragma("unroll") for (int m = 0; m < 4; ++m) _Pragma("unroll") for (int k = 0; k < 2; ++k) dst[m][k] = *(const LAS bf16x8*)(lds + PG8_SA(b, h) + aoff + m * 2048 + k * 1024); } while (0)
#define PG8_LDB(dst, b, h) do { _Pragma("unroll") for (int n = 0; n < 2; ++n) _Pragma("unroll") for (int k = 0; k < 2; ++k) dst[n][k] = *(const LAS bf16x8*)(lds + PG8_SB(b, h) + boff + n * 2048 + k * 1024); } while (0)
#define PG8_MMA(ai, bj, At, Bt) do { __builtin_amdgcn_s_setprio(1); _Pragma("unroll") for (int m = 0; m < 4; ++m) _Pragma("unroll") for (int n = 0; n < 2; ++n) _Pragma("unroll") for (int k = 0; k < 2; ++k) \
        acc[ai][bj][m][n] = __builtin_amdgcn_mfma_f32_16x16x32_bf16(Bt[n][k], At[m][k], acc[ai][bj][m][n], 0, 0, 0); __builtin_amdgcn_s_setprio(0); } while (0)
#define PG8_WAIT_V(n) asm volatile("s_waitcnt vmcnt(" #n ")" ::: "memory")
#define PG8_WAIT_L(n) asm volatile("s_waitcnt lgkmcnt(" #n ")" ::: "memory")
#define PG8_BAR __builtin_amdgcn_s_barrier()
#define PG8_SCHED __builtin_amdgcn_sched_barrier(0)
    Unit cur, nxt; int ui = 0;
    if (!S.next(0, cur)) return;
    f32x4 acc[2][2][4][2];
#pragma unroll
    for (int a = 0; a < 2; ++a)
#pragma unroll
        for (int b = 0; b < 2; ++b)
#pragma unroll
            for (int m = 0; m < 4; ++m)
#pragma unroll
                for (int n = 0; n < 2; ++n) acc[a][b][m][n] = (f32x4){0.f, 0.f, 0.f, 0.f};
    bf16x8 At[4][2], B0[2][2], B1[2][2];
    const char* cA = (const char*)g.A + (size_t)cur.pm * tstep; const char* cB = (const char*)g.Bt + (size_t)cur.pn * tstep;
    PG8_STAGE(PG8_SB(0, 0), cB, voffB); PG8_STAGE(PG8_SA(0, 0), cA, voffA); PG8_STAGE(PG8_SB(0, 1), cB + hstep, voffB); PG8_STAGE(PG8_SA(0, 1), cA + hstep, voffA);
    if (wr == 1) PG8_BAR;
    PG8_WAIT_V(4); PG8_BAR;
    PG8_STAGE(PG8_SB(1, 0), cB + kstep, voffB); PG8_STAGE(PG8_SA(1, 0), cA + kstep, voffA); PG8_STAGE(PG8_SB(1, 1), cB + hstep + kstep, voffB);
    PG8_WAIT_V(6); PG8_BAR;
    for (;;) {
        const bool has_next = S.next(ui + 1, nxt);
        const char* nA = has_next ? (const char*)g.A + (size_t)nxt.pm * tstep : cA; const char* nB = has_next ? (const char*)g.Bt + (size_t)nxt.pn * tstep : cB;
        for (int t = 0; t < nt; t += 2) {
            const bool last = (t == nt - 2);
            const char* a1 = cA + (size_t)(t + 1) * kstep;
            const char* a2 = last ? nA : cA + (size_t)(t + 2) * kstep; const char* b2 = last ? nB : cB + (size_t)(t + 2) * kstep;
            const char* a3 = a2 + kstep; const char* b3 = b2 + kstep;
            PG8_LDB(B0, 0, 0); PG8_SCHED; PG8_LDA(At, 0, 0); PG8_STAGE(PG8_SA(1, 1), a1 + hstep, voffA);
            PG8_WAIT_L(8); PG8_BAR; PG8_WAIT_L(0); PG8_MMA(0, 0, At, B0); PG8_BAR; PG8_SCHED;
            PG8_LDB(B1, 0, 1); PG8_STAGE(PG8_SB(0, 0), b2, voffB);
            PG8_BAR; PG8_WAIT_L(0); PG8_MMA(0, 1, At, B1); PG8_BAR;
            PG8_LDA(At, 0, 1); PG8_STAGE(PG8_SA(0, 0), a2, voffA);
            PG8_BAR; PG8_WAIT_L(0); PG8_MMA(1, 0, At, B0); PG8_BAR; PG8_SCHED;
            PG8_STAGE(PG8_SB(0, 1), b2 + hstep, voffB);
            PG8_WAIT_V(6); PG8_BAR; PG8_MMA(1, 1, At, B1); PG8_BAR;
            PG8_LDB(B0, 1, 0); PG8_SCHED; PG8_LDA(At, 1, 0); PG8_STAGE(PG8_SA(0, 1), a2 + hstep, voffA);
            PG8_WAIT_L(8); PG8_BAR; PG8_WAIT_L(0); PG8_MMA(0, 0, At, B0); PG8_BAR; PG8_SCHED;
            PG8_LDB(B1, 1, 1); PG8_STAGE(PG8_SB(1, 0), b3, voffB);
            PG8_BAR; PG8_WAIT_L(0); PG8_MMA(0, 1, At, B1); PG8_BAR;
            PG8_LDA(At, 1, 1); PG8_STAGE(PG8_SA(1, 0), a3, voffA);
            PG8_BAR; PG8_WAIT_L(0); PG8_MMA(1, 0, At, B0); PG8_BAR; PG8_SCHED;
            PG8_STAGE(PG8_SB(1, 1), b3 + hstep, voffB);
            PG8_WAIT_V(6); PG8_BAR; PG8_MMA(1, 1, At, B1); PG8_BAR;
        }
        E(acc, cur, wr, wc, fr, fq);
        if (!has_next) break;
#pragma unroll
        for (int a = 0; a < 2; ++a)
#pragma unroll
            for (int b = 0; b < 2; ++b)
#pragma unroll
                for (int m = 0; m < 4; ++m)
#pragma unroll
                    for (int n = 0; n < 2; ++n) acc[a][b][m][n] = (f32x4){0.f, 0.f, 0.f, 0.f};
        cur = nxt; cA = nA; cB = nB; ++ui;
    }
    PG8_WAIT_V(0);
    if (wr == 0) PG8_BAR;
    PG8_BAR;
#undef PG8_SA
#undef PG8_SB
#undef PG8_STAGE
#undef PG8_LDA
#undef PG8_LDB
#undef PG8_MMA
#undef PG8_WAIT_V
#undef PG8_WAIT_L
#undef PG8_BAR
#undef PG8_SCHED
}
}

struct EpiProj {
    static constexpr bool PERM = true;
    bf16_t* O; int ldc; const float* ssq;
    __device__ __forceinline__ void operator()(const f32x4 (&acc)[2][2][4][2], const pg8::Unit& u, int wr, int wc, int fr, int fq) const {
        const int row0 = u.pm * 256 + wr * 64 + fr, col0 = u.pn * 256 + wc * 32 + 8 * fq;
#pragma unroll
        for (int ai = 0; ai < 2; ++ai)
#pragma unroll
            for (int m = 0; m < 4; ++m) {
                const int row = row0 + ai * 128 + m * 16;
                const float rstd = rsqrtf(ssq[row] * (1.0f / 1024.0f) + 1e-6f);
                bf16_t* rowp = O + (size_t)row * ldc + col0;
#pragma unroll
                for (int bj = 0; bj < 2; ++bj) {
                    const f32x4 v0 = acc[ai][bj][m][0] * rstd, v1 = acc[ai][bj][m][1] * rstd;
                    u32x4 w; w.x = cvt_pk_bf16(v0[0], v0[1]); w.y = cvt_pk_bf16(v0[2], v0[3]); w.z = cvt_pk_bf16(v1[0], v1[1]); w.w = cvt_pk_bf16(v1[2], v1[3]);
                    *(u32x4*)(rowp + bj * 128) = w;
                }
            }
    }
};
struct EpiRes {
    static constexpr bool PERM = false;
    const float* xp; const float* xs; float* Xf; bf16_t* Xb; float* ssq_next;
    __device__ __forceinline__ void operator()(const f32x4 (&acc)[2][2][4][2], const pg8::Unit& u, int wr, int wc, int fr, int fq) const {
        const int row0 = u.pm * 256 + wr * 64 + fr, col0 = u.pn * 256 + wc * 32 + 4 * fq;
#pragma unroll
        for (int ai = 0; ai < 2; ++ai)
#pragma unroll
            for (int m = 0; m < 4; ++m) {
                const int row = row0 + ai * 128 + m * 16;
                const float* src = xp ? (row < NTP ? xp + (size_t)row * 1024 : xs + (size_t)(row - NTP) * 1024) : Xf + (size_t)row * 1024;
                float part = 0.f;
#pragma unroll
                for (int bj = 0; bj < 2; ++bj)
#pragma unroll
                    for (int n = 0; n < 2; ++n) {
                        const int col = col0 + bj * 128 + n * 16;
                        const f32x4 x = *(const f32x4*)(src + col) + acc[ai][bj][m][n];
                        *(f32x4*)(Xf + (size_t)row * 1024 + col) = x;
                        st_bf4(Xb + (size_t)row * 1024 + col, x);
                        part += dot4(x, x);
                    }
                part += __shfl_xor(part, 16); part += __shfl_xor(part, 32);
                if (fq == 0) atomicAdd(ssq_next + row, part);
            }
    }
};

__device__ __forceinline__ void tr_tile(const Ctx cx, LAS float* T, const float* src, int ld, int col0, int k0, bf16_t* dst, int Ktot, int drow0, const float* scale, bool zero) {
    const int tid = cx.tid;
    if (zero) {
        const int n = tid >> 3, kc = (tid & 7) * 8;
        *(u32x4*)(dst + (size_t)(drow0 + n) * Ktot + k0 + kc) = (u32x4){0u, 0u, 0u, 0u};
        return;
    }
#pragma unroll
    for (int pass = 0; pass < 2; ++pass) {
        const int kk = (tid >> 4) + pass * 32, nn = (tid & 15) * 4;
        f32x4 v = *(const f32x4*)(src + (size_t)(k0 + kk) * ld + col0 + nn);
        if (scale) v = v * scale[k0 + kk];
        T[kk * 65 + nn] = v[0]; T[kk * 65 + nn + 1] = v[1]; T[kk * 65 + nn + 2] = v[2]; T[kk * 65 + nn + 3] = v[3];
    }
    __syncthreads();
    {
        const int n = tid >> 3, kc = (tid & 7) * 8;
        u32x4 w;
        w.x = cvt_pk_bf16(T[(kc + 0) * 65 + n], T[(kc + 1) * 65 + n]); w.y = cvt_pk_bf16(T[(kc + 2) * 65 + n], T[(kc + 3) * 65 + n]);
        w.z = cvt_pk_bf16(T[(kc + 4) * 65 + n], T[(kc + 5) * 65 + n]); w.w = cvt_pk_bf16(T[(kc + 6) * 65 + n], T[(kc + 7) * 65 + n]);
        *(u32x4*)(dst + (size_t)(drow0 + n) * Ktot + k0 + kc) = w;
    }
    __syncthreads();
}

__device__ void phase_prepass(const Params& p, const Ctx cx, LAS unsigned char* lds) {
    LAS float* T = (LAS float*)lds;
    const int tid = cx.tid;
    for (int job = cx.bid; job < 4544; job += cx.nblk) {
        int j = job;
        if (j < 2176) {
            const int i = j / 1088, r = j % 1088, nt = r / 16, kt = r % 16;
            const int n0 = nt * 64;
            int col0; bool zero = false;
            if (n0 < 2048) col0 = n0; else if (n0 < 2560) col0 = 3712 + (n0 - 2048); else if (n0 < 4224) col0 = 2048 + (n0 - 2560); else { col0 = 0; zero = true; }
            tr_tile(cx, T, PIN(I_WINE) + (size_t)i * 1024 * 4224, 4224, col0, kt * 64, (bf16_t*)(PWS + WS_WINE) + (size_t)i * 4352 * 1024, 1024, n0, PIN(I_NORMW) + (2 * i) * 1024, zero);
            continue;
        }
        j -= 2176;
        if (j < 512) { const int i = j / 256, r = j % 256, nt = r / 16, kt = r % 16;
            tr_tile(cx, T, PIN(I_WOUTE) + (size_t)i * 1024 * 1024, 1024, nt * 64, kt * 64, (bf16_t*)(PWS + WS_WOUTE) + (size_t)i * 1024 * 1024, 1024, nt * 64, nullptr, false); continue; }
        j -= 512;
        if (j < 1280) { const int i = j / 640, r = j % 640, nt = r / 16, kt = r % 16;
            tr_tile(cx, T, PIN(I_WINO) + (size_t)i * 1024 * 2560, 2560, nt * 64, kt * 64, (bf16_t*)(PWS + WS_WINO) + (size_t)i * 2560 * 1024, 1024, nt * 64, PIN(I_NORMW) + (2 * i + 1) * 1024, false); continue; }
        j -= 1280;
        if (j < 512) { const int i = j / 256, r = j % 256, nt = r / 16, kt = r % 16;
            tr_tile(cx, T, PIN(I_WOUTO) + (size_t)i * 1024 * 1024, 1024, nt * 64, kt * 64, (bf16_t*)(PWS + WS_WOUTO) + (size_t)i * 1024 * 1024, 1024, nt * 64, nullptr, false); continue; }
        j -= 512;
        if (j < 16) { const int i = j / 8, nt = j % 8;
            tr_tile(cx, T, PIN(I_W2) + (size_t)i * 64 * 512, 512, nt * 64, 0, (bf16_t*)(PWS + WS_W2T) + (size_t)i * 512 * 64, 64, nt * 64, nullptr, false); continue; }
        j -= 16;
        if (j < 16) { const int i = j / 8, nt = j % 8;
            tr_tile(cx, T, PIN(I_A2) + (size_t)i * 64 * 512, 512, nt * 64, 0, (bf16_t*)(PWS + WS_A2T) + (size_t)i * 512 * 64, 64, nt * 64, nullptr, false); continue; }
        j -= 16;
        { const int ig = j / 4, r = j % 4, nt = r / 2, kt = r % 2;
            tr_tile(cx, T, PIN(I_POOLW) + (size_t)ig * 128 * 128, 128, nt * 64, kt * 64, (bf16_t*)(PWS + WS_POOLWT) + (size_t)ig * 128 * 128, 128, nt * 64, nullptr, false); }
    }
    const int gtid = cx.bid * 512 + tid, gthreads = cx.nblk * 512;
    for (int e = gtid; e < 8 * 128 * 128; e += gthreads) {
        const int s = e & 127, t = (e >> 7) & 127;
        ((bf16_t*)(PWS + WS_SPW))[e] = (s <= t) ? (bf16_t)(cvt_pk_bf16(PIN(I_SPW)[e], 0.f) & 0xffffu) : (bf16_t)0;
    }
    for (int e = gtid; e < 4 * NTOK; e += gthreads) ((float*)(PWS + WS_SSQ))[NTOK + e] = 0.f;
    const int wid = tid >> 6, lane = tid & 63;
    for (int row = cx.bid * 8 + wid; row < NTOK; row += cx.nblk * 8) {
        const float* src = row < NTP ? PIN(I_XP) + (size_t)row * 1024 : PIN(I_XS) + (size_t)(row - NTP) * 1024;
        bf16_t* dst = (bf16_t*)(PWS + WS_XB) + (size_t)row * 1024;
        float ss = 0.f;
#pragma unroll
        for (int i = 0; i < 4; ++i) { const f32x4 v = *(const f32x4*)(src + i * 256 + lane * 4); ss += dot4(v, v); st_bf4(dst + i * 256 + lane * 4, v); }
#pragma unroll
        for (int o = 32; o >= 1; o >>= 1) ss += __shfl_xor(ss, o);
        if (lane == 0) ((float*)(PWS + WS_SSQ))[row] = ss;
    }
}

__device__ __forceinline__ f32x4 shift4(const bf16_t* cur, bool hp, const float* st, int col, const float* mu) {
    const f32x4 q = ld_bf4(cur + col);
    f32x4 pv;
    if (hp) pv = ld_bf4(cur - LDB + col); else if (st) pv = *(const f32x4*)(st + col); else pv = (f32x4){0.f, 0.f, 0.f, 0.f};
    const f32x4 m = *(const f32x4*)(mu + col);
    return q + m * (pv - q);
}

__device__ void phase_even_prep(const Params& p, const Ctx cx, int pair) {
    const int tid = cx.tid, wid = tid >> 6, lane = tid & 63, fr = lane & 15, fq = lane >> 4;
    const bf16_t* PB = (const bf16_t*)(PWS + WS_PROJB);
    float* Wdec = (float*)(PWS + WS_WDEC);
    bf16_t* Aa = (bf16_t*)(PWS + WS_AA);
    bf16_t* Ycat = (bf16_t*)(PWS + WS_YCAT);
    const float* mu = PIN(I_MU) + pair * 1664;
    const bf16_t* W2T = (const bf16_t*)(PWS + WS_W2T) + (size_t)pair * 512 * 64;
    const bf16_t* A2T = (const bf16_t*)(PWS + WS_A2T) + (size_t)pair * 512 * 64;
    const float* w0 = PIN(I_W0) + pair * 512; const float* a0 = PIN(I_A0) + pair * 512;
    const float* k_a = PIN(I_KA) + pair * 512; const float* r_k = PIN(I_RK) + pair * 512;
    for (int unit = cx.bid * 8 + wid; unit < NTOK / 16; unit += cx.nblk * 8) {
        const int row = unit * 16 + fr;
        const bool samp = row >= NTP;
        int b, t; if (!samp) { b = row >> 11; t = row & 2047; } else { const int q = row - NTP; b = q >> 3; t = q & 7; }
        const bf16_t* cur = PB + (size_t)row * LDB;
        const bool hp = t > 0;
        const float* st = samp ? PIN(I_SSHIFT) + ((size_t)pair * 128 + b) * 1664 : nullptr;
        bf16x8 Aw[2], Al[2];
#pragma unroll
        for (int ks = 0; ks < 2; ++ks) {
            const int cw = 1536 + ks * 32 + fq * 8, ca = 1600 + ks * 32 + fq * 8;
            const f32x4 w_lo = shift4(cur, hp, st, cw, mu), w_hi = shift4(cur, hp, st, cw + 4, mu);
            const f32x4 a_lo = shift4(cur, hp, st, ca, mu), a_hi = shift4(cur, hp, st, ca + 4, mu);
            u32x4 pw, pa;
            float th[8];
#pragma unroll
            for (int j = 0; j < 4; ++j) { th[j] = 2.0f * sigmoidf_(2.0f * w_lo[j]) - 1.0f; th[4 + j] = 2.0f * sigmoidf_(2.0f * w_hi[j]) - 1.0f; }
            pw.x = cvt_pk_bf16(th[0], th[1]); pw.y = cvt_pk_bf16(th[2], th[3]); pw.z = cvt_pk_bf16(th[4], th[5]); pw.w = cvt_pk_bf16(th[6], th[7]);
            pa.x = cvt_pk_bf16(a_lo[0], a_lo[1]); pa.y = cvt_pk_bf16(a_lo[2], a_lo[3]); pa.z = cvt_pk_bf16(a_hi[0], a_hi[1]); pa.w = cvt_pk_bf16(a_hi[2], a_hi[3]);
            Aw[ks] = __builtin_bit_cast(bf16x8, pw); Al[ks] = __builtin_bit_cast(bf16x8, pa);
        }
#pragma unroll 1
        for (int h = 0; h < 8; ++h) {
            float bon = 0.f;
#pragma unroll 1
            for (int nt = 0; nt < 4; ++nt) {
                const int n0 = h * 64 + nt * 16;
                f32x4 lw = (f32x4){0.f, 0.f, 0.f, 0.f}, la = (f32x4){0.f, 0.f, 0.f, 0.f};
#pragma unroll
                for (int ks = 0; ks < 2; ++ks) {
                    const bf16x8 wf = *(const bf16x8*)(W2T + (size_t)(n0 + fr) * 64 + ks * 32 + fq * 8);
                    const bf16x8 af = *(const bf16x8*)(A2T + (size_t)(n0 + fr) * 64 + ks * 32 + fq * 8);
                    lw = __builtin_amdgcn_mfma_f32_16x16x32_bf16(wf, Aw[ks], lw, 0, 0, 0);
                    la = __builtin_amdgcn_mfma_f32_16x16x32_bf16(af, Al[ks], la, 0, 0, 0);
                }
                const int ch = n0 + fq * 4;
                const f32x4 r4 = shift4(cur, hp, st, ch, mu), k4 = shift4(cur, hp, st, 512 + ch, mu);
                const f32x4 w04 = *(const f32x4*)(w0 + ch), a04 = *(const f32x4*)(a0 + ch), ka4 = *(const f32x4*)(k_a + ch), rk4 = *(const f32x4*)(r_k + ch);
                f32x4 dec, av;
#pragma unroll
                for (int j = 0; j < 4; ++j) {
                    const float z_ = -(w04[j] + lw[j]);
                    const float wlog = -__logf(1.0f + __expf(z_)) - 0.5f;
                    dec[j] = __expf(-__expf(wlog));
                    av[j] = sigmoidf_(a04[j] + la[j]);
                    const float kp = k4[j] * (1.0f + (av[j] - 1.0f) * ka4[j]);
                    bon += r4[j] * kp * rk4[j];
                }
                *(f32x4*)(Wdec + (size_t)row * 512 + ch) = dec;
                st_bf4(Aa + (size_t)row * 512 + ch, av);
            }
            bon += __shfl_xor(bon, 16); bon += __shfl_xor(bon, 32);
#pragma unroll 1
            for (int nt = 0; nt < 4; ++nt) {
                const int ch = h * 64 + nt * 16 + fq * 4;
                st_bf4(Ycat + (size_t)row * 1024 + 512 + ch, shift4(cur, hp, st, 1024 + ch, mu) * bon);
            }
        }
    }
    const int gtid = cx.bid * 512 + tid, gthreads = cx.nblk * 512;
    for (int e = gtid; e < 136 * 1664; e += gthreads) {
        const int sr = e / 1664, c = e % 1664;
        if (sr < 8) POUT[O_SHIFTP + ((size_t)pair * 8 + sr) * 1664 + c] = bf2f(PB[(size_t)(sr * 2048 + 2047) * LDB + c]);
        else { const int b = sr - 8; POUT[O_SHIFTS + ((size_t)pair * 128 + b) * 1664 + c] = bf2f(PB[(size_t)(NTP + b * 8 + 7) * LDB + c]); }
    }
}

__device__ __forceinline__ void scan_step(f32x4& S, const f32x4 w, const f32x4 k, const f32x4 kk, const f32x4 bb, const f32x4 r, const float v, float& y) {
    float pd = dot4(S, kk);
    const f32x4 tmp = S * w + k * v;
    pd = allsum16(pd);
    S = tmp - bb * pd;
    y = allsum16(dot4(S, r));
}

__device__ void phase_scan(const Params& p, const Ctx cx, int pair, LAS unsigned char* lds) {
    const int tid = cx.tid, wid = tid >> 6, lane = tid & 63, rs = lane >> 4, cgi = lane & 15;
    const bf16_t* PB = (const bf16_t*)(PWS + WS_PROJB);
    const float* Wdec = (const float*)(PWS + WS_WDEC);
    const bf16_t* Aa = (const bf16_t*)(PWS + WS_AA);
    float* Y = (float*)(PWS + WS_Y);
    const float* mu = PIN(I_MU) + pair * 1664;
    const float* k_k = PIN(I_KK) + pair * 512; const float* k_a = PIN(I_KA) + pair * 512;
    {
        LAS float* vb = (LAS float*)lds + wid * 3072;
        for (int st = cx.bid * 8 + wid; st < 2048; st += cx.nblk * 8) {
            const int bh = st >> 1, half = st & 1, b = bh >> 3, h = bh & 7, ch = h * 64 + cgi * 4;
            const float* stp = PIN(I_SSHIFT) + ((size_t)pair * 128 + b) * 1664;
            const f32x4 kkc = *(const f32x4*)(k_k + ch), kac = *(const f32x4*)(k_a + ch);
            {
#pragma unroll
                for (int tt = 0; tt < 2; ++tt) {
                    const int t = rs + tt * 4;
                    const size_t row = NTP + b * 8 + t;
                    const bf16_t* cur = PB + row * LDB;
                    const f32x4 r = shift4(cur, t > 0, stp, ch, mu), k = shift4(cur, t > 0, stp, 512 + ch, mu), v = shift4(cur, t > 0, stp, 1024 + ch, mu);
                    const f32x4 a = ld_bf4(Aa + row * 512 + ch);
                    const f32x4 w = *(const f32x4*)(Wdec + row * 512 + ch);
                    const f32x4 kkv = k * kkc;
                    const float ss = allsum16(dot4(kkv, kkv));
                    const float inv = 1.0f / fmaxf(sqrtf(ss), 1e-12f);
                    const f32x4 kkn = kkv * inv;
                    LAS float* o = vb + t * 384 + cgi * 4;
                    *(LAS f32x4*)(o) = w; *(LAS f32x4*)(o + 64) = k * (1.0f + (a - 1.0f) * kac); *(LAS f32x4*)(o + 128) = kkn; *(LAS f32x4*)(o + 192) = kkn * a;
                    *(LAS f32x4*)(o + 256) = r; *(LAS f32x4*)(o + 320) = v;
                }
            }
            asm volatile("s_waitcnt lgkmcnt(0)" ::: "memory");
            __builtin_amdgcn_wave_barrier();
#pragma unroll 1
            for (int rq = 0; rq < 8; ++rq) {
                const int ri = half * 32 + rq * 4 + rs;
                const size_t so = ((((size_t)pair * 128 + b) * 8 + h) * 64 + ri) * 64 + cgi * 4;
                f32x4 S = *(const f32x4*)(PIN(I_SWKV) + so);
#pragma unroll
                for (int t = 0; t < 8; ++t) {
                    LAS const float* r0 = vb + t * 384 + cgi * 4;
                    float y; scan_step(S, *(LAS const f32x4*)(r0), *(LAS const f32x4*)(r0 + 64), *(LAS const f32x4*)(r0 + 128), *(LAS const f32x4*)(r0 + 192), *(LAS const f32x4*)(r0 + 256), vb[t * 384 + 320 + ri], y);
                    if (cgi == 0) Y[(size_t)(NTP + b * 8 + t) * 512 + h * 64 + ri] = y;
                }
                *(f32x4*)(POUT + O_WKVS + so) = S;
            }
            asm volatile("s_waitcnt lgkmcnt(0)" ::: "memory");
            __builtin_amdgcn_wave_barrier();
        }
    }
    __syncthreads();
    LAS float* rec = (LAS float*)lds;
    for (int pt = cx.bid; pt < 256; pt += cx.nblk) {
        const int xcd = pt & 7, slot = pt >> 3, bh = xcd * 8 + (slot >> 2), rg = slot & 3, b = bh >> 3, h = bh & 7;
        const int lt = tid - 256, ls = (lt >> 4) & 15, lcg = lt & 15, lch = h * 64 + lcg * 4;
        u32x2 qr = {0u, 0u}, qk = {0u, 0u}, qv = {0u, 0u}, pr = {0u, 0u}, pk = {0u, 0u}, pv = {0u, 0u}, qa = {0u, 0u};
        f32x4 qw = (f32x4){0.f, 0.f, 0.f, 0.f};
        f32x4 mur, muk, muv, kkc, kac;
        const int ri = rg * 16 + (wid & 3) * 4 + rs;
        f32x4 S = (f32x4){0.f, 0.f, 0.f, 0.f};
#define SCAN_ISSUE(c) do { const int t_ = (c) * 16 + ls; const size_t row_ = (size_t)b * 2048 + t_; const bf16_t* cur_ = PB + row_ * LDB; \
            qr = *(const u32x2*)(cur_ + lch); qk = *(const u32x2*)(cur_ + 512 + lch); qv = *(const u32x2*)(cur_ + 1024 + lch); \
            if (t_ > 0) { pr = *(const u32x2*)(cur_ - LDB + lch); pk = *(const u32x2*)(cur_ - LDB + 512 + lch); pv = *(const u32x2*)(cur_ - LDB + 1024 + lch); } \
            else { pr = (u32x2){0u, 0u}; pk = pr; pv = pr; } \
            qw = *(const f32x4*)(Wdec + row_ * 512 + lch); qa = *(const u32x2*)(Aa + row_ * 512 + lch); } while (0)
#define SCAN_PROCESS(buf) do { const f32x4 r0_ = cvt4(qr), k0_ = cvt4(qk), v0_ = cvt4(qv); \
            const f32x4 r_ = r0_ + mur * (cvt4(pr) - r0_), k_ = k0_ + muk * (cvt4(pk) - k0_), v_ = v0_ + muv * (cvt4(pv) - v0_), a_ = cvt4(qa); \
            const f32x4 kkv_ = k_ * kkc; const float ss_ = allsum16(dot4(kkv_, kkv_)); const float inv_ = 1.0f / fmaxf(sqrtf(ss_), 1e-12f); \
            const f32x4 kkn_ = kkv_ * inv_; \
            LAS float* o_ = rec + (buf) * 6144 + ls * 384 + lcg * 4; \
            *(LAS f32x4*)(o_) = qw; *(LAS f32x4*)(o_ + 64) = k_ * (1.0f + (a_ - 1.0f) * kac); *(LAS f32x4*)(o_ + 128) = kkn_; *(LAS f32x4*)(o_ + 192) = kkn_ * a_; \
            *(LAS f32x4*)(o_ + 256) = r_; *(LAS f32x4*)(o_ + 320) = v_; } while (0)
        if (wid >= 4) {
            mur = *(const f32x4*)(mu + lch); muk = *(const f32x4*)(mu + 512 + lch); muv = *(const f32x4*)(mu + 1024 + lch);
            kkc = *(const f32x4*)(k_k + lch); kac = *(const f32x4*)(k_a + lch);
            SCAN_ISSUE(0); SCAN_PROCESS(0); SCAN_ISSUE(1);
        }
        __syncthreads();
        for (int c = 0; c < 128; ++c) {
            if (wid < 4) {
                LAS const float* rb = rec + (c & 1) * 6144 + cgi * 4;
                float* yp = Y + ((size_t)b * 2048 + c * 16) * 512 + h * 64 + ri;
#pragma unroll 4
                for (int s = 0; s < 16; ++s) {
                    LAS const float* r0 = rb + s * 384;
                    float y;
                    scan_step(S, *(LAS const f32x4*)(r0), *(LAS const f32x4*)(r0 + 64), *(LAS const f32x4*)(r0 + 128), *(LAS const f32x4*)(r0 + 192), *(LAS const f32x4*)(r0 + 256),
                              rec[(c & 1) * 6144 + s * 384 + 320 + ri], y);
                    if (cgi == 0) yp[(size_t)s * 512] = y;
                }
            } else {
                if (c + 1 < 128) { SCAN_PROCESS((c + 1) & 1); if (c + 2 < 128) SCAN_ISSUE(c + 2); }
            }
            __syncthreads();
        }
        if (wid < 4) *(f32x4*)(POUT + O_WKVP + ((((size_t)pair * 8 + b) * 8 + h) * 64 + ri) * 64 + cgi * 4) = S;
#undef SCAN_ISSUE
#undef SCAN_PROCESS
    }
}

__device__ void phase_even_post(const Params& p, const Ctx cx, int pair) {
    const int gtid = cx.bid * 512 + cx.tid, gthreads = cx.nblk * 512;
    const bf16_t* PA = (const bf16_t*)(PWS + WS_R1);
    bf16_t* Ycat = (bf16_t*)(PWS + WS_YCAT);
    const float* Y = (const float*)(PWS + WS_Y);
    const float* gn_g = PIN(I_GNG) + pair * 512; const float* gn_b = PIN(I_GNB) + pair * 512;
    for (int e = gtid; e < NTOK * 128; e += gthreads) {
        const int row = e >> 7, ch = (e & 127) * 4;
        const f32x4 y = *(const f32x4*)(Y + (size_t)row * 512 + ch);
        const float mean = allsum16(y[0] + y[1] + y[2] + y[3]) * (1.0f / 64.0f);
        const f32x4 d = y - mean;
        const float var = allsum16(dot4(d, d)) * (1.0f / 64.0f);
        const float rstd = rsqrtf(var + 64e-5f);
        const f32x4 g = *(const f32x4*)(gn_g + ch), bb = *(const f32x4*)(gn_b + ch);
        bf16_t* yo = Ycat + (size_t)row * 1024 + 512 + ch;
        const f32x4 bv = ld_bf4(yo);
        const f32x4 bz = ld_bf4(PA + (size_t)row * LDA + 2048 + ch);
        f32x4 o;
#pragma unroll
        for (int j = 0; j < 4; ++j) o[j] = (d[j] * rstd * g[j] + bb[j] + bv[j]) * siluf_(bz[j]);
        st_bf4(yo, o);
    }
    const float* cw = PIN(I_CONVW) + pair * 3 * 512;
    for (int e = gtid; e < NTOK * 128; e += gthreads) {
        const int row = e >> 7, ch = (e & 127) * 4;
        const bool samp = row >= NTP;
        int b, t, T; if (!samp) { b = row >> 11; t = row & 2047; T = 2048; } else { const int q = row - NTP; b = q >> 3; t = q & 7; T = 8; }
        const bf16_t* cur = PA + (size_t)row * LDA;
        const f32x4 u0 = ld_bf4(cur + 1024 + ch) * ld_bf4(cur + ch);
        f32x4 u1, u2;
        const float* hist = PIN(I_SCONV) + ((size_t)pair * 128 + b) * 2 * 512 + ch;
        if (t >= 1) u1 = ld_bf4(cur - LDA + 1024 + ch) * ld_bf4(cur - LDA + ch);
        else if (samp) u1 = *(const f32x4*)(hist + 512); else u1 = (f32x4){0.f, 0.f, 0.f, 0.f};
        if (t >= 2) u2 = ld_bf4(cur - 2 * LDA + 1024 + ch) * ld_bf4(cur - 2 * LDA + ch);
        else if (samp) u2 = *(const f32x4*)(hist + (t == 1 ? 512 : 0)); else u2 = (f32x4){0.f, 0.f, 0.f, 0.f};
        const f32x4 c0 = *(const f32x4*)(cw + ch), c1 = *(const f32x4*)(cw + 512 + ch), c2 = *(const f32x4*)(cw + 1024 + ch);
        const f32x4 conv = c0 * u2 + c1 * u1 + c2 * u0;
        const f32x4 ab = ld_bf4(cur + 512 + ch), az = ld_bf4(cur + 1536 + ch);
        f32x4 o;
#pragma unroll
        for (int j = 0; j < 4; ++j) o[j] = ab[j] * conv[j] * siluf_(az[j]);
        st_bf4(Ycat + (size_t)row * 1024 + ch, o);
        if (t >= T - 2) {
            float* dst = samp ? POUT + O_CONVS + (((size_t)pair * 128 + b) * 2 + (t - (T - 2))) * 512 + ch : POUT + O_CONVP + (((size_t)pair * 8 + b) * 2 + (t - (T - 2))) * 512 + ch;
            *(f32x4*)dst = u0;
        }
    }
}

__device__ void phase_odd_mixer(const Params& p, const Ctx cx, int pair, LAS unsigned char* lds) {
    const int tid = cx.tid, wid = tid >> 6, lane = tid & 63, fr = lane & 15, fq = lane >> 4;
    const bf16_t* PO = (const bf16_t*)(PWS + WS_R1);
    bf16_t* Ycat = (bf16_t*)(PWS + WS_YCAT);
    LAS bf16_t* LA = (LAS bf16_t*)lds;
    LAS bf16_t* LB = (LAS bf16_t*)(lds + 128 * 136 * 2);
    LAS float* stat = (LAS float*)(lds + 2 * 128 * 136 * 2);
    for (int it = cx.bid; it < 1088; it += cx.nblk) {
        const int tile = it >> 3, kind = (it >> 2) & 1, g = it & 3;
        const int r0 = tile * 128;
        const bool samp = r0 >= NTP;
        if (kind == 0) {
            const int w = 2 << g;
            for (int e = tid; e < 128 * 32; e += 512) {
                const int tl = e >> 5, c = (e & 31) * 4, row = r0 + tl;
                int b, t; if (!samp) { b = row >> 11; t = row & 2047; } else { const int q = row - NTP; b = q >> 3; t = q & 7; }
                const bf16_t* cur = PO + (size_t)row * LDA + g * 128 + c;
                const f32x4 pt = ld_bf4(cur);
                f32x4 sum = pt;
                for (int d = 1; d < w; ++d) {
                    const int tt = t - d;
                    if (tt >= 0) sum += ld_bf4(cur - (size_t)d * LDA);
                    else if (samp) sum += *(const f32x4*)(PIN(I_SPOOL) + (((size_t)pair * 128 + b) * 15 + (15 + tt)) * 512 + g * 128 + c);
                }
                const float cnt = samp ? (float)w : fminf((float)w, (float)(t + 1));
                const f32x4 pooled = sum * (1.0f / cnt) - pt;
                u32x2 u; u.x = cvt_pk_bf16(pooled[0], pooled[1]); u.y = cvt_pk_bf16(pooled[2], pooled[3]);
                *(LAS u32x2*)(LA + tl * 136 + c) = u;
            }
            __syncthreads();
            const bf16_t* Bw = (const bf16_t*)(PWS + WS_POOLWT) + ((size_t)pair * 4 + g) * 128 * 128;
            const int row = r0 + wid * 16 + fr;
            bf16x8 af[4];
#pragma unroll
            for (int ks = 0; ks < 4; ++ks) af[ks] = *(const LAS bf16x8*)(LA + (wid * 16 + fr) * 136 + ks * 32 + fq * 8);
#pragma unroll
            for (int nt = 0; nt < 8; ++nt) {
                f32x4 acc = (f32x4){0.f, 0.f, 0.f, 0.f};
#pragma unroll
                for (int ks = 0; ks < 4; ++ks) {
                    const bf16x8 bf = *(const bf16x8*)(Bw + (size_t)(nt * 16 + fr) * 128 + ks * 32 + fq * 8);
                    acc = __builtin_amdgcn_mfma_f32_16x16x32_bf16(bf, af[ks], acc, 0, 0, 0);
                }
                const int d = g * 128 + nt * 16 + fq * 4;
                const f32x4 cz = ld_bf4(PO + (size_t)row * LDA + 512 + d), ps = *(const f32x4*)(PIN(I_PSCALE) + pair * 512 + d);
                f32x4 o;
#pragma unroll
                for (int j = 0; j < 4; ++j) o[j] = acc[j] * ps[j] * siluf_(cz[j]);
                st_bf4(Ycat + (size_t)row * 1024 + d, o);
            }
            __syncthreads();
        } else {
            {
                const int tl = tid >> 2, q = tid & 3;
                const bf16_t* vr = PO + (size_t)(r0 + tl) * LDA + 1536 + q * 128;
                float s = 0.f, ss = 0.f;
#pragma unroll
                for (int i = 0; i < 32; ++i) { const f32x4 v = ld_bf4(vr + i * 4); s += v[0] + v[1] + v[2] + v[3]; ss += dot4(v, v); }
                s = allsum4(s); ss = allsum4(ss);
                const float mean = s * (1.0f / 512.0f);
                const float var = fmaxf(ss * (1.0f / 512.0f) - mean * mean, 0.f);
                if (q == 0) { stat[tl * 2] = mean; stat[tl * 2 + 1] = rsqrtf(var + 1e-5f); }
            }
            __syncthreads();
            {
                const int tl = tid >> 2, q = tid & 3, row = r0 + tl;
                const float mean = stat[tl * 2], rstd = stat[tl * 2 + 1];
                const bf16_t* vr = PO + (size_t)row * LDA + 1536 + g * 128 + q * 32;
                const float* lg = PIN(I_LNG) + pair * 512 + g * 128 + q * 32; const float* lb = PIN(I_LNB) + pair * 512 + g * 128 + q * 32;
#pragma unroll
                for (int i = 0; i < 8; ++i) {
                    const f32x4 v = ld_bf4(vr + i * 4);
                    const f32x4 vn = (v - mean) * rstd * *(const f32x4*)(lg + i * 4) + *(const f32x4*)(lb + i * 4);
                    if (samp) *(f32x4*)(POUT + O_CHUNKV + ((size_t)pair * 1024 + (row - NTP)) * 512 + g * 128 + q * 32 + i * 4) = vn;
#pragma unroll
                    for (int j = 0; j < 4; ++j) LB[(q * 32 + i * 4 + j) * 136 + tl] = (bf16_t)(cvt_pk_bf16(vn[j], 0.f) & 0xffffu);
                }
            }
            if (!samp) {
                const bf16_t* Wsrc = (const bf16_t*)(PWS + WS_SPW) + ((size_t)pair * 4 + g) * 128 * 128;
                for (int e = tid; e < 128 * 16; e += 512) { const int t = e >> 4, s8 = (e & 15) * 8; *(LAS u32x4*)(LA + t * 136 + s8) = *(const u32x4*)(Wsrc + t * 128 + s8); }
            } else {
                const float* Wsrc = PIN(I_SPW) + ((size_t)pair * 4 + g) * 128 * 128;
                for (int e = tid; e < 128 * 128; e += 512) { const int t = e >> 7, s = e & 127;
                    const float v = ((t >> 3) == (s >> 3) && (s & 7) <= (t & 7)) ? Wsrc[(t & 7) * 128 + (s & 7)] : 0.f;
                    LA[t * 136 + s] = (bf16_t)(cvt_pk_bf16(v, 0.f) & 0xffffu); }
            }
            __syncthreads();
            {
                const int tl = wid * 16 + fr, row = r0 + tl;
                const float bias = PIN(I_SPB)[((size_t)pair * 4 + g) * 128 + (samp ? (tl & 7) : tl)];
                bf16x8 wf[4];
#pragma unroll
                for (int ks = 0; ks < 4; ++ks) wf[ks] = *(const LAS bf16x8*)(LA + tl * 136 + ks * 32 + fq * 8);
#pragma unroll
                for (int nt = 0; nt < 8; ++nt) {
                    f32x4 acc = (f32x4){0.f, 0.f, 0.f, 0.f};
#pragma unroll
                    for (int ks = 0; ks < 4; ++ks) {
                        if (ks * 32 <= wid * 16 + 15) {
                            const bf16x8 vf = *(const LAS bf16x8*)(LB + (nt * 16 + fr) * 136 + ks * 32 + fq * 8);
                            acc = __builtin_amdgcn_mfma_f32_16x16x32_bf16(vf, wf[ks], acc, 0, 0, 0);
                        }
                    }
                    const int c = g * 128 + nt * 16 + fq * 4;
                    const f32x4 u = ld_bf4(PO + (size_t)row * LDA + 1024 + c), dz = ld_bf4(PO + (size_t)row * LDA + 2048 + c);
                    f32x4 o;
#pragma unroll
                    for (int j = 0; j < 4; ++j) o[j] = u[j] * (acc[j] + bias) * siluf_(dz[j]);
                    st_bf4(Ycat + (size_t)row * 1024 + 512 + c, o);
                }
            }
            __syncthreads();
        }
    }
    const int gtid = cx.bid * 512 + tid, gthreads = cx.nblk * 512;
    for (int e = gtid; e < 136 * 15 * 512; e += gthreads) {
        const int c = e & 511, q = e >> 9, sr = q / 15, k = q % 15;
        if (sr < 8) POUT[O_POOLP + (((size_t)pair * 8 + sr) * 15 + k) * 512 + c] = bf2f(PO[(size_t)(sr * 2048 + 2033 + k) * LDA + c]);
        else { const int b = sr - 8;
            POUT[O_POOLS + (((size_t)pair * 128 + b) * 15 + k) * 512 + c] = (k < 7) ? PIN(I_SPOOL)[(((size_t)pair * 128 + b) * 15 + 8 + k) * 512 + c] : bf2f(PO[(size_t)(NTP + b * 8 + (k - 7)) * LDA + c]); }
    }
}

__device__ void phase_final(const Params& p, const Ctx cx) {
    const int gtid = cx.bid * 512 + cx.tid, gthreads = cx.nblk * 512;
    const float* ssq = (const float*)(PWS + WS_SSQ) + 4 * NTOK;
    for (int e = gtid; e < NTOK * 256; e += gthreads) {
        const int row = e >> 8, c = (e & 255) * 4;
        const float rstd = rsqrtf(ssq[row] * (1.0f / 1024.0f) + 1e-6f);
        f32x4* px = (f32x4*)(POUT + (size_t)row * 1024 + c);
        *px = *px * rstd * *(const f32x4*)(PIN(I_FNORMW) + c);
    }
}

#define XB_TMO      128
#define XB_XCNT(j)  (256  + 64 * (j))
#define XB_XSUB(j)  (1280 + 64 * (j))
#define XB_XGEN(j)  (2304 + 64 * (j))
#define XB_TOP      3328
#define XB_TOPGEN   3392
#define XCD_BAR_WORDS 3456
#define XB_SPIN_CAP (1u << 18)
__device__ __forceinline__ unsigned xb_ld(unsigned* p)              { return __hip_atomic_load(p, __ATOMIC_RELAXED, __HIP_MEMORY_SCOPE_AGENT); }
__device__ __forceinline__ unsigned xb_add(unsigned* p, unsigned v) { return __hip_atomic_fetch_add(p, v, __ATOMIC_RELAXED, __HIP_MEMORY_SCOPE_AGENT); }
__device__ __forceinline__ unsigned xb_xcc_id() { return (unsigned)__builtin_amdgcn_s_getreg((3 << 11) | 20) & 0xFu; }
#define XB_SPIN(cond, bar) do { unsigned _sp = 0; while (cond) { __builtin_amdgcn_s_sleep(1); \
    if ((++_sp & 255u) == 0u) { if (xb_ld(&(bar)[XB_TMO])) break; if (_sp > XB_SPIN_CAP) { atomicAdd(&(bar)[XB_TMO], 1u); break; } } } } while (0)
struct XcdBarrier { unsigned* bar; unsigned x; volatile LAS unsigned* st; };
__device__ __forceinline__ XcdBarrier xcd_barrier_post(unsigned* bar, volatile LAS unsigned* st) {
    XcdBarrier b; b.bar = bar; b.x = xb_xcc_id(); b.st = st;
    if (threadIdx.x == 0) (void)xb_add(&bar[XB_XCNT(b.x)], 1u);
    return b;
}
__device__ __forceinline__ void xcd_barrier_complete(unsigned* bar, unsigned x, unsigned& nloc, unsigned& nx) {
    const unsigned G = gridDim.x * gridDim.y * gridDim.z;
    unsigned sum, cnt, mine, sp = 0u;
    for (;;) {
        sum = 0u; cnt = 0u; mine = 0u;
#pragma unroll
        for (unsigned j = 0; j < 16; ++j) { const unsigned c = xb_ld(&bar[XB_XCNT(j)]); sum += c; cnt += (c > 0u) ? 1u : 0u; mine = (j == x) ? c : mine; }
        if (sum == G) break;
        __builtin_amdgcn_s_sleep(1);
        if ((++sp & 255u) == 0u) { if (xb_ld(&bar[XB_TMO])) break; if (sp > XB_SPIN_CAP) { atomicAdd(&bar[XB_TMO], 1u); break; } }
    }
    nloc = mine > 0u ? mine : 1u; nx = cnt > 0u ? cnt : 1u;
}
__device__ __forceinline__ void xcd_barrier(const XcdBarrier& b) {
    asm volatile("s_waitcnt vmcnt(0)" ::: "memory");
    __syncthreads();
    if (threadIdx.x == 0) {
        unsigned* bar = b.bar;
        __builtin_amdgcn_s_waitcnt(0);
        unsigned nloc = b.st[0], nx = b.st[1];
        if (nloc == 0u) { xcd_barrier_complete(bar, b.x, nloc, nx); b.st[0] = nloc; b.st[1] = nx; }
        const unsigned old = xb_add(&bar[XB_XSUB(b.x)], 1u);
        const unsigned gen = old / nloc;
        if (old + 1u == (gen + 1u) * nloc) {
            __builtin_amdgcn_fence(__ATOMIC_RELEASE, "agent");
            asm volatile("s_waitcnt vmcnt(0)" ::: "memory");
            const unsigned og = xb_add(&bar[XB_TOP], 1u);
            const unsigned tg = og / nx;
            if (og + 1u == (tg + 1u) * nx) xb_add(&bar[XB_TOPGEN], 1u);
            else XB_SPIN(xb_ld(&bar[XB_TOPGEN]) == tg, bar);
            __builtin_amdgcn_fence(__ATOMIC_ACQUIRE, "agent");
            xb_add(&bar[XB_XGEN(b.x)], 1u);
            asm volatile("s_waitcnt vmcnt(0)" ::: "memory");
        } else {
            XB_SPIN(xb_ld(&bar[XB_XGEN(b.x)]) == gen, bar);
            __builtin_amdgcn_fence(__ATOMIC_ACQUIRE, "agent");
            asm volatile("s_waitcnt vmcnt(0)" ::: "memory");
        }
    }
    __syncthreads();
}

__device__ void run_gemm_proj(const Params& p, const Ctx cx, LAS unsigned char* lds, const bf16_t* Bt, int N, bf16_t* O, int ldc, int layer) {
    pg8::Gemm g{(const bf16_t*)(PWS + WS_XB), Bt, NTOK, N, 1024};
    pg8::StaticOrder S; S.init(NTOK, N, (int)cx.nblk, (int)cx.bid);
    EpiProj E{O, ldc, (const float*)(PWS + WS_SSQ) + (size_t)layer * NTOK};
    pg8::gemm_phase<EpiProj>(cx, lds, g, S, E);
}
__device__ void run_gemm_res(const Params& p, const Ctx cx, LAS unsigned char* lds, const bf16_t* Bt, int layer) {
    pg8::Gemm g{(const bf16_t*)(PWS + WS_YCAT), Bt, NTOK, 1024, 1024};
    pg8::StaticOrder S; S.init(NTOK, 1024, (int)cx.nblk, (int)cx.bid);
    EpiRes E{layer == 0 ? PIN(I_XP) : nullptr, PIN(I_XS), POUT, (bf16_t*)(PWS + WS_XB), (float*)(PWS + WS_SSQ) + (size_t)(layer + 1) * NTOK};
    pg8::gemm_phase<EpiRes>(cx, lds, g, S, E);
}

constexpr int N_PHASES = 20;
#ifndef PHMASK
#define PHMASK 0xffff
#endif
#define PHON(n) ((PHMASK >> ((n) % 16)) & 1)
__global__ void __launch_bounds__(512, 2) fwd_kernel(Params p) {
    extern __shared__ __attribute__((aligned(16))) unsigned char lds_raw[];
    LAS unsigned char* lds = (LAS unsigned char*)lds_raw;
    volatile LAS unsigned* bar_st = (volatile LAS unsigned*)(lds + 131072);
    if (threadIdx.x < 4) bar_st[threadIdx.x] = 0u;
    __syncthreads();
    const XcdBarrier gbar = xcd_barrier_post((unsigned*)((unsigned char*)p.ptr[30] + WS_BAR), bar_st);
    if (p.ph_hi < 0) cg::this_grid().sync();
#define GRID_SYNC() xcd_barrier(gbar)
#ifdef SYNCPROBE
    for (int i = 0; i < SYNCPROBE; ++i) GRID_SYNC();
#endif
#ifdef REPMASK
    for (int pc = p.ph_lo * 2; pc < p.ph_hi * 2; ++pc) {
        const int ph = pc >> 1;
        { const int s_ = (ph == 0 || ph == N_PHASES - 1) ? 31 : (ph - 1) % 9; if ((pc & 1) && !((REPMASK >> s_) & 1)) continue; }
        if (pc > p.ph_lo * 2) GRID_SYNC();
#else
    for (int ph = p.ph_lo; ph < p.ph_hi; ++ph) {
        if (ph > p.ph_lo) GRID_SYNC();
#endif
        Ctx cx; cx.tid = threadIdx.x; cx.bid = blockIdx.x; cx.nblk = gridDim.x;
        asm volatile("s_mov_b32 %0, 0" : "=s"(cx.z));
        asm volatile("" : "+v"(cx.tid)); asm volatile("" : "+s"(cx.bid)); asm volatile("" : "+s"(cx.nblk));
        const int pair = (ph - 1) / 9, s = (ph == 0) ? 100 : (ph == N_PHASES - 1 ? 101 : (ph - 1) % 9);
        if (s == 0 || s == 3 || s == 6) {
#if PHON(0)
            const bf16_t* WinE = (const bf16_t*)(PWS + WS_WINE) + (size_t)pair * 4352 * 1024;
            const bf16_t* Bt = s == 0 ? WinE + (size_t)2560 * 1024 : (s == 3 ? WinE : (const bf16_t*)(PWS + WS_WINO) + (size_t)pair * 2560 * 1024);
            const int N = s == 0 ? 1792 : 2560;
            run_gemm_proj(p, cx, lds, Bt, N, (bf16_t*)(PWS + WS_R1), N, 2 * pair + (s == 6 ? 1 : 0));
#endif
        } else if (s == 5 || s == 8) {
#if PHON(5)
            const bf16_t* Bt = (const bf16_t*)(PWS + (s == 5 ? WS_WOUTE : WS_WOUTO)) + (size_t)pair * 1024 * 1024;
            run_gemm_res(p, cx, lds, Bt, 2 * pair + (s == 8 ? 1 : 0));
#endif
        } else if (s == 1) {
#if PHON(1)
            phase_even_prep(p, cx, pair);
#endif
        } else if (s == 2) {
#if PHON(2)
            phase_scan(p, cx, pair, lds);
#endif
        } else if (s == 4) {
#if PHON(4)
            phase_even_post(p, cx, pair);
#endif
        } else if (s == 7) {
#if PHON(7)
            phase_odd_mixer(p, cx, pair, lds);
#endif
        } else if (s == 100) {
#if PHON(10)
            phase_prepass(p, cx, lds);
#endif
        } else {
#if PHON(11)
            phase_final(p, cx);
#endif
        }
    }
}

extern "C" void kernel_launch(void* const* d_in, const int* in_sizes, int n_in, void* d_out, int out_size, void* d_ws, size_t ws_size, hipStream_t stream) {
    static int grid = 0;
    if (grid == 0) {
        if (n_in != 29 || ws_size < WS_END) { fprintf(stderr, "kernel_launch: unexpected n_in %d / ws_size %zu (need %zu)\n", n_in, ws_size, (size_t)WS_END); grid = -1; return; }
        int dev = 0, cus = 0, per_cu = 0;
        hipGetDevice(&dev);
        hipDeviceGetAttribute(&cus, hipDeviceAttributeMultiprocessorCount, dev);
        if (hipFuncSetAttribute((const void*)fwd_kernel, hipFuncAttributeMaxDynamicSharedMemorySize, LDS_BYTES) != hipSuccess) { fprintf(stderr, "kernel_launch: hipFuncSetAttribute failed\n"); grid = -1; return; }
        if (hipOccupancyMaxActiveBlocksPerMultiprocessor(&per_cu, (const void*)fwd_kernel, 512, LDS_BYTES) != hipSuccess || per_cu < 1) { fprintf(stderr, "kernel_launch: occupancy query gave %d\n", per_cu); per_cu = 1; }
        (void)hipGetLastError();
        grid = cus * per_cu;
        if (grid > 256) grid = 256;
    }
    if (grid < 0) return;
    Params p{};
    for (int i = 0; i < 29; ++i) p.ptr[i] = d_in[i];
    p.ptr[29] = d_out; p.ptr[30] = d_ws; p.ptr[31] = nullptr;
    (void)hipMemsetAsync((unsigned char*)d_ws + WS_BAR, 0, 16384, stream);
#if ONE_LAUNCH
    p.ph_lo = 0; p.ph_hi = N_PHASES;
    void* args[] = {&p};
    hipError_t e = hipLaunchCooperativeKernel((const void*)fwd_kernel, dim3(grid), dim3(512), args, LDS_BYTES, stream);
    if (e != hipSuccess) fprintf(stderr, "cooperative launch failed: %s (grid %d)\n", hipGetErrorString(e), grid);
#else
    for (int ph = 0; ph < N_PHASES; ++ph) {
        p.ph_lo = ph; p.ph_hi = ph + 1;
        hipLaunchKernelGGL(fwd_kernel, dim3(grid), dim3(512), LDS_BYTES, stream, p);
    }
#endif
}
```

```cpp
#include <hip/hip_runtime.h>
#include <hip/hip_cooperative_groups.h>
#include <cstdio>
namespace cg = cooperative_groups;

#ifndef ONE_LAUNCH
#define ONE_LAUNCH 1
#endif

#define LAS __attribute__((address_space(3)))
typedef unsigned short bf16_t;
typedef short bf16x8 __attribute__((ext_vector_type(8)));
typedef float f32x4 __attribute__((ext_vector_type(4)));
typedef unsigned u32x4 __attribute__((ext_vector_type(4)));
typedef unsigned u32x2 __attribute__((ext_vector_type(2)));

constexpr int NTOK = 17408, NTP = 16384;
constexpr int LDB = 1792;
constexpr int LDA = 2560;
constexpr size_t O_CONVP = 17825792, O_CONVS = 17842176, O_SHIFTP = 18104320, O_SHIFTS = 18130944, O_WKVP = 18556928, O_WKVS = 19081216,
                 O_POOLP = 27469824, O_POOLS = 27592704, O_CHUNKV = 29558784;
constexpr size_t WS_WINE = 0;
constexpr size_t WS_WOUTE = WS_WINE + 2ull * 4352 * 1024 * 2;
constexpr size_t WS_WINO = WS_WOUTE + 2ull * 1024 * 1024 * 2;
constexpr size_t WS_WOUTO = WS_WINO + 2ull * 2560 * 1024 * 2;
constexpr size_t WS_W2T = WS_WOUTO + 2ull * 1024 * 1024 * 2;
constexpr size_t WS_A2T = WS_W2T + 2ull * 512 * 64 * 2;
constexpr size_t WS_POOLWT = WS_A2T + 2ull * 512 * 64 * 2;
constexpr size_t WS_SPW = WS_POOLWT + 8ull * 128 * 128 * 2;
constexpr size_t WS_XB = WS_SPW + 8ull * 128 * 128 * 2;
constexpr size_t WS_YCAT = WS_XB + (size_t)NTOK * 1024 * 2;
constexpr size_t WS_SSQ = WS_YCAT + (size_t)NTOK * 1024 * 2;
constexpr size_t WS_Y = WS_SSQ + 5ull * NTOK * 4;
constexpr size_t WS_R1 = WS_Y + (size_t)NTOK * 512 * 4;
constexpr size_t WS_PROJB = WS_R1;
constexpr size_t WS_WDEC = WS_PROJB + (size_t)NTOK * LDB * 2;
constexpr size_t WS_AA = WS_WDEC + (size_t)NTOK * 512 * 4;
constexpr size_t WS_BAR = WS_AA + (size_t)NTOK * 512 * 2;
constexpr size_t WS_END = WS_BAR + 16384;
constexpr int LDS_BYTES = 131072 + 16;

struct Params {
    const void* ptr[32];
    int ph_lo, ph_hi;
};
struct Ctx { int tid, bid, nblk, z; };
#define PIN(i) ((const float*)p.ptr[(i) + cx.z])
#define POUT ((float*)p.ptr[29 + cx.z])
#define PWS ((unsigned char*)p.ptr[30 + cx.z])
enum { I_XP = 0, I_XS, I_SCONV, I_SSHIFT, I_SWKV, I_SPOOL, I_NORMW, I_FNORMW, I_WINE, I_CONVW, I_MU, I_W0, I_W2, I_A0, I_A2, I_KK, I_KA, I_RK, I_GNG, I_GNB,
       I_WOUTE, I_WINO, I_POOLW, I_PSCALE, I_LNG, I_LNB, I_SPW, I_SPB, I_WOUTO };

__device__ __forceinline__ unsigned cvt_pk_bf16(float lo, float hi) { unsigned r; asm("v_cvt_pk_bf16_f32 %0, %1, %2" : "=v"(r) : "v"(lo), "v"(hi)); return r; }
__device__ __forceinline__ float bf_lo(unsigned u) { return __uint_as_float(u << 16); }
__device__ __forceinline__ float bf_hi(unsigned u) { return __uint_as_float(u & 0xffff0000u); }
__device__ __forceinline__ float bf2f(bf16_t b) { return __uint_as_float(((unsigned)b) << 16); }
__device__ __forceinline__ f32x4 cvt4(u32x2 u) { return (f32x4){bf_lo(u.x), bf_hi(u.x), bf_lo(u.y), bf_hi(u.y)}; }
__device__ __forceinline__ f32x4 ld_bf4(const bf16_t* p) { return cvt4(*(const u32x2*)p); }
__device__ __forceinline__ void st_bf4(bf16_t* p, f32x4 v) { u32x2 u; u.x = cvt_pk_bf16(v[0], v[1]); u.y = cvt_pk_bf16(v[2], v[3]); *(u32x2*)p = u; }
__device__ __forceinline__ float sigmoidf_(float x) { return 1.0f / (1.0f + __expf(-x)); }
__device__ __forceinline__ float siluf_(float x) { return x / (1.0f + __expf(-x)); }
template <int CTRL> __device__ __forceinline__ float dpp_f(float x) { return __builtin_bit_cast(float, __builtin_amdgcn_mov_dpp(__builtin_bit_cast(int, x), CTRL, 0xf, 0xf, true)); }
__device__ __forceinline__ float allsum16(float x) { x += dpp_f<0xB1>(x); x += dpp_f<0x4E>(x); x += dpp_f<0x141>(x); x += dpp_f<0x128>(x); return x; }
__device__ __forceinline__ float allsum4(float x) { x += dpp_f<0xB1>(x); x += dpp_f<0x4E>(x); return x; }
__device__ __forceinline__ float dot4(f32x4 a, f32x4 b) { return a[0] * b[0] + a[1] * b[1] + a[2] * b[2] + a[3] * b[3]; }

namespace pg8 {
constexpr int BM = 256, BK = 64, HALF = 128, HTB = HALF * BK * 2, NXCD = 8, WGM = 8;
__device__ __forceinline__ int lds_byte(int r, int c) { const int st = (r >> 4) * 2 + (c >> 5), rr = r & 15, cc = c & 31, ob = rr * 64 + cc * 2; return st * 1024 + (ob ^ (((ob >> 9) & 1) << 5)); }
__device__ __forceinline__ void stage_rc(int b, int& R, int& C) { const int st = b / 1024, sb = b % 1024, swz = sb ^ (((sb >> 9) & 1) << 5); R = (st >> 1) * 16 + swz / 64; C = (st & 1) * 32 + (swz % 64) / 2; }
__device__ __forceinline__ int perm32(int rho) { const int n = rho >> 4, i = rho & 15; return 8 * (i >> 2) + 4 * n + (i & 3); }
struct Unit { int pm, pn; };
struct Gemm { const bf16_t* A; const bf16_t* Bt; int M, N, K; };
struct StaticOrder {
    int nM, nN, nwg, G, c;
    __device__ void init(int M, int N, int G_, int c_) { nM = M / BM; nN = N / BM; nwg = nM * nN; G = G_; c = c_; }
    __device__ bool next(int i, Unit& u) const {
        const long L = (long)i * G + c; if (L >= nwg) return false;
        int wgid = (int)L; { const int q = nwg / NXCD, r = nwg % NXCD, xcd = wgid % NXCD, off = wgid / NXCD; wgid = (xcd < r ? xcd * (q + 1) : r * (q + 1) + (xcd - r) * q) + off; }
        const int nig = WGM * nN, gid = wgid / nig, fm = gid * WGM, gsz = (nM - fm) < WGM ? (nM - fm) : WGM;
        u.pm = fm + ((wgid % nig) % gsz); u.pn = (wgid % nig) / gsz; return true;
    }
};

template <class Epi>
__device__ __forceinline__ void gemm_phase(const Ctx cx, LAS unsigned char* lds, const Gemm g, const StaticOrder& S, const Epi& E) {
    const int tid = cx.tid, wid = __builtin_amdgcn_readfirstlane(tid >> 6), lane = tid & 63, wr = wid >> 2, wc = wid & 3, fr = lane & 15, fq = lane >> 4;
    const int K = g.K, nt = K / BK;
    unsigned voffA[2], voffB[2];
#pragma unroll
    for (int i = 0; i < 2; ++i) { int R, C; stage_rc(tid * 16 + i * 8192, R, C); const int Rb = Epi::PERM ? ((R & ~31) + perm32(R & 31)) : R;
        voffA[i] = (unsigned)(R * K + C) * 2u; voffB[i] = (unsigned)(Rb * K + C) * 2u; }
    const size_t kstep = (size_t)(BK * 2);
    const size_t hstep = (size_t)HALF * K * 2;
    const size_t tstep = 2 * hstep;
    const unsigned ldsw = (unsigned)wid * 1024u;
    const int aoff = lds_byte(wr * 64 + fr, fq * 8), boff = lds_byte(wc * 32 + fr, fq * 8);
#define PG8_SA(b, h) (((b) * 2 + (h)) * HTB)
#define PG8_SB(b, h) ((4 + (b) * 2 + (h)) * HTB)
#define PG8_STAGE(bufoff, gbase, voff) do { _Pragma("unroll") for (int _i = 0; _i < 2; ++_i) \
        __builtin_amdgcn_global_load_lds((const unsigned*)((const char*)(gbase) + (voff)[_i]), (LAS unsigned*)(lds + (bufoff) + ldsw + _i * 8192), 16, 0, 0); } while (0)
#define PG8_LDA(dst, b, h) do { _Pragma("unroll") for (int m = 0; m < 4; ++m) _Pragma("unroll") for (int k = 0; k < 2; ++k) dst[m][k] = *(const LAS bf16x8*)(lds + PG8_SA(b, h) + aoff + m * 2048 + k * 1024); } while (0)
#define PG8_LDB(dst, b, h) do { _Pragma("unroll") for (int n = 0; n < 2; ++n) _Pragma("unroll") for (int k = 0; k < 2; ++k) dst[n][k] = *(const LAS bf16x8*)(lds + PG8_SB(b, h) + boff + n * 2048 + k * 1024); } while (0)
#define PG8_MMA(ai, bj, At, Bt) do { __builtin_amdgcn_s_setprio(1); _Pragma("unroll") for (int m = 0; m < 4; ++m) _Pragma("unroll") for (int n = 0; n < 2; ++n) _Pragma("unroll") for (int k = 0; k < 2; ++k) \
        acc[ai][bj][m][n] = __builtin_amdgcn_mfma_f32_16x16x32_bf16(Bt[n][k], At[m][k], acc[ai][bj][m][n], 0, 0, 0); __builtin_amdgcn_s_setprio(0); } while (0)
#define PG8_WAIT_V(n) asm volatile("s_waitcnt vmcnt(" #n ")" ::: "memory")
#define PG8_WAIT_L(n) asm volatile("s_waitcnt lgkmcnt(" #n ")" ::: "memory")
#define PG8_BAR __builtin_amdgcn_s_barrier()
#define PG8_SCHED __builtin_amdgcn_sched_barrier(0)
    Unit cur, nxt; int ui = 0;
    if (!S.next(0, cur)) return;
    f32x4 acc[2][2][4][2];
#pragma unroll
    for (int a = 0; a < 2; ++a)
#pragma unroll
        for (int b = 0; b < 2; ++b)
#pragma unroll
            for (int m = 0; m < 4; ++m)
#pragma unroll
                for (int n = 0; n < 2; ++n) acc[a][b][m][n] = (f32x4){0.f, 0.f, 0.f, 0.f};
    bf16x8 At[4][2], B0[2][2], B1[2][2];
    const char* cA = (const char*)g.A + (size_t)cur.pm * tstep; const char* cB = (const char*)g.Bt + (size_t)cur.pn * tstep;
    PG8_STAGE(PG8_SB(0, 0), cB, voffB); PG8_STAGE(PG8_SA(0, 0), cA, voffA); PG8_STAGE(PG8_SB(0, 1), cB + hstep, voffB); PG8_STAGE(PG8_SA(0, 1), cA + hstep, voffA);
    if (wr == 1) PG8_BAR;
    PG8_WAIT_V(4); PG8_BAR;
    PG8_STAGE(PG8_SB(1, 0), cB + kstep, voffB); PG8_STAGE(PG8_SA(1, 0), cA + kstep, voffA); PG8_STAGE(PG8_SB(1, 1), cB + hstep + kstep, voffB);
    PG8_WAIT_V(6); PG8_BAR;
    for (;;) {
        const bool has_next = S.next(ui + 1, nxt);
        const char* nA = has_next ? (const char*)g.A + (size_t)nxt.pm * tstep : cA; const char* nB = has_next ? (const char*)g.Bt + (size_t)nxt.pn * tstep : cB;
        for (int t = 0; t < nt; t += 2) {
            const bool last = (t == nt - 2);
            const char* a1 = cA + (size_t)(t + 1) * kstep;
            const char* a2 = last ? nA : cA + (size_t)(t + 2) * kstep; const char* b2 = last ? nB : cB + (size_t)(t + 2) * kstep;
            const char* a3 = a2 + kstep; const char* b3 = b2 + kstep;
            PG8_LDB(B0, 0, 0); PG8_SCHED; PG8_LDA(At, 0, 0); PG8_STAGE(PG8_SA(1, 1), a1 + hstep, voffA);
            PG8_WAIT_L(8); PG8_BAR; PG8_WAIT_L(0); PG8_MMA(0, 0, At, B0); PG8_BAR; PG8_SCHED;
            PG8_LDB(B1, 0, 1); PG8_STAGE(PG8_SB(0, 0), b2, voffB);
            PG8_BAR; PG8_WAIT_L(0); PG8_MMA(0, 1, At, B1); PG8_BAR;
            PG8_LDA(At, 0, 1); PG8_STAGE(PG8_SA(0, 0), a2, voffA);
            PG8_BAR; PG8_WAIT_L(0); PG8_MMA(1, 0, At, B0); PG8_BAR; PG8_SCHED;
            PG8_STAGE(PG8_SB(0, 1), b2 + hstep, voffB);
            PG8_WAIT_V(6); PG8_BAR; PG8_MMA(1, 1, At, B1); PG8_BAR;
            PG8_LDB(B0, 1, 0); PG8_SCHED; PG8_LDA(At, 1, 0); PG8_STAGE(PG8_SA(0, 1), a2 + hstep, voffA);
            PG8_WAIT_L(8); PG8_BAR; PG8_WAIT_L(0); PG8_MMA(0, 0, At, B0); PG8_BAR; PG8_SCHED;
            PG8_LDB(B1, 1, 1); PG8_STAGE(PG8_SB(1, 0), b3, voffB);
            PG8_BAR; PG8_WAIT_L(0); PG8_MMA(0, 1, At, B1); PG8_BAR;
            PG8_LDA(At, 1, 1); PG8_STAGE(PG8_SA(1, 0), a3, voffA);
            PG8_BAR; PG8_WAIT_L(0); PG8_MMA(1, 0, At, B0); PG8_BAR; PG8_SCHED;
            PG8_STAGE(PG8_SB(1, 1), b3 + hstep, voffB);
            PG8_WAIT_V(6); PG8_BAR; PG8_MMA(1, 1, At, B1); PG8_BAR;
        }
        E(acc, cur, wr, wc, fr, fq);
        if (!has_next) break;
#pragma unroll
        for (int a = 0; a < 2; ++a)
#pragma unroll
            for (int b = 0; b < 2; ++b)
#pragma unroll
                for (int m = 0; m < 4; ++m)
#pragma unroll
                    for (int n = 0; n < 2; ++n) acc[a][b][m][n] = (f32x4){0.f, 0.f, 0.f, 0.f};
        cur = nxt; cA = nA; cB = nB; ++ui;
    }
    PG8_WAIT_V(0);
    if (wr == 0) PG8_BAR;
    PG8_BAR;
#undef PG8_SA
#undef PG8_SB
#undef PG8_STAGE
#undef PG8_LDA
#undef PG8_LDB
#undef PG8_MMA
#undef PG8_WAIT_V
#undef PG8_WAIT_L
#undef PG8_BAR
#undef PG8_SCHED
}
}

struct EpiProj {
    static constexpr bool PERM = true;
    bf16_t* O; int ldc; const float* ssq;
    __device__ __forceinline__ void operator()(const f32x4 (&acc)[2][2][4][2], const pg8::Unit& u, int wr, int wc, int fr, int fq) const {
        const int row0 = u.pm * 256 + wr * 64 + fr, col0 = u.pn * 256 + wc * 32 + 8 * fq;
#pragma unroll
        for (int ai = 0; ai < 2; ++ai)
#pragma unroll
            for (int m = 0; m < 4; ++m) {
                const int row = row0 + ai * 128 + m * 16;
                const float rstd = rsqrtf(ssq[row] * (1.0f / 1024.0f) + 1e-6f);
                bf16_t* rowp = O + (size_t)row * ldc + col0;
#pragma unroll
                for (int bj = 0; bj < 2; ++bj) {
                    const f32x4 v0 = acc[ai][bj][m][0] * rstd, v1 = acc[ai][bj][m][1] * rstd;
                    u32x4 w; w.x = cvt_pk_bf16(v0[0], v0[1]); w.y = cvt_pk_bf16(v0[2], v0[3]); w.z = cvt_pk_bf16(v1[0], v1[1]); w.w = cvt_pk_bf16(v1[2], v1[3]);
                    *(u32x4*)(rowp + bj * 128) = w;
                }
            }
    }
};
struct EpiRes {
    static constexpr bool PERM = false;
    const float* xp; const float* xs; float* Xf; bf16_t* Xb; float* ssq_next;
    __device__ __forceinline__ void operator()(const f32x4 (&acc)[2][2][4][2], const pg8::Unit& u, int wr, int wc, int fr, int fq) const {
        const int row0 = u.pm * 256 + wr * 64 + fr, col0 = u.pn * 256 + wc * 32 + 4 * fq;
#pragma unroll
        for (int ai = 0; ai < 2; ++ai)
#pragma unroll
            for (int m = 0; m < 4; ++m) {
                const int row = row0 + ai * 128 + m * 16;
                const float* src = xp ? (row < NTP ? xp + (size_t)row * 1024 : xs + (size_t)(row - NTP) * 1024) : Xf + (size_t)row * 1024;
                float part = 0.f;
#pragma unroll
                for (int bj = 0; bj < 2; ++bj)
#pragma unroll
                    for (int n = 0; n < 2; ++n) {
                        const int col = col0 + bj * 128 + n * 16;
                        const f32x4 x = *(const f32x4*)(src + col) + acc[ai][bj][m][n];
                        *(f32x4*)(Xf + (size_t)row * 1024 + col) = x;
                        st_bf4(Xb + (size_t)row * 1024 + col, x);
                        part += dot4(x, x);
                    }
                part += __shfl_xor(part, 16); part += __shfl_xor(part, 32);
                if (fq == 0) atomicAdd(ssq_next + row, part);
            }
    }
};

__device__ __forceinline__ void tr_tile(const Ctx cx, LAS float* T, const float* src, int ld, int col0, int k0, bf16_t* dst, int Ktot, int drow0, const float* scale, bool zero) {
    const int tid = cx.tid;
    if (zero) {
        const int n = tid >> 3, kc = (tid & 7) * 8;
        *(u32x4*)(dst + (size_t)(drow0 + n) * Ktot + k0 + kc) = (u32x4){0u, 0u, 0u, 0u};
        return;
    }
#pragma unroll
    for (int pass = 0; pass < 2; ++pass) {
        const int kk = (tid >> 4) + pass * 32, nn = (tid & 15) * 4;
        f32x4 v = *(const f32x4*)(src + (size_t)(k0 + kk) * ld + col0 + nn);
        if (scale) v = v * scale[k0 + kk];
        T[kk * 65 + nn] = v[0]; T[kk * 65 + nn + 1] = v[1]; T[kk * 65 + nn + 2] = v[2]; T[kk * 65 + nn + 3] = v[3];
    }
    __syncthreads();
    {
        const int n = tid >> 3, kc = (tid & 7) * 8;
        u32x4 w;
        w.x = cvt_pk_bf16(T[(kc + 0) * 65 + n], T[(kc + 1) * 65 + n]); w.y = cvt_pk_bf16(T[(kc + 2) * 65 + n], T[(kc + 3) * 65 + n]);
        w.z = cvt_pk_bf16(T[(kc + 4) * 65 + n], T[(kc + 5) * 65 + n]); w.w = cvt_pk_bf16(T[(kc + 6) * 65 + n], T[(kc + 7) * 65 + n]);
        *(u32x4*)(dst + (size_t)(drow0 + n) * Ktot + k0 + kc) = w;
    }
    __syncthreads();
}

__device__ void phase_prepass(const Params& p, const Ctx cx, LAS unsigned char* lds) {
    LAS float* T = (LAS float*)lds;
    const int tid = cx.tid;
    for (int job = cx.bid; job < 4544; job += cx.nblk) {
        int j = job;
        if (j < 2176) {
            const int i = j / 1088, r = j % 1088, nt = r / 16, kt = r % 16;
            const int n0 = nt * 64;
            int col0; bool zero = false;
            if (n0 < 2048) col0 = n0; else if (n0 < 2560) col0 = 3712 + (n0 - 2048); else if (n0 < 4224) col0 = 2048 + (n0 - 2560); else { col0 = 0; zero = true; }
            tr_tile(cx, T, PIN(I_WINE) + (size_t)i * 1024 * 4224, 4224, col0, kt * 64, (bf16_t*)(PWS + WS_WINE) + (size_t)i * 4352 * 1024, 1024, n0, PIN(I_NORMW) + (2 * i) * 1024, zero);
            continue;
        }
        j -= 2176;
        if (j < 512) { const int i = j / 256, r = j % 256, nt = r / 16, kt = r % 16;
            tr_tile(cx, T, PIN(I_WOUTE) + (size_t)i * 1024 * 1024, 1024, nt * 64, kt * 64, (bf16_t*)(PWS + WS_WOUTE) + (size_t)i * 1024 * 1024, 1024, nt * 64, nullptr, false); continue; }
        j -= 512;
        if (j < 1280) { const int i = j / 640, r = j % 640, nt = r / 16, kt = r % 16;
            tr_tile(cx, T, PIN(I_WINO) + (size_t)i * 1024 * 2560, 2560, nt * 64, kt * 64, (bf16_t*)(PWS + WS_WINO) + (size_t)i * 2560 * 1024, 1024, nt * 64, PIN(I_NORMW) + (2 * i + 1) * 1024, false); continue; }
        j -= 1280;
        if (j < 512) { const int i = j / 256, r = j % 256, nt = r / 16, kt = r % 16;
            tr_tile(cx, T, PIN(I_WOUTO) + (size_t)i * 1024 * 1024, 1024, nt * 64, kt * 64, (bf16_t*)(PWS + WS_WOUTO) + (size_t)i * 1024 * 1024, 1024, nt * 64, nullptr, false); continue; }
        j -= 512;
        if (j < 16) { const int i = j / 8, nt = j % 8;
            tr_tile(cx, T, PIN(I_W2) + (size_t)i * 64 * 512, 512, nt * 64, 0, (bf16_t*)(PWS + WS_W2T) + (size_t)i * 512 * 64, 64, nt * 64, nullptr, false); continue; }
        j -= 16;
        if (j < 16) { const int i = j / 8, nt = j % 8;
            tr_tile(cx, T, PIN(I_A2) + (size_t)i * 64 * 512, 512, nt * 64, 0, (bf16_t*)(PWS + WS_A2T) + (size_t)i * 512 * 64, 64, nt * 64, nullptr, false); continue; }
        j -= 16;
        { const int ig = j / 4, r = j % 4, nt = r / 2, kt = r % 2;
            tr_tile(cx, T, PIN(I_POOLW) + (size_t)ig * 128 * 128, 128, nt * 64, kt * 64, (bf16_t*)(PWS + WS_POOLWT) + (size_t)ig * 128 * 128, 128, nt * 64, nullptr, false); }
    }
    const int gtid = cx.bid * 512 + tid, gthreads = cx.nblk * 512;
    for (int e = gtid; e < 8 * 128 * 128; e += gthreads) {
        const int s = e & 127, t = (e >> 7) & 127;
        ((bf16_t*)(PWS + WS_SPW))[e] = (s <= t) ? (bf16_t)(cvt_pk_bf16(PIN(I_SPW)[e], 0.f) & 0xffffu) : (bf16_t)0;
    }
    for (int e = gtid; e < 4 * NTOK; e += gthreads) ((float*)(PWS + WS_SSQ))[NTOK + e] = 0.f;
    const int wid = tid >> 6, lane = tid & 63;
    for (int row = cx.bid * 8 + wid; row < NTOK; row += cx.nblk * 8) {
        const float* src = row < NTP ? PIN(I_XP) + (size_t)row * 1024 : PIN(I_XS) + (size_t)(row - NTP) * 1024;
        bf16_t* dst = (bf16_t*)(PWS + WS_XB) + (size_t)row * 1024;
        float ss = 0.f;
#pragma unroll
        for (int i = 0; i < 4; ++i) { const f32x4 v = *(const f32x4*)(src + i * 256 + lane * 4); ss += dot4(v, v); st_bf4(dst + i * 256 + lane * 4, v); }
#pragma unroll
        for (int o = 32; o >= 1; o >>= 1) ss += __shfl_xor(ss, o);
        if (lane == 0) ((float*)(PWS + WS_SSQ))[row] = ss;
    }
}

__device__ __forceinline__ f32x4 shift4(const bf16_t* cur, bool hp, const float* st, int col, const float* mu) {
    const f32x4 q = ld_bf4(cur + col);
    f32x4 pv;
    if (hp) pv = ld_bf4(cur - LDB + col); else if (st) pv = *(const f32x4*)(st + col); else pv = (f32x4){0.f, 0.f, 0.f, 0.f};
    const f32x4 m = *(const f32x4*)(mu + col);
    return q + m * (pv - q);
}

__device__ void phase_even_prep(const Params& p, const Ctx cx, int pair) {
    const int tid = cx.tid, wid = tid >> 6, lane = tid & 63, fr = lane & 15, fq = lane >> 4;
    const bf16_t* PB = (const bf16_t*)(PWS + WS_PROJB);
    float* Wdec = (float*)(PWS + WS_WDEC);
    bf16_t* Aa = (bf16_t*)(PWS + WS_AA);
    bf16_t* Ycat = (bf16_t*)(PWS + WS_YCAT);
    const float* mu = PIN(I_MU) + pair * 1664;
    const bf16_t* W2T = (const bf16_t*)(PWS + WS_W2T) + (size_t)pair * 512 * 64;
    const bf16_t* A2T = (const bf16_t*)(PWS + WS_A2T) + (size_t)pair * 512 * 64;
    const float* w0 = PIN(I_W0) + pair * 512; const float* a0 = PIN(I_A0) + pair * 512;
    const float* k_a = PIN(I_KA) + pair * 512; const float* r_k = PIN(I_RK) + pair * 512;
    for (int unit = cx.bid * 8 + wid; unit < NTOK / 16; unit += cx.nblk * 8) {
        const int row = unit * 16 + fr;
        const bool samp = row >= NTP;
        int b, t; if (!samp) { b = row >> 11; t = row & 2047; } else { const int q = row - NTP; b = q >> 3; t = q & 7; }
        const bf16_t* cur = PB + (size_t)row * LDB;
        const bool hp = t > 0;
        const float* st = samp ? PIN(I_SSHIFT) + ((size_t)pair * 128 + b) * 1664 : nullptr;
        bf16x8 Aw[2], Al[2];
#pragma unroll
        for (int ks = 0; ks < 2; ++ks) {
            const int cw = 1536 + ks * 32 + fq * 8, ca = 1600 + ks * 32 + fq * 8;
            const f32x4 w_lo = shift4(cur, hp, st, cw, mu), w_hi = shift4(cur, hp, st, cw + 4, mu);
            const f32x4 a_lo = shift4(cur, hp, st, ca, mu), a_hi = shift4(cur, hp, st, ca + 4, mu);
            u32x4 pw, pa;
            float th[8];
#pragma unroll
            for (int j = 0; j < 4; ++j) { th[j] = 2.0f * sigmoidf_(2.0f * w_lo[j]) - 1.0f; th[4 + j] = 2.0f * sigmoidf_(2.0f * w_hi[j]) - 1.0f; }
            pw.x = cvt_pk_bf16(th[0], th[1]); pw.y = cvt_pk_bf16(th[2], th[3]); pw.z = cvt_pk_bf16(th[4], th[5]); pw.w = cvt_pk_bf16(th[6], th[7]);
            pa.x = cvt_pk_bf16(a_lo[0], a_lo[1]); pa.y = cvt_pk_bf16(a_lo[2], a_lo[3]); pa.z = cvt_pk_bf16(a_hi[0], a_hi[1]); pa.w = cvt_pk_bf16(a_hi[2], a_hi[3]);
            Aw[ks] = __builtin_bit_cast(bf16x8, pw); Al[ks] = __builtin_bit_cast(bf16x8, pa);
        }
#pragma unroll 1
        for (int h = 0; h < 8; ++h) {
            float bon = 0.f;
#pragma unroll 1
            for (int nt = 0; nt < 4; ++nt) {
                const int n0 = h * 64 + nt * 16;
                f32x4 lw = (f32x4){0.f, 0.f, 0.f, 0.f}, la = (f32x4){0.f, 0.f, 0.f, 0.f};
#pragma unroll
                for (int ks = 0; ks < 2; ++ks) {
                    const bf16x8 wf = *(const bf16x8*)(W2T + (size_t)(n0 + fr) * 64 + ks * 32 + fq * 8);
                    const bf16x8 af = *(const bf16x8*)(A2T + (size_t)(n0 + fr) * 64 + ks * 32 + fq * 8);
                    lw = __builtin_amdgcn_mfma_f32_16x16x32_bf16(wf, Aw[ks], lw, 0, 0, 0);
                    la = __builtin_amdgcn_mfma_f32_16x16x32_bf16(af, Al[ks], la, 0, 0, 0);
                }
                const int ch = n0 + fq * 4;
                const f32x4 r4 = shift4(cur, hp, st, ch, mu), k4 = shift4(cur, hp, st, 512 + ch, mu);
                const f32x4 w04 = *(const f32x4*)(w0 + ch), a04 = *(const f32x4*)(a0 + ch), ka4 = *(const f32x4*)(k_a + ch), rk4 = *(const f32x4*)(r_k + ch);
                f32x4 dec, av;
#pragma unroll
                for (int j = 0; j < 4; ++j) {
                    const float z_ = -(w04[j] + lw[j]);
                    const float wlog = -__logf(1.0f + __expf(z_)) - 0.5f;
                    dec[j] = __expf(-__expf(wlog));
                    av[j] = sigmoidf_(a04[j] + la[j]);
                    const float kp = k4[j] * (1.0f + (av[j] - 1.0f) * ka4[j]);
                    bon += r4[j] * kp * rk4[j];
                }
                *(f32x4*)(Wdec + (size_t)row * 512 + ch) = dec;
                st_bf4(Aa + (size_t)row * 512 + ch, av);
            }
            bon += __shfl_xor(bon, 16); bon += __shfl_xor(bon, 32);
#pragma unroll 1
            for (int nt = 0; nt < 4; ++nt) {
                const int ch = h * 64 + nt * 16 + fq * 4;
                st_bf4(Ycat + (size_t)row * 1024 + 512 + ch, shift4(cur, hp, st, 1024 + ch, mu) * bon);
            }
        }
    }
    const int gtid = cx.bid * 512 + tid, gthreads = cx.nblk * 512;
    for (int e = gtid; e < 136 * 1664; e += gthreads) {
        const int sr = e / 1664, c = e % 1664;
        if (sr < 8) POUT[O_SHIFTP + ((size_t)pair * 8 + sr) * 1664 + c] = bf2f(PB[(size_t)(sr * 2048 + 2047) * LDB + c]);
        else { const int b = sr - 8; POUT[O_SHIFTS + ((size_t)pair * 128 + b) * 1664 + c] = bf2f(PB[(size_t)(NTP + b * 8 + 7) * LDB + c]); }
    }
}

__device__ __forceinline__ void scan_step(f32x4& S, const f32x4 w, const f32x4 k, const f32x4 kk, const f32x4 bb, const f32x4 r, const float v, float& y) {
    float pd = dot4(S, kk);
    const f32x4 tmp = S * w + k * v;
    pd = allsum16(pd);
    S = tmp - bb * pd;
    y = allsum16(dot4(S, r));
}

__device__ void phase_scan(const Params& p, const Ctx cx, int pair, LAS unsigned char* lds) {
    const int tid = cx.tid, wid = tid >> 6, lane = tid & 63, rs = lane >> 4, cgi = lane & 15;
    const bf16_t* PB = (const bf16_t*)(PWS + WS_PROJB);
    const float* Wdec = (const float*)(PWS + WS_WDEC);
    const bf16_t* Aa = (const bf16_t*)(PWS + WS_AA);
    float* Y = (float*)(PWS + WS_Y);
    const float* mu = PIN(I_MU) + pair * 1664;
    const float* k_k = PIN(I_KK) + pair * 512; const float* k_a = PIN(I_KA) + pair * 512;
    {
        LAS float* vb = (LAS float*)lds + wid * 3072;
        for (int st = cx.bid * 8 + wid; st < 2048; st += cx.nblk * 8) {
            const int bh = st >> 1, half = st & 1, b = bh >> 3, h = bh & 7, ch = h * 64 + cgi * 4;
            const float* stp = PIN(I_SSHIFT) + ((size_t)pair * 128 + b) * 1664;
            const f32x4 kkc = *(const f32x4*)(k_k + ch), kac = *(const f32x4*)(k_a + ch);
            {
#pragma unroll
                for (int tt = 0; tt < 2; ++tt) {
                    const int t = rs + tt * 4;
                    const size_t row = NTP + b * 8 + t;
                    const bf16_t* cur = PB + row * LDB;
                    const f32x4 r = shift4(cur, t > 0, stp, ch, mu), k = shift4(cur, t > 0, stp, 512 + ch, mu), v = shift4(cur, t > 0, stp, 1024 + ch, mu);
                    const f32x4 a = ld_bf4(Aa + row * 512 + ch);
                    const f32x4 w = *(const f32x4*)(Wdec + row * 512 + ch);
                    const f32x4 kkv = k * kkc;
                    const float ss = allsum16(dot4(kkv, kkv));
                    const float inv = 1.0f / fmaxf(sqrtf(ss), 1e-12f);
                    const f32x4 kkn = kkv * inv;
                    LAS float* o = vb + t * 384 + cgi * 4;
                    *(LAS f32x4*)(o) = w; *(LAS f32x4*)(o + 64) = k * (1.0f + (a - 1.0f) * kac); *(LAS f32x4*)(o + 128) = kkn; *(LAS f32x4*)(o + 192) = kkn * a;
                    *(LAS f32x4*)(o + 256) = r; *(LAS f32x4*)(o + 320) = v;
                }
            }
            asm volatile("s_waitcnt lgkmcnt(0)" ::: "memory");
            __builtin_amdgcn_wave_barrier();
#pragma unroll 1
            for (int rq = 0; rq < 8; ++rq) {
                const int ri = half * 32 + rq * 4 + rs;
                const size_t so = ((((size_t)pair * 128 + b) * 8 + h) * 64 + ri) * 64 + cgi * 4;
                f32x4 S = *(const f32x4*)(PIN(I_SWKV) + so);
#pragma unroll
                for (int t = 0; t < 8; ++t) {
                    LAS const float* r0 = vb + t * 384 + cgi * 4;
                    float y; scan_step(S, *(LAS const f32x4*)(r0), *(LAS const f32x4*)(r0 + 64), *(LAS const f32x4*)(r0 + 128), *(LAS const f32x4*)(r0 + 192), *(LAS const f32x4*)(r0 + 256), vb[t * 384 + 320 + ri], y);
                    if (cgi == 0) Y[(size_t)(NTP + b * 8 + t) * 512 + h * 64 + ri] = y;
                }
                *(f32x4*)(POUT + O_WKVS + so) = S;
            }
            asm volatile("s_waitcnt lgkmcnt(0)" ::: "memory");
            __builtin_amdgcn_wave_barrier();
        }
    }
    __syncthreads();
    LAS float* rec = (LAS float*)lds;
    for (int pt = cx.bid; pt < 256; pt += cx.nblk) {
        const int xcd = pt & 7, slot = pt >> 3, bh = xcd * 8 + (slot >> 2), rg = slot & 3, b = bh >> 3, h = bh & 7;
        const int lt = tid - 256, ls = (lt >> 4) & 15, lcg = lt & 15, lch = h * 64 + lcg * 4;
        u32x2 qr = {0u, 0u}, qk = {0u, 0u}, qv = {0u, 0u}, pr = {0u, 0u}, pk = {0u, 0u}, pv = {0u, 0u}, qa = {0u, 0u};
        f32x4 qw = (f32x4){0.f, 0.f, 0.f, 0.f};
        f32x4 mur, muk, muv, kkc, kac;
        const int ri = rg * 16 + (wid & 3) * 4 + rs;
        f32x4 S = (f32x4){0.f, 0.f, 0.f, 0.f};
#define SCAN_ISSUE(c) do { const int t_ = (c) * 16 + ls; const size_t row_ = (size_t)b * 2048 + t_; const bf16_t* cur_ = PB + row_ * LDB; \
            qr = *(const u32x2*)(cur_ + lch); qk = *(const u32x2*)(cur_ + 512 + lch); qv = *(const u32x2*)(cur_ + 1024 + lch); \
            if (t_ > 0) { pr = *(const u32x2*)(cur_ - LDB + lch); pk = *(const u32x2*)(cur_ - LDB + 512 + lch); pv = *(const u32x2*)(cur_ - LDB + 1024 + lch); } \
            else { pr = (u32x2){0u, 0u}; pk = pr; pv = pr; } \
            qw = *(const f32x4*)(Wdec + row_ * 512 + lch); qa = *(const u32x2*)(Aa + row_ * 512 + lch); } while (0)
#define SCAN_PROCESS(buf) do { const f32x4 r0_ = cvt4(qr), k0_ = cvt4(qk), v0_ = cvt4(qv); \
            const f32x4 r_ = r0_ + mur * (cvt4(pr) - r0_), k_ = k0_ + muk * (cvt4(pk) - k0_), v_ = v0_ + muv * (cvt4(pv) - v0_), a_ = cvt4(qa); \
            const f32x4 kkv_ = k_ * kkc; const float ss_ = allsum16(dot4(kkv_, kkv_)); const float inv_ = 1.0f / fmaxf(sqrtf(ss_), 1e-12f); \
            const f32x4 kkn_ = kkv_ * inv_; \
            LAS float* o_ = rec + (buf) * 6144 + ls * 384 + lcg * 4; \
            *(LAS f32x4*)(o_) = qw; *(LAS f32x4*)(o_ + 64) = k_ * (1.0f + (a_ - 1.0f) * kac); *(LAS f32x4*)(o_ + 128) = kkn_; *(LAS f32x4*)(o_ + 192) = kkn_ * a_; \
            *(LAS f32x4*)(o_ + 256) = r_; *(LAS f32x4*)(o_ + 320) = v_; } while (0)
        if (wid >= 4) {
            mur = *(const f32x4*)(mu + lch); muk = *(const f32x4*)(mu + 512 + lch); muv = *(const f32x4*)(mu + 1024 + lch);
            kkc = *(const f32x4*)(k_k + lch); kac = *(const f32x4*)(k_a + lch);
            SCAN_ISSUE(0); SCAN_PROCESS(0); SCAN_ISSUE(1);
        }
        __syncthreads();
        for (int c = 0; c < 128; ++c) {
            if (wid < 4) {
                LAS const float* rb = rec + (c & 1) * 6144 + cgi * 4;
                LAS const float* rv = rec + (c & 1) * 6144 + 320 + ri;
                float ykeep = 0.f;
                f32x4 nw = *(LAS const f32x4*)(rb), nk = *(LAS const f32x4*)(rb + 64), nkk = *(LAS const f32x4*)(rb + 128), nb = *(LAS const f32x4*)(rb + 192), nr = *(LAS const f32x4*)(rb + 256);
                float nv = rv[0];
#pragma unroll
                for (int s = 0; s < 16; ++s) {
                    const f32x4 cw = nw, ck = nk, ckk = nkk, cb = nb, cr = nr; const float cv = nv;
                    if (s + 1 < 16) {
                        LAS const float* r1 = rb + (s + 1) * 384;
                        nw = *(LAS const f32x4*)(r1); nk = *(LAS const f32x4*)(r1 + 64); nkk = *(LAS const f32x4*)(r1 + 128); nb = *(LAS const f32x4*)(r1 + 192); nr = *(LAS const f32x4*)(r1 + 256);
                        nv = rv[(s + 1) * 384];
                    }
                    float y;
                    scan_step(S, cw, ck, ckk, cb, cr, cv, y);
                    ykeep = (cgi == s) ? y : ykeep;
                }
                Y[((size_t)b * 2048 + c * 16 + cgi) * 512 + h * 64 + ri] = ykeep;
            } else {
                if (c + 1 < 128) { SCAN_PROCESS((c + 1) & 1); if (c + 2 < 128) SCAN_ISSUE(c + 2); }
            }
            __syncthreads();
        }
        if (wid < 4) *(f32x4*)(POUT + O_WKVP + ((((size_t)pair * 8 + b) * 8 + h) * 64 + ri) * 64 + cgi * 4) = S;
#undef SCAN_ISSUE
#undef SCAN_PROCESS
    }
}

__device__ void phase_even_post(const Params& p, const Ctx cx, int pair) {
    const int gtid = cx.bid * 512 + cx.tid, gthreads = cx.nblk * 512;
    const bf16_t* PA = (const bf16_t*)(PWS + WS_R1);
    bf16_t* Ycat = (bf16_t*)(PWS + WS_YCAT);
    const float* Y = (const float*)(PWS + WS_Y);
    const float* gn_g = PIN(I_GNG) + pair * 512; const float* gn_b = PIN(I_GNB) + pair * 512;
    for (int e = gtid; e < NTOK * 128; e += gthreads) {
        const int row = e >> 7, ch = (e & 127) * 4;
        const f32x4 y = *(const f32x4*)(Y + (size_t)row * 512 + ch);
        const float mean = allsum16(y[0] + y[1] + y[2] + y[3]) * (1.0f / 64.0f);
        const f32x4 d = y - mean;
        const float var = allsum16(dot4(d, d)) * (1.0f / 64.0f);
        const float rstd = rsqrtf(var + 64e-5f);
        const f32x4 g = *(const f32x4*)(gn_g + ch), bb = *(const f32x4*)(gn_b + ch);
        bf16_t* yo = Ycat + (size_t)row * 1024 + 512 + ch;
        const f32x4 bv = ld_bf4(yo);
        const f32x4 bz = ld_bf4(PA + (size_t)row * LDA + 2048 + ch);
        f32x4 o;
#pragma unroll
        for (int j = 0; j < 4; ++j) o[j] = (d[j] * rstd * g[j] + bb[j] + bv[j]) * siluf_(bz[j]);
        st_bf4(yo, o);
    }
    const float* cw = PIN(I_CONVW) + pair * 3 * 512;
    for (int e = gtid; e < NTOK * 128; e += gthreads) {
        const int row = e >> 7, ch = (e & 127) * 4;
        const bool samp = row >= NTP;
        int b, t, T; if (!samp) { b = row >> 11; t = row & 2047; T = 2048; } else { const int q = row - NTP; b = q >> 3; t = q & 7; T = 8; }
        const bf16_t* cur = PA + (size_t)row * LDA;
        const f32x4 u0 = ld_bf4(cur + 1024 + ch) * ld_bf4(cur + ch);
        f32x4 u1, u2;
        const float* hist = PIN(I_SCONV) + ((size_t)pair * 128 + b) * 2 * 512 + ch;
        if (t >= 1) u1 = ld_bf4(cur - LDA + 1024 + ch) * ld_bf4(cur - LDA + ch);
        else if (samp) u1 = *(const f32x4*)(hist + 512); else u1 = (f32x4){0.f, 0.f, 0.f, 0.f};
        if (t >= 2) u2 = ld_bf4(cur - 2 * LDA + 1024 + ch) * ld_bf4(cur - 2 * LDA + ch);
        else if (samp) u2 = *(const f32x4*)(hist + (t == 1 ? 512 : 0)); else u2 = (f32x4){0.f, 0.f, 0.f, 0.f};
        const f32x4 c0 = *(const f32x4*)(cw + ch), c1 = *(const f32x4*)(cw + 512 + ch), c2 = *(const f32x4*)(cw + 1024 + ch);
        const f32x4 conv = c0 * u2 + c1 * u1 + c2 * u0;
        const f32x4 ab = ld_bf4(cur + 512 + ch), az = ld_bf4(cur + 1536 + ch);
        f32x4 o;
#pragma unroll
        for (int j = 0; j < 4; ++j) o[j] = ab[j] * conv[j] * siluf_(az[j]);
        st_bf4(Ycat + (size_t)row * 1024 + ch, o);
        if (t >= T - 2) {
            float* dst = samp ? POUT + O_CONVS + (((size_t)pair * 128 + b) * 2 + (t - (T - 2))) * 512 + ch : POUT + O_CONVP + (((size_t)pair * 8 + b) * 2 + (t - (T - 2))) * 512 + ch;
            *(f32x4*)dst = u0;
        }
    }
}

__device__ void phase_odd_mixer(const Params& p, const Ctx cx, int pair, LAS unsigned char* lds) {
    const int tid = cx.tid, wid = tid >> 6, lane = tid & 63, fr = lane & 15, fq = lane >> 4;
    const bf16_t* PO = (const bf16_t*)(PWS + WS_R1);
    bf16_t* Ycat = (bf16_t*)(PWS + WS_YCAT);
    LAS bf16_t* LA = (LAS bf16_t*)lds;
    LAS bf16_t* LB = (LAS bf16_t*)(lds + 128 * 136 * 2);
    LAS float* stat = (LAS float*)(lds + 2 * 128 * 136 * 2);
    for (int it = cx.bid; it < 1088; it += cx.nblk) {
        const int tile = it >> 3, kind = (it >> 2) & 1, g = it & 3;
        const int r0 = tile * 128;
        const bool samp = r0 >= NTP;
        if (kind == 0) {
            const int w = 2 << g;
            for (int e = tid; e < 128 * 32; e += 512) {
                const int tl = e >> 5, c = (e & 31) * 4, row = r0 + tl;
                int b, t; if (!samp) { b = row >> 11; t = row & 2047; } else { const int q = row - NTP; b = q >> 3; t = q & 7; }
                const bf16_t* cur = PO + (size_t)row * LDA + g * 128 + c;
                const f32x4 pt = ld_bf4(cur);
                f32x4 sum = pt;
                for (int d = 1; d < w; ++d) {
                    const int tt = t - d;
                    if (tt >= 0) sum += ld_bf4(cur - (size_t)d * LDA);
                    else if (samp) sum += *(const f32x4*)(PIN(I_SPOOL) + (((size_t)pair * 128 + b) * 15 + (15 + tt)) * 512 + g * 128 + c);
                }
                const float cnt = samp ? (float)w : fminf((float)w, (float)(t + 1));
                const f32x4 pooled = sum * (1.0f / cnt) - pt;
                u32x2 u; u.x = cvt_pk_bf16(pooled[0], pooled[1]); u.y = cvt_pk_bf16(pooled[2], pooled[3]);
                *(LAS u32x2*)(LA + tl * 136 + c) = u;
            }
            __syncthreads();
            const bf16_t* Bw = (const bf16_t*)(PWS + WS_POOLWT) + ((size_t)pair * 4 + g) * 128 * 128;
            const int row = r0 + wid * 16 + fr;
            bf16x8 af[4];
#pragma unroll
            for (int ks = 0; ks < 4; ++ks) af[ks] = *(const LAS bf16x8*)(LA + (wid * 16 + fr) * 136 + ks * 32 + fq * 8);
#pragma unroll
            for (int nt = 0; nt < 8; ++nt) {
                f32x4 acc = (f32x4){0.f, 0.f, 0.f, 0.f};
#pragma unroll
                for (int ks = 0; ks < 4; ++ks) {
                    const bf16x8 bf = *(const bf16x8*)(Bw + (size_t)(nt * 16 + fr) * 128 + ks * 32 + fq * 8);
                    acc = __builtin_amdgcn_mfma_f32_16x16x32_bf16(bf, af[ks], acc, 0, 0, 0);
                }
                const int d = g * 128 + nt * 16 + fq * 4;
                const f32x4 cz = ld_bf4(PO + (size_t)row * LDA + 512 + d), ps = *(const f32x4*)(PIN(I_PSCALE) + pair * 512 + d);
                f32x4 o;
#pragma unroll
                for (int j = 0; j < 4; ++j) o[j] = acc[j] * ps[j] * siluf_(cz[j]);
                st_bf4(Ycat + (size_t)row * 1024 + d, o);
            }
            __syncthreads();
        } else {
            {
                const int tl = tid >> 2, q = tid & 3;
                const bf16_t* vr = PO + (size_t)(r0 + tl) * LDA + 1536 + q * 128;
                float s = 0.f, ss = 0.f;
#pragma unroll
                for (int i = 0; i < 32; ++i) { const f32x4 v = ld_bf4(vr + i * 4); s += v[0] + v[1] + v[2] + v[3]; ss += dot4(v, v); }
                s = allsum4(s); ss = allsum4(ss);
                const float mean = s * (1.0f / 512.0f);
                const float var = fmaxf(ss * (1.0f / 512.0f) - mean * mean, 0.f);
                if (q == 0) { stat[tl * 2] = mean; stat[tl * 2 + 1] = rsqrtf(var + 1e-5f); }
            }
            __syncthreads();
            {
                const int tl = tid >> 2, q = tid & 3, row = r0 + tl;
                const float mean = stat[tl * 2], rstd = stat[tl * 2 + 1];
                const bf16_t* vr = PO + (size_t)row * LDA + 1536 + g * 128 + q * 32;
                const float* lg = PIN(I_LNG) + pair * 512 + g * 128 + q * 32; const float* lb = PIN(I_LNB) + pair * 512 + g * 128 + q * 32;
#pragma unroll
                for (int i = 0; i < 8; ++i) {
                    const f32x4 v = ld_bf4(vr + i * 4);
                    const f32x4 vn = (v - mean) * rstd * *(const f32x4*)(lg + i * 4) + *(const f32x4*)(lb + i * 4);
                    if (samp) *(f32x4*)(POUT + O_CHUNKV + ((size_t)pair * 1024 + (row - NTP)) * 512 + g * 128 + q * 32 + i * 4) = vn;
#pragma unroll
                    for (int j = 0; j < 4; ++j) LB[(q * 32 + i * 4 + j) * 136 + tl] = (bf16_t)(cvt_pk_bf16(vn[j], 0.f) & 0xffffu);
                }
            }
            if (!samp) {
                const bf16_t* Wsrc = (const bf16_t*)(PWS + WS_SPW) + ((size_t)pair * 4 + g) * 128 * 128;
                for (int e = tid; e < 128 * 16; e += 512) { const int t = e >> 4, s8 = (e & 15) * 8; *(LAS u32x4*)(LA + t * 136 + s8) = *(const u32x4*)(Wsrc + t * 128 + s8); }
            } else {
                const float* Wsrc = PIN(I_SPW) + ((size_t)pair * 4 + g) * 128 * 128;
                for (int e = tid; e < 128 * 128; e += 512) { const int t = e >> 7, s = e & 127;
                    const float v = ((t >> 3) == (s >> 3) && (s & 7) <= (t & 7)) ? Wsrc[(t & 7) * 128 + (s & 7)] : 0.f;
                    LA[t * 136 + s] = (bf16_t)(cvt_pk_bf16(v, 0.f) & 0xffffu); }
            }
            __syncthreads();
            {
                const int tl = wid * 16 + fr, row = r0 + tl;
                const float bias = PIN(I_SPB)[((size_t)pair * 4 + g) * 128 + (samp ? (tl & 7) : tl)];
                bf16x8 wf[4];
#pragma unroll
                for (int ks = 0; ks < 4; ++ks) wf[ks] = *(const LAS bf16x8*)(LA + tl * 136 + ks * 32 + fq * 8);
#pragma unroll
                for (int nt = 0; nt < 8; ++nt) {
                    f32x4 acc = (f32x4){0.f, 0.f, 0.f, 0.f};
#pragma unroll
                    for (int ks = 0; ks < 4; ++ks) {
                        if (ks * 32 <= wid * 16 + 15) {
                            const bf16x8 vf = *(const LAS bf16x8*)(LB + (nt * 16 + fr) * 136 + ks * 32 + fq * 8);
                            acc = __builtin_amdgcn_mfma_f32_16x16x32_bf16(vf, wf[ks], acc, 0, 0, 0);
                        }
                    }
                    const int c = g * 128 + nt * 16 + fq * 4;
                    const f32x4 u = ld_bf4(PO + (size_t)row * LDA + 1024 + c), dz = ld_bf4(PO + (size_t)row * LDA + 2048 + c);
                    f32x4 o;
#pragma unroll
                    for (int j = 0; j < 4; ++j) o[j] = u[j] * (acc[j] + bias) * siluf_(dz[j]);
                    st_bf4(Ycat + (size_t)row * 1024 + 512 + c, o);
                }
            }
            __syncthreads();
        }
    }
    const int gtid = cx.bid * 512 + tid, gthreads = cx.nblk * 512;
    for (int e = gtid; e < 136 * 15 * 512; e += gthreads) {
        const int c = e & 511, q = e >> 9, sr = q / 15, k = q % 15;
        if (sr < 8) POUT[O_POOLP + (((size_t)pair * 8 + sr) * 15 + k) * 512 + c] = bf2f(PO[(size_t)(sr * 2048 + 2033 + k) * LDA + c]);
        else { const int b = sr - 8;
            POUT[O_POOLS + (((size_t)pair * 128 + b) * 15 + k) * 512 + c] = (k < 7) ? PIN(I_SPOOL)[(((size_t)pair * 128 + b) * 15 + 8 + k) * 512 + c] : bf2f(PO[(size_t)(NTP + b * 8 + (k - 7)) * LDA + c]); }
    }
}

__device__ void phase_final(const Params& p, const Ctx cx) {
    const int gtid = cx.bid * 512 + cx.tid, gthreads = cx.nblk * 512;
    const float* ssq = (const float*)(PWS + WS_SSQ) + 4 * NTOK;
    for (int e = gtid; e < NTOK * 256; e += gthreads) {
        const int row = e >> 8, c = (e & 255) * 4;
        const float rstd = rsqrtf(ssq[row] * (1.0f / 1024.0f) + 1e-6f);
        f32x4* px = (f32x4*)(POUT + (size_t)row * 1024 + c);
        *px = *px * rstd * *(const f32x4*)(PIN(I_FNORMW) + c);
    }
}

#define XB_TMO      128
#define XB_XCNT(j)  (256  + 64 * (j))
#define XB_XSUB(j)  (1280 + 64 * (j))
#define XB_XGEN(j)  (2304 + 64 * (j))
#define XB_TOP      3328
#define XB_TOPGEN   3392
#define XCD_BAR_WORDS 3456
#define XB_SPIN_CAP (1u << 18)
__device__ __forceinline__ unsigned xb_ld(unsigned* p)              { return __hip_atomic_load(p, __ATOMIC_RELAXED, __HIP_MEMORY_SCOPE_AGENT); }
__device__ __forceinline__ unsigned xb_add(unsigned* p, unsigned v) { return __hip_atomic_fetch_add(p, v, __ATOMIC_RELAXED, __HIP_MEMORY_SCOPE_AGENT); }
__device__ __forceinline__ unsigned xb_xcc_id() { return (unsigned)__builtin_amdgcn_s_getreg((3 << 11) | 20) & 0xFu; }
#define XB_SPIN(cond, bar) do { unsigned _sp = 0; while (cond) { __builtin_amdgcn_s_sleep(1); \
    if ((++_sp & 255u) == 0u) { if (xb_ld(&(bar)[XB_TMO])) break; if (_sp > XB_SPIN_CAP) { atomicAdd(&(bar)[XB_TMO], 1u); break; } } } } while (0)
struct XcdBarrier { unsigned* bar; unsigned x; volatile LAS unsigned* st; };
__device__ __forceinline__ XcdBarrier xcd_barrier_post(unsigned* bar, volatile LAS unsigned* st) {
    XcdBarrier b; b.bar = bar; b.x = xb_xcc_id(); b.st = st;
    if (threadIdx.x == 0) (void)xb_add(&bar[XB_XCNT(b.x)], 1u);
    return b;
}
__device__ __forceinline__ void xcd_barrier_complete(unsigned* bar, unsigned x, unsigned& nloc, unsigned& nx) {
    const unsigned G = gridDim.x * gridDim.y * gridDim.z;
    unsigned sum, cnt, mine, sp = 0u;
    for (;;) {
        sum = 0u; cnt = 0u; mine = 0u;
#pragma unroll
        for (unsigned j = 0; j < 16; ++j) { const unsigned c = xb_ld(&bar[XB_XCNT(j)]); sum += c; cnt += (c > 0u) ? 1u : 0u; mine = (j == x) ? c : mine; }
        if (sum == G) break;
        __builtin_amdgcn_s_sleep(1);
        if ((++sp & 255u) == 0u) { if (xb_ld(&bar[XB_TMO])) break; if (sp > XB_SPIN_CAP) { atomicAdd(&bar[XB_TMO], 1u); break; } }
    }
    nloc = mine > 0u ? mine : 1u; nx = cnt > 0u ? cnt : 1u;
}
__device__ __forceinline__ void xcd_barrier(const XcdBarrier& b) {
    asm volatile("s_waitcnt vmcnt(0)" ::: "memory");
    __syncthreads();
    if (threadIdx.x == 0) {
        unsigned* bar = b.bar;
        __builtin_amdgcn_s_waitcnt(0);
        unsigned nloc = b.st[0], nx = b.st[1];
        if (nloc == 0u) { xcd_barrier_complete(bar, b.x, nloc, nx); b.st[0] = nloc; b.st[1] = nx; }
        const unsigned old = xb_add(&bar[XB_XSUB(b.x)], 1u);
        const unsigned gen = old / nloc;
        if (old + 1u == (gen + 1u) * nloc) {
            __builtin_amdgcn_fence(__ATOMIC_RELEASE, "agent");
            asm volatile("s_waitcnt vmcnt(0)" ::: "memory");
            const unsigned og = xb_add(&bar[XB_TOP], 1u);
            const unsigned tg = og / nx;
            if (og + 1u == (tg + 1u) * nx) xb_add(&bar[XB_TOPGEN], 1u);
            else XB_SPIN(xb_ld(&bar[XB_TOPGEN]) == tg, bar);
            __builtin_amdgcn_fence(__ATOMIC_ACQUIRE, "agent");
            xb_add(&bar[XB_XGEN(b.x)], 1u);
            asm volatile("s_waitcnt vmcnt(0)" ::: "memory");
        } else {
            XB_SPIN(xb_ld(&bar[XB_XGEN(b.x)]) == gen, bar);
            __builtin_amdgcn_fence(__ATOMIC_ACQUIRE, "agent");
            asm volatile("s_waitcnt vmcnt(0)" ::: "memory");
        }
    }
    __syncthreads();
}

__device__ void run_gemm_proj(const Params& p, const Ctx cx, LAS unsigned char* lds, const bf16_t* Bt, int N, bf16_t* O, int ldc, int layer) {
    pg8::Gemm g{(const bf16_t*)(PWS + WS_XB), Bt, NTOK, N, 1024};
    pg8::StaticOrder S; S.init(NTOK, N, (int)cx.nblk, (int)cx.bid);
    EpiProj E{O, ldc, (const float*)(PWS + WS_SSQ) + (size_t)layer * NTOK};
    pg8::gemm_phase<EpiProj>(cx, lds, g, S, E);
}
__device__ void run_gemm_res(const Params& p, const Ctx cx, LAS unsigned char* lds, const bf16_t* Bt, int layer) {
    pg8::Gemm g{(const bf16_t*)(PWS + WS_YCAT), Bt, NTOK, 1024, 1024};
    pg8::StaticOrder S; S.init(NTOK, 1024, (int)cx.nblk, (int)cx.bid);
    EpiRes E{layer == 0 ? PIN(I_XP) : nullptr, PIN(I_XS), POUT, (bf16_t*)(PWS + WS_XB), (float*)(PWS + WS_SSQ) + (size_t)(layer + 1) * NTOK};
    pg8::gemm_phase<EpiRes>(cx, lds, g, S, E);
}

constexpr int N_PHASES = 20;
#ifndef PHMASK
#define PHMASK 0xffff
#endif
#define PHON(n) ((PHMASK >> ((n) % 16)) & 1)
__global__ void __launch_bounds__(512, 2) fwd_kernel(Params p) {
    extern __shared__ __attribute__((aligned(16))) unsigned char lds_raw[];
    LAS unsigned char* lds = (LAS unsigned char*)lds_raw;
    volatile LAS unsigned* bar_st = (volatile LAS unsigned*)(lds + 131072);
    if (threadIdx.x < 4) bar_st[threadIdx.x] = 0u;
    __syncthreads();
    const XcdBarrier gbar = xcd_barrier_post((unsigned*)((unsigned char*)p.ptr[30] + WS_BAR), bar_st);
    if (p.ph_hi < 0) cg::this_grid().sync();
#define GRID_SYNC() xcd_barrier(gbar)
#ifdef SYNCPROBE
    for (int i = 0; i < SYNCPROBE; ++i) GRID_SYNC();
#endif
#ifdef REPMASK
    for (int pc = p.ph_lo * 2; pc < p.ph_hi * 2; ++pc) {
        const int ph = pc >> 1;
        { const int s_ = (ph == 0 || ph == N_PHASES - 1) ? 31 : (ph - 1) % 9; if ((pc & 1) && !((REPMASK >> s_) & 1)) continue; }
        if (pc > p.ph_lo * 2) GRID_SYNC();
#else
    for (int ph = p.ph_lo; ph < p.ph_hi; ++ph) {
        if (ph > p.ph_lo) GRID_SYNC();
#endif
        Ctx cx; cx.tid = threadIdx.x; cx.bid = blockIdx.x; cx.nblk = gridDim.x;
        asm volatile("s_mov_b32 %0, 0" : "=s"(cx.z));
        asm volatile("" : "+v"(cx.tid)); asm volatile("" : "+s"(cx.bid)); asm volatile("" : "+s"(cx.nblk));
        const int pair = (ph - 1) / 9, s = (ph == 0) ? 100 : (ph == N_PHASES - 1 ? 101 : (ph - 1) % 9);
        if (s == 0 || s == 3 || s == 6) {
#if PHON(0)
            const bf16_t* WinE = (const bf16_t*)(PWS + WS_WINE) + (size_t)pair * 4352 * 1024;
            const bf16_t* Bt = s == 0 ? WinE + (size_t)2560 * 1024 : (s == 3 ? WinE : (const bf16_t*)(PWS + WS_WINO) + (size_t)pair * 2560 * 1024);
            const int N = s == 0 ? 1792 : 2560;
            run_gemm_proj(p, cx, lds, Bt, N, (bf16_t*)(PWS + WS_R1), N, 2 * pair + (s == 6 ? 1 : 0));
#endif
        } else if (s == 5 || s == 8) {
#if PHON(5)
            const bf16_t* Bt = (const bf16_t*)(PWS + (s == 5 ? WS_WOUTE : WS_WOUTO)) + (size_t)pair * 1024 * 1024;
            run_gemm_res(p, cx, lds, Bt, 2 * pair + (s == 8 ? 1 : 0));
#endif
        } else if (s == 1) {
#if PHON(1)
            phase_even_prep(p, cx, pair);
#endif
        } else if (s == 2) {
#if PHON(2)
            phase_scan(p, cx, pair, lds);
#endif
        } else if (s == 4) {
#if PHON(4)
            phase_even_post(p, cx, pair);
#endif
        } else if (s == 7) {
#if PHON(7)
            phase_odd_mixer(p, cx, pair, lds);
#endif
        } else if (s == 100) {
#if PHON(10)
            phase_prepass(p, cx, lds);
#endif
        } else {
#if PHON(11)
            phase_final(p, cx);
#endif
        }
    }
}

extern "C" void kernel_launch(void* const* d_in, const int* in_sizes, int n_in, void* d_out, int out_size, void* d_ws, size_t ws_size, hipStream_t stream) {
    static int grid = 0;
    if (grid == 0) {
        if (n_in != 29 || ws_size < WS_END) { fprintf(stderr, "kernel_launch: unexpected n_in %d / ws_size %zu (need %zu)\n", n_in, ws_size, (size_t)WS_END); grid = -1; return; }
        int dev = 0, cus = 0, per_cu = 0;
        hipGetDevice(&dev);
        hipDeviceGetAttribute(&cus, hipDeviceAttributeMultiprocessorCount, dev);
        if (hipFuncSetAttribute((const void*)fwd_kernel, hipFuncAttributeMaxDynamicSharedMemorySize, LDS_BYTES) != hipSuccess) { fprintf(stderr, "kernel_launch: hipFuncSetAttribute failed\n"); grid = -1; return; }
        if (hipOccupancyMaxActiveBlocksPerMultiprocessor(&per_cu, (const void*)fwd_kernel, 512, LDS_BYTES) != hipSuccess || per_cu < 1) { fprintf(stderr, "kernel_launch: occupancy query gave %d\n", per_cu); per_cu = 1; }
        (void)hipGetLastError();
        grid = cus * per_cu;
        if (grid > 256) grid = 256;
    }
    if (grid < 0) return;
    Params p{};
    for (int i = 0; i < 29; ++i) p.ptr[i] = d_in[i];
    p.ptr[29] = d_out; p.ptr[30] = d_ws; p.ptr[31] = nullptr;
    (void)hipMemsetAsync((unsigned char*)d_ws + WS_BAR, 0, 16384, stream);
#if ONE_LAUNCH
    p.ph_lo = 0; p.ph_hi = N_PHASES;
    void* args[] = {&p};
    hipError_t e = hipLaunchCooperativeKernel((const void*)fwd_kernel, dim3(grid), dim3(512), args, LDS_BYTES, stream);
    if (e != hipSuccess) fprintf(stderr, "cooperative launch failed: %s (grid %d)\n", hipGetErrorString(e), grid);
#else
    for (int ph = 0; ph < N_PHASES; ++ph) {
        p.ph_lo = ph; p.ph_hi = ph + 1;
        hipLaunchKernelGGL(fwd_kernel, dim3(grid), dim3(512), LDS_BYTES, stream, p);
    }
#endif
}
```

```cpp
#include <hip/hip_runtime.h>
#include <hip/hip_cooperative_groups.h>
#include <cstdio>
namespace cg = cooperative_groups;

#ifndef ONE_LAUNCH
#define ONE_LAUNCH 1
#endif

#define LAS __attribute__((address_space(3)))
typedef unsigned short bf16_t;
typedef short bf16x8 __attribute__((ext_vector_type(8)));
typedef float f32x4 __attribute__((ext_vector_type(4)));
typedef unsigned u32x4 __attribute__((ext_vector_type(4)));
typedef unsigned u32x2 __attribute__((ext_vector_type(2)));

constexpr int NTOK = 17408, NTP = 16384;
constexpr int LDB = 1792;
constexpr int LDA = 2560;
constexpr size_t O_CONVP = 17825792, O_CONVS = 17842176, O_SHIFTP = 18104320, O_SHIFTS = 18130944, O_WKVP = 18556928, O_WKVS = 19081216,
                 O_POOLP = 27469824, O_POOLS = 27592704, O_CHUNKV = 29558784;
constexpr size_t WS_WINE = 0;
constexpr size_t WS_WOUTE = WS_WINE + 2ull * 4352 * 1024 * 2;
constexpr size_t WS_WINO = WS_WOUTE + 2ull * 1024 * 1024 * 2;
constexpr size_t WS_WOUTO = WS_WINO + 2ull * 2560 * 1024 * 2;
constexpr size_t WS_W2T = WS_WOUTO + 2ull * 1024 * 1024 * 2;
constexpr size_t WS_A2T = WS_W2T + 2ull * 512 * 64 * 2;
constexpr size_t WS_POOLWT = WS_A2T + 2ull * 512 * 64 * 2;
constexpr size_t WS_SPW = WS_POOLWT + 8ull * 128 * 128 * 2;
constexpr size_t WS_XB = WS_SPW + 8ull * 128 * 128 * 2;
constexpr size_t WS_YCAT = WS_XB + (size_t)NTOK * 1024 * 2;
constexpr size_t WS_SSQ = WS_YCAT + (size_t)NTOK * 1024 * 2;
constexpr size_t WS_Y = WS_SSQ + 5ull * NTOK * 4;
constexpr size_t WS_R1 = WS_Y + (size_t)NTOK * 512 * 4;
constexpr size_t WS_PROJB = WS_R1;
constexpr size_t WS_WDEC = WS_PROJB + (size_t)NTOK * LDB * 2;
constexpr size_t WS_AA = WS_WDEC + (size_t)NTOK * 512 * 4;
constexpr size_t WS_BAR = WS_AA + (size_t)NTOK * 512 * 2;
constexpr size_t WS_END = WS_BAR + 16384;
constexpr int LDS_BYTES = 131072 + 16;

struct Params {
    const void* ptr[32];
    int ph_lo, ph_hi;
};
struct Ctx { int tid, bid, nblk, z; };
#define PIN(i) ((const float*)p.ptr[(i) + cx.z])
#define POUT ((float*)p.ptr[29 + cx.z])
#define PWS ((unsigned char*)p.ptr[30 + cx.z])
enum { I_XP = 0, I_XS, I_SCONV, I_SSHIFT, I_SWKV, I_SPOOL, I_NORMW, I_FNORMW, I_WINE, I_CONVW, I_MU, I_W0, I_W2, I_A0, I_A2, I_KK, I_KA, I_RK, I_GNG, I_GNB,
       I_WOUTE, I_WINO, I_POOLW, I_PSCALE, I_LNG, I_LNB, I_SPW, I_SPB, I_WOUTO };

__device__ __forceinline__ unsigned cvt_pk_bf16(float lo, float hi) { unsigned r; asm("v_cvt_pk_bf16_f32 %0, %1, %2" : "=v"(r) : "v"(lo), "v"(hi)); return r; }
__device__ __forceinline__ float bf_lo(unsigned u) { return __uint_as_float(u << 16); }
__device__ __forceinline__ float bf_hi(unsigned u) { return __uint_as_float(u & 0xffff0000u); }
__device__ __forceinline__ float bf2f(bf16_t b) { return __uint_as_float(((unsigned)b) << 16); }
__device__ __forceinline__ f32x4 cvt4(u32x2 u) { return (f32x4){bf_lo(u.x), bf_hi(u.x), bf_lo(u.y), bf_hi(u.y)}; }
__device__ __forceinline__ f32x4 ld_bf4(const bf16_t* p) { return cvt4(*(const u32x2*)p); }
__device__ __forceinline__ void st_bf4(bf16_t* p, f32x4 v) { u32x2 u; u.x = cvt_pk_bf16(v[0], v[1]); u.y = cvt_pk_bf16(v[2], v[3]); *(u32x2*)p = u; }
__device__ __forceinline__ float sigmoidf_(float x) { return 1.0f / (1.0f + __expf(-x)); }
__device__ __forceinline__ float siluf_(float x) { return x / (1.0f + __expf(-x)); }
template <int CTRL> __device__ __forceinline__ float dpp_f(float x) { return __builtin_bit_cast(float, __builtin_amdgcn_mov_dpp(__builtin_bit_cast(int, x), CTRL, 0xf, 0xf, true)); }
__device__ __forceinline__ float allsum16(float x) { x += dpp_f<0xB1>(x); x += dpp_f<0x4E>(x); x += dpp_f<0x141>(x); x += dpp_f<0x128>(x); return x; }
__device__ __forceinline__ float allsum4(float x) { x += dpp_f<0xB1>(x); x += dpp_f<0x4E>(x); return x; }
__device__ __forceinline__ float dot4(f32x4 a, f32x4 b) { return a[0] * b[0] + a[1] * b[1] + a[2] * b[2] + a[3] * b[3]; }

namespace pg8 {
constexpr int BM = 256, BK = 64, HALF = 128, HTB = HALF * BK * 2, NXCD = 8, WGM = 8;
__device__ __forceinline__ int lds_byte(int r, int c) { const int st = (r >> 4) * 2 + (c >> 5), rr = r & 15, cc = c & 31, ob = rr * 64 + cc * 2; return st * 1024 + (ob ^ (((ob >> 9) & 1) << 5)); }
__device__ __forceinline__ void stage_rc(int b, int& R, int& C) { const int st = b / 1024, sb = b % 1024, swz = sb ^ (((sb >> 9) & 1) << 5); R = (st >> 1) * 16 + swz / 64; C = (st & 1) * 32 + (swz % 64) / 2; }
__device__ __forceinline__ int perm32(int rho) { const int n = rho >> 4, i = rho & 15; return 8 * (i >> 2) + 4 * n + (i & 3); }
struct Unit { int pm, pn; };
struct Gemm { const bf16_t* A; const bf16_t* Bt; int M, N, K; };
struct StaticOrder {
    int nM, nN, nwg, G, c;
    __device__ void init(int M, int N, int G_, int c_) { nM = M / BM; nN = N / BM; nwg = nM * nN; G = G_; c = c_; }
    __device__ bool next(int i, Unit& u) const {
        const long L = (long)i * G + c; if (L >= nwg) return false;
        int wgid = (int)L; { const int q = nwg / NXCD, r = nwg % NXCD, xcd = wgid % NXCD, off = wgid / NXCD; wgid = (xcd < r ? xcd * (q + 1) : r * (q + 1) + (xcd - r) * q) + off; }
        const int nig = WGM * nN, gid = wgid / nig, fm = gid * WGM, gsz = (nM - fm) < WGM ? (nM - fm) : WGM;
        u.pm = fm + ((wgid % nig) % gsz); u.pn = (wgid % nig) / gsz; return true;
    }
};

template <class Epi>
__device__ __forceinline__ void gemm_phase(const Ctx cx, LAS unsigned char* lds, const Gemm g, const StaticOrder& S, const Epi& E) {
    const int tid = cx.tid, wid = __builtin_amdgcn_readfirstlane(tid >> 6), lane = tid & 63, wr = wid >> 2, wc = wid & 3, fr = lane & 15, fq = lane >> 4;
    const int K = g.K, nt = K / BK;
    unsigned voffA[2], voffB[2];
#pragma unroll
    for (int i = 0; i < 2; ++i) { int R, C; stage_rc(tid * 16 + i * 8192, R, C); const int Rb = Epi::PERM ? ((R & ~31) + perm32(R & 31)) : R;
        voffA[i] = (unsigned)(R * K + C) * 2u; voffB[i] = (unsigned)(Rb * K + C) * 2u; }
    const size_t kstep = (size_t)(BK * 2);
    const size_t hstep = (size_t)HALF * K * 2;
    const size_t tstep = 2 * hstep;
    const unsigned ldsw = (unsigned)wid * 1024u;
    const int aoff = lds_byte(wr * 64 + fr, fq * 8), boff = lds_byte(wc * 32 + fr, fq * 8);
#define PG8_SA(b, h) (((b) * 2 + (h)) * HTB)
#define PG8_SB(b, h) ((4 + (b) * 2 + (h)) * HTB)
#define PG8_STAGE(bufoff, gbase, voff) do { _Pragma("unroll") for (int _i = 0; _i < 2; ++_i) \
        __builtin_amdgcn_global_load_lds((const unsigned*)((const char*)(gbase) + (voff)[_i]), (LAS unsigned*)(lds + (bufoff) + ldsw + _i * 8192), 16, 0, 0); } while (0)
#define PG8_LDA(dst, b, h) do { _Pragma("unroll") for (int m = 0; m < 4; ++m) _Pragma("unroll") for (int k = 0; k < 2; ++k) dst[m][k] = *(const LAS bf16x8*)(lds + PG8_SA(b, h) + aoff + m * 2048 + k * 1024); } while (0)
#define PG8_LDB(dst, b, h) do { _Pragma("unroll") for (int n = 0; n < 2; ++n) _Pragma("unroll") for (int k = 0; k < 2; ++k) dst[n][k] = *(const LAS bf16x8*)(lds + PG8_SB(b, h) + boff + n * 2048 + k * 1024); } while (0)
#define PG8_MMA(ai, bj, At, Bt) do { __builtin_amdgcn_s_setprio(1); _Pragma("unroll") for (int m = 0; m < 4; ++m) _Pragma("unroll") for (int n = 0; n < 2; ++n) _Pragma("unroll") for (int k = 0; k < 2; ++k) \
        acc[ai][bj][m][n] = __builtin_amdgcn_mfma_f32_16x16x32_bf16(Bt[n][k], At[m][k], acc[ai][bj][m][n], 0, 0, 0); __builtin_amdgcn_s_setprio(0); } while (0)
#define PG8_WAIT_V(n) asm volatile("s_waitcnt vmcnt(" #n ")" ::: "memory")
#define PG8_WAIT_L(n) asm volatile("s_waitcnt lgkmcnt(" #n ")" ::: "memory")
#define PG8_BAR __builtin_amdgcn_s_barrier()
#define PG8_SCHED __builtin_amdgcn_sched_barrier(0)
    Unit cur, nxt; int ui = 0;
    if (!S.next(0, cur)) return;
    f32x4 acc[2][2][4][2];
#pragma unroll
    for (int a = 0; a < 2; ++a)
#pragma unroll
        for (int b = 0; b < 2; ++b)
#pragma unroll
            for (int m = 0; m < 4; ++m)
#pragma unroll
                for (int n = 0; n < 2; ++n) acc[a][b][m][n] = (f32x4){0.f, 0.f, 0.f, 0.f};
    bf16x8 At[4][2], B0[2][2], B1[2][2];
    const char* cA = (const char*)g.A + (size_t)cur.pm * tstep; const char* cB = (const char*)g.Bt + (size_t)cur.pn * tstep;
    PG8_STAGE(PG8_SB(0, 0), cB, voffB); PG8_STAGE(PG8_SA(0, 0), cA, voffA); PG8_STAGE(PG8_SB(0, 1), cB + hstep, voffB); PG8_STAGE(PG8_SA(0, 1), cA + hstep, voffA);
    if (wr == 1) PG8_BAR;
    PG8_WAIT_V(4); PG8_BAR;
    PG8_STAGE(PG8_SB(1, 0), cB + kstep, voffB); PG8_STAGE(PG8_SA(1, 0), cA + kstep, voffA); PG8_STAGE(PG8_SB(1, 1), cB + hstep + kstep, voffB);
    PG8_WAIT_V(6); PG8_BAR;
    for (;;) {
        const bool has_next = S.next(ui + 1, nxt);
        const char* nA = has_next ? (const char*)g.A + (size_t)nxt.pm * tstep : cA; const char* nB = has_next ? (const char*)g.Bt + (size_t)nxt.pn * tstep : cB;
        for (int t = 0; t < nt; t += 2) {
            const bool last = (t == nt - 2);
            const char* a1 = cA + (size_t)(t + 1) * kstep;
            const char* a2 = last ? nA : cA + (size_t)(t + 2) * kstep; const char* b2 = last ? nB : cB + (size_t)(t + 2) * kstep;
            const char* a3 = a2 + kstep; const char* b3 = b2 + kstep;
            PG8_LDB(B0, 0, 0); PG8_SCHED; PG8_LDA(At, 0, 0); PG8_STAGE(PG8_SA(1, 1), a1 + hstep, voffA);
            PG8_WAIT_L(8); PG8_BAR; PG8_WAIT_L(0); PG8_MMA(0, 0, At, B0); PG8_BAR; PG8_SCHED;
            PG8_LDB(B1, 0, 1); PG8_STAGE(PG8_SB(0, 0), b2, voffB);
            PG8_BAR; PG8_WAIT_L(0); PG8_MMA(0, 1, At, B1); PG8_BAR;
            PG8_LDA(At, 0, 1); PG8_STAGE(PG8_SA(0, 0), a2, voffA);
            PG8_BAR; PG8_WAIT_L(0); PG8_MMA(1, 0, At, B0); PG8_BAR; PG8_SCHED;
            PG8_STAGE(PG8_SB(0, 1), b2 + hstep, voffB);
            PG8_WAIT_V(6); PG8_BAR; PG8_MMA(1, 1, At, B1); PG8_BAR;
            PG8_LDB(B0, 1, 0); PG8_SCHED; PG8_LDA(At, 1, 0); PG8_STAGE(PG8_SA(0, 1), a2 + hstep, voffA);
            PG8_WAIT_L(8); PG8_BAR; PG8_WAIT_L(0); PG8_MMA(0, 0, At, B0); PG8_BAR; PG8_SCHED;
            PG8_LDB(B1, 1, 1); PG8_STAGE(PG8_SB(1, 0), b3, voffB);
            PG8_BAR; PG8_WAIT_L(0); PG8_MMA(0, 1, At, B1); PG8_BAR;
            PG8_LDA(At, 1, 1); PG8_STAGE(PG8_SA(1, 0), a3, voffA);
            PG8_BAR; PG8_WAIT_L(0); PG8_MMA(1, 0, At, B0); PG8_BAR; PG8_SCHED;
            PG8_STAGE(PG8_SB(1, 1), b3 + hstep, voffB);
            PG8_WAIT_V(6); PG8_BAR; PG8_MMA(1, 1, At, B1); PG8_BAR;
        }
        E(acc, cur, wr, wc, fr, fq);
        if (!has_next) break;
#pragma unroll
        for (int a = 0; a < 2; ++a)
#pragma unroll
            for (int b = 0; b < 2; ++b)
#pragma unroll
                for (int m = 0; m < 4; ++m)
#pragma unroll
                    for (int n = 0; n < 2; ++n) acc[a][b][m][n] = (f32x4){0.f, 0.f, 0.f, 0.f};
        cur = nxt; cA = nA; cB = nB; ++ui;
    }
    PG8_WAIT_V(0);
    if (wr == 0) PG8_BAR;
    PG8_BAR;
#undef PG8_SA
#undef PG8_SB
#undef PG8_STAGE
#undef PG8_LDA
#undef PG8_LDB
#undef PG8_MMA
#undef PG8_WAIT_V
#undef PG8_WAIT_L
#undef PG8_BAR
#undef PG8_SCHED
}
}

struct EpiProj {
    static constexpr bool PERM = true;
    bf16_t* O; int ldc; const float* ssq;
    __device__ __forceinline__ void operator()(const f32x4 (&acc)[2][2][4][2], const pg8::Unit& u, int wr, int wc, int fr, int fq) const {
        const int row0 = u.pm * 256 + wr * 64 + fr, col0 = u.pn * 256 + wc * 32 + 8 * fq;
#pragma unroll
        for (int ai = 0; ai < 2; ++ai)
#pragma unroll
            for (int m = 0; m < 4; ++m) {
                const int row = row0 + ai * 128 + m * 16;
                const float rstd = rsqrtf(ssq[row] * (1.0f / 1024.0f) + 1e-6f);
                bf16_t* rowp = O + (size_t)row * ldc + col0;
#pragma unroll
                for (int bj = 0; bj < 2; ++bj) {
                    const f32x4 v0 = acc[ai][bj][m][0] * rstd, v1 = acc[ai][bj][m][1] * rstd;
                    u32x4 w; w.x = cvt_pk_bf16(v0[0], v0[1]); w.y = cvt_pk_bf16(v0[2], v0[3]); w.z = cvt_pk_bf16(v1[0], v1[1]); w.w = cvt_pk_bf16(v1[2], v1[3]);
                    *(u32x4*)(rowp + bj * 128) = w;
                }
            }
    }
};
struct EpiRes {
    static constexpr bool PERM = false;
    const float* xp; const float* xs; float* Xf; bf16_t* Xb; float* ssq_next;
    __device__ __forceinline__ void operator()(const f32x4 (&acc)[2][2][4][2], const pg8::Unit& u, int wr, int wc, int fr, int fq) const {
        const int row0 = u.pm * 256 + wr * 64 + fr, col0 = u.pn * 256 + wc * 32 + 4 * fq;
#pragma unroll
        for (int ai = 0; ai < 2; ++ai)
#pragma unroll
            for (int m = 0; m < 4; ++m) {
                const int row = row0 + ai * 128 + m * 16;
                const float* src = xp ? (row < NTP ? xp + (size_t)row * 1024 : xs + (size_t)(row - NTP) * 1024) : Xf + (size_t)row * 1024;
                float part = 0.f;
#pragma unroll
                for (int bj = 0; bj < 2; ++bj)
#pragma unroll
                    for (int n = 0; n < 2; ++n) {
                        const int col = col0 + bj * 128 + n * 16;
                        const f32x4 x = *(const f32x4*)(src + col) + acc[ai][bj][m][n];
                        *(f32x4*)(Xf + (size_t)row * 1024 + col) = x;
                        st_bf4(Xb + (size_t)row * 1024 + col, x);
                        part += dot4(x, x);
                    }
                part += __shfl_xor(part, 16); part += __shfl_xor(part, 32);
                if (fq == 0) atomicAdd(ssq_next + row, part);
            }
    }
};

__device__ __forceinline__ void tr_tile(const Ctx cx, LAS float* T, const float* src, int ld, int col0, int k0, bf16_t* dst, int Ktot, int drow0, const float* scale, bool zero) {
    const int tid = cx.tid;
    if (zero) {
        const int n = tid >> 3, kc = (tid & 7) * 8;
        *(u32x4*)(dst + (size_t)(drow0 + n) * Ktot + k0 + kc) = (u32x4){0u, 0u, 0u, 0u};
        return;
    }
#pragma unroll
    for (int pass = 0; pass < 2; ++pass) {
        const int kk = (tid >> 4) + pass * 32, nn = (tid & 15) * 4;
        f32x4 v = *(const f32x4*)(src + (size_t)(k0 + kk) * ld + col0 + nn);
        if (scale) v = v * scale[k0 + kk];
        T[kk * 65 + nn] = v[0]; T[kk * 65 + nn + 1] = v[1]; T[kk * 65 + nn + 2] = v[2]; T[kk * 65 + nn + 3] = v[3];
    }
    __syncthreads();
    {
        const int n = tid >> 3, kc = (tid & 7) * 8;
        u32x4 w;
        w.x = cvt_pk_bf16(T[(kc + 0) * 65 + n], T[(kc + 1) * 65 + n]); w.y = cvt_pk_bf16(T[(kc + 2) * 65 + n], T[(kc + 3) * 65 + n]);
        w.z = cvt_pk_bf16(T[(kc + 4) * 65 + n], T[(kc + 5) * 65 + n]); w.w = cvt_pk_bf16(T[(kc + 6) * 65 + n], T[(kc + 7) * 65 + n]);
        *(u32x4*)(dst + (size_t)(drow0 + n) * Ktot + k0 + kc) = w;
    }
    __syncthreads();
}

__device__ void phase_prepass(const Params& p, const Ctx cx, LAS unsigned char* lds) {
    LAS float* T = (LAS float*)lds;
    const int tid = cx.tid;
    for (int job = cx.bid; job < 4544; job += cx.nblk) {
        int j = job;
        if (j < 2176) {
            const int i = j / 1088, r = j % 1088, nt = r / 16, kt = r % 16;
            const int n0 = nt * 64;
            int col0; bool zero = false;
            if (n0 < 2048) col0 = n0; else if (n0 < 2560) col0 = 3712 + (n0 - 2048); else if (n0 < 4224) col0 = 2048 + (n0 - 2560); else { col0 = 0; zero = true; }
            tr_tile(cx, T, PIN(I_WINE) + (size_t)i * 1024 * 4224, 4224, col0, kt * 64, (bf16_t*)(PWS + WS_WINE) + (size_t)i * 4352 * 1024, 1024, n0, PIN(I_NORMW) + (2 * i) * 1024, zero);
            continue;
        }
        j -= 2176;
        if (j < 512) { const int i = j / 256, r = j % 256, nt = r / 16, kt = r % 16;
            tr_tile(cx, T, PIN(I_WOUTE) + (size_t)i * 1024 * 1024, 1024, nt * 64, kt * 64, (bf16_t*)(PWS + WS_WOUTE) + (size_t)i * 1024 * 1024, 1024, nt * 64, nullptr, false); continue; }
        j -= 512;
        if (j < 1280) { const int i = j / 640, r = j % 640, nt = r / 16, kt = r % 16;
            tr_tile(cx, T, PIN(I_WINO) + (size_t)i * 1024 * 2560, 2560, nt * 64, kt * 64, (bf16_t*)(PWS + WS_WINO) + (size_t)i * 2560 * 1024, 1024, nt * 64, PIN(I_NORMW) + (2 * i + 1) * 1024, false); continue; }
        j -= 1280;
        if (j < 512) { const int i = j / 256, r = j % 256, nt = r / 16, kt = r % 16;
            tr_tile(cx, T, PIN(I_WOUTO) + (size_t)i * 1024 * 1024, 1024, nt * 64, kt * 64, (bf16_t*)(PWS + WS_WOUTO) + (size_t)i * 1024 * 1024, 1024, nt * 64, nullptr, false); continue; }
        j -= 512;
        if (j < 16) { const int i = j / 8, nt = j % 8;
            tr_tile(cx, T, PIN(I_W2) + (size_t)i * 64 * 512, 512, nt * 64, 0, (bf16_t*)(PWS + WS_W2T) + (size_t)i * 512 * 64, 64, nt * 64, nullptr, false); continue; }
        j -= 16;
        if (j < 16) { const int i = j / 8, nt = j % 8;
            tr_tile(cx, T, PIN(I_A2) + (size_t)i * 64 * 512, 512, nt * 64, 0, (bf16_t*)(PWS + WS_A2T) + (size_t)i * 512 * 64, 64, nt * 64, nullptr, false); continue; }
        j -= 16;
        { const int ig = j / 4, r = j % 4, nt = r / 2, kt = r % 2;
            tr_tile(cx, T, PIN(I_POOLW) + (size_t)ig * 128 * 128, 128, nt * 64, kt * 64, (bf16_t*)(PWS + WS_POOLWT) + (size_t)ig * 128 * 128, 128, nt * 64, nullptr, false); }
    }
    const int gtid = cx.bid * 512 + tid, gthreads = cx.nblk * 512;
    for (int e = gtid; e < 8 * 128 * 128; e += gthreads) {
        const int s = e & 127, t = (e >> 7) & 127;
        ((bf16_t*)(PWS + WS_SPW))[e] = (s <= t) ? (bf16_t)(cvt_pk_bf16(PIN(I_SPW)[e], 0.f) & 0xffffu) : (bf16_t)0;
    }
    for (int e = gtid; e < 4 * NTOK; e += gthreads) ((float*)(PWS + WS_SSQ))[NTOK + e] = 0.f;
    const int wid = tid >> 6, lane = tid & 63;
    for (int row = cx.bid * 8 + wid; row < NTOK; row += cx.nblk * 8) {
        const float* src = row < NTP ? PIN(I_XP) + (size_t)row * 1024 : PIN(I_XS) + (size_t)(row - NTP) * 1024;
        bf16_t* dst = (bf16_t*)(PWS + WS_XB) + (size_t)row * 1024;
        float ss = 0.f;
#pragma unroll
        for (int i = 0; i < 4; ++i) { const f32x4 v = *(const f32x4*)(src + i * 256 + lane * 4); ss += dot4(v, v); st_bf4(dst + i * 256 + lane * 4, v); }
#pragma unroll
        for (int o = 32; o >= 1; o >>= 1) ss += __shfl_xor(ss, o);
        if (lane == 0) ((float*)(PWS + WS_SSQ))[row] = ss;
    }
}

__device__ __forceinline__ f32x4 shift4(const bf16_t* cur, bool hp, const float* st, int col, const float* mu) {
    const f32x4 q = ld_bf4(cur + col);
    f32x4 pv;
    if (hp) pv = ld_bf4(cur - LDB + col); else if (st) pv = *(const f32x4*)(st + col); else pv = (f32x4){0.f, 0.f, 0.f, 0.f};
    const f32x4 m = *(const f32x4*)(mu + col);
    return q + m * (pv - q);
}

__device__ void phase_even_prep(const Params& p, const Ctx cx, int pair) {
    const int tid = cx.tid, wid = tid >> 6, lane = tid & 63, fr = lane & 15, fq = lane >> 4;
    const bf16_t* PB = (const bf16_t*)(PWS + WS_PROJB);
    float* Wdec = (float*)(PWS + WS_WDEC);
    bf16_t* Aa = (bf16_t*)(PWS + WS_AA);
    bf16_t* Ycat = (bf16_t*)(PWS + WS_YCAT);
    const float* mu = PIN(I_MU) + pair * 1664;
    const bf16_t* W2T = (const bf16_t*)(PWS + WS_W2T) + (size_t)pair * 512 * 64;
    const bf16_t* A2T = (const bf16_t*)(PWS + WS_A2T) + (size_t)pair * 512 * 64;
    const float* w0 = PIN(I_W0) + pair * 512; const float* a0 = PIN(I_A0) + pair * 512;
    const float* k_a = PIN(I_KA) + pair * 512; const float* r_k = PIN(I_RK) + pair * 512;
    for (int unit = cx.bid * 8 + wid; unit < (NTOK / 16) * 8; unit += cx.nblk * 8) {
        const int row = (unit >> 3) * 16 + fr, h = unit & 7;
        const bool samp = row >= NTP;
        int b, t; if (!samp) { b = row >> 11; t = row & 2047; } else { const int q = row - NTP; b = q >> 3; t = q & 7; }
        const bf16_t* cur = PB + (size_t)row * LDB;
        const bool hp = t > 0;
        const float* st = samp ? PIN(I_SSHIFT) + ((size_t)pair * 128 + b) * 1664 : nullptr;
        bf16x8 Aw[2], Al[2];
#pragma unroll
        for (int ks = 0; ks < 2; ++ks) {
            const int cw = 1536 + ks * 32 + fq * 8, ca = 1600 + ks * 32 + fq * 8;
            const f32x4 w_lo = shift4(cur, hp, st, cw, mu), w_hi = shift4(cur, hp, st, cw + 4, mu);
            const f32x4 a_lo = shift4(cur, hp, st, ca, mu), a_hi = shift4(cur, hp, st, ca + 4, mu);
            u32x4 pw, pa;
            float th[8];
#pragma unroll
            for (int j = 0; j < 4; ++j) { th[j] = 2.0f * sigmoidf_(2.0f * w_lo[j]) - 1.0f; th[4 + j] = 2.0f * sigmoidf_(2.0f * w_hi[j]) - 1.0f; }
            pw.x = cvt_pk_bf16(th[0], th[1]); pw.y = cvt_pk_bf16(th[2], th[3]); pw.z = cvt_pk_bf16(th[4], th[5]); pw.w = cvt_pk_bf16(th[6], th[7]);
            pa.x = cvt_pk_bf16(a_lo[0], a_lo[1]); pa.y = cvt_pk_bf16(a_lo[2], a_lo[3]); pa.z = cvt_pk_bf16(a_hi[0], a_hi[1]); pa.w = cvt_pk_bf16(a_hi[2], a_hi[3]);
            Aw[ks] = __builtin_bit_cast(bf16x8, pw); Al[ks] = __builtin_bit_cast(bf16x8, pa);
        }
        float bon = 0.f;
#pragma unroll 2
        for (int nt = 0; nt < 4; ++nt) {
            const int n0 = h * 64 + nt * 16;
            f32x4 lw = (f32x4){0.f, 0.f, 0.f, 0.f}, la = (f32x4){0.f, 0.f, 0.f, 0.f};
#pragma unroll
            for (int ks = 0; ks < 2; ++ks) {
                const bf16x8 wf = *(const bf16x8*)(W2T + (size_t)(n0 + fr) * 64 + ks * 32 + fq * 8);
                const bf16x8 af = *(const bf16x8*)(A2T + (size_t)(n0 + fr) * 64 + ks * 32 + fq * 8);
                lw = __builtin_amdgcn_mfma_f32_16x16x32_bf16(wf, Aw[ks], lw, 0, 0, 0);
                la = __builtin_amdgcn_mfma_f32_16x16x32_bf16(af, Al[ks], la, 0, 0, 0);
            }
            const int ch = n0 + fq * 4;
            const f32x4 r4 = shift4(cur, hp, st, ch, mu), k4 = shift4(cur, hp, st, 512 + ch, mu);
            const f32x4 w04 = *(const f32x4*)(w0 + ch), a04 = *(const f32x4*)(a0 + ch), ka4 = *(const f32x4*)(k_a + ch), rk4 = *(const f32x4*)(r_k + ch);
            f32x4 dec, av;
#pragma unroll
            for (int j = 0; j < 4; ++j) {
                const float z_ = -(w04[j] + lw[j]);
                const float wlog = -__logf(1.0f + __expf(z_)) - 0.5f;
                dec[j] = __expf(-__expf(wlog));
                av[j] = sigmoidf_(a04[j] + la[j]);
                const float kp = k4[j] * (1.0f + (av[j] - 1.0f) * ka4[j]);
                bon += r4[j] * kp * rk4[j];
            }
            *(f32x4*)(Wdec + (size_t)row * 512 + ch) = dec;
            st_bf4(Aa + (size_t)row * 512 + ch, av);
        }
        bon += __shfl_xor(bon, 16); bon += __shfl_xor(bon, 32);
#pragma unroll
        for (int nt = 0; nt < 4; ++nt) { const int ch = h * 64 + nt * 16 + fq * 4; st_bf4(Ycat + (size_t)row * 1024 + 512 + ch, shift4(cur, hp, st, 1024 + ch, mu) * bon); }
    }
    const int gtid = cx.bid * 512 + tid, gthreads = cx.nblk * 512;
    for (int e = gtid; e < 136 * 1664; e += gthreads) {
        const int sr = e / 1664, c = e % 1664;
        if (sr < 8) POUT[O_SHIFTP + ((size_t)pair * 8 + sr) * 1664 + c] = bf2f(PB[(size_t)(sr * 2048 + 2047) * LDB + c]);
        else { const int b = sr - 8; POUT[O_SHIFTS + ((size_t)pair * 128 + b) * 1664 + c] = bf2f(PB[(size_t)(NTP + b * 8 + 7) * LDB + c]); }
    }
}

__device__ __forceinline__ void scan_step(f32x4& S, const f32x4 w, const f32x4 k, const f32x4 kk, const f32x4 bb, const f32x4 r, const float v, float& y) {
    float pd = dot4(S, kk);
    const f32x4 tmp = S * w + k * v;
    pd = allsum16(pd);
    S = tmp - bb * pd;
    y = allsum16(dot4(S, r));
}

__device__ void phase_scan(const Params& p, const Ctx cx, int pair, LAS unsigned char* lds) {
    const int tid = cx.tid, wid = tid >> 6, lane = tid & 63, rs = lane >> 4, cgi = lane & 15;
    const bf16_t* PB = (const bf16_t*)(PWS + WS_PROJB);
    const float* Wdec = (const float*)(PWS + WS_WDEC);
    const bf16_t* Aa = (const bf16_t*)(PWS + WS_AA);
    float* Y = (float*)(PWS + WS_Y);
    const float* mu = PIN(I_MU) + pair * 1664;
    const float* k_k = PIN(I_KK) + pair * 512; const float* k_a = PIN(I_KA) + pair * 512;
    {
        LAS float* vb = (LAS float*)lds + wid * 3072;
        for (int st = cx.bid * 8 + wid; st < 2048; st += cx.nblk * 8) {
            const int bh = st >> 1, half = st & 1, b = bh >> 3, h = bh & 7, ch = h * 64 + cgi * 4;
            const float* stp = PIN(I_SSHIFT) + ((size_t)pair * 128 + b) * 1664;
            const f32x4 kkc = *(const f32x4*)(k_k + ch), kac = *(const f32x4*)(k_a + ch);
            {
#pragma unroll
                for (int tt = 0; tt < 2; ++tt) {
                    const int t = rs + tt * 4;
                    const size_t row = NTP + b * 8 + t;
                    const bf16_t* cur = PB + row * LDB;
                    const f32x4 r = shift4(cur, t > 0, stp, ch, mu), k = shift4(cur, t > 0, stp, 512 + ch, mu), v = shift4(cur, t > 0, stp, 1024 + ch, mu);
                    const f32x4 a = ld_bf4(Aa + row * 512 + ch);
                    const f32x4 w = *(const f32x4*)(Wdec + row * 512 + ch);
                    const f32x4 kkv = k * kkc;
                    const float ss = allsum16(dot4(kkv, kkv));
                    const float inv = 1.0f / fmaxf(sqrtf(ss), 1e-12f);
                    const f32x4 kkn = kkv * inv;
                    LAS float* o = vb + t * 384 + cgi * 4;
                    *(LAS f32x4*)(o) = w; *(LAS f32x4*)(o + 64) = k * (1.0f + (a - 1.0f) * kac); *(LAS f32x4*)(o + 128) = kkn; *(LAS f32x4*)(o + 192) = kkn * a;
                    *(LAS f32x4*)(o + 256) = r; *(LAS f32x4*)(o + 320) = v;
                }
            }
            asm volatile("s_waitcnt lgkmcnt(0)" ::: "memory");
            __builtin_amdgcn_wave_barrier();
#pragma unroll 1
            for (int rq = 0; rq < 8; ++rq) {
                const int ri = half * 32 + rq * 4 + rs;
                const size_t so = ((((size_t)pair * 128 + b) * 8 + h) * 64 + ri) * 64 + cgi * 4;
                f32x4 S = *(const f32x4*)(PIN(I_SWKV) + so);
#pragma unroll
                for (int t = 0; t < 8; ++t) {
                    LAS const float* r0 = vb + t * 384 + cgi * 4;
                    float y; scan_step(S, *(LAS const f32x4*)(r0), *(LAS const f32x4*)(r0 + 64), *(LAS const f32x4*)(r0 + 128), *(LAS const f32x4*)(r0 + 192), *(LAS const f32x4*)(r0 + 256), vb[t * 384 + 320 + ri], y);
                    if (cgi == 0) Y[(size_t)(NTP + b * 8 + t) * 512 + h * 64 + ri] = y;
                }
                *(f32x4*)(POUT + O_WKVS + so) = S;
            }
            asm volatile("s_waitcnt lgkmcnt(0)" ::: "memory");
            __builtin_amdgcn_wave_barrier();
        }
    }
    __syncthreads();
    LAS float* rec = (LAS float*)lds;
    for (int pt = cx.bid; pt < 256; pt += cx.nblk) {
        const int xcd = pt & 7, slot = pt >> 3, bh = xcd * 8 + (slot >> 2), rg = slot & 3, b = bh >> 3, h = bh & 7;
        const int lt = tid - 256, ls = (lt >> 4) & 15, lcg = lt & 15, lch = h * 64 + lcg * 4;
        u32x2 qr = {0u, 0u}, qk = {0u, 0u}, qv = {0u, 0u}, pr = {0u, 0u}, pk = {0u, 0u}, pv = {0u, 0u}, qa = {0u, 0u};
        f32x4 qw = (f32x4){0.f, 0.f, 0.f, 0.f};
        f32x4 mur, muk, muv, kkc, kac;
        const int ri = rg * 16 + (wid & 3) * 4 + rs;
        f32x4 S = (f32x4){0.f, 0.f, 0.f, 0.f};
#define SCAN_ISSUE(c) do { const int t_ = (c) * 16 + ls; const size_t row_ = (size_t)b * 2048 + t_; const bf16_t* cur_ = PB + row_ * LDB; \
            qr = *(const u32x2*)(cur_ + lch); qk = *(const u32x2*)(cur_ + 512 + lch); qv = *(const u32x2*)(cur_ + 1024 + lch); \
            if (t_ > 0) { pr = *(const u32x2*)(cur_ - LDB + lch); pk = *(const u32x2*)(cur_ - LDB + 512 + lch); pv = *(const u32x2*)(cur_ - LDB + 1024 + lch); } \
            else { pr = (u32x2){0u, 0u}; pk = pr; pv = pr; } \
            qw = *(const f32x4*)(Wdec + row_ * 512 + lch); qa = *(const u32x2*)(Aa + row_ * 512 + lch); } while (0)
#define SCAN_PROCESS(buf) do { const f32x4 r0_ = cvt4(qr), k0_ = cvt4(qk), v0_ = cvt4(qv); \
            const f32x4 r_ = r0_ + mur * (cvt4(pr) - r0_), k_ = k0_ + muk * (cvt4(pk) - k0_), v_ = v0_ + muv * (cvt4(pv) - v0_), a_ = cvt4(qa); \
            const f32x4 kkv_ = k_ * kkc; const float ss_ = allsum16(dot4(kkv_, kkv_)); const float inv_ = 1.0f / fmaxf(sqrtf(ss_), 1e-12f); \
            const f32x4 kkn_ = kkv_ * inv_; \
            LAS float* o_ = rec + (buf) * 6144 + ls * 384 + lcg * 4; \
            *(LAS f32x4*)(o_) = qw; *(LAS f32x4*)(o_ + 64) = k_ * (1.0f + (a_ - 1.0f) * kac); *(LAS f32x4*)(o_ + 128) = kkn_; *(LAS f32x4*)(o_ + 192) = kkn_ * a_; \
            *(LAS f32x4*)(o_ + 256) = r_; *(LAS f32x4*)(o_ + 320) = v_; } while (0)
        if (wid >= 4) {
            mur = *(const f32x4*)(mu + lch); muk = *(const f32x4*)(mu + 512 + lch); muv = *(const f32x4*)(mu + 1024 + lch);
            kkc = *(const f32x4*)(k_k + lch); kac = *(const f32x4*)(k_a + lch);
            SCAN_ISSUE(0); SCAN_PROCESS(0); SCAN_ISSUE(1);
        }
        __syncthreads();
        for (int c = 0; c < 128; ++c) {
            if (wid < 4) {
                LAS const float* rb = rec + (c & 1) * 6144 + cgi * 4;
                LAS const float* rv = rec + (c & 1) * 6144 + 320 + ri;
                float ykeep = 0.f;
                f32x4 nw = *(LAS const f32x4*)(rb), nk = *(LAS const f32x4*)(rb + 64), nkk = *(LAS const f32x4*)(rb + 128), nb = *(LAS const f32x4*)(rb + 192), nr = *(LAS const f32x4*)(rb + 256);
                float nv = rv[0];
#pragma unroll
                for (int s = 0; s < 16; ++s) {
                    const f32x4 cw = nw, ck = nk, ckk = nkk, cb = nb, cr = nr; const float cv = nv;
                    if (s + 1 < 16) {
                        LAS const float* r1 = rb + (s + 1) * 384;
                        nw = *(LAS const f32x4*)(r1); nk = *(LAS const f32x4*)(r1 + 64); nkk = *(LAS const f32x4*)(r1 + 128); nb = *(LAS const f32x4*)(r1 + 192); nr = *(LAS const f32x4*)(r1 + 256);
                        nv = rv[(s + 1) * 384];
                    }
                    float y;
                    scan_step(S, cw, ck, ckk, cb, cr, cv, y);
                    ykeep = (cgi == s) ? y : ykeep;
                }
                Y[((size_t)b * 2048 + c * 16 + cgi) * 512 + h * 64 + ri] = ykeep;
            } else {
                if (c + 1 < 128) { SCAN_PROCESS((c + 1) & 1); if (c + 2 < 128) SCAN_ISSUE(c + 2); }
            }
            __syncthreads();
        }
        if (wid < 4) *(f32x4*)(POUT + O_WKVP + ((((size_t)pair * 8 + b) * 8 + h) * 64 + ri) * 64 + cgi * 4) = S;
#undef SCAN_ISSUE
#undef SCAN_PROCESS
    }
}

__device__ void phase_even_post(const Params& p, const Ctx cx, int pair) {
    const int gtid = cx.bid * 512 + cx.tid, gthreads = cx.nblk * 512;
    const bf16_t* PA = (const bf16_t*)(PWS + WS_R1);
    bf16_t* Ycat = (bf16_t*)(PWS + WS_YCAT);
    const float* Y = (const float*)(PWS + WS_Y);
    const float* gn_g = PIN(I_GNG) + pair * 512; const float* gn_b = PIN(I_GNB) + pair * 512;
    for (int e = gtid; e < NTOK * 128; e += gthreads) {
        const int row = e >> 7, ch = (e & 127) * 4;
        const f32x4 y = *(const f32x4*)(Y + (size_t)row * 512 + ch);
        const float mean = allsum16(y[0] + y[1] + y[2] + y[3]) * (1.0f / 64.0f);
        const f32x4 d = y - mean;
        const float var = allsum16(dot4(d, d)) * (1.0f / 64.0f);
        const float rstd = rsqrtf(var + 64e-5f);
        const f32x4 g = *(const f32x4*)(gn_g + ch), bb = *(const f32x4*)(gn_b + ch);
        bf16_t* yo = Ycat + (size_t)row * 1024 + 512 + ch;
        const f32x4 bv = ld_bf4(yo);
        const f32x4 bz = ld_bf4(PA + (size_t)row * LDA + 2048 + ch);
        f32x4 o;
#pragma unroll
        for (int j = 0; j < 4; ++j) o[j] = (d[j] * rstd * g[j] + bb[j] + bv[j]) * siluf_(bz[j]);
        st_bf4(yo, o);
    }
    const float* cw = PIN(I_CONVW) + pair * 3 * 512;
    for (int e = gtid; e < NTOK * 128; e += gthreads) {
        const int row = e >> 7, ch = (e & 127) * 4;
        const bool samp = row >= NTP;
        int b, t, T; if (!samp) { b = row >> 11; t = row & 2047; T = 2048; } else { const int q = row - NTP; b = q >> 3; t = q & 7; T = 8; }
        const bf16_t* cur = PA + (size_t)row * LDA;
        const f32x4 u0 = ld_bf4(cur + 1024 + ch) * ld_bf4(cur + ch);
        f32x4 u1, u2;
        const float* hist = PIN(I_SCONV) + ((size_t)pair * 128 + b) * 2 * 512 + ch;
        if (t >= 1) u1 = ld_bf4(cur - LDA + 1024 + ch) * ld_bf4(cur - LDA + ch);
        else if (samp) u1 = *(const f32x4*)(hist + 512); else u1 = (f32x4){0.f, 0.f, 0.f, 0.f};
        if (t >= 2) u2 = ld_bf4(cur - 2 * LDA + 1024 + ch) * ld_bf4(cur - 2 * LDA + ch);
        else if (samp) u2 = *(const f32x4*)(hist + (t == 1 ? 512 : 0)); else u2 = (f32x4){0.f, 0.f, 0.f, 0.f};
        const f32x4 c0 = *(const f32x4*)(cw + ch), c1 = *(const f32x4*)(cw + 512 + ch), c2 = *(const f32x4*)(cw + 1024 + ch);
        const f32x4 conv = c0 * u2 + c1 * u1 + c2 * u0;
        const f32x4 ab = ld_bf4(cur + 512 + ch), az = ld_bf4(cur + 1536 + ch);
        f32x4 o;
#pragma unroll
        for (int j = 0; j < 4; ++j) o[j] = ab[j] * conv[j] * siluf_(az[j]);
        st_bf4(Ycat + (size_t)row * 1024 + ch, o);
        if (t >= T - 2) {
            float* dst = samp ? POUT + O_CONVS + (((size_t)pair * 128 + b) * 2 + (t - (T - 2))) * 512 + ch : POUT + O_CONVP + (((size_t)pair * 8 + b) * 2 + (t - (T - 2))) * 512 + ch;
            *(f32x4*)dst = u0;
        }
    }
}

__device__ void phase_odd_mixer(const Params& p, const Ctx cx, int pair, LAS unsigned char* lds) {
    const int tid = cx.tid, wid = tid >> 6, lane = tid & 63, fr = lane & 15, fq = lane >> 4;
    const bf16_t* PO = (const bf16_t*)(PWS + WS_R1);
    bf16_t* Ycat = (bf16_t*)(PWS + WS_YCAT);
    LAS bf16_t* LA = (LAS bf16_t*)lds;
    LAS bf16_t* LB = (LAS bf16_t*)(lds + 128 * 136 * 2);
    LAS float* stat = (LAS float*)(lds + 2 * 128 * 136 * 2);
    LAS float* LE = (LAS float*)(lds + 128 * 136 * 2);
    for (int round = 0; round < 8; ++round) {
        int it;
        if (cx.nblk == 256) {
            if (round == 0) it = cx.bid < 136 ? cx.bid : 136 + 136 + (cx.bid - 136);
            else if (round == 1) it = cx.bid < 136 ? 136 + cx.bid : 136 + 136 + 120 + (cx.bid - 136);
            else if (cx.bid >= 136) it = 136 + 136 + 120 * round + (cx.bid - 136);
            else it = 1 << 20;
        } else it = cx.bid + round * cx.nblk;
        if (it >= 680) { if (cx.nblk == 256 ? round >= 4 : true) break; else continue; }
        if (it >= 136) {
            const int ci = it - 136, tile = ci >> 2, g = ci & 3, r0 = tile * 128;
            const bool samp = r0 >= NTP;
            const int w = 2 << g;
            if (!samp) {
                const int t0 = r0 & 2047;
                for (int e = tid; e < 143 * 32; e += 512) {
                    const int er = e >> 5, c = (e & 31) * 4;
                    f32x4 v = (f32x4){0.f, 0.f, 0.f, 0.f};
                    if (t0 + er - 15 >= 0) v = ld_bf4(PO + (size_t)(r0 + er - 15) * LDA + g * 128 + c);
                    *(LAS f32x4*)(LE + er * 128 + c) = v;
                }
                __syncthreads();
                for (int e = tid; e < 128 * 32; e += 512) {
                    const int tl = e >> 5, c = (e & 31) * 4;
                    const f32x4 pt = *(LAS const f32x4*)(LE + (tl + 15) * 128 + c);
                    f32x4 sum = pt;
                    for (int d = 1; d < w; ++d) sum += *(LAS const f32x4*)(LE + (tl + 15 - d) * 128 + c);
                    const float cnt = fminf((float)w, (float)(t0 + tl + 1));
                    const f32x4 pooled = sum * (1.0f / cnt) - pt;
                    u32x2 u; u.x = cvt_pk_bf16(pooled[0], pooled[1]); u.y = cvt_pk_bf16(pooled[2], pooled[3]);
                    *(LAS u32x2*)(LA + tl * 136 + c) = u;
                }
            } else {
                for (int e = tid; e < 128 * 32; e += 512) {
                    const int tl = e >> 5, c = (e & 31) * 4, row = r0 + tl;
                    const int q = row - NTP, b = q >> 3, t = q & 7;
                    const bf16_t* cur = PO + (size_t)row * LDA + g * 128 + c;
                    const f32x4 pt = ld_bf4(cur);
                    f32x4 sum = pt;
                    for (int d = 1; d < w; ++d) {
                        const int tt = t - d;
                        if (tt >= 0) sum += ld_bf4(cur - (size_t)d * LDA);
                        else sum += *(const f32x4*)(PIN(I_SPOOL) + (((size_t)pair * 128 + b) * 15 + (15 + tt)) * 512 + g * 128 + c);
                    }
                    const f32x4 pooled = sum * (1.0f / (float)w) - pt;
                    u32x2 u; u.x = cvt_pk_bf16(pooled[0], pooled[1]); u.y = cvt_pk_bf16(pooled[2], pooled[3]);
                    *(LAS u32x2*)(LA + tl * 136 + c) = u;
                }
            }
            __syncthreads();
            const bf16_t* Bw = (const bf16_t*)(PWS + WS_POOLWT) + ((size_t)pair * 4 + g) * 128 * 128;
            const int row = r0 + wid * 16 + fr;
            bf16x8 af[4];
#pragma unroll
            for (int ks = 0; ks < 4; ++ks) af[ks] = *(const LAS bf16x8*)(LA + (wid * 16 + fr) * 136 + ks * 32 + fq * 8);
#pragma unroll
            for (int nt = 0; nt < 8; ++nt) {
                f32x4 acc = (f32x4){0.f, 0.f, 0.f, 0.f};
#pragma unroll
                for (int ks = 0; ks < 4; ++ks) {
                    const bf16x8 bf = *(const bf16x8*)(Bw + (size_t)(nt * 16 + fr) * 128 + ks * 32 + fq * 8);
                    acc = __builtin_amdgcn_mfma_f32_16x16x32_bf16(bf, af[ks], acc, 0, 0, 0);
                }
                const int d = g * 128 + nt * 16 + fq * 4;
                const f32x4 cz = ld_bf4(PO + (size_t)row * LDA + 512 + d), ps = *(const f32x4*)(PIN(I_PSCALE) + pair * 512 + d);
                f32x4 o;
#pragma unroll
                for (int j = 0; j < 4; ++j) o[j] = acc[j] * ps[j] * siluf_(cz[j]);
                st_bf4(Ycat + (size_t)row * 1024 + d, o);
            }
            __syncthreads();
        } else {
            const int tile = it, r0 = tile * 128;
            const bool samp = r0 >= NTP;
            {
                const int tl = tid >> 2, q = tid & 3;
                const bf16_t* vr = PO + (size_t)(r0 + tl) * LDA + 1536 + q * 128;
                float s_ = 0.f, ss = 0.f;
#pragma unroll
                for (int i = 0; i < 16; ++i) { const u32x4 raw = *(const u32x4*)(vr + i * 8); const f32x4 v0 = cvt4((u32x2){raw.x, raw.y}), v1 = cvt4((u32x2){raw.z, raw.w});
                    s_ += (v0[0] + v0[1]) + (v0[2] + v0[3]) + (v1[0] + v1[1]) + (v1[2] + v1[3]); ss += dot4(v0, v0) + dot4(v1, v1); }
                s_ = allsum4(s_); ss = allsum4(ss);
                const float mean = s_ * (1.0f / 512.0f);
                const float var = fmaxf(ss * (1.0f / 512.0f) - mean * mean, 0.f);
                if (q == 0) { stat[tl * 2] = mean; stat[tl * 2 + 1] = rsqrtf(var + 1e-5f); }
            }
            __syncthreads();
#pragma unroll 1
            for (int g = 0; g < 4; ++g) {
                {
                    const int tl = tid >> 2, q = tid & 3, row = r0 + tl;
                    const float mean = stat[tl * 2], rstd = stat[tl * 2 + 1];
                    const bf16_t* vr = PO + (size_t)row * LDA + 1536 + g * 128 + q * 32;
                    const float* lg = PIN(I_LNG) + pair * 512 + g * 128 + q * 32; const float* lb = PIN(I_LNB) + pair * 512 + g * 128 + q * 32;
#pragma unroll
                    for (int i = 0; i < 8; ++i) {
                        const f32x4 v = ld_bf4(vr + i * 4);
                        const f32x4 vn = (v - mean) * rstd * *(const f32x4*)(lg + i * 4) + *(const f32x4*)(lb + i * 4);
                        if (samp) *(f32x4*)(POUT + O_CHUNKV + ((size_t)pair * 1024 + (row - NTP)) * 512 + g * 128 + q * 32 + i * 4) = vn;
#pragma unroll
                        for (int j = 0; j < 4; ++j) LB[(q * 32 + i * 4 + j) * 136 + tl] = (bf16_t)(cvt_pk_bf16(vn[j], 0.f) & 0xffffu);
                    }
                }
                if (!samp) {
                    const bf16_t* Wsrc = (const bf16_t*)(PWS + WS_SPW) + ((size_t)pair * 4 + g) * 128 * 128;
                    for (int e = tid; e < 128 * 16; e += 512) { const int t = e >> 4, s8 = (e & 15) * 8; *(LAS u32x4*)(LA + t * 136 + s8) = *(const u32x4*)(Wsrc + t * 128 + s8); }
                } else {
                    const float* Wsrc = PIN(I_SPW) + ((size_t)pair * 4 + g) * 128 * 128;
                    for (int e = tid; e < 128 * 128; e += 512) { const int t = e >> 7, s2 = e & 127;
                        const float v = ((t >> 3) == (s2 >> 3) && (s2 & 7) <= (t & 7)) ? Wsrc[(t & 7) * 128 + (s2 & 7)] : 0.f;
                        LA[t * 136 + s2] = (bf16_t)(cvt_pk_bf16(v, 0.f) & 0xffffu); }
                }
                __syncthreads();
                {
                    const int tl = wid * 16 + fr, row = r0 + tl;
                    const float bias = PIN(I_SPB)[((size_t)pair * 4 + g) * 128 + (samp ? (tl & 7) : tl)];
                    bf16x8 wf[4];
#pragma unroll
                    for (int ks = 0; ks < 4; ++ks) wf[ks] = *(const LAS bf16x8*)(LA + tl * 136 + ks * 32 + fq * 8);
#pragma unroll
                    for (int nt = 0; nt < 8; ++nt) {
                        f32x4 acc = (f32x4){0.f, 0.f, 0.f, 0.f};
#pragma unroll
                        for (int ks = 0; ks < 4; ++ks) {
                            if (ks * 32 <= wid * 16 + 15) {
                                const bf16x8 vf = *(const LAS bf16x8*)(LB + (nt * 16 + fr) * 136 + ks * 32 + fq * 8);
                                acc = __builtin_amdgcn_mfma_f32_16x16x32_bf16(vf, wf[ks], acc, 0, 0, 0);
                            }
                        }
                        const int c = g * 128 + nt * 16 + fq * 4;
                        const f32x4 u = ld_bf4(PO + (size_t)row * LDA + 1024 + c), dz = ld_bf4(PO + (size_t)row * LDA + 2048 + c);
                        f32x4 o;
#pragma unroll
                        for (int j = 0; j < 4; ++j) o[j] = u[j] * (acc[j] + bias) * siluf_(dz[j]);
                        st_bf4(Ycat + (size_t)row * 1024 + 512 + c, o);
                    }
                }
                __syncthreads();
            }
        }
    }
    const int gtid = cx.bid * 512 + tid, gthreads = cx.nblk * 512;
    for (int e = gtid; e < 136 * 15 * 512; e += gthreads) {
        const int c = e & 511, q = e >> 9, sr = q / 15, k = q % 15;
        if (sr < 8) POUT[O_POOLP + (((size_t)pair * 8 + sr) * 15 + k) * 512 + c] = bf2f(PO[(size_t)(sr * 2048 + 2033 + k) * LDA + c]);
        else { const int b = sr - 8;
            POUT[O_POOLS + (((size_t)pair * 128 + b) * 15 + k) * 512 + c] = (k < 7) ? PIN(I_SPOOL)[(((size_t)pair * 128 + b) * 15 + 8 + k) * 512 + c] : bf2f(PO[(size_t)(NTP + b * 8 + (k - 7)) * LDA + c]); }
    }
}

__device__ void phase_final(const Params& p, const Ctx cx) {
    const int gtid = cx.bid * 512 + cx.tid, gthreads = cx.nblk * 512;
    const float* ssq = (const float*)(PWS + WS_SSQ) + 4 * NTOK;
    for (int e = gtid; e < NTOK * 256; e += gthreads) {
        const int row = e >> 8, c = (e & 255) * 4;
        const float rstd = rsqrtf(ssq[row] * (1.0f / 1024.0f) + 1e-6f);
        f32x4* px = (f32x4*)(POUT + (size_t)row * 1024 + c);
        *px = *px * rstd * *(const f32x4*)(PIN(I_FNORMW) + c);
    }
}

#define XB_TMO      128
#define XB_XCNT(j)  (256  + 64 * (j))
#define XB_XSUB(j)  (1280 + 64 * (j))
#define XB_XGEN(j)  (2304 + 64 * (j))
#define XB_TOP      3328
#define XB_TOPGEN   3392
#define XCD_BAR_WORDS 3456
#define XB_SPIN_CAP (1u << 18)
__device__ __forceinline__ unsigned xb_ld(unsigned* p)              { return __hip_atomic_load(p, __ATOMIC_RELAXED, __HIP_MEMORY_SCOPE_AGENT); }
__device__ __forceinline__ unsigned xb_add(unsigned* p, unsigned v) { return __hip_atomic_fetch_add(p, v, __ATOMIC_RELAXED, __HIP_MEMORY_SCOPE_AGENT); }
__device__ __forceinline__ unsigned xb_xcc_id() { return (unsigned)__builtin_amdgcn_s_getreg((3 << 11) | 20) & 0xFu; }
#define XB_SPIN(cond, bar) do { unsigned _sp = 0; while (cond) { __builtin_amdgcn_s_sleep(1); \
    if ((++_sp & 255u) == 0u) { if (xb_ld(&(bar)[XB_TMO])) break; if (_sp > XB_SPIN_CAP) { atomicAdd(&(bar)[XB_TMO], 1u); break; } } } } while (0)
struct XcdBarrier { unsigned* bar; unsigned x; volatile LAS unsigned* st; };
__device__ __forceinline__ XcdBarrier xcd_barrier_post(unsigned* bar, volatile LAS unsigned* st) {
    XcdBarrier b; b.bar = bar; b.x = xb_xcc_id(); b.st = st;
    if (threadIdx.x == 0) (void)xb_add(&bar[XB_XCNT(b.x)], 1u);
    return b;
}
__device__ __forceinline__ void xcd_barrier_complete(unsigned* bar, unsigned x, unsigned& nloc, unsigned& nx) {
    const unsigned G = gridDim.x * gridDim.y * gridDim.z;
    unsigned sum, cnt, mine, sp = 0u;
    for (;;) {
        sum = 0u; cnt = 0u; mine = 0u;
#pragma unroll
        for (unsigned j = 0; j < 16; ++j) { const unsigned c = xb_ld(&bar[XB_XCNT(j)]); sum += c; cnt += (c > 0u) ? 1u : 0u; mine = (j == x) ? c : mine; }
        if (sum == G) break;
        __builtin_amdgcn_s_sleep(1);
        if ((++sp & 255u) == 0u) { if (xb_ld(&bar[XB_TMO])) break; if (sp > XB_SPIN_CAP) { atomicAdd(&bar[XB_TMO], 1u); break; } }
    }
    nloc = mine > 0u ? mine : 1u; nx = cnt > 0u ? cnt : 1u;
}
__device__ __forceinline__ void xcd_barrier(const XcdBarrier& b) {
    asm volatile("s_waitcnt vmcnt(0)" ::: "memory");
    __syncthreads();
    if (threadIdx.x == 0) {
        unsigned* bar = b.bar;
        __builtin_amdgcn_s_waitcnt(0);
        unsigned nloc = b.st[0], nx = b.st[1];
        if (nloc == 0u) { xcd_barrier_complete(bar, b.x, nloc, nx); b.st[0] = nloc; b.st[1] = nx; }
        const unsigned old = xb_add(&bar[XB_XSUB(b.x)], 1u);
        const unsigned gen = old / nloc;
        if (old + 1u == (gen + 1u) * nloc) {
            __builtin_amdgcn_fence(__ATOMIC_RELEASE, "agent");
            asm volatile("s_waitcnt vmcnt(0)" ::: "memory");
            const unsigned og = xb_add(&bar[XB_TOP], 1u);
            const unsigned tg = og / nx;
            if (og + 1u == (tg + 1u) * nx) xb_add(&bar[XB_TOPGEN], 1u);
            else XB_SPIN(xb_ld(&bar[XB_TOPGEN]) == tg, bar);
            __builtin_amdgcn_fence(__ATOMIC_ACQUIRE, "agent");
            xb_add(&bar[XB_XGEN(b.x)], 1u);
            asm volatile("s_waitcnt vmcnt(0)" ::: "memory");
        } else {
            XB_SPIN(xb_ld(&bar[XB_XGEN(b.x)]) == gen, bar);
            __builtin_amdgcn_fence(__ATOMIC_ACQUIRE, "agent");
            asm volatile("s_waitcnt vmcnt(0)" ::: "memory");
        }
    }
    __syncthreads();
}

__device__ void run_gemm_proj(const Params& p, const Ctx cx, LAS unsigned char* lds, const bf16_t* Bt, int N, bf16_t* O, int ldc, int layer) {
    pg8::Gemm g{(const bf16_t*)(PWS + WS_XB), Bt, NTOK, N, 1024};
    pg8::StaticOrder S; S.init(NTOK, N, (int)cx.nblk, (int)cx.bid);
    EpiProj E{O, ldc, (const float*)(PWS + WS_SSQ) + (size_t)layer * NTOK};
    pg8::gemm_phase<EpiProj>(cx, lds, g, S, E);
}
__device__ void run_gemm_res(const Params& p, const Ctx cx, LAS unsigned char* lds, const bf16_t* Bt, int layer) {
    pg8::Gemm g{(const bf16_t*)(PWS + WS_YCAT), Bt, NTOK, 1024, 1024};
    pg8::StaticOrder S; S.init(NTOK, 1024, (int)cx.nblk, (int)cx.bid);
    EpiRes E{layer == 0 ? PIN(I_XP) : nullptr, PIN(I_XS), POUT, (bf16_t*)(PWS + WS_XB), (float*)(PWS + WS_SSQ) + (size_t)(layer + 1) * NTOK};
    pg8::gemm_phase<EpiRes>(cx, lds, g, S, E);
}

constexpr int N_PHASES = 20;
#ifndef PHMASK
#define PHMASK 0xffff
#endif
#define PHON(n) ((PHMASK >> ((n) % 16)) & 1)
__global__ void __launch_bounds__(512, 2) fwd_kernel(Params p) {
    extern __shared__ __attribute__((aligned(16))) unsigned char lds_raw[];
    LAS unsigned char* lds = (LAS unsigned char*)lds_raw;
    volatile LAS unsigned* bar_st = (volatile LAS unsigned*)(lds + 131072);
    if (threadIdx.x < 4) bar_st[threadIdx.x] = 0u;
    __syncthreads();
    const XcdBarrier gbar = xcd_barrier_post((unsigned*)((unsigned char*)p.ptr[30] + WS_BAR), bar_st);
    if (p.ph_hi < 0) cg::this_grid().sync();
#define GRID_SYNC() xcd_barrier(gbar)
#ifdef SYNCPROBE
    for (int i = 0; i < SYNCPROBE; ++i) GRID_SYNC();
#endif
#ifdef REPMASK
    for (int pc = p.ph_lo * 2; pc < p.ph_hi * 2; ++pc) {
        const int ph = pc >> 1;
        { const int s_ = (ph == 0 || ph == N_PHASES - 1) ? 31 : (ph - 1) % 9; if ((pc & 1) && !((REPMASK >> s_) & 1)) continue; }
        if (pc > p.ph_lo * 2) GRID_SYNC();
#else
    for (int ph = p.ph_lo; ph < p.ph_hi; ++ph) {
        if (ph > p.ph_lo) GRID_SYNC();
#endif
        Ctx cx; cx.tid = threadIdx.x; cx.bid = blockIdx.x; cx.nblk = gridDim.x;
        asm volatile("s_mov_b32 %0, 0" : "=s"(cx.z));
        asm volatile("" : "+v"(cx.tid)); asm volatile("" : "+s"(cx.bid)); asm volatile("" : "+s"(cx.nblk));
        const int pair = (ph - 1) / 9, s = (ph == 0) ? 100 : (ph == N_PHASES - 1 ? 101 : (ph - 1) % 9);
        if (s == 0 || s == 3 || s == 6) {
#if PHON(0)
            const bf16_t* WinE = (const bf16_t*)(PWS + WS_WINE) + (size_t)pair * 4352 * 1024;
            const bf16_t* Bt = s == 0 ? WinE + (size_t)2560 * 1024 : (s == 3 ? WinE : (const bf16_t*)(PWS + WS_WINO) + (size_t)pair * 2560 * 1024);
            const int N = s == 0 ? 1792 : 2560;
            run_gemm_proj(p, cx, lds, Bt, N, (bf16_t*)(PWS + WS_R1), N, 2 * pair + (s == 6 ? 1 : 0));
#endif
        } else if (s == 5 || s == 8) {
#if PHON(5)
            const bf16_t* Bt = (const bf16_t*)(PWS + (s == 5 ? WS_WOUTE : WS_WOUTO)) + (size_t)pair * 1024 * 1024;
            run_gemm_res(p, cx, lds, Bt, 2 * pair + (s == 8 ? 1 : 0));
#endif
        } else if (s == 1) {
#if PHON(1)
            phase_even_prep(p, cx, pair);
#endif
        } else if (s == 2) {
#if PHON(2)
            phase_scan(p, cx, pair, lds);
#endif
        } else if (s == 4) {
#if PHON(4)
            phase_even_post(p, cx, pair);
#endif
        } else if (s == 7) {
#if PHON(7)
            phase_odd_mixer(p, cx, pair, lds);
#endif
        } else if (s == 100) {
#if PHON(10)
            phase_prepass(p, cx, lds);
#endif
        } else {
#if PHON(11)
            phase_final(p, cx);
#endif
        }
    }
}

extern "C" void kernel_launch(void* const* d_in, const int* in_sizes, int n_in, void* d_out, int out_size, void* d_ws, size_t ws_size, hipStream_t stream) {
    static int grid = 0;
    if (grid == 0) {
        if (n_in != 29 || ws_size < WS_END) { fprintf(stderr, "kernel_launch: unexpected n_in %d / ws_size %zu (need %zu)\n", n_in, ws_size, (size_t)WS_END); grid = -1; return; }
        int dev = 0, cus = 0, per_cu = 0;
        hipGetDevice(&dev);
        hipDeviceGetAttribute(&cus, hipDeviceAttributeMultiprocessorCount, dev);
        if (hipFuncSetAttribute((const void*)fwd_kernel, hipFuncAttributeMaxDynamicSharedMemorySize, LDS_BYTES) != hipSuccess) { fprintf(stderr, "kernel_launch: hipFuncSetAttribute failed\n"); grid = -1; return; }
        if (hipOccupancyMaxActiveBlocksPerMultiprocessor(&per_cu, (const void*)fwd_kernel, 512, LDS_BYTES) != hipSuccess || per_cu < 1) { fprintf(stderr, "kernel_launch: occupancy query gave %d\n", per_cu); per_cu = 1; }
        (void)hipGetLastError();
        grid = cus * per_cu;
        if (grid > 256) grid = 256;
    }
    if (grid < 0) return;
    Params p{};
    for (int i = 0; i < 29; ++i) p.ptr[i] = d_in[i];
    p.ptr[29] = d_out; p.ptr[30] = d_ws; p.ptr[31] = nullptr;
    (void)hipMemsetAsync((unsigned char*)d_ws + WS_BAR, 0, 16384, stream);
#if ONE_LAUNCH
    p.ph_lo = 0; p.ph_hi = N_PHASES;
    void* args[] = {&p};
    hipError_t e = hipLaunchCooperativeKernel((const void*)fwd_kernel, dim3(grid), dim3(512), args, LDS_BYTES, stream);
    if (e != hipSuccess) fprintf(stderr, "cooperative launch failed: %s (grid %d)\n", hipGetErrorString(e), grid);
#else
    for (int ph = 0; ph < N_PHASES; ++ph) {
        p.ph_lo = ph; p.ph_hi = ph + 1;
        hipLaunchKernelGGL(fwd_kernel, dim3(grid), dim3(512), LDS_BYTES, stream, p);
    }
#endif
}
```

```cpp
#include <hip/hip_runtime.h>
#include <hip/hip_cooperative_groups.h>
#include <cstdio>
namespace cg = cooperative_groups;

#ifndef ONE_LAUNCH
#define ONE_LAUNCH 1
#endif

#define LAS __attribute__((address_space(3)))
typedef unsigned short bf16_t;
typedef short bf16x8 __attribute__((ext_vector_type(8)));
typedef float f32x4 __attribute__((ext_vector_type(4)));
typedef unsigned u32x4 __attribute__((ext_vector_type(4)));
typedef unsigned u32x2 __attribute__((ext_vector_type(2)));

constexpr int NTOK = 17408, NTP = 16384;
constexpr int LDB = 1792;
constexpr int LDA = 2560;
constexpr size_t O_CONVP = 17825792, O_CONVS = 17842176, O_SHIFTP = 18104320, O_SHIFTS = 18130944, O_WKVP = 18556928, O_WKVS = 19081216,
                 O_POOLP = 27469824, O_POOLS = 27592704, O_CHUNKV = 29558784;
constexpr size_t WS_WINE = 0;
constexpr size_t WS_WOUTE = WS_WINE + 2ull * 4352 * 1024 * 2;
constexpr size_t WS_WINO = WS_WOUTE + 2ull * 1024 * 1024 * 2;
constexpr size_t WS_WOUTO = WS_WINO + 2ull * 2560 * 1024 * 2;
constexpr size_t WS_W2T = WS_WOUTO + 2ull * 1024 * 1024 * 2;
constexpr size_t WS_A2T = WS_W2T + 2ull * 512 * 64 * 2;
constexpr size_t WS_POOLWT = WS_A2T + 2ull * 512 * 64 * 2;
constexpr size_t WS_SPW = WS_POOLWT + 8ull * 128 * 128 * 2;
constexpr size_t WS_XB = WS_SPW + 8ull * 128 * 128 * 2;
constexpr size_t WS_YCAT = WS_XB + (size_t)NTOK * 1024 * 2;
constexpr size_t WS_SSQ = WS_YCAT + (size_t)NTOK * 1024 * 2;
constexpr size_t WS_Y = WS_SSQ + 5ull * NTOK * 16 * 4;
constexpr size_t WS_R1 = WS_Y + (size_t)NTOK * 512 * 4;
constexpr size_t WS_PROJB = WS_R1;
constexpr size_t WS_WDEC = WS_PROJB + (size_t)NTOK * LDB * 2;
constexpr size_t WS_AA = WS_WDEC + (size_t)NTOK * 512 * 4;
constexpr size_t WS_BAR = WS_AA + (size_t)NTOK * 512 * 2;
constexpr size_t WS_END = WS_BAR + 16384;
constexpr int LDS_BYTES = 131072 + 16;

struct Params {
    const void* ptr[32];
    int ph_lo, ph_hi;
};
struct Ctx { int tid, bid, nblk, z; };
#define PIN(i) ((const float*)p.ptr[(i) + cx.z])
#define POUT ((float*)p.ptr[29 + cx.z])
#define PWS ((unsigned char*)p.ptr[30 + cx.z])
enum { I_XP = 0, I_XS, I_SCONV, I_SSHIFT, I_SWKV, I_SPOOL, I_NORMW, I_FNORMW, I_WINE, I_CONVW, I_MU, I_W0, I_W2, I_A0, I_A2, I_KK, I_KA, I_RK, I_GNG, I_GNB,
       I_WOUTE, I_WINO, I_POOLW, I_PSCALE, I_LNG, I_LNB, I_SPW, I_SPB, I_WOUTO };

__device__ __forceinline__ unsigned cvt_pk_bf16(float lo, float hi) { unsigned r; asm("v_cvt_pk_bf16_f32 %0, %1, %2" : "=v"(r) : "v"(lo), "v"(hi)); return r; }
__device__ __forceinline__ float bf_lo(unsigned u) { return __uint_as_float(u << 16); }
__device__ __forceinline__ float bf_hi(unsigned u) { return __uint_as_float(u & 0xffff0000u); }
__device__ __forceinline__ float bf2f(bf16_t b) { return __uint_as_float(((unsigned)b) << 16); }
__device__ __forceinline__ f32x4 cvt4(u32x2 u) { return (f32x4){bf_lo(u.x), bf_hi(u.x), bf_lo(u.y), bf_hi(u.y)}; }
__device__ __forceinline__ f32x4 ld_bf4(const bf16_t* p) { return cvt4(*(const u32x2*)p); }
__device__ __forceinline__ void st_bf4(bf16_t* p, f32x4 v) { u32x2 u; u.x = cvt_pk_bf16(v[0], v[1]); u.y = cvt_pk_bf16(v[2], v[3]); *(u32x2*)p = u; }
__device__ __forceinline__ float sigmoidf_(float x) { return 1.0f / (1.0f + __expf(-x)); }
__device__ __forceinline__ float siluf_(float x) { return x / (1.0f + __expf(-x)); }
template <int CTRL> __device__ __forceinline__ float dpp_f(float x) { return __builtin_bit_cast(float, __builtin_amdgcn_mov_dpp(__builtin_bit_cast(int, x), CTRL, 0xf, 0xf, true)); }
__device__ __forceinline__ float allsum16(float x) { x += dpp_f<0xB1>(x); x += dpp_f<0x4E>(x); x += dpp_f<0x141>(x); x += dpp_f<0x128>(x); return x; }
__device__ __forceinline__ float allsum4(float x) { x += dpp_f<0xB1>(x); x += dpp_f<0x4E>(x); return x; }
__device__ __forceinline__ float dot4(f32x4 a, f32x4 b) { return a[0] * b[0] + a[1] * b[1] + a[2] * b[2] + a[3] * b[3]; }

__device__ __forceinline__ float ssq_sum(const float* part) {
    const f32x4 a = *(const f32x4*)(part), b = *(const f32x4*)(part + 4), c = *(const f32x4*)(part + 8), d = *(const f32x4*)(part + 12);
    return ((a[0] + a[1]) + (a[2] + a[3])) + ((b[0] + b[1]) + (b[2] + b[3])) + ((c[0] + c[1]) + (c[2] + c[3])) + ((d[0] + d[1]) + (d[2] + d[3]));
}

namespace pg8 {
constexpr int BM = 256, BK = 64, HALF = 128, HTB = HALF * BK * 2, NXCD = 8, WGM = 8;
__device__ __forceinline__ int lds_byte(int r, int c) { const int st = (r >> 4) * 2 + (c >> 5), rr = r & 15, cc = c & 31, ob = rr * 64 + cc * 2; return st * 1024 + (ob ^ (((ob >> 9) & 1) << 5)); }
__device__ __forceinline__ void stage_rc(int b, int& R, int& C) { const int st = b / 1024, sb = b % 1024, swz = sb ^ (((sb >> 9) & 1) << 5); R = (st >> 1) * 16 + swz / 64; C = (st & 1) * 32 + (swz % 64) / 2; }
__device__ __forceinline__ int perm32(int rho) { const int n = rho >> 4, i = rho & 15; return 8 * (i >> 2) + 4 * n + (i & 3); }
struct Unit { int pm, pn; };
struct Gemm { const bf16_t* A; const bf16_t* Bt; int M, N, K; };
struct StaticOrder {
    int nM, nN, nwg, G, c;
    __device__ void init(int M, int N, int G_, int c_) { nM = M / BM; nN = N / BM; nwg = nM * nN; G = G_; c = c_; }
    __device__ bool next(int i, Unit& u) const {
        const long L = (long)i * G + c; if (L >= nwg) return false;
        int wgid = (int)L; { const int q = nwg / NXCD, r = nwg % NXCD, xcd = wgid % NXCD, off = wgid / NXCD; wgid = (xcd < r ? xcd * (q + 1) : r * (q + 1) + (xcd - r) * q) + off; }
        const int nig = WGM * nN, gid = wgid / nig, fm = gid * WGM, gsz = (nM - fm) < WGM ? (nM - fm) : WGM;
        u.pm = fm + ((wgid % nig) % gsz); u.pn = (wgid % nig) / gsz; return true;
    }
};

template <class Epi>
__device__ __forceinline__ void gemm_phase(const Ctx cx, LAS unsigned char* lds, const Gemm g, const StaticOrder& S, const Epi& E) {
    const int tid = cx.tid, wid = __builtin_amdgcn_readfirstlane(tid >> 6), lane = tid & 63, wr = wid >> 2, wc = wid & 3, fr = lane & 15, fq = lane >> 4;
    const int K = g.K, nt = K / BK;
    unsigned voffA[2], voffB[2];
#pragma unroll
    for (int i = 0; i < 2; ++i) { int R, C; stage_rc(tid * 16 + i * 8192, R, C); const int Rb = Epi::PERM ? ((R & ~31) + perm32(R & 31)) : R;
        voffA[i] = (unsigned)(R * K + C) * 2u; voffB[i] = (unsigned)(Rb * K + C) * 2u; }
    const size_t kstep = (size_t)(BK * 2);
    const size_t hstep = (size_t)HALF * K * 2;
    const size_t tstep = 2 * hstep;
    const unsigned ldsw = (unsigned)wid * 1024u;
    const int aoff = lds_byte(wr * 64 + fr, fq * 8), boff = lds_byte(wc * 32 + fr, fq * 8);
#define PG8_SA(b, h) (((b) * 2 + (h)) * HTB)
#define PG8_SB(b, h) ((4 + (b) * 2 + (h)) * HTB)
#define PG8_STAGE(bufoff, gbase, voff) do { _Pragma("unroll") for (int _i = 0; _i < 2; ++_i) \
        __builtin_amdgcn_global_load_lds((const unsigned*)((const char*)(gbase) + (voff)[_i]), (LAS unsigned*)(lds + (bufoff) + ldsw + _i * 8192), 16, 0, 0); } while (0)
#define PG8_LDA(dst, b, h) do { _Pragma("unroll") for (int m = 0; m < 4; ++m) _Pragma("unroll") for (int k = 0; k < 2; ++k) dst[m][k] = *(const LAS bf16x8*)(lds + PG8_SA(b, h) + aoff + m * 2048 + k * 1024); } while (0)
#define PG8_LDB(dst, b, h) do { _Pragma("unroll") for (int n = 0; n < 2; ++n) _Pragma("unroll") for (int k = 0; k < 2; ++k) dst[n][k] = *(const LAS bf16x8*)(lds + PG8_SB(b, h) + boff + n * 2048 + k * 1024); } while (0)
#define PG8_MMA(ai, bj, At, Bt) do { __builtin_amdgcn_s_setprio(1); _Pragma("unroll") for (int m = 0; m < 4; ++m) _Pragma("unroll") for (int n = 0; n < 2; ++n) _Pragma("unroll") for (int k = 0; k < 2; ++k) \
        acc[ai][bj][m][n] = __builtin_amdgcn_mfma_f32_16x16x32_bf16(Bt[n][k], At[m][k], acc[ai][bj][m][n], 0, 0, 0); __builtin_amdgcn_s_setprio(0); } while (0)
#define PG8_WAIT_V(n) asm volatile("s_waitcnt vmcnt(" #n ")" ::: "memory")
#define PG8_WAIT_L(n) asm volatile("s_waitcnt lgkmcnt(" #n ")" ::: "memory")
#define PG8_BAR __builtin_amdgcn_s_barrier()
#define PG8_SCHED __builtin_amdgcn_sched_barrier(0)
    Unit cur, nxt; int ui = 0;
    if (!S.next(0, cur)) return;
    f32x4 acc[2][2][4][2];
#pragma unroll
    for (int a = 0; a < 2; ++a)
#pragma unroll
        for (int b = 0; b < 2; ++b)
#pragma unroll
            for (int m = 0; m < 4; ++m)
#pragma unroll
                for (int n = 0; n < 2; ++n) acc[a][b][m][n] = (f32x4){0.f, 0.f, 0.f, 0.f};
    bf16x8 At[4][2], B0[2][2], B1[2][2];
    const char* cA = (const char*)g.A + (size_t)cur.pm * tstep; const char* cB = (const char*)g.Bt + (size_t)cur.pn * tstep;
    PG8_STAGE(PG8_SB(0, 0), cB, voffB); PG8_STAGE(PG8_SA(0, 0), cA, voffA); PG8_STAGE(PG8_SB(0, 1), cB + hstep, voffB); PG8_STAGE(PG8_SA(0, 1), cA + hstep, voffA);
    if (wr == 1) PG8_BAR;
    PG8_WAIT_V(4); PG8_BAR;
    PG8_STAGE(PG8_SB(1, 0), cB + kstep, voffB); PG8_STAGE(PG8_SA(1, 0), cA + kstep, voffA); PG8_STAGE(PG8_SB(1, 1), cB + hstep + kstep, voffB);
    PG8_WAIT_V(6); PG8_BAR;
    for (;;) {
        const bool has_next = S.next(ui + 1, nxt);
        const char* nA = has_next ? (const char*)g.A + (size_t)nxt.pm * tstep : cA; const char* nB = has_next ? (const char*)g.Bt + (size_t)nxt.pn * tstep : cB;
        for (int t = 0; t < nt; t += 2) {
            const bool last = (t == nt - 2);
            const char* a1 = cA + (size_t)(t + 1) * kstep;
            const char* a2 = last ? nA : cA + (size_t)(t + 2) * kstep; const char* b2 = last ? nB : cB + (size_t)(t + 2) * kstep;
            const char* a3 = a2 + kstep; const char* b3 = b2 + kstep;
            PG8_LDB(B0, 0, 0); PG8_SCHED; PG8_LDA(At, 0, 0); PG8_STAGE(PG8_SA(1, 1), a1 + hstep, voffA);
            PG8_WAIT_L(8); PG8_BAR; PG8_WAIT_L(0); PG8_MMA(0, 0, At, B0); PG8_BAR; PG8_SCHED;
            PG8_LDB(B1, 0, 1); PG8_STAGE(PG8_SB(0, 0), b2, voffB);
            PG8_BAR; PG8_WAIT_L(0); PG8_MMA(0, 1, At, B1); PG8_BAR;
            PG8_LDA(At, 0, 1); PG8_STAGE(PG8_SA(0, 0), a2, voffA);
            PG8_BAR; PG8_WAIT_L(0); PG8_MMA(1, 0, At, B0); PG8_BAR; PG8_SCHED;
            PG8_STAGE(PG8_SB(0, 1), b2 + hstep, voffB);
            PG8_WAIT_V(6); PG8_BAR; PG8_MMA(1, 1, At, B1); PG8_BAR;
            PG8_LDB(B0, 1, 0); PG8_SCHED; PG8_LDA(At, 1, 0); PG8_STAGE(PG8_SA(0, 1), a2 + hstep, voffA);
            PG8_WAIT_L(8); PG8_BAR; PG8_WAIT_L(0); PG8_MMA(0, 0, At, B0); PG8_BAR; PG8_SCHED;
            PG8_LDB(B1, 1, 1); PG8_STAGE(PG8_SB(1, 0), b3, voffB);
            PG8_BAR; PG8_WAIT_L(0); PG8_MMA(0, 1, At, B1); PG8_BAR;
            PG8_LDA(At, 1, 1); PG8_STAGE(PG8_SA(1, 0), a3, voffA);
            PG8_BAR; PG8_WAIT_L(0); PG8_MMA(1, 0, At, B0); PG8_BAR; PG8_SCHED;
            PG8_STAGE(PG8_SB(1, 1), b3 + hstep, voffB);
            PG8_WAIT_V(6); PG8_BAR; PG8_MMA(1, 1, At, B1); PG8_BAR;
        }
        E(acc, cur, wr, wc, fr, fq);
        if (!has_next) break;
#pragma unroll
        for (int a = 0; a < 2; ++a)
#pragma unroll
            for (int b = 0; b < 2; ++b)
#pragma unroll
                for (int m = 0; m < 4; ++m)
#pragma unroll
                    for (int n = 0; n < 2; ++n) acc[a][b][m][n] = (f32x4){0.f, 0.f, 0.f, 0.f};
        cur = nxt; cA = nA; cB = nB; ++ui;
    }
    PG8_WAIT_V(0);
    if (wr == 0) PG8_BAR;
    PG8_BAR;
#undef PG8_SA
#undef PG8_SB
#undef PG8_STAGE
#undef PG8_LDA
#undef PG8_LDB
#undef PG8_MMA
#undef PG8_WAIT_V
#undef PG8_WAIT_L
#undef PG8_BAR
#undef PG8_SCHED
}
}

struct EpiProj {
    static constexpr bool PERM = true;
    bf16_t* O; int ldc; const float* ssq;
    __device__ __forceinline__ void operator()(const f32x4 (&acc)[2][2][4][2], const pg8::Unit& u, int wr, int wc, int fr, int fq) const {
        const int row0 = u.pm * 256 + wr * 64 + fr, col0 = u.pn * 256 + wc * 32 + 8 * fq;
#pragma unroll
        for (int ai = 0; ai < 2; ++ai)
#pragma unroll
            for (int m = 0; m < 4; ++m) {
                const int row = row0 + ai * 128 + m * 16;
                const float rstd = rsqrtf(ssq_sum(ssq + (size_t)row * 16) * (1.0f / 1024.0f) + 1e-6f);
                bf16_t* rowp = O + (size_t)row * ldc + col0;
#pragma unroll
                for (int bj = 0; bj < 2; ++bj) {
                    const f32x4 v0 = acc[ai][bj][m][0] * rstd, v1 = acc[ai][bj][m][1] * rstd;
                    u32x4 w; w.x = cvt_pk_bf16(v0[0], v0[1]); w.y = cvt_pk_bf16(v0[2], v0[3]); w.z = cvt_pk_bf16(v1[0], v1[1]); w.w = cvt_pk_bf16(v1[2], v1[3]);
                    *(u32x4*)(rowp + bj * 128) = w;
                }
            }
    }
};
template <bool FIRST>
__device__ __forceinline__ void epi_res_rows(const f32x4 (&acc)[2][2][4][2], const float* __restrict__ src32, const bf16_t* __restrict__ src16, bf16_t* __restrict__ Xb, float* __restrict__ ssqp,
                                             int row0, int col0, int slot, int fq) {
    f32x4 x[2][4];
#pragma unroll
    for (int q = 0; q < 4; ++q) { const size_t o = (size_t)row0 * 1024 + col0 + (q >> 1) * 128 + (q & 1) * 16; x[0][q] = FIRST ? *(const f32x4*)(src32 + o) : ld_bf4(src16 + o); }
#pragma unroll
    for (int gi = 0; gi < 8; ++gi) {
        const int ai = gi >> 2, m = gi & 3, row = row0 + ai * 128 + m * 16;
        if (gi + 1 < 8) {
            const int nrow = row0 + ((gi + 1) >> 2) * 128 + ((gi + 1) & 3) * 16;
#pragma unroll
            for (int q = 0; q < 4; ++q) { const size_t o = (size_t)nrow * 1024 + col0 + (q >> 1) * 128 + (q & 1) * 16; x[(gi + 1) & 1][q] = FIRST ? *(const f32x4*)(src32 + o) : ld_bf4(src16 + o); }
        }
        float part = 0.f;
#pragma unroll
        for (int q = 0; q < 4; ++q) {
            const int col = col0 + (q >> 1) * 128 + (q & 1) * 16;
            const f32x4 v = x[gi & 1][q] + acc[ai][q >> 1][m][q & 1];
            st_bf4(Xb + (size_t)row * 1024 + col, v);
            part += dot4(v, v);
        }
        part += __shfl_xor(part, 16); part += __shfl_xor(part, 32);
        if (fq == 0) ssqp[(size_t)row * 16 + slot] = part;
    }
}
struct EpiRes {
    static constexpr bool PERM = false;
    const float* xp; const float* xs; bf16_t* Xb; float* ssq_next;
    __device__ __forceinline__ void operator()(const f32x4 (&acc)[2][2][4][2], const pg8::Unit& u, int wr, int wc, int fr, int fq) const {
        const int row0 = u.pm * 256 + wr * 64 + fr, col0 = u.pn * 256 + wc * 32 + 4 * fq;
        if (xp) epi_res_rows<true>(acc, row0 < NTP ? xp : xs - (size_t)NTP * 1024, nullptr, Xb, ssq_next, row0, col0, u.pn * 4 + wc, fq);
        else epi_res_rows<false>(acc, nullptr, Xb, Xb, ssq_next, row0, col0, u.pn * 4 + wc, fq);
    }
};

__device__ __forceinline__ void tr_tile(const Ctx cx, LAS float* T, const float* src, int ld, int col0, int k0, bf16_t* dst, int Ktot, int drow0, const float* scale, bool zero) {
    const int tid = cx.tid;
    if (zero) {
        const int n = tid >> 3, kc = (tid & 7) * 8;
        *(u32x4*)(dst + (size_t)(drow0 + n) * Ktot + k0 + kc) = (u32x4){0u, 0u, 0u, 0u};
        return;
    }
#pragma unroll
    for (int pass = 0; pass < 2; ++pass) {
        const int kk = (tid >> 4) + pass * 32, nn = (tid & 15) * 4;
        f32x4 v = *(const f32x4*)(src + (size_t)(k0 + kk) * ld + col0 + nn);
        if (scale) v = v * scale[k0 + kk];
        T[kk * 65 + nn] = v[0]; T[kk * 65 + nn + 1] = v[1]; T[kk * 65 + nn + 2] = v[2]; T[kk * 65 + nn + 3] = v[3];
    }
    __syncthreads();
    {
        const int n = tid >> 3, kc = (tid & 7) * 8;
        u32x4 w;
        w.x = cvt_pk_bf16(T[(kc + 0) * 65 + n], T[(kc + 1) * 65 + n]); w.y = cvt_pk_bf16(T[(kc + 2) * 65 + n], T[(kc + 3) * 65 + n]);
        w.z = cvt_pk_bf16(T[(kc + 4) * 65 + n], T[(kc + 5) * 65 + n]); w.w = cvt_pk_bf16(T[(kc + 6) * 65 + n], T[(kc + 7) * 65 + n]);
        *(u32x4*)(dst + (size_t)(drow0 + n) * Ktot + k0 + kc) = w;
    }
    __syncthreads();
}

__device__ void phase_prepass(const Params& p, const Ctx cx, LAS unsigned char* lds) {
    LAS float* T = (LAS float*)lds;
    const int tid = cx.tid;
    for (int job = cx.bid; job < 4544; job += cx.nblk) {
        int j = job;
        if (j < 2176) {
            const int i = j / 1088, r = j % 1088, nt = r / 16, kt = r % 16;
            const int n0 = nt * 64;
            int col0; bool zero = false;
            if (n0 < 2048) col0 = n0; else if (n0 < 2560) col0 = 3712 + (n0 - 2048); else if (n0 < 4224) col0 = 2048 + (n0 - 2560); else { col0 = 0; zero = true; }
            tr_tile(cx, T, PIN(I_WINE) + (size_t)i * 1024 * 4224, 4224, col0, kt * 64, (bf16_t*)(PWS + WS_WINE) + (size_t)i * 4352 * 1024, 1024, n0, PIN(I_NORMW) + (2 * i) * 1024, zero);
            continue;
        }
        j -= 2176;
        if (j < 512) { const int i = j / 256, r = j % 256, nt = r / 16, kt = r % 16;
            tr_tile(cx, T, PIN(I_WOUTE) + (size_t)i * 1024 * 1024, 1024, nt * 64, kt * 64, (bf16_t*)(PWS + WS_WOUTE) + (size_t)i * 1024 * 1024, 1024, nt * 64, nullptr, false); continue; }
        j -= 512;
        if (j < 1280) { const int i = j / 640, r = j % 640, nt = r / 16, kt = r % 16;
            tr_tile(cx, T, PIN(I_WINO) + (size_t)i * 1024 * 2560, 2560, nt * 64, kt * 64, (bf16_t*)(PWS + WS_WINO) + (size_t)i * 2560 * 1024, 1024, nt * 64, PIN(I_NORMW) + (2 * i + 1) * 1024, false); continue; }
        j -= 1280;
        if (j < 512) { const int i = j / 256, r = j % 256, nt = r / 16, kt = r % 16;
            tr_tile(cx, T, PIN(I_WOUTO) + (size_t)i * 1024 * 1024, 1024, nt * 64, kt * 64, (bf16_t*)(PWS + WS_WOUTO) + (size_t)i * 1024 * 1024, 1024, nt * 64, nullptr, false); continue; }
        j -= 512;
        if (j < 16) { const int i = j / 8, nt = j % 8;
            tr_tile(cx, T, PIN(I_W2) + (size_t)i * 64 * 512, 512, nt * 64, 0, (bf16_t*)(PWS + WS_W2T) + (size_t)i * 512 * 64, 64, nt * 64, nullptr, false); continue; }
        j -= 16;
        if (j < 16) { const int i = j / 8, nt = j % 8;
            tr_tile(cx, T, PIN(I_A2) + (size_t)i * 64 * 512, 512, nt * 64, 0, (bf16_t*)(PWS + WS_A2T) + (size_t)i * 512 * 64, 64, nt * 64, nullptr, false); continue; }
        j -= 16;
        { const int ig = j / 4, r = j % 4, nt = r / 2, kt = r % 2;
            tr_tile(cx, T, PIN(I_POOLW) + (size_t)ig * 128 * 128, 128, nt * 64, kt * 64, (bf16_t*)(PWS + WS_POOLWT) + (size_t)ig * 128 * 128, 128, nt * 64, nullptr, false); }
    }
    const int gtid = cx.bid * 512 + tid, gthreads = cx.nblk * 512;
    for (int e = gtid; e < 8 * 128 * 128; e += gthreads) {
        const int s = e & 127, t = (e >> 7) & 127;
        ((bf16_t*)(PWS + WS_SPW))[e] = (s <= t) ? (bf16_t)(cvt_pk_bf16(PIN(I_SPW)[e], 0.f) & 0xffffu) : (bf16_t)0;
    }
    const int wid = tid >> 6, lane = tid & 63;
    for (int row = cx.bid * 8 + wid; row < NTOK; row += cx.nblk * 8) {
        const float* src = row < NTP ? PIN(I_XP) + (size_t)row * 1024 : PIN(I_XS) + (size_t)(row - NTP) * 1024;
        bf16_t* dst = (bf16_t*)(PWS + WS_XB) + (size_t)row * 1024;
        float ss = 0.f;
#pragma unroll
        for (int i = 0; i < 4; ++i) { const f32x4 v = *(const f32x4*)(src + i * 256 + lane * 4); ss += dot4(v, v); st_bf4(dst + i * 256 + lane * 4, v); }
#pragma unroll
        for (int o = 32; o >= 1; o >>= 1) ss += __shfl_xor(ss, o);
        if (lane < 16) ((float*)(PWS + WS_SSQ))[(size_t)row * 16 + lane] = (lane == 0) ? ss : 0.f;
    }
}

__device__ __forceinline__ f32x4 shift4(const bf16_t* cur, bool hp, const float* st, int col, const float* mu) {
    const f32x4 q = ld_bf4(cur + col);
    f32x4 pv;
    if (hp) pv = ld_bf4(cur - LDB + col); else if (st) pv = *(const f32x4*)(st + col); else pv = (f32x4){0.f, 0.f, 0.f, 0.f};
    const f32x4 m = *(const f32x4*)(mu + col);
    return q + m * (pv - q);
}

__device__ void phase_even_prep(const Params& p, const Ctx cx, int pair) {
    const int tid = cx.tid, wid = tid >> 6, lane = tid & 63, fr = lane & 15, fq = lane >> 4;
    const bf16_t* PB = (const bf16_t*)(PWS + WS_PROJB);
    float* Wdec = (float*)(PWS + WS_WDEC);
    bf16_t* Aa = (bf16_t*)(PWS + WS_AA);
    bf16_t* Ycat = (bf16_t*)(PWS + WS_YCAT);
    const float* mu = PIN(I_MU) + pair * 1664;
    const bf16_t* W2T = (const bf16_t*)(PWS + WS_W2T) + (size_t)pair * 512 * 64;
    const bf16_t* A2T = (const bf16_t*)(PWS + WS_A2T) + (size_t)pair * 512 * 64;
    const float* w0 = PIN(I_W0) + pair * 512; const float* a0 = PIN(I_A0) + pair * 512;
    const float* k_a = PIN(I_KA) + pair * 512; const float* r_k = PIN(I_RK) + pair * 512;
    for (int unit = cx.bid * 8 + wid; unit < (NTOK / 16) * 8; unit += cx.nblk * 8) {
        const int row = (unit >> 3) * 16 + fr, h = unit & 7;
        const bool samp = row >= NTP;
        int b, t; if (!samp) { b = row >> 11; t = row & 2047; } else { const int q = row - NTP; b = q >> 3; t = q & 7; }
        const bf16_t* cur = PB + (size_t)row * LDB;
        const bool hp = t > 0;
        const float* st = samp ? PIN(I_SSHIFT) + ((size_t)pair * 128 + b) * 1664 : nullptr;
        bf16x8 Aw[2], Al[2];
#pragma unroll
        for (int ks = 0; ks < 2; ++ks) {
            const int cw = 1536 + ks * 32 + fq * 8, ca = 1600 + ks * 32 + fq * 8;
            const f32x4 w_lo = shift4(cur, hp, st, cw, mu), w_hi = shift4(cur, hp, st, cw + 4, mu);
            const f32x4 a_lo = shift4(cur, hp, st, ca, mu), a_hi = shift4(cur, hp, st, ca + 4, mu);
            u32x4 pw, pa;
            float th[8];
#pragma unroll
            for (int j = 0; j < 4; ++j) { th[j] = 2.0f * sigmoidf_(2.0f * w_lo[j]) - 1.0f; th[4 + j] = 2.0f * sigmoidf_(2.0f * w_hi[j]) - 1.0f; }
            pw.x = cvt_pk_bf16(th[0], th[1]); pw.y = cvt_pk_bf16(th[2], th[3]); pw.z = cvt_pk_bf16(th[4], th[5]); pw.w = cvt_pk_bf16(th[6], th[7]);
            pa.x = cvt_pk_bf16(a_lo[0], a_lo[1]); pa.y = cvt_pk_bf16(a_lo[2], a_lo[3]); pa.z = cvt_pk_bf16(a_hi[0], a_hi[1]); pa.w = cvt_pk_bf16(a_hi[2], a_hi[3]);
            Aw[ks] = __builtin_bit_cast(bf16x8, pw); Al[ks] = __builtin_bit_cast(bf16x8, pa);
        }
        float bon = 0.f;
#pragma unroll 2
        for (int nt = 0; nt < 4; ++nt) {
            const int n0 = h * 64 + nt * 16;
            f32x4 lw = (f32x4){0.f, 0.f, 0.f, 0.f}, la = (f32x4){0.f, 0.f, 0.f, 0.f};
#pragma unroll
            for (int ks = 0; ks < 2; ++ks) {
                const bf16x8 wf = *(const bf16x8*)(W2T + (size_t)(n0 + fr) * 64 + ks * 32 + fq * 8);
                const bf16x8 af = *(const bf16x8*)(A2T + (size_t)(n0 + fr) * 64 + ks * 32 + fq * 8);
                lw = __builtin_amdgcn_mfma_f32_16x16x32_bf16(wf, Aw[ks], lw, 0, 0, 0);
                la = __builtin_amdgcn_mfma_f32_16x16x32_bf16(af, Al[ks], la, 0, 0, 0);
            }
            const int ch = n0 + fq * 4;
            const f32x4 r4 = shift4(cur, hp, st, ch, mu), k4 = shift4(cur, hp, st, 512 + ch, mu);
            const f32x4 w04 = *(const f32x4*)(w0 + ch), a04 = *(const f32x4*)(a0 + ch), ka4 = *(const f32x4*)(k_a + ch), rk4 = *(const f32x4*)(r_k + ch);
            f32x4 dec, av;
#pragma unroll
            for (int j = 0; j < 4; ++j) {
                const float z_ = -(w04[j] + lw[j]);
                const float wlog = -__logf(1.0f + __expf(z_)) - 0.5f;
                dec[j] = __expf(-__expf(wlog));
                av[j] = sigmoidf_(a04[j] + la[j]);
                const float kp = k4[j] * (1.0f + (av[j] - 1.0f) * ka4[j]);
                bon += r4[j] * kp * rk4[j];
            }
            *(f32x4*)(Wdec + (size_t)row * 512 + ch) = dec;
            st_bf4(Aa + (size_t)row * 512 + ch, av);
        }
        bon += __shfl_xor(bon, 16); bon += __shfl_xor(bon, 32);
#pragma unroll
        for (int nt = 0; nt < 4; ++nt) { const int ch = h * 64 + nt * 16 + fq * 4; st_bf4(Ycat + (size_t)row * 1024 + 512 + ch, shift4(cur, hp, st, 1024 + ch, mu) * bon); }
    }
    const int gtid = cx.bid * 512 + tid, gthreads = cx.nblk * 512;
    for (int e = gtid; e < 136 * 1664; e += gthreads) {
        const int sr = e / 1664, c = e % 1664;
        if (sr < 8) POUT[O_SHIFTP + ((size_t)pair * 8 + sr) * 1664 + c] = bf2f(PB[(size_t)(sr * 2048 + 2047) * LDB + c]);
        else { const int b = sr - 8; POUT[O_SHIFTS + ((size_t)pair * 128 + b) * 1664 + c] = bf2f(PB[(size_t)(NTP + b * 8 + 7) * LDB + c]); }
    }
}

__device__ __forceinline__ void scan_step(f32x4& S, const f32x4 w, const f32x4 k, const f32x4 kk, const f32x4 bb, const f32x4 r, const float v, float& y) {
    float pd = dot4(S, kk);
    const f32x4 tmp = S * w + k * v;
    pd = allsum16(pd);
    S = tmp - bb * pd;
    y = allsum16(dot4(S, r));
}

__device__ void phase_scan(const Params& p, const Ctx cx, int pair, LAS unsigned char* lds) {
    const int tid = cx.tid, wid = tid >> 6, lane = tid & 63, rs = lane >> 4, cgi = lane & 15;
    const bf16_t* PB = (const bf16_t*)(PWS + WS_PROJB);
    const float* Wdec = (const float*)(PWS + WS_WDEC);
    const bf16_t* Aa = (const bf16_t*)(PWS + WS_AA);
    float* Y = (float*)(PWS + WS_Y);
    const float* mu = PIN(I_MU) + pair * 1664;
    const float* k_k = PIN(I_KK) + pair * 512; const float* k_a = PIN(I_KA) + pair * 512;
    {
        LAS float* vb = (LAS float*)lds + wid * 3072;
        for (int st = cx.bid * 8 + wid; st < 2048; st += cx.nblk * 8) {
            const int bh = st >> 1, half = st & 1, b = bh >> 3, h = bh & 7, ch = h * 64 + cgi * 4;
            const float* stp = PIN(I_SSHIFT) + ((size_t)pair * 128 + b) * 1664;
            const f32x4 kkc = *(const f32x4*)(k_k + ch), kac = *(const f32x4*)(k_a + ch);
            {
#pragma unroll
                for (int tt = 0; tt < 2; ++tt) {
                    const int t = rs + tt * 4;
                    const size_t row = NTP + b * 8 + t;
                    const bf16_t* cur = PB + row * LDB;
                    const f32x4 r = shift4(cur, t > 0, stp, ch, mu), k = shift4(cur, t > 0, stp, 512 + ch, mu), v = shift4(cur, t > 0, stp, 1024 + ch, mu);
                    const f32x4 a = ld_bf4(Aa + row * 512 + ch);
                    const f32x4 w = *(const f32x4*)(Wdec + row * 512 + ch);
                    const f32x4 kkv = k * kkc;
                    const float ss = allsum16(dot4(kkv, kkv));
                    const float inv = 1.0f / fmaxf(sqrtf(ss), 1e-12f);
                    const f32x4 kkn = kkv * inv;
                    LAS float* o = vb + t * 384 + cgi * 4;
                    *(LAS f32x4*)(o) = w; *(LAS f32x4*)(o + 64) = k * (1.0f + (a - 1.0f) * kac); *(LAS f32x4*)(o + 128) = kkn; *(LAS f32x4*)(o + 192) = kkn * a;
                    *(LAS f32x4*)(o + 256) = r; *(LAS f32x4*)(o + 320) = v;
                }
            }
            asm volatile("s_waitcnt lgkmcnt(0)" ::: "memory");
            __builtin_amdgcn_wave_barrier();
#pragma unroll 1
            for (int rq = 0; rq < 8; ++rq) {
                const int ri = half * 32 + rq * 4 + rs;
                const size_t so = ((((size_t)pair * 128 + b) * 8 + h) * 64 + ri) * 64 + cgi * 4;
                f32x4 S = *(const f32x4*)(PIN(I_SWKV) + so);
#pragma unroll
                for (int t = 0; t < 8; ++t) {
                    LAS const float* r0 = vb + t * 384 + cgi * 4;
                    float y; scan_step(S, *(LAS const f32x4*)(r0), *(LAS const f32x4*)(r0 + 64), *(LAS const f32x4*)(r0 + 128), *(LAS const f32x4*)(r0 + 192), *(LAS const f32x4*)(r0 + 256), vb[t * 384 + 320 + ri], y);
                    if (cgi == 0) Y[(size_t)(NTP + b * 8 + t) * 512 + h * 64 + ri] = y;
                }
                *(f32x4*)(POUT + O_WKVS + so) = S;
            }
            asm volatile("s_waitcnt lgkmcnt(0)" ::: "memory");
            __builtin_amdgcn_wave_barrier();
        }
    }
    __syncthreads();
    LAS float* rec = (LAS float*)lds;
    for (int pt = cx.bid; pt < 256; pt += cx.nblk) {
        const int xcd = pt & 7, slot = pt >> 3, bh = xcd * 8 + (slot >> 2), rg = slot & 3, b = bh >> 3, h = bh & 7;
        const int lt = tid - 256, ls = (lt >> 4) & 15, lcg = lt & 15, lch = h * 64 + lcg * 4;
        u32x2 qr = {0u, 0u}, qk = {0u, 0u}, qv = {0u, 0u}, pr = {0u, 0u}, pk = {0u, 0u}, pv = {0u, 0u}, qa = {0u, 0u};
        f32x4 qw = (f32x4){0.f, 0.f, 0.f, 0.f};
        f32x4 mur, muk, muv, kkc, kac;
        const int ri = rg * 16 + (wid & 3) * 4 + rs;
        f32x4 S = (f32x4){0.f, 0.f, 0.f, 0.f};
#define SCAN_ISSUE(c) do { const int t_ = (c) * 16 + ls; const size_t row_ = (size_t)b * 2048 + t_; const bf16_t* cur_ = PB + row_ * LDB; \
            qr = *(const u32x2*)(cur_ + lch); qk = *(const u32x2*)(cur_ + 512 + lch); qv = *(const u32x2*)(cur_ + 1024 + lch); \
            if (t_ > 0) { pr = *(const u32x2*)(cur_ - LDB + lch); pk = *(const u32x2*)(cur_ - LDB + 512 + lch); pv = *(const u32x2*)(cur_ - LDB + 1024 + lch); } \
            else { pr = (u32x2){0u, 0u}; pk = pr; pv = pr; } \
            qw = *(const f32x4*)(Wdec + row_ * 512 + lch); qa = *(const u32x2*)(Aa + row_ * 512 + lch); } while (0)
#define SCAN_PROCESS(buf) do { const f32x4 r0_ = cvt4(qr), k0_ = cvt4(qk), v0_ = cvt4(qv); \
            const f32x4 r_ = r0_ + mur * (cvt4(pr) - r0_), k_ = k0_ + muk * (cvt4(pk) - k0_), v_ = v0_ + muv * (cvt4(pv) - v0_), a_ = cvt4(qa); \
            const f32x4 kkv_ = k_ * kkc; const float ss_ = allsum16(dot4(kkv_, kkv_)); const float inv_ = 1.0f / fmaxf(sqrtf(ss_), 1e-12f); \
            const f32x4 kkn_ = kkv_ * inv_; \
            LAS float* o_ = rec + (buf) * 6144 + ls * 384 + lcg * 4; \
            *(LAS f32x4*)(o_) = qw; *(LAS f32x4*)(o_ + 64) = k_ * (1.0f + (a_ - 1.0f) * kac); *(LAS f32x4*)(o_ + 128) = kkn_; *(LAS f32x4*)(o_ + 192) = kkn_ * a_; \
            *(LAS f32x4*)(o_ + 256) = r_; *(LAS f32x4*)(o_ + 320) = v_; } while (0)
        if (wid >= 4) {
            mur = *(const f32x4*)(mu + lch); muk = *(const f32x4*)(mu + 512 + lch); muv = *(const f32x4*)(mu + 1024 + lch);
            kkc = *(const f32x4*)(k_k + lch); kac = *(const f32x4*)(k_a + lch);
            SCAN_ISSUE(0); SCAN_PROCESS(0); SCAN_ISSUE(1);
        }
        __syncthreads();
        for (int c = 0; c < 128; ++c) {
            if (wid < 4) {
                LAS const float* rb = rec + (c & 1) * 6144 + cgi * 4;
                LAS const float* rv = rec + (c & 1) * 6144 + 320 + ri;
                float ykeep = 0.f;
                f32x4 nw = *(LAS const f32x4*)(rb), nk = *(LAS const f32x4*)(rb + 64), nkk = *(LAS const f32x4*)(rb + 128), nb = *(LAS const f32x4*)(rb + 192), nr = *(LAS const f32x4*)(rb + 256);
                float nv = rv[0];
#pragma unroll
                for (int s = 0; s < 16; ++s) {
                    const f32x4 cw = nw, ck = nk, ckk = nkk, cb = nb, cr = nr; const float cv = nv;
                    if (s + 1 < 16) {
                        LAS const float* r1 = rb + (s + 1) * 384;
                        nw = *(LAS const f32x4*)(r1); nk = *(LAS const f32x4*)(r1 + 64); nkk = *(LAS const f32x4*)(r1 + 128); nb = *(LAS const f32x4*)(r1 + 192); nr = *(LAS const f32x4*)(r1 + 256);
                        nv = rv[(s + 1) * 384];
                    }
                    float y;
                    scan_step(S, cw, ck, ckk, cb, cr, cv, y);
                    ykeep = (cgi == s) ? y : ykeep;
                }
                Y[((size_t)b * 2048 + c * 16 + cgi) * 512 + h * 64 + ri] = ykeep;
            } else {
                if (c + 1 < 128) { SCAN_PROCESS((c + 1) & 1); if (c + 2 < 128) SCAN_ISSUE(c + 2); }
            }
            __syncthreads();
        }
        if (wid < 4) *(f32x4*)(POUT + O_WKVP + ((((size_t)pair * 8 + b) * 8 + h) * 64 + ri) * 64 + cgi * 4) = S;
#undef SCAN_ISSUE
#undef SCAN_PROCESS
    }
}

__device__ void phase_even_post(const Params& p, const Ctx cx, int pair) {
    const int gtid = cx.bid * 512 + cx.tid, gthreads = cx.nblk * 512;
    const bf16_t* PA = (const bf16_t*)(PWS + WS_R1);
    bf16_t* Ycat = (bf16_t*)(PWS + WS_YCAT);
    const float* Y = (const float*)(PWS + WS_Y);
    constexpr int NIT = NTOK * 128, UB = 4;
    const float* gn_g = PIN(I_GNG) + pair * 512; const float* gn_b = PIN(I_GNB) + pair * 512;
    for (int e0 = gtid; e0 < NIT; e0 += gthreads * UB) {
        f32x4 y[UB], bv[UB], bz[UB]; bool ok[UB];
#pragma unroll
        for (int u = 0; u < UB; ++u) {
            const int e = e0 + u * gthreads; ok[u] = e < NIT;
            const int ee = ok[u] ? e : e0; const int row = ee >> 7, ch = (ee & 127) * 4;
            y[u] = *(const f32x4*)(Y + (size_t)row * 512 + ch);
            bv[u] = ld_bf4(Ycat + (size_t)row * 1024 + 512 + ch);
            bz[u] = ld_bf4(PA + (size_t)row * LDA + 2048 + ch);
        }
#pragma unroll
        for (int u = 0; u < UB; ++u) {
            const int e = e0 + u * gthreads;
            const int ee = ok[u] ? e : e0; const int row = ee >> 7, ch = (ee & 127) * 4;
            const float mean = allsum16(y[u][0] + y[u][1] + y[u][2] + y[u][3]) * (1.0f / 64.0f);
            const f32x4 d = y[u] - mean;
            const float var = allsum16(dot4(d, d)) * (1.0f / 64.0f);
            const float rstd = rsqrtf(var + 64e-5f);
            const f32x4 g = *(const f32x4*)(gn_g + ch), bb = *(const f32x4*)(gn_b + ch);
            f32x4 o;
#pragma unroll
            for (int j = 0; j < 4; ++j) o[j] = (d[j] * rstd * g[j] + bb[j] + bv[u][j]) * siluf_(bz[u][j]);
            if (ok[u]) st_bf4(Ycat + (size_t)row * 1024 + 512 + ch, o);
        }
    }
    const float* cw = PIN(I_CONVW) + pair * 3 * 512;
    for (int e0 = gtid; e0 < NIT; e0 += gthreads * UB) {
        f32x4 h0[UB], c0v[UB], h1[UB], c1v[UB], h2[UB], c2v[UB], ab[UB], az[UB]; bool ok[UB];
#pragma unroll
        for (int u = 0; u < UB; ++u) {
            const int e = e0 + u * gthreads; ok[u] = e < NIT;
            const int ee = ok[u] ? e : e0; const int row = ee >> 7, ch = (ee & 127) * 4;
            const int t = row < NTP ? (row & 2047) : ((row - NTP) & 7);
            const bf16_t* cur = PA + (size_t)row * LDA + ch;
            const bf16_t* p1 = t >= 1 ? cur - LDA : cur; const bf16_t* p2 = t >= 2 ? cur - 2 * LDA : cur;
            h0[u] = ld_bf4(cur); c0v[u] = ld_bf4(cur + 1024); h1[u] = ld_bf4(p1); c1v[u] = ld_bf4(p1 + 1024); h2[u] = ld_bf4(p2); c2v[u] = ld_bf4(p2 + 1024);
            ab[u] = ld_bf4(cur + 512); az[u] = ld_bf4(cur + 1536);
        }
#pragma unroll
        for (int u = 0; u < UB; ++u) {
            const int e = e0 + u * gthreads;
            const int ee = ok[u] ? e : e0; const int row = ee >> 7, ch = (ee & 127) * 4;
            const bool samp = row >= NTP;
            int b, t, T; if (!samp) { b = row >> 11; t = row & 2047; T = 2048; } else { const int q = row - NTP; b = q >> 3; t = q & 7; T = 8; }
            const f32x4 u0 = c0v[u] * h0[u];
            f32x4 u1 = c1v[u] * h1[u], u2 = c2v[u] * h2[u];
            if (t < 2) {
                const f32x4 zero = (f32x4){0.f, 0.f, 0.f, 0.f};
                const float* hist = PIN(I_SCONV) + ((size_t)pair * 128 + (samp ? b : 0)) * 2 * 512 + ch;
                if (t == 0) { u1 = samp ? *(const f32x4*)(hist + 512) : zero; u2 = samp ? *(const f32x4*)(hist) : zero; }
                else { u2 = samp ? *(const f32x4*)(hist + 512) : zero; }
            }
            const f32x4 k0 = *(const f32x4*)(cw + ch), k1 = *(const f32x4*)(cw + 512 + ch), k2 = *(const f32x4*)(cw + 1024 + ch);
            const f32x4 conv = k0 * u2 + k1 * u1 + k2 * u0;
            f32x4 o;
#pragma unroll
            for (int j = 0; j < 4; ++j) o[j] = ab[u][j] * conv[j] * siluf_(az[u][j]);
            if (ok[u]) {
                st_bf4(Ycat + (size_t)row * 1024 + ch, o);
                if (t >= T - 2) {
                    float* dst = samp ? POUT + O_CONVS + (((size_t)pair * 128 + b) * 2 + (t - (T - 2))) * 512 + ch : POUT + O_CONVP + (((size_t)pair * 8 + b) * 2 + (t - (T - 2))) * 512 + ch;
                    *(f32x4*)dst = u0;
                }
            }
        }
    }
}

__device__ void phase_odd_mixer(const Params& p, const Ctx cx, int pair, LAS unsigned char* lds) {
    const int tid = cx.tid, wid = tid >> 6, lane = tid & 63, fr = lane & 15, fq = lane >> 4;
    const bf16_t* PO = (const bf16_t*)(PWS + WS_R1);
    bf16_t* Ycat = (bf16_t*)(PWS + WS_YCAT);
    LAS bf16_t* LA = (LAS bf16_t*)lds;
    LAS bf16_t* LB = (LAS bf16_t*)(lds + 128 * 136 * 2);
    LAS float* stat = (LAS float*)(lds + 2 * 128 * 136 * 2);
    LAS float* LE = (LAS float*)(lds + 128 * 136 * 2);
    for (int round = 0; round < 8; ++round) {
        int it;
        if (cx.nblk == 256) {
            if (round == 0) it = cx.bid < 136 ? cx.bid : 136 + 136 + (cx.bid - 136);
            else if (round == 1) it = cx.bid < 136 ? 136 + cx.bid : 136 + 136 + 120 + (cx.bid - 136);
            else if (cx.bid >= 136) it = 136 + 136 + 120 * round + (cx.bid - 136);
            else it = 1 << 20;
        } else it = cx.bid + round * cx.nblk;
        if (it >= 680) { if (cx.nblk == 256 ? round >= 4 : true) break; else continue; }
        if (it >= 136) {
            const int ci = it - 136, tile = ci >> 2, g = ci & 3, r0 = tile * 128;
            const bool samp = r0 >= NTP;
            const int w = 2 << g;
            if (!samp) {
                const int t0 = r0 & 2047;
                for (int e = tid; e < 143 * 32; e += 512) {
                    const int er = e >> 5, c = (e & 31) * 4;
                    f32x4 v = (f32x4){0.f, 0.f, 0.f, 0.f};
                    if (t0 + er - 15 >= 0) v = ld_bf4(PO + (size_t)(r0 + er - 15) * LDA + g * 128 + c);
                    *(LAS f32x4*)(LE + er * 128 + c) = v;
                }
                __syncthreads();
                for (int e = tid; e < 128 * 32; e += 512) {
                    const int tl = e >> 5, c = (e & 31) * 4;
                    const f32x4 pt = *(LAS const f32x4*)(LE + (tl + 15) * 128 + c);
                    f32x4 sum = pt;
                    for (int d = 1; d < w; ++d) sum += *(LAS const f32x4*)(LE + (tl + 15 - d) * 128 + c);
                    const float cnt = fminf((float)w, (float)(t0 + tl + 1));
                    const f32x4 pooled = sum * (1.0f / cnt) - pt;
                    u32x2 u; u.x = cvt_pk_bf16(pooled[0], pooled[1]); u.y = cvt_pk_bf16(pooled[2], pooled[3]);
                    *(LAS u32x2*)(LA + tl * 136 + c) = u;
                }
            } else {
                for (int e = tid; e < 128 * 32; e += 512) {
                    const int tl = e >> 5, c = (e & 31) * 4, row = r0 + tl;
                    const int q = row - NTP, b = q >> 3, t = q & 7;
                    const bf16_t* cur = PO + (size_t)row * LDA + g * 128 + c;
                    const f32x4 pt = ld_bf4(cur);
                    f32x4 sum = pt;
                    for (int d = 1; d < w; ++d) {
                        const int tt = t - d;
                        if (tt >= 0) sum += ld_bf4(cur - (size_t)d * LDA);
                        else sum += *(const f32x4*)(PIN(I_SPOOL) + (((size_t)pair * 128 + b) * 15 + (15 + tt)) * 512 + g * 128 + c);
                    }
                    const f32x4 pooled = sum * (1.0f / (float)w) - pt;
                    u32x2 u; u.x = cvt_pk_bf16(pooled[0], pooled[1]); u.y = cvt_pk_bf16(pooled[2], pooled[3]);
                    *(LAS u32x2*)(LA + tl * 136 + c) = u;
                }
            }
            __syncthreads();
            const bf16_t* Bw = (const bf16_t*)(PWS + WS_POOLWT) + ((size_t)pair * 4 + g) * 128 * 128;
            const int row = r0 + wid * 16 + fr;
            bf16x8 af[4];
#pragma unroll
            for (int ks = 0; ks < 4; ++ks) af[ks] = *(const LAS bf16x8*)(LA + (wid * 16 + fr) * 136 + ks * 32 + fq * 8);
#pragma unroll
            for (int nt = 0; nt < 8; ++nt) {
                f32x4 acc = (f32x4){0.f, 0.f, 0.f, 0.f};
#pragma unroll
                for (int ks = 0; ks < 4; ++ks) {
                    const bf16x8 bf = *(const bf16x8*)(Bw + (size_t)(nt * 16 + fr) * 128 + ks * 32 + fq * 8);
                    acc = __builtin_amdgcn_mfma_f32_16x16x32_bf16(bf, af[ks], acc, 0, 0, 0);
                }
                const int d = g * 128 + nt * 16 + fq * 4;
                const f32x4 cz = ld_bf4(PO + (size_t)row * LDA + 512 + d), ps = *(const f32x4*)(PIN(I_PSCALE) + pair * 512 + d);
                f32x4 o;
#pragma unroll
                for (int j = 0; j < 4; ++j) o[j] = acc[j] * ps[j] * siluf_(cz[j]);
                st_bf4(Ycat + (size_t)row * 1024 + d, o);
            }
            __syncthreads();
        } else {
            const int tile = it, r0 = tile * 128;
            const bool samp = r0 >= NTP;
            {
                const int tl = tid >> 2, q = tid & 3;
                const bf16_t* vr = PO + (size_t)(r0 + tl) * LDA + 1536 + q * 128;
                float s_ = 0.f, ss = 0.f;
#pragma unroll
                for (int i = 0; i < 16; ++i) { const u32x4 raw = *(const u32x4*)(vr + i * 8); const f32x4 v0 = cvt4((u32x2){raw.x, raw.y}), v1 = cvt4((u32x2){raw.z, raw.w});
                    s_ += (v0[0] + v0[1]) + (v0[2] + v0[3]) + (v1[0] + v1[1]) + (v1[2] + v1[3]); ss += dot4(v0, v0) + dot4(v1, v1); }
                s_ = allsum4(s_); ss = allsum4(ss);
                const float mean = s_ * (1.0f / 512.0f);
                const float var = fmaxf(ss * (1.0f / 512.0f) - mean * mean, 0.f);
                if (q == 0) { stat[tl * 2] = mean; stat[tl * 2 + 1] = rsqrtf(var + 1e-5f); }
            }
            __syncthreads();
#pragma unroll 1
            for (int g = 0; g < 4; ++g) {
                {
                    const int tl = tid >> 2, q = tid & 3, row = r0 + tl;
                    const float mean = stat[tl * 2], rstd = stat[tl * 2 + 1];
                    const bf16_t* vr = PO + (size_t)row * LDA + 1536 + g * 128 + q * 32;
                    const float* lg = PIN(I_LNG) + pair * 512 + g * 128 + q * 32; const float* lb = PIN(I_LNB) + pair * 512 + g * 128 + q * 32;
#pragma unroll
                    for (int i = 0; i < 8; ++i) {
                        const f32x4 v = ld_bf4(vr + i * 4);
                        const f32x4 vn = (v - mean) * rstd * *(const f32x4*)(lg + i * 4) + *(const f32x4*)(lb + i * 4);
                        if (samp) *(f32x4*)(POUT + O_CHUNKV + ((size_t)pair * 1024 + (row - NTP)) * 512 + g * 128 + q * 32 + i * 4) = vn;
#pragma unroll
                        for (int j = 0; j < 4; ++j) LB[(q * 32 + i * 4 + j) * 136 + tl] = (bf16_t)(cvt_pk_bf16(vn[j], 0.f) & 0xffffu);
                    }
                }
                if (!samp) {
                    const bf16_t* Wsrc = (const bf16_t*)(PWS + WS_SPW) + ((size_t)pair * 4 + g) * 128 * 128;
                    for (int e = tid; e < 128 * 16; e += 512) { const int t = e >> 4, s8 = (e & 15) * 8; *(LAS u32x4*)(LA + t * 136 + s8) = *(const u32x4*)(Wsrc + t * 128 + s8); }
                } else {
                    const float* Wsrc = PIN(I_SPW) + ((size_t)pair * 4 + g) * 128 * 128;
                    for (int e = tid; e < 128 * 128; e += 512) { const int t = e >> 7, s2 = e & 127;
                        const float v = ((t >> 3) == (s2 >> 3) && (s2 & 7) <= (t & 7)) ? Wsrc[(t & 7) * 128 + (s2 & 7)] : 0.f;
                        LA[t * 136 + s2] = (bf16_t)(cvt_pk_bf16(v, 0.f) & 0xffffu); }
                }
                __syncthreads();
                {
                    const int tl = wid * 16 + fr, row = r0 + tl;
                    const float bias = PIN(I_SPB)[((size_t)pair * 4 + g) * 128 + (samp ? (tl & 7) : tl)];
                    bf16x8 wf[4];
#pragma unroll
                    for (int ks = 0; ks < 4; ++ks) wf[ks] = *(const LAS bf16x8*)(LA + tl * 136 + ks * 32 + fq * 8);
#pragma unroll
                    for (int nt = 0; nt < 8; ++nt) {
                        f32x4 acc = (f32x4){0.f, 0.f, 0.f, 0.f};
#pragma unroll
                        for (int ks = 0; ks < 4; ++ks) {
                            if (ks * 32 <= wid * 16 + 15) {
                                const bf16x8 vf = *(const LAS bf16x8*)(LB + (nt * 16 + fr) * 136 + ks * 32 + fq * 8);
                                acc = __builtin_amdgcn_mfma_f32_16x16x32_bf16(vf, wf[ks], acc, 0, 0, 0);
                            }
                        }
                        const int c = g * 128 + nt * 16 + fq * 4;
                        const f32x4 u = ld_bf4(PO + (size_t)row * LDA + 1024 + c), dz = ld_bf4(PO + (size_t)row * LDA + 2048 + c);
                        f32x4 o;
#pragma unroll
                        for (int j = 0; j < 4; ++j) o[j] = u[j] * (acc[j] + bias) * siluf_(dz[j]);
                        st_bf4(Ycat + (size_t)row * 1024 + 512 + c, o);
                    }
                }
                __syncthreads();
            }
        }
    }
    const int gtid = cx.bid * 512 + tid, gthreads = cx.nblk * 512;
    for (int e = gtid; e < 136 * 15 * 512; e += gthreads) {
        const int c = e & 511, q = e >> 9, sr = q / 15, k = q % 15;
        if (sr < 8) POUT[O_POOLP + (((size_t)pair * 8 + sr) * 15 + k) * 512 + c] = bf2f(PO[(size_t)(sr * 2048 + 2033 + k) * LDA + c]);
        else { const int b = sr - 8;
            POUT[O_POOLS + (((size_t)pair * 128 + b) * 15 + k) * 512 + c] = (k < 7) ? PIN(I_SPOOL)[(((size_t)pair * 128 + b) * 15 + 8 + k) * 512 + c] : bf2f(PO[(size_t)(NTP + b * 8 + (k - 7)) * LDA + c]); }
    }
}

__device__ void phase_final(const Params& p, const Ctx cx) {
    const int gtid = cx.bid * 512 + cx.tid, gthreads = cx.nblk * 512;
    const float* ssq = (const float*)(PWS + WS_SSQ) + (size_t)4 * NTOK * 16;
    const bf16_t* Xb = (const bf16_t*)(PWS + WS_XB);
    constexpr int NIT = NTOK * 256, UB = 4;
    for (int e0 = gtid; e0 < NIT; e0 += gthreads * UB) {
        f32x4 x[UB]; float sq[UB]; bool ok[UB];
#pragma unroll
        for (int u = 0; u < UB; ++u) { const int e = e0 + u * gthreads; ok[u] = e < NIT; const int ee = ok[u] ? e : e0; const int row = ee >> 8, c = (ee & 255) * 4;
            x[u] = ld_bf4(Xb + (size_t)row * 1024 + c); sq[u] = ssq_sum(ssq + (size_t)row * 16); }
#pragma unroll
        for (int u = 0; u < UB; ++u) { const int e = e0 + u * gthreads; const int ee = ok[u] ? e : e0; const int row = ee >> 8, c = (ee & 255) * 4;
            const float rstd = rsqrtf(sq[u] * (1.0f / 1024.0f) + 1e-6f);
            if (ok[u]) *(f32x4*)(POUT + (size_t)row * 1024 + c) = x[u] * rstd * *(const f32x4*)(PIN(I_FNORMW) + c); }
    }
}

#define XB_TMO      128
#define XB_XCNT(j)  (256  + 64 * (j))
#define XB_XSUB(j)  (1280 + 64 * (j))
#define XB_XGEN(j)  (2304 + 64 * (j))
#define XB_TOP      3328
#define XB_TOPGEN   3392
#define XCD_BAR_WORDS 3456
#define XB_SPIN_CAP (1u << 18)
__device__ __forceinline__ unsigned xb_ld(unsigned* p)              { return __hip_atomic_load(p, __ATOMIC_RELAXED, __HIP_MEMORY_SCOPE_AGENT); }
__device__ __forceinline__ unsigned xb_add(unsigned* p, unsigned v) { return __hip_atomic_fetch_add(p, v, __ATOMIC_RELAXED, __HIP_MEMORY_SCOPE_AGENT); }
__device__ __forceinline__ unsigned xb_xcc_id() { return (unsigned)__builtin_amdgcn_s_getreg((3 << 11) | 20) & 0xFu; }
#define XB_SPIN(cond, bar) do { unsigned _sp = 0; while (cond) { __builtin_amdgcn_s_sleep(1); \
    if ((++_sp & 255u) == 0u) { if (xb_ld(&(bar)[XB_TMO])) break; if (_sp > XB_SPIN_CAP) { atomicAdd(&(bar)[XB_TMO], 1u); break; } } } } while (0)
struct XcdBarrier { unsigned* bar; unsigned x; volatile LAS unsigned* st; };
__device__ __forceinline__ XcdBarrier xcd_barrier_post(unsigned* bar, volatile LAS unsigned* st) {
    XcdBarrier b; b.bar = bar; b.x = xb_xcc_id(); b.st = st;
    if (threadIdx.x == 0) (void)xb_add(&bar[XB_XCNT(b.x)], 1u);
    return b;
}
__device__ __forceinline__ void xcd_barrier_complete(unsigned* bar, unsigned x, unsigned& nloc, unsigned& nx) {
    const unsigned G = gridDim.x * gridDim.y * gridDim.z;
    unsigned sum, cnt, mine, sp = 0u;
    for (;;) {
        sum = 0u; cnt = 0u; mine = 0u;
#pragma unroll
        for (unsigned j = 0; j < 16; ++j) { const unsigned c = xb_ld(&bar[XB_XCNT(j)]); sum += c; cnt += (c > 0u) ? 1u : 0u; mine = (j == x) ? c : mine; }
        if (sum == G) break;
        __builtin_amdgcn_s_sleep(1);
        if ((++sp & 255u) == 0u) { if (xb_ld(&bar[XB_TMO])) break; if (sp > XB_SPIN_CAP) { atomicAdd(&bar[XB_TMO], 1u); break; } }
    }
    nloc = mine > 0u ? mine : 1u; nx = cnt > 0u ? cnt : 1u;
}
__device__ __forceinline__ void xcd_barrier(const XcdBarrier& b) {
    asm volatile("s_waitcnt vmcnt(0)" ::: "memory");
    __syncthreads();
    if (threadIdx.x == 0) {
        unsigned* bar = b.bar;
        __builtin_amdgcn_s_waitcnt(0);
        unsigned nloc = b.st[0], nx = b.st[1];
        if (nloc == 0u) { xcd_barrier_complete(bar, b.x, nloc, nx); b.st[0] = nloc; b.st[1] = nx; }
        const unsigned old = xb_add(&bar[XB_XSUB(b.x)], 1u);
        const unsigned gen = old / nloc;
        if (old + 1u == (gen + 1u) * nloc) {
            __builtin_amdgcn_fence(__ATOMIC_RELEASE, "agent");
            asm volatile("s_waitcnt vmcnt(0)" ::: "memory");
            const unsigned og = xb_add(&bar[XB_TOP], 1u);
            const unsigned tg = og / nx;
            if (og + 1u == (tg + 1u) * nx) xb_add(&bar[XB_TOPGEN], 1u);
            else XB_SPIN(xb_ld(&bar[XB_TOPGEN]) == tg, bar);
            __builtin_amdgcn_fence(__ATOMIC_ACQUIRE, "agent");
            xb_add(&bar[XB_XGEN(b.x)], 1u);
            asm volatile("s_waitcnt vmcnt(0)" ::: "memory");
        } else {
            XB_SPIN(xb_ld(&bar[XB_XGEN(b.x)]) == gen, bar);
            __builtin_amdgcn_fence(__ATOMIC_ACQUIRE, "agent");
            asm volatile("s_waitcnt vmcnt(0)" ::: "memory");
        }
    }
    __syncthreads();
}

__device__ void run_gemm_proj(const Params& p, const Ctx cx, LAS unsigned char* lds, const bf16_t* Bt, int N, bf16_t* O, int ldc, int layer) {
    pg8::Gemm g{(const bf16_t*)(PWS + WS_XB), Bt, NTOK, N, 1024};
    pg8::StaticOrder S; S.init(NTOK, N, (int)cx.nblk, (int)cx.bid);
    EpiProj E{O, ldc, (const float*)(PWS + WS_SSQ) + (size_t)layer * NTOK * 16};
    pg8::gemm_phase<EpiProj>(cx, lds, g, S, E);
}
__device__ void run_gemm_res(const Params& p, const Ctx cx, LAS unsigned char* lds, const bf16_t* Bt, int layer) {
    pg8::Gemm g{(const bf16_t*)(PWS + WS_YCAT), Bt, NTOK, 1024, 1024};
    pg8::StaticOrder S; S.init(NTOK, 1024, (int)cx.nblk, (int)cx.bid);
    EpiRes E{layer == 0 ? PIN(I_XP) : nullptr, PIN(I_XS), (bf16_t*)(PWS + WS_XB), (float*)(PWS + WS_SSQ) + (size_t)(layer + 1) * NTOK * 16};
    pg8::gemm_phase<EpiRes>(cx, lds, g, S, E);
}

constexpr int N_PHASES = 20;
#ifndef PHMASK
#define PHMASK 0xffff
#endif
#define PHON(n) ((PHMASK >> ((n) % 16)) & 1)
__global__ void __launch_bounds__(512, 2) fwd_kernel(Params p) {
    extern __shared__ __attribute__((aligned(16))) unsigned char lds_raw[];
    LAS unsigned char* lds = (LAS unsigned char*)lds_raw;
    volatile LAS unsigned* bar_st = (volatile LAS unsigned*)(lds + 131072);
    if (threadIdx.x < 4) bar_st[threadIdx.x] = 0u;
    __syncthreads();
    const XcdBarrier gbar = xcd_barrier_post((unsigned*)((unsigned char*)p.ptr[30] + WS_BAR), bar_st);
    if (p.ph_hi < 0) cg::this_grid().sync();
#define GRID_SYNC() xcd_barrier(gbar)
#ifdef SYNCPROBE
    for (int i = 0; i < SYNCPROBE; ++i) GRID_SYNC();
#endif
#ifdef REPMASK
    for (int pc = p.ph_lo * 2; pc < p.ph_hi * 2; ++pc) {
        const int ph = pc >> 1;
        { const int s_ = (ph == 0) ? 9 : (ph == N_PHASES - 1) ? 31 : (ph - 1) % 9; if ((pc & 1) && !((REPMASK >> s_) & 1)) continue; }
        if (pc > p.ph_lo * 2) GRID_SYNC();
#else
    for (int ph = p.ph_lo; ph < p.ph_hi; ++ph) {
        if (ph > p.ph_lo) GRID_SYNC();
#endif
        Ctx cx; cx.tid = threadIdx.x; cx.bid = blockIdx.x; cx.nblk = gridDim.x;
        asm volatile("s_mov_b32 %0, 0" : "=s"(cx.z));
        asm volatile("" : "+v"(cx.tid)); asm volatile("" : "+s"(cx.bid)); asm volatile("" : "+s"(cx.nblk));
        const int pair = (ph - 1) / 9, s = (ph == 0) ? 100 : (ph == N_PHASES - 1 ? 101 : (ph - 1) % 9);
        if (s == 0 || s == 3 || s == 6) {
#if PHON(0)
            const bf16_t* WinE = (const bf16_t*)(PWS + WS_WINE) + (size_t)pair * 4352 * 1024;
            const bf16_t* Bt = s == 0 ? WinE + (size_t)2560 * 1024 : (s == 3 ? WinE : (const bf16_t*)(PWS + WS_WINO) + (size_t)pair * 2560 * 1024);
            const int N = s == 0 ? 1792 : 2560;
            run_gemm_proj(p, cx, lds, Bt, N, (bf16_t*)(PWS + WS_R1), N, 2 * pair + (s == 6 ? 1 : 0));
#endif
        } else if (s == 5 || s == 8) {
#if PHON(5)
            const bf16_t* Bt = (const bf16_t*)(PWS + (s == 5 ? WS_WOUTE : WS_WOUTO)) + (size_t)pair * 1024 * 1024;
            run_gemm_res(p, cx, lds, Bt, 2 * pair + (s == 8 ? 1 : 0));
#endif
        } else if (s == 1) {
#if PHON(1)
            phase_even_prep(p, cx, pair);
#endif
        } else if (s == 2) {
#if PHON(2)
            phase_scan(p, cx, pair, lds);
#endif
        } else if (s == 4) {
#if PHON(4)
            phase_even_post(p, cx, pair);
#endif
        } else if (s == 7) {
#if PHON(7)
            phase_odd_mixer(p, cx, pair, lds);
#endif
        } else if (s == 100) {
#if PHON(10)
            phase_prepass(p, cx, lds);
#endif
        } else {
#if PHON(11)
            phase_final(p, cx);
#endif
        }
    }
}

extern "C" void kernel_launch(void* const* d_in, const int* in_sizes, int n_in, void* d_out, int out_size, void* d_ws, size_t ws_size, hipStream_t stream) {
    static int grid = 0;
    if (grid == 0) {
        if (n_in != 29 || ws_size < WS_END) { fprintf(stderr, "kernel_launch: unexpected n_in %d / ws_size %zu (need %zu)\n", n_in, ws_size, (size_t)WS_END); grid = -1; return; }
        int dev = 0, cus = 0, per_cu = 0;
        hipGetDevice(&dev);
        hipDeviceGetAttribute(&cus, hipDeviceAttributeMultiprocessorCount, dev);
        if (hipFuncSetAttribute((const void*)fwd_kernel, hipFuncAttributeMaxDynamicSharedMemorySize, LDS_BYTES) != hipSuccess) { fprintf(stderr, "kernel_launch: hipFuncSetAttribute failed\n"); grid = -1; return; }
        if (hipOccupancyMaxActiveBlocksPerMultiprocessor(&per_cu, (const void*)fwd_kernel, 512, LDS_BYTES) != hipSuccess || per_cu < 1) { fprintf(stderr, "kernel_launch: occupancy query gave %d\n", per_cu); per_cu = 1; }
        (void)hipGetLastError();
        grid = cus * per_cu;
        if (grid > 256) grid = 256;
    }
    if (grid < 0) return;
    Params p{};
    for (int i = 0; i < 29; ++i) p.ptr[i] = d_in[i];
    p.ptr[29] = d_out; p.ptr[30] = d_ws; p.ptr[31] = nullptr;
    (void)hipMemsetAsync((unsigned char*)d_ws + WS_BAR, 0, 16384, stream);
#if ONE_LAUNCH
    p.ph_lo = 0; p.ph_hi = N_PHASES;
    void* args[] = {&p};
    hipError_t e = hipLaunchCooperativeKernel((const void*)fwd_kernel, dim3(grid), dim3(512), args, LDS_BYTES, stream);
    if (e != hipSuccess) fprintf(stderr, "cooperative launch failed: %s (grid %d)\n", hipGetErrorString(e), grid);
#else
    for (int ph = 0; ph < N_PHASES; ++ph) {
        p.ph_lo = ph; p.ph_hi = ph + 1;
        hipLaunchKernelGGL(fwd_kernel, dim3(grid), dim3(512), LDS_BYTES, stream, p);
    }
#endif
}
```

```cpp
#include <hip/hip_runtime.h>
#include <hip/hip_cooperative_groups.h>
#include <cstdio>
namespace cg = cooperative_groups;

#ifndef ONE_LAUNCH
#define ONE_LAUNCH 1
#endif

#define LAS __attribute__((address_space(3)))
typedef unsigned short bf16_t;
typedef short bf16x8 __attribute__((ext_vector_type(8)));
typedef float f32x4 __attribute__((ext_vector_type(4)));
typedef unsigned u32x4 __attribute__((ext_vector_type(4)));
typedef unsigned u32x2 __attribute__((ext_vector_type(2)));

constexpr int NTOK = 17408, NTP = 16384;
constexpr int LDB = 1792;
constexpr int LDA = 2560;
constexpr size_t O_CONVP = 17825792, O_CONVS = 17842176, O_SHIFTP = 18104320, O_SHIFTS = 18130944, O_WKVP = 18556928, O_WKVS = 19081216,
                 O_POOLP = 27469824, O_POOLS = 27592704, O_CHUNKV = 29558784;
constexpr size_t WS_WINE = 0;
constexpr size_t WS_WOUTE = WS_WINE + 2ull * 4352 * 1024 * 2;
constexpr size_t WS_WINO = WS_WOUTE + 2ull * 1024 * 1024 * 2;
constexpr size_t WS_WOUTO = WS_WINO + 2ull * 2560 * 1024 * 2;
constexpr size_t WS_W2T = WS_WOUTO + 2ull * 1024 * 1024 * 2;
constexpr size_t WS_A2T = WS_W2T + 2ull * 512 * 64 * 2;
constexpr size_t WS_POOLWT = WS_A2T + 2ull * 512 * 64 * 2;
constexpr size_t WS_SPW = WS_POOLWT + 8ull * 128 * 128 * 2;
constexpr size_t WS_XB = WS_SPW + 8ull * 128 * 128 * 2;
constexpr size_t WS_YCAT = WS_XB + (size_t)NTOK * 1024 * 2;
constexpr size_t WS_SSQ = WS_YCAT + (size_t)NTOK * 1024 * 2;
constexpr size_t WS_Y = WS_SSQ + 5ull * NTOK * 16 * 4;
constexpr size_t WS_R1 = WS_Y + (size_t)NTOK * 512 * 4;
constexpr size_t WS_PROJB = WS_R1;
constexpr size_t WS_WDEC = WS_PROJB + (size_t)NTOK * LDB * 2;
constexpr size_t WS_AA = WS_WDEC + (size_t)NTOK * 512 * 4;
constexpr size_t WS_BAR = WS_AA + (size_t)NTOK * 512 * 2;
constexpr size_t WS_END = WS_BAR + 16384;
constexpr int LDS_BYTES = 131072 + 16;

struct Params {
    const void* ptr[32];
    int ph_lo, ph_hi;
};
struct Ctx { int tid, bid, nblk, z; };
#define PIN(i) ((const float*)p.ptr[(i) + cx.z])
#define POUT ((float*)p.ptr[29 + cx.z])
#define PWS ((unsigned char*)p.ptr[30 + cx.z])
enum { I_XP = 0, I_XS, I_SCONV, I_SSHIFT, I_SWKV, I_SPOOL, I_NORMW, I_FNORMW, I_WINE, I_CONVW, I_MU, I_W0, I_W2, I_A0, I_A2, I_KK, I_KA, I_RK, I_GNG, I_GNB,
       I_WOUTE, I_WINO, I_POOLW, I_PSCALE, I_LNG, I_LNB, I_SPW, I_SPB, I_WOUTO };

__device__ __forceinline__ unsigned cvt_pk_bf16(float lo, float hi) { unsigned r; asm("v_cvt_pk_bf16_f32 %0, %1, %2" : "=v"(r) : "v"(lo), "v"(hi)); return r; }
__device__ __forceinline__ float bf_lo(unsigned u) { return __uint_as_float(u << 16); }
__device__ __forceinline__ float bf_hi(unsigned u) { return __uint_as_float(u & 0xffff0000u); }
__device__ __forceinline__ float bf2f(bf16_t b) { return __uint_as_float(((unsigned)b) << 16); }
__device__ __forceinline__ f32x4 cvt4(u32x2 u) { return (f32x4){bf_lo(u.x), bf_hi(u.x), bf_lo(u.y), bf_hi(u.y)}; }
__device__ __forceinline__ f32x4 ld_bf4(const bf16_t* p) { return cvt4(*(const u32x2*)p); }
__device__ __forceinline__ void st_bf4(bf16_t* p, f32x4 v) { u32x2 u; u.x = cvt_pk_bf16(v[0], v[1]); u.y = cvt_pk_bf16(v[2], v[3]); *(u32x2*)p = u; }
__device__ __forceinline__ float sigmoidf_(float x) { return 1.0f / (1.0f + __expf(-x)); }
__device__ __forceinline__ float siluf_(float x) { return x / (1.0f + __expf(-x)); }
template <int CTRL> __device__ __forceinline__ float dpp_f(float x) { return __builtin_bit_cast(float, __builtin_amdgcn_mov_dpp(__builtin_bit_cast(int, x), CTRL, 0xf, 0xf, true)); }
__device__ __forceinline__ float allsum16(float x) { x += dpp_f<0xB1>(x); x += dpp_f<0x4E>(x); x += dpp_f<0x141>(x); x += dpp_f<0x128>(x); return x; }
__device__ __forceinline__ float allsum4(float x) { x += dpp_f<0xB1>(x); x += dpp_f<0x4E>(x); return x; }
__device__ __forceinline__ float dot4(f32x4 a, f32x4 b) { return a[0] * b[0] + a[1] * b[1] + a[2] * b[2] + a[3] * b[3]; }

__device__ __forceinline__ float ssq_sum(const float* part) {
    const f32x4 a = *(const f32x4*)(part), b = *(const f32x4*)(part + 4), c = *(const f32x4*)(part + 8), d = *(const f32x4*)(part + 12);
    return ((a[0] + a[1]) + (a[2] + a[3])) + ((b[0] + b[1]) + (b[2] + b[3])) + ((c[0] + c[1]) + (c[2] + c[3])) + ((d[0] + d[1]) + (d[2] + d[3]));
}

namespace pg8 {
constexpr int BM = 256, BK = 64, HALF = 128, HTB = HALF * BK * 2, NXCD = 8, WGM = 8;
__device__ __forceinline__ int lds_byte(int r, int c) { const int st = (r >> 4) * 2 + (c >> 5), rr = r & 15, cc = c & 31, ob = rr * 64 + cc * 2; return st * 1024 + (ob ^ (((ob >> 9) & 1) << 5)); }
__device__ __forceinline__ void stage_rc(int b, int& R, int& C) { const int st = b / 1024, sb = b % 1024, swz = sb ^ (((sb >> 9) & 1) << 5); R = (st >> 1) * 16 + swz / 64; C = (st & 1) * 32 + (swz % 64) / 2; }
__device__ __forceinline__ int perm32(int rho) { const int n = rho >> 4, i = rho & 15; return 8 * (i >> 2) + 4 * n + (i & 3); }
struct Unit { int pm, pn; };
struct Gemm { const bf16_t* A; const bf16_t* Bt; int M, N, K; };
struct StaticOrder {
    int nM, nN, nwg, G, c;
    __device__ void init(int M, int N, int G_, int c_) { nM = M / BM; nN = N / BM; nwg = nM * nN; G = G_; c = c_; }
    __device__ bool next(int i, Unit& u) const {
        const long L = (long)i * G + c; if (L >= nwg) return false;
        int wgid = (int)L; { const int q = nwg / NXCD, r = nwg % NXCD, xcd = wgid % NXCD, off = wgid / NXCD; wgid = (xcd < r ? xcd * (q + 1) : r * (q + 1) + (xcd - r) * q) + off; }
        const int nig = WGM * nN, gid = wgid / nig, fm = gid * WGM, gsz = (nM - fm) < WGM ? (nM - fm) : WGM;
        u.pm = fm + ((wgid % nig) % gsz); u.pn = (wgid % nig) / gsz; return true;
    }
};

template <class Epi>
__device__ __forceinline__ void gemm_phase(const Ctx cx, LAS unsigned char* lds, const Gemm g, const StaticOrder& S, const Epi& E) {
    const int tid = cx.tid, wid = __builtin_amdgcn_readfirstlane(tid >> 6), lane = tid & 63, wr = wid >> 2, wc = wid & 3, fr = lane & 15, fq = lane >> 4;
    const int K = g.K, nt = K / BK;
    unsigned voffA[2], voffB[2];
#pragma unroll
    for (int i = 0; i < 2; ++i) { int R, C; stage_rc(tid * 16 + i * 8192, R, C); const int Rb = Epi::PERM ? ((R & ~31) + perm32(R & 31)) : R;
        voffA[i] = (unsigned)(R * K + C) * 2u; voffB[i] = (unsigned)(Rb * K + C) * 2u; }
    const size_t kstep = (size_t)(BK * 2);
    const size_t hstep = (size_t)HALF * K * 2;
    const size_t tstep = 2 * hstep;
    const unsigned ldsw = (unsigned)wid * 1024u;
    const int aoff = lds_byte(wr * 64 + fr, fq * 8), boff = lds_byte(wc * 32 + fr, fq * 8);
#define PG8_SA(b, h) (((b) * 2 + (h)) * HTB)
#define PG8_SB(b, h) ((4 + (b) * 2 + (h)) * HTB)
#define PG8_STAGE(bufoff, gbase, voff) do { _Pragma("unroll") for (int _i = 0; _i < 2; ++_i) \
        __builtin_amdgcn_global_load_lds((const unsigned*)((const char*)(gbase) + (voff)[_i]), (LAS unsigned*)(lds + (bufoff) + ldsw + _i * 8192), 16, 0, 0); } while (0)
#define PG8_LDA(dst, b, h) do { _Pragma("unroll") for (int m = 0; m < 4; ++m) _Pragma("unroll") for (int k = 0; k < 2; ++k) dst[m][k] = *(const LAS bf16x8*)(lds + PG8_SA(b, h) + aoff + m * 2048 + k * 1024); } while (0)
#define PG8_LDB(dst, b, h) do { _Pragma("unroll") for (int n = 0; n < 2; ++n) _Pragma("unroll") for (int k = 0; k < 2; ++k) dst[n][k] = *(const LAS bf16x8*)(lds + PG8_SB(b, h) + boff + n * 2048 + k * 1024); } while (0)
#define PG8_MMA(ai, bj, At, Bt) do { __builtin_amdgcn_s_setprio(1); _Pragma("unroll") for (int m = 0; m < 4; ++m) _Pragma("unroll") for (int n = 0; n < 2; ++n) _Pragma("unroll") for (int k = 0; k < 2; ++k) \
        acc[ai][bj][m][n] = __builtin_amdgcn_mfma_f32_16x16x32_bf16(Bt[n][k], At[m][k], acc[ai][bj][m][n], 0, 0, 0); __builtin_amdgcn_s_setprio(0); } while (0)
#define PG8_WAIT_V(n) asm volatile("s_waitcnt vmcnt(" #n ")" ::: "memory")
#define PG8_WAIT_L(n) asm volatile("s_waitcnt lgkmcnt(" #n ")" ::: "memory")
#define PG8_BAR __builtin_amdgcn_s_barrier()
#define PG8_SCHED __builtin_amdgcn_sched_barrier(0)
    Unit cur, nxt; int ui = 0;
    if (!S.next(0, cur)) return;
    f32x4 acc[2][2][4][2];
#pragma unroll
    for (int a = 0; a < 2; ++a)
#pragma unroll
        for (int b = 0; b < 2; ++b)
#pragma unroll
            for (int m = 0; m < 4; ++m)
#pragma unroll
                for (int n = 0; n < 2; ++n) acc[a][b][m][n] = (f32x4){0.f, 0.f, 0.f, 0.f};
    bf16x8 At[4][2], B0[2][2], B1[2][2];
    const char* cA = (const char*)g.A + (size_t)cur.pm * tstep; const char* cB = (const char*)g.Bt + (size_t)cur.pn * tstep;
    PG8_STAGE(PG8_SB(0, 0), cB, voffB); PG8_STAGE(PG8_SA(0, 0), cA, voffA); PG8_STAGE(PG8_SB(0, 1), cB + hstep, voffB); PG8_STAGE(PG8_SA(0, 1), cA + hstep, voffA);
    if (wr == 1) PG8_BAR;
    PG8_WAIT_V(4); PG8_BAR;
    PG8_STAGE(PG8_SB(1, 0), cB + kstep, voffB); PG8_STAGE(PG8_SA(1, 0), cA + kstep, voffA); PG8_STAGE(PG8_SB(1, 1), cB + hstep + kstep, voffB);
    PG8_WAIT_V(6); PG8_BAR;
    for (;;) {
        const bool has_next = S.next(ui + 1, nxt);
        const char* nA = has_next ? (const char*)g.A + (size_t)nxt.pm * tstep : cA; const char* nB = has_next ? (const char*)g.Bt + (size_t)nxt.pn * tstep : cB;
        for (int t = 0; t < nt; t += 2) {
            const bool last = (t == nt - 2);
            const char* a1 = cA + (size_t)(t + 1) * kstep;
            const char* a2 = last ? nA : cA + (size_t)(t + 2) * kstep; const char* b2 = last ? nB : cB + (size_t)(t + 2) * kstep;
            const char* a3 = a2 + kstep; const char* b3 = b2 + kstep;
            PG8_LDB(B0, 0, 0); PG8_SCHED; PG8_LDA(At, 0, 0); PG8_STAGE(PG8_SA(1, 1), a1 + hstep, voffA);
            PG8_WAIT_L(8); PG8_BAR; PG8_WAIT_L(0); PG8_MMA(0, 0, At, B0); PG8_BAR; PG8_SCHED;
            PG8_LDB(B1, 0, 1); PG8_STAGE(PG8_SB(0, 0), b2, voffB);
            PG8_BAR; PG8_WAIT_L(0); PG8_MMA(0, 1, At, B1); PG8_BAR;
            PG8_LDA(At, 0, 1); PG8_STAGE(PG8_SA(0, 0), a2, voffA);
            PG8_BAR; PG8_WAIT_L(0); PG8_MMA(1, 0, At, B0); PG8_BAR; PG8_SCHED;
            PG8_STAGE(PG8_SB(0, 1), b2 + hstep, voffB);
            PG8_WAIT_V(6); PG8_BAR; PG8_MMA(1, 1, At, B1); PG8_BAR;
            PG8_LDB(B0, 1, 0); PG8_SCHED; PG8_LDA(At, 1, 0); PG8_STAGE(PG8_SA(0, 1), a2 + hstep, voffA);
            PG8_WAIT_L(8); PG8_BAR; PG8_WAIT_L(0); PG8_MMA(0, 0, At, B0); PG8_BAR; PG8_SCHED;
            PG8_LDB(B1, 1, 1); PG8_STAGE(PG8_SB(1, 0), b3, voffB);
            PG8_BAR; PG8_WAIT_L(0); PG8_MMA(0, 1, At, B1); PG8_BAR;
            PG8_LDA(At, 1, 1); PG8_STAGE(PG8_SA(1, 0), a3, voffA);
            PG8_BAR; PG8_WAIT_L(0); PG8_MMA(1, 0, At, B0); PG8_BAR; PG8_SCHED;
            PG8_STAGE(PG8_SB(1, 1), b3 + hstep, voffB);
            PG8_WAIT_V(6); PG8_BAR; PG8_MMA(1, 1, At, B1); PG8_BAR;
        }
        E(acc, cur, wr, wc, fr, fq);
        if (!has_next) break;
#pragma unroll
        for (int a = 0; a < 2; ++a)
#pragma unroll
            for (int b = 0; b < 2; ++b)
#pragma unroll
                for (int m = 0; m < 4; ++m)
#pragma unroll
                    for (int n = 0; n < 2; ++n) acc[a][b][m][n] = (f32x4){0.f, 0.f, 0.f, 0.f};
        cur = nxt; cA = nA; cB = nB; ++ui;
    }
    PG8_WAIT_V(0);
    if (wr == 0) PG8_BAR;
    PG8_BAR;
#undef PG8_SA
#undef PG8_SB
#undef PG8_STAGE
#undef PG8_LDA
#undef PG8_LDB
#undef PG8_MMA
#undef PG8_WAIT_V
#undef PG8_WAIT_L
#undef PG8_BAR
#undef PG8_SCHED
}
}

struct EpiProj {
    static constexpr bool PERM = true;
    bf16_t* O; int ldc; const float* ssq;
    __device__ __forceinline__ void operator()(const f32x4 (&acc)[2][2][4][2], const pg8::Unit& u, int wr, int wc, int fr, int fq) const {
        const int row0 = u.pm * 256 + wr * 64 + fr, col0 = u.pn * 256 + wc * 32 + 8 * fq;
#pragma unroll
        for (int ai = 0; ai < 2; ++ai)
#pragma unroll
            for (int m = 0; m < 4; ++m) {
                const int row = row0 + ai * 128 + m * 16;
                const float rstd = rsqrtf(ssq_sum(ssq + (size_t)row * 16) * (1.0f / 1024.0f) + 1e-6f);
                bf16_t* rowp = O + (size_t)row * ldc + col0;
#pragma unroll
                for (int bj = 0; bj < 2; ++bj) {
                    const f32x4 v0 = acc[ai][bj][m][0] * rstd, v1 = acc[ai][bj][m][1] * rstd;
                    u32x4 w; w.x = cvt_pk_bf16(v0[0], v0[1]); w.y = cvt_pk_bf16(v0[2], v0[3]); w.z = cvt_pk_bf16(v1[0], v1[1]); w.w = cvt_pk_bf16(v1[2], v1[3]);
                    *(u32x4*)(rowp + bj * 128) = w;
                }
            }
    }
};
struct X8 { f32x4 lo, hi; };
template <bool FIRST> __device__ __forceinline__ X8 ld_x8(const float* __restrict__ s32, const bf16_t* __restrict__ s16, size_t o) {
    X8 r;
    if (FIRST) { r.lo = *(const f32x4*)(s32 + o); r.hi = *(const f32x4*)(s32 + o + 4); }
    else { const u32x4 u = *(const u32x4*)(s16 + o); r.lo = cvt4((u32x2){u.x, u.y}); r.hi = cvt4((u32x2){u.z, u.w}); }
    return r;
}
__device__ __forceinline__ void st_x8(bf16_t* p, f32x4 lo, f32x4 hi) { u32x4 w; w.x = cvt_pk_bf16(lo[0], lo[1]); w.y = cvt_pk_bf16(lo[2], lo[3]); w.z = cvt_pk_bf16(hi[0], hi[1]); w.w = cvt_pk_bf16(hi[2], hi[3]); *(u32x4*)p = w; }
template <bool FIRST>
__device__ __forceinline__ void epi_res_rows(const f32x4 (&acc)[2][2][4][2], const float* __restrict__ src32, const bf16_t* __restrict__ src16, bf16_t* __restrict__ Xb, float* __restrict__ ssqp,
                                             int row0, int col0, int slot, int fq) {
    X8 x[2][2];
#pragma unroll
    for (int bj = 0; bj < 2; ++bj) x[0][bj] = ld_x8<FIRST>(src32, src16, (size_t)row0 * 1024 + col0 + bj * 128);
#pragma unroll
    for (int gi = 0; gi < 8; ++gi) {
        const int ai = gi >> 2, m = gi & 3, row = row0 + ai * 128 + m * 16;
        if (gi + 1 < 8) {
            const int nrow = row0 + ((gi + 1) >> 2) * 128 + ((gi + 1) & 3) * 16;
#pragma unroll
            for (int bj = 0; bj < 2; ++bj) x[(gi + 1) & 1][bj] = ld_x8<FIRST>(src32, src16, (size_t)nrow * 1024 + col0 + bj * 128);
        }
        float part = 0.f;
#pragma unroll
        for (int bj = 0; bj < 2; ++bj) {
            const f32x4 lo = x[gi & 1][bj].lo + acc[ai][bj][m][0], hi = x[gi & 1][bj].hi + acc[ai][bj][m][1];
            st_x8(Xb + (size_t)row * 1024 + col0 + bj * 128, lo, hi);
            part += dot4(lo, lo) + dot4(hi, hi);
        }
        part += __shfl_xor(part, 16); part += __shfl_xor(part, 32);
        if (fq == 0) ssqp[(size_t)row * 16 + slot] = part;
    }
}
struct EpiRes {
    static constexpr bool PERM = true;
    const float* xp; const float* xs; bf16_t* Xb; float* ssq_next;
    __device__ __forceinline__ void operator()(const f32x4 (&acc)[2][2][4][2], const pg8::Unit& u, int wr, int wc, int fr, int fq) const {
        const int row0 = u.pm * 256 + wr * 64 + fr, col0 = u.pn * 256 + wc * 32 + 8 * fq;
        if (xp) epi_res_rows<true>(acc, row0 < NTP ? xp : xs - (size_t)NTP * 1024, nullptr, Xb, ssq_next, row0, col0, u.pn * 4 + wc, fq);
        else epi_res_rows<false>(acc, nullptr, Xb, Xb, ssq_next, row0, col0, u.pn * 4 + wc, fq);
    }
};

template <bool FIRST>
__device__ __forceinline__ void res_sample_tile(const Ctx cx, const bf16_t* __restrict__ A, const bf16_t* __restrict__ Bt, const float* __restrict__ xs, bf16_t* __restrict__ Xb, float* __restrict__ ssqp, int tile) {
    const int tid = cx.tid, wid = tid >> 6, lane = tid & 63, fr = lane & 15, fq = lane >> 4;
    const int tm = tile >> 3, tn = tile & 7;
    const int r0 = NTP + tm * 64 + (wid & 3) * 16, c0 = tn * 128 + (wid >> 2) * 64;
    const bf16_t* ap = A + (size_t)(r0 + fr) * 1024 + fq * 8;
    const bf16_t* bp = Bt + (size_t)(c0 + fr) * 1024 + fq * 8;
    f32x4 acc[4];
#pragma unroll
    for (int nt = 0; nt < 4; ++nt) acc[nt] = (f32x4){0.f, 0.f, 0.f, 0.f};
#pragma unroll 8
    for (int ks = 0; ks < 32; ++ks) {
        const bf16x8 af = *(const bf16x8*)(ap + ks * 32);
#pragma unroll
        for (int nt = 0; nt < 4; ++nt) {
            const bf16x8 bf = *(const bf16x8*)(bp + (size_t)nt * 16 * 1024 + ks * 32);
            acc[nt] = __builtin_amdgcn_mfma_f32_16x16x32_bf16(bf, af, acc[nt], 0, 0, 0);
        }
    }
    const int row = r0 + fr;
    float part = 0.f;
#pragma unroll
    for (int nt = 0; nt < 4; ++nt) {
        const int col = c0 + nt * 16 + fq * 4;
        const f32x4 xo = FIRST ? *(const f32x4*)(xs + (size_t)(row - NTP) * 1024 + col) : ld_bf4(Xb + (size_t)row * 1024 + col);
        const f32x4 v = xo + acc[nt];
        st_bf4(Xb + (size_t)row * 1024 + col, v);
        part += dot4(v, v);
    }
    part += __shfl_xor(part, 16); part += __shfl_xor(part, 32);
    if (fq == 0) ssqp[(size_t)row * 16 + (c0 >> 6)] = part;
}

__device__ __forceinline__ void tr_tile(const Ctx cx, LAS float* T, const float* src, int ld, int col0, int k0, bf16_t* dst, int Ktot, int drow0, const float* scale, bool zero) {
    const int tid = cx.tid;
    if (zero) {
        const int n = tid >> 3, kc = (tid & 7) * 8;
        *(u32x4*)(dst + (size_t)(drow0 + n) * Ktot + k0 + kc) = (u32x4){0u, 0u, 0u, 0u};
        return;
    }
#pragma unroll
    for (int pass = 0; pass < 2; ++pass) {
        const int kk = (tid >> 4) + pass * 32, nn = (tid & 15) * 4;
        f32x4 v = *(const f32x4*)(src + (size_t)(k0 + kk) * ld + col0 + nn);
        if (scale) v = v * scale[k0 + kk];
        T[kk * 65 + nn] = v[0]; T[kk * 65 + nn + 1] = v[1]; T[kk * 65 + nn + 2] = v[2]; T[kk * 65 + nn + 3] = v[3];
    }
    __syncthreads();
    {
        const int n = tid >> 3, kc = (tid & 7) * 8;
        u32x4 w;
        w.x = cvt_pk_bf16(T[(kc + 0) * 65 + n], T[(kc + 1) * 65 + n]); w.y = cvt_pk_bf16(T[(kc + 2) * 65 + n], T[(kc + 3) * 65 + n]);
        w.z = cvt_pk_bf16(T[(kc + 4) * 65 + n], T[(kc + 5) * 65 + n]); w.w = cvt_pk_bf16(T[(kc + 6) * 65 + n], T[(kc + 7) * 65 + n]);
        *(u32x4*)(dst + (size_t)(drow0 + n) * Ktot + k0 + kc) = w;
    }
    __syncthreads();
}

__device__ void phase_prepass(const Params& p, const Ctx cx, LAS unsigned char* lds) {
    LAS float* T = (LAS float*)lds;
    const int tid = cx.tid;
    for (int job = cx.bid; job < 4544; job += cx.nblk) {
        int j = job;
        if (j < 2176) {
            const int i = j / 1088, r = j % 1088, nt = r / 16, kt = r % 16;
            const int n0 = nt * 64;
            int col0; bool zero = false;
            if (n0 < 2048) col0 = n0; else if (n0 < 2560) col0 = 3712 + (n0 - 2048); else if (n0 < 4224) col0 = 2048 + (n0 - 2560); else { col0 = 0; zero = true; }
            tr_tile(cx, T, PIN(I_WINE) + (size_t)i * 1024 * 4224, 4224, col0, kt * 64, (bf16_t*)(PWS + WS_WINE) + (size_t)i * 4352 * 1024, 1024, n0, PIN(I_NORMW) + (2 * i) * 1024, zero);
            continue;
        }
        j -= 2176;
        if (j < 512) { const int i = j / 256, r = j % 256, nt = r / 16, kt = r % 16;
            tr_tile(cx, T, PIN(I_WOUTE) + (size_t)i * 1024 * 1024, 1024, nt * 64, kt * 64, (bf16_t*)(PWS + WS_WOUTE) + (size_t)i * 1024 * 1024, 1024, nt * 64, nullptr, false); continue; }
        j -= 512;
        if (j < 1280) { const int i = j / 640, r = j % 640, nt = r / 16, kt = r % 16;
            tr_tile(cx, T, PIN(I_WINO) + (size_t)i * 1024 * 2560, 2560, nt * 64, kt * 64, (bf16_t*)(PWS + WS_WINO) + (size_t)i * 2560 * 1024, 1024, nt * 64, PIN(I_NORMW) + (2 * i + 1) * 1024, false); continue; }
        j -= 1280;
        if (j < 512) { const int i = j / 256, r = j % 256, nt = r / 16, kt = r % 16;
            tr_tile(cx, T, PIN(I_WOUTO) + (size_t)i * 1024 * 1024, 1024, nt * 64, kt * 64, (bf16_t*)(PWS + WS_WOUTO) + (size_t)i * 1024 * 1024, 1024, nt * 64, nullptr, false); continue; }
        j -= 512;
        if (j < 16) { const int i = j / 8, nt = j % 8;
            tr_tile(cx, T, PIN(I_W2) + (size_t)i * 64 * 512, 512, nt * 64, 0, (bf16_t*)(PWS + WS_W2T) + (size_t)i * 512 * 64, 64, nt * 64, nullptr, false); continue; }
        j -= 16;
        if (j < 16) { const int i = j / 8, nt = j % 8;
            tr_tile(cx, T, PIN(I_A2) + (size_t)i * 64 * 512, 512, nt * 64, 0, (bf16_t*)(PWS + WS_A2T) + (size_t)i * 512 * 64, 64, nt * 64, nullptr, false); continue; }
        j -= 16;
        { const int ig = j / 4, r = j % 4, nt = r / 2, kt = r % 2;
            tr_tile(cx, T, PIN(I_POOLW) + (size_t)ig * 128 * 128, 128, nt * 64, kt * 64, (bf16_t*)(PWS + WS_POOLWT) + (size_t)ig * 128 * 128, 128, nt * 64, nullptr, false); }
    }
    const int gtid = cx.bid * 512 + tid, gthreads = cx.nblk * 512;
    for (int e = gtid; e < 8 * 128 * 128; e += gthreads) {
        const int s = e & 127, t = (e >> 7) & 127;
        ((bf16_t*)(PWS + WS_SPW))[e] = (s <= t) ? (bf16_t)(cvt_pk_bf16(PIN(I_SPW)[e], 0.f) & 0xffffu) : (bf16_t)0;
    }
    const int wid = tid >> 6, lane = tid & 63;
    for (int row = cx.bid * 8 + wid; row < NTOK; row += cx.nblk * 8) {
        const float* src = row < NTP ? PIN(I_XP) + (size_t)row * 1024 : PIN(I_XS) + (size_t)(row - NTP) * 1024;
        bf16_t* dst = (bf16_t*)(PWS + WS_XB) + (size_t)row * 1024;
        float ss = 0.f;
#pragma unroll
        for (int i = 0; i < 4; ++i) { const f32x4 v = *(const f32x4*)(src + i * 256 + lane * 4); ss += dot4(v, v); st_bf4(dst + i * 256 + lane * 4, v); }
#pragma unroll
        for (int o = 32; o >= 1; o >>= 1) ss += __shfl_xor(ss, o);
        if (lane < 16) ((float*)(PWS + WS_SSQ))[(size_t)row * 16 + lane] = (lane == 0) ? ss : 0.f;
    }
}

__device__ __forceinline__ f32x4 shift4(const bf16_t* cur, bool hp, const float* st, int col, const float* mu) {
    const f32x4 q = ld_bf4(cur + col);
    f32x4 pv;
    if (hp) pv = ld_bf4(cur - LDB + col); else if (st) pv = *(const f32x4*)(st + col); else pv = (f32x4){0.f, 0.f, 0.f, 0.f};
    const f32x4 m = *(const f32x4*)(mu + col);
    return q + m * (pv - q);
}

__device__ void phase_even_prep(const Params& p, const Ctx cx, int pair) {
    const int tid = cx.tid, wid = tid >> 6, lane = tid & 63, fr = lane & 15, fq = lane >> 4;
    const bf16_t* PB = (const bf16_t*)(PWS + WS_PROJB);
    float* Wdec = (float*)(PWS + WS_WDEC);
    bf16_t* Aa = (bf16_t*)(PWS + WS_AA);
    bf16_t* Ycat = (bf16_t*)(PWS + WS_YCAT);
    const float* mu = PIN(I_MU) + pair * 1664;
    const bf16_t* W2T = (const bf16_t*)(PWS + WS_W2T) + (size_t)pair * 512 * 64;
    const bf16_t* A2T = (const bf16_t*)(PWS + WS_A2T) + (size_t)pair * 512 * 64;
    const float* w0 = PIN(I_W0) + pair * 512; const float* a0 = PIN(I_A0) + pair * 512;
    const float* k_a = PIN(I_KA) + pair * 512; const float* r_k = PIN(I_RK) + pair * 512;
    for (int unit = cx.bid * 8 + wid; unit < (NTOK / 16) * 8; unit += cx.nblk * 8) {
        const int row = (unit >> 3) * 16 + fr, h = unit & 7;
        const bool samp = row >= NTP;
        int b, t; if (!samp) { b = row >> 11; t = row & 2047; } else { const int q = row - NTP; b = q >> 3; t = q & 7; }
        const bf16_t* cur = PB + (size_t)row * LDB;
        const bool hp = t > 0;
        const float* st = samp ? PIN(I_SSHIFT) + ((size_t)pair * 128 + b) * 1664 : nullptr;
        bf16x8 Aw[2], Al[2];
#pragma unroll
        for (int ks = 0; ks < 2; ++ks) {
            const int cw = 1536 + ks * 32 + fq * 8, ca = 1600 + ks * 32 + fq * 8;
            const f32x4 w_lo = shift4(cur, hp, st, cw, mu), w_hi = shift4(cur, hp, st, cw + 4, mu);
            const f32x4 a_lo = shift4(cur, hp, st, ca, mu), a_hi = shift4(cur, hp, st, ca + 4, mu);
            u32x4 pw, pa;
            float th[8];
#pragma unroll
            for (int j = 0; j < 4; ++j) { th[j] = 2.0f * sigmoidf_(2.0f * w_lo[j]) - 1.0f; th[4 + j] = 2.0f * sigmoidf_(2.0f * w_hi[j]) - 1.0f; }
            pw.x = cvt_pk_bf16(th[0], th[1]); pw.y = cvt_pk_bf16(th[2], th[3]); pw.z = cvt_pk_bf16(th[4], th[5]); pw.w = cvt_pk_bf16(th[6], th[7]);
            pa.x = cvt_pk_bf16(a_lo[0], a_lo[1]); pa.y = cvt_pk_bf16(a_lo[2], a_lo[3]); pa.z = cvt_pk_bf16(a_hi[0], a_hi[1]); pa.w = cvt_pk_bf16(a_hi[2], a_hi[3]);
            Aw[ks] = __builtin_bit_cast(bf16x8, pw); Al[ks] = __builtin_bit_cast(bf16x8, pa);
        }
        float bon = 0.f;
#pragma unroll 2
        for (int nt = 0; nt < 4; ++nt) {
            const int n0 = h * 64 + nt * 16;
            f32x4 lw = (f32x4){0.f, 0.f, 0.f, 0.f}, la = (f32x4){0.f, 0.f, 0.f, 0.f};
#pragma unroll
            for (int ks = 0; ks < 2; ++ks) {
                const bf16x8 wf = *(const bf16x8*)(W2T + (size_t)(n0 + fr) * 64 + ks * 32 + fq * 8);
                const bf16x8 af = *(const bf16x8*)(A2T + (size_t)(n0 + fr) * 64 + ks * 32 + fq * 8);
                lw = __builtin_amdgcn_mfma_f32_16x16x32_bf16(wf, Aw[ks], lw, 0, 0, 0);
                la = __builtin_amdgcn_mfma_f32_16x16x32_bf16(af, Al[ks], la, 0, 0, 0);
            }
            const int ch = n0 + fq * 4;
            const f32x4 r4 = shift4(cur, hp, st, ch, mu), k4 = shift4(cur, hp, st, 512 + ch, mu);
            const f32x4 w04 = *(const f32x4*)(w0 + ch), a04 = *(const f32x4*)(a0 + ch), ka4 = *(const f32x4*)(k_a + ch), rk4 = *(const f32x4*)(r_k + ch);
            f32x4 dec, av;
#pragma unroll
            for (int j = 0; j < 4; ++j) {
                const float z_ = -(w04[j] + lw[j]);
                const float wlog = -__logf(1.0f + __expf(z_)) - 0.5f;
                dec[j] = __expf(-__expf(wlog));
                av[j] = sigmoidf_(a04[j] + la[j]);
                const float kp = k4[j] * (1.0f + (av[j] - 1.0f) * ka4[j]);
                bon += r4[j] * kp * rk4[j];
            }
            *(f32x4*)(Wdec + (size_t)row * 512 + ch) = dec;
            st_bf4(Aa + (size_t)row * 512 + ch, av);
        }
        bon += __shfl_xor(bon, 16); bon += __shfl_xor(bon, 32);
#pragma unroll
        for (int nt = 0; nt < 4; ++nt) { const int ch = h * 64 + nt * 16 + fq * 4; st_bf4(Ycat + (size_t)row * 1024 + 512 + ch, shift4(cur, hp, st, 1024 + ch, mu) * bon); }
    }
    const int gtid = cx.bid * 512 + tid, gthreads = cx.nblk * 512;
    for (int e = gtid; e < 136 * 1664; e += gthreads) {
        const int sr = e / 1664, c = e % 1664;
        if (sr < 8) POUT[O_SHIFTP + ((size_t)pair * 8 + sr) * 1664 + c] = bf2f(PB[(size_t)(sr * 2048 + 2047) * LDB + c]);
        else { const int b = sr - 8; POUT[O_SHIFTS + ((size_t)pair * 128 + b) * 1664 + c] = bf2f(PB[(size_t)(NTP + b * 8 + 7) * LDB + c]); }
    }
}

__device__ __forceinline__ void scan_step(f32x4& S, const f32x4 w, const f32x4 k, const f32x4 kk, const f32x4 bb, const f32x4 r, const float v, float& y) {
    float pd = dot4(S, kk);
    const f32x4 tmp = S * w + k * v;
    pd = allsum16(pd);
    S = tmp - bb * pd;
    y = allsum16(dot4(S, r));
}

__device__ void phase_scan(const Params& p, const Ctx cx, int pair, LAS unsigned char* lds) {
    const int tid = cx.tid, wid = tid >> 6, lane = tid & 63, rs = lane >> 4, cgi = lane & 15;
    const bf16_t* PB = (const bf16_t*)(PWS + WS_PROJB);
    const float* Wdec = (const float*)(PWS + WS_WDEC);
    const bf16_t* Aa = (const bf16_t*)(PWS + WS_AA);
    float* Y = (float*)(PWS + WS_Y);
    const float* mu = PIN(I_MU) + pair * 1664;
    const float* k_k = PIN(I_KK) + pair * 512; const float* k_a = PIN(I_KA) + pair * 512;
    {
        LAS float* vb = (LAS float*)lds + wid * 3072;
        for (int st = cx.bid * 8 + wid; st < 2048; st += cx.nblk * 8) {
            const int bh = st >> 1, half = st & 1, b = bh >> 3, h = bh & 7, ch = h * 64 + cgi * 4;
            const float* stp = PIN(I_SSHIFT) + ((size_t)pair * 128 + b) * 1664;
            const f32x4 kkc = *(const f32x4*)(k_k + ch), kac = *(const f32x4*)(k_a + ch);
            {
#pragma unroll
                for (int tt = 0; tt < 2; ++tt) {
                    const int t = rs + tt * 4;
                    const size_t row = NTP + b * 8 + t;
                    const bf16_t* cur = PB + row * LDB;
                    const f32x4 r = shift4(cur, t > 0, stp, ch, mu), k = shift4(cur, t > 0, stp, 512 + ch, mu), v = shift4(cur, t > 0, stp, 1024 + ch, mu);
                    const f32x4 a = ld_bf4(Aa + row * 512 + ch);
                    const f32x4 w = *(const f32x4*)(Wdec + row * 512 + ch);
                    const f32x4 kkv = k * kkc;
                    const float ss = allsum16(dot4(kkv, kkv));
                    const float inv = 1.0f / fmaxf(sqrtf(ss), 1e-12f);
                    const f32x4 kkn = kkv * inv;
                    LAS float* o = vb + t * 384 + cgi * 4;
                    *(LAS f32x4*)(o) = w; *(LAS f32x4*)(o + 64) = k * (1.0f + (a - 1.0f) * kac); *(LAS f32x4*)(o + 128) = kkn; *(LAS f32x4*)(o + 192) = kkn * a;
                    *(LAS f32x4*)(o + 256) = r; *(LAS f32x4*)(o + 320) = v;
                }
            }
            asm volatile("s_waitcnt lgkmcnt(0)" ::: "memory");
            __builtin_amdgcn_wave_barrier();
#pragma unroll 1
            for (int rq = 0; rq < 8; ++rq) {
                const int ri = half * 32 + rq * 4 + rs;
                const size_t so = ((((size_t)pair * 128 + b) * 8 + h) * 64 + ri) * 64 + cgi * 4;
                f32x4 S = *(const f32x4*)(PIN(I_SWKV) + so);
#pragma unroll
                for (int t = 0; t < 8; ++t) {
                    LAS const float* r0 = vb + t * 384 + cgi * 4;
                    float y; scan_step(S, *(LAS const f32x4*)(r0), *(LAS const f32x4*)(r0 + 64), *(LAS const f32x4*)(r0 + 128), *(LAS const f32x4*)(r0 + 192), *(LAS const f32x4*)(r0 + 256), vb[t * 384 + 320 + ri], y);
                    if (cgi == 0) Y[(size_t)(NTP + b * 8 + t) * 512 + h * 64 + ri] = y;
                }
                *(f32x4*)(POUT + O_WKVS + so) = S;
            }
            asm volatile("s_waitcnt lgkmcnt(0)" ::: "memory");
            __builtin_amdgcn_wave_barrier();
        }
    }
    __syncthreads();
    LAS float* rec = (LAS float*)lds;
    for (int pt = cx.bid; pt < 256; pt += cx.nblk) {
        const int xcd = pt & 7, slot = pt >> 3, bh = xcd * 8 + (slot >> 2), rg = slot & 3, b = bh >> 3, h = bh & 7;
        const int lt = tid - 256, ls = (lt >> 4) & 15, lcg = lt & 15, lch = h * 64 + lcg * 4;
        u32x2 qr = {0u, 0u}, qk = {0u, 0u}, qv = {0u, 0u}, pr = {0u, 0u}, pk = {0u, 0u}, pv = {0u, 0u}, qa = {0u, 0u};
        f32x4 qw = (f32x4){0.f, 0.f, 0.f, 0.f};
        f32x4 mur, muk, muv, kkc, kac;
        const int ri = rg * 16 + (wid & 3) * 4 + rs;
        f32x4 S = (f32x4){0.f, 0.f, 0.f, 0.f};
#define SCAN_ISSUE(c) do { const int t_ = (c) * 16 + ls; const size_t row_ = (size_t)b * 2048 + t_; const bf16_t* cur_ = PB + row_ * LDB; \
            qr = *(const u32x2*)(cur_ + lch); qk = *(const u32x2*)(cur_ + 512 + lch); qv = *(const u32x2*)(cur_ + 1024 + lch); \
            if (t_ > 0) { pr = *(const u32x2*)(cur_ - LDB + lch); pk = *(const u32x2*)(cur_ - LDB + 512 + lch); pv = *(const u32x2*)(cur_ - LDB + 1024 + lch); } \
            else { pr = (u32x2){0u, 0u}; pk = pr; pv = pr; } \
            qw = *(const f32x4*)(Wdec + row_ * 512 + lch); qa = *(const u32x2*)(Aa + row_ * 512 + lch); } while (0)
#define SCAN_PROCESS(buf) do { const f32x4 r0_ = cvt4(qr), k0_ = cvt4(qk), v0_ = cvt4(qv); \
            const f32x4 r_ = r0_ + mur * (cvt4(pr) - r0_), k_ = k0_ + muk * (cvt4(pk) - k0_), v_ = v0_ + muv * (cvt4(pv) - v0_), a_ = cvt4(qa); \
            const f32x4 kkv_ = k_ * kkc; const float ss_ = allsum16(dot4(kkv_, kkv_)); const float inv_ = 1.0f / fmaxf(sqrtf(ss_), 1e-12f); \
            const f32x4 kkn_ = kkv_ * inv_; \
            LAS float* o_ = rec + (buf) * 6144 + ls * 384 + lcg * 4; \
            *(LAS f32x4*)(o_) = qw; *(LAS f32x4*)(o_ + 64) = k_ * (1.0f + (a_ - 1.0f) * kac); *(LAS f32x4*)(o_ + 128) = kkn_; *(LAS f32x4*)(o_ + 192) = kkn_ * a_; \
            *(LAS f32x4*)(o_ + 256) = r_; *(LAS f32x4*)(o_ + 320) = v_; } while (0)
        if (wid >= 4) {
            mur = *(const f32x4*)(mu + lch); muk = *(const f32x4*)(mu + 512 + lch); muv = *(const f32x4*)(mu + 1024 + lch);
            kkc = *(const f32x4*)(k_k + lch); kac = *(const f32x4*)(k_a + lch);
            SCAN_ISSUE(0); SCAN_PROCESS(0); SCAN_ISSUE(1);
        }
        __syncthreads();
        for (int c = 0; c < 128; ++c) {
            if (wid < 4) {
                LAS const float* rb = rec + (c & 1) * 6144 + cgi * 4;
                LAS const float* rv = rec + (c & 1) * 6144 + 320 + ri;
                float ykeep = 0.f;
                f32x4 nw = *(LAS const f32x4*)(rb), nk = *(LAS const f32x4*)(rb + 64), nkk = *(LAS const f32x4*)(rb + 128), nb = *(LAS const f32x4*)(rb + 192), nr = *(LAS const f32x4*)(rb + 256);
                float nv = rv[0];
#pragma unroll
                for (int s = 0; s < 16; ++s) {
                    const f32x4 cw = nw, ck = nk, ckk = nkk, cb = nb, cr = nr; const float cv = nv;
                    if (s + 1 < 16) {
                        LAS const float* r1 = rb + (s + 1) * 384;
                        nw = *(LAS const f32x4*)(r1); nk = *(LAS const f32x4*)(r1 + 64); nkk = *(LAS const f32x4*)(r1 + 128); nb = *(LAS const f32x4*)(r1 + 192); nr = *(LAS const f32x4*)(r1 + 256);
                        nv = rv[(s + 1) * 384];
                    }
                    float y;
                    scan_step(S, cw, ck, ckk, cb, cr, cv, y);
                    ykeep = (cgi == s) ? y : ykeep;
                }
                Y[((size_t)b * 2048 + c * 16 + cgi) * 512 + h * 64 + ri] = ykeep;
            } else {
                if (c + 1 < 128) { SCAN_PROCESS((c + 1) & 1); if (c + 2 < 128) SCAN_ISSUE(c + 2); }
            }
            __syncthreads();
        }
        if (wid < 4) *(f32x4*)(POUT + O_WKVP + ((((size_t)pair * 8 + b) * 8 + h) * 64 + ri) * 64 + cgi * 4) = S;
#undef SCAN_ISSUE
#undef SCAN_PROCESS
    }
}

__device__ void phase_even_post(const Params& p, const Ctx cx, int pair) {
    const int gtid = cx.bid * 512 + cx.tid, gthreads = cx.nblk * 512;
    const bf16_t* PA = (const bf16_t*)(PWS + WS_R1);
    bf16_t* Ycat = (bf16_t*)(PWS + WS_YCAT);
    const float* Y = (const float*)(PWS + WS_Y);
    constexpr int NIT = NTOK * 128, UB = 4;
    const float* gn_g = PIN(I_GNG) + pair * 512; const float* gn_b = PIN(I_GNB) + pair * 512;
    for (int e0 = gtid; e0 < NIT; e0 += gthreads * UB) {
        f32x4 y[UB], bv[UB], bz[UB]; bool ok[UB];
#pragma unroll
        for (int u = 0; u < UB; ++u) {
            const int e = e0 + u * gthreads; ok[u] = e < NIT;
            const int ee = ok[u] ? e : e0; const int row = ee >> 7, ch = (ee & 127) * 4;
            y[u] = *(const f32x4*)(Y + (size_t)row * 512 + ch);
            bv[u] = ld_bf4(Ycat + (size_t)row * 1024 + 512 + ch);
            bz[u] = ld_bf4(PA + (size_t)row * LDA + 2048 + ch);
        }
#pragma unroll
        for (int u = 0; u < UB; ++u) {
            const int e = e0 + u * gthreads;
            const int ee = ok[u] ? e : e0; const int row = ee >> 7, ch = (ee & 127) * 4;
            const float mean = allsum16(y[u][0] + y[u][1] + y[u][2] + y[u][3]) * (1.0f / 64.0f);
            const f32x4 d = y[u] - mean;
            const float var = allsum16(dot4(d, d)) * (1.0f / 64.0f);
            const float rstd = rsqrtf(var + 64e-5f);
            const f32x4 g = *(const f32x4*)(gn_g + ch), bb = *(const f32x4*)(gn_b + ch);
            f32x4 o;
#pragma unroll
            for (int j = 0; j < 4; ++j) o[j] = (d[j] * rstd * g[j] + bb[j] + bv[u][j]) * siluf_(bz[u][j]);
            if (ok[u]) st_bf4(Ycat + (size_t)row * 1024 + 512 + ch, o);
        }
    }
    const float* cw = PIN(I_CONVW) + pair * 3 * 512;
    for (int e0 = gtid; e0 < NIT; e0 += gthreads * UB) {
        f32x4 h0[UB], c0v[UB], h1[UB], c1v[UB], h2[UB], c2v[UB], ab[UB], az[UB]; bool ok[UB];
#pragma unroll
        for (int u = 0; u < UB; ++u) {
            const int e = e0 + u * gthreads; ok[u] = e < NIT;
            const int ee = ok[u] ? e : e0; const int row = ee >> 7, ch = (ee & 127) * 4;
            const int t = row < NTP ? (row & 2047) : ((row - NTP) & 7);
            const bf16_t* cur = PA + (size_t)row * LDA + ch;
            const bf16_t* p1 = t >= 1 ? cur - LDA : cur; const bf16_t* p2 = t >= 2 ? cur - 2 * LDA : cur;
            h0[u] = ld_bf4(cur); c0v[u] = ld_bf4(cur + 1024); h1[u] = ld_bf4(p1); c1v[u] = ld_bf4(p1 + 1024); h2[u] = ld_bf4(p2); c2v[u] = ld_bf4(p2 + 1024);
            ab[u] = ld_bf4(cur + 512); az[u] = ld_bf4(cur + 1536);
        }
#pragma unroll
        for (int u = 0; u < UB; ++u) {
            const int e = e0 + u * gthreads;
            const int ee = ok[u] ? e : e0; const int row = ee >> 7, ch = (ee & 127) * 4;
            const bool samp = row >= NTP;
            int b, t, T; if (!samp) { b = row >> 11; t = row & 2047; T = 2048; } else { const int q = row - NTP; b = q >> 3; t = q & 7; T = 8; }
            const f32x4 u0 = c0v[u] * h0[u];
            f32x4 u1 = c1v[u] * h1[u], u2 = c2v[u] * h2[u];
            if (t < 2) {
                const f32x4 zero = (f32x4){0.f, 0.f, 0.f, 0.f};
                const float* hist = PIN(I_SCONV) + ((size_t)pair * 128 + (samp ? b : 0)) * 2 * 512 + ch;
                if (t == 0) { u1 = samp ? *(const f32x4*)(hist + 512) : zero; u2 = samp ? *(const f32x4*)(hist) : zero; }
                else { u2 = samp ? *(const f32x4*)(hist + 512) : zero; }
            }
            const f32x4 k0 = *(const f32x4*)(cw + ch), k1 = *(const f32x4*)(cw + 512 + ch), k2 = *(const f32x4*)(cw + 1024 + ch);
            const f32x4 conv = k0 * u2 + k1 * u1 + k2 * u0;
            f32x4 o;
#pragma unroll
            for (int j = 0; j < 4; ++j) o[j] = ab[u][j] * conv[j] * siluf_(az[u][j]);
            if (ok[u]) {
                st_bf4(Ycat + (size_t)row * 1024 + ch, o);
                if (t >= T - 2) {
                    float* dst = samp ? POUT + O_CONVS + (((size_t)pair * 128 + b) * 2 + (t - (T - 2))) * 512 + ch : POUT + O_CONVP + (((size_t)pair * 8 + b) * 2 + (t - (T - 2))) * 512 + ch;
                    *(f32x4*)dst = u0;
                }
            }
        }
    }
}

__device__ void phase_odd_mixer(const Params& p, const Ctx cx, int pair, LAS unsigned char* lds) {
    const int tid = cx.tid, wid = tid >> 6, lane = tid & 63, fr = lane & 15, fq = lane >> 4;
    const bf16_t* PO = (const bf16_t*)(PWS + WS_R1);
    bf16_t* Ycat = (bf16_t*)(PWS + WS_YCAT);
    LAS bf16_t* LA = (LAS bf16_t*)lds;
    LAS bf16_t* LB = (LAS bf16_t*)(lds + 128 * 136 * 2);
    LAS float* stat = (LAS float*)(lds + 2 * 128 * 136 * 2);
    LAS float* LE = (LAS float*)(lds + 128 * 136 * 2);
    for (int round = 0; round < 8; ++round) {
        int it;
        if (cx.nblk == 256) {
            if (round == 0) it = cx.bid < 136 ? cx.bid : 136 + 136 + (cx.bid - 136);
            else if (round == 1) it = cx.bid < 136 ? 136 + cx.bid : 136 + 136 + 120 + (cx.bid - 136);
            else if (cx.bid >= 136) it = 136 + 136 + 120 * round + (cx.bid - 136);
            else it = 1 << 20;
        } else it = cx.bid + round * cx.nblk;
        if (it >= 680) { if (cx.nblk == 256 ? round >= 4 : true) break; else continue; }
        if (it >= 136) {
            const int ci = it - 136, tile = ci >> 2, g = ci & 3, r0 = tile * 128;
            const bool samp = r0 >= NTP;
            const int w = 2 << g;
            if (!samp) {
                const int t0 = r0 & 2047;
                for (int e = tid; e < 143 * 32; e += 512) {
                    const int er = e >> 5, c = (e & 31) * 4;
                    f32x4 v = (f32x4){0.f, 0.f, 0.f, 0.f};
                    if (t0 + er - 15 >= 0) v = ld_bf4(PO + (size_t)(r0 + er - 15) * LDA + g * 128 + c);
                    *(LAS f32x4*)(LE + er * 128 + c) = v;
                }
                __syncthreads();
                for (int e = tid; e < 128 * 32; e += 512) {
                    const int tl = e >> 5, c = (e & 31) * 4;
                    const f32x4 pt = *(LAS const f32x4*)(LE + (tl + 15) * 128 + c);
                    f32x4 sum = pt;
                    for (int d = 1; d < w; ++d) sum += *(LAS const f32x4*)(LE + (tl + 15 - d) * 128 + c);
                    const float cnt = fminf((float)w, (float)(t0 + tl + 1));
                    const f32x4 pooled = sum * (1.0f / cnt) - pt;
                    u32x2 u; u.x = cvt_pk_bf16(pooled[0], pooled[1]); u.y = cvt_pk_bf16(pooled[2], pooled[3]);
                    *(LAS u32x2*)(LA + tl * 136 + c) = u;
                }
            } else {
                for (int e = tid; e < 128 * 32; e += 512) {
                    const int tl = e >> 5, c = (e & 31) * 4, row = r0 + tl;
                    const int q = row - NTP, b = q >> 3, t = q & 7;
                    const bf16_t* cur = PO + (size_t)row * LDA + g * 128 + c;
                    const f32x4 pt = ld_bf4(cur);
                    f32x4 sum = pt;
                    for (int d = 1; d < w; ++d) {
                        const int tt = t - d;
                        if (tt >= 0) sum += ld_bf4(cur - (size_t)d * LDA);
                        else sum += *(const f32x4*)(PIN(I_SPOOL) + (((size_t)pair * 128 + b) * 15 + (15 + tt)) * 512 + g * 128 + c);
                    }
                    const f32x4 pooled = sum * (1.0f / (float)w) - pt;
                    u32x2 u; u.x = cvt_pk_bf16(pooled[0], pooled[1]); u.y = cvt_pk_bf16(pooled[2], pooled[3]);
                    *(LAS u32x2*)(LA + tl * 136 + c) = u;
                }
            }
            __syncthreads();
            const bf16_t* Bw = (const bf16_t*)(PWS + WS_POOLWT) + ((size_t)pair * 4 + g) * 128 * 128;
            const int row = r0 + wid * 16 + fr;
            bf16x8 af[4];
#pragma unroll
            for (int ks = 0; ks < 4; ++ks) af[ks] = *(const LAS bf16x8*)(LA + (wid * 16 + fr) * 136 + ks * 32 + fq * 8);
#pragma unroll
            for (int nt = 0; nt < 8; ++nt) {
                f32x4 acc = (f32x4){0.f, 0.f, 0.f, 0.f};
#pragma unroll
                for (int ks = 0; ks < 4; ++ks) {
                    const bf16x8 bf = *(const bf16x8*)(Bw + (size_t)(nt * 16 + fr) * 128 + ks * 32 + fq * 8);
                    acc = __builtin_amdgcn_mfma_f32_16x16x32_bf16(bf, af[ks], acc, 0, 0, 0);
                }
                const int d = g * 128 + nt * 16 + fq * 4;
                const f32x4 cz = ld_bf4(PO + (size_t)row * LDA + 512 + d), ps = *(const f32x4*)(PIN(I_PSCALE) + pair * 512 + d);
                f32x4 o;
#pragma unroll
                for (int j = 0; j < 4; ++j) o[j] = acc[j] * ps[j] * siluf_(cz[j]);
                st_bf4(Ycat + (size_t)row * 1024 + d, o);
            }
            __syncthreads();
        } else {
            const int tile = it, r0 = tile * 128;
            const bool samp = r0 >= NTP;
            {
                const int tl = tid >> 2, q = tid & 3;
                const bf16_t* vr = PO + (size_t)(r0 + tl) * LDA + 1536 + q * 128;
                float s_ = 0.f, ss = 0.f;
#pragma unroll
                for (int i = 0; i < 16; ++i) { const u32x4 raw = *(const u32x4*)(vr + i * 8); const f32x4 v0 = cvt4((u32x2){raw.x, raw.y}), v1 = cvt4((u32x2){raw.z, raw.w});
                    s_ += (v0[0] + v0[1]) + (v0[2] + v0[3]) + (v1[0] + v1[1]) + (v1[2] + v1[3]); ss += dot4(v0, v0) + dot4(v1, v1); }
                s_ = allsum4(s_); ss = allsum4(ss);
                const float mean = s_ * (1.0f / 512.0f);
                const float var = fmaxf(ss * (1.0f / 512.0f) - mean * mean, 0.f);
                if (q == 0) { stat[tl * 2] = mean; stat[tl * 2 + 1] = rsqrtf(var + 1e-5f); }
            }
            __syncthreads();
#pragma unroll 1
            for (int g = 0; g < 4; ++g) {
                {
                    const int tl = tid >> 2, q = tid & 3, row = r0 + tl;
                    const float mean = stat[tl * 2], rstd = stat[tl * 2 + 1];
                    const bf16_t* vr = PO + (size_t)row * LDA + 1536 + g * 128 + q * 32;
                    const float* lg = PIN(I_LNG) + pair * 512 + g * 128 + q * 32; const float* lb = PIN(I_LNB) + pair * 512 + g * 128 + q * 32;
#pragma unroll
                    for (int i = 0; i < 8; ++i) {
                        const f32x4 v = ld_bf4(vr + i * 4);
                        const f32x4 vn = (v - mean) * rstd * *(const f32x4*)(lg + i * 4) + *(const f32x4*)(lb + i * 4);
                        if (samp) *(f32x4*)(POUT + O_CHUNKV + ((size_t)pair * 1024 + (row - NTP)) * 512 + g * 128 + q * 32 + i * 4) = vn;
#pragma unroll
                        for (int j = 0; j < 4; ++j) LB[(q * 32 + i * 4 + j) * 136 + tl] = (bf16_t)(cvt_pk_bf16(vn[j], 0.f) & 0xffffu);
                    }
                }
                if (!samp) {
                    const bf16_t* Wsrc = (const bf16_t*)(PWS + WS_SPW) + ((size_t)pair * 4 + g) * 128 * 128;
                    for (int e = tid; e < 128 * 16; e += 512) { const int t = e >> 4, s8 = (e & 15) * 8; *(LAS u32x4*)(LA + t * 136 + s8) = *(const u32x4*)(Wsrc + t * 128 + s8); }
                } else {
                    const float* Wsrc = PIN(I_SPW) + ((size_t)pair * 4 + g) * 128 * 128;
                    for (int e = tid; e < 128 * 128; e += 512) { const int t = e >> 7, s2 = e & 127;
                        const float v = ((t >> 3) == (s2 >> 3) && (s2 & 7) <= (t & 7)) ? Wsrc[(t & 7) * 128 + (s2 & 7)] : 0.f;
                        LA[t * 136 + s2] = (bf16_t)(cvt_pk_bf16(v, 0.f) & 0xffffu); }
                }
                __syncthreads();
                {
                    const int tl = wid * 16 + fr, row = r0 + tl;
                    const float bias = PIN(I_SPB)[((size_t)pair * 4 + g) * 128 + (samp ? (tl & 7) : tl)];
                    bf16x8 wf[4];
#pragma unroll
                    for (int ks = 0; ks < 4; ++ks) wf[ks] = *(const LAS bf16x8*)(LA + tl * 136 + ks * 32 + fq * 8);
#pragma unroll
                    for (int nt = 0; nt < 8; ++nt) {
                        f32x4 acc = (f32x4){0.f, 0.f, 0.f, 0.f};
#pragma unroll
                        for (int ks = 0; ks < 4; ++ks) {
                            if (ks * 32 <= wid * 16 + 15) {
                                const bf16x8 vf = *(const LAS bf16x8*)(LB + (nt * 16 + fr) * 136 + ks * 32 + fq * 8);
                                acc = __builtin_amdgcn_mfma_f32_16x16x32_bf16(vf, wf[ks], acc, 0, 0, 0);
                            }
                        }
                        const int c = g * 128 + nt * 16 + fq * 4;
                        const f32x4 u = ld_bf4(PO + (size_t)row * LDA + 1024 + c), dz = ld_bf4(PO + (size_t)row * LDA + 2048 + c);
                        f32x4 o;
#pragma unroll
                        for (int j = 0; j < 4; ++j) o[j] = u[j] * (acc[j] + bias) * siluf_(dz[j]);
                        st_bf4(Ycat + (size_t)row * 1024 + 512 + c, o);
                    }
                }
                __syncthreads();
            }
        }
    }
    const int gtid = cx.bid * 512 + tid, gthreads = cx.nblk * 512;
    for (int e = gtid; e < 136 * 15 * 512; e += gthreads) {
        const int c = e & 511, q = e >> 9, sr = q / 15, k = q % 15;
        if (sr < 8) POUT[O_POOLP + (((size_t)pair * 8 + sr) * 15 + k) * 512 + c] = bf2f(PO[(size_t)(sr * 2048 + 2033 + k) * LDA + c]);
        else { const int b = sr - 8;
            POUT[O_POOLS + (((size_t)pair * 128 + b) * 15 + k) * 512 + c] = (k < 7) ? PIN(I_SPOOL)[(((size_t)pair * 128 + b) * 15 + 8 + k) * 512 + c] : bf2f(PO[(size_t)(NTP + b * 8 + (k - 7)) * LDA + c]); }
    }
}

__device__ void phase_final(const Params& p, const Ctx cx) {
    const int gtid = cx.bid * 512 + cx.tid, gthreads = cx.nblk * 512;
    const float* ssq = (const float*)(PWS + WS_SSQ) + (size_t)4 * NTOK * 16;
    const bf16_t* Xb = (const bf16_t*)(PWS + WS_XB);
    constexpr int NIT = NTOK * 256, UB = 4;
    for (int e0 = gtid; e0 < NIT; e0 += gthreads * UB) {
        f32x4 x[UB]; float sq[UB]; bool ok[UB];
#pragma unroll
        for (int u = 0; u < UB; ++u) { const int e = e0 + u * gthreads; ok[u] = e < NIT; const int ee = ok[u] ? e : e0; const int row = ee >> 8, c = (ee & 255) * 4;
            x[u] = ld_bf4(Xb + (size_t)row * 1024 + c); sq[u] = ssq_sum(ssq + (size_t)row * 16); }
#pragma unroll
        for (int u = 0; u < UB; ++u) { const int e = e0 + u * gthreads; const int ee = ok[u] ? e : e0; const int row = ee >> 8, c = (ee & 255) * 4;
            const float rstd = rsqrtf(sq[u] * (1.0f / 1024.0f) + 1e-6f);
            if (ok[u]) *(f32x4*)(POUT + (size_t)row * 1024 + c) = x[u] * rstd * *(const f32x4*)(PIN(I_FNORMW) + c); }
    }
}

#define XB_TMO      128
#define XB_XCNT(j)  (256  + 64 * (j))
#define XB_XSUB(j)  (1280 + 64 * (j))
#define XB_XGEN(j)  (2304 + 64 * (j))
#define XB_TOP      3328
#define XB_TOPGEN   3392
#define XCD_BAR_WORDS 3456
#define XB_SPIN_CAP (1u << 18)
__device__ __forceinline__ unsigned xb_ld(unsigned* p)              { return __hip_atomic_load(p, __ATOMIC_RELAXED, __HIP_MEMORY_SCOPE_AGENT); }
__device__ __forceinline__ unsigned xb_add(unsigned* p, unsigned v) { return __hip_atomic_fetch_add(p, v, __ATOMIC_RELAXED, __HIP_MEMORY_SCOPE_AGENT); }
__device__ __forceinline__ unsigned xb_xcc_id() { return (unsigned)__builtin_amdgcn_s_getreg((3 << 11) | 20) & 0xFu; }
#define XB_SPIN(cond, bar) do { unsigned _sp = 0; while (cond) { __builtin_amdgcn_s_sleep(1); \
    if ((++_sp & 255u) == 0u) { if (xb_ld(&(bar)[XB_TMO])) break; if (_sp > XB_SPIN_CAP) { atomicAdd(&(bar)[XB_TMO], 1u); break; } } } } while (0)
struct XcdBarrier { unsigned* bar; unsigned x; volatile LAS unsigned* st; };
__device__ __forceinline__ XcdBarrier xcd_barrier_post(unsigned* bar, volatile LAS unsigned* st) {
    XcdBarrier b; b.bar = bar; b.x = xb_xcc_id(); b.st = st;
    if (threadIdx.x == 0) (void)xb_add(&bar[XB_XCNT(b.x)], 1u);
    return b;
}
__device__ __forceinline__ void xcd_barrier_complete(unsigned* bar, unsigned x, unsigned& nloc, unsigned& nx) {
    const unsigned G = gridDim.x * gridDim.y * gridDim.z;
    unsigned sum, cnt, mine, sp = 0u;
    for (;;) {
        sum = 0u; cnt = 0u; mine = 0u;
#pragma unroll
        for (unsigned j = 0; j < 16; ++j) { const unsigned c = xb_ld(&bar[XB_XCNT(j)]); sum += c; cnt += (c > 0u) ? 1u : 0u; mine = (j == x) ? c : mine; }
        if (sum == G) break;
        __builtin_amdgcn_s_sleep(1);
        if ((++sp & 255u) == 0u) { if (xb_ld(&bar[XB_TMO])) break; if (sp > XB_SPIN_CAP) { atomicAdd(&bar[XB_TMO], 1u); break; } }
    }
    nloc = mine > 0u ? mine : 1u; nx = cnt > 0u ? cnt : 1u;
}
__device__ __forceinline__ void xcd_barrier(const XcdBarrier& b) {
    asm volatile("s_waitcnt vmcnt(0)" ::: "memory");
    __syncthreads();
    if (threadIdx.x == 0) {
        unsigned* bar = b.bar;
        __builtin_amdgcn_s_waitcnt(0);
        unsigned nloc = b.st[0], nx = b.st[1];
        if (nloc == 0u) { xcd_barrier_complete(bar, b.x, nloc, nx); b.st[0] = nloc; b.st[1] = nx; }
        const unsigned old = xb_add(&bar[XB_XSUB(b.x)], 1u);
        const unsigned gen = old / nloc;
        if (old + 1u == (gen + 1u) * nloc) {
            __builtin_amdgcn_fence(__ATOMIC_RELEASE, "agent");
            asm volatile("s_waitcnt vmcnt(0)" ::: "memory");
            const unsigned og = xb_add(&bar[XB_TOP], 1u);
            const unsigned tg = og / nx;
            if (og + 1u == (tg + 1u) * nx) xb_add(&bar[XB_TOPGEN], 1u);
            else XB_SPIN(xb_ld(&bar[XB_TOPGEN]) == tg, bar);
            __builtin_amdgcn_fence(__ATOMIC_ACQUIRE, "agent");
            xb_add(&bar[XB_XGEN(b.x)], 1u);
            asm volatile("s_waitcnt vmcnt(0)" ::: "memory");
        } else {
            XB_SPIN(xb_ld(&bar[XB_XGEN(b.x)]) == gen, bar);
            __builtin_amdgcn_fence(__ATOMIC_ACQUIRE, "agent");
            asm volatile("s_waitcnt vmcnt(0)" ::: "memory");
        }
    }
    __syncthreads();
}

__device__ void run_gemm_proj(const Params& p, const Ctx cx, LAS unsigned char* lds, const bf16_t* Bt, int N, bf16_t* O, int ldc, int layer) {
    pg8::Gemm g{(const bf16_t*)(PWS + WS_XB), Bt, NTOK, N, 1024};
    pg8::StaticOrder S; S.init(NTOK, N, (int)cx.nblk, (int)cx.bid);
    EpiProj E{O, ldc, (const float*)(PWS + WS_SSQ) + (size_t)layer * NTOK * 16};
    pg8::gemm_phase<EpiProj>(cx, lds, g, S, E);
}
__device__ void run_gemm_res(const Params& p, const Ctx cx, LAS unsigned char* lds, const bf16_t* Bt, int layer) {
    const bf16_t* A = (const bf16_t*)(PWS + WS_YCAT);
    bf16_t* Xb = (bf16_t*)(PWS + WS_XB);
    float* ssqn = (float*)(PWS + WS_SSQ) + (size_t)(layer + 1) * NTOK * 16;
    pg8::Gemm g{A, Bt, NTOK, 1024, 1024};
    pg8::StaticOrder S; S.init(NTOK, 1024, (int)cx.nblk, (int)cx.bid);
    EpiRes E{layer == 0 ? PIN(I_XP) : nullptr, PIN(I_XS), Xb, ssqn};
    pg8::gemm_phase<EpiRes>(cx, lds, g, S, E);
}

constexpr int N_PHASES = 20;
#ifndef PHMASK
#define PHMASK 0xffff
#endif
#define PHON(n) ((PHMASK >> ((n) % 16)) & 1)
__global__ void __launch_bounds__(512, 2) fwd_kernel(Params p) {
    extern __shared__ __attribute__((aligned(16))) unsigned char lds_raw[];
    LAS unsigned char* lds = (LAS unsigned char*)lds_raw;
    volatile LAS unsigned* bar_st = (volatile LAS unsigned*)(lds + 131072);
    if (threadIdx.x < 4) bar_st[threadIdx.x] = 0u;
    __syncthreads();
    const XcdBarrier gbar = xcd_barrier_post((unsigned*)((unsigned char*)p.ptr[30] + WS_BAR), bar_st);
    if (p.ph_hi < 0) cg::this_grid().sync();
#define GRID_SYNC() xcd_barrier(gbar)
#ifdef SYNCPROBE
    for (int i = 0; i < SYNCPROBE; ++i) GRID_SYNC();
#endif
#ifdef REPMASK
    for (int pc = p.ph_lo * 2; pc < p.ph_hi * 2; ++pc) {
        const int ph = pc >> 1;
        { const int s_ = (ph == 0) ? 9 : (ph == N_PHASES - 1) ? 31 : (ph - 1) % 9; if ((pc & 1) && !((REPMASK >> s_) & 1)) continue; }
        if (pc > p.ph_lo * 2) GRID_SYNC();
#else
    for (int ph = p.ph_lo; ph < p.ph_hi; ++ph) {
        if (ph > p.ph_lo) GRID_SYNC();
#endif
        Ctx cx; cx.tid = threadIdx.x; cx.bid = blockIdx.x; cx.nblk = gridDim.x;
        asm volatile("s_mov_b32 %0, 0" : "=s"(cx.z));
        asm volatile("" : "+v"(cx.tid)); asm volatile("" : "+s"(cx.bid)); asm volatile("" : "+s"(cx.nblk));
        const int pair = (ph - 1) / 9, s = (ph == 0) ? 100 : (ph == N_PHASES - 1 ? 101 : (ph - 1) % 9);
        if (s == 0 || s == 3 || s == 6) {
#if PHON(0)
            const bf16_t* WinE = (const bf16_t*)(PWS + WS_WINE) + (size_t)pair * 4352 * 1024;
            const bf16_t* Bt = s == 0 ? WinE + (size_t)2560 * 1024 : (s == 3 ? WinE : (const bf16_t*)(PWS + WS_WINO) + (size_t)pair * 2560 * 1024);
            const int N = s == 0 ? 1792 : 2560;
            run_gemm_proj(p, cx, lds, Bt, N, (bf16_t*)(PWS + WS_R1), N, 2 * pair + (s == 6 ? 1 : 0));
#endif
        } else if (s == 5 || s == 8) {
#if PHON(5)
            const bf16_t* Bt = (const bf16_t*)(PWS + (s == 5 ? WS_WOUTE : WS_WOUTO)) + (size_t)pair * 1024 * 1024;
            run_gemm_res(p, cx, lds, Bt, 2 * pair + (s == 8 ? 1 : 0));
#endif
        } else if (s == 1) {
#if PHON(1)
            phase_even_prep(p, cx, pair);
#endif
        } else if (s == 2) {
#if PHON(2)
            phase_scan(p, cx, pair, lds);
#endif
        } else if (s == 4) {
#if PHON(4)
            phase_even_post(p, cx, pair);
#endif
        } else if (s == 7) {
#if PHON(7)
            phase_odd_mixer(p, cx, pair, lds);
#endif
        } else if (s == 100) {
#if PHON(10)
            phase_prepass(p, cx, lds);
#endif
        } else {
#if PHON(11)
            phase_final(p, cx);
#endif
        }
    }
}

extern "C" void kernel_launch(void* const* d_in, const int* in_sizes, int n_in, void* d_out, int out_size, void* d_ws, size_t ws_size, hipStream_t stream) {
    static int grid = 0;
    if (grid == 0) {
        if (n_in != 29 || ws_size < WS_END) { fprintf(stderr, "kernel_launch: unexpected n_in %d / ws_size %zu (need %zu)\n", n_in, ws_size, (size_t)WS_END); grid = -1; return; }
        int dev = 0, cus = 0, per_cu = 0;
        hipGetDevice(&dev);
        hipDeviceGetAttribute(&cus, hipDeviceAttributeMultiprocessorCount, dev);
        if (hipFuncSetAttribute((const void*)fwd_kernel, hipFuncAttributeMaxDynamicSharedMemorySize, LDS_BYTES) != hipSuccess) { fprintf(stderr, "kernel_launch: hipFuncSetAttribute failed\n"); grid = -1; return; }
        if (hipOccupancyMaxActiveBlocksPerMultiprocessor(&per_cu, (const void*)fwd_kernel, 512, LDS_BYTES) != hipSuccess || per_cu < 1) { fprintf(stderr, "kernel_launch: occupancy query gave %d\n", per_cu); per_cu = 1; }
        (void)hipGetLastError();
        grid = cus * per_cu;
        if (grid > 256) grid = 256;
    }
    if (grid < 0) return;
    Params p{};
    for (int i = 0; i < 29; ++i) p.ptr[i] = d_in[i];
    p.ptr[29] = d_out; p.ptr[30] = d_ws; p.ptr[31] = nullptr;
    (void)hipMemsetAsync((unsigned char*)d_ws + WS_BAR, 0, 16384, stream);
#if ONE_LAUNCH
    p.ph_lo = 0; p.ph_hi = N_PHASES;
    void* args[] = {&p};
    hipError_t e = hipLaunchCooperativeKernel((const void*)fwd_kernel, dim3(grid), dim3(512), args, LDS_BYTES, stream);
    if (e != hipSuccess) fprintf(stderr, "cooperative launch failed: %s (grid %d)\n", hipGetErrorString(e), grid);
#else
    for (int ph = 0; ph < N_PHASES; ++ph) {
        p.ph_lo = ph; p.ph_hi = ph + 1;
        hipLaunchKernelGGL(fwd_kernel, dim3(grid), dim3(512), LDS_BYTES, stream, p);
    }
#endif
}
```

```cpp
#include <hip/hip_runtime.h>
#include <hip/hip_cooperative_groups.h>
#include <cstdio>
namespace cg = cooperative_groups;

#ifndef ONE_LAUNCH
#define ONE_LAUNCH 1
#endif

#define LAS __attribute__((address_space(3)))
typedef unsigned short bf16_t;
typedef short bf16x8 __attribute__((ext_vector_type(8)));
typedef float f32x4 __attribute__((ext_vector_type(4)));
typedef unsigned u32x4 __attribute__((ext_vector_type(4)));
typedef unsigned u32x2 __attribute__((ext_vector_type(2)));

constexpr int NTOK = 17408, NTP = 16384;
constexpr int LDB = 1792;
constexpr int LDA = 2560;
constexpr size_t O_CONVP = 17825792, O_CONVS = 17842176, O_SHIFTP = 18104320, O_SHIFTS = 18130944, O_WKVP = 18556928, O_WKVS = 19081216,
                 O_POOLP = 27469824, O_POOLS = 27592704, O_CHUNKV = 29558784;
constexpr size_t WS_WINE = 0;
constexpr size_t WS_WOUTE = WS_WINE + 2ull * 4352 * 1024 * 2;
constexpr size_t WS_WINO = WS_WOUTE + 2ull * 1024 * 1024 * 2;
constexpr size_t WS_WOUTO = WS_WINO + 2ull * 2560 * 1024 * 2;
constexpr size_t WS_W2T = WS_WOUTO + 2ull * 1024 * 1024 * 2;
constexpr size_t WS_A2T = WS_W2T + 2ull * 512 * 64 * 2;
constexpr size_t WS_POOLWT = WS_A2T + 2ull * 512 * 64 * 2;
constexpr size_t WS_SPW = WS_POOLWT + 8ull * 128 * 128 * 2;
constexpr size_t WS_XB = WS_SPW + 8ull * 128 * 128 * 2;
constexpr size_t WS_YCAT = WS_XB + (size_t)NTOK * 1024 * 2;
constexpr size_t WS_SSQ = WS_YCAT + (size_t)NTOK * 1024 * 2;
constexpr size_t WS_Y = WS_SSQ + 5ull * NTOK * 16 * 4;
constexpr size_t WS_R1 = WS_Y + (size_t)NTOK * 512 * 4;
constexpr size_t WS_PROJB = WS_R1;
constexpr size_t WS_WDEC = WS_PROJB + (size_t)NTOK * LDB * 2;
constexpr size_t WS_AA = WS_WDEC + (size_t)NTOK * 512 * 4;
constexpr size_t WS_BAR = WS_AA + (size_t)NTOK * 512 * 2;
constexpr size_t WS_END = WS_BAR + 16384;
constexpr int LDS_MAIN = 147456;
constexpr int LDS_BYTES = LDS_MAIN + 16;

struct Params {
    const void* ptr[32];
    int ph_lo, ph_hi;
};
struct Ctx { int tid, bid, nblk, z; };
#define PIN(i) ((const float*)p.ptr[(i) + cx.z])
#define POUT ((float*)p.ptr[29 + cx.z])
#define PWS ((unsigned char*)p.ptr[30 + cx.z])
enum { I_XP = 0, I_XS, I_SCONV, I_SSHIFT, I_SWKV, I_SPOOL, I_NORMW, I_FNORMW, I_WINE, I_CONVW, I_MU, I_W0, I_W2, I_A0, I_A2, I_KK, I_KA, I_RK, I_GNG, I_GNB,
       I_WOUTE, I_WINO, I_POOLW, I_PSCALE, I_LNG, I_LNB, I_SPW, I_SPB, I_WOUTO };

__device__ __forceinline__ unsigned cvt_pk_bf16(float lo, float hi) { unsigned r; asm("v_cvt_pk_bf16_f32 %0, %1, %2" : "=v"(r) : "v"(lo), "v"(hi)); return r; }
__device__ __forceinline__ float bf_lo(unsigned u) { return __uint_as_float(u << 16); }
__device__ __forceinline__ float bf_hi(unsigned u) { return __uint_as_float(u & 0xffff0000u); }
__device__ __forceinline__ float bf2f(bf16_t b) { return __uint_as_float(((unsigned)b) << 16); }
__device__ __forceinline__ f32x4 cvt4(u32x2 u) { return (f32x4){bf_lo(u.x), bf_hi(u.x), bf_lo(u.y), bf_hi(u.y)}; }
__device__ __forceinline__ f32x4 ld_bf4(const bf16_t* p) { return cvt4(*(const u32x2*)p); }
__device__ __forceinline__ void st_bf4(bf16_t* p, f32x4 v) { u32x2 u; u.x = cvt_pk_bf16(v[0], v[1]); u.y = cvt_pk_bf16(v[2], v[3]); *(u32x2*)p = u; }
__device__ __forceinline__ float sigmoidf_(float x) { return 1.0f / (1.0f + __expf(-x)); }
__device__ __forceinline__ float siluf_(float x) { return x / (1.0f + __expf(-x)); }
template <int CTRL> __device__ __forceinline__ float dpp_f(float x) { return __builtin_bit_cast(float, __builtin_amdgcn_mov_dpp(__builtin_bit_cast(int, x), CTRL, 0xf, 0xf, true)); }
__device__ __forceinline__ float allsum16(float x) { x += dpp_f<0xB1>(x); x += dpp_f<0x4E>(x); x += dpp_f<0x141>(x); x += dpp_f<0x128>(x); return x; }
__device__ __forceinline__ float allsum4(float x) { x += dpp_f<0xB1>(x); x += dpp_f<0x4E>(x); return x; }
__device__ __forceinline__ float dot4(f32x4 a, f32x4 b) { return a[0] * b[0] + a[1] * b[1] + a[2] * b[2] + a[3] * b[3]; }

__device__ __forceinline__ float ssq_sum(const float* part) {
    const f32x4 a = *(const f32x4*)(part), b = *(const f32x4*)(part + 4), c = *(const f32x4*)(part + 8), d = *(const f32x4*)(part + 12);
    return ((a[0] + a[1]) + (a[2] + a[3])) + ((b[0] + b[1]) + (b[2] + b[3])) + ((c[0] + c[1]) + (c[2] + c[3])) + ((d[0] + d[1]) + (d[2] + d[3]));
}

namespace pg8 {
constexpr int BM = 256, BK = 64, HALF = 128, HTB = HALF * BK * 2, NXCD = 8, WGM = 8;
__device__ __forceinline__ int lds_byte(int r, int c) { const int st = (r >> 4) * 2 + (c >> 5), rr = r & 15, cc = c & 31, ob = rr * 64 + cc * 2; return st * 1024 + (ob ^ (((ob >> 9) & 1) << 5)); }
__device__ __forceinline__ void stage_rc(int b, int& R, int& C) { const int st = b / 1024, sb = b % 1024, swz = sb ^ (((sb >> 9) & 1) << 5); R = (st >> 1) * 16 + swz / 64; C = (st & 1) * 32 + (swz % 64) / 2; }
__device__ __forceinline__ int perm32(int rho) { const int n = rho >> 4, i = rho & 15; return 8 * (i >> 2) + 4 * n + (i & 3); }
struct Unit { int pm, pn; };
struct Gemm { const bf16_t* A; const bf16_t* Bt; int M, N, K; };
struct StaticOrder {
    int nM, nN, nwg, G, c;
    __device__ void init(int M, int N, int G_, int c_) { nM = M / BM; nN = N / BM; nwg = nM * nN; G = G_; c = c_; }
    __device__ bool next(int i, Unit& u) const {
        const long L = (long)i * G + c; if (L >= nwg) return false;
        int wgid = (int)L; { const int q = nwg / NXCD, r = nwg % NXCD, xcd = wgid % NXCD, off = wgid / NXCD; wgid = (xcd < r ? xcd * (q + 1) : r * (q + 1) + (xcd - r) * q) + off; }
        const int nig = WGM * nN, gid = wgid / nig, fm = gid * WGM, gsz = (nM - fm) < WGM ? (nM - fm) : WGM;
        u.pm = fm + ((wgid % nig) % gsz); u.pn = (wgid % nig) / gsz; return true;
    }
};

template <class Epi>
__device__ __forceinline__ void gemm_phase(const Ctx cx, LAS unsigned char* lds, const Gemm g, const StaticOrder& S, const Epi& E) {
    const int tid = cx.tid, wid = __builtin_amdgcn_readfirstlane(tid >> 6), lane = tid & 63, wr = wid >> 2, wc = wid & 3, fr = lane & 15, fq = lane >> 4;
    const int K = g.K, nt = K / BK;
    unsigned voffA[2], voffB[2];
#pragma unroll
    for (int i = 0; i < 2; ++i) { int R, C; stage_rc(tid * 16 + i * 8192, R, C); const int Rb = Epi::PERM ? ((R & ~31) + perm32(R & 31)) : R;
        voffA[i] = (unsigned)(R * K + C) * 2u; voffB[i] = (unsigned)(Rb * K + C) * 2u; }
    const size_t kstep = (size_t)(BK * 2);
    const size_t hstep = (size_t)HALF * K * 2;
    const size_t tstep = 2 * hstep;
    const unsigned ldsw = (unsigned)wid * 1024u;
    const int aoff = lds_byte(wr * 64 + fr, fq * 8), boff = lds_byte(wc * 32 + fr, fq * 8);
#define PG8_SA(b, h) (((b) * 2 + (h)) * HTB)
#define PG8_SB(b, h) ((4 + (b) * 2 + (h)) * HTB)
#define PG8_STAGE(bufoff, gbase, voff) do { _Pragma("unroll") for (int _i = 0; _i < 2; ++_i) \
        __builtin_amdgcn_global_load_lds((const unsigned*)((const char*)(gbase) + (voff)[_i]), (LAS unsigned*)(lds + (bufoff) + ldsw + _i * 8192), 16, 0, 0); } while (0)
#define PG8_LDA(dst, b, h) do { _Pragma("unroll") for (int m = 0; m < 4; ++m) _Pragma("unroll") for (int k = 0; k < 2; ++k) dst[m][k] = *(const LAS bf16x8*)(lds + PG8_SA(b, h) + aoff + m * 2048 + k * 1024); } while (0)
#define PG8_LDB(dst, b, h) do { _Pragma("unroll") for (int n = 0; n < 2; ++n) _Pragma("unroll") for (int k = 0; k < 2; ++k) dst[n][k] = *(const LAS bf16x8*)(lds + PG8_SB(b, h) + boff + n * 2048 + k * 1024); } while (0)
#define PG8_MMA(ai, bj, At, Bt) do { __builtin_amdgcn_s_setprio(1); _Pragma("unroll") for (int m = 0; m < 4; ++m) _Pragma("unroll") for (int n = 0; n < 2; ++n) _Pragma("unroll") for (int k = 0; k < 2; ++k) \
        acc[ai][bj][m][n] = __builtin_amdgcn_mfma_f32_16x16x32_bf16(Bt[n][k], At[m][k], acc[ai][bj][m][n], 0, 0, 0); __builtin_amdgcn_s_setprio(0); } while (0)
#define PG8_WAIT_V(n) asm volatile("s_waitcnt vmcnt(" #n ")" ::: "memory")
#define PG8_WAIT_L(n) asm volatile("s_waitcnt lgkmcnt(" #n ")" ::: "memory")
#define PG8_BAR __builtin_amdgcn_s_barrier()
#define PG8_SCHED __builtin_amdgcn_sched_barrier(0)
    Unit cur, nxt; int ui = 0;
    if (!S.next(0, cur)) return;
    f32x4 acc[2][2][4][2];
#pragma unroll
    for (int a = 0; a < 2; ++a)
#pragma unroll
        for (int b = 0; b < 2; ++b)
#pragma unroll
            for (int m = 0; m < 4; ++m)
#pragma unroll
                for (int n = 0; n < 2; ++n) acc[a][b][m][n] = (f32x4){0.f, 0.f, 0.f, 0.f};
    bf16x8 At[4][2], B0[2][2], B1[2][2];
    const char* cA = (const char*)g.A + (size_t)cur.pm * tstep; const char* cB = (const char*)g.Bt + (size_t)cur.pn * tstep;
    PG8_STAGE(PG8_SB(0, 0), cB, voffB); PG8_STAGE(PG8_SA(0, 0), cA, voffA); PG8_STAGE(PG8_SB(0, 1), cB + hstep, voffB); PG8_STAGE(PG8_SA(0, 1), cA + hstep, voffA);
    if (wr == 1) PG8_BAR;
    PG8_WAIT_V(4); PG8_BAR;
    PG8_STAGE(PG8_SB(1, 0), cB + kstep, voffB); PG8_STAGE(PG8_SA(1, 0), cA + kstep, voffA); PG8_STAGE(PG8_SB(1, 1), cB + hstep + kstep, voffB);
    PG8_WAIT_V(6); PG8_BAR;
    for (;;) {
        const bool has_next = S.next(ui + 1, nxt);
        const char* nA = has_next ? (const char*)g.A + (size_t)nxt.pm * tstep : cA; const char* nB = has_next ? (const char*)g.Bt + (size_t)nxt.pn * tstep : cB;
        for (int t = 0; t < nt; t += 2) {
            const bool last = (t == nt - 2);
            const char* a1 = cA + (size_t)(t + 1) * kstep;
            const char* a2 = last ? nA : cA + (size_t)(t + 2) * kstep; const char* b2 = last ? nB : cB + (size_t)(t + 2) * kstep;
            const char* a3 = a2 + kstep; const char* b3 = b2 + kstep;
            PG8_LDB(B0, 0, 0); PG8_SCHED; PG8_LDA(At, 0, 0); PG8_STAGE(PG8_SA(1, 1), a1 + hstep, voffA);
            PG8_WAIT_L(8); PG8_BAR; PG8_WAIT_L(0); PG8_MMA(0, 0, At, B0); PG8_BAR; PG8_SCHED;
            PG8_LDB(B1, 0, 1); PG8_STAGE(PG8_SB(0, 0), b2, voffB);
            PG8_BAR; PG8_WAIT_L(0); PG8_MMA(0, 1, At, B1); PG8_BAR;
            PG8_LDA(At, 0, 1); PG8_STAGE(PG8_SA(0, 0), a2, voffA);
            PG8_BAR; PG8_WAIT_L(0); PG8_MMA(1, 0, At, B0); PG8_BAR; PG8_SCHED;
            PG8_STAGE(PG8_SB(0, 1), b2 + hstep, voffB);
            PG8_WAIT_V(6); PG8_BAR; PG8_MMA(1, 1, At, B1); PG8_BAR;
            PG8_LDB(B0, 1, 0); PG8_SCHED; PG8_LDA(At, 1, 0); PG8_STAGE(PG8_SA(0, 1), a2 + hstep, voffA);
            PG8_WAIT_L(8); PG8_BAR; PG8_WAIT_L(0); PG8_MMA(0, 0, At, B0); PG8_BAR; PG8_SCHED;
            PG8_LDB(B1, 1, 1); PG8_STAGE(PG8_SB(1, 0), b3, voffB);
            PG8_BAR; PG8_WAIT_L(0); PG8_MMA(0, 1, At, B1); PG8_BAR;
            PG8_LDA(At, 1, 1); PG8_STAGE(PG8_SA(1, 0), a3, voffA);
            PG8_BAR; PG8_WAIT_L(0); PG8_MMA(1, 0, At, B0); PG8_BAR; PG8_SCHED;
            PG8_STAGE(PG8_SB(1, 1), b3 + hstep, voffB);
            PG8_WAIT_V(6); PG8_BAR; PG8_MMA(1, 1, At, B1); PG8_BAR;
        }
        E(acc, cur, wr, wc, fr, fq);
        if (!has_next) break;
#pragma unroll
        for (int a = 0; a < 2; ++a)
#pragma unroll
            for (int b = 0; b < 2; ++b)
#pragma unroll
                for (int m = 0; m < 4; ++m)
#pragma unroll
                    for (int n = 0; n < 2; ++n) acc[a][b][m][n] = (f32x4){0.f, 0.f, 0.f, 0.f};
        cur = nxt; cA = nA; cB = nB; ++ui;
    }
    PG8_WAIT_V(0);
    if (wr == 0) PG8_BAR;
    PG8_BAR;
#undef PG8_SA
#undef PG8_SB
#undef PG8_STAGE
#undef PG8_LDA
#undef PG8_LDB
#undef PG8_MMA
#undef PG8_WAIT_V
#undef PG8_WAIT_L
#undef PG8_BAR
#undef PG8_SCHED
}
}

struct EpiProj {
    static constexpr bool PERM = true;
    bf16_t* O; int ldc; const float* ssq;
    __device__ __forceinline__ void operator()(const f32x4 (&acc)[2][2][4][2], const pg8::Unit& u, int wr, int wc, int fr, int fq) const {
        const int row0 = u.pm * 256 + wr * 64 + fr, col0 = u.pn * 256 + wc * 32 + 8 * fq;
#pragma unroll
        for (int ai = 0; ai < 2; ++ai)
#pragma unroll
            for (int m = 0; m < 4; ++m) {
                const int row = row0 + ai * 128 + m * 16;
                const float rstd = rsqrtf(ssq_sum(ssq + (size_t)row * 16) * (1.0f / 1024.0f) + 1e-6f);
                bf16_t* rowp = O + (size_t)row * ldc + col0;
#pragma unroll
                for (int bj = 0; bj < 2; ++bj) {
                    const f32x4 v0 = acc[ai][bj][m][0] * rstd, v1 = acc[ai][bj][m][1] * rstd;
                    u32x4 w; w.x = cvt_pk_bf16(v0[0], v0[1]); w.y = cvt_pk_bf16(v0[2], v0[3]); w.z = cvt_pk_bf16(v1[0], v1[1]); w.w = cvt_pk_bf16(v1[2], v1[3]);
                    *(u32x4*)(rowp + bj * 128) = w;
                }
            }
    }
};
struct X8 { f32x4 lo, hi; };
template <bool FIRST> __device__ __forceinline__ X8 ld_x8(const float* __restrict__ s32, const bf16_t* __restrict__ s16, size_t o) {
    X8 r;
    if (FIRST) { r.lo = *(const f32x4*)(s32 + o); r.hi = *(const f32x4*)(s32 + o + 4); }
    else { const u32x4 u = *(const u32x4*)(s16 + o); r.lo = cvt4((u32x2){u.x, u.y}); r.hi = cvt4((u32x2){u.z, u.w}); }
    return r;
}
__device__ __forceinline__ void st_x8(bf16_t* p, f32x4 lo, f32x4 hi) { u32x4 w; w.x = cvt_pk_bf16(lo[0], lo[1]); w.y = cvt_pk_bf16(lo[2], lo[3]); w.z = cvt_pk_bf16(hi[0], hi[1]); w.w = cvt_pk_bf16(hi[2], hi[3]); *(u32x4*)p = w; }
template <bool FIRST>
__device__ __forceinline__ void epi_res_rows(const f32x4 (&acc)[2][2][4][2], const float* __restrict__ src32, const bf16_t* __restrict__ src16, bf16_t* __restrict__ Xb, float* __restrict__ ssqp,
                                             int row0, int col0, int slot, int fq) {
    X8 x[2][2];
#pragma unroll
    for (int bj = 0; bj < 2; ++bj) x[0][bj] = ld_x8<FIRST>(src32, src16, (size_t)row0 * 1024 + col0 + bj * 128);
#pragma unroll
    for (int gi = 0; gi < 8; ++gi) {
        const int ai = gi >> 2, m = gi & 3, row = row0 + ai * 128 + m * 16;
        if (gi + 1 < 8) {
            const int nrow = row0 + ((gi + 1) >> 2) * 128 + ((gi + 1) & 3) * 16;
#pragma unroll
            for (int bj = 0; bj < 2; ++bj) x[(gi + 1) & 1][bj] = ld_x8<FIRST>(src32, src16, (size_t)nrow * 1024 + col0 + bj * 128);
        }
        float part = 0.f;
#pragma unroll
        for (int bj = 0; bj < 2; ++bj) {
            const f32x4 lo = x[gi & 1][bj].lo + acc[ai][bj][m][0], hi = x[gi & 1][bj].hi + acc[ai][bj][m][1];
            st_x8(Xb + (size_t)row * 1024 + col0 + bj * 128, lo, hi);
            part += dot4(lo, lo) + dot4(hi, hi);
        }
        part += __shfl_xor(part, 16); part += __shfl_xor(part, 32);
        if (fq == 0) ssqp[(size_t)row * 16 + slot] = part;
    }
}
struct EpiRes {
    static constexpr bool PERM = true;
    const float* xp; const float* xs; bf16_t* Xb; float* ssq_next;
    __device__ __forceinline__ void operator()(const f32x4 (&acc)[2][2][4][2], const pg8::Unit& u, int wr, int wc, int fr, int fq) const {
        const int row0 = u.pm * 256 + wr * 64 + fr, col0 = u.pn * 256 + wc * 32 + 8 * fq;
        if (xp) epi_res_rows<true>(acc, row0 < NTP ? xp : xs - (size_t)NTP * 1024, nullptr, Xb, ssq_next, row0, col0, u.pn * 4 + wc, fq);
        else epi_res_rows<false>(acc, nullptr, Xb, Xb, ssq_next, row0, col0, u.pn * 4 + wc, fq);
    }
};

template <bool FIRST>
__device__ __forceinline__ void res_sample_tile(const Ctx cx, const bf16_t* __restrict__ A, const bf16_t* __restrict__ Bt, const float* __restrict__ xs, bf16_t* __restrict__ Xb, float* __restrict__ ssqp, int tile) {
    const int tid = cx.tid, wid = tid >> 6, lane = tid & 63, fr = lane & 15, fq = lane >> 4;
    const int tm = tile >> 3, tn = tile & 7;
    const int r0 = NTP + tm * 64 + (wid & 3) * 16, c0 = tn * 128 + (wid >> 2) * 64;
    const bf16_t* ap = A + (size_t)(r0 + fr) * 1024 + fq * 8;
    const bf16_t* bp = Bt + (size_t)(c0 + fr) * 1024 + fq * 8;
    f32x4 acc[4];
#pragma unroll
    for (int nt = 0; nt < 4; ++nt) acc[nt] = (f32x4){0.f, 0.f, 0.f, 0.f};
#pragma unroll 8
    for (int ks = 0; ks < 32; ++ks) {
        const bf16x8 af = *(const bf16x8*)(ap + ks * 32);
#pragma unroll
        for (int nt = 0; nt < 4; ++nt) {
            const bf16x8 bf = *(const bf16x8*)(bp + (size_t)nt * 16 * 1024 + ks * 32);
            acc[nt] = __builtin_amdgcn_mfma_f32_16x16x32_bf16(bf, af, acc[nt], 0, 0, 0);
        }
    }
    const int row = r0 + fr;
    float part = 0.f;
#pragma unroll
    for (int nt = 0; nt < 4; ++nt) {
        const int col = c0 + nt * 16 + fq * 4;
        const f32x4 xo = FIRST ? *(const f32x4*)(xs + (size_t)(row - NTP) * 1024 + col) : ld_bf4(Xb + (size_t)row * 1024 + col);
        const f32x4 v = xo + acc[nt];
        st_bf4(Xb + (size_t)row * 1024 + col, v);
        part += dot4(v, v);
    }
    part += __shfl_xor(part, 16); part += __shfl_xor(part, 32);
    if (fq == 0) ssqp[(size_t)row * 16 + (c0 >> 6)] = part;
}

__device__ __forceinline__ void tr_tile(const Ctx cx, LAS float* T, const float* src, int ld, int col0, int k0, bf16_t* dst, int Ktot, int drow0, const float* scale, bool zero) {
    const int tid = cx.tid;
    if (zero) {
        const int n = tid >> 3, kc = (tid & 7) * 8;
        *(u32x4*)(dst + (size_t)(drow0 + n) * Ktot + k0 + kc) = (u32x4){0u, 0u, 0u, 0u};
        return;
    }
#pragma unroll
    for (int pass = 0; pass < 2; ++pass) {
        const int kk = (tid >> 4) + pass * 32, nn = (tid & 15) * 4;
        f32x4 v = *(const f32x4*)(src + (size_t)(k0 + kk) * ld + col0 + nn);
        if (scale) v = v * scale[k0 + kk];
        T[kk * 65 + nn] = v[0]; T[kk * 65 + nn + 1] = v[1]; T[kk * 65 + nn + 2] = v[2]; T[kk * 65 + nn + 3] = v[3];
    }
    __syncthreads();
    {
        const int n = tid >> 3, kc = (tid & 7) * 8;
        u32x4 w;
        w.x = cvt_pk_bf16(T[(kc + 0) * 65 + n], T[(kc + 1) * 65 + n]); w.y = cvt_pk_bf16(T[(kc + 2) * 65 + n], T[(kc + 3) * 65 + n]);
        w.z = cvt_pk_bf16(T[(kc + 4) * 65 + n], T[(kc + 5) * 65 + n]); w.w = cvt_pk_bf16(T[(kc + 6) * 65 + n], T[(kc + 7) * 65 + n]);
        *(u32x4*)(dst + (size_t)(drow0 + n) * Ktot + k0 + kc) = w;
    }
    __syncthreads();
}

__device__ void phase_prepass(const Params& p, const Ctx cx, LAS unsigned char* lds) {
    LAS float* T = (LAS float*)lds;
    const int tid = cx.tid;
    for (int job = cx.bid; job < 4544; job += cx.nblk) {
        int j = job;
        if (j < 2176) {
            const int i = j / 1088, r = j % 1088, nt = r / 16, kt = r % 16;
            const int n0 = nt * 64;
            int col0; bool zero = false;
            if (n0 < 2048) col0 = n0; else if (n0 < 2560) col0 = 3712 + (n0 - 2048); else if (n0 < 4224) col0 = 2048 + (n0 - 2560); else { col0 = 0; zero = true; }
            tr_tile(cx, T, PIN(I_WINE) + (size_t)i * 1024 * 4224, 4224, col0, kt * 64, (bf16_t*)(PWS + WS_WINE) + (size_t)i * 4352 * 1024, 1024, n0, PIN(I_NORMW) + (2 * i) * 1024, zero);
            continue;
        }
        j -= 2176;
        if (j < 512) { const int i = j / 256, r = j % 256, nt = r / 16, kt = r % 16;
            tr_tile(cx, T, PIN(I_WOUTE) + (size_t)i * 1024 * 1024, 1024, nt * 64, kt * 64, (bf16_t*)(PWS + WS_WOUTE) + (size_t)i * 1024 * 1024, 1024, nt * 64, nullptr, false); continue; }
        j -= 512;
        if (j < 1280) { const int i = j / 640, r = j % 640, nt = r / 16, kt = r % 16;
            tr_tile(cx, T, PIN(I_WINO) + (size_t)i * 1024 * 2560, 2560, nt * 64, kt * 64, (bf16_t*)(PWS + WS_WINO) + (size_t)i * 2560 * 1024, 1024, nt * 64, PIN(I_NORMW) + (2 * i + 1) * 1024, false); continue; }
        j -= 1280;
        if (j < 512) { const int i = j / 256, r = j % 256, nt = r / 16, kt = r % 16;
            tr_tile(cx, T, PIN(I_WOUTO) + (size_t)i * 1024 * 1024, 1024, nt * 64, kt * 64, (bf16_t*)(PWS + WS_WOUTO) + (size_t)i * 1024 * 1024, 1024, nt * 64, nullptr, false); continue; }
        j -= 512;
        if (j < 16) { const int i = j / 8, nt = j % 8;
            tr_tile(cx, T, PIN(I_W2) + (size_t)i * 64 * 512, 512, nt * 64, 0, (bf16_t*)(PWS + WS_W2T) + (size_t)i * 512 * 64, 64, nt * 64, nullptr, false); continue; }
        j -= 16;
        if (j < 16) { const int i = j / 8, nt = j % 8;
            tr_tile(cx, T, PIN(I_A2) + (size_t)i * 64 * 512, 512, nt * 64, 0, (bf16_t*)(PWS + WS_A2T) + (size_t)i * 512 * 64, 64, nt * 64, nullptr, false); continue; }
        j -= 16;
        { const int ig = j / 4, r = j % 4, nt = r / 2, kt = r % 2;
            tr_tile(cx, T, PIN(I_POOLW) + (size_t)ig * 128 * 128, 128, nt * 64, kt * 64, (bf16_t*)(PWS + WS_POOLWT) + (size_t)ig * 128 * 128, 128, nt * 64, nullptr, false); }
    }
    const int gtid = cx.bid * 512 + tid, gthreads = cx.nblk * 512;
    for (int e = gtid; e < 8 * 128 * 128; e += gthreads) {
        const int s = e & 127, t = (e >> 7) & 127;
        ((bf16_t*)(PWS + WS_SPW))[e] = (s <= t) ? (bf16_t)(cvt_pk_bf16(PIN(I_SPW)[e], 0.f) & 0xffffu) : (bf16_t)0;
    }
    const int wid = tid >> 6, lane = tid & 63;
    for (int row = cx.bid * 8 + wid; row < NTOK; row += cx.nblk * 8) {
        const float* src = row < NTP ? PIN(I_XP) + (size_t)row * 1024 : PIN(I_XS) + (size_t)(row - NTP) * 1024;
        bf16_t* dst = (bf16_t*)(PWS + WS_XB) + (size_t)row * 1024;
        float ss = 0.f;
#pragma unroll
        for (int i = 0; i < 4; ++i) { const f32x4 v = *(const f32x4*)(src + i * 256 + lane * 4); ss += dot4(v, v); st_bf4(dst + i * 256 + lane * 4, v); }
#pragma unroll
        for (int o = 32; o >= 1; o >>= 1) ss += __shfl_xor(ss, o);
        if (lane < 16) ((float*)(PWS + WS_SSQ))[(size_t)row * 16 + lane] = (lane == 0) ? ss : 0.f;
    }
}

__device__ __forceinline__ f32x4 shift4(const bf16_t* cur, bool hp, const float* st, int col, const float* mu) {
    const f32x4 q = ld_bf4(cur + col);
    f32x4 pv;
    if (hp) pv = ld_bf4(cur - LDB + col); else if (st) pv = *(const f32x4*)(st + col); else pv = (f32x4){0.f, 0.f, 0.f, 0.f};
    const f32x4 m = *(const f32x4*)(mu + col);
    return q + m * (pv - q);
}

__device__ void phase_even_prep(const Params& p, const Ctx cx, int pair, LAS unsigned char* lds) {
    const int tid = cx.tid, wid = tid >> 6, lane = tid & 63, fr = lane & 15, fq = lane >> 4;
    const bf16_t* PB = (const bf16_t*)(PWS + WS_PROJB);
    float* Wdec = (float*)(PWS + WS_WDEC);
    bf16_t* Aa = (bf16_t*)(PWS + WS_AA);
    bf16_t* Ycat = (bf16_t*)(PWS + WS_YCAT);
    const float* mu_ = PIN(I_MU) + pair * 1664;
    const float* w0_ = PIN(I_W0) + pair * 512; const float* a0_ = PIN(I_A0) + pair * 512;
    const float* k_a_ = PIN(I_KA) + pair * 512; const float* r_k_ = PIN(I_RK) + pair * 512;
    constexpr int RS = 3344;
    constexpr int TB = 17 * RS;
    constexpr int NCH = 17 * 208;
    const int h = wid;
    bf16x8 wfr[4][2], afr[4][2];
    {
        const bf16_t* W2T = (const bf16_t*)(PWS + WS_W2T) + (size_t)pair * 512 * 64;
        const bf16_t* A2T = (const bf16_t*)(PWS + WS_A2T) + (size_t)pair * 512 * 64;
#pragma unroll
        for (int nt = 0; nt < 4; ++nt)
#pragma unroll
            for (int ks = 0; ks < 2; ++ks) {
                wfr[nt][ks] = *(const bf16x8*)(W2T + (size_t)(h * 64 + nt * 16 + fr) * 64 + ks * 32 + fq * 8);
                afr[nt][ks] = *(const bf16x8*)(A2T + (size_t)(h * 64 + nt * 16 + fr) * 64 + ks * 32 + fq * 8);
            }
    }
    constexpr int buf = 0;
    for (int tile = cx.bid; tile < NTOK / 16; tile += cx.nblk) {
        int zz; asm volatile("v_mov_b32 %0, 0" : "=v"(zz));
        const int tidv = tid + zz, fr = (tidv & 15), fq = (tidv >> 4) & 3;
        {
            const int r0_ = tile * 16;
#pragma unroll
            for (int i_ = 0; i_ < 7; ++i_) {
                const int c_ = tidv + i_ * 512;
                if (c_ < NCH) { const int lr_ = c_ / 208, cc_ = c_ % 208; int gr_ = r0_ - 1 + lr_; gr_ = gr_ < 0 ? 0 : gr_;
                    *(LAS u32x4*)(lds + lr_ * RS + cc_ * 16) = *(const u32x4*)(PB + (size_t)gr_ * LDB + cc_ * 8); }
            }
        }
        __syncthreads();
        {
            const int row = tile * 16 + fr;
            const bool samp = row >= NTP;
            int b, t; if (!samp) { b = row >> 11; t = row & 2047; } else { const int q = row - NTP; b = q >> 3; t = q & 7; }
            const bool hp = t > 0;
            const float* st = samp ? PIN(I_SSHIFT) + ((size_t)pair * 128 + b) * 1664 : nullptr;
            const float* mu = mu_ + zz; const float* w0 = w0_ + zz; const float* a0 = a0_ + zz; const float* k_a = k_a_ + zz; const float* r_k = r_k_ + zz;
            LAS const unsigned char* curL = lds + buf * TB + (fr + 1) * RS;
            LAS const unsigned char* prvL = lds + buf * TB + fr * RS;
            auto sh4 = [&](int col) -> f32x4 {
                const f32x4 q = cvt4(*(LAS const u32x2*)(curL + col * 2));
                f32x4 pv;
                if (hp) pv = cvt4(*(LAS const u32x2*)(prvL + col * 2)); else if (st) pv = *(const f32x4*)(st + col); else pv = (f32x4){0.f, 0.f, 0.f, 0.f};
                const f32x4 m = *(const f32x4*)(mu + col);
                return q + m * (pv - q);
            };
            bf16x8 Aw[2], Al[2];
#pragma unroll
            for (int ks = 0; ks < 2; ++ks) {
                const int cw = 1536 + ks * 32 + fq * 8, ca = 1600 + ks * 32 + fq * 8;
                const f32x4 w_lo = sh4(cw), w_hi = sh4(cw + 4), a_lo = sh4(ca), a_hi = sh4(ca + 4);
                u32x4 pw, pa;
                float th[8];
#pragma unroll
                for (int j = 0; j < 4; ++j) { th[j] = 2.0f * sigmoidf_(2.0f * w_lo[j]) - 1.0f; th[4 + j] = 2.0f * sigmoidf_(2.0f * w_hi[j]) - 1.0f; }
                pw.x = cvt_pk_bf16(th[0], th[1]); pw.y = cvt_pk_bf16(th[2], th[3]); pw.z = cvt_pk_bf16(th[4], th[5]); pw.w = cvt_pk_bf16(th[6], th[7]);
                pa.x = cvt_pk_bf16(a_lo[0], a_lo[1]); pa.y = cvt_pk_bf16(a_lo[2], a_lo[3]); pa.z = cvt_pk_bf16(a_hi[0], a_hi[1]); pa.w = cvt_pk_bf16(a_hi[2], a_hi[3]);
                Aw[ks] = __builtin_bit_cast(bf16x8, pw); Al[ks] = __builtin_bit_cast(bf16x8, pa);
            }
            float bon = 0.f;
#pragma unroll
            for (int nt = 0; nt < 4; ++nt) {
                f32x4 lw = (f32x4){0.f, 0.f, 0.f, 0.f}, la = (f32x4){0.f, 0.f, 0.f, 0.f};
#pragma unroll
                for (int ks = 0; ks < 2; ++ks) {
                    lw = __builtin_amdgcn_mfma_f32_16x16x32_bf16(wfr[nt][ks], Aw[ks], lw, 0, 0, 0);
                    la = __builtin_amdgcn_mfma_f32_16x16x32_bf16(afr[nt][ks], Al[ks], la, 0, 0, 0);
                }
                const int ch = h * 64 + nt * 16 + fq * 4;
                const f32x4 r4 = sh4(ch), k4 = sh4(512 + ch);
                const f32x4 w04 = *(const f32x4*)(w0 + ch), a04 = *(const f32x4*)(a0 + ch), ka4 = *(const f32x4*)(k_a + ch), rk4 = *(const f32x4*)(r_k + ch);
                f32x4 dec, av;
#pragma unroll
                for (int j = 0; j < 4; ++j) {
                    const float z_ = -(w04[j] + lw[j]);
                    const float wlog = -__logf(1.0f + __expf(z_)) - 0.5f;
                    dec[j] = __expf(-__expf(wlog));
                    av[j] = sigmoidf_(a04[j] + la[j]);
                    const float kp = k4[j] * (1.0f + (av[j] - 1.0f) * ka4[j]);
                    bon += r4[j] * kp * rk4[j];
                }
                *(f32x4*)(Wdec + (size_t)row * 512 + ch) = dec;
                st_bf4(Aa + (size_t)row * 512 + ch, av);
            }
            bon += __shfl_xor(bon, 16); bon += __shfl_xor(bon, 32);
#pragma unroll
            for (int nt = 0; nt < 4; ++nt) { const int ch = h * 64 + nt * 16 + fq * 4; st_bf4(Ycat + (size_t)row * 1024 + 512 + ch, sh4(1024 + ch) * bon); }
        }
        __syncthreads();
    }
    const int gtid = cx.bid * 512 + tid, gthreads = cx.nblk * 512;
    for (int e = gtid; e < 136 * 1664; e += gthreads) {
        const int sr = e / 1664, c = e % 1664;
        if (sr < 8) POUT[O_SHIFTP + ((size_t)pair * 8 + sr) * 1664 + c] = bf2f(PB[(size_t)(sr * 2048 + 2047) * LDB + c]);
        else { const int b = sr - 8; POUT[O_SHIFTS + ((size_t)pair * 128 + b) * 1664 + c] = bf2f(PB[(size_t)(NTP + b * 8 + 7) * LDB + c]); }
    }
}

__device__ __forceinline__ void scan_step(f32x4& S, const f32x4 w, const f32x4 k, const f32x4 kk, const f32x4 bb, const f32x4 r, const float v, float& y) {
    float pd = dot4(S, kk);
    const f32x4 tmp = S * w + k * v;
    pd = allsum16(pd);
    S = tmp - bb * pd;
    y = allsum16(dot4(S, r));
}

__device__ void phase_scan(const Params& p, const Ctx cx, int pair, LAS unsigned char* lds) {
    const int tid = cx.tid, wid = tid >> 6, lane = tid & 63, rs = lane >> 4, cgi = lane & 15;
    const bf16_t* PB = (const bf16_t*)(PWS + WS_PROJB);
    const float* Wdec = (const float*)(PWS + WS_WDEC);
    const bf16_t* Aa = (const bf16_t*)(PWS + WS_AA);
    float* Y = (float*)(PWS + WS_Y);
    const float* mu = PIN(I_MU) + pair * 1664;
    const float* k_k = PIN(I_KK) + pair * 512; const float* k_a = PIN(I_KA) + pair * 512;
    {
        LAS float* vb = (LAS float*)lds + wid * 3072;
        for (int st = cx.bid * 8 + wid; st < 2048; st += cx.nblk * 8) {
            const int bh = st >> 1, half = st & 1, b = bh >> 3, h = bh & 7, ch = h * 64 + cgi * 4;
            const float* stp = PIN(I_SSHIFT) + ((size_t)pair * 128 + b) * 1664;
            const f32x4 kkc = *(const f32x4*)(k_k + ch), kac = *(const f32x4*)(k_a + ch);
            {
#pragma unroll
                for (int tt = 0; tt < 2; ++tt) {
                    const int t = rs + tt * 4;
                    const size_t row = NTP + b * 8 + t;
                    const bf16_t* cur = PB + row * LDB;
                    const f32x4 r = shift4(cur, t > 0, stp, ch, mu), k = shift4(cur, t > 0, stp, 512 + ch, mu), v = shift4(cur, t > 0, stp, 1024 + ch, mu);
                    const f32x4 a = ld_bf4(Aa + row * 512 + ch);
                    const f32x4 w = *(const f32x4*)(Wdec + row * 512 + ch);
                    const f32x4 kkv = k * kkc;
                    const float ss = allsum16(dot4(kkv, kkv));
                    const float inv = 1.0f / fmaxf(sqrtf(ss), 1e-12f);
                    const f32x4 kkn = kkv * inv;
                    LAS float* o = vb + t * 384 + cgi * 4;
                    *(LAS f32x4*)(o) = w; *(LAS f32x4*)(o + 64) = k * (1.0f + (a - 1.0f) * kac); *(LAS f32x4*)(o + 128) = kkn; *(LAS f32x4*)(o + 192) = kkn * a;
                    *(LAS f32x4*)(o + 256) = r; *(LAS f32x4*)(o + 320) = v;
                }
            }
            asm volatile("s_waitcnt lgkmcnt(0)" ::: "memory");
            __builtin_amdgcn_wave_barrier();
#pragma unroll 1
            for (int rq = 0; rq < 8; ++rq) {
                const int ri = half * 32 + rq * 4 + rs;
                const size_t so = ((((size_t)pair * 128 + b) * 8 + h) * 64 + ri) * 64 + cgi * 4;
                f32x4 S = *(const f32x4*)(PIN(I_SWKV) + so);
#pragma unroll
                for (int t = 0; t < 8; ++t) {
                    LAS const float* r0 = vb + t * 384 + cgi * 4;
                    float y; scan_step(S, *(LAS const f32x4*)(r0), *(LAS const f32x4*)(r0 + 64), *(LAS const f32x4*)(r0 + 128), *(LAS const f32x4*)(r0 + 192), *(LAS const f32x4*)(r0 + 256), vb[t * 384 + 320 + ri], y);
                    if (cgi == 0) Y[(size_t)(NTP + b * 8 + t) * 512 + h * 64 + ri] = y;
                }
                *(f32x4*)(POUT + O_WKVS + so) = S;
            }
            asm volatile("s_waitcnt lgkmcnt(0)" ::: "memory");
            __builtin_amdgcn_wave_barrier();
        }
    }
    __syncthreads();
    LAS float* rec = (LAS float*)lds;
    for (int pt = cx.bid; pt < 256; pt += cx.nblk) {
        const int xcd = pt & 7, slot = pt >> 3, bh = xcd * 8 + (slot >> 2), rg = slot & 3, b = bh >> 3, h = bh & 7;
        const int lt = tid - 256, ls = (lt >> 4) & 15, lcg = lt & 15, lch = h * 64 + lcg * 4;
        u32x2 qr = {0u, 0u}, qk = {0u, 0u}, qv = {0u, 0u}, pr = {0u, 0u}, pk = {0u, 0u}, pv = {0u, 0u}, qa = {0u, 0u};
        f32x4 qw = (f32x4){0.f, 0.f, 0.f, 0.f};
        f32x4 mur, muk, muv, kkc, kac;
        const int ri = rg * 16 + (wid & 3) * 4 + rs;
        f32x4 S = (f32x4){0.f, 0.f, 0.f, 0.f};
#define SCAN_ISSUE(c) do { const int t_ = (c) * 16 + ls; const size_t row_ = (size_t)b * 2048 + t_; const bf16_t* cur_ = PB + row_ * LDB; \
            qr = *(const u32x2*)(cur_ + lch); qk = *(const u32x2*)(cur_ + 512 + lch); qv = *(const u32x2*)(cur_ + 1024 + lch); \
            if (t_ > 0) { pr = *(const u32x2*)(cur_ - LDB + lch); pk = *(const u32x2*)(cur_ - LDB + 512 + lch); pv = *(const u32x2*)(cur_ - LDB + 1024 + lch); } \
            else { pr = (u32x2){0u, 0u}; pk = pr; pv = pr; } \
            qw = *(const f32x4*)(Wdec + row_ * 512 + lch); qa = *(const u32x2*)(Aa + row_ * 512 + lch); } while (0)
#define SCAN_PROCESS(buf) do { const f32x4 r0_ = cvt4(qr), k0_ = cvt4(qk), v0_ = cvt4(qv); \
            const f32x4 r_ = r0_ + mur * (cvt4(pr) - r0_), k_ = k0_ + muk * (cvt4(pk) - k0_), v_ = v0_ + muv * (cvt4(pv) - v0_), a_ = cvt4(qa); \
            const f32x4 kkv_ = k_ * kkc; const float ss_ = allsum16(dot4(kkv_, kkv_)); const float inv_ = 1.0f / fmaxf(sqrtf(ss_), 1e-12f); \
            const f32x4 kkn_ = kkv_ * inv_; \
            LAS float* o_ = rec + (buf) * 6144 + ls * 384 + lcg * 4; \
            *(LAS f32x4*)(o_) = qw; *(LAS f32x4*)(o_ + 64) = k_ * (1.0f + (a_ - 1.0f) * kac); *(LAS f32x4*)(o_ + 128) = kkn_; *(LAS f32x4*)(o_ + 192) = kkn_ * a_; \
            *(LAS f32x4*)(o_ + 256) = r_; *(LAS f32x4*)(o_ + 320) = v_; } while (0)
        if (wid >= 4) {
            mur = *(const f32x4*)(mu + lch); muk = *(const f32x4*)(mu + 512 + lch); muv = *(const f32x4*)(mu + 1024 + lch);
            kkc = *(const f32x4*)(k_k + lch); kac = *(const f32x4*)(k_a + lch);
            SCAN_ISSUE(0); SCAN_PROCESS(0); SCAN_ISSUE(1);
        }
        __syncthreads();
        for (int c = 0; c < 128; ++c) {
            if (wid < 4) {
                LAS const float* rb = rec + (c & 1) * 6144 + cgi * 4;
                LAS const float* rv = rec + (c & 1) * 6144 + 320 + ri;
                float ykeep = 0.f;
                f32x4 nw = *(LAS const f32x4*)(rb), nk = *(LAS const f32x4*)(rb + 64), nkk = *(LAS const f32x4*)(rb + 128), nb = *(LAS const f32x4*)(rb + 192), nr = *(LAS const f32x4*)(rb + 256);
                float nv = rv[0];
#pragma unroll
                for (int s = 0; s < 16; ++s) {
                    const f32x4 cw = nw, ck = nk, ckk = nkk, cb = nb, cr = nr; const float cv = nv;
                    if (s + 1 < 16) {
                        LAS const float* r1 = rb + (s + 1) * 384;
                        nw = *(LAS const f32x4*)(r1); nk = *(LAS const f32x4*)(r1 + 64); nkk = *(LAS const f32x4*)(r1 + 128); nb = *(LAS const f32x4*)(r1 + 192); nr = *(LAS const f32x4*)(r1 + 256);
                        nv = rv[(s + 1) * 384];
                    }
                    float y;
                    scan_step(S, cw, ck, ckk, cb, cr, cv, y);
                    ykeep = (cgi == s) ? y : ykeep;
                }
                Y[((size_t)b * 2048 + c * 16 + cgi) * 512 + h * 64 + ri] = ykeep;
            } else {
                if (c + 1 < 128) { SCAN_PROCESS((c + 1) & 1); if (c + 2 < 128) SCAN_ISSUE(c + 2); }
            }
            __syncthreads();
        }
        if (wid < 4) *(f32x4*)(POUT + O_WKVP + ((((size_t)pair * 8 + b) * 8 + h) * 64 + ri) * 64 + cgi * 4) = S;
#undef SCAN_ISSUE
#undef SCAN_PROCESS
    }
}

__device__ void phase_even_post(const Params& p, const Ctx cx, int pair) {
    const int gtid = cx.bid * 512 + cx.tid, gthreads = cx.nblk * 512;
    const bf16_t* PA = (const bf16_t*)(PWS + WS_R1);
    bf16_t* Ycat = (bf16_t*)(PWS + WS_YCAT);
    const float* Y = (const float*)(PWS + WS_Y);
    constexpr int NIT = NTOK * 128, UB = 4;
    const float* gn_g = PIN(I_GNG) + pair * 512; const float* gn_b = PIN(I_GNB) + pair * 512;
    for (int e0 = gtid; e0 < NIT; e0 += gthreads * UB) {
        f32x4 y[UB], bv[UB], bz[UB]; bool ok[UB];
#pragma unroll
        for (int u = 0; u < UB; ++u) {
            const int e = e0 + u * gthreads; ok[u] = e < NIT;
            const int ee = ok[u] ? e : e0; const int row = ee >> 7, ch = (ee & 127) * 4;
            y[u] = *(const f32x4*)(Y + (size_t)row * 512 + ch);
            bv[u] = ld_bf4(Ycat + (size_t)row * 1024 + 512 + ch);
            bz[u] = ld_bf4(PA + (size_t)row * LDA + 2048 + ch);
        }
#pragma unroll
        for (int u = 0; u < UB; ++u) {
            const int e = e0 + u * gthreads;
            const int ee = ok[u] ? e : e0; const int row = ee >> 7, ch = (ee & 127) * 4;
            const float mean = allsum16(y[u][0] + y[u][1] + y[u][2] + y[u][3]) * (1.0f / 64.0f);
            const f32x4 d = y[u] - mean;
            const float var = allsum16(dot4(d, d)) * (1.0f / 64.0f);
            const float rstd = rsqrtf(var + 64e-5f);
            const f32x4 g = *(const f32x4*)(gn_g + ch), bb = *(const f32x4*)(gn_b + ch);
            f32x4 o;
#pragma unroll
            for (int j = 0; j < 4; ++j) o[j] = (d[j] * rstd * g[j] + bb[j] + bv[u][j]) * siluf_(bz[u][j]);
            if (ok[u]) st_bf4(Ycat + (size_t)row * 1024 + 512 + ch, o);
        }
    }
    const float* cw = PIN(I_CONVW) + pair * 3 * 512;
    for (int e0 = gtid; e0 < NIT; e0 += gthreads * UB) {
        f32x4 h0[UB], c0v[UB], h1[UB], c1v[UB], h2[UB], c2v[UB], ab[UB], az[UB]; bool ok[UB];
#pragma unroll
        for (int u = 0; u < UB; ++u) {
            const int e = e0 + u * gthreads; ok[u] = e < NIT;
            const int ee = ok[u] ? e : e0; const int row = ee >> 7, ch = (ee & 127) * 4;
            const int t = row < NTP ? (row & 2047) : ((row - NTP) & 7);
            const bf16_t* cur = PA + (size_t)row * LDA + ch;
            const bf16_t* p1 = t >= 1 ? cur - LDA : cur; const bf16_t* p2 = t >= 2 ? cur - 2 * LDA : cur;
            h0[u] = ld_bf4(cur); c0v[u] = ld_bf4(cur + 1024); h1[u] = ld_bf4(p1); c1v[u] = ld_bf4(p1 + 1024); h2[u] = ld_bf4(p2); c2v[u] = ld_bf4(p2 + 1024);
            ab[u] = ld_bf4(cur + 512); az[u] = ld_bf4(cur + 1536);
        }
#pragma unroll
        for (int u = 0; u < UB; ++u) {
            const int e = e0 + u * gthreads;
            const int ee = ok[u] ? e : e0; const int row = ee >> 7, ch = (ee & 127) * 4;
            const bool samp = row >= NTP;
            int b, t, T; if (!samp) { b = row >> 11; t = row & 2047; T = 2048; } else { const int q = row - NTP; b = q >> 3; t = q & 7; T = 8; }
            const f32x4 u0 = c0v[u] * h0[u];
            f32x4 u1 = c1v[u] * h1[u], u2 = c2v[u] * h2[u];
            if (t < 2) {
                const f32x4 zero = (f32x4){0.f, 0.f, 0.f, 0.f};
                const float* hist = PIN(I_SCONV) + ((size_t)pair * 128 + (samp ? b : 0)) * 2 * 512 + ch;
                if (t == 0) { u1 = samp ? *(const f32x4*)(hist + 512) : zero; u2 = samp ? *(const f32x4*)(hist) : zero; }
                else { u2 = samp ? *(const f32x4*)(hist + 512) : zero; }
            }
            const f32x4 k0 = *(const f32x4*)(cw + ch), k1 = *(const f32x4*)(cw + 512 + ch), k2 = *(const f32x4*)(cw + 1024 + ch);
            const f32x4 conv = k0 * u2 + k1 * u1 + k2 * u0;
            f32x4 o;
#pragma unroll
            for (int j = 0; j < 4; ++j) o[j] = ab[u][j] * conv[j] * siluf_(az[u][j]);
            if (ok[u]) {
                st_bf4(Ycat + (size_t)row * 1024 + ch, o);
                if (t >= T - 2) {
                    float* dst = samp ? POUT + O_CONVS + (((size_t)pair * 128 + b) * 2 + (t - (T - 2))) * 512 + ch : POUT + O_CONVP + (((size_t)pair * 8 + b) * 2 + (t - (T - 2))) * 512 + ch;
                    *(f32x4*)dst = u0;
                }
            }
        }
    }
}

__device__ void phase_odd_mixer(const Params& p, const Ctx cx, int pair, LAS unsigned char* lds) {
    const int tid = cx.tid, wid = tid >> 6, lane = tid & 63, fr = lane & 15, fq = lane >> 4;
    const bf16_t* PO = (const bf16_t*)(PWS + WS_R1);
    bf16_t* Ycat = (bf16_t*)(PWS + WS_YCAT);
    LAS bf16_t* LA = (LAS bf16_t*)lds;
    LAS bf16_t* LB = (LAS bf16_t*)(lds + 128 * 136 * 2);
    LAS float* stat = (LAS float*)(lds + 2 * 128 * 136 * 2);
    LAS float* LE = (LAS float*)(lds + 128 * 136 * 2);
    LAS bf16_t* LW = (LAS bf16_t*)(lds + 128 * 136 * 2 + 143 * 128 * 4);
#ifdef MIXPROBE
    for (int rr = 0; rr < 16; ++rr) {
        const int round = rr & 7;
#else
    for (int round = 0; round < 8; ++round) {
#endif
        int it;
        if (cx.nblk == 256) {
            if (round == 0) it = cx.bid < 136 ? cx.bid : 136 + 136 + (cx.bid - 136);
            else if (round == 1) it = cx.bid < 136 ? 136 + cx.bid : 136 + 136 + 120 + (cx.bid - 136);
            else if (cx.bid >= 136) it = 136 + 136 + 120 * round + (cx.bid - 136);
            else it = 1 << 20;
        } else it = cx.bid + round * cx.nblk;
#ifdef MIXPROBE
        if (it >= 680) continue;
        if (rr >= 8 && ((MIXPROBE == 1) != (it < 136))) continue;
#else
        if (it >= 680) { if (cx.nblk == 256 ? round >= 4 : true) break; else continue; }
#endif
        if (it >= 136) {
            const int ci = it - 136, tile = ci >> 2, g = ci & 3, r0 = tile * 128;
            const bool samp = r0 >= NTP;
            const int w = 2 << g;
            const bf16_t* Bw = (const bf16_t*)(PWS + WS_POOLWT) + ((size_t)pair * 4 + g) * 128 * 128;
            {
                u32x4 wr_[4];
#pragma unroll
                for (int i = 0; i < 4; ++i) { const int e = tid + i * 512, d_ = e >> 4, c8 = (e & 15) * 8; wr_[i] = *(const u32x4*)(Bw + d_ * 128 + c8); }
#pragma unroll
                for (int i = 0; i < 4; ++i) { const int e = tid + i * 512, d_ = e >> 4, c8 = (e & 15) * 8; *(LAS u32x4*)(LW + d_ * 136 + c8) = wr_[i]; }
            }
            if (!samp) {
                const int t0 = r0 & 2047;
                {
                    u32x2 raw[9];
#pragma unroll
                    for (int i = 0; i < 9; ++i) {
                        const int e = tid + i * 512, er = e >> 5, c = (e & 31) * 4;
                        raw[i] = (u32x2){0u, 0u};
                        if (e < 143 * 32 && t0 + er - 15 >= 0) raw[i] = *(const u32x2*)(PO + (size_t)(r0 + er - 15) * LDA + g * 128 + c);
                    }
#pragma unroll
                    for (int i = 0; i < 9; ++i) {
                        const int e = tid + i * 512, er = e >> 5, c = (e & 31) * 4;
                        if (e < 143 * 32) *(LAS f32x4*)(LE + er * 128 + c) = cvt4(raw[i]);
                    }
                }
                __syncthreads();
                {
                    const int c = (tid & 31) * 4, tl0 = (tid >> 5) * 8;
                    f32x4 sum = (f32x4){0.f, 0.f, 0.f, 0.f};
#pragma unroll 4
                    for (int d = 0; d < w; ++d) sum += *(LAS const f32x4*)(LE + (tl0 + 15 - d) * 128 + c);
#pragma unroll
                    for (int k = 0; k < 8; ++k) {
                        const int tl = tl0 + k;
                        const f32x4 pt = *(LAS const f32x4*)(LE + (tl + 15) * 128 + c);
                        if (k > 0) sum += pt - *(LAS const f32x4*)(LE + (tl + 15 - w) * 128 + c);
                        const float cnt = fminf((float)w, (float)(t0 + tl + 1));
                        const f32x4 pooled = sum * (1.0f / cnt) - pt;
                        u32x2 u; u.x = cvt_pk_bf16(pooled[0], pooled[1]); u.y = cvt_pk_bf16(pooled[2], pooled[3]);
                        *(LAS u32x2*)(LA + tl * 136 + c) = u;
                    }
                }
            } else {
                for (int e = tid; e < 128 * 32; e += 512) {
                    const int tl = e >> 5, c = (e & 31) * 4, row = r0 + tl;
                    const int q = row - NTP, b = q >> 3, t = q & 7;
                    const bf16_t* cur = PO + (size_t)row * LDA + g * 128 + c;
                    const f32x4 pt = ld_bf4(cur);
                    f32x4 sum = pt;
                    for (int d = 1; d < w; ++d) {
                        const int tt = t - d;
                        if (tt >= 0) sum += ld_bf4(cur - (size_t)d * LDA);
                        else sum += *(const f32x4*)(PIN(I_SPOOL) + (((size_t)pair * 128 + b) * 15 + (15 + tt)) * 512 + g * 128 + c);
                    }
                    const f32x4 pooled = sum * (1.0f / (float)w) - pt;
                    u32x2 u; u.x = cvt_pk_bf16(pooled[0], pooled[1]); u.y = cvt_pk_bf16(pooled[2], pooled[3]);
                    *(LAS u32x2*)(LA + tl * 136 + c) = u;
                }
            }
            __syncthreads();
            const int row = r0 + wid * 16 + fr;
            bf16x8 af[4];
#pragma unroll
            for (int ks = 0; ks < 4; ++ks) af[ks] = *(const LAS bf16x8*)(LA + (wid * 16 + fr) * 136 + ks * 32 + fq * 8);
#pragma unroll
            for (int nt = 0; nt < 8; ++nt) {
                f32x4 acc = (f32x4){0.f, 0.f, 0.f, 0.f};
#pragma unroll
                for (int ks = 0; ks < 4; ++ks) {
                    const bf16x8 bf = *(const LAS bf16x8*)(LW + (nt * 16 + fr) * 136 + ks * 32 + fq * 8);
                    acc = __builtin_amdgcn_mfma_f32_16x16x32_bf16(bf, af[ks], acc, 0, 0, 0);
                }
                const int d = g * 128 + nt * 16 + fq * 4;
                const f32x4 cz = ld_bf4(PO + (size_t)row * LDA + 512 + d), ps = *(const f32x4*)(PIN(I_PSCALE) + pair * 512 + d);
                f32x4 o;
#pragma unroll
                for (int j = 0; j < 4; ++j) o[j] = acc[j] * ps[j] * siluf_(cz[j]);
                st_bf4(Ycat + (size_t)row * 1024 + d, o);
            }
            __syncthreads();
        } else {
            const int tile = it, r0 = tile * 128;
            const bool samp = r0 >= NTP;
            {
                const int tl = tid >> 2, q = tid & 3;
                const bf16_t* vr = PO + (size_t)(r0 + tl) * LDA + 1536 + q * 128;
                float s_ = 0.f, ss = 0.f;
#pragma unroll
                for (int i = 0; i < 16; ++i) { const u32x4 raw = *(const u32x4*)(vr + i * 8); const f32x4 v0 = cvt4((u32x2){raw.x, raw.y}), v1 = cvt4((u32x2){raw.z, raw.w});
                    s_ += (v0[0] + v0[1]) + (v0[2] + v0[3]) + (v1[0] + v1[1]) + (v1[2] + v1[3]); ss += dot4(v0, v0) + dot4(v1, v1); }
                s_ = allsum4(s_); ss = allsum4(ss);
                const float mean = s_ * (1.0f / 512.0f);
                const float var = fmaxf(ss * (1.0f / 512.0f) - mean * mean, 0.f);
                if (q == 0) { stat[tl * 2] = mean; stat[tl * 2 + 1] = rsqrtf(var + 1e-5f); }
            }
            __syncthreads();
#pragma unroll 1
            for (int g = 0; g < 4; ++g) {
                {
                    const int tl = tid >> 2, q = tid & 3, row = r0 + tl;
                    const float mean = stat[tl * 2], rstd = stat[tl * 2 + 1];
                    const bf16_t* vr = PO + (size_t)row * LDA + 1536 + g * 128 + q * 32;
                    const float* lg = PIN(I_LNG) + pair * 512 + g * 128 + q * 32; const float* lb = PIN(I_LNB) + pair * 512 + g * 128 + q * 32;
#pragma unroll
                    for (int i = 0; i < 8; ++i) {
                        const f32x4 v = ld_bf4(vr + i * 4);
                        const f32x4 vn = (v - mean) * rstd * *(const f32x4*)(lg + i * 4) + *(const f32x4*)(lb + i * 4);
                        if (samp) *(f32x4*)(POUT + O_CHUNKV + ((size_t)pair * 1024 + (row - NTP)) * 512 + g * 128 + q * 32 + i * 4) = vn;
#pragma unroll
                        for (int j = 0; j < 4; ++j) LB[(q * 32 + i * 4 + j) * 136 + tl] = (bf16_t)(cvt_pk_bf16(vn[j], 0.f) & 0xffffu);
                    }
                }
                if (!samp) {
                    const bf16_t* Wsrc = (const bf16_t*)(PWS + WS_SPW) + ((size_t)pair * 4 + g) * 128 * 128;
                    u32x4 wr_[4];
#pragma unroll
                    for (int i = 0; i < 4; ++i) { const int e = tid + i * 512, t = e >> 4, s8 = (e & 15) * 8; wr_[i] = *(const u32x4*)(Wsrc + t * 128 + s8); }
#pragma unroll
                    for (int i = 0; i < 4; ++i) { const int e = tid + i * 512, t = e >> 4, s8 = (e & 15) * 8; *(LAS u32x4*)(LA + t * 136 + s8) = wr_[i]; }
                } else {
                    const float* Wsrc = PIN(I_SPW) + ((size_t)pair * 4 + g) * 128 * 128;
                    for (int e = tid; e < 128 * 128; e += 512) { const int t = e >> 7, s2 = e & 127;
                        const float v = ((t >> 3) == (s2 >> 3) && (s2 & 7) <= (t & 7)) ? Wsrc[(t & 7) * 128 + (s2 & 7)] : 0.f;
                        LA[t * 136 + s2] = (bf16_t)(cvt_pk_bf16(v, 0.f) & 0xffffu); }
                }
                __syncthreads();
                {
                    const int tl = wid * 16 + fr, row = r0 + tl;
                    const float bias = PIN(I_SPB)[((size_t)pair * 4 + g) * 128 + (samp ? (tl & 7) : tl)];
                    bf16x8 wf[4];
#pragma unroll
                    for (int ks = 0; ks < 4; ++ks) wf[ks] = *(const LAS bf16x8*)(LA + tl * 136 + ks * 32 + fq * 8);
#pragma unroll
                    for (int nt = 0; nt < 8; ++nt) {
                        f32x4 acc = (f32x4){0.f, 0.f, 0.f, 0.f};
#pragma unroll
                        for (int ks = 0; ks < 4; ++ks) {
                            if (ks * 32 <= wid * 16 + 15) {
                                const bf16x8 vf = *(const LAS bf16x8*)(LB + (nt * 16 + fr) * 136 + ks * 32 + fq * 8);
                                acc = __builtin_amdgcn_mfma_f32_16x16x32_bf16(vf, wf[ks], acc, 0, 0, 0);
                            }
                        }
                        const int c = g * 128 + nt * 16 + fq * 4;
                        const f32x4 u = ld_bf4(PO + (size_t)row * LDA + 1024 + c), dz = ld_bf4(PO + (size_t)row * LDA + 2048 + c);
                        f32x4 o;
#pragma unroll
                        for (int j = 0; j < 4; ++j) o[j] = u[j] * (acc[j] + bias) * siluf_(dz[j]);
                        st_bf4(Ycat + (size_t)row * 1024 + 512 + c, o);
                    }
                }
                __syncthreads();
            }
        }
    }
    const int gtid = cx.bid * 512 + tid, gthreads = cx.nblk * 512;
    for (int e = gtid; e < 136 * 15 * 512; e += gthreads) {
        const int c = e & 511, q = e >> 9, sr = q / 15, k = q % 15;
        if (sr < 8) POUT[O_POOLP + (((size_t)pair * 8 + sr) * 15 + k) * 512 + c] = bf2f(PO[(size_t)(sr * 2048 + 2033 + k) * LDA + c]);
        else { const int b = sr - 8;
            POUT[O_POOLS + (((size_t)pair * 128 + b) * 15 + k) * 512 + c] = (k < 7) ? PIN(I_SPOOL)[(((size_t)pair * 128 + b) * 15 + 8 + k) * 512 + c] : bf2f(PO[(size_t)(NTP + b * 8 + (k - 7)) * LDA + c]); }
    }
}

__device__ void phase_final(const Params& p, const Ctx cx) {
    const int gtid = cx.bid * 512 + cx.tid, gthreads = cx.nblk * 512;
    const float* ssq = (const float*)(PWS + WS_SSQ) + (size_t)4 * NTOK * 16;
    const bf16_t* Xb = (const bf16_t*)(PWS + WS_XB);
    constexpr int NIT = NTOK * 256, UB = 4;
    for (int e0 = gtid; e0 < NIT; e0 += gthreads * UB) {
        f32x4 x[UB]; float sq[UB]; bool ok[UB];
#pragma unroll
        for (int u = 0; u < UB; ++u) { const int e = e0 + u * gthreads; ok[u] = e < NIT; const int ee = ok[u] ? e : e0; const int row = ee >> 8, c = (ee & 255) * 4;
            x[u] = ld_bf4(Xb + (size_t)row * 1024 + c); sq[u] = ssq_sum(ssq + (size_t)row * 16); }
#pragma unroll
        for (int u = 0; u < UB; ++u) { const int e = e0 + u * gthreads; const int ee = ok[u] ? e : e0; const int row = ee >> 8, c = (ee & 255) * 4;
            const float rstd = rsqrtf(sq[u] * (1.0f / 1024.0f) + 1e-6f);
            if (ok[u]) *(f32x4*)(POUT + (size_t)row * 1024 + c) = x[u] * rstd * *(const f32x4*)(PIN(I_FNORMW) + c); }
    }
}

#define XB_TMO      128
#define XB_XCNT(j)  (256  + 64 * (j))
#define XB_XSUB(j)  (1280 + 64 * (j))
#define XB_XGEN(j)  (2304 + 64 * (j))
#define XB_TOP      3328
#define XB_TOPGEN   3392
#define XCD_BAR_WORDS 3456
#define XB_SPIN_CAP (1u << 18)
__device__ __forceinline__ unsigned xb_ld(unsigned* p)              { return __hip_atomic_load(p, __ATOMIC_RELAXED, __HIP_MEMORY_SCOPE_AGENT); }
__device__ __forceinline__ unsigned xb_add(unsigned* p, unsigned v) { return __hip_atomic_fetch_add(p, v, __ATOMIC_RELAXED, __HIP_MEMORY_SCOPE_AGENT); }
__device__ __forceinline__ unsigned xb_xcc_id() { return (unsigned)__builtin_amdgcn_s_getreg((3 << 11) | 20) & 0xFu; }
#define XB_SPIN(cond, bar) do { unsigned _sp = 0; while (cond) { __builtin_amdgcn_s_sleep(1); \
    if ((++_sp & 255u) == 0u) { if (xb_ld(&(bar)[XB_TMO])) break; if (_sp > XB_SPIN_CAP) { atomicAdd(&(bar)[XB_TMO], 1u); break; } } } } while (0)
struct XcdBarrier { unsigned* bar; unsigned x; volatile LAS unsigned* st; };
__device__ __forceinline__ XcdBarrier xcd_barrier_post(unsigned* bar, volatile LAS unsigned* st) {
    XcdBarrier b; b.bar = bar; b.x = xb_xcc_id(); b.st = st;
    if (threadIdx.x == 0) (void)xb_add(&bar[XB_XCNT(b.x)], 1u);
    return b;
}
__device__ __forceinline__ void xcd_barrier_complete(unsigned* bar, unsigned x, unsigned& nloc, unsigned& nx) {
    const unsigned G = gridDim.x * gridDim.y * gridDim.z;
    unsigned sum, cnt, mine, sp = 0u;
    for (;;) {
        sum = 0u; cnt = 0u; mine = 0u;
#pragma unroll
        for (unsigned j = 0; j < 16; ++j) { const unsigned c = xb_ld(&bar[XB_XCNT(j)]); sum += c; cnt += (c > 0u) ? 1u : 0u; mine = (j == x) ? c : mine; }
        if (sum == G) break;
        __builtin_amdgcn_s_sleep(1);
        if ((++sp & 255u) == 0u) { if (xb_ld(&bar[XB_TMO])) break; if (sp > XB_SPIN_CAP) { atomicAdd(&bar[XB_TMO], 1u); break; } }
    }
    nloc = mine > 0u ? mine : 1u; nx = cnt > 0u ? cnt : 1u;
}
__device__ __forceinline__ void xcd_barrier(const XcdBarrier& b) {
    asm volatile("s_waitcnt vmcnt(0)" ::: "memory");
    __syncthreads();
    if (threadIdx.x == 0) {
        unsigned* bar = b.bar;
        __builtin_amdgcn_s_waitcnt(0);
        unsigned nloc = b.st[0], nx = b.st[1];
        if (nloc == 0u) { xcd_barrier_complete(bar, b.x, nloc, nx); b.st[0] = nloc; b.st[1] = nx; }
        const unsigned old = xb_add(&bar[XB_XSUB(b.x)], 1u);
        const unsigned gen = old / nloc;
        if (old + 1u == (gen + 1u) * nloc) {
            __builtin_amdgcn_fence(__ATOMIC_RELEASE, "agent");
            asm volatile("s_waitcnt vmcnt(0)" ::: "memory");
            const unsigned og = xb_add(&bar[XB_TOP], 1u);
            const unsigned tg = og / nx;
            if (og + 1u == (tg + 1u) * nx) xb_add(&bar[XB_TOPGEN], 1u);
            else XB_SPIN(xb_ld(&bar[XB_TOPGEN]) == tg, bar);
            __builtin_amdgcn_fence(__ATOMIC_ACQUIRE, "agent");
            xb_add(&bar[XB_XGEN(b.x)], 1u);
            asm volatile("s_waitcnt vmcnt(0)" ::: "memory");
        } else {
            XB_SPIN(xb_ld(&bar[XB_XGEN(b.x)]) == gen, bar);
            __builtin_amdgcn_fence(__ATOMIC_ACQUIRE, "agent");
            asm volatile("s_waitcnt vmcnt(0)" ::: "memory");
        }
    }
    __syncthreads();
}

__device__ void run_gemm_proj(const Params& p, const Ctx cx, LAS unsigned char* lds, const bf16_t* Bt, int N, bf16_t* O, int ldc, int layer) {
    pg8::Gemm g{(const bf16_t*)(PWS + WS_XB), Bt, NTOK, N, 1024};
    pg8::StaticOrder S; S.init(NTOK, N, (int)cx.nblk, (int)cx.bid);
    EpiProj E{O, ldc, (const float*)(PWS + WS_SSQ) + (size_t)layer * NTOK * 16};
    pg8::gemm_phase<EpiProj>(cx, lds, g, S, E);
}
__device__ void run_gemm_res(const Params& p, const Ctx cx, LAS unsigned char* lds, const bf16_t* Bt, int layer) {
    const bf16_t* A = (const bf16_t*)(PWS + WS_YCAT);
    bf16_t* Xb = (bf16_t*)(PWS + WS_XB);
    float* ssqn = (float*)(PWS + WS_SSQ) + (size_t)(layer + 1) * NTOK * 16;
    pg8::Gemm g{A, Bt, NTOK, 1024, 1024};
    pg8::StaticOrder S; S.init(NTOK, 1024, (int)cx.nblk, (int)cx.bid);
    EpiRes E{layer == 0 ? PIN(I_XP) : nullptr, PIN(I_XS), Xb, ssqn};
    pg8::gemm_phase<EpiRes>(cx, lds, g, S, E);
}

constexpr int N_PHASES = 20;
#ifndef PHMASK
#define PHMASK 0xffff
#endif
#define PHON(n) ((PHMASK >> ((n) % 16)) & 1)
__global__ void __launch_bounds__(512, 2) fwd_kernel(Params p) {
    extern __shared__ __attribute__((aligned(16))) unsigned char lds_raw[];
    LAS unsigned char* lds = (LAS unsigned char*)lds_raw;
    volatile LAS unsigned* bar_st = (volatile LAS unsigned*)(lds + LDS_MAIN);
    if (threadIdx.x < 4) bar_st[threadIdx.x] = 0u;
    __syncthreads();
    const XcdBarrier gbar = xcd_barrier_post((unsigned*)((unsigned char*)p.ptr[30] + WS_BAR), bar_st);
    if (p.ph_hi < 0) cg::this_grid().sync();
#define GRID_SYNC() xcd_barrier(gbar)
#ifdef SYNCPROBE
    for (int i = 0; i < SYNCPROBE; ++i) GRID_SYNC();
#endif
#ifdef REPMASK
    for (int pc = p.ph_lo * 2; pc < p.ph_hi * 2; ++pc) {
        const int ph = pc >> 1;
        { const int s_ = (ph == 0) ? 9 : (ph == N_PHASES - 1) ? 31 : (ph - 1) % 9; if ((pc & 1) && !((REPMASK >> s_) & 1)) continue; }
        if (pc > p.ph_lo * 2) GRID_SYNC();
#else
    for (int ph = p.ph_lo; ph < p.ph_hi; ++ph) {
        if (ph > p.ph_lo) GRID_SYNC();
#endif
        Ctx cx; cx.tid = threadIdx.x; cx.bid = blockIdx.x; cx.nblk = gridDim.x;
        asm volatile("s_mov_b32 %0, 0" : "=s"(cx.z));
        asm volatile("" : "+v"(cx.tid)); asm volatile("" : "+s"(cx.bid)); asm volatile("" : "+s"(cx.nblk));
        const int pair = (ph - 1) / 9, s = (ph == 0) ? 100 : (ph == N_PHASES - 1 ? 101 : (ph - 1) % 9);
        if (s == 0 || s == 3 || s == 6) {
#if PHON(0)
            const bf16_t* WinE = (const bf16_t*)(PWS + WS_WINE) + (size_t)pair * 4352 * 1024;
            const bf16_t* Bt = s == 0 ? WinE + (size_t)2560 * 1024 : (s == 3 ? WinE : (const bf16_t*)(PWS + WS_WINO) + (size_t)pair * 2560 * 1024);
            const int N = s == 0 ? 1792 : 2560;
            run_gemm_proj(p, cx, lds, Bt, N, (bf16_t*)(PWS + WS_R1), N, 2 * pair + (s == 6 ? 1 : 0));
#endif
        } else if (s == 5 || s == 8) {
#if PHON(5)
            const bf16_t* Bt = (const bf16_t*)(PWS + (s == 5 ? WS_WOUTE : WS_WOUTO)) + (size_t)pair * 1024 * 1024;
            run_gemm_res(p, cx, lds, Bt, 2 * pair + (s == 8 ? 1 : 0));
#endif
        } else if (s == 1) {
#if PHON(1)
            phase_even_prep(p, cx, pair, lds);
#endif
        } else if (s == 2) {
#if PHON(2)
            phase_scan(p, cx, pair, lds);
#endif
        } else if (s == 4) {
#if PHON(4)
            phase_even_post(p, cx, pair);
#endif
        } else if (s == 7) {
#if PHON(7)
            phase_odd_mixer(p, cx, pair, lds);
#endif
        } else if (s == 100) {
#if PHON(10)
            phase_prepass(p, cx, lds);
#endif
        } else {
#if PHON(11)
            phase_final(p, cx);
#endif
        }
    }
}

extern "C" void kernel_launch(void* const* d_in, const int* in_sizes, int n_in, void* d_out, int out_size, void* d_ws, size_t ws_size, hipStream_t stream) {
    static int grid = 0;
    if (grid == 0) {
        if (n_in != 29 || ws_size < WS_END) { fprintf(stderr, "kernel_launch: unexpected n_in %d / ws_size %zu (need %zu)\n", n_in, ws_size, (size_t)WS_END); grid = -1; return; }
        int dev = 0, cus = 0, per_cu = 0;
        hipGetDevice(&dev);
        hipDeviceGetAttribute(&cus, hipDeviceAttributeMultiprocessorCount, dev);
        if (hipFuncSetAttribute((const void*)fwd_kernel, hipFuncAttributeMaxDynamicSharedMemorySize, LDS_BYTES) != hipSuccess) { fprintf(stderr, "kernel_launch: hipFuncSetAttribute failed\n"); grid = -1; return; }
        if (hipOccupancyMaxActiveBlocksPerMultiprocessor(&per_cu, (const void*)fwd_kernel, 512, LDS_BYTES) != hipSuccess || per_cu < 1) { fprintf(stderr, "kernel_launch: occupancy query gave %d\n", per_cu); per_cu = 1; }
        (void)hipGetLastError();
        grid = cus * per_cu;
        if (grid > 256) grid = 256;
    }
    if (grid < 0) return;
    Params p{};
    for (int i = 0; i < 29; ++i) p.ptr[i] = d_in[i];
    p.ptr[29] = d_out; p.ptr[30] = d_ws; p.ptr[31] = nullptr;
    (void)hipMemsetAsync((unsigned char*)d_ws + WS_BAR, 0, 16384, stream);
#if ONE_LAUNCH
    p.ph_lo = 0; p.ph_hi = N_PHASES;
    void* args[] = {&p};
    hipError_t e = hipLaunchCooperativeKernel((const void*)fwd_kernel, dim3(grid), dim3(512), args, LDS_BYTES, stream);
    if (e != hipSuccess) fprintf(stderr, "cooperative launch failed: %s (grid %d)\n", hipGetErrorString(e), grid);
#else
    for (int ph = 0; ph < N_PHASES; ++ph) {
        p.ph_lo = ph; p.ph_hi = ph + 1;
        hipLaunchKernelGGL(fwd_kernel, dim3(grid), dim3(512), LDS_BYTES, stream, p);
    }
#endif
}
```

```cpp
#include <hip/hip_runtime.h>
#include <hip/hip_cooperative_groups.h>
#include <cstdio>
namespace cg = cooperative_groups;

#ifndef ONE_LAUNCH
#define ONE_LAUNCH 1
#endif

#define LAS __attribute__((address_space(3)))
typedef unsigned short bf16_t;
typedef short bf16x8 __attribute__((ext_vector_type(8)));
typedef float f32x4 __attribute__((ext_vector_type(4)));
typedef unsigned u32x4 __attribute__((ext_vector_type(4)));
typedef unsigned u32x2 __attribute__((ext_vector_type(2)));

constexpr int NTOK = 17408, NTP = 16384;
constexpr int LDB = 1792;
constexpr int LDA = 2560;
constexpr size_t O_CONVP = 17825792, O_CONVS = 17842176, O_SHIFTP = 18104320, O_SHIFTS = 18130944, O_WKVP = 18556928, O_WKVS = 19081216,
                 O_POOLP = 27469824, O_POOLS = 27592704, O_CHUNKV = 29558784;
constexpr size_t WS_WINE = 0;
constexpr size_t WS_WOUTE = WS_WINE + 2ull * 4352 * 1024 * 2;
constexpr size_t WS_WINO = WS_WOUTE + 2ull * 1024 * 1024 * 2;
constexpr size_t WS_WOUTO = WS_WINO + 2ull * 2560 * 1024 * 2;
constexpr size_t WS_W2T = WS_WOUTO + 2ull * 1024 * 1024 * 2;
constexpr size_t WS_A2T = WS_W2T + 2ull * 512 * 64 * 2;
constexpr size_t WS_POOLWT = WS_A2T + 2ull * 512 * 64 * 2;
constexpr size_t WS_SPW = WS_POOLWT + 8ull * 128 * 128 * 2;
constexpr size_t WS_XB = WS_SPW + 8ull * 128 * 128 * 2;
constexpr size_t WS_YCAT = WS_XB + (size_t)NTOK * 1024 * 2;
constexpr size_t WS_SSQ = WS_YCAT + (size_t)NTOK * 1024 * 2;
constexpr size_t WS_Y = WS_SSQ + 5ull * NTOK * 16 * 4;
constexpr size_t WS_R1 = WS_Y + (size_t)NTOK * 512 * 4;
constexpr size_t WS_PROJB = WS_R1;
constexpr size_t WS_WDEC = WS_PROJB + (size_t)NTOK * LDB * 2;
constexpr size_t WS_AA = WS_WDEC + (size_t)NTOK * 512 * 4;
constexpr size_t WS_BAR = WS_AA + (size_t)NTOK * 512 * 2;
constexpr size_t WS_END = WS_BAR + 16384;
constexpr int LDS_MAIN = 147456;
constexpr int LDS_BYTES = LDS_MAIN + 16;

struct Params {
    const void* ptr[32];
    int ph_lo, ph_hi;
};
struct Ctx { int tid, bid, nblk, z; };
#define PIN(i) ((const float*)p.ptr[(i) + cx.z])
#define POUT ((float*)p.ptr[29 + cx.z])
#define PWS ((unsigned char*)p.ptr[30 + cx.z])
enum { I_XP = 0, I_XS, I_SCONV, I_SSHIFT, I_SWKV, I_SPOOL, I_NORMW, I_FNORMW, I_WINE, I_CONVW, I_MU, I_W0, I_W2, I_A0, I_A2, I_KK, I_KA, I_RK, I_GNG, I_GNB,
       I_WOUTE, I_WINO, I_POOLW, I_PSCALE, I_LNG, I_LNB, I_SPW, I_SPB, I_WOUTO };

__device__ __forceinline__ unsigned cvt_pk_bf16(float lo, float hi) { unsigned r; asm("v_cvt_pk_bf16_f32 %0, %1, %2" : "=v"(r) : "v"(lo), "v"(hi)); return r; }
__device__ __forceinline__ float bf_lo(unsigned u) { return __uint_as_float(u << 16); }
__device__ __forceinline__ float bf_hi(unsigned u) { return __uint_as_float(u & 0xffff0000u); }
__device__ __forceinline__ float bf2f(bf16_t b) { return __uint_as_float(((unsigned)b) << 16); }
__device__ __forceinline__ f32x4 cvt4(u32x2 u) { return (f32x4){bf_lo(u.x), bf_hi(u.x), bf_lo(u.y), bf_hi(u.y)}; }
__device__ __forceinline__ f32x4 ld_bf4(const bf16_t* p) { return cvt4(*(const u32x2*)p); }
__device__ __forceinline__ void st_bf4(bf16_t* p, f32x4 v) { u32x2 u; u.x = cvt_pk_bf16(v[0], v[1]); u.y = cvt_pk_bf16(v[2], v[3]); *(u32x2*)p = u; }
__device__ __forceinline__ float sigmoidf_(float x) { return 1.0f / (1.0f + __expf(-x)); }
__device__ __forceinline__ float siluf_(float x) { return x / (1.0f + __expf(-x)); }
template <int CTRL> __device__ __forceinline__ float dpp_f(float x) { return __builtin_bit_cast(float, __builtin_amdgcn_mov_dpp(__builtin_bit_cast(int, x), CTRL, 0xf, 0xf, true)); }
__device__ __forceinline__ float allsum16(float x) { x += dpp_f<0xB1>(x); x += dpp_f<0x4E>(x); x += dpp_f<0x141>(x); x += dpp_f<0x128>(x); return x; }
__device__ __forceinline__ float allsum4(float x) { x += dpp_f<0xB1>(x); x += dpp_f<0x4E>(x); return x; }
__device__ __forceinline__ float dot4(f32x4 a, f32x4 b) { return a[0] * b[0] + a[1] * b[1] + a[2] * b[2] + a[3] * b[3]; }

__device__ __forceinline__ float ssq_sum(const float* part) {
    const f32x4 a = *(const f32x4*)(part), b = *(const f32x4*)(part + 4), c = *(const f32x4*)(part + 8), d = *(const f32x4*)(part + 12);
    return ((a[0] + a[1]) + (a[2] + a[3])) + ((b[0] + b[1]) + (b[2] + b[3])) + ((c[0] + c[1]) + (c[2] + c[3])) + ((d[0] + d[1]) + (d[2] + d[3]));
}

namespace pg8 {
constexpr int BM = 256, BK = 64, HALF = 128, HTB = HALF * BK * 2, NXCD = 8, WGM = 8;
__device__ __forceinline__ int lds_byte(int r, int c) { const int st = (r >> 4) * 2 + (c >> 5), rr = r & 15, cc = c & 31, ob = rr * 64 + cc * 2; return st * 1024 + (ob ^ (((ob >> 9) & 1) << 5)); }
__device__ __forceinline__ void stage_rc(int b, int& R, int& C) { const int st = b / 1024, sb = b % 1024, swz = sb ^ (((sb >> 9) & 1) << 5); R = (st >> 1) * 16 + swz / 64; C = (st & 1) * 32 + (swz % 64) / 2; }
__device__ __forceinline__ int perm32(int rho) { const int n = rho >> 4, i = rho & 15; return 8 * (i >> 2) + 4 * n + (i & 3); }
struct Unit { int pm, pn; };
struct Gemm { const bf16_t* A; const bf16_t* Bt; int M, N, K; };
struct StaticOrder {
    int nM, nN, nwg, G, c;
    __device__ void init(int M, int N, int G_, int c_) { nM = M / BM; nN = N / BM; nwg = nM * nN; G = G_; c = c_; }
    __device__ bool next(int i, Unit& u) const {
        const long L = (long)i * G + c; if (L >= nwg) return false;
        int wgid = (int)L; { const int q = nwg / NXCD, r = nwg % NXCD, xcd = wgid % NXCD, off = wgid / NXCD; wgid = (xcd < r ? xcd * (q + 1) : r * (q + 1) + (xcd - r) * q) + off; }
        const int nig = WGM * nN, gid = wgid / nig, fm = gid * WGM, gsz = (nM - fm) < WGM ? (nM - fm) : WGM;
        u.pm = fm + ((wgid % nig) % gsz); u.pn = (wgid % nig) / gsz; return true;
    }
};

template <class Epi>
__device__ __forceinline__ void gemm_phase(const Ctx cx, LAS unsigned char* lds, const Gemm g, const StaticOrder& S, const Epi& E) {
    const int tid = cx.tid, wid = __builtin_amdgcn_readfirstlane(tid >> 6), lane = tid & 63, wr = wid >> 2, wc = wid & 3, fr = lane & 15, fq = lane >> 4;
    const int K = g.K, nt = K / BK;
    unsigned voffA[2], voffB[2];
#pragma unroll
    for (int i = 0; i < 2; ++i) { int R, C; stage_rc(tid * 16 + i * 8192, R, C); const int Rb = Epi::PERM ? ((R & ~31) + perm32(R & 31)) : R;
        voffA[i] = (unsigned)(R * K + C) * 2u; voffB[i] = (unsigned)(Rb * K + C) * 2u; }
    const size_t kstep = (size_t)(BK * 2);
    const size_t hstep = (size_t)HALF * K * 2;
    const size_t tstep = 2 * hstep;
    const unsigned ldsw = (unsigned)wid * 1024u;
    const int aoff = lds_byte(wr * 64 + fr, fq * 8), boff = lds_byte(wc * 32 + fr, fq * 8);
#define PG8_SA(b, h) (((b) * 2 + (h)) * HTB)
#define PG8_SB(b, h) ((4 + (b) * 2 + (h)) * HTB)
#define PG8_STAGE(bufoff, gbase, voff) do { _Pragma("unroll") for (int _i = 0; _i < 2; ++_i) \
        __builtin_amdgcn_global_load_lds((const unsigned*)((const char*)(gbase) + (voff)[_i]), (LAS unsigned*)(lds + (bufoff) + ldsw + _i * 8192), 16, 0, 0); } while (0)
#define PG8_LDA(dst, b, h) do { _Pragma("unroll") for (int m = 0; m < 4; ++m) _Pragma("unroll") for (int k = 0; k < 2; ++k) dst[m][k] = *(const LAS bf16x8*)(lds + PG8_SA(b, h) + aoff + m * 2048 + k * 1024); } while (0)
#define PG8_LDB(dst, b, h) do { _Pragma("unroll") for (int n = 0; n < 2; ++n) _Pragma("unroll") for (int k = 0; k < 2; ++k) dst[n][k] = *(const LAS bf16x8*)(lds + PG8_SB(b, h) + boff + n * 2048 + k * 1024); } while (0)
#define PG8_MMA(ai, bj, At, Bt) do { __builtin_amdgcn_s_setprio(1); _Pragma("unroll") for (int m = 0; m < 4; ++m) _Pragma("unroll") for (int n = 0; n < 2; ++n) _Pragma("unroll") for (int k = 0; k < 2; ++k) \
        acc[ai][bj][m][n] = __builtin_amdgcn_mfma_f32_16x16x32_bf16(Bt[n][k], At[m][k], acc[ai][bj][m][n], 0, 0, 0); __builtin_amdgcn_s_setprio(0); } while (0)
#define PG8_WAIT_V(n) asm volatile("s_waitcnt vmcnt(" #n ")" ::: "memory")
#define PG8_WAIT_L(n) asm volatile("s_waitcnt lgkmcnt(" #n ")" ::: "memory")
#define PG8_BAR __builtin_amdgcn_s_barrier()
#define PG8_SCHED __builtin_amdgcn_sched_barrier(0)
    Unit cur, nxt; int ui = 0;
    if (!S.next(0, cur)) return;
    f32x4 acc[2][2][4][2];
#pragma unroll
    for (int a = 0; a < 2; ++a)
#pragma unroll
        for (int b = 0; b < 2; ++b)
#pragma unroll
            for (int m = 0; m < 4; ++m)
#pragma unroll
                for (int n = 0; n < 2; ++n) acc[a][b][m][n] = (f32x4){0.f, 0.f, 0.f, 0.f};
    bf16x8 At[4][2], B0[2][2], B1[2][2];
    const char* cA = (const char*)g.A + (size_t)cur.pm * tstep; const char* cB = (const char*)g.Bt + (size_t)cur.pn * tstep;
    PG8_STAGE(PG8_SB(0, 0), cB, voffB); PG8_STAGE(PG8_SA(0, 0), cA, voffA); PG8_STAGE(PG8_SB(0, 1), cB + hstep, voffB); PG8_STAGE(PG8_SA(0, 1), cA + hstep, voffA);
    if (wr == 1) PG8_BAR;
    PG8_WAIT_V(4); PG8_BAR;
    PG8_STAGE(PG8_SB(1, 0), cB + kstep, voffB); PG8_STAGE(PG8_SA(1, 0), cA + kstep, voffA); PG8_STAGE(PG8_SB(1, 1), cB + hstep + kstep, voffB);
    PG8_WAIT_V(6); PG8_BAR;
    for (;;) {
        const bool has_next = S.next(ui + 1, nxt);
        const char* nA = has_next ? (const char*)g.A + (size_t)nxt.pm * tstep : cA; const char* nB = has_next ? (const char*)g.Bt + (size_t)nxt.pn * tstep : cB;
        for (int t = 0; t < nt; t += 2) {
            const bool last = (t == nt - 2);
            const char* a1 = cA + (size_t)(t + 1) * kstep;
            const char* a2 = last ? nA : cA + (size_t)(t + 2) * kstep; const char* b2 = last ? nB : cB + (size_t)(t + 2) * kstep;
            const char* a3 = a2 + kstep; const char* b3 = b2 + kstep;
            PG8_LDB(B0, 0, 0); PG8_SCHED; PG8_LDA(At, 0, 0); PG8_STAGE(PG8_SA(1, 1), a1 + hstep, voffA);
            PG8_WAIT_L(8); PG8_BAR; PG8_WAIT_L(0); PG8_MMA(0, 0, At, B0); PG8_BAR; PG8_SCHED;
            PG8_LDB(B1, 0, 1); PG8_STAGE(PG8_SB(0, 0), b2, voffB);
            PG8_BAR; PG8_WAIT_L(0); PG8_MMA(0, 1, At, B1); PG8_BAR;
            PG8_LDA(At, 0, 1); PG8_STAGE(PG8_SA(0, 0), a2, voffA);
            PG8_BAR; PG8_WAIT_L(0); PG8_MMA(1, 0, At, B0); PG8_BAR; PG8_SCHED;
            PG8_STAGE(PG8_SB(0, 1), b2 + hstep, voffB);
            PG8_WAIT_V(6); PG8_BAR; PG8_MMA(1, 1, At, B1); PG8_BAR;
            PG8_LDB(B0, 1, 0); PG8_SCHED; PG8_LDA(At, 1, 0); PG8_STAGE(PG8_SA(0, 1), a2 + hstep, voffA);
            PG8_WAIT_L(8); PG8_BAR; PG8_WAIT_L(0); PG8_MMA(0, 0, At, B0); PG8_BAR; PG8_SCHED;
            PG8_LDB(B1, 1, 1); PG8_STAGE(PG8_SB(1, 0), b3, voffB);
            PG8_BAR; PG8_WAIT_L(0); PG8_MMA(0, 1, At, B1); PG8_BAR;
            PG8_LDA(At, 1, 1); PG8_STAGE(PG8_SA(1, 0), a3, voffA);
            PG8_BAR; PG8_WAIT_L(0); PG8_MMA(1, 0, At, B0); PG8_BAR; PG8_SCHED;
            PG8_STAGE(PG8_SB(1, 1), b3 + hstep, voffB);
            PG8_WAIT_V(6); PG8_BAR; PG8_MMA(1, 1, At, B1); PG8_BAR;
        }
        E(acc, cur, wr, wc, fr, fq);
        if (!has_next) break;
#pragma unroll
        for (int a = 0; a < 2; ++a)
#pragma unroll
            for (int b = 0; b < 2; ++b)
#pragma unroll
                for (int m = 0; m < 4; ++m)
#pragma unroll
                    for (int n = 0; n < 2; ++n) acc[a][b][m][n] = (f32x4){0.f, 0.f, 0.f, 0.f};
        cur = nxt; cA = nA; cB = nB; ++ui;
    }
    PG8_WAIT_V(0);
    if (wr == 0) PG8_BAR;
    PG8_BAR;
#undef PG8_SA
#undef PG8_SB
#undef PG8_STAGE
#undef PG8_LDA
#undef PG8_LDB
#undef PG8_MMA
#undef PG8_WAIT_V
#undef PG8_WAIT_L
#undef PG8_BAR
#undef PG8_SCHED
}
}

struct EpiProj {
    static constexpr bool PERM = true;
    bf16_t* O; int ldc; const float* ssq;
    __device__ __forceinline__ void operator()(const f32x4 (&acc)[2][2][4][2], const pg8::Unit& u, int wr, int wc, int fr, int fq) const {
        const int row0 = u.pm * 256 + wr * 64 + fr, col0 = u.pn * 256 + wc * 32 + 8 * fq;
#pragma unroll
        for (int ai = 0; ai < 2; ++ai)
#pragma unroll
            for (int m = 0; m < 4; ++m) {
                const int row = row0 + ai * 128 + m * 16;
                const float rstd = rsqrtf(ssq_sum(ssq + (size_t)row * 16) * (1.0f / 1024.0f) + 1e-6f);
                bf16_t* rowp = O + (size_t)row * ldc + col0;
#pragma unroll
                for (int bj = 0; bj < 2; ++bj) {
                    const f32x4 v0 = acc[ai][bj][m][0] * rstd, v1 = acc[ai][bj][m][1] * rstd;
                    u32x4 w; w.x = cvt_pk_bf16(v0[0], v0[1]); w.y = cvt_pk_bf16(v0[2], v0[3]); w.z = cvt_pk_bf16(v1[0], v1[1]); w.w = cvt_pk_bf16(v1[2], v1[3]);
                    *(u32x4*)(rowp + bj * 128) = w;
                }
            }
    }
};
struct X8 { f32x4 lo, hi; };
template <bool FIRST> __device__ __forceinline__ X8 ld_x8(const float* __restrict__ s32, const bf16_t* __restrict__ s16, size_t o) {
    X8 r;
    if (FIRST) { r.lo = *(const f32x4*)(s32 + o); r.hi = *(const f32x4*)(s32 + o + 4); }
    else { const u32x4 u = *(const u32x4*)(s16 + o); r.lo = cvt4((u32x2){u.x, u.y}); r.hi = cvt4((u32x2){u.z, u.w}); }
    return r;
}
__device__ __forceinline__ void st_x8(bf16_t* p, f32x4 lo, f32x4 hi) { u32x4 w; w.x = cvt_pk_bf16(lo[0], lo[1]); w.y = cvt_pk_bf16(lo[2], lo[3]); w.z = cvt_pk_bf16(hi[0], hi[1]); w.w = cvt_pk_bf16(hi[2], hi[3]); *(u32x4*)p = w; }
template <bool FIRST>
__device__ __forceinline__ void epi_res_rows(const f32x4 (&acc)[2][2][4][2], const float* __restrict__ src32, const bf16_t* __restrict__ src16, bf16_t* __restrict__ Xb, float* __restrict__ ssqp,
                                             int row0, int col0, int slot, int fq) {
    X8 x[2][2];
#pragma unroll
    for (int bj = 0; bj < 2; ++bj) x[0][bj] = ld_x8<FIRST>(src32, src16, (size_t)row0 * 1024 + col0 + bj * 128);
#pragma unroll
    for (int gi = 0; gi < 8; ++gi) {
        const int ai = gi >> 2, m = gi & 3, row = row0 + ai * 128 + m * 16;
        if (gi + 1 < 8) {
            const int nrow = row0 + ((gi + 1) >> 2) * 128 + ((gi + 1) & 3) * 16;
#pragma unroll
            for (int bj = 0; bj < 2; ++bj) x[(gi + 1) & 1][bj] = ld_x8<FIRST>(src32, src16, (size_t)nrow * 1024 + col0 + bj * 128);
        }
        float part = 0.f;
#pragma unroll
        for (int bj = 0; bj < 2; ++bj) {
            const f32x4 lo = x[gi & 1][bj].lo + acc[ai][bj][m][0], hi = x[gi & 1][bj].hi + acc[ai][bj][m][1];
            st_x8(Xb + (size_t)row * 1024 + col0 + bj * 128, lo, hi);
            part += dot4(lo, lo) + dot4(hi, hi);
        }
        part += __shfl_xor(part, 16); part += __shfl_xor(part, 32);
        if (fq == 0) ssqp[(size_t)row * 16 + slot] = part;
    }
}
struct EpiRes {
    static constexpr bool PERM = true;
    const float* xp; const float* xs; bf16_t* Xb; float* ssq_next;
    __device__ __forceinline__ void operator()(const f32x4 (&acc)[2][2][4][2], const pg8::Unit& u, int wr, int wc, int fr, int fq) const {
        const int row0 = u.pm * 256 + wr * 64 + fr, col0 = u.pn * 256 + wc * 32 + 8 * fq;
        if (xp) epi_res_rows<true>(acc, row0 < NTP ? xp : xs - (size_t)NTP * 1024, nullptr, Xb, ssq_next, row0, col0, u.pn * 4 + wc, fq);
        else epi_res_rows<false>(acc, nullptr, Xb, Xb, ssq_next, row0, col0, u.pn * 4 + wc, fq);
    }
};

template <bool FIRST>
__device__ __forceinline__ void res_sample_tile(const Ctx cx, const bf16_t* __restrict__ A, const bf16_t* __restrict__ Bt, const float* __restrict__ xs, bf16_t* __restrict__ Xb, float* __restrict__ ssqp, int tile) {
    const int tid = cx.tid, wid = tid >> 6, lane = tid & 63, fr = lane & 15, fq = lane >> 4;
    const int tm = tile >> 3, tn = tile & 7;
    const int r0 = NTP + tm * 64 + (wid & 3) * 16, c0 = tn * 128 + (wid >> 2) * 64;
    const bf16_t* ap = A + (size_t)(r0 + fr) * 1024 + fq * 8;
    const bf16_t* bp = Bt + (size_t)(c0 + fr) * 1024 + fq * 8;
    f32x4 acc[4];
#pragma unroll
    for (int nt = 0; nt < 4; ++nt) acc[nt] = (f32x4){0.f, 0.f, 0.f, 0.f};
#pragma unroll 8
    for (int ks = 0; ks < 32; ++ks) {
        const bf16x8 af = *(const bf16x8*)(ap + ks * 32);
#pragma unroll
        for (int nt = 0; nt < 4; ++nt) {
            const bf16x8 bf = *(const bf16x8*)(bp + (size_t)nt * 16 * 1024 + ks * 32);
            acc[nt] = __builtin_amdgcn_mfma_f32_16x16x32_bf16(bf, af, acc[nt], 0, 0, 0);
        }
    }
    const int row = r0 + fr;
    float part = 0.f;
#pragma unroll
    for (int nt = 0; nt < 4; ++nt) {
        const int col = c0 + nt * 16 + fq * 4;
        const f32x4 xo = FIRST ? *(const f32x4*)(xs + (size_t)(row - NTP) * 1024 + col) : ld_bf4(Xb + (size_t)row * 1024 + col);
        const f32x4 v = xo + acc[nt];
        st_bf4(Xb + (size_t)row * 1024 + col, v);
        part += dot4(v, v);
    }
    part += __shfl_xor(part, 16); part += __shfl_xor(part, 32);
    if (fq == 0) ssqp[(size_t)row * 16 + (c0 >> 6)] = part;
}

__device__ __forceinline__ void tr_tile(const Ctx cx, LAS float* T, const float* src, int ld, int col0, int k0, bf16_t* dst, int Ktot, int drow0, const float* scale, bool zero) {
    const int tid = cx.tid;
    if (zero) {
        const int n = tid >> 3, kc = (tid & 7) * 8;
        *(u32x4*)(dst + (size_t)(drow0 + n) * Ktot + k0 + kc) = (u32x4){0u, 0u, 0u, 0u};
        return;
    }
#pragma unroll
    for (int pass = 0; pass < 2; ++pass) {
        const int kk = (tid >> 4) + pass * 32, nn = (tid & 15) * 4;
        f32x4 v = *(const f32x4*)(src + (size_t)(k0 + kk) * ld + col0 + nn);
        if (scale) v = v * scale[k0 + kk];
        T[kk * 65 + nn] = v[0]; T[kk * 65 + nn + 1] = v[1]; T[kk * 65 + nn + 2] = v[2]; T[kk * 65 + nn + 3] = v[3];
    }
    __syncthreads();
    {
        const int n = tid >> 3, kc = (tid & 7) * 8;
        u32x4 w;
        w.x = cvt_pk_bf16(T[(kc + 0) * 65 + n], T[(kc + 1) * 65 + n]); w.y = cvt_pk_bf16(T[(kc + 2) * 65 + n], T[(kc + 3) * 65 + n]);
        w.z = cvt_pk_bf16(T[(kc + 4) * 65 + n], T[(kc + 5) * 65 + n]); w.w = cvt_pk_bf16(T[(kc + 6) * 65 + n], T[(kc + 7) * 65 + n]);
        *(u32x4*)(dst + (size_t)(drow0 + n) * Ktot + k0 + kc) = w;
    }
    __syncthreads();
}

__device__ void phase_prepass(const Params& p, const Ctx cx, LAS unsigned char* lds) {
    LAS float* T = (LAS float*)lds;
    const int tid = cx.tid;
    for (int job = cx.bid; job < 4544; job += cx.nblk) {
        int j = job;
        if (j < 2176) {
            const int i = j / 1088, r = j % 1088, nt = r / 16, kt = r % 16;
            const int n0 = nt * 64;
            int col0; bool zero = false;
            if (n0 < 2048) col0 = n0; else if (n0 < 2560) col0 = 3712 + (n0 - 2048); else if (n0 < 4224) col0 = 2048 + (n0 - 2560); else { col0 = 0; zero = true; }
            tr_tile(cx, T, PIN(I_WINE) + (size_t)i * 1024 * 4224, 4224, col0, kt * 64, (bf16_t*)(PWS + WS_WINE) + (size_t)i * 4352 * 1024, 1024, n0, PIN(I_NORMW) + (2 * i) * 1024, zero);
            continue;
        }
        j -= 2176;
        if (j < 512) { const int i = j / 256, r = j % 256, nt = r / 16, kt = r % 16;
            tr_tile(cx, T, PIN(I_WOUTE) + (size_t)i * 1024 * 1024, 1024, nt * 64, kt * 64, (bf16_t*)(PWS + WS_WOUTE) + (size_t)i * 1024 * 1024, 1024, nt * 64, nullptr, false); continue; }
        j -= 512;
        if (j < 1280) { const int i = j / 640, r = j % 640, nt = r / 16, kt = r % 16;
            tr_tile(cx, T, PIN(I_WINO) + (size_t)i * 1024 * 2560, 2560, nt * 64, kt * 64, (bf16_t*)(PWS + WS_WINO) + (size_t)i * 2560 * 1024, 1024, nt * 64, PIN(I_NORMW) + (2 * i + 1) * 1024, false); continue; }
        j -= 1280;
        if (j < 512) { const int i = j / 256, r = j % 256, nt = r / 16, kt = r % 16;
            tr_tile(cx, T, PIN(I_WOUTO) + (size_t)i * 1024 * 1024, 1024, nt * 64, kt * 64, (bf16_t*)(PWS + WS_WOUTO) + (size_t)i * 1024 * 1024, 1024, nt * 64, nullptr, false); continue; }
        j -= 512;
        if (j < 16) { const int i = j / 8, nt = j % 8;
            tr_tile(cx, T, PIN(I_W2) + (size_t)i * 64 * 512, 512, nt * 64, 0, (bf16_t*)(PWS + WS_W2T) + (size_t)i * 512 * 64, 64, nt * 64, nullptr, false); continue; }
        j -= 16;
        if (j < 16) { const int i = j / 8, nt = j % 8;
            tr_tile(cx, T, PIN(I_A2) + (size_t)i * 64 * 512, 512, nt * 64, 0, (bf16_t*)(PWS + WS_A2T) + (size_t)i * 512 * 64, 64, nt * 64, nullptr, false); continue; }
        j -= 16;
        { const int ig = j / 4, r = j % 4, nt = r / 2, kt = r % 2;
            tr_tile(cx, T, PIN(I_POOLW) + (size_t)ig * 128 * 128, 128, nt * 64, kt * 64, (bf16_t*)(PWS + WS_POOLWT) + (size_t)ig * 128 * 128, 128, nt * 64, nullptr, false); }
    }
    const int gtid = cx.bid * 512 + tid, gthreads = cx.nblk * 512;
    for (int e = gtid; e < 8 * 128 * 128; e += gthreads) {
        const int s = e & 127, t = (e >> 7) & 127;
        ((bf16_t*)(PWS + WS_SPW))[e] = (s <= t) ? (bf16_t)(cvt_pk_bf16(PIN(I_SPW)[e], 0.f) & 0xffffu) : (bf16_t)0;
    }
    const int wid = tid >> 6, lane = tid & 63;
    for (int row = cx.bid * 8 + wid; row < NTOK; row += cx.nblk * 8) {
        const float* src = row < NTP ? PIN(I_XP) + (size_t)row * 1024 : PIN(I_XS) + (size_t)(row - NTP) * 1024;
        bf16_t* dst = (bf16_t*)(PWS + WS_XB) + (size_t)row * 1024;
        float ss = 0.f;
#pragma unroll
        for (int i = 0; i < 4; ++i) { const f32x4 v = *(const f32x4*)(src + i * 256 + lane * 4); ss += dot4(v, v); st_bf4(dst + i * 256 + lane * 4, v); }
#pragma unroll
        for (int o = 32; o >= 1; o >>= 1) ss += __shfl_xor(ss, o);
        if (lane < 16) ((float*)(PWS + WS_SSQ))[(size_t)row * 16 + lane] = (lane == 0) ? ss : 0.f;
    }
}

__device__ __forceinline__ f32x4 shift4(const bf16_t* cur, bool hp, const float* st, int col, const float* mu) {
    const f32x4 q = ld_bf4(cur + col);
    f32x4 pv;
    if (hp) pv = ld_bf4(cur - LDB + col); else if (st) pv = *(const f32x4*)(st + col); else pv = (f32x4){0.f, 0.f, 0.f, 0.f};
    const f32x4 m = *(const f32x4*)(mu + col);
    return q + m * (pv - q);
}

__device__ void phase_even_prep(const Params& p, const Ctx cx, int pair, LAS unsigned char* lds) {
    const int tid = cx.tid, wid = tid >> 6, lane = tid & 63, fr = lane & 15, fq = lane >> 4;
    const bf16_t* PB = (const bf16_t*)(PWS + WS_PROJB);
    float* Wdec = (float*)(PWS + WS_WDEC);
    bf16_t* Aa = (bf16_t*)(PWS + WS_AA);
    bf16_t* Ycat = (bf16_t*)(PWS + WS_YCAT);
    const float* mu_ = PIN(I_MU) + pair * 1664;
    const float* w0_ = PIN(I_W0) + pair * 512; const float* a0_ = PIN(I_A0) + pair * 512;
    const float* k_a_ = PIN(I_KA) + pair * 512; const float* r_k_ = PIN(I_RK) + pair * 512;
    constexpr int RS = 3344;
    constexpr int TB = 17 * RS;
    constexpr int NCH = 17 * 208;
    const int h = wid;
    bf16x8 wfr[4][2], afr[4][2];
    {
        const bf16_t* W2T = (const bf16_t*)(PWS + WS_W2T) + (size_t)pair * 512 * 64;
        const bf16_t* A2T = (const bf16_t*)(PWS + WS_A2T) + (size_t)pair * 512 * 64;
#pragma unroll
        for (int nt = 0; nt < 4; ++nt)
#pragma unroll
            for (int ks = 0; ks < 2; ++ks) {
                wfr[nt][ks] = *(const bf16x8*)(W2T + (size_t)(h * 64 + nt * 16 + fr) * 64 + ks * 32 + fq * 8);
                afr[nt][ks] = *(const bf16x8*)(A2T + (size_t)(h * 64 + nt * 16 + fr) * 64 + ks * 32 + fq * 8);
            }
    }
    constexpr int buf = 0;
    for (int tile = cx.bid; tile < NTOK / 16; tile += cx.nblk) {
        int zz; asm volatile("v_mov_b32 %0, 0" : "=v"(zz));
        const int tidv = tid + zz, fr = (tidv & 15), fq = (tidv >> 4) & 3;
        {
            const int r0_ = tile * 16;
#pragma unroll
            for (int i_ = 0; i_ < 7; ++i_) {
                const int c_ = tidv + i_ * 512;
                if (c_ < NCH) { const int lr_ = c_ / 208, cc_ = c_ % 208; int gr_ = r0_ - 1 + lr_; gr_ = gr_ < 0 ? 0 : gr_;
                    *(LAS u32x4*)(lds + lr_ * RS + cc_ * 16) = *(const u32x4*)(PB + (size_t)gr_ * LDB + cc_ * 8); }
            }
        }
        __syncthreads();
        {
            const int row = tile * 16 + fr;
            const bool samp = row >= NTP;
            int b, t; if (!samp) { b = row >> 11; t = row & 2047; } else { const int q = row - NTP; b = q >> 3; t = q & 7; }
            const bool hp = t > 0;
            const float* st = samp ? PIN(I_SSHIFT) + ((size_t)pair * 128 + b) * 1664 : nullptr;
            const float* mu = mu_ + zz; const float* w0 = w0_ + zz; const float* a0 = a0_ + zz; const float* k_a = k_a_ + zz; const float* r_k = r_k_ + zz;
            LAS const unsigned char* curL = lds + buf * TB + (fr + 1) * RS;
            LAS const unsigned char* prvL = lds + buf * TB + fr * RS;
            auto sh4 = [&](int col) -> f32x4 {
                const f32x4 q = cvt4(*(LAS const u32x2*)(curL + col * 2));
                f32x4 pv;
                if (hp) pv = cvt4(*(LAS const u32x2*)(prvL + col * 2)); else if (st) pv = *(const f32x4*)(st + col); else pv = (f32x4){0.f, 0.f, 0.f, 0.f};
                const f32x4 m = *(const f32x4*)(mu + col);
                return q + m * (pv - q);
            };
            bf16x8 Aw[2], Al[2];
#pragma unroll
            for (int ks = 0; ks < 2; ++ks) {
                const int cw = 1536 + ks * 32 + fq * 8, ca = 1600 + ks * 32 + fq * 8;
                const f32x4 w_lo = sh4(cw), w_hi = sh4(cw + 4), a_lo = sh4(ca), a_hi = sh4(ca + 4);
                u32x4 pw, pa;
                float th[8];
#pragma unroll
                for (int j = 0; j < 4; ++j) { th[j] = 2.0f * sigmoidf_(2.0f * w_lo[j]) - 1.0f; th[4 + j] = 2.0f * sigmoidf_(2.0f * w_hi[j]) - 1.0f; }
                pw.x = cvt_pk_bf16(th[0], th[1]); pw.y = cvt_pk_bf16(th[2], th[3]); pw.z = cvt_pk_bf16(th[4], th[5]); pw.w = cvt_pk_bf16(th[6], th[7]);
                pa.x = cvt_pk_bf16(a_lo[0], a_lo[1]); pa.y = cvt_pk_bf16(a_lo[2], a_lo[3]); pa.z = cvt_pk_bf16(a_hi[0], a_hi[1]); pa.w = cvt_pk_bf16(a_hi[2], a_hi[3]);
                Aw[ks] = __builtin_bit_cast(bf16x8, pw); Al[ks] = __builtin_bit_cast(bf16x8, pa);
            }
            float bon = 0.f;
#pragma unroll
            for (int nt = 0; nt < 4; ++nt) {
                f32x4 lw = (f32x4){0.f, 0.f, 0.f, 0.f}, la = (f32x4){0.f, 0.f, 0.f, 0.f};
#pragma unroll
                for (int ks = 0; ks < 2; ++ks) {
                    lw = __builtin_amdgcn_mfma_f32_16x16x32_bf16(wfr[nt][ks], Aw[ks], lw, 0, 0, 0);
                    la = __builtin_amdgcn_mfma_f32_16x16x32_bf16(afr[nt][ks], Al[ks], la, 0, 0, 0);
                }
                const int ch = h * 64 + nt * 16 + fq * 4;
                const f32x4 r4 = sh4(ch), k4 = sh4(512 + ch);
                const f32x4 w04 = *(const f32x4*)(w0 + ch), a04 = *(const f32x4*)(a0 + ch), ka4 = *(const f32x4*)(k_a + ch), rk4 = *(const f32x4*)(r_k + ch);
                f32x4 dec, av;
#pragma unroll
                for (int j = 0; j < 4; ++j) {
                    const float z_ = -(w04[j] + lw[j]);
                    const float wlog = -__logf(1.0f + __expf(z_)) - 0.5f;
                    dec[j] = __expf(-__expf(wlog));
                    av[j] = sigmoidf_(a04[j] + la[j]);
                    const float kp = k4[j] * (1.0f + (av[j] - 1.0f) * ka4[j]);
                    bon += r4[j] * kp * rk4[j];
                }
                *(f32x4*)(Wdec + (size_t)row * 512 + ch) = dec;
                st_bf4(Aa + (size_t)row * 512 + ch, av);
            }
            bon += __shfl_xor(bon, 16); bon += __shfl_xor(bon, 32);
#pragma unroll
            for (int nt = 0; nt < 4; ++nt) { const int ch = h * 64 + nt * 16 + fq * 4; st_bf4(Ycat + (size_t)row * 1024 + 512 + ch, sh4(1024 + ch) * bon); }
        }
        __syncthreads();
    }
    const int gtid = cx.bid * 512 + tid, gthreads = cx.nblk * 512;
    for (int e = gtid; e < 136 * 1664; e += gthreads) {
        const int sr = e / 1664, c = e % 1664;
        if (sr < 8) POUT[O_SHIFTP + ((size_t)pair * 8 + sr) * 1664 + c] = bf2f(PB[(size_t)(sr * 2048 + 2047) * LDB + c]);
        else { const int b = sr - 8; POUT[O_SHIFTS + ((size_t)pair * 128 + b) * 1664 + c] = bf2f(PB[(size_t)(NTP + b * 8 + 7) * LDB + c]); }
    }
}

typedef float f32x2 __attribute__((ext_vector_type(2)));
__device__ __forceinline__ void scan_step(f32x4& S, const f32x4 w, const f32x4 k, const f32x4 kk, const f32x4 nb, const f32x4 r, const float v, float& y) {
    const f32x2 S01 = {S[0], S[1]}, S23 = {S[2], S[3]};
    f32x2 pp = S01 * (f32x2){kk[0], kk[1]};
    pp = S23 * (f32x2){kk[2], kk[3]} + pp;
    float pd = pp[0] + pp[1];
    const f32x2 vv = {v, v};
    const f32x2 t01 = S01 * (f32x2){w[0], w[1]} + (f32x2){k[0], k[1]} * vv;
    const f32x2 t23 = S23 * (f32x2){w[2], w[3]} + (f32x2){k[2], k[3]} * vv;
    pd = allsum16(pd);
    const f32x2 pdv = {pd, pd};
    const f32x2 n01 = (f32x2){nb[0], nb[1]} * pdv + t01, n23 = (f32x2){nb[2], nb[3]} * pdv + t23;
    S = (f32x4){n01[0], n01[1], n23[0], n23[1]};
    f32x2 q = n01 * (f32x2){r[0], r[1]};
    q = n23 * (f32x2){r[2], r[3]} + q;
    y = allsum16(q[0] + q[1]);
}

__device__ void phase_scan(const Params& p, const Ctx cx, int pair, LAS unsigned char* lds) {
    const int tid = cx.tid, wid = tid >> 6, lane = tid & 63, rs = lane >> 4, cgi = lane & 15;
    const bf16_t* PB = (const bf16_t*)(PWS + WS_PROJB);
    const float* Wdec = (const float*)(PWS + WS_WDEC);
    const bf16_t* Aa = (const bf16_t*)(PWS + WS_AA);
    float* Y = (float*)(PWS + WS_Y);
    const float* mu = PIN(I_MU) + pair * 1664;
    const float* k_k = PIN(I_KK) + pair * 512; const float* k_a = PIN(I_KA) + pair * 512;
    {
        LAS float* vb = (LAS float*)lds + wid * 3072;
        for (int st = cx.bid * 8 + wid; st < 2048; st += cx.nblk * 8) {
            const int bh = st >> 1, half = st & 1, b = bh >> 3, h = bh & 7, ch = h * 64 + cgi * 4;
            const float* stp = PIN(I_SSHIFT) + ((size_t)pair * 128 + b) * 1664;
            const f32x4 kkc = *(const f32x4*)(k_k + ch), kac = *(const f32x4*)(k_a + ch);
            {
#pragma unroll
                for (int tt = 0; tt < 2; ++tt) {
                    const int t = rs + tt * 4;
                    const size_t row = NTP + b * 8 + t;
                    const bf16_t* cur = PB + row * LDB;
                    const f32x4 r = shift4(cur, t > 0, stp, ch, mu), k = shift4(cur, t > 0, stp, 512 + ch, mu), v = shift4(cur, t > 0, stp, 1024 + ch, mu);
                    const f32x4 a = ld_bf4(Aa + row * 512 + ch);
                    const f32x4 w = *(const f32x4*)(Wdec + row * 512 + ch);
                    const f32x4 kkv = k * kkc;
                    const float ss = allsum16(dot4(kkv, kkv));
                    const float inv = 1.0f / fmaxf(sqrtf(ss), 1e-12f);
                    const f32x4 kkn = kkv * inv;
                    LAS float* o = vb + t * 384 + cgi * 4;
                    *(LAS f32x4*)(o) = w; *(LAS f32x4*)(o + 64) = k * (1.0f + (a - 1.0f) * kac); *(LAS f32x4*)(o + 128) = kkn; *(LAS f32x4*)(o + 192) = -(kkn * a);
                    *(LAS f32x4*)(o + 256) = r; *(LAS f32x4*)(o + 320) = v;
                }
            }
            asm volatile("s_waitcnt lgkmcnt(0)" ::: "memory");
            __builtin_amdgcn_wave_barrier();
#pragma unroll 1
            for (int rq = 0; rq < 8; ++rq) {
                const int ri = half * 32 + rq * 4 + rs;
                const size_t so = ((((size_t)pair * 128 + b) * 8 + h) * 64 + ri) * 64 + cgi * 4;
                f32x4 S = *(const f32x4*)(PIN(I_SWKV) + so);
#pragma unroll
                for (int t = 0; t < 8; ++t) {
                    LAS const float* r0 = vb + t * 384 + cgi * 4;
                    float y; scan_step(S, *(LAS const f32x4*)(r0), *(LAS const f32x4*)(r0 + 64), *(LAS const f32x4*)(r0 + 128), *(LAS const f32x4*)(r0 + 192), *(LAS const f32x4*)(r0 + 256), vb[t * 384 + 320 + ri], y);
                    if (cgi == 0) Y[(size_t)(NTP + b * 8 + t) * 512 + h * 64 + ri] = y;
                }
                *(f32x4*)(POUT + O_WKVS + so) = S;
            }
            asm volatile("s_waitcnt lgkmcnt(0)" ::: "memory");
            __builtin_amdgcn_wave_barrier();
        }
    }
    __syncthreads();
    LAS float* rec = (LAS float*)lds;
    for (int pt = cx.bid; pt < 256; pt += cx.nblk) {
        const int xcd = pt & 7, slot = pt >> 3, bh = xcd * 8 + (slot >> 2), rg = slot & 3, b = bh >> 3, h = bh & 7;
        const int lt = tid - 256, ls = (lt >> 4) & 15, lcg = lt & 15, lch = h * 64 + lcg * 4;
        u32x2 qr = {0u, 0u}, qk = {0u, 0u}, qv = {0u, 0u}, pr = {0u, 0u}, pk = {0u, 0u}, pv = {0u, 0u}, qa = {0u, 0u};
        f32x4 qw = (f32x4){0.f, 0.f, 0.f, 0.f};
        f32x4 mur, muk, muv, kkc, kac;
        const int ri = rg * 16 + (wid & 3) * 4 + rs;
        f32x4 S = (f32x4){0.f, 0.f, 0.f, 0.f};
#define SCAN_ISSUE(c) do { const int t_ = (c) * 16 + ls; const size_t row_ = (size_t)b * 2048 + t_; const bf16_t* cur_ = PB + row_ * LDB; \
            qr = *(const u32x2*)(cur_ + lch); qk = *(const u32x2*)(cur_ + 512 + lch); qv = *(const u32x2*)(cur_ + 1024 + lch); \
            if (t_ > 0) { pr = *(const u32x2*)(cur_ - LDB + lch); pk = *(const u32x2*)(cur_ - LDB + 512 + lch); pv = *(const u32x2*)(cur_ - LDB + 1024 + lch); } \
            else { pr = (u32x2){0u, 0u}; pk = pr; pv = pr; } \
            qw = *(const f32x4*)(Wdec + row_ * 512 + lch); qa = *(const u32x2*)(Aa + row_ * 512 + lch); } while (0)
#define SCAN_PROCESS(buf) do { const f32x4 r0_ = cvt4(qr), k0_ = cvt4(qk), v0_ = cvt4(qv); \
            const f32x4 r_ = r0_ + mur * (cvt4(pr) - r0_), k_ = k0_ + muk * (cvt4(pk) - k0_), v_ = v0_ + muv * (cvt4(pv) - v0_), a_ = cvt4(qa); \
            const f32x4 kkv_ = k_ * kkc; const float ss_ = allsum16(dot4(kkv_, kkv_)); const float inv_ = __builtin_amdgcn_rsqf(fmaxf(ss_, 1e-24f)); \
            const f32x4 kkn_ = kkv_ * inv_; \
            LAS float* o_ = rec + (buf) * 6144 + ls * 384 + lcg * 4; \
            *(LAS f32x4*)(o_) = qw; *(LAS f32x4*)(o_ + 64) = k_ * (1.0f + (a_ - 1.0f) * kac); *(LAS f32x4*)(o_ + 128) = kkn_; *(LAS f32x4*)(o_ + 192) = -(kkn_ * a_); \
            *(LAS f32x4*)(o_ + 256) = r_; *(LAS f32x4*)(o_ + 320) = v_; } while (0)
        if (wid >= 4) {
            mur = *(const f32x4*)(mu + lch); muk = *(const f32x4*)(mu + 512 + lch); muv = *(const f32x4*)(mu + 1024 + lch);
            kkc = *(const f32x4*)(k_k + lch); kac = *(const f32x4*)(k_a + lch);
            SCAN_ISSUE(0); SCAN_PROCESS(0); SCAN_ISSUE(1);
        }
        __syncthreads();
        for (int c = 0; c < 128; ++c) {
            if (wid < 4) {
                LAS const float* rb = rec + (c & 1) * 6144 + cgi * 4;
                LAS const float* rv = rec + (c & 1) * 6144 + 320 + ri;
                float ykeep = 0.f;
                f32x4 nw = *(LAS const f32x4*)(rb), nk = *(LAS const f32x4*)(rb + 64), nkk = *(LAS const f32x4*)(rb + 128), nb = *(LAS const f32x4*)(rb + 192), nr = *(LAS const f32x4*)(rb + 256);
                float nv = rv[0];
#pragma unroll
                for (int s = 0; s < 16; ++s) {
                    const f32x4 cw = nw, ck = nk, ckk = nkk, cb = nb, cr = nr; const float cv = nv;
                    if (s + 1 < 16) {
                        LAS const float* r1 = rb + (s + 1) * 384;
                        nw = *(LAS const f32x4*)(r1); nk = *(LAS const f32x4*)(r1 + 64); nkk = *(LAS const f32x4*)(r1 + 128); nb = *(LAS const f32x4*)(r1 + 192); nr = *(LAS const f32x4*)(r1 + 256);
                        nv = rv[(s + 1) * 384];
                    }
                    float y;
                    scan_step(S, cw, ck, ckk, cb, cr, cv, y);
                    ykeep = (cgi == s) ? y : ykeep;
                }
                Y[((size_t)b * 2048 + c * 16 + cgi) * 512 + h * 64 + ri] = ykeep;
            } else {
                if (c + 1 < 128) { SCAN_PROCESS((c + 1) & 1); if (c + 2 < 128) SCAN_ISSUE(c + 2); }
            }
            __syncthreads();
        }
        if (wid < 4) *(f32x4*)(POUT + O_WKVP + ((((size_t)pair * 8 + b) * 8 + h) * 64 + ri) * 64 + cgi * 4) = S;
#undef SCAN_ISSUE
#undef SCAN_PROCESS
    }
}

__device__ void phase_even_post(const Params& p, const Ctx cx, int pair) {
    const int gtid = cx.bid * 512 + cx.tid, gthreads = cx.nblk * 512;
    const bf16_t* PA = (const bf16_t*)(PWS + WS_R1);
    bf16_t* Ycat = (bf16_t*)(PWS + WS_YCAT);
    const float* Y = (const float*)(PWS + WS_Y);
    constexpr int NIT = NTOK * 128, UB = 4;
    const float* gn_g = PIN(I_GNG) + pair * 512; const float* gn_b = PIN(I_GNB) + pair * 512;
    for (int e0 = gtid; e0 < NIT; e0 += gthreads * UB) {
        f32x4 y[UB], bv[UB], bz[UB]; bool ok[UB];
#pragma unroll
        for (int u = 0; u < UB; ++u) {
            const int e = e0 + u * gthreads; ok[u] = e < NIT;
            const int ee = ok[u] ? e : e0; const int row = ee >> 7, ch = (ee & 127) * 4;
            y[u] = *(const f32x4*)(Y + (size_t)row * 512 + ch);
            bv[u] = ld_bf4(Ycat + (size_t)row * 1024 + 512 + ch);
            bz[u] = ld_bf4(PA + (size_t)row * LDA + 2048 + ch);
        }
#pragma unroll
        for (int u = 0; u < UB; ++u) {
            const int e = e0 + u * gthreads;
            const int ee = ok[u] ? e : e0; const int row = ee >> 7, ch = (ee & 127) * 4;
            const float mean = allsum16(y[u][0] + y[u][1] + y[u][2] + y[u][3]) * (1.0f / 64.0f);
            const f32x4 d = y[u] - mean;
            const float var = allsum16(dot4(d, d)) * (1.0f / 64.0f);
            const float rstd = rsqrtf(var + 64e-5f);
            const f32x4 g = *(const f32x4*)(gn_g + ch), bb = *(const f32x4*)(gn_b + ch);
            f32x4 o;
#pragma unroll
            for (int j = 0; j < 4; ++j) o[j] = (d[j] * rstd * g[j] + bb[j] + bv[u][j]) * siluf_(bz[u][j]);
            if (ok[u]) st_bf4(Ycat + (size_t)row * 1024 + 512 + ch, o);
        }
    }
    const float* cw = PIN(I_CONVW) + pair * 3 * 512;
    for (int e0 = gtid; e0 < NIT; e0 += gthreads * UB) {
        f32x4 h0[UB], c0v[UB], h1[UB], c1v[UB], h2[UB], c2v[UB], ab[UB], az[UB]; bool ok[UB];
#pragma unroll
        for (int u = 0; u < UB; ++u) {
            const int e = e0 + u * gthreads; ok[u] = e < NIT;
            const int ee = ok[u] ? e : e0; const int row = ee >> 7, ch = (ee & 127) * 4;
            const int t = row < NTP ? (row & 2047) : ((row - NTP) & 7);
            const bf16_t* cur = PA + (size_t)row * LDA + ch;
            const bf16_t* p1 = t >= 1 ? cur - LDA : cur; const bf16_t* p2 = t >= 2 ? cur - 2 * LDA : cur;
            h0[u] = ld_bf4(cur); c0v[u] = ld_bf4(cur + 1024); h1[u] = ld_bf4(p1); c1v[u] = ld_bf4(p1 + 1024); h2[u] = ld_bf4(p2); c2v[u] = ld_bf4(p2 + 1024);
            ab[u] = ld_bf4(cur + 512); az[u] = ld_bf4(cur + 1536);
        }
#pragma unroll
        for (int u = 0; u < UB; ++u) {
            const int e = e0 + u * gthreads;
            const int ee = ok[u] ? e : e0; const int row = ee >> 7, ch = (ee & 127) * 4;
            const bool samp = row >= NTP;
            int b, t, T; if (!samp) { b = row >> 11; t = row & 2047; T = 2048; } else { const int q = row - NTP; b = q >> 3; t = q & 7; T = 8; }
            const f32x4 u0 = c0v[u] * h0[u];
            f32x4 u1 = c1v[u] * h1[u], u2 = c2v[u] * h2[u];
            if (t < 2) {
                const f32x4 zero = (f32x4){0.f, 0.f, 0.f, 0.f};
                const float* hist = PIN(I_SCONV) + ((size_t)pair * 128 + (samp ? b : 0)) * 2 * 512 + ch;
                if (t == 0) { u1 = samp ? *(const f32x4*)(hist + 512) : zero; u2 = samp ? *(const f32x4*)(hist) : zero; }
                else { u2 = samp ? *(const f32x4*)(hist + 512) : zero; }
            }
            const f32x4 k0 = *(const f32x4*)(cw + ch), k1 = *(const f32x4*)(cw + 512 + ch), k2 = *(const f32x4*)(cw + 1024 + ch);
            const f32x4 conv = k0 * u2 + k1 * u1 + k2 * u0;
            f32x4 o;
#pragma unroll
            for (int j = 0; j < 4; ++j) o[j] = ab[u][j] * conv[j] * siluf_(az[u][j]);
            if (ok[u]) {
                st_bf4(Ycat + (size_t)row * 1024 + ch, o);
                if (t >= T - 2) {
                    float* dst = samp ? POUT + O_CONVS + (((size_t)pair * 128 + b) * 2 + (t - (T - 2))) * 512 + ch : POUT + O_CONVP + (((size_t)pair * 8 + b) * 2 + (t - (T - 2))) * 512 + ch;
                    *(f32x4*)dst = u0;
                }
            }
        }
    }
}

__device__ void phase_odd_mixer(const Params& p, const Ctx cx, int pair, LAS unsigned char* lds) {
    const int tid = cx.tid, wid = tid >> 6, lane = tid & 63, fr = lane & 15, fq = lane >> 4;
    const bf16_t* PO = (const bf16_t*)(PWS + WS_R1);
    bf16_t* Ycat = (bf16_t*)(PWS + WS_YCAT);
    LAS bf16_t* LA = (LAS bf16_t*)lds;
    LAS bf16_t* LB = (LAS bf16_t*)(lds + 128 * 136 * 2);
    LAS float* stat = (LAS float*)(lds + 2 * 128 * 136 * 2);
    LAS float* LE = (LAS float*)(lds + 128 * 136 * 2);
    LAS bf16_t* LW = (LAS bf16_t*)(lds + 128 * 136 * 2 + 143 * 128 * 4);
#ifdef MIXPROBE
    for (int rr = 0; rr < 16; ++rr) {
        const int round = rr & 7;
#else
    for (int round = 0; round < 8; ++round) {
#endif
        int it;
        if (cx.nblk == 256) {
            if (round == 0) it = cx.bid < 136 ? cx.bid : 136 + 136 + (cx.bid - 136);
            else if (round == 1) it = cx.bid < 136 ? 136 + cx.bid : 136 + 136 + 120 + (cx.bid - 136);
            else if (cx.bid >= 136) it = 136 + 136 + 120 * round + (cx.bid - 136);
            else it = 1 << 20;
        } else it = cx.bid + round * cx.nblk;
#ifdef MIXPROBE
        if (it >= 680) continue;
        if (rr >= 8 && ((MIXPROBE == 1) != (it < 136))) continue;
#else
        if (it >= 680) { if (cx.nblk == 256 ? round >= 4 : true) break; else continue; }
#endif
        if (it >= 136) {
            const int ci = it - 136, tile = ci >> 2, g = ci & 3, r0 = tile * 128;
            const bool samp = r0 >= NTP;
            const int w = 2 << g;
            const bf16_t* Bw = (const bf16_t*)(PWS + WS_POOLWT) + ((size_t)pair * 4 + g) * 128 * 128;
            {
                u32x4 wr_[4];
#pragma unroll
                for (int i = 0; i < 4; ++i) { const int e = tid + i * 512, d_ = e >> 4, c8 = (e & 15) * 8; wr_[i] = *(const u32x4*)(Bw + d_ * 128 + c8); }
#pragma unroll
                for (int i = 0; i < 4; ++i) { const int e = tid + i * 512, d_ = e >> 4, c8 = (e & 15) * 8; *(LAS u32x4*)(LW + d_ * 136 + c8) = wr_[i]; }
            }
            if (!samp) {
                const int t0 = r0 & 2047;
                {
                    u32x2 raw[9];
#pragma unroll
                    for (int i = 0; i < 9; ++i) {
                        const int e = tid + i * 512, er = e >> 5, c = (e & 31) * 4;
                        raw[i] = (u32x2){0u, 0u};
                        if (e < 143 * 32 && t0 + er - 15 >= 0) raw[i] = *(const u32x2*)(PO + (size_t)(r0 + er - 15) * LDA + g * 128 + c);
                    }
#pragma unroll
                    for (int i = 0; i < 9; ++i) {
                        const int e = tid + i * 512, er = e >> 5, c = (e & 31) * 4;
                        if (e < 143 * 32) *(LAS f32x4*)(LE + er * 128 + c) = cvt4(raw[i]);
                    }
                }
                __syncthreads();
                {
                    const int c = (tid & 31) * 4, tl0 = (tid >> 5) * 8;
                    f32x4 sum = (f32x4){0.f, 0.f, 0.f, 0.f};
#pragma unroll 4
                    for (int d = 0; d < w; ++d) sum += *(LAS const f32x4*)(LE + (tl0 + 15 - d) * 128 + c);
#pragma unroll
                    for (int k = 0; k < 8; ++k) {
                        const int tl = tl0 + k;
                        const f32x4 pt = *(LAS const f32x4*)(LE + (tl + 15) * 128 + c);
                        if (k > 0) sum += pt - *(LAS const f32x4*)(LE + (tl + 15 - w) * 128 + c);
                        const float cnt = fminf((float)w, (float)(t0 + tl + 1));
                        const f32x4 pooled = sum * (1.0f / cnt) - pt;
                        u32x2 u; u.x = cvt_pk_bf16(pooled[0], pooled[1]); u.y = cvt_pk_bf16(pooled[2], pooled[3]);
                        *(LAS u32x2*)(LA + tl * 136 + c) = u;
                    }
                }
            } else {
                for (int e = tid; e < 128 * 32; e += 512) {
                    const int tl = e >> 5, c = (e & 31) * 4, row = r0 + tl;
                    const int q = row - NTP, b = q >> 3, t = q & 7;
                    const bf16_t* cur = PO + (size_t)row * LDA + g * 128 + c;
                    const f32x4 pt = ld_bf4(cur);
                    f32x4 sum = pt;
                    for (int d = 1; d < w; ++d) {
                        const int tt = t - d;
                        if (tt >= 0) sum += ld_bf4(cur - (size_t)d * LDA);
                        else sum += *(const f32x4*)(PIN(I_SPOOL) + (((size_t)pair * 128 + b) * 15 + (15 + tt)) * 512 + g * 128 + c);
                    }
                    const f32x4 pooled = sum * (1.0f / (float)w) - pt;
                    u32x2 u; u.x = cvt_pk_bf16(pooled[0], pooled[1]); u.y = cvt_pk_bf16(pooled[2], pooled[3]);
                    *(LAS u32x2*)(LA + tl * 136 + c) = u;
                }
            }
            __syncthreads();
            const int row = r0 + wid * 16 + fr;
            bf16x8 af[4];
#pragma unroll
            for (int ks = 0; ks < 4; ++ks) af[ks] = *(const LAS bf16x8*)(LA + (wid * 16 + fr) * 136 + ks * 32 + fq * 8);
#pragma unroll
            for (int nt = 0; nt < 8; ++nt) {
                f32x4 acc = (f32x4){0.f, 0.f, 0.f, 0.f};
#pragma unroll
                for (int ks = 0; ks < 4; ++ks) {
                    const bf16x8 bf = *(const LAS bf16x8*)(LW + (nt * 16 + fr) * 136 + ks * 32 + fq * 8);
                    acc = __builtin_amdgcn_mfma_f32_16x16x32_bf16(bf, af[ks], acc, 0, 0, 0);
                }
                const int d = g * 128 + nt * 16 + fq * 4;
                const f32x4 cz = ld_bf4(PO + (size_t)row * LDA + 512 + d), ps = *(const f32x4*)(PIN(I_PSCALE) + pair * 512 + d);
                f32x4 o;
#pragma unroll
                for (int j = 0; j < 4; ++j) o[j] = acc[j] * ps[j] * siluf_(cz[j]);
                st_bf4(Ycat + (size_t)row * 1024 + d, o);
            }
            __syncthreads();
        } else {
            const int tile = it, r0 = tile * 128;
            const bool samp = r0 >= NTP;
            {
                const int tl = tid >> 2, q = tid & 3;
                const bf16_t* vr = PO + (size_t)(r0 + tl) * LDA + 1536 + q * 128;
                float s_ = 0.f, ss = 0.f;
#pragma unroll
                for (int i = 0; i < 16; ++i) { const u32x4 raw = *(const u32x4*)(vr + i * 8); const f32x4 v0 = cvt4((u32x2){raw.x, raw.y}), v1 = cvt4((u32x2){raw.z, raw.w});
                    s_ += (v0[0] + v0[1]) + (v0[2] + v0[3]) + (v1[0] + v1[1]) + (v1[2] + v1[3]); ss += dot4(v0, v0) + dot4(v1, v1); }
                s_ = allsum4(s_); ss = allsum4(ss);
                const float mean = s_ * (1.0f / 512.0f);
                const float var = fmaxf(ss * (1.0f / 512.0f) - mean * mean, 0.f);
                if (q == 0) { stat[tl * 2] = mean; stat[tl * 2 + 1] = rsqrtf(var + 1e-5f); }
            }
            __syncthreads();
#pragma unroll 1
            for (int g = 0; g < 4; ++g) {
                {
                    const int tl = tid >> 2, q = tid & 3, row = r0 + tl;
                    const float mean = stat[tl * 2], rstd = stat[tl * 2 + 1];
                    const bf16_t* vr = PO + (size_t)row * LDA + 1536 + g * 128 + q * 32;
                    const float* lg = PIN(I_LNG) + pair * 512 + g * 128 + q * 32; const float* lb = PIN(I_LNB) + pair * 512 + g * 128 + q * 32;
#pragma unroll
                    for (int i = 0; i < 8; ++i) {
                        const f32x4 v = ld_bf4(vr + i * 4);
                        const f32x4 vn = (v - mean) * rstd * *(const f32x4*)(lg + i * 4) + *(const f32x4*)(lb + i * 4);
                        if (samp) *(f32x4*)(POUT + O_CHUNKV + ((size_t)pair * 1024 + (row - NTP)) * 512 + g * 128 + q * 32 + i * 4) = vn;
#pragma unroll
                        for (int j = 0; j < 4; ++j) LB[(q * 32 + i * 4 + j) * 136 + tl] = (bf16_t)(cvt_pk_bf16(vn[j], 0.f) & 0xffffu);
                    }
                }
                if (!samp) {
                    const bf16_t* Wsrc = (const bf16_t*)(PWS + WS_SPW) + ((size_t)pair * 4 + g) * 128 * 128;
                    u32x4 wr_[4];
#pragma unroll
                    for (int i = 0; i < 4; ++i) { const int e = tid + i * 512, t = e >> 4, s8 = (e & 15) * 8; wr_[i] = *(const u32x4*)(Wsrc + t * 128 + s8); }
#pragma unroll
                    for (int i = 0; i < 4; ++i) { const int e = tid + i * 512, t = e >> 4, s8 = (e & 15) * 8; *(LAS u32x4*)(LA + t * 136 + s8) = wr_[i]; }
                } else {
                    const float* Wsrc = PIN(I_SPW) + ((size_t)pair * 4 + g) * 128 * 128;
                    for (int e = tid; e < 128 * 128; e += 512) { const int t = e >> 7, s2 = e & 127;
                        const float v = ((t >> 3) == (s2 >> 3) && (s2 & 7) <= (t & 7)) ? Wsrc[(t & 7) * 128 + (s2 & 7)] : 0.f;
                        LA[t * 136 + s2] = (bf16_t)(cvt_pk_bf16(v, 0.f) & 0xffffu); }
                }
                __syncthreads();
                {
                    const int tl = wid * 16 + fr, row = r0 + tl;
                    const float bias = PIN(I_SPB)[((size_t)pair * 4 + g) * 128 + (samp ? (tl & 7) : tl)];
                    bf16x8 wf[4];
#pragma unroll
                    for (int ks = 0; ks < 4; ++ks) wf[ks] = *(const LAS bf16x8*)(LA + tl * 136 + ks * 32 + fq * 8);
#pragma unroll
                    for (int nt = 0; nt < 8; ++nt) {
                        f32x4 acc = (f32x4){0.f, 0.f, 0.f, 0.f};
#pragma unroll
                        for (int ks = 0; ks < 4; ++ks) {
                            if (ks * 32 <= wid * 16 + 15) {
                                const bf16x8 vf = *(const LAS bf16x8*)(LB + (nt * 16 + fr) * 136 + ks * 32 + fq * 8);
                                acc = __builtin_amdgcn_mfma_f32_16x16x32_bf16(vf, wf[ks], acc, 0, 0, 0);
                            }
                        }
                        const int c = g * 128 + nt * 16 + fq * 4;
                        const f32x4 u = ld_bf4(PO + (size_t)row * LDA + 1024 + c), dz = ld_bf4(PO + (size_t)row * LDA + 2048 + c);
                        f32x4 o;
#pragma unroll
                        for (int j = 0; j < 4; ++j) o[j] = u[j] * (acc[j] + bias) * siluf_(dz[j]);
                        st_bf4(Ycat + (size_t)row * 1024 + 512 + c, o);
                    }
                }
                __syncthreads();
            }
        }
    }
    const int gtid = cx.bid * 512 + tid, gthreads = cx.nblk * 512;
    for (int e = gtid; e < 136 * 15 * 512; e += gthreads) {
        const int c = e & 511, q = e >> 9, sr = q / 15, k = q % 15;
        if (sr < 8) POUT[O_POOLP + (((size_t)pair * 8 + sr) * 15 + k) * 512 + c] = bf2f(PO[(size_t)(sr * 2048 + 2033 + k) * LDA + c]);
        else { const int b = sr - 8;
            POUT[O_POOLS + (((size_t)pair * 128 + b) * 15 + k) * 512 + c] = (k < 7) ? PIN(I_SPOOL)[(((size_t)pair * 128 + b) * 15 + 8 + k) * 512 + c] : bf2f(PO[(size_t)(NTP + b * 8 + (k - 7)) * LDA + c]); }
    }
}

__device__ void phase_final(const Params& p, const Ctx cx) {
    const int gtid = cx.bid * 512 + cx.tid, gthreads = cx.nblk * 512;
    const float* ssq = (const float*)(PWS + WS_SSQ) + (size_t)4 * NTOK * 16;
    const bf16_t* Xb = (const bf16_t*)(PWS + WS_XB);
    constexpr int NIT = NTOK * 256, UB = 4;
    for (int e0 = gtid; e0 < NIT; e0 += gthreads * UB) {
        f32x4 x[UB]; float sq[UB]; bool ok[UB];
#pragma unroll
        for (int u = 0; u < UB; ++u) { const int e = e0 + u * gthreads; ok[u] = e < NIT; const int ee = ok[u] ? e : e0; const int row = ee >> 8, c = (ee & 255) * 4;
            x[u] = ld_bf4(Xb + (size_t)row * 1024 + c); sq[u] = ssq_sum(ssq + (size_t)row * 16); }
#pragma unroll
        for (int u = 0; u < UB; ++u) { const int e = e0 + u * gthreads; const int ee = ok[u] ? e : e0; const int row = ee >> 8, c = (ee & 255) * 4;
            const float rstd = rsqrtf(sq[u] * (1.0f / 1024.0f) + 1e-6f);
            if (ok[u]) *(f32x4*)(POUT + (size_t)row * 1024 + c) = x[u] * rstd * *(const f32x4*)(PIN(I_FNORMW) + c); }
    }
}

#define XB_TMO      128
#define XB_XCNT(j)  (256  + 64 * (j))
#define XB_XSUB(j)  (1280 + 64 * (j))
#define XB_XGEN(j)  (2304 + 64 * (j))
#define XB_TOP      3328
#define XB_TOPGEN   3392
#define XCD_BAR_WORDS 3456
#define XB_SPIN_CAP (1u << 18)
__device__ __forceinline__ unsigned xb_ld(unsigned* p)              { return __hip_atomic_load(p, __ATOMIC_RELAXED, __HIP_MEMORY_SCOPE_AGENT); }
__device__ __forceinline__ unsigned xb_add(unsigned* p, unsigned v) { return __hip_atomic_fetch_add(p, v, __ATOMIC_RELAXED, __HIP_MEMORY_SCOPE_AGENT); }
__device__ __forceinline__ unsigned xb_xcc_id() { return (unsigned)__builtin_amdgcn_s_getreg((3 << 11) | 20) & 0xFu; }
#define XB_SPIN(cond, bar) do { unsigned _sp = 0; while (cond) { __builtin_amdgcn_s_sleep(1); \
    if ((++_sp & 255u) == 0u) { if (xb_ld(&(bar)[XB_TMO])) break; if (_sp > XB_SPIN_CAP) { atomicAdd(&(bar)[XB_TMO], 1u); break; } } } } while (0)
struct XcdBarrier { unsigned* bar; unsigned x; volatile LAS unsigned* st; };
__device__ __forceinline__ XcdBarrier xcd_barrier_post(unsigned* bar, volatile LAS unsigned* st) {
    XcdBarrier b; b.bar = bar; b.x = xb_xcc_id(); b.st = st;
    if (threadIdx.x == 0) (void)xb_add(&bar[XB_XCNT(b.x)], 1u);
    return b;
}
__device__ __forceinline__ void xcd_barrier_complete(unsigned* bar, unsigned x, unsigned& nloc, unsigned& nx) {
    const unsigned G = gridDim.x * gridDim.y * gridDim.z;
    unsigned sum, cnt, mine, sp = 0u;
    for (;;) {
        sum = 0u; cnt = 0u; mine = 0u;
#pragma unroll
        for (unsigned j = 0; j < 16; ++j) { const unsigned c = xb_ld(&bar[XB_XCNT(j)]); sum += c; cnt += (c > 0u) ? 1u : 0u; mine = (j == x) ? c : mine; }
        if (sum == G) break;
        __builtin_amdgcn_s_sleep(1);
        if ((++sp & 255u) == 0u) { if (xb_ld(&bar[XB_TMO])) break; if (sp > XB_SPIN_CAP) { atomicAdd(&bar[XB_TMO], 1u); break; } }
    }
    nloc = mine > 0u ? mine : 1u; nx = cnt > 0u ? cnt : 1u;
}
__device__ __forceinline__ void xcd_barrier(const XcdBarrier& b) {
    asm volatile("s_waitcnt vmcnt(0)" ::: "memory");
    __syncthreads();
    if (threadIdx.x == 0) {
        unsigned* bar = b.bar;
        __builtin_amdgcn_s_waitcnt(0);
        unsigned nloc = b.st[0], nx = b.st[1];
        if (nloc == 0u) { xcd_barrier_complete(bar, b.x, nloc, nx); b.st[0] = nloc; b.st[1] = nx; }
        const unsigned old = xb_add(&bar[XB_XSUB(b.x)], 1u);
        const unsigned gen = old / nloc;
        if (old + 1u == (gen + 1u) * nloc) {
            __builtin_amdgcn_fence(__ATOMIC_RELEASE, "agent");
            asm volatile("s_waitcnt vmcnt(0)" ::: "memory");
            const unsigned og = xb_add(&bar[XB_TOP], 1u);
            const unsigned tg = og / nx;
            if (og + 1u == (tg + 1u) * nx) xb_add(&bar[XB_TOPGEN], 1u);
            else XB_SPIN(xb_ld(&bar[XB_TOPGEN]) == tg, bar);
            __builtin_amdgcn_fence(__ATOMIC_ACQUIRE, "agent");
            xb_add(&bar[XB_XGEN(b.x)], 1u);
            asm volatile("s_waitcnt vmcnt(0)" ::: "memory");
        } else {
            XB_SPIN(xb_ld(&bar[XB_XGEN(b.x)]) == gen, bar);
            __builtin_amdgcn_fence(__ATOMIC_ACQUIRE, "agent");
            asm volatile("s_waitcnt vmcnt(0)" ::: "memory");
        }
    }
    __syncthreads();
}

__device__ void run_gemm_proj(const Params& p, const Ctx cx, LAS unsigned char* lds, const bf16_t* Bt, int N, bf16_t* O, int ldc, int layer) {
    pg8::Gemm g{(const bf16_t*)(PWS + WS_XB), Bt, NTOK, N, 1024};
    pg8::StaticOrder S; S.init(NTOK, N, (int)cx.nblk, (int)cx.bid);
    EpiProj E{O, ldc, (const float*)(PWS + WS_SSQ) + (size_t)layer * NTOK * 16};
    pg8::gemm_phase<EpiProj>(cx, lds, g, S, E);
}
__device__ void run_gemm_res(const Params& p, const Ctx cx, LAS unsigned char* lds, const bf16_t* Bt, int layer) {
    const bf16_t* A = (const bf16_t*)(PWS + WS_YCAT);
    bf16_t* Xb = (bf16_t*)(PWS + WS_XB);
    float* ssqn = (float*)(PWS + WS_SSQ) + (size_t)(layer + 1) * NTOK * 16;
    pg8::Gemm g{A, Bt, NTOK, 1024, 1024};
    pg8::StaticOrder S; S.init(NTOK, 1024, (int)cx.nblk, (int)cx.bid);
    EpiRes E{layer == 0 ? PIN(I_XP) : nullptr, PIN(I_XS), Xb, ssqn};
    pg8::gemm_phase<EpiRes>(cx, lds, g, S, E);
}

constexpr int N_PHASES = 20;
#ifndef PHMASK
#define PHMASK 0xffff
#endif
#define PHON(n) ((PHMASK >> ((n) % 16)) & 1)
__global__ void __launch_bounds__(512, 2) fwd_kernel(Params p) {
    extern __shared__ __attribute__((aligned(16))) unsigned char lds_raw[];
    LAS unsigned char* lds = (LAS unsigned char*)lds_raw;
    volatile LAS unsigned* bar_st = (volatile LAS unsigned*)(lds + LDS_MAIN);
    if (threadIdx.x < 4) bar_st[threadIdx.x] = 0u;
    __syncthreads();
    const XcdBarrier gbar = xcd_barrier_post((unsigned*)((unsigned char*)p.ptr[30] + WS_BAR), bar_st);
    if (p.ph_hi < 0) cg::this_grid().sync();
#define GRID_SYNC() xcd_barrier(gbar)
#ifdef SYNCPROBE
    for (int i = 0; i < SYNCPROBE; ++i) GRID_SYNC();
#endif
#ifdef REPMASK
    for (int pc = p.ph_lo * 2; pc < p.ph_hi * 2; ++pc) {
        const int ph = pc >> 1;
        { const int s_ = (ph == 0) ? 9 : (ph == N_PHASES - 1) ? 31 : (ph - 1) % 9; if ((pc & 1) && !((REPMASK >> s_) & 1)) continue; }
        if (pc > p.ph_lo * 2) GRID_SYNC();
#else
    for (int ph = p.ph_lo; ph < p.ph_hi; ++ph) {
        if (ph > p.ph_lo) GRID_SYNC();
#endif
        Ctx cx; cx.tid = threadIdx.x; cx.bid = blockIdx.x; cx.nblk = gridDim.x;
        asm volatile("s_mov_b32 %0, 0" : "=s"(cx.z));
        asm volatile("" : "+v"(cx.tid)); asm volatile("" : "+s"(cx.bid)); asm volatile("" : "+s"(cx.nblk));
        const int pair = (ph - 1) / 9, s = (ph == 0) ? 100 : (ph == N_PHASES - 1 ? 101 : (ph - 1) % 9);
        if (s == 0 || s == 3 || s == 6) {
#if PHON(0)
            const bf16_t* WinE = (const bf16_t*)(PWS + WS_WINE) + (size_t)pair * 4352 * 1024;
            const bf16_t* Bt = s == 0 ? WinE + (size_t)2560 * 1024 : (s == 3 ? WinE : (const bf16_t*)(PWS + WS_WINO) + (size_t)pair * 2560 * 1024);
            const int N = s == 0 ? 1792 : 2560;
            run_gemm_proj(p, cx, lds, Bt, N, (bf16_t*)(PWS + WS_R1), N, 2 * pair + (s == 6 ? 1 : 0));
#endif
        } else if (s == 5 || s == 8) {
#if PHON(5)
            const bf16_t* Bt = (const bf16_t*)(PWS + (s == 5 ? WS_WOUTE : WS_WOUTO)) + (size_t)pair * 1024 * 1024;
            run_gemm_res(p, cx, lds, Bt, 2 * pair + (s == 8 ? 1 : 0));
#endif
        } else if (s == 1) {
#if PHON(1)
            phase_even_prep(p, cx, pair, lds);
#endif
        } else if (s == 2) {
#if PHON(2)
            phase_scan(p, cx, pair, lds);
#endif
        } else if (s == 4) {
#if PHON(4)
            phase_even_post(p, cx, pair);
#endif
        } else if (s == 7) {
#if PHON(7)
            phase_odd_mixer(p, cx, pair, lds);
#endif
        } else if (s == 100) {
#if PHON(10)
            phase_prepass(p, cx, lds);
#endif
        } else {
#if PHON(11)
            phase_final(p, cx);
#endif
        }
    }
}

extern "C" void kernel_launch(void* const* d_in, const int* in_sizes, int n_in, void* d_out, int out_size, void* d_ws, size_t ws_size, hipStream_t stream) {
    static int grid = 0;
    if (grid == 0) {
        if (n_in != 29 || ws_size < WS_END) { fprintf(stderr, "kernel_launch: unexpected n_in %d / ws_size %zu (need %zu)\n", n_in, ws_size, (size_t)WS_END); grid = -1; return; }
        int dev = 0, cus = 0, per_cu = 0;
        hipGetDevice(&dev);
        hipDeviceGetAttribute(&cus, hipDeviceAttributeMultiprocessorCount, dev);
        if (hipFuncSetAttribute((const void*)fwd_kernel, hipFuncAttributeMaxDynamicSharedMemorySize, LDS_BYTES) != hipSuccess) { fprintf(stderr, "kernel_launch: hipFuncSetAttribute failed\n"); grid = -1; return; }
        if (hipOccupancyMaxActiveBlocksPerMultiprocessor(&per_cu, (const void*)fwd_kernel, 512, LDS_BYTES) != hipSuccess || per_cu < 1) { fprintf(stderr, "kernel_launch: occupancy query gave %d\n", per_cu); per_cu = 1; }
        (void)hipGetLastError();
        grid = cus * per_cu;
        if (grid > 256) grid = 256;
    }
    if (grid < 0) return;
    Params p{};
    for (int i = 0; i < 29; ++i) p.ptr[i] = d_in[i];
    p.ptr[29] = d_out; p.ptr[30] = d_ws; p.ptr[31] = nullptr;
    (void)hipMemsetAsync((unsigned char*)d_ws + WS_BAR, 0, 16384, stream);
#if ONE_LAUNCH
    p.ph_lo = 0; p.ph_hi = N_PHASES;
    void* args[] = {&p};
    hipError_t e = hipLaunchCooperativeKernel((const void*)fwd_kernel, dim3(grid), dim3(512), args, LDS_BYTES, stream);
    if (e != hipSuccess) fprintf(stderr, "cooperative launch failed: %s (grid %d)\n", hipGetErrorString(e), grid);
#else
    for (int ph = 0; ph < N_PHASES; ++ph) {
        p.ph_lo = ph; p.ph_hi = ph + 1;
        hipLaunchKernelGGL(fwd_kernel, dim3(grid), dim3(512), LDS_BYTES, stream, p);
    }
#endif
}
```

```cpp
#include <hip/hip_runtime.h>
#include <hip/hip_cooperative_groups.h>
#include <cstdio>
namespace cg = cooperative_groups;

#ifndef ONE_LAUNCH
#define ONE_LAUNCH 1
#endif

#define LAS __attribute__((address_space(3)))
typedef unsigned short bf16_t;
typedef short bf16x8 __attribute__((ext_vector_type(8)));
typedef float f32x4 __attribute__((ext_vector_type(4)));
typedef unsigned u32x4 __attribute__((ext_vector_type(4)));
typedef unsigned u32x2 __attribute__((ext_vector_type(2)));

constexpr int NTOK = 17408, NTP = 16384;
constexpr int LDB = 1792;
constexpr int LDA = 2560;
constexpr size_t O_CONVP = 17825792, O_CONVS = 17842176, O_SHIFTP = 18104320, O_SHIFTS = 18130944, O_WKVP = 18556928, O_WKVS = 19081216,
                 O_POOLP = 27469824, O_POOLS = 27592704, O_CHUNKV = 29558784;
constexpr size_t WS_WINE = 0;
constexpr size_t WS_WOUTE = WS_WINE + 2ull * 4352 * 1024 * 2;
constexpr size_t WS_WINO = WS_WOUTE + 2ull * 1024 * 1024 * 2;
constexpr size_t WS_WOUTO = WS_WINO + 2ull * 2560 * 1024 * 2;
constexpr size_t WS_W2T = WS_WOUTO + 2ull * 1024 * 1024 * 2;
constexpr size_t WS_A2T = WS_W2T + 2ull * 512 * 64 * 2;
constexpr size_t WS_POOLWT = WS_A2T + 2ull * 512 * 64 * 2;
constexpr size_t WS_SPW = WS_POOLWT + 8ull * 128 * 128 * 2;
constexpr size_t WS_XB = WS_SPW + 8ull * 128 * 128 * 2;
constexpr size_t WS_YCAT = WS_XB + (size_t)NTOK * 1024 * 2;
constexpr size_t WS_SSQ = WS_YCAT + (size_t)NTOK * 1024 * 2;
constexpr size_t WS_Y = WS_SSQ + 5ull * NTOK * 16 * 4;
constexpr size_t WS_R1 = WS_Y + (size_t)NTOK * 512 * 4;
constexpr size_t WS_PROJB = WS_R1;
constexpr size_t WS_WDEC = WS_PROJB + (size_t)NTOK * LDB * 2;
constexpr size_t WS_AA = WS_WDEC + (size_t)NTOK * 512 * 4;
constexpr size_t WS_BAR = WS_AA + (size_t)NTOK * 512 * 2;
constexpr size_t WS_END = WS_BAR + 16384;
constexpr int LDS_MAIN = 147456;
constexpr int LDS_BYTES = LDS_MAIN + 16;

struct Params {
    const void* ptr[32];
    int ph_lo, ph_hi;
};
struct Ctx { int tid, bid, nblk, z; };
#define PIN(i) ((const float*)p.ptr[(i) + cx.z])
#define POUT ((float*)p.ptr[29 + cx.z])
#define PWS ((unsigned char*)p.ptr[30 + cx.z])
enum { I_XP = 0, I_XS, I_SCONV, I_SSHIFT, I_SWKV, I_SPOOL, I_NORMW, I_FNORMW, I_WINE, I_CONVW, I_MU, I_W0, I_W2, I_A0, I_A2, I_KK, I_KA, I_RK, I_GNG, I_GNB,
       I_WOUTE, I_WINO, I_POOLW, I_PSCALE, I_LNG, I_LNB, I_SPW, I_SPB, I_WOUTO };

__device__ __forceinline__ unsigned cvt_pk_bf16(float lo, float hi) { unsigned r; asm("v_cvt_pk_bf16_f32 %0, %1, %2" : "=v"(r) : "v"(lo), "v"(hi)); return r; }
__device__ __forceinline__ float bf_lo(unsigned u) { return __uint_as_float(u << 16); }
__device__ __forceinline__ float bf_hi(unsigned u) { return __uint_as_float(u & 0xffff0000u); }
__device__ __forceinline__ float bf2f(bf16_t b) { return __uint_as_float(((unsigned)b) << 16); }
__device__ __forceinline__ f32x4 cvt4(u32x2 u) { return (f32x4){bf_lo(u.x), bf_hi(u.x), bf_lo(u.y), bf_hi(u.y)}; }
__device__ __forceinline__ f32x4 ld_bf4(const bf16_t* p) { return cvt4(*(const u32x2*)p); }
__device__ __forceinline__ void st_bf4(bf16_t* p, f32x4 v) { u32x2 u; u.x = cvt_pk_bf16(v[0], v[1]); u.y = cvt_pk_bf16(v[2], v[3]); *(u32x2*)p = u; }
__device__ __forceinline__ float sigmoidf_(float x) { return 1.0f / (1.0f + __expf(-x)); }
__device__ __forceinline__ float siluf_(float x) { return x / (1.0f + __expf(-x)); }
template <int CTRL> __device__ __forceinline__ float dpp_f(float x) { return __builtin_bit_cast(float, __builtin_amdgcn_mov_dpp(__builtin_bit_cast(int, x), CTRL, 0xf, 0xf, true)); }
__device__ __forceinline__ float allsum16(float x) { x += dpp_f<0xB1>(x); x += dpp_f<0x4E>(x); x += dpp_f<0x141>(x); x += dpp_f<0x128>(x); return x; }
__device__ __forceinline__ float allsum4(float x) { x += dpp_f<0xB1>(x); x += dpp_f<0x4E>(x); return x; }
__device__ __forceinline__ float dot4(f32x4 a, f32x4 b) { return a[0] * b[0] + a[1] * b[1] + a[2] * b[2] + a[3] * b[3]; }

__device__ __forceinline__ float ssq_sum(const float* part) {
    const f32x4 a = *(const f32x4*)(part), b = *(const f32x4*)(part + 4), c = *(const f32x4*)(part + 8), d = *(const f32x4*)(part + 12);
    return ((a[0] + a[1]) + (a[2] + a[3])) + ((b[0] + b[1]) + (b[2] + b[3])) + ((c[0] + c[1]) + (c[2] + c[3])) + ((d[0] + d[1]) + (d[2] + d[3]));
}

namespace pg8 {
constexpr int BM = 256, BK = 64, HALF = 128, HTB = HALF * BK * 2, NXCD = 8, WGM = 8;
__device__ __forceinline__ int lds_byte(int r, int c) { const int st = (r >> 4) * 2 + (c >> 5), rr = r & 15, cc = c & 31, ob = rr * 64 + cc * 2; return st * 1024 + (ob ^ (((ob >> 9) & 1) << 5)); }
__device__ __forceinline__ void stage_rc(int b, int& R, int& C) { const int st = b / 1024, sb = b % 1024, swz = sb ^ (((sb >> 9) & 1) << 5); R = (st >> 1) * 16 + swz / 64; C = (st & 1) * 32 + (swz % 64) / 2; }
__device__ __forceinline__ int perm32(int rho) { const int n = rho >> 4, i = rho & 15; return 8 * (i >> 2) + 4 * n + (i & 3); }
struct Unit { int pm, pn; };
struct Gemm { const bf16_t* A; const bf16_t* Bt; int M, N, K; };
struct StaticOrder {
    int nM, nN, nwg, G, c;
    __device__ void init(int M, int N, int G_, int c_) { nM = M / BM; nN = N / BM; nwg = nM * nN; G = G_; c = c_; }
    __device__ bool next(int i, Unit& u) const {
        const long L = (long)i * G + c; if (L >= nwg) return false;
        int wgid = (int)L; { const int q = nwg / NXCD, r = nwg % NXCD, xcd = wgid % NXCD, off = wgid / NXCD; wgid = (xcd < r ? xcd * (q + 1) : r * (q + 1) + (xcd - r) * q) + off; }
        const int nig = WGM * nN, gid = wgid / nig, fm = gid * WGM, gsz = (nM - fm) < WGM ? (nM - fm) : WGM;
        u.pm = fm + ((wgid % nig) % gsz); u.pn = (wgid % nig) / gsz; return true;
    }
};

template <class Epi>
__device__ __forceinline__ void gemm_phase(const Ctx cx, LAS unsigned char* lds, const Gemm g, const StaticOrder& S, const Epi& E) {
    const int tid = cx.tid, wid = __builtin_amdgcn_readfirstlane(tid >> 6), lane = tid & 63, wr = wid >> 2, wc = wid & 3, fr = lane & 15, fq = lane >> 4;
    const int K = g.K, nt = K / BK;
    unsigned voffA[2], voffB[2];
#pragma unroll
    for (int i = 0; i < 2; ++i) { int R, C; stage_rc(tid * 16 + i * 8192, R, C); const int Rb = Epi::PERM ? ((R & ~31) + perm32(R & 31)) : R;
        voffA[i] = (unsigned)(R * K + C) * 2u; voffB[i] = (unsigned)(Rb * K + C) * 2u; }
    const size_t kstep = (size_t)(BK * 2);
    const size_t hstep = (size_t)HALF * K * 2;
    const size_t tstep = 2 * hstep;
    const unsigned ldsw = (unsigned)wid * 1024u;
    const int aoff = lds_byte(wr * 64 + fr, fq * 8), boff = lds_byte(wc * 32 + fr, fq * 8);
#define PG8_SA(b, h) (((b) * 2 + (h)) * HTB)
#define PG8_SB(b, h) ((4 + (b) * 2 + (h)) * HTB)
#define PG8_STAGE(bufoff, gbase, voff) do { _Pragma("unroll") for (int _i = 0; _i < 2; ++_i) \
        __builtin_amdgcn_global_load_lds((const unsigned*)((const char*)(gbase) + (voff)[_i]), (LAS unsigned*)(lds + (bufoff) + ldsw + _i * 8192), 16, 0, 0); } while (0)
#define PG8_LDA(dst, b, h) do { _Pragma("unroll") for (int m = 0; m < 4; ++m) _Pragma("unroll") for (int k = 0; k < 2; ++k) dst[m][k] = *(const LAS bf16x8*)(lds + PG8_SA(b, h) + aoff + m * 2048 + k * 1024); } while (0)
#define PG8_LDB(dst, b, h) do { _Pragma("unroll") for (int n = 0; n < 2; ++n) _Pragma("unroll") for (int k = 0; k < 2; ++k) dst[n][k] = *(const LAS bf16x8*)(lds + PG8_SB(b, h) + boff + n * 2048 + k * 1024); } while (0)
#define PG8_MMA(ai, bj, At, Bt) do { __builtin_amdgcn_s_setprio(1); _Pragma("unroll") for (int m = 0; m < 4; ++m) _Pragma("unroll") for (int n = 0; n < 2; ++n) _Pragma("unroll") for (int k = 0; k < 2; ++k) \
        acc[ai][bj][m][n] = __builtin_amdgcn_mfma_f32_16x16x32_bf16(Bt[n][k], At[m][k], acc[ai][bj][m][n], 0, 0, 0); __builtin_amdgcn_s_setprio(0); } while (0)
#define PG8_WAIT_V(n) asm volatile("s_waitcnt vmcnt(" #n ")" ::: "memory")
#define PG8_WAIT_L(n) asm volatile("s_waitcnt lgkmcnt(" #n ")" ::: "memory")
#define PG8_BAR __builtin_amdgcn_s_barrier()
#define PG8_SCHED __builtin_amdgcn_sched_barrier(0)
    Unit cur, nxt; int ui = 0;
    if (!S.next(0, cur)) return;
    f32x4 acc[2][2][4][2];
#pragma unroll
    for (int a = 0; a < 2; ++a)
#pragma unroll
        for (int b = 0; b < 2; ++b)
#pragma unroll
            for (int m = 0; m < 4; ++m)
#pragma unroll
                for (int n = 0; n < 2; ++n) acc[a][b][m][n] = (f32x4){0.f, 0.f, 0.f, 0.f};
    bf16x8 At[4][2], B0[2][2], B1[2][2];
    const char* cA = (const char*)g.A + (size_t)cur.pm * tstep; const char* cB = (const char*)g.Bt + (size_t)cur.pn * tstep;
    PG8_STAGE(PG8_SB(0, 0), cB, voffB); PG8_STAGE(PG8_SA(0, 0), cA, voffA); PG8_STAGE(PG8_SB(0, 1), cB + hstep, voffB); PG8_STAGE(PG8_SA(0, 1), cA + hstep, voffA);
    if (wr == 1) PG8_BAR;
    PG8_WAIT_V(4); PG8_BAR;
    PG8_STAGE(PG8_SB(1, 0), cB + kstep, voffB); PG8_STAGE(PG8_SA(1, 0), cA + kstep, voffA); PG8_STAGE(PG8_SB(1, 1), cB + hstep + kstep, voffB);
    PG8_WAIT_V(6); PG8_BAR;
    for (;;) {
        const bool has_next = S.next(ui + 1, nxt);
        const char* nA = has_next ? (const char*)g.A + (size_t)nxt.pm * tstep : cA; const char* nB = has_next ? (const char*)g.Bt + (size_t)nxt.pn * tstep : cB;
        for (int t = 0; t < nt; t += 2) {
            const bool last = (t == nt - 2);
            const char* a1 = cA + (size_t)(t + 1) * kstep;
            const char* a2 = last ? nA : cA + (size_t)(t + 2) * kstep; const char* b2 = last ? nB : cB + (size_t)(t + 2) * kstep;
            const char* a3 = a2 + kstep; const char* b3 = b2 + kstep;
            PG8_LDB(B0, 0, 0); PG8_SCHED; PG8_LDA(At, 0, 0); PG8_STAGE(PG8_SA(1, 1), a1 + hstep, voffA);
            PG8_WAIT_L(8); PG8_BAR; PG8_WAIT_L(0); PG8_MMA(0, 0, At, B0); PG8_BAR; PG8_SCHED;
            PG8_LDB(B1, 0, 1); PG8_STAGE(PG8_SB(0, 0), b2, voffB);
            PG8_BAR; PG8_WAIT_L(0); PG8_MMA(0, 1, At, B1); PG8_BAR;
            PG8_LDA(At, 0, 1); PG8_STAGE(PG8_SA(0, 0), a2, voffA);
            PG8_BAR; PG8_WAIT_L(0); PG8_MMA(1, 0, At, B0); PG8_BAR; PG8_SCHED;
            PG8_STAGE(PG8_SB(0, 1), b2 + hstep, voffB);
            PG8_WAIT_V(6); PG8_BAR; PG8_MMA(1, 1, At, B1); PG8_BAR;
            PG8_LDB(B0, 1, 0); PG8_SCHED; PG8_LDA(At, 1, 0); PG8_STAGE(PG8_SA(0, 1), a2 + hstep, voffA);
            PG8_WAIT_L(8); PG8_BAR; PG8_WAIT_L(0); PG8_MMA(0, 0, At, B0); PG8_BAR; PG8_SCHED;
            PG8_LDB(B1, 1, 1); PG8_STAGE(PG8_SB(1, 0), b3, voffB);
            PG8_BAR; PG8_WAIT_L(0); PG8_MMA(0, 1, At, B1); PG8_BAR;
            PG8_LDA(At, 1, 1); PG8_STAGE(PG8_SA(1, 0), a3, voffA);
            PG8_BAR; PG8_WAIT_L(0); PG8_MMA(1, 0, At, B0); PG8_BAR; PG8_SCHED;
            PG8_STAGE(PG8_SB(1, 1), b3 + hstep, voffB);
            PG8_WAIT_V(6); PG8_BAR; PG8_MMA(1, 1, At, B1); PG8_BAR;
        }
        E(acc, cur, wr, wc, fr, fq);
        if (!has_next) break;
#pragma unroll
        for (int a = 0; a < 2; ++a)
#pragma unroll
            for (int b = 0; b < 2; ++b)
#pragma unroll
                for (int m = 0; m < 4; ++m)
#pragma unroll
                    for (int n = 0; n < 2; ++n) acc[a][b][m][n] = (f32x4){0.f, 0.f, 0.f, 0.f};
        cur = nxt; cA = nA; cB = nB; ++ui;
    }
    PG8_WAIT_V(0);
    if (wr == 0) PG8_BAR;
    PG8_BAR;
#undef PG8_SA
#undef PG8_SB
#undef PG8_STAGE
#undef PG8_LDA
#undef PG8_LDB
#undef PG8_MMA
#undef PG8_WAIT_V
#undef PG8_WAIT_L
#undef PG8_BAR
#undef PG8_SCHED
}
}

struct EpiProj {
    static constexpr bool PERM = true;
    bf16_t* O; int ldc; LAS const float* rl; int pm0, pm1, pm2, pm3;
    __device__ __forceinline__ void operator()(const f32x4 (&acc)[2][2][4][2], const pg8::Unit& u, int wr, int wc, int fr, int fq) const {
        const int row0 = u.pm * 256 + wr * 64 + fr, col0 = u.pn * 256 + wc * 32 + 8 * fq;
        const int sel = u.pm == pm0 ? 0 : (u.pm == pm1 ? 1 : (u.pm == pm2 ? 2 : 3));
        LAS const float* rp = rl + sel * 256 + wr * 64 + fr;
#pragma unroll
        for (int ai = 0; ai < 2; ++ai)
#pragma unroll
            for (int m = 0; m < 4; ++m) {
                const int row = row0 + ai * 128 + m * 16;
                const float rstd = rp[ai * 128 + m * 16];
                bf16_t* rowp = O + (size_t)row * ldc + col0;
#pragma unroll
                for (int bj = 0; bj < 2; ++bj) {
                    const f32x4 v0 = acc[ai][bj][m][0] * rstd, v1 = acc[ai][bj][m][1] * rstd;
                    u32x4 w; w.x = cvt_pk_bf16(v0[0], v0[1]); w.y = cvt_pk_bf16(v0[2], v0[3]); w.z = cvt_pk_bf16(v1[0], v1[1]); w.w = cvt_pk_bf16(v1[2], v1[3]);
                    *(u32x4*)(rowp + bj * 128) = w;
                }
            }
    }
};
struct X8 { f32x4 lo, hi; };
template <bool FIRST> __device__ __forceinline__ X8 ld_x8(const float* __restrict__ s32, const bf16_t* __restrict__ s16, size_t o) {
    X8 r;
    if (FIRST) { r.lo = *(const f32x4*)(s32 + o); r.hi = *(const f32x4*)(s32 + o + 4); }
    else { const u32x4 u = *(const u32x4*)(s16 + o); r.lo = cvt4((u32x2){u.x, u.y}); r.hi = cvt4((u32x2){u.z, u.w}); }
    return r;
}
__device__ __forceinline__ void st_x8(bf16_t* p, f32x4 lo, f32x4 hi) { u32x4 w; w.x = cvt_pk_bf16(lo[0], lo[1]); w.y = cvt_pk_bf16(lo[2], lo[3]); w.z = cvt_pk_bf16(hi[0], hi[1]); w.w = cvt_pk_bf16(hi[2], hi[3]); *(u32x4*)p = w; }
template <bool FIRST>
__device__ __forceinline__ void epi_res_rows(const f32x4 (&acc)[2][2][4][2], const float* __restrict__ src32, const bf16_t* __restrict__ src16, bf16_t* __restrict__ Xb, float* __restrict__ ssqp,
                                             int row0, int col0, int slot, int fq) {
    X8 x[2][2];
#pragma unroll
    for (int bj = 0; bj < 2; ++bj) x[0][bj] = ld_x8<FIRST>(src32, src16, (size_t)row0 * 1024 + col0 + bj * 128);
#pragma unroll
    for (int gi = 0; gi < 8; ++gi) {
        const int ai = gi >> 2, m = gi & 3, row = row0 + ai * 128 + m * 16;
        if (gi + 1 < 8) {
            const int nrow = row0 + ((gi + 1) >> 2) * 128 + ((gi + 1) & 3) * 16;
#pragma unroll
            for (int bj = 0; bj < 2; ++bj) x[(gi + 1) & 1][bj] = ld_x8<FIRST>(src32, src16, (size_t)nrow * 1024 + col0 + bj * 128);
        }
        float part = 0.f;
#pragma unroll
        for (int bj = 0; bj < 2; ++bj) {
            const f32x4 lo = x[gi & 1][bj].lo + acc[ai][bj][m][0], hi = x[gi & 1][bj].hi + acc[ai][bj][m][1];
            st_x8(Xb + (size_t)row * 1024 + col0 + bj * 128, lo, hi);
            part += dot4(lo, lo) + dot4(hi, hi);
        }
        part += __shfl_xor(part, 16); part += __shfl_xor(part, 32);
        if (fq == 0) ssqp[(size_t)row * 16 + slot] = part;
    }
}
struct EpiRes {
    static constexpr bool PERM = true;
    const float* xp; const float* xs; bf16_t* Xb; float* ssq_next;
    __device__ __forceinline__ void operator()(const f32x4 (&acc)[2][2][4][2], const pg8::Unit& u, int wr, int wc, int fr, int fq) const {
        const int row0 = u.pm * 256 + wr * 64 + fr, col0 = u.pn * 256 + wc * 32 + 8 * fq;
        if (xp) epi_res_rows<true>(acc, row0 < NTP ? xp : xs - (size_t)NTP * 1024, nullptr, Xb, ssq_next, row0, col0, u.pn * 4 + wc, fq);
        else epi_res_rows<false>(acc, nullptr, Xb, Xb, ssq_next, row0, col0, u.pn * 4 + wc, fq);
    }
};

template <bool FIRST>
__device__ __forceinline__ void res_sample_tile(const Ctx cx, const bf16_t* __restrict__ A, const bf16_t* __restrict__ Bt, const float* __restrict__ xs, bf16_t* __restrict__ Xb, float* __restrict__ ssqp, int tile) {
    const int tid = cx.tid, wid = tid >> 6, lane = tid & 63, fr = lane & 15, fq = lane >> 4;
    const int tm = tile >> 3, tn = tile & 7;
    const int r0 = NTP + tm * 64 + (wid & 3) * 16, c0 = tn * 128 + (wid >> 2) * 64;
    const bf16_t* ap = A + (size_t)(r0 + fr) * 1024 + fq * 8;
    const bf16_t* bp = Bt + (size_t)(c0 + fr) * 1024 + fq * 8;
    f32x4 acc[4];
#pragma unroll
    for (int nt = 0; nt < 4; ++nt) acc[nt] = (f32x4){0.f, 0.f, 0.f, 0.f};
#pragma unroll 8
    for (int ks = 0; ks < 32; ++ks) {
        const bf16x8 af = *(const bf16x8*)(ap + ks * 32);
#pragma unroll
        for (int nt = 0; nt < 4; ++nt) {
            const bf16x8 bf = *(const bf16x8*)(bp + (size_t)nt * 16 * 1024 + ks * 32);
            acc[nt] = __builtin_amdgcn_mfma_f32_16x16x32_bf16(bf, af, acc[nt], 0, 0, 0);
        }
    }
    const int row = r0 + fr;
    float part = 0.f;
#pragma unroll
    for (int nt = 0; nt < 4; ++nt) {
        const int col = c0 + nt * 16 + fq * 4;
        const f32x4 xo = FIRST ? *(const f32x4*)(xs + (size_t)(row - NTP) * 1024 + col) : ld_bf4(Xb + (size_t)row * 1024 + col);
        const f32x4 v = xo + acc[nt];
        st_bf4(Xb + (size_t)row * 1024 + col, v);
        part += dot4(v, v);
    }
    part += __shfl_xor(part, 16); part += __shfl_xor(part, 32);
    if (fq == 0) ssqp[(size_t)row * 16 + (c0 >> 6)] = part;
}

__device__ __forceinline__ void tr_tile(const Ctx cx, LAS float* T, const float* src, int ld, int col0, int k0, bf16_t* dst, int Ktot, int drow0, const float* scale, bool zero) {
    const int tid = cx.tid;
    if (zero) {
        const int n = tid >> 3, kc = (tid & 7) * 8;
        *(u32x4*)(dst + (size_t)(drow0 + n) * Ktot + k0 + kc) = (u32x4){0u, 0u, 0u, 0u};
        return;
    }
#pragma unroll
    for (int pass = 0; pass < 2; ++pass) {
        const int kk = (tid >> 4) + pass * 32, nn = (tid & 15) * 4;
        f32x4 v = *(const f32x4*)(src + (size_t)(k0 + kk) * ld + col0 + nn);
        if (scale) v = v * scale[k0 + kk];
        T[kk * 65 + nn] = v[0]; T[kk * 65 + nn + 1] = v[1]; T[kk * 65 + nn + 2] = v[2]; T[kk * 65 + nn + 3] = v[3];
    }
    __syncthreads();
    {
        const int n = tid >> 3, kc = (tid & 7) * 8;
        u32x4 w;
        w.x = cvt_pk_bf16(T[(kc + 0) * 65 + n], T[(kc + 1) * 65 + n]); w.y = cvt_pk_bf16(T[(kc + 2) * 65 + n], T[(kc + 3) * 65 + n]);
        w.z = cvt_pk_bf16(T[(kc + 4) * 65 + n], T[(kc + 5) * 65 + n]); w.w = cvt_pk_bf16(T[(kc + 6) * 65 + n], T[(kc + 7) * 65 + n]);
        *(u32x4*)(dst + (size_t)(drow0 + n) * Ktot + k0 + kc) = w;
    }
    __syncthreads();
}

__device__ void phase_prepass(const Params& p, const Ctx cx, LAS unsigned char* lds) {
    LAS float* T = (LAS float*)lds;
    const int tid = cx.tid;
    for (int job = cx.bid; job < 4544; job += cx.nblk) {
        int j = job;
        if (j < 2176) {
            const int i = j / 1088, r = j % 1088, nt = r / 16, kt = r % 16;
            const int n0 = nt * 64;
            int col0; bool zero = false;
            if (n0 < 2048) col0 = n0; else if (n0 < 2560) col0 = 3712 + (n0 - 2048); else if (n0 < 4224) col0 = 2048 + (n0 - 2560); else { col0 = 0; zero = true; }
            tr_tile(cx, T, PIN(I_WINE) + (size_t)i * 1024 * 4224, 4224, col0, kt * 64, (bf16_t*)(PWS + WS_WINE) + (size_t)i * 4352 * 1024, 1024, n0, PIN(I_NORMW) + (2 * i) * 1024, zero);
            continue;
        }
        j -= 2176;
        if (j < 512) { const int i = j / 256, r = j % 256, nt = r / 16, kt = r % 16;
            tr_tile(cx, T, PIN(I_WOUTE) + (size_t)i * 1024 * 1024, 1024, nt * 64, kt * 64, (bf16_t*)(PWS + WS_WOUTE) + (size_t)i * 1024 * 1024, 1024, nt * 64, nullptr, false); continue; }
        j -= 512;
        if (j < 1280) { const int i = j / 640, r = j % 640, nt = r / 16, kt = r % 16;
            tr_tile(cx, T, PIN(I_WINO) + (size_t)i * 1024 * 2560, 2560, nt * 64, kt * 64, (bf16_t*)(PWS + WS_WINO) + (size_t)i * 2560 * 1024, 1024, nt * 64, PIN(I_NORMW) + (2 * i + 1) * 1024, false); continue; }
        j -= 1280;
        if (j < 512) { const int i = j / 256, r = j % 256, nt = r / 16, kt = r % 16;
            tr_tile(cx, T, PIN(I_WOUTO) + (size_t)i * 1024 * 1024, 1024, nt * 64, kt * 64, (bf16_t*)(PWS + WS_WOUTO) + (size_t)i * 1024 * 1024, 1024, nt * 64, nullptr, false); continue; }
        j -= 512;
        if (j < 16) { const int i = j / 8, nt = j % 8;
            tr_tile(cx, T, PIN(I_W2) + (size_t)i * 64 * 512, 512, nt * 64, 0, (bf16_t*)(PWS + WS_W2T) + (size_t)i * 512 * 64, 64, nt * 64, nullptr, false); continue; }
        j -= 16;
        if (j < 16) { const int i = j / 8, nt = j % 8;
            tr_tile(cx, T, PIN(I_A2) + (size_t)i * 64 * 512, 512, nt * 64, 0, (bf16_t*)(PWS + WS_A2T) + (size_t)i * 512 * 64, 64, nt * 64, nullptr, false); continue; }
        j -= 16;
        { const int ig = j / 4, r = j % 4, nt = r / 2, kt = r % 2;
            tr_tile(cx, T, PIN(I_POOLW) + (size_t)ig * 128 * 128, 128, nt * 64, kt * 64, (bf16_t*)(PWS + WS_POOLWT) + (size_t)ig * 128 * 128, 128, nt * 64, nullptr, false); }
    }
    const int gtid = cx.bid * 512 + tid, gthreads = cx.nblk * 512;
    for (int e = gtid; e < 8 * 128 * 128; e += gthreads) {
        const int s = e & 127, t = (e >> 7) & 127;
        ((bf16_t*)(PWS + WS_SPW))[e] = (s <= t) ? (bf16_t)(cvt_pk_bf16(PIN(I_SPW)[e], 0.f) & 0xffffu) : (bf16_t)0;
    }
    const int wid = tid >> 6, lane = tid & 63;
    for (int row = cx.bid * 8 + wid; row < NTOK; row += cx.nblk * 8) {
        const float* src = row < NTP ? PIN(I_XP) + (size_t)row * 1024 : PIN(I_XS) + (size_t)(row - NTP) * 1024;
        bf16_t* dst = (bf16_t*)(PWS + WS_XB) + (size_t)row * 1024;
        float ss = 0.f;
#pragma unroll
        for (int i = 0; i < 4; ++i) { const f32x4 v = *(const f32x4*)(src + i * 256 + lane * 4); ss += dot4(v, v); st_bf4(dst + i * 256 + lane * 4, v); }
#pragma unroll
        for (int o = 32; o >= 1; o >>= 1) ss += __shfl_xor(ss, o);
        if (lane < 16) ((float*)(PWS + WS_SSQ))[(size_t)row * 16 + lane] = (lane == 0) ? ss : 0.f;
    }
}

__device__ __forceinline__ f32x4 shift4(const bf16_t* cur, bool hp, const float* st, int col, const float* mu) {
    const f32x4 q = ld_bf4(cur + col);
    f32x4 pv;
    if (hp) pv = ld_bf4(cur - LDB + col); else if (st) pv = *(const f32x4*)(st + col); else pv = (f32x4){0.f, 0.f, 0.f, 0.f};
    const f32x4 m = *(const f32x4*)(mu + col);
    return q + m * (pv - q);
}

__device__ void phase_even_prep(const Params& p, const Ctx cx, int pair, LAS unsigned char* lds) {
    const int tid = cx.tid, wid = tid >> 6, lane = tid & 63, fr = lane & 15, fq = lane >> 4;
    const bf16_t* PB = (const bf16_t*)(PWS + WS_PROJB);
    float* Wdec = (float*)(PWS + WS_WDEC);
    bf16_t* Aa = (bf16_t*)(PWS + WS_AA);
    bf16_t* Ycat = (bf16_t*)(PWS + WS_YCAT);
    const float* mu_ = PIN(I_MU) + pair * 1664;
    const float* w0_ = PIN(I_W0) + pair * 512; const float* a0_ = PIN(I_A0) + pair * 512;
    const float* k_a_ = PIN(I_KA) + pair * 512; const float* r_k_ = PIN(I_RK) + pair * 512;
    constexpr int RS = 3344;
    constexpr int TB = 17 * RS;
    constexpr int NCH = 17 * 208;
    const int h = wid;
    bf16x8 wfr[4][2], afr[4][2];
    {
        const bf16_t* W2T = (const bf16_t*)(PWS + WS_W2T) + (size_t)pair * 512 * 64;
        const bf16_t* A2T = (const bf16_t*)(PWS + WS_A2T) + (size_t)pair * 512 * 64;
#pragma unroll
        for (int nt = 0; nt < 4; ++nt)
#pragma unroll
            for (int ks = 0; ks < 2; ++ks) {
                wfr[nt][ks] = *(const bf16x8*)(W2T + (size_t)(h * 64 + nt * 16 + fr) * 64 + ks * 32 + fq * 8);
                afr[nt][ks] = *(const bf16x8*)(A2T + (size_t)(h * 64 + nt * 16 + fr) * 64 + ks * 32 + fq * 8);
            }
    }
    constexpr int buf = 0;
    for (int tile = cx.bid; tile < NTOK / 16; tile += cx.nblk) {
        int zz; asm volatile("v_mov_b32 %0, 0" : "=v"(zz));
        const int tidv = tid + zz, fr = (tidv & 15), fq = (tidv >> 4) & 3;
        {
            const int r0_ = tile * 16;
#pragma unroll
            for (int i_ = 0; i_ < 7; ++i_) {
                const int c_ = tidv + i_ * 512;
                if (c_ < NCH) { const int lr_ = c_ / 208, cc_ = c_ % 208; int gr_ = r0_ - 1 + lr_; gr_ = gr_ < 0 ? 0 : gr_;
                    *(LAS u32x4*)(lds + lr_ * RS + cc_ * 16) = *(const u32x4*)(PB + (size_t)gr_ * LDB + cc_ * 8); }
            }
        }
        __syncthreads();
        {
            const int row = tile * 16 + fr;
            const bool samp = row >= NTP;
            int b, t; if (!samp) { b = row >> 11; t = row & 2047; } else { const int q = row - NTP; b = q >> 3; t = q & 7; }
            const bool hp = t > 0;
            const float* st = samp ? PIN(I_SSHIFT) + ((size_t)pair * 128 + b) * 1664 : nullptr;
            const float* mu = mu_ + zz; const float* w0 = w0_ + zz; const float* a0 = a0_ + zz; const float* k_a = k_a_ + zz; const float* r_k = r_k_ + zz;
            LAS const unsigned char* curL = lds + buf * TB + (fr + 1) * RS;
            LAS const unsigned char* prvL = lds + buf * TB + fr * RS;
            auto sh4 = [&](int col) -> f32x4 {
                const f32x4 q = cvt4(*(LAS const u32x2*)(curL + col * 2));
                f32x4 pv;
                if (hp) pv = cvt4(*(LAS const u32x2*)(prvL + col * 2)); else if (st) pv = *(const f32x4*)(st + col); else pv = (f32x4){0.f, 0.f, 0.f, 0.f};
                const f32x4 m = *(const f32x4*)(mu + col);
                return q + m * (pv - q);
            };
            bf16x8 Aw[2], Al[2];
#pragma unroll
            for (int ks = 0; ks < 2; ++ks) {
                const int cw = 1536 + ks * 32 + fq * 8, ca = 1600 + ks * 32 + fq * 8;
                const f32x4 w_lo = sh4(cw), w_hi = sh4(cw + 4), a_lo = sh4(ca), a_hi = sh4(ca + 4);
                u32x4 pw, pa;
                float th[8];
#pragma unroll
                for (int j = 0; j < 4; ++j) { th[j] = 2.0f * sigmoidf_(2.0f * w_lo[j]) - 1.0f; th[4 + j] = 2.0f * sigmoidf_(2.0f * w_hi[j]) - 1.0f; }
                pw.x = cvt_pk_bf16(th[0], th[1]); pw.y = cvt_pk_bf16(th[2], th[3]); pw.z = cvt_pk_bf16(th[4], th[5]); pw.w = cvt_pk_bf16(th[6], th[7]);
                pa.x = cvt_pk_bf16(a_lo[0], a_lo[1]); pa.y = cvt_pk_bf16(a_lo[2], a_lo[3]); pa.z = cvt_pk_bf16(a_hi[0], a_hi[1]); pa.w = cvt_pk_bf16(a_hi[2], a_hi[3]);
                Aw[ks] = __builtin_bit_cast(bf16x8, pw); Al[ks] = __builtin_bit_cast(bf16x8, pa);
            }
            float bon = 0.f;
#pragma unroll
            for (int nt = 0; nt < 4; ++nt) {
                f32x4 lw = (f32x4){0.f, 0.f, 0.f, 0.f}, la = (f32x4){0.f, 0.f, 0.f, 0.f};
#pragma unroll
                for (int ks = 0; ks < 2; ++ks) {
                    lw = __builtin_amdgcn_mfma_f32_16x16x32_bf16(wfr[nt][ks], Aw[ks], lw, 0, 0, 0);
                    la = __builtin_amdgcn_mfma_f32_16x16x32_bf16(afr[nt][ks], Al[ks], la, 0, 0, 0);
                }
                const int ch = h * 64 + nt * 16 + fq * 4;
                const f32x4 r4 = sh4(ch), k4 = sh4(512 + ch);
                const f32x4 w04 = *(const f32x4*)(w0 + ch), a04 = *(const f32x4*)(a0 + ch), ka4 = *(const f32x4*)(k_a + ch), rk4 = *(const f32x4*)(r_k + ch);
                f32x4 dec, av;
#pragma unroll
                for (int j = 0; j < 4; ++j) {
                    const float z_ = -(w04[j] + lw[j]);
                    const float wlog = -__logf(1.0f + __expf(z_)) - 0.5f;
                    dec[j] = __expf(-__expf(wlog));
                    av[j] = sigmoidf_(a04[j] + la[j]);
                    const float kp = k4[j] * (1.0f + (av[j] - 1.0f) * ka4[j]);
                    bon += r4[j] * kp * rk4[j];
                }
                *(f32x4*)(Wdec + (size_t)row * 512 + ch) = dec;
                st_bf4(Aa + (size_t)row * 512 + ch, av);
            }
            bon += __shfl_xor(bon, 16); bon += __shfl_xor(bon, 32);
#pragma unroll
            for (int nt = 0; nt < 4; ++nt) { const int ch = h * 64 + nt * 16 + fq * 4; st_bf4(Ycat + (size_t)row * 1024 + 512 + ch, sh4(1024 + ch) * bon); }
        }
        __syncthreads();
    }
    const int gtid = cx.bid * 512 + tid, gthreads = cx.nblk * 512;
    for (int e = gtid; e < 136 * 1664; e += gthreads) {
        const int sr = e / 1664, c = e % 1664;
        if (sr < 8) POUT[O_SHIFTP + ((size_t)pair * 8 + sr) * 1664 + c] = bf2f(PB[(size_t)(sr * 2048 + 2047) * LDB + c]);
        else { const int b = sr - 8; POUT[O_SHIFTS + ((size_t)pair * 128 + b) * 1664 + c] = bf2f(PB[(size_t)(NTP + b * 8 + 7) * LDB + c]); }
    }
}

typedef float f32x2 __attribute__((ext_vector_type(2)));
__device__ __forceinline__ void scan_step(f32x4& S, const f32x4 w, const f32x4 k, const f32x4 kk, const f32x4 nb, const f32x4 r, const float v, float& y) {
    const f32x2 S01 = {S[0], S[1]}, S23 = {S[2], S[3]};
    f32x2 pp = S01 * (f32x2){kk[0], kk[1]};
    pp = S23 * (f32x2){kk[2], kk[3]} + pp;
    float pd = pp[0] + pp[1];
    const f32x2 vv = {v, v};
    const f32x2 t01 = S01 * (f32x2){w[0], w[1]} + (f32x2){k[0], k[1]} * vv;
    const f32x2 t23 = S23 * (f32x2){w[2], w[3]} + (f32x2){k[2], k[3]} * vv;
    pd = allsum16(pd);
    const f32x2 pdv = {pd, pd};
    const f32x2 n01 = (f32x2){nb[0], nb[1]} * pdv + t01, n23 = (f32x2){nb[2], nb[3]} * pdv + t23;
    S = (f32x4){n01[0], n01[1], n23[0], n23[1]};
    f32x2 q = n01 * (f32x2){r[0], r[1]};
    q = n23 * (f32x2){r[2], r[3]} + q;
    y = allsum16(q[0] + q[1]);
}

__device__ void phase_scan(const Params& p, const Ctx cx, int pair, LAS unsigned char* lds) {
    const int tid = cx.tid, wid = tid >> 6, lane = tid & 63, rs = lane >> 4, cgi = lane & 15;
    const bf16_t* PB = (const bf16_t*)(PWS + WS_PROJB);
    const float* Wdec = (const float*)(PWS + WS_WDEC);
    const bf16_t* Aa = (const bf16_t*)(PWS + WS_AA);
    float* Y = (float*)(PWS + WS_Y);
    const float* mu = PIN(I_MU) + pair * 1664;
    const float* k_k = PIN(I_KK) + pair * 512; const float* k_a = PIN(I_KA) + pair * 512;
    {
        LAS float* vb = (LAS float*)lds + wid * 3072;
        for (int st = cx.bid * 8 + wid; st < 2048; st += cx.nblk * 8) {
            const int bh = st >> 1, half = st & 1, b = bh >> 3, h = bh & 7, ch = h * 64 + cgi * 4;
            const float* stp = PIN(I_SSHIFT) + ((size_t)pair * 128 + b) * 1664;
            const f32x4 kkc = *(const f32x4*)(k_k + ch), kac = *(const f32x4*)(k_a + ch);
            {
#pragma unroll
                for (int tt = 0; tt < 2; ++tt) {
                    const int t = rs + tt * 4;
                    const size_t row = NTP + b * 8 + t;
                    const bf16_t* cur = PB + row * LDB;
                    const f32x4 r = shift4(cur, t > 0, stp, ch, mu), k = shift4(cur, t > 0, stp, 512 + ch, mu), v = shift4(cur, t > 0, stp, 1024 + ch, mu);
                    const f32x4 a = ld_bf4(Aa + row * 512 + ch);
                    const f32x4 w = *(const f32x4*)(Wdec + row * 512 + ch);
                    const f32x4 kkv = k * kkc;
                    const float ss = allsum16(dot4(kkv, kkv));
                    const float inv = 1.0f / fmaxf(sqrtf(ss), 1e-12f);
                    const f32x4 kkn = kkv * inv;
                    LAS float* o = vb + t * 384 + cgi * 4;
                    *(LAS f32x4*)(o) = w; *(LAS f32x4*)(o + 64) = k * (1.0f + (a - 1.0f) * kac); *(LAS f32x4*)(o + 128) = kkn; *(LAS f32x4*)(o + 192) = -(kkn * a);
                    *(LAS f32x4*)(o + 256) = r; *(LAS f32x4*)(o + 320) = v;
                }
            }
            asm volatile("s_waitcnt lgkmcnt(0)" ::: "memory");
            __builtin_amdgcn_wave_barrier();
#pragma unroll 1
            for (int rq = 0; rq < 8; ++rq) {
                const int ri = half * 32 + rq * 4 + rs;
                const size_t so = ((((size_t)pair * 128 + b) * 8 + h) * 64 + ri) * 64 + cgi * 4;
                f32x4 S = *(const f32x4*)(PIN(I_SWKV) + so);
#pragma unroll
                for (int t = 0; t < 8; ++t) {
                    LAS const float* r0 = vb + t * 384 + cgi * 4;
                    float y; scan_step(S, *(LAS const f32x4*)(r0), *(LAS const f32x4*)(r0 + 64), *(LAS const f32x4*)(r0 + 128), *(LAS const f32x4*)(r0 + 192), *(LAS const f32x4*)(r0 + 256), vb[t * 384 + 320 + ri], y);
                    if (cgi == 0) Y[(size_t)(NTP + b * 8 + t) * 512 + h * 64 + ri] = y;
                }
                *(f32x4*)(POUT + O_WKVS + so) = S;
            }
            asm volatile("s_waitcnt lgkmcnt(0)" ::: "memory");
            __builtin_amdgcn_wave_barrier();
        }
    }
    __syncthreads();
    LAS float* rec = (LAS float*)lds;
    for (int pt = cx.bid; pt < 256; pt += cx.nblk) {
        const int xcd = pt & 7, slot = pt >> 3, bh = xcd * 8 + (slot >> 2), rg = slot & 3, b = bh >> 3, h = bh & 7;
        const int lt = tid - 256, ls = (lt >> 4) & 15, lcg = lt & 15, lch = h * 64 + lcg * 4;
        u32x2 qr = {0u, 0u}, qk = {0u, 0u}, qv = {0u, 0u}, pr = {0u, 0u}, pk = {0u, 0u}, pv = {0u, 0u}, qa = {0u, 0u};
        f32x4 qw = (f32x4){0.f, 0.f, 0.f, 0.f};
        f32x4 mur, muk, muv, kkc, kac;
        const int ri = rg * 16 + (wid & 3) * 4 + rs;
        f32x4 S = (f32x4){0.f, 0.f, 0.f, 0.f};
#define SCAN_ISSUE(c) do { const int t_ = (c) * 16 + ls; const size_t row_ = (size_t)b * 2048 + t_; const bf16_t* cur_ = PB + row_ * LDB; \
            qr = *(const u32x2*)(cur_ + lch); qk = *(const u32x2*)(cur_ + 512 + lch); qv = *(const u32x2*)(cur_ + 1024 + lch); \
            if (t_ > 0) { pr = *(const u32x2*)(cur_ - LDB + lch); pk = *(const u32x2*)(cur_ - LDB + 512 + lch); pv = *(const u32x2*)(cur_ - LDB + 1024 + lch); } \
            else { pr = (u32x2){0u, 0u}; pk = pr; pv = pr; } \
            qw = *(const f32x4*)(Wdec + row_ * 512 + lch); qa = *(const u32x2*)(Aa + row_ * 512 + lch); } while (0)
#define SCAN_PROCESS(buf) do { const f32x4 r0_ = cvt4(qr), k0_ = cvt4(qk), v0_ = cvt4(qv); \
            const f32x4 r_ = r0_ + mur * (cvt4(pr) - r0_), k_ = k0_ + muk * (cvt4(pk) - k0_), v_ = v0_ + muv * (cvt4(pv) - v0_), a_ = cvt4(qa); \
            const f32x4 kkv_ = k_ * kkc; const float ss_ = allsum16(dot4(kkv_, kkv_)); const float inv_ = __builtin_amdgcn_rsqf(fmaxf(ss_, 1e-24f)); \
            const f32x4 kkn_ = kkv_ * inv_; \
            LAS float* o_ = rec + (buf) * 6144 + ls * 384 + lcg * 4; \
            *(LAS f32x4*)(o_) = qw; *(LAS f32x4*)(o_ + 64) = k_ * (1.0f + (a_ - 1.0f) * kac); *(LAS f32x4*)(o_ + 128) = kkn_; *(LAS f32x4*)(o_ + 192) = -(kkn_ * a_); \
            *(LAS f32x4*)(o_ + 256) = r_; *(LAS f32x4*)(o_ + 320) = v_; } while (0)
        if (wid >= 4) {
            mur = *(const f32x4*)(mu + lch); muk = *(const f32x4*)(mu + 512 + lch); muv = *(const f32x4*)(mu + 1024 + lch);
            kkc = *(const f32x4*)(k_k + lch); kac = *(const f32x4*)(k_a + lch);
            SCAN_ISSUE(0); SCAN_PROCESS(0); SCAN_ISSUE(1);
        }
        __syncthreads();
        for (int c = 0; c < 128; ++c) {
            if (wid < 4) {
                LAS const float* rb = rec + (c & 1) * 6144 + cgi * 4;
                LAS const float* rv = rec + (c & 1) * 6144 + 320 + ri;
                float ykeep = 0.f;
                f32x4 nw = *(LAS const f32x4*)(rb), nk = *(LAS const f32x4*)(rb + 64), nkk = *(LAS const f32x4*)(rb + 128), nb = *(LAS const f32x4*)(rb + 192), nr = *(LAS const f32x4*)(rb + 256);
                float nv = rv[0];
#pragma unroll
                for (int s = 0; s < 16; ++s) {
                    const f32x4 cw = nw, ck = nk, ckk = nkk, cb = nb, cr = nr; const float cv = nv;
                    if (s + 1 < 16) {
                        LAS const float* r1 = rb + (s + 1) * 384;
                        nw = *(LAS const f32x4*)(r1); nk = *(LAS const f32x4*)(r1 + 64); nkk = *(LAS const f32x4*)(r1 + 128); nb = *(LAS const f32x4*)(r1 + 192); nr = *(LAS const f32x4*)(r1 + 256);
                        nv = rv[(s + 1) * 384];
                    }
                    float y;
                    scan_step(S, cw, ck, ckk, cb, cr, cv, y);
                    ykeep = (cgi == s) ? y : ykeep;
                }
                Y[((size_t)b * 2048 + c * 16 + cgi) * 512 + h * 64 + ri] = ykeep;
            } else {
                if (c + 1 < 128) { SCAN_PROCESS((c + 1) & 1); if (c + 2 < 128) SCAN_ISSUE(c + 2); }
            }
            __syncthreads();
        }
        if (wid < 4) *(f32x4*)(POUT + O_WKVP + ((((size_t)pair * 8 + b) * 8 + h) * 64 + ri) * 64 + cgi * 4) = S;
#undef SCAN_ISSUE
#undef SCAN_PROCESS
    }
}

__device__ void phase_even_post(const Params& p, const Ctx cx, int pair) {
    const int gtid = cx.bid * 512 + cx.tid, gthreads = cx.nblk * 512;
    const bf16_t* PA = (const bf16_t*)(PWS + WS_R1);
    bf16_t* Ycat = (bf16_t*)(PWS + WS_YCAT);
    const float* Y = (const float*)(PWS + WS_Y);
    constexpr int NIT = NTOK * 128, UB = 4;
    const float* gn_g = PIN(I_GNG) + pair * 512; const float* gn_b = PIN(I_GNB) + pair * 512;
    for (int e0 = gtid; e0 < NIT; e0 += gthreads * UB) {
        f32x4 y[UB], bv[UB], bz[UB]; bool ok[UB];
#pragma unroll
        for (int u = 0; u < UB; ++u) {
            const int e = e0 + u * gthreads; ok[u] = e < NIT;
            const int ee = ok[u] ? e : e0; const int row = ee >> 7, ch = (ee & 127) * 4;
            y[u] = *(const f32x4*)(Y + (size_t)row * 512 + ch);
            bv[u] = ld_bf4(Ycat + (size_t)row * 1024 + 512 + ch);
            bz[u] = ld_bf4(PA + (size_t)row * LDA + 2048 + ch);
        }
#pragma unroll
        for (int u = 0; u < UB; ++u) {
            const int e = e0 + u * gthreads;
            const int ee = ok[u] ? e : e0; const int row = ee >> 7, ch = (ee & 127) * 4;
            const float mean = allsum16(y[u][0] + y[u][1] + y[u][2] + y[u][3]) * (1.0f / 64.0f);
            const f32x4 d = y[u] - mean;
            const float var = allsum16(dot4(d, d)) * (1.0f / 64.0f);
            const float rstd = rsqrtf(var + 64e-5f);
            const f32x4 g = *(const f32x4*)(gn_g + ch), bb = *(const f32x4*)(gn_b + ch);
            f32x4 o;
#pragma unroll
            for (int j = 0; j < 4; ++j) o[j] = (d[j] * rstd * g[j] + bb[j] + bv[u][j]) * siluf_(bz[u][j]);
            if (ok[u]) st_bf4(Ycat + (size_t)row * 1024 + 512 + ch, o);
        }
    }
    const float* cw = PIN(I_CONVW) + pair * 3 * 512;
    for (int e0 = gtid; e0 < NIT; e0 += gthreads * UB) {
        f32x4 h0[UB], c0v[UB], h1[UB], c1v[UB], h2[UB], c2v[UB], ab[UB], az[UB]; bool ok[UB];
#pragma unroll
        for (int u = 0; u < UB; ++u) {
            const int e = e0 + u * gthreads; ok[u] = e < NIT;
            const int ee = ok[u] ? e : e0; const int row = ee >> 7, ch = (ee & 127) * 4;
            const int t = row < NTP ? (row & 2047) : ((row - NTP) & 7);
            const bf16_t* cur = PA + (size_t)row * LDA + ch;
            const bf16_t* p1 = t >= 1 ? cur - LDA : cur; const bf16_t* p2 = t >= 2 ? cur - 2 * LDA : cur;
            h0[u] = ld_bf4(cur); c0v[u] = ld_bf4(cur + 1024); h1[u] = ld_bf4(p1); c1v[u] = ld_bf4(p1 + 1024); h2[u] = ld_bf4(p2); c2v[u] = ld_bf4(p2 + 1024);
            ab[u] = ld_bf4(cur + 512); az[u] = ld_bf4(cur + 1536);
        }
#pragma unroll
        for (int u = 0; u < UB; ++u) {
            const int e = e0 + u * gthreads;
            const int ee = ok[u] ? e : e0; const int row = ee >> 7, ch = (ee & 127) * 4;
            const bool samp = row >= NTP;
            int b, t, T; if (!samp) { b = row >> 11; t = row & 2047; T = 2048; } else { const int q = row - NTP; b = q >> 3; t = q & 7; T = 8; }
            const f32x4 u0 = c0v[u] * h0[u];
            f32x4 u1 = c1v[u] * h1[u], u2 = c2v[u] * h2[u];
            if (t < 2) {
                const f32x4 zero = (f32x4){0.f, 0.f, 0.f, 0.f};
                const float* hist = PIN(I_SCONV) + ((size_t)pair * 128 + (samp ? b : 0)) * 2 * 512 + ch;
                if (t == 0) { u1 = samp ? *(const f32x4*)(hist + 512) : zero; u2 = samp ? *(const f32x4*)(hist) : zero; }
                else { u2 = samp ? *(const f32x4*)(hist + 512) : zero; }
            }
            const f32x4 k0 = *(const f32x4*)(cw + ch), k1 = *(const f32x4*)(cw + 512 + ch), k2 = *(const f32x4*)(cw + 1024 + ch);
            const f32x4 conv = k0 * u2 + k1 * u1 + k2 * u0;
            f32x4 o;
#pragma unroll
            for (int j = 0; j < 4; ++j) o[j] = ab[u][j] * conv[j] * siluf_(az[u][j]);
            if (ok[u]) {
                st_bf4(Ycat + (size_t)row * 1024 + ch, o);
                if (t >= T - 2) {
                    float* dst = samp ? POUT + O_CONVS + (((size_t)pair * 128 + b) * 2 + (t - (T - 2))) * 512 + ch : POUT + O_CONVP + (((size_t)pair * 8 + b) * 2 + (t - (T - 2))) * 512 + ch;
                    *(f32x4*)dst = u0;
                }
            }
        }
    }
}

__device__ void phase_odd_mixer(const Params& p, const Ctx cx, int pair, LAS unsigned char* lds) {
    const int tid = cx.tid, wid = tid >> 6, lane = tid & 63, fr = lane & 15, fq = lane >> 4;
    const bf16_t* PO = (const bf16_t*)(PWS + WS_R1);
    bf16_t* Ycat = (bf16_t*)(PWS + WS_YCAT);
    LAS bf16_t* LA = (LAS bf16_t*)lds;
    LAS bf16_t* LB = (LAS bf16_t*)(lds + 128 * 136 * 2);
    LAS float* stat = (LAS float*)(lds + 2 * 128 * 136 * 2);
    LAS float* LE = (LAS float*)(lds + 128 * 136 * 2);
    LAS bf16_t* LW = (LAS bf16_t*)(lds + 128 * 136 * 2 + 143 * 128 * 4);
#ifdef MIXPROBE
    for (int rr = 0; rr < 16; ++rr) {
        const int round = rr & 7;
#else
    for (int round = 0; round < 8; ++round) {
#endif
        int it;
        if (cx.nblk == 256) {
            if (round == 0) it = cx.bid < 136 ? cx.bid : 136 + 136 + (cx.bid - 136);
            else if (round == 1) it = cx.bid < 136 ? 136 + cx.bid : 136 + 136 + 120 + (cx.bid - 136);
            else if (cx.bid >= 136) it = 136 + 136 + 120 * round + (cx.bid - 136);
            else it = 1 << 20;
        } else it = cx.bid + round * cx.nblk;
#ifdef MIXPROBE
        if (it >= 680) continue;
        if (rr >= 8 && ((MIXPROBE == 1) != (it < 136))) continue;
#else
        if (it >= 680) { if (cx.nblk == 256 ? round >= 4 : true) break; else continue; }
#endif
        if (it >= 136) {
            const int ci = it - 136, tile = ci >> 2, g = ci & 3, r0 = tile * 128;
            const bool samp = r0 >= NTP;
            const int w = 2 << g;
            const bf16_t* Bw = (const bf16_t*)(PWS + WS_POOLWT) + ((size_t)pair * 4 + g) * 128 * 128;
            {
                u32x4 wr_[4];
#pragma unroll
                for (int i = 0; i < 4; ++i) { const int e = tid + i * 512, d_ = e >> 4, c8 = (e & 15) * 8; wr_[i] = *(const u32x4*)(Bw + d_ * 128 + c8); }
#pragma unroll
                for (int i = 0; i < 4; ++i) { const int e = tid + i * 512, d_ = e >> 4, c8 = (e & 15) * 8; *(LAS u32x4*)(LW + d_ * 136 + c8) = wr_[i]; }
            }
            if (!samp) {
                const int t0 = r0 & 2047;
                {
                    u32x2 raw[9];
#pragma unroll
                    for (int i = 0; i < 9; ++i) {
                        const int e = tid + i * 512, er = e >> 5, c = (e & 31) * 4;
                        raw[i] = (u32x2){0u, 0u};
                        if (e < 143 * 32 && t0 + er - 15 >= 0) raw[i] = *(const u32x2*)(PO + (size_t)(r0 + er - 15) * LDA + g * 128 + c);
                    }
#pragma unroll
                    for (int i = 0; i < 9; ++i) {
                        const int e = tid + i * 512, er = e >> 5, c = (e & 31) * 4;
                        if (e < 143 * 32) *(LAS f32x4*)(LE + er * 128 + c) = cvt4(raw[i]);
                    }
                }
                __syncthreads();
                {
                    const int c = (tid & 31) * 4, tl0 = (tid >> 5) * 8;
                    f32x4 sum = (f32x4){0.f, 0.f, 0.f, 0.f};
#pragma unroll 4
                    for (int d = 0; d < w; ++d) sum += *(LAS const f32x4*)(LE + (tl0 + 15 - d) * 128 + c);
#pragma unroll
                    for (int k = 0; k < 8; ++k) {
                        const int tl = tl0 + k;
                        const f32x4 pt = *(LAS const f32x4*)(LE + (tl + 15) * 128 + c);
                        if (k > 0) sum += pt - *(LAS const f32x4*)(LE + (tl + 15 - w) * 128 + c);
                        const float cnt = fminf((float)w, (float)(t0 + tl + 1));
                        const f32x4 pooled = sum * (1.0f / cnt) - pt;
                        u32x2 u; u.x = cvt_pk_bf16(pooled[0], pooled[1]); u.y = cvt_pk_bf16(pooled[2], pooled[3]);
                        *(LAS u32x2*)(LA + tl * 136 + c) = u;
                    }
                }
            } else {
                for (int e = tid; e < 128 * 32; e += 512) {
                    const int tl = e >> 5, c = (e & 31) * 4, row = r0 + tl;
                    const int q = row - NTP, b = q >> 3, t = q & 7;
                    const bf16_t* cur = PO + (size_t)row * LDA + g * 128 + c;
                    const f32x4 pt = ld_bf4(cur);
                    f32x4 sum = pt;
                    for (int d = 1; d < w; ++d) {
                        const int tt = t - d;
                        if (tt >= 0) sum += ld_bf4(cur - (size_t)d * LDA);
                        else sum += *(const f32x4*)(PIN(I_SPOOL) + (((size_t)pair * 128 + b) * 15 + (15 + tt)) * 512 + g * 128 + c);
                    }
                    const f32x4 pooled = sum * (1.0f / (float)w) - pt;
                    u32x2 u; u.x = cvt_pk_bf16(pooled[0], pooled[1]); u.y = cvt_pk_bf16(pooled[2], pooled[3]);
                    *(LAS u32x2*)(LA + tl * 136 + c) = u;
                }
            }
            __syncthreads();
            const int row = r0 + wid * 16 + fr;
            bf16x8 af[4];
#pragma unroll
            for (int ks = 0; ks < 4; ++ks) af[ks] = *(const LAS bf16x8*)(LA + (wid * 16 + fr) * 136 + ks * 32 + fq * 8);
#pragma unroll
            for (int nt = 0; nt < 8; ++nt) {
                f32x4 acc = (f32x4){0.f, 0.f, 0.f, 0.f};
#pragma unroll
                for (int ks = 0; ks < 4; ++ks) {
                    const bf16x8 bf = *(const LAS bf16x8*)(LW + (nt * 16 + fr) * 136 + ks * 32 + fq * 8);
                    acc = __builtin_amdgcn_mfma_f32_16x16x32_bf16(bf, af[ks], acc, 0, 0, 0);
                }
                const int d = g * 128 + nt * 16 + fq * 4;
                const f32x4 cz = ld_bf4(PO + (size_t)row * LDA + 512 + d), ps = *(const f32x4*)(PIN(I_PSCALE) + pair * 512 + d);
                f32x4 o;
#pragma unroll
                for (int j = 0; j < 4; ++j) o[j] = acc[j] * ps[j] * siluf_(cz[j]);
                st_bf4(Ycat + (size_t)row * 1024 + d, o);
            }
            __syncthreads();
        } else {
            const int tile = it, r0 = tile * 128;
            const bool samp = r0 >= NTP;
            {
                const int tl = tid >> 2, q = tid & 3;
                const bf16_t* vr = PO + (size_t)(r0 + tl) * LDA + 1536 + q * 128;
                float s_ = 0.f, ss = 0.f;
#pragma unroll
                for (int i = 0; i < 16; ++i) { const u32x4 raw = *(const u32x4*)(vr + i * 8); const f32x4 v0 = cvt4((u32x2){raw.x, raw.y}), v1 = cvt4((u32x2){raw.z, raw.w});
                    s_ += (v0[0] + v0[1]) + (v0[2] + v0[3]) + (v1[0] + v1[1]) + (v1[2] + v1[3]); ss += dot4(v0, v0) + dot4(v1, v1); }
                s_ = allsum4(s_); ss = allsum4(ss);
                const float mean = s_ * (1.0f / 512.0f);
                const float var = fmaxf(ss * (1.0f / 512.0f) - mean * mean, 0.f);
                if (q == 0) { stat[tl * 2] = mean; stat[tl * 2 + 1] = rsqrtf(var + 1e-5f); }
            }
            __syncthreads();
#pragma unroll 1
            for (int g = 0; g < 4; ++g) {
                {
                    const int tl = tid >> 2, q = tid & 3, row = r0 + tl;
                    const float mean = stat[tl * 2], rstd = stat[tl * 2 + 1];
                    const bf16_t* vr = PO + (size_t)row * LDA + 1536 + g * 128 + q * 32;
                    const float* lg = PIN(I_LNG) + pair * 512 + g * 128 + q * 32; const float* lb = PIN(I_LNB) + pair * 512 + g * 128 + q * 32;
#pragma unroll
                    for (int i = 0; i < 8; ++i) {
                        const f32x4 v = ld_bf4(vr + i * 4);
                        const f32x4 vn = (v - mean) * rstd * *(const f32x4*)(lg + i * 4) + *(const f32x4*)(lb + i * 4);
                        if (samp) *(f32x4*)(POUT + O_CHUNKV + ((size_t)pair * 1024 + (row - NTP)) * 512 + g * 128 + q * 32 + i * 4) = vn;
#pragma unroll
                        for (int j = 0; j < 4; ++j) LB[(q * 32 + i * 4 + j) * 136 + tl] = (bf16_t)(cvt_pk_bf16(vn[j], 0.f) & 0xffffu);
                    }
                }
                if (!samp) {
                    const bf16_t* Wsrc = (const bf16_t*)(PWS + WS_SPW) + ((size_t)pair * 4 + g) * 128 * 128;
                    u32x4 wr_[4];
#pragma unroll
                    for (int i = 0; i < 4; ++i) { const int e = tid + i * 512, t = e >> 4, s8 = (e & 15) * 8; wr_[i] = *(const u32x4*)(Wsrc + t * 128 + s8); }
#pragma unroll
                    for (int i = 0; i < 4; ++i) { const int e = tid + i * 512, t = e >> 4, s8 = (e & 15) * 8; *(LAS u32x4*)(LA + t * 136 + s8) = wr_[i]; }
                } else {
                    const float* Wsrc = PIN(I_SPW) + ((size_t)pair * 4 + g) * 128 * 128;
                    for (int e = tid; e < 128 * 128; e += 512) { const int t = e >> 7, s2 = e & 127;
                        const float v = ((t >> 3) == (s2 >> 3) && (s2 & 7) <= (t & 7)) ? Wsrc[(t & 7) * 128 + (s2 & 7)] : 0.f;
                        LA[t * 136 + s2] = (bf16_t)(cvt_pk_bf16(v, 0.f) & 0xffffu); }
                }
                __syncthreads();
                {
                    const int tl = wid * 16 + fr, row = r0 + tl;
                    const float bias = PIN(I_SPB)[((size_t)pair * 4 + g) * 128 + (samp ? (tl & 7) : tl)];
                    bf16x8 wf[4];
#pragma unroll
                    for (int ks = 0; ks < 4; ++ks) wf[ks] = *(const LAS bf16x8*)(LA + tl * 136 + ks * 32 + fq * 8);
#pragma unroll
                    for (int nt = 0; nt < 8; ++nt) {
                        f32x4 acc = (f32x4){0.f, 0.f, 0.f, 0.f};
#pragma unroll
                        for (int ks = 0; ks < 4; ++ks) {
                            if (ks * 32 <= wid * 16 + 15) {
                                const bf16x8 vf = *(const LAS bf16x8*)(LB + (nt * 16 + fr) * 136 + ks * 32 + fq * 8);
                                acc = __builtin_amdgcn_mfma_f32_16x16x32_bf16(vf, wf[ks], acc, 0, 0, 0);
                            }
                        }
                        const int c = g * 128 + nt * 16 + fq * 4;
                        const f32x4 u = ld_bf4(PO + (size_t)row * LDA + 1024 + c), dz = ld_bf4(PO + (size_t)row * LDA + 2048 + c);
                        f32x4 o;
#pragma unroll
                        for (int j = 0; j < 4; ++j) o[j] = u[j] * (acc[j] + bias) * siluf_(dz[j]);
                        st_bf4(Ycat + (size_t)row * 1024 + 512 + c, o);
                    }
                }
                __syncthreads();
            }
        }
    }
    const int gtid = cx.bid * 512 + tid, gthreads = cx.nblk * 512;
    for (int e = gtid; e < 136 * 15 * 512; e += gthreads) {
        const int c = e & 511, q = e >> 9, sr = q / 15, k = q % 15;
        if (sr < 8) POUT[O_POOLP + (((size_t)pair * 8 + sr) * 15 + k) * 512 + c] = bf2f(PO[(size_t)(sr * 2048 + 2033 + k) * LDA + c]);
        else { const int b = sr - 8;
            POUT[O_POOLS + (((size_t)pair * 128 + b) * 15 + k) * 512 + c] = (k < 7) ? PIN(I_SPOOL)[(((size_t)pair * 128 + b) * 15 + 8 + k) * 512 + c] : bf2f(PO[(size_t)(NTP + b * 8 + (k - 7)) * LDA + c]); }
    }
}

__device__ void phase_final(const Params& p, const Ctx cx) {
    const int gtid = cx.bid * 512 + cx.tid, gthreads = cx.nblk * 512;
    const float* ssq = (const float*)(PWS + WS_SSQ) + (size_t)4 * NTOK * 16;
    const bf16_t* Xb = (const bf16_t*)(PWS + WS_XB);
    constexpr int NIT = NTOK * 256, UB = 4;
    for (int e0 = gtid; e0 < NIT; e0 += gthreads * UB) {
        f32x4 x[UB]; float sq[UB]; bool ok[UB];
#pragma unroll
        for (int u = 0; u < UB; ++u) { const int e = e0 + u * gthreads; ok[u] = e < NIT; const int ee = ok[u] ? e : e0; const int row = ee >> 8, c = (ee & 255) * 4;
            x[u] = ld_bf4(Xb + (size_t)row * 1024 + c); sq[u] = ssq_sum(ssq + (size_t)row * 16); }
#pragma unroll
        for (int u = 0; u < UB; ++u) { const int e = e0 + u * gthreads; const int ee = ok[u] ? e : e0; const int row = ee >> 8, c = (ee & 255) * 4;
            const float rstd = rsqrtf(sq[u] * (1.0f / 1024.0f) + 1e-6f);
            if (ok[u]) *(f32x4*)(POUT + (size_t)row * 1024 + c) = x[u] * rstd * *(const f32x4*)(PIN(I_FNORMW) + c); }
    }
}

#define XB_TMO      128
#define XB_XCNT(j)  (256  + 64 * (j))
#define XB_XSUB(j)  (1280 + 64 * (j))
#define XB_XGEN(j)  (2304 + 64 * (j))
#define XB_TOP      3328
#define XB_TOPGEN   3392
#define XCD_BAR_WORDS 3456
#define XB_SPIN_CAP (1u << 18)
__device__ __forceinline__ unsigned xb_ld(unsigned* p)              { return __hip_atomic_load(p, __ATOMIC_RELAXED, __HIP_MEMORY_SCOPE_AGENT); }
__device__ __forceinline__ unsigned xb_add(unsigned* p, unsigned v) { return __hip_atomic_fetch_add(p, v, __ATOMIC_RELAXED, __HIP_MEMORY_SCOPE_AGENT); }
__device__ __forceinline__ unsigned xb_xcc_id() { return (unsigned)__builtin_amdgcn_s_getreg((3 << 11) | 20) & 0xFu; }
#define XB_SPIN(cond, bar) do { unsigned _sp = 0; while (cond) { __builtin_amdgcn_s_sleep(1); \
    if ((++_sp & 255u) == 0u) { if (xb_ld(&(bar)[XB_TMO])) break; if (_sp > XB_SPIN_CAP) { atomicAdd(&(bar)[XB_TMO], 1u); break; } } } } while (0)
struct XcdBarrier { unsigned* bar; unsigned x; volatile LAS unsigned* st; };
__device__ __forceinline__ XcdBarrier xcd_barrier_post(unsigned* bar, volatile LAS unsigned* st) {
    XcdBarrier b; b.bar = bar; b.x = xb_xcc_id(); b.st = st;
    if (threadIdx.x == 0) (void)xb_add(&bar[XB_XCNT(b.x)], 1u);
    return b;
}
__device__ __forceinline__ void xcd_barrier_complete(unsigned* bar, unsigned x, unsigned& nloc, unsigned& nx) {
    const unsigned G = gridDim.x * gridDim.y * gridDim.z;
    unsigned sum, cnt, mine, sp = 0u;
    for (;;) {
        sum = 0u; cnt = 0u; mine = 0u;
#pragma unroll
        for (unsigned j = 0; j < 16; ++j) { const unsigned c = xb_ld(&bar[XB_XCNT(j)]); sum += c; cnt += (c > 0u) ? 1u : 0u; mine = (j == x) ? c : mine; }
        if (sum == G) break;
        __builtin_amdgcn_s_sleep(1);
        if ((++sp & 255u) == 0u) { if (xb_ld(&bar[XB_TMO])) break; if (sp > XB_SPIN_CAP) { atomicAdd(&bar[XB_TMO], 1u); break; } }
    }
    nloc = mine > 0u ? mine : 1u; nx = cnt > 0u ? cnt : 1u;
}
__device__ __forceinline__ void xcd_barrier(const XcdBarrier& b) {
    asm volatile("s_waitcnt vmcnt(0)" ::: "memory");
    __syncthreads();
    if (threadIdx.x == 0) {
        unsigned* bar = b.bar;
        __builtin_amdgcn_s_waitcnt(0);
        unsigned nloc = b.st[0], nx = b.st[1];
        if (nloc == 0u) { xcd_barrier_complete(bar, b.x, nloc, nx); b.st[0] = nloc; b.st[1] = nx; }
        const unsigned old = xb_add(&bar[XB_XSUB(b.x)], 1u);
        const unsigned gen = old / nloc;
        if (old + 1u == (gen + 1u) * nloc) {
            __builtin_amdgcn_fence(__ATOMIC_RELEASE, "agent");
            asm volatile("s_waitcnt vmcnt(0)" ::: "memory");
            const unsigned og = xb_add(&bar[XB_TOP], 1u);
            const unsigned tg = og / nx;
            if (og + 1u == (tg + 1u) * nx) xb_add(&bar[XB_TOPGEN], 1u);
            else XB_SPIN(xb_ld(&bar[XB_TOPGEN]) == tg, bar);
            __builtin_amdgcn_fence(__ATOMIC_ACQUIRE, "agent");
            xb_add(&bar[XB_XGEN(b.x)], 1u);
            asm volatile("s_waitcnt vmcnt(0)" ::: "memory");
        } else {
            XB_SPIN(xb_ld(&bar[XB_XGEN(b.x)]) == gen, bar);
            __builtin_amdgcn_fence(__ATOMIC_ACQUIRE, "agent");
            asm volatile("s_waitcnt vmcnt(0)" ::: "memory");
        }
    }
    __syncthreads();
}

__device__ void run_gemm_proj(const Params& p, const Ctx cx, LAS unsigned char* lds, const bf16_t* Bt, int N, bf16_t* O, int ldc, int layer) {
    pg8::Gemm g{(const bf16_t*)(PWS + WS_XB), Bt, NTOK, N, 1024};
    pg8::StaticOrder S; S.init(NTOK, N, (int)cx.nblk, (int)cx.bid);
    const float* ssq = (const float*)(PWS + WS_SSQ) + (size_t)layer * NTOK * 16;
    LAS float* rl = (LAS float*)(lds + 131072);
    int pm0 = -1, pm1 = -1, pm2 = -1, pm3 = -1, np = 0;
    for (int i = 0; i < 64; ++i) {
        pg8::Unit u; if (!S.next(i, u)) break;
        if (u.pm == pm0 || u.pm == pm1 || u.pm == pm2 || u.pm == pm3) continue;
        if (np == 0) pm0 = u.pm; else if (np == 1) pm1 = u.pm; else if (np == 2) pm2 = u.pm; else pm3 = u.pm;
        ++np;
    }
    for (int r = cx.tid; r < np * 256; r += 512) {
        const int i = r >> 8, pm = i == 0 ? pm0 : (i == 1 ? pm1 : (i == 2 ? pm2 : pm3));
        rl[r] = rsqrtf(ssq_sum(ssq + (size_t)(pm * 256 + (r & 255)) * 16) * (1.0f / 1024.0f) + 1e-6f);
    }
    __syncthreads();
    EpiProj E{O, ldc, rl, pm0, pm1, pm2, pm3};
    pg8::gemm_phase<EpiProj>(cx, lds, g, S, E);
}
__device__ void run_gemm_res(const Params& p, const Ctx cx, LAS unsigned char* lds, const bf16_t* Bt, int layer) {
    const bf16_t* A = (const bf16_t*)(PWS + WS_YCAT);
    bf16_t* Xb = (bf16_t*)(PWS + WS_XB);
    float* ssqn = (float*)(PWS + WS_SSQ) + (size_t)(layer + 1) * NTOK * 16;
    pg8::Gemm g{A, Bt, NTOK, 1024, 1024};
    pg8::StaticOrder S; S.init(NTOK, 1024, (int)cx.nblk, (int)cx.bid);
    EpiRes E{layer == 0 ? PIN(I_XP) : nullptr, PIN(I_XS), Xb, ssqn};
    pg8::gemm_phase<EpiRes>(cx, lds, g, S, E);
}

constexpr int N_PHASES = 20;
#ifndef PHMASK
#define PHMASK 0xffff
#endif
#define PHON(n) ((PHMASK >> ((n) % 16)) & 1)
__global__ void __launch_bounds__(512, 2) fwd_kernel(Params p) {
    extern __shared__ __attribute__((aligned(16))) unsigned char lds_raw[];
    LAS unsigned char* lds = (LAS unsigned char*)lds_raw;
    volatile LAS unsigned* bar_st = (volatile LAS unsigned*)(lds + LDS_MAIN);
    if (threadIdx.x < 4) bar_st[threadIdx.x] = 0u;
    __syncthreads();
    const XcdBarrier gbar = xcd_barrier_post((unsigned*)((unsigned char*)p.ptr[30] + WS_BAR), bar_st);
    if (p.ph_hi < 0) cg::this_grid().sync();
#define GRID_SYNC() xcd_barrier(gbar)
#ifdef SYNCPROBE
    for (int i = 0; i < SYNCPROBE; ++i) GRID_SYNC();
#endif
#ifdef REPMASK
    for (int pc = p.ph_lo * 2; pc < p.ph_hi * 2; ++pc) {
        const int ph = pc >> 1;
        { const int s_ = (ph == 0) ? 9 : (ph == N_PHASES - 1) ? 31 : (ph - 1) % 9; if ((pc & 1) && !((REPMASK >> s_) & 1)) continue; }
        if (pc > p.ph_lo * 2) GRID_SYNC();
#else
    for (int ph = p.ph_lo; ph < p.ph_hi; ++ph) {
        if (ph > p.ph_lo) GRID_SYNC();
#endif
        Ctx cx; cx.tid = threadIdx.x; cx.bid = blockIdx.x; cx.nblk = gridDim.x;
        asm volatile("s_mov_b32 %0, 0" : "=s"(cx.z));
        asm volatile("" : "+v"(cx.tid)); asm volatile("" : "+s"(cx.bid)); asm volatile("" : "+s"(cx.nblk));
        const int pair = (ph - 1) / 9, s = (ph == 0) ? 100 : (ph == N_PHASES - 1 ? 101 : (ph - 1) % 9);
        if (s == 0 || s == 3 || s == 6) {
#if PHON(0)
            const bf16_t* WinE = (const bf16_t*)(PWS + WS_WINE) + (size_t)pair * 4352 * 1024;
            const bf16_t* Bt = s == 0 ? WinE + (size_t)2560 * 1024 : (s == 3 ? WinE : (const bf16_t*)(PWS + WS_WINO) + (size_t)pair * 2560 * 1024);
            const int N = s == 0 ? 1792 : 2560;
            run_gemm_proj(p, cx, lds, Bt, N, (bf16_t*)(PWS + WS_R1), N, 2 * pair + (s == 6 ? 1 : 0));
#endif
        } else if (s == 5 || s == 8) {
#if PHON(5)
            const bf16_t* Bt = (const bf16_t*)(PWS + (s == 5 ? WS_WOUTE : WS_WOUTO)) + (size_t)pair * 1024 * 1024;
            run_gemm_res(p, cx, lds, Bt, 2 * pair + (s == 8 ? 1 : 0));
#endif
        } else if (s == 1) {
#if PHON(1)
            phase_even_prep(p, cx, pair, lds);
#endif
        } else if (s == 2) {
#if PHON(2)
            phase_scan(p, cx, pair, lds);
#endif
        } else if (s == 4) {
#if PHON(4)
            phase_even_post(p, cx, pair);
#endif
        } else if (s == 7) {
#if PHON(7)
            phase_odd_mixer(p, cx, pair, lds);
#endif
        } else if (s == 100) {
#if PHON(10)
            phase_prepass(p, cx, lds);
#endif
        } else {
#if PHON(11)
            phase_final(p, cx);
#endif
        }
    }
}

extern "C" void kernel_launch(void* const* d_in, const int* in_sizes, int n_in, void* d_out, int out_size, void* d_ws, size_t ws_size, hipStream_t stream) {
    static int grid = 0;
    if (grid == 0) {
        if (n_in != 29 || ws_size < WS_END) { fprintf(stderr, "kernel_launch: unexpected n_in %d / ws_size %zu (need %zu)\n", n_in, ws_size, (size_t)WS_END); grid = -1; return; }
        int dev = 0, cus = 0, per_cu = 0;
        hipGetDevice(&dev);
        hipDeviceGetAttribute(&cus, hipDeviceAttributeMultiprocessorCount, dev);
        if (hipFuncSetAttribute((const void*)fwd_kernel, hipFuncAttributeMaxDynamicSharedMemorySize, LDS_BYTES) != hipSuccess) { fprintf(stderr, "kernel_launch: hipFuncSetAttribute failed\n"); grid = -1; return; }
        if (hipOccupancyMaxActiveBlocksPerMultiprocessor(&per_cu, (const void*)fwd_kernel, 512, LDS_BYTES) != hipSuccess || per_cu < 1) { fprintf(stderr, "kernel_launch: occupancy query gave %d\n", per_cu); per_cu = 1; }
        (void)hipGetLastError();
        grid = cus * per_cu;
        if (grid > 256) grid = 256;
    }
    if (grid < 0) return;
    Params p{};
    for (int i = 0; i < 29; ++i) p.ptr[i] = d_in[i];
    p.ptr[29] = d_out; p.ptr[30] = d_ws; p.ptr[31] = nullptr;
    (void)hipMemsetAsync((unsigned char*)d_ws + WS_BAR, 0, 16384, stream);
#if ONE_LAUNCH
    p.ph_lo = 0; p.ph_hi = N_PHASES;
    void* args[] = {&p};
    hipError_t e = hipLaunchCooperativeKernel((const void*)fwd_kernel, dim3(grid), dim3(512), args, LDS_BYTES, stream);
    if (e != hipSuccess) fprintf(stderr, "cooperative launch failed: %s (grid %d)\n", hipGetErrorString(e), grid);
#else
    for (int ph = 0; ph < N_PHASES; ++ph) {
        p.ph_lo = ph; p.ph_hi = ph + 1;
        hipLaunchKernelGGL(fwd_kernel, dim3(grid), dim3(512), LDS_BYTES, stream, p);
    }
#endif
}
```

```cpp
#include <hip/hip_runtime.h>
#include <hip/hip_cooperative_groups.h>
#include <cstdio>
namespace cg = cooperative_groups;

#ifndef ONE_LAUNCH
#define ONE_LAUNCH 1
#endif

#define LAS __attribute__((address_space(3)))
typedef unsigned short bf16_t;
typedef short bf16x8 __attribute__((ext_vector_type(8)));
typedef float f32x4 __attribute__((ext_vector_type(4)));
typedef unsigned u32x4 __attribute__((ext_vector_type(4)));
typedef unsigned u32x2 __attribute__((ext_vector_type(2)));

constexpr int NTOK = 17408, NTP = 16384;
constexpr int LDB = 1792;
constexpr int LDA = 2560;
constexpr size_t O_CONVP = 17825792, O_CONVS = 17842176, O_SHIFTP = 18104320, O_SHIFTS = 18130944, O_WKVP = 18556928, O_WKVS = 19081216,
                 O_POOLP = 27469824, O_POOLS = 27592704, O_CHUNKV = 29558784;
constexpr size_t WS_WINE = 0;
constexpr size_t WS_WOUTE = WS_WINE + 2ull * 4352 * 1024 * 2;
constexpr size_t WS_WINO = WS_WOUTE + 2ull * 1024 * 1024 * 2;
constexpr size_t WS_WOUTO = WS_WINO + 2ull * 2560 * 1024 * 2;
constexpr size_t WS_W2T = WS_WOUTO + 2ull * 1024 * 1024 * 2;
constexpr size_t WS_A2T = WS_W2T + 2ull * 512 * 64 * 2;
constexpr size_t WS_POOLWT = WS_A2T + 2ull * 512 * 64 * 2;
constexpr size_t WS_SPW = WS_POOLWT + 8ull * 128 * 128 * 2;
constexpr size_t WS_XB = WS_SPW + 8ull * 128 * 128 * 2;
constexpr size_t WS_YCAT = WS_XB + (size_t)NTOK * 1024 * 2;
constexpr size_t WS_SSQ = WS_YCAT + (size_t)NTOK * 1024 * 2;
constexpr size_t WS_Y = WS_SSQ + 5ull * NTOK * 16 * 4;
constexpr size_t WS_R1 = WS_Y + (size_t)NTOK * 512 * 4;
constexpr size_t WS_PROJB = WS_R1;
constexpr size_t WS_WDEC = WS_PROJB + (size_t)NTOK * LDB * 2;
constexpr size_t WS_AA = WS_WDEC + (size_t)NTOK * 512 * 4;
constexpr size_t WS_BAR = WS_AA + (size_t)NTOK * 512 * 2;
constexpr size_t WS_END = WS_BAR + 16384;
constexpr int LDS_MAIN = 147456;
constexpr int LDS_BYTES = LDS_MAIN + 16;

struct Params {
    const void* ptr[32];
    int ph_lo, ph_hi;
};
struct Ctx { int tid, bid, nblk, z; };
#define PIN(i) ((const float*)p.ptr[(i) + cx.z])
#define POUT ((float*)p.ptr[29 + cx.z])
#define PWS ((unsigned char*)p.ptr[30 + cx.z])
enum { I_XP = 0, I_XS, I_SCONV, I_SSHIFT, I_SWKV, I_SPOOL, I_NORMW, I_FNORMW, I_WINE, I_CONVW, I_MU, I_W0, I_W2, I_A0, I_A2, I_KK, I_KA, I_RK, I_GNG, I_GNB,
       I_WOUTE, I_WINO, I_POOLW, I_PSCALE, I_LNG, I_LNB, I_SPW, I_SPB, I_WOUTO };

__device__ __forceinline__ unsigned cvt_pk_bf16(float lo, float hi) { unsigned r; asm("v_cvt_pk_bf16_f32 %0, %1, %2" : "=v"(r) : "v"(lo), "v"(hi)); return r; }
__device__ __forceinline__ float bf_lo(unsigned u) { return __uint_as_float(u << 16); }
__device__ __forceinline__ float bf_hi(unsigned u) { return __uint_as_float(u & 0xffff0000u); }
__device__ __forceinline__ float bf2f(bf16_t b) { return __uint_as_float(((unsigned)b) << 16); }
__device__ __forceinline__ f32x4 cvt4(u32x2 u) { return (f32x4){bf_lo(u.x), bf_hi(u.x), bf_lo(u.y), bf_hi(u.y)}; }
__device__ __forceinline__ f32x4 ld_bf4(const bf16_t* p) { return cvt4(*(const u32x2*)p); }
__device__ __forceinline__ void st_bf4(bf16_t* p, f32x4 v) { u32x2 u; u.x = cvt_pk_bf16(v[0], v[1]); u.y = cvt_pk_bf16(v[2], v[3]); *(u32x2*)p = u; }
__device__ __forceinline__ float sigmoidf_(float x) { return 1.0f / (1.0f + __expf(-x)); }
__device__ __forceinline__ float siluf_(float x) { return x / (1.0f + __expf(-x)); }
template <int CTRL> __device__ __forceinline__ float dpp_f(float x) { return __builtin_bit_cast(float, __builtin_amdgcn_mov_dpp(__builtin_bit_cast(int, x), CTRL, 0xf, 0xf, true)); }
__device__ __forceinline__ float allsum16(float x) { x += dpp_f<0xB1>(x); x += dpp_f<0x4E>(x); x += dpp_f<0x141>(x); x += dpp_f<0x128>(x); return x; }
__device__ __forceinline__ float allsum4(float x) { x += dpp_f<0xB1>(x); x += dpp_f<0x4E>(x); return x; }
__device__ __forceinline__ float dot4(f32x4 a, f32x4 b) { return a[0] * b[0] + a[1] * b[1] + a[2] * b[2] + a[3] * b[3]; }

__device__ __forceinline__ float ssq_sum(const float* part) {
    const f32x4 a = *(const f32x4*)(part), b = *(const f32x4*)(part + 4), c = *(const f32x4*)(part + 8), d = *(const f32x4*)(part + 12);
    return ((a[0] + a[1]) + (a[2] + a[3])) + ((b[0] + b[1]) + (b[2] + b[3])) + ((c[0] + c[1]) + (c[2] + c[3])) + ((d[0] + d[1]) + (d[2] + d[3]));
}

namespace pg8 {
constexpr int BM = 256, BK = 64, HALF = 128, HTB = HALF * BK * 2, NXCD = 8, WGM = 8;
__device__ __forceinline__ int lds_byte(int r, int c) { const int st = (r >> 4) * 2 + (c >> 5), rr = r & 15, cc = c & 31, ob = rr * 64 + cc * 2; return st * 1024 + (ob ^ (((ob >> 9) & 1) << 5)); }
__device__ __forceinline__ void stage_rc(int b, int& R, int& C) { const int st = b / 1024, sb = b % 1024, swz = sb ^ (((sb >> 9) & 1) << 5); R = (st >> 1) * 16 + swz / 64; C = (st & 1) * 32 + (swz % 64) / 2; }
__device__ __forceinline__ int perm32(int rho) { const int n = rho >> 4, i = rho & 15; return 8 * (i >> 2) + 4 * n + (i & 3); }
struct Unit { int pm, pn; };
struct Gemm { const bf16_t* A; const bf16_t* Bt; int M, N, K; };
struct StaticOrder {
    int nM, nN, nwg, G, c;
    __device__ void init(int M, int N, int G_, int c_) { nM = M / BM; nN = N / BM; nwg = nM * nN; G = G_; c = c_; }
    __device__ bool next(int i, Unit& u) const {
        const long L = (long)i * G + c; if (L >= nwg) return false;
        int wgid = (int)L; { const int q = nwg / NXCD, r = nwg % NXCD, xcd = wgid % NXCD, off = wgid / NXCD; wgid = (xcd < r ? xcd * (q + 1) : r * (q + 1) + (xcd - r) * q) + off; }
        const int nig = WGM * nN, gid = wgid / nig, fm = gid * WGM, gsz = (nM - fm) < WGM ? (nM - fm) : WGM;
        u.pm = fm + ((wgid % nig) % gsz); u.pn = (wgid % nig) / gsz; return true;
    }
};

template <class Epi>
__device__ __forceinline__ void gemm_phase(const Ctx cx, LAS unsigned char* lds, const Gemm g, const StaticOrder& S, const Epi& E) {
    const int tid = cx.tid, wid = __builtin_amdgcn_readfirstlane(tid >> 6), lane = tid & 63, wr = wid >> 2, wc = wid & 3, fr = lane & 15, fq = lane >> 4;
    const int K = g.K, nt = K / BK;
    unsigned voffA[2], voffB[2];
#pragma unroll
    for (int i = 0; i < 2; ++i) { int R, C; stage_rc(tid * 16 + i * 8192, R, C); const int Rb = Epi::PERM ? ((R & ~31) + perm32(R & 31)) : R;
        voffA[i] = (unsigned)(R * K + C) * 2u; voffB[i] = (unsigned)(Rb * K + C) * 2u; }
    const size_t kstep = (size_t)(BK * 2);
    const size_t hstep = (size_t)HALF * K * 2;
    const size_t tstep = 2 * hstep;
    const unsigned ldsw = (unsigned)wid * 1024u;
    const int aoff = lds_byte(wr * 64 + fr, fq * 8), boff = lds_byte(wc * 32 + fr, fq * 8);
#define PG8_SA(b, h) (((b) * 2 + (h)) * HTB)
#define PG8_SB(b, h) ((4 + (b) * 2 + (h)) * HTB)
#define PG8_STAGE(bufoff, gbase, voff) do { _Pragma("unroll") for (int _i = 0; _i < 2; ++_i) \
        __builtin_amdgcn_global_load_lds((const unsigned*)((const char*)(gbase) + (voff)[_i]), (LAS unsigned*)(lds + (bufoff) + ldsw + _i * 8192), 16, 0, 0); } while (0)
#define PG8_LDA(dst, b, h) do { _Pragma("unroll") for (int m = 0; m < 4; ++m) _Pragma("unroll") for (int k = 0; k < 2; ++k) dst[m][k] = *(const LAS bf16x8*)(lds + PG8_SA(b, h) + aoff + m * 2048 + k * 1024); } while (0)
#define PG8_LDB(dst, b, h) do { _Pragma("unroll") for (int n = 0; n < 2; ++n) _Pragma("unroll") for (int k = 0; k < 2; ++k) dst[n][k] = *(const LAS bf16x8*)(lds + PG8_SB(b, h) + boff + n * 2048 + k * 1024); } while (0)
#define PG8_MMA(ai, bj, At, Bt) do { __builtin_amdgcn_s_setprio(1); _Pragma("unroll") for (int m = 0; m < 4; ++m) _Pragma("unroll") for (int n = 0; n < 2; ++n) _Pragma("unroll") for (int k = 0; k < 2; ++k) \
        acc[ai][bj][m][n] = __builtin_amdgcn_mfma_f32_16x16x32_bf16(Bt[n][k], At[m][k], acc[ai][bj][m][n], 0, 0, 0); __builtin_amdgcn_s_setprio(0); } while (0)
#define PG8_WAIT_V(n) asm volatile("s_waitcnt vmcnt(" #n ")" ::: "memory")
#define PG8_WAIT_L(n) asm volatile("s_waitcnt lgkmcnt(" #n ")" ::: "memory")
#define PG8_BAR __builtin_amdgcn_s_barrier()
#define PG8_SCHED __builtin_amdgcn_sched_barrier(0)
    Unit cur, nxt; int ui = 0;
    if (!S.next(0, cur)) return;
    f32x4 acc[2][2][4][2];
#pragma unroll
    for (int a = 0; a < 2; ++a)
#pragma unroll
        for (int b = 0; b < 2; ++b)
#pragma unroll
            for (int m = 0; m < 4; ++m)
#pragma unroll
                for (int n = 0; n < 2; ++n) acc[a][b][m][n] = (f32x4){0.f, 0.f, 0.f, 0.f};
    bf16x8 At[4][2], B0[2][2], B1[2][2];
    const char* cA = (const char*)g.A + (size_t)cur.pm * tstep; const char* cB = (const char*)g.Bt + (size_t)cur.pn * tstep;
    PG8_STAGE(PG8_SB(0, 0), cB, voffB); PG8_STAGE(PG8_SA(0, 0), cA, voffA); PG8_STAGE(PG8_SB(0, 1), cB + hstep, voffB); PG8_STAGE(PG8_SA(0, 1), cA + hstep, voffA);
    if (wr == 1) PG8_BAR;
    PG8_WAIT_V(4); PG8_BAR;
    PG8_STAGE(PG8_SB(1, 0), cB + kstep, voffB); PG8_STAGE(PG8_SA(1, 0), cA + kstep, voffA); PG8_STAGE(PG8_SB(1, 1), cB + hstep + kstep, voffB);
    PG8_WAIT_V(6); PG8_BAR;
    for (;;) {
        const bool has_next = S.next(ui + 1, nxt);
        const char* nA = has_next ? (const char*)g.A + (size_t)nxt.pm * tstep : cA; const char* nB = has_next ? (const char*)g.Bt + (size_t)nxt.pn * tstep : cB;
        for (int t = 0; t < nt; t += 2) {
            const bool last = (t == nt - 2);
            const char* a1 = cA + (size_t)(t + 1) * kstep;
            const char* a2 = last ? nA : cA + (size_t)(t + 2) * kstep; const char* b2 = last ? nB : cB + (size_t)(t + 2) * kstep;
            const char* a3 = a2 + kstep; const char* b3 = b2 + kstep;
            PG8_LDB(B0, 0, 0); PG8_SCHED; PG8_LDA(At, 0, 0); PG8_STAGE(PG8_SA(1, 1), a1 + hstep, voffA);
            PG8_WAIT_L(8); PG8_BAR; PG8_WAIT_L(0); PG8_MMA(0, 0, At, B0); PG8_BAR; PG8_SCHED;
            PG8_LDB(B1, 0, 1); PG8_STAGE(PG8_SB(0, 0), b2, voffB);
            PG8_BAR; PG8_WAIT_L(0); PG8_MMA(0, 1, At, B1); PG8_BAR;
            PG8_LDA(At, 0, 1); PG8_STAGE(PG8_SA(0, 0), a2, voffA);
            PG8_BAR; PG8_WAIT_L(0); PG8_MMA(1, 0, At, B0); PG8_BAR; PG8_SCHED;
            PG8_STAGE(PG8_SB(0, 1), b2 + hstep, voffB);
            PG8_WAIT_V(6); PG8_BAR; PG8_MMA(1, 1, At, B1); PG8_BAR;
            PG8_LDB(B0, 1, 0); PG8_SCHED; PG8_LDA(At, 1, 0); PG8_STAGE(PG8_SA(0, 1), a2 + hstep, voffA);
            PG8_WAIT_L(8); PG8_BAR; PG8_WAIT_L(0); PG8_MMA(0, 0, At, B0); PG8_BAR; PG8_SCHED;
            PG8_LDB(B1, 1, 1); PG8_STAGE(PG8_SB(1, 0), b3, voffB);
            PG8_BAR; PG8_WAIT_L(0); PG8_MMA(0, 1, At, B1); PG8_BAR;
            PG8_LDA(At, 1, 1); PG8_STAGE(PG8_SA(1, 0), a3, voffA);
            PG8_BAR; PG8_WAIT_L(0); PG8_MMA(1, 0, At, B0); PG8_BAR; PG8_SCHED;
            PG8_STAGE(PG8_SB(1, 1), b3 + hstep, voffB);
            PG8_WAIT_V(6); PG8_BAR; PG8_MMA(1, 1, At, B1); PG8_BAR;
        }
        E(acc, cur, wr, wc, fr, fq);
        if (!has_next) break;
#pragma unroll
        for (int a = 0; a < 2; ++a)
#pragma unroll
            for (int b = 0; b < 2; ++b)
#pragma unroll
                for (int m = 0; m < 4; ++m)
#pragma unroll
                    for (int n = 0; n < 2; ++n) acc[a][b][m][n] = (f32x4){0.f, 0.f, 0.f, 0.f};
        cur = nxt; cA = nA; cB = nB; ++ui;
    }
    PG8_WAIT_V(0);
    if (wr == 0) PG8_BAR;
    PG8_BAR;
#undef PG8_SA
#undef PG8_SB
#undef PG8_STAGE
#undef PG8_LDA
#undef PG8_LDB
#undef PG8_MMA
#undef PG8_WAIT_V
#undef PG8_WAIT_L
#undef PG8_BAR
#undef PG8_SCHED
}
}

struct EpiProj {
    static constexpr bool PERM = true;
    bf16_t* O; int ldc; LAS const float* rl; int pm0, pm1, pm2, pm3;
    __device__ __forceinline__ void operator()(const f32x4 (&acc)[2][2][4][2], const pg8::Unit& u, int wr, int wc, int fr, int fq) const {
        const int row0 = u.pm * 256 + wr * 64 + fr, col0 = u.pn * 256 + wc * 32 + 8 * fq;
        const int sel = u.pm == pm0 ? 0 : (u.pm == pm1 ? 1 : (u.pm == pm2 ? 2 : 3));
        LAS const float* rp = rl + sel * 256 + wr * 64 + fr;
#pragma unroll
        for (int ai = 0; ai < 2; ++ai)
#pragma unroll
            for (int m = 0; m < 4; ++m) {
                const int row = row0 + ai * 128 + m * 16;
                const float rstd = rp[ai * 128 + m * 16];
                bf16_t* rowp = O + (size_t)row * ldc + col0;
#pragma unroll
                for (int bj = 0; bj < 2; ++bj) {
                    const f32x4 v0 = acc[ai][bj][m][0] * rstd, v1 = acc[ai][bj][m][1] * rstd;
                    u32x4 w; w.x = cvt_pk_bf16(v0[0], v0[1]); w.y = cvt_pk_bf16(v0[2], v0[3]); w.z = cvt_pk_bf16(v1[0], v1[1]); w.w = cvt_pk_bf16(v1[2], v1[3]);
                    *(u32x4*)(rowp + bj * 128) = w;
                }
            }
    }
};
struct X8 { f32x4 lo, hi; };
template <bool FIRST> __device__ __forceinline__ X8 ld_x8(const float* __restrict__ s32, const bf16_t* __restrict__ s16, size_t o) {
    X8 r;
    if (FIRST) { r.lo = *(const f32x4*)(s32 + o); r.hi = *(const f32x4*)(s32 + o + 4); }
    else { const u32x4 u = *(const u32x4*)(s16 + o); r.lo = cvt4((u32x2){u.x, u.y}); r.hi = cvt4((u32x2){u.z, u.w}); }
    return r;
}
__device__ __forceinline__ void st_x8(bf16_t* p, f32x4 lo, f32x4 hi) { u32x4 w; w.x = cvt_pk_bf16(lo[0], lo[1]); w.y = cvt_pk_bf16(lo[2], lo[3]); w.z = cvt_pk_bf16(hi[0], hi[1]); w.w = cvt_pk_bf16(hi[2], hi[3]); *(u32x4*)p = w; }
template <bool FIRST>
__device__ __forceinline__ void epi_res_rows(const f32x4 (&acc)[2][2][4][2], const float* __restrict__ src32, const bf16_t* __restrict__ src16, bf16_t* __restrict__ Xb, float* __restrict__ ssqp,
                                             int row0, int col0, int slot, int fq) {
    X8 x[2][2];
#pragma unroll
    for (int bj = 0; bj < 2; ++bj) x[0][bj] = ld_x8<FIRST>(src32, src16, (size_t)row0 * 1024 + col0 + bj * 128);
#pragma unroll
    for (int gi = 0; gi < 8; ++gi) {
        const int ai = gi >> 2, m = gi & 3, row = row0 + ai * 128 + m * 16;
        if (gi + 1 < 8) {
            const int nrow = row0 + ((gi + 1) >> 2) * 128 + ((gi + 1) & 3) * 16;
#pragma unroll
            for (int bj = 0; bj < 2; ++bj) x[(gi + 1) & 1][bj] = ld_x8<FIRST>(src32, src16, (size_t)nrow * 1024 + col0 + bj * 128);
        }
        float part = 0.f;
#pragma unroll
        for (int bj = 0; bj < 2; ++bj) {
            const f32x4 lo = x[gi & 1][bj].lo + acc[ai][bj][m][0], hi = x[gi & 1][bj].hi + acc[ai][bj][m][1];
            st_x8(Xb + (size_t)row * 1024 + col0 + bj * 128, lo, hi);
            part += dot4(lo, lo) + dot4(hi, hi);
        }
        part += __shfl_xor(part, 16); part += __shfl_xor(part, 32);
        if (fq == 0) ssqp[(size_t)row * 16 + slot] = part;
    }
}
struct EpiRes {
    static constexpr bool PERM = true;
    const float* xp; const float* xs; bf16_t* Xb; float* ssq_next;
    __device__ __forceinline__ void operator()(const f32x4 (&acc)[2][2][4][2], const pg8::Unit& u, int wr, int wc, int fr, int fq) const {
        const int row0 = u.pm * 256 + wr * 64 + fr, col0 = u.pn * 256 + wc * 32 + 8 * fq;
        if (xp) epi_res_rows<true>(acc, row0 < NTP ? xp : xs - (size_t)NTP * 1024, nullptr, Xb, ssq_next, row0, col0, u.pn * 4 + wc, fq);
        else epi_res_rows<false>(acc, nullptr, Xb, Xb, ssq_next, row0, col0, u.pn * 4 + wc, fq);
    }
};

template <bool FIRST>
__device__ __forceinline__ void res_sample_tile(const Ctx cx, const bf16_t* __restrict__ A, const bf16_t* __restrict__ Bt, const float* __restrict__ xs, bf16_t* __restrict__ Xb, float* __restrict__ ssqp, int tile) {
    const int tid = cx.tid, wid = tid >> 6, lane = tid & 63, fr = lane & 15, fq = lane >> 4;
    const int tm = tile >> 3, tn = tile & 7;
    const int r0 = NTP + tm * 64 + (wid & 3) * 16, c0 = tn * 128 + (wid >> 2) * 64;
    const bf16_t* ap = A + (size_t)(r0 + fr) * 1024 + fq * 8;
    const bf16_t* bp = Bt + (size_t)(c0 + fr) * 1024 + fq * 8;
    f32x4 acc[4];
#pragma unroll
    for (int nt = 0; nt < 4; ++nt) acc[nt] = (f32x4){0.f, 0.f, 0.f, 0.f};
#pragma unroll 8
    for (int ks = 0; ks < 32; ++ks) {
        const bf16x8 af = *(const bf16x8*)(ap + ks * 32);
#pragma unroll
        for (int nt = 0; nt < 4; ++nt) {
            const bf16x8 bf = *(const bf16x8*)(bp + (size_t)nt * 16 * 1024 + ks * 32);
            acc[nt] = __builtin_amdgcn_mfma_f32_16x16x32_bf16(bf, af, acc[nt], 0, 0, 0);
        }
    }
    const int row = r0 + fr;
    float part = 0.f;
#pragma unroll
    for (int nt = 0; nt < 4; ++nt) {
        const int col = c0 + nt * 16 + fq * 4;
        const f32x4 xo = FIRST ? *(const f32x4*)(xs + (size_t)(row - NTP) * 1024 + col) : ld_bf4(Xb + (size_t)row * 1024 + col);
        const f32x4 v = xo + acc[nt];
        st_bf4(Xb + (size_t)row * 1024 + col, v);
        part += dot4(v, v);
    }
    part += __shfl_xor(part, 16); part += __shfl_xor(part, 32);
    if (fq == 0) ssqp[(size_t)row * 16 + (c0 >> 6)] = part;
}

__device__ __forceinline__ void tr_tile(const Ctx cx, LAS float* T, const float* src, int ld, int col0, int k0, bf16_t* dst, int Ktot, int drow0, const float* scale, bool zero) {
    const int tid = cx.tid;
    if (zero) {
        const int n = tid >> 3, kc = (tid & 7) * 8;
        *(u32x4*)(dst + (size_t)(drow0 + n) * Ktot + k0 + kc) = (u32x4){0u, 0u, 0u, 0u};
        return;
    }
#pragma unroll
    for (int pass = 0; pass < 2; ++pass) {
        const int kk = (tid >> 4) + pass * 32, nn = (tid & 15) * 4;
        f32x4 v = *(const f32x4*)(src + (size_t)(k0 + kk) * ld + col0 + nn);
        if (scale) v = v * scale[k0 + kk];
        T[kk * 65 + nn] = v[0]; T[kk * 65 + nn + 1] = v[1]; T[kk * 65 + nn + 2] = v[2]; T[kk * 65 + nn + 3] = v[3];
    }
    __syncthreads();
    {
        const int n = tid >> 3, kc = (tid & 7) * 8;
        u32x4 w;
        w.x = cvt_pk_bf16(T[(kc + 0) * 65 + n], T[(kc + 1) * 65 + n]); w.y = cvt_pk_bf16(T[(kc + 2) * 65 + n], T[(kc + 3) * 65 + n]);
        w.z = cvt_pk_bf16(T[(kc + 4) * 65 + n], T[(kc + 5) * 65 + n]); w.w = cvt_pk_bf16(T[(kc + 6) * 65 + n], T[(kc + 7) * 65 + n]);
        *(u32x4*)(dst + (size_t)(drow0 + n) * Ktot + k0 + kc) = w;
    }
    __syncthreads();
}

__device__ void phase_prepass(const Params& p, const Ctx cx, LAS unsigned char* lds) {
    LAS float* T = (LAS float*)lds;
    const int tid = cx.tid;
    for (int job = cx.bid; job < 4544; job += cx.nblk) {
        int j = job;
        if (j < 2176) {
            const int i = j / 1088, r = j % 1088, nt = r / 16, kt = r % 16;
            const int n0 = nt * 64;
            int col0; bool zero = false;
            if (n0 < 2048) col0 = n0; else if (n0 < 2560) col0 = 3712 + (n0 - 2048); else if (n0 < 4224) col0 = 2048 + (n0 - 2560); else { col0 = 0; zero = true; }
            tr_tile(cx, T, PIN(I_WINE) + (size_t)i * 1024 * 4224, 4224, col0, kt * 64, (bf16_t*)(PWS + WS_WINE) + (size_t)i * 4352 * 1024, 1024, n0, PIN(I_NORMW) + (2 * i) * 1024, zero);
            continue;
        }
        j -= 2176;
        if (j < 512) { const int i = j / 256, r = j % 256, nt = r / 16, kt = r % 16;
            tr_tile(cx, T, PIN(I_WOUTE) + (size_t)i * 1024 * 1024, 1024, nt * 64, kt * 64, (bf16_t*)(PWS + WS_WOUTE) + (size_t)i * 1024 * 1024, 1024, nt * 64, nullptr, false); continue; }
        j -= 512;
        if (j < 1280) { const int i = j / 640, r = j % 640, nt = r / 16, kt = r % 16;
            tr_tile(cx, T, PIN(I_WINO) + (size_t)i * 1024 * 2560, 2560, nt * 64, kt * 64, (bf16_t*)(PWS + WS_WINO) + (size_t)i * 2560 * 1024, 1024, nt * 64, PIN(I_NORMW) + (2 * i + 1) * 1024, false); continue; }
        j -= 1280;
        if (j < 512) { const int i = j / 256, r = j % 256, nt = r / 16, kt = r % 16;
            tr_tile(cx, T, PIN(I_WOUTO) + (size_t)i * 1024 * 1024, 1024, nt * 64, kt * 64, (bf16_t*)(PWS + WS_WOUTO) + (size_t)i * 1024 * 1024, 1024, nt * 64, nullptr, false); continue; }
        j -= 512;
        if (j < 16) { const int i = j / 8, nt = j % 8;
            tr_tile(cx, T, PIN(I_W2) + (size_t)i * 64 * 512, 512, nt * 64, 0, (bf16_t*)(PWS + WS_W2T) + (size_t)i * 512 * 64, 64, nt * 64, nullptr, false); continue; }
        j -= 16;
        if (j < 16) { const int i = j / 8, nt = j % 8;
            tr_tile(cx, T, PIN(I_A2) + (size_t)i * 64 * 512, 512, nt * 64, 0, (bf16_t*)(PWS + WS_A2T) + (size_t)i * 512 * 64, 64, nt * 64, nullptr, false); continue; }
        j -= 16;
        { const int ig = j / 4, r = j % 4, nt = r / 2, kt = r % 2;
            tr_tile(cx, T, PIN(I_POOLW) + (size_t)ig * 128 * 128, 128, nt * 64, kt * 64, (bf16_t*)(PWS + WS_POOLWT) + (size_t)ig * 128 * 128, 128, nt * 64, nullptr, false); }
    }
    const int gtid = cx.bid * 512 + tid, gthreads = cx.nblk * 512;
    for (int e = gtid; e < 8 * 128 * 128; e += gthreads) {
        const int s = e & 127, t = (e >> 7) & 127;
        ((bf16_t*)(PWS + WS_SPW))[e] = (s <= t) ? (bf16_t)(cvt_pk_bf16(PIN(I_SPW)[e], 0.f) & 0xffffu) : (bf16_t)0;
    }
    const int wid = tid >> 6, lane = tid & 63;
    for (int row = cx.bid * 8 + wid; row < NTOK; row += cx.nblk * 8) {
        const float* src = row < NTP ? PIN(I_XP) + (size_t)row * 1024 : PIN(I_XS) + (size_t)(row - NTP) * 1024;
        bf16_t* dst = (bf16_t*)(PWS + WS_XB) + (size_t)row * 1024;
        float ss = 0.f;
#pragma unroll
        for (int i = 0; i < 4; ++i) { const f32x4 v = *(const f32x4*)(src + i * 256 + lane * 4); ss += dot4(v, v); st_bf4(dst + i * 256 + lane * 4, v); }
#pragma unroll
        for (int o = 32; o >= 1; o >>= 1) ss += __shfl_xor(ss, o);
        if (lane < 16) ((float*)(PWS + WS_SSQ))[(size_t)row * 16 + lane] = (lane == 0) ? ss : 0.f;
    }
}

__device__ __forceinline__ f32x4 shift4(const bf16_t* cur, bool hp, const float* st, int col, const float* mu) {
    const f32x4 q = ld_bf4(cur + col);
    f32x4 pv;
    if (hp) pv = ld_bf4(cur - LDB + col); else if (st) pv = *(const f32x4*)(st + col); else pv = (f32x4){0.f, 0.f, 0.f, 0.f};
    const f32x4 m = *(const f32x4*)(mu + col);
    return q + m * (pv - q);
}

__device__ void phase_even_prep(const Params& p, const Ctx cx, int pair, LAS unsigned char* lds) {
    const int tid = cx.tid, wid = tid >> 6, lane = tid & 63, fr = lane & 15, fq = lane >> 4;
    const bf16_t* PB = (const bf16_t*)(PWS + WS_PROJB);
    float* Wdec = (float*)(PWS + WS_WDEC);
    bf16_t* Aa = (bf16_t*)(PWS + WS_AA);
    bf16_t* Ycat = (bf16_t*)(PWS + WS_YCAT);
    const float* mu_ = PIN(I_MU) + pair * 1664;
    const float* w0_ = PIN(I_W0) + pair * 512; const float* a0_ = PIN(I_A0) + pair * 512;
    const float* k_a_ = PIN(I_KA) + pair * 512; const float* r_k_ = PIN(I_RK) + pair * 512;
    constexpr int RS = 3344;
    constexpr int TB = 17 * RS;
    constexpr int NCH = 17 * 208;
    const int h = wid;
    bf16x8 wfr[4][2], afr[4][2];
    {
        const bf16_t* W2T = (const bf16_t*)(PWS + WS_W2T) + (size_t)pair * 512 * 64;
        const bf16_t* A2T = (const bf16_t*)(PWS + WS_A2T) + (size_t)pair * 512 * 64;
#pragma unroll
        for (int nt = 0; nt < 4; ++nt)
#pragma unroll
            for (int ks = 0; ks < 2; ++ks) {
                wfr[nt][ks] = *(const bf16x8*)(W2T + (size_t)(h * 64 + nt * 16 + fr) * 64 + ks * 32 + fq * 8);
                afr[nt][ks] = *(const bf16x8*)(A2T + (size_t)(h * 64 + nt * 16 + fr) * 64 + ks * 32 + fq * 8);
            }
    }
    constexpr int buf = 0;
    for (int tile = cx.bid; tile < NTOK / 16; tile += cx.nblk) {
        int zz; asm volatile("v_mov_b32 %0, 0" : "=v"(zz));
        const int tidv = tid + zz, fr = (tidv & 15), fq = (tidv >> 4) & 3;
        {
            const int r0_ = tile * 16;
#pragma unroll
            for (int i_ = 0; i_ < 7; ++i_) {
                const int c_ = tidv + i_ * 512;
                if (c_ < NCH) { const int lr_ = c_ / 208, cc_ = c_ % 208; int gr_ = r0_ - 1 + lr_; gr_ = gr_ < 0 ? 0 : gr_;
                    *(LAS u32x4*)(lds + lr_ * RS + cc_ * 16) = *(const u32x4*)(PB + (size_t)gr_ * LDB + cc_ * 8); }
            }
        }
        __syncthreads();
        {
            const int row = tile * 16 + fr;
            const bool samp = row >= NTP;
            int b, t; if (!samp) { b = row >> 11; t = row & 2047; } else { const int q = row - NTP; b = q >> 3; t = q & 7; }
            const bool hp = t > 0;
            const float* st = samp ? PIN(I_SSHIFT) + ((size_t)pair * 128 + b) * 1664 : nullptr;
            const float* mu = mu_ + zz; const float* w0 = w0_ + zz; const float* a0 = a0_ + zz; const float* k_a = k_a_ + zz; const float* r_k = r_k_ + zz;
            LAS const unsigned char* curL = lds + buf * TB + (fr + 1) * RS;
            LAS const unsigned char* prvL = lds + buf * TB + fr * RS;
            auto sh4 = [&](int col) -> f32x4 {
                const f32x4 q = cvt4(*(LAS const u32x2*)(curL + col * 2));
                f32x4 pv;
                if (hp) pv = cvt4(*(LAS const u32x2*)(prvL + col * 2)); else if (st) pv = *(const f32x4*)(st + col); else pv = (f32x4){0.f, 0.f, 0.f, 0.f};
                const f32x4 m = *(const f32x4*)(mu + col);
                return q + m * (pv - q);
            };
            bf16x8 Aw[2], Al[2];
#pragma unroll
            for (int ks = 0; ks < 2; ++ks) {
                const int cw = 1536 + ks * 32 + fq * 8, ca = 1600 + ks * 32 + fq * 8;
                const f32x4 w_lo = sh4(cw), w_hi = sh4(cw + 4), a_lo = sh4(ca), a_hi = sh4(ca + 4);
                u32x4 pw, pa;
                float th[8];
#pragma unroll
                for (int j = 0; j < 4; ++j) { th[j] = 2.0f * sigmoidf_(2.0f * w_lo[j]) - 1.0f; th[4 + j] = 2.0f * sigmoidf_(2.0f * w_hi[j]) - 1.0f; }
                pw.x = cvt_pk_bf16(th[0], th[1]); pw.y = cvt_pk_bf16(th[2], th[3]); pw.z = cvt_pk_bf16(th[4], th[5]); pw.w = cvt_pk_bf16(th[6], th[7]);
                pa.x = cvt_pk_bf16(a_lo[0], a_lo[1]); pa.y = cvt_pk_bf16(a_lo[2], a_lo[3]); pa.z = cvt_pk_bf16(a_hi[0], a_hi[1]); pa.w = cvt_pk_bf16(a_hi[2], a_hi[3]);
                Aw[ks] = __builtin_bit_cast(bf16x8, pw); Al[ks] = __builtin_bit_cast(bf16x8, pa);
            }
            float bon = 0.f;
#pragma unroll
            for (int nt = 0; nt < 4; ++nt) {
                f32x4 lw = (f32x4){0.f, 0.f, 0.f, 0.f}, la = (f32x4){0.f, 0.f, 0.f, 0.f};
#pragma unroll
                for (int ks = 0; ks < 2; ++ks) {
                    lw = __builtin_amdgcn_mfma_f32_16x16x32_bf16(wfr[nt][ks], Aw[ks], lw, 0, 0, 0);
                    la = __builtin_amdgcn_mfma_f32_16x16x32_bf16(afr[nt][ks], Al[ks], la, 0, 0, 0);
                }
                const int ch = h * 64 + nt * 16 + fq * 4;
                const f32x4 r4 = sh4(ch), k4 = sh4(512 + ch);
                const f32x4 w04 = *(const f32x4*)(w0 + ch), a04 = *(const f32x4*)(a0 + ch), ka4 = *(const f32x4*)(k_a + ch), rk4 = *(const f32x4*)(r_k + ch);
                f32x4 dec, av;
#pragma unroll
                for (int j = 0; j < 4; ++j) {
                    const float z_ = -(w04[j] + lw[j]);
                    const float wlog = -__logf(1.0f + __expf(z_)) - 0.5f;
                    dec[j] = __expf(-__expf(wlog));
                    av[j] = sigmoidf_(a04[j] + la[j]);
                    const float kp = k4[j] * (1.0f + (av[j] - 1.0f) * ka4[j]);
                    bon += r4[j] * kp * rk4[j];
                }
                *(f32x4*)(Wdec + (size_t)row * 512 + ch) = dec;
                st_bf4(Aa + (size_t)row * 512 + ch, av);
            }
            bon += __shfl_xor(bon, 16); bon += __shfl_xor(bon, 32);
#pragma unroll
            for (int nt = 0; nt < 4; ++nt) { const int ch = h * 64 + nt * 16 + fq * 4; st_bf4(Ycat + (size_t)row * 1024 + 512 + ch, sh4(1024 + ch) * bon); }
        }
        __syncthreads();
    }
    const int gtid = cx.bid * 512 + tid, gthreads = cx.nblk * 512;
    for (int e = gtid; e < 136 * 1664; e += gthreads) {
        const int sr = e / 1664, c = e % 1664;
        if (sr < 8) POUT[O_SHIFTP + ((size_t)pair * 8 + sr) * 1664 + c] = bf2f(PB[(size_t)(sr * 2048 + 2047) * LDB + c]);
        else { const int b = sr - 8; POUT[O_SHIFTS + ((size_t)pair * 128 + b) * 1664 + c] = bf2f(PB[(size_t)(NTP + b * 8 + 7) * LDB + c]); }
    }
}

typedef float f32x2 __attribute__((ext_vector_type(2)));
template <bool RED = true>
__device__ __forceinline__ void scan_step(f32x4& S, const f32x4 w, const f32x4 k, const f32x4 kk, const f32x4 nb, const f32x4 r, const float v, float& y) {
    const f32x2 S01 = {S[0], S[1]}, S23 = {S[2], S[3]};
    f32x2 pp = S01 * (f32x2){kk[0], kk[1]};
    pp = S23 * (f32x2){kk[2], kk[3]} + pp;
    float pd = pp[0] + pp[1];
    const f32x2 vv = {v, v};
    const f32x2 t01 = S01 * (f32x2){w[0], w[1]} + (f32x2){k[0], k[1]} * vv;
    const f32x2 t23 = S23 * (f32x2){w[2], w[3]} + (f32x2){k[2], k[3]} * vv;
    pd = allsum16(pd);
    const f32x2 pdv = {pd, pd};
    const f32x2 n01 = (f32x2){nb[0], nb[1]} * pdv + t01, n23 = (f32x2){nb[2], nb[3]} * pdv + t23;
    S = (f32x4){n01[0], n01[1], n23[0], n23[1]};
    f32x2 q = n01 * (f32x2){r[0], r[1]};
    q = n23 * (f32x2){r[2], r[3]} + q;
    y = RED ? allsum16(q[0] + q[1]) : (q[0] + q[1]);
}
__device__ __forceinline__ float reduce_scatter16(const float (&yp)[16], int cgi) {
    const bool b3 = cgi & 8, b2 = cgi & 4, b1 = cgi & 2, b0 = cgi & 1;
    float a[8], bq[4], c[2];
#pragma unroll
    for (int j = 0; j < 8; ++j) { const float keep = b3 ? yp[8 + j] : yp[j], send = b3 ? yp[j] : yp[8 + j]; a[j] = keep + dpp_f<0x128>(send); }
#pragma unroll
    for (int k = 0; k < 4; ++k) { const float keep = b2 ? a[4 + k] : a[k], send = b2 ? a[k] : a[4 + k]; bq[k] = keep + dpp_f<0x141>(send); }
#pragma unroll
    for (int m = 0; m < 2; ++m) { const float keep = b1 ? bq[2 + m] : bq[m], send = b1 ? bq[m] : bq[2 + m]; c[m] = keep + dpp_f<0x4E>(send); }
    const float keep = b0 ? c[1] : c[0], send = b0 ? c[0] : c[1];
    return keep + dpp_f<0xB1>(send);
}

__device__ void phase_scan(const Params& p, const Ctx cx, int pair, LAS unsigned char* lds) {
    const int tid = cx.tid, wid = tid >> 6, lane = tid & 63, rs = lane >> 4, cgi = lane & 15;
    const bf16_t* PB = (const bf16_t*)(PWS + WS_PROJB);
    const float* Wdec = (const float*)(PWS + WS_WDEC);
    const bf16_t* Aa = (const bf16_t*)(PWS + WS_AA);
    float* Y = (float*)(PWS + WS_Y);
    const float* mu = PIN(I_MU) + pair * 1664;
    const float* k_k = PIN(I_KK) + pair * 512; const float* k_a = PIN(I_KA) + pair * 512;
    {
        LAS float* vb = (LAS float*)lds + wid * 3072;
        for (int st = cx.bid * 8 + wid; st < 2048; st += cx.nblk * 8) {
            const int bh = st >> 1, half = st & 1, b = bh >> 3, h = bh & 7, ch = h * 64 + cgi * 4;
            const float* stp = PIN(I_SSHIFT) + ((size_t)pair * 128 + b) * 1664;
            const f32x4 kkc = *(const f32x4*)(k_k + ch), kac = *(const f32x4*)(k_a + ch);
            {
#pragma unroll
                for (int tt = 0; tt < 2; ++tt) {
                    const int t = rs + tt * 4;
                    const size_t row = NTP + b * 8 + t;
                    const bf16_t* cur = PB + row * LDB;
                    const f32x4 r = shift4(cur, t > 0, stp, ch, mu), k = shift4(cur, t > 0, stp, 512 + ch, mu), v = shift4(cur, t > 0, stp, 1024 + ch, mu);
                    const f32x4 a = ld_bf4(Aa + row * 512 + ch);
                    const f32x4 w = *(const f32x4*)(Wdec + row * 512 + ch);
                    const f32x4 kkv = k * kkc;
                    const float ss = allsum16(dot4(kkv, kkv));
                    const float inv = 1.0f / fmaxf(sqrtf(ss), 1e-12f);
                    const f32x4 kkn = kkv * inv;
                    LAS float* o = vb + t * 384 + cgi * 4;
                    *(LAS f32x4*)(o) = w; *(LAS f32x4*)(o + 64) = k * (1.0f + (a - 1.0f) * kac); *(LAS f32x4*)(o + 128) = kkn; *(LAS f32x4*)(o + 192) = -(kkn * a);
                    *(LAS f32x4*)(o + 256) = r; *(LAS f32x4*)(o + 320) = v;
                }
            }
            asm volatile("s_waitcnt lgkmcnt(0)" ::: "memory");
            __builtin_amdgcn_wave_barrier();
#pragma unroll 1
            for (int rq = 0; rq < 8; ++rq) {
                const int ri = half * 32 + rq * 4 + rs;
                const size_t so = ((((size_t)pair * 128 + b) * 8 + h) * 64 + ri) * 64 + cgi * 4;
                f32x4 S = *(const f32x4*)(PIN(I_SWKV) + so);
#pragma unroll
                for (int t = 0; t < 8; ++t) {
                    LAS const float* r0 = vb + t * 384 + cgi * 4;
                    float y; scan_step(S, *(LAS const f32x4*)(r0), *(LAS const f32x4*)(r0 + 64), *(LAS const f32x4*)(r0 + 128), *(LAS const f32x4*)(r0 + 192), *(LAS const f32x4*)(r0 + 256), vb[t * 384 + 320 + ri], y);
                    if (cgi == 0) Y[(size_t)(NTP + b * 8 + t) * 512 + h * 64 + ri] = y;
                }
                *(f32x4*)(POUT + O_WKVS + so) = S;
            }
            asm volatile("s_waitcnt lgkmcnt(0)" ::: "memory");
            __builtin_amdgcn_wave_barrier();
        }
    }
    __syncthreads();
    LAS float* rec = (LAS float*)lds;
    for (int pt = cx.bid; pt < 256; pt += cx.nblk) {
        const int xcd = pt & 7, slot = pt >> 3, bh = xcd * 8 + (slot >> 2), rg = slot & 3, b = bh >> 3, h = bh & 7;
        const int lt = tid - 256, ls = (lt >> 4) & 15, lcg = lt & 15, lch = h * 64 + lcg * 4;
        u32x2 qr = {0u, 0u}, qk = {0u, 0u}, qv = {0u, 0u}, pr = {0u, 0u}, pk = {0u, 0u}, pv = {0u, 0u}, qa = {0u, 0u};
        f32x4 qw = (f32x4){0.f, 0.f, 0.f, 0.f};
        f32x4 mur, muk, muv, kkc, kac;
        const int ri = rg * 16 + (wid & 3) * 4 + rs;
        f32x4 S = (f32x4){0.f, 0.f, 0.f, 0.f};
#define SCAN_ISSUE(c) do { const int t_ = (c) * 16 + ls; const size_t row_ = (size_t)b * 2048 + t_; const bf16_t* cur_ = PB + row_ * LDB; \
            qr = *(const u32x2*)(cur_ + lch); qk = *(const u32x2*)(cur_ + 512 + lch); qv = *(const u32x2*)(cur_ + 1024 + lch); \
            if (t_ > 0) { pr = *(const u32x2*)(cur_ - LDB + lch); pk = *(const u32x2*)(cur_ - LDB + 512 + lch); pv = *(const u32x2*)(cur_ - LDB + 1024 + lch); } \
            else { pr = (u32x2){0u, 0u}; pk = pr; pv = pr; } \
            qw = *(const f32x4*)(Wdec + row_ * 512 + lch); qa = *(const u32x2*)(Aa + row_ * 512 + lch); } while (0)
#define SCAN_PROCESS(buf) do { const f32x4 r0_ = cvt4(qr), k0_ = cvt4(qk), v0_ = cvt4(qv); \
            const f32x4 r_ = r0_ + mur * (cvt4(pr) - r0_), k_ = k0_ + muk * (cvt4(pk) - k0_), v_ = v0_ + muv * (cvt4(pv) - v0_), a_ = cvt4(qa); \
            const f32x4 kkv_ = k_ * kkc; const float ss_ = allsum16(dot4(kkv_, kkv_)); const float inv_ = __builtin_amdgcn_rsqf(fmaxf(ss_, 1e-24f)); \
            const f32x4 kkn_ = kkv_ * inv_; \
            LAS float* o_ = rec + (buf) * 6144 + ls * 384 + lcg * 4; \
            *(LAS f32x4*)(o_) = qw; *(LAS f32x4*)(o_ + 64) = k_ * (1.0f + (a_ - 1.0f) * kac); *(LAS f32x4*)(o_ + 128) = kkn_; *(LAS f32x4*)(o_ + 192) = -(kkn_ * a_); \
            *(LAS f32x4*)(o_ + 256) = r_; *(LAS f32x4*)(o_ + 320) = v_; } while (0)
        if (wid >= 4) {
            mur = *(const f32x4*)(mu + lch); muk = *(const f32x4*)(mu + 512 + lch); muv = *(const f32x4*)(mu + 1024 + lch);
            kkc = *(const f32x4*)(k_k + lch); kac = *(const f32x4*)(k_a + lch);
            SCAN_ISSUE(0); SCAN_PROCESS(0); SCAN_ISSUE(1);
        }
        __syncthreads();
        for (int c = 0; c < 128; ++c) {
            if (wid < 4) {
                LAS const float* rb = rec + (c & 1) * 6144 + cgi * 4;
                LAS const float* rv = rec + (c & 1) * 6144 + 320 + ri;
                float yp[16];
                f32x4 nw = *(LAS const f32x4*)(rb), nk = *(LAS const f32x4*)(rb + 64), nkk = *(LAS const f32x4*)(rb + 128), nb = *(LAS const f32x4*)(rb + 192), nr = *(LAS const f32x4*)(rb + 256);
                float nv = rv[0];
#pragma unroll
                for (int s = 0; s < 16; ++s) {
                    const f32x4 cw = nw, ck = nk, ckk = nkk, cb = nb, cr = nr; const float cv = nv;
                    if (s + 1 < 16) {
                        LAS const float* r1 = rb + (s + 1) * 384;
                        nw = *(LAS const f32x4*)(r1); nk = *(LAS const f32x4*)(r1 + 64); nkk = *(LAS const f32x4*)(r1 + 128); nb = *(LAS const f32x4*)(r1 + 192); nr = *(LAS const f32x4*)(r1 + 256);
                        nv = rv[(s + 1) * 384];
                    }
                    scan_step<false>(S, cw, ck, ckk, cb, cr, cv, yp[s]);
                }
                Y[((size_t)b * 2048 + c * 16 + cgi) * 512 + h * 64 + ri] = reduce_scatter16(yp, cgi);
            } else {
                if (c + 1 < 128) { SCAN_PROCESS((c + 1) & 1); if (c + 2 < 128) SCAN_ISSUE(c + 2); }
            }
            __syncthreads();
        }
        if (wid < 4) *(f32x4*)(POUT + O_WKVP + ((((size_t)pair * 8 + b) * 8 + h) * 64 + ri) * 64 + cgi * 4) = S;
#undef SCAN_ISSUE
#undef SCAN_PROCESS
    }
}

__device__ void phase_even_post(const Params& p, const Ctx cx, int pair) {
    const int gtid = cx.bid * 512 + cx.tid, gthreads = cx.nblk * 512;
    const bf16_t* PA = (const bf16_t*)(PWS + WS_R1);
    bf16_t* Ycat = (bf16_t*)(PWS + WS_YCAT);
    const float* Y = (const float*)(PWS + WS_Y);
    constexpr int NIT = NTOK * 128, UB = 4;
    const float* gn_g = PIN(I_GNG) + pair * 512; const float* gn_b = PIN(I_GNB) + pair * 512;
    for (int e0 = gtid; e0 < NIT; e0 += gthreads * UB) {
        f32x4 y[UB], bv[UB], bz[UB]; bool ok[UB];
#pragma unroll
        for (int u = 0; u < UB; ++u) {
            const int e = e0 + u * gthreads; ok[u] = e < NIT;
            const int ee = ok[u] ? e : e0; const int row = ee >> 7, ch = (ee & 127) * 4;
            y[u] = *(const f32x4*)(Y + (size_t)row * 512 + ch);
            bv[u] = ld_bf4(Ycat + (size_t)row * 1024 + 512 + ch);
            bz[u] = ld_bf4(PA + (size_t)row * LDA + 2048 + ch);
        }
#pragma unroll
        for (int u = 0; u < UB; ++u) {
            const int e = e0 + u * gthreads;
            const int ee = ok[u] ? e : e0; const int row = ee >> 7, ch = (ee & 127) * 4;
            const float mean = allsum16(y[u][0] + y[u][1] + y[u][2] + y[u][3]) * (1.0f / 64.0f);
            const f32x4 d = y[u] - mean;
            const float var = allsum16(dot4(d, d)) * (1.0f / 64.0f);
            const float rstd = rsqrtf(var + 64e-5f);
            const f32x4 g = *(const f32x4*)(gn_g + ch), bb = *(const f32x4*)(gn_b + ch);
            f32x4 o;
#pragma unroll
            for (int j = 0; j < 4; ++j) o[j] = (d[j] * rstd * g[j] + bb[j] + bv[u][j]) * siluf_(bz[u][j]);
            if (ok[u]) st_bf4(Ycat + (size_t)row * 1024 + 512 + ch, o);
        }
    }
    const float* cw = PIN(I_CONVW) + pair * 3 * 512;
    for (int e0 = gtid; e0 < NIT; e0 += gthreads * UB) {
        f32x4 h0[UB], c0v[UB], h1[UB], c1v[UB], h2[UB], c2v[UB], ab[UB], az[UB]; bool ok[UB];
#pragma unroll
        for (int u = 0; u < UB; ++u) {
            const int e = e0 + u * gthreads; ok[u] = e < NIT;
            const int ee = ok[u] ? e : e0; const int row = ee >> 7, ch = (ee & 127) * 4;
            const int t = row < NTP ? (row & 2047) : ((row - NTP) & 7);
            const bf16_t* cur = PA + (size_t)row * LDA + ch;
            const bf16_t* p1 = t >= 1 ? cur - LDA : cur; const bf16_t* p2 = t >= 2 ? cur - 2 * LDA : cur;
            h0[u] = ld_bf4(cur); c0v[u] = ld_bf4(cur + 1024); h1[u] = ld_bf4(p1); c1v[u] = ld_bf4(p1 + 1024); h2[u] = ld_bf4(p2); c2v[u] = ld_bf4(p2 + 1024);
            ab[u] = ld_bf4(cur + 512); az[u] = ld_bf4(cur + 1536);
        }
#pragma unroll
        for (int u = 0; u < UB; ++u) {
            const int e = e0 + u * gthreads;
            const int ee = ok[u] ? e : e0; const int row = ee >> 7, ch = (ee & 127) * 4;
            const bool samp = row >= NTP;
            int b, t, T; if (!samp) { b = row >> 11; t = row & 2047; T = 2048; } else { const int q = row - NTP; b = q >> 3; t = q & 7; T = 8; }
            const f32x4 u0 = c0v[u] * h0[u];
            f32x4 u1 = c1v[u] * h1[u], u2 = c2v[u] * h2[u];
            if (t < 2) {
                const f32x4 zero = (f32x4){0.f, 0.f, 0.f, 0.f};
                const float* hist = PIN(I_SCONV) + ((size_t)pair * 128 + (samp ? b : 0)) * 2 * 512 + ch;
                if (t == 0) { u1 = samp ? *(const f32x4*)(hist + 512) : zero; u2 = samp ? *(const f32x4*)(hist) : zero; }
                else { u2 = samp ? *(const f32x4*)(hist + 512) : zero; }
            }
            const f32x4 k0 = *(const f32x4*)(cw + ch), k1 = *(const f32x4*)(cw + 512 + ch), k2 = *(const f32x4*)(cw + 1024 + ch);
            const f32x4 conv = k0 * u2 + k1 * u1 + k2 * u0;
            f32x4 o;
#pragma unroll
            for (int j = 0; j < 4; ++j) o[j] = ab[u][j] * conv[j] * siluf_(az[u][j]);
            if (ok[u]) {
                st_bf4(Ycat + (size_t)row * 1024 + ch, o);
                if (t >= T - 2) {
                    float* dst = samp ? POUT + O_CONVS + (((size_t)pair * 128 + b) * 2 + (t - (T - 2))) * 512 + ch : POUT + O_CONVP + (((size_t)pair * 8 + b) * 2 + (t - (T - 2))) * 512 + ch;
                    *(f32x4*)dst = u0;
                }
            }
        }
    }
}

__device__ void phase_odd_mixer(const Params& p, const Ctx cx, int pair, LAS unsigned char* lds) {
    const int tid = cx.tid, wid = tid >> 6, lane = tid & 63, fr = lane & 15, fq = lane >> 4;
    const bf16_t* PO = (const bf16_t*)(PWS + WS_R1);
    bf16_t* Ycat = (bf16_t*)(PWS + WS_YCAT);
    LAS bf16_t* LA = (LAS bf16_t*)lds;
    LAS bf16_t* LB = (LAS bf16_t*)(lds + 128 * 136 * 2);
    LAS float* stat = (LAS float*)(lds + 2 * 128 * 136 * 2);
    LAS float* LE = (LAS float*)(lds + 128 * 136 * 2);
    LAS bf16_t* LW = (LAS bf16_t*)(lds + 128 * 136 * 2 + 143 * 128 * 4);
#ifdef MIXPROBE
    for (int rr = 0; rr < 16; ++rr) {
        const int round = rr & 7;
#else
    for (int round = 0; round < 8; ++round) {
#endif
        int it;
        if (cx.nblk == 256) {
            if (round == 0) it = cx.bid < 136 ? cx.bid : 136 + 136 + (cx.bid - 136);
            else if (round == 1) it = cx.bid < 136 ? 136 + cx.bid : 136 + 136 + 120 + (cx.bid - 136);
            else if (cx.bid >= 136) it = 136 + 136 + 120 * round + (cx.bid - 136);
            else it = 1 << 20;
        } else it = cx.bid + round * cx.nblk;
#ifdef MIXPROBE
        if (it >= 680) continue;
        if (rr >= 8 && ((MIXPROBE == 1) != (it < 136))) continue;
#else
        if (it >= 680) { if (cx.nblk == 256 ? round >= 4 : true) break; else continue; }
#endif
        if (it >= 136) {
            const int ci = it - 136, tile = ci >> 2, g = ci & 3, r0 = tile * 128;
            const bool samp = r0 >= NTP;
            const int w = 2 << g;
            const bf16_t* Bw = (const bf16_t*)(PWS + WS_POOLWT) + ((size_t)pair * 4 + g) * 128 * 128;
            {
                u32x4 wr_[4];
#pragma unroll
                for (int i = 0; i < 4; ++i) { const int e = tid + i * 512, d_ = e >> 4, c8 = (e & 15) * 8; wr_[i] = *(const u32x4*)(Bw + d_ * 128 + c8); }
#pragma unroll
                for (int i = 0; i < 4; ++i) { const int e = tid + i * 512, d_ = e >> 4, c8 = (e & 15) * 8; *(LAS u32x4*)(LW + d_ * 136 + c8) = wr_[i]; }
            }
            if (!samp) {
                const int t0 = r0 & 2047;
                {
                    u32x2 raw[9];
#pragma unroll
                    for (int i = 0; i < 9; ++i) {
                        const int e = tid + i * 512, er = e >> 5, c = (e & 31) * 4;
                        raw[i] = (u32x2){0u, 0u};
                        if (e < 143 * 32 && t0 + er - 15 >= 0) raw[i] = *(const u32x2*)(PO + (size_t)(r0 + er - 15) * LDA + g * 128 + c);
                    }
#pragma unroll
                    for (int i = 0; i < 9; ++i) {
                        const int e = tid + i * 512, er = e >> 5, c = (e & 31) * 4;
                        if (e < 143 * 32) *(LAS f32x4*)(LE + er * 128 + c) = cvt4(raw[i]);
                    }
                }
                __syncthreads();
                {
                    const int c = (tid & 31) * 4, tl0 = (tid >> 5) * 8;
                    f32x4 sum = (f32x4){0.f, 0.f, 0.f, 0.f};
#pragma unroll 4
                    for (int d = 0; d < w; ++d) sum += *(LAS const f32x4*)(LE + (tl0 + 15 - d) * 128 + c);
#pragma unroll
                    for (int k = 0; k < 8; ++k) {
                        const int tl = tl0 + k;
                        const f32x4 pt = *(LAS const f32x4*)(LE + (tl + 15) * 128 + c);
                        if (k > 0) sum += pt - *(LAS const f32x4*)(LE + (tl + 15 - w) * 128 + c);
                        const float cnt = fminf((float)w, (float)(t0 + tl + 1));
                        const f32x4 pooled = sum * (1.0f / cnt) - pt;
                        u32x2 u; u.x = cvt_pk_bf16(pooled[0], pooled[1]); u.y = cvt_pk_bf16(pooled[2], pooled[3]);
                        *(LAS u32x2*)(LA + tl * 136 + c) = u;
                    }
                }
            } else {
                for (int e = tid; e < 128 * 32; e += 512) {
                    const int tl = e >> 5, c = (e & 31) * 4, row = r0 + tl;
                    const int q = row - NTP, b = q >> 3, t = q & 7;
                    const bf16_t* cur = PO + (size_t)row * LDA + g * 128 + c;
                    const f32x4 pt = ld_bf4(cur);
                    f32x4 sum = pt;
                    for (int d = 1; d < w; ++d) {
                        const int tt = t - d;
                        if (tt >= 0) sum += ld_bf4(cur - (size_t)d * LDA);
                        else sum += *(const f32x4*)(PIN(I_SPOOL) + (((size_t)pair * 128 + b) * 15 + (15 + tt)) * 512 + g * 128 + c);
                    }
                    const f32x4 pooled = sum * (1.0f / (float)w) - pt;
                    u32x2 u; u.x = cvt_pk_bf16(pooled[0], pooled[1]); u.y = cvt_pk_bf16(pooled[2], pooled[3]);
                    *(LAS u32x2*)(LA + tl * 136 + c) = u;
                }
            }
            __syncthreads();
            const int row = r0 + wid * 16 + fr;
            bf16x8 af[4];
#pragma unroll
            for (int ks = 0; ks < 4; ++ks) af[ks] = *(const LAS bf16x8*)(LA + (wid * 16 + fr) * 136 + ks * 32 + fq * 8);
#pragma unroll
            for (int nt = 0; nt < 8; ++nt) {
                f32x4 acc = (f32x4){0.f, 0.f, 0.f, 0.f};
#pragma unroll
                for (int ks = 0; ks < 4; ++ks) {
                    const bf16x8 bf = *(const LAS bf16x8*)(LW + (nt * 16 + fr) * 136 + ks * 32 + fq * 8);
                    acc = __builtin_amdgcn_mfma_f32_16x16x32_bf16(bf, af[ks], acc, 0, 0, 0);
                }
                const int d = g * 128 + nt * 16 + fq * 4;
                const f32x4 cz = ld_bf4(PO + (size_t)row * LDA + 512 + d), ps = *(const f32x4*)(PIN(I_PSCALE) + pair * 512 + d);
                f32x4 o;
#pragma unroll
                for (int j = 0; j < 4; ++j) o[j] = acc[j] * ps[j] * siluf_(cz[j]);
                st_bf4(Ycat + (size_t)row * 1024 + d, o);
            }
            __syncthreads();
        } else {
            const int tile = it, r0 = tile * 128;
            const bool samp = r0 >= NTP;
            {
                const int tl = tid >> 2, q = tid & 3;
                const bf16_t* vr = PO + (size_t)(r0 + tl) * LDA + 1536 + q * 128;
                float s_ = 0.f, ss = 0.f;
#pragma unroll
                for (int i = 0; i < 16; ++i) { const u32x4 raw = *(const u32x4*)(vr + i * 8); const f32x4 v0 = cvt4((u32x2){raw.x, raw.y}), v1 = cvt4((u32x2){raw.z, raw.w});
                    s_ += (v0[0] + v0[1]) + (v0[2] + v0[3]) + (v1[0] + v1[1]) + (v1[2] + v1[3]); ss += dot4(v0, v0) + dot4(v1, v1); }
                s_ = allsum4(s_); ss = allsum4(ss);
                const float mean = s_ * (1.0f / 512.0f);
                const float var = fmaxf(ss * (1.0f / 512.0f) - mean * mean, 0.f);
                if (q == 0) { stat[tl * 2] = mean; stat[tl * 2 + 1] = rsqrtf(var + 1e-5f); }
            }
            __syncthreads();
#pragma unroll 1
            for (int g = 0; g < 4; ++g) {
                {
                    const int tl = tid >> 2, q = tid & 3, row = r0 + tl;
                    const float mean = stat[tl * 2], rstd = stat[tl * 2 + 1];
                    const bf16_t* vr = PO + (size_t)row * LDA + 1536 + g * 128 + q * 32;
                    const float* lg = PIN(I_LNG) + pair * 512 + g * 128 + q * 32; const float* lb = PIN(I_LNB) + pair * 512 + g * 128 + q * 32;
#pragma unroll
                    for (int i = 0; i < 8; ++i) {
                        const f32x4 v = ld_bf4(vr + i * 4);
                        const f32x4 vn = (v - mean) * rstd * *(const f32x4*)(lg + i * 4) + *(const f32x4*)(lb + i * 4);
                        if (samp) *(f32x4*)(POUT + O_CHUNKV + ((size_t)pair * 1024 + (row - NTP)) * 512 + g * 128 + q * 32 + i * 4) = vn;
#pragma unroll
                        for (int j = 0; j < 4; ++j) LB[(q * 32 + i * 4 + j) * 136 + tl] = (bf16_t)(cvt_pk_bf16(vn[j], 0.f) & 0xffffu);
                    }
                }
                if (!samp) {
                    const bf16_t* Wsrc = (const bf16_t*)(PWS + WS_SPW) + ((size_t)pair * 4 + g) * 128 * 128;
                    u32x4 wr_[4];
#pragma unroll
                    for (int i = 0; i < 4; ++i) { const int e = tid + i * 512, t = e >> 4, s8 = (e & 15) * 8; wr_[i] = *(const u32x4*)(Wsrc + t * 128 + s8); }
#pragma unroll
                    for (int i = 0; i < 4; ++i) { const int e = tid + i * 512, t = e >> 4, s8 = (e & 15) * 8; *(LAS u32x4*)(LA + t * 136 + s8) = wr_[i]; }
                } else {
                    const float* Wsrc = PIN(I_SPW) + ((size_t)pair * 4 + g) * 128 * 128;
                    for (int e = tid; e < 128 * 128; e += 512) { const int t = e >> 7, s2 = e & 127;
                        const float v = ((t >> 3) == (s2 >> 3) && (s2 & 7) <= (t & 7)) ? Wsrc[(t & 7) * 128 + (s2 & 7)] : 0.f;
                        LA[t * 136 + s2] = (bf16_t)(cvt_pk_bf16(v, 0.f) & 0xffffu); }
                }
                __syncthreads();
                {
                    const int tl = wid * 16 + fr, row = r0 + tl;
                    const float bias = PIN(I_SPB)[((size_t)pair * 4 + g) * 128 + (samp ? (tl & 7) : tl)];
                    bf16x8 wf[4];
#pragma unroll
                    for (int ks = 0; ks < 4; ++ks) wf[ks] = *(const LAS bf16x8*)(LA + tl * 136 + ks * 32 + fq * 8);
#pragma unroll
                    for (int nt = 0; nt < 8; ++nt) {
                        f32x4 acc = (f32x4){0.f, 0.f, 0.f, 0.f};
#pragma unroll
                        for (int ks = 0; ks < 4; ++ks) {
                            if (ks * 32 <= wid * 16 + 15) {
                                const bf16x8 vf = *(const LAS bf16x8*)(LB + (nt * 16 + fr) * 136 + ks * 32 + fq * 8);
                                acc = __builtin_amdgcn_mfma_f32_16x16x32_bf16(vf, wf[ks], acc, 0, 0, 0);
                            }
                        }
                        const int c = g * 128 + nt * 16 + fq * 4;
                        const f32x4 u = ld_bf4(PO + (size_t)row * LDA + 1024 + c), dz = ld_bf4(PO + (size_t)row * LDA + 2048 + c);
                        f32x4 o;
#pragma unroll
                        for (int j = 0; j < 4; ++j) o[j] = u[j] * (acc[j] + bias) * siluf_(dz[j]);
                        st_bf4(Ycat + (size_t)row * 1024 + 512 + c, o);
                    }
                }
                __syncthreads();
            }
        }
    }
    const int gtid = cx.bid * 512 + tid, gthreads = cx.nblk * 512;
    for (int e = gtid; e < 136 * 15 * 512; e += gthreads) {
        const int c = e & 511, q = e >> 9, sr = q / 15, k = q % 15;
        if (sr < 8) POUT[O_POOLP + (((size_t)pair * 8 + sr) * 15 + k) * 512 + c] = bf2f(PO[(size_t)(sr * 2048 + 2033 + k) * LDA + c]);
        else { const int b = sr - 8;
            POUT[O_POOLS + (((size_t)pair * 128 + b) * 15 + k) * 512 + c] = (k < 7) ? PIN(I_SPOOL)[(((size_t)pair * 128 + b) * 15 + 8 + k) * 512 + c] : bf2f(PO[(size_t)(NTP + b * 8 + (k - 7)) * LDA + c]); }
    }
}

__device__ void phase_final(const Params& p, const Ctx cx) {
    const int gtid = cx.bid * 512 + cx.tid, gthreads = cx.nblk * 512;
    const float* ssq = (const float*)(PWS + WS_SSQ) + (size_t)4 * NTOK * 16;
    const bf16_t* Xb = (const bf16_t*)(PWS + WS_XB);
    constexpr int NIT = NTOK * 256, UB = 4;
    for (int e0 = gtid; e0 < NIT; e0 += gthreads * UB) {
        f32x4 x[UB]; float sq[UB]; bool ok[UB];
#pragma unroll
        for (int u = 0; u < UB; ++u) { const int e = e0 + u * gthreads; ok[u] = e < NIT; const int ee = ok[u] ? e : e0; const int row = ee >> 8, c = (ee & 255) * 4;
            x[u] = ld_bf4(Xb + (size_t)row * 1024 + c); sq[u] = ssq_sum(ssq + (size_t)row * 16); }
#pragma unroll
        for (int u = 0; u < UB; ++u) { const int e = e0 + u * gthreads; const int ee = ok[u] ? e : e0; const int row = ee >> 8, c = (ee & 255) * 4;
            const float rstd = rsqrtf(sq[u] * (1.0f / 1024.0f) + 1e-6f);
            if (ok[u]) *(f32x4*)(POUT + (size_t)row * 1024 + c) = x[u] * rstd * *(const f32x4*)(PIN(I_FNORMW) + c); }
    }
}

#define XB_TMO      128
#define XB_XCNT(j)  (256  + 64 * (j))
#define XB_XSUB(j)  (1280 + 64 * (j))
#define XB_XGEN(j)  (2304 + 64 * (j))
#define XB_TOP      3328
#define XB_TOPGEN   3392
#define XCD_BAR_WORDS 3456
#define XB_SPIN_CAP (1u << 18)
__device__ __forceinline__ unsigned xb_ld(unsigned* p)              { return __hip_atomic_load(p, __ATOMIC_RELAXED, __HIP_MEMORY_SCOPE_AGENT); }
__device__ __forceinline__ unsigned xb_add(unsigned* p, unsigned v) { return __hip_atomic_fetch_add(p, v, __ATOMIC_RELAXED, __HIP_MEMORY_SCOPE_AGENT); }
__device__ __forceinline__ unsigned xb_xcc_id() { return (unsigned)__builtin_amdgcn_s_getreg((3 << 11) | 20) & 0xFu; }
#define XB_SPIN(cond, bar) do { unsigned _sp = 0; while (cond) { __builtin_amdgcn_s_sleep(1); \
    if ((++_sp & 255u) == 0u) { if (xb_ld(&(bar)[XB_TMO])) break; if (_sp > XB_SPIN_CAP) { atomicAdd(&(bar)[XB_TMO], 1u); break; } } } } while (0)
struct XcdBarrier { unsigned* bar; unsigned x; volatile LAS unsigned* st; };
__device__ __forceinline__ XcdBarrier xcd_barrier_post(unsigned* bar, volatile LAS unsigned* st) {
    XcdBarrier b; b.bar = bar; b.x = xb_xcc_id(); b.st = st;
    if (threadIdx.x == 0) (void)xb_add(&bar[XB_XCNT(b.x)], 1u);
    return b;
}
__device__ __forceinline__ void xcd_barrier_complete(unsigned* bar, unsigned x, unsigned& nloc, unsigned& nx) {
    const unsigned G = gridDim.x * gridDim.y * gridDim.z;
    unsigned sum, cnt, mine, sp = 0u;
    for (;;) {
        sum = 0u; cnt = 0u; mine = 0u;
#pragma unroll
        for (unsigned j = 0; j < 16; ++j) { const unsigned c = xb_ld(&bar[XB_XCNT(j)]); sum += c; cnt += (c > 0u) ? 1u : 0u; mine = (j == x) ? c : mine; }
        if (sum == G) break;
        __builtin_amdgcn_s_sleep(1);
        if ((++sp & 255u) == 0u) { if (xb_ld(&bar[XB_TMO])) break; if (sp > XB_SPIN_CAP) { atomicAdd(&bar[XB_TMO], 1u); break; } }
    }
    nloc = mine > 0u ? mine : 1u; nx = cnt > 0u ? cnt : 1u;
}
__device__ __forceinline__ void xcd_barrier(const XcdBarrier& b) {
    asm volatile("s_waitcnt vmcnt(0)" ::: "memory");
    __syncthreads();
    if (threadIdx.x == 0) {
        unsigned* bar = b.bar;
        __builtin_amdgcn_s_waitcnt(0);
        unsigned nloc = b.st[0], nx = b.st[1];
        if (nloc == 0u) { xcd_barrier_complete(bar, b.x, nloc, nx); b.st[0] = nloc; b.st[1] = nx; }
        const unsigned old = xb_add(&bar[XB_XSUB(b.x)], 1u);
        const unsigned gen = old / nloc;
        if (old + 1u == (gen + 1u) * nloc) {
            __builtin_amdgcn_fence(__ATOMIC_RELEASE, "agent");
            asm volatile("s_waitcnt vmcnt(0)" ::: "memory");
            const unsigned og = xb_add(&bar[XB_TOP], 1u);
            const unsigned tg = og / nx;
            if (og + 1u == (tg + 1u) * nx) xb_add(&bar[XB_TOPGEN], 1u);
            else XB_SPIN(xb_ld(&bar[XB_TOPGEN]) == tg, bar);
            __builtin_amdgcn_fence(__ATOMIC_ACQUIRE, "agent");
            xb_add(&bar[XB_XGEN(b.x)], 1u);
            asm volatile("s_waitcnt vmcnt(0)" ::: "memory");
        } else {
            XB_SPIN(xb_ld(&bar[XB_XGEN(b.x)]) == gen, bar);
            __builtin_amdgcn_fence(__ATOMIC_ACQUIRE, "agent");
            asm volatile("s_waitcnt vmcnt(0)" ::: "memory");
        }
    }
    __syncthreads();
}

__device__ void run_gemm_proj(const Params& p, const Ctx cx, LAS unsigned char* lds, const bf16_t* Bt, int N, bf16_t* O, int ldc, int layer) {
    pg8::Gemm g{(const bf16_t*)(PWS + WS_XB), Bt, NTOK, N, 1024};
    pg8::StaticOrder S; S.init(NTOK, N, (int)cx.nblk, (int)cx.bid);
    const float* ssq = (const float*)(PWS + WS_SSQ) + (size_t)layer * NTOK * 16;
    LAS float* rl = (LAS float*)(lds + 131072);
    int pm0 = -1, pm1 = -1, pm2 = -1, pm3 = -1, np = 0;
    for (int i = 0; i < 64; ++i) {
        pg8::Unit u; if (!S.next(i, u)) break;
        if (u.pm == pm0 || u.pm == pm1 || u.pm == pm2 || u.pm == pm3) continue;
        if (np == 0) pm0 = u.pm; else if (np == 1) pm1 = u.pm; else if (np == 2) pm2 = u.pm; else pm3 = u.pm;
        ++np;
    }
    for (int r = cx.tid; r < np * 256; r += 512) {
        const int i = r >> 8, pm = i == 0 ? pm0 : (i == 1 ? pm1 : (i == 2 ? pm2 : pm3));
        rl[r] = rsqrtf(ssq_sum(ssq + (size_t)(pm * 256 + (r & 255)) * 16) * (1.0f / 1024.0f) + 1e-6f);
    }
    __syncthreads();
    EpiProj E{O, ldc, rl, pm0, pm1, pm2, pm3};
    pg8::gemm_phase<EpiProj>(cx, lds, g, S, E);
}
__device__ void run_gemm_res(const Params& p, const Ctx cx, LAS unsigned char* lds, const bf16_t* Bt, int layer) {
    const bf16_t* A = (const bf16_t*)(PWS + WS_YCAT);
    bf16_t* Xb = (bf16_t*)(PWS + WS_XB);
    float* ssqn = (float*)(PWS + WS_SSQ) + (size_t)(layer + 1) * NTOK * 16;
    pg8::Gemm g{A, Bt, NTOK, 1024, 1024};
    pg8::StaticOrder S; S.init(NTOK, 1024, (int)cx.nblk, (int)cx.bid);
    EpiRes E{layer == 0 ? PIN(I_XP) : nullptr, PIN(I_XS), Xb, ssqn};
    pg8::gemm_phase<EpiRes>(cx, lds, g, S, E);
}

constexpr int N_PHASES = 20;
#ifndef PHMASK
#define PHMASK 0xffff
#endif
#define PHON(n) ((PHMASK >> ((n) % 16)) & 1)
__global__ void __launch_bounds__(512, 2) fwd_kernel(Params p) {
    extern __shared__ __attribute__((aligned(16))) unsigned char lds_raw[];
    LAS unsigned char* lds = (LAS unsigned char*)lds_raw;
    volatile LAS unsigned* bar_st = (volatile LAS unsigned*)(lds + LDS_MAIN);
    if (threadIdx.x < 4) bar_st[threadIdx.x] = 0u;
    __syncthreads();
    const XcdBarrier gbar = xcd_barrier_post((unsigned*)((unsigned char*)p.ptr[30] + WS_BAR), bar_st);
    if (p.ph_hi < 0) cg::this_grid().sync();
#define GRID_SYNC() xcd_barrier(gbar)
#ifdef SYNCPROBE
    for (int i = 0; i < SYNCPROBE; ++i) GRID_SYNC();
#endif
#ifdef REPMASK
    for (int pc = p.ph_lo * 2; pc < p.ph_hi * 2; ++pc) {
        const int ph = pc >> 1;
        { const int s_ = (ph == 0) ? 9 : (ph == N_PHASES - 1) ? 31 : (ph - 1) % 9; if ((pc & 1) && !((REPMASK >> s_) & 1)) continue; }
        if (pc > p.ph_lo * 2) GRID_SYNC();
#else
    for (int ph = p.ph_lo; ph < p.ph_hi; ++ph) {
        if (ph > p.ph_lo) GRID_SYNC();
#endif
        Ctx cx; cx.tid = threadIdx.x; cx.bid = blockIdx.x; cx.nblk = gridDim.x;
        asm volatile("s_mov_b32 %0, 0" : "=s"(cx.z));
        asm volatile("" : "+v"(cx.tid)); asm volatile("" : "+s"(cx.bid)); asm volatile("" : "+s"(cx.nblk));
        const int pair = (ph - 1) / 9, s = (ph == 0) ? 100 : (ph == N_PHASES - 1 ? 101 : (ph - 1) % 9);
        if (s == 0 || s == 3 || s == 6) {
#if PHON(0)
            const bf16_t* WinE = (const bf16_t*)(PWS + WS_WINE) + (size_t)pair * 4352 * 1024;
            const bf16_t* Bt = s == 0 ? WinE + (size_t)2560 * 1024 : (s == 3 ? WinE : (const bf16_t*)(PWS + WS_WINO) + (size_t)pair * 2560 * 1024);
            const int N = s == 0 ? 1792 : 2560;
            run_gemm_proj(p, cx, lds, Bt, N, (bf16_t*)(PWS + WS_R1), N, 2 * pair + (s == 6 ? 1 : 0));
#endif
        } else if (s == 5 || s == 8) {
#if PHON(5)
            const bf16_t* Bt = (const bf16_t*)(PWS + (s == 5 ? WS_WOUTE : WS_WOUTO)) + (size_t)pair * 1024 * 1024;
            run_gemm_res(p, cx, lds, Bt, 2 * pair + (s == 8 ? 1 : 0));
#endif
        } else if (s == 1) {
#if PHON(1)
            phase_even_prep(p, cx, pair, lds);
#endif
        } else if (s == 2) {
#if PHON(2)
            phase_scan(p, cx, pair, lds);
#endif
        } else if (s == 4) {
#if PHON(4)
            phase_even_post(p, cx, pair);
#endif
        } else if (s == 7) {
#if PHON(7)
            phase_odd_mixer(p, cx, pair, lds);
#endif
        } else if (s == 100) {
#if PHON(10)
            phase_prepass(p, cx, lds);
#endif
        } else {
#if PHON(11)
            phase_final(p, cx);
#endif
        }
    }
}

extern "C" void kernel_launch(void* const* d_in, const int* in_sizes, int n_in, void* d_out, int out_size, void* d_ws, size_t ws_size, hipStream_t stream) {
    static int grid = 0;
    if (grid == 0) {
        if (n_in != 29 || ws_size < WS_END) { fprintf(stderr, "kernel_launch: unexpected n_in %d / ws_size %zu (need %zu)\n", n_in, ws_size, (size_t)WS_END); grid = -1; return; }
        int dev = 0, cus = 0, per_cu = 0;
        hipGetDevice(&dev);
        hipDeviceGetAttribute(&cus, hipDeviceAttributeMultiprocessorCount, dev);
        if (hipFuncSetAttribute((const void*)fwd_kernel, hipFuncAttributeMaxDynamicSharedMemorySize, LDS_BYTES) != hipSuccess) { fprintf(stderr, "kernel_launch: hipFuncSetAttribute failed\n"); grid = -1; return; }
        if (hipOccupancyMaxActiveBlocksPerMultiprocessor(&per_cu, (const void*)fwd_kernel, 512, LDS_BYTES) != hipSuccess || per_cu < 1) { fprintf(stderr, "kernel_launch: occupancy query gave %d\n", per_cu); per_cu = 1; }
        (void)hipGetLastError();
        grid = cus * per_cu;
        if (grid > 256) grid = 256;
    }
    if (grid < 0) return;
    Params p{};
    for (int i = 0; i < 29; ++i) p.ptr[i] = d_in[i];
    p.ptr[29] = d_out; p.ptr[30] = d_ws; p.ptr[31] = nullptr;
    (void)hipMemsetAsync((unsigned char*)d_ws + WS_BAR, 0, 16384, stream);
#if ONE_LAUNCH
    p.ph_lo = 0; p.ph_hi = N_PHASES;
    void* args[] = {&p};
    hipError_t e = hipLaunchCooperativeKernel((const void*)fwd_kernel, dim3(grid), dim3(512), args, LDS_BYTES, stream);
    if (e != hipSuccess) fprintf(stderr, "cooperative launch failed: %s (grid %d)\n", hipGetErrorString(e), grid);
#else
    for (int ph = 0; ph < N_PHASES; ++ph) {
        p.ph_lo = ph; p.ph_hi = ph + 1;
        hipLaunchKernelGGL(fwd_kernel, dim3(grid), dim3(512), LDS_BYTES, stream, p);
    }
#endif
}
```

```cpp
#include <hip/hip_runtime.h>
#include <hip/hip_cooperative_groups.h>
#include <cstdio>
namespace cg = cooperative_groups;

#ifndef ONE_LAUNCH
#define ONE_LAUNCH 1
#endif

#define LAS __attribute__((address_space(3)))
typedef unsigned short bf16_t;
typedef short bf16x8 __attribute__((ext_vector_type(8)));
typedef float f32x4 __attribute__((ext_vector_type(4)));
typedef unsigned u32x4 __attribute__((ext_vector_type(4)));
typedef unsigned u32x2 __attribute__((ext_vector_type(2)));

constexpr int NTOK = 17408, NTP = 16384;
constexpr int LDB = 1792;
constexpr int LDA = 2560;
constexpr size_t O_CONVP = 17825792, O_CONVS = 17842176, O_SHIFTP = 18104320, O_SHIFTS = 18130944, O_WKVP = 18556928, O_WKVS = 19081216,
                 O_POOLP = 27469824, O_POOLS = 27592704, O_CHUNKV = 29558784;
constexpr size_t WS_WINE = 0;
constexpr size_t WS_WOUTE = WS_WINE + 2ull * 4352 * 1024 * 2;
constexpr size_t WS_WINO = WS_WOUTE + 2ull * 1024 * 1024 * 2;
constexpr size_t WS_WOUTO = WS_WINO + 2ull * 2560 * 1024 * 2;
constexpr size_t WS_W2T = WS_WOUTO + 2ull * 1024 * 1024 * 2;
constexpr size_t WS_A2T = WS_W2T + 2ull * 512 * 64 * 2;
constexpr size_t WS_POOLWT = WS_A2T + 2ull * 512 * 64 * 2;
constexpr size_t WS_SPW = WS_POOLWT + 8ull * 128 * 128 * 2;
constexpr size_t WS_XB = WS_SPW + 8ull * 128 * 128 * 2;
constexpr size_t WS_YCAT = WS_XB + (size_t)NTOK * 1024 * 2;
constexpr size_t WS_SSQ = WS_YCAT + (size_t)NTOK * 1024 * 2;
constexpr size_t WS_Y = WS_SSQ + 5ull * NTOK * 16 * 4;
constexpr size_t WS_R1 = WS_Y + (size_t)NTOK * 512 * 4;
constexpr size_t WS_PROJB = WS_R1;
constexpr size_t WS_WDEC = WS_PROJB + (size_t)NTOK * LDB * 2;
constexpr size_t WS_AA = WS_WDEC + (size_t)NTOK * 512 * 4;
constexpr size_t WS_BAR = WS_AA + (size_t)NTOK * 512 * 2;
constexpr size_t WS_END = WS_BAR + 16384;
constexpr int LDS_MAIN = 147456;
constexpr int LDS_BYTES = LDS_MAIN + 16;

struct Params {
    const void* ptr[32];
    int ph_lo, ph_hi;
};
struct Ctx { int tid, bid, nblk, z; };
#define PIN(i) ((const float*)p.ptr[(i) + cx.z])
#define POUT ((float*)p.ptr[29 + cx.z])
#define PWS ((unsigned char*)p.ptr[30 + cx.z])
enum { I_XP = 0, I_XS, I_SCONV, I_SSHIFT, I_SWKV, I_SPOOL, I_NORMW, I_FNORMW, I_WINE, I_CONVW, I_MU, I_W0, I_W2, I_A0, I_A2, I_KK, I_KA, I_RK, I_GNG, I_GNB,
       I_WOUTE, I_WINO, I_POOLW, I_PSCALE, I_LNG, I_LNB, I_SPW, I_SPB, I_WOUTO };

__device__ __forceinline__ unsigned cvt_pk_bf16(float lo, float hi) { unsigned r; asm("v_cvt_pk_bf16_f32 %0, %1, %2" : "=v"(r) : "v"(lo), "v"(hi)); return r; }
__device__ __forceinline__ float bf_lo(unsigned u) { return __uint_as_float(u << 16); }
__device__ __forceinline__ float bf_hi(unsigned u) { return __uint_as_float(u & 0xffff0000u); }
__device__ __forceinline__ float bf2f(bf16_t b) { return __uint_as_float(((unsigned)b) << 16); }
__device__ __forceinline__ f32x4 cvt4(u32x2 u) { return (f32x4){bf_lo(u.x), bf_hi(u.x), bf_lo(u.y), bf_hi(u.y)}; }
__device__ __forceinline__ f32x4 ld_bf4(const bf16_t* p) { return cvt4(*(const u32x2*)p); }
__device__ __forceinline__ void st_bf4(bf16_t* p, f32x4 v) { u32x2 u; u.x = cvt_pk_bf16(v[0], v[1]); u.y = cvt_pk_bf16(v[2], v[3]); *(u32x2*)p = u; }
__device__ __forceinline__ float sigmoidf_(float x) { return 1.0f / (1.0f + __expf(-x)); }
__device__ __forceinline__ float siluf_(float x) { return x / (1.0f + __expf(-x)); }
template <int CTRL> __device__ __forceinline__ float dpp_f(float x) { return __builtin_bit_cast(float, __builtin_amdgcn_mov_dpp(__builtin_bit_cast(int, x), CTRL, 0xf, 0xf, true)); }
__device__ __forceinline__ float allsum16(float x) { x += dpp_f<0xB1>(x); x += dpp_f<0x4E>(x); x += dpp_f<0x141>(x); x += dpp_f<0x128>(x); return x; }
__device__ __forceinline__ float allsum4(float x) { x += dpp_f<0xB1>(x); x += dpp_f<0x4E>(x); return x; }
__device__ __forceinline__ float dot4(f32x4 a, f32x4 b) { return a[0] * b[0] + a[1] * b[1] + a[2] * b[2] + a[3] * b[3]; }

__device__ __forceinline__ float ssq_sum(const float* part) {
    const f32x4 a = *(const f32x4*)(part), b = *(const f32x4*)(part + 4), c = *(const f32x4*)(part + 8), d = *(const f32x4*)(part + 12);
    return ((a[0] + a[1]) + (a[2] + a[3])) + ((b[0] + b[1]) + (b[2] + b[3])) + ((c[0] + c[1]) + (c[2] + c[3])) + ((d[0] + d[1]) + (d[2] + d[3]));
}

namespace pg8 {
constexpr int BM = 256, BK = 64, HALF = 128, HTB = HALF * BK * 2, NXCD = 8, WGM = 8;
__device__ __forceinline__ int lds_byte(int r, int c) { const int st = (r >> 4) * 2 + (c >> 5), rr = r & 15, cc = c & 31, ob = rr * 64 + cc * 2; return st * 1024 + (ob ^ (((ob >> 9) & 1) << 5)); }
__device__ __forceinline__ void stage_rc(int b, int& R, int& C) { const int st = b / 1024, sb = b % 1024, swz = sb ^ (((sb >> 9) & 1) << 5); R = (st >> 1) * 16 + swz / 64; C = (st & 1) * 32 + (swz % 64) / 2; }
__device__ __forceinline__ int perm32(int rho) { const int n = rho >> 4, i = rho & 15; return 8 * (i >> 2) + 4 * n + (i & 3); }
struct Unit { int pm, pn; };
struct Gemm { const bf16_t* A; const bf16_t* Bt; int M, N, K; };
struct StaticOrder {
    int nM, nN, nwg, G, c;
    __device__ void init(int M, int N, int G_, int c_) { nM = M / BM; nN = N / BM; nwg = nM * nN; G = G_; c = c_; }
    __device__ bool next(int i, Unit& u) const {
        const long L = (long)i * G + c; if (L >= nwg) return false;
        int wgid = (int)L; { const int q = nwg / NXCD, r = nwg % NXCD, xcd = wgid % NXCD, off = wgid / NXCD; wgid = (xcd < r ? xcd * (q + 1) : r * (q + 1) + (xcd - r) * q) + off; }
        const int nig = WGM * nN, gid = wgid / nig, fm = gid * WGM, gsz = (nM - fm) < WGM ? (nM - fm) : WGM;
        u.pm = fm + ((wgid % nig) % gsz); u.pn = (wgid % nig) / gsz; return true;
    }
};

template <class Epi>
__device__ __forceinline__ void gemm_phase(const Ctx cx, LAS unsigned char* lds, const Gemm g, const StaticOrder& S, const Epi& E) {
    const int tid = cx.tid, wid = __builtin_amdgcn_readfirstlane(tid >> 6), lane = tid & 63, wr = wid >> 2, wc = wid & 3, fr = lane & 15, fq = lane >> 4;
    const int K = g.K, nt = K / BK;
    unsigned voffA[2], voffB[2];
#pragma unroll
    for (int i = 0; i < 2; ++i) { int R, C; stage_rc(tid * 16 + i * 8192, R, C); const int Rb = Epi::PERM ? ((R & ~31) + perm32(R & 31)) : R;
        voffA[i] = (unsigned)(R * K + C) * 2u; voffB[i] = (unsigned)(Rb * K + C) * 2u; }
    const size_t kstep = (size_t)(BK * 2);
    const size_t hstep = (size_t)HALF * K * 2;
    const size_t tstep = 2 * hstep;
    const unsigned ldsw = (unsigned)wid * 1024u;
    const int aoff = lds_byte(wr * 64 + fr, fq * 8), boff = lds_byte(wc * 32 + fr, fq * 8);
#define PG8_SA(b, h) (((b) * 2 + (h)) * HTB)
#define PG8_SB(b, h) ((4 + (b) * 2 + (h)) * HTB)
#define PG8_STAGE(bufoff, gbase, voff) do { _Pragma("unroll") for (int _i = 0; _i < 2; ++_i) \
        __builtin_amdgcn_global_load_lds((const unsigned*)((const char*)(gbase) + (voff)[_i]), (LAS unsigned*)(lds + (bufoff) + ldsw + _i * 8192), 16, 0, 0); } while (0)
#define PG8_LDA(dst, b, h) do { _Pragma("unroll") for (int m = 0; m < 4; ++m) _Pragma("unroll") for (int k = 0; k < 2; ++k) dst[m][k] = *(const LAS bf16x8*)(lds + PG8_SA(b, h) + aoff + m * 2048 + k * 1024); } while (0)
#define PG8_LDB(dst, b, h) do { _Pragma("unroll") for (int n = 0; n < 2; ++n) _Pragma("unroll") for (int k = 0; k < 2; ++k) dst[n][k] = *(const LAS bf16x8*)(lds + PG8_SB(b, h) + boff + n * 2048 + k * 1024); } while (0)
#define PG8_MMA(ai, bj, At, Bt) do { __builtin_amdgcn_s_setprio(1); _Pragma("unroll") for (int m = 0; m < 4; ++m) _Pragma("unroll") for (int n = 0; n < 2; ++n) _Pragma("unroll") for (int k = 0; k < 2; ++k) \
        acc[ai][bj][m][n] = __builtin_amdgcn_mfma_f32_16x16x32_bf16(Bt[n][k], At[m][k], acc[ai][bj][m][n], 0, 0, 0); __builtin_amdgcn_s_setprio(0); } while (0)
#define PG8_WAIT_V(n) asm volatile("s_waitcnt vmcnt(" #n ")" ::: "memory")
#define PG8_WAIT_L(n) asm volatile("s_waitcnt lgkmcnt(" #n ")" ::: "memory")
#define PG8_BAR __builtin_amdgcn_s_barrier()
#define PG8_SCHED __builtin_amdgcn_sched_barrier(0)
    Unit cur, nxt; int ui = 0;
    if (!S.next(0, cur)) return;
    f32x4 acc[2][2][4][2];
#pragma unroll
    for (int a = 0; a < 2; ++a)
#pragma unroll
        for (int b = 0; b < 2; ++b)
#pragma unroll
            for (int m = 0; m < 4; ++m)
#pragma unroll
                for (int n = 0; n < 2; ++n) acc[a][b][m][n] = (f32x4){0.f, 0.f, 0.f, 0.f};
    bf16x8 At[4][2], B0[2][2], B1[2][2];
    const char* cA = (const char*)g.A + (size_t)cur.pm * tstep; const char* cB = (const char*)g.Bt + (size_t)cur.pn * tstep;
    PG8_STAGE(PG8_SB(0, 0), cB, voffB); PG8_STAGE(PG8_SA(0, 0), cA, voffA); PG8_STAGE(PG8_SB(0, 1), cB + hstep, voffB); PG8_STAGE(PG8_SA(0, 1), cA + hstep, voffA);
    if (wr == 1) PG8_BAR;
    PG8_WAIT_V(4); PG8_BAR;
    PG8_STAGE(PG8_SB(1, 0), cB + kstep, voffB); PG8_STAGE(PG8_SA(1, 0), cA + kstep, voffA); PG8_STAGE(PG8_SB(1, 1), cB + hstep + kstep, voffB);
    PG8_WAIT_V(6); PG8_BAR;
    for (;;) {
        const bool has_next = S.next(ui + 1, nxt);
        const char* nA = has_next ? (const char*)g.A + (size_t)nxt.pm * tstep : cA; const char* nB = has_next ? (const char*)g.Bt + (size_t)nxt.pn * tstep : cB;
        for (int t = 0; t < nt; t += 2) {
            const bool last = (t == nt - 2);
            const char* a1 = cA + (size_t)(t + 1) * kstep;
            const char* a2 = last ? nA : cA + (size_t)(t + 2) * kstep; const char* b2 = last ? nB : cB + (size_t)(t + 2) * kstep;
            const char* a3 = a2 + kstep; const char* b3 = b2 + kstep;
            PG8_LDB(B0, 0, 0); PG8_SCHED; PG8_LDA(At, 0, 0); PG8_STAGE(PG8_SA(1, 1), a1 + hstep, voffA);
            PG8_WAIT_L(8); PG8_BAR; PG8_WAIT_L(0); PG8_MMA(0, 0, At, B0); PG8_BAR; PG8_SCHED;
            PG8_LDB(B1, 0, 1); PG8_STAGE(PG8_SB(0, 0), b2, voffB);
            PG8_BAR; PG8_WAIT_L(0); PG8_MMA(0, 1, At, B1); PG8_BAR;
            PG8_LDA(At, 0, 1); PG8_STAGE(PG8_SA(0, 0), a2, voffA);
            PG8_BAR; PG8_WAIT_L(0); PG8_MMA(1, 0, At, B0); PG8_BAR; PG8_SCHED;
            PG8_STAGE(PG8_SB(0, 1), b2 + hstep, voffB);
            PG8_WAIT_V(6); PG8_BAR; PG8_MMA(1, 1, At, B1); PG8_BAR;
            PG8_LDB(B0, 1, 0); PG8_SCHED; PG8_LDA(At, 1, 0); PG8_STAGE(PG8_SA(0, 1), a2 + hstep, voffA);
            PG8_WAIT_L(8); PG8_BAR; PG8_WAIT_L(0); PG8_MMA(0, 0, At, B0); PG8_BAR; PG8_SCHED;
            PG8_LDB(B1, 1, 1); PG8_STAGE(PG8_SB(1, 0), b3, voffB);
            PG8_BAR; PG8_WAIT_L(0); PG8_MMA(0, 1, At, B1); PG8_BAR;
            PG8_LDA(At, 1, 1); PG8_STAGE(PG8_SA(1, 0), a3, voffA);
            PG8_BAR; PG8_WAIT_L(0); PG8_MMA(1, 0, At, B0); PG8_BAR; PG8_SCHED;
            PG8_STAGE(PG8_SB(1, 1), b3 + hstep, voffB);
            PG8_WAIT_V(6); PG8_BAR; PG8_MMA(1, 1, At, B1); PG8_BAR;
        }
        E(acc, cur, wr, wc, fr, fq);
        if (!has_next) break;
#pragma unroll
        for (int a = 0; a < 2; ++a)
#pragma unroll
            for (int b = 0; b < 2; ++b)
#pragma unroll
                for (int m = 0; m < 4; ++m)
#pragma unroll
                    for (int n = 0; n < 2; ++n) acc[a][b][m][n] = (f32x4){0.f, 0.f, 0.f, 0.f};
        cur = nxt; cA = nA; cB = nB; ++ui;
    }
    PG8_WAIT_V(0);
    if (wr == 0) PG8_BAR;
    PG8_BAR;
#undef PG8_SA
#undef PG8_SB
#undef PG8_STAGE
#undef PG8_LDA
#undef PG8_LDB
#undef PG8_MMA
#undef PG8_WAIT_V
#undef PG8_WAIT_L
#undef PG8_BAR
#undef PG8_SCHED
}
}

struct EpiProj {
    static constexpr bool PERM = true;
    bf16_t* O; int ldc; LAS const float* rl; int pm0, pm1, pm2, pm3;
    __device__ __forceinline__ void operator()(const f32x4 (&acc)[2][2][4][2], const pg8::Unit& u, int wr, int wc, int fr, int fq) const {
        const int row0 = u.pm * 256 + wr * 64 + fr, col0 = u.pn * 256 + wc * 32 + 8 * fq;
        const int sel = u.pm == pm0 ? 0 : (u.pm == pm1 ? 1 : (u.pm == pm2 ? 2 : 3));
        LAS const float* rp = rl + sel * 256 + wr * 64 + fr;
#pragma unroll
        for (int ai = 0; ai < 2; ++ai)
#pragma unroll
            for (int m = 0; m < 4; ++m) {
                const int row = row0 + ai * 128 + m * 16;
                const float rstd = rp[ai * 128 + m * 16];
                bf16_t* rowp = O + (size_t)row * ldc + col0;
#pragma unroll
                for (int bj = 0; bj < 2; ++bj) {
                    const f32x4 v0 = acc[ai][bj][m][0] * rstd, v1 = acc[ai][bj][m][1] * rstd;
                    u32x4 w; w.x = cvt_pk_bf16(v0[0], v0[1]); w.y = cvt_pk_bf16(v0[2], v0[3]); w.z = cvt_pk_bf16(v1[0], v1[1]); w.w = cvt_pk_bf16(v1[2], v1[3]);
                    *(u32x4*)(rowp + bj * 128) = w;
                }
            }
    }
};
struct X8 { f32x4 lo, hi; };
template <bool FIRST> __device__ __forceinline__ X8 ld_x8(const float* __restrict__ s32, const bf16_t* __restrict__ s16, size_t o) {
    X8 r;
    if (FIRST) { r.lo = *(const f32x4*)(s32 + o); r.hi = *(const f32x4*)(s32 + o + 4); }
    else { const u32x4 u = *(const u32x4*)(s16 + o); r.lo = cvt4((u32x2){u.x, u.y}); r.hi = cvt4((u32x2){u.z, u.w}); }
    return r;
}
__device__ __forceinline__ void st_x8(bf16_t* p, f32x4 lo, f32x4 hi) { u32x4 w; w.x = cvt_pk_bf16(lo[0], lo[1]); w.y = cvt_pk_bf16(lo[2], lo[3]); w.z = cvt_pk_bf16(hi[0], hi[1]); w.w = cvt_pk_bf16(hi[2], hi[3]); *(u32x4*)p = w; }
template <bool FIRST>
__device__ __forceinline__ void epi_res_rows(const f32x4 (&acc)[2][2][4][2], const float* __restrict__ src32, const bf16_t* __restrict__ src16, bf16_t* __restrict__ Xb, float* __restrict__ ssqp,
                                             int row0, int col0, int slot, int fq) {
    X8 x[2][2];
#pragma unroll
    for (int bj = 0; bj < 2; ++bj) x[0][bj] = ld_x8<FIRST>(src32, src16, (size_t)row0 * 1024 + col0 + bj * 128);
#pragma unroll
    for (int gi = 0; gi < 8; ++gi) {
        const int ai = gi >> 2, m = gi & 3, row = row0 + ai * 128 + m * 16;
        if (gi + 1 < 8) {
            const int nrow = row0 + ((gi + 1) >> 2) * 128 + ((gi + 1) & 3) * 16;
#pragma unroll
            for (int bj = 0; bj < 2; ++bj) x[(gi + 1) & 1][bj] = ld_x8<FIRST>(src32, src16, (size_t)nrow * 1024 + col0 + bj * 128);
        }
        float part = 0.f;
#pragma unroll
        for (int bj = 0; bj < 2; ++bj) {
            const f32x4 lo = x[gi & 1][bj].lo + acc[ai][bj][m][0], hi = x[gi & 1][bj].hi + acc[ai][bj][m][1];
            st_x8(Xb + (size_t)row * 1024 + col0 + bj * 128, lo, hi);
            part += dot4(lo, lo) + dot4(hi, hi);
        }
        part += __shfl_xor(part, 16); part += __shfl_xor(part, 32);
        if (fq == 0) ssqp[(size_t)row * 16 + slot] = part;
    }
}
struct EpiRes {
    static constexpr bool PERM = true;
    const float* xp; const float* xs; bf16_t* Xb; float* ssq_next;
    __device__ __forceinline__ void operator()(const f32x4 (&acc)[2][2][4][2], const pg8::Unit& u, int wr, int wc, int fr, int fq) const {
        const int row0 = u.pm * 256 + wr * 64 + fr, col0 = u.pn * 256 + wc * 32 + 8 * fq;
        if (xp) epi_res_rows<true>(acc, row0 < NTP ? xp : xs - (size_t)NTP * 1024, nullptr, Xb, ssq_next, row0, col0, u.pn * 4 + wc, fq);
        else epi_res_rows<false>(acc, nullptr, Xb, Xb, ssq_next, row0, col0, u.pn * 4 + wc, fq);
    }
};

template <bool FIRST>
__device__ __forceinline__ void res_sample_tile(const Ctx cx, const bf16_t* __restrict__ A, const bf16_t* __restrict__ Bt, const float* __restrict__ xs, bf16_t* __restrict__ Xb, float* __restrict__ ssqp, int tile) {
    const int tid = cx.tid, wid = tid >> 6, lane = tid & 63, fr = lane & 15, fq = lane >> 4;
    const int tm = tile >> 3, tn = tile & 7;
    const int r0 = NTP + tm * 64 + (wid & 3) * 16, c0 = tn * 128 + (wid >> 2) * 64;
    const bf16_t* ap = A + (size_t)(r0 + fr) * 1024 + fq * 8;
    const bf16_t* bp = Bt + (size_t)(c0 + fr) * 1024 + fq * 8;
    f32x4 acc[4];
#pragma unroll
    for (int nt = 0; nt < 4; ++nt) acc[nt] = (f32x4){0.f, 0.f, 0.f, 0.f};
#pragma unroll 8
    for (int ks = 0; ks < 32; ++ks) {
        const bf16x8 af = *(const bf16x8*)(ap + ks * 32);
#pragma unroll
        for (int nt = 0; nt < 4; ++nt) {
            const bf16x8 bf = *(const bf16x8*)(bp + (size_t)nt * 16 * 1024 + ks * 32);
            acc[nt] = __builtin_amdgcn_mfma_f32_16x16x32_bf16(bf, af, acc[nt], 0, 0, 0);
        }
    }
    const int row = r0 + fr;
    float part = 0.f;
#pragma unroll
    for (int nt = 0; nt < 4; ++nt) {
        const int col = c0 + nt * 16 + fq * 4;
        const f32x4 xo = FIRST ? *(const f32x4*)(xs + (size_t)(row - NTP) * 1024 + col) : ld_bf4(Xb + (size_t)row * 1024 + col);
        const f32x4 v = xo + acc[nt];
        st_bf4(Xb + (size_t)row * 1024 + col, v);
        part += dot4(v, v);
    }
    part += __shfl_xor(part, 16); part += __shfl_xor(part, 32);
    if (fq == 0) ssqp[(size_t)row * 16 + (c0 >> 6)] = part;
}

__device__ __forceinline__ void tr_tile(const Ctx cx, LAS float* T, const float* src, int ld, int col0, int k0, bf16_t* dst, int Ktot, int drow0, const float* scale, bool zero) {
    const int tid = cx.tid;
    if (zero) {
        const int n = tid >> 3, kc = (tid & 7) * 8;
        *(u32x4*)(dst + (size_t)(drow0 + n) * Ktot + k0 + kc) = (u32x4){0u, 0u, 0u, 0u};
        return;
    }
#pragma unroll
    for (int pass = 0; pass < 2; ++pass) {
        const int kk = (tid >> 4) + pass * 32, nn = (tid & 15) * 4;
        f32x4 v = *(const f32x4*)(src + (size_t)(k0 + kk) * ld + col0 + nn);
        if (scale) v = v * scale[k0 + kk];
        T[kk * 65 + nn] = v[0]; T[kk * 65 + nn + 1] = v[1]; T[kk * 65 + nn + 2] = v[2]; T[kk * 65 + nn + 3] = v[3];
    }
    __syncthreads();
    {
        const int n = tid >> 3, kc = (tid & 7) * 8;
        u32x4 w;
        w.x = cvt_pk_bf16(T[(kc + 0) * 65 + n], T[(kc + 1) * 65 + n]); w.y = cvt_pk_bf16(T[(kc + 2) * 65 + n], T[(kc + 3) * 65 + n]);
        w.z = cvt_pk_bf16(T[(kc + 4) * 65 + n], T[(kc + 5) * 65 + n]); w.w = cvt_pk_bf16(T[(kc + 6) * 65 + n], T[(kc + 7) * 65 + n]);
        *(u32x4*)(dst + (size_t)(drow0 + n) * Ktot + k0 + kc) = w;
    }
    __syncthreads();
}

__device__ void phase_prepass(const Params& p, const Ctx cx, LAS unsigned char* lds) {
    LAS float* T = (LAS float*)lds;
    const int tid = cx.tid;
    for (int job = cx.bid; job < 4544; job += cx.nblk) {
        int j = job;
        if (j < 2176) {
            const int i = j / 1088, r = j % 1088, nt = r / 16, kt = r % 16;
            const int n0 = nt * 64;
            int col0; bool zero = false;
            if (n0 < 2048) col0 = n0; else if (n0 < 2560) col0 = 3712 + (n0 - 2048); else if (n0 < 4224) col0 = 2048 + (n0 - 2560); else { col0 = 0; zero = true; }
            tr_tile(cx, T, PIN(I_WINE) + (size_t)i * 1024 * 4224, 4224, col0, kt * 64, (bf16_t*)(PWS + WS_WINE) + (size_t)i * 4352 * 1024, 1024, n0, PIN(I_NORMW) + (2 * i) * 1024, zero);
            continue;
        }
        j -= 2176;
        if (j < 512) { const int i = j / 256, r = j % 256, nt = r / 16, kt = r % 16;
            tr_tile(cx, T, PIN(I_WOUTE) + (size_t)i * 1024 * 1024, 1024, nt * 64, kt * 64, (bf16_t*)(PWS + WS_WOUTE) + (size_t)i * 1024 * 1024, 1024, nt * 64, nullptr, false); continue; }
        j -= 512;
        if (j < 1280) { const int i = j / 640, r = j % 640, nt = r / 16, kt = r % 16;
            tr_tile(cx, T, PIN(I_WINO) + (size_t)i * 1024 * 2560, 2560, nt * 64, kt * 64, (bf16_t*)(PWS + WS_WINO) + (size_t)i * 2560 * 1024, 1024, nt * 64, PIN(I_NORMW) + (2 * i + 1) * 1024, false); continue; }
        j -= 1280;
        if (j < 512) { const int i = j / 256, r = j % 256, nt = r / 16, kt = r % 16;
            tr_tile(cx, T, PIN(I_WOUTO) + (size_t)i * 1024 * 1024, 1024, nt * 64, kt * 64, (bf16_t*)(PWS + WS_WOUTO) + (size_t)i * 1024 * 1024, 1024, nt * 64, nullptr, false); continue; }
        j -= 512;
        if (j < 16) { const int i = j / 8, nt = j % 8;
            tr_tile(cx, T, PIN(I_W2) + (size_t)i * 64 * 512, 512, nt * 64, 0, (bf16_t*)(PWS + WS_W2T) + (size_t)i * 512 * 64, 64, nt * 64, nullptr, false); continue; }
        j -= 16;
        if (j < 16) { const int i = j / 8, nt = j % 8;
            tr_tile(cx, T, PIN(I_A2) + (size_t)i * 64 * 512, 512, nt * 64, 0, (bf16_t*)(PWS + WS_A2T) + (size_t)i * 512 * 64, 64, nt * 64, nullptr, false); continue; }
        j -= 16;
        { const int ig = j / 4, r = j % 4, nt = r / 2, kt = r % 2;
            tr_tile(cx, T, PIN(I_POOLW) + (size_t)ig * 128 * 128, 128, nt * 64, kt * 64, (bf16_t*)(PWS + WS_POOLWT) + (size_t)ig * 128 * 128, 128, nt * 64, nullptr, false); }
    }
    const int gtid = cx.bid * 512 + tid, gthreads = cx.nblk * 512;
    for (int e = gtid; e < 8 * 128 * 128; e += gthreads) {
        const int s = e & 127, t = (e >> 7) & 127;
        ((bf16_t*)(PWS + WS_SPW))[e] = (s <= t) ? (bf16_t)(cvt_pk_bf16(PIN(I_SPW)[e], 0.f) & 0xffffu) : (bf16_t)0;
    }
    const int wid = tid >> 6, lane = tid & 63;
    for (int row = cx.bid * 8 + wid; row < NTOK; row += cx.nblk * 8) {
        const float* src = row < NTP ? PIN(I_XP) + (size_t)row * 1024 : PIN(I_XS) + (size_t)(row - NTP) * 1024;
        bf16_t* dst = (bf16_t*)(PWS + WS_XB) + (size_t)row * 1024;
        float ss = 0.f;
#pragma unroll
        for (int i = 0; i < 4; ++i) { const f32x4 v = *(const f32x4*)(src + i * 256 + lane * 4); ss += dot4(v, v); st_bf4(dst + i * 256 + lane * 4, v); }
#pragma unroll
        for (int o = 32; o >= 1; o >>= 1) ss += __shfl_xor(ss, o);
        if (lane < 16) ((float*)(PWS + WS_SSQ))[(size_t)row * 16 + lane] = (lane == 0) ? ss : 0.f;
    }
}

__device__ __forceinline__ f32x4 shift4(const bf16_t* cur, bool hp, const float* st, int col, const float* mu) {
    const f32x4 q = ld_bf4(cur + col);
    f32x4 pv;
    if (hp) pv = ld_bf4(cur - LDB + col); else if (st) pv = *(const f32x4*)(st + col); else pv = (f32x4){0.f, 0.f, 0.f, 0.f};
    const f32x4 m = *(const f32x4*)(mu + col);
    return q + m * (pv - q);
}

__device__ void phase_even_prep(const Params& p, const Ctx cx, int pair, LAS unsigned char* lds) {
    const int tid = cx.tid, wid = tid >> 6, lane = tid & 63, fr = lane & 15, fq = lane >> 4;
    const bf16_t* PB = (const bf16_t*)(PWS + WS_PROJB);
    float* Wdec = (float*)(PWS + WS_WDEC);
    bf16_t* Aa = (bf16_t*)(PWS + WS_AA);
    bf16_t* Ycat = (bf16_t*)(PWS + WS_YCAT);
    const float* mu_ = PIN(I_MU) + pair * 1664;
    const float* w0_ = PIN(I_W0) + pair * 512; const float* a0_ = PIN(I_A0) + pair * 512;
    const float* k_a_ = PIN(I_KA) + pair * 512; const float* r_k_ = PIN(I_RK) + pair * 512;
    constexpr int RS = 3344;
    constexpr int TB = 17 * RS;
    constexpr int NCH = 17 * 208;
    const int h = wid;
    bf16x8 wfr[4][2], afr[4][2];
    {
        const bf16_t* W2T = (const bf16_t*)(PWS + WS_W2T) + (size_t)pair * 512 * 64;
        const bf16_t* A2T = (const bf16_t*)(PWS + WS_A2T) + (size_t)pair * 512 * 64;
#pragma unroll
        for (int nt = 0; nt < 4; ++nt)
#pragma unroll
            for (int ks = 0; ks < 2; ++ks) {
                wfr[nt][ks] = *(const bf16x8*)(W2T + (size_t)(h * 64 + nt * 16 + fr) * 64 + ks * 32 + fq * 8);
                afr[nt][ks] = *(const bf16x8*)(A2T + (size_t)(h * 64 + nt * 16 + fr) * 64 + ks * 32 + fq * 8);
            }
    }
    constexpr int buf = 0;
    for (int tile = cx.bid; tile < NTOK / 16; tile += cx.nblk) {
        int zz; asm volatile("v_mov_b32 %0, 0" : "=v"(zz));
        const int tidv = tid + zz, fr = (tidv & 15), fq = (tidv >> 4) & 3;
        {
            const int r0_ = tile * 16;
#pragma unroll
            for (int i_ = 0; i_ < 7; ++i_) {
                const int c_ = tidv + i_ * 512;
                if (c_ < NCH) { const int lr_ = c_ / 208, cc_ = c_ % 208; int gr_ = r0_ - 1 + lr_; gr_ = gr_ < 0 ? 0 : gr_;
                    *(LAS u32x4*)(lds + lr_ * RS + cc_ * 16) = *(const u32x4*)(PB + (size_t)gr_ * LDB + cc_ * 8); }
            }
        }
        __syncthreads();
        {
            const int row = tile * 16 + fr;
            const bool samp = row >= NTP;
            int b, t; if (!samp) { b = row >> 11; t = row & 2047; } else { const int q = row - NTP; b = q >> 3; t = q & 7; }
            const bool hp = t > 0;
            const float* st = samp ? PIN(I_SSHIFT) + ((size_t)pair * 128 + b) * 1664 : nullptr;
            const float* mu = mu_ + zz; const float* w0 = w0_ + zz; const float* a0 = a0_ + zz; const float* k_a = k_a_ + zz; const float* r_k = r_k_ + zz;
            LAS const unsigned char* curL = lds + buf * TB + (fr + 1) * RS;
            LAS const unsigned char* prvL = lds + buf * TB + fr * RS;
            auto sh4 = [&](int col) -> f32x4 {
                const f32x4 q = cvt4(*(LAS const u32x2*)(curL + col * 2));
                f32x4 pv;
                if (hp) pv = cvt4(*(LAS const u32x2*)(prvL + col * 2)); else if (st) pv = *(const f32x4*)(st + col); else pv = (f32x4){0.f, 0.f, 0.f, 0.f};
                const f32x4 m = *(const f32x4*)(mu + col);
                return q + m * (pv - q);
            };
            bf16x8 Aw[2], Al[2];
#pragma unroll
            for (int ks = 0; ks < 2; ++ks) {
                const int cw = 1536 + ks * 32 + fq * 8, ca = 1600 + ks * 32 + fq * 8;
                const f32x4 w_lo = sh4(cw), w_hi = sh4(cw + 4), a_lo = sh4(ca), a_hi = sh4(ca + 4);
                u32x4 pw, pa;
                float th[8];
#pragma unroll
                for (int j = 0; j < 4; ++j) { th[j] = 2.0f * sigmoidf_(2.0f * w_lo[j]) - 1.0f; th[4 + j] = 2.0f * sigmoidf_(2.0f * w_hi[j]) - 1.0f; }
                pw.x = cvt_pk_bf16(th[0], th[1]); pw.y = cvt_pk_bf16(th[2], th[3]); pw.z = cvt_pk_bf16(th[4], th[5]); pw.w = cvt_pk_bf16(th[6], th[7]);
                pa.x = cvt_pk_bf16(a_lo[0], a_lo[1]); pa.y = cvt_pk_bf16(a_lo[2], a_lo[3]); pa.z = cvt_pk_bf16(a_hi[0], a_hi[1]); pa.w = cvt_pk_bf16(a_hi[2], a_hi[3]);
                Aw[ks] = __builtin_bit_cast(bf16x8, pw); Al[ks] = __builtin_bit_cast(bf16x8, pa);
            }
            float bon = 0.f;
#pragma unroll
            for (int nt = 0; nt < 4; ++nt) {
                f32x4 lw = (f32x4){0.f, 0.f, 0.f, 0.f}, la = (f32x4){0.f, 0.f, 0.f, 0.f};
#pragma unroll
                for (int ks = 0; ks < 2; ++ks) {
                    lw = __builtin_amdgcn_mfma_f32_16x16x32_bf16(wfr[nt][ks], Aw[ks], lw, 0, 0, 0);
                    la = __builtin_amdgcn_mfma_f32_16x16x32_bf16(afr[nt][ks], Al[ks], la, 0, 0, 0);
                }
                const int ch = h * 64 + nt * 16 + fq * 4;
                const f32x4 r4 = sh4(ch), k4 = sh4(512 + ch);
                const f32x4 w04 = *(const f32x4*)(w0 + ch), a04 = *(const f32x4*)(a0 + ch), ka4 = *(const f32x4*)(k_a + ch), rk4 = *(const f32x4*)(r_k + ch);
                f32x4 dec, av;
#pragma unroll
                for (int j = 0; j < 4; ++j) {
                    const float z_ = -(w04[j] + lw[j]);
                    const float wlog = -__logf(1.0f + __expf(z_)) - 0.5f;
                    dec[j] = __expf(-__expf(wlog));
                    av[j] = sigmoidf_(a04[j] + la[j]);
                    const float kp = k4[j] * (1.0f + (av[j] - 1.0f) * ka4[j]);
                    bon += r4[j] * kp * rk4[j];
                }
                *(f32x4*)(Wdec + (size_t)row * 512 + ch) = dec;
                st_bf4(Aa + (size_t)row * 512 + ch, av);
            }
            bon += __shfl_xor(bon, 16); bon += __shfl_xor(bon, 32);
#pragma unroll
            for (int nt = 0; nt < 4; ++nt) { const int ch = h * 64 + nt * 16 + fq * 4; st_bf4(Ycat + (size_t)row * 1024 + 512 + ch, sh4(1024 + ch) * bon); }
        }
        __syncthreads();
    }
    const int gtid = cx.bid * 512 + tid, gthreads = cx.nblk * 512;
    for (int e = gtid; e < 136 * 1664; e += gthreads) {
        const int sr = e / 1664, c = e % 1664;
        if (sr < 8) POUT[O_SHIFTP + ((size_t)pair * 8 + sr) * 1664 + c] = bf2f(PB[(size_t)(sr * 2048 + 2047) * LDB + c]);
        else { const int b = sr - 8; POUT[O_SHIFTS + ((size_t)pair * 128 + b) * 1664 + c] = bf2f(PB[(size_t)(NTP + b * 8 + 7) * LDB + c]); }
    }
}

typedef float f32x2 __attribute__((ext_vector_type(2)));
template <bool RED = true>
__device__ __forceinline__ void scan_step(f32x4& S, const f32x4 w, const f32x4 k, const f32x4 kk, const f32x4 nb, const f32x4 r, const float v, float& y) {
    const f32x2 S01 = {S[0], S[1]}, S23 = {S[2], S[3]};
    f32x2 pp = S01 * (f32x2){kk[0], kk[1]};
    pp = S23 * (f32x2){kk[2], kk[3]} + pp;
    float pd = pp[0] + pp[1];
    const f32x2 vv = {v, v};
    const f32x2 t01 = S01 * (f32x2){w[0], w[1]} + (f32x2){k[0], k[1]} * vv;
    const f32x2 t23 = S23 * (f32x2){w[2], w[3]} + (f32x2){k[2], k[3]} * vv;
    pd = allsum16(pd);
    const f32x2 pdv = {pd, pd};
    const f32x2 n01 = (f32x2){nb[0], nb[1]} * pdv + t01, n23 = (f32x2){nb[2], nb[3]} * pdv + t23;
    S = (f32x4){n01[0], n01[1], n23[0], n23[1]};
    f32x2 q = n01 * (f32x2){r[0], r[1]};
    q = n23 * (f32x2){r[2], r[3]} + q;
    y = RED ? allsum16(q[0] + q[1]) : (q[0] + q[1]);
}
__device__ __forceinline__ float reduce_scatter16(const float (&yp)[16], int cgi) {
    const bool b3 = cgi & 8, b2 = cgi & 4, b1 = cgi & 2, b0 = cgi & 1;
    float a[8], bq[4], c[2];
#pragma unroll
    for (int j = 0; j < 8; ++j) { const float keep = b3 ? yp[8 + j] : yp[j], send = b3 ? yp[j] : yp[8 + j]; a[j] = keep + dpp_f<0x128>(send); }
#pragma unroll
    for (int k = 0; k < 4; ++k) { const float keep = b2 ? a[4 + k] : a[k], send = b2 ? a[k] : a[4 + k]; bq[k] = keep + dpp_f<0x141>(send); }
#pragma unroll
    for (int m = 0; m < 2; ++m) { const float keep = b1 ? bq[2 + m] : bq[m], send = b1 ? bq[m] : bq[2 + m]; c[m] = keep + dpp_f<0x4E>(send); }
    const float keep = b0 ? c[1] : c[0], send = b0 ? c[0] : c[1];
    return keep + dpp_f<0xB1>(send);
}

__device__ void phase_scan(const Params& p, const Ctx cx, int pair, LAS unsigned char* lds) {
    const int tid = cx.tid, wid = tid >> 6, lane = tid & 63, rs = lane >> 4, cgi = lane & 15;
    const bf16_t* PB = (const bf16_t*)(PWS + WS_PROJB);
    const float* Wdec = (const float*)(PWS + WS_WDEC);
    const bf16_t* Aa = (const bf16_t*)(PWS + WS_AA);
    float* Y = (float*)(PWS + WS_Y);
    const float* mu = PIN(I_MU) + pair * 1664;
    const float* k_k = PIN(I_KK) + pair * 512; const float* k_a = PIN(I_KA) + pair * 512;
    {
        LAS float* vb = (LAS float*)lds + wid * 3072;
        for (int st = cx.bid * 8 + wid; st < 2048; st += cx.nblk * 8) {
            const int bh = st >> 1, half = st & 1, b = bh >> 3, h = bh & 7, ch = h * 64 + cgi * 4;
            const float* stp = PIN(I_SSHIFT) + ((size_t)pair * 128 + b) * 1664;
            const f32x4 kkc = *(const f32x4*)(k_k + ch), kac = *(const f32x4*)(k_a + ch);
            {
#pragma unroll
                for (int tt = 0; tt < 2; ++tt) {
                    const int t = rs + tt * 4;
                    const size_t row = NTP + b * 8 + t;
                    const bf16_t* cur = PB + row * LDB;
                    const f32x4 r = shift4(cur, t > 0, stp, ch, mu), k = shift4(cur, t > 0, stp, 512 + ch, mu), v = shift4(cur, t > 0, stp, 1024 + ch, mu);
                    const f32x4 a = ld_bf4(Aa + row * 512 + ch);
                    const f32x4 w = *(const f32x4*)(Wdec + row * 512 + ch);
                    const f32x4 kkv = k * kkc;
                    const float ss = allsum16(dot4(kkv, kkv));
                    const float inv = 1.0f / fmaxf(sqrtf(ss), 1e-12f);
                    const f32x4 kkn = kkv * inv;
                    LAS float* o = vb + t * 384 + cgi * 4;
                    *(LAS f32x4*)(o) = w; *(LAS f32x4*)(o + 64) = k * (1.0f + (a - 1.0f) * kac); *(LAS f32x4*)(o + 128) = kkn; *(LAS f32x4*)(o + 192) = -(kkn * a);
                    *(LAS f32x4*)(o + 256) = r; *(LAS f32x4*)(o + 320) = v;
                }
            }
            asm volatile("s_waitcnt lgkmcnt(0)" ::: "memory");
            __builtin_amdgcn_wave_barrier();
#pragma unroll 1
            for (int rq = 0; rq < 8; ++rq) {
                const int ri = half * 32 + rq * 4 + rs;
                const size_t so = ((((size_t)pair * 128 + b) * 8 + h) * 64 + ri) * 64 + cgi * 4;
                f32x4 S = *(const f32x4*)(PIN(I_SWKV) + so);
#pragma unroll
                for (int t = 0; t < 8; ++t) {
                    LAS const float* r0 = vb + t * 384 + cgi * 4;
                    float y; scan_step(S, *(LAS const f32x4*)(r0), *(LAS const f32x4*)(r0 + 64), *(LAS const f32x4*)(r0 + 128), *(LAS const f32x4*)(r0 + 192), *(LAS const f32x4*)(r0 + 256), vb[t * 384 + 320 + ri], y);
                    if (cgi == 0) Y[(size_t)(NTP + b * 8 + t) * 512 + h * 64 + ri] = y;
                }
                *(f32x4*)(POUT + O_WKVS + so) = S;
            }
            asm volatile("s_waitcnt lgkmcnt(0)" ::: "memory");
            __builtin_amdgcn_wave_barrier();
        }
    }
    __syncthreads();
    LAS float* rec = (LAS float*)lds;
    for (int pt = cx.bid; pt < 256; pt += cx.nblk) {
        const int xcd = pt & 7, slot = pt >> 3, bh = xcd * 8 + (slot >> 2), rg = slot & 3, b = bh >> 3, h = bh & 7;
        const int lt = tid - 256, ls = (lt >> 4) & 15, lcg = lt & 15, lch = h * 64 + lcg * 4;
        u32x2 qr = {0u, 0u}, qk = {0u, 0u}, qv = {0u, 0u}, pr = {0u, 0u}, pk = {0u, 0u}, pv = {0u, 0u}, qa = {0u, 0u};
        f32x4 qw = (f32x4){0.f, 0.f, 0.f, 0.f};
        f32x4 mur, muk, muv, kkc, kac;
        const int ri = rg * 16 + (wid & 3) * 4 + rs;
        f32x4 S = (f32x4){0.f, 0.f, 0.f, 0.f};
#define SCAN_ISSUE(c) do { const int t_ = (c) * 16 + ls; const size_t row_ = (size_t)b * 2048 + t_; const bf16_t* cur_ = PB + row_ * LDB; \
            qr = *(const u32x2*)(cur_ + lch); qk = *(const u32x2*)(cur_ + 512 + lch); qv = *(const u32x2*)(cur_ + 1024 + lch); \
            if (t_ > 0) { pr = *(const u32x2*)(cur_ - LDB + lch); pk = *(const u32x2*)(cur_ - LDB + 512 + lch); pv = *(const u32x2*)(cur_ - LDB + 1024 + lch); } \
            else { pr = (u32x2){0u, 0u}; pk = pr; pv = pr; } \
            qw = *(const f32x4*)(Wdec + row_ * 512 + lch); qa = *(const u32x2*)(Aa + row_ * 512 + lch); } while (0)
#define SCAN_PROCESS(buf) do { const f32x4 r0_ = cvt4(qr), k0_ = cvt4(qk), v0_ = cvt4(qv); \
            const f32x4 r_ = r0_ + mur * (cvt4(pr) - r0_), k_ = k0_ + muk * (cvt4(pk) - k0_), v_ = v0_ + muv * (cvt4(pv) - v0_), a_ = cvt4(qa); \
            const f32x4 kkv_ = k_ * kkc; const float ss_ = allsum16(dot4(kkv_, kkv_)); const float inv_ = __builtin_amdgcn_rsqf(fmaxf(ss_, 1e-24f)); \
            const f32x4 kkn_ = kkv_ * inv_; \
            LAS float* o_ = rec + (buf) * 6144 + ls * 384 + lcg * 4; \
            *(LAS f32x4*)(o_) = qw; *(LAS f32x4*)(o_ + 64) = k_ * (1.0f + (a_ - 1.0f) * kac); *(LAS f32x4*)(o_ + 128) = kkn_; *(LAS f32x4*)(o_ + 192) = -(kkn_ * a_); \
            *(LAS f32x4*)(o_ + 256) = r_; *(LAS f32x4*)(o_ + 320) = v_; } while (0)
        if (wid >= 4) {
            mur = *(const f32x4*)(mu + lch); muk = *(const f32x4*)(mu + 512 + lch); muv = *(const f32x4*)(mu + 1024 + lch);
            kkc = *(const f32x4*)(k_k + lch); kac = *(const f32x4*)(k_a + lch);
            SCAN_ISSUE(0); SCAN_PROCESS(0); SCAN_ISSUE(1);
        }
        __syncthreads();
        for (int c = 0; c < 128; ++c) {
            if (wid < 4) {
                LAS const float* rb = rec + (c & 1) * 6144 + cgi * 4;
                LAS const float* rv = rec + (c & 1) * 6144 + 320 + ri;
                float yp[16];
                f32x4 nw = *(LAS const f32x4*)(rb), nk = *(LAS const f32x4*)(rb + 64), nkk = *(LAS const f32x4*)(rb + 128), nb = *(LAS const f32x4*)(rb + 192), nr = *(LAS const f32x4*)(rb + 256);
                float nv = rv[0];
#pragma unroll
                for (int s = 0; s < 16; ++s) {
                    const f32x4 cw = nw, ck = nk, ckk = nkk, cb = nb, cr = nr; const float cv = nv;
                    if (s + 1 < 16) {
                        LAS const float* r1 = rb + (s + 1) * 384;
                        nw = *(LAS const f32x4*)(r1); nk = *(LAS const f32x4*)(r1 + 64); nkk = *(LAS const f32x4*)(r1 + 128); nb = *(LAS const f32x4*)(r1 + 192); nr = *(LAS const f32x4*)(r1 + 256);
                        nv = rv[(s + 1) * 384];
                    }
                    scan_step<false>(S, cw, ck, ckk, cb, cr, cv, yp[s]);
                }
                Y[((size_t)b * 2048 + c * 16 + cgi) * 512 + h * 64 + ri] = reduce_scatter16(yp, cgi);
            } else {
                if (c + 1 < 128) { SCAN_PROCESS((c + 1) & 1); if (c + 2 < 128) SCAN_ISSUE(c + 2); }
            }
            __syncthreads();
        }
        if (wid < 4) *(f32x4*)(POUT + O_WKVP + ((((size_t)pair * 8 + b) * 8 + h) * 64 + ri) * 64 + cgi * 4) = S;
#undef SCAN_ISSUE
#undef SCAN_PROCESS
    }
}

__device__ void phase_even_post(const Params& p, const Ctx cx, int pair) {
    const int gtid = cx.bid * 512 + cx.tid, gthreads = cx.nblk * 512;
    const bf16_t* PA = (const bf16_t*)(PWS + WS_R1);
    bf16_t* Ycat = (bf16_t*)(PWS + WS_YCAT);
    const float* Y = (const float*)(PWS + WS_Y);
    constexpr int NIT = NTOK * 128, UB = 4;
    const float* gn_g = PIN(I_GNG) + pair * 512; const float* gn_b = PIN(I_GNB) + pair * 512;
    for (int e0 = gtid; e0 < NIT; e0 += gthreads * UB) {
        f32x4 y[UB], bv[UB], bz[UB]; bool ok[UB];
#pragma unroll
        for (int u = 0; u < UB; ++u) {
            const int e = e0 + u * gthreads; ok[u] = e < NIT;
            const int ee = ok[u] ? e : e0; const int row = ee >> 7, ch = (ee & 127) * 4;
            y[u] = *(const f32x4*)(Y + (size_t)row * 512 + ch);
            bv[u] = ld_bf4(Ycat + (size_t)row * 1024 + 512 + ch);
            bz[u] = ld_bf4(PA + (size_t)row * LDA + 2048 + ch);
        }
#pragma unroll
        for (int u = 0; u < UB; ++u) {
            const int e = e0 + u * gthreads;
            const int ee = ok[u] ? e : e0; const int row = ee >> 7, ch = (ee & 127) * 4;
            const float mean = allsum16(y[u][0] + y[u][1] + y[u][2] + y[u][3]) * (1.0f / 64.0f);
            const f32x4 d = y[u] - mean;
            const float var = allsum16(dot4(d, d)) * (1.0f / 64.0f);
            const float rstd = rsqrtf(var + 64e-5f);
            const f32x4 g = *(const f32x4*)(gn_g + ch), bb = *(const f32x4*)(gn_b + ch);
            f32x4 o;
#pragma unroll
            for (int j = 0; j < 4; ++j) o[j] = (d[j] * rstd * g[j] + bb[j] + bv[u][j]) * siluf_(bz[u][j]);
            if (ok[u]) st_bf4(Ycat + (size_t)row * 1024 + 512 + ch, o);
        }
    }
    const float* cw = PIN(I_CONVW) + pair * 3 * 512;
    for (int e0 = gtid; e0 < NIT; e0 += gthreads * UB) {
        f32x4 h0[UB], c0v[UB], h1[UB], c1v[UB], h2[UB], c2v[UB], ab[UB], az[UB]; bool ok[UB];
#pragma unroll
        for (int u = 0; u < UB; ++u) {
            const int e = e0 + u * gthreads; ok[u] = e < NIT;
            const int ee = ok[u] ? e : e0; const int row = ee >> 7, ch = (ee & 127) * 4;
            const int t = row < NTP ? (row & 2047) : ((row - NTP) & 7);
            const bf16_t* cur = PA + (size_t)row * LDA + ch;
            const bf16_t* p1 = t >= 1 ? cur - LDA : cur; const bf16_t* p2 = t >= 2 ? cur - 2 * LDA : cur;
            h0[u] = ld_bf4(cur); c0v[u] = ld_bf4(cur + 1024); h1[u] = ld_bf4(p1); c1v[u] = ld_bf4(p1 + 1024); h2[u] = ld_bf4(p2); c2v[u] = ld_bf4(p2 + 1024);
            ab[u] = ld_bf4(cur + 512); az[u] = ld_bf4(cur + 1536);
        }
#pragma unroll
        for (int u = 0; u < UB; ++u) {
            const int e = e0 + u * gthreads;
            const int ee = ok[u] ? e : e0; const int row = ee >> 7, ch = (ee & 127) * 4;
            const bool samp = row >= NTP;
            int b, t, T; if (!samp) { b = row >> 11; t = row & 2047; T = 2048; } else { const int q = row - NTP; b = q >> 3; t = q & 7; T = 8; }
            const f32x4 u0 = c0v[u] * h0[u];
            f32x4 u1 = c1v[u] * h1[u], u2 = c2v[u] * h2[u];
            if (t < 2) {
                const f32x4 zero = (f32x4){0.f, 0.f, 0.f, 0.f};
                const float* hist = PIN(I_SCONV) + ((size_t)pair * 128 + (samp ? b : 0)) * 2 * 512 + ch;
                if (t == 0) { u1 = samp ? *(const f32x4*)(hist + 512) : zero; u2 = samp ? *(const f32x4*)(hist) : zero; }
                else { u2 = samp ? *(const f32x4*)(hist + 512) : zero; }
            }
            const f32x4 k0 = *(const f32x4*)(cw + ch), k1 = *(const f32x4*)(cw + 512 + ch), k2 = *(const f32x4*)(cw + 1024 + ch);
            const f32x4 conv = k0 * u2 + k1 * u1 + k2 * u0;
            f32x4 o;
#pragma unroll
            for (int j = 0; j < 4; ++j) o[j] = ab[u][j] * conv[j] * siluf_(az[u][j]);
            if (ok[u]) {
                st_bf4(Ycat + (size_t)row * 1024 + ch, o);
                if (t >= T - 2) {
                    float* dst = samp ? POUT + O_CONVS + (((size_t)pair * 128 + b) * 2 + (t - (T - 2))) * 512 + ch : POUT + O_CONVP + (((size_t)pair * 8 + b) * 2 + (t - (T - 2))) * 512 + ch;
                    *(f32x4*)dst = u0;
                }
            }
        }
    }
}

__device__ void phase_odd_mixer(const Params& p, const Ctx cx, int pair, LAS unsigned char* lds) {
    const int tid = cx.tid, wid = tid >> 6, lane = tid & 63, fr = lane & 15, fq = lane >> 4;
    const bf16_t* PO = (const bf16_t*)(PWS + WS_R1);
    bf16_t* Ycat = (bf16_t*)(PWS + WS_YCAT);
    LAS bf16_t* LA = (LAS bf16_t*)lds;
    LAS bf16_t* LB = (LAS bf16_t*)(lds + 128 * 136 * 2);
    LAS float* stat = (LAS float*)(lds + 2 * 128 * 136 * 2);
    LAS float* LE = (LAS float*)(lds + 128 * 136 * 2);
    LAS bf16_t* LW = (LAS bf16_t*)(lds + 128 * 136 * 2 + 143 * 128 * 4);
    for (int tile = cx.bid; tile < 136; tile += cx.nblk) {
        const int r0 = tile * 128;
        const bool samp = r0 >= NTP;
        const int tl_ = tid >> 2, q_ = tid & 3;
        {
            const bf16_t* vr = PO + (size_t)(r0 + tl_) * LDA + 1536 + q_ * 128;
            float s_ = 0.f, ss = 0.f;
#pragma unroll
            for (int i = 0; i < 16; ++i) { const u32x4 raw = *(const u32x4*)(vr + i * 8); const f32x4 v0 = cvt4((u32x2){raw.x, raw.y}), v1 = cvt4((u32x2){raw.z, raw.w});
                s_ += (v0[0] + v0[1]) + (v0[2] + v0[3]) + (v1[0] + v1[1]) + (v1[2] + v1[3]); ss += dot4(v0, v0) + dot4(v1, v1); }
            s_ = allsum4(s_); ss = allsum4(ss);
            const float mean = s_ * (1.0f / 512.0f);
            const float var = fmaxf(ss * (1.0f / 512.0f) - mean * mean, 0.f);
            if (q_ == 0) { stat[tl_ * 2] = mean; stat[tl_ * 2 + 1] = rsqrtf(var + 1e-5f); }
        }
        u32x2 rv[8]; u32x4 rw[4];
#define MIX_LOAD_G(gg) do { const bf16_t* vr_ = PO + (size_t)(r0 + tl_) * LDA + 1536 + (gg) * 128 + q_ * 32; \
            _Pragma("unroll") for (int i = 0; i < 8; ++i) rv[i] = *(const u32x2*)(vr_ + i * 4); \
            if (!samp) { const bf16_t* Ws_ = (const bf16_t*)(PWS + WS_SPW) + ((size_t)pair * 4 + (gg)) * 128 * 128; \
                _Pragma("unroll") for (int i = 0; i < 4; ++i) { const int e = tid + i * 512; rw[i] = *(const u32x4*)(Ws_ + (e >> 4) * 128 + (e & 15) * 8); } } } while (0)
        MIX_LOAD_G(0);
        __syncthreads();
#pragma unroll 1
        for (int g = 0; g < 4; ++g) {
            u32x2 ur[8], dzr[8];
#pragma unroll
            for (int nt = 0; nt < 8; ++nt) { const size_t o_ = (size_t)(r0 + wid * 16 + fr) * LDA + g * 128 + nt * 16 + fq * 4; ur[nt] = *(const u32x2*)(PO + o_ + 1024); dzr[nt] = *(const u32x2*)(PO + o_ + 2048); }
            {
                const int row = r0 + tl_;
                const float mean = stat[tl_ * 2], rstd = stat[tl_ * 2 + 1];
                const float* lg = PIN(I_LNG) + pair * 512 + g * 128 + q_ * 32; const float* lb = PIN(I_LNB) + pair * 512 + g * 128 + q_ * 32;
#pragma unroll
                for (int i = 0; i < 8; ++i) {
                    const f32x4 v = cvt4(rv[i]);
                    const f32x4 vn = (v - mean) * rstd * *(const f32x4*)(lg + i * 4) + *(const f32x4*)(lb + i * 4);
                    if (samp) *(f32x4*)(POUT + O_CHUNKV + ((size_t)pair * 1024 + (row - NTP)) * 512 + g * 128 + q_ * 32 + i * 4) = vn;
#pragma unroll
                    for (int j = 0; j < 4; ++j) LB[(q_ * 32 + i * 4 + j) * 136 + tl_] = (bf16_t)(cvt_pk_bf16(vn[j], 0.f) & 0xffffu);
                }
            }
            if (!samp) {
#pragma unroll
                for (int i = 0; i < 4; ++i) { const int e = tid + i * 512; *(LAS u32x4*)(LA + (e >> 4) * 136 + (e & 15) * 8) = rw[i]; }
            } else {
                const float* Wsrc = PIN(I_SPW) + ((size_t)pair * 4 + g) * 128 * 128;
                for (int e = tid; e < 128 * 128; e += 512) { const int t = e >> 7, s2 = e & 127;
                    const float v = ((t >> 3) == (s2 >> 3) && (s2 & 7) <= (t & 7)) ? Wsrc[(t & 7) * 128 + (s2 & 7)] : 0.f;
                    LA[t * 136 + s2] = (bf16_t)(cvt_pk_bf16(v, 0.f) & 0xffffu); }
            }
            if (g + 1 < 4) MIX_LOAD_G(g + 1);
            __syncthreads();
            {
                const int tl = wid * 16 + fr, row = r0 + tl;
                const float bias = PIN(I_SPB)[((size_t)pair * 4 + g) * 128 + (samp ? (tl & 7) : tl)];
                bf16x8 wf[4];
#pragma unroll
                for (int ks = 0; ks < 4; ++ks) wf[ks] = *(const LAS bf16x8*)(LA + tl * 136 + ks * 32 + fq * 8);
#pragma unroll
                for (int nt = 0; nt < 8; ++nt) {
                    f32x4 acc = (f32x4){0.f, 0.f, 0.f, 0.f};
#pragma unroll
                    for (int ks = 0; ks < 4; ++ks) {
                        if (ks * 32 <= wid * 16 + 15) {
                            const bf16x8 vf = *(const LAS bf16x8*)(LB + (nt * 16 + fr) * 136 + ks * 32 + fq * 8);
                            acc = __builtin_amdgcn_mfma_f32_16x16x32_bf16(vf, wf[ks], acc, 0, 0, 0);
                        }
                    }
                    const int c = g * 128 + nt * 16 + fq * 4;
                    const f32x4 u = cvt4(ur[nt]), dz = cvt4(dzr[nt]);
                    f32x4 o;
#pragma unroll
                    for (int j = 0; j < 4; ++j) o[j] = u[j] * (acc[j] + bias) * siluf_(dz[j]);
                    st_bf4(Ycat + (size_t)row * 1024 + 512 + c, o);
                }
            }
            __syncthreads();
        }
#undef MIX_LOAD_G
    }
    {
        int ci, cstride;
        if (cx.nblk == 256) { if (cx.bid < 136) { ci = cx.bid; cstride = 1 << 20; } else { ci = cx.bid; cstride = 120; } }
        else { ci = cx.bid; cstride = cx.nblk; }
        u32x4 pw[4]; u32x2 pe[9];
#define MIX_LOAD_C(cc) do { const int tile_ = (cc) >> 2, g_ = (cc) & 3, r0_ = tile_ * 128; \
            const bf16_t* Bw_ = (const bf16_t*)(PWS + WS_POOLWT) + ((size_t)pair * 4 + g_) * 128 * 128; \
            _Pragma("unroll") for (int i = 0; i < 4; ++i) { const int e = tid + i * 512; pw[i] = *(const u32x4*)(Bw_ + (e >> 4) * 128 + (e & 15) * 8); } \
            if (r0_ < NTP) { const int t0_ = r0_ & 2047; \
                _Pragma("unroll") for (int i = 0; i < 9; ++i) { const int e = tid + i * 512, er = e >> 5, c = (e & 31) * 4; pe[i] = (u32x2){0u, 0u}; \
                    if (e < 143 * 32 && t0_ + er - 15 >= 0) pe[i] = *(const u32x2*)(PO + (size_t)(r0_ + er - 15) * LDA + g_ * 128 + c); } } } while (0)
        if (ci < 544) MIX_LOAD_C(ci);
        for (; ci < 544; ci += cstride) {
            const int tile = ci >> 2, g = ci & 3, r0 = tile * 128;
            const bool samp = r0 >= NTP;
            const int w = 2 << g;
            const int row = r0 + wid * 16 + fr;
            u32x2 czr[8]; f32x4 psr[8];
#pragma unroll
            for (int nt = 0; nt < 8; ++nt) { const int d = g * 128 + nt * 16 + fq * 4; czr[nt] = *(const u32x2*)(PO + (size_t)row * LDA + 512 + d); psr[nt] = *(const f32x4*)(PIN(I_PSCALE) + pair * 512 + d); }
#pragma unroll
            for (int i = 0; i < 4; ++i) { const int e = tid + i * 512; *(LAS u32x4*)(LW + (e >> 4) * 136 + (e & 15) * 8) = pw[i]; }
            if (!samp) {
                const int t0 = r0 & 2047;
#pragma unroll
                for (int i = 0; i < 9; ++i) { const int e = tid + i * 512, er = e >> 5, c = (e & 31) * 4; if (e < 143 * 32) *(LAS f32x4*)(LE + er * 128 + c) = cvt4(pe[i]); }
                __syncthreads();
                {
                    const int c = (tid & 31) * 4, tl0 = (tid >> 5) * 8;
                    f32x4 sum = (f32x4){0.f, 0.f, 0.f, 0.f};
#pragma unroll 4
                    for (int d = 0; d < w; ++d) sum += *(LAS const f32x4*)(LE + (tl0 + 15 - d) * 128 + c);
#pragma unroll
                    for (int k = 0; k < 8; ++k) {
                        const int tl = tl0 + k;
                        const f32x4 pt = *(LAS const f32x4*)(LE + (tl + 15) * 128 + c);
                        if (k > 0) sum += pt - *(LAS const f32x4*)(LE + (tl + 15 - w) * 128 + c);
                        const float cnt = fminf((float)w, (float)(t0 + tl + 1));
                        const f32x4 pooled = sum * (1.0f / cnt) - pt;
                        u32x2 u; u.x = cvt_pk_bf16(pooled[0], pooled[1]); u.y = cvt_pk_bf16(pooled[2], pooled[3]);
                        *(LAS u32x2*)(LA + tl * 136 + c) = u;
                    }
                }
            } else {
                for (int e = tid; e < 128 * 32; e += 512) {
                    const int tl = e >> 5, c = (e & 31) * 4, rowe = r0 + tl;
                    const int q = rowe - NTP, b = q >> 3, t = q & 7;
                    const bf16_t* cur = PO + (size_t)rowe * LDA + g * 128 + c;
                    const f32x4 pt = ld_bf4(cur);
                    f32x4 sum = pt;
                    for (int d = 1; d < w; ++d) {
                        const int tt = t - d;
                        if (tt >= 0) sum += ld_bf4(cur - (size_t)d * LDA);
                        else sum += *(const f32x4*)(PIN(I_SPOOL) + (((size_t)pair * 128 + b) * 15 + (15 + tt)) * 512 + g * 128 + c);
                    }
                    const f32x4 pooled = sum * (1.0f / (float)w) - pt;
                    u32x2 u; u.x = cvt_pk_bf16(pooled[0], pooled[1]); u.y = cvt_pk_bf16(pooled[2], pooled[3]);
                    *(LAS u32x2*)(LA + tl * 136 + c) = u;
                }
            }
            if (ci + cstride < 544) MIX_LOAD_C(ci + cstride);
            __syncthreads();
            bf16x8 af[4];
#pragma unroll
            for (int ks = 0; ks < 4; ++ks) af[ks] = *(const LAS bf16x8*)(LA + (wid * 16 + fr) * 136 + ks * 32 + fq * 8);
#pragma unroll
            for (int nt = 0; nt < 8; ++nt) {
                f32x4 acc = (f32x4){0.f, 0.f, 0.f, 0.f};
#pragma unroll
                for (int ks = 0; ks < 4; ++ks) {
                    const bf16x8 bf = *(const LAS bf16x8*)(LW + (nt * 16 + fr) * 136 + ks * 32 + fq * 8);
                    acc = __builtin_amdgcn_mfma_f32_16x16x32_bf16(bf, af[ks], acc, 0, 0, 0);
                }
                const int d = g * 128 + nt * 16 + fq * 4;
                const f32x4 cz = cvt4(czr[nt]), ps = psr[nt];
                f32x4 o;
#pragma unroll
                for (int j = 0; j < 4; ++j) o[j] = acc[j] * ps[j] * siluf_(cz[j]);
                st_bf4(Ycat + (size_t)row * 1024 + d, o);
            }
            __syncthreads();
        }
#undef MIX_LOAD_C
    }
    const int gtid = cx.bid * 512 + tid, gthreads = cx.nblk * 512;
    for (int e = gtid; e < 136 * 15 * 512; e += gthreads) {
        const int c = e & 511, q = e >> 9, sr = q / 15, k = q % 15;
        if (sr < 8) POUT[O_POOLP + (((size_t)pair * 8 + sr) * 15 + k) * 512 + c] = bf2f(PO[(size_t)(sr * 2048 + 2033 + k) * LDA + c]);
        else { const int b = sr - 8;
            POUT[O_POOLS + (((size_t)pair * 128 + b) * 15 + k) * 512 + c] = (k < 7) ? PIN(I_SPOOL)[(((size_t)pair * 128 + b) * 15 + 8 + k) * 512 + c] : bf2f(PO[(size_t)(NTP + b * 8 + (k - 7)) * LDA + c]); }
    }
}

__device__ void phase_final(const Params& p, const Ctx cx) {
    const int gtid = cx.bid * 512 + cx.tid, gthreads = cx.nblk * 512;
    const float* ssq = (const float*)(PWS + WS_SSQ) + (size_t)4 * NTOK * 16;
    const bf16_t* Xb = (const bf16_t*)(PWS + WS_XB);
    constexpr int NIT = NTOK * 256, UB = 4;
    for (int e0 = gtid; e0 < NIT; e0 += gthreads * UB) {
        f32x4 x[UB]; float sq[UB]; bool ok[UB];
#pragma unroll
        for (int u = 0; u < UB; ++u) { const int e = e0 + u * gthreads; ok[u] = e < NIT; const int ee = ok[u] ? e : e0; const int row = ee >> 8, c = (ee & 255) * 4;
            x[u] = ld_bf4(Xb + (size_t)row * 1024 + c); sq[u] = ssq_sum(ssq + (size_t)row * 16); }
#pragma unroll
        for (int u = 0; u < UB; ++u) { const int e = e0 + u * gthreads; const int ee = ok[u] ? e : e0; const int row = ee >> 8, c = (ee & 255) * 4;
            const float rstd = rsqrtf(sq[u] * (1.0f / 1024.0f) + 1e-6f);
            if (ok[u]) *(f32x4*)(POUT + (size_t)row * 1024 + c) = x[u] * rstd * *(const f32x4*)(PIN(I_FNORMW) + c); }
    }
}

#define XB_TMO      128
#define XB_XCNT(j)  (256  + 64 * (j))
#define XB_XSUB(j)  (1280 + 64 * (j))
#define XB_XGEN(j)  (2304 + 64 * (j))
#define XB_TOP      3328
#define XB_TOPGEN   3392
#define XCD_BAR_WORDS 3456
#define XB_SPIN_CAP (1u << 18)
__device__ __forceinline__ unsigned xb_ld(unsigned* p)              { return __hip_atomic_load(p, __ATOMIC_RELAXED, __HIP_MEMORY_SCOPE_AGENT); }
__device__ __forceinline__ unsigned xb_add(unsigned* p, unsigned v) { return __hip_atomic_fetch_add(p, v, __ATOMIC_RELAXED, __HIP_MEMORY_SCOPE_AGENT); }
__device__ __forceinline__ unsigned xb_xcc_id() { return (unsigned)__builtin_amdgcn_s_getreg((3 << 11) | 20) & 0xFu; }
#define XB_SPIN(cond, bar) do { unsigned _sp = 0; while (cond) { __builtin_amdgcn_s_sleep(1); \
    if ((++_sp & 255u) == 0u) { if (xb_ld(&(bar)[XB_TMO])) break; if (_sp > XB_SPIN_CAP) { atomicAdd(&(bar)[XB_TMO], 1u); break; } } } } while (0)
struct XcdBarrier { unsigned* bar; unsigned x; volatile LAS unsigned* st; };
__device__ __forceinline__ XcdBarrier xcd_barrier_post(unsigned* bar, volatile LAS unsigned* st) {
    XcdBarrier b; b.bar = bar; b.x = xb_xcc_id(); b.st = st;
    if (threadIdx.x == 0) (void)xb_add(&bar[XB_XCNT(b.x)], 1u);
    return b;
}
__device__ __forceinline__ void xcd_barrier_complete(unsigned* bar, unsigned x, unsigned& nloc, unsigned& nx) {
    const unsigned G = gridDim.x * gridDim.y * gridDim.z;
    unsigned sum, cnt, mine, sp = 0u;
    for (;;) {
        sum = 0u; cnt = 0u; mine = 0u;
#pragma unroll
        for (unsigned j = 0; j < 16; ++j) { const unsigned c = xb_ld(&bar[XB_XCNT(j)]); sum += c; cnt += (c > 0u) ? 1u : 0u; mine = (j == x) ? c : mine; }
        if (sum == G) break;
        __builtin_amdgcn_s_sleep(1);
        if ((++sp & 255u) == 0u) { if (xb_ld(&bar[XB_TMO])) break; if (sp > XB_SPIN_CAP) { atomicAdd(&bar[XB_TMO], 1u); break; } }
    }
    nloc = mine > 0u ? mine : 1u; nx = cnt > 0u ? cnt : 1u;
}
__device__ __forceinline__ void xcd_barrier(const XcdBarrier& b) {
    asm volatile("s_waitcnt vmcnt(0)" ::: "memory");
    __syncthreads();
    if (threadIdx.x == 0) {
        unsigned* bar = b.bar;
        __builtin_amdgcn_s_waitcnt(0);
        unsigned nloc = b.st[0], nx = b.st[1];
        if (nloc == 0u) { xcd_barrier_complete(bar, b.x, nloc, nx); b.st[0] = nloc; b.st[1] = nx; }
        const unsigned old = xb_add(&bar[XB_XSUB(b.x)], 1u);
        const unsigned gen = old / nloc;
        if (old + 1u == (gen + 1u) * nloc) {
            __builtin_amdgcn_fence(__ATOMIC_RELEASE, "agent");
            asm volatile("s_waitcnt vmcnt(0)" ::: "memory");
            const unsigned og = xb_add(&bar[XB_TOP], 1u);
            const unsigned tg = og / nx;
            if (og + 1u == (tg + 1u) * nx) xb_add(&bar[XB_TOPGEN], 1u);
            else XB_SPIN(xb_ld(&bar[XB_TOPGEN]) == tg, bar);
            __builtin_amdgcn_fence(__ATOMIC_ACQUIRE, "agent");
            xb_add(&bar[XB_XGEN(b.x)], 1u);
            asm volatile("s_waitcnt vmcnt(0)" ::: "memory");
        } else {
            XB_SPIN(xb_ld(&bar[XB_XGEN(b.x)]) == gen, bar);
            __builtin_amdgcn_fence(__ATOMIC_ACQUIRE, "agent");
            asm volatile("s_waitcnt vmcnt(0)" ::: "memory");
        }
    }
    __syncthreads();
}

__device__ void run_gemm_proj(const Params& p, const Ctx cx, LAS unsigned char* lds, const bf16_t* Bt, int N, bf16_t* O, int ldc, int layer) {
    pg8::Gemm g{(const bf16_t*)(PWS + WS_XB), Bt, NTOK, N, 1024};
    pg8::StaticOrder S; S.init(NTOK, N, (int)cx.nblk, (int)cx.bid);
    const float* ssq = (const float*)(PWS + WS_SSQ) + (size_t)layer * NTOK * 16;
    LAS float* rl = (LAS float*)(lds + 131072);
    int pm0 = -1, pm1 = -1, pm2 = -1, pm3 = -1, np = 0;
    for (int i = 0; i < 64; ++i) {
        pg8::Unit u; if (!S.next(i, u)) break;
        if (u.pm == pm0 || u.pm == pm1 || u.pm == pm2 || u.pm == pm3) continue;
        if (np == 0) pm0 = u.pm; else if (np == 1) pm1 = u.pm; else if (np == 2) pm2 = u.pm; else pm3 = u.pm;
        ++np;
    }
    for (int r = cx.tid; r < np * 256; r += 512) {
        const int i = r >> 8, pm = i == 0 ? pm0 : (i == 1 ? pm1 : (i == 2 ? pm2 : pm3));
        rl[r] = rsqrtf(ssq_sum(ssq + (size_t)(pm * 256 + (r & 255)) * 16) * (1.0f / 1024.0f) + 1e-6f);
    }
    __syncthreads();
    EpiProj E{O, ldc, rl, pm0, pm1, pm2, pm3};
    pg8::gemm_phase<EpiProj>(cx, lds, g, S, E);
}
__device__ void run_gemm_res(const Params& p, const Ctx cx, LAS unsigned char* lds, const bf16_t* Bt, int layer) {
    const bf16_t* A = (const bf16_t*)(PWS + WS_YCAT);
    bf16_t* Xb = (bf16_t*)(PWS + WS_XB);
    float* ssqn = (float*)(PWS + WS_SSQ) + (size_t)(layer + 1) * NTOK * 16;
    pg8::Gemm g{A, Bt, NTOK, 1024, 1024};
    pg8::StaticOrder S; S.init(NTOK, 1024, (int)cx.nblk, (int)cx.bid);
    EpiRes E{layer == 0 ? PIN(I_XP) : nullptr, PIN(I_XS), Xb, ssqn};
    pg8::gemm_phase<EpiRes>(cx, lds, g, S, E);
}

constexpr int N_PHASES = 20;
#ifndef PHMASK
#define PHMASK 0xffff
#endif
#define PHON(n) ((PHMASK >> ((n) % 16)) & 1)
__global__ void __launch_bounds__(512, 2) fwd_kernel(Params p) {
    extern __shared__ __attribute__((aligned(16))) unsigned char lds_raw[];
    LAS unsigned char* lds = (LAS unsigned char*)lds_raw;
    volatile LAS unsigned* bar_st = (volatile LAS unsigned*)(lds + LDS_MAIN);
    if (threadIdx.x < 4) bar_st[threadIdx.x] = 0u;
    __syncthreads();
    const XcdBarrier gbar = xcd_barrier_post((unsigned*)((unsigned char*)p.ptr[30] + WS_BAR), bar_st);
    if (p.ph_hi < 0) cg::this_grid().sync();
#define GRID_SYNC() xcd_barrier(gbar)
#ifdef SYNCPROBE
    for (int i = 0; i < SYNCPROBE; ++i) GRID_SYNC();
#endif
#ifdef REPMASK
    for (int pc = p.ph_lo * 2; pc < p.ph_hi * 2; ++pc) {
        const int ph = pc >> 1;
        { const int s_ = (ph == 0) ? 9 : (ph == N_PHASES - 1) ? 31 : (ph - 1) % 9; if ((pc & 1) && !((REPMASK >> s_) & 1)) continue; }
        if (pc > p.ph_lo * 2) GRID_SYNC();
#else
    for (int ph = p.ph_lo; ph < p.ph_hi; ++ph) {
        if (ph > p.ph_lo) GRID_SYNC();
#endif
        Ctx cx; cx.tid = threadIdx.x; cx.bid = blockIdx.x; cx.nblk = gridDim.x;
        asm volatile("s_mov_b32 %0, 0" : "=s"(cx.z));
        asm volatile("" : "+v"(cx.tid)); asm volatile("" : "+s"(cx.bid)); asm volatile("" : "+s"(cx.nblk));
        const int pair = (ph - 1) / 9, s = (ph == 0) ? 100 : (ph == N_PHASES - 1 ? 101 : (ph - 1) % 9);
        if (s == 0 || s == 3 || s == 6) {
#if PHON(0)
            const bf16_t* WinE = (const bf16_t*)(PWS + WS_WINE) + (size_t)pair * 4352 * 1024;
            const bf16_t* Bt = s == 0 ? WinE + (size_t)2560 * 1024 : (s == 3 ? WinE : (const bf16_t*)(PWS + WS_WINO) + (size_t)pair * 2560 * 1024);
            const int N = s == 0 ? 1792 : 2560;
            run_gemm_proj(p, cx, lds, Bt, N, (bf16_t*)(PWS + WS_R1), N, 2 * pair + (s == 6 ? 1 : 0));
#endif
        } else if (s == 5 || s == 8) {
#if PHON(5)
            const bf16_t* Bt = (const bf16_t*)(PWS + (s == 5 ? WS_WOUTE : WS_WOUTO)) + (size_t)pair * 1024 * 1024;
            run_gemm_res(p, cx, lds, Bt, 2 * pair + (s == 8 ? 1 : 0));
#endif
        } else if (s == 1) {
#if PHON(1)
            phase_even_prep(p, cx, pair, lds);
#endif
        } else if (s == 2) {
#if PHON(2)
            phase_scan(p, cx, pair, lds);
#endif
        } else if (s == 4) {
#if PHON(4)
            phase_even_post(p, cx, pair);
#endif
        } else if (s == 7) {
#if PHON(7)
            phase_odd_mixer(p, cx, pair, lds);
#endif
        } else if (s == 100) {
#if PHON(10)
            phase_prepass(p, cx, lds);
#endif
        } else {
#if PHON(11)
            phase_final(p, cx);
#endif
        }
    }
}

extern "C" void kernel_launch(void* const* d_in, const int* in_sizes, int n_in, void* d_out, int out_size, void* d_ws, size_t ws_size, hipStream_t stream) {
    static int grid = 0;
    if (grid == 0) {
        if (n_in != 29 || ws_size < WS_END) { fprintf(stderr, "kernel_launch: unexpected n_in %d / ws_size %zu (need %zu)\n", n_in, ws_size, (size_t)WS_END); grid = -1; return; }
        int dev = 0, cus = 0, per_cu = 0;
        hipGetDevice(&dev);
        hipDeviceGetAttribute(&cus, hipDeviceAttributeMultiprocessorCount, dev);
        if (hipFuncSetAttribute((const void*)fwd_kernel, hipFuncAttributeMaxDynamicSharedMemorySize, LDS_BYTES) != hipSuccess) { fprintf(stderr, "kernel_launch: hipFuncSetAttribute failed\n"); grid = -1; return; }
        if (hipOccupancyMaxActiveBlocksPerMultiprocessor(&per_cu, (const void*)fwd_kernel, 512, LDS_BYTES) != hipSuccess || per_cu < 1) { fprintf(stderr, "kernel_launch: occupancy query gave %d\n", per_cu); per_cu = 1; }
        (void)hipGetLastError();
        grid = cus * per_cu;
        if (grid > 256) grid = 256;
    }
    if (grid < 0) return;
    Params p{};
    for (int i = 0; i < 29; ++i) p.ptr[i] = d_in[i];
    p.ptr[29] = d_out; p.ptr[30] = d_ws; p.ptr[31] = nullptr;
    (void)hipMemsetAsync((unsigned char*)d_ws + WS_BAR, 0, 16384, stream);
#if ONE_LAUNCH
    p.ph_lo = 0; p.ph_hi = N_PHASES;
    void* args[] = {&p};
    hipError_t e = hipLaunchCooperativeKernel((const void*)fwd_kernel, dim3(grid), dim3(512), args, LDS_BYTES, stream);
    if (e != hipSuccess) fprintf(stderr, "cooperative launch failed: %s (grid %d)\n", hipGetErrorString(e), grid);
#else
    for (int ph = 0; ph < N_PHASES; ++ph) {
        p.ph_lo = ph; p.ph_hi = ph + 1;
        hipLaunchKernelGGL(fwd_kernel, dim3(grid), dim3(512), LDS_BYTES, stream, p);
    }
#endif
}
```

```cpp
#include <hip/hip_runtime.h>
#include <hip/hip_cooperative_groups.h>
#include <cstdio>
namespace cg = cooperative_groups;

#ifndef ONE_LAUNCH
#define ONE_LAUNCH 1
#endif

#define LAS __attribute__((address_space(3)))
typedef unsigned short bf16_t;
typedef short bf16x8 __attribute__((ext_vector_type(8)));
typedef float f32x4 __attribute__((ext_vector_type(4)));
typedef unsigned u32x4 __attribute__((ext_vector_type(4)));
typedef unsigned u32x2 __attribute__((ext_vector_type(2)));

constexpr int NTOK = 17408, NTP = 16384;
constexpr int LDB = 1792;
constexpr int LDA = 2560;
constexpr size_t O_CONVP = 17825792, O_CONVS = 17842176, O_SHIFTP = 18104320, O_SHIFTS = 18130944, O_WKVP = 18556928, O_WKVS = 19081216,
                 O_POOLP = 27469824, O_POOLS = 27592704, O_CHUNKV = 29558784;
constexpr size_t WS_WINE = 0;
constexpr size_t WS_WOUTE = WS_WINE + 2ull * 4352 * 1024 * 2;
constexpr size_t WS_WINO = WS_WOUTE + 2ull * 1024 * 1024 * 2;
constexpr size_t WS_WOUTO = WS_WINO + 2ull * 2560 * 1024 * 2;
constexpr size_t WS_W2T = WS_WOUTO + 2ull * 1024 * 1024 * 2;
constexpr size_t WS_A2T = WS_W2T + 2ull * 512 * 64 * 2;
constexpr size_t WS_POOLWT = WS_A2T + 2ull * 512 * 64 * 2;
constexpr size_t WS_SPW = WS_POOLWT + 8ull * 128 * 128 * 2;
constexpr size_t WS_XB = WS_SPW + 8ull * 128 * 128 * 2;
constexpr size_t WS_YCAT = WS_XB + (size_t)NTOK * 1024 * 2;
constexpr size_t WS_SSQ = WS_YCAT + (size_t)NTOK * 1024 * 2;
constexpr size_t WS_Y = WS_SSQ + 5ull * NTOK * 16 * 4;
constexpr size_t WS_R1 = WS_Y + (size_t)NTOK * 512 * 4;
constexpr size_t WS_PROJB = WS_R1;
constexpr size_t WS_WDEC = WS_PROJB + (size_t)NTOK * LDB * 2;
constexpr size_t WS_AA = WS_WDEC + (size_t)NTOK * 512 * 4;
constexpr size_t WS_BAR = WS_AA + (size_t)NTOK * 512 * 2;
constexpr size_t WS_END = WS_BAR + 16384;
constexpr int LDS_MAIN = 147456;
constexpr int LDS_BYTES = LDS_MAIN + 16;

struct Params {
    const void* ptr[32];
    int ph_lo, ph_hi;
};
struct Ctx { int tid, bid, nblk, z; };
#define PIN(i) ((const float*)p.ptr[(i) + cx.z])
#define POUT ((float*)p.ptr[29 + cx.z])
#define PWS ((unsigned char*)p.ptr[30 + cx.z])
enum { I_XP = 0, I_XS, I_SCONV, I_SSHIFT, I_SWKV, I_SPOOL, I_NORMW, I_FNORMW, I_WINE, I_CONVW, I_MU, I_W0, I_W2, I_A0, I_A2, I_KK, I_KA, I_RK, I_GNG, I_GNB,
       I_WOUTE, I_WINO, I_POOLW, I_PSCALE, I_LNG, I_LNB, I_SPW, I_SPB, I_WOUTO };

__device__ __forceinline__ unsigned cvt_pk_bf16(float lo, float hi) { unsigned r; asm("v_cvt_pk_bf16_f32 %0, %1, %2" : "=v"(r) : "v"(lo), "v"(hi)); return r; }
__device__ __forceinline__ float bf_lo(unsigned u) { return __uint_as_float(u << 16); }
__device__ __forceinline__ float bf_hi(unsigned u) { return __uint_as_float(u & 0xffff0000u); }
__device__ __forceinline__ float bf2f(bf16_t b) { return __uint_as_float(((unsigned)b) << 16); }
__device__ __forceinline__ f32x4 cvt4(u32x2 u) { return (f32x4){bf_lo(u.x), bf_hi(u.x), bf_lo(u.y), bf_hi(u.y)}; }
__device__ __forceinline__ f32x4 ld_bf4(const bf16_t* p) { return cvt4(*(const u32x2*)p); }
__device__ __forceinline__ void st_bf4(bf16_t* p, f32x4 v) { u32x2 u; u.x = cvt_pk_bf16(v[0], v[1]); u.y = cvt_pk_bf16(v[2], v[3]); *(u32x2*)p = u; }
__device__ __forceinline__ float sigmoidf_(float x) { return 1.0f / (1.0f + __expf(-x)); }
__device__ __forceinline__ float siluf_(float x) { return x / (1.0f + __expf(-x)); }
template <int CTRL> __device__ __forceinline__ float dpp_f(float x) { return __builtin_bit_cast(float, __builtin_amdgcn_mov_dpp(__builtin_bit_cast(int, x), CTRL, 0xf, 0xf, true)); }
__device__ __forceinline__ float allsum16(float x) { x += dpp_f<0xB1>(x); x += dpp_f<0x4E>(x); x += dpp_f<0x141>(x); x += dpp_f<0x128>(x); return x; }
__device__ __forceinline__ float allsum4(float x) { x += dpp_f<0xB1>(x); x += dpp_f<0x4E>(x); return x; }
__device__ __forceinline__ float dot4(f32x4 a, f32x4 b) { return a[0] * b[0] + a[1] * b[1] + a[2] * b[2] + a[3] * b[3]; }

__device__ __forceinline__ float ssq_sum(const float* part) {
    const f32x4 a = *(const f32x4*)(part), b = *(const f32x4*)(part + 4), c = *(const f32x4*)(part + 8), d = *(const f32x4*)(part + 12);
    return ((a[0] + a[1]) + (a[2] + a[3])) + ((b[0] + b[1]) + (b[2] + b[3])) + ((c[0] + c[1]) + (c[2] + c[3])) + ((d[0] + d[1]) + (d[2] + d[3]));
}

namespace pg8 {
constexpr int BM = 256, BK = 64, HALF = 128, HTB = HALF * BK * 2, NXCD = 8, WGM = 8;
__device__ __forceinline__ int lds_byte(int r, int c) { const int st = (r >> 4) * 2 + (c >> 5), rr = r & 15, cc = c & 31, ob = rr * 64 + cc * 2; return st * 1024 + (ob ^ (((ob >> 9) & 1) << 5)); }
__device__ __forceinline__ void stage_rc(int b, int& R, int& C) { const int st = b / 1024, sb = b % 1024, swz = sb ^ (((sb >> 9) & 1) << 5); R = (st >> 1) * 16 + swz / 64; C = (st & 1) * 32 + (swz % 64) / 2; }
__device__ __forceinline__ int perm32(int rho) { const int n = rho >> 4, i = rho & 15; return 8 * (i >> 2) + 4 * n + (i & 3); }
struct Unit { int pm, pn; };
struct Gemm { const bf16_t* A; const bf16_t* Bt; int M, N, K; };
struct StaticOrder {
    int nM, nN, nwg, G, c;
    __device__ void init(int M, int N, int G_, int c_) { nM = M / BM; nN = N / BM; nwg = nM * nN; G = G_; c = c_; }
    __device__ bool next(int i, Unit& u) const {
        const long L = (long)i * G + c; if (L >= nwg) return false;
        int wgid = (int)L; { const int q = nwg / NXCD, r = nwg % NXCD, xcd = wgid % NXCD, off = wgid / NXCD; wgid = (xcd < r ? xcd * (q + 1) : r * (q + 1) + (xcd - r) * q) + off; }
        const int nig = WGM * nN, gid = wgid / nig, fm = gid * WGM, gsz = (nM - fm) < WGM ? (nM - fm) : WGM;
        u.pm = fm + ((wgid % nig) % gsz); u.pn = (wgid % nig) / gsz; return true;
    }
};

template <class Epi>
__device__ __forceinline__ void gemm_phase(const Ctx cx, LAS unsigned char* lds, const Gemm g, const StaticOrder& S, const Epi& E) {
    const int tid = cx.tid, wid = __builtin_amdgcn_readfirstlane(tid >> 6), lane = tid & 63, wr = wid >> 2, wc = wid & 3, fr = lane & 15, fq = lane >> 4;
    const int K = g.K, nt = K / BK;
    unsigned voffA[2], voffB[2];
#pragma unroll
    for (int i = 0; i < 2; ++i) { int R, C; stage_rc(tid * 16 + i * 8192, R, C); const int Rb = Epi::PERM ? ((R & ~31) + perm32(R & 31)) : R;
        voffA[i] = (unsigned)(R * K + C) * 2u; voffB[i] = (unsigned)(Rb * K + C) * 2u; }
    const size_t kstep = (size_t)(BK * 2);
    const size_t hstep = (size_t)HALF * K * 2;
    const size_t tstep = 2 * hstep;
    const unsigned ldsw = (unsigned)wid * 1024u;
    const int aoff = lds_byte(wr * 64 + fr, fq * 8), boff = lds_byte(wc * 32 + fr, fq * 8);
#define PG8_SA(b, h) (((b) * 2 + (h)) * HTB)
#define PG8_SB(b, h) ((4 + (b) * 2 + (h)) * HTB)
#define PG8_STAGE(bufoff, gbase, voff) do { _Pragma("unroll") for (int _i = 0; _i < 2; ++_i) \
        __builtin_amdgcn_global_load_lds((const unsigned*)((const char*)(gbase) + (voff)[_i]), (LAS unsigned*)(lds + (bufoff) + ldsw + _i * 8192), 16, 0, 0); } while (0)
#define PG8_LDA(dst, b, h) do { _Pragma("unroll") for (int m = 0; m < 4; ++m) _Pragma("unroll") for (int k = 0; k < 2; ++k) dst[m][k] = *(const LAS bf16x8*)(lds + PG8_SA(b, h) + aoff + m * 2048 + k * 1024); } while (0)
#define PG8_LDB(dst, b, h) do { _Pragma("unroll") for (int n = 0; n < 2; ++n) _Pragma("unroll") for (int k = 0; k < 2; ++k) dst[n][k] = *(const LAS bf16x8*)(lds + PG8_SB(b, h) + boff + n * 2048 + k * 1024); } while (0)
#define PG8_MMA(ai, bj, At, Bt) do { __builtin_amdgcn_s_setprio(1); _Pragma("unroll") for (int m = 0; m < 4; ++m) _Pragma("unroll") for (int n = 0; n < 2; ++n) _Pragma("unroll") for (int k = 0; k < 2; ++k) \
        acc[ai][bj][m][n] = __builtin_amdgcn_mfma_f32_16x16x32_bf16(Bt[n][k], At[m][k], acc[ai][bj][m][n], 0, 0, 0); __builtin_amdgcn_s_setprio(0); } while (0)
#define PG8_WAIT_V(n) asm volatile("s_waitcnt vmcnt(" #n ")" ::: "memory")
#define PG8_WAIT_L(n) asm volatile("s_waitcnt lgkmcnt(" #n ")" ::: "memory")
#define PG8_BAR __builtin_amdgcn_s_barrier()
#define PG8_SCHED __builtin_amdgcn_sched_barrier(0)
    Unit cur, nxt; int ui = 0;
    if (!S.next(0, cur)) return;
    f32x4 acc[2][2][4][2];
#pragma unroll
    for (int a = 0; a < 2; ++a)
#pragma unroll
        for (int b = 0; b < 2; ++b)
#pragma unroll
            for (int m = 0; m < 4; ++m)
#pragma unroll
                for (int n = 0; n < 2; ++n) acc[a][b][m][n] = (f32x4){0.f, 0.f, 0.f, 0.f};
    bf16x8 At[4][2], B0[2][2], B1[2][2];
    const char* cA = (const char*)g.A + (size_t)cur.pm * tstep; const char* cB = (const char*)g.Bt + (size_t)cur.pn * tstep;
    PG8_STAGE(PG8_SB(0, 0), cB, voffB); PG8_STAGE(PG8_SA(0, 0), cA, voffA); PG8_STAGE(PG8_SB(0, 1), cB + hstep, voffB); PG8_STAGE(PG8_SA(0, 1), cA + hstep, voffA);
    if (wr == 1) PG8_BAR;
    PG8_WAIT_V(4); PG8_BAR;
    PG8_STAGE(PG8_SB(1, 0), cB + kstep, voffB); PG8_STAGE(PG8_SA(1, 0), cA + kstep, voffA); PG8_STAGE(PG8_SB(1, 1), cB + hstep + kstep, voffB);
    PG8_WAIT_V(6); PG8_BAR;
    for (;;) {
        const bool has_next = S.next(ui + 1, nxt);
        const char* nA = has_next ? (const char*)g.A + (size_t)nxt.pm * tstep : cA; const char* nB = has_next ? (const char*)g.Bt + (size_t)nxt.pn * tstep : cB;
        for (int t = 0; t < nt; t += 2) {
            const bool last = (t == nt - 2);
            const char* a1 = cA + (size_t)(t + 1) * kstep;
            const char* a2 = last ? nA : cA + (size_t)(t + 2) * kstep; const char* b2 = last ? nB : cB + (size_t)(t + 2) * kstep;
            const char* a3 = a2 + kstep; const char* b3 = b2 + kstep;
            PG8_LDB(B0, 0, 0); PG8_SCHED; PG8_LDA(At, 0, 0); PG8_STAGE(PG8_SA(1, 1), a1 + hstep, voffA);
            PG8_WAIT_L(8); PG8_BAR; PG8_WAIT_L(0); PG8_MMA(0, 0, At, B0); PG8_BAR; PG8_SCHED;
            PG8_LDB(B1, 0, 1); PG8_STAGE(PG8_SB(0, 0), b2, voffB);
            PG8_BAR; PG8_WAIT_L(0); PG8_MMA(0, 1, At, B1); PG8_BAR;
            PG8_LDA(At, 0, 1); PG8_STAGE(PG8_SA(0, 0), a2, voffA);
            PG8_BAR; PG8_WAIT_L(0); PG8_MMA(1, 0, At, B0); PG8_BAR; PG8_SCHED;
            PG8_STAGE(PG8_SB(0, 1), b2 + hstep, voffB);
            PG8_WAIT_V(6); PG8_BAR; PG8_MMA(1, 1, At, B1); PG8_BAR;
            PG8_LDB(B0, 1, 0); PG8_SCHED; PG8_LDA(At, 1, 0); PG8_STAGE(PG8_SA(0, 1), a2 + hstep, voffA);
            PG8_WAIT_L(8); PG8_BAR; PG8_WAIT_L(0); PG8_MMA(0, 0, At, B0); PG8_BAR; PG8_SCHED;
            PG8_LDB(B1, 1, 1); PG8_STAGE(PG8_SB(1, 0), b3, voffB);
            PG8_BAR; PG8_WAIT_L(0); PG8_MMA(0, 1, At, B1); PG8_BAR;
            PG8_LDA(At, 1, 1); PG8_STAGE(PG8_SA(1, 0), a3, voffA);
            PG8_BAR; PG8_WAIT_L(0); PG8_MMA(1, 0, At, B0); PG8_BAR; PG8_SCHED;
            PG8_STAGE(PG8_SB(1, 1), b3 + hstep, voffB);
            PG8_WAIT_V(6); PG8_BAR; PG8_MMA(1, 1, At, B1); PG8_BAR;
        }
        E(acc, cur, wr, wc, fr, fq);
        if (!has_next) break;
#pragma unroll
        for (int a = 0; a < 2; ++a)
#pragma unroll
            for (int b = 0; b < 2; ++b)
#pragma unroll
                for (int m = 0; m < 4; ++m)
#pragma unroll
                    for (int n = 0; n < 2; ++n) acc[a][b][m][n] = (f32x4){0.f, 0.f, 0.f, 0.f};
        cur = nxt; cA = nA; cB = nB; ++ui;
    }
    PG8_WAIT_V(0);
    if (wr == 0) PG8_BAR;
    PG8_BAR;
#undef PG8_SA
#undef PG8_SB
#undef PG8_STAGE
#undef PG8_LDA
#undef PG8_LDB
#undef PG8_MMA
#undef PG8_WAIT_V
#undef PG8_WAIT_L
#undef PG8_BAR
#undef PG8_SCHED
}
}

struct EpiProj {
    static constexpr bool PERM = true;
    bf16_t* O; int ldc; LAS const float* rl; int pm0, pm1, pm2, pm3;
    __device__ __forceinline__ void operator()(const f32x4 (&acc)[2][2][4][2], const pg8::Unit& u, int wr, int wc, int fr, int fq) const {
        const int row0 = u.pm * 256 + wr * 64 + fr, col0 = u.pn * 256 + wc * 32 + 8 * fq;
        const int sel = u.pm == pm0 ? 0 : (u.pm == pm1 ? 1 : (u.pm == pm2 ? 2 : 3));
        LAS const float* rp = rl + sel * 256 + wr * 64 + fr;
#pragma unroll
        for (int ai = 0; ai < 2; ++ai)
#pragma unroll
            for (int m = 0; m < 4; ++m) {
                const int row = row0 + ai * 128 + m * 16;
                const float rstd = rp[ai * 128 + m * 16];
                bf16_t* rowp = O + (size_t)row * ldc + col0;
#pragma unroll
                for (int bj = 0; bj < 2; ++bj) {
                    const f32x4 v0 = acc[ai][bj][m][0] * rstd, v1 = acc[ai][bj][m][1] * rstd;
                    u32x4 w; w.x = cvt_pk_bf16(v0[0], v0[1]); w.y = cvt_pk_bf16(v0[2], v0[3]); w.z = cvt_pk_bf16(v1[0], v1[1]); w.w = cvt_pk_bf16(v1[2], v1[3]);
                    *(u32x4*)(rowp + bj * 128) = w;
                }
            }
    }
};
struct X8 { f32x4 lo, hi; };
template <bool FIRST> __device__ __forceinline__ X8 ld_x8(const float* __restrict__ s32, const bf16_t* __restrict__ s16, size_t o) {
    X8 r;
    if (FIRST) { r.lo = *(const f32x4*)(s32 + o); r.hi = *(const f32x4*)(s32 + o + 4); }
    else { const u32x4 u = *(const u32x4*)(s16 + o); r.lo = cvt4((u32x2){u.x, u.y}); r.hi = cvt4((u32x2){u.z, u.w}); }
    return r;
}
__device__ __forceinline__ void st_x8(bf16_t* p, f32x4 lo, f32x4 hi) { u32x4 w; w.x = cvt_pk_bf16(lo[0], lo[1]); w.y = cvt_pk_bf16(lo[2], lo[3]); w.z = cvt_pk_bf16(hi[0], hi[1]); w.w = cvt_pk_bf16(hi[2], hi[3]); *(u32x4*)p = w; }
template <bool FIRST>
__device__ __forceinline__ void epi_res_rows(const f32x4 (&acc)[2][2][4][2], const float* __restrict__ src32, const bf16_t* __restrict__ src16, bf16_t* __restrict__ Xb, float* __restrict__ ssqp,
                                             int row0, int col0, int slot, int fq) {
    X8 x[2][2];
#pragma unroll
    for (int bj = 0; bj < 2; ++bj) x[0][bj] = ld_x8<FIRST>(src32, src16, (size_t)row0 * 1024 + col0 + bj * 128);
#pragma unroll
    for (int gi = 0; gi < 8; ++gi) {
        const int ai = gi >> 2, m = gi & 3, row = row0 + ai * 128 + m * 16;
        if (gi + 1 < 8) {
            const int nrow = row0 + ((gi + 1) >> 2) * 128 + ((gi + 1) & 3) * 16;
#pragma unroll
            for (int bj = 0; bj < 2; ++bj) x[(gi + 1) & 1][bj] = ld_x8<FIRST>(src32, src16, (size_t)nrow * 1024 + col0 + bj * 128);
        }
        float part = 0.f;
#pragma unroll
        for (int bj = 0; bj < 2; ++bj) {
            const f32x4 lo = x[gi & 1][bj].lo + acc[ai][bj][m][0], hi = x[gi & 1][bj].hi + acc[ai][bj][m][1];
            st_x8(Xb + (size_t)row * 1024 + col0 + bj * 128, lo, hi);
            part += dot4(lo, lo) + dot4(hi, hi);
        }
        part += __shfl_xor(part, 16); part += __shfl_xor(part, 32);
        if (fq == 0) ssqp[(size_t)row * 16 + slot] = part;
    }
}
struct EpiRes {
    static constexpr bool PERM = true;
    const float* xp; const float* xs; bf16_t* Xb; float* ssq_next;
    __device__ __forceinline__ void operator()(const f32x4 (&acc)[2][2][4][2], const pg8::Unit& u, int wr, int wc, int fr, int fq) const {
        const int row0 = u.pm * 256 + wr * 64 + fr, col0 = u.pn * 256 + wc * 32 + 8 * fq;
        if (xp) epi_res_rows<true>(acc, row0 < NTP ? xp : xs - (size_t)NTP * 1024, nullptr, Xb, ssq_next, row0, col0, u.pn * 4 + wc, fq);
        else epi_res_rows<false>(acc, nullptr, Xb, Xb, ssq_next, row0, col0, u.pn * 4 + wc, fq);
    }
};

template <bool FIRST>
__device__ __forceinline__ void res_sample_tile(const Ctx cx, const bf16_t* __restrict__ A, const bf16_t* __restrict__ Bt, const float* __restrict__ xs, bf16_t* __restrict__ Xb, float* __restrict__ ssqp, int tile) {
    const int tid = cx.tid, wid = tid >> 6, lane = tid & 63, fr = lane & 15, fq = lane >> 4;
    const int tm = tile >> 3, tn = tile & 7;
    const int r0 = NTP + tm * 64 + (wid & 3) * 16, c0 = tn * 128 + (wid >> 2) * 64;
    const bf16_t* ap = A + (size_t)(r0 + fr) * 1024 + fq * 8;
    const bf16_t* bp = Bt + (size_t)(c0 + fr) * 1024 + fq * 8;
    f32x4 acc[4];
#pragma unroll
    for (int nt = 0; nt < 4; ++nt) acc[nt] = (f32x4){0.f, 0.f, 0.f, 0.f};
#pragma unroll 8
    for (int ks = 0; ks < 32; ++ks) {
        const bf16x8 af = *(const bf16x8*)(ap + ks * 32);
#pragma unroll
        for (int nt = 0; nt < 4; ++nt) {
            const bf16x8 bf = *(const bf16x8*)(bp + (size_t)nt * 16 * 1024 + ks * 32);
            acc[nt] = __builtin_amdgcn_mfma_f32_16x16x32_bf16(bf, af, acc[nt], 0, 0, 0);
        }
    }
    const int row = r0 + fr;
    float part = 0.f;
#pragma unroll
    for (int nt = 0; nt < 4; ++nt) {
        const int col = c0 + nt * 16 + fq * 4;
        const f32x4 xo = FIRST ? *(const f32x4*)(xs + (size_t)(row - NTP) * 1024 + col) : ld_bf4(Xb + (size_t)row * 1024 + col);
        const f32x4 v = xo + acc[nt];
        st_bf4(Xb + (size_t)row * 1024 + col, v);
        part += dot4(v, v);
    }
    part += __shfl_xor(part, 16); part += __shfl_xor(part, 32);
    if (fq == 0) ssqp[(size_t)row * 16 + (c0 >> 6)] = part;
}

__device__ __forceinline__ void tr_tile(const Ctx cx, LAS float* T, const float* src, int ld, int col0, int k0, bf16_t* dst, int Ktot, int drow0, const float* scale, bool zero) {
    const int tid = cx.tid;
    if (zero) {
        const int n = tid >> 3, kc = (tid & 7) * 8;
        *(u32x4*)(dst + (size_t)(drow0 + n) * Ktot + k0 + kc) = (u32x4){0u, 0u, 0u, 0u};
        return;
    }
#pragma unroll
    for (int pass = 0; pass < 2; ++pass) {
        const int kk = (tid >> 4) + pass * 32, nn = (tid & 15) * 4;
        f32x4 v = *(const f32x4*)(src + (size_t)(k0 + kk) * ld + col0 + nn);
        if (scale) v = v * scale[k0 + kk];
        T[kk * 65 + nn] = v[0]; T[kk * 65 + nn + 1] = v[1]; T[kk * 65 + nn + 2] = v[2]; T[kk * 65 + nn + 3] = v[3];
    }
    __syncthreads();
    {
        const int n = tid >> 3, kc = (tid & 7) * 8;
        u32x4 w;
        w.x = cvt_pk_bf16(T[(kc + 0) * 65 + n], T[(kc + 1) * 65 + n]); w.y = cvt_pk_bf16(T[(kc + 2) * 65 + n], T[(kc + 3) * 65 + n]);
        w.z = cvt_pk_bf16(T[(kc + 4) * 65 + n], T[(kc + 5) * 65 + n]); w.w = cvt_pk_bf16(T[(kc + 6) * 65 + n], T[(kc + 7) * 65 + n]);
        *(u32x4*)(dst + (size_t)(drow0 + n) * Ktot + k0 + kc) = w;
    }
    __syncthreads();
}

__device__ void phase_prepass(const Params& p, const Ctx cx, LAS unsigned char* lds) {
    LAS float* T = (LAS float*)lds;
    const int tid = cx.tid;
    for (int job = cx.bid; job < 4544; job += cx.nblk) {
        int j = job;
        if (j < 2176) {
            const int i = j / 1088, r = j % 1088, nt = r / 16, kt = r % 16;
            const int n0 = nt * 64;
            int col0; bool zero = false;
            if (n0 < 2048) col0 = n0; else if (n0 < 2560) col0 = 3712 + (n0 - 2048); else if (n0 < 4224) col0 = 2048 + (n0 - 2560); else { col0 = 0; zero = true; }
            tr_tile(cx, T, PIN(I_WINE) + (size_t)i * 1024 * 4224, 4224, col0, kt * 64, (bf16_t*)(PWS + WS_WINE) + (size_t)i * 4352 * 1024, 1024, n0, PIN(I_NORMW) + (2 * i) * 1024, zero);
            continue;
        }
        j -= 2176;
        if (j < 512) { const int i = j / 256, r = j % 256, nt = r / 16, kt = r % 16;
            tr_tile(cx, T, PIN(I_WOUTE) + (size_t)i * 1024 * 1024, 1024, nt * 64, kt * 64, (bf16_t*)(PWS + WS_WOUTE) + (size_t)i * 1024 * 1024, 1024, nt * 64, nullptr, false); continue; }
        j -= 512;
        if (j < 1280) { const int i = j / 640, r = j % 640, nt = r / 16, kt = r % 16;
            tr_tile(cx, T, PIN(I_WINO) + (size_t)i * 1024 * 2560, 2560, nt * 64, kt * 64, (bf16_t*)(PWS + WS_WINO) + (size_t)i * 2560 * 1024, 1024, nt * 64, PIN(I_NORMW) + (2 * i + 1) * 1024, false); continue; }
        j -= 1280;
        if (j < 512) { const int i = j / 256, r = j % 256, nt = r / 16, kt = r % 16;
            tr_tile(cx, T, PIN(I_WOUTO) + (size_t)i * 1024 * 1024, 1024, nt * 64, kt * 64, (bf16_t*)(PWS + WS_WOUTO) + (size_t)i * 1024 * 1024, 1024, nt * 64, nullptr, false); continue; }
        j -= 512;
        if (j < 16) { const int i = j / 8, nt = j % 8;
            tr_tile(cx, T, PIN(I_W2) + (size_t)i * 64 * 512, 512, nt * 64, 0, (bf16_t*)(PWS + WS_W2T) + (size_t)i * 512 * 64, 64, nt * 64, nullptr, false); continue; }
        j -= 16;
        if (j < 16) { const int i = j / 8, nt = j % 8;
            tr_tile(cx, T, PIN(I_A2) + (size_t)i * 64 * 512, 512, nt * 64, 0, (bf16_t*)(PWS + WS_A2T) + (size_t)i * 512 * 64, 64, nt * 64, nullptr, false); continue; }
        j -= 16;
        { const int ig = j / 4, r = j % 4, nt = r / 2, kt = r % 2;
            tr_tile(cx, T, PIN(I_POOLW) + (size_t)ig * 128 * 128, 128, nt * 64, kt * 64, (bf16_t*)(PWS + WS_POOLWT) + (size_t)ig * 128 * 128, 128, nt * 64, nullptr, false); }
    }
    const int gtid = cx.bid * 512 + tid, gthreads = cx.nblk * 512;
    for (int e = gtid; e < 8 * 128 * 128; e += gthreads) {
        const int s = e & 127, t = (e >> 7) & 127;
        ((bf16_t*)(PWS + WS_SPW))[e] = (s <= t) ? (bf16_t)(cvt_pk_bf16(PIN(I_SPW)[e], 0.f) & 0xffffu) : (bf16_t)0;
    }
    const int wid = tid >> 6, lane = tid & 63;
    for (int row = cx.bid * 8 + wid; row < NTOK; row += cx.nblk * 8) {
        const float* src = row < NTP ? PIN(I_XP) + (size_t)row * 1024 : PIN(I_XS) + (size_t)(row - NTP) * 1024;
        bf16_t* dst = (bf16_t*)(PWS + WS_XB) + (size_t)row * 1024;
        float ss = 0.f;
#pragma unroll
        for (int i = 0; i < 4; ++i) { const f32x4 v = *(const f32x4*)(src + i * 256 + lane * 4); ss += dot4(v, v); st_bf4(dst + i * 256 + lane * 4, v); }
#pragma unroll
        for (int o = 32; o >= 1; o >>= 1) ss += __shfl_xor(ss, o);
        if (lane < 16) ((float*)(PWS + WS_SSQ))[(size_t)row * 16 + lane] = (lane == 0) ? ss : 0.f;
    }
}

__device__ __forceinline__ f32x4 shift4(const bf16_t* cur, bool hp, const float* st, int col, const float* mu) {
    const f32x4 q = ld_bf4(cur + col);
    f32x4 pv;
    if (hp) pv = ld_bf4(cur - LDB + col); else if (st) pv = *(const f32x4*)(st + col); else pv = (f32x4){0.f, 0.f, 0.f, 0.f};
    const f32x4 m = *(const f32x4*)(mu + col);
    return q + m * (pv - q);
}

__device__ void phase_even_prep(const Params& p, const Ctx cx, int pair, LAS unsigned char* lds) {
    const int tid = cx.tid, wid = tid >> 6, lane = tid & 63, fr = lane & 15, fq = lane >> 4;
    const bf16_t* PB = (const bf16_t*)(PWS + WS_PROJB);
    float* Wdec = (float*)(PWS + WS_WDEC);
    bf16_t* Aa = (bf16_t*)(PWS + WS_AA);
    bf16_t* Ycat = (bf16_t*)(PWS + WS_YCAT);
    const float* mu_ = PIN(I_MU) + pair * 1664;
    const float* w0_ = PIN(I_W0) + pair * 512; const float* a0_ = PIN(I_A0) + pair * 512;
    const float* k_a_ = PIN(I_KA) + pair * 512; const float* r_k_ = PIN(I_RK) + pair * 512;
    constexpr int RS = 3344;
    constexpr int TB = 17 * RS;
    constexpr int NCH = 17 * 208;
    const int h = wid;
    bf16x8 wfr[4][2], afr[4][2];
    {
        const bf16_t* W2T = (const bf16_t*)(PWS + WS_W2T) + (size_t)pair * 512 * 64;
        const bf16_t* A2T = (const bf16_t*)(PWS + WS_A2T) + (size_t)pair * 512 * 64;
#pragma unroll
        for (int nt = 0; nt < 4; ++nt)
#pragma unroll
            for (int ks = 0; ks < 2; ++ks) {
                wfr[nt][ks] = *(const bf16x8*)(W2T + (size_t)(h * 64 + nt * 16 + fr) * 64 + ks * 32 + fq * 8);
                afr[nt][ks] = *(const bf16x8*)(A2T + (size_t)(h * 64 + nt * 16 + fr) * 64 + ks * 32 + fq * 8);
            }
    }
    constexpr int TBD = 56 * 1024;
    const int widu = __builtin_amdgcn_readfirstlane(tid >> 6);
#define PREP_DMA(tile_, b_, lane_) do { _Pragma("unroll") for (int i_ = 0; i_ < 7; ++i_) { const int k_ = widu * 7 + i_, q_ = k_ * 64 + (lane_); \
            int lr_ = q_ / 209, cc_ = q_ - lr_ * 209; if (lr_ > 16) { lr_ = 16; cc_ = 0; } if (cc_ > 207) cc_ = 0; \
            int gr_ = (tile_) * 16 - 1 + lr_; gr_ = gr_ < 0 ? 0 : gr_; \
            __builtin_amdgcn_global_load_lds((const unsigned*)(PB + (size_t)gr_ * LDB + cc_ * 8), (LAS unsigned*)(lds + (b_) * TBD + k_ * 1024), 16, 0, 0); } } while (0)
    int buf = 0;
    if ((int)cx.bid < NTOK / 16) PREP_DMA((int)cx.bid, 0, tid & 63);
    asm volatile("s_waitcnt vmcnt(0)" ::: "memory");
    __syncthreads();
    for (int tile = cx.bid; tile < NTOK / 16; tile += cx.nblk) {
        int zz; asm volatile("v_mov_b32 %0, 0" : "=v"(zz));
        const int tidv = tid + zz, fr = (tidv & 15), fq = (tidv >> 4) & 3;
        if (tile + (int)cx.nblk < NTOK / 16) PREP_DMA(tile + (int)cx.nblk, buf ^ 1, tidv & 63);
        {
            const int row = tile * 16 + fr;
            const bool samp = row >= NTP;
            int b, t; if (!samp) { b = row >> 11; t = row & 2047; } else { const int q = row - NTP; b = q >> 3; t = q & 7; }
            const bool hp = t > 0;
            const float* st = samp ? PIN(I_SSHIFT) + ((size_t)pair * 128 + b) * 1664 : nullptr;
            const float* mu = mu_ + zz; const float* w0 = w0_ + zz; const float* a0 = a0_ + zz; const float* k_a = k_a_ + zz; const float* r_k = r_k_ + zz;
            LAS const unsigned char* curL = lds + buf * TBD + (fr + 1) * RS;
            LAS const unsigned char* prvL = lds + buf * TBD + fr * RS;
            auto sh4 = [&](int col) -> f32x4 {
                const f32x4 q = cvt4(*(LAS const u32x2*)(curL + col * 2));
                f32x4 pv;
                if (hp) pv = cvt4(*(LAS const u32x2*)(prvL + col * 2)); else if (st) pv = *(const f32x4*)(st + col); else pv = (f32x4){0.f, 0.f, 0.f, 0.f};
                const f32x4 m = *(const f32x4*)(mu + col);
                return q + m * (pv - q);
            };
            bf16x8 Aw[2], Al[2];
#pragma unroll
            for (int ks = 0; ks < 2; ++ks) {
                const int cw = 1536 + ks * 32 + fq * 8, ca = 1600 + ks * 32 + fq * 8;
                const f32x4 w_lo = sh4(cw), w_hi = sh4(cw + 4), a_lo = sh4(ca), a_hi = sh4(ca + 4);
                u32x4 pw, pa;
                float th[8];
#pragma unroll
                for (int j = 0; j < 4; ++j) { th[j] = 2.0f * sigmoidf_(2.0f * w_lo[j]) - 1.0f; th[4 + j] = 2.0f * sigmoidf_(2.0f * w_hi[j]) - 1.0f; }
                pw.x = cvt_pk_bf16(th[0], th[1]); pw.y = cvt_pk_bf16(th[2], th[3]); pw.z = cvt_pk_bf16(th[4], th[5]); pw.w = cvt_pk_bf16(th[6], th[7]);
                pa.x = cvt_pk_bf16(a_lo[0], a_lo[1]); pa.y = cvt_pk_bf16(a_lo[2], a_lo[3]); pa.z = cvt_pk_bf16(a_hi[0], a_hi[1]); pa.w = cvt_pk_bf16(a_hi[2], a_hi[3]);
                Aw[ks] = __builtin_bit_cast(bf16x8, pw); Al[ks] = __builtin_bit_cast(bf16x8, pa);
            }
            float bon = 0.f;
#pragma unroll
            for (int nt = 0; nt < 4; ++nt) {
                f32x4 lw = (f32x4){0.f, 0.f, 0.f, 0.f}, la = (f32x4){0.f, 0.f, 0.f, 0.f};
#pragma unroll
                for (int ks = 0; ks < 2; ++ks) {
                    lw = __builtin_amdgcn_mfma_f32_16x16x32_bf16(wfr[nt][ks], Aw[ks], lw, 0, 0, 0);
                    la = __builtin_amdgcn_mfma_f32_16x16x32_bf16(afr[nt][ks], Al[ks], la, 0, 0, 0);
                }
                const int ch = h * 64 + nt * 16 + fq * 4;
                const f32x4 r4 = sh4(ch), k4 = sh4(512 + ch);
                const f32x4 w04 = *(const f32x4*)(w0 + ch), a04 = *(const f32x4*)(a0 + ch), ka4 = *(const f32x4*)(k_a + ch), rk4 = *(const f32x4*)(r_k + ch);
                f32x4 dec, av;
#pragma unroll
                for (int j = 0; j < 4; ++j) {
                    const float z_ = -(w04[j] + lw[j]);
                    const float wlog = -__logf(1.0f + __expf(z_)) - 0.5f;
                    dec[j] = __expf(-__expf(wlog));
                    av[j] = sigmoidf_(a04[j] + la[j]);
                    const float kp = k4[j] * (1.0f + (av[j] - 1.0f) * ka4[j]);
                    bon += r4[j] * kp * rk4[j];
                }
                *(f32x4*)(Wdec + (size_t)row * 512 + ch) = dec;
                st_bf4(Aa + (size_t)row * 512 + ch, av);
            }
            bon += __shfl_xor(bon, 16); bon += __shfl_xor(bon, 32);
#pragma unroll
            for (int nt = 0; nt < 4; ++nt) { const int ch = h * 64 + nt * 16 + fq * 4; st_bf4(Ycat + (size_t)row * 1024 + 512 + ch, sh4(1024 + ch) * bon); }
        }
        asm volatile("s_waitcnt vmcnt(0)" ::: "memory");
        __syncthreads();
        buf ^= 1;
    }
#undef PREP_DMA
    const int gtid = cx.bid * 512 + tid, gthreads = cx.nblk * 512;
    for (int e = gtid; e < 136 * 1664; e += gthreads) {
        const int sr = e / 1664, c = e % 1664;
        if (sr < 8) POUT[O_SHIFTP + ((size_t)pair * 8 + sr) * 1664 + c] = bf2f(PB[(size_t)(sr * 2048 + 2047) * LDB + c]);
        else { const int b = sr - 8; POUT[O_SHIFTS + ((size_t)pair * 128 + b) * 1664 + c] = bf2f(PB[(size_t)(NTP + b * 8 + 7) * LDB + c]); }
    }
}

typedef float f32x2 __attribute__((ext_vector_type(2)));
template <bool RED = true>
__device__ __forceinline__ void scan_step(f32x4& S, const f32x4 w, const f32x4 k, const f32x4 kk, const f32x4 nb, const f32x4 r, const float v, float& y) {
    const f32x2 S01 = {S[0], S[1]}, S23 = {S[2], S[3]};
    f32x2 pp = S01 * (f32x2){kk[0], kk[1]};
    pp = S23 * (f32x2){kk[2], kk[3]} + pp;
    float pd = pp[0] + pp[1];
    const f32x2 vv = {v, v};
    const f32x2 t01 = S01 * (f32x2){w[0], w[1]} + (f32x2){k[0], k[1]} * vv;
    const f32x2 t23 = S23 * (f32x2){w[2], w[3]} + (f32x2){k[2], k[3]} * vv;
    pd = allsum16(pd);
    const f32x2 pdv = {pd, pd};
    const f32x2 n01 = (f32x2){nb[0], nb[1]} * pdv + t01, n23 = (f32x2){nb[2], nb[3]} * pdv + t23;
    S = (f32x4){n01[0], n01[1], n23[0], n23[1]};
    f32x2 q = n01 * (f32x2){r[0], r[1]};
    q = n23 * (f32x2){r[2], r[3]} + q;
    y = RED ? allsum16(q[0] + q[1]) : (q[0] + q[1]);
}
__device__ __forceinline__ float reduce_scatter16(const float (&yp)[16], int cgi) {
    const bool b3 = cgi & 8, b2 = cgi & 4, b1 = cgi & 2, b0 = cgi & 1;
    float a[8], bq[4], c[2];
#pragma unroll
    for (int j = 0; j < 8; ++j) { const float keep = b3 ? yp[8 + j] : yp[j], send = b3 ? yp[j] : yp[8 + j]; a[j] = keep + dpp_f<0x128>(send); }
#pragma unroll
    for (int k = 0; k < 4; ++k) { const float keep = b2 ? a[4 + k] : a[k], send = b2 ? a[k] : a[4 + k]; bq[k] = keep + dpp_f<0x141>(send); }
#pragma unroll
    for (int m = 0; m < 2; ++m) { const float keep = b1 ? bq[2 + m] : bq[m], send = b1 ? bq[m] : bq[2 + m]; c[m] = keep + dpp_f<0x4E>(send); }
    const float keep = b0 ? c[1] : c[0], send = b0 ? c[0] : c[1];
    return keep + dpp_f<0xB1>(send);
}

__device__ void phase_scan(const Params& p, const Ctx cx, int pair, LAS unsigned char* lds) {
    const int tid = cx.tid, wid = tid >> 6, lane = tid & 63, rs = lane >> 4, cgi = lane & 15;
    const bf16_t* PB = (const bf16_t*)(PWS + WS_PROJB);
    const float* Wdec = (const float*)(PWS + WS_WDEC);
    const bf16_t* Aa = (const bf16_t*)(PWS + WS_AA);
    float* Y = (float*)(PWS + WS_Y);
    const float* mu = PIN(I_MU) + pair * 1664;
    const float* k_k = PIN(I_KK) + pair * 512; const float* k_a = PIN(I_KA) + pair * 512;
    {
        LAS float* vb = (LAS float*)lds + wid * 3072;
        for (int st = cx.bid * 8 + wid; st < 2048; st += cx.nblk * 8) {
            const int bh = st >> 1, half = st & 1, b = bh >> 3, h = bh & 7, ch = h * 64 + cgi * 4;
            const float* stp = PIN(I_SSHIFT) + ((size_t)pair * 128 + b) * 1664;
            const f32x4 kkc = *(const f32x4*)(k_k + ch), kac = *(const f32x4*)(k_a + ch);
            {
#pragma unroll
                for (int tt = 0; tt < 2; ++tt) {
                    const int t = rs + tt * 4;
                    const size_t row = NTP + b * 8 + t;
                    const bf16_t* cur = PB + row * LDB;
                    const f32x4 r = shift4(cur, t > 0, stp, ch, mu), k = shift4(cur, t > 0, stp, 512 + ch, mu), v = shift4(cur, t > 0, stp, 1024 + ch, mu);
                    const f32x4 a = ld_bf4(Aa + row * 512 + ch);
                    const f32x4 w = *(const f32x4*)(Wdec + row * 512 + ch);
                    const f32x4 kkv = k * kkc;
                    const float ss = allsum16(dot4(kkv, kkv));
                    const float inv = 1.0f / fmaxf(sqrtf(ss), 1e-12f);
                    const f32x4 kkn = kkv * inv;
                    LAS float* o = vb + t * 384 + cgi * 4;
                    *(LAS f32x4*)(o) = w; *(LAS f32x4*)(o + 64) = k * (1.0f + (a - 1.0f) * kac); *(LAS f32x4*)(o + 128) = kkn; *(LAS f32x4*)(o + 192) = -(kkn * a);
                    *(LAS f32x4*)(o + 256) = r; *(LAS f32x4*)(o + 320) = v;
                }
            }
            asm volatile("s_waitcnt lgkmcnt(0)" ::: "memory");
            __builtin_amdgcn_wave_barrier();
#pragma unroll 1
            for (int rq = 0; rq < 8; ++rq) {
                const int ri = half * 32 + rq * 4 + rs;
                const size_t so = ((((size_t)pair * 128 + b) * 8 + h) * 64 + ri) * 64 + cgi * 4;
                f32x4 S = *(const f32x4*)(PIN(I_SWKV) + so);
#pragma unroll
                for (int t = 0; t < 8; ++t) {
                    LAS const float* r0 = vb + t * 384 + cgi * 4;
                    float y; scan_step(S, *(LAS const f32x4*)(r0), *(LAS const f32x4*)(r0 + 64), *(LAS const f32x4*)(r0 + 128), *(LAS const f32x4*)(r0 + 192), *(LAS const f32x4*)(r0 + 256), vb[t * 384 + 320 + ri], y);
                    if (cgi == 0) Y[(size_t)(NTP + b * 8 + t) * 512 + h * 64 + ri] = y;
                }
                *(f32x4*)(POUT + O_WKVS + so) = S;
            }
            asm volatile("s_waitcnt lgkmcnt(0)" ::: "memory");
            __builtin_amdgcn_wave_barrier();
        }
    }
    __syncthreads();
    LAS float* rec = (LAS float*)lds;
    for (int pt = cx.bid; pt < 256; pt += cx.nblk) {
        const int xcd = pt & 7, slot = pt >> 3, bh = xcd * 8 + (slot >> 2), rg = slot & 3, b = bh >> 3, h = bh & 7;
        const int lt = tid - 256, ls = (lt >> 4) & 15, lcg = lt & 15, lch = h * 64 + lcg * 4;
        u32x2 qr = {0u, 0u}, qk = {0u, 0u}, qv = {0u, 0u}, pr = {0u, 0u}, pk = {0u, 0u}, pv = {0u, 0u}, qa = {0u, 0u};
        f32x4 qw = (f32x4){0.f, 0.f, 0.f, 0.f};
        f32x4 mur, muk, muv, kkc, kac;
        const int ri = rg * 16 + (wid & 3) * 4 + rs;
        f32x4 S = (f32x4){0.f, 0.f, 0.f, 0.f};
#define SCAN_ISSUE(c) do { const int t_ = (c) * 16 + ls; const size_t row_ = (size_t)b * 2048 + t_; const bf16_t* cur_ = PB + row_ * LDB; \
            qr = *(const u32x2*)(cur_ + lch); qk = *(const u32x2*)(cur_ + 512 + lch); qv = *(const u32x2*)(cur_ + 1024 + lch); \
            if (t_ > 0) { pr = *(const u32x2*)(cur_ - LDB + lch); pk = *(const u32x2*)(cur_ - LDB + 512 + lch); pv = *(const u32x2*)(cur_ - LDB + 1024 + lch); } \
            else { pr = (u32x2){0u, 0u}; pk = pr; pv = pr; } \
            qw = *(const f32x4*)(Wdec + row_ * 512 + lch); qa = *(const u32x2*)(Aa + row_ * 512 + lch); } while (0)
#define SCAN_PROCESS(buf) do { const f32x4 r0_ = cvt4(qr), k0_ = cvt4(qk), v0_ = cvt4(qv); \
            const f32x4 r_ = r0_ + mur * (cvt4(pr) - r0_), k_ = k0_ + muk * (cvt4(pk) - k0_), v_ = v0_ + muv * (cvt4(pv) - v0_), a_ = cvt4(qa); \
            const f32x4 kkv_ = k_ * kkc; const float ss_ = allsum16(dot4(kkv_, kkv_)); const float inv_ = __builtin_amdgcn_rsqf(fmaxf(ss_, 1e-24f)); \
            const f32x4 kkn_ = kkv_ * inv_; \
            LAS float* o_ = rec + (buf) * 6144 + ls * 384 + lcg * 4; \
            *(LAS f32x4*)(o_) = qw; *(LAS f32x4*)(o_ + 64) = k_ * (1.0f + (a_ - 1.0f) * kac); *(LAS f32x4*)(o_ + 128) = kkn_; *(LAS f32x4*)(o_ + 192) = -(kkn_ * a_); \
            *(LAS f32x4*)(o_ + 256) = r_; *(LAS f32x4*)(o_ + 320) = v_; } while (0)
        if (wid >= 4) {
            mur = *(const f32x4*)(mu + lch); muk = *(const f32x4*)(mu + 512 + lch); muv = *(const f32x4*)(mu + 1024 + lch);
            kkc = *(const f32x4*)(k_k + lch); kac = *(const f32x4*)(k_a + lch);
            SCAN_ISSUE(0); SCAN_PROCESS(0); SCAN_ISSUE(1);
        }
        __syncthreads();
        for (int c = 0; c < 128; ++c) {
            if (wid < 4) {
                LAS const float* rb = rec + (c & 1) * 6144 + cgi * 4;
                LAS const float* rv = rec + (c & 1) * 6144 + 320 + ri;
                float yp[16];
                f32x4 nw = *(LAS const f32x4*)(rb), nk = *(LAS const f32x4*)(rb + 64), nkk = *(LAS const f32x4*)(rb + 128), nb = *(LAS const f32x4*)(rb + 192), nr = *(LAS const f32x4*)(rb + 256);
                float nv = rv[0];
#pragma unroll
                for (int s = 0; s < 16; ++s) {
                    const f32x4 cw = nw, ck = nk, ckk = nkk, cb = nb, cr = nr; const float cv = nv;
                    if (s + 1 < 16) {
                        LAS const float* r1 = rb + (s + 1) * 384;
                        nw = *(LAS const f32x4*)(r1); nk = *(LAS const f32x4*)(r1 + 64); nkk = *(LAS const f32x4*)(r1 + 128); nb = *(LAS const f32x4*)(r1 + 192); nr = *(LAS const f32x4*)(r1 + 256);
                        nv = rv[(s + 1) * 384];
                    }
                    scan_step<false>(S, cw, ck, ckk, cb, cr, cv, yp[s]);
                }
                Y[((size_t)b * 2048 + c * 16 + cgi) * 512 + h * 64 + ri] = reduce_scatter16(yp, cgi);
            } else {
                if (c + 1 < 128) { SCAN_PROCESS((c + 1) & 1); if (c + 2 < 128) SCAN_ISSUE(c + 2); }
            }
            __syncthreads();
        }
        if (wid < 4) *(f32x4*)(POUT + O_WKVP + ((((size_t)pair * 8 + b) * 8 + h) * 64 + ri) * 64 + cgi * 4) = S;
#undef SCAN_ISSUE
#undef SCAN_PROCESS
    }
}

__device__ void phase_even_post(const Params& p, const Ctx cx, int pair) {
    const int gtid = cx.bid * 512 + cx.tid, gthreads = cx.nblk * 512;
    const bf16_t* PA = (const bf16_t*)(PWS + WS_R1);
    bf16_t* Ycat = (bf16_t*)(PWS + WS_YCAT);
    const float* Y = (const float*)(PWS + WS_Y);
    constexpr int NIT = NTOK * 128, UB = 4;
    const float* gn_g = PIN(I_GNG) + pair * 512; const float* gn_b = PIN(I_GNB) + pair * 512;
    for (int e0 = gtid; e0 < NIT; e0 += gthreads * UB) {
        f32x4 y[UB], bv[UB], bz[UB]; bool ok[UB];
#pragma unroll
        for (int u = 0; u < UB; ++u) {
            const int e = e0 + u * gthreads; ok[u] = e < NIT;
            const int ee = ok[u] ? e : e0; const int row = ee >> 7, ch = (ee & 127) * 4;
            y[u] = *(const f32x4*)(Y + (size_t)row * 512 + ch);
            bv[u] = ld_bf4(Ycat + (size_t)row * 1024 + 512 + ch);
            bz[u] = ld_bf4(PA + (size_t)row * LDA + 2048 + ch);
        }
#pragma unroll
        for (int u = 0; u < UB; ++u) {
            const int e = e0 + u * gthreads;
            const int ee = ok[u] ? e : e0; const int row = ee >> 7, ch = (ee & 127) * 4;
            const float mean = allsum16(y[u][0] + y[u][1] + y[u][2] + y[u][3]) * (1.0f / 64.0f);
            const f32x4 d = y[u] - mean;
            const float var = allsum16(dot4(d, d)) * (1.0f / 64.0f);
            const float rstd = rsqrtf(var + 64e-5f);
            const f32x4 g = *(const f32x4*)(gn_g + ch), bb = *(const f32x4*)(gn_b + ch);
            f32x4 o;
#pragma unroll
            for (int j = 0; j < 4; ++j) o[j] = (d[j] * rstd * g[j] + bb[j] + bv[u][j]) * siluf_(bz[u][j]);
            if (ok[u]) st_bf4(Ycat + (size_t)row * 1024 + 512 + ch, o);
        }
    }
    const float* cw = PIN(I_CONVW) + pair * 3 * 512;
    for (int e0 = gtid; e0 < NIT; e0 += gthreads * UB) {
        f32x4 h0[UB], c0v[UB], h1[UB], c1v[UB], h2[UB], c2v[UB], ab[UB], az[UB]; bool ok[UB];
#pragma unroll
        for (int u = 0; u < UB; ++u) {
            const int e = e0 + u * gthreads; ok[u] = e < NIT;
            const int ee = ok[u] ? e : e0; const int row = ee >> 7, ch = (ee & 127) * 4;
            const int t = row < NTP ? (row & 2047) : ((row - NTP) & 7);
            const bf16_t* cur = PA + (size_t)row * LDA + ch;
            const bf16_t* p1 = t >= 1 ? cur - LDA : cur; const bf16_t* p2 = t >= 2 ? cur - 2 * LDA : cur;
            h0[u] = ld_bf4(cur); c0v[u] = ld_bf4(cur + 1024); h1[u] = ld_bf4(p1); c1v[u] = ld_bf4(p1 + 1024); h2[u] = ld_bf4(p2); c2v[u] = ld_bf4(p2 + 1024);
            ab[u] = ld_bf4(cur + 512); az[u] = ld_bf4(cur + 1536);
        }
#pragma unroll
        for (int u = 0; u < UB; ++u) {
            const int e = e0 + u * gthreads;
            const int ee = ok[u] ? e : e0; const int row = ee >> 7, ch = (ee & 127) * 4;
            const bool samp = row >= NTP;
            int b, t, T; if (!samp) { b = row >> 11; t = row & 2047; T = 2048; } else { const int q = row - NTP; b = q >> 3; t = q & 7; T = 8; }
            const f32x4 u0 = c0v[u] * h0[u];
            f32x4 u1 = c1v[u] * h1[u], u2 = c2v[u] * h2[u];
            if (t < 2) {
                const f32x4 zero = (f32x4){0.f, 0.f, 0.f, 0.f};
                const float* hist = PIN(I_SCONV) + ((size_t)pair * 128 + (samp ? b : 0)) * 2 * 512 + ch;
                if (t == 0) { u1 = samp ? *(const f32x4*)(hist + 512) : zero; u2 = samp ? *(const f32x4*)(hist) : zero; }
                else { u2 = samp ? *(const f32x4*)(hist + 512) : zero; }
            }
            const f32x4 k0 = *(const f32x4*)(cw + ch), k1 = *(const f32x4*)(cw + 512 + ch), k2 = *(const f32x4*)(cw + 1024 + ch);
            const f32x4 conv = k0 * u2 + k1 * u1 + k2 * u0;
            f32x4 o;
#pragma unroll
            for (int j = 0; j < 4; ++j) o[j] = ab[u][j] * conv[j] * siluf_(az[u][j]);
            if (ok[u]) {
                st_bf4(Ycat + (size_t)row * 1024 + ch, o);
                if (t >= T - 2) {
                    float* dst = samp ? POUT + O_CONVS + (((size_t)pair * 128 + b) * 2 + (t - (T - 2))) * 512 + ch : POUT + O_CONVP + (((size_t)pair * 8 + b) * 2 + (t - (T - 2))) * 512 + ch;
                    *(f32x4*)dst = u0;
                }
            }
        }
    }
}

__device__ void phase_odd_mixer(const Params& p, const Ctx cx, int pair, LAS unsigned char* lds) {
    const int tid = cx.tid, wid = tid >> 6, lane = tid & 63, fr = lane & 15, fq = lane >> 4;
    const bf16_t* PO = (const bf16_t*)(PWS + WS_R1);
    bf16_t* Ycat = (bf16_t*)(PWS + WS_YCAT);
    LAS bf16_t* LA = (LAS bf16_t*)lds;
    LAS bf16_t* LB = (LAS bf16_t*)(lds + 128 * 136 * 2);
    LAS float* stat = (LAS float*)(lds + 2 * 128 * 136 * 2);
    LAS float* LE = (LAS float*)(lds + 128 * 136 * 2);
    LAS bf16_t* LW = (LAS bf16_t*)(lds + 128 * 136 * 2 + 143 * 128 * 4);
    for (int tile = cx.bid; tile < 136; tile += cx.nblk) {
        const int r0 = tile * 128;
        const bool samp = r0 >= NTP;
        const int tl_ = tid >> 2, q_ = tid & 3;
        {
            const bf16_t* vr = PO + (size_t)(r0 + tl_) * LDA + 1536 + q_ * 128;
            float s_ = 0.f, ss = 0.f;
#pragma unroll
            for (int i = 0; i < 16; ++i) { const u32x4 raw = *(const u32x4*)(vr + i * 8); const f32x4 v0 = cvt4((u32x2){raw.x, raw.y}), v1 = cvt4((u32x2){raw.z, raw.w});
                s_ += (v0[0] + v0[1]) + (v0[2] + v0[3]) + (v1[0] + v1[1]) + (v1[2] + v1[3]); ss += dot4(v0, v0) + dot4(v1, v1); }
            s_ = allsum4(s_); ss = allsum4(ss);
            const float mean = s_ * (1.0f / 512.0f);
            const float var = fmaxf(ss * (1.0f / 512.0f) - mean * mean, 0.f);
            if (q_ == 0) { stat[tl_ * 2] = mean; stat[tl_ * 2 + 1] = rsqrtf(var + 1e-5f); }
        }
        u32x2 rv[8]; u32x4 rw[4];
#define MIX_LOAD_G(gg) do { const bf16_t* vr_ = PO + (size_t)(r0 + tl_) * LDA + 1536 + (gg) * 128 + q_ * 32; \
            _Pragma("unroll") for (int i = 0; i < 8; ++i) rv[i] = *(const u32x2*)(vr_ + i * 4); \
            if (!samp) { const bf16_t* Ws_ = (const bf16_t*)(PWS + WS_SPW) + ((size_t)pair * 4 + (gg)) * 128 * 128; \
                _Pragma("unroll") for (int i = 0; i < 4; ++i) { const int e = tid + i * 512; rw[i] = *(const u32x4*)(Ws_ + (e >> 4) * 128 + (e & 15) * 8); } } } while (0)
        MIX_LOAD_G(0);
        __syncthreads();
#pragma unroll 1
        for (int g = 0; g < 4; ++g) {
            u32x2 ur[8], dzr[8];
#pragma unroll
            for (int nt = 0; nt < 8; ++nt) { const size_t o_ = (size_t)(r0 + wid * 16 + fr) * LDA + g * 128 + nt * 16 + fq * 4; ur[nt] = *(const u32x2*)(PO + o_ + 1024); dzr[nt] = *(const u32x2*)(PO + o_ + 2048); }
            {
                const int row = r0 + tl_;
                const float mean = stat[tl_ * 2], rstd = stat[tl_ * 2 + 1];
                const float* lg = PIN(I_LNG) + pair * 512 + g * 128 + q_ * 32; const float* lb = PIN(I_LNB) + pair * 512 + g * 128 + q_ * 32;
#pragma unroll
                for (int i = 0; i < 8; ++i) {
                    const f32x4 v = cvt4(rv[i]);
                    const f32x4 vn = (v - mean) * rstd * *(const f32x4*)(lg + i * 4) + *(const f32x4*)(lb + i * 4);
                    if (samp) *(f32x4*)(POUT + O_CHUNKV + ((size_t)pair * 1024 + (row - NTP)) * 512 + g * 128 + q_ * 32 + i * 4) = vn;
#pragma unroll
                    for (int j = 0; j < 4; ++j) LB[(q_ * 32 + i * 4 + j) * 136 + tl_] = (bf16_t)(cvt_pk_bf16(vn[j], 0.f) & 0xffffu);
                }
            }
            if (!samp) {
#pragma unroll
                for (int i = 0; i < 4; ++i) { const int e = tid + i * 512; *(LAS u32x4*)(LA + (e >> 4) * 136 + (e & 15) * 8) = rw[i]; }
            } else {
                const float* Wsrc = PIN(I_SPW) + ((size_t)pair * 4 + g) * 128 * 128;
                for (int e = tid; e < 128 * 128; e += 512) { const int t = e >> 7, s2 = e & 127;
                    const float v = ((t >> 3) == (s2 >> 3) && (s2 & 7) <= (t & 7)) ? Wsrc[(t & 7) * 128 + (s2 & 7)] : 0.f;
                    LA[t * 136 + s2] = (bf16_t)(cvt_pk_bf16(v, 0.f) & 0xffffu); }
            }
            if (g + 1 < 4) MIX_LOAD_G(g + 1);
            __syncthreads();
            {
                const int tl = wid * 16 + fr, row = r0 + tl;
                const float bias = PIN(I_SPB)[((size_t)pair * 4 + g) * 128 + (samp ? (tl & 7) : tl)];
                bf16x8 wf[4];
#pragma unroll
                for (int ks = 0; ks < 4; ++ks) wf[ks] = *(const LAS bf16x8*)(LA + tl * 136 + ks * 32 + fq * 8);
#pragma unroll
                for (int nt = 0; nt < 8; ++nt) {
                    f32x4 acc = (f32x4){0.f, 0.f, 0.f, 0.f};
#pragma unroll
                    for (int ks = 0; ks < 4; ++ks) {
                        if (ks * 32 <= wid * 16 + 15) {
                            const bf16x8 vf = *(const LAS bf16x8*)(LB + (nt * 16 + fr) * 136 + ks * 32 + fq * 8);
                            acc = __builtin_amdgcn_mfma_f32_16x16x32_bf16(vf, wf[ks], acc, 0, 0, 0);
                        }
                    }
                    const int c = g * 128 + nt * 16 + fq * 4;
                    const f32x4 u = cvt4(ur[nt]), dz = cvt4(dzr[nt]);
                    f32x4 o;
#pragma unroll
                    for (int j = 0; j < 4; ++j) o[j] = u[j] * (acc[j] + bias) * siluf_(dz[j]);
                    st_bf4(Ycat + (size_t)row * 1024 + 512 + c, o);
                }
            }
            __syncthreads();
        }
#undef MIX_LOAD_G
    }
    {
        int ci, cstride;
        if (cx.nblk == 256) { if (cx.bid < 136) { ci = cx.bid; cstride = 1 << 20; } else { ci = cx.bid; cstride = 120; } }
        else { ci = cx.bid; cstride = cx.nblk; }
        u32x4 pw[4]; u32x2 pe[9];
#define MIX_LOAD_C(cc) do { const int tile_ = (cc) >> 2, g_ = (cc) & 3, r0_ = tile_ * 128; \
            const bf16_t* Bw_ = (const bf16_t*)(PWS + WS_POOLWT) + ((size_t)pair * 4 + g_) * 128 * 128; \
            _Pragma("unroll") for (int i = 0; i < 4; ++i) { const int e = tid + i * 512; pw[i] = *(const u32x4*)(Bw_ + (e >> 4) * 128 + (e & 15) * 8); } \
            if (r0_ < NTP) { const int t0_ = r0_ & 2047; \
                _Pragma("unroll") for (int i = 0; i < 9; ++i) { const int e = tid + i * 512, er = e >> 5, c = (e & 31) * 4; pe[i] = (u32x2){0u, 0u}; \
                    if (e < 143 * 32 && t0_ + er - 15 >= 0) pe[i] = *(const u32x2*)(PO + (size_t)(r0_ + er - 15) * LDA + g_ * 128 + c); } } } while (0)
        if (ci < 544) MIX_LOAD_C(ci);
        for (; ci < 544; ci += cstride) {
            const int tile = ci >> 2, g = ci & 3, r0 = tile * 128;
            const bool samp = r0 >= NTP;
            const int w = 2 << g;
            const int row = r0 + wid * 16 + fr;
            u32x2 czr[8]; f32x4 psr[8];
#pragma unroll
            for (int nt = 0; nt < 8; ++nt) { const int d = g * 128 + nt * 16 + fq * 4; czr[nt] = *(const u32x2*)(PO + (size_t)row * LDA + 512 + d); psr[nt] = *(const f32x4*)(PIN(I_PSCALE) + pair * 512 + d); }
#pragma unroll
            for (int i = 0; i < 4; ++i) { const int e = tid + i * 512; *(LAS u32x4*)(LW + (e >> 4) * 136 + (e & 15) * 8) = pw[i]; }
            if (!samp) {
                const int t0 = r0 & 2047;
#pragma unroll
                for (int i = 0; i < 9; ++i) { const int e = tid + i * 512, er = e >> 5, c = (e & 31) * 4; if (e < 143 * 32) *(LAS f32x4*)(LE + er * 128 + c) = cvt4(pe[i]); }
                __syncthreads();
                {
                    const int c = (tid & 31) * 4, tl0 = (tid >> 5) * 8;
                    f32x4 sum = (f32x4){0.f, 0.f, 0.f, 0.f};
#pragma unroll 4
                    for (int d = 0; d < w; ++d) sum += *(LAS const f32x4*)(LE + (tl0 + 15 - d) * 128 + c);
#pragma unroll
                    for (int k = 0; k < 8; ++k) {
                        const int tl = tl0 + k;
                        const f32x4 pt = *(LAS const f32x4*)(LE + (tl + 15) * 128 + c);
                        if (k > 0) sum += pt - *(LAS const f32x4*)(LE + (tl + 15 - w) * 128 + c);
                        const float cnt = fminf((float)w, (float)(t0 + tl + 1));
                        const f32x4 pooled = sum * (1.0f / cnt) - pt;
                        u32x2 u; u.x = cvt_pk_bf16(pooled[0], pooled[1]); u.y = cvt_pk_bf16(pooled[2], pooled[3]);
                        *(LAS u32x2*)(LA + tl * 136 + c) = u;
                    }
                }
            } else {
                for (int e = tid; e < 128 * 32; e += 512) {
                    const int tl = e >> 5, c = (e & 31) * 4, rowe = r0 + tl;
                    const int q = rowe - NTP, b = q >> 3, t = q & 7;
                    const bf16_t* cur = PO + (size_t)rowe * LDA + g * 128 + c;
                    const f32x4 pt = ld_bf4(cur);
                    f32x4 sum = pt;
                    for (int d = 1; d < w; ++d) {
                        const int tt = t - d;
                        if (tt >= 0) sum += ld_bf4(cur - (size_t)d * LDA);
                        else sum += *(const f32x4*)(PIN(I_SPOOL) + (((size_t)pair * 128 + b) * 15 + (15 + tt)) * 512 + g * 128 + c);
                    }
                    const f32x4 pooled = sum * (1.0f / (float)w) - pt;
                    u32x2 u; u.x = cvt_pk_bf16(pooled[0], pooled[1]); u.y = cvt_pk_bf16(pooled[2], pooled[3]);
                    *(LAS u32x2*)(LA + tl * 136 + c) = u;
                }
            }
            if (ci + cstride < 544) MIX_LOAD_C(ci + cstride);
            __syncthreads();
            bf16x8 af[4];
#pragma unroll
            for (int ks = 0; ks < 4; ++ks) af[ks] = *(const LAS bf16x8*)(LA + (wid * 16 + fr) * 136 + ks * 32 + fq * 8);
#pragma unroll
            for (int nt = 0; nt < 8; ++nt) {
                f32x4 acc = (f32x4){0.f, 0.f, 0.f, 0.f};
#pragma unroll
                for (int ks = 0; ks < 4; ++ks) {
                    const bf16x8 bf = *(const LAS bf16x8*)(LW + (nt * 16 + fr) * 136 + ks * 32 + fq * 8);
                    acc = __builtin_amdgcn_mfma_f32_16x16x32_bf16(bf, af[ks], acc, 0, 0, 0);
                }
                const int d = g * 128 + nt * 16 + fq * 4;
                const f32x4 cz = cvt4(czr[nt]), ps = psr[nt];
                f32x4 o;
#pragma unroll
                for (int j = 0; j < 4; ++j) o[j] = acc[j] * ps[j] * siluf_(cz[j]);
                st_bf4(Ycat + (size_t)row * 1024 + d, o);
            }
            __syncthreads();
        }
#undef MIX_LOAD_C
    }
    const int gtid = cx.bid * 512 + tid, gthreads = cx.nblk * 512;
    for (int e = gtid; e < 136 * 15 * 512; e += gthreads) {
        const int c = e & 511, q = e >> 9, sr = q / 15, k = q % 15;
        if (sr < 8) POUT[O_POOLP + (((size_t)pair * 8 + sr) * 15 + k) * 512 + c] = bf2f(PO[(size_t)(sr * 2048 + 2033 + k) * LDA + c]);
        else { const int b = sr - 8;
            POUT[O_POOLS + (((size_t)pair * 128 + b) * 15 + k) * 512 + c] = (k < 7) ? PIN(I_SPOOL)[(((size_t)pair * 128 + b) * 15 + 8 + k) * 512 + c] : bf2f(PO[(size_t)(NTP + b * 8 + (k - 7)) * LDA + c]); }
    }
}

__device__ void phase_final(const Params& p, const Ctx cx) {
    const int gtid = cx.bid * 512 + cx.tid, gthreads = cx.nblk * 512;
    const float* ssq = (const float*)(PWS + WS_SSQ) + (size_t)4 * NTOK * 16;
    const bf16_t* Xb = (const bf16_t*)(PWS + WS_XB);
    constexpr int NIT = NTOK * 256, UB = 4;
    for (int e0 = gtid; e0 < NIT; e0 += gthreads * UB) {
        f32x4 x[UB]; float sq[UB]; bool ok[UB];
#pragma unroll
        for (int u = 0; u < UB; ++u) { const int e = e0 + u * gthreads; ok[u] = e < NIT; const int ee = ok[u] ? e : e0; const int row = ee >> 8, c = (ee & 255) * 4;
            x[u] = ld_bf4(Xb + (size_t)row * 1024 + c); sq[u] = ssq_sum(ssq + (size_t)row * 16); }
#pragma unroll
        for (int u = 0; u < UB; ++u) { const int e = e0 + u * gthreads; const int ee = ok[u] ? e : e0; const int row = ee >> 8, c = (ee & 255) * 4;
            const float rstd = rsqrtf(sq[u] * (1.0f / 1024.0f) + 1e-6f);
            if (ok[u]) *(f32x4*)(POUT + (size_t)row * 1024 + c) = x[u] * rstd * *(const f32x4*)(PIN(I_FNORMW) + c); }
    }
}

#define XB_TMO      128
#define XB_XCNT(j)  (256  + 64 * (j))
#define XB_XSUB(j)  (1280 + 64 * (j))
#define XB_XGEN(j)  (2304 + 64 * (j))
#define XB_TOP      3328
#define XB_TOPGEN   3392
#define XCD_BAR_WORDS 3456
#define XB_SPIN_CAP (1u << 18)
__device__ __forceinline__ unsigned xb_ld(unsigned* p)              { return __hip_atomic_load(p, __ATOMIC_RELAXED, __HIP_MEMORY_SCOPE_AGENT); }
__device__ __forceinline__ unsigned xb_add(unsigned* p, unsigned v) { return __hip_atomic_fetch_add(p, v, __ATOMIC_RELAXED, __HIP_MEMORY_SCOPE_AGENT); }
__device__ __forceinline__ unsigned xb_xcc_id() { return (unsigned)__builtin_amdgcn_s_getreg((3 << 11) | 20) & 0xFu; }
#define XB_SPIN(cond, bar) do { unsigned _sp = 0; while (cond) { __builtin_amdgcn_s_sleep(1); \
    if ((++_sp & 255u) == 0u) { if (xb_ld(&(bar)[XB_TMO])) break; if (_sp > XB_SPIN_CAP) { atomicAdd(&(bar)[XB_TMO], 1u); break; } } } } while (0)
struct XcdBarrier { unsigned* bar; unsigned x; volatile LAS unsigned* st; };
__device__ __forceinline__ XcdBarrier xcd_barrier_post(unsigned* bar, volatile LAS unsigned* st) {
    XcdBarrier b; b.bar = bar; b.x = xb_xcc_id(); b.st = st;
    if (threadIdx.x == 0) (void)xb_add(&bar[XB_XCNT(b.x)], 1u);
    return b;
}
__device__ __forceinline__ void xcd_barrier_complete(unsigned* bar, unsigned x, unsigned& nloc, unsigned& nx) {
    const unsigned G = gridDim.x * gridDim.y * gridDim.z;
    unsigned sum, cnt, mine, sp = 0u;
    for (;;) {
        sum = 0u; cnt = 0u; mine = 0u;
#pragma unroll
        for (unsigned j = 0; j < 16; ++j) { const unsigned c = xb_ld(&bar[XB_XCNT(j)]); sum += c; cnt += (c > 0u) ? 1u : 0u; mine = (j == x) ? c : mine; }
        if (sum == G) break;
        __builtin_amdgcn_s_sleep(1);
        if ((++sp & 255u) == 0u) { if (xb_ld(&bar[XB_TMO])) break; if (sp > XB_SPIN_CAP) { atomicAdd(&bar[XB_TMO], 1u); break; } }
    }
    nloc = mine > 0u ? mine : 1u; nx = cnt > 0u ? cnt : 1u;
}
__device__ __forceinline__ void xcd_barrier(const XcdBarrier& b) {
    asm volatile("s_waitcnt vmcnt(0)" ::: "memory");
    __syncthreads();
    if (threadIdx.x == 0) {
        unsigned* bar = b.bar;
        __builtin_amdgcn_s_waitcnt(0);
        unsigned nloc = b.st[0], nx = b.st[1];
        if (nloc == 0u) { xcd_barrier_complete(bar, b.x, nloc, nx); b.st[0] = nloc; b.st[1] = nx; }
        const unsigned old = xb_add(&bar[XB_XSUB(b.x)], 1u);
        const unsigned gen = old / nloc;
        if (old + 1u == (gen + 1u) * nloc) {
            __builtin_amdgcn_fence(__ATOMIC_RELEASE, "agent");
            asm volatile("s_waitcnt vmcnt(0)" ::: "memory");
            const unsigned og = xb_add(&bar[XB_TOP], 1u);
            const unsigned tg = og / nx;
            if (og + 1u == (tg + 1u) * nx) xb_add(&bar[XB_TOPGEN], 1u);
            else XB_SPIN(xb_ld(&bar[XB_TOPGEN]) == tg, bar);
            __builtin_amdgcn_fence(__ATOMIC_ACQUIRE, "agent");
            xb_add(&bar[XB_XGEN(b.x)], 1u);
            asm volatile("s_waitcnt vmcnt(0)" ::: "memory");
        } else {
            XB_SPIN(xb_ld(&bar[XB_XGEN(b.x)]) == gen, bar);
            __builtin_amdgcn_fence(__ATOMIC_ACQUIRE, "agent");
            asm volatile("s_waitcnt vmcnt(0)" ::: "memory");
        }
    }
    __syncthreads();
}

__device__ void run_gemm_proj(const Params& p, const Ctx cx, LAS unsigned char* lds, const bf16_t* Bt, int N, bf16_t* O, int ldc, int layer) {
    pg8::Gemm g{(const bf16_t*)(PWS + WS_XB), Bt, NTOK, N, 1024};
    pg8::StaticOrder S; S.init(NTOK, N, (int)cx.nblk, (int)cx.bid);
    const float* ssq = (const float*)(PWS + WS_SSQ) + (size_t)layer * NTOK * 16;
    LAS float* rl = (LAS float*)(lds + 131072);
    int pm0 = -1, pm1 = -1, pm2 = -1, pm3 = -1, np = 0;
    for (int i = 0; i < 64; ++i) {
        pg8::Unit u; if (!S.next(i, u)) break;
        if (u.pm == pm0 || u.pm == pm1 || u.pm == pm2 || u.pm == pm3) continue;
        if (np == 0) pm0 = u.pm; else if (np == 1) pm1 = u.pm; else if (np == 2) pm2 = u.pm; else pm3 = u.pm;
        ++np;
    }
    for (int r = cx.tid; r < np * 256; r += 512) {
        const int i = r >> 8, pm = i == 0 ? pm0 : (i == 1 ? pm1 : (i == 2 ? pm2 : pm3));
        rl[r] = rsqrtf(ssq_sum(ssq + (size_t)(pm * 256 + (r & 255)) * 16) * (1.0f / 1024.0f) + 1e-6f);
    }
    __syncthreads();
    EpiProj E{O, ldc, rl, pm0, pm1, pm2, pm3};
    pg8::gemm_phase<EpiProj>(cx, lds, g, S, E);
}
__device__ void run_gemm_res(const Params& p, const Ctx cx, LAS unsigned char* lds, const bf16_t* Bt, int layer) {
    const bf16_t* A = (const bf16_t*)(PWS + WS_YCAT);
    bf16_t* Xb = (bf16_t*)(PWS + WS_XB);
    float* ssqn = (float*)(PWS + WS_SSQ) + (size_t)(layer + 1) * NTOK * 16;
    pg8::Gemm g{A, Bt, NTOK, 1024, 1024};
    pg8::StaticOrder S; S.init(NTOK, 1024, (int)cx.nblk, (int)cx.bid);
    EpiRes E{layer == 0 ? PIN(I_XP) : nullptr, PIN(I_XS), Xb, ssqn};
    pg8::gemm_phase<EpiRes>(cx, lds, g, S, E);
}

constexpr int N_PHASES = 20;
#ifndef PHMASK
#define PHMASK 0xffff
#endif
#define PHON(n) ((PHMASK >> ((n) % 16)) & 1)
__global__ void __launch_bounds__(512, 2) fwd_kernel(Params p) {
    extern __shared__ __attribute__((aligned(16))) unsigned char lds_raw[];
    LAS unsigned char* lds = (LAS unsigned char*)lds_raw;
    volatile LAS unsigned* bar_st = (volatile LAS unsigned*)(lds + LDS_MAIN);
    if (threadIdx.x < 4) bar_st[threadIdx.x] = 0u;
    __syncthreads();
    const XcdBarrier gbar = xcd_barrier_post((unsigned*)((unsigned char*)p.ptr[30] + WS_BAR), bar_st);
    if (p.ph_hi < 0) cg::this_grid().sync();
#define GRID_SYNC() xcd_barrier(gbar)
#ifdef SYNCPROBE
    for (int i = 0; i < SYNCPROBE; ++i) GRID_SYNC();
#endif
#ifdef REPMASK
    for (int pc = p.ph_lo * 2; pc < p.ph_hi * 2; ++pc) {
        const int ph = pc >> 1;
        { const int s_ = (ph == 0) ? 9 : (ph == N_PHASES - 1) ? 31 : (ph - 1) % 9; if ((pc & 1) && !((REPMASK >> s_) & 1)) continue; }
        if (pc > p.ph_lo * 2) GRID_SYNC();
#else
    for (int ph = p.ph_lo; ph < p.ph_hi; ++ph) {
        if (ph > p.ph_lo) GRID_SYNC();
#endif
        Ctx cx; cx.tid = threadIdx.x; cx.bid = blockIdx.x; cx.nblk = gridDim.x;
        asm volatile("s_mov_b32 %0, 0" : "=s"(cx.z));
        asm volatile("" : "+v"(cx.tid)); asm volatile("" : "+s"(cx.bid)); asm volatile("" : "+s"(cx.nblk));
        const int pair = (ph - 1) / 9, s = (ph == 0) ? 100 : (ph == N_PHASES - 1 ? 101 : (ph - 1) % 9);
        if (s == 0 || s == 3 || s == 6) {
#if PHON(0)
            const bf16_t* WinE = (const bf16_t*)(PWS + WS_WINE) + (size_t)pair * 4352 * 1024;
            const bf16_t* Bt = s == 0 ? WinE + (size_t)2560 * 1024 : (s == 3 ? WinE : (const bf16_t*)(PWS + WS_WINO) + (size_t)pair * 2560 * 1024);
            const int N = s == 0 ? 1792 : 2560;
            run_gemm_proj(p, cx, lds, Bt, N, (bf16_t*)(PWS + WS_R1), N, 2 * pair + (s == 6 ? 1 : 0));
#endif
        } else if (s == 5 || s == 8) {
#if PHON(5)
            const bf16_t* Bt = (const bf16_t*)(PWS + (s == 5 ? WS_WOUTE : WS_WOUTO)) + (size_t)pair * 1024 * 1024;
            run_gemm_res(p, cx, lds, Bt, 2 * pair + (s == 8 ? 1 : 0));
#endif
        } else if (s == 1) {
#if PHON(1)
            phase_even_prep(p, cx, pair, lds);
#endif
        } else if (s == 2) {
#if PHON(2)
            phase_scan(p, cx, pair, lds);
#endif
        } else if (s == 4) {
#if PHON(4)
            phase_even_post(p, cx, pair);
#endif
        } else if (s == 7) {
#if PHON(7)
            phase_odd_mixer(p, cx, pair, lds);
#endif
        } else if (s == 100) {
#if PHON(10)
            phase_prepass(p, cx, lds);
#endif
        } else {
#if PHON(11)
            phase_final(p, cx);
#endif
        }
    }
}

extern "C" void kernel_launch(void* const* d_in, const int* in_sizes, int n_in, void* d_out, int out_size, void* d_ws, size_t ws_size, hipStream_t stream) {
    static int grid = 0;
    if (grid == 0) {
        if (n_in != 29 || ws_size < WS_END) { fprintf(stderr, "kernel_launch: unexpected n_in %d / ws_size %zu (need %zu)\n", n_in, ws_size, (size_t)WS_END); grid = -1; return; }
        int dev = 0, cus = 0, per_cu = 0;
        hipGetDevice(&dev);
        hipDeviceGetAttribute(&cus, hipDeviceAttributeMultiprocessorCount, dev);
        if (hipFuncSetAttribute((const void*)fwd_kernel, hipFuncAttributeMaxDynamicSharedMemorySize, LDS_BYTES) != hipSuccess) { fprintf(stderr, "kernel_launch: hipFuncSetAttribute failed\n"); grid = -1; return; }
        if (hipOccupancyMaxActiveBlocksPerMultiprocessor(&per_cu, (const void*)fwd_kernel, 512, LDS_BYTES) != hipSuccess || per_cu < 1) { fprintf(stderr, "kernel_launch: occupancy query gave %d\n", per_cu); per_cu = 1; }
        (void)hipGetLastError();
        grid = cus * per_cu;
        if (grid > 256) grid = 256;
    }
    if (grid < 0) return;
    Params p{};
    for (int i = 0; i < 29; ++i) p.ptr[i] = d_in[i];
    p.ptr[29] = d_out; p.ptr[30] = d_ws; p.ptr[31] = nullptr;
    (void)hipMemsetAsync((unsigned char*)d_ws + WS_BAR, 0, 16384, stream);
#if ONE_LAUNCH
    p.ph_lo = 0; p.ph_hi = N_PHASES;
    void* args[] = {&p};
    hipError_t e = hipLaunchCooperativeKernel((const void*)fwd_kernel, dim3(grid), dim3(512), args, LDS_BYTES, stream);
    if (e != hipSuccess) fprintf(stderr, "cooperative launch failed: %s (grid %d)\n", hipGetErrorString(e), grid);
#else
    for (int ph = 0; ph < N_PHASES; ++ph) {
        p.ph_lo = ph; p.ph_hi = ph + 1;
        hipLaunchKernelGGL(fwd_kernel, dim3(grid), dim3(512), LDS_BYTES, stream, p);
    }
#endif
}
```

```cpp
#include <hip/hip_runtime.h>
#include <hip/hip_cooperative_groups.h>
#include <cstdio>
namespace cg = cooperative_groups;

#ifndef ONE_LAUNCH
#define ONE_LAUNCH 1
#endif

#define LAS __attribute__((address_space(3)))
typedef unsigned short bf16_t;
typedef short bf16x8 __attribute__((ext_vector_type(8)));
typedef float f32x4 __attribute__((ext_vector_type(4)));
typedef unsigned u32x4 __attribute__((ext_vector_type(4)));
typedef unsigned u32x2 __attribute__((ext_vector_type(2)));

constexpr int NTOK = 17408, NTP = 16384;
constexpr int LDB = 1792;
constexpr int LDA = 2560;
constexpr size_t O_CONVP = 17825792, O_CONVS = 17842176, O_SHIFTP = 18104320, O_SHIFTS = 18130944, O_WKVP = 18556928, O_WKVS = 19081216,
                 O_POOLP = 27469824, O_POOLS = 27592704, O_CHUNKV = 29558784;
constexpr size_t WS_WINE = 0;
constexpr size_t WS_WOUTE = WS_WINE + 2ull * 4352 * 1024 * 2;
constexpr size_t WS_WINO = WS_WOUTE + 2ull * 1024 * 1024 * 2;
constexpr size_t WS_WOUTO = WS_WINO + 2ull * 2560 * 1024 * 2;
constexpr size_t WS_W2T = WS_WOUTO + 2ull * 1024 * 1024 * 2;
constexpr size_t WS_A2T = WS_W2T + 2ull * 512 * 64 * 2;
constexpr size_t WS_POOLWT = WS_A2T + 2ull * 512 * 64 * 2;
constexpr size_t WS_SPW = WS_POOLWT + 8ull * 128 * 128 * 2;
constexpr size_t WS_XB = WS_SPW + 8ull * 128 * 128 * 2;
constexpr size_t WS_YCAT = WS_XB + (size_t)NTOK * 1024 * 2;
constexpr size_t WS_SSQ = WS_YCAT + (size_t)NTOK * 1024 * 2;
constexpr size_t WS_Y = WS_SSQ + 5ull * NTOK * 16 * 4;
constexpr size_t WS_R1 = WS_Y + (size_t)NTOK * 512 * 4;
constexpr size_t WS_PROJB = WS_R1;
constexpr size_t WS_WDEC = WS_PROJB + (size_t)NTOK * LDB * 2;
constexpr size_t WS_AA = WS_WDEC + (size_t)NTOK * 512 * 4;
constexpr size_t WS_BAR = WS_AA + (size_t)NTOK * 512 * 2;
constexpr size_t WS_END = WS_BAR + 16384;
constexpr int LDS_MAIN = 147456;
constexpr int LDS_BYTES = LDS_MAIN + 16;

struct Params {
    const void* ptr[32];
    int ph_lo, ph_hi;
};
struct Ctx { int tid, bid, nblk, z; };
#define PIN(i) ((const float*)p.ptr[(i) + cx.z])
#define POUT ((float*)p.ptr[29 + cx.z])
#define PWS ((unsigned char*)p.ptr[30 + cx.z])
enum { I_XP = 0, I_XS, I_SCONV, I_SSHIFT, I_SWKV, I_SPOOL, I_NORMW, I_FNORMW, I_WINE, I_CONVW, I_MU, I_W0, I_W2, I_A0, I_A2, I_KK, I_KA, I_RK, I_GNG, I_GNB,
       I_WOUTE, I_WINO, I_POOLW, I_PSCALE, I_LNG, I_LNB, I_SPW, I_SPB, I_WOUTO };

__device__ __forceinline__ unsigned cvt_pk_bf16(float lo, float hi) { unsigned r; asm("v_cvt_pk_bf16_f32 %0, %1, %2" : "=v"(r) : "v"(lo), "v"(hi)); return r; }
__device__ __forceinline__ float bf_lo(unsigned u) { return __uint_as_float(u << 16); }
__device__ __forceinline__ float bf_hi(unsigned u) { return __uint_as_float(u & 0xffff0000u); }
__device__ __forceinline__ float bf2f(bf16_t b) { return __uint_as_float(((unsigned)b) << 16); }
__device__ __forceinline__ f32x4 cvt4(u32x2 u) { return (f32x4){bf_lo(u.x), bf_hi(u.x), bf_lo(u.y), bf_hi(u.y)}; }
__device__ __forceinline__ f32x4 ld_bf4(const bf16_t* p) { return cvt4(*(const u32x2*)p); }
__device__ __forceinline__ void st_bf4(bf16_t* p, f32x4 v) { u32x2 u; u.x = cvt_pk_bf16(v[0], v[1]); u.y = cvt_pk_bf16(v[2], v[3]); *(u32x2*)p = u; }
__device__ __forceinline__ float sigmoidf_(float x) { return 1.0f / (1.0f + __expf(-x)); }
__device__ __forceinline__ float siluf_(float x) { return x / (1.0f + __expf(-x)); }
template <int CTRL> __device__ __forceinline__ float dpp_f(float x) { return __builtin_bit_cast(float, __builtin_amdgcn_mov_dpp(__builtin_bit_cast(int, x), CTRL, 0xf, 0xf, true)); }
__device__ __forceinline__ float allsum16(float x) { x += dpp_f<0xB1>(x); x += dpp_f<0x4E>(x); x += dpp_f<0x141>(x); x += dpp_f<0x128>(x); return x; }
__device__ __forceinline__ float allsum4(float x) { x += dpp_f<0xB1>(x); x += dpp_f<0x4E>(x); return x; }
__device__ __forceinline__ float dot4(f32x4 a, f32x4 b) { return a[0] * b[0] + a[1] * b[1] + a[2] * b[2] + a[3] * b[3]; }

__device__ __forceinline__ float ssq_sum(const float* part) {
    const f32x4 a = *(const f32x4*)(part), b = *(const f32x4*)(part + 4), c = *(const f32x4*)(part + 8), d = *(const f32x4*)(part + 12);
    return ((a[0] + a[1]) + (a[2] + a[3])) + ((b[0] + b[1]) + (b[2] + b[3])) + ((c[0] + c[1]) + (c[2] + c[3])) + ((d[0] + d[1]) + (d[2] + d[3]));
}

namespace pg8 {
constexpr int BM = 256, BK = 64, HALF = 128, HTB = HALF * BK * 2, NXCD = 8, WGM = 8;
__device__ __forceinline__ int lds_byte(int r, int c) { const int st = (r >> 4) * 2 + (c >> 5), rr = r & 15, cc = c & 31, ob = rr * 64 + cc * 2; return st * 1024 + (ob ^ (((ob >> 9) & 1) << 5)); }
__device__ __forceinline__ void stage_rc(int b, int& R, int& C) { const int st = b / 1024, sb = b % 1024, swz = sb ^ (((sb >> 9) & 1) << 5); R = (st >> 1) * 16 + swz / 64; C = (st & 1) * 32 + (swz % 64) / 2; }
__device__ __forceinline__ int perm32(int rho) { const int n = rho >> 4, i = rho & 15; return 8 * (i >> 2) + 4 * n + (i & 3); }
struct Unit { int pm, pn; };
struct Gemm { const bf16_t* A; const bf16_t* Bt; int M, N, K; };
struct StaticOrder {
    int nM, nN, nwg, G, c;
    __device__ void init(int M, int N, int G_, int c_) { nM = M / BM; nN = N / BM; nwg = nM * nN; G = G_; c = c_; }
    __device__ bool next(int i, Unit& u) const {
        const long L = (long)i * G + c; if (L >= nwg) return false;
        int wgid = (int)L; { const int q = nwg / NXCD, r = nwg % NXCD, xcd = wgid % NXCD, off = wgid / NXCD; wgid = (xcd < r ? xcd * (q + 1) : r * (q + 1) + (xcd - r) * q) + off; }
        const int nig = WGM * nN, gid = wgid / nig, fm = gid * WGM, gsz = (nM - fm) < WGM ? (nM - fm) : WGM;
        u.pm = fm + ((wgid % nig) % gsz); u.pn = (wgid % nig) / gsz; return true;
    }
};

template <class Epi>
__device__ __forceinline__ void gemm_phase(const Ctx cx, LAS unsigned char* lds, const Gemm g, const StaticOrder& S, const Epi& E) {
    const int tid = cx.tid, wid = __builtin_amdgcn_readfirstlane(tid >> 6), lane = tid & 63, wr = wid >> 2, wc = wid & 3, fr = lane & 15, fq = lane >> 4;
    const int K = g.K, nt = K / BK;
    unsigned voffA[2], voffB[2];
#pragma unroll
    for (int i = 0; i < 2; ++i) { int R, C; stage_rc(tid * 16 + i * 8192, R, C); const int Rb = Epi::PERM ? ((R & ~31) + perm32(R & 31)) : R;
        voffA[i] = (unsigned)(R * K + C) * 2u; voffB[i] = (unsigned)(Rb * K + C) * 2u; }
    const size_t kstep = (size_t)(BK * 2);
    const size_t hstep = (size_t)HALF * K * 2;
    const size_t tstep = 2 * hstep;
    const unsigned ldsw = (unsigned)wid * 1024u;
    const int aoff = lds_byte(wr * 64 + fr, fq * 8), boff = lds_byte(wc * 32 + fr, fq * 8);
#define PG8_SA(b, h) (((b) * 2 + (h)) * HTB)
#define PG8_SB(b, h) ((4 + (b) * 2 + (h)) * HTB)
#define PG8_STAGE(bufoff, gbase, voff) do { _Pragma("unroll") for (int _i = 0; _i < 2; ++_i) \
        __builtin_amdgcn_global_load_lds((const unsigned*)((const char*)(gbase) + (voff)[_i]), (LAS unsigned*)(lds + (bufoff) + ldsw + _i * 8192), 16, 0, 0); } while (0)
#define PG8_LDA(dst, b, h) do { _Pragma("unroll") for (int m = 0; m < 4; ++m) _Pragma("unroll") for (int k = 0; k < 2; ++k) dst[m][k] = *(const LAS bf16x8*)(lds + PG8_SA(b, h) + aoff + m * 2048 + k * 1024); } while (0)
#define PG8_LDB(dst, b, h) do { _Pragma("unroll") for (int n = 0; n < 2; ++n) _Pragma("unroll") for (int k = 0; k < 2; ++k) dst[n][k] = *(const LAS bf16x8*)(lds + PG8_SB(b, h) + boff + n * 2048 + k * 1024); } while (0)
#define PG8_MMA(ai, bj, At, Bt) do { __builtin_amdgcn_s_setprio(1); _Pragma("unroll") for (int m = 0; m < 4; ++m) _Pragma("unroll") for (int n = 0; n < 2; ++n) _Pragma("unroll") for (int k = 0; k < 2; ++k) \
        acc[ai][bj][m][n] = __builtin_amdgcn_mfma_f32_16x16x32_bf16(Bt[n][k], At[m][k], acc[ai][bj][m][n], 0, 0, 0); __builtin_amdgcn_s_setprio(0); } while (0)
#define PG8_WAIT_V(n) asm volatile("s_waitcnt vmcnt(" #n ")" ::: "memory")
#define PG8_WAIT_L(n) asm volatile("s_waitcnt lgkmcnt(" #n ")" ::: "memory")
#define PG8_BAR __builtin_amdgcn_s_barrier()
#define PG8_SCHED __builtin_amdgcn_sched_barrier(0)
    Unit cur, nxt; int ui = 0;
    if (!S.next(0, cur)) return;
    f32x4 acc[2][2][4][2];
#pragma unroll
    for (int a = 0; a < 2; ++a)
#pragma unroll
        for (int b = 0; b < 2; ++b)
#pragma unroll
            for (int m = 0; m < 4; ++m)
#pragma unroll
                for (int n = 0; n < 2; ++n) acc[a][b][m][n] = (f32x4){0.f, 0.f, 0.f, 0.f};
    bf16x8 At[4][2], B0[2][2], B1[2][2];
    const char* cA = (const char*)g.A + (size_t)cur.pm * tstep; const char* cB = (const char*)g.Bt + (size_t)cur.pn * tstep;
    PG8_STAGE(PG8_SB(0, 0), cB, voffB); PG8_STAGE(PG8_SA(0, 0), cA, voffA); PG8_STAGE(PG8_SB(0, 1), cB + hstep, voffB); PG8_STAGE(PG8_SA(0, 1), cA + hstep, voffA);
    if (wr == 1) PG8_BAR;
    PG8_WAIT_V(4); PG8_BAR;
    PG8_STAGE(PG8_SB(1, 0), cB + kstep, voffB); PG8_STAGE(PG8_SA(1, 0), cA + kstep, voffA); PG8_STAGE(PG8_SB(1, 1), cB + hstep + kstep, voffB);
    PG8_WAIT_V(6); PG8_BAR;
    for (;;) {
        const bool has_next = S.next(ui + 1, nxt);
        const char* nA = has_next ? (const char*)g.A + (size_t)nxt.pm * tstep : cA; const char* nB = has_next ? (const char*)g.Bt + (size_t)nxt.pn * tstep : cB;
        for (int t = 0; t < nt; t += 2) {
            const bool last = (t == nt - 2);
            const char* a1 = cA + (size_t)(t + 1) * kstep;
            const char* a2 = last ? nA : cA + (size_t)(t + 2) * kstep; const char* b2 = last ? nB : cB + (size_t)(t + 2) * kstep;
            const char* a3 = a2 + kstep; const char* b3 = b2 + kstep;
            PG8_LDB(B0, 0, 0); PG8_SCHED; PG8_LDA(At, 0, 0); PG8_STAGE(PG8_SA(1, 1), a1 + hstep, voffA);
            PG8_WAIT_L(8); PG8_BAR; PG8_WAIT_L(0); PG8_MMA(0, 0, At, B0); PG8_BAR; PG8_SCHED;
            PG8_LDB(B1, 0, 1); PG8_STAGE(PG8_SB(0, 0), b2, voffB);
            PG8_BAR; PG8_WAIT_L(0); PG8_MMA(0, 1, At, B1); PG8_BAR;
            PG8_LDA(At, 0, 1); PG8_STAGE(PG8_SA(0, 0), a2, voffA);
            PG8_BAR; PG8_WAIT_L(0); PG8_MMA(1, 0, At, B0); PG8_BAR; PG8_SCHED;
            PG8_STAGE(PG8_SB(0, 1), b2 + hstep, voffB);
            PG8_WAIT_V(6); PG8_BAR; PG8_MMA(1, 1, At, B1); PG8_BAR;
            PG8_LDB(B0, 1, 0); PG8_SCHED; PG8_LDA(At, 1, 0); PG8_STAGE(PG8_SA(0, 1), a2 + hstep, voffA);
            PG8_WAIT_L(8); PG8_BAR; PG8_WAIT_L(0); PG8_MMA(0, 0, At, B0); PG8_BAR; PG8_SCHED;
            PG8_LDB(B1, 1, 1); PG8_STAGE(PG8_SB(1, 0), b3, voffB);
            PG8_BAR; PG8_WAIT_L(0); PG8_MMA(0, 1, At, B1); PG8_BAR;
            PG8_LDA(At, 1, 1); PG8_STAGE(PG8_SA(1, 0), a3, voffA);
            PG8_BAR; PG8_WAIT_L(0); PG8_MMA(1, 0, At, B0); PG8_BAR; PG8_SCHED;
            PG8_STAGE(PG8_SB(1, 1), b3 + hstep, voffB);
            PG8_WAIT_V(6); PG8_BAR; PG8_MMA(1, 1, At, B1); PG8_BAR;
        }
        E(acc, cur, wr, wc, fr, fq);
        if (!has_next) break;
#pragma unroll
        for (int a = 0; a < 2; ++a)
#pragma unroll
            for (int b = 0; b < 2; ++b)
#pragma unroll
                for (int m = 0; m < 4; ++m)
#pragma unroll
                    for (int n = 0; n < 2; ++n) acc[a][b][m][n] = (f32x4){0.f, 0.f, 0.f, 0.f};
        cur = nxt; cA = nA; cB = nB; ++ui;
    }
    PG8_WAIT_V(0);
    if (wr == 0) PG8_BAR;
    PG8_BAR;
#undef PG8_SA
#undef PG8_SB
#undef PG8_STAGE
#undef PG8_LDA
#undef PG8_LDB
#undef PG8_MMA
#undef PG8_WAIT_V
#undef PG8_WAIT_L
#undef PG8_BAR
#undef PG8_SCHED
}
}

struct EpiProj {
    static constexpr bool PERM = true;
    bf16_t* O; int ldc; LAS const float* rl; int pm0, pm1, pm2, pm3;
    __device__ __forceinline__ void operator()(const f32x4 (&acc)[2][2][4][2], const pg8::Unit& u, int wr, int wc, int fr, int fq) const {
        const int row0 = u.pm * 256 + wr * 64 + fr, col0 = u.pn * 256 + wc * 32 + 8 * fq;
        const int sel = u.pm == pm0 ? 0 : (u.pm == pm1 ? 1 : (u.pm == pm2 ? 2 : 3));
        LAS const float* rp = rl + sel * 256 + wr * 64 + fr;
#pragma unroll
        for (int ai = 0; ai < 2; ++ai)
#pragma unroll
            for (int m = 0; m < 4; ++m) {
                const int row = row0 + ai * 128 + m * 16;
                const float rstd = rp[ai * 128 + m * 16];
                bf16_t* rowp = O + (size_t)row * ldc + col0;
#pragma unroll
                for (int bj = 0; bj < 2; ++bj) {
                    const f32x4 v0 = acc[ai][bj][m][0] * rstd, v1 = acc[ai][bj][m][1] * rstd;
                    u32x4 w; w.x = cvt_pk_bf16(v0[0], v0[1]); w.y = cvt_pk_bf16(v0[2], v0[3]); w.z = cvt_pk_bf16(v1[0], v1[1]); w.w = cvt_pk_bf16(v1[2], v1[3]);
                    *(u32x4*)(rowp + bj * 128) = w;
                }
            }
    }
};
struct X8 { f32x4 lo, hi; };
template <bool FIRST> __device__ __forceinline__ X8 ld_x8(const float* __restrict__ s32, const bf16_t* __restrict__ s16, size_t o) {
    X8 r;
    if (FIRST) { r.lo = *(const f32x4*)(s32 + o); r.hi = *(const f32x4*)(s32 + o + 4); }
    else { const u32x4 u = *(const u32x4*)(s16 + o); r.lo = cvt4((u32x2){u.x, u.y}); r.hi = cvt4((u32x2){u.z, u.w}); }
    return r;
}
__device__ __forceinline__ void st_x8(bf16_t* p, f32x4 lo, f32x4 hi) { u32x4 w; w.x = cvt_pk_bf16(lo[0], lo[1]); w.y = cvt_pk_bf16(lo[2], lo[3]); w.z = cvt_pk_bf16(hi[0], hi[1]); w.w = cvt_pk_bf16(hi[2], hi[3]); *(u32x4*)p = w; }
template <bool FIRST>
__device__ __forceinline__ void epi_res_rows(const f32x4 (&acc)[2][2][4][2], const float* __restrict__ src32, const bf16_t* __restrict__ src16, bf16_t* __restrict__ Xb, float* __restrict__ ssqp,
                                             int row0, int col0, int slot, int fq) {
    X8 x[2][2];
#pragma unroll
    for (int bj = 0; bj < 2; ++bj) x[0][bj] = ld_x8<FIRST>(src32, src16, (size_t)row0 * 1024 + col0 + bj * 128);
#pragma unroll
    for (int gi = 0; gi < 8; ++gi) {
        const int ai = gi >> 2, m = gi & 3, row = row0 + ai * 128 + m * 16;
        if (gi + 1 < 8) {
            const int nrow = row0 + ((gi + 1) >> 2) * 128 + ((gi + 1) & 3) * 16;
#pragma unroll
            for (int bj = 0; bj < 2; ++bj) x[(gi + 1) & 1][bj] = ld_x8<FIRST>(src32, src16, (size_t)nrow * 1024 + col0 + bj * 128);
        }
        float part = 0.f;
#pragma unroll
        for (int bj = 0; bj < 2; ++bj) {
            const f32x4 lo = x[gi & 1][bj].lo + acc[ai][bj][m][0], hi = x[gi & 1][bj].hi + acc[ai][bj][m][1];
            st_x8(Xb + (size_t)row * 1024 + col0 + bj * 128, lo, hi);
            part += dot4(lo, lo) + dot4(hi, hi);
        }
        part += __shfl_xor(part, 16); part += __shfl_xor(part, 32);
        if (fq == 0) ssqp[(size_t)row * 16 + slot] = part;
    }
}
struct EpiRes {
    static constexpr bool PERM = true;
    const float* xp; const float* xs; bf16_t* Xb; float* ssq_next;
    __device__ __forceinline__ void operator()(const f32x4 (&acc)[2][2][4][2], const pg8::Unit& u, int wr, int wc, int fr, int fq) const {
        const int row0 = u.pm * 256 + wr * 64 + fr, col0 = u.pn * 256 + wc * 32 + 8 * fq;
        if (xp) epi_res_rows<true>(acc, row0 < NTP ? xp : xs - (size_t)NTP * 1024, nullptr, Xb, ssq_next, row0, col0, u.pn * 4 + wc, fq);
        else epi_res_rows<false>(acc, nullptr, Xb, Xb, ssq_next, row0, col0, u.pn * 4 + wc, fq);
    }
};

template <bool FIRST>
__device__ __forceinline__ void res_sample_tile(const Ctx cx, const bf16_t* __restrict__ A, const bf16_t* __restrict__ Bt, const float* __restrict__ xs, bf16_t* __restrict__ Xb, float* __restrict__ ssqp, int tile) {
    const int tid = cx.tid, wid = tid >> 6, lane = tid & 63, fr = lane & 15, fq = lane >> 4;
    const int tm = tile >> 3, tn = tile & 7;
    const int r0 = NTP + tm * 64 + (wid & 3) * 16, c0 = tn * 128 + (wid >> 2) * 64;
    const bf16_t* ap = A + (size_t)(r0 + fr) * 1024 + fq * 8;
    const bf16_t* bp = Bt + (size_t)(c0 + fr) * 1024 + fq * 8;
    f32x4 acc[4];
#pragma unroll
    for (int nt = 0; nt < 4; ++nt) acc[nt] = (f32x4){0.f, 0.f, 0.f, 0.f};
#pragma unroll 8
    for (int ks = 0; ks < 32; ++ks) {
        const bf16x8 af = *(const bf16x8*)(ap + ks * 32);
#pragma unroll
        for (int nt = 0; nt < 4; ++nt) {
            const bf16x8 bf = *(const bf16x8*)(bp + (size_t)nt * 16 * 1024 + ks * 32);
            acc[nt] = __builtin_amdgcn_mfma_f32_16x16x32_bf16(bf, af, acc[nt], 0, 0, 0);
        }
    }
    const int row = r0 + fr;
    float part = 0.f;
#pragma unroll
    for (int nt = 0; nt < 4; ++nt) {
        const int col = c0 + nt * 16 + fq * 4;
        const f32x4 xo = FIRST ? *(const f32x4*)(xs + (size_t)(row - NTP) * 1024 + col) : ld_bf4(Xb + (size_t)row * 1024 + col);
        const f32x4 v = xo + acc[nt];
        st_bf4(Xb + (size_t)row * 1024 + col, v);
        part += dot4(v, v);
    }
    part += __shfl_xor(part, 16); part += __shfl_xor(part, 32);
    if (fq == 0) ssqp[(size_t)row * 16 + (c0 >> 6)] = part;
}

__device__ __forceinline__ void tr_tile(const Ctx cx, LAS float* T, const float* src, int ld, int col0, int k0, bf16_t* dst, int Ktot, int drow0, const float* scale, bool zero) {
    const int tid = cx.tid;
    if (zero) {
        const int n = tid >> 3, kc = (tid & 7) * 8;
        *(u32x4*)(dst + (size_t)(drow0 + n) * Ktot + k0 + kc) = (u32x4){0u, 0u, 0u, 0u};
        return;
    }
#pragma unroll
    for (int pass = 0; pass < 2; ++pass) {
        const int kk = (tid >> 4) + pass * 32, nn = (tid & 15) * 4;
        f32x4 v = *(const f32x4*)(src + (size_t)(k0 + kk) * ld + col0 + nn);
        if (scale) v = v * scale[k0 + kk];
        T[kk * 65 + nn] = v[0]; T[kk * 65 + nn + 1] = v[1]; T[kk * 65 + nn + 2] = v[2]; T[kk * 65 + nn + 3] = v[3];
    }
    __syncthreads();
    {
        const int n = tid >> 3, kc = (tid & 7) * 8;
        u32x4 w;
        w.x = cvt_pk_bf16(T[(kc + 0) * 65 + n], T[(kc + 1) * 65 + n]); w.y = cvt_pk_bf16(T[(kc + 2) * 65 + n], T[(kc + 3) * 65 + n]);
        w.z = cvt_pk_bf16(T[(kc + 4) * 65 + n], T[(kc + 5) * 65 + n]); w.w = cvt_pk_bf16(T[(kc + 6) * 65 + n], T[(kc + 7) * 65 + n]);
        *(u32x4*)(dst + (size_t)(drow0 + n) * Ktot + k0 + kc) = w;
    }
    __syncthreads();
}

__device__ void phase_prepass(const Params& p, const Ctx cx, LAS unsigned char* lds) {
    LAS float* T = (LAS float*)lds;
    const int tid = cx.tid;
    for (int job = cx.bid; job < 4544; job += cx.nblk) {
        int j = job;
        if (j < 2176) {
            const int i = j / 1088, r = j % 1088, nt = r / 16, kt = r % 16;
            const int n0 = nt * 64;
            int col0; bool zero = false;
            if (n0 < 2048) col0 = n0; else if (n0 < 2560) col0 = 3712 + (n0 - 2048); else if (n0 < 4224) col0 = 2048 + (n0 - 2560); else { col0 = 0; zero = true; }
            tr_tile(cx, T, PIN(I_WINE) + (size_t)i * 1024 * 4224, 4224, col0, kt * 64, (bf16_t*)(PWS + WS_WINE) + (size_t)i * 4352 * 1024, 1024, n0, PIN(I_NORMW) + (2 * i) * 1024, zero);
            continue;
        }
        j -= 2176;
        if (j < 512) { const int i = j / 256, r = j % 256, nt = r / 16, kt = r % 16;
            tr_tile(cx, T, PIN(I_WOUTE) + (size_t)i * 1024 * 1024, 1024, nt * 64, kt * 64, (bf16_t*)(PWS + WS_WOUTE) + (size_t)i * 1024 * 1024, 1024, nt * 64, nullptr, false); continue; }
        j -= 512;
        if (j < 1280) { const int i = j / 640, r = j % 640, nt = r / 16, kt = r % 16;
            tr_tile(cx, T, PIN(I_WINO) + (size_t)i * 1024 * 2560, 2560, nt * 64, kt * 64, (bf16_t*)(PWS + WS_WINO) + (size_t)i * 2560 * 1024, 1024, nt * 64, PIN(I_NORMW) + (2 * i + 1) * 1024, false); continue; }
        j -= 1280;
        if (j < 512) { const int i = j / 256, r = j % 256, nt = r / 16, kt = r % 16;
            tr_tile(cx, T, PIN(I_WOUTO) + (size_t)i * 1024 * 1024, 1024, nt * 64, kt * 64, (bf16_t*)(PWS + WS_WOUTO) + (size_t)i * 1024 * 1024, 1024, nt * 64, nullptr, false); continue; }
        j -= 512;
        if (j < 16) { const int i = j / 8, nt = j % 8;
            tr_tile(cx, T, PIN(I_W2) + (size_t)i * 64 * 512, 512, nt * 64, 0, (bf16_t*)(PWS + WS_W2T) + (size_t)i * 512 * 64, 64, nt * 64, nullptr, false); continue; }
        j -= 16;
        if (j < 16) { const int i = j / 8, nt = j % 8;
            tr_tile(cx, T, PIN(I_A2) + (size_t)i * 64 * 512, 512, nt * 64, 0, (bf16_t*)(PWS + WS_A2T) + (size_t)i * 512 * 64, 64, nt * 64, nullptr, false); continue; }
        j -= 16;
        { const int ig = j / 4, r = j % 4, nt = r / 2, kt = r % 2;
            tr_tile(cx, T, PIN(I_POOLW) + (size_t)ig * 128 * 128, 128, nt * 64, kt * 64, (bf16_t*)(PWS + WS_POOLWT) + (size_t)ig * 128 * 128, 128, nt * 64, nullptr, false); }
    }
    const int gtid = cx.bid * 512 + tid, gthreads = cx.nblk * 512;
    for (int e = gtid; e < 8 * 128 * 128; e += gthreads) {
        const int s = e & 127, t = (e >> 7) & 127;
        ((bf16_t*)(PWS + WS_SPW))[e] = (s <= t) ? (bf16_t)(cvt_pk_bf16(PIN(I_SPW)[e], 0.f) & 0xffffu) : (bf16_t)0;
    }
    const int wid = tid >> 6, lane = tid & 63;
    for (int row = cx.bid * 8 + wid; row < NTOK; row += cx.nblk * 8) {
        const float* src = row < NTP ? PIN(I_XP) + (size_t)row * 1024 : PIN(I_XS) + (size_t)(row - NTP) * 1024;
        bf16_t* dst = (bf16_t*)(PWS + WS_XB) + (size_t)row * 1024;
        float ss = 0.f;
#pragma unroll
        for (int i = 0; i < 4; ++i) { const f32x4 v = *(const f32x4*)(src + i * 256 + lane * 4); ss += dot4(v, v); st_bf4(dst + i * 256 + lane * 4, v); }
#pragma unroll
        for (int o = 32; o >= 1; o >>= 1) ss += __shfl_xor(ss, o);
        if (lane < 16) ((float*)(PWS + WS_SSQ))[(size_t)row * 16 + lane] = (lane == 0) ? ss : 0.f;
    }
}

__device__ __forceinline__ f32x4 shift4(const bf16_t* cur, bool hp, const float* st, int col, const float* mu) {
    const f32x4 q = ld_bf4(cur + col);
    f32x4 pv;
    if (hp) pv = ld_bf4(cur - LDB + col); else if (st) pv = *(const f32x4*)(st + col); else pv = (f32x4){0.f, 0.f, 0.f, 0.f};
    const f32x4 m = *(const f32x4*)(mu + col);
    return q + m * (pv - q);
}

__device__ void phase_even_prep(const Params& p, const Ctx cx, int pair, LAS unsigned char* lds) {
    const int tid = cx.tid, wid = tid >> 6, lane = tid & 63, fr = lane & 15, fq = lane >> 4;
    const bf16_t* PB = (const bf16_t*)(PWS + WS_PROJB);
    float* Wdec = (float*)(PWS + WS_WDEC);
    bf16_t* Aa = (bf16_t*)(PWS + WS_AA);
    bf16_t* Ycat = (bf16_t*)(PWS + WS_YCAT);
    const float* mu_ = PIN(I_MU) + pair * 1664;
    const float* w0_ = PIN(I_W0) + pair * 512; const float* a0_ = PIN(I_A0) + pair * 512;
    const float* k_a_ = PIN(I_KA) + pair * 512; const float* r_k_ = PIN(I_RK) + pair * 512;
    constexpr int RS = 3344;
    constexpr int TB = 17 * RS;
    constexpr int NCH = 17 * 208;
    const int h = wid;
    bf16x8 wfr[4][2], afr[4][2];
    {
        const bf16_t* W2T = (const bf16_t*)(PWS + WS_W2T) + (size_t)pair * 512 * 64;
        const bf16_t* A2T = (const bf16_t*)(PWS + WS_A2T) + (size_t)pair * 512 * 64;
#pragma unroll
        for (int nt = 0; nt < 4; ++nt)
#pragma unroll
            for (int ks = 0; ks < 2; ++ks) {
                wfr[nt][ks] = *(const bf16x8*)(W2T + (size_t)(h * 64 + nt * 16 + fr) * 64 + ks * 32 + fq * 8);
                afr[nt][ks] = *(const bf16x8*)(A2T + (size_t)(h * 64 + nt * 16 + fr) * 64 + ks * 32 + fq * 8);
            }
    }
    constexpr int TBD = 56 * 1024;
    const int widu = __builtin_amdgcn_readfirstlane(tid >> 6);
#define PREP_DMA(tile_, b_, lane_) do { _Pragma("unroll") for (int i_ = 0; i_ < 7; ++i_) { const int k_ = widu * 7 + i_, q_ = k_ * 64 + (lane_); \
            int lr_ = q_ / 209, cc_ = q_ - lr_ * 209; if (lr_ > 16) { lr_ = 16; cc_ = 0; } if (cc_ > 207) cc_ = 0; \
            int gr_ = (tile_) * 16 - 1 + lr_; gr_ = gr_ < 0 ? 0 : gr_; \
            __builtin_amdgcn_global_load_lds((const unsigned*)(PB + (size_t)gr_ * LDB + cc_ * 8), (LAS unsigned*)(lds + (b_) * TBD + k_ * 1024), 16, 0, 0); } } while (0)
    int buf = 0;
    if ((int)cx.bid < NTOK / 16) PREP_DMA((int)cx.bid, 0, tid & 63);
    asm volatile("s_waitcnt vmcnt(0)" ::: "memory");
    __syncthreads();
    for (int tile = cx.bid; tile < NTOK / 16; tile += cx.nblk) {
        int zz; asm volatile("v_mov_b32 %0, 0" : "=v"(zz));
        const int tidv = tid + zz, fr = (tidv & 15), fq = (tidv >> 4) & 3;
        if (tile + (int)cx.nblk < NTOK / 16) PREP_DMA(tile + (int)cx.nblk, buf ^ 1, tidv & 63);
        {
            const int row = tile * 16 + fr;
            const bool samp = row >= NTP;
            int b, t; if (!samp) { b = row >> 11; t = row & 2047; } else { const int q = row - NTP; b = q >> 3; t = q & 7; }
            const bool hp = t > 0;
            const float* st = samp ? PIN(I_SSHIFT) + ((size_t)pair * 128 + b) * 1664 : nullptr;
            const float* mu = mu_ + zz; const float* w0 = w0_ + zz; const float* a0 = a0_ + zz; const float* k_a = k_a_ + zz; const float* r_k = r_k_ + zz;
            LAS const unsigned char* curL = lds + buf * TBD + (fr + 1) * RS;
            LAS const unsigned char* prvL = lds + buf * TBD + fr * RS;
            auto sh4 = [&](int col) -> f32x4 {
                const f32x4 q = cvt4(*(LAS const u32x2*)(curL + col * 2));
                f32x4 pv;
                if (hp) pv = cvt4(*(LAS const u32x2*)(prvL + col * 2)); else if (st) pv = *(const f32x4*)(st + col); else pv = (f32x4){0.f, 0.f, 0.f, 0.f};
                const f32x4 m = *(const f32x4*)(mu + col);
                return q + m * (pv - q);
            };
            bf16x8 Aw[2], Al[2];
#pragma unroll
            for (int ks = 0; ks < 2; ++ks) {
                const int cw = 1536 + ks * 32 + fq * 8, ca = 1600 + ks * 32 + fq * 8;
                const f32x4 w_lo = sh4(cw), w_hi = sh4(cw + 4), a_lo = sh4(ca), a_hi = sh4(ca + 4);
                u32x4 pw, pa;
                float th[8];
#pragma unroll
                for (int j = 0; j < 4; ++j) { th[j] = 2.0f * sigmoidf_(2.0f * w_lo[j]) - 1.0f; th[4 + j] = 2.0f * sigmoidf_(2.0f * w_hi[j]) - 1.0f; }
                pw.x = cvt_pk_bf16(th[0], th[1]); pw.y = cvt_pk_bf16(th[2], th[3]); pw.z = cvt_pk_bf16(th[4], th[5]); pw.w = cvt_pk_bf16(th[6], th[7]);
                pa.x = cvt_pk_bf16(a_lo[0], a_lo[1]); pa.y = cvt_pk_bf16(a_lo[2], a_lo[3]); pa.z = cvt_pk_bf16(a_hi[0], a_hi[1]); pa.w = cvt_pk_bf16(a_hi[2], a_hi[3]);
                Aw[ks] = __builtin_bit_cast(bf16x8, pw); Al[ks] = __builtin_bit_cast(bf16x8, pa);
            }
            float bon = 0.f;
#pragma unroll
            for (int nt = 0; nt < 4; ++nt) {
                f32x4 lw = (f32x4){0.f, 0.f, 0.f, 0.f}, la = (f32x4){0.f, 0.f, 0.f, 0.f};
#pragma unroll
                for (int ks = 0; ks < 2; ++ks) {
                    lw = __builtin_amdgcn_mfma_f32_16x16x32_bf16(wfr[nt][ks], Aw[ks], lw, 0, 0, 0);
                    la = __builtin_amdgcn_mfma_f32_16x16x32_bf16(afr[nt][ks], Al[ks], la, 0, 0, 0);
                }
                const int ch = h * 64 + nt * 16 + fq * 4;
                const f32x4 r4 = sh4(ch), k4 = sh4(512 + ch);
                const f32x4 w04 = *(const f32x4*)(w0 + ch), a04 = *(const f32x4*)(a0 + ch), ka4 = *(const f32x4*)(k_a + ch), rk4 = *(const f32x4*)(r_k + ch);
                f32x4 dec, av;
#pragma unroll
                for (int j = 0; j < 4; ++j) {
                    const float z_ = -(w04[j] + lw[j]);
                    const float wlog = -__logf(1.0f + __expf(z_)) - 0.5f;
                    dec[j] = __expf(-__expf(wlog));
                    av[j] = sigmoidf_(a04[j] + la[j]);
                    const float kp = k4[j] * (1.0f + (av[j] - 1.0f) * ka4[j]);
                    bon += r4[j] * kp * rk4[j];
                }
                *(f32x4*)(Wdec + (size_t)row * 512 + ch) = dec;
                st_bf4(Aa + (size_t)row * 512 + ch, av);
            }
            bon += __shfl_xor(bon, 16); bon += __shfl_xor(bon, 32);
#pragma unroll
            for (int nt = 0; nt < 4; ++nt) { const int ch = h * 64 + nt * 16 + fq * 4; st_bf4(Ycat + (size_t)row * 1024 + 512 + ch, sh4(1024 + ch) * bon); }
        }
        asm volatile("s_waitcnt vmcnt(0)" ::: "memory");
        __syncthreads();
        buf ^= 1;
    }
#undef PREP_DMA
    const int gtid = cx.bid * 512 + tid, gthreads = cx.nblk * 512;
    for (int e = gtid; e < 136 * 1664; e += gthreads) {
        const int sr = e / 1664, c = e % 1664;
        if (sr < 8) POUT[O_SHIFTP + ((size_t)pair * 8 + sr) * 1664 + c] = bf2f(PB[(size_t)(sr * 2048 + 2047) * LDB + c]);
        else { const int b = sr - 8; POUT[O_SHIFTS + ((size_t)pair * 128 + b) * 1664 + c] = bf2f(PB[(size_t)(NTP + b * 8 + 7) * LDB + c]); }
    }
}

typedef float f32x2 __attribute__((ext_vector_type(2)));
template <bool RED = true>
__device__ __forceinline__ void scan_step(f32x4& S, const f32x4 w, const f32x4 k, const f32x4 kk, const f32x4 nb, const f32x4 r, const float v, float& y) {
    const f32x2 S01 = {S[0], S[1]}, S23 = {S[2], S[3]};
    f32x2 pp = S01 * (f32x2){kk[0], kk[1]};
    pp = S23 * (f32x2){kk[2], kk[3]} + pp;
    float pd = pp[0] + pp[1];
    const f32x2 vv = {v, v};
    const f32x2 t01 = S01 * (f32x2){w[0], w[1]} + (f32x2){k[0], k[1]} * vv;
    const f32x2 t23 = S23 * (f32x2){w[2], w[3]} + (f32x2){k[2], k[3]} * vv;
    pd = allsum16(pd);
    const f32x2 pdv = {pd, pd};
    const f32x2 n01 = (f32x2){nb[0], nb[1]} * pdv + t01, n23 = (f32x2){nb[2], nb[3]} * pdv + t23;
    S = (f32x4){n01[0], n01[1], n23[0], n23[1]};
    f32x2 q = n01 * (f32x2){r[0], r[1]};
    q = n23 * (f32x2){r[2], r[3]} + q;
    y = RED ? allsum16(q[0] + q[1]) : (q[0] + q[1]);
}
__device__ __forceinline__ float reduce_scatter16(const float (&yp)[16], int cgi) {
    const bool b3 = cgi & 8, b2 = cgi & 4, b1 = cgi & 2, b0 = cgi & 1;
    float a[8], bq[4], c[2];
#pragma unroll
    for (int j = 0; j < 8; ++j) { const float keep = b3 ? yp[8 + j] : yp[j], send = b3 ? yp[j] : yp[8 + j]; a[j] = keep + dpp_f<0x128>(send); }
#pragma unroll
    for (int k = 0; k < 4; ++k) { const float keep = b2 ? a[4 + k] : a[k], send = b2 ? a[k] : a[4 + k]; bq[k] = keep + dpp_f<0x141>(send); }
#pragma unroll
    for (int m = 0; m < 2; ++m) { const float keep = b1 ? bq[2 + m] : bq[m], send = b1 ? bq[m] : bq[2 + m]; c[m] = keep + dpp_f<0x4E>(send); }
    const float keep = b0 ? c[1] : c[0], send = b0 ? c[0] : c[1];
    return keep + dpp_f<0xB1>(send);
}

__device__ void phase_scan(const Params& p, const Ctx cx, int pair, LAS unsigned char* lds) {
    const int tid = cx.tid, wid = tid >> 6, lane = tid & 63, rs = lane >> 4, cgi = lane & 15;
    const bf16_t* PB = (const bf16_t*)(PWS + WS_PROJB);
    const float* Wdec = (const float*)(PWS + WS_WDEC);
    const bf16_t* Aa = (const bf16_t*)(PWS + WS_AA);
    float* Y = (float*)(PWS + WS_Y);
    const float* mu = PIN(I_MU) + pair * 1664;
    const float* k_k = PIN(I_KK) + pair * 512; const float* k_a = PIN(I_KA) + pair * 512;
    {
        LAS float* vb = (LAS float*)lds + wid * 3072;
        for (int st = cx.bid * 8 + wid; st < 2048; st += cx.nblk * 8) {
            const int bh = st >> 1, half = st & 1, b = bh >> 3, h = bh & 7, ch = h * 64 + cgi * 4;
            const float* stp = PIN(I_SSHIFT) + ((size_t)pair * 128 + b) * 1664;
            const f32x4 kkc = *(const f32x4*)(k_k + ch), kac = *(const f32x4*)(k_a + ch);
            {
#pragma unroll
                for (int tt = 0; tt < 2; ++tt) {
                    const int t = rs + tt * 4;
                    const size_t row = NTP + b * 8 + t;
                    const bf16_t* cur = PB + row * LDB;
                    const f32x4 r = shift4(cur, t > 0, stp, ch, mu), k = shift4(cur, t > 0, stp, 512 + ch, mu), v = shift4(cur, t > 0, stp, 1024 + ch, mu);
                    const f32x4 a = ld_bf4(Aa + row * 512 + ch);
                    const f32x4 w = *(const f32x4*)(Wdec + row * 512 + ch);
                    const f32x4 kkv = k * kkc;
                    const float ss = allsum16(dot4(kkv, kkv));
                    const float inv = 1.0f / fmaxf(sqrtf(ss), 1e-12f);
                    const f32x4 kkn = kkv * inv;
                    LAS float* o = vb + t * 384 + cgi * 4;
                    *(LAS f32x4*)(o) = w; *(LAS f32x4*)(o + 64) = k * (1.0f + (a - 1.0f) * kac); *(LAS f32x4*)(o + 128) = kkn; *(LAS f32x4*)(o + 192) = -(kkn * a);
                    *(LAS f32x4*)(o + 256) = r; *(LAS f32x4*)(o + 320) = v;
                }
            }
            asm volatile("s_waitcnt lgkmcnt(0)" ::: "memory");
            __builtin_amdgcn_wave_barrier();
#pragma unroll 1
            for (int rq = 0; rq < 8; ++rq) {
                const int ri = half * 32 + rq * 4 + rs;
                const size_t so = ((((size_t)pair * 128 + b) * 8 + h) * 64 + ri) * 64 + cgi * 4;
                f32x4 S = *(const f32x4*)(PIN(I_SWKV) + so);
#pragma unroll
                for (int t = 0; t < 8; ++t) {
                    LAS const float* r0 = vb + t * 384 + cgi * 4;
                    float y; scan_step(S, *(LAS const f32x4*)(r0), *(LAS const f32x4*)(r0 + 64), *(LAS const f32x4*)(r0 + 128), *(LAS const f32x4*)(r0 + 192), *(LAS const f32x4*)(r0 + 256), vb[t * 384 + 320 + ri], y);
                    if (cgi == 0) Y[(size_t)(NTP + b * 8 + t) * 512 + h * 64 + ri] = y;
                }
                *(f32x4*)(POUT + O_WKVS + so) = S;
            }
            asm volatile("s_waitcnt lgkmcnt(0)" ::: "memory");
            __builtin_amdgcn_wave_barrier();
        }
    }
    __syncthreads();
    LAS float* rec = (LAS float*)lds;
    for (int pt = cx.bid; pt < 256; pt += cx.nblk) {
        const int xcd = pt & 7, slot = pt >> 3, bh = xcd * 8 + (slot >> 2), rg = slot & 3, b = bh >> 3, h = bh & 7;
        const int lt = tid - 256, ls = (lt >> 4) & 15, lcg = lt & 15, lch = h * 64 + lcg * 4;
        u32x2 qr = {0u, 0u}, qk = {0u, 0u}, qv = {0u, 0u}, pr = {0u, 0u}, pk = {0u, 0u}, pv = {0u, 0u}, qa = {0u, 0u};
        f32x4 qw = (f32x4){0.f, 0.f, 0.f, 0.f};
        f32x4 mur, muk, muv, kkc, kac;
        const int ri = rg * 16 + (wid & 3) * 4 + rs;
        f32x4 S = (f32x4){0.f, 0.f, 0.f, 0.f};
#define SCAN_ISSUE(c) do { const int t_ = (c) * 16 + ls; const size_t row_ = (size_t)b * 2048 + t_; const bf16_t* cur_ = PB + row_ * LDB; \
            qr = *(const u32x2*)(cur_ + lch); qk = *(const u32x2*)(cur_ + 512 + lch); qv = *(const u32x2*)(cur_ + 1024 + lch); \
            if (t_ > 0) { pr = *(const u32x2*)(cur_ - LDB + lch); pk = *(const u32x2*)(cur_ - LDB + 512 + lch); pv = *(const u32x2*)(cur_ - LDB + 1024 + lch); } \
            else { pr = (u32x2){0u, 0u}; pk = pr; pv = pr; } \
            qw = *(const f32x4*)(Wdec + row_ * 512 + lch); qa = *(const u32x2*)(Aa + row_ * 512 + lch); } while (0)
#define SCAN_PROCESS(buf) do { const f32x4 r0_ = cvt4(qr), k0_ = cvt4(qk), v0_ = cvt4(qv); \
            const f32x4 r_ = r0_ + mur * (cvt4(pr) - r0_), k_ = k0_ + muk * (cvt4(pk) - k0_), v_ = v0_ + muv * (cvt4(pv) - v0_), a_ = cvt4(qa); \
            const f32x4 kkv_ = k_ * kkc; const float ss_ = allsum16(dot4(kkv_, kkv_)); const float inv_ = __builtin_amdgcn_rsqf(fmaxf(ss_, 1e-24f)); \
            const f32x4 kkn_ = kkv_ * inv_; \
            LAS float* o_ = rec + (buf) * 6144 + ls * 384 + lcg * 4; \
            *(LAS f32x4*)(o_) = qw; *(LAS f32x4*)(o_ + 64) = k_ * (1.0f + (a_ - 1.0f) * kac); *(LAS f32x4*)(o_ + 128) = kkn_; *(LAS f32x4*)(o_ + 192) = -(kkn_ * a_); \
            *(LAS f32x4*)(o_ + 256) = r_; *(LAS f32x4*)(o_ + 320) = v_; } while (0)
        if (wid >= 4) {
            mur = *(const f32x4*)(mu + lch); muk = *(const f32x4*)(mu + 512 + lch); muv = *(const f32x4*)(mu + 1024 + lch);
            kkc = *(const f32x4*)(k_k + lch); kac = *(const f32x4*)(k_a + lch);
            SCAN_ISSUE(0); SCAN_PROCESS(0); SCAN_ISSUE(1);
        }
        __syncthreads();
        for (int c = 0; c < 128; ++c) {
            if (wid < 4) {
                LAS const float* rb = rec + (c & 1) * 6144 + cgi * 4;
                LAS const float* rv = rec + (c & 1) * 6144 + 320 + ri;
                float yp[16];
                f32x4 nw = *(LAS const f32x4*)(rb), nk = *(LAS const f32x4*)(rb + 64), nkk = *(LAS const f32x4*)(rb + 128), nb = *(LAS const f32x4*)(rb + 192), nr = *(LAS const f32x4*)(rb + 256);
                float nv = rv[0];
#pragma unroll
                for (int s = 0; s < 16; ++s) {
                    const f32x4 cw = nw, ck = nk, ckk = nkk, cb = nb, cr = nr; const float cv = nv;
                    if (s + 1 < 16) {
                        LAS const float* r1 = rb + (s + 1) * 384;
                        nw = *(LAS const f32x4*)(r1); nk = *(LAS const f32x4*)(r1 + 64); nkk = *(LAS const f32x4*)(r1 + 128); nb = *(LAS const f32x4*)(r1 + 192); nr = *(LAS const f32x4*)(r1 + 256);
                        nv = rv[(s + 1) * 384];
                    }
                    scan_step<false>(S, cw, ck, ckk, cb, cr, cv, yp[s]);
                }
                Y[((size_t)b * 2048 + c * 16 + cgi) * 512 + h * 64 + ri] = reduce_scatter16(yp, cgi);
            } else {
                if (c + 1 < 128) { SCAN_PROCESS((c + 1) & 1); if (c + 2 < 128) SCAN_ISSUE(c + 2); }
            }
            __syncthreads();
        }
        if (wid < 4) *(f32x4*)(POUT + O_WKVP + ((((size_t)pair * 8 + b) * 8 + h) * 64 + ri) * 64 + cgi * 4) = S;
#undef SCAN_ISSUE
#undef SCAN_PROCESS
    }
}

__device__ void phase_even_post(const Params& p, const Ctx cx, int pair) {
    const int gtid = cx.bid * 512 + cx.tid, gthreads = cx.nblk * 512;
    const bf16_t* PA = (const bf16_t*)(PWS + WS_R1);
    bf16_t* Ycat = (bf16_t*)(PWS + WS_YCAT);
    const float* Y = (const float*)(PWS + WS_Y);
    constexpr int NIT = NTOK * 128, UB = 4;
    const float* gn_g = PIN(I_GNG) + pair * 512; const float* gn_b = PIN(I_GNB) + pair * 512;
    for (int e0 = gtid; e0 < NIT; e0 += gthreads * UB) {
        f32x4 y[UB], bv[UB], bz[UB]; bool ok[UB];
#pragma unroll
        for (int u = 0; u < UB; ++u) {
            const int e = e0 + u * gthreads; ok[u] = e < NIT;
            const int ee = ok[u] ? e : e0; const int row = ee >> 7, ch = (ee & 127) * 4;
            y[u] = *(const f32x4*)(Y + (size_t)row * 512 + ch);
            bv[u] = ld_bf4(Ycat + (size_t)row * 1024 + 512 + ch);
            bz[u] = ld_bf4(PA + (size_t)row * LDA + 2048 + ch);
        }
#pragma unroll
        for (int u = 0; u < UB; ++u) {
            const int e = e0 + u * gthreads;
            const int ee = ok[u] ? e : e0; const int row = ee >> 7, ch = (ee & 127) * 4;
            const float mean = allsum16(y[u][0] + y[u][1] + y[u][2] + y[u][3]) * (1.0f / 64.0f);
            const f32x4 d = y[u] - mean;
            const float var = allsum16(dot4(d, d)) * (1.0f / 64.0f);
            const float rstd = rsqrtf(var + 64e-5f);
            const f32x4 g = *(const f32x4*)(gn_g + ch), bb = *(const f32x4*)(gn_b + ch);
            f32x4 o;
#pragma unroll
            for (int j = 0; j < 4; ++j) o[j] = (d[j] * rstd * g[j] + bb[j] + bv[u][j]) * siluf_(bz[u][j]);
            if (ok[u]) st_bf4(Ycat + (size_t)row * 1024 + 512 + ch, o);
        }
    }
    const float* cw = PIN(I_CONVW) + pair * 3 * 512;
    constexpr int NRUN = (NTOK / 8) * 128;
    for (int e = gtid; e < NRUN; e += gthreads) {
        const int run = e >> 7, ch = (e & 127) * 4, row0 = run * 8;
        const bool samp = row0 >= NTP;
        int b, t0, T; if (!samp) { b = row0 >> 11; t0 = row0 & 2047; T = 2048; } else { b = (row0 - NTP) >> 3; t0 = 0; T = 8; }
        const bf16_t* base = PA + (size_t)row0 * LDA + ch;
        u32x2 rh[10], rc[10], rb[8], rz[8];
#pragma unroll
        for (int k = 0; k < 10; ++k) {
            const bool have = (k >= 2) || (t0 > 0);
            const bf16_t* pr = have ? base + (ptrdiff_t)(k - 2) * LDA : base;
            rh[k] = *(const u32x2*)(pr); rc[k] = *(const u32x2*)(pr + 1024);
        }
#pragma unroll
        for (int k = 0; k < 8; ++k) { rb[k] = *(const u32x2*)(base + (size_t)k * LDA + 512); rz[k] = *(const u32x2*)(base + (size_t)k * LDA + 1536); }
        const f32x4 k0 = *(const f32x4*)(cw + ch), k1 = *(const f32x4*)(cw + 512 + ch), k2 = *(const f32x4*)(cw + 1024 + ch);
        f32x4 um2, um1;
        if (t0 > 0) { um2 = cvt4(rc[0]) * cvt4(rh[0]); um1 = cvt4(rc[1]) * cvt4(rh[1]); }
        else if (samp) { const float* hist = PIN(I_SCONV) + ((size_t)pair * 128 + b) * 2 * 512 + ch; um2 = *(const f32x4*)(hist); um1 = *(const f32x4*)(hist + 512); }
        else { um2 = (f32x4){0.f, 0.f, 0.f, 0.f}; um1 = um2; }
#pragma unroll
        for (int k = 0; k < 8; ++k) {
            const f32x4 u0 = cvt4(rc[k + 2]) * cvt4(rh[k + 2]);
            const f32x4 conv = k0 * um2 + k1 * um1 + k2 * u0;
            const f32x4 ab = cvt4(rb[k]), az = cvt4(rz[k]);
            f32x4 o;
#pragma unroll
            for (int j = 0; j < 4; ++j) o[j] = ab[j] * conv[j] * siluf_(az[j]);
            const int row = row0 + k, t = t0 + k;
            st_bf4(Ycat + (size_t)row * 1024 + ch, o);
            if (t >= T - 2) {
                float* dst = samp ? POUT + O_CONVS + (((size_t)pair * 128 + b) * 2 + (t - (T - 2))) * 512 + ch : POUT + O_CONVP + (((size_t)pair * 8 + b) * 2 + (t - (T - 2))) * 512 + ch;
                *(f32x4*)dst = u0;
            }
            um2 = um1; um1 = u0;
        }
    }
}

__device__ void phase_odd_mixer(const Params& p, const Ctx cx, int pair, LAS unsigned char* lds) {
    const int tid = cx.tid, wid = tid >> 6, lane = tid & 63, fr = lane & 15, fq = lane >> 4;
    const bf16_t* PO = (const bf16_t*)(PWS + WS_R1);
    bf16_t* Ycat = (bf16_t*)(PWS + WS_YCAT);
    LAS bf16_t* LA = (LAS bf16_t*)lds;
    LAS bf16_t* LB = (LAS bf16_t*)(lds + 128 * 136 * 2);
    LAS float* stat = (LAS float*)(lds + 2 * 128 * 136 * 2);
    LAS float* LE = (LAS float*)(lds + 128 * 136 * 2);
    LAS bf16_t* LW = (LAS bf16_t*)(lds + 128 * 136 * 2 + 143 * 128 * 4);
    for (int tile = cx.bid; tile < 136; tile += cx.nblk) {
        const int r0 = tile * 128;
        const bool samp = r0 >= NTP;
        const int tl_ = tid >> 2, q_ = tid & 3;
        {
            const bf16_t* vr = PO + (size_t)(r0 + tl_) * LDA + 1536 + q_ * 128;
            float s_ = 0.f, ss = 0.f;
#pragma unroll
            for (int i = 0; i < 16; ++i) { const u32x4 raw = *(const u32x4*)(vr + i * 8); const f32x4 v0 = cvt4((u32x2){raw.x, raw.y}), v1 = cvt4((u32x2){raw.z, raw.w});
                s_ += (v0[0] + v0[1]) + (v0[2] + v0[3]) + (v1[0] + v1[1]) + (v1[2] + v1[3]); ss += dot4(v0, v0) + dot4(v1, v1); }
            s_ = allsum4(s_); ss = allsum4(ss);
            const float mean = s_ * (1.0f / 512.0f);
            const float var = fmaxf(ss * (1.0f / 512.0f) - mean * mean, 0.f);
            if (q_ == 0) { stat[tl_ * 2] = mean; stat[tl_ * 2 + 1] = rsqrtf(var + 1e-5f); }
        }
        u32x2 rv[8]; u32x4 rw[4];
#define MIX_LOAD_G(gg) do { const bf16_t* vr_ = PO + (size_t)(r0 + tl_) * LDA + 1536 + (gg) * 128 + q_ * 32; \
            _Pragma("unroll") for (int i = 0; i < 8; ++i) rv[i] = *(const u32x2*)(vr_ + i * 4); \
            if (!samp) { const bf16_t* Ws_ = (const bf16_t*)(PWS + WS_SPW) + ((size_t)pair * 4 + (gg)) * 128 * 128; \
                _Pragma("unroll") for (int i = 0; i < 4; ++i) { const int e = tid + i * 512; rw[i] = *(const u32x4*)(Ws_ + (e >> 4) * 128 + (e & 15) * 8); } } } while (0)
        MIX_LOAD_G(0);
        __syncthreads();
#pragma unroll 1
        for (int g = 0; g < 4; ++g) {
            u32x2 ur[8], dzr[8];
#pragma unroll
            for (int nt = 0; nt < 8; ++nt) { const size_t o_ = (size_t)(r0 + wid * 16 + fr) * LDA + g * 128 + nt * 16 + fq * 4; ur[nt] = *(const u32x2*)(PO + o_ + 1024); dzr[nt] = *(const u32x2*)(PO + o_ + 2048); }
            {
                const int row = r0 + tl_;
                const float mean = stat[tl_ * 2], rstd = stat[tl_ * 2 + 1];
                const float* lg = PIN(I_LNG) + pair * 512 + g * 128 + q_ * 32; const float* lb = PIN(I_LNB) + pair * 512 + g * 128 + q_ * 32;
#pragma unroll
                for (int i = 0; i < 8; ++i) {
                    const f32x4 v = cvt4(rv[i]);
                    const f32x4 vn = (v - mean) * rstd * *(const f32x4*)(lg + i * 4) + *(const f32x4*)(lb + i * 4);
                    if (samp) *(f32x4*)(POUT + O_CHUNKV + ((size_t)pair * 1024 + (row - NTP)) * 512 + g * 128 + q_ * 32 + i * 4) = vn;
#pragma unroll
                    for (int j = 0; j < 4; ++j) LB[(q_ * 32 + i * 4 + j) * 136 + tl_] = (bf16_t)(cvt_pk_bf16(vn[j], 0.f) & 0xffffu);
                }
            }
            if (!samp) {
#pragma unroll
                for (int i = 0; i < 4; ++i) { const int e = tid + i * 512; *(LAS u32x4*)(LA + (e >> 4) * 136 + (e & 15) * 8) = rw[i]; }
            } else {
                const float* Wsrc = PIN(I_SPW) + ((size_t)pair * 4 + g) * 128 * 128;
                for (int e = tid; e < 128 * 128; e += 512) { const int t = e >> 7, s2 = e & 127;
                    const float v = ((t >> 3) == (s2 >> 3) && (s2 & 7) <= (t & 7)) ? Wsrc[(t & 7) * 128 + (s2 & 7)] : 0.f;
                    LA[t * 136 + s2] = (bf16_t)(cvt_pk_bf16(v, 0.f) & 0xffffu); }
            }
            if (g + 1 < 4) MIX_LOAD_G(g + 1);
            __syncthreads();
            {
                const int tl = wid * 16 + fr, row = r0 + tl;
                const float bias = PIN(I_SPB)[((size_t)pair * 4 + g) * 128 + (samp ? (tl & 7) : tl)];
                bf16x8 wf[4];
#pragma unroll
                for (int ks = 0; ks < 4; ++ks) wf[ks] = *(const LAS bf16x8*)(LA + tl * 136 + ks * 32 + fq * 8);
#pragma unroll
                for (int nt = 0; nt < 8; ++nt) {
                    f32x4 acc = (f32x4){0.f, 0.f, 0.f, 0.f};
#pragma unroll
                    for (int ks = 0; ks < 4; ++ks) {
                        if (ks * 32 <= wid * 16 + 15) {
                            const bf16x8 vf = *(const LAS bf16x8*)(LB + (nt * 16 + fr) * 136 + ks * 32 + fq * 8);
                            acc = __builtin_amdgcn_mfma_f32_16x16x32_bf16(vf, wf[ks], acc, 0, 0, 0);
                        }
                    }
                    const int c = g * 128 + nt * 16 + fq * 4;
                    const f32x4 u = cvt4(ur[nt]), dz = cvt4(dzr[nt]);
                    f32x4 o;
#pragma unroll
                    for (int j = 0; j < 4; ++j) o[j] = u[j] * (acc[j] + bias) * siluf_(dz[j]);
                    st_bf4(Ycat + (size_t)row * 1024 + 512 + c, o);
                }
            }
            __syncthreads();
        }
#undef MIX_LOAD_G
    }
    {
        int ci, cstride;
        if (cx.nblk == 256) { if (cx.bid < 136) { ci = cx.bid; cstride = 1 << 20; } else { ci = cx.bid; cstride = 120; } }
        else { ci = cx.bid; cstride = cx.nblk; }
        u32x4 pw[4]; u32x2 pe[9];
#define MIX_LOAD_C(cc) do { const int tile_ = (cc) >> 2, g_ = (cc) & 3, r0_ = tile_ * 128; \
            const bf16_t* Bw_ = (const bf16_t*)(PWS + WS_POOLWT) + ((size_t)pair * 4 + g_) * 128 * 128; \
            _Pragma("unroll") for (int i = 0; i < 4; ++i) { const int e = tid + i * 512; pw[i] = *(const u32x4*)(Bw_ + (e >> 4) * 128 + (e & 15) * 8); } \
            if (r0_ < NTP) { const int t0_ = r0_ & 2047; \
                _Pragma("unroll") for (int i = 0; i < 9; ++i) { const int e = tid + i * 512, er = e >> 5, c = (e & 31) * 4; pe[i] = (u32x2){0u, 0u}; \
                    if (e < 143 * 32 && t0_ + er - 15 >= 0) pe[i] = *(const u32x2*)(PO + (size_t)(r0_ + er - 15) * LDA + g_ * 128 + c); } } } while (0)
        if (ci < 544) MIX_LOAD_C(ci);
        for (; ci < 544; ci += cstride) {
            const int tile = ci >> 2, g = ci & 3, r0 = tile * 128;
            const bool samp = r0 >= NTP;
            const int w = 2 << g;
            const int row = r0 + wid * 16 + fr;
            u32x2 czr[8]; f32x4 psr[8];
#pragma unroll
            for (int nt = 0; nt < 8; ++nt) { const int d = g * 128 + nt * 16 + fq * 4; czr[nt] = *(const u32x2*)(PO + (size_t)row * LDA + 512 + d); psr[nt] = *(const f32x4*)(PIN(I_PSCALE) + pair * 512 + d); }
#pragma unroll
            for (int i = 0; i < 4; ++i) { const int e = tid + i * 512; *(LAS u32x4*)(LW + (e >> 4) * 136 + (e & 15) * 8) = pw[i]; }
            if (!samp) {
                const int t0 = r0 & 2047;
#pragma unroll
                for (int i = 0; i < 9; ++i) { const int e = tid + i * 512, er = e >> 5, c = (e & 31) * 4; if (e < 143 * 32) *(LAS f32x4*)(LE + er * 128 + c) = cvt4(pe[i]); }
                __syncthreads();
                {
                    const int c = (tid & 31) * 4, tl0 = (tid >> 5) * 8;
                    f32x4 sum = (f32x4){0.f, 0.f, 0.f, 0.f};
#pragma unroll 4
                    for (int d = 0; d < w; ++d) sum += *(LAS const f32x4*)(LE + (tl0 + 15 - d) * 128 + c);
#pragma unroll
                    for (int k = 0; k < 8; ++k) {
                        const int tl = tl0 + k;
                        const f32x4 pt = *(LAS const f32x4*)(LE + (tl + 15) * 128 + c);
                        if (k > 0) sum += pt - *(LAS const f32x4*)(LE + (tl + 15 - w) * 128 + c);
                        const float cnt = fminf((float)w, (float)(t0 + tl + 1));
                        const f32x4 pooled = sum * (1.0f / cnt) - pt;
                        u32x2 u; u.x = cvt_pk_bf16(pooled[0], pooled[1]); u.y = cvt_pk_bf16(pooled[2], pooled[3]);
                        *(LAS u32x2*)(LA + tl * 136 + c) = u;
                    }
                }
            } else {
                for (int e = tid; e < 128 * 32; e += 512) {
                    const int tl = e >> 5, c = (e & 31) * 4, rowe = r0 + tl;
                    const int q = rowe - NTP, b = q >> 3, t = q & 7;
                    const bf16_t* cur = PO + (size_t)rowe * LDA + g * 128 + c;
                    const f32x4 pt = ld_bf4(cur);
                    f32x4 sum = pt;
                    for (int d = 1; d < w; ++d) {
                        const int tt = t - d;
                        if (tt >= 0) sum += ld_bf4(cur - (size_t)d * LDA);
                        else sum += *(const f32x4*)(PIN(I_SPOOL) + (((size_t)pair * 128 + b) * 15 + (15 + tt)) * 512 + g * 128 + c);
                    }
                    const f32x4 pooled = sum * (1.0f / (float)w) - pt;
                    u32x2 u; u.x = cvt_pk_bf16(pooled[0], pooled[1]); u.y = cvt_pk_bf16(pooled[2], pooled[3]);
                    *(LAS u32x2*)(LA + tl * 136 + c) = u;
                }
            }
            if (ci + cstride < 544) MIX_LOAD_C(ci + cstride);
            __syncthreads();
            bf16x8 af[4];
#pragma unroll
            for (int ks = 0; ks < 4; ++ks) af[ks] = *(const LAS bf16x8*)(LA + (wid * 16 + fr) * 136 + ks * 32 + fq * 8);
#pragma unroll
            for (int nt = 0; nt < 8; ++nt) {
                f32x4 acc = (f32x4){0.f, 0.f, 0.f, 0.f};
#pragma unroll
                for (int ks = 0; ks < 4; ++ks) {
                    const bf16x8 bf = *(const LAS bf16x8*)(LW + (nt * 16 + fr) * 136 + ks * 32 + fq * 8);
                    acc = __builtin_amdgcn_mfma_f32_16x16x32_bf16(bf, af[ks], acc, 0, 0, 0);
                }
                const int d = g * 128 + nt * 16 + fq * 4;
                const f32x4 cz = cvt4(czr[nt]), ps = psr[nt];
                f32x4 o;
#pragma unroll
                for (int j = 0; j < 4; ++j) o[j] = acc[j] * ps[j] * siluf_(cz[j]);
                st_bf4(Ycat + (size_t)row * 1024 + d, o);
            }
            __syncthreads();
        }
#undef MIX_LOAD_C
    }
    const int gtid = cx.bid * 512 + tid, gthreads = cx.nblk * 512;
    for (int e = gtid; e < 136 * 15 * 512; e += gthreads) {
        const int c = e & 511, q = e >> 9, sr = q / 15, k = q % 15;
        if (sr < 8) POUT[O_POOLP + (((size_t)pair * 8 + sr) * 15 + k) * 512 + c] = bf2f(PO[(size_t)(sr * 2048 + 2033 + k) * LDA + c]);
        else { const int b = sr - 8;
            POUT[O_POOLS + (((size_t)pair * 128 + b) * 15 + k) * 512 + c] = (k < 7) ? PIN(I_SPOOL)[(((size_t)pair * 128 + b) * 15 + 8 + k) * 512 + c] : bf2f(PO[(size_t)(NTP + b * 8 + (k - 7)) * LDA + c]); }
    }
}

__device__ void phase_final(const Params& p, const Ctx cx) {
    const int gtid = cx.bid * 512 + cx.tid, gthreads = cx.nblk * 512;
    const float* ssq = (const float*)(PWS + WS_SSQ) + (size_t)4 * NTOK * 16;
    const bf16_t* Xb = (const bf16_t*)(PWS + WS_XB);
    constexpr int NIT = NTOK * 256, UB = 4;
    for (int e0 = gtid; e0 < NIT; e0 += gthreads * UB) {
        f32x4 x[UB]; float sq[UB]; bool ok[UB];
#pragma unroll
        for (int u = 0; u < UB; ++u) { const int e = e0 + u * gthreads; ok[u] = e < NIT; const int ee = ok[u] ? e : e0; const int row = ee >> 8, c = (ee & 255) * 4;
            x[u] = ld_bf4(Xb + (size_t)row * 1024 + c); sq[u] = ssq_sum(ssq + (size_t)row * 16); }
#pragma unroll
        for (int u = 0; u < UB; ++u) { const int e = e0 + u * gthreads; const int ee = ok[u] ? e : e0; const int row = ee >> 8, c = (ee & 255) * 4;
            const float rstd = rsqrtf(sq[u] * (1.0f / 1024.0f) + 1e-6f);
            if (ok[u]) *(f32x4*)(POUT + (size_t)row * 1024 + c) = x[u] * rstd * *(const f32x4*)(PIN(I_FNORMW) + c); }
    }
}

#define XB_TMO      128
#define XB_XCNT(j)  (256  + 64 * (j))
#define XB_XSUB(j)  (1280 + 64 * (j))
#define XB_XGEN(j)  (2304 + 64 * (j))
#define XB_TOP      3328
#define XB_TOPGEN   3392
#define XCD_BAR_WORDS 3456
#define XB_SPIN_CAP (1u << 18)
__device__ __forceinline__ unsigned xb_ld(unsigned* p)              { return __hip_atomic_load(p, __ATOMIC_RELAXED, __HIP_MEMORY_SCOPE_AGENT); }
__device__ __forceinline__ unsigned xb_add(unsigned* p, unsigned v) { return __hip_atomic_fetch_add(p, v, __ATOMIC_RELAXED, __HIP_MEMORY_SCOPE_AGENT); }
__device__ __forceinline__ unsigned xb_xcc_id() { return (unsigned)__builtin_amdgcn_s_getreg((3 << 11) | 20) & 0xFu; }
#define XB_SPIN(cond, bar) do { unsigned _sp = 0; while (cond) { __builtin_amdgcn_s_sleep(1); \
    if ((++_sp & 255u) == 0u) { if (xb_ld(&(bar)[XB_TMO])) break; if (_sp > XB_SPIN_CAP) { atomicAdd(&(bar)[XB_TMO], 1u); break; } } } } while (0)
struct XcdBarrier { unsigned* bar; unsigned x; volatile LAS unsigned* st; };
__device__ __forceinline__ XcdBarrier xcd_barrier_post(unsigned* bar, volatile LAS unsigned* st) {
    XcdBarrier b; b.bar = bar; b.x = xb_xcc_id(); b.st = st;
    if (threadIdx.x == 0) (void)xb_add(&bar[XB_XCNT(b.x)], 1u);
    return b;
}
__device__ __forceinline__ void xcd_barrier_complete(unsigned* bar, unsigned x, unsigned& nloc, unsigned& nx) {
    const unsigned G = gridDim.x * gridDim.y * gridDim.z;
    unsigned sum, cnt, mine, sp = 0u;
    for (;;) {
        sum = 0u; cnt = 0u; mine = 0u;
#pragma unroll
        for (unsigned j = 0; j < 16; ++j) { const unsigned c = xb_ld(&bar[XB_XCNT(j)]); sum += c; cnt += (c > 0u) ? 1u : 0u; mine = (j == x) ? c : mine; }
        if (sum == G) break;
        __builtin_amdgcn_s_sleep(1);
        if ((++sp & 255u) == 0u) { if (xb_ld(&bar[XB_TMO])) break; if (sp > XB_SPIN_CAP) { atomicAdd(&bar[XB_TMO], 1u); break; } }
    }
    nloc = mine > 0u ? mine : 1u; nx = cnt > 0u ? cnt : 1u;
}
__device__ __forceinline__ void xcd_barrier(const XcdBarrier& b) {
    asm volatile("s_waitcnt vmcnt(0)" ::: "memory");
    __syncthreads();
    if (threadIdx.x == 0) {
        unsigned* bar = b.bar;
        __builtin_amdgcn_s_waitcnt(0);
        unsigned nloc = b.st[0], nx = b.st[1];
        if (nloc == 0u) { xcd_barrier_complete(bar, b.x, nloc, nx); b.st[0] = nloc; b.st[1] = nx; }
        const unsigned old = xb_add(&bar[XB_XSUB(b.x)], 1u);
        const unsigned gen = old / nloc;
        if (old + 1u == (gen + 1u) * nloc) {
            __builtin_amdgcn_fence(__ATOMIC_RELEASE, "agent");
            asm volatile("s_waitcnt vmcnt(0)" ::: "memory");
            const unsigned og = xb_add(&bar[XB_TOP], 1u);
            const unsigned tg = og / nx;
            if (og + 1u == (tg + 1u) * nx) xb_add(&bar[XB_TOPGEN], 1u);
            else XB_SPIN(xb_ld(&bar[XB_TOPGEN]) == tg, bar);
            __builtin_amdgcn_fence(__ATOMIC_ACQUIRE, "agent");
            xb_add(&bar[XB_XGEN(b.x)], 1u);
            asm volatile("s_waitcnt vmcnt(0)" ::: "memory");
        } else {
            XB_SPIN(xb_ld(&bar[XB_XGEN(b.x)]) == gen, bar);
            __builtin_amdgcn_fence(__ATOMIC_ACQUIRE, "agent");
            asm volatile("s_waitcnt vmcnt(0)" ::: "memory");
        }
    }
    __syncthreads();
}

__device__ void run_gemm_proj(const Params& p, const Ctx cx, LAS unsigned char* lds, const bf16_t* Bt, int N, bf16_t* O, int ldc, int layer) {
    pg8::Gemm g{(const bf16_t*)(PWS + WS_XB), Bt, NTOK, N, 1024};
    pg8::StaticOrder S; S.init(NTOK, N, (int)cx.nblk, (int)cx.bid);
    const float* ssq = (const float*)(PWS + WS_SSQ) + (size_t)layer * NTOK * 16;
    LAS float* rl = (LAS float*)(lds + 131072);
    int pm0 = -1, pm1 = -1, pm2 = -1, pm3 = -1, np = 0;
    for (int i = 0; i < 64; ++i) {
        pg8::Unit u; if (!S.next(i, u)) break;
        if (u.pm == pm0 || u.pm == pm1 || u.pm == pm2 || u.pm == pm3) continue;
        if (np == 0) pm0 = u.pm; else if (np == 1) pm1 = u.pm; else if (np == 2) pm2 = u.pm; else pm3 = u.pm;
        ++np;
    }
    for (int r = cx.tid; r < np * 256; r += 512) {
        const int i = r >> 8, pm = i == 0 ? pm0 : (i == 1 ? pm1 : (i == 2 ? pm2 : pm3));
        rl[r] = rsqrtf(ssq_sum(ssq + (size_t)(pm * 256 + (r & 255)) * 16) * (1.0f / 1024.0f) + 1e-6f);
    }
    __syncthreads();
    EpiProj E{O, ldc, rl, pm0, pm1, pm2, pm3};
    pg8::gemm_phase<EpiProj>(cx, lds, g, S, E);
}
__device__ void run_gemm_res(const Params& p, const Ctx cx, LAS unsigned char* lds, const bf16_t* Bt, int layer) {
    const bf16_t* A = (const bf16_t*)(PWS + WS_YCAT);
    bf16_t* Xb = (bf16_t*)(PWS + WS_XB);
    float* ssqn = (float*)(PWS + WS_SSQ) + (size_t)(layer + 1) * NTOK * 16;
    pg8::Gemm g{A, Bt, NTOK, 1024, 1024};
    pg8::StaticOrder S; S.init(NTOK, 1024, (int)cx.nblk, (int)cx.bid);
    EpiRes E{layer == 0 ? PIN(I_XP) : nullptr, PIN(I_XS), Xb, ssqn};
    pg8::gemm_phase<EpiRes>(cx, lds, g, S, E);
}

constexpr int N_PHASES = 20;
#ifndef PHMASK
#define PHMASK 0xffff
#endif
#define PHON(n) ((PHMASK >> ((n) % 16)) & 1)
__global__ void __launch_bounds__(512, 2) fwd_kernel(Params p) {
    extern __shared__ __attribute__((aligned(16))) unsigned char lds_raw[];
    LAS unsigned char* lds = (LAS unsigned char*)lds_raw;
    volatile LAS unsigned* bar_st = (volatile LAS unsigned*)(lds + LDS_MAIN);
    if (threadIdx.x < 4) bar_st[threadIdx.x] = 0u;
    __syncthreads();
    const XcdBarrier gbar = xcd_barrier_post((unsigned*)((unsigned char*)p.ptr[30] + WS_BAR), bar_st);
    if (p.ph_hi < 0) cg::this_grid().sync();
#define GRID_SYNC() xcd_barrier(gbar)
#ifdef SYNCPROBE
    for (int i = 0; i < SYNCPROBE; ++i) GRID_SYNC();
#endif
#ifdef REPMASK
    for (int pc = p.ph_lo * 2; pc < p.ph_hi * 2; ++pc) {
        const int ph = pc >> 1;
        { const int s_ = (ph == 0) ? 9 : (ph == N_PHASES - 1) ? 31 : (ph - 1) % 9; if ((pc & 1) && !((REPMASK >> s_) & 1)) continue; }
        if (pc > p.ph_lo * 2) GRID_SYNC();
#else
    for (int ph = p.ph_lo; ph < p.ph_hi; ++ph) {
        if (ph > p.ph_lo) GRID_SYNC();
#endif
        Ctx cx; cx.tid = threadIdx.x; cx.bid = blockIdx.x; cx.nblk = gridDim.x;
        asm volatile("s_mov_b32 %0, 0" : "=s"(cx.z));
        asm volatile("" : "+v"(cx.tid)); asm volatile("" : "+s"(cx.bid)); asm volatile("" : "+s"(cx.nblk));
        const int pair = (ph - 1) / 9, s = (ph == 0) ? 100 : (ph == N_PHASES - 1 ? 101 : (ph - 1) % 9);
        if (s == 0 || s == 3 || s == 6) {
#if PHON(0)
            const bf16_t* WinE = (const bf16_t*)(PWS + WS_WINE) + (size_t)pair * 4352 * 1024;
            const bf16_t* Bt = s == 0 ? WinE + (size_t)2560 * 1024 : (s == 3 ? WinE : (const bf16_t*)(PWS + WS_WINO) + (size_t)pair * 2560 * 1024);
            const int N = s == 0 ? 1792 : 2560;
            run_gemm_proj(p, cx, lds, Bt, N, (bf16_t*)(PWS + WS_R1), N, 2 * pair + (s == 6 ? 1 : 0));
#endif
        } else if (s == 5 || s == 8) {
#if PHON(5)
            const bf16_t* Bt = (const bf16_t*)(PWS + (s == 5 ? WS_WOUTE : WS_WOUTO)) + (size_t)pair * 1024 * 1024;
            run_gemm_res(p, cx, lds, Bt, 2 * pair + (s == 8 ? 1 : 0));
#endif
        } else if (s == 1) {
#if PHON(1)
            phase_even_prep(p, cx, pair, lds);
#endif
        } else if (s == 2) {
#if PHON(2)
            phase_scan(p, cx, pair, lds);
#endif
        } else if (s == 4) {
#if PHON(4)
            phase_even_post(p, cx, pair);
#endif
        } else if (s == 7) {
#if PHON(7)
            phase_odd_mixer(p, cx, pair, lds);
#endif
        } else if (s == 100) {
#if PHON(10)
            phase_prepass(p, cx, lds);
#endif
        } else {
#if PHON(11)
            phase_final(p, cx);
#endif
        }
    }
}

extern "C" void kernel_launch(void* const* d_in, const int* in_sizes, int n_in, void* d_out, int out_size, void* d_ws, size_t ws_size, hipStream_t stream) {
    static int grid = 0;
    if (grid == 0) {
        if (n_in != 29 || ws_size < WS_END) { fprintf(stderr, "kernel_launch: unexpected n_in %d / ws_size %zu (need %zu)\n", n_in, ws_size, (size_t)WS_END); grid = -1; return; }
        int dev = 0, cus = 0, per_cu = 0;
        hipGetDevice(&dev);
        hipDeviceGetAttribute(&cus, hipDeviceAttributeMultiprocessorCount, dev);
        if (hipFuncSetAttribute((const void*)fwd_kernel, hipFuncAttributeMaxDynamicSharedMemorySize, LDS_BYTES) != hipSuccess) { fprintf(stderr, "kernel_launch: hipFuncSetAttribute failed\n"); grid = -1; return; }
        if (hipOccupancyMaxActiveBlocksPerMultiprocessor(&per_cu, (const void*)fwd_kernel, 512, LDS_BYTES) != hipSuccess || per_cu < 1) { fprintf(stderr, "kernel_launch: occupancy query gave %d\n", per_cu); per_cu = 1; }
        (void)hipGetLastError();
        grid = cus * per_cu;
        if (grid > 256) grid = 256;
    }
    if (grid < 0) return;
    Params p{};
    for (int i = 0; i < 29; ++i) p.ptr[i] = d_in[i];
    p.ptr[29] = d_out; p.ptr[30] = d_ws; p.ptr[31] = nullptr;
    (void)hipMemsetAsync((unsigned char*)d_ws + WS_BAR, 0, 16384, stream);
#if ONE_LAUNCH
    p.ph_lo = 0; p.ph_hi = N_PHASES;
    void* args[] = {&p};
    hipError_t e = hipLaunchCooperativeKernel((const void*)fwd_kernel, dim3(grid), dim3(512), args, LDS_BYTES, stream);
    if (e != hipSuccess) fprintf(stderr, "cooperative launch failed: %s (grid %d)\n", hipGetErrorString(e), grid);
#else
    for (int ph = 0; ph < N_PHASES; ++ph) {
        p.ph_lo = ph; p.ph_hi = ph + 1;
        hipLaunchKernelGGL(fwd_kernel, dim3(grid), dim3(512), LDS_BYTES, stream, p);
    }
#endif
}
```

```cpp
#include <hip/hip_runtime.h>
#include <hip/hip_cooperative_groups.h>
#include <cstdio>
namespace cg = cooperative_groups;

#ifndef ONE_LAUNCH
#define ONE_LAUNCH 1
#endif

#define LAS __attribute__((address_space(3)))
typedef unsigned short bf16_t;
typedef short bf16x8 __attribute__((ext_vector_type(8)));
typedef float f32x4 __attribute__((ext_vector_type(4)));
typedef unsigned u32x4 __attribute__((ext_vector_type(4)));
typedef unsigned u32x2 __attribute__((ext_vector_type(2)));

constexpr int NTOK = 17408, NTP = 16384;
constexpr int LDB = 1792;
constexpr int LDA = 2560;
constexpr size_t O_CONVP = 17825792, O_CONVS = 17842176, O_SHIFTP = 18104320, O_SHIFTS = 18130944, O_WKVP = 18556928, O_WKVS = 19081216,
                 O_POOLP = 27469824, O_POOLS = 27592704, O_CHUNKV = 29558784;
constexpr size_t WS_WINE = 0;
constexpr size_t WS_WOUTE = WS_WINE + 2ull * 4352 * 1024 * 2;
constexpr size_t WS_WINO = WS_WOUTE + 2ull * 1024 * 1024 * 2;
constexpr size_t WS_WOUTO = WS_WINO + 2ull * 2560 * 1024 * 2;
constexpr size_t WS_W2T = WS_WOUTO + 2ull * 1024 * 1024 * 2;
constexpr size_t WS_A2T = WS_W2T + 2ull * 512 * 64 * 2;
constexpr size_t WS_POOLWT = WS_A2T + 2ull * 512 * 64 * 2;
constexpr size_t WS_SPW = WS_POOLWT + 8ull * 128 * 128 * 2;
constexpr size_t WS_XB = WS_SPW + 8ull * 128 * 128 * 2;
constexpr size_t WS_YCAT = WS_XB + (size_t)NTOK * 1024 * 2;
constexpr size_t WS_SSQ = WS_YCAT + (size_t)NTOK * 1024 * 2;
constexpr size_t WS_Y = WS_SSQ + 5ull * NTOK * 16 * 4;
constexpr size_t WS_R1 = WS_Y + (size_t)NTOK * 512 * 4;
constexpr size_t WS_PROJB = WS_R1;
constexpr size_t WS_WDEC = WS_PROJB + (size_t)NTOK * LDB * 2;
constexpr size_t WS_AA = WS_WDEC + (size_t)NTOK * 512 * 4;
constexpr size_t WS_BAR = WS_AA + (size_t)NTOK * 512 * 2;
constexpr size_t WS_END = WS_BAR + 16384;
constexpr int LDS_MAIN = 147456;
constexpr int LDS_BYTES = LDS_MAIN + 16;

struct Params {
    const void* ptr[32];
    int ph_lo, ph_hi;
};
struct Ctx { int tid, bid, nblk, z; };
#define PIN(i) ((const float*)p.ptr[(i) + cx.z])
#define POUT ((float*)p.ptr[29 + cx.z])
#define PWS ((unsigned char*)p.ptr[30 + cx.z])
enum { I_XP = 0, I_XS, I_SCONV, I_SSHIFT, I_SWKV, I_SPOOL, I_NORMW, I_FNORMW, I_WINE, I_CONVW, I_MU, I_W0, I_W2, I_A0, I_A2, I_KK, I_KA, I_RK, I_GNG, I_GNB,
       I_WOUTE, I_WINO, I_POOLW, I_PSCALE, I_LNG, I_LNB, I_SPW, I_SPB, I_WOUTO };

__device__ __forceinline__ unsigned cvt_pk_bf16(float lo, float hi) { unsigned r; asm("v_cvt_pk_bf16_f32 %0, %1, %2" : "=v"(r) : "v"(lo), "v"(hi)); return r; }
__device__ __forceinline__ float bf_lo(unsigned u) { return __uint_as_float(u << 16); }
__device__ __forceinline__ float bf_hi(unsigned u) { return __uint_as_float(u & 0xffff0000u); }
__device__ __forceinline__ float bf2f(bf16_t b) { return __uint_as_float(((unsigned)b) << 16); }
__device__ __forceinline__ f32x4 cvt4(u32x2 u) { return (f32x4){bf_lo(u.x), bf_hi(u.x), bf_lo(u.y), bf_hi(u.y)}; }
__device__ __forceinline__ f32x4 ld_bf4(const bf16_t* p) { return cvt4(*(const u32x2*)p); }
__device__ __forceinline__ void st_bf4(bf16_t* p, f32x4 v) { u32x2 u; u.x = cvt_pk_bf16(v[0], v[1]); u.y = cvt_pk_bf16(v[2], v[3]); *(u32x2*)p = u; }
__device__ __forceinline__ float sigmoidf_(float x) { return 1.0f / (1.0f + __expf(-x)); }
__device__ __forceinline__ float siluf_(float x) { return x / (1.0f + __expf(-x)); }
template <int CTRL> __device__ __forceinline__ float dpp_f(float x) { return __builtin_bit_cast(float, __builtin_amdgcn_mov_dpp(__builtin_bit_cast(int, x), CTRL, 0xf, 0xf, true)); }
__device__ __forceinline__ float allsum16(float x) { x += dpp_f<0xB1>(x); x += dpp_f<0x4E>(x); x += dpp_f<0x141>(x); x += dpp_f<0x128>(x); return x; }
__device__ __forceinline__ float allsum4(float x) { x += dpp_f<0xB1>(x); x += dpp_f<0x4E>(x); return x; }
__device__ __forceinline__ float dot4(f32x4 a, f32x4 b) { return a[0] * b[0] + a[1] * b[1] + a[2] * b[2] + a[3] * b[3]; }

__device__ __forceinline__ float ssq_sum(const float* part) {
    const f32x4 a = *(const f32x4*)(part), b = *(const f32x4*)(part + 4), c = *(const f32x4*)(part + 8), d = *(const f32x4*)(part + 12);
    return ((a[0] + a[1]) + (a[2] + a[3])) + ((b[0] + b[1]) + (b[2] + b[3])) + ((c[0] + c[1]) + (c[2] + c[3])) + ((d[0] + d[1]) + (d[2] + d[3]));
}

namespace pg8 {
constexpr int BM = 256, BK = 64, HALF = 128, HTB = HALF * BK * 2, NXCD = 8, WGM = 8;
__device__ __forceinline__ int lds_byte(int r, int c) { const int st = (r >> 4) * 2 + (c >> 5), rr = r & 15, cc = c & 31, ob = rr * 64 + cc * 2; return st * 1024 + (ob ^ (((ob >> 9) & 1) << 5)); }
__device__ __forceinline__ void stage_rc(int b, int& R, int& C) { const int st = b / 1024, sb = b % 1024, swz = sb ^ (((sb >> 9) & 1) << 5); R = (st >> 1) * 16 + swz / 64; C = (st & 1) * 32 + (swz % 64) / 2; }
__device__ __forceinline__ int perm32(int rho) { const int n = rho >> 4, i = rho & 15; return 8 * (i >> 2) + 4 * n + (i & 3); }
struct Unit { int pm, pn; };
struct Gemm { const bf16_t* A; const bf16_t* Bt; int M, N, K; };
struct StaticOrder {
    int nM, nN, nwg, G, c;
    __device__ void init(int M, int N, int G_, int c_) { nM = M / BM; nN = N / BM; nwg = nM * nN; G = G_; c = c_; }
    __device__ bool next(int i, Unit& u) const {
        const long L = (long)i * G + c; if (L >= nwg) return false;
        int wgid = (int)L; { const int q = nwg / NXCD, r = nwg % NXCD, xcd = wgid % NXCD, off = wgid / NXCD; wgid = (xcd < r ? xcd * (q + 1) : r * (q + 1) + (xcd - r) * q) + off; }
        const int nig = WGM * nN, gid = wgid / nig, fm = gid * WGM, gsz = (nM - fm) < WGM ? (nM - fm) : WGM;
        u.pm = fm + ((wgid % nig) % gsz); u.pn = (wgid % nig) / gsz; return true;
    }
};

template <class Epi>
__device__ __forceinline__ void gemm_phase(const Ctx cx, LAS unsigned char* lds, const Gemm g, const StaticOrder& S, const Epi& E) {
    const int tid = cx.tid, wid = __builtin_amdgcn_readfirstlane(tid >> 6), lane = tid & 63, wr = wid >> 2, wc = wid & 3, fr = lane & 15, fq = lane >> 4;
    const int K = g.K, nt = K / BK;
    unsigned voffA[2], voffB[2];
#pragma unroll
    for (int i = 0; i < 2; ++i) { int R, C; stage_rc(tid * 16 + i * 8192, R, C); const int Rb = Epi::PERM ? ((R & ~31) + perm32(R & 31)) : R;
        voffA[i] = (unsigned)(R * K + C) * 2u; voffB[i] = (unsigned)(Rb * K + C) * 2u; }
    const size_t kstep = (size_t)(BK * 2);
    const size_t hstep = (size_t)HALF * K * 2;
    const size_t tstep = 2 * hstep;
    const unsigned ldsw = (unsigned)wid * 1024u;
    const int aoff = lds_byte(wr * 64 + fr, fq * 8), boff = lds_byte(wc * 32 + fr, fq * 8);
#define PG8_SA(b, h) (((b) * 2 + (h)) * HTB)
#define PG8_SB(b, h) ((4 + (b) * 2 + (h)) * HTB)
#define PG8_STAGE(bufoff, gbase, voff) do { _Pragma("unroll") for (int _i = 0; _i < 2; ++_i) \
        __builtin_amdgcn_global_load_lds((const unsigned*)((const char*)(gbase) + (voff)[_i]), (LAS unsigned*)(lds + (bufoff) + ldsw + _i * 8192), 16, 0, 0); } while (0)
#define PG8_LDA(dst, b, h) do { _Pragma("unroll") for (int m = 0; m < 4; ++m) _Pragma("unroll") for (int k = 0; k < 2; ++k) dst[m][k] = *(const LAS bf16x8*)(lds + PG8_SA(b, h) + aoff + m * 2048 + k * 1024); } while (0)
#define PG8_LDB(dst, b, h) do { _Pragma("unroll") for (int n = 0; n < 2; ++n) _Pragma("unroll") for (int k = 0; k < 2; ++k) dst[n][k] = *(const LAS bf16x8*)(lds + PG8_SB(b, h) + boff + n * 2048 + k * 1024); } while (0)
#define PG8_MMA(ai, bj, At, Bt) do { __builtin_amdgcn_s_setprio(1); _Pragma("unroll") for (int m = 0; m < 4; ++m) _Pragma("unroll") for (int n = 0; n < 2; ++n) _Pragma("unroll") for (int k = 0; k < 2; ++k) \
        acc[ai][bj][m][n] = __builtin_amdgcn_mfma_f32_16x16x32_bf16(Bt[n][k], At[m][k], acc[ai][bj][m][n], 0, 0, 0); __builtin_amdgcn_s_setprio(0); } while (0)
#define PG8_WAIT_V(n) asm volatile("s_waitcnt vmcnt(" #n ")" ::: "memory")
#define PG8_WAIT_L(n) asm volatile("s_waitcnt lgkmcnt(" #n ")" ::: "memory")
#define PG8_BAR __builtin_amdgcn_s_barrier()
#define PG8_SCHED __builtin_amdgcn_sched_barrier(0)
    Unit cur, nxt; int ui = 0;
    if (!S.next(0, cur)) return;
    f32x4 acc[2][2][4][2];
#pragma unroll
    for (int a = 0; a < 2; ++a)
#pragma unroll
        for (int b = 0; b < 2; ++b)
#pragma unroll
            for (int m = 0; m < 4; ++m)
#pragma unroll
                for (int n = 0; n < 2; ++n) acc[a][b][m][n] = (f32x4){0.f, 0.f, 0.f, 0.f};
    bf16x8 At[4][2], B0[2][2], B1[2][2];
    const char* cA = (const char*)g.A + (size_t)cur.pm * tstep; const char* cB = (const char*)g.Bt + (size_t)cur.pn * tstep;
    PG8_STAGE(PG8_SB(0, 0), cB, voffB); PG8_STAGE(PG8_SA(0, 0), cA, voffA); PG8_STAGE(PG8_SB(0, 1), cB + hstep, voffB); PG8_STAGE(PG8_SA(0, 1), cA + hstep, voffA);
    if (wr == 1) PG8_BAR;
    PG8_WAIT_V(4); PG8_BAR;
    PG8_STAGE(PG8_SB(1, 0), cB + kstep, voffB); PG8_STAGE(PG8_SA(1, 0), cA + kstep, voffA); PG8_STAGE(PG8_SB(1, 1), cB + hstep + kstep, voffB);
    PG8_WAIT_V(6); PG8_BAR;
    for (;;) {
        const bool has_next = S.next(ui + 1, nxt);
        const char* nA = has_next ? (const char*)g.A + (size_t)nxt.pm * tstep : cA; const char* nB = has_next ? (const char*)g.Bt + (size_t)nxt.pn * tstep : cB;
        for (int t = 0; t < nt; t += 2) {
            const bool last = (t == nt - 2);
            const char* a1 = cA + (size_t)(t + 1) * kstep;
            const char* a2 = last ? nA : cA + (size_t)(t + 2) * kstep; const char* b2 = last ? nB : cB + (size_t)(t + 2) * kstep;
            const char* a3 = a2 + kstep; const char* b3 = b2 + kstep;
            PG8_LDB(B0, 0, 0); PG8_SCHED; PG8_LDA(At, 0, 0); PG8_STAGE(PG8_SA(1, 1), a1 + hstep, voffA);
            PG8_WAIT_L(8); PG8_BAR; PG8_WAIT_L(0); PG8_MMA(0, 0, At, B0); PG8_BAR; PG8_SCHED;
            PG8_LDB(B1, 0, 1); PG8_STAGE(PG8_SB(0, 0), b2, voffB);
            PG8_BAR; PG8_WAIT_L(0); PG8_MMA(0, 1, At, B1); PG8_BAR;
            PG8_LDA(At, 0, 1); PG8_STAGE(PG8_SA(0, 0), a2, voffA);
            PG8_BAR; PG8_WAIT_L(0); PG8_MMA(1, 0, At, B0); PG8_BAR; PG8_SCHED;
            PG8_STAGE(PG8_SB(0, 1), b2 + hstep, voffB);
            PG8_WAIT_V(6); PG8_BAR; PG8_MMA(1, 1, At, B1); PG8_BAR;
            PG8_LDB(B0, 1, 0); PG8_SCHED; PG8_LDA(At, 1, 0); PG8_STAGE(PG8_SA(0, 1), a2 + hstep, voffA);
            PG8_WAIT_L(8); PG8_BAR; PG8_WAIT_L(0); PG8_MMA(0, 0, At, B0); PG8_BAR; PG8_SCHED;
            PG8_LDB(B1, 1, 1); PG8_STAGE(PG8_SB(1, 0), b3, voffB);
            PG8_BAR; PG8_WAIT_L(0); PG8_MMA(0, 1, At, B1); PG8_BAR;
            PG8_LDA(At, 1, 1); PG8_STAGE(PG8_SA(1, 0), a3, voffA);
            PG8_BAR; PG8_WAIT_L(0); PG8_MMA(1, 0, At, B0); PG8_BAR; PG8_SCHED;
            PG8_STAGE(PG8_SB(1, 1), b3 + hstep, voffB);
            PG8_WAIT_V(6); PG8_BAR; PG8_MMA(1, 1, At, B1); PG8_BAR;
        }
        E(acc, cur, wr, wc, fr, fq);
        if (!has_next) break;
#pragma unroll
        for (int a = 0; a < 2; ++a)
#pragma unroll
            for (int b = 0; b < 2; ++b)
#pragma unroll
                for (int m = 0; m < 4; ++m)
#pragma unroll
                    for (int n = 0; n < 2; ++n) acc[a][b][m][n] = (f32x4){0.f, 0.f, 0.f, 0.f};
        cur = nxt; cA = nA; cB = nB; ++ui;
    }
    PG8_WAIT_V(0);
    if (wr == 0) PG8_BAR;
    PG8_BAR;
#undef PG8_SA
#undef PG8_SB
#undef PG8_STAGE
#undef PG8_LDA
#undef PG8_LDB
#undef PG8_MMA
#undef PG8_WAIT_V
#undef PG8_WAIT_L
#undef PG8_BAR
#undef PG8_SCHED
}
}

struct EpiProj {
    static constexpr bool PERM = true;
    bf16_t* O; int ldc; LAS const float* rl; int pm0, pm1, pm2, pm3;
    __device__ __forceinline__ void operator()(const f32x4 (&acc)[2][2][4][2], const pg8::Unit& u, int wr, int wc, int fr, int fq) const {
        const int row0 = u.pm * 256 + wr * 64 + fr, col0 = u.pn * 256 + wc * 32 + 8 * fq;
        const int sel = u.pm == pm0 ? 0 : (u.pm == pm1 ? 1 : (u.pm == pm2 ? 2 : 3));
        LAS const float* rp = rl + sel * 256 + wr * 64 + fr;
#pragma unroll
        for (int ai = 0; ai < 2; ++ai)
#pragma unroll
            for (int m = 0; m < 4; ++m) {
                const int row = row0 + ai * 128 + m * 16;
                const float rstd = rp[ai * 128 + m * 16];
                bf16_t* rowp = O + (size_t)row * ldc + col0;
#pragma unroll
                for (int bj = 0; bj < 2; ++bj) {
                    const f32x4 v0 = acc[ai][bj][m][0] * rstd, v1 = acc[ai][bj][m][1] * rstd;
                    u32x4 w; w.x = cvt_pk_bf16(v0[0], v0[1]); w.y = cvt_pk_bf16(v0[2], v0[3]); w.z = cvt_pk_bf16(v1[0], v1[1]); w.w = cvt_pk_bf16(v1[2], v1[3]);
                    *(u32x4*)(rowp + bj * 128) = w;
                }
            }
    }
};
struct X8 { f32x4 lo, hi; };
template <bool FIRST> __device__ __forceinline__ X8 ld_x8(const float* __restrict__ s32, const bf16_t* __restrict__ s16, size_t o) {
    X8 r;
    if (FIRST) { r.lo = *(const f32x4*)(s32 + o); r.hi = *(const f32x4*)(s32 + o + 4); }
    else { const u32x4 u = *(const u32x4*)(s16 + o); r.lo = cvt4((u32x2){u.x, u.y}); r.hi = cvt4((u32x2){u.z, u.w}); }
    return r;
}
__device__ __forceinline__ void st_x8(bf16_t* p, f32x4 lo, f32x4 hi) { u32x4 w; w.x = cvt_pk_bf16(lo[0], lo[1]); w.y = cvt_pk_bf16(lo[2], lo[3]); w.z = cvt_pk_bf16(hi[0], hi[1]); w.w = cvt_pk_bf16(hi[2], hi[3]); *(u32x4*)p = w; }
template <bool FIRST>
__device__ __forceinline__ void epi_res_rows(const f32x4 (&acc)[2][2][4][2], const float* __restrict__ src32, const bf16_t* __restrict__ src16, bf16_t* __restrict__ Xb, float* __restrict__ ssqp,
                                             int row0, int col0, int slot, int fq) {
    X8 x[2][2];
#pragma unroll
    for (int bj = 0; bj < 2; ++bj) x[0][bj] = ld_x8<FIRST>(src32, src16, (size_t)row0 * 1024 + col0 + bj * 128);
#pragma unroll
    for (int gi = 0; gi < 8; ++gi) {
        const int ai = gi >> 2, m = gi & 3, row = row0 + ai * 128 + m * 16;
        if (gi + 1 < 8) {
            const int nrow = row0 + ((gi + 1) >> 2) * 128 + ((gi + 1) & 3) * 16;
#pragma unroll
            for (int bj = 0; bj < 2; ++bj) x[(gi + 1) & 1][bj] = ld_x8<FIRST>(src32, src16, (size_t)nrow * 1024 + col0 + bj * 128);
        }
        float part = 0.f;
#pragma unroll
        for (int bj = 0; bj < 2; ++bj) {
            const f32x4 lo = x[gi & 1][bj].lo + acc[ai][bj][m][0], hi = x[gi & 1][bj].hi + acc[ai][bj][m][1];
            st_x8(Xb + (size_t)row * 1024 + col0 + bj * 128, lo, hi);
            part += dot4(lo, lo) + dot4(hi, hi);
        }
        part += __shfl_xor(part, 16); part += __shfl_xor(part, 32);
        if (fq == 0) ssqp[(size_t)row * 16 + slot] = part;
    }
}
struct EpiRes {
    static constexpr bool PERM = true;
    const float* xp; const float* xs; bf16_t* Xb; float* ssq_next;
    __device__ __forceinline__ void operator()(const f32x4 (&acc)[2][2][4][2], const pg8::Unit& u, int wr, int wc, int fr, int fq) const {
        const int row0 = u.pm * 256 + wr * 64 + fr, col0 = u.pn * 256 + wc * 32 + 8 * fq;
        if (xp) epi_res_rows<true>(acc, row0 < NTP ? xp : xs - (size_t)NTP * 1024, nullptr, Xb, ssq_next, row0, col0, u.pn * 4 + wc, fq);
        else epi_res_rows<false>(acc, nullptr, Xb, Xb, ssq_next, row0, col0, u.pn * 4 + wc, fq);
    }
};

template <bool FIRST>
__device__ __forceinline__ void res_sample_tile(const Ctx cx, const bf16_t* __restrict__ A, const bf16_t* __restrict__ Bt, const float* __restrict__ xs, bf16_t* __restrict__ Xb, float* __restrict__ ssqp, int tile) {
    const int tid = cx.tid, wid = tid >> 6, lane = tid & 63, fr = lane & 15, fq = lane >> 4;
    const int tm = tile >> 3, tn = tile & 7;
    const int r0 = NTP + tm * 64 + (wid & 3) * 16, c0 = tn * 128 + (wid >> 2) * 64;
    const bf16_t* ap = A + (size_t)(r0 + fr) * 1024 + fq * 8;
    const bf16_t* bp = Bt + (size_t)(c0 + fr) * 1024 + fq * 8;
    f32x4 acc[4];
#pragma unroll
    for (int nt = 0; nt < 4; ++nt) acc[nt] = (f32x4){0.f, 0.f, 0.f, 0.f};
#pragma unroll 8
    for (int ks = 0; ks < 32; ++ks) {
        const bf16x8 af = *(const bf16x8*)(ap + ks * 32);
#pragma unroll
        for (int nt = 0; nt < 4; ++nt) {
            const bf16x8 bf = *(const bf16x8*)(bp + (size_t)nt * 16 * 1024 + ks * 32);
            acc[nt] = __builtin_amdgcn_mfma_f32_16x16x32_bf16(bf, af, acc[nt], 0, 0, 0);
        }
    }
    const int row = r0 + fr;
    float part = 0.f;
#pragma unroll
    for (int nt = 0; nt < 4; ++nt) {
        const int col = c0 + nt * 16 + fq * 4;
        const f32x4 xo = FIRST ? *(const f32x4*)(xs + (size_t)(row - NTP) * 1024 + col) : ld_bf4(Xb + (size_t)row * 1024 + col);
        const f32x4 v = xo + acc[nt];
        st_bf4(Xb + (size_t)row * 1024 + col, v);
        part += dot4(v, v);
    }
    part += __shfl_xor(part, 16); part += __shfl_xor(part, 32);
    if (fq == 0) ssqp[(size_t)row * 16 + (c0 >> 6)] = part;
}

struct TrJob { const float* src; int ld, col0, k0; bf16_t* dst; int Ktot, drow0; const float* scale; bool zero; };
__device__ __forceinline__ TrJob tr_decode(const Params& p, const Ctx cx, int job) {
    TrJob J; J.zero = false; J.scale = nullptr;
    int j = job;
    if (j < 2176) {
        const int i = j / 1088, r = j % 1088, nt = r / 16, kt = r % 16, n0 = nt * 64;
        int col0 = 0;
        if (n0 < 2048) col0 = n0; else if (n0 < 2560) col0 = 3712 + (n0 - 2048); else if (n0 < 4224) col0 = 2048 + (n0 - 2560); else J.zero = true;
        J.src = PIN(I_WINE) + (size_t)i * 1024 * 4224; J.ld = 4224; J.col0 = col0; J.k0 = kt * 64; J.dst = (bf16_t*)(PWS + WS_WINE) + (size_t)i * 4352 * 1024; J.Ktot = 1024; J.drow0 = n0; J.scale = PIN(I_NORMW) + (2 * i) * 1024;
        return J;
    }
    j -= 2176;
    if (j < 512) { const int i = j / 256, r = j % 256, nt = r / 16, kt = r % 16;
        J.src = PIN(I_WOUTE) + (size_t)i * 1024 * 1024; J.ld = 1024; J.col0 = nt * 64; J.k0 = kt * 64; J.dst = (bf16_t*)(PWS + WS_WOUTE) + (size_t)i * 1024 * 1024; J.Ktot = 1024; J.drow0 = nt * 64; return J; }
    j -= 512;
    if (j < 1280) { const int i = j / 640, r = j % 640, nt = r / 16, kt = r % 16;
        J.src = PIN(I_WINO) + (size_t)i * 1024 * 2560; J.ld = 2560; J.col0 = nt * 64; J.k0 = kt * 64; J.dst = (bf16_t*)(PWS + WS_WINO) + (size_t)i * 2560 * 1024; J.Ktot = 1024; J.drow0 = nt * 64; J.scale = PIN(I_NORMW) + (2 * i + 1) * 1024; return J; }
    j -= 1280;
    if (j < 512) { const int i = j / 256, r = j % 256, nt = r / 16, kt = r % 16;
        J.src = PIN(I_WOUTO) + (size_t)i * 1024 * 1024; J.ld = 1024; J.col0 = nt * 64; J.k0 = kt * 64; J.dst = (bf16_t*)(PWS + WS_WOUTO) + (size_t)i * 1024 * 1024; J.Ktot = 1024; J.drow0 = nt * 64; return J; }
    j -= 512;
    if (j < 16) { const int i = j / 8, nt = j % 8;
        J.src = PIN(I_W2) + (size_t)i * 64 * 512; J.ld = 512; J.col0 = nt * 64; J.k0 = 0; J.dst = (bf16_t*)(PWS + WS_W2T) + (size_t)i * 512 * 64; J.Ktot = 64; J.drow0 = nt * 64; return J; }
    j -= 16;
    if (j < 16) { const int i = j / 8, nt = j % 8;
        J.src = PIN(I_A2) + (size_t)i * 64 * 512; J.ld = 512; J.col0 = nt * 64; J.k0 = 0; J.dst = (bf16_t*)(PWS + WS_A2T) + (size_t)i * 512 * 64; J.Ktot = 64; J.drow0 = nt * 64; return J; }
    j -= 16;
    { const int ig = j / 4, r = j % 4, nt = r / 2, kt = r % 2;
        J.src = PIN(I_POOLW) + (size_t)ig * 128 * 128; J.ld = 128; J.col0 = nt * 64; J.k0 = kt * 64; J.dst = (bf16_t*)(PWS + WS_POOLWT) + (size_t)ig * 128 * 128; J.Ktot = 128; J.drow0 = nt * 64; }
    return J;
}
__device__ __forceinline__ void tr_load(const TrJob& J, int tid, f32x4& va, f32x4& vb) {
    const int nn = (tid & 15) * 4, ka = tid >> 4, kb = ka + 32;
    va = (f32x4){0.f, 0.f, 0.f, 0.f}; vb = va;
    if (!J.zero) {
        va = *(const f32x4*)(J.src + (size_t)(J.k0 + ka) * J.ld + J.col0 + nn); vb = *(const f32x4*)(J.src + (size_t)(J.k0 + kb) * J.ld + J.col0 + nn);
        if (J.scale) { va = va * J.scale[J.k0 + ka]; vb = vb * J.scale[J.k0 + kb]; }
    }
}

__device__ void phase_prepass(const Params& p, const Ctx cx, LAS unsigned char* lds) {
    LAS float* T = (LAS float*)lds;
    const int tid = cx.tid;
    {
        int job = cx.bid;
        f32x4 va = (f32x4){0.f, 0.f, 0.f, 0.f}, vb = va;
        if (job < 4544) { const TrJob J0 = tr_decode(p, cx, job); tr_load(J0, tid, va, vb); }
        for (; job < 4544; job += cx.nblk) {
            f32x4 na = va, nb = vb;
            if (job + (int)cx.nblk < 4544) { const TrJob Jn = tr_decode(p, cx, job + (int)cx.nblk); tr_load(Jn, tid, na, nb); }
            {
                const int nn = (tid & 15) * 4, ka = tid >> 4, kb = ka + 32;
                T[ka * 65 + nn] = va[0]; T[ka * 65 + nn + 1] = va[1]; T[ka * 65 + nn + 2] = va[2]; T[ka * 65 + nn + 3] = va[3];
                T[kb * 65 + nn] = vb[0]; T[kb * 65 + nn + 1] = vb[1]; T[kb * 65 + nn + 2] = vb[2]; T[kb * 65 + nn + 3] = vb[3];
            }
            __syncthreads();
            {
                const TrJob J = tr_decode(p, cx, job);
                const int n = tid >> 3, kc = (tid & 7) * 8;
                u32x4 w;
                w.x = cvt_pk_bf16(T[(kc + 0) * 65 + n], T[(kc + 1) * 65 + n]); w.y = cvt_pk_bf16(T[(kc + 2) * 65 + n], T[(kc + 3) * 65 + n]);
                w.z = cvt_pk_bf16(T[(kc + 4) * 65 + n], T[(kc + 5) * 65 + n]); w.w = cvt_pk_bf16(T[(kc + 6) * 65 + n], T[(kc + 7) * 65 + n]);
                *(u32x4*)(J.dst + (size_t)(J.drow0 + n) * J.Ktot + J.k0 + kc) = w;
            }
            __syncthreads();
            va = na; vb = nb;
        }
    }
    const int gtid = cx.bid * 512 + tid, gthreads = cx.nblk * 512;
    for (int e = gtid; e < 8 * 128 * 128; e += gthreads) {
        const int s = e & 127, t = (e >> 7) & 127;
        ((bf16_t*)(PWS + WS_SPW))[e] = (s <= t) ? (bf16_t)(cvt_pk_bf16(PIN(I_SPW)[e], 0.f) & 0xffffu) : (bf16_t)0;
    }
    const int wid = tid >> 6, lane = tid & 63;
    for (int row0 = cx.bid * 8 + wid; row0 < NTOK; row0 += cx.nblk * 8 * 3) {
        f32x4 v[3][4];
#pragma unroll
        for (int r = 0; r < 3; ++r) {
            const int row = row0 + r * cx.nblk * 8; const int rr = row < NTOK ? row : row0;
            const float* src = rr < NTP ? PIN(I_XP) + (size_t)rr * 1024 : PIN(I_XS) + (size_t)(rr - NTP) * 1024;
#pragma unroll
            for (int i = 0; i < 4; ++i) v[r][i] = *(const f32x4*)(src + i * 256 + lane * 4);
        }
#pragma unroll
        for (int r = 0; r < 3; ++r) {
            const int row = row0 + r * cx.nblk * 8;
            if (row < NTOK) {
                bf16_t* dst = (bf16_t*)(PWS + WS_XB) + (size_t)row * 1024;
                float ss = 0.f;
#pragma unroll
                for (int i = 0; i < 4; ++i) { ss += dot4(v[r][i], v[r][i]); st_bf4(dst + i * 256 + lane * 4, v[r][i]); }
#pragma unroll
                for (int o = 32; o >= 1; o >>= 1) ss += __shfl_xor(ss, o);
                if (lane < 16) ((float*)(PWS + WS_SSQ))[(size_t)row * 16 + lane] = (lane == 0) ? ss : 0.f;
            }
        }
    }
}

__device__ __forceinline__ f32x4 shift4(const bf16_t* cur, bool hp, const float* st, int col, const float* mu) {
    const f32x4 q = ld_bf4(cur + col);
    f32x4 pv;
    if (hp) pv = ld_bf4(cur - LDB + col); else if (st) pv = *(const f32x4*)(st + col); else pv = (f32x4){0.f, 0.f, 0.f, 0.f};
    const f32x4 m = *(const f32x4*)(mu + col);
    return q + m * (pv - q);
}

__device__ void phase_even_prep(const Params& p, const Ctx cx, int pair, LAS unsigned char* lds) {
    const int tid = cx.tid, wid = tid >> 6, lane = tid & 63, fr = lane & 15, fq = lane >> 4;
    const bf16_t* PB = (const bf16_t*)(PWS + WS_PROJB);
    float* Wdec = (float*)(PWS + WS_WDEC);
    bf16_t* Aa = (bf16_t*)(PWS + WS_AA);
    bf16_t* Ycat = (bf16_t*)(PWS + WS_YCAT);
    const float* mu_ = PIN(I_MU) + pair * 1664;
    const float* w0_ = PIN(I_W0) + pair * 512; const float* a0_ = PIN(I_A0) + pair * 512;
    const float* k_a_ = PIN(I_KA) + pair * 512; const float* r_k_ = PIN(I_RK) + pair * 512;
    constexpr int RS = 3344;
    constexpr int TB = 17 * RS;
    constexpr int NCH = 17 * 208;
    const int h = wid;
    bf16x8 wfr[4][2], afr[4][2];
    {
        const bf16_t* W2T = (const bf16_t*)(PWS + WS_W2T) + (size_t)pair * 512 * 64;
        const bf16_t* A2T = (const bf16_t*)(PWS + WS_A2T) + (size_t)pair * 512 * 64;
#pragma unroll
        for (int nt = 0; nt < 4; ++nt)
#pragma unroll
            for (int ks = 0; ks < 2; ++ks) {
                wfr[nt][ks] = *(const bf16x8*)(W2T + (size_t)(h * 64 + nt * 16 + fr) * 64 + ks * 32 + fq * 8);
                afr[nt][ks] = *(const bf16x8*)(A2T + (size_t)(h * 64 + nt * 16 + fr) * 64 + ks * 32 + fq * 8);
            }
    }
    constexpr int TBD = 56 * 1024;
    const int widu = __builtin_amdgcn_readfirstlane(tid >> 6);
#define PREP_DMA(tile_, b_, lane_) do { _Pragma("unroll") for (int i_ = 0; i_ < 7; ++i_) { const int k_ = widu * 7 + i_, q_ = k_ * 64 + (lane_); \
            int lr_ = q_ / 209, cc_ = q_ - lr_ * 209; if (lr_ > 16) { lr_ = 16; cc_ = 0; } if (cc_ > 207) cc_ = 0; \
            int gr_ = (tile_) * 16 - 1 + lr_; gr_ = gr_ < 0 ? 0 : gr_; \
            __builtin_amdgcn_global_load_lds((const unsigned*)(PB + (size_t)gr_ * LDB + cc_ * 8), (LAS unsigned*)(lds + (b_) * TBD + k_ * 1024), 16, 0, 0); } } while (0)
    int buf = 0;
    if ((int)cx.bid < NTOK / 16) PREP_DMA((int)cx.bid, 0, tid & 63);
    asm volatile("s_waitcnt vmcnt(0)" ::: "memory");
    __syncthreads();
    for (int tile = cx.bid; tile < NTOK / 16; tile += cx.nblk) {
        int zz; asm volatile("v_mov_b32 %0, 0" : "=v"(zz));
        const int tidv = tid + zz, fr = (tidv & 15), fq = (tidv >> 4) & 3;
        if (tile + (int)cx.nblk < NTOK / 16) PREP_DMA(tile + (int)cx.nblk, buf ^ 1, tidv & 63);
        {
            const int row = tile * 16 + fr;
            const bool samp = row >= NTP;
            int b, t; if (!samp) { b = row >> 11; t = row & 2047; } else { const int q = row - NTP; b = q >> 3; t = q & 7; }
            const bool hp = t > 0;
            const float* st = samp ? PIN(I_SSHIFT) + ((size_t)pair * 128 + b) * 1664 : nullptr;
            const float* mu = mu_ + zz; const float* w0 = w0_ + zz; const float* a0 = a0_ + zz; const float* k_a = k_a_ + zz; const float* r_k = r_k_ + zz;
            LAS const unsigned char* curL = lds + buf * TBD + (fr + 1) * RS;
            LAS const unsigned char* prvL = lds + buf * TBD + fr * RS;
            auto sh4 = [&](int col) -> f32x4 {
                const f32x4 q = cvt4(*(LAS const u32x2*)(curL + col * 2));
                f32x4 pv;
                if (hp) pv = cvt4(*(LAS const u32x2*)(prvL + col * 2)); else if (st) pv = *(const f32x4*)(st + col); else pv = (f32x4){0.f, 0.f, 0.f, 0.f};
                const f32x4 m = *(const f32x4*)(mu + col);
                return q + m * (pv - q);
            };
            bf16x8 Aw[2], Al[2];
#pragma unroll
            for (int ks = 0; ks < 2; ++ks) {
                const int cw = 1536 + ks * 32 + fq * 8, ca = 1600 + ks * 32 + fq * 8;
                const f32x4 w_lo = sh4(cw), w_hi = sh4(cw + 4), a_lo = sh4(ca), a_hi = sh4(ca + 4);
                u32x4 pw, pa;
                float th[8];
#pragma unroll
                for (int j = 0; j < 4; ++j) { th[j] = 2.0f * sigmoidf_(2.0f * w_lo[j]) - 1.0f; th[4 + j] = 2.0f * sigmoidf_(2.0f * w_hi[j]) - 1.0f; }
                pw.x = cvt_pk_bf16(th[0], th[1]); pw.y = cvt_pk_bf16(th[2], th[3]); pw.z = cvt_pk_bf16(th[4], th[5]); pw.w = cvt_pk_bf16(th[6], th[7]);
                pa.x = cvt_pk_bf16(a_lo[0], a_lo[1]); pa.y = cvt_pk_bf16(a_lo[2], a_lo[3]); pa.z = cvt_pk_bf16(a_hi[0], a_hi[1]); pa.w = cvt_pk_bf16(a_hi[2], a_hi[3]);
                Aw[ks] = __builtin_bit_cast(bf16x8, pw); Al[ks] = __builtin_bit_cast(bf16x8, pa);
            }
            float bon = 0.f;
#pragma unroll
            for (int nt = 0; nt < 4; ++nt) {
                f32x4 lw = (f32x4){0.f, 0.f, 0.f, 0.f}, la = (f32x4){0.f, 0.f, 0.f, 0.f};
#pragma unroll
                for (int ks = 0; ks < 2; ++ks) {
                    lw = __builtin_amdgcn_mfma_f32_16x16x32_bf16(wfr[nt][ks], Aw[ks], lw, 0, 0, 0);
                    la = __builtin_amdgcn_mfma_f32_16x16x32_bf16(afr[nt][ks], Al[ks], la, 0, 0, 0);
                }
                const int ch = h * 64 + nt * 16 + fq * 4;
                const f32x4 r4 = sh4(ch), k4 = sh4(512 + ch);
                const f32x4 w04 = *(const f32x4*)(w0 + ch), a04 = *(const f32x4*)(a0 + ch), ka4 = *(const f32x4*)(k_a + ch), rk4 = *(const f32x4*)(r_k + ch);
                f32x4 dec, av;
#pragma unroll
                for (int j = 0; j < 4; ++j) {
                    const float z_ = -(w04[j] + lw[j]);
                    const float wlog = -__logf(1.0f + __expf(z_)) - 0.5f;
                    dec[j] = __expf(-__expf(wlog));
                    av[j] = sigmoidf_(a04[j] + la[j]);
                    const float kp = k4[j] * (1.0f + (av[j] - 1.0f) * ka4[j]);
                    bon += r4[j] * kp * rk4[j];
                }
                *(f32x4*)(Wdec + (size_t)row * 512 + ch) = dec;
                st_bf4(Aa + (size_t)row * 512 + ch, av);
            }
            bon += __shfl_xor(bon, 16); bon += __shfl_xor(bon, 32);
#pragma unroll
            for (int nt = 0; nt < 4; ++nt) { const int ch = h * 64 + nt * 16 + fq * 4; st_bf4(Ycat + (size_t)row * 1024 + 512 + ch, sh4(1024 + ch) * bon); }
        }
        asm volatile("s_waitcnt vmcnt(0)" ::: "memory");
        __syncthreads();
        buf ^= 1;
    }
#undef PREP_DMA
    const int gtid = cx.bid * 512 + tid, gthreads = cx.nblk * 512;
    for (int e = gtid; e < 136 * 1664; e += gthreads) {
        const int sr = e / 1664, c = e % 1664;
        if (sr < 8) POUT[O_SHIFTP + ((size_t)pair * 8 + sr) * 1664 + c] = bf2f(PB[(size_t)(sr * 2048 + 2047) * LDB + c]);
        else { const int b = sr - 8; POUT[O_SHIFTS + ((size_t)pair * 128 + b) * 1664 + c] = bf2f(PB[(size_t)(NTP + b * 8 + 7) * LDB + c]); }
    }
}

typedef float f32x2 __attribute__((ext_vector_type(2)));
template <bool RED = true>
__device__ __forceinline__ void scan_step(f32x4& S, const f32x4 w, const f32x4 k, const f32x4 kk, const f32x4 nb, const f32x4 r, const float v, float& y) {
    const f32x2 S01 = {S[0], S[1]}, S23 = {S[2], S[3]};
    f32x2 pp = S01 * (f32x2){kk[0], kk[1]};
    pp = S23 * (f32x2){kk[2], kk[3]} + pp;
    float pd = pp[0] + pp[1];
    const f32x2 vv = {v, v};
    const f32x2 t01 = S01 * (f32x2){w[0], w[1]} + (f32x2){k[0], k[1]} * vv;
    const f32x2 t23 = S23 * (f32x2){w[2], w[3]} + (f32x2){k[2], k[3]} * vv;
    pd = allsum16(pd);
    const f32x2 pdv = {pd, pd};
    const f32x2 n01 = (f32x2){nb[0], nb[1]} * pdv + t01, n23 = (f32x2){nb[2], nb[3]} * pdv + t23;
    S = (f32x4){n01[0], n01[1], n23[0], n23[1]};
    f32x2 q = n01 * (f32x2){r[0], r[1]};
    q = n23 * (f32x2){r[2], r[3]} + q;
    y = RED ? allsum16(q[0] + q[1]) : (q[0] + q[1]);
}
__device__ __forceinline__ float reduce_scatter16(const float (&yp)[16], int cgi) {
    const bool b3 = cgi & 8, b2 = cgi & 4, b1 = cgi & 2, b0 = cgi & 1;
    float a[8], bq[4], c[2];
#pragma unroll
    for (int j = 0; j < 8; ++j) { const float keep = b3 ? yp[8 + j] : yp[j], send = b3 ? yp[j] : yp[8 + j]; a[j] = keep + dpp_f<0x128>(send); }
#pragma unroll
    for (int k = 0; k < 4; ++k) { const float keep = b2 ? a[4 + k] : a[k], send = b2 ? a[k] : a[4 + k]; bq[k] = keep + dpp_f<0x141>(send); }
#pragma unroll
    for (int m = 0; m < 2; ++m) { const float keep = b1 ? bq[2 + m] : bq[m], send = b1 ? bq[m] : bq[2 + m]; c[m] = keep + dpp_f<0x4E>(send); }
    const float keep = b0 ? c[1] : c[0], send = b0 ? c[0] : c[1];
    return keep + dpp_f<0xB1>(send);
}

__device__ void phase_scan(const Params& p, const Ctx cx, int pair, LAS unsigned char* lds) {
    const int tid = cx.tid, wid = tid >> 6, lane = tid & 63, rs = lane >> 4, cgi = lane & 15;
    const bf16_t* PB = (const bf16_t*)(PWS + WS_PROJB);
    const float* Wdec = (const float*)(PWS + WS_WDEC);
    const bf16_t* Aa = (const bf16_t*)(PWS + WS_AA);
    float* Y = (float*)(PWS + WS_Y);
    const float* mu = PIN(I_MU) + pair * 1664;
    const float* k_k = PIN(I_KK) + pair * 512; const float* k_a = PIN(I_KA) + pair * 512;
    {
        LAS float* vb = (LAS float*)lds + wid * 3072;
        for (int st = cx.bid * 8 + wid; st < 2048; st += cx.nblk * 8) {
            const int bh = st >> 1, half = st & 1, b = bh >> 3, h = bh & 7, ch = h * 64 + cgi * 4;
            const float* stp = PIN(I_SSHIFT) + ((size_t)pair * 128 + b) * 1664;
            const f32x4 kkc = *(const f32x4*)(k_k + ch), kac = *(const f32x4*)(k_a + ch);
            {
#pragma unroll
                for (int tt = 0; tt < 2; ++tt) {
                    const int t = rs + tt * 4;
                    const size_t row = NTP + b * 8 + t;
                    const bf16_t* cur = PB + row * LDB;
                    const f32x4 r = shift4(cur, t > 0, stp, ch, mu), k = shift4(cur, t > 0, stp, 512 + ch, mu), v = shift4(cur, t > 0, stp, 1024 + ch, mu);
                    const f32x4 a = ld_bf4(Aa + row * 512 + ch);
                    const f32x4 w = *(const f32x4*)(Wdec + row * 512 + ch);
                    const f32x4 kkv = k * kkc;
                    const float ss = allsum16(dot4(kkv, kkv));
                    const float inv = 1.0f / fmaxf(sqrtf(ss), 1e-12f);
                    const f32x4 kkn = kkv * inv;
                    LAS float* o = vb + t * 384 + cgi * 4;
                    *(LAS f32x4*)(o) = w; *(LAS f32x4*)(o + 64) = k * (1.0f + (a - 1.0f) * kac); *(LAS f32x4*)(o + 128) = kkn; *(LAS f32x4*)(o + 192) = -(kkn * a);
                    *(LAS f32x4*)(o + 256) = r; *(LAS f32x4*)(o + 320) = v;
                }
            }
            asm volatile("s_waitcnt lgkmcnt(0)" ::: "memory");
            __builtin_amdgcn_wave_barrier();
            const size_t so0 = ((((size_t)pair * 128 + b) * 8 + h) * 64 + half * 32 + rs) * 64 + cgi * 4;
            f32x4 Snext = *(const f32x4*)(PIN(I_SWKV) + so0);
#pragma unroll 1
            for (int rq = 0; rq < 8; ++rq) {
                const int ri = half * 32 + rq * 4 + rs;
                const size_t so = so0 + (size_t)rq * 256;
                f32x4 S = Snext;
                if (rq + 1 < 8) Snext = *(const f32x4*)(PIN(I_SWKV) + so + 256);
#pragma unroll
                for (int t = 0; t < 8; ++t) {
                    LAS const float* r0 = vb + t * 384 + cgi * 4;
                    float y; scan_step(S, *(LAS const f32x4*)(r0), *(LAS const f32x4*)(r0 + 64), *(LAS const f32x4*)(r0 + 128), *(LAS const f32x4*)(r0 + 192), *(LAS const f32x4*)(r0 + 256), vb[t * 384 + 320 + ri], y);
                    if (cgi == 0) Y[(size_t)(NTP + b * 8 + t) * 512 + h * 64 + ri] = y;
                }
                *(f32x4*)(POUT + O_WKVS + so) = S;
            }
            asm volatile("s_waitcnt lgkmcnt(0)" ::: "memory");
            __builtin_amdgcn_wave_barrier();
        }
    }
    __syncthreads();
    LAS float* rec = (LAS float*)lds;
    for (int pt = cx.bid; pt < 256; pt += cx.nblk) {
        const int xcd = pt & 7, slot = pt >> 3, bh = xcd * 8 + (slot >> 2), rg = slot & 3, b = bh >> 3, h = bh & 7;
        const int lt = tid - 256, ls = (lt >> 4) & 15, lcg = lt & 15, lch = h * 64 + lcg * 4;
        u32x2 qr = {0u, 0u}, qk = {0u, 0u}, qv = {0u, 0u}, pr = {0u, 0u}, pk = {0u, 0u}, pv = {0u, 0u}, qa = {0u, 0u};
        f32x4 qw = (f32x4){0.f, 0.f, 0.f, 0.f};
        f32x4 mur, muk, muv, kkc, kac;
        const int ri = rg * 16 + (wid & 3) * 4 + rs;
        f32x4 S = (f32x4){0.f, 0.f, 0.f, 0.f};
#define SCAN_ISSUE(c) do { const int t_ = (c) * 16 + ls; const size_t row_ = (size_t)b * 2048 + t_; const bf16_t* cur_ = PB + row_ * LDB; \
            qr = *(const u32x2*)(cur_ + lch); qk = *(const u32x2*)(cur_ + 512 + lch); qv = *(const u32x2*)(cur_ + 1024 + lch); \
            if (t_ > 0) { pr = *(const u32x2*)(cur_ - LDB + lch); pk = *(const u32x2*)(cur_ - LDB + 512 + lch); pv = *(const u32x2*)(cur_ - LDB + 1024 + lch); } \
            else { pr = (u32x2){0u, 0u}; pk = pr; pv = pr; } \
            qw = *(const f32x4*)(Wdec + row_ * 512 + lch); qa = *(const u32x2*)(Aa + row_ * 512 + lch); } while (0)
#define SCAN_PROCESS(buf) do { const f32x4 r0_ = cvt4(qr), k0_ = cvt4(qk), v0_ = cvt4(qv); \
            const f32x4 r_ = r0_ + mur * (cvt4(pr) - r0_), k_ = k0_ + muk * (cvt4(pk) - k0_), v_ = v0_ + muv * (cvt4(pv) - v0_), a_ = cvt4(qa); \
            const f32x4 kkv_ = k_ * kkc; const float ss_ = allsum16(dot4(kkv_, kkv_)); const float inv_ = __builtin_amdgcn_rsqf(fmaxf(ss_, 1e-24f)); \
            const f32x4 kkn_ = kkv_ * inv_; \
            LAS float* o_ = rec + (buf) * 6144 + ls * 384 + lcg * 4; \
            *(LAS f32x4*)(o_) = qw; *(LAS f32x4*)(o_ + 64) = k_ * (1.0f + (a_ - 1.0f) * kac); *(LAS f32x4*)(o_ + 128) = kkn_; *(LAS f32x4*)(o_ + 192) = -(kkn_ * a_); \
            *(LAS f32x4*)(o_ + 256) = r_; *(LAS f32x4*)(o_ + 320) = v_; } while (0)
        if (wid >= 4) {
            mur = *(const f32x4*)(mu + lch); muk = *(const f32x4*)(mu + 512 + lch); muv = *(const f32x4*)(mu + 1024 + lch);
            kkc = *(const f32x4*)(k_k + lch); kac = *(const f32x4*)(k_a + lch);
            SCAN_ISSUE(0); SCAN_PROCESS(0); SCAN_ISSUE(1);
        }
        __syncthreads();
        for (int c = 0; c < 128; ++c) {
            if (wid < 4) {
                LAS const float* rb = rec + (c & 1) * 6144 + cgi * 4;
                LAS const float* rv = rec + (c & 1) * 6144 + 320 + ri;
                float yp[16];
                f32x4 nw = *(LAS const f32x4*)(rb), nk = *(LAS const f32x4*)(rb + 64), nkk = *(LAS const f32x4*)(rb + 128), nb = *(LAS const f32x4*)(rb + 192), nr = *(LAS const f32x4*)(rb + 256);
                float nv = rv[0];
#pragma unroll
                for (int s = 0; s < 16; ++s) {
                    const f32x4 cw = nw, ck = nk, ckk = nkk, cb = nb, cr = nr; const float cv = nv;
                    if (s + 1 < 16) {
                        LAS const float* r1 = rb + (s + 1) * 384;
                        nw = *(LAS const f32x4*)(r1); nk = *(LAS const f32x4*)(r1 + 64); nkk = *(LAS const f32x4*)(r1 + 128); nb = *(LAS const f32x4*)(r1 + 192); nr = *(LAS const f32x4*)(r1 + 256);
                        nv = rv[(s + 1) * 384];
                    }
                    scan_step<false>(S, cw, ck, ckk, cb, cr, cv, yp[s]);
                }
                Y[((size_t)b * 2048 + c * 16 + cgi) * 512 + h * 64 + ri] = reduce_scatter16(yp, cgi);
            } else {
                if (c + 1 < 128) { SCAN_PROCESS((c + 1) & 1); if (c + 2 < 128) SCAN_ISSUE(c + 2); }
            }
            __syncthreads();
        }
        if (wid < 4) *(f32x4*)(POUT + O_WKVP + ((((size_t)pair * 8 + b) * 8 + h) * 64 + ri) * 64 + cgi * 4) = S;
#undef SCAN_ISSUE
#undef SCAN_PROCESS
    }
}

__device__ void phase_even_post(const Params& p, const Ctx cx, int pair) {
    const int gtid = cx.bid * 512 + cx.tid, gthreads = cx.nblk * 512;
    const bf16_t* PA = (const bf16_t*)(PWS + WS_R1);
    bf16_t* Ycat = (bf16_t*)(PWS + WS_YCAT);
    const float* Y = (const float*)(PWS + WS_Y);
    constexpr int NIT = NTOK * 128, UB = 4;
    const float* gn_g = PIN(I_GNG) + pair * 512; const float* gn_b = PIN(I_GNB) + pair * 512;
    for (int e0 = gtid; e0 < NIT; e0 += gthreads * UB) {
        f32x4 y[UB], bv[UB], bz[UB]; bool ok[UB];
#pragma unroll
        for (int u = 0; u < UB; ++u) {
            const int e = e0 + u * gthreads; ok[u] = e < NIT;
            const int ee = ok[u] ? e : e0; const int row = ee >> 7, ch = (ee & 127) * 4;
            y[u] = *(const f32x4*)(Y + (size_t)row * 512 + ch);
            bv[u] = ld_bf4(Ycat + (size_t)row * 1024 + 512 + ch);
            bz[u] = ld_bf4(PA + (size_t)row * LDA + 2048 + ch);
        }
#pragma unroll
        for (int u = 0; u < UB; ++u) {
            const int e = e0 + u * gthreads;
            const int ee = ok[u] ? e : e0; const int row = ee >> 7, ch = (ee & 127) * 4;
            const float mean = allsum16(y[u][0] + y[u][1] + y[u][2] + y[u][3]) * (1.0f / 64.0f);
            const f32x4 d = y[u] - mean;
            const float var = allsum16(dot4(d, d)) * (1.0f / 64.0f);
            const float rstd = rsqrtf(var + 64e-5f);
            const f32x4 g = *(const f32x4*)(gn_g + ch), bb = *(const f32x4*)(gn_b + ch);
            f32x4 o;
#pragma unroll
            for (int j = 0; j < 4; ++j) o[j] = (d[j] * rstd * g[j] + bb[j] + bv[u][j]) * siluf_(bz[u][j]);
            if (ok[u]) st_bf4(Ycat + (size_t)row * 1024 + 512 + ch, o);
        }
    }
    const float* cw = PIN(I_CONVW) + pair * 3 * 512;
    constexpr int NRUN = (NTOK / 8) * 128;
    for (int e = gtid; e < NRUN; e += gthreads) {
        const int run = e >> 7, ch = (e & 127) * 4, row0 = run * 8;
        const bool samp = row0 >= NTP;
        int b, t0, T; if (!samp) { b = row0 >> 11; t0 = row0 & 2047; T = 2048; } else { b = (row0 - NTP) >> 3; t0 = 0; T = 8; }
        const bf16_t* base = PA + (size_t)row0 * LDA + ch;
        u32x2 rh[10], rc[10], rb[8], rz[8];
#pragma unroll
        for (int k = 0; k < 10; ++k) {
            const bool have = (k >= 2) || (t0 > 0);
            const bf16_t* pr = have ? base + (ptrdiff_t)(k - 2) * LDA : base;
            rh[k] = *(const u32x2*)(pr); rc[k] = *(const u32x2*)(pr + 1024);
        }
#pragma unroll
        for (int k = 0; k < 8; ++k) { rb[k] = *(const u32x2*)(base + (size_t)k * LDA + 512); rz[k] = *(const u32x2*)(base + (size_t)k * LDA + 1536); }
        const f32x4 k0 = *(const f32x4*)(cw + ch), k1 = *(const f32x4*)(cw + 512 + ch), k2 = *(const f32x4*)(cw + 1024 + ch);
        f32x4 um2, um1;
        if (t0 > 0) { um2 = cvt4(rc[0]) * cvt4(rh[0]); um1 = cvt4(rc[1]) * cvt4(rh[1]); }
        else if (samp) { const float* hist = PIN(I_SCONV) + ((size_t)pair * 128 + b) * 2 * 512 + ch; um2 = *(const f32x4*)(hist); um1 = *(const f32x4*)(hist + 512); }
        else { um2 = (f32x4){0.f, 0.f, 0.f, 0.f}; um1 = um2; }
#pragma unroll
        for (int k = 0; k < 8; ++k) {
            const f32x4 u0 = cvt4(rc[k + 2]) * cvt4(rh[k + 2]);
            const f32x4 conv = k0 * um2 + k1 * um1 + k2 * u0;
            const f32x4 ab = cvt4(rb[k]), az = cvt4(rz[k]);
            f32x4 o;
#pragma unroll
            for (int j = 0; j < 4; ++j) o[j] = ab[j] * conv[j] * siluf_(az[j]);
            const int row = row0 + k, t = t0 + k;
            st_bf4(Ycat + (size_t)row * 1024 + ch, o);
            if (t >= T - 2) {
                float* dst = samp ? POUT + O_CONVS + (((size_t)pair * 128 + b) * 2 + (t - (T - 2))) * 512 + ch : POUT + O_CONVP + (((size_t)pair * 8 + b) * 2 + (t - (T - 2))) * 512 + ch;
                *(f32x4*)dst = u0;
            }
            um2 = um1; um1 = u0;
        }
    }
}

template <int W>
__device__ __forceinline__ void pool_sample_run(const float* __restrict__ hist, const bf16_t* __restrict__ cur, LAS bf16_t* out) {
    f32x4 ext[23];
#pragma unroll
    for (int k = 0; k < 15; ++k) ext[k] = (k >= 16 - W) ? *(const f32x4*)(hist + (size_t)k * 512) : (f32x4){0.f, 0.f, 0.f, 0.f};
#pragma unroll
    for (int k = 0; k < 8; ++k) ext[15 + k] = ld_bf4(cur + (size_t)k * LDA);
    f32x4 sum = (f32x4){0.f, 0.f, 0.f, 0.f};
#pragma unroll
    for (int d = 0; d < W; ++d) sum += ext[15 - d];
#pragma unroll
    for (int t = 0; t < 8; ++t) {
        if (t > 0) sum += ext[15 + t] - ext[15 + t - W];
        const f32x4 pooled = sum * (1.0f / (float)W) - ext[15 + t];
        u32x2 u; u.x = cvt_pk_bf16(pooled[0], pooled[1]); u.y = cvt_pk_bf16(pooled[2], pooled[3]);
        *(LAS u32x2*)(out + t * 136) = u;
    }
}

__device__ void phase_odd_mixer(const Params& p, const Ctx cx, int pair, LAS unsigned char* lds) {
    const int tid = cx.tid, wid = tid >> 6, lane = tid & 63, fr = lane & 15, fq = lane >> 4;
    const bf16_t* PO = (const bf16_t*)(PWS + WS_R1);
    bf16_t* Ycat = (bf16_t*)(PWS + WS_YCAT);
    LAS bf16_t* LA = (LAS bf16_t*)lds;
    LAS bf16_t* LB = (LAS bf16_t*)(lds + 128 * 136 * 2);
    LAS float* stat = (LAS float*)(lds + 2 * 128 * 136 * 2);
    LAS float* LE = (LAS float*)(lds + 128 * 136 * 2);
    LAS bf16_t* LW = (LAS bf16_t*)(lds + 128 * 136 * 2 + 143 * 128 * 4);
    for (int tile = cx.bid; tile < 136; tile += cx.nblk) {
        const int r0 = tile * 128;
        const bool samp = r0 >= NTP;
        const int tl_ = tid >> 2, q_ = tid & 3;
        {
            const bf16_t* vr = PO + (size_t)(r0 + tl_) * LDA + 1536 + q_ * 128;
            float s_ = 0.f, ss = 0.f;
#pragma unroll
            for (int i = 0; i < 16; ++i) { const u32x4 raw = *(const u32x4*)(vr + i * 8); const f32x4 v0 = cvt4((u32x2){raw.x, raw.y}), v1 = cvt4((u32x2){raw.z, raw.w});
                s_ += (v0[0] + v0[1]) + (v0[2] + v0[3]) + (v1[0] + v1[1]) + (v1[2] + v1[3]); ss += dot4(v0, v0) + dot4(v1, v1); }
            s_ = allsum4(s_); ss = allsum4(ss);
            const float mean = s_ * (1.0f / 512.0f);
            const float var = fmaxf(ss * (1.0f / 512.0f) - mean * mean, 0.f);
            if (q_ == 0) { stat[tl_ * 2] = mean; stat[tl_ * 2 + 1] = rsqrtf(var + 1e-5f); }
        }
        u32x2 rv[8]; u32x4 rw[4];
#define MIX_LOAD_G(gg) do { const bf16_t* vr_ = PO + (size_t)(r0 + tl_) * LDA + 1536 + (gg) * 128 + q_ * 32; \
            _Pragma("unroll") for (int i = 0; i < 8; ++i) rv[i] = *(const u32x2*)(vr_ + i * 4); \
            if (!samp) { const bf16_t* Ws_ = (const bf16_t*)(PWS + WS_SPW) + ((size_t)pair * 4 + (gg)) * 128 * 128; \
                _Pragma("unroll") for (int i = 0; i < 4; ++i) { const int e = tid + i * 512; rw[i] = *(const u32x4*)(Ws_ + (e >> 4) * 128 + (e & 15) * 8); } } } while (0)
        MIX_LOAD_G(0);
        __syncthreads();
#pragma unroll 1
        for (int g = 0; g < 4; ++g) {
            u32x2 ur[8], dzr[8];
#pragma unroll
            for (int nt = 0; nt < 8; ++nt) { const size_t o_ = (size_t)(r0 + wid * 16 + fr) * LDA + g * 128 + nt * 16 + fq * 4; ur[nt] = *(const u32x2*)(PO + o_ + 1024); dzr[nt] = *(const u32x2*)(PO + o_ + 2048); }
            {
                const int row = r0 + tl_;
                const float mean = stat[tl_ * 2], rstd = stat[tl_ * 2 + 1];
                const float* lg = PIN(I_LNG) + pair * 512 + g * 128 + q_ * 32; const float* lb = PIN(I_LNB) + pair * 512 + g * 128 + q_ * 32;
#pragma unroll
                for (int i = 0; i < 8; ++i) {
                    const f32x4 v = cvt4(rv[i]);
                    const f32x4 vn = (v - mean) * rstd * *(const f32x4*)(lg + i * 4) + *(const f32x4*)(lb + i * 4);
                    if (samp) *(f32x4*)(POUT + O_CHUNKV + ((size_t)pair * 1024 + (row - NTP)) * 512 + g * 128 + q_ * 32 + i * 4) = vn;
#pragma unroll
                    for (int j = 0; j < 4; ++j) LB[(q_ * 32 + i * 4 + j) * 136 + tl_] = (bf16_t)(cvt_pk_bf16(vn[j], 0.f) & 0xffffu);
                }
            }
            if (!samp) {
#pragma unroll
                for (int i = 0; i < 4; ++i) { const int e = tid + i * 512; *(LAS u32x4*)(LA + (e >> 4) * 136 + (e & 15) * 8) = rw[i]; }
            } else {
                const float* Wsrc = PIN(I_SPW) + ((size_t)pair * 4 + g) * 128 * 128;
                LAS float* w8 = stat + 256;
                if (tid < 64) w8[tid] = Wsrc[(tid >> 3) * 128 + (tid & 7)];
                __syncthreads();
                for (int e = tid; e < 128 * 128; e += 512) { const int t = e >> 7, s2 = e & 127;
                    const float v = ((t >> 3) == (s2 >> 3) && (s2 & 7) <= (t & 7)) ? w8[(t & 7) * 8 + (s2 & 7)] : 0.f;
                    LA[t * 136 + s2] = (bf16_t)(cvt_pk_bf16(v, 0.f) & 0xffffu); }
            }
            if (g + 1 < 4) MIX_LOAD_G(g + 1);
            __syncthreads();
            {
                const int tl = wid * 16 + fr, row = r0 + tl;
                const float bias = PIN(I_SPB)[((size_t)pair * 4 + g) * 128 + (samp ? (tl & 7) : tl)];
                bf16x8 wf[4];
#pragma unroll
                for (int ks = 0; ks < 4; ++ks) wf[ks] = *(const LAS bf16x8*)(LA + tl * 136 + ks * 32 + fq * 8);
#pragma unroll
                for (int nt = 0; nt < 8; ++nt) {
                    f32x4 acc = (f32x4){0.f, 0.f, 0.f, 0.f};
#pragma unroll
                    for (int ks = 0; ks < 4; ++ks) {
                        if (ks * 32 <= wid * 16 + 15) {
                            const bf16x8 vf = *(const LAS bf16x8*)(LB + (nt * 16 + fr) * 136 + ks * 32 + fq * 8);
                            acc = __builtin_amdgcn_mfma_f32_16x16x32_bf16(vf, wf[ks], acc, 0, 0, 0);
                        }
                    }
                    const int c = g * 128 + nt * 16 + fq * 4;
                    const f32x4 u = cvt4(ur[nt]), dz = cvt4(dzr[nt]);
                    f32x4 o;
#pragma unroll
                    for (int j = 0; j < 4; ++j) o[j] = u[j] * (acc[j] + bias) * siluf_(dz[j]);
                    st_bf4(Ycat + (size_t)row * 1024 + 512 + c, o);
                }
            }
            __syncthreads();
        }
#undef MIX_LOAD_G
    }
    {
        int ci, cstride;
        if (cx.nblk == 256) { if (cx.bid < 136) { ci = cx.bid; cstride = 1 << 20; } else { ci = cx.bid; cstride = 120; } }
        else { ci = cx.bid; cstride = cx.nblk; }
        u32x4 pw[4]; u32x2 pe[9];
#define MIX_LOAD_C(cc) do { const int tile_ = (cc) >> 2, g_ = (cc) & 3, r0_ = tile_ * 128; \
            const bf16_t* Bw_ = (const bf16_t*)(PWS + WS_POOLWT) + ((size_t)pair * 4 + g_) * 128 * 128; \
            _Pragma("unroll") for (int i = 0; i < 4; ++i) { const int e = tid + i * 512; pw[i] = *(const u32x4*)(Bw_ + (e >> 4) * 128 + (e & 15) * 8); } \
            if (r0_ < NTP) { const int t0_ = r0_ & 2047; \
                _Pragma("unroll") for (int i = 0; i < 9; ++i) { const int e = tid + i * 512, er = e >> 5, c = (e & 31) * 4; pe[i] = (u32x2){0u, 0u}; \
                    if (e < 143 * 32 && t0_ + er - 15 >= 0) pe[i] = *(const u32x2*)(PO + (size_t)(r0_ + er - 15) * LDA + g_ * 128 + c); } } } while (0)
        if (ci < 544) MIX_LOAD_C(ci);
        for (; ci < 544; ci += cstride) {
            const int tile = ci >> 2, g = ci & 3, r0 = tile * 128;
            const bool samp = r0 >= NTP;
            const int w = 2 << g;
            const int row = r0 + wid * 16 + fr;
            u32x2 czr[8]; f32x4 psr[8];
#pragma unroll
            for (int nt = 0; nt < 8; ++nt) { const int d = g * 128 + nt * 16 + fq * 4; czr[nt] = *(const u32x2*)(PO + (size_t)row * LDA + 512 + d); psr[nt] = *(const f32x4*)(PIN(I_PSCALE) + pair * 512 + d); }
#pragma unroll
            for (int i = 0; i < 4; ++i) { const int e = tid + i * 512; *(LAS u32x4*)(LW + (e >> 4) * 136 + (e & 15) * 8) = pw[i]; }
            if (!samp) {
                const int t0 = r0 & 2047;
#pragma unroll
                for (int i = 0; i < 9; ++i) { const int e = tid + i * 512, er = e >> 5, c = (e & 31) * 4; if (e < 143 * 32) *(LAS f32x4*)(LE + er * 128 + c) = cvt4(pe[i]); }
                __syncthreads();
                {
                    const int c = (tid & 31) * 4, tl0 = (tid >> 5) * 8;
                    f32x4 sum = (f32x4){0.f, 0.f, 0.f, 0.f};
#pragma unroll 4
                    for (int d = 0; d < w; ++d) sum += *(LAS const f32x4*)(LE + (tl0 + 15 - d) * 128 + c);
#pragma unroll
                    for (int k = 0; k < 8; ++k) {
                        const int tl = tl0 + k;
                        const f32x4 pt = *(LAS const f32x4*)(LE + (tl + 15) * 128 + c);
                        if (k > 0) sum += pt - *(LAS const f32x4*)(LE + (tl + 15 - w) * 128 + c);
                        const float cnt = fminf((float)w, (float)(t0 + tl + 1));
                        const f32x4 pooled = sum * (1.0f / cnt) - pt;
                        u32x2 u; u.x = cvt_pk_bf16(pooled[0], pooled[1]); u.y = cvt_pk_bf16(pooled[2], pooled[3]);
                        *(LAS u32x2*)(LA + tl * 136 + c) = u;
                    }
                }
            } else {
                const int sq = tid >> 5, c = (tid & 31) * 4, bb = (r0 - NTP) / 8 + sq;
                const float* hist = PIN(I_SPOOL) + ((size_t)pair * 128 + bb) * 15 * 512 + g * 128 + c;
                const bf16_t* cur = PO + (size_t)(r0 + sq * 8) * LDA + g * 128 + c;
                LAS bf16_t* out = LA + (sq * 8) * 136 + c;
                if (g == 0) pool_sample_run<2>(hist, cur, out); else if (g == 1) pool_sample_run<4>(hist, cur, out);
                else if (g == 2) pool_sample_run<8>(hist, cur, out); else pool_sample_run<16>(hist, cur, out);
            }
            if (ci + cstride < 544) MIX_LOAD_C(ci + cstride);
            __syncthreads();
            bf16x8 af[4];
#pragma unroll
            for (int ks = 0; ks < 4; ++ks) af[ks] = *(const LAS bf16x8*)(LA + (wid * 16 + fr) * 136 + ks * 32 + fq * 8);
#pragma unroll
            for (int nt = 0; nt < 8; ++nt) {
                f32x4 acc = (f32x4){0.f, 0.f, 0.f, 0.f};
#pragma unroll
                for (int ks = 0; ks < 4; ++ks) {
                    const bf16x8 bf = *(const LAS bf16x8*)(LW + (nt * 16 + fr) * 136 + ks * 32 + fq * 8);
                    acc = __builtin_amdgcn_mfma_f32_16x16x32_bf16(bf, af[ks], acc, 0, 0, 0);
                }
                const int d = g * 128 + nt * 16 + fq * 4;
                const f32x4 cz = cvt4(czr[nt]), ps = psr[nt];
                f32x4 o;
#pragma unroll
                for (int j = 0; j < 4; ++j) o[j] = acc[j] * ps[j] * siluf_(cz[j]);
                st_bf4(Ycat + (size_t)row * 1024 + d, o);
            }
            __syncthreads();
        }
#undef MIX_LOAD_C
    }
    const int gtid = cx.bid * 512 + tid, gthreads = cx.nblk * 512;
    for (int e = gtid; e < 136 * 15 * 128; e += gthreads) {
        const int c = (e & 127) * 4, q = e >> 7, sr = q / 15, k = q - sr * 15;
        if (sr < 8) *(f32x4*)(POUT + O_POOLP + (((size_t)pair * 8 + sr) * 15 + k) * 512 + c) = ld_bf4(PO + (size_t)(sr * 2048 + 2033 + k) * LDA + c);
        else { const int b = sr - 8;
            *(f32x4*)(POUT + O_POOLS + (((size_t)pair * 128 + b) * 15 + k) * 512 + c) = (k < 7) ? *(const f32x4*)(PIN(I_SPOOL) + (((size_t)pair * 128 + b) * 15 + 8 + k) * 512 + c) : ld_bf4(PO + (size_t)(NTP + b * 8 + (k - 7)) * LDA + c); }
    }
}

__device__ void phase_final(const Params& p, const Ctx cx) {
    const int gtid = cx.bid * 512 + cx.tid, gthreads = cx.nblk * 512;
    const float* ssq = (const float*)(PWS + WS_SSQ) + (size_t)4 * NTOK * 16;
    const bf16_t* Xb = (const bf16_t*)(PWS + WS_XB);
    constexpr int NIT = NTOK * 256, UB = 4;
    for (int e0 = gtid; e0 < NIT; e0 += gthreads * UB) {
        f32x4 x[UB]; float sq[UB]; bool ok[UB];
#pragma unroll
        for (int u = 0; u < UB; ++u) { const int e = e0 + u * gthreads; ok[u] = e < NIT; const int ee = ok[u] ? e : e0; const int row = ee >> 8, c = (ee & 255) * 4;
            x[u] = ld_bf4(Xb + (size_t)row * 1024 + c); sq[u] = ssq_sum(ssq + (size_t)row * 16); }
#pragma unroll
        for (int u = 0; u < UB; ++u) { const int e = e0 + u * gthreads; const int ee = ok[u] ? e : e0; const int row = ee >> 8, c = (ee & 255) * 4;
            const float rstd = rsqrtf(sq[u] * (1.0f / 1024.0f) + 1e-6f);
            if (ok[u]) *(f32x4*)(POUT + (size_t)row * 1024 + c) = x[u] * rstd * *(const f32x4*)(PIN(I_FNORMW) + c); }
    }
}

#define XB_TMO      128
#define XB_XCNT(j)  (256  + 64 * (j))
#define XB_XSUB(j)  (1280 + 64 * (j))
#define XB_XGEN(j)  (2304 + 64 * (j))
#define XB_TOP      3328
#define XB_TOPGEN   3392
#define XCD_BAR_WORDS 3456
#define XB_SPIN_CAP (1u << 18)
__device__ __forceinline__ unsigned xb_ld(unsigned* p)              { return __hip_atomic_load(p, __ATOMIC_RELAXED, __HIP_MEMORY_SCOPE_AGENT); }
__device__ __forceinline__ unsigned xb_add(unsigned* p, unsigned v) { return __hip_atomic_fetch_add(p, v, __ATOMIC_RELAXED, __HIP_MEMORY_SCOPE_AGENT); }
__device__ __forceinline__ unsigned xb_xcc_id() { return (unsigned)__builtin_amdgcn_s_getreg((3 << 11) | 20) & 0xFu; }
#define XB_SPIN(cond, bar) do { unsigned _sp = 0; while (cond) { __builtin_amdgcn_s_sleep(1); \
    if ((++_sp & 255u) == 0u) { if (xb_ld(&(bar)[XB_TMO])) break; if (_sp > XB_SPIN_CAP) { atomicAdd(&(bar)[XB_TMO], 1u); break; } } } } while (0)
struct XcdBarrier { unsigned* bar; unsigned x; volatile LAS unsigned* st; };
__device__ __forceinline__ XcdBarrier xcd_barrier_post(unsigned* bar, volatile LAS unsigned* st) {
    XcdBarrier b; b.bar = bar; b.x = xb_xcc_id(); b.st = st;
    if (threadIdx.x == 0) (void)xb_add(&bar[XB_XCNT(b.x)], 1u);
    return b;
}
__device__ __forceinline__ void xcd_barrier_complete(unsigned* bar, unsigned x, unsigned& nloc, unsigned& nx) {
    const unsigned G = gridDim.x * gridDim.y * gridDim.z;
    unsigned sum, cnt, mine, sp = 0u;
    for (;;) {
        sum = 0u; cnt = 0u; mine = 0u;
#pragma unroll
        for (unsigned j = 0; j < 16; ++j) { const unsigned c = xb_ld(&bar[XB_XCNT(j)]); sum += c; cnt += (c > 0u) ? 1u : 0u; mine = (j == x) ? c : mine; }
        if (sum == G) break;
        __builtin_amdgcn_s_sleep(1);
        if ((++sp & 255u) == 0u) { if (xb_ld(&bar[XB_TMO])) break; if (sp > XB_SPIN_CAP) { atomicAdd(&bar[XB_TMO], 1u); break; } }
    }
    nloc = mine > 0u ? mine : 1u; nx = cnt > 0u ? cnt : 1u;
}
__device__ __forceinline__ void xcd_barrier(const XcdBarrier& b) {
    asm volatile("s_waitcnt vmcnt(0)" ::: "memory");
    __syncthreads();
    if (threadIdx.x == 0) {
        unsigned* bar = b.bar;
        __builtin_amdgcn_s_waitcnt(0);
        unsigned nloc = b.st[0], nx = b.st[1];
        if (nloc == 0u) { xcd_barrier_complete(bar, b.x, nloc, nx); b.st[0] = nloc; b.st[1] = nx; }
        const unsigned old = xb_add(&bar[XB_XSUB(b.x)], 1u);
        const unsigned gen = old / nloc;
        if (old + 1u == (gen + 1u) * nloc) {
            __builtin_amdgcn_fence(__ATOMIC_RELEASE, "agent");
            asm volatile("s_waitcnt vmcnt(0)" ::: "memory");
            const unsigned og = xb_add(&bar[XB_TOP], 1u);
            const unsigned tg = og / nx;
            if (og + 1u == (tg + 1u) * nx) xb_add(&bar[XB_TOPGEN], 1u);
            else XB_SPIN(xb_ld(&bar[XB_TOPGEN]) == tg, bar);
            __builtin_amdgcn_fence(__ATOMIC_ACQUIRE, "agent");
            xb_add(&bar[XB_XGEN(b.x)], 1u);
            asm volatile("s_waitcnt vmcnt(0)" ::: "memory");
        } else {
            XB_SPIN(xb_ld(&bar[XB_XGEN(b.x)]) == gen, bar);
            __builtin_amdgcn_fence(__ATOMIC_ACQUIRE, "agent");
            asm volatile("s_waitcnt vmcnt(0)" ::: "memory");
        }
    }
    __syncthreads();
}

__device__ void run_gemm_proj(const Params& p, const Ctx cx, LAS unsigned char* lds, const bf16_t* Bt, int N, bf16_t* O, int ldc, int layer) {
    pg8::Gemm g{(const bf16_t*)(PWS + WS_XB), Bt, NTOK, N, 1024};
    pg8::StaticOrder S; S.init(NTOK, N, (int)cx.nblk, (int)cx.bid);
    const float* ssq = (const float*)(PWS + WS_SSQ) + (size_t)layer * NTOK * 16;
    LAS float* rl = (LAS float*)(lds + 131072);
    int pm0 = -1, pm1 = -1, pm2 = -1, pm3 = -1, np = 0;
    for (int i = 0; i < 64; ++i) {
        pg8::Unit u; if (!S.next(i, u)) break;
        if (u.pm == pm0 || u.pm == pm1 || u.pm == pm2 || u.pm == pm3) continue;
        if (np == 0) pm0 = u.pm; else if (np == 1) pm1 = u.pm; else if (np == 2) pm2 = u.pm; else pm3 = u.pm;
        ++np;
    }
    for (int r = cx.tid; r < np * 256; r += 512) {
        const int i = r >> 8, pm = i == 0 ? pm0 : (i == 1 ? pm1 : (i == 2 ? pm2 : pm3));
        rl[r] = rsqrtf(ssq_sum(ssq + (size_t)(pm * 256 + (r & 255)) * 16) * (1.0f / 1024.0f) + 1e-6f);
    }
    __syncthreads();
    EpiProj E{O, ldc, rl, pm0, pm1, pm2, pm3};
    pg8::gemm_phase<EpiProj>(cx, lds, g, S, E);
}
__device__ void run_gemm_res(const Params& p, const Ctx cx, LAS unsigned char* lds, const bf16_t* Bt, int layer) {
    const bf16_t* A = (const bf16_t*)(PWS + WS_YCAT);
    bf16_t* Xb = (bf16_t*)(PWS + WS_XB);
    float* ssqn = (float*)(PWS + WS_SSQ) + (size_t)(layer + 1) * NTOK * 16;
    pg8::Gemm g{A, Bt, NTOK, 1024, 1024};
    pg8::StaticOrder S; S.init(NTOK, 1024, (int)cx.nblk, (int)cx.bid);
    EpiRes E{layer == 0 ? PIN(I_XP) : nullptr, PIN(I_XS), Xb, ssqn};
    pg8::gemm_phase<EpiRes>(cx, lds, g, S, E);
}

constexpr int N_PHASES = 20;
#ifndef PHMASK
#define PHMASK 0xffff
#endif
#define PHON(n) ((PHMASK >> ((n) % 16)) & 1)
__global__ void __launch_bounds__(512, 2) fwd_kernel(Params p) {
    extern __shared__ __attribute__((aligned(16))) unsigned char lds_raw[];
    LAS unsigned char* lds = (LAS unsigned char*)lds_raw;
    volatile LAS unsigned* bar_st = (volatile LAS unsigned*)(lds + LDS_MAIN);
    if (threadIdx.x < 4) bar_st[threadIdx.x] = 0u;
    __syncthreads();
    const XcdBarrier gbar = xcd_barrier_post((unsigned*)((unsigned char*)p.ptr[30] + WS_BAR), bar_st);
    if (p.ph_hi < 0) cg::this_grid().sync();
#define GRID_SYNC() xcd_barrier(gbar)
#ifdef SYNCPROBE
    for (int i = 0; i < SYNCPROBE; ++i) GRID_SYNC();
#endif
#ifdef REPMASK
    for (int pc = p.ph_lo * 2; pc < p.ph_hi * 2; ++pc) {
        const int ph = pc >> 1;
        { const int s_ = (ph == 0) ? 9 : (ph == N_PHASES - 1) ? 31 : (ph - 1) % 9; if ((pc & 1) && !((REPMASK >> s_) & 1)) continue; }
        if (pc > p.ph_lo * 2) GRID_SYNC();
#else
    for (int ph = p.ph_lo; ph < p.ph_hi; ++ph) {
        if (ph > p.ph_lo) GRID_SYNC();
#endif
        Ctx cx; cx.tid = threadIdx.x; cx.bid = blockIdx.x; cx.nblk = gridDim.x;
        asm volatile("s_mov_b32 %0, 0" : "=s"(cx.z));
        asm volatile("" : "+v"(cx.tid)); asm volatile("" : "+s"(cx.bid)); asm volatile("" : "+s"(cx.nblk));
        const int pair = (ph - 1) / 9, s = (ph == 0) ? 100 : (ph == N_PHASES - 1 ? 101 : (ph - 1) % 9);
        if (s == 0 || s == 3 || s == 6) {
#if PHON(0)
            const bf16_t* WinE = (const bf16_t*)(PWS + WS_WINE) + (size_t)pair * 4352 * 1024;
            const bf16_t* Bt = s == 0 ? WinE + (size_t)2560 * 1024 : (s == 3 ? WinE : (const bf16_t*)(PWS + WS_WINO) + (size_t)pair * 2560 * 1024);
            const int N = s == 0 ? 1792 : 2560;
            run_gemm_proj(p, cx, lds, Bt, N, (bf16_t*)(PWS + WS_R1), N, 2 * pair + (s == 6 ? 1 : 0));
#endif
        } else if (s == 5 || s == 8) {
#if PHON(5)
            const bf16_t* Bt = (const bf16_t*)(PWS + (s == 5 ? WS_WOUTE : WS_WOUTO)) + (size_t)pair * 1024 * 1024;
            run_gemm_res(p, cx, lds, Bt, 2 * pair + (s == 8 ? 1 : 0));
#endif
        } else if (s == 1) {
#if PHON(1)
            phase_even_prep(p, cx, pair, lds);
#endif
        } else if (s == 2) {
#if PHON(2)
            phase_scan(p, cx, pair, lds);
#endif
        } else if (s == 4) {
#if PHON(4)
            phase_even_post(p, cx, pair);
#endif
        } else if (s == 7) {
#if PHON(7)
            phase_odd_mixer(p, cx, pair, lds);
#endif
        } else if (s == 100) {
#if PHON(10)
            phase_prepass(p, cx, lds);
#endif
        } else {
#if PHON(11)
            phase_final(p, cx);
#endif
        }
    }
}

extern "C" void kernel_launch(void* const* d_in, const int* in_sizes, int n_in, void* d_out, int out_size, void* d_ws, size_t ws_size, hipStream_t stream) {
    static int grid = 0;
    if (grid == 0) {
        if (n_in != 29 || ws_size < WS_END) { fprintf(stderr, "kernel_launch: unexpected n_in %d / ws_size %zu (need %zu)\n", n_in, ws_size, (size_t)WS_END); grid = -1; return; }
        int dev = 0, cus = 0, per_cu = 0;
        hipGetDevice(&dev);
        hipDeviceGetAttribute(&cus, hipDeviceAttributeMultiprocessorCount, dev);
        if (hipFuncSetAttribute((const void*)fwd_kernel, hipFuncAttributeMaxDynamicSharedMemorySize, LDS_BYTES) != hipSuccess) { fprintf(stderr, "kernel_launch: hipFuncSetAttribute failed\n"); grid = -1; return; }
        if (hipOccupancyMaxActiveBlocksPerMultiprocessor(&per_cu, (const void*)fwd_kernel, 512, LDS_BYTES) != hipSuccess || per_cu < 1) { fprintf(stderr, "kernel_launch: occupancy query gave %d\n", per_cu); per_cu = 1; }
        (void)hipGetLastError();
        grid = cus * per_cu;
        if (grid > 256) grid = 256;
    }
    if (grid < 0) return;
    Params p{};
    for (int i = 0; i < 29; ++i) p.ptr[i] = d_in[i];
    p.ptr[29] = d_out; p.ptr[30] = d_ws; p.ptr[31] = nullptr;
    (void)hipMemsetAsync((unsigned char*)d_ws + WS_BAR, 0, 16384, stream);
#if ONE_LAUNCH
    p.ph_lo = 0; p.ph_hi = N_PHASES;
    void* args[] = {&p};
    hipError_t e = hipLaunchCooperativeKernel((const void*)fwd_kernel, dim3(grid), dim3(512), args, LDS_BYTES, stream);
    if (e != hipSuccess) fprintf(stderr, "cooperative launch failed: %s (grid %d)\n", hipGetErrorString(e), grid);
#else
    for (int ph = 0; ph < N_PHASES; ++ph) {
        p.ph_lo = ph; p.ph_hi = ph + 1;
        hipLaunchKernelGGL(fwd_kernel, dim3(grid), dim3(512), LDS_BYTES, stream, p);
    }
#endif
}
```

```cpp
#include <hip/hip_runtime.h>
#include <hip/hip_cooperative_groups.h>
#include <cstdio>
namespace cg = cooperative_groups;

#ifndef ONE_LAUNCH
#define ONE_LAUNCH 1
#endif

#define LAS __attribute__((address_space(3)))
typedef unsigned short bf16_t;
typedef short bf16x8 __attribute__((ext_vector_type(8)));
typedef float f32x4 __attribute__((ext_vector_type(4)));
typedef unsigned u32x4 __attribute__((ext_vector_type(4)));
typedef unsigned u32x2 __attribute__((ext_vector_type(2)));

constexpr int NTOK = 17408, NTP = 16384;
constexpr int LDB = 1792;
constexpr int LDA = 2560;
constexpr size_t O_CONVP = 17825792, O_CONVS = 17842176, O_SHIFTP = 18104320, O_SHIFTS = 18130944, O_WKVP = 18556928, O_WKVS = 19081216,
                 O_POOLP = 27469824, O_POOLS = 27592704, O_CHUNKV = 29558784;
constexpr size_t WS_WINE = 0;
constexpr size_t WS_WOUTE = WS_WINE + 2ull * 4352 * 1024 * 2;
constexpr size_t WS_WINO = WS_WOUTE + 2ull * 1024 * 1024 * 2;
constexpr size_t WS_WOUTO = WS_WINO + 2ull * 2560 * 1024 * 2;
constexpr size_t WS_W2T = WS_WOUTO + 2ull * 1024 * 1024 * 2;
constexpr size_t WS_A2T = WS_W2T + 2ull * 512 * 64 * 2;
constexpr size_t WS_POOLWT = WS_A2T + 2ull * 512 * 64 * 2;
constexpr size_t WS_SPW = WS_POOLWT + 8ull * 128 * 128 * 2;
constexpr size_t WS_XB = WS_SPW + 8ull * 128 * 128 * 2;
constexpr size_t WS_YCAT = WS_XB + (size_t)NTOK * 1024 * 2;
constexpr size_t WS_SSQ = WS_YCAT + (size_t)NTOK * 1024 * 2;
constexpr size_t WS_Y = WS_SSQ + 5ull * NTOK * 16 * 4;
constexpr size_t WS_R1 = WS_Y + (size_t)NTOK * 512 * 4;
constexpr size_t WS_PROJB = WS_R1;
constexpr size_t WS_WDEC = WS_PROJB + (size_t)NTOK * LDB * 2;
constexpr size_t WS_AA = WS_WDEC + (size_t)NTOK * 512 * 4;
constexpr size_t WS_BAR = WS_AA + (size_t)NTOK * 512 * 2;
constexpr size_t WS_END = WS_BAR + 16384;
constexpr int LDS_MAIN = 147456;
constexpr int LDS_BYTES = LDS_MAIN + 16;

struct Params {
    const void* ptr[32];
    int ph_lo, ph_hi;
};
struct Ctx { int tid, bid, nblk, z; };
#define PIN(i) ((const float*)p.ptr[(i) + cx.z])
#define POUT ((float*)p.ptr[29 + cx.z])
#define PWS ((unsigned char*)p.ptr[30 + cx.z])
enum { I_XP = 0, I_XS, I_SCONV, I_SSHIFT, I_SWKV, I_SPOOL, I_NORMW, I_FNORMW, I_WINE, I_CONVW, I_MU, I_W0, I_W2, I_A0, I_A2, I_KK, I_KA, I_RK, I_GNG, I_GNB,
       I_WOUTE, I_WINO, I_POOLW, I_PSCALE, I_LNG, I_LNB, I_SPW, I_SPB, I_WOUTO };

__device__ __forceinline__ unsigned cvt_pk_bf16(float lo, float hi) { unsigned r; asm("v_cvt_pk_bf16_f32 %0, %1, %2" : "=v"(r) : "v"(lo), "v"(hi)); return r; }
__device__ __forceinline__ float bf_lo(unsigned u) { return __uint_as_float(u << 16); }
__device__ __forceinline__ float bf_hi(unsigned u) { return __uint_as_float(u & 0xffff0000u); }
__device__ __forceinline__ float bf2f(bf16_t b) { return __uint_as_float(((unsigned)b) << 16); }
__device__ __forceinline__ f32x4 cvt4(u32x2 u) { return (f32x4){bf_lo(u.x), bf_hi(u.x), bf_lo(u.y), bf_hi(u.y)}; }
__device__ __forceinline__ f32x4 ld_bf4(const bf16_t* p) { return cvt4(*(const u32x2*)p); }
__device__ __forceinline__ void st_bf4(bf16_t* p, f32x4 v) { u32x2 u; u.x = cvt_pk_bf16(v[0], v[1]); u.y = cvt_pk_bf16(v[2], v[3]); *(u32x2*)p = u; }
__device__ __forceinline__ float sigmoidf_(float x) { return 1.0f / (1.0f + __expf(-x)); }
__device__ __forceinline__ float siluf_(float x) { return x / (1.0f + __expf(-x)); }
template <int CTRL> __device__ __forceinline__ float dpp_f(float x) { return __builtin_bit_cast(float, __builtin_amdgcn_mov_dpp(__builtin_bit_cast(int, x), CTRL, 0xf, 0xf, true)); }
__device__ __forceinline__ float allsum16(float x) { x += dpp_f<0xB1>(x); x += dpp_f<0x4E>(x); x += dpp_f<0x141>(x); x += dpp_f<0x128>(x); return x; }
__device__ __forceinline__ float allsum4(float x) { x += dpp_f<0xB1>(x); x += dpp_f<0x4E>(x); return x; }
__device__ __forceinline__ float dot4(f32x4 a, f32x4 b) { return a[0] * b[0] + a[1] * b[1] + a[2] * b[2] + a[3] * b[3]; }

__device__ __forceinline__ float ssq_sum(const float* part) {
    const f32x4 a = *(const f32x4*)(part), b = *(const f32x4*)(part + 4), c = *(const f32x4*)(part + 8), d = *(const f32x4*)(part + 12);
    return ((a[0] + a[1]) + (a[2] + a[3])) + ((b[0] + b[1]) + (b[2] + b[3])) + ((c[0] + c[1]) + (c[2] + c[3])) + ((d[0] + d[1]) + (d[2] + d[3]));
}

namespace pg8 {
constexpr int BM = 256, BK = 64, HALF = 128, HTB = HALF * BK * 2, NXCD = 8, WGM = 8;
__device__ __forceinline__ int lds_byte(int r, int c) { const int st = (r >> 4) * 2 + (c >> 5), rr = r & 15, cc = c & 31, ob = rr * 64 + cc * 2; return st * 1024 + (ob ^ (((ob >> 9) & 1) << 5)); }
__device__ __forceinline__ void stage_rc(int b, int& R, int& C) { const int st = b / 1024, sb = b % 1024, swz = sb ^ (((sb >> 9) & 1) << 5); R = (st >> 1) * 16 + swz / 64; C = (st & 1) * 32 + (swz % 64) / 2; }
__device__ __forceinline__ int perm32(int rho) { const int n = rho >> 4, i = rho & 15; return 8 * (i >> 2) + 4 * n + (i & 3); }
struct Unit { int pm, pn; };
struct Gemm { const bf16_t* A; const bf16_t* Bt; int M, N, K; };
struct StaticOrder {
    int nM, nN, nwg, G, c;
    __device__ void init(int M, int N, int G_, int c_) { nM = M / BM; nN = N / BM; nwg = nM * nN; G = G_; c = c_; }
    __device__ bool next(int i, Unit& u) const {
        const long L = (long)i * G + c; if (L >= nwg) return false;
        int wgid = (int)L; { const int q = nwg / NXCD, r = nwg % NXCD, xcd = wgid % NXCD, off = wgid / NXCD; wgid = (xcd < r ? xcd * (q + 1) : r * (q + 1) + (xcd - r) * q) + off; }
        const int nig = WGM * nN, gid = wgid / nig, fm = gid * WGM, gsz = (nM - fm) < WGM ? (nM - fm) : WGM;
        u.pm = fm + ((wgid % nig) % gsz); u.pn = (wgid % nig) / gsz; return true;
    }
};

template <class Epi>
__device__ __forceinline__ void gemm_phase(const Ctx cx, LAS unsigned char* lds, const Gemm g, const StaticOrder& S, const Epi& E) {
    const int tid = cx.tid, wid = __builtin_amdgcn_readfirstlane(tid >> 6), lane = tid & 63, wr = wid >> 2, wc = wid & 3, fr = lane & 15, fq = lane >> 4;
    const int K = g.K, nt = K / BK;
    unsigned voffA[2], voffB[2];
#pragma unroll
    for (int i = 0; i < 2; ++i) { int R, C; stage_rc(tid * 16 + i * 8192, R, C); const int Rb = Epi::PERM ? ((R & ~31) + perm32(R & 31)) : R;
        voffA[i] = (unsigned)(R * K + C) * 2u; voffB[i] = (unsigned)(Rb * K + C) * 2u; }
    const size_t kstep = (size_t)(BK * 2);
    const size_t hstep = (size_t)HALF * K * 2;
    const size_t tstep = 2 * hstep;
    const unsigned ldsw = (unsigned)wid * 1024u;
    const int aoff = lds_byte(wr * 64 + fr, fq * 8), boff = lds_byte(wc * 32 + fr, fq * 8);
#define PG8_SA(b, h) (((b) * 2 + (h)) * HTB)
#define PG8_SB(b, h) ((4 + (b) * 2 + (h)) * HTB)
#define PG8_STAGE(bufoff, gbase, voff) do { _Pragma("unroll") for (int _i = 0; _i < 2; ++_i) \
        __builtin_amdgcn_global_load_lds((const unsigned*)((const char*)(gbase) + (voff)[_i]), (LAS unsigned*)(lds + (bufoff) + ldsw + _i * 8192), 16, 0, 0); } while (0)
#define PG8_LDA(dst, b, h) do { _Pragma("unroll") for (int m = 0; m < 4; ++m) _Pragma("unroll") for (int k = 0; k < 2; ++k) dst[m][k] = *(const LAS bf16x8*)(lds + PG8_SA(b, h) + aoff + m * 2048 + k * 1024); } while (0)
#define PG8_LDB(dst, b, h) do { _Pragma("unroll") for (int n = 0; n < 2; ++n) _Pragma("unroll") for (int k = 0; k < 2; ++k) dst[n][k] = *(const LAS bf16x8*)(lds + PG8_SB(b, h) + boff + n * 2048 + k * 1024); } while (0)
#define PG8_MMA(ai, bj, At, Bt) do { __builtin_amdgcn_s_setprio(1); _Pragma("unroll") for (int m = 0; m < 4; ++m) _Pragma("unroll") for (int n = 0; n < 2; ++n) _Pragma("unroll") for (int k = 0; k < 2; ++k) \
        acc[ai][bj][m][n] = __builtin_amdgcn_mfma_f32_16x16x32_bf16(Bt[n][k], At[m][k], acc[ai][bj][m][n], 0, 0, 0); __builtin_amdgcn_s_setprio(0); } while (0)
#define PG8_WAIT_V(n) asm volatile("s_waitcnt vmcnt(" #n ")" ::: "memory")
#define PG8_WAIT_L(n) asm volatile("s_waitcnt lgkmcnt(" #n ")" ::: "memory")
#define PG8_BAR __builtin_amdgcn_s_barrier()
#define PG8_SCHED __builtin_amdgcn_sched_barrier(0)
    Unit cur, nxt; int ui = 0;
    if (!S.next(0, cur)) return;
    f32x4 acc[2][2][4][2];
#pragma unroll
    for (int a = 0; a < 2; ++a)
#pragma unroll
        for (int b = 0; b < 2; ++b)
#pragma unroll
            for (int m = 0; m < 4; ++m)
#pragma unroll
                for (int n = 0; n < 2; ++n) acc[a][b][m][n] = (f32x4){0.f, 0.f, 0.f, 0.f};
    bf16x8 At[4][2], B0[2][2], B1[2][2];
    const char* cA = (const char*)g.A + (size_t)cur.pm * tstep; const char* cB = (const char*)g.Bt + (size_t)cur.pn * tstep;
    PG8_STAGE(PG8_SB(0, 0), cB, voffB); PG8_STAGE(PG8_SA(0, 0), cA, voffA); PG8_STAGE(PG8_SB(0, 1), cB + hstep, voffB); PG8_STAGE(PG8_SA(0, 1), cA + hstep, voffA);
    if (wr == 1) PG8_BAR;
    PG8_WAIT_V(4); PG8_BAR;
    PG8_STAGE(PG8_SB(1, 0), cB + kstep, voffB); PG8_STAGE(PG8_SA(1, 0), cA + kstep, voffA); PG8_STAGE(PG8_SB(1, 1), cB + hstep + kstep, voffB);
    PG8_WAIT_V(6); PG8_BAR;
    for (;;) {
        const bool has_next = S.next(ui + 1, nxt);
        const char* nA = has_next ? (const char*)g.A + (size_t)nxt.pm * tstep : cA; const char* nB = has_next ? (const char*)g.Bt + (size_t)nxt.pn * tstep : cB;
        for (int t = 0; t < nt; t += 2) {
            const bool last = (t == nt - 2);
            const char* a1 = cA + (size_t)(t + 1) * kstep;
            const char* a2 = last ? nA : cA + (size_t)(t + 2) * kstep; const char* b2 = last ? nB : cB + (size_t)(t + 2) * kstep;
            const char* a3 = a2 + kstep; const char* b3 = b2 + kstep;
            PG8_LDB(B0, 0, 0); PG8_SCHED; PG8_LDA(At, 0, 0); PG8_STAGE(PG8_SA(1, 1), a1 + hstep, voffA);
            PG8_WAIT_L(8); PG8_BAR; PG8_WAIT_L(0); PG8_MMA(0, 0, At, B0); PG8_BAR; PG8_SCHED;
            PG8_LDB(B1, 0, 1); PG8_STAGE(PG8_SB(0, 0), b2, voffB);
            PG8_BAR; PG8_WAIT_L(0); PG8_MMA(0, 1, At, B1); PG8_BAR;
            PG8_LDA(At, 0, 1); PG8_STAGE(PG8_SA(0, 0), a2, voffA);
            PG8_BAR; PG8_WAIT_L(0); PG8_MMA(1, 0, At, B0); PG8_BAR; PG8_SCHED;
            PG8_STAGE(PG8_SB(0, 1), b2 + hstep, voffB);
            PG8_WAIT_V(6); PG8_BAR; PG8_MMA(1, 1, At, B1); PG8_BAR;
            PG8_LDB(B0, 1, 0); PG8_SCHED; PG8_LDA(At, 1, 0); PG8_STAGE(PG8_SA(0, 1), a2 + hstep, voffA);
            PG8_WAIT_L(8); PG8_BAR; PG8_WAIT_L(0); PG8_MMA(0, 0, At, B0); PG8_BAR; PG8_SCHED;
            PG8_LDB(B1, 1, 1); PG8_STAGE(PG8_SB(1, 0), b3, voffB);
            PG8_BAR; PG8_WAIT_L(0); PG8_MMA(0, 1, At, B1); PG8_BAR;
            PG8_LDA(At, 1, 1); PG8_STAGE(PG8_SA(1, 0), a3, voffA);
            PG8_BAR; PG8_WAIT_L(0); PG8_MMA(1, 0, At, B0); PG8_BAR; PG8_SCHED;
            PG8_STAGE(PG8_SB(1, 1), b3 + hstep, voffB);
            PG8_WAIT_V(6); PG8_BAR; PG8_MMA(1, 1, At, B1); PG8_BAR;
        }
        E(acc, cur, wr, wc, fr, fq);
        if (!has_next) break;
#pragma unroll
        for (int a = 0; a < 2; ++a)
#pragma unroll
            for (int b = 0; b < 2; ++b)
#pragma unroll
                for (int m = 0; m < 4; ++m)
#pragma unroll
                    for (int n = 0; n < 2; ++n) acc[a][b][m][n] = (f32x4){0.f, 0.f, 0.f, 0.f};
        cur = nxt; cA = nA; cB = nB; ++ui;
    }
    PG8_WAIT_V(0);
    if (wr == 0) PG8_BAR;
    PG8_BAR;
#undef PG8_SA
#undef PG8_SB
#undef PG8_STAGE
#undef PG8_LDA
#undef PG8_LDB
#undef PG8_MMA
#undef PG8_WAIT_V
#undef PG8_WAIT_L
#undef PG8_BAR
#undef PG8_SCHED
}
}

struct EpiProj {
    static constexpr bool PERM = true;
    bf16_t* O; int ldc; LAS const float* rl; int pm0, pm1, pm2, pm3;
    __device__ __forceinline__ void operator()(const f32x4 (&acc)[2][2][4][2], const pg8::Unit& u, int wr, int wc, int fr, int fq) const {
        const int row0 = u.pm * 256 + wr * 64 + fr, col0 = u.pn * 256 + wc * 32 + 8 * fq;
        const int sel = u.pm == pm0 ? 0 : (u.pm == pm1 ? 1 : (u.pm == pm2 ? 2 : 3));
        LAS const float* rp = rl + sel * 256 + wr * 64 + fr;
#pragma unroll
        for (int ai = 0; ai < 2; ++ai)
#pragma unroll
            for (int m = 0; m < 4; ++m) {
                const int row = row0 + ai * 128 + m * 16;
                const float rstd = rp[ai * 128 + m * 16];
                bf16_t* rowp = O + (size_t)row * ldc + col0;
#pragma unroll
                for (int bj = 0; bj < 2; ++bj) {
                    const f32x4 v0 = acc[ai][bj][m][0] * rstd, v1 = acc[ai][bj][m][1] * rstd;
                    u32x4 w; w.x = cvt_pk_bf16(v0[0], v0[1]); w.y = cvt_pk_bf16(v0[2], v0[3]); w.z = cvt_pk_bf16(v1[0], v1[1]); w.w = cvt_pk_bf16(v1[2], v1[3]);
                    *(u32x4*)(rowp + bj * 128) = w;
                }
            }
    }
};
struct X8 { f32x4 lo, hi; };
template <bool FIRST> __device__ __forceinline__ X8 ld_x8(const float* __restrict__ s32, const bf16_t* __restrict__ s16, size_t o) {
    X8 r;
    if (FIRST) { r.lo = *(const f32x4*)(s32 + o); r.hi = *(const f32x4*)(s32 + o + 4); }
    else { const u32x4 u = *(const u32x4*)(s16 + o); r.lo = cvt4((u32x2){u.x, u.y}); r.hi = cvt4((u32x2){u.z, u.w}); }
    return r;
}
__device__ __forceinline__ void st_x8(bf16_t* p, f32x4 lo, f32x4 hi) { u32x4 w; w.x = cvt_pk_bf16(lo[0], lo[1]); w.y = cvt_pk_bf16(lo[2], lo[3]); w.z = cvt_pk_bf16(hi[0], hi[1]); w.w = cvt_pk_bf16(hi[2], hi[3]); *(u32x4*)p = w; }
template <bool FIRST>
__device__ __forceinline__ void epi_res_rows(const f32x4 (&acc)[2][2][4][2], const float* __restrict__ src32, const bf16_t* __restrict__ src16, bf16_t* __restrict__ Xb, float* __restrict__ ssqp,
                                             int row0, int col0, int slot, int fq) {
    if constexpr (FIRST) {
#pragma unroll
        for (int ai = 0; ai < 2; ++ai) {
            X8 x[4][2];
#pragma unroll
            for (int m = 0; m < 4; ++m)
#pragma unroll
                for (int bj = 0; bj < 2; ++bj) x[m][bj] = ld_x8<true>(src32, src16, (size_t)(row0 + ai * 128 + m * 16) * 1024 + col0 + bj * 128);
#pragma unroll
            for (int m = 0; m < 4; ++m) {
                const int row = row0 + ai * 128 + m * 16;
                float part = 0.f;
#pragma unroll
                for (int bj = 0; bj < 2; ++bj) {
                    const f32x4 lo = x[m][bj].lo + acc[ai][bj][m][0], hi = x[m][bj].hi + acc[ai][bj][m][1];
                    st_x8(Xb + (size_t)row * 1024 + col0 + bj * 128, lo, hi);
                    part += dot4(lo, lo) + dot4(hi, hi);
                }
                part += __shfl_xor(part, 16); part += __shfl_xor(part, 32);
                if (fq == 0) ssqp[(size_t)row * 16 + slot] = part;
            }
        }
    } else {
        u32x4 xr[2][4][2];
#pragma unroll
        for (int ai = 0; ai < 2; ++ai)
#pragma unroll
            for (int m = 0; m < 4; ++m)
#pragma unroll
                for (int bj = 0; bj < 2; ++bj) xr[ai][m][bj] = *(const u32x4*)(src16 + (size_t)(row0 + ai * 128 + m * 16) * 1024 + col0 + bj * 128);
#pragma unroll
        for (int ai = 0; ai < 2; ++ai)
#pragma unroll
            for (int m = 0; m < 4; ++m) {
                const int row = row0 + ai * 128 + m * 16;
                float part = 0.f;
#pragma unroll
                for (int bj = 0; bj < 2; ++bj) {
                    const u32x4 u = xr[ai][m][bj];
                    const f32x4 lo = cvt4((u32x2){u.x, u.y}) + acc[ai][bj][m][0], hi = cvt4((u32x2){u.z, u.w}) + acc[ai][bj][m][1];
                    st_x8(Xb + (size_t)row * 1024 + col0 + bj * 128, lo, hi);
                    part += dot4(lo, lo) + dot4(hi, hi);
                }
                part += __shfl_xor(part, 16); part += __shfl_xor(part, 32);
                if (fq == 0) ssqp[(size_t)row * 16 + slot] = part;
            }
    }
}
struct EpiRes {
    static constexpr bool PERM = true;
    const float* xp; const float* xs; bf16_t* Xb; float* ssq_next;
    __device__ __forceinline__ void operator()(const f32x4 (&acc)[2][2][4][2], const pg8::Unit& u, int wr, int wc, int fr, int fq) const {
        const int row0 = u.pm * 256 + wr * 64 + fr, col0 = u.pn * 256 + wc * 32 + 8 * fq;
        if (xp) epi_res_rows<true>(acc, row0 < NTP ? xp : xs - (size_t)NTP * 1024, nullptr, Xb, ssq_next, row0, col0, u.pn * 4 + wc, fq);
        else epi_res_rows<false>(acc, nullptr, Xb, Xb, ssq_next, row0, col0, u.pn * 4 + wc, fq);
    }
};

template <bool FIRST>
__device__ __forceinline__ void res_sample_tile(const Ctx cx, const bf16_t* __restrict__ A, const bf16_t* __restrict__ Bt, const float* __restrict__ xs, bf16_t* __restrict__ Xb, float* __restrict__ ssqp, int tile) {
    const int tid = cx.tid, wid = tid >> 6, lane = tid & 63, fr = lane & 15, fq = lane >> 4;
    const int tm = tile >> 3, tn = tile & 7;
    const int r0 = NTP + tm * 64 + (wid & 3) * 16, c0 = tn * 128 + (wid >> 2) * 64;
    const bf16_t* ap = A + (size_t)(r0 + fr) * 1024 + fq * 8;
    const bf16_t* bp = Bt + (size_t)(c0 + fr) * 1024 + fq * 8;
    f32x4 acc[4];
#pragma unroll
    for (int nt = 0; nt < 4; ++nt) acc[nt] = (f32x4){0.f, 0.f, 0.f, 0.f};
#pragma unroll 8
    for (int ks = 0; ks < 32; ++ks) {
        const bf16x8 af = *(const bf16x8*)(ap + ks * 32);
#pragma unroll
        for (int nt = 0; nt < 4; ++nt) {
            const bf16x8 bf = *(const bf16x8*)(bp + (size_t)nt * 16 * 1024 + ks * 32);
            acc[nt] = __builtin_amdgcn_mfma_f32_16x16x32_bf16(bf, af, acc[nt], 0, 0, 0);
        }
    }
    const int row = r0 + fr;
    float part = 0.f;
#pragma unroll
    for (int nt = 0; nt < 4; ++nt) {
        const int col = c0 + nt * 16 + fq * 4;
        const f32x4 xo = FIRST ? *(const f32x4*)(xs + (size_t)(row - NTP) * 1024 + col) : ld_bf4(Xb + (size_t)row * 1024 + col);
        const f32x4 v = xo + acc[nt];
        st_bf4(Xb + (size_t)row * 1024 + col, v);
        part += dot4(v, v);
    }
    part += __shfl_xor(part, 16); part += __shfl_xor(part, 32);
    if (fq == 0) ssqp[(size_t)row * 16 + (c0 >> 6)] = part;
}

struct TrJob { const float* src; int ld, col0, k0; bf16_t* dst; int Ktot, drow0; const float* scale; bool zero; };
__device__ __forceinline__ TrJob tr_decode(const Params& p, const Ctx cx, int job) {
    TrJob J; J.zero = false; J.scale = nullptr;
    int j = job;
    if (j < 2176) {
        const int i = j / 1088, r = j % 1088, nt = r / 16, kt = r % 16, n0 = nt * 64;
        int col0 = 0;
        if (n0 < 2048) col0 = n0; else if (n0 < 2560) col0 = 3712 + (n0 - 2048); else if (n0 < 4224) col0 = 2048 + (n0 - 2560); else J.zero = true;
        J.src = PIN(I_WINE) + (size_t)i * 1024 * 4224; J.ld = 4224; J.col0 = col0; J.k0 = kt * 64; J.dst = (bf16_t*)(PWS + WS_WINE) + (size_t)i * 4352 * 1024; J.Ktot = 1024; J.drow0 = n0; J.scale = PIN(I_NORMW) + (2 * i) * 1024;
        return J;
    }
    j -= 2176;
    if (j < 512) { const int i = j / 256, r = j % 256, nt = r / 16, kt = r % 16;
        J.src = PIN(I_WOUTE) + (size_t)i * 1024 * 1024; J.ld = 1024; J.col0 = nt * 64; J.k0 = kt * 64; J.dst = (bf16_t*)(PWS + WS_WOUTE) + (size_t)i * 1024 * 1024; J.Ktot = 1024; J.drow0 = nt * 64; return J; }
    j -= 512;
    if (j < 1280) { const int i = j / 640, r = j % 640, nt = r / 16, kt = r % 16;
        J.src = PIN(I_WINO) + (size_t)i * 1024 * 2560; J.ld = 2560; J.col0 = nt * 64; J.k0 = kt * 64; J.dst = (bf16_t*)(PWS + WS_WINO) + (size_t)i * 2560 * 1024; J.Ktot = 1024; J.drow0 = nt * 64; J.scale = PIN(I_NORMW) + (2 * i + 1) * 1024; return J; }
    j -= 1280;
    if (j < 512) { const int i = j / 256, r = j % 256, nt = r / 16, kt = r % 16;
        J.src = PIN(I_WOUTO) + (size_t)i * 1024 * 1024; J.ld = 1024; J.col0 = nt * 64; J.k0 = kt * 64; J.dst = (bf16_t*)(PWS + WS_WOUTO) + (size_t)i * 1024 * 1024; J.Ktot = 1024; J.drow0 = nt * 64; return J; }
    j -= 512;
    if (j < 16) { const int i = j / 8, nt = j % 8;
        J.src = PIN(I_W2) + (size_t)i * 64 * 512; J.ld = 512; J.col0 = nt * 64; J.k0 = 0; J.dst = (bf16_t*)(PWS + WS_W2T) + (size_t)i * 512 * 64; J.Ktot = 64; J.drow0 = nt * 64; return J; }
    j -= 16;
    if (j < 16) { const int i = j / 8, nt = j % 8;
        J.src = PIN(I_A2) + (size_t)i * 64 * 512; J.ld = 512; J.col0 = nt * 64; J.k0 = 0; J.dst = (bf16_t*)(PWS + WS_A2T) + (size_t)i * 512 * 64; J.Ktot = 64; J.drow0 = nt * 64; return J; }
    j -= 16;
    { const int ig = j / 4, r = j % 4, nt = r / 2, kt = r % 2;
        J.src = PIN(I_POOLW) + (size_t)ig * 128 * 128; J.ld = 128; J.col0 = nt * 64; J.k0 = kt * 64; J.dst = (bf16_t*)(PWS + WS_POOLWT) + (size_t)ig * 128 * 128; J.Ktot = 128; J.drow0 = nt * 64; }
    return J;
}
__device__ __forceinline__ void tr_load(const TrJob& J, int tid, f32x4& va, f32x4& vb) {
    const int nn = (tid & 15) * 4, ka = tid >> 4, kb = ka + 32;
    va = (f32x4){0.f, 0.f, 0.f, 0.f}; vb = va;
    if (!J.zero) {
        va = *(const f32x4*)(J.src + (size_t)(J.k0 + ka) * J.ld + J.col0 + nn); vb = *(const f32x4*)(J.src + (size_t)(J.k0 + kb) * J.ld + J.col0 + nn);
        if (J.scale) { va = va * J.scale[J.k0 + ka]; vb = vb * J.scale[J.k0 + kb]; }
    }
}

__device__ void phase_prepass(const Params& p, const Ctx cx, LAS unsigned char* lds) {
    LAS float* T = (LAS float*)lds;
    const int tid = cx.tid;
    {
        int job = cx.bid;
        f32x4 va = (f32x4){0.f, 0.f, 0.f, 0.f}, vb = va;
        if (job < 4544) { const TrJob J0 = tr_decode(p, cx, job); tr_load(J0, tid, va, vb); }
        for (; job < 4544; job += cx.nblk) {
            f32x4 na = va, nb = vb;
            if (job + (int)cx.nblk < 4544) { const TrJob Jn = tr_decode(p, cx, job + (int)cx.nblk); tr_load(Jn, tid, na, nb); }
            {
                const int nn = (tid & 15) * 4, ka = tid >> 4, kb = ka + 32;
                T[ka * 65 + nn] = va[0]; T[ka * 65 + nn + 1] = va[1]; T[ka * 65 + nn + 2] = va[2]; T[ka * 65 + nn + 3] = va[3];
                T[kb * 65 + nn] = vb[0]; T[kb * 65 + nn + 1] = vb[1]; T[kb * 65 + nn + 2] = vb[2]; T[kb * 65 + nn + 3] = vb[3];
            }
            __syncthreads();
            {
                const TrJob J = tr_decode(p, cx, job);
                const int n = tid >> 3, kc = (tid & 7) * 8;
                u32x4 w;
                w.x = cvt_pk_bf16(T[(kc + 0) * 65 + n], T[(kc + 1) * 65 + n]); w.y = cvt_pk_bf16(T[(kc + 2) * 65 + n], T[(kc + 3) * 65 + n]);
                w.z = cvt_pk_bf16(T[(kc + 4) * 65 + n], T[(kc + 5) * 65 + n]); w.w = cvt_pk_bf16(T[(kc + 6) * 65 + n], T[(kc + 7) * 65 + n]);
                *(u32x4*)(J.dst + (size_t)(J.drow0 + n) * J.Ktot + J.k0 + kc) = w;
            }
            __syncthreads();
            va = na; vb = nb;
        }
    }
    const int gtid = cx.bid * 512 + tid, gthreads = cx.nblk * 512;
    for (int e = gtid; e < 8 * 128 * 128; e += gthreads) {
        const int s = e & 127, t = (e >> 7) & 127;
        ((bf16_t*)(PWS + WS_SPW))[e] = (s <= t) ? (bf16_t)(cvt_pk_bf16(PIN(I_SPW)[e], 0.f) & 0xffffu) : (bf16_t)0;
    }
    const int wid = tid >> 6, lane = tid & 63;
    for (int row0 = cx.bid * 8 + wid; row0 < NTOK; row0 += cx.nblk * 8 * 3) {
        f32x4 v[3][4];
#pragma unroll
        for (int r = 0; r < 3; ++r) {
            const int row = row0 + r * cx.nblk * 8; const int rr = row < NTOK ? row : row0;
            const float* src = rr < NTP ? PIN(I_XP) + (size_t)rr * 1024 : PIN(I_XS) + (size_t)(rr - NTP) * 1024;
#pragma unroll
            for (int i = 0; i < 4; ++i) v[r][i] = *(const f32x4*)(src + i * 256 + lane * 4);
        }
#pragma unroll
        for (int r = 0; r < 3; ++r) {
            const int row = row0 + r * cx.nblk * 8;
            if (row < NTOK) {
                bf16_t* dst = (bf16_t*)(PWS + WS_XB) + (size_t)row * 1024;
                float ss = 0.f;
#pragma unroll
                for (int i = 0; i < 4; ++i) { ss += dot4(v[r][i], v[r][i]); st_bf4(dst + i * 256 + lane * 4, v[r][i]); }
#pragma unroll
                for (int o = 32; o >= 1; o >>= 1) ss += __shfl_xor(ss, o);
                if (lane < 16) ((float*)(PWS + WS_SSQ))[(size_t)row * 16 + lane] = (lane == 0) ? ss : 0.f;
            }
        }
    }
}

__device__ __forceinline__ f32x4 shift4(const bf16_t* cur, bool hp, const float* st, int col, const float* mu) {
    const f32x4 q = ld_bf4(cur + col);
    f32x4 pv;
    if (hp) pv = ld_bf4(cur - LDB + col); else if (st) pv = *(const f32x4*)(st + col); else pv = (f32x4){0.f, 0.f, 0.f, 0.f};
    const f32x4 m = *(const f32x4*)(mu + col);
    return q + m * (pv - q);
}

__device__ void phase_even_prep(const Params& p, const Ctx cx, int pair, LAS unsigned char* lds) {
    const int tid = cx.tid, wid = tid >> 6, lane = tid & 63, fr = lane & 15, fq = lane >> 4;
    const bf16_t* PB = (const bf16_t*)(PWS + WS_PROJB);
    float* Wdec = (float*)(PWS + WS_WDEC);
    bf16_t* Aa = (bf16_t*)(PWS + WS_AA);
    bf16_t* Ycat = (bf16_t*)(PWS + WS_YCAT);
    const float* mu_ = PIN(I_MU) + pair * 1664;
    const float* w0_ = PIN(I_W0) + pair * 512; const float* a0_ = PIN(I_A0) + pair * 512;
    const float* k_a_ = PIN(I_KA) + pair * 512; const float* r_k_ = PIN(I_RK) + pair * 512;
    constexpr int RS = 3344;
    constexpr int TB = 17 * RS;
    constexpr int NCH = 17 * 208;
    const int h = wid;
    bf16x8 wfr[4][2], afr[4][2];
    {
        const bf16_t* W2T = (const bf16_t*)(PWS + WS_W2T) + (size_t)pair * 512 * 64;
        const bf16_t* A2T = (const bf16_t*)(PWS + WS_A2T) + (size_t)pair * 512 * 64;
#pragma unroll
        for (int nt = 0; nt < 4; ++nt)
#pragma unroll
            for (int ks = 0; ks < 2; ++ks) {
                wfr[nt][ks] = *(const bf16x8*)(W2T + (size_t)(h * 64 + nt * 16 + fr) * 64 + ks * 32 + fq * 8);
                afr[nt][ks] = *(const bf16x8*)(A2T + (size_t)(h * 64 + nt * 16 + fr) * 64 + ks * 32 + fq * 8);
            }
    }
    constexpr int TBD = 56 * 1024;
    const int widu = __builtin_amdgcn_readfirstlane(tid >> 6);
#define PREP_DMA(tile_, b_, lane_) do { _Pragma("unroll") for (int i_ = 0; i_ < 7; ++i_) { const int k_ = widu * 7 + i_, q_ = k_ * 64 + (lane_); \
            int lr_ = q_ / 209, cc_ = q_ - lr_ * 209; if (lr_ > 16) { lr_ = 16; cc_ = 0; } if (cc_ > 207) cc_ = 0; \
            int gr_ = (tile_) * 16 - 1 + lr_; gr_ = gr_ < 0 ? 0 : gr_; \
            __builtin_amdgcn_global_load_lds((const unsigned*)(PB + (size_t)gr_ * LDB + cc_ * 8), (LAS unsigned*)(lds + (b_) * TBD + k_ * 1024), 16, 0, 0); } } while (0)
    int buf = 0;
    if ((int)cx.bid < NTOK / 16) PREP_DMA((int)cx.bid, 0, tid & 63);
    asm volatile("s_waitcnt vmcnt(0)" ::: "memory");
    __syncthreads();
    for (int tile = cx.bid; tile < NTOK / 16; tile += cx.nblk) {
        int zz; asm volatile("v_mov_b32 %0, 0" : "=v"(zz));
        const int tidv = tid + zz, fr = (tidv & 15), fq = (tidv >> 4) & 3;
        if (tile + (int)cx.nblk < NTOK / 16) PREP_DMA(tile + (int)cx.nblk, buf ^ 1, tidv & 63);
        {
            const int row = tile * 16 + fr;
            const bool samp = row >= NTP;
            int b, t; if (!samp) { b = row >> 11; t = row & 2047; } else { const int q = row - NTP; b = q >> 3; t = q & 7; }
            const bool hp = t > 0;
            const float* st = samp ? PIN(I_SSHIFT) + ((size_t)pair * 128 + b) * 1664 : nullptr;
            const float* mu = mu_ + zz; const float* w0 = w0_ + zz; const float* a0 = a0_ + zz; const float* k_a = k_a_ + zz; const float* r_k = r_k_ + zz;
            LAS const unsigned char* curL = lds + buf * TBD + (fr + 1) * RS;
            LAS const unsigned char* prvL = lds + buf * TBD + fr * RS;
            auto sh4 = [&](int col) -> f32x4 {
                const f32x4 q = cvt4(*(LAS const u32x2*)(curL + col * 2));
                f32x4 pv;
                if (hp) pv = cvt4(*(LAS const u32x2*)(prvL + col * 2)); else if (st) pv = *(const f32x4*)(st + col); else pv = (f32x4){0.f, 0.f, 0.f, 0.f};
                const f32x4 m = *(const f32x4*)(mu + col);
                return q + m * (pv - q);
            };
            bf16x8 Aw[2], Al[2];
#pragma unroll
            for (int ks = 0; ks < 2; ++ks) {
                const int cw = 1536 + ks * 32 + fq * 8, ca = 1600 + ks * 32 + fq * 8;
                const f32x4 w_lo = sh4(cw), w_hi = sh4(cw + 4), a_lo = sh4(ca), a_hi = sh4(ca + 4);
                u32x4 pw, pa;
                float th[8];
#pragma unroll
                for (int j = 0; j < 4; ++j) { th[j] = 2.0f * sigmoidf_(2.0f * w_lo[j]) - 1.0f; th[4 + j] = 2.0f * sigmoidf_(2.0f * w_hi[j]) - 1.0f; }
                pw.x = cvt_pk_bf16(th[0], th[1]); pw.y = cvt_pk_bf16(th[2], th[3]); pw.z = cvt_pk_bf16(th[4], th[5]); pw.w = cvt_pk_bf16(th[6], th[7]);
                pa.x = cvt_pk_bf16(a_lo[0], a_lo[1]); pa.y = cvt_pk_bf16(a_lo[2], a_lo[3]); pa.z = cvt_pk_bf16(a_hi[0], a_hi[1]); pa.w = cvt_pk_bf16(a_hi[2], a_hi[3]);
                Aw[ks] = __builtin_bit_cast(bf16x8, pw); Al[ks] = __builtin_bit_cast(bf16x8, pa);
            }
            float bon = 0.f;
#pragma unroll
            for (int nt = 0; nt < 4; ++nt) {
                f32x4 lw = (f32x4){0.f, 0.f, 0.f, 0.f}, la = (f32x4){0.f, 0.f, 0.f, 0.f};
#pragma unroll
                for (int ks = 0; ks < 2; ++ks) {
                    lw = __builtin_amdgcn_mfma_f32_16x16x32_bf16(wfr[nt][ks], Aw[ks], lw, 0, 0, 0);
                    la = __builtin_amdgcn_mfma_f32_16x16x32_bf16(afr[nt][ks], Al[ks], la, 0, 0, 0);
                }
                const int ch = h * 64 + nt * 16 + fq * 4;
                const f32x4 r4 = sh4(ch), k4 = sh4(512 + ch);
                const f32x4 w04 = *(const f32x4*)(w0 + ch), a04 = *(const f32x4*)(a0 + ch), ka4 = *(const f32x4*)(k_a + ch), rk4 = *(const f32x4*)(r_k + ch);
                f32x4 dec, av;
#pragma unroll
                for (int j = 0; j < 4; ++j) {
                    const float z_ = -(w04[j] + lw[j]);
                    const float wlog = -__logf(1.0f + __expf(z_)) - 0.5f;
                    dec[j] = __expf(-__expf(wlog));
                    av[j] = sigmoidf_(a04[j] + la[j]);
                    const float kp = k4[j] * (1.0f + (av[j] - 1.0f) * ka4[j]);
                    bon += r4[j] * kp * rk4[j];
                }
                *(f32x4*)(Wdec + (size_t)row * 512 + ch) = dec;
                st_bf4(Aa + (size_t)row * 512 + ch, av);
            }
            bon += __shfl_xor(bon, 16); bon += __shfl_xor(bon, 32);
#pragma unroll
            for (int nt = 0; nt < 4; ++nt) { const int ch = h * 64 + nt * 16 + fq * 4; st_bf4(Ycat + (size_t)row * 1024 + 512 + ch, sh4(1024 + ch) * bon); }
        }
        asm volatile("s_waitcnt vmcnt(0)" ::: "memory");
        __syncthreads();
        buf ^= 1;
    }
#undef PREP_DMA
    const int gtid = cx.bid * 512 + tid, gthreads = cx.nblk * 512;
    for (int e = gtid; e < 136 * 1664; e += gthreads) {
        const int sr = e / 1664, c = e % 1664;
        if (sr < 8) POUT[O_SHIFTP + ((size_t)pair * 8 + sr) * 1664 + c] = bf2f(PB[(size_t)(sr * 2048 + 2047) * LDB + c]);
        else { const int b = sr - 8; POUT[O_SHIFTS + ((size_t)pair * 128 + b) * 1664 + c] = bf2f(PB[(size_t)(NTP + b * 8 + 7) * LDB + c]); }
    }
}

typedef float f32x2 __attribute__((ext_vector_type(2)));
template <bool RED = true>
__device__ __forceinline__ void scan_step(f32x4& S, const f32x4 w, const f32x4 k, const f32x4 kk, const f32x4 nb, const f32x4 r, const float v, float& y) {
    const f32x2 S01 = {S[0], S[1]}, S23 = {S[2], S[3]};
    f32x2 pp = S01 * (f32x2){kk[0], kk[1]};
    pp = S23 * (f32x2){kk[2], kk[3]} + pp;
    float pd = pp[0] + pp[1];
    const f32x2 vv = {v, v};
    const f32x2 t01 = S01 * (f32x2){w[0], w[1]} + (f32x2){k[0], k[1]} * vv;
    const f32x2 t23 = S23 * (f32x2){w[2], w[3]} + (f32x2){k[2], k[3]} * vv;
    pd = allsum16(pd);
    const f32x2 pdv = {pd, pd};
    const f32x2 n01 = (f32x2){nb[0], nb[1]} * pdv + t01, n23 = (f32x2){nb[2], nb[3]} * pdv + t23;
    S = (f32x4){n01[0], n01[1], n23[0], n23[1]};
    f32x2 q = n01 * (f32x2){r[0], r[1]};
    q = n23 * (f32x2){r[2], r[3]} + q;
    y = RED ? allsum16(q[0] + q[1]) : (q[0] + q[1]);
}
__device__ __forceinline__ float reduce_scatter16(const float (&yp)[16], int cgi) {
    const bool b3 = cgi & 8, b2 = cgi & 4, b1 = cgi & 2, b0 = cgi & 1;
    float a[8], bq[4], c[2];
#pragma unroll
    for (int j = 0; j < 8; ++j) { const float keep = b3 ? yp[8 + j] : yp[j], send = b3 ? yp[j] : yp[8 + j]; a[j] = keep + dpp_f<0x128>(send); }
#pragma unroll
    for (int k = 0; k < 4; ++k) { const float keep = b2 ? a[4 + k] : a[k], send = b2 ? a[k] : a[4 + k]; bq[k] = keep + dpp_f<0x141>(send); }
#pragma unroll
    for (int m = 0; m < 2; ++m) { const float keep = b1 ? bq[2 + m] : bq[m], send = b1 ? bq[m] : bq[2 + m]; c[m] = keep + dpp_f<0x4E>(send); }
    const float keep = b0 ? c[1] : c[0], send = b0 ? c[0] : c[1];
    return keep + dpp_f<0xB1>(send);
}

__device__ void phase_scan(const Params& p, const Ctx cx, int pair, LAS unsigned char* lds) {
    const int tid = cx.tid, wid = tid >> 6, lane = tid & 63, rs = lane >> 4, cgi = lane & 15;
    const bf16_t* PB = (const bf16_t*)(PWS + WS_PROJB);
    const float* Wdec = (const float*)(PWS + WS_WDEC);
    const bf16_t* Aa = (const bf16_t*)(PWS + WS_AA);
    float* Y = (float*)(PWS + WS_Y);
    const float* mu = PIN(I_MU) + pair * 1664;
    const float* k_k = PIN(I_KK) + pair * 512; const float* k_a = PIN(I_KA) + pair * 512;
    {
        LAS float* vb = (LAS float*)lds + wid * 3072;
        for (int st = cx.bid * 8 + wid; st < 2048; st += cx.nblk * 8) {
            const int bh = st >> 1, half = st & 1, b = bh >> 3, h = bh & 7, ch = h * 64 + cgi * 4;
            const float* stp = PIN(I_SSHIFT) + ((size_t)pair * 128 + b) * 1664;
            const f32x4 kkc = *(const f32x4*)(k_k + ch), kac = *(const f32x4*)(k_a + ch);
            {
#pragma unroll
                for (int tt = 0; tt < 2; ++tt) {
                    const int t = rs + tt * 4;
                    const size_t row = NTP + b * 8 + t;
                    const bf16_t* cur = PB + row * LDB;
                    const f32x4 r = shift4(cur, t > 0, stp, ch, mu), k = shift4(cur, t > 0, stp, 512 + ch, mu), v = shift4(cur, t > 0, stp, 1024 + ch, mu);
                    const f32x4 a = ld_bf4(Aa + row * 512 + ch);
                    const f32x4 w = *(const f32x4*)(Wdec + row * 512 + ch);
                    const f32x4 kkv = k * kkc;
                    const float ss = allsum16(dot4(kkv, kkv));
                    const float inv = 1.0f / fmaxf(sqrtf(ss), 1e-12f);
                    const f32x4 kkn = kkv * inv;
                    LAS float* o = vb + t * 384 + cgi * 4;
                    *(LAS f32x4*)(o) = w; *(LAS f32x4*)(o + 64) = k * (1.0f + (a - 1.0f) * kac); *(LAS f32x4*)(o + 128) = kkn; *(LAS f32x4*)(o + 192) = -(kkn * a);
                    *(LAS f32x4*)(o + 256) = r; *(LAS f32x4*)(o + 320) = v;
                }
            }
            asm volatile("s_waitcnt lgkmcnt(0)" ::: "memory");
            __builtin_amdgcn_wave_barrier();
            const size_t so0 = ((((size_t)pair * 128 + b) * 8 + h) * 64 + half * 32 + rs) * 64 + cgi * 4;
            f32x4 Snext = *(const f32x4*)(PIN(I_SWKV) + so0);
#pragma unroll 1
            for (int rq = 0; rq < 8; ++rq) {
                const int ri = half * 32 + rq * 4 + rs;
                const size_t so = so0 + (size_t)rq * 256;
                f32x4 S = Snext;
                if (rq + 1 < 8) Snext = *(const f32x4*)(PIN(I_SWKV) + so + 256);
#pragma unroll
                for (int t = 0; t < 8; ++t) {
                    LAS const float* r0 = vb + t * 384 + cgi * 4;
                    float y; scan_step(S, *(LAS const f32x4*)(r0), *(LAS const f32x4*)(r0 + 64), *(LAS const f32x4*)(r0 + 128), *(LAS const f32x4*)(r0 + 192), *(LAS const f32x4*)(r0 + 256), vb[t * 384 + 320 + ri], y);
                    if (cgi == 0) Y[(size_t)(NTP + b * 8 + t) * 512 + h * 64 + ri] = y;
                }
                *(f32x4*)(POUT + O_WKVS + so) = S;
            }
            asm volatile("s_waitcnt lgkmcnt(0)" ::: "memory");
            __builtin_amdgcn_wave_barrier();
        }
    }
    __syncthreads();
    LAS float* rec = (LAS float*)lds;
    for (int pt = cx.bid; pt < 256; pt += cx.nblk) {
        const int xcd = pt & 7, slot = pt >> 3, bh = xcd * 8 + (slot >> 2), rg = slot & 3, b = bh >> 3, h = bh & 7;
        const int lt = tid - 256, ls = (lt >> 4) & 15, lcg = lt & 15, lch = h * 64 + lcg * 4;
        u32x2 qr = {0u, 0u}, qk = {0u, 0u}, qv = {0u, 0u}, pr = {0u, 0u}, pk = {0u, 0u}, pv = {0u, 0u}, qa = {0u, 0u};
        f32x4 qw = (f32x4){0.f, 0.f, 0.f, 0.f};
        f32x4 mur, muk, muv, kkc, kac;
        const int ri = rg * 16 + (wid & 3) * 4 + rs;
        f32x4 S = (f32x4){0.f, 0.f, 0.f, 0.f};
#define SCAN_ISSUE(c) do { const int t_ = (c) * 16 + ls; const size_t row_ = (size_t)b * 2048 + t_; const bf16_t* cur_ = PB + row_ * LDB; \
            qr = *(const u32x2*)(cur_ + lch); qk = *(const u32x2*)(cur_ + 512 + lch); qv = *(const u32x2*)(cur_ + 1024 + lch); \
            if (t_ > 0) { pr = *(const u32x2*)(cur_ - LDB + lch); pk = *(const u32x2*)(cur_ - LDB + 512 + lch); pv = *(const u32x2*)(cur_ - LDB + 1024 + lch); } \
            else { pr = (u32x2){0u, 0u}; pk = pr; pv = pr; } \
            qw = *(const f32x4*)(Wdec + row_ * 512 + lch); qa = *(const u32x2*)(Aa + row_ * 512 + lch); } while (0)
#define SCAN_PROCESS(buf) do { const f32x4 r0_ = cvt4(qr), k0_ = cvt4(qk), v0_ = cvt4(qv); \
            const f32x4 r_ = r0_ + mur * (cvt4(pr) - r0_), k_ = k0_ + muk * (cvt4(pk) - k0_), v_ = v0_ + muv * (cvt4(pv) - v0_), a_ = cvt4(qa); \
            const f32x4 kkv_ = k_ * kkc; const float ss_ = allsum16(dot4(kkv_, kkv_)); const float inv_ = __builtin_amdgcn_rsqf(fmaxf(ss_, 1e-24f)); \
            const f32x4 kkn_ = kkv_ * inv_; \
            LAS float* o_ = rec + (buf) * 6144 + ls * 384 + lcg * 4; \
            *(LAS f32x4*)(o_) = qw; *(LAS f32x4*)(o_ + 64) = k_ * (1.0f + (a_ - 1.0f) * kac); *(LAS f32x4*)(o_ + 128) = kkn_; *(LAS f32x4*)(o_ + 192) = -(kkn_ * a_); \
            *(LAS f32x4*)(o_ + 256) = r_; *(LAS f32x4*)(o_ + 320) = v_; } while (0)
        if (wid >= 4) {
            mur = *(const f32x4*)(mu + lch); muk = *(const f32x4*)(mu + 512 + lch); muv = *(const f32x4*)(mu + 1024 + lch);
            kkc = *(const f32x4*)(k_k + lch); kac = *(const f32x4*)(k_a + lch);
            SCAN_ISSUE(0); SCAN_PROCESS(0); SCAN_ISSUE(1);
        }
        __syncthreads();
        for (int c = 0; c < 128; ++c) {
            if (wid < 4) {
                LAS const float* rb = rec + (c & 1) * 6144 + cgi * 4;
                LAS const float* rv = rec + (c & 1) * 6144 + 320 + ri;
                float yp[16];
                f32x4 nw = *(LAS const f32x4*)(rb), nk = *(LAS const f32x4*)(rb + 64), nkk = *(LAS const f32x4*)(rb + 128), nb = *(LAS const f32x4*)(rb + 192), nr = *(LAS const f32x4*)(rb + 256);
                float nv = rv[0];
#pragma unroll
                for (int s = 0; s < 16; ++s) {
                    const f32x4 cw = nw, ck = nk, ckk = nkk, cb = nb, cr = nr; const float cv = nv;
                    if (s + 1 < 16) {
                        LAS const float* r1 = rb + (s + 1) * 384;
                        nw = *(LAS const f32x4*)(r1); nk = *(LAS const f32x4*)(r1 + 64); nkk = *(LAS const f32x4*)(r1 + 128); nb = *(LAS const f32x4*)(r1 + 192); nr = *(LAS const f32x4*)(r1 + 256);
                        nv = rv[(s + 1) * 384];
                    }
                    scan_step<false>(S, cw, ck, ckk, cb, cr, cv, yp[s]);
                }
                Y[((size_t)b * 2048 + c * 16 + cgi) * 512 + h * 64 + ri] = reduce_scatter16(yp, cgi);
            } else {
                if (c + 1 < 128) { SCAN_PROCESS((c + 1) & 1); if (c + 2 < 128) SCAN_ISSUE(c + 2); }
            }
            __syncthreads();
        }
        if (wid < 4) *(f32x4*)(POUT + O_WKVP + ((((size_t)pair * 8 + b) * 8 + h) * 64 + ri) * 64 + cgi * 4) = S;
#undef SCAN_ISSUE
#undef SCAN_PROCESS
    }
}

__device__ void phase_even_post(const Params& p, const Ctx cx, int pair) {
    const int gtid = cx.bid * 512 + cx.tid, gthreads = cx.nblk * 512;
    const bf16_t* PA = (const bf16_t*)(PWS + WS_R1);
    bf16_t* Ycat = (bf16_t*)(PWS + WS_YCAT);
    const float* Y = (const float*)(PWS + WS_Y);
    constexpr int NIT = NTOK * 128, UB = 4;
    const float* gn_g = PIN(I_GNG) + pair * 512; const float* gn_b = PIN(I_GNB) + pair * 512;
    for (int e0 = gtid; e0 < NIT; e0 += gthreads * UB) {
        f32x4 y[UB], bv[UB], bz[UB]; bool ok[UB];
#pragma unroll
        for (int u = 0; u < UB; ++u) {
            const int e = e0 + u * gthreads; ok[u] = e < NIT;
            const int ee = ok[u] ? e : e0; const int row = ee >> 7, ch = (ee & 127) * 4;
            y[u] = *(const f32x4*)(Y + (size_t)row * 512 + ch);
            bv[u] = ld_bf4(Ycat + (size_t)row * 1024 + 512 + ch);
            bz[u] = ld_bf4(PA + (size_t)row * LDA + 2048 + ch);
        }
#pragma unroll
        for (int u = 0; u < UB; ++u) {
            const int e = e0 + u * gthreads;
            const int ee = ok[u] ? e : e0; const int row = ee >> 7, ch = (ee & 127) * 4;
            const float mean = allsum16(y[u][0] + y[u][1] + y[u][2] + y[u][3]) * (1.0f / 64.0f);
            const f32x4 d = y[u] - mean;
            const float var = allsum16(dot4(d, d)) * (1.0f / 64.0f);
            const float rstd = rsqrtf(var + 64e-5f);
            const f32x4 g = *(const f32x4*)(gn_g + ch), bb = *(const f32x4*)(gn_b + ch);
            f32x4 o;
#pragma unroll
            for (int j = 0; j < 4; ++j) o[j] = (d[j] * rstd * g[j] + bb[j] + bv[u][j]) * siluf_(bz[u][j]);
            if (ok[u]) st_bf4(Ycat + (size_t)row * 1024 + 512 + ch, o);
        }
    }
    const float* cw = PIN(I_CONVW) + pair * 3 * 512;
    constexpr int NRUN = (NTOK / 8) * 128;
    for (int e = gtid; e < NRUN; e += gthreads) {
        const int run = e >> 7, ch = (e & 127) * 4, row0 = run * 8;
        const bool samp = row0 >= NTP;
        int b, t0, T; if (!samp) { b = row0 >> 11; t0 = row0 & 2047; T = 2048; } else { b = (row0 - NTP) >> 3; t0 = 0; T = 8; }
        const bf16_t* base = PA + (size_t)row0 * LDA + ch;
        u32x2 rh[10], rc[10], rb[8], rz[8];
#pragma unroll
        for (int k = 0; k < 10; ++k) {
            const bool have = (k >= 2) || (t0 > 0);
            const bf16_t* pr = have ? base + (ptrdiff_t)(k - 2) * LDA : base;
            rh[k] = *(const u32x2*)(pr); rc[k] = *(const u32x2*)(pr + 1024);
        }
#pragma unroll
        for (int k = 0; k < 8; ++k) { rb[k] = *(const u32x2*)(base + (size_t)k * LDA + 512); rz[k] = *(const u32x2*)(base + (size_t)k * LDA + 1536); }
        const f32x4 k0 = *(const f32x4*)(cw + ch), k1 = *(const f32x4*)(cw + 512 + ch), k2 = *(const f32x4*)(cw + 1024 + ch);
        f32x4 um2, um1;
        if (t0 > 0) { um2 = cvt4(rc[0]) * cvt4(rh[0]); um1 = cvt4(rc[1]) * cvt4(rh[1]); }
        else if (samp) { const float* hist = PIN(I_SCONV) + ((size_t)pair * 128 + b) * 2 * 512 + ch; um2 = *(const f32x4*)(hist); um1 = *(const f32x4*)(hist + 512); }
        else { um2 = (f32x4){0.f, 0.f, 0.f, 0.f}; um1 = um2; }
#pragma unroll
        for (int k = 0; k < 8; ++k) {
            const f32x4 u0 = cvt4(rc[k + 2]) * cvt4(rh[k + 2]);
            const f32x4 conv = k0 * um2 + k1 * um1 + k2 * u0;
            const f32x4 ab = cvt4(rb[k]), az = cvt4(rz[k]);
            f32x4 o;
#pragma unroll
            for (int j = 0; j < 4; ++j) o[j] = ab[j] * conv[j] * siluf_(az[j]);
            const int row = row0 + k, t = t0 + k;
            st_bf4(Ycat + (size_t)row * 1024 + ch, o);
            if (t >= T - 2) {
                float* dst = samp ? POUT + O_CONVS + (((size_t)pair * 128 + b) * 2 + (t - (T - 2))) * 512 + ch : POUT + O_CONVP + (((size_t)pair * 8 + b) * 2 + (t - (T - 2))) * 512 + ch;
                *(f32x4*)dst = u0;
            }
            um2 = um1; um1 = u0;
        }
    }
}

template <int W>
__device__ __forceinline__ void pool_sample_run(const float* __restrict__ hist, const bf16_t* __restrict__ cur, LAS bf16_t* out) {
    f32x4 ext[23];
#pragma unroll
    for (int k = 0; k < 15; ++k) ext[k] = (k >= 16 - W) ? *(const f32x4*)(hist + (size_t)k * 512) : (f32x4){0.f, 0.f, 0.f, 0.f};
#pragma unroll
    for (int k = 0; k < 8; ++k) ext[15 + k] = ld_bf4(cur + (size_t)k * LDA);
    f32x4 sum = (f32x4){0.f, 0.f, 0.f, 0.f};
#pragma unroll
    for (int d = 0; d < W; ++d) sum += ext[15 - d];
#pragma unroll
    for (int t = 0; t < 8; ++t) {
        if (t > 0) sum += ext[15 + t] - ext[15 + t - W];
        const f32x4 pooled = sum * (1.0f / (float)W) - ext[15 + t];
        u32x2 u; u.x = cvt_pk_bf16(pooled[0], pooled[1]); u.y = cvt_pk_bf16(pooled[2], pooled[3]);
        *(LAS u32x2*)(out + t * 136) = u;
    }
}

__device__ void phase_odd_mixer(const Params& p, const Ctx cx, int pair, LAS unsigned char* lds) {
    const int tid = cx.tid, wid = tid >> 6, lane = tid & 63, fr = lane & 15, fq = lane >> 4;
    const bf16_t* PO = (const bf16_t*)(PWS + WS_R1);
    bf16_t* Ycat = (bf16_t*)(PWS + WS_YCAT);
    LAS bf16_t* LA = (LAS bf16_t*)lds;
    LAS bf16_t* LB = (LAS bf16_t*)(lds + 128 * 136 * 2);
    LAS float* stat = (LAS float*)(lds + 2 * 128 * 136 * 2);
    LAS float* LE = (LAS float*)(lds + 128 * 136 * 2);
    LAS bf16_t* LW = (LAS bf16_t*)(lds + 128 * 136 * 2 + 143 * 128 * 4);
    for (int tile = cx.bid; tile < 136; tile += cx.nblk) {
        const int r0 = tile * 128;
        const bool samp = r0 >= NTP;
        const int tl_ = tid >> 2, q_ = tid & 3;
        {
            const bf16_t* vr = PO + (size_t)(r0 + tl_) * LDA + 1536 + q_ * 128;
            float s_ = 0.f, ss = 0.f;
#pragma unroll
            for (int i = 0; i < 16; ++i) { const u32x4 raw = *(const u32x4*)(vr + i * 8); const f32x4 v0 = cvt4((u32x2){raw.x, raw.y}), v1 = cvt4((u32x2){raw.z, raw.w});
                s_ += (v0[0] + v0[1]) + (v0[2] + v0[3]) + (v1[0] + v1[1]) + (v1[2] + v1[3]); ss += dot4(v0, v0) + dot4(v1, v1); }
            s_ = allsum4(s_); ss = allsum4(ss);
            const float mean = s_ * (1.0f / 512.0f);
            const float var = fmaxf(ss * (1.0f / 512.0f) - mean * mean, 0.f);
            if (q_ == 0) { stat[tl_ * 2] = mean; stat[tl_ * 2 + 1] = rsqrtf(var + 1e-5f); }
        }
        u32x2 rv[8]; u32x4 rw[4];
#define MIX_LOAD_G(gg) do { const bf16_t* vr_ = PO + (size_t)(r0 + tl_) * LDA + 1536 + (gg) * 128 + q_ * 32; \
            _Pragma("unroll") for (int i = 0; i < 8; ++i) rv[i] = *(const u32x2*)(vr_ + i * 4); \
            if (!samp) { const bf16_t* Ws_ = (const bf16_t*)(PWS + WS_SPW) + ((size_t)pair * 4 + (gg)) * 128 * 128; \
                _Pragma("unroll") for (int i = 0; i < 4; ++i) { const int e = tid + i * 512; rw[i] = *(const u32x4*)(Ws_ + (e >> 4) * 128 + (e & 15) * 8); } } } while (0)
        MIX_LOAD_G(0);
        __syncthreads();
#pragma unroll 1
        for (int g = 0; g < 4; ++g) {
            u32x2 ur[8], dzr[8];
#pragma unroll
            for (int nt = 0; nt < 8; ++nt) { const size_t o_ = (size_t)(r0 + wid * 16 + fr) * LDA + g * 128 + nt * 16 + fq * 4; ur[nt] = *(const u32x2*)(PO + o_ + 1024); dzr[nt] = *(const u32x2*)(PO + o_ + 2048); }
            {
                const int row = r0 + tl_;
                const float mean = stat[tl_ * 2], rstd = stat[tl_ * 2 + 1];
                const float* lg = PIN(I_LNG) + pair * 512 + g * 128 + q_ * 32; const float* lb = PIN(I_LNB) + pair * 512 + g * 128 + q_ * 32;
#pragma unroll
                for (int i = 0; i < 8; ++i) {
                    const f32x4 v = cvt4(rv[i]);
                    const f32x4 vn = (v - mean) * rstd * *(const f32x4*)(lg + i * 4) + *(const f32x4*)(lb + i * 4);
                    if (samp) *(f32x4*)(POUT + O_CHUNKV + ((size_t)pair * 1024 + (row - NTP)) * 512 + g * 128 + q_ * 32 + i * 4) = vn;
#pragma unroll
                    for (int j = 0; j < 4; ++j) LB[(q_ * 32 + i * 4 + j) * 136 + tl_] = (bf16_t)(cvt_pk_bf16(vn[j], 0.f) & 0xffffu);
                }
            }
            if (!samp) {
#pragma unroll
                for (int i = 0; i < 4; ++i) { const int e = tid + i * 512; *(LAS u32x4*)(LA + (e >> 4) * 136 + (e & 15) * 8) = rw[i]; }
            } else {
                const float* Wsrc = PIN(I_SPW) + ((size_t)pair * 4 + g) * 128 * 128;
                LAS float* w8 = stat + 256;
                if (tid < 64) w8[tid] = Wsrc[(tid >> 3) * 128 + (tid & 7)];
                __syncthreads();
                for (int e = tid; e < 128 * 128; e += 512) { const int t = e >> 7, s2 = e & 127;
                    const float v = ((t >> 3) == (s2 >> 3) && (s2 & 7) <= (t & 7)) ? w8[(t & 7) * 8 + (s2 & 7)] : 0.f;
                    LA[t * 136 + s2] = (bf16_t)(cvt_pk_bf16(v, 0.f) & 0xffffu); }
            }
            if (g + 1 < 4) MIX_LOAD_G(g + 1);
            __syncthreads();
            {
                const int tl = wid * 16 + fr, row = r0 + tl;
                const float bias = PIN(I_SPB)[((size_t)pair * 4 + g) * 128 + (samp ? (tl & 7) : tl)];
                bf16x8 wf[4];
#pragma unroll
                for (int ks = 0; ks < 4; ++ks) wf[ks] = *(const LAS bf16x8*)(LA + tl * 136 + ks * 32 + fq * 8);
#pragma unroll
                for (int nt = 0; nt < 8; ++nt) {
                    f32x4 acc = (f32x4){0.f, 0.f, 0.f, 0.f};
#pragma unroll
                    for (int ks = 0; ks < 4; ++ks) {
                        if (ks * 32 <= wid * 16 + 15) {
                            const bf16x8 vf = *(const LAS bf16x8*)(LB + (nt * 16 + fr) * 136 + ks * 32 + fq * 8);
                            acc = __builtin_amdgcn_mfma_f32_16x16x32_bf16(vf, wf[ks], acc, 0, 0, 0);
                        }
                    }
                    const int c = g * 128 + nt * 16 + fq * 4;
                    const f32x4 u = cvt4(ur[nt]), dz = cvt4(dzr[nt]);
                    f32x4 o;
#pragma unroll
                    for (int j = 0; j < 4; ++j) o[j] = u[j] * (acc[j] + bias) * siluf_(dz[j]);
                    st_bf4(Ycat + (size_t)row * 1024 + 512 + c, o);
                }
            }
            __syncthreads();
        }
#undef MIX_LOAD_G
    }
    {
        int ci, cstride;
        if (cx.nblk == 256) { if (cx.bid < 136) { ci = cx.bid; cstride = 1 << 20; } else { ci = cx.bid; cstride = 120; } }
        else { ci = cx.bid; cstride = cx.nblk; }
        u32x4 pw[4]; u32x2 pe[9];
#define MIX_LOAD_C(cc) do { const int tile_ = (cc) >> 2, g_ = (cc) & 3, r0_ = tile_ * 128; \
            const bf16_t* Bw_ = (const bf16_t*)(PWS + WS_POOLWT) + ((size_t)pair * 4 + g_) * 128 * 128; \
            _Pragma("unroll") for (int i = 0; i < 4; ++i) { const int e = tid + i * 512; pw[i] = *(const u32x4*)(Bw_ + (e >> 4) * 128 + (e & 15) * 8); } \
            if (r0_ < NTP) { const int t0_ = r0_ & 2047; \
                _Pragma("unroll") for (int i = 0; i < 9; ++i) { const int e = tid + i * 512, er = e >> 5, c = (e & 31) * 4; pe[i] = (u32x2){0u, 0u}; \
                    if (e < 143 * 32 && t0_ + er - 15 >= 0) pe[i] = *(const u32x2*)(PO + (size_t)(r0_ + er - 15) * LDA + g_ * 128 + c); } } } while (0)
        if (ci < 544) MIX_LOAD_C(ci);
        for (; ci < 544; ci += cstride) {
            const int tile = ci >> 2, g = ci & 3, r0 = tile * 128;
            const bool samp = r0 >= NTP;
            const int w = 2 << g;
            const int row = r0 + wid * 16 + fr;
            u32x2 czr[8]; f32x4 psr[8];
#pragma unroll
            for (int nt = 0; nt < 8; ++nt) { const int d = g * 128 + nt * 16 + fq * 4; czr[nt] = *(const u32x2*)(PO + (size_t)row * LDA + 512 + d); psr[nt] = *(const f32x4*)(PIN(I_PSCALE) + pair * 512 + d); }
#pragma unroll
            for (int i = 0; i < 4; ++i) { const int e = tid + i * 512; *(LAS u32x4*)(LW + (e >> 4) * 136 + (e & 15) * 8) = pw[i]; }
            if (!samp) {
                const int t0 = r0 & 2047;
#pragma unroll
                for (int i = 0; i < 9; ++i) { const int e = tid + i * 512, er = e >> 5, c = (e & 31) * 4; if (e < 143 * 32) *(LAS f32x4*)(LE + er * 128 + c) = cvt4(pe[i]); }
                __syncthreads();
                {
                    const int c = (tid & 31) * 4, tl0 = (tid >> 5) * 8;
                    f32x4 sum = (f32x4){0.f, 0.f, 0.f, 0.f};
#pragma unroll 4
                    for (int d = 0; d < w; ++d) sum += *(LAS const f32x4*)(LE + (tl0 + 15 - d) * 128 + c);
#pragma unroll
                    for (int k = 0; k < 8; ++k) {
                        const int tl = tl0 + k;
                        const f32x4 pt = *(LAS const f32x4*)(LE + (tl + 15) * 128 + c);
                        if (k > 0) sum += pt - *(LAS const f32x4*)(LE + (tl + 15 - w) * 128 + c);
                        const float cnt = fminf((float)w, (float)(t0 + tl + 1));
                        const f32x4 pooled = sum * (1.0f / cnt) - pt;
                        u32x2 u; u.x = cvt_pk_bf16(pooled[0], pooled[1]); u.y = cvt_pk_bf16(pooled[2], pooled[3]);
                        *(LAS u32x2*)(LA + tl * 136 + c) = u;
                    }
                }
            } else {
                const int sq = tid >> 5, c = (tid & 31) * 4, bb = (r0 - NTP) / 8 + sq;
                const float* hist = PIN(I_SPOOL) + ((size_t)pair * 128 + bb) * 15 * 512 + g * 128 + c;
                const bf16_t* cur = PO + (size_t)(r0 + sq * 8) * LDA + g * 128 + c;
                LAS bf16_t* out = LA + (sq * 8) * 136 + c;
                if (g == 0) pool_sample_run<2>(hist, cur, out); else if (g == 1) pool_sample_run<4>(hist, cur, out);
                else if (g == 2) pool_sample_run<8>(hist, cur, out); else pool_sample_run<16>(hist, cur, out);
            }
            if (ci + cstride < 544) MIX_LOAD_C(ci + cstride);
            __syncthreads();
            bf16x8 af[4];
#pragma unroll
            for (int ks = 0; ks < 4; ++ks) af[ks] = *(const LAS bf16x8*)(LA + (wid * 16 + fr) * 136 + ks * 32 + fq * 8);
#pragma unroll
            for (int nt = 0; nt < 8; ++nt) {
                f32x4 acc = (f32x4){0.f, 0.f, 0.f, 0.f};
#pragma unroll
                for (int ks = 0; ks < 4; ++ks) {
                    const bf16x8 bf = *(const LAS bf16x8*)(LW + (nt * 16 + fr) * 136 + ks * 32 + fq * 8);
                    acc = __builtin_amdgcn_mfma_f32_16x16x32_bf16(bf, af[ks], acc, 0, 0, 0);
                }
                const int d = g * 128 + nt * 16 + fq * 4;
                const f32x4 cz = cvt4(czr[nt]), ps = psr[nt];
                f32x4 o;
#pragma unroll
                for (int j = 0; j < 4; ++j) o[j] = acc[j] * ps[j] * siluf_(cz[j]);
                st_bf4(Ycat + (size_t)row * 1024 + d, o);
            }
            __syncthreads();
        }
#undef MIX_LOAD_C
    }
    const int gtid = cx.bid * 512 + tid, gthreads = cx.nblk * 512;
    for (int e = gtid; e < 136 * 15 * 128; e += gthreads) {
        const int c = (e & 127) * 4, q = e >> 7, sr = q / 15, k = q - sr * 15;
        if (sr < 8) *(f32x4*)(POUT + O_POOLP + (((size_t)pair * 8 + sr) * 15 + k) * 512 + c) = ld_bf4(PO + (size_t)(sr * 2048 + 2033 + k) * LDA + c);
        else { const int b = sr - 8;
            *(f32x4*)(POUT + O_POOLS + (((size_t)pair * 128 + b) * 15 + k) * 512 + c) = (k < 7) ? *(const f32x4*)(PIN(I_SPOOL) + (((size_t)pair * 128 + b) * 15 + 8 + k) * 512 + c) : ld_bf4(PO + (size_t)(NTP + b * 8 + (k - 7)) * LDA + c); }
    }
}

__device__ void phase_final(const Params& p, const Ctx cx) {
    const int gtid = cx.bid * 512 + cx.tid, gthreads = cx.nblk * 512;
    const float* ssq = (const float*)(PWS + WS_SSQ) + (size_t)4 * NTOK * 16;
    const bf16_t* Xb = (const bf16_t*)(PWS + WS_XB);
    constexpr int NIT = NTOK * 256, UB = 4;
    for (int e0 = gtid; e0 < NIT; e0 += gthreads * UB) {
        f32x4 x[UB]; float sq[UB]; bool ok[UB];
#pragma unroll
        for (int u = 0; u < UB; ++u) { const int e = e0 + u * gthreads; ok[u] = e < NIT; const int ee = ok[u] ? e : e0; const int row = ee >> 8, c = (ee & 255) * 4;
            x[u] = ld_bf4(Xb + (size_t)row * 1024 + c); sq[u] = ssq_sum(ssq + (size_t)row * 16); }
#pragma unroll
        for (int u = 0; u < UB; ++u) { const int e = e0 + u * gthreads; const int ee = ok[u] ? e : e0; const int row = ee >> 8, c = (ee & 255) * 4;
            const float rstd = rsqrtf(sq[u] * (1.0f / 1024.0f) + 1e-6f);
            if (ok[u]) *(f32x4*)(POUT + (size_t)row * 1024 + c) = x[u] * rstd * *(const f32x4*)(PIN(I_FNORMW) + c); }
    }
}

#define XB_TMO      128
#define XB_XCNT(j)  (256  + 64 * (j))
#define XB_XSUB(j)  (1280 + 64 * (j))
#define XB_XGEN(j)  (2304 + 64 * (j))
#define XB_TOP      3328
#define XB_TOPGEN   3392
#define XCD_BAR_WORDS 3456
#define XB_SPIN_CAP (1u << 18)
__device__ __forceinline__ unsigned xb_ld(unsigned* p)              { return __hip_atomic_load(p, __ATOMIC_RELAXED, __HIP_MEMORY_SCOPE_AGENT); }
__device__ __forceinline__ unsigned xb_add(unsigned* p, unsigned v) { return __hip_atomic_fetch_add(p, v, __ATOMIC_RELAXED, __HIP_MEMORY_SCOPE_AGENT); }
__device__ __forceinline__ unsigned xb_xcc_id() { return (unsigned)__builtin_amdgcn_s_getreg((3 << 11) | 20) & 0xFu; }
#define XB_SPIN(cond, bar) do { unsigned _sp = 0; while (cond) { __builtin_amdgcn_s_sleep(1); \
    if ((++_sp & 255u) == 0u) { if (xb_ld(&(bar)[XB_TMO])) break; if (_sp > XB_SPIN_CAP) { atomicAdd(&(bar)[XB_TMO], 1u); break; } } } } while (0)
struct XcdBarrier { unsigned* bar; unsigned x; volatile LAS unsigned* st; };
__device__ __forceinline__ XcdBarrier xcd_barrier_post(unsigned* bar, volatile LAS unsigned* st) {
    XcdBarrier b; b.bar = bar; b.x = xb_xcc_id(); b.st = st;
    if (threadIdx.x == 0) (void)xb_add(&bar[XB_XCNT(b.x)], 1u);
    return b;
}
__device__ __forceinline__ void xcd_barrier_complete(unsigned* bar, unsigned x, unsigned& nloc, unsigned& nx) {
    const unsigned G = gridDim.x * gridDim.y * gridDim.z;
    unsigned sum, cnt, mine, sp = 0u;
    for (;;) {
        sum = 0u; cnt = 0u; mine = 0u;
#pragma unroll
        for (unsigned j = 0; j < 16; ++j) { const unsigned c = xb_ld(&bar[XB_XCNT(j)]); sum += c; cnt += (c > 0u) ? 1u : 0u; mine = (j == x) ? c : mine; }
        if (sum == G) break;
        __builtin_amdgcn_s_sleep(1);
        if ((++sp & 255u) == 0u) { if (xb_ld(&bar[XB_TMO])) break; if (sp > XB_SPIN_CAP) { atomicAdd(&bar[XB_TMO], 1u); break; } }
    }
    nloc = mine > 0u ? mine : 1u; nx = cnt > 0u ? cnt : 1u;
}
__device__ __forceinline__ void xcd_barrier(const XcdBarrier& b) {
    asm volatile("s_waitcnt vmcnt(0)" ::: "memory");
    __syncthreads();
    if (threadIdx.x == 0) {
        unsigned* bar = b.bar;
        __builtin_amdgcn_s_waitcnt(0);
        unsigned nloc = b.st[0], nx = b.st[1];
        if (nloc == 0u) { xcd_barrier_complete(bar, b.x, nloc, nx); b.st[0] = nloc; b.st[1] = nx; }
        const unsigned old = xb_add(&bar[XB_XSUB(b.x)], 1u);
        const unsigned gen = old / nloc;
        if (old + 1u == (gen + 1u) * nloc) {
            __builtin_amdgcn_fence(__ATOMIC_RELEASE, "agent");
            asm volatile("s_waitcnt vmcnt(0)" ::: "memory");
            const unsigned og = xb_add(&bar[XB_TOP], 1u);
            const unsigned tg = og / nx;
            if (og + 1u == (tg + 1u) * nx) xb_add(&bar[XB_TOPGEN], 1u);
            else XB_SPIN(xb_ld(&bar[XB_TOPGEN]) == tg, bar);
            __builtin_amdgcn_fence(__ATOMIC_ACQUIRE, "agent");
            xb_add(&bar[XB_XGEN(b.x)], 1u);
            asm volatile("s_waitcnt vmcnt(0)" ::: "memory");
        } else {
            XB_SPIN(xb_ld(&bar[XB_XGEN(b.x)]) == gen, bar);
            __builtin_amdgcn_fence(__ATOMIC_ACQUIRE, "agent");
            asm volatile("s_waitcnt vmcnt(0)" ::: "memory");
        }
    }
    __syncthreads();
}

__device__ void run_gemm_proj(const Params& p, const Ctx cx, LAS unsigned char* lds, const bf16_t* Bt, int N, bf16_t* O, int ldc, int layer) {
    pg8::Gemm g{(const bf16_t*)(PWS + WS_XB), Bt, NTOK, N, 1024};
    pg8::StaticOrder S; S.init(NTOK, N, (int)cx.nblk, (int)cx.bid);
    const float* ssq = (const float*)(PWS + WS_SSQ) + (size_t)layer * NTOK * 16;
    LAS float* rl = (LAS float*)(lds + 131072);
    int pm0 = -1, pm1 = -1, pm2 = -1, pm3 = -1, np = 0;
    for (int i = 0; i < 64; ++i) {
        pg8::Unit u; if (!S.next(i, u)) break;
        if (u.pm == pm0 || u.pm == pm1 || u.pm == pm2 || u.pm == pm3) continue;
        if (np == 0) pm0 = u.pm; else if (np == 1) pm1 = u.pm; else if (np == 2) pm2 = u.pm; else pm3 = u.pm;
        ++np;
    }
    for (int r = cx.tid; r < np * 256; r += 512) {
        const int i = r >> 8, pm = i == 0 ? pm0 : (i == 1 ? pm1 : (i == 2 ? pm2 : pm3));
        rl[r] = rsqrtf(ssq_sum(ssq + (size_t)(pm * 256 + (r & 255)) * 16) * (1.0f / 1024.0f) + 1e-6f);
    }
    __syncthreads();
    EpiProj E{O, ldc, rl, pm0, pm1, pm2, pm3};
    pg8::gemm_phase<EpiProj>(cx, lds, g, S, E);
}
__device__ void run_gemm_res(const Params& p, const Ctx cx, LAS unsigned char* lds, const bf16_t* Bt, int layer) {
    const bf16_t* A = (const bf16_t*)(PWS + WS_YCAT);
    bf16_t* Xb = (bf16_t*)(PWS + WS_XB);
    float* ssqn = (float*)(PWS + WS_SSQ) + (size_t)(layer + 1) * NTOK * 16;
    pg8::Gemm g{A, Bt, NTOK, 1024, 1024};
    pg8::StaticOrder S; S.init(NTOK, 1024, (int)cx.nblk, (int)cx.bid);
    EpiRes E{layer == 0 ? PIN(I_XP) : nullptr, PIN(I_XS), Xb, ssqn};
    pg8::gemm_phase<EpiRes>(cx, lds, g, S, E);
}

constexpr int N_PHASES = 20;
#ifndef PHMASK
#define PHMASK 0xffff
#endif
#define PHON(n) ((PHMASK >> ((n) % 16)) & 1)
__global__ void __launch_bounds__(512, 2) fwd_kernel(Params p) {
    extern __shared__ __attribute__((aligned(16))) unsigned char lds_raw[];
    LAS unsigned char* lds = (LAS unsigned char*)lds_raw;
    volatile LAS unsigned* bar_st = (volatile LAS unsigned*)(lds + LDS_MAIN);
    if (threadIdx.x < 4) bar_st[threadIdx.x] = 0u;
    __syncthreads();
    const XcdBarrier gbar = xcd_barrier_post((unsigned*)((unsigned char*)p.ptr[30] + WS_BAR), bar_st);
    if (p.ph_hi < 0) cg::this_grid().sync();
#define GRID_SYNC() xcd_barrier(gbar)
#ifdef SYNCPROBE
    for (int i = 0; i < SYNCPROBE; ++i) GRID_SYNC();
#endif
#ifdef REPMASK
    for (int pc = p.ph_lo * 2; pc < p.ph_hi * 2; ++pc) {
        const int ph = pc >> 1;
        { const int s_ = (ph == 0) ? 9 : (ph == N_PHASES - 1) ? 31 : (ph - 1) % 9; if ((pc & 1) && !((REPMASK >> s_) & 1)) continue; }
        if (pc > p.ph_lo * 2) GRID_SYNC();
#else
    for (int ph = p.ph_lo; ph < p.ph_hi; ++ph) {
        if (ph > p.ph_lo) GRID_SYNC();
#endif
        Ctx cx; cx.tid = threadIdx.x; cx.bid = blockIdx.x; cx.nblk = gridDim.x;
        asm volatile("s_mov_b32 %0, 0" : "=s"(cx.z));
        asm volatile("" : "+v"(cx.tid)); asm volatile("" : "+s"(cx.bid)); asm volatile("" : "+s"(cx.nblk));
        const int pair = (ph - 1) / 9, s = (ph == 0) ? 100 : (ph == N_PHASES - 1 ? 101 : (ph - 1) % 9);
        if (s == 0 || s == 3 || s == 6) {
#if PHON(0)
            const bf16_t* WinE = (const bf16_t*)(PWS + WS_WINE) + (size_t)pair * 4352 * 1024;
            const bf16_t* Bt = s == 0 ? WinE + (size_t)2560 * 1024 : (s == 3 ? WinE : (const bf16_t*)(PWS + WS_WINO) + (size_t)pair * 2560 * 1024);
            const int N = s == 0 ? 1792 : 2560;
            run_gemm_proj(p, cx, lds, Bt, N, (bf16_t*)(PWS + WS_R1), N, 2 * pair + (s == 6 ? 1 : 0));
#endif
        } else if (s == 5 || s == 8) {
#if PHON(5)
            const bf16_t* Bt = (const bf16_t*)(PWS + (s == 5 ? WS_WOUTE : WS_WOUTO)) + (size_t)pair * 1024 * 1024;
            run_gemm_res(p, cx, lds, Bt, 2 * pair + (s == 8 ? 1 : 0));
#endif
        } else if (s == 1) {
#if PHON(1)
            phase_even_prep(p, cx, pair, lds);
#endif
        } else if (s == 2) {
#if PHON(2)
            phase_scan(p, cx, pair, lds);
#endif
        } else if (s == 4) {
#if PHON(4)
            phase_even_post(p, cx, pair);
#endif
        } else if (s == 7) {
#if PHON(7)
            phase_odd_mixer(p, cx, pair, lds);
#endif
        } else if (s == 100) {
#if PHON(10)
            phase_prepass(p, cx, lds);
#endif
        } else {
#if PHON(11)
            phase_final(p, cx);
#endif
        }
    }
}

extern "C" void kernel_launch(void* const* d_in, const int* in_sizes, int n_in, void* d_out, int out_size, void* d_ws, size_t ws_size, hipStream_t stream) {
    static int grid = 0;
    if (grid == 0) {
        if (n_in != 29 || ws_size < WS_END) { fprintf(stderr, "kernel_launch: unexpected n_in %d / ws_size %zu (need %zu)\n", n_in, ws_size, (size_t)WS_END); grid = -1; return; }
        int dev = 0, cus = 0, per_cu = 0;
        hipGetDevice(&dev);
        hipDeviceGetAttribute(&cus, hipDeviceAttributeMultiprocessorCount, dev);
        if (hipFuncSetAttribute((const void*)fwd_kernel, hipFuncAttributeMaxDynamicSharedMemorySize, LDS_BYTES) != hipSuccess) { fprintf(stderr, "kernel_launch: hipFuncSetAttribute failed\n"); grid = -1; return; }
        if (hipOccupancyMaxActiveBlocksPerMultiprocessor(&per_cu, (const void*)fwd_kernel, 512, LDS_BYTES) != hipSuccess || per_cu < 1) { fprintf(stderr, "kernel_launch: occupancy query gave %d\n", per_cu); per_cu = 1; }
        (void)hipGetLastError();
        grid = cus * per_cu;
        if (grid > 256) grid = 256;
    }
    if (grid < 0) return;
    Params p{};
    for (int i = 0; i < 29; ++i) p.ptr[i] = d_in[i];
    p.ptr[29] = d_out; p.ptr[30] = d_ws; p.ptr[31] = nullptr;
    (void)hipMemsetAsync((unsigned char*)d_ws + WS_BAR, 0, 16384, stream);
#if ONE_LAUNCH
    p.ph_lo = 0; p.ph_hi = N_PHASES;
    void* args[] = {&p};
    hipError_t e = hipLaunchCooperativeKernel((const void*)fwd_kernel, dim3(grid), dim3(512), args, LDS_BYTES, stream);
    if (e != hipSuccess) fprintf(stderr, "cooperative launch failed: %s (grid %d)\n", hipGetErrorString(e), grid);
#else
    for (int ph = 0; ph < N_PHASES; ++ph) {
        p.ph_lo = ph; p.ph_hi = ph + 1;
        hipLaunchKernelGGL(fwd_kernel, dim3(grid), dim3(512), LDS_BYTES, stream, p);
    }
#endif
}
```

```cpp
#include <hip/hip_runtime.h>
#include <hip/hip_cooperative_groups.h>
#include <cstdio>
namespace cg = cooperative_groups;

#ifndef ONE_LAUNCH
#define ONE_LAUNCH 1
#endif

#define LAS __attribute__((address_space(3)))
typedef unsigned short bf16_t;
typedef short bf16x8 __attribute__((ext_vector_type(8)));
typedef float f32x4 __attribute__((ext_vector_type(4)));
typedef unsigned u32x4 __attribute__((ext_vector_type(4)));
typedef unsigned u32x2 __attribute__((ext_vector_type(2)));

constexpr int NTOK = 17408, NTP = 16384;
constexpr int LDB = 1792;
constexpr int LDA = 2560;
constexpr size_t O_CONVP = 17825792, O_CONVS = 17842176, O_SHIFTP = 18104320, O_SHIFTS = 18130944, O_WKVP = 18556928, O_WKVS = 19081216,
                 O_POOLP = 27469824, O_POOLS = 27592704, O_CHUNKV = 29558784;
constexpr size_t WS_WINE = 0;
constexpr size_t WS_WOUTE = WS_WINE + 2ull * 4352 * 1024 * 2;
constexpr size_t WS_WINO = WS_WOUTE + 2ull * 1024 * 1024 * 2;
constexpr size_t WS_WOUTO = WS_WINO + 2ull * 2560 * 1024 * 2;
constexpr size_t WS_W2T = WS_WOUTO + 2ull * 1024 * 1024 * 2;
constexpr size_t WS_A2T = WS_W2T + 2ull * 512 * 64 * 2;
constexpr size_t WS_POOLWT = WS_A2T + 2ull * 512 * 64 * 2;
constexpr size_t WS_SPW = WS_POOLWT + 8ull * 128 * 128 * 2;
constexpr size_t WS_XB = WS_SPW + 8ull * 128 * 128 * 2;
constexpr size_t WS_YCAT = WS_XB + (size_t)NTOK * 1024 * 2;
constexpr size_t WS_SSQ = WS_YCAT + (size_t)NTOK * 1024 * 2;
constexpr size_t WS_Y = WS_SSQ + 5ull * NTOK * 16 * 4;
constexpr size_t WS_R1 = WS_Y + (size_t)NTOK * 512 * 4;
constexpr size_t WS_PROJB = WS_R1;
constexpr size_t WS_WDEC = WS_PROJB + (size_t)NTOK * LDB * 2;
constexpr size_t WS_AA = WS_WDEC + (size_t)NTOK * 512 * 4;
constexpr size_t WS_BAR = WS_AA + (size_t)NTOK * 512 * 2;
constexpr size_t WS_END = WS_BAR + 16384;
constexpr int LDS_MAIN = 147456;
constexpr int LDS_BYTES = LDS_MAIN + 16;

struct Params {
    const void* ptr[32];
    int ph_lo, ph_hi;
};
struct Ctx { int tid, bid, nblk, z; };
#define PIN(i) ((const float*)p.ptr[(i) + cx.z])
#define POUT ((float*)p.ptr[29 + cx.z])
#define PWS ((unsigned char*)p.ptr[30 + cx.z])
enum { I_XP = 0, I_XS, I_SCONV, I_SSHIFT, I_SWKV, I_SPOOL, I_NORMW, I_FNORMW, I_WINE, I_CONVW, I_MU, I_W0, I_W2, I_A0, I_A2, I_KK, I_KA, I_RK, I_GNG, I_GNB,
       I_WOUTE, I_WINO, I_POOLW, I_PSCALE, I_LNG, I_LNB, I_SPW, I_SPB, I_WOUTO };

__device__ __forceinline__ unsigned cvt_pk_bf16(float lo, float hi) { unsigned r; asm("v_cvt_pk_bf16_f32 %0, %1, %2" : "=v"(r) : "v"(lo), "v"(hi)); return r; }
__device__ __forceinline__ float bf_lo(unsigned u) { return __uint_as_float(u << 16); }
__device__ __forceinline__ float bf_hi(unsigned u) { return __uint_as_float(u & 0xffff0000u); }
__device__ __forceinline__ float bf2f(bf16_t b) { return __uint_as_float(((unsigned)b) << 16); }
__device__ __forceinline__ f32x4 cvt4(u32x2 u) { return (f32x4){bf_lo(u.x), bf_hi(u.x), bf_lo(u.y), bf_hi(u.y)}; }
__device__ __forceinline__ f32x4 ld_bf4(const bf16_t* p) { return cvt4(*(const u32x2*)p); }
__device__ __forceinline__ void st_bf4(bf16_t* p, f32x4 v) { u32x2 u; u.x = cvt_pk_bf16(v[0], v[1]); u.y = cvt_pk_bf16(v[2], v[3]); *(u32x2*)p = u; }
__device__ __forceinline__ float sigmoidf_(float x) { return 1.0f / (1.0f + __expf(-x)); }
__device__ __forceinline__ float siluf_(float x) { return x / (1.0f + __expf(-x)); }
template <int CTRL> __device__ __forceinline__ float dpp_f(float x) { return __builtin_bit_cast(float, __builtin_amdgcn_mov_dpp(__builtin_bit_cast(int, x), CTRL, 0xf, 0xf, true)); }
__device__ __forceinline__ float allsum16(float x) { x += dpp_f<0xB1>(x); x += dpp_f<0x4E>(x); x += dpp_f<0x141>(x); x += dpp_f<0x128>(x); return x; }
__device__ __forceinline__ float allsum4(float x) { x += dpp_f<0xB1>(x); x += dpp_f<0x4E>(x); return x; }
__device__ __forceinline__ float dot4(f32x4 a, f32x4 b) { return a[0] * b[0] + a[1] * b[1] + a[2] * b[2] + a[3] * b[3]; }

__device__ __forceinline__ float ssq_sum(const float* part) {
    const f32x4 a = *(const f32x4*)(part), b = *(const f32x4*)(part + 4), c = *(const f32x4*)(part + 8), d = *(const f32x4*)(part + 12);
    return ((a[0] + a[1]) + (a[2] + a[3])) + ((b[0] + b[1]) + (b[2] + b[3])) + ((c[0] + c[1]) + (c[2] + c[3])) + ((d[0] + d[1]) + (d[2] + d[3]));
}

namespace pg8 {
constexpr int BM = 256, BK = 64, HALF = 128, HTB = HALF * BK * 2, NXCD = 8, WGM = 8;
__device__ __forceinline__ int lds_byte(int r, int c) { const int st = (r >> 4) * 2 + (c >> 5), rr = r & 15, cc = c & 31, ob = rr * 64 + cc * 2; return st * 1024 + (ob ^ (((ob >> 9) & 1) << 5)); }
__device__ __forceinline__ void stage_rc(int b, int& R, int& C) { const int st = b / 1024, sb = b % 1024, swz = sb ^ (((sb >> 9) & 1) << 5); R = (st >> 1) * 16 + swz / 64; C = (st & 1) * 32 + (swz % 64) / 2; }
__device__ __forceinline__ int perm32(int rho) { const int n = rho >> 4, i = rho & 15; return 8 * (i >> 2) + 4 * n + (i & 3); }
struct Unit { int pm, pn; };
struct Gemm { const bf16_t* A; const bf16_t* Bt; int M, N, K; };
struct StaticOrder {
    int nM, nN, nwg, G, c;
    __device__ void init(int M, int N, int G_, int c_) { nM = M / BM; nN = N / BM; nwg = nM * nN; G = G_; c = c_; }
    __device__ bool next(int i, Unit& u) const {
        const long L = (long)i * G + c; if (L >= nwg) return false;
        int wgid = (int)L; { const int q = nwg / NXCD, r = nwg % NXCD, xcd = wgid % NXCD, off = wgid / NXCD; wgid = (xcd < r ? xcd * (q + 1) : r * (q + 1) + (xcd - r) * q) + off; }
        const int nig = WGM * nN, gid = wgid / nig, fm = gid * WGM, gsz = (nM - fm) < WGM ? (nM - fm) : WGM;
        u.pm = fm + ((wgid % nig) % gsz); u.pn = (wgid % nig) / gsz; return true;
    }
};

template <class Epi>
__device__ __forceinline__ void gemm_phase(const Ctx cx, LAS unsigned char* lds, const Gemm g, const StaticOrder& S, const Epi& E) {
    const int tid = cx.tid, wid = __builtin_amdgcn_readfirstlane(tid >> 6), lane = tid & 63, wr = wid >> 2, wc = wid & 3, fr = lane & 15, fq = lane >> 4;
    const int K = g.K, nt = K / BK;
    unsigned voffA[2], voffB[2];
#pragma unroll
    for (int i = 0; i < 2; ++i) { int R, C; stage_rc(tid * 16 + i * 8192, R, C); const int Rb = Epi::PERM ? ((R & ~31) + perm32(R & 31)) : R;
        voffA[i] = (unsigned)(R * K + C) * 2u; voffB[i] = (unsigned)(Rb * K + C) * 2u; }
    const size_t kstep = (size_t)(BK * 2);
    const size_t hstep = (size_t)HALF * K * 2;
    const size_t tstep = 2 * hstep;
    const unsigned ldsw = (unsigned)wid * 1024u;
    const int aoff = lds_byte(wr * 64 + fr, fq * 8), boff = lds_byte(wc * 32 + fr, fq * 8);
#define PG8_SA(b, h) (((b) * 2 + (h)) * HTB)
#define PG8_SB(b, h) ((4 + (b) * 2 + (h)) * HTB)
#define PG8_STAGE(bufoff, gbase, voff) do { _Pragma("unroll") for (int _i = 0; _i < 2; ++_i) \
        __builtin_amdgcn_global_load_lds((const unsigned*)((const char*)(gbase) + (voff)[_i]), (LAS unsigned*)(lds + (bufoff) + ldsw + _i * 8192), 16, 0, 0); } while (0)
#define PG8_LDA(dst, b, h) do { _Pragma("unroll") for (int m = 0; m < 4; ++m) _Pragma("unroll") for (int k = 0; k < 2; ++k) dst[m][k] = *(const LAS bf16x8*)(lds + PG8_SA(b, h) + aoff + m * 2048 + k * 1024); } while (0)
#define PG8_LDB(dst, b, h) do { _Pragma("unroll") for (int n = 0; n < 2; ++n) _Pragma("unroll") for (int k = 0; k < 2; ++k) dst[n][k] = *(const LAS bf16x8*)(lds + PG8_SB(b, h) + boff + n * 2048 + k * 1024); } while (0)
#define PG8_MMA(ai, bj, At, Bt) do { __builtin_amdgcn_s_setprio(1); _Pragma("unroll") for (int m = 0; m < 4; ++m) _Pragma("unroll") for (int n = 0; n < 2; ++n) _Pragma("unroll") for (int k = 0; k < 2; ++k) \
        acc[ai][bj][m][n] = __builtin_amdgcn_mfma_f32_16x16x32_bf16(Bt[n][k], At[m][k], acc[ai][bj][m][n], 0, 0, 0); __builtin_amdgcn_s_setprio(0); } while (0)
#define PG8_WAIT_V(n) asm volatile("s_waitcnt vmcnt(" #n ")" ::: "memory")
#define PG8_WAIT_L(n) asm volatile("s_waitcnt lgkmcnt(" #n ")" ::: "memory")
#define PG8_BAR __builtin_amdgcn_s_barrier()
#define PG8_SCHED __builtin_amdgcn_sched_barrier(0)
    Unit cur, nxt; int ui = 0;
    if (!S.next(0, cur)) return;
    f32x4 acc[2][2][4][2];
#pragma unroll
    for (int a = 0; a < 2; ++a)
#pragma unroll
        for (int b = 0; b < 2; ++b)
#pragma unroll
            for (int m = 0; m < 4; ++m)
#pragma unroll
                for (int n = 0; n < 2; ++n) acc[a][b][m][n] = (f32x4){0.f, 0.f, 0.f, 0.f};
    bf16x8 At[4][2], B0[2][2], B1[2][2];
    const char* cA = (const char*)g.A + (size_t)cur.pm * tstep; const char* cB = (const char*)g.Bt + (size_t)cur.pn * tstep;
    PG8_STAGE(PG8_SB(0, 0), cB, voffB); PG8_STAGE(PG8_SA(0, 0), cA, voffA); PG8_STAGE(PG8_SB(0, 1), cB + hstep, voffB); PG8_STAGE(PG8_SA(0, 1), cA + hstep, voffA);
    if (wr == 1) PG8_BAR;
    PG8_WAIT_V(4); PG8_BAR;
    PG8_STAGE(PG8_SB(1, 0), cB + kstep, voffB); PG8_STAGE(PG8_SA(1, 0), cA + kstep, voffA); PG8_STAGE(PG8_SB(1, 1), cB + hstep + kstep, voffB);
    PG8_WAIT_V(6); PG8_BAR;
    for (;;) {
        const bool has_next = S.next(ui + 1, nxt);
        const char* nA = has_next ? (const char*)g.A + (size_t)nxt.pm * tstep : cA; const char* nB = has_next ? (const char*)g.Bt + (size_t)nxt.pn * tstep : cB;
        for (int t = 0; t < nt; t += 2) {
            const bool last = (t == nt - 2);
            const char* a1 = cA + (size_t)(t + 1) * kstep;
            const char* a2 = last ? nA : cA + (size_t)(t + 2) * kstep; const char* b2 = last ? nB : cB + (size_t)(t + 2) * kstep;
            const char* a3 = a2 + kstep; const char* b3 = b2 + kstep;
            PG8_LDB(B0, 0, 0); PG8_SCHED; PG8_LDA(At, 0, 0); PG8_STAGE(PG8_SA(1, 1), a1 + hstep, voffA);
            PG8_WAIT_L(8); PG8_BAR; PG8_WAIT_L(0); PG8_MMA(0, 0, At, B0); PG8_BAR; PG8_SCHED;
            PG8_LDB(B1, 0, 1); PG8_STAGE(PG8_SB(0, 0), b2, voffB);
            PG8_BAR; PG8_WAIT_L(0); PG8_MMA(0, 1, At, B1); PG8_BAR;
            PG8_LDA(At, 0, 1); PG8_STAGE(PG8_SA(0, 0), a2, voffA);
            PG8_BAR; PG8_WAIT_L(0); PG8_MMA(1, 0, At, B0); PG8_BAR; PG8_SCHED;
            PG8_STAGE(PG8_SB(0, 1), b2 + hstep, voffB);
            PG8_WAIT_V(6); PG8_BAR; PG8_MMA(1, 1, At, B1); PG8_BAR;
            PG8_LDB(B0, 1, 0); PG8_SCHED; PG8_LDA(At, 1, 0); PG8_STAGE(PG8_SA(0, 1), a2 + hstep, voffA);
            PG8_WAIT_L(8); PG8_BAR; PG8_WAIT_L(0); PG8_MMA(0, 0, At, B0); PG8_BAR; PG8_SCHED;
            PG8_LDB(B1, 1, 1); PG8_STAGE(PG8_SB(1, 0), b3, voffB);
            PG8_BAR; PG8_WAIT_L(0); PG8_MMA(0, 1, At, B1); PG8_BAR;
            PG8_LDA(At, 1, 1); PG8_STAGE(PG8_SA(1, 0), a3, voffA);
            PG8_BAR; PG8_WAIT_L(0); PG8_MMA(1, 0, At, B0); PG8_BAR; PG8_SCHED;
            PG8_STAGE(PG8_SB(1, 1), b3 + hstep, voffB);
            PG8_WAIT_V(6); PG8_BAR; PG8_MMA(1, 1, At, B1); PG8_BAR;
        }
        E(acc, cur, wr, wc, fr, fq);
        if (!has_next) break;
#pragma unroll
        for (int a = 0; a < 2; ++a)
#pragma unroll
            for (int b = 0; b < 2; ++b)
#pragma unroll
                for (int m = 0; m < 4; ++m)
#pragma unroll
                    for (int n = 0; n < 2; ++n) acc[a][b][m][n] = (f32x4){0.f, 0.f, 0.f, 0.f};
        cur = nxt; cA = nA; cB = nB; ++ui;
    }
    PG8_WAIT_V(0);
    if (wr == 0) PG8_BAR;
    PG8_BAR;
#undef PG8_SA
#undef PG8_SB
#undef PG8_STAGE
#undef PG8_LDA
#undef PG8_LDB
#undef PG8_MMA
#undef PG8_WAIT_V
#undef PG8_WAIT_L
#undef PG8_BAR
#undef PG8_SCHED
}
}

struct EpiProj {
    static constexpr bool PERM = true;
    bf16_t* O; int ldc; LAS const float* rl; int pm0, pm1, pm2, pm3;
    __device__ __forceinline__ void operator()(const f32x4 (&acc)[2][2][4][2], const pg8::Unit& u, int wr, int wc, int fr, int fq) const {
        const int row0 = u.pm * 256 + wr * 64 + fr, col0 = u.pn * 256 + wc * 32 + 8 * fq;
        const int sel = u.pm == pm0 ? 0 : (u.pm == pm1 ? 1 : (u.pm == pm2 ? 2 : 3));
        LAS const float* rp = rl + sel * 256 + wr * 64 + fr;
#pragma unroll
        for (int ai = 0; ai < 2; ++ai)
#pragma unroll
            for (int m = 0; m < 4; ++m) {
                const int row = row0 + ai * 128 + m * 16;
                const float rstd = rp[ai * 128 + m * 16];
                bf16_t* rowp = O + (size_t)row * ldc + col0;
#pragma unroll
                for (int bj = 0; bj < 2; ++bj) {
                    const f32x4 v0 = acc[ai][bj][m][0] * rstd, v1 = acc[ai][bj][m][1] * rstd;
                    u32x4 w; w.x = cvt_pk_bf16(v0[0], v0[1]); w.y = cvt_pk_bf16(v0[2], v0[3]); w.z = cvt_pk_bf16(v1[0], v1[1]); w.w = cvt_pk_bf16(v1[2], v1[3]);
                    *(u32x4*)(rowp + bj * 128) = w;
                }
            }
    }
};
struct X8 { f32x4 lo, hi; };
template <bool FIRST> __device__ __forceinline__ X8 ld_x8(const float* __restrict__ s32, const bf16_t* __restrict__ s16, size_t o) {
    X8 r;
    if (FIRST) { r.lo = *(const f32x4*)(s32 + o); r.hi = *(const f32x4*)(s32 + o + 4); }
    else { const u32x4 u = *(const u32x4*)(s16 + o); r.lo = cvt4((u32x2){u.x, u.y}); r.hi = cvt4((u32x2){u.z, u.w}); }
    return r;
}
__device__ __forceinline__ void st_x8(bf16_t* p, f32x4 lo, f32x4 hi) { u32x4 w; w.x = cvt_pk_bf16(lo[0], lo[1]); w.y = cvt_pk_bf16(lo[2], lo[3]); w.z = cvt_pk_bf16(hi[0], hi[1]); w.w = cvt_pk_bf16(hi[2], hi[3]); *(u32x4*)p = w; }
template <bool FIRST>
__device__ __forceinline__ void epi_res_rows(const f32x4 (&acc)[2][2][4][2], const float* __restrict__ src32, const bf16_t* __restrict__ src16, bf16_t* __restrict__ Xb, float* __restrict__ ssqp,
                                             int row0, int col0, int slot, int fq) {
    if constexpr (FIRST) {
#pragma unroll
        for (int ai = 0; ai < 2; ++ai) {
            X8 x[4][2];
#pragma unroll
            for (int m = 0; m < 4; ++m)
#pragma unroll
                for (int bj = 0; bj < 2; ++bj) x[m][bj] = ld_x8<true>(src32, src16, (size_t)(row0 + ai * 128 + m * 16) * 1024 + col0 + bj * 128);
#pragma unroll
            for (int m = 0; m < 4; ++m) {
                const int row = row0 + ai * 128 + m * 16;
                float part = 0.f;
#pragma unroll
                for (int bj = 0; bj < 2; ++bj) {
                    const f32x4 lo = x[m][bj].lo + acc[ai][bj][m][0], hi = x[m][bj].hi + acc[ai][bj][m][1];
                    st_x8(Xb + (size_t)row * 1024 + col0 + bj * 128, lo, hi);
                    part += dot4(lo, lo) + dot4(hi, hi);
                }
                part += __shfl_xor(part, 16); part += __shfl_xor(part, 32);
                if (fq == 0) ssqp[(size_t)row * 16 + slot] = part;
            }
        }
    } else {
        u32x4 xr[2][4][2];
#pragma unroll
        for (int ai = 0; ai < 2; ++ai)
#pragma unroll
            for (int m = 0; m < 4; ++m)
#pragma unroll
                for (int bj = 0; bj < 2; ++bj) xr[ai][m][bj] = *(const u32x4*)(src16 + (size_t)(row0 + ai * 128 + m * 16) * 1024 + col0 + bj * 128);
#pragma unroll
        for (int ai = 0; ai < 2; ++ai)
#pragma unroll
            for (int m = 0; m < 4; ++m) {
                const int row = row0 + ai * 128 + m * 16;
                float part = 0.f;
#pragma unroll
                for (int bj = 0; bj < 2; ++bj) {
                    const u32x4 u = xr[ai][m][bj];
                    const f32x4 lo = cvt4((u32x2){u.x, u.y}) + acc[ai][bj][m][0], hi = cvt4((u32x2){u.z, u.w}) + acc[ai][bj][m][1];
                    st_x8(Xb + (size_t)row * 1024 + col0 + bj * 128, lo, hi);
                    part += dot4(lo, lo) + dot4(hi, hi);
                }
                part += __shfl_xor(part, 16); part += __shfl_xor(part, 32);
                if (fq == 0) ssqp[(size_t)row * 16 + slot] = part;
            }
    }
}
struct EpiRes {
    static constexpr bool PERM = true;
    const float* xp; const float* xs; bf16_t* Xb; float* ssq_next;
    __device__ __forceinline__ void operator()(const f32x4 (&acc)[2][2][4][2], const pg8::Unit& u, int wr, int wc, int fr, int fq) const {
        const int row0 = u.pm * 256 + wr * 64 + fr, col0 = u.pn * 256 + wc * 32 + 8 * fq;
        if (xp) epi_res_rows<true>(acc, row0 < NTP ? xp : xs - (size_t)NTP * 1024, nullptr, Xb, ssq_next, row0, col0, u.pn * 4 + wc, fq);
        else epi_res_rows<false>(acc, nullptr, Xb, Xb, ssq_next, row0, col0, u.pn * 4 + wc, fq);
    }
};

template <bool FIRST>
__device__ __forceinline__ void res_sample_tile(const Ctx cx, const bf16_t* __restrict__ A, const bf16_t* __restrict__ Bt, const float* __restrict__ xs, bf16_t* __restrict__ Xb, float* __restrict__ ssqp, int tile) {
    const int tid = cx.tid, wid = tid >> 6, lane = tid & 63, fr = lane & 15, fq = lane >> 4;
    const int tm = tile >> 3, tn = tile & 7;
    const int r0 = NTP + tm * 64 + (wid & 3) * 16, c0 = tn * 128 + (wid >> 2) * 64;
    const bf16_t* ap = A + (size_t)(r0 + fr) * 1024 + fq * 8;
    const bf16_t* bp = Bt + (size_t)(c0 + fr) * 1024 + fq * 8;
    f32x4 acc[4];
#pragma unroll
    for (int nt = 0; nt < 4; ++nt) acc[nt] = (f32x4){0.f, 0.f, 0.f, 0.f};
#pragma unroll 8
    for (int ks = 0; ks < 32; ++ks) {
        const bf16x8 af = *(const bf16x8*)(ap + ks * 32);
#pragma unroll
        for (int nt = 0; nt < 4; ++nt) {
            const bf16x8 bf = *(const bf16x8*)(bp + (size_t)nt * 16 * 1024 + ks * 32);
            acc[nt] = __builtin_amdgcn_mfma_f32_16x16x32_bf16(bf, af, acc[nt], 0, 0, 0);
        }
    }
    const int row = r0 + fr;
    float part = 0.f;
#pragma unroll
    for (int nt = 0; nt < 4; ++nt) {
        const int col = c0 + nt * 16 + fq * 4;
        const f32x4 xo = FIRST ? *(const f32x4*)(xs + (size_t)(row - NTP) * 1024 + col) : ld_bf4(Xb + (size_t)row * 1024 + col);
        const f32x4 v = xo + acc[nt];
        st_bf4(Xb + (size_t)row * 1024 + col, v);
        part += dot4(v, v);
    }
    part += __shfl_xor(part, 16); part += __shfl_xor(part, 32);
    if (fq == 0) ssqp[(size_t)row * 16 + (c0 >> 6)] = part;
}

struct TrJob { const float* src; int ld, col0, k0; bf16_t* dst; int Ktot, drow0; const float* scale; bool zero; };
__device__ __forceinline__ TrJob tr_decode(const Params& p, const Ctx cx, int job) {
    TrJob J; J.zero = false; J.scale = nullptr;
    int j = job;
    if (j < 2176) {
        const int i = j / 1088, r = j % 1088, nt = r / 16, kt = r % 16, n0 = nt * 64;
        int col0 = 0;
        if (n0 < 2048) col0 = n0; else if (n0 < 2560) col0 = 3712 + (n0 - 2048); else if (n0 < 4224) col0 = 2048 + (n0 - 2560); else J.zero = true;
        J.src = PIN(I_WINE) + (size_t)i * 1024 * 4224; J.ld = 4224; J.col0 = col0; J.k0 = kt * 64; J.dst = (bf16_t*)(PWS + WS_WINE) + (size_t)i * 4352 * 1024; J.Ktot = 1024; J.drow0 = n0; J.scale = PIN(I_NORMW) + (2 * i) * 1024;
        return J;
    }
    j -= 2176;
    if (j < 512) { const int i = j / 256, r = j % 256, nt = r / 16, kt = r % 16;
        J.src = PIN(I_WOUTE) + (size_t)i * 1024 * 1024; J.ld = 1024; J.col0 = nt * 64; J.k0 = kt * 64; J.dst = (bf16_t*)(PWS + WS_WOUTE) + (size_t)i * 1024 * 1024; J.Ktot = 1024; J.drow0 = nt * 64; return J; }
    j -= 512;
    if (j < 1280) { const int i = j / 640, r = j % 640, nt = r / 16, kt = r % 16;
        J.src = PIN(I_WINO) + (size_t)i * 1024 * 2560; J.ld = 2560; J.col0 = nt * 64; J.k0 = kt * 64; J.dst = (bf16_t*)(PWS + WS_WINO) + (size_t)i * 2560 * 1024; J.Ktot = 1024; J.drow0 = nt * 64; J.scale = PIN(I_NORMW) + (2 * i + 1) * 1024; return J; }
    j -= 1280;
    if (j < 512) { const int i = j / 256, r = j % 256, nt = r / 16, kt = r % 16;
        J.src = PIN(I_WOUTO) + (size_t)i * 1024 * 1024; J.ld = 1024; J.col0 = nt * 64; J.k0 = kt * 64; J.dst = (bf16_t*)(PWS + WS_WOUTO) + (size_t)i * 1024 * 1024; J.Ktot = 1024; J.drow0 = nt * 64; return J; }
    j -= 512;
    if (j < 16) { const int i = j / 8, nt = j % 8;
        J.src = PIN(I_W2) + (size_t)i * 64 * 512; J.ld = 512; J.col0 = nt * 64; J.k0 = 0; J.dst = (bf16_t*)(PWS + WS_W2T) + (size_t)i * 512 * 64; J.Ktot = 64; J.drow0 = nt * 64; return J; }
    j -= 16;
    if (j < 16) { const int i = j / 8, nt = j % 8;
        J.src = PIN(I_A2) + (size_t)i * 64 * 512; J.ld = 512; J.col0 = nt * 64; J.k0 = 0; J.dst = (bf16_t*)(PWS + WS_A2T) + (size_t)i * 512 * 64; J.Ktot = 64; J.drow0 = nt * 64; return J; }
    j -= 16;
    { const int ig = j / 4, r = j % 4, nt = r / 2, kt = r % 2;
        J.src = PIN(I_POOLW) + (size_t)ig * 128 * 128; J.ld = 128; J.col0 = nt * 64; J.k0 = kt * 64; J.dst = (bf16_t*)(PWS + WS_POOLWT) + (size_t)ig * 128 * 128; J.Ktot = 128; J.drow0 = nt * 64; }
    return J;
}
__device__ __forceinline__ void tr_load(const TrJob& J, int tid, f32x4& va, f32x4& vb) {
    const int nn = (tid & 15) * 4, ka = tid >> 4, kb = ka + 32;
    va = (f32x4){0.f, 0.f, 0.f, 0.f}; vb = va;
    if (!J.zero) {
        va = *(const f32x4*)(J.src + (size_t)(J.k0 + ka) * J.ld + J.col0 + nn); vb = *(const f32x4*)(J.src + (size_t)(J.k0 + kb) * J.ld + J.col0 + nn);
        if (J.scale) { va = va * J.scale[J.k0 + ka]; vb = vb * J.scale[J.k0 + kb]; }
    }
}

__device__ void phase_prepass(const Params& p, const Ctx cx, LAS unsigned char* lds) {
    LAS float* T = (LAS float*)lds;
    const int tid = cx.tid;
    {
        int job = cx.bid;
        f32x4 va = (f32x4){0.f, 0.f, 0.f, 0.f}, vb = va;
        if (job < 4544) { const TrJob J0 = tr_decode(p, cx, job); tr_load(J0, tid, va, vb); }
        for (; job < 4544; job += cx.nblk) {
            f32x4 na = va, nb = vb;
            if (job + (int)cx.nblk < 4544) { const TrJob Jn = tr_decode(p, cx, job + (int)cx.nblk); tr_load(Jn, tid, na, nb); }
            {
                const int nn = (tid & 15) * 4, ka = tid >> 4, kb = ka + 32;
                T[ka * 65 + nn] = va[0]; T[ka * 65 + nn + 1] = va[1]; T[ka * 65 + nn + 2] = va[2]; T[ka * 65 + nn + 3] = va[3];
                T[kb * 65 + nn] = vb[0]; T[kb * 65 + nn + 1] = vb[1]; T[kb * 65 + nn + 2] = vb[2]; T[kb * 65 + nn + 3] = vb[3];
            }
            __syncthreads();
            {
                const TrJob J = tr_decode(p, cx, job);
                const int n = tid >> 3, kc = (tid & 7) * 8;
                u32x4 w;
                w.x = cvt_pk_bf16(T[(kc + 0) * 65 + n], T[(kc + 1) * 65 + n]); w.y = cvt_pk_bf16(T[(kc + 2) * 65 + n], T[(kc + 3) * 65 + n]);
                w.z = cvt_pk_bf16(T[(kc + 4) * 65 + n], T[(kc + 5) * 65 + n]); w.w = cvt_pk_bf16(T[(kc + 6) * 65 + n], T[(kc + 7) * 65 + n]);
                *(u32x4*)(J.dst + (size_t)(J.drow0 + n) * J.Ktot + J.k0 + kc) = w;
            }
            __syncthreads();
            va = na; vb = nb;
        }
    }
    const int gtid = cx.bid * 512 + tid, gthreads = cx.nblk * 512;
    for (int e = gtid; e < 8 * 128 * 128; e += gthreads) {
        const int s = e & 127, t = (e >> 7) & 127;
        ((bf16_t*)(PWS + WS_SPW))[e] = (s <= t) ? (bf16_t)(cvt_pk_bf16(PIN(I_SPW)[e], 0.f) & 0xffffu) : (bf16_t)0;
    }
    const int wid = tid >> 6, lane = tid & 63;
    for (int row0 = cx.bid * 8 + wid; row0 < NTOK; row0 += cx.nblk * 8 * 3) {
        f32x4 v[3][4];
#pragma unroll
        for (int r = 0; r < 3; ++r) {
            const int row = row0 + r * cx.nblk * 8; const int rr = row < NTOK ? row : row0;
            const float* src = rr < NTP ? PIN(I_XP) + (size_t)rr * 1024 : PIN(I_XS) + (size_t)(rr - NTP) * 1024;
#pragma unroll
            for (int i = 0; i < 4; ++i) v[r][i] = *(const f32x4*)(src + i * 256 + lane * 4);
        }
#pragma unroll
        for (int r = 0; r < 3; ++r) {
            const int row = row0 + r * cx.nblk * 8;
            if (row < NTOK) {
                bf16_t* dst = (bf16_t*)(PWS + WS_XB) + (size_t)row * 1024;
                float ss = 0.f;
#pragma unroll
                for (int i = 0; i < 4; ++i) { ss += dot4(v[r][i], v[r][i]); st_bf4(dst + i * 256 + lane * 4, v[r][i]); }
#pragma unroll
                for (int o = 32; o >= 1; o >>= 1) ss += __shfl_xor(ss, o);
                if (lane < 16) ((float*)(PWS + WS_SSQ))[(size_t)row * 16 + lane] = (lane == 0) ? ss : 0.f;
            }
        }
    }
}

__device__ __forceinline__ f32x4 shift4(const bf16_t* cur, bool hp, const float* st, int col, const float* mu) {
    const f32x4 q = ld_bf4(cur + col);
    f32x4 pv;
    if (hp) pv = ld_bf4(cur - LDB + col); else if (st) pv = *(const f32x4*)(st + col); else pv = (f32x4){0.f, 0.f, 0.f, 0.f};
    const f32x4 m = *(const f32x4*)(mu + col);
    return q + m * (pv - q);
}

__device__ void phase_even_prep(const Params& p, const Ctx cx, int pair, LAS unsigned char* lds) {
    const int tid = cx.tid, wid = tid >> 6, lane = tid & 63, fr = lane & 15, fq = lane >> 4;
    const bf16_t* PB = (const bf16_t*)(PWS + WS_PROJB);
    float* Wdec = (float*)(PWS + WS_WDEC);
    bf16_t* Aa = (bf16_t*)(PWS + WS_AA);
    bf16_t* Ycat = (bf16_t*)(PWS + WS_YCAT);
    const float* mu_ = PIN(I_MU) + pair * 1664;
    const float* w0_ = PIN(I_W0) + pair * 512; const float* a0_ = PIN(I_A0) + pair * 512;
    const float* k_a_ = PIN(I_KA) + pair * 512; const float* r_k_ = PIN(I_RK) + pair * 512;
    constexpr int RS = 3344;
    constexpr int TB = 17 * RS;
    constexpr int NCH = 17 * 208;
    const int h = wid;
    bf16x8 wfr[4][2], afr[4][2];
    {
        const bf16_t* W2T = (const bf16_t*)(PWS + WS_W2T) + (size_t)pair * 512 * 64;
        const bf16_t* A2T = (const bf16_t*)(PWS + WS_A2T) + (size_t)pair * 512 * 64;
#pragma unroll
        for (int nt = 0; nt < 4; ++nt)
#pragma unroll
            for (int ks = 0; ks < 2; ++ks) {
                wfr[nt][ks] = *(const bf16x8*)(W2T + (size_t)(h * 64 + nt * 16 + fr) * 64 + ks * 32 + fq * 8);
                afr[nt][ks] = *(const bf16x8*)(A2T + (size_t)(h * 64 + nt * 16 + fr) * 64 + ks * 32 + fq * 8);
            }
    }
    constexpr int TBD = 56 * 1024;
    const int widu = __builtin_amdgcn_readfirstlane(tid >> 6);
#define PREP_DMA(tile_, b_, lane_) do { _Pragma("unroll") for (int i_ = 0; i_ < 7; ++i_) { const int k_ = widu * 7 + i_, q_ = k_ * 64 + (lane_); \
            int lr_ = q_ / 209, cc_ = q_ - lr_ * 209; if (lr_ > 16) { lr_ = 16; cc_ = 0; } if (cc_ > 207) cc_ = 0; \
            int gr_ = (tile_) * 16 - 1 + lr_; gr_ = gr_ < 0 ? 0 : gr_; \
            __builtin_amdgcn_global_load_lds((const unsigned*)(PB + (size_t)gr_ * LDB + cc_ * 8), (LAS unsigned*)(lds + (b_) * TBD + k_ * 1024), 16, 0, 0); } } while (0)
    int buf = 0;
    if ((int)cx.bid < NTOK / 16) PREP_DMA((int)cx.bid, 0, tid & 63);
    asm volatile("s_waitcnt vmcnt(0)" ::: "memory");
    __syncthreads();
    for (int tile = cx.bid; tile < NTOK / 16; tile += cx.nblk) {
        int zz; asm volatile("v_mov_b32 %0, 0" : "=v"(zz));
        const int tidv = tid + zz, fr = (tidv & 15), fq = (tidv >> 4) & 3;
        if (tile + (int)cx.nblk < NTOK / 16) PREP_DMA(tile + (int)cx.nblk, buf ^ 1, tidv & 63);
        {
            const int row = tile * 16 + fr;
            const bool samp = row >= NTP;
            int b, t; if (!samp) { b = row >> 11; t = row & 2047; } else { const int q = row - NTP; b = q >> 3; t = q & 7; }
            const bool hp = t > 0;
            const float* st = samp ? PIN(I_SSHIFT) + ((size_t)pair * 128 + b) * 1664 : nullptr;
            const float* mu = mu_ + zz; const float* w0 = w0_ + zz; const float* a0 = a0_ + zz; const float* k_a = k_a_ + zz; const float* r_k = r_k_ + zz;
            LAS const unsigned char* curL = lds + buf * TBD + (fr + 1) * RS;
            LAS const unsigned char* prvL = lds + buf * TBD + fr * RS;
            auto sh4 = [&](int col) -> f32x4 {
                const f32x4 q = cvt4(*(LAS const u32x2*)(curL + col * 2));
                f32x4 pv;
                if (hp) pv = cvt4(*(LAS const u32x2*)(prvL + col * 2)); else if (st) pv = *(const f32x4*)(st + col); else pv = (f32x4){0.f, 0.f, 0.f, 0.f};
                const f32x4 m = *(const f32x4*)(mu + col);
                return q + m * (pv - q);
            };
            bf16x8 Aw[2], Al[2];
#pragma unroll
            for (int ks = 0; ks < 2; ++ks) {
                const int cw = 1536 + ks * 32 + fq * 8, ca = 1600 + ks * 32 + fq * 8;
                const f32x4 w_lo = sh4(cw), w_hi = sh4(cw + 4), a_lo = sh4(ca), a_hi = sh4(ca + 4);
                u32x4 pw, pa;
                float th[8];
#pragma unroll
                for (int j = 0; j < 4; ++j) { th[j] = 2.0f * sigmoidf_(2.0f * w_lo[j]) - 1.0f; th[4 + j] = 2.0f * sigmoidf_(2.0f * w_hi[j]) - 1.0f; }
                pw.x = cvt_pk_bf16(th[0], th[1]); pw.y = cvt_pk_bf16(th[2], th[3]); pw.z = cvt_pk_bf16(th[4], th[5]); pw.w = cvt_pk_bf16(th[6], th[7]);
                pa.x = cvt_pk_bf16(a_lo[0], a_lo[1]); pa.y = cvt_pk_bf16(a_lo[2], a_lo[3]); pa.z = cvt_pk_bf16(a_hi[0], a_hi[1]); pa.w = cvt_pk_bf16(a_hi[2], a_hi[3]);
                Aw[ks] = __builtin_bit_cast(bf16x8, pw); Al[ks] = __builtin_bit_cast(bf16x8, pa);
            }
            float bon = 0.f;
#pragma unroll
            for (int nt = 0; nt < 4; ++nt) {
                f32x4 lw = (f32x4){0.f, 0.f, 0.f, 0.f}, la = (f32x4){0.f, 0.f, 0.f, 0.f};
#pragma unroll
                for (int ks = 0; ks < 2; ++ks) {
                    lw = __builtin_amdgcn_mfma_f32_16x16x32_bf16(wfr[nt][ks], Aw[ks], lw, 0, 0, 0);
                    la = __builtin_amdgcn_mfma_f32_16x16x32_bf16(afr[nt][ks], Al[ks], la, 0, 0, 0);
                }
                const int ch = h * 64 + nt * 16 + fq * 4;
                const f32x4 r4 = sh4(ch), k4 = sh4(512 + ch);
                const f32x4 w04 = *(const f32x4*)(w0 + ch), a04 = *(const f32x4*)(a0 + ch), ka4 = *(const f32x4*)(k_a + ch), rk4 = *(const f32x4*)(r_k + ch);
                f32x4 dec, av;
#pragma unroll
                for (int j = 0; j < 4; ++j) {
                    const float z_ = -(w04[j] + lw[j]);
                    const float wlog = -__logf(1.0f + __expf(z_)) - 0.5f;
                    dec[j] = __expf(-__expf(wlog));
                    av[j] = sigmoidf_(a04[j] + la[j]);
                    const float kp = k4[j] * (1.0f + (av[j] - 1.0f) * ka4[j]);
                    bon += r4[j] * kp * rk4[j];
                }
                *(f32x4*)(Wdec + (size_t)row * 512 + ch) = dec;
                st_bf4(Aa + (size_t)row * 512 + ch, av);
            }
            bon += __shfl_xor(bon, 16); bon += __shfl_xor(bon, 32);
#pragma unroll
            for (int nt = 0; nt < 4; ++nt) { const int ch = h * 64 + nt * 16 + fq * 4; st_bf4(Ycat + (size_t)row * 1024 + 512 + ch, sh4(1024 + ch) * bon); }
        }
        asm volatile("s_waitcnt vmcnt(0)" ::: "memory");
        __syncthreads();
        buf ^= 1;
    }
#undef PREP_DMA
    const int gtid = cx.bid * 512 + tid, gthreads = cx.nblk * 512;
    for (int e = gtid; e < 136 * 1664; e += gthreads) {
        const int sr = e / 1664, c = e % 1664;
        if (sr < 8) POUT[O_SHIFTP + ((size_t)pair * 8 + sr) * 1664 + c] = bf2f(PB[(size_t)(sr * 2048 + 2047) * LDB + c]);
        else { const int b = sr - 8; POUT[O_SHIFTS + ((size_t)pair * 128 + b) * 1664 + c] = bf2f(PB[(size_t)(NTP + b * 8 + 7) * LDB + c]); }
    }
}

typedef float f32x2 __attribute__((ext_vector_type(2)));
template <bool RED = true>
__device__ __forceinline__ void scan_step(f32x4& S, const f32x4 w, const f32x4 k, const f32x4 kk, const f32x4 nb, const f32x4 r, const float v, float& y) {
    const f32x2 S01 = {S[0], S[1]}, S23 = {S[2], S[3]};
    f32x2 pp = S01 * (f32x2){kk[0], kk[1]};
    pp = S23 * (f32x2){kk[2], kk[3]} + pp;
    float pd = pp[0] + pp[1];
    const f32x2 vv = {v, v};
    const f32x2 t01 = S01 * (f32x2){w[0], w[1]} + (f32x2){k[0], k[1]} * vv;
    const f32x2 t23 = S23 * (f32x2){w[2], w[3]} + (f32x2){k[2], k[3]} * vv;
    pd = allsum16(pd);
    const f32x2 pdv = {pd, pd};
    const f32x2 n01 = (f32x2){nb[0], nb[1]} * pdv + t01, n23 = (f32x2){nb[2], nb[3]} * pdv + t23;
    S = (f32x4){n01[0], n01[1], n23[0], n23[1]};
    f32x2 q = n01 * (f32x2){r[0], r[1]};
    q = n23 * (f32x2){r[2], r[3]} + q;
    y = RED ? allsum16(q[0] + q[1]) : (q[0] + q[1]);
}
__device__ __forceinline__ float reduce_scatter16(const float (&yp)[16], int cgi) {
    const bool b3 = cgi & 8, b2 = cgi & 4, b1 = cgi & 2, b0 = cgi & 1;
    float a[8], bq[4], c[2];
#pragma unroll
    for (int j = 0; j < 8; ++j) { const float keep = b3 ? yp[8 + j] : yp[j], send = b3 ? yp[j] : yp[8 + j]; a[j] = keep + dpp_f<0x128>(send); }
#pragma unroll
    for (int k = 0; k < 4; ++k) { const float keep = b2 ? a[4 + k] : a[k], send = b2 ? a[k] : a[4 + k]; bq[k] = keep + dpp_f<0x141>(send); }
#pragma unroll
    for (int m = 0; m < 2; ++m) { const float keep = b1 ? bq[2 + m] : bq[m], send = b1 ? bq[m] : bq[2 + m]; c[m] = keep + dpp_f<0x4E>(send); }
    const float keep = b0 ? c[1] : c[0], send = b0 ? c[0] : c[1];
    return keep + dpp_f<0xB1>(send);
}

__device__ void phase_scan(const Params& p, const Ctx cx, int pair, LAS unsigned char* lds) {
    const int tid = cx.tid, wid = tid >> 6, lane = tid & 63, rs = lane >> 4, cgi = lane & 15;
    const bf16_t* PB = (const bf16_t*)(PWS + WS_PROJB);
    const float* Wdec = (const float*)(PWS + WS_WDEC);
    const bf16_t* Aa = (const bf16_t*)(PWS + WS_AA);
    float* Y = (float*)(PWS + WS_Y);
    const float* mu = PIN(I_MU) + pair * 1664;
    const float* k_k = PIN(I_KK) + pair * 512; const float* k_a = PIN(I_KA) + pair * 512;
    {
        LAS float* vb = (LAS float*)lds + wid * 3072;
        for (int st = cx.bid * 8 + wid; st < 2048; st += cx.nblk * 8) {
            const int bh = st >> 1, half = st & 1, b = bh >> 3, h = bh & 7, ch = h * 64 + cgi * 4;
            const float* stp = PIN(I_SSHIFT) + ((size_t)pair * 128 + b) * 1664;
            const f32x4 kkc = *(const f32x4*)(k_k + ch), kac = *(const f32x4*)(k_a + ch);
            {
#pragma unroll
                for (int tt = 0; tt < 2; ++tt) {
                    const int t = rs + tt * 4;
                    const size_t row = NTP + b * 8 + t;
                    const bf16_t* cur = PB + row * LDB;
                    const f32x4 r = shift4(cur, t > 0, stp, ch, mu), k = shift4(cur, t > 0, stp, 512 + ch, mu), v = shift4(cur, t > 0, stp, 1024 + ch, mu);
                    const f32x4 a = ld_bf4(Aa + row * 512 + ch);
                    const f32x4 w = *(const f32x4*)(Wdec + row * 512 + ch);
                    const f32x4 kkv = k * kkc;
                    const float ss = allsum16(dot4(kkv, kkv));
                    const float inv = 1.0f / fmaxf(sqrtf(ss), 1e-12f);
                    const f32x4 kkn = kkv * inv;
                    LAS float* o = vb + t * 384 + cgi * 4;
                    *(LAS f32x4*)(o) = w; *(LAS f32x4*)(o + 64) = k * (1.0f + (a - 1.0f) * kac); *(LAS f32x4*)(o + 128) = kkn; *(LAS f32x4*)(o + 192) = -(kkn * a);
                    *(LAS f32x4*)(o + 256) = r; *(LAS f32x4*)(o + 320) = v;
                }
            }
            asm volatile("s_waitcnt lgkmcnt(0)" ::: "memory");
            __builtin_amdgcn_wave_barrier();
            const size_t so0 = ((((size_t)pair * 128 + b) * 8 + h) * 64 + half * 32 + rs) * 64 + cgi * 4;
            f32x4 Snext = *(const f32x4*)(PIN(I_SWKV) + so0);
#pragma unroll 1
            for (int rq = 0; rq < 8; ++rq) {
                const int ri = half * 32 + rq * 4 + rs;
                const size_t so = so0 + (size_t)rq * 256;
                f32x4 S = Snext;
                if (rq + 1 < 8) Snext = *(const f32x4*)(PIN(I_SWKV) + so + 256);
#pragma unroll
                for (int t = 0; t < 8; ++t) {
                    LAS const float* r0 = vb + t * 384 + cgi * 4;
                    float y; scan_step(S, *(LAS const f32x4*)(r0), *(LAS const f32x4*)(r0 + 64), *(LAS const f32x4*)(r0 + 128), *(LAS const f32x4*)(r0 + 192), *(LAS const f32x4*)(r0 + 256), vb[t * 384 + 320 + ri], y);
                    if (cgi == 0) Y[(size_t)(NTP + b * 8 + t) * 512 + h * 64 + ri] = y;
                }
                *(f32x4*)(POUT + O_WKVS + so) = S;
            }
            asm volatile("s_waitcnt lgkmcnt(0)" ::: "memory");
            __builtin_amdgcn_wave_barrier();
        }
    }
    __syncthreads();
    LAS float* rec = (LAS float*)lds;
    for (int pt = cx.bid; pt < 256; pt += cx.nblk) {
        const int xcd = pt & 7, slot = pt >> 3, bh = xcd * 8 + (slot >> 2), rg = slot & 3, b = bh >> 3, h = bh & 7;
        const int lt = tid - 256, ls = (lt >> 4) & 15, lcg = lt & 15, lch = h * 64 + lcg * 4;
        u32x2 qr = {0u, 0u}, qk = {0u, 0u}, qv = {0u, 0u}, pr = {0u, 0u}, pk = {0u, 0u}, pv = {0u, 0u}, qa = {0u, 0u};
        f32x4 qw = (f32x4){0.f, 0.f, 0.f, 0.f};
        f32x4 mur, muk, muv, kkc, kac;
        const int ri = rg * 16 + (wid & 3) * 4 + rs;
        f32x4 S = (f32x4){0.f, 0.f, 0.f, 0.f};
#define SCAN_ISSUE(c) do { const int t_ = (c) * 16 + ls; const size_t row_ = (size_t)b * 2048 + t_; const bf16_t* cur_ = PB + row_ * LDB; \
            qr = *(const u32x2*)(cur_ + lch); qk = *(const u32x2*)(cur_ + 512 + lch); qv = *(const u32x2*)(cur_ + 1024 + lch); \
            if (t_ > 0) { pr = *(const u32x2*)(cur_ - LDB + lch); pk = *(const u32x2*)(cur_ - LDB + 512 + lch); pv = *(const u32x2*)(cur_ - LDB + 1024 + lch); } \
            else { pr = (u32x2){0u, 0u}; pk = pr; pv = pr; } \
            qw = *(const f32x4*)(Wdec + row_ * 512 + lch); qa = *(const u32x2*)(Aa + row_ * 512 + lch); } while (0)
#define SCAN_PROCESS(buf) do { const f32x4 r0_ = cvt4(qr), k0_ = cvt4(qk), v0_ = cvt4(qv); \
            const f32x4 r_ = r0_ + mur * (cvt4(pr) - r0_), k_ = k0_ + muk * (cvt4(pk) - k0_), v_ = v0_ + muv * (cvt4(pv) - v0_), a_ = cvt4(qa); \
            const f32x4 kkv_ = k_ * kkc; const float ss_ = allsum16(dot4(kkv_, kkv_)); const float inv_ = __builtin_amdgcn_rsqf(fmaxf(ss_, 1e-24f)); \
            const f32x4 kkn_ = kkv_ * inv_; \
            LAS float* o_ = rec + (buf) * 6144 + ls * 384 + lcg * 4; \
            *(LAS f32x4*)(o_) = qw; *(LAS f32x4*)(o_ + 64) = k_ * (1.0f + (a_ - 1.0f) * kac); *(LAS f32x4*)(o_ + 128) = kkn_; *(LAS f32x4*)(o_ + 192) = -(kkn_ * a_); \
            *(LAS f32x4*)(o_ + 256) = r_; *(LAS f32x4*)(o_ + 320) = v_; } while (0)
        if (wid >= 4) {
            mur = *(const f32x4*)(mu + lch); muk = *(const f32x4*)(mu + 512 + lch); muv = *(const f32x4*)(mu + 1024 + lch);
            kkc = *(const f32x4*)(k_k + lch); kac = *(const f32x4*)(k_a + lch);
            SCAN_ISSUE(0); SCAN_PROCESS(0); SCAN_ISSUE(1);
        }
        __syncthreads();
        for (int c = 0; c < 128; ++c) {
            if (wid < 4) {
                LAS const float* rb = rec + (c & 1) * 6144 + cgi * 4;
                LAS const float* rv = rec + (c & 1) * 6144 + 320 + ri;
                float yp[16];
                f32x4 nw = *(LAS const f32x4*)(rb), nk = *(LAS const f32x4*)(rb + 64), nkk = *(LAS const f32x4*)(rb + 128), nb = *(LAS const f32x4*)(rb + 192), nr = *(LAS const f32x4*)(rb + 256);
                float nv = rv[0];
#pragma unroll
                for (int s = 0; s < 16; ++s) {
                    const f32x4 cw = nw, ck = nk, ckk = nkk, cb = nb, cr = nr; const float cv = nv;
                    if (s + 1 < 16) {
                        LAS const float* r1 = rb + (s + 1) * 384;
                        nw = *(LAS const f32x4*)(r1); nk = *(LAS const f32x4*)(r1 + 64); nkk = *(LAS const f32x4*)(r1 + 128); nb = *(LAS const f32x4*)(r1 + 192); nr = *(LAS const f32x4*)(r1 + 256);
                        nv = rv[(s + 1) * 384];
                    }
                    scan_step<false>(S, cw, ck, ckk, cb, cr, cv, yp[s]);
                }
                Y[((size_t)b * 2048 + c * 16 + cgi) * 512 + h * 64 + ri] = reduce_scatter16(yp, cgi);
            } else {
                if (c + 1 < 128) { SCAN_PROCESS((c + 1) & 1); if (c + 2 < 128) SCAN_ISSUE(c + 2); }
            }
            __syncthreads();
        }
        if (wid < 4) *(f32x4*)(POUT + O_WKVP + ((((size_t)pair * 8 + b) * 8 + h) * 64 + ri) * 64 + cgi * 4) = S;
#undef SCAN_ISSUE
#undef SCAN_PROCESS
    }
}

__device__ void phase_even_post(const Params& p, const Ctx cx, int pair) {
    const int gtid = cx.bid * 512 + cx.tid, gthreads = cx.nblk * 512;
    const bf16_t* PA = (const bf16_t*)(PWS + WS_R1);
    bf16_t* Ycat = (bf16_t*)(PWS + WS_YCAT);
    const float* Y = (const float*)(PWS + WS_Y);
    constexpr int NIT = NTOK * 128, UB = 4;
    const float* gn_g = PIN(I_GNG) + pair * 512; const float* gn_b = PIN(I_GNB) + pair * 512;
    for (int e0 = gtid; e0 < NIT; e0 += gthreads * UB) {
        f32x4 y[UB], bv[UB], bz[UB]; bool ok[UB];
#pragma unroll
        for (int u = 0; u < UB; ++u) {
            const int e = e0 + u * gthreads; ok[u] = e < NIT;
            const int ee = ok[u] ? e : e0; const int row = ee >> 7, ch = (ee & 127) * 4;
            y[u] = *(const f32x4*)(Y + (size_t)row * 512 + ch);
            bv[u] = ld_bf4(Ycat + (size_t)row * 1024 + 512 + ch);
            bz[u] = ld_bf4(PA + (size_t)row * LDA + 2048 + ch);
        }
#pragma unroll
        for (int u = 0; u < UB; ++u) {
            const int e = e0 + u * gthreads;
            const int ee = ok[u] ? e : e0; const int row = ee >> 7, ch = (ee & 127) * 4;
            const float mean = allsum16(y[u][0] + y[u][1] + y[u][2] + y[u][3]) * (1.0f / 64.0f);
            const f32x4 d = y[u] - mean;
            const float var = allsum16(dot4(d, d)) * (1.0f / 64.0f);
            const float rstd = rsqrtf(var + 64e-5f);
            const f32x4 g = *(const f32x4*)(gn_g + ch), bb = *(const f32x4*)(gn_b + ch);
            f32x4 o;
#pragma unroll
            for (int j = 0; j < 4; ++j) o[j] = (d[j] * rstd * g[j] + bb[j] + bv[u][j]) * siluf_(bz[u][j]);
            if (ok[u]) st_bf4(Ycat + (size_t)row * 1024 + 512 + ch, o);
        }
    }
    const float* cw = PIN(I_CONVW) + pair * 3 * 512;
    constexpr int NRUN = (NTOK / 8) * 128;
    for (int e = gtid; e < NRUN; e += gthreads) {
        const int run = e >> 7, ch = (e & 127) * 4, row0 = run * 8;
        const bool samp = row0 >= NTP;
        int b, t0, T; if (!samp) { b = row0 >> 11; t0 = row0 & 2047; T = 2048; } else { b = (row0 - NTP) >> 3; t0 = 0; T = 8; }
        const bf16_t* base = PA + (size_t)row0 * LDA + ch;
        u32x2 rh[10], rc[10], rb[8], rz[8];
#pragma unroll
        for (int k = 0; k < 10; ++k) {
            const bool have = (k >= 2) || (t0 > 0);
            const bf16_t* pr = have ? base + (ptrdiff_t)(k - 2) * LDA : base;
            rh[k] = *(const u32x2*)(pr); rc[k] = *(const u32x2*)(pr + 1024);
        }
#pragma unroll
        for (int k = 0; k < 8; ++k) { rb[k] = *(const u32x2*)(base + (size_t)k * LDA + 512); rz[k] = *(const u32x2*)(base + (size_t)k * LDA + 1536); }
        const f32x4 k0 = *(const f32x4*)(cw + ch), k1 = *(const f32x4*)(cw + 512 + ch), k2 = *(const f32x4*)(cw + 1024 + ch);
        f32x4 um2, um1;
        if (t0 > 0) { um2 = cvt4(rc[0]) * cvt4(rh[0]); um1 = cvt4(rc[1]) * cvt4(rh[1]); }
        else if (samp) { const float* hist = PIN(I_SCONV) + ((size_t)pair * 128 + b) * 2 * 512 + ch; um2 = *(const f32x4*)(hist); um1 = *(const f32x4*)(hist + 512); }
        else { um2 = (f32x4){0.f, 0.f, 0.f, 0.f}; um1 = um2; }
#pragma unroll
        for (int k = 0; k < 8; ++k) {
            const f32x4 u0 = cvt4(rc[k + 2]) * cvt4(rh[k + 2]);
            const f32x4 conv = k0 * um2 + k1 * um1 + k2 * u0;
            const f32x4 ab = cvt4(rb[k]), az = cvt4(rz[k]);
            f32x4 o;
#pragma unroll
            for (int j = 0; j < 4; ++j) o[j] = ab[j] * conv[j] * siluf_(az[j]);
            const int row = row0 + k, t = t0 + k;
            st_bf4(Ycat + (size_t)row * 1024 + ch, o);
            if (t >= T - 2) {
                float* dst = samp ? POUT + O_CONVS + (((size_t)pair * 128 + b) * 2 + (t - (T - 2))) * 512 + ch : POUT + O_CONVP + (((size_t)pair * 8 + b) * 2 + (t - (T - 2))) * 512 + ch;
                *(f32x4*)dst = u0;
            }
            um2 = um1; um1 = u0;
        }
    }
}

template <int W>
__device__ __forceinline__ void pool_sample_run(const float* __restrict__ hist, const bf16_t* __restrict__ cur, LAS bf16_t* out) {
    f32x4 ext[23];
#pragma unroll
    for (int k = 0; k < 15; ++k) ext[k] = (k >= 16 - W) ? *(const f32x4*)(hist + (size_t)k * 512) : (f32x4){0.f, 0.f, 0.f, 0.f};
#pragma unroll
    for (int k = 0; k < 8; ++k) ext[15 + k] = ld_bf4(cur + (size_t)k * LDA);
    f32x4 sum = (f32x4){0.f, 0.f, 0.f, 0.f};
#pragma unroll
    for (int d = 0; d < W; ++d) sum += ext[15 - d];
#pragma unroll
    for (int t = 0; t < 8; ++t) {
        if (t > 0) sum += ext[15 + t] - ext[15 + t - W];
        const f32x4 pooled = sum * (1.0f / (float)W) - ext[15 + t];
        u32x2 u; u.x = cvt_pk_bf16(pooled[0], pooled[1]); u.y = cvt_pk_bf16(pooled[2], pooled[3]);
        *(LAS u32x2*)(out + t * 136) = u;
    }
}

__device__ void phase_odd_mixer(const Params& p, const Ctx cx, int pair, LAS unsigned char* lds) {
    const int tid = cx.tid, wid = tid >> 6, lane = tid & 63, fr = lane & 15, fq = lane >> 4;
    const bf16_t* PO = (const bf16_t*)(PWS + WS_R1);
    bf16_t* Ycat = (bf16_t*)(PWS + WS_YCAT);
    LAS bf16_t* LA = (LAS bf16_t*)lds;
    LAS bf16_t* LB = (LAS bf16_t*)(lds + 128 * 136 * 2);
    LAS float* stat = (LAS float*)(lds + 2 * 128 * 136 * 2);
    LAS float* LE = (LAS float*)(lds + 128 * 136 * 2);
    LAS bf16_t* LW = (LAS bf16_t*)(lds + 128 * 136 * 2 + 143 * 128 * 4);
    for (int tile = cx.bid; tile < 136; tile += cx.nblk) {
        const int r0 = tile * 128;
        const bool samp = r0 >= NTP;
        const int tl_ = tid >> 2, q_ = tid & 3;
        {
            const bf16_t* vr = PO + (size_t)(r0 + tl_) * LDA + 1536 + q_ * 128;
            float s_ = 0.f, ss = 0.f;
#pragma unroll
            for (int i = 0; i < 16; ++i) { const u32x4 raw = *(const u32x4*)(vr + i * 8); const f32x4 v0 = cvt4((u32x2){raw.x, raw.y}), v1 = cvt4((u32x2){raw.z, raw.w});
                s_ += (v0[0] + v0[1]) + (v0[2] + v0[3]) + (v1[0] + v1[1]) + (v1[2] + v1[3]); ss += dot4(v0, v0) + dot4(v1, v1); }
            s_ = allsum4(s_); ss = allsum4(ss);
            const float mean = s_ * (1.0f / 512.0f);
            const float var = fmaxf(ss * (1.0f / 512.0f) - mean * mean, 0.f);
            if (q_ == 0) { stat[tl_ * 2] = mean; stat[tl_ * 2 + 1] = rsqrtf(var + 1e-5f); }
        }
        u32x2 rv[8]; u32x4 rw[4];
#define MIX_LOAD_G(gg) do { const bf16_t* vr_ = PO + (size_t)(r0 + tl_) * LDA + 1536 + (gg) * 128 + q_ * 32; \
            _Pragma("unroll") for (int i = 0; i < 8; ++i) rv[i] = *(const u32x2*)(vr_ + i * 4); \
            if (!samp) { const bf16_t* Ws_ = (const bf16_t*)(PWS + WS_SPW) + ((size_t)pair * 4 + (gg)) * 128 * 128; \
                _Pragma("unroll") for (int i = 0; i < 4; ++i) { const int e = tid + i * 512; rw[i] = *(const u32x4*)(Ws_ + (e >> 4) * 128 + (e & 15) * 8); } } } while (0)
        MIX_LOAD_G(0);
        __syncthreads();
#pragma unroll 1
        for (int g = 0; g < 4; ++g) {
            u32x2 ur[8], dzr[8];
#pragma unroll
            for (int nt = 0; nt < 8; ++nt) { const size_t o_ = (size_t)(r0 + wid * 16 + fr) * LDA + g * 128 + nt * 16 + fq * 4; ur[nt] = *(const u32x2*)(PO + o_ + 1024); dzr[nt] = *(const u32x2*)(PO + o_ + 2048); }
            {
                const int row = r0 + tl_;
                const float mean = stat[tl_ * 2], rstd = stat[tl_ * 2 + 1];
                const float* lg = PIN(I_LNG) + pair * 512 + g * 128 + q_ * 32; const float* lb = PIN(I_LNB) + pair * 512 + g * 128 + q_ * 32;
#pragma unroll
                for (int i = 0; i < 8; ++i) {
                    const f32x4 v = cvt4(rv[i]);
                    const f32x4 vn = (v - mean) * rstd * *(const f32x4*)(lg + i * 4) + *(const f32x4*)(lb + i * 4);
                    if (samp) *(f32x4*)(POUT + O_CHUNKV + ((size_t)pair * 1024 + (row - NTP)) * 512 + g * 128 + q_ * 32 + i * 4) = vn;
                    {
                        const float p0 = dpp_f<0x104>(vn[0]), p1 = dpp_f<0x104>(vn[1]);
                        const float p2 = dpp_f<0x114>(vn[2]), p3 = dpp_f<0x114>(vn[3]);
                        const bool odd = tl_ & 1;
                        const unsigned wa = odd ? cvt_pk_bf16(p2, vn[2]) : cvt_pk_bf16(vn[0], p0);
                        const unsigned wb = odd ? cvt_pk_bf16(p3, vn[3]) : cvt_pk_bf16(vn[1], p1);
                        const int cb = q_ * 32 + i * 4 + (odd ? 2 : 0), tb = tl_ & ~1;
                        *(LAS unsigned*)(LB + (cb) * 136 + tb) = wa;
                        *(LAS unsigned*)(LB + (cb + 1) * 136 + tb) = wb;
                    }
                }
            }
            if (!samp) {
#pragma unroll
                for (int i = 0; i < 4; ++i) { const int e = tid + i * 512; *(LAS u32x4*)(LA + (e >> 4) * 136 + (e & 15) * 8) = rw[i]; }
            } else {
                const float* Wsrc = PIN(I_SPW) + ((size_t)pair * 4 + g) * 128 * 128;
                LAS float* w8 = stat + 256;
                if (tid < 64) w8[tid] = Wsrc[(tid >> 3) * 128 + (tid & 7)];
                __syncthreads();
                for (int e = tid; e < 128 * 128; e += 512) { const int t = e >> 7, s2 = e & 127;
                    const float v = ((t >> 3) == (s2 >> 3) && (s2 & 7) <= (t & 7)) ? w8[(t & 7) * 8 + (s2 & 7)] : 0.f;
                    LA[t * 136 + s2] = (bf16_t)(cvt_pk_bf16(v, 0.f) & 0xffffu); }
            }
            if (g + 1 < 4) MIX_LOAD_G(g + 1);
            __syncthreads();
            {
                const int tl = wid * 16 + fr, row = r0 + tl;
                const float bias = PIN(I_SPB)[((size_t)pair * 4 + g) * 128 + (samp ? (tl & 7) : tl)];
                bf16x8 wf[4];
#pragma unroll
                for (int ks = 0; ks < 4; ++ks) wf[ks] = *(const LAS bf16x8*)(LA + tl * 136 + ks * 32 + fq * 8);
#pragma unroll
                for (int nt = 0; nt < 8; ++nt) {
                    f32x4 acc = (f32x4){0.f, 0.f, 0.f, 0.f};
#pragma unroll
                    for (int ks = 0; ks < 4; ++ks) {
                        if (ks * 32 <= wid * 16 + 15) {
                            const bf16x8 vf = *(const LAS bf16x8*)(LB + (nt * 16 + fr) * 136 + ks * 32 + fq * 8);
                            acc = __builtin_amdgcn_mfma_f32_16x16x32_bf16(vf, wf[ks], acc, 0, 0, 0);
                        }
                    }
                    const int c = g * 128 + nt * 16 + fq * 4;
                    const f32x4 u = cvt4(ur[nt]), dz = cvt4(dzr[nt]);
                    f32x4 o;
#pragma unroll
                    for (int j = 0; j < 4; ++j) o[j] = u[j] * (acc[j] + bias) * siluf_(dz[j]);
                    st_bf4(Ycat + (size_t)row * 1024 + 512 + c, o);
                }
            }
            __syncthreads();
        }
#undef MIX_LOAD_G
    }
    {
        int ci, cstride;
        if (cx.nblk == 256) { if (cx.bid < 136) { ci = 1 << 20; cstride = 1 << 20; } else { ci = cx.bid - 136; cstride = 120; } }
        else { ci = cx.bid; cstride = cx.nblk; }
        u32x4 pw[4]; u32x2 pe[9];
#define MIX_LOAD_C(cc) do { const int tile_ = (cc) >> 2, g_ = (cc) & 3, r0_ = tile_ * 128; \
            const bf16_t* Bw_ = (const bf16_t*)(PWS + WS_POOLWT) + ((size_t)pair * 4 + g_) * 128 * 128; \
            _Pragma("unroll") for (int i = 0; i < 4; ++i) { const int e = tid + i * 512; pw[i] = *(const u32x4*)(Bw_ + (e >> 4) * 128 + (e & 15) * 8); } \
            if (r0_ < NTP) { const int t0_ = r0_ & 2047; \
                _Pragma("unroll") for (int i = 0; i < 9; ++i) { const int e = tid + i * 512, er = e >> 5, c = (e & 31) * 4; pe[i] = (u32x2){0u, 0u}; \
                    if (e < 143 * 32 && t0_ + er - 15 >= 0) pe[i] = *(const u32x2*)(PO + (size_t)(r0_ + er - 15) * LDA + g_ * 128 + c); } } } while (0)
        if (ci < 544) MIX_LOAD_C(ci);
        for (; ci < 544; ci += cstride) {
            const int tile = ci >> 2, g = ci & 3, r0 = tile * 128;
            const bool samp = r0 >= NTP;
            const int w = 2 << g;
            const int row = r0 + wid * 16 + fr;
            u32x2 czr[8]; f32x4 psr[8];
#pragma unroll
            for (int nt = 0; nt < 8; ++nt) { const int d = g * 128 + nt * 16 + fq * 4; czr[nt] = *(const u32x2*)(PO + (size_t)row * LDA + 512 + d); psr[nt] = *(const f32x4*)(PIN(I_PSCALE) + pair * 512 + d); }
#pragma unroll
            for (int i = 0; i < 4; ++i) { const int e = tid + i * 512; *(LAS u32x4*)(LW + (e >> 4) * 136 + (e & 15) * 8) = pw[i]; }
            if (!samp) {
                const int t0 = r0 & 2047;
#pragma unroll
                for (int i = 0; i < 9; ++i) { const int e = tid + i * 512, er = e >> 5, c = (e & 31) * 4; if (e < 143 * 32) *(LAS f32x4*)(LE + er * 128 + c) = cvt4(pe[i]); }
                __syncthreads();
                {
                    const int c = (tid & 31) * 4, tl0 = (tid >> 5) * 8;
                    f32x4 sum = (f32x4){0.f, 0.f, 0.f, 0.f};
#pragma unroll 4
                    for (int d = 0; d < w; ++d) sum += *(LAS const f32x4*)(LE + (tl0 + 15 - d) * 128 + c);
#pragma unroll
                    for (int k = 0; k < 8; ++k) {
                        const int tl = tl0 + k;
                        const f32x4 pt = *(LAS const f32x4*)(LE + (tl + 15) * 128 + c);
                        if (k > 0) sum += pt - *(LAS const f32x4*)(LE + (tl + 15 - w) * 128 + c);
                        const float cnt = fminf((float)w, (float)(t0 + tl + 1));
                        const f32x4 pooled = sum * (1.0f / cnt) - pt;
                        u32x2 u; u.x = cvt_pk_bf16(pooled[0], pooled[1]); u.y = cvt_pk_bf16(pooled[2], pooled[3]);
                        *(LAS u32x2*)(LA + tl * 136 + c) = u;
                    }
                }
            } else {
                const int sq = tid >> 5, c = (tid & 31) * 4, bb = (r0 - NTP) / 8 + sq;
                const float* hist = PIN(I_SPOOL) + ((size_t)pair * 128 + bb) * 15 * 512 + g * 128 + c;
                const bf16_t* cur = PO + (size_t)(r0 + sq * 8) * LDA + g * 128 + c;
                LAS bf16_t* out = LA + (sq * 8) * 136 + c;
                if (g == 0) pool_sample_run<2>(hist, cur, out); else if (g == 1) pool_sample_run<4>(hist, cur, out);
                else if (g == 2) pool_sample_run<8>(hist, cur, out); else pool_sample_run<16>(hist, cur, out);
            }
            if (ci + cstride < 544) MIX_LOAD_C(ci + cstride);
            __syncthreads();
            bf16x8 af[4];
#pragma unroll
            for (int ks = 0; ks < 4; ++ks) af[ks] = *(const LAS bf16x8*)(LA + (wid * 16 + fr) * 136 + ks * 32 + fq * 8);
#pragma unroll
            for (int nt = 0; nt < 8; ++nt) {
                f32x4 acc = (f32x4){0.f, 0.f, 0.f, 0.f};
#pragma unroll
                for (int ks = 0; ks < 4; ++ks) {
                    const bf16x8 bf = *(const LAS bf16x8*)(LW + (nt * 16 + fr) * 136 + ks * 32 + fq * 8);
                    acc = __builtin_amdgcn_mfma_f32_16x16x32_bf16(bf, af[ks], acc, 0, 0, 0);
                }
                const int d = g * 128 + nt * 16 + fq * 4;
                const f32x4 cz = cvt4(czr[nt]), ps = psr[nt];
                f32x4 o;
#pragma unroll
                for (int j = 0; j < 4; ++j) o[j] = acc[j] * ps[j] * siluf_(cz[j]);
                st_bf4(Ycat + (size_t)row * 1024 + d, o);
            }
            __syncthreads();
        }
#undef MIX_LOAD_C
    }
    const int gtid = cx.bid * 512 + tid, gthreads = cx.nblk * 512;
    for (int e = gtid; e < 136 * 15 * 128; e += gthreads) {
        const int c = (e & 127) * 4, q = e >> 7, sr = q / 15, k = q - sr * 15;
        if (sr < 8) *(f32x4*)(POUT + O_POOLP + (((size_t)pair * 8 + sr) * 15 + k) * 512 + c) = ld_bf4(PO + (size_t)(sr * 2048 + 2033 + k) * LDA + c);
        else { const int b = sr - 8;
            *(f32x4*)(POUT + O_POOLS + (((size_t)pair * 128 + b) * 15 + k) * 512 + c) = (k < 7) ? *(const f32x4*)(PIN(I_SPOOL) + (((size_t)pair * 128 + b) * 15 + 8 + k) * 512 + c) : ld_bf4(PO + (size_t)(NTP + b * 8 + (k - 7)) * LDA + c); }
    }
}

__device__ void phase_final(const Params& p, const Ctx cx) {
    const int gtid = cx.bid * 512 + cx.tid, gthreads = cx.nblk * 512;
    const float* ssq = (const float*)(PWS + WS_SSQ) + (size_t)4 * NTOK * 16;
    const bf16_t* Xb = (const bf16_t*)(PWS + WS_XB);
    constexpr int NIT = NTOK * 256, UB = 4;
    for (int e0 = gtid; e0 < NIT; e0 += gthreads * UB) {
        f32x4 x[UB]; float sq[UB]; bool ok[UB];
#pragma unroll
        for (int u = 0; u < UB; ++u) { const int e = e0 + u * gthreads; ok[u] = e < NIT; const int ee = ok[u] ? e : e0; const int row = ee >> 8, c = (ee & 255) * 4;
            x[u] = ld_bf4(Xb + (size_t)row * 1024 + c); sq[u] = ssq_sum(ssq + (size_t)row * 16); }
#pragma unroll
        for (int u = 0; u < UB; ++u) { const int e = e0 + u * gthreads; const int ee = ok[u] ? e : e0; const int row = ee >> 8, c = (ee & 255) * 4;
            const float rstd = rsqrtf(sq[u] * (1.0f / 1024.0f) + 1e-6f);
            if (ok[u]) *(f32x4*)(POUT + (size_t)row * 1024 + c) = x[u] * rstd * *(const f32x4*)(PIN(I_FNORMW) + c); }
    }
}

#define XB_TMO      128
#define XB_XCNT(j)  (256  + 64 * (j))
#define XB_XSUB(j)  (1280 + 64 * (j))
#define XB_XGEN(j)  (2304 + 64 * (j))
#define XB_TOP      3328
#define XB_TOPGEN   3392
#define XCD_BAR_WORDS 3456
#define XB_SPIN_CAP (1u << 18)
__device__ __forceinline__ unsigned xb_ld(unsigned* p)              { return __hip_atomic_load(p, __ATOMIC_RELAXED, __HIP_MEMORY_SCOPE_AGENT); }
__device__ __forceinline__ unsigned xb_add(unsigned* p, unsigned v) { return __hip_atomic_fetch_add(p, v, __ATOMIC_RELAXED, __HIP_MEMORY_SCOPE_AGENT); }
__device__ __forceinline__ unsigned xb_xcc_id() { return (unsigned)__builtin_amdgcn_s_getreg((3 << 11) | 20) & 0xFu; }
#define XB_SPIN(cond, bar) do { unsigned _sp = 0; while (cond) { __builtin_amdgcn_s_sleep(1); \
    if ((++_sp & 255u) == 0u) { if (xb_ld(&(bar)[XB_TMO])) break; if (_sp > XB_SPIN_CAP) { atomicAdd(&(bar)[XB_TMO], 1u); break; } } } } while (0)
struct XcdBarrier { unsigned* bar; unsigned x; volatile LAS unsigned* st; };
__device__ __forceinline__ XcdBarrier xcd_barrier_post(unsigned* bar, volatile LAS unsigned* st) {
    XcdBarrier b; b.bar = bar; b.x = xb_xcc_id(); b.st = st;
    if (threadIdx.x == 0) (void)xb_add(&bar[XB_XCNT(b.x)], 1u);
    return b;
}
__device__ __forceinline__ void xcd_barrier_complete(unsigned* bar, unsigned x, unsigned& nloc, unsigned& nx) {
    const unsigned G = gridDim.x * gridDim.y * gridDim.z;
    unsigned sum, cnt, mine, sp = 0u;
    for (;;) {
        sum = 0u; cnt = 0u; mine = 0u;
#pragma unroll
        for (unsigned j = 0; j < 16; ++j) { const unsigned c = xb_ld(&bar[XB_XCNT(j)]); sum += c; cnt += (c > 0u) ? 1u : 0u; mine = (j == x) ? c : mine; }
        if (sum == G) break;
        __builtin_amdgcn_s_sleep(1);
        if ((++sp & 255u) == 0u) { if (xb_ld(&bar[XB_TMO])) break; if (sp > XB_SPIN_CAP) { atomicAdd(&bar[XB_TMO], 1u); break; } }
    }
    nloc = mine > 0u ? mine : 1u; nx = cnt > 0u ? cnt : 1u;
}
__device__ __forceinline__ void xcd_barrier(const XcdBarrier& b) {
    asm volatile("s_waitcnt vmcnt(0)" ::: "memory");
    __syncthreads();
    if (threadIdx.x == 0) {
        unsigned* bar = b.bar;
        __builtin_amdgcn_s_waitcnt(0);
        unsigned nloc = b.st[0], nx = b.st[1];
        if (nloc == 0u) { xcd_barrier_complete(bar, b.x, nloc, nx); b.st[0] = nloc; b.st[1] = nx; }
        const unsigned old = xb_add(&bar[XB_XSUB(b.x)], 1u);
        const unsigned gen = old / nloc;
        if (old + 1u == (gen + 1u) * nloc) {
            __builtin_amdgcn_fence(__ATOMIC_RELEASE, "agent");
            asm volatile("s_waitcnt vmcnt(0)" ::: "memory");
            const unsigned og = xb_add(&bar[XB_TOP], 1u);
            const unsigned tg = og / nx;
            if (og + 1u == (tg + 1u) * nx) xb_add(&bar[XB_TOPGEN], 1u);
            else XB_SPIN(xb_ld(&bar[XB_TOPGEN]) == tg, bar);
            __builtin_amdgcn_fence(__ATOMIC_ACQUIRE, "agent");
            xb_add(&bar[XB_XGEN(b.x)], 1u);
            asm volatile("s_waitcnt vmcnt(0)" ::: "memory");
        } else {
            XB_SPIN(xb_ld(&bar[XB_XGEN(b.x)]) == gen, bar);
            __builtin_amdgcn_fence(__ATOMIC_ACQUIRE, "agent");
            asm volatile("s_waitcnt vmcnt(0)" ::: "memory");
        }
    }
    __syncthreads();
}

__device__ void run_gemm_proj(const Params& p, const Ctx cx, LAS unsigned char* lds, const bf16_t* Bt, int N, bf16_t* O, int ldc, int layer) {
    pg8::Gemm g{(const bf16_t*)(PWS + WS_XB), Bt, NTOK, N, 1024};
    pg8::StaticOrder S; S.init(NTOK, N, (int)cx.nblk, (int)cx.bid);
    const float* ssq = (const float*)(PWS + WS_SSQ) + (size_t)layer * NTOK * 16;
    LAS float* rl = (LAS float*)(lds + 131072);
    int pm0 = -1, pm1 = -1, pm2 = -1, pm3 = -1, np = 0;
    for (int i = 0; i < 64; ++i) {
        pg8::Unit u; if (!S.next(i, u)) break;
        if (u.pm == pm0 || u.pm == pm1 || u.pm == pm2 || u.pm == pm3) continue;
        if (np == 0) pm0 = u.pm; else if (np == 1) pm1 = u.pm; else if (np == 2) pm2 = u.pm; else pm3 = u.pm;
        ++np;
    }
    for (int r = cx.tid; r < np * 256; r += 512) {
        const int i = r >> 8, pm = i == 0 ? pm0 : (i == 1 ? pm1 : (i == 2 ? pm2 : pm3));
        rl[r] = rsqrtf(ssq_sum(ssq + (size_t)(pm * 256 + (r & 255)) * 16) * (1.0f / 1024.0f) + 1e-6f);
    }
    __syncthreads();
    EpiProj E{O, ldc, rl, pm0, pm1, pm2, pm3};
    pg8::gemm_phase<EpiProj>(cx, lds, g, S, E);
}
__device__ void run_gemm_res(const Params& p, const Ctx cx, LAS unsigned char* lds, const bf16_t* Bt, int layer) {
    const bf16_t* A = (const bf16_t*)(PWS + WS_YCAT);
    bf16_t* Xb = (bf16_t*)(PWS + WS_XB);
    float* ssqn = (float*)(PWS + WS_SSQ) + (size_t)(layer + 1) * NTOK * 16;
    pg8::Gemm g{A, Bt, NTOK, 1024, 1024};
    pg8::StaticOrder S; S.init(NTOK, 1024, (int)cx.nblk, (int)cx.bid);
    EpiRes E{layer == 0 ? PIN(I_XP) : nullptr, PIN(I_XS), Xb, ssqn};
    pg8::gemm_phase<EpiRes>(cx, lds, g, S, E);
}

constexpr int N_PHASES = 20;
#ifndef PHMASK
#define PHMASK 0xffff
#endif
#define PHON(n) ((PHMASK >> ((n) % 16)) & 1)
__global__ void __launch_bounds__(512, 2) fwd_kernel(Params p) {
    extern __shared__ __attribute__((aligned(16))) unsigned char lds_raw[];
    LAS unsigned char* lds = (LAS unsigned char*)lds_raw;
    volatile LAS unsigned* bar_st = (volatile LAS unsigned*)(lds + LDS_MAIN);
    if (threadIdx.x < 4) bar_st[threadIdx.x] = 0u;
    __syncthreads();
    const XcdBarrier gbar = xcd_barrier_post((unsigned*)((unsigned char*)p.ptr[30] + WS_BAR), bar_st);
    if (p.ph_hi < 0) cg::this_grid().sync();
#define GRID_SYNC() xcd_barrier(gbar)
#ifdef SYNCPROBE
    for (int i = 0; i < SYNCPROBE; ++i) GRID_SYNC();
#endif
#ifdef REPMASK
    for (int pc = p.ph_lo * 2; pc < p.ph_hi * 2; ++pc) {
        const int ph = pc >> 1;
        { const int s_ = (ph == 0) ? 9 : (ph == N_PHASES - 1) ? 31 : (ph - 1) % 9; if ((pc & 1) && !((REPMASK >> s_) & 1)) continue; }
        if (pc > p.ph_lo * 2) GRID_SYNC();
#else
    for (int ph = p.ph_lo; ph < p.ph_hi; ++ph) {
        if (ph > p.ph_lo) GRID_SYNC();
#endif
        Ctx cx; cx.tid = threadIdx.x; cx.bid = blockIdx.x; cx.nblk = gridDim.x;
        asm volatile("s_mov_b32 %0, 0" : "=s"(cx.z));
        asm volatile("" : "+v"(cx.tid)); asm volatile("" : "+s"(cx.bid)); asm volatile("" : "+s"(cx.nblk));
        const int pair = (ph - 1) / 9, s = (ph == 0) ? 100 : (ph == N_PHASES - 1 ? 101 : (ph - 1) % 9);
        if (s == 0 || s == 3 || s == 6) {
#if PHON(0)
            const bf16_t* WinE = (const bf16_t*)(PWS + WS_WINE) + (size_t)pair * 4352 * 1024;
            const bf16_t* Bt = s == 0 ? WinE + (size_t)2560 * 1024 : (s == 3 ? WinE : (const bf16_t*)(PWS + WS_WINO) + (size_t)pair * 2560 * 1024);
            const int N = s == 0 ? 1792 : 2560;
            run_gemm_proj(p, cx, lds, Bt, N, (bf16_t*)(PWS + WS_R1), N, 2 * pair + (s == 6 ? 1 : 0));
#endif
        } else if (s == 5 || s == 8) {
#if PHON(5)
            const bf16_t* Bt = (const bf16_t*)(PWS + (s == 5 ? WS_WOUTE : WS_WOUTO)) + (size_t)pair * 1024 * 1024;
            run_gemm_res(p, cx, lds, Bt, 2 * pair + (s == 8 ? 1 : 0));
#endif
        } else if (s == 1) {
#if PHON(1)
            phase_even_prep(p, cx, pair, lds);
#endif
        } else if (s == 2) {
#if PHON(2)
            phase_scan(p, cx, pair, lds);
#endif
        } else if (s == 4) {
#if PHON(4)
            phase_even_post(p, cx, pair);
#endif
        } else if (s == 7) {
#if PHON(7)
            phase_odd_mixer(p, cx, pair, lds);
#endif
        } else if (s == 100) {
#if PHON(10)
            phase_prepass(p, cx, lds);
#endif
        } else {
#if PHON(11)
            phase_final(p, cx);
#endif
        }
    }
}

extern "C" void kernel_launch(void* const* d_in, const int* in_sizes, int n_in, void* d_out, int out_size, void* d_ws, size_t ws_size, hipStream_t stream) {
    static int grid = 0;
    if (grid == 0) {
        if (n_in != 29 || ws_size < WS_END) { fprintf(stderr, "kernel_launch: unexpected n_in %d / ws_size %zu (need %zu)\n", n_in, ws_size, (size_t)WS_END); grid = -1; return; }
        int dev = 0, cus = 0, per_cu = 0;
        hipGetDevice(&dev);
        hipDeviceGetAttribute(&cus, hipDeviceAttributeMultiprocessorCount, dev);
        if (hipFuncSetAttribute((const void*)fwd_kernel, hipFuncAttributeMaxDynamicSharedMemorySize, LDS_BYTES) != hipSuccess) { fprintf(stderr, "kernel_launch: hipFuncSetAttribute failed\n"); grid = -1; return; }
        if (hipOccupancyMaxActiveBlocksPerMultiprocessor(&per_cu, (const void*)fwd_kernel, 512, LDS_BYTES) != hipSuccess || per_cu < 1) { fprintf(stderr, "kernel_launch: occupancy query gave %d\n", per_cu); per_cu = 1; }
        (void)hipGetLastError();
        grid = cus * per_cu;
        if (grid > 256) grid = 256;
    }
    if (grid < 0) return;
    Params p{};
    for (int i = 0; i < 29; ++i) p.ptr[i] = d_in[i];
    p.ptr[29] = d_out; p.ptr[30] = d_ws; p.ptr[31] = nullptr;
    (void)hipMemsetAsync((unsigned char*)d_ws + WS_BAR, 0, 16384, stream);
#if ONE_LAUNCH
    p.ph_lo = 0; p.ph_hi = N_PHASES;
    void* args[] = {&p};
    hipError_t e = hipLaunchCooperativeKernel((const void*)fwd_kernel, dim3(grid), dim3(512), args, LDS_BYTES, stream);
    if (e != hipSuccess) fprintf(stderr, "cooperative launch failed: %s (grid %d)\n", hipGetErrorString(e), grid);
#else
    for (int ph = 0; ph < N_PHASES; ++ph) {
        p.ph_lo = ph; p.ph_hi = ph + 1;
        hipLaunchKernelGGL(fwd_kernel, dim3(grid), dim3(512), LDS_BYTES, stream, p);
    }
#endif
}
```

```cpp
#include <hip/hip_runtime.h>
#include <hip/hip_cooperative_groups.h>
#include <cstdio>
namespace cg = cooperative_groups;

#ifndef ONE_LAUNCH
#define ONE_LAUNCH 1
#endif

#define LAS __attribute__((address_space(3)))
typedef unsigned short bf16_t;
typedef short bf16x8 __attribute__((ext_vector_type(8)));
typedef float f32x4 __attribute__((ext_vector_type(4)));
typedef unsigned u32x4 __attribute__((ext_vector_type(4)));
typedef unsigned u32x2 __attribute__((ext_vector_type(2)));

constexpr int NTOK = 17408, NTP = 16384;
constexpr int LDB = 1792;
constexpr int LDA = 2560;
constexpr size_t O_CONVP = 17825792, O_CONVS = 17842176, O_SHIFTP = 18104320, O_SHIFTS = 18130944, O_WKVP = 18556928, O_WKVS = 19081216,
                 O_POOLP = 27469824, O_POOLS = 27592704, O_CHUNKV = 29558784;
constexpr size_t WS_WINE = 0;
constexpr size_t WS_WOUTE = WS_WINE + 2ull * 4352 * 1024 * 2;
constexpr size_t WS_WINO = WS_WOUTE + 2ull * 1024 * 1024 * 2;
constexpr size_t WS_WOUTO = WS_WINO + 2ull * 2560 * 1024 * 2;
constexpr size_t WS_W2T = WS_WOUTO + 2ull * 1024 * 1024 * 2;
constexpr size_t WS_A2T = WS_W2T + 2ull * 512 * 64 * 2;
constexpr size_t WS_POOLWT = WS_A2T + 2ull * 512 * 64 * 2;
constexpr size_t WS_SPW = WS_POOLWT + 8ull * 128 * 128 * 2;
constexpr size_t WS_XB = WS_SPW + 8ull * 128 * 128 * 2;
constexpr size_t WS_YCAT = WS_XB + (size_t)NTOK * 1024 * 2;
constexpr size_t WS_SSQ = WS_YCAT + (size_t)NTOK * 1024 * 2;
constexpr size_t WS_Y = WS_SSQ + 5ull * NTOK * 16 * 4;
constexpr size_t WS_R1 = WS_Y + (size_t)NTOK * 512 * 4;
constexpr size_t WS_PROJB = WS_R1;
constexpr size_t WS_WDEC = WS_PROJB + (size_t)NTOK * LDB * 2;
constexpr size_t WS_AA = WS_WDEC + (size_t)NTOK * 512 * 4;
constexpr size_t WS_BAR = WS_AA + (size_t)NTOK * 512 * 2;
constexpr size_t WS_END = WS_BAR + 16384;
constexpr int LDS_MAIN = 147456;
constexpr int LDS_BYTES = LDS_MAIN + 16;

struct Params {
    const void* ptr[32];
    int ph_lo, ph_hi;
};
struct Ctx { int tid, bid, nblk, z; };
#define PIN(i) ((const float*)p.ptr[(i) + cx.z])
#define POUT ((float*)p.ptr[29 + cx.z])
#define PWS ((unsigned char*)p.ptr[30 + cx.z])
enum { I_XP = 0, I_XS, I_SCONV, I_SSHIFT, I_SWKV, I_SPOOL, I_NORMW, I_FNORMW, I_WINE, I_CONVW, I_MU, I_W0, I_W2, I_A0, I_A2, I_KK, I_KA, I_RK, I_GNG, I_GNB,
       I_WOUTE, I_WINO, I_POOLW, I_PSCALE, I_LNG, I_LNB, I_SPW, I_SPB, I_WOUTO };

__device__ __forceinline__ unsigned cvt_pk_bf16(float lo, float hi) { unsigned r; asm("v_cvt_pk_bf16_f32 %0, %1, %2" : "=v"(r) : "v"(lo), "v"(hi)); return r; }
__device__ __forceinline__ float bf_lo(unsigned u) { return __uint_as_float(u << 16); }
__device__ __forceinline__ float bf_hi(unsigned u) { return __uint_as_float(u & 0xffff0000u); }
__device__ __forceinline__ float bf2f(bf16_t b) { return __uint_as_float(((unsigned)b) << 16); }
__device__ __forceinline__ f32x4 cvt4(u32x2 u) { return (f32x4){bf_lo(u.x), bf_hi(u.x), bf_lo(u.y), bf_hi(u.y)}; }
__device__ __forceinline__ f32x4 ld_bf4(const bf16_t* p) { return cvt4(*(const u32x2*)p); }
__device__ __forceinline__ void st_bf4(bf16_t* p, f32x4 v) { u32x2 u; u.x = cvt_pk_bf16(v[0], v[1]); u.y = cvt_pk_bf16(v[2], v[3]); *(u32x2*)p = u; }
__device__ __forceinline__ float sigmoidf_(float x) { return 1.0f / (1.0f + __expf(-x)); }
__device__ __forceinline__ float siluf_(float x) { return x / (1.0f + __expf(-x)); }
template <int CTRL> __device__ __forceinline__ float dpp_f(float x) { return __builtin_bit_cast(float, __builtin_amdgcn_mov_dpp(__builtin_bit_cast(int, x), CTRL, 0xf, 0xf, true)); }
__device__ __forceinline__ float allsum16(float x) { x += dpp_f<0xB1>(x); x += dpp_f<0x4E>(x); x += dpp_f<0x141>(x); x += dpp_f<0x128>(x); return x; }
__device__ __forceinline__ float allsum4(float x) { x += dpp_f<0xB1>(x); x += dpp_f<0x4E>(x); return x; }
__device__ __forceinline__ float dot4(f32x4 a, f32x4 b) { return a[0] * b[0] + a[1] * b[1] + a[2] * b[2] + a[3] * b[3]; }

__device__ __forceinline__ float ssq_sum(const float* part) {
    const f32x4 a = *(const f32x4*)(part), b = *(const f32x4*)(part + 4), c = *(const f32x4*)(part + 8), d = *(const f32x4*)(part + 12);
    return ((a[0] + a[1]) + (a[2] + a[3])) + ((b[0] + b[1]) + (b[2] + b[3])) + ((c[0] + c[1]) + (c[2] + c[3])) + ((d[0] + d[1]) + (d[2] + d[3]));
}

namespace pg8 {
constexpr int BM = 256, BK = 64, HALF = 128, HTB = HALF * BK * 2, NXCD = 8, WGM = 8;
__device__ __forceinline__ int lds_byte(int r, int c) { const int st = (r >> 4) * 2 + (c >> 5), rr = r & 15, cc = c & 31, ob = rr * 64 + cc * 2; return st * 1024 + (ob ^ (((ob >> 9) & 1) << 5)); }
__device__ __forceinline__ void stage_rc(int b, int& R, int& C) { const int st = b / 1024, sb = b % 1024, swz = sb ^ (((sb >> 9) & 1) << 5); R = (st >> 1) * 16 + swz / 64; C = (st & 1) * 32 + (swz % 64) / 2; }
__device__ __forceinline__ int perm32(int rho) { const int n = rho >> 4, i = rho & 15; return 8 * (i >> 2) + 4 * n + (i & 3); }
struct Unit { int pm, pn; };
struct Gemm { const bf16_t* A; const bf16_t* Bt; int M, N, K; };
struct StaticOrder {
    int nM, nN, nwg, G, c;
    __device__ void init(int M, int N, int G_, int c_) { nM = M / BM; nN = N / BM; nwg = nM * nN; G = G_; c = c_; }
    __device__ bool next(int i, Unit& u) const {
        const long L = (long)i * G + c; if (L >= nwg) return false;
        int wgid = (int)L; { const int q = nwg / NXCD, r = nwg % NXCD, xcd = wgid % NXCD, off = wgid / NXCD; wgid = (xcd < r ? xcd * (q + 1) : r * (q + 1) + (xcd - r) * q) + off; }
        const int nig = WGM * nN, gid = wgid / nig, fm = gid * WGM, gsz = (nM - fm) < WGM ? (nM - fm) : WGM;
        u.pm = fm + ((wgid % nig) % gsz); u.pn = (wgid % nig) / gsz; return true;
    }
};

template <class Epi>
__device__ __forceinline__ void gemm_phase(const Ctx cx, LAS unsigned char* lds, const Gemm g, const StaticOrder& S, const Epi& E) {
    const int tid = cx.tid, wid = __builtin_amdgcn_readfirstlane(tid >> 6), lane = tid & 63, wr = wid >> 2, wc = wid & 3, fr = lane & 15, fq = lane >> 4;
    const int K = g.K, nt = K / BK;
    unsigned voffA[2], voffB[2];
#pragma unroll
    for (int i = 0; i < 2; ++i) { int R, C; stage_rc(tid * 16 + i * 8192, R, C); const int Rb = Epi::PERM ? ((R & ~31) + perm32(R & 31)) : R;
        voffA[i] = (unsigned)(R * K + C) * 2u; voffB[i] = (unsigned)(Rb * K + C) * 2u; }
    const size_t kstep = (size_t)(BK * 2);
    const size_t hstep = (size_t)HALF * K * 2;
    const size_t tstep = 2 * hstep;
    const unsigned ldsw = (unsigned)wid * 1024u;
    const int aoff = lds_byte(wr * 64 + fr, fq * 8), boff = lds_byte(wc * 32 + fr, fq * 8);
#define PG8_SA(b, h) (((b) * 2 + (h)) * HTB)
#define PG8_SB(b, h) ((4 + (b) * 2 + (h)) * HTB)
#define PG8_STAGE(bufoff, gbase, voff) do { _Pragma("unroll") for (int _i = 0; _i < 2; ++_i) \
        __builtin_amdgcn_global_load_lds((const unsigned*)((const char*)(gbase) + (voff)[_i]), (LAS unsigned*)(lds + (bufoff) + ldsw + _i * 8192), 16, 0, 0); } while (0)
#define PG8_LDA(dst, b, h) do { _Pragma("unroll") for (int m = 0; m < 4; ++m) _Pragma("unroll") for (int k = 0; k < 2; ++k) dst[m][k] = *(const LAS bf16x8*)(lds + PG8_SA(b, h) + aoff + m * 2048 + k * 1024); } while (0)
#define PG8_LDB(dst, b, h) do { _Pragma("unroll") for (int n = 0; n < 2; ++n) _Pragma("unroll") for (int k = 0; k < 2; ++k) dst[n][k] = *(const LAS bf16x8*)(lds + PG8_SB(b, h) + boff + n * 2048 + k * 1024); } while (0)
#define PG8_MMA(ai, bj, At, Bt) do { __builtin_amdgcn_s_setprio(1); _Pragma("unroll") for (int m = 0; m < 4; ++m) _Pragma("unroll") for (int n = 0; n < 2; ++n) _Pragma("unroll") for (int k = 0; k < 2; ++k) \
        acc[ai][bj][m][n] = __builtin_amdgcn_mfma_f32_16x16x32_bf16(Bt[n][k], At[m][k], acc[ai][bj][m][n], 0, 0, 0); __builtin_amdgcn_s_setprio(0); } while (0)
#define PG8_WAIT_V(n) asm volatile("s_waitcnt vmcnt(" #n ")" ::: "memory")
#define PG8_WAIT_L(n) asm volatile("s_waitcnt lgkmcnt(" #n ")" ::: "memory")
#define PG8_BAR __builtin_amdgcn_s_barrier()
#define PG8_SCHED __builtin_amdgcn_sched_barrier(0)
    Unit cur, nxt; int ui = 0;
    if (!S.next(0, cur)) return;
    f32x4 acc[2][2][4][2];
#pragma unroll
    for (int a = 0; a < 2; ++a)
#pragma unroll
        for (int b = 0; b < 2; ++b)
#pragma unroll
            for (int m = 0; m < 4; ++m)
#pragma unroll
                for (int n = 0; n < 2; ++n) acc[a][b][m][n] = (f32x4){0.f, 0.f, 0.f, 0.f};
    bf16x8 At[4][2], B0[2][2], B1[2][2];
    const char* cA = (const char*)g.A + (size_t)cur.pm * tstep; const char* cB = (const char*)g.Bt + (size_t)cur.pn * tstep;
    PG8_STAGE(PG8_SB(0, 0), cB, voffB); PG8_STAGE(PG8_SA(0, 0), cA, voffA); PG8_STAGE(PG8_SB(0, 1), cB + hstep, voffB); PG8_STAGE(PG8_SA(0, 1), cA + hstep, voffA);
    if (wr == 1) PG8_BAR;
    PG8_WAIT_V(4); PG8_BAR;
    PG8_STAGE(PG8_SB(1, 0), cB + kstep, voffB); PG8_STAGE(PG8_SA(1, 0), cA + kstep, voffA); PG8_STAGE(PG8_SB(1, 1), cB + hstep + kstep, voffB);
    PG8_WAIT_V(6); PG8_BAR;
    for (;;) {
        const bool has_next = S.next(ui + 1, nxt);
        const char* nA = has_next ? (const char*)g.A + (size_t)nxt.pm * tstep : cA; const char* nB = has_next ? (const char*)g.Bt + (size_t)nxt.pn * tstep : cB;
        for (int t = 0; t < nt; t += 2) {
            const bool last = (t == nt - 2);
            const char* a1 = cA + (size_t)(t + 1) * kstep;
            const char* a2 = last ? nA : cA + (size_t)(t + 2) * kstep; const char* b2 = last ? nB : cB + (size_t)(t + 2) * kstep;
            const char* a3 = a2 + kstep; const char* b3 = b2 + kstep;
            PG8_LDB(B0, 0, 0); PG8_SCHED; PG8_LDA(At, 0, 0); PG8_STAGE(PG8_SA(1, 1), a1 + hstep, voffA);
            PG8_WAIT_L(8); PG8_BAR; PG8_WAIT_L(0); PG8_MMA(0, 0, At, B0); PG8_BAR; PG8_SCHED;
            PG8_LDB(B1, 0, 1); PG8_STAGE(PG8_SB(0, 0), b2, voffB);
            PG8_BAR; PG8_WAIT_L(0); PG8_MMA(0, 1, At, B1); PG8_BAR;
            PG8_LDA(At, 0, 1); PG8_STAGE(PG8_SA(0, 0), a2, voffA);
            PG8_BAR; PG8_WAIT_L(0); PG8_MMA(1, 0, At, B0); PG8_BAR; PG8_SCHED;
            PG8_STAGE(PG8_SB(0, 1), b2 + hstep, voffB);
            PG8_WAIT_V(6); PG8_BAR; PG8_MMA(1, 1, At, B1); PG8_BAR;
            PG8_LDB(B0, 1, 0); PG8_SCHED; PG8_LDA(At, 1, 0); PG8_STAGE(PG8_SA(0, 1), a2 + hstep, voffA);
            PG8_WAIT_L(8); PG8_BAR; PG8_WAIT_L(0); PG8_MMA(0, 0, At, B0); PG8_BAR; PG8_SCHED;
            PG8_LDB(B1, 1, 1); PG8_STAGE(PG8_SB(1, 0), b3, voffB);
            PG8_BAR; PG8_WAIT_L(0); PG8_MMA(0, 1, At, B1); PG8_BAR;
            PG8_LDA(At, 1, 1); PG8_STAGE(PG8_SA(1, 0), a3, voffA);
            PG8_BAR; PG8_WAIT_L(0); PG8_MMA(1, 0, At, B0); PG8_BAR; PG8_SCHED;
            PG8_STAGE(PG8_SB(1, 1), b3 + hstep, voffB);
            PG8_WAIT_V(6); PG8_BAR; PG8_MMA(1, 1, At, B1); PG8_BAR;
        }
        E(acc, cur, wr, wc, fr, fq);
        if (!has_next) break;
#pragma unroll
        for (int a = 0; a < 2; ++a)
#pragma unroll
            for (int b = 0; b < 2; ++b)
#pragma unroll
                for (int m = 0; m < 4; ++m)
#pragma unroll
                    for (int n = 0; n < 2; ++n) acc[a][b][m][n] = (f32x4){0.f, 0.f, 0.f, 0.f};
        cur = nxt; cA = nA; cB = nB; ++ui;
    }
    PG8_WAIT_V(0);
    if (wr == 0) PG8_BAR;
    PG8_BAR;
#undef PG8_SA
#undef PG8_SB
#undef PG8_STAGE
#undef PG8_LDA
#undef PG8_LDB
#undef PG8_MMA
#undef PG8_WAIT_V
#undef PG8_WAIT_L
#undef PG8_BAR
#undef PG8_SCHED
}
}

struct EpiProj {
    static constexpr bool PERM = true;
    bf16_t* O; int ldc; LAS const float* rl; int pm0, pm1, pm2, pm3;
    __device__ __forceinline__ void operator()(const f32x4 (&acc)[2][2][4][2], const pg8::Unit& u, int wr, int wc, int fr, int fq) const {
        const int row0 = u.pm * 256 + wr * 64 + fr, col0 = u.pn * 256 + wc * 32 + 8 * fq;
        const int sel = u.pm == pm0 ? 0 : (u.pm == pm1 ? 1 : (u.pm == pm2 ? 2 : 3));
        LAS const float* rp = rl + sel * 256 + wr * 64 + fr;
#pragma unroll
        for (int ai = 0; ai < 2; ++ai)
#pragma unroll
            for (int m = 0; m < 4; ++m) {
                const int row = row0 + ai * 128 + m * 16;
                const float rstd = rp[ai * 128 + m * 16];
                bf16_t* rowp = O + (size_t)row * ldc + col0;
#pragma unroll
                for (int bj = 0; bj < 2; ++bj) {
                    const f32x4 v0 = acc[ai][bj][m][0] * rstd, v1 = acc[ai][bj][m][1] * rstd;
                    u32x4 w; w.x = cvt_pk_bf16(v0[0], v0[1]); w.y = cvt_pk_bf16(v0[2], v0[3]); w.z = cvt_pk_bf16(v1[0], v1[1]); w.w = cvt_pk_bf16(v1[2], v1[3]);
                    *(u32x4*)(rowp + bj * 128) = w;
                }
            }
    }
};
struct X8 { f32x4 lo, hi; };
template <bool FIRST> __device__ __forceinline__ X8 ld_x8(const float* __restrict__ s32, const bf16_t* __restrict__ s16, size_t o) {
    X8 r;
    if (FIRST) { r.lo = *(const f32x4*)(s32 + o); r.hi = *(const f32x4*)(s32 + o + 4); }
    else { const u32x4 u = *(const u32x4*)(s16 + o); r.lo = cvt4((u32x2){u.x, u.y}); r.hi = cvt4((u32x2){u.z, u.w}); }
    return r;
}
__device__ __forceinline__ void st_x8(bf16_t* p, f32x4 lo, f32x4 hi) { u32x4 w; w.x = cvt_pk_bf16(lo[0], lo[1]); w.y = cvt_pk_bf16(lo[2], lo[3]); w.z = cvt_pk_bf16(hi[0], hi[1]); w.w = cvt_pk_bf16(hi[2], hi[3]); *(u32x4*)p = w; }
template <bool FIRST>
__device__ __forceinline__ void epi_res_rows(const f32x4 (&acc)[2][2][4][2], const float* __restrict__ src32, const bf16_t* __restrict__ src16, bf16_t* __restrict__ Xb, float* __restrict__ ssqp,
                                             int row0, int col0, int slot, int fq) {
    if constexpr (FIRST) {
#pragma unroll
        for (int ai = 0; ai < 2; ++ai) {
            X8 x[4][2];
#pragma unroll
            for (int m = 0; m < 4; ++m)
#pragma unroll
                for (int bj = 0; bj < 2; ++bj) x[m][bj] = ld_x8<true>(src32, src16, (size_t)(row0 + ai * 128 + m * 16) * 1024 + col0 + bj * 128);
#pragma unroll
            for (int m = 0; m < 4; ++m) {
                const int row = row0 + ai * 128 + m * 16;
                float part = 0.f;
#pragma unroll
                for (int bj = 0; bj < 2; ++bj) {
                    const f32x4 lo = x[m][bj].lo + acc[ai][bj][m][0], hi = x[m][bj].hi + acc[ai][bj][m][1];
                    st_x8(Xb + (size_t)row * 1024 + col0 + bj * 128, lo, hi);
                    part += dot4(lo, lo) + dot4(hi, hi);
                }
                part += __shfl_xor(part, 16); part += __shfl_xor(part, 32);
                if (fq == 0) ssqp[(size_t)row * 16 + slot] = part;
            }
        }
    } else {
        u32x4 xr[2][4][2];
#pragma unroll
        for (int ai = 0; ai < 2; ++ai)
#pragma unroll
            for (int m = 0; m < 4; ++m)
#pragma unroll
                for (int bj = 0; bj < 2; ++bj) xr[ai][m][bj] = *(const u32x4*)(src16 + (size_t)(row0 + ai * 128 + m * 16) * 1024 + col0 + bj * 128);
#pragma unroll
        for (int ai = 0; ai < 2; ++ai)
#pragma unroll
            for (int m = 0; m < 4; ++m) {
                const int row = row0 + ai * 128 + m * 16;
                float part = 0.f;
#pragma unroll
                for (int bj = 0; bj < 2; ++bj) {
                    const u32x4 u = xr[ai][m][bj];
                    const f32x4 lo = cvt4((u32x2){u.x, u.y}) + acc[ai][bj][m][0], hi = cvt4((u32x2){u.z, u.w}) + acc[ai][bj][m][1];
                    st_x8(Xb + (size_t)row * 1024 + col0 + bj * 128, lo, hi);
                    part += dot4(lo, lo) + dot4(hi, hi);
                }
                part += __shfl_xor(part, 16); part += __shfl_xor(part, 32);
                if (fq == 0) ssqp[(size_t)row * 16 + slot] = part;
            }
    }
}
struct EpiRes {
    static constexpr bool PERM = true;
    const float* xp; const float* xs; bf16_t* Xb; float* ssq_next;
    __device__ __forceinline__ void operator()(const f32x4 (&acc)[2][2][4][2], const pg8::Unit& u, int wr, int wc, int fr, int fq) const {
        const int row0 = u.pm * 256 + wr * 64 + fr, col0 = u.pn * 256 + wc * 32 + 8 * fq;
        if (xp) epi_res_rows<true>(acc, row0 < NTP ? xp : xs - (size_t)NTP * 1024, nullptr, Xb, ssq_next, row0, col0, u.pn * 4 + wc, fq);
        else epi_res_rows<false>(acc, nullptr, Xb, Xb, ssq_next, row0, col0, u.pn * 4 + wc, fq);
    }
};

template <bool FIRST>
__device__ __forceinline__ void res_sample_tile(const Ctx cx, const bf16_t* __restrict__ A, const bf16_t* __restrict__ Bt, const float* __restrict__ xs, bf16_t* __restrict__ Xb, float* __restrict__ ssqp, int tile) {
    const int tid = cx.tid, wid = tid >> 6, lane = tid & 63, fr = lane & 15, fq = lane >> 4;
    const int tm = tile >> 3, tn = tile & 7;
    const int r0 = NTP + tm * 64 + (wid & 3) * 16, c0 = tn * 128 + (wid >> 2) * 64;
    const bf16_t* ap = A + (size_t)(r0 + fr) * 1024 + fq * 8;
    const bf16_t* bp = Bt + (size_t)(c0 + fr) * 1024 + fq * 8;
    f32x4 acc[4];
#pragma unroll
    for (int nt = 0; nt < 4; ++nt) acc[nt] = (f32x4){0.f, 0.f, 0.f, 0.f};
#pragma unroll 8
    for (int ks = 0; ks < 32; ++ks) {
        const bf16x8 af = *(const bf16x8*)(ap + ks * 32);
#pragma unroll
        for (int nt = 0; nt < 4; ++nt) {
            const bf16x8 bf = *(const bf16x8*)(bp + (size_t)nt * 16 * 1024 + ks * 32);
            acc[nt] = __builtin_amdgcn_mfma_f32_16x16x32_bf16(bf, af, acc[nt], 0, 0, 0);
        }
    }
    const int row = r0 + fr;
    float part = 0.f;
#pragma unroll
    for (int nt = 0; nt < 4; ++nt) {
        const int col = c0 + nt * 16 + fq * 4;
        const f32x4 xo = FIRST ? *(const f32x4*)(xs + (size_t)(row - NTP) * 1024 + col) : ld_bf4(Xb + (size_t)row * 1024 + col);
        const f32x4 v = xo + acc[nt];
        st_bf4(Xb + (size_t)row * 1024 + col, v);
        part += dot4(v, v);
    }
    part += __shfl_xor(part, 16); part += __shfl_xor(part, 32);
    if (fq == 0) ssqp[(size_t)row * 16 + (c0 >> 6)] = part;
}

struct TrJob { const float* src; int ld, col0, k0; bf16_t* dst; int Ktot, drow0; const float* scale; bool zero; };
__device__ __forceinline__ TrJob tr_decode(const Params& p, const Ctx cx, int job) {
    TrJob J; J.zero = false; J.scale = nullptr;
    int j = job;
    if (j < 2176) {
        const int i = j / 1088, r = j % 1088, nt = r / 16, kt = r % 16, n0 = nt * 64;
        int col0 = 0;
        if (n0 < 2048) col0 = n0; else if (n0 < 2560) col0 = 3712 + (n0 - 2048); else if (n0 < 4224) col0 = 2048 + (n0 - 2560); else J.zero = true;
        J.src = PIN(I_WINE) + (size_t)i * 1024 * 4224; J.ld = 4224; J.col0 = col0; J.k0 = kt * 64; J.dst = (bf16_t*)(PWS + WS_WINE) + (size_t)i * 4352 * 1024; J.Ktot = 1024; J.drow0 = n0; J.scale = PIN(I_NORMW) + (2 * i) * 1024;
        return J;
    }
    j -= 2176;
    if (j < 512) { const int i = j / 256, r = j % 256, nt = r / 16, kt = r % 16;
        J.src = PIN(I_WOUTE) + (size_t)i * 1024 * 1024; J.ld = 1024; J.col0 = nt * 64; J.k0 = kt * 64; J.dst = (bf16_t*)(PWS + WS_WOUTE) + (size_t)i * 1024 * 1024; J.Ktot = 1024; J.drow0 = nt * 64; return J; }
    j -= 512;
    if (j < 1280) { const int i = j / 640, r = j % 640, nt = r / 16, kt = r % 16;
        J.src = PIN(I_WINO) + (size_t)i * 1024 * 2560; J.ld = 2560; J.col0 = nt * 64; J.k0 = kt * 64; J.dst = (bf16_t*)(PWS + WS_WINO) + (size_t)i * 2560 * 1024; J.Ktot = 1024; J.drow0 = nt * 64; J.scale = PIN(I_NORMW) + (2 * i + 1) * 1024; return J; }
    j -= 1280;
    if (j < 512) { const int i = j / 256, r = j % 256, nt = r / 16, kt = r % 16;
        J.src = PIN(I_WOUTO) + (size_t)i * 1024 * 1024; J.ld = 1024; J.col0 = nt * 64; J.k0 = kt * 64; J.dst = (bf16_t*)(PWS + WS_WOUTO) + (size_t)i * 1024 * 1024; J.Ktot = 1024; J.drow0 = nt * 64; return J; }
    j -= 512;
    if (j < 16) { const int i = j / 8, nt = j % 8;
        J.src = PIN(I_W2) + (size_t)i * 64 * 512; J.ld = 512; J.col0 = nt * 64; J.k0 = 0; J.dst = (bf16_t*)(PWS + WS_W2T) + (size_t)i * 512 * 64; J.Ktot = 64; J.drow0 = nt * 64; return J; }
    j -= 16;
    if (j < 16) { const int i = j / 8, nt = j % 8;
        J.src = PIN(I_A2) + (size_t)i * 64 * 512; J.ld = 512; J.col0 = nt * 64; J.k0 = 0; J.dst = (bf16_t*)(PWS + WS_A2T) + (size_t)i * 512 * 64; J.Ktot = 64; J.drow0 = nt * 64; return J; }
    j -= 16;
    { const int ig = j / 4, r = j % 4, nt = r / 2, kt = r % 2;
        J.src = PIN(I_POOLW) + (size_t)ig * 128 * 128; J.ld = 128; J.col0 = nt * 64; J.k0 = kt * 64; J.dst = (bf16_t*)(PWS + WS_POOLWT) + (size_t)ig * 128 * 128; J.Ktot = 128; J.drow0 = nt * 64; }
    return J;
}
__device__ __forceinline__ void tr_load(const TrJob& J, int tid, f32x4& va, f32x4& vb) {
    const int nn = (tid & 15) * 4, ka = tid >> 4, kb = ka + 32;
    va = (f32x4){0.f, 0.f, 0.f, 0.f}; vb = va;
    if (!J.zero) {
        va = *(const f32x4*)(J.src + (size_t)(J.k0 + ka) * J.ld + J.col0 + nn); vb = *(const f32x4*)(J.src + (size_t)(J.k0 + kb) * J.ld + J.col0 + nn);
        if (J.scale) { va = va * J.scale[J.k0 + ka]; vb = vb * J.scale[J.k0 + kb]; }
    }
}

__device__ void phase_prepass(const Params& p, const Ctx cx, LAS unsigned char* lds) {
    LAS float* T = (LAS float*)lds;
    const int tid = cx.tid;
    {
        int job = cx.bid;
        f32x4 va = (f32x4){0.f, 0.f, 0.f, 0.f}, vb = va;
        if (job < 4544) { const TrJob J0 = tr_decode(p, cx, job); tr_load(J0, tid, va, vb); }
        for (; job < 4544; job += cx.nblk) {
            f32x4 na = va, nb = vb;
            if (job + (int)cx.nblk < 4544) { const TrJob Jn = tr_decode(p, cx, job + (int)cx.nblk); tr_load(Jn, tid, na, nb); }
            {
                const int nn = (tid & 15) * 4, ka = tid >> 4, kb = ka + 32;
                T[ka * 65 + nn] = va[0]; T[ka * 65 + nn + 1] = va[1]; T[ka * 65 + nn + 2] = va[2]; T[ka * 65 + nn + 3] = va[3];
                T[kb * 65 + nn] = vb[0]; T[kb * 65 + nn + 1] = vb[1]; T[kb * 65 + nn + 2] = vb[2]; T[kb * 65 + nn + 3] = vb[3];
            }
            __syncthreads();
            {
                const TrJob J = tr_decode(p, cx, job);
                const int n = tid >> 3, kc = (tid & 7) * 8;
                u32x4 w;
                w.x = cvt_pk_bf16(T[(kc + 0) * 65 + n], T[(kc + 1) * 65 + n]); w.y = cvt_pk_bf16(T[(kc + 2) * 65 + n], T[(kc + 3) * 65 + n]);
                w.z = cvt_pk_bf16(T[(kc + 4) * 65 + n], T[(kc + 5) * 65 + n]); w.w = cvt_pk_bf16(T[(kc + 6) * 65 + n], T[(kc + 7) * 65 + n]);
                *(u32x4*)(J.dst + (size_t)(J.drow0 + n) * J.Ktot + J.k0 + kc) = w;
            }
            __syncthreads();
            va = na; vb = nb;
        }
    }
    const int gtid = cx.bid * 512 + tid, gthreads = cx.nblk * 512;
    for (int e = gtid; e < 8 * 128 * 128; e += gthreads) {
        const int s = e & 127, t = (e >> 7) & 127;
        ((bf16_t*)(PWS + WS_SPW))[e] = (s <= t) ? (bf16_t)(cvt_pk_bf16(PIN(I_SPW)[e], 0.f) & 0xffffu) : (bf16_t)0;
    }
    const int wid = tid >> 6, lane = tid & 63;
    for (int row0 = cx.bid * 8 + wid; row0 < NTOK; row0 += cx.nblk * 8 * 3) {
        f32x4 v[3][4];
#pragma unroll
        for (int r = 0; r < 3; ++r) {
            const int row = row0 + r * cx.nblk * 8; const int rr = row < NTOK ? row : row0;
            const float* src = rr < NTP ? PIN(I_XP) + (size_t)rr * 1024 : PIN(I_XS) + (size_t)(rr - NTP) * 1024;
#pragma unroll
            for (int i = 0; i < 4; ++i) v[r][i] = *(const f32x4*)(src + i * 256 + lane * 4);
        }
#pragma unroll
        for (int r = 0; r < 3; ++r) {
            const int row = row0 + r * cx.nblk * 8;
            if (row < NTOK) {
                bf16_t* dst = (bf16_t*)(PWS + WS_XB) + (size_t)row * 1024;
                float ss = 0.f;
#pragma unroll
                for (int i = 0; i < 4; ++i) { ss += dot4(v[r][i], v[r][i]); st_bf4(dst + i * 256 + lane * 4, v[r][i]); }
#pragma unroll
                for (int o = 32; o >= 1; o >>= 1) ss += __shfl_xor(ss, o);
                if (lane < 16) ((float*)(PWS + WS_SSQ))[(size_t)row * 16 + lane] = (lane == 0) ? ss : 0.f;
            }
        }
    }
}

__device__ __forceinline__ f32x4 shift4(const bf16_t* cur, bool hp, const float* st, int col, const float* mu) {
    const f32x4 q = ld_bf4(cur + col);
    f32x4 pv;
    if (hp) pv = ld_bf4(cur - LDB + col); else if (st) pv = *(const f32x4*)(st + col); else pv = (f32x4){0.f, 0.f, 0.f, 0.f};
    const f32x4 m = *(const f32x4*)(mu + col);
    return q + m * (pv - q);
}

__device__ void phase_even_prep(const Params& p, const Ctx cx, int pair, LAS unsigned char* lds) {
    const int tid = cx.tid, wid = tid >> 6, lane = tid & 63, fr = lane & 15, fq = lane >> 4;
    const bf16_t* PB = (const bf16_t*)(PWS + WS_PROJB);
    float* Wdec = (float*)(PWS + WS_WDEC);
    bf16_t* Aa = (bf16_t*)(PWS + WS_AA);
    bf16_t* Ycat = (bf16_t*)(PWS + WS_YCAT);
    const float* mu_ = PIN(I_MU) + pair * 1664;
    const float* w0_ = PIN(I_W0) + pair * 512; const float* a0_ = PIN(I_A0) + pair * 512;
    const float* k_a_ = PIN(I_KA) + pair * 512; const float* r_k_ = PIN(I_RK) + pair * 512;
    constexpr int RS = 3344;
    constexpr int TB = 17 * RS;
    constexpr int NCH = 17 * 208;
    const int h = wid;
    bf16x8 wfr[4][2], afr[4][2];
    {
        const bf16_t* W2T = (const bf16_t*)(PWS + WS_W2T) + (size_t)pair * 512 * 64;
        const bf16_t* A2T = (const bf16_t*)(PWS + WS_A2T) + (size_t)pair * 512 * 64;
#pragma unroll
        for (int nt = 0; nt < 4; ++nt)
#pragma unroll
            for (int ks = 0; ks < 2; ++ks) {
                wfr[nt][ks] = *(const bf16x8*)(W2T + (size_t)(h * 64 + nt * 16 + fr) * 64 + ks * 32 + fq * 8);
                afr[nt][ks] = *(const bf16x8*)(A2T + (size_t)(h * 64 + nt * 16 + fr) * 64 + ks * 32 + fq * 8);
            }
    }
    constexpr int TBD = 56 * 1024;
    const int widu = __builtin_amdgcn_readfirstlane(tid >> 6);
#define PREP_DMA(tile_, b_, lane_) do { _Pragma("unroll") for (int i_ = 0; i_ < 7; ++i_) { const int k_ = widu * 7 + i_, q_ = k_ * 64 + (lane_); \
            int lr_ = q_ / 209, cc_ = q_ - lr_ * 209; if (lr_ > 16) { lr_ = 16; cc_ = 0; } if (cc_ > 207) cc_ = 0; \
            int gr_ = (tile_) * 16 - 1 + lr_; gr_ = gr_ < 0 ? 0 : gr_; \
            __builtin_amdgcn_global_load_lds((const unsigned*)(PB + (size_t)gr_ * LDB + cc_ * 8), (LAS unsigned*)(lds + (b_) * TBD + k_ * 1024), 16, 0, 0); } } while (0)
    int buf = 0;
    if ((int)cx.bid < NTOK / 16) PREP_DMA((int)cx.bid, 0, tid & 63);
    asm volatile("s_waitcnt vmcnt(0)" ::: "memory");
    __syncthreads();
    for (int tile = cx.bid; tile < NTOK / 16; tile += cx.nblk) {
        int zz; asm volatile("v_mov_b32 %0, 0" : "=v"(zz));
        const int tidv = tid + zz, fr = (tidv & 15), fq = (tidv >> 4) & 3;
        if (tile + (int)cx.nblk < NTOK / 16) PREP_DMA(tile + (int)cx.nblk, buf ^ 1, tidv & 63);
        {
            const int row = tile * 16 + fr;
            const bool samp = row >= NTP;
            int b, t; if (!samp) { b = row >> 11; t = row & 2047; } else { const int q = row - NTP; b = q >> 3; t = q & 7; }
            const bool hp = t > 0;
            const float* st = samp ? PIN(I_SSHIFT) + ((size_t)pair * 128 + b) * 1664 : nullptr;
            const float* mu = mu_ + zz; const float* w0 = w0_ + zz; const float* a0 = a0_ + zz; const float* k_a = k_a_ + zz; const float* r_k = r_k_ + zz;
            LAS const unsigned char* curL = lds + buf * TBD + (fr + 1) * RS;
            LAS const unsigned char* prvL = lds + buf * TBD + fr * RS;
            auto sh4 = [&](int col) -> f32x4 {
                const f32x4 q = cvt4(*(LAS const u32x2*)(curL + col * 2));
                f32x4 pv;
                if (hp) pv = cvt4(*(LAS const u32x2*)(prvL + col * 2)); else if (st) pv = *(const f32x4*)(st + col); else pv = (f32x4){0.f, 0.f, 0.f, 0.f};
                const f32x4 m = *(const f32x4*)(mu + col);
                return q + m * (pv - q);
            };
            bf16x8 Aw[2], Al[2];
#pragma unroll
            for (int ks = 0; ks < 2; ++ks) {
                const int cw = 1536 + ks * 32 + fq * 8, ca = 1600 + ks * 32 + fq * 8;
                const f32x4 w_lo = sh4(cw), w_hi = sh4(cw + 4), a_lo = sh4(ca), a_hi = sh4(ca + 4);
                u32x4 pw, pa;
                float th[8];
#pragma unroll
                for (int j = 0; j < 4; ++j) { th[j] = 2.0f * sigmoidf_(2.0f * w_lo[j]) - 1.0f; th[4 + j] = 2.0f * sigmoidf_(2.0f * w_hi[j]) - 1.0f; }
                pw.x = cvt_pk_bf16(th[0], th[1]); pw.y = cvt_pk_bf16(th[2], th[3]); pw.z = cvt_pk_bf16(th[4], th[5]); pw.w = cvt_pk_bf16(th[6], th[7]);
                pa.x = cvt_pk_bf16(a_lo[0], a_lo[1]); pa.y = cvt_pk_bf16(a_lo[2], a_lo[3]); pa.z = cvt_pk_bf16(a_hi[0], a_hi[1]); pa.w = cvt_pk_bf16(a_hi[2], a_hi[3]);
                Aw[ks] = __builtin_bit_cast(bf16x8, pw); Al[ks] = __builtin_bit_cast(bf16x8, pa);
            }
            float bon = 0.f;
#pragma unroll
            for (int nt = 0; nt < 4; ++nt) {
                f32x4 lw = (f32x4){0.f, 0.f, 0.f, 0.f}, la = (f32x4){0.f, 0.f, 0.f, 0.f};
#pragma unroll
                for (int ks = 0; ks < 2; ++ks) {
                    lw = __builtin_amdgcn_mfma_f32_16x16x32_bf16(wfr[nt][ks], Aw[ks], lw, 0, 0, 0);
                    la = __builtin_amdgcn_mfma_f32_16x16x32_bf16(afr[nt][ks], Al[ks], la, 0, 0, 0);
                }
                const int ch = h * 64 + nt * 16 + fq * 4;
                const f32x4 r4 = sh4(ch), k4 = sh4(512 + ch);
                const f32x4 w04 = *(const f32x4*)(w0 + ch), a04 = *(const f32x4*)(a0 + ch), ka4 = *(const f32x4*)(k_a + ch), rk4 = *(const f32x4*)(r_k + ch);
                f32x4 dec, av;
#pragma unroll
                for (int j = 0; j < 4; ++j) {
                    const float z_ = -(w04[j] + lw[j]);
                    const float wlog = -__logf(1.0f + __expf(z_)) - 0.5f;
                    dec[j] = __expf(-__expf(wlog));
                    av[j] = sigmoidf_(a04[j] + la[j]);
                    const float kp = k4[j] * (1.0f + (av[j] - 1.0f) * ka4[j]);
                    bon += r4[j] * kp * rk4[j];
                }
                *(f32x4*)(Wdec + (size_t)row * 512 + ch) = dec;
                st_bf4(Aa + (size_t)row * 512 + ch, av);
            }
            bon += __shfl_xor(bon, 16); bon += __shfl_xor(bon, 32);
#pragma unroll
            for (int nt = 0; nt < 4; ++nt) { const int ch = h * 64 + nt * 16 + fq * 4; st_bf4(Ycat + (size_t)row * 1024 + 512 + ch, sh4(1024 + ch) * bon); }
        }
        asm volatile("s_waitcnt vmcnt(0)" ::: "memory");
        __syncthreads();
        buf ^= 1;
    }
#undef PREP_DMA
    const int gtid = cx.bid * 512 + tid, gthreads = cx.nblk * 512;
    for (int e = gtid; e < 136 * 1664; e += gthreads) {
        const int sr = e / 1664, c = e % 1664;
        if (sr < 8) POUT[O_SHIFTP + ((size_t)pair * 8 + sr) * 1664 + c] = bf2f(PB[(size_t)(sr * 2048 + 2047) * LDB + c]);
        else { const int b = sr - 8; POUT[O_SHIFTS + ((size_t)pair * 128 + b) * 1664 + c] = bf2f(PB[(size_t)(NTP + b * 8 + 7) * LDB + c]); }
    }
}

typedef float f32x2 __attribute__((ext_vector_type(2)));
template <bool RED = true>
__device__ __forceinline__ void scan_step(f32x4& S, const f32x4 w, const f32x4 k, const f32x4 kk, const f32x4 nb, const f32x4 r, const float v, float& y) {
    const f32x2 S01 = {S[0], S[1]}, S23 = {S[2], S[3]};
    f32x2 pp = S01 * (f32x2){kk[0], kk[1]};
    pp = S23 * (f32x2){kk[2], kk[3]} + pp;
    float pd = pp[0] + pp[1];
    const f32x2 vv = {v, v};
    const f32x2 t01 = S01 * (f32x2){w[0], w[1]} + (f32x2){k[0], k[1]} * vv;
    const f32x2 t23 = S23 * (f32x2){w[2], w[3]} + (f32x2){k[2], k[3]} * vv;
    pd = allsum16(pd);
    const f32x2 pdv = {pd, pd};
    const f32x2 n01 = (f32x2){nb[0], nb[1]} * pdv + t01, n23 = (f32x2){nb[2], nb[3]} * pdv + t23;
    S = (f32x4){n01[0], n01[1], n23[0], n23[1]};
    f32x2 q = n01 * (f32x2){r[0], r[1]};
    q = n23 * (f32x2){r[2], r[3]} + q;
    y = RED ? allsum16(q[0] + q[1]) : (q[0] + q[1]);
}
__device__ __forceinline__ float reduce_scatter16(const float (&yp)[16], int cgi) {
    const bool b3 = cgi & 8, b2 = cgi & 4, b1 = cgi & 2, b0 = cgi & 1;
    float a[8], bq[4], c[2];
#pragma unroll
    for (int j = 0; j < 8; ++j) { const float keep = b3 ? yp[8 + j] : yp[j], send = b3 ? yp[j] : yp[8 + j]; a[j] = keep + dpp_f<0x128>(send); }
#pragma unroll
    for (int k = 0; k < 4; ++k) { const float keep = b2 ? a[4 + k] : a[k], send = b2 ? a[k] : a[4 + k]; bq[k] = keep + dpp_f<0x141>(send); }
#pragma unroll
    for (int m = 0; m < 2; ++m) { const float keep = b1 ? bq[2 + m] : bq[m], send = b1 ? bq[m] : bq[2 + m]; c[m] = keep + dpp_f<0x4E>(send); }
    const float keep = b0 ? c[1] : c[0], send = b0 ? c[0] : c[1];
    return keep + dpp_f<0xB1>(send);
}

__device__ void phase_scan(const Params& p, const Ctx cx, int pair, LAS unsigned char* lds) {
    const int tid = cx.tid, wid = tid >> 6, lane = tid & 63, rs = lane >> 4, cgi = lane & 15;
    const bf16_t* PB = (const bf16_t*)(PWS + WS_PROJB);
    const float* Wdec = (const float*)(PWS + WS_WDEC);
    const bf16_t* Aa = (const bf16_t*)(PWS + WS_AA);
    float* Y = (float*)(PWS + WS_Y);
    const float* mu = PIN(I_MU) + pair * 1664;
    const float* k_k = PIN(I_KK) + pair * 512; const float* k_a = PIN(I_KA) + pair * 512;
    {
        LAS float* vb = (LAS float*)lds + wid * 3072;
        for (int st = cx.bid * 8 + wid; st < 2048; st += cx.nblk * 8) {
            const int bh = st >> 1, half = st & 1, b = bh >> 3, h = bh & 7, ch = h * 64 + cgi * 4;
            const float* stp = PIN(I_SSHIFT) + ((size_t)pair * 128 + b) * 1664;
            const f32x4 kkc = *(const f32x4*)(k_k + ch), kac = *(const f32x4*)(k_a + ch);
            {
#pragma unroll
                for (int tt = 0; tt < 2; ++tt) {
                    const int t = rs + tt * 4;
                    const size_t row = NTP + b * 8 + t;
                    const bf16_t* cur = PB + row * LDB;
                    const f32x4 r = shift4(cur, t > 0, stp, ch, mu), k = shift4(cur, t > 0, stp, 512 + ch, mu), v = shift4(cur, t > 0, stp, 1024 + ch, mu);
                    const f32x4 a = ld_bf4(Aa + row * 512 + ch);
                    const f32x4 w = *(const f32x4*)(Wdec + row * 512 + ch);
                    const f32x4 kkv = k * kkc;
                    const float ss = allsum16(dot4(kkv, kkv));
                    const float inv = 1.0f / fmaxf(sqrtf(ss), 1e-12f);
                    const f32x4 kkn = kkv * inv;
                    LAS float* o = vb + t * 384 + cgi * 4;
                    *(LAS f32x4*)(o) = w; *(LAS f32x4*)(o + 64) = k * (1.0f + (a - 1.0f) * kac); *(LAS f32x4*)(o + 128) = kkn; *(LAS f32x4*)(o + 192) = -(kkn * a);
                    *(LAS f32x4*)(o + 256) = r; *(LAS f32x4*)(o + 320) = v;
                }
            }
            asm volatile("s_waitcnt lgkmcnt(0)" ::: "memory");
            __builtin_amdgcn_wave_barrier();
            const size_t so0 = ((((size_t)pair * 128 + b) * 8 + h) * 64 + half * 32 + rs) * 64 + cgi * 4;
            f32x4 Snext = *(const f32x4*)(PIN(I_SWKV) + so0);
#pragma unroll 1
            for (int rq = 0; rq < 8; ++rq) {
                const int ri = half * 32 + rq * 4 + rs;
                const size_t so = so0 + (size_t)rq * 256;
                f32x4 S = Snext;
                if (rq + 1 < 8) Snext = *(const f32x4*)(PIN(I_SWKV) + so + 256);
#pragma unroll
                for (int t = 0; t < 8; ++t) {
                    LAS const float* r0 = vb + t * 384 + cgi * 4;
                    float y; scan_step(S, *(LAS const f32x4*)(r0), *(LAS const f32x4*)(r0 + 64), *(LAS const f32x4*)(r0 + 128), *(LAS const f32x4*)(r0 + 192), *(LAS const f32x4*)(r0 + 256), vb[t * 384 + 320 + ri], y);
                    if (cgi == 0) Y[(size_t)(NTP + b * 8 + t) * 512 + h * 64 + ri] = y;
                }
                *(f32x4*)(POUT + O_WKVS + so) = S;
            }
            asm volatile("s_waitcnt lgkmcnt(0)" ::: "memory");
            __builtin_amdgcn_wave_barrier();
        }
    }
    __syncthreads();
    LAS float* rec = (LAS float*)lds;
    for (int pt = cx.bid; pt < 256; pt += cx.nblk) {
        const int xcd = pt & 7, slot = pt >> 3, bh = xcd * 8 + (slot >> 2), rg = slot & 3, b = bh >> 3, h = bh & 7;
        const int lt = tid - 256, ls = (lt >> 4) & 15, lcg = lt & 15, lch = h * 64 + lcg * 4;
        u32x2 qr = {0u, 0u}, qk = {0u, 0u}, qv = {0u, 0u}, pr = {0u, 0u}, pk = {0u, 0u}, pv = {0u, 0u}, qa = {0u, 0u};
        f32x4 qw = (f32x4){0.f, 0.f, 0.f, 0.f};
        f32x4 mur, muk, muv, kkc, kac;
        const int ri = rg * 16 + (wid & 3) * 4 + rs;
        f32x4 S = (f32x4){0.f, 0.f, 0.f, 0.f};
#define SCAN_ISSUE(c) do { const int t_ = (c) * 16 + ls; const size_t row_ = (size_t)b * 2048 + t_; const bf16_t* cur_ = PB + row_ * LDB; \
            qr = *(const u32x2*)(cur_ + lch); qk = *(const u32x2*)(cur_ + 512 + lch); qv = *(const u32x2*)(cur_ + 1024 + lch); \
            if (t_ > 0) { pr = *(const u32x2*)(cur_ - LDB + lch); pk = *(const u32x2*)(cur_ - LDB + 512 + lch); pv = *(const u32x2*)(cur_ - LDB + 1024 + lch); } \
            else { pr = (u32x2){0u, 0u}; pk = pr; pv = pr; } \
            qw = *(const f32x4*)(Wdec + row_ * 512 + lch); qa = *(const u32x2*)(Aa + row_ * 512 + lch); } while (0)
#define SCAN_PROCESS(buf) do { const f32x4 r0_ = cvt4(qr), k0_ = cvt4(qk), v0_ = cvt4(qv); \
            const f32x4 r_ = r0_ + mur * (cvt4(pr) - r0_), k_ = k0_ + muk * (cvt4(pk) - k0_), v_ = v0_ + muv * (cvt4(pv) - v0_), a_ = cvt4(qa); \
            const f32x4 kkv_ = k_ * kkc; const float ss_ = allsum16(dot4(kkv_, kkv_)); const float inv_ = __builtin_amdgcn_rsqf(fmaxf(ss_, 1e-24f)); \
            const f32x4 kkn_ = kkv_ * inv_; \
            LAS float* o_ = rec + (buf) * 6144 + ls * 384 + lcg * 4; \
            *(LAS f32x4*)(o_) = qw; *(LAS f32x4*)(o_ + 64) = k_ * (1.0f + (a_ - 1.0f) * kac); *(LAS f32x4*)(o_ + 128) = kkn_; *(LAS f32x4*)(o_ + 192) = -(kkn_ * a_); \
            *(LAS f32x4*)(o_ + 256) = r_; *(LAS f32x4*)(o_ + 320) = v_; } while (0)
        if (wid >= 4) {
            mur = *(const f32x4*)(mu + lch); muk = *(const f32x4*)(mu + 512 + lch); muv = *(const f32x4*)(mu + 1024 + lch);
            kkc = *(const f32x4*)(k_k + lch); kac = *(const f32x4*)(k_a + lch);
            SCAN_ISSUE(0); SCAN_PROCESS(0); SCAN_ISSUE(1);
        }
        __syncthreads();
        for (int c = 0; c < 128; ++c) {
            if (wid < 4) {
                LAS const float* rb = rec + (c & 1) * 6144 + cgi * 4;
                LAS const float* rv = rec + (c & 1) * 6144 + 320 + ri;
                float yp[16];
                f32x4 nw = *(LAS const f32x4*)(rb), nk = *(LAS const f32x4*)(rb + 64), nkk = *(LAS const f32x4*)(rb + 128), nb = *(LAS const f32x4*)(rb + 192), nr = *(LAS const f32x4*)(rb + 256);
                float nv = rv[0];
#pragma unroll
                for (int s = 0; s < 16; ++s) {
                    const f32x4 cw = nw, ck = nk, ckk = nkk, cb = nb, cr = nr; const float cv = nv;
                    if (s + 1 < 16) {
                        LAS const float* r1 = rb + (s + 1) * 384;
                        nw = *(LAS const f32x4*)(r1); nk = *(LAS const f32x4*)(r1 + 64); nkk = *(LAS const f32x4*)(r1 + 128); nb = *(LAS const f32x4*)(r1 + 192); nr = *(LAS const f32x4*)(r1 + 256);
                        nv = rv[(s + 1) * 384];
                    }
                    scan_step<false>(S, cw, ck, ckk, cb, cr, cv, yp[s]);
                }
                Y[((size_t)b * 2048 + c * 16 + cgi) * 512 + h * 64 + ri] = reduce_scatter16(yp, cgi);
            } else {
                if (c + 1 < 128) { SCAN_PROCESS((c + 1) & 1); if (c + 2 < 128) SCAN_ISSUE(c + 2); }
            }
            __syncthreads();
        }
        if (wid < 4) *(f32x4*)(POUT + O_WKVP + ((((size_t)pair * 8 + b) * 8 + h) * 64 + ri) * 64 + cgi * 4) = S;
#undef SCAN_ISSUE
#undef SCAN_PROCESS
    }
}

__device__ void phase_even_post(const Params& p, const Ctx cx, int pair) {
    const int gtid = cx.bid * 512 + cx.tid, gthreads = cx.nblk * 512;
    const bf16_t* PA = (const bf16_t*)(PWS + WS_R1);
    bf16_t* Ycat = (bf16_t*)(PWS + WS_YCAT);
    const float* Y = (const float*)(PWS + WS_Y);
    constexpr int NIT = NTOK * 128, UB = 4;
    const float* gn_g = PIN(I_GNG) + pair * 512; const float* gn_b = PIN(I_GNB) + pair * 512;
    for (int e0 = gtid; e0 < NIT; e0 += gthreads * UB) {
        f32x4 y[UB], bv[UB], bz[UB]; bool ok[UB];
#pragma unroll
        for (int u = 0; u < UB; ++u) {
            const int e = e0 + u * gthreads; ok[u] = e < NIT;
            const int ee = ok[u] ? e : e0; const int row = ee >> 7, ch = (ee & 127) * 4;
            y[u] = *(const f32x4*)(Y + (size_t)row * 512 + ch);
            bv[u] = ld_bf4(Ycat + (size_t)row * 1024 + 512 + ch);
            bz[u] = ld_bf4(PA + (size_t)row * LDA + 2048 + ch);
        }
#pragma unroll
        for (int u = 0; u < UB; ++u) {
            const int e = e0 + u * gthreads;
            const int ee = ok[u] ? e : e0; const int row = ee >> 7, ch = (ee & 127) * 4;
            const float mean = allsum16(y[u][0] + y[u][1] + y[u][2] + y[u][3]) * (1.0f / 64.0f);
            const f32x4 d = y[u] - mean;
            const float var = allsum16(dot4(d, d)) * (1.0f / 64.0f);
            const float rstd = rsqrtf(var + 64e-5f);
            const f32x4 g = *(const f32x4*)(gn_g + ch), bb = *(const f32x4*)(gn_b + ch);
            f32x4 o;
#pragma unroll
            for (int j = 0; j < 4; ++j) o[j] = (d[j] * rstd * g[j] + bb[j] + bv[u][j]) * siluf_(bz[u][j]);
            if (ok[u]) st_bf4(Ycat + (size_t)row * 1024 + 512 + ch, o);
        }
    }
    const float* cw = PIN(I_CONVW) + pair * 3 * 512;
    constexpr int NRUN = (NTOK / 8) * 128;
    for (int e = gtid; e < NRUN; e += gthreads) {
        const int run = e >> 7, ch = (e & 127) * 4, row0 = run * 8;
        const bool samp = row0 >= NTP;
        int b, t0, T; if (!samp) { b = row0 >> 11; t0 = row0 & 2047; T = 2048; } else { b = (row0 - NTP) >> 3; t0 = 0; T = 8; }
        const bf16_t* base = PA + (size_t)row0 * LDA + ch;
        u32x2 rh[10], rc[10], rb[8], rz[8];
#pragma unroll
        for (int k = 0; k < 10; ++k) {
            const bool have = (k >= 2) || (t0 > 0);
            const bf16_t* pr = have ? base + (ptrdiff_t)(k - 2) * LDA : base;
            rh[k] = *(const u32x2*)(pr); rc[k] = *(const u32x2*)(pr + 1024);
        }
#pragma unroll
        for (int k = 0; k < 8; ++k) { rb[k] = *(const u32x2*)(base + (size_t)k * LDA + 512); rz[k] = *(const u32x2*)(base + (size_t)k * LDA + 1536); }
        const f32x4 k0 = *(const f32x4*)(cw + ch), k1 = *(const f32x4*)(cw + 512 + ch), k2 = *(const f32x4*)(cw + 1024 + ch);
        f32x4 um2, um1;
        if (t0 > 0) { um2 = cvt4(rc[0]) * cvt4(rh[0]); um1 = cvt4(rc[1]) * cvt4(rh[1]); }
        else if (samp) { const float* hist = PIN(I_SCONV) + ((size_t)pair * 128 + b) * 2 * 512 + ch; um2 = *(const f32x4*)(hist); um1 = *(const f32x4*)(hist + 512); }
        else { um2 = (f32x4){0.f, 0.f, 0.f, 0.f}; um1 = um2; }
#pragma unroll
        for (int k = 0; k < 8; ++k) {
            const f32x4 u0 = cvt4(rc[k + 2]) * cvt4(rh[k + 2]);
            const f32x4 conv = k0 * um2 + k1 * um1 + k2 * u0;
            const f32x4 ab = cvt4(rb[k]), az = cvt4(rz[k]);
            f32x4 o;
#pragma unroll
            for (int j = 0; j < 4; ++j) o[j] = ab[j] * conv[j] * siluf_(az[j]);
            const int row = row0 + k, t = t0 + k;
            st_bf4(Ycat + (size_t)row * 1024 + ch, o);
            if (t >= T - 2) {
                float* dst = samp ? POUT + O_CONVS + (((size_t)pair * 128 + b) * 2 + (t - (T - 2))) * 512 + ch : POUT + O_CONVP + (((size_t)pair * 8 + b) * 2 + (t - (T - 2))) * 512 + ch;
                *(f32x4*)dst = u0;
            }
            um2 = um1; um1 = u0;
        }
    }
}

template <int W>
__device__ __forceinline__ void pool_sample_run(const float* __restrict__ hist, const bf16_t* __restrict__ cur, LAS bf16_t* out) {
    f32x4 ext[23];
#pragma unroll
    for (int k = 0; k < 15; ++k) ext[k] = (k >= 16 - W) ? *(const f32x4*)(hist + (size_t)k * 512) : (f32x4){0.f, 0.f, 0.f, 0.f};
#pragma unroll
    for (int k = 0; k < 8; ++k) ext[15 + k] = ld_bf4(cur + (size_t)k * LDA);
    f32x4 sum = (f32x4){0.f, 0.f, 0.f, 0.f};
#pragma unroll
    for (int d = 0; d < W; ++d) sum += ext[15 - d];
#pragma unroll
    for (int t = 0; t < 8; ++t) {
        if (t > 0) sum += ext[15 + t] - ext[15 + t - W];
        const f32x4 pooled = sum * (1.0f / (float)W) - ext[15 + t];
        u32x2 u; u.x = cvt_pk_bf16(pooled[0], pooled[1]); u.y = cvt_pk_bf16(pooled[2], pooled[3]);
        *(LAS u32x2*)(out + t * 136) = u;
    }
}

__device__ void phase_odd_mixer(const Params& p, const Ctx cx, int pair, LAS unsigned char* lds) {
    const int tid = cx.tid, wid = tid >> 6, lane = tid & 63, fr = lane & 15, fq = lane >> 4;
    const bf16_t* PO = (const bf16_t*)(PWS + WS_R1);
    bf16_t* Ycat = (bf16_t*)(PWS + WS_YCAT);
    LAS bf16_t* LA = (LAS bf16_t*)lds;
    LAS bf16_t* LB = (LAS bf16_t*)(lds + 128 * 136 * 2);
    LAS float* stat = (LAS float*)(lds + 2 * 128 * 136 * 2);
    LAS float* LE = (LAS float*)(lds + 128 * 136 * 2);
    LAS bf16_t* LW = (LAS bf16_t*)(lds + 128 * 136 * 2 + 143 * 128 * 4);
    for (int di = 0; di < 8; ++di) {
        int tile, g0, ng;
        if (cx.nblk == 256) {
            if (di == 0) { tile = cx.bid >> 1; g0 = (cx.bid & 1) * 2; ng = 2; }
            else if (di == 1 && cx.bid < 32) { tile = 128 + (cx.bid >> 2); g0 = cx.bid & 3; ng = 1; }
            else break;
        } else { tile = cx.bid + di * cx.nblk; g0 = 0; ng = 4; if (tile >= 136) break; }
        const int r0 = tile * 128;
        const bool samp = r0 >= NTP;
        const int tl_ = tid >> 2, q_ = tid & 3;
        {
            const bf16_t* vr = PO + (size_t)(r0 + tl_) * LDA + 1536 + q_ * 128;
            float s_ = 0.f, ss = 0.f;
#pragma unroll
            for (int i = 0; i < 16; ++i) { const u32x4 raw = *(const u32x4*)(vr + i * 8); const f32x4 v0 = cvt4((u32x2){raw.x, raw.y}), v1 = cvt4((u32x2){raw.z, raw.w});
                s_ += (v0[0] + v0[1]) + (v0[2] + v0[3]) + (v1[0] + v1[1]) + (v1[2] + v1[3]); ss += dot4(v0, v0) + dot4(v1, v1); }
            s_ = allsum4(s_); ss = allsum4(ss);
            const float mean = s_ * (1.0f / 512.0f);
            const float var = fmaxf(ss * (1.0f / 512.0f) - mean * mean, 0.f);
            if (q_ == 0) { stat[tl_ * 2] = mean; stat[tl_ * 2 + 1] = rsqrtf(var + 1e-5f); }
        }
        u32x2 rv[8]; u32x4 rw[4];
#define MIX_LOAD_G(gg) do { const bf16_t* vr_ = PO + (size_t)(r0 + tl_) * LDA + 1536 + (gg) * 128 + q_ * 32; \
            _Pragma("unroll") for (int i = 0; i < 8; ++i) rv[i] = *(const u32x2*)(vr_ + i * 4); \
            if (!samp) { const bf16_t* Ws_ = (const bf16_t*)(PWS + WS_SPW) + ((size_t)pair * 4 + (gg)) * 128 * 128; \
                _Pragma("unroll") for (int i = 0; i < 4; ++i) { const int e = tid + i * 512; rw[i] = *(const u32x4*)(Ws_ + (e >> 4) * 128 + (e & 15) * 8); } } } while (0)
        MIX_LOAD_G(g0);
        __syncthreads();
#pragma unroll 1
        for (int g = g0; g < g0 + ng; ++g) {
            u32x2 ur[8], dzr[8];
#pragma unroll
            for (int nt = 0; nt < 8; ++nt) { const size_t o_ = (size_t)(r0 + wid * 16 + fr) * LDA + g * 128 + nt * 16 + fq * 4; ur[nt] = *(const u32x2*)(PO + o_ + 1024); dzr[nt] = *(const u32x2*)(PO + o_ + 2048); }
            {
                const int row = r0 + tl_;
                const float mean = stat[tl_ * 2], rstd = stat[tl_ * 2 + 1];
                const float* lg = PIN(I_LNG) + pair * 512 + g * 128 + q_ * 32; const float* lb = PIN(I_LNB) + pair * 512 + g * 128 + q_ * 32;
#pragma unroll
                for (int i = 0; i < 8; ++i) {
                    const f32x4 v = cvt4(rv[i]);
                    const f32x4 vn = (v - mean) * rstd * *(const f32x4*)(lg + i * 4) + *(const f32x4*)(lb + i * 4);
                    if (samp) *(f32x4*)(POUT + O_CHUNKV + ((size_t)pair * 1024 + (row - NTP)) * 512 + g * 128 + q_ * 32 + i * 4) = vn;
                    {
                        const float p0 = dpp_f<0x104>(vn[0]), p1 = dpp_f<0x104>(vn[1]);
                        const float p2 = dpp_f<0x114>(vn[2]), p3 = dpp_f<0x114>(vn[3]);
                        const bool odd = tl_ & 1;
                        const unsigned wa = odd ? cvt_pk_bf16(p2, vn[2]) : cvt_pk_bf16(vn[0], p0);
                        const unsigned wb = odd ? cvt_pk_bf16(p3, vn[3]) : cvt_pk_bf16(vn[1], p1);
                        const int cb = q_ * 32 + i * 4 + (odd ? 2 : 0), tb = tl_ & ~1;
                        *(LAS unsigned*)(LB + (cb) * 136 + tb) = wa;
                        *(LAS unsigned*)(LB + (cb + 1) * 136 + tb) = wb;
                    }
                }
            }
            if (!samp) {
#pragma unroll
                for (int i = 0; i < 4; ++i) { const int e = tid + i * 512; *(LAS u32x4*)(LA + (e >> 4) * 136 + (e & 15) * 8) = rw[i]; }
            } else {
                const float* Wsrc = PIN(I_SPW) + ((size_t)pair * 4 + g) * 128 * 128;
                LAS float* w8 = stat + 256;
                if (tid < 64) w8[tid] = Wsrc[(tid >> 3) * 128 + (tid & 7)];
                __syncthreads();
                for (int e = tid; e < 128 * 128; e += 512) { const int t = e >> 7, s2 = e & 127;
                    const float v = ((t >> 3) == (s2 >> 3) && (s2 & 7) <= (t & 7)) ? w8[(t & 7) * 8 + (s2 & 7)] : 0.f;
                    LA[t * 136 + s2] = (bf16_t)(cvt_pk_bf16(v, 0.f) & 0xffffu); }
            }
            if (g + 1 < g0 + ng) MIX_LOAD_G(g + 1);
            __syncthreads();
            {
                const int tl = wid * 16 + fr, row = r0 + tl;
                const float bias = PIN(I_SPB)[((size_t)pair * 4 + g) * 128 + (samp ? (tl & 7) : tl)];
                bf16x8 wf[4];
#pragma unroll
                for (int ks = 0; ks < 4; ++ks) wf[ks] = *(const LAS bf16x8*)(LA + tl * 136 + ks * 32 + fq * 8);
#pragma unroll
                for (int nt = 0; nt < 8; ++nt) {
                    f32x4 acc = (f32x4){0.f, 0.f, 0.f, 0.f};
#pragma unroll
                    for (int ks = 0; ks < 4; ++ks) {
                        if (ks * 32 <= wid * 16 + 15) {
                            const bf16x8 vf = *(const LAS bf16x8*)(LB + (nt * 16 + fr) * 136 + ks * 32 + fq * 8);
                            acc = __builtin_amdgcn_mfma_f32_16x16x32_bf16(vf, wf[ks], acc, 0, 0, 0);
                        }
                    }
                    const int c = g * 128 + nt * 16 + fq * 4;
                    const f32x4 u = cvt4(ur[nt]), dz = cvt4(dzr[nt]);
                    f32x4 o;
#pragma unroll
                    for (int j = 0; j < 4; ++j) o[j] = u[j] * (acc[j] + bias) * siluf_(dz[j]);
                    st_bf4(Ycat + (size_t)row * 1024 + 512 + c, o);
                }
            }
            __syncthreads();
        }
#undef MIX_LOAD_G
    }
    {
        int ci, cstride;
        if (cx.nblk == 256) { if (cx.bid < 32) { ci = 1 << 20; cstride = 1 << 20; } else { ci = cx.bid - 32; cstride = 224; } }
        else { ci = cx.bid; cstride = cx.nblk; }
        u32x4 pw[4]; u32x2 pe[9];
#define MIX_LOAD_C(cc) do { const int tile_ = (cc) >> 2, g_ = (cc) & 3, r0_ = tile_ * 128; \
            const bf16_t* Bw_ = (const bf16_t*)(PWS + WS_POOLWT) + ((size_t)pair * 4 + g_) * 128 * 128; \
            _Pragma("unroll") for (int i = 0; i < 4; ++i) { const int e = tid + i * 512; pw[i] = *(const u32x4*)(Bw_ + (e >> 4) * 128 + (e & 15) * 8); } \
            if (r0_ < NTP) { const int t0_ = r0_ & 2047; \
                _Pragma("unroll") for (int i = 0; i < 9; ++i) { const int e = tid + i * 512, er = e >> 5, c = (e & 31) * 4; pe[i] = (u32x2){0u, 0u}; \
                    if (e < 143 * 32 && t0_ + er - 15 >= 0) pe[i] = *(const u32x2*)(PO + (size_t)(r0_ + er - 15) * LDA + g_ * 128 + c); } } } while (0)
        if (ci < 544) MIX_LOAD_C(ci);
        for (; ci < 544; ci += cstride) {
            const int tile = ci >> 2, g = ci & 3, r0 = tile * 128;
            const bool samp = r0 >= NTP;
            const int w = 2 << g;
            const int row = r0 + wid * 16 + fr;
            u32x2 czr[8]; f32x4 psr[8];
#pragma unroll
            for (int nt = 0; nt < 8; ++nt) { const int d = g * 128 + nt * 16 + fq * 4; czr[nt] = *(const u32x2*)(PO + (size_t)row * LDA + 512 + d); psr[nt] = *(const f32x4*)(PIN(I_PSCALE) + pair * 512 + d); }
#pragma unroll
            for (int i = 0; i < 4; ++i) { const int e = tid + i * 512; *(LAS u32x4*)(LW + (e >> 4) * 136 + (e & 15) * 8) = pw[i]; }
            if (!samp) {
                const int t0 = r0 & 2047;
#pragma unroll
                for (int i = 0; i < 9; ++i) { const int e = tid + i * 512, er = e >> 5, c = (e & 31) * 4; if (e < 143 * 32) *(LAS f32x4*)(LE + er * 128 + c) = cvt4(pe[i]); }
                __syncthreads();
                {
                    const int c = (tid & 31) * 4, tl0 = (tid >> 5) * 8;
                    f32x4 sum = (f32x4){0.f, 0.f, 0.f, 0.f};
#pragma unroll 4
                    for (int d = 0; d < w; ++d) sum += *(LAS const f32x4*)(LE + (tl0 + 15 - d) * 128 + c);
#pragma unroll
                    for (int k = 0; k < 8; ++k) {
                        const int tl = tl0 + k;
                        const f32x4 pt = *(LAS const f32x4*)(LE + (tl + 15) * 128 + c);
                        if (k > 0) sum += pt - *(LAS const f32x4*)(LE + (tl + 15 - w) * 128 + c);
                        const float cnt = fminf((float)w, (float)(t0 + tl + 1));
                        const f32x4 pooled = sum * (1.0f / cnt) - pt;
                        u32x2 u; u.x = cvt_pk_bf16(pooled[0], pooled[1]); u.y = cvt_pk_bf16(pooled[2], pooled[3]);
                        *(LAS u32x2*)(LA + tl * 136 + c) = u;
                    }
                }
            } else {
                const int sq = tid >> 5, c = (tid & 31) * 4, bb = (r0 - NTP) / 8 + sq;
                const float* hist = PIN(I_SPOOL) + ((size_t)pair * 128 + bb) * 15 * 512 + g * 128 + c;
                const bf16_t* cur = PO + (size_t)(r0 + sq * 8) * LDA + g * 128 + c;
                LAS bf16_t* out = LA + (sq * 8) * 136 + c;
                if (g == 0) pool_sample_run<2>(hist, cur, out); else if (g == 1) pool_sample_run<4>(hist, cur, out);
                else if (g == 2) pool_sample_run<8>(hist, cur, out); else pool_sample_run<16>(hist, cur, out);
            }
            if (ci + cstride < 544) MIX_LOAD_C(ci + cstride);
            __syncthreads();
            bf16x8 af[4];
#pragma unroll
            for (int ks = 0; ks < 4; ++ks) af[ks] = *(const LAS bf16x8*)(LA + (wid * 16 + fr) * 136 + ks * 32 + fq * 8);
#pragma unroll
            for (int nt = 0; nt < 8; ++nt) {
                f32x4 acc = (f32x4){0.f, 0.f, 0.f, 0.f};
#pragma unroll
                for (int ks = 0; ks < 4; ++ks) {
                    const bf16x8 bf = *(const LAS bf16x8*)(LW + (nt * 16 + fr) * 136 + ks * 32 + fq * 8);
                    acc = __builtin_amdgcn_mfma_f32_16x16x32_bf16(bf, af[ks], acc, 0, 0, 0);
                }
                const int d = g * 128 + nt * 16 + fq * 4;
                const f32x4 cz = cvt4(czr[nt]), ps = psr[nt];
                f32x4 o;
#pragma unroll
                for (int j = 0; j < 4; ++j) o[j] = acc[j] * ps[j] * siluf_(cz[j]);
                st_bf4(Ycat + (size_t)row * 1024 + d, o);
            }
            __syncthreads();
        }
#undef MIX_LOAD_C
    }
    const int gtid = cx.bid * 512 + tid, gthreads = cx.nblk * 512;
    for (int e = gtid; e < 136 * 15 * 128; e += gthreads) {
        const int c = (e & 127) * 4, q = e >> 7, sr = q / 15, k = q - sr * 15;
        if (sr < 8) *(f32x4*)(POUT + O_POOLP + (((size_t)pair * 8 + sr) * 15 + k) * 512 + c) = ld_bf4(PO + (size_t)(sr * 2048 + 2033 + k) * LDA + c);
        else { const int b = sr - 8;
            *(f32x4*)(POUT + O_POOLS + (((size_t)pair * 128 + b) * 15 + k) * 512 + c) = (k < 7) ? *(const f32x4*)(PIN(I_SPOOL) + (((size_t)pair * 128 + b) * 15 + 8 + k) * 512 + c) : ld_bf4(PO + (size_t)(NTP + b * 8 + (k - 7)) * LDA + c); }
    }
}

__device__ void phase_final(const Params& p, const Ctx cx) {
    const int gtid = cx.bid * 512 + cx.tid, gthreads = cx.nblk * 512;
    const float* ssq = (const float*)(PWS + WS_SSQ) + (size_t)4 * NTOK * 16;
    const bf16_t* Xb = (const bf16_t*)(PWS + WS_XB);
    constexpr int NIT = NTOK * 256, UB = 4;
    for (int e0 = gtid; e0 < NIT; e0 += gthreads * UB) {
        f32x4 x[UB]; float sq[UB]; bool ok[UB];
#pragma unroll
        for (int u = 0; u < UB; ++u) { const int e = e0 + u * gthreads; ok[u] = e < NIT; const int ee = ok[u] ? e : e0; const int row = ee >> 8, c = (ee & 255) * 4;
            x[u] = ld_bf4(Xb + (size_t)row * 1024 + c); sq[u] = ssq_sum(ssq + (size_t)row * 16); }
#pragma unroll
        for (int u = 0; u < UB; ++u) { const int e = e0 + u * gthreads; const int ee = ok[u] ? e : e0; const int row = ee >> 8, c = (ee & 255) * 4;
            const float rstd = rsqrtf(sq[u] * (1.0f / 1024.0f) + 1e-6f);
            if (ok[u]) *(f32x4*)(POUT + (size_t)row * 1024 + c) = x[u] * rstd * *(const f32x4*)(PIN(I_FNORMW) + c); }
    }
}

#define XB_TMO      128
#define XB_XCNT(j)  (256  + 64 * (j))
#define XB_XSUB(j)  (1280 + 64 * (j))
#define XB_XGEN(j)  (2304 + 64 * (j))
#define XB_TOP      3328
#define XB_TOPGEN   3392
#define XCD_BAR_WORDS 3456
#define XB_SPIN_CAP (1u << 18)
__device__ __forceinline__ unsigned xb_ld(unsigned* p)              { return __hip_atomic_load(p, __ATOMIC_RELAXED, __HIP_MEMORY_SCOPE_AGENT); }
__device__ __forceinline__ unsigned xb_add(unsigned* p, unsigned v) { return __hip_atomic_fetch_add(p, v, __ATOMIC_RELAXED, __HIP_MEMORY_SCOPE_AGENT); }
__device__ __forceinline__ unsigned xb_xcc_id() { return (unsigned)__builtin_amdgcn_s_getreg((3 << 11) | 20) & 0xFu; }
#define XB_SPIN(cond, bar) do { unsigned _sp = 0; while (cond) { __builtin_amdgcn_s_sleep(1); \
    if ((++_sp & 255u) == 0u) { if (xb_ld(&(bar)[XB_TMO])) break; if (_sp > XB_SPIN_CAP) { atomicAdd(&(bar)[XB_TMO], 1u); break; } } } } while (0)
struct XcdBarrier { unsigned* bar; unsigned x; volatile LAS unsigned* st; };
__device__ __forceinline__ XcdBarrier xcd_barrier_post(unsigned* bar, volatile LAS unsigned* st) {
    XcdBarrier b; b.bar = bar; b.x = xb_xcc_id(); b.st = st;
    if (threadIdx.x == 0) (void)xb_add(&bar[XB_XCNT(b.x)], 1u);
    return b;
}
__device__ __forceinline__ void xcd_barrier_complete(unsigned* bar, unsigned x, unsigned& nloc, unsigned& nx) {
    const unsigned G = gridDim.x * gridDim.y * gridDim.z;
    unsigned sum, cnt, mine, sp = 0u;
    for (;;) {
        sum = 0u; cnt = 0u; mine = 0u;
#pragma unroll
        for (unsigned j = 0; j < 16; ++j) { const unsigned c = xb_ld(&bar[XB_XCNT(j)]); sum += c; cnt += (c > 0u) ? 1u : 0u; mine = (j == x) ? c : mine; }
        if (sum == G) break;
        __builtin_amdgcn_s_sleep(1);
        if ((++sp & 255u) == 0u) { if (xb_ld(&bar[XB_TMO])) break; if (sp > XB_SPIN_CAP) { atomicAdd(&bar[XB_TMO], 1u); break; } }
    }
    nloc = mine > 0u ? mine : 1u; nx = cnt > 0u ? cnt : 1u;
}
__device__ __forceinline__ void xcd_barrier(const XcdBarrier& b) {
    asm volatile("s_waitcnt vmcnt(0)" ::: "memory");
    __syncthreads();
    if (threadIdx.x == 0) {
        unsigned* bar = b.bar;
        __builtin_amdgcn_s_waitcnt(0);
        unsigned nloc = b.st[0], nx = b.st[1];
        if (nloc == 0u) { xcd_barrier_complete(bar, b.x, nloc, nx); b.st[0] = nloc; b.st[1] = nx; }
        const unsigned old = xb_add(&bar[XB_XSUB(b.x)], 1u);
        const unsigned gen = old / nloc;
        if (old + 1u == (gen + 1u) * nloc) {
            __builtin_amdgcn_fence(__ATOMIC_RELEASE, "agent");
            asm volatile("s_waitcnt vmcnt(0)" ::: "memory");
            const unsigned og = xb_add(&bar[XB_TOP], 1u);
            const unsigned tg = og / nx;
            if (og + 1u == (tg + 1u) * nx) xb_add(&bar[XB_TOPGEN], 1u);
            else XB_SPIN(xb_ld(&bar[XB_TOPGEN]) == tg, bar);
            __builtin_amdgcn_fence(__ATOMIC_ACQUIRE, "agent");
            xb_add(&bar[XB_XGEN(b.x)], 1u);
            asm volatile("s_waitcnt vmcnt(0)" ::: "memory");
        } else {
            XB_SPIN(xb_ld(&bar[XB_XGEN(b.x)]) == gen, bar);
            __builtin_amdgcn_fence(__ATOMIC_ACQUIRE, "agent");
            asm volatile("s_waitcnt vmcnt(0)" ::: "memory");
        }
    }
    __syncthreads();
}

__device__ void run_gemm_proj(const Params& p, const Ctx cx, LAS unsigned char* lds, const bf16_t* Bt, int N, bf16_t* O, int ldc, int layer) {
    pg8::Gemm g{(const bf16_t*)(PWS + WS_XB), Bt, NTOK, N, 1024};
    pg8::StaticOrder S; S.init(NTOK, N, (int)cx.nblk, (int)cx.bid);
    const float* ssq = (const float*)(PWS + WS_SSQ) + (size_t)layer * NTOK * 16;
    LAS float* rl = (LAS float*)(lds + 131072);
    int pm0 = -1, pm1 = -1, pm2 = -1, pm3 = -1, np = 0;
    for (int i = 0; i < 64; ++i) {
        pg8::Unit u; if (!S.next(i, u)) break;
        if (u.pm == pm0 || u.pm == pm1 || u.pm == pm2 || u.pm == pm3) continue;
        if (np == 0) pm0 = u.pm; else if (np == 1) pm1 = u.pm; else if (np == 2) pm2 = u.pm; else pm3 = u.pm;
        ++np;
    }
    for (int r = cx.tid; r < np * 256; r += 512) {
        const int i = r >> 8, pm = i == 0 ? pm0 : (i == 1 ? pm1 : (i == 2 ? pm2 : pm3));
        rl[r] = rsqrtf(ssq_sum(ssq + (size_t)(pm * 256 + (r & 255)) * 16) * (1.0f / 1024.0f) + 1e-6f);
    }
    __syncthreads();
    EpiProj E{O, ldc, rl, pm0, pm1, pm2, pm3};
    pg8::gemm_phase<EpiProj>(cx, lds, g, S, E);
}
__device__ void run_gemm_res(const Params& p, const Ctx cx, LAS unsigned char* lds, const bf16_t* Bt, int layer) {
    const bf16_t* A = (const bf16_t*)(PWS + WS_YCAT);
    bf16_t* Xb = (bf16_t*)(PWS + WS_XB);
    float* ssqn = (float*)(PWS + WS_SSQ) + (size_t)(layer + 1) * NTOK * 16;
    pg8::Gemm g{A, Bt, NTOK, 1024, 1024};
    pg8::StaticOrder S; S.init(NTOK, 1024, (int)cx.nblk, (int)cx.bid);
    EpiRes E{layer == 0 ? PIN(I_XP) : nullptr, PIN(I_XS), Xb, ssqn};
    pg8::gemm_phase<EpiRes>(cx, lds, g, S, E);
}

constexpr int N_PHASES = 20;
#ifndef PHMASK
#define PHMASK 0xffff
#endif
#define PHON(n) ((PHMASK >> ((n) % 16)) & 1)
__global__ void __launch_bounds__(512, 2) fwd_kernel(Params p) {
    extern __shared__ __attribute__((aligned(16))) unsigned char lds_raw[];
    LAS unsigned char* lds = (LAS unsigned char*)lds_raw;
    volatile LAS unsigned* bar_st = (volatile LAS unsigned*)(lds + LDS_MAIN);
    if (threadIdx.x < 4) bar_st[threadIdx.x] = 0u;
    __syncthreads();
    const XcdBarrier gbar = xcd_barrier_post((unsigned*)((unsigned char*)p.ptr[30] + WS_BAR), bar_st);
    if (p.ph_hi < 0) cg::this_grid().sync();
#define GRID_SYNC() xcd_barrier(gbar)
#ifdef SYNCPROBE
    for (int i = 0; i < SYNCPROBE; ++i) GRID_SYNC();
#endif
#ifdef REPMASK
    for (int pc = p.ph_lo * 2; pc < p.ph_hi * 2; ++pc) {
        const int ph = pc >> 1;
        { const int s_ = (ph == 0) ? 9 : (ph == N_PHASES - 1) ? 31 : (ph - 1) % 9; if ((pc & 1) && !((REPMASK >> s_) & 1)) continue; }
        if (pc > p.ph_lo * 2) GRID_SYNC();
#else
    for (int ph = p.ph_lo; ph < p.ph_hi; ++ph) {
        if (ph > p.ph_lo) GRID_SYNC();
#endif
        Ctx cx; cx.tid = threadIdx.x; cx.bid = blockIdx.x; cx.nblk = gridDim.x;
        asm volatile("s_mov_b32 %0, 0" : "=s"(cx.z));
        asm volatile("" : "+v"(cx.tid)); asm volatile("" : "+s"(cx.bid)); asm volatile("" : "+s"(cx.nblk));
        const int pair = (ph - 1) / 9, s = (ph == 0) ? 100 : (ph == N_PHASES - 1 ? 101 : (ph - 1) % 9);
        if (s == 0 || s == 3 || s == 6) {
#if PHON(0)
            const bf16_t* WinE = (const bf16_t*)(PWS + WS_WINE) + (size_t)pair * 4352 * 1024;
            const bf16_t* Bt = s == 0 ? WinE + (size_t)2560 * 1024 : (s == 3 ? WinE : (const bf16_t*)(PWS + WS_WINO) + (size_t)pair * 2560 * 1024);
            const int N = s == 0 ? 1792 : 2560;
            run_gemm_proj(p, cx, lds, Bt, N, (bf16_t*)(PWS + WS_R1), N, 2 * pair + (s == 6 ? 1 : 0));
#endif
        } else if (s == 5 || s == 8) {
#if PHON(5)
            const bf16_t* Bt = (const bf16_t*)(PWS + (s == 5 ? WS_WOUTE : WS_WOUTO)) + (size_t)pair * 1024 * 1024;
            run_gemm_res(p, cx, lds, Bt, 2 * pair + (s == 8 ? 1 : 0));
#endif
        } else if (s == 1) {
#if PHON(1)
            phase_even_prep(p, cx, pair, lds);
#endif
        } else if (s == 2) {
#if PHON(2)
            phase_scan(p, cx, pair, lds);
#endif
        } else if (s == 4) {
#if PHON(4)
            phase_even_post(p, cx, pair);
#endif
        } else if (s == 7) {
#if PHON(7)
            phase_odd_mixer(p, cx, pair, lds);
#endif
        } else if (s == 100) {
#if PHON(10)
            phase_prepass(p, cx, lds);
#endif
        } else {
#if PHON(11)
            phase_final(p, cx);
#endif
        }
    }
}

extern "C" void kernel_launch(void* const* d_in, const int* in_sizes, int n_in, void* d_out, int out_size, void* d_ws, size_t ws_size, hipStream_t stream) {
    static int grid = 0;
    if (grid == 0) {
        if (n_in != 29 || ws_size < WS_END) { fprintf(stderr, "kernel_launch: unexpected n_in %d / ws_size %zu (need %zu)\n", n_in, ws_size, (size_t)WS_END); grid = -1; return; }
        int dev = 0, cus = 0, per_cu = 0;
        hipGetDevice(&dev);
        hipDeviceGetAttribute(&cus, hipDeviceAttributeMultiprocessorCount, dev);
        if (hipFuncSetAttribute((const void*)fwd_kernel, hipFuncAttributeMaxDynamicSharedMemorySize, LDS_BYTES) != hipSuccess) { fprintf(stderr, "kernel_launch: hipFuncSetAttribute failed\n"); grid = -1; return; }
        if (hipOccupancyMaxActiveBlocksPerMultiprocessor(&per_cu, (const void*)fwd_kernel, 512, LDS_BYTES) != hipSuccess || per_cu < 1) { fprintf(stderr, "kernel_launch: occupancy query gave %d\n", per_cu); per_cu = 1; }
        (void)hipGetLastError();
        grid = cus * per_cu;
        if (grid > 256) grid = 256;
    }
    if (grid < 0) return;
    Params p{};
    for (int i = 0; i < 29; ++i) p.ptr[i] = d_in[i];
    p.ptr[29] = d_out; p.ptr[30] = d_ws; p.ptr[31] = nullptr;
    (void)hipMemsetAsync((unsigned char*)d_ws + WS_BAR, 0, 16384, stream);
#if ONE_LAUNCH
    p.ph_lo = 0; p.ph_hi = N_PHASES;
    void* args[] = {&p};
    hipError_t e = hipLaunchCooperativeKernel((const void*)fwd_kernel, dim3(grid), dim3(512), args, LDS_BYTES, stream);
    if (e != hipSuccess) fprintf(stderr, "cooperative launch failed: %s (grid %d)\n", hipGetErrorString(e), grid);
#else
    for (int ph = 0; ph < N_PHASES; ++ph) {
        p.ph_lo = ph; p.ph_hi = ph + 1;
        hipLaunchKernelGGL(fwd_kernel, dim3(grid), dim3(512), LDS_BYTES, stream, p);
    }
#endif
}
```

```cpp
#include <hip/hip_runtime.h>
#include <hip/hip_cooperative_groups.h>
#include <cstdio>
namespace cg = cooperative_groups;

#ifndef ONE_LAUNCH
#define ONE_LAUNCH 1
#endif

#define LAS __attribute__((address_space(3)))
typedef unsigned short bf16_t;
typedef short bf16x8 __attribute__((ext_vector_type(8)));
typedef float f32x4 __attribute__((ext_vector_type(4)));
typedef unsigned u32x4 __attribute__((ext_vector_type(4)));
typedef unsigned u32x2 __attribute__((ext_vector_type(2)));

constexpr int NTOK = 17408, NTP = 16384;
constexpr int LDB = 1792;
constexpr int LDA = 2560;
constexpr size_t O_CONVP = 17825792, O_CONVS = 17842176, O_SHIFTP = 18104320, O_SHIFTS = 18130944, O_WKVP = 18556928, O_WKVS = 19081216,
                 O_POOLP = 27469824, O_POOLS = 27592704, O_CHUNKV = 29558784;
constexpr size_t WS_WINE = 0;
constexpr size_t WS_WOUTE = WS_WINE + 2ull * 4352 * 1024 * 2;
constexpr size_t WS_WINO = WS_WOUTE + 2ull * 1024 * 1024 * 2;
constexpr size_t WS_WOUTO = WS_WINO + 2ull * 2560 * 1024 * 2;
constexpr size_t WS_W2T = WS_WOUTO + 2ull * 1024 * 1024 * 2;
constexpr size_t WS_A2T = WS_W2T + 2ull * 512 * 64 * 2;
constexpr size_t WS_POOLWT = WS_A2T + 2ull * 512 * 64 * 2;
constexpr size_t WS_SPW = WS_POOLWT + 8ull * 128 * 128 * 2;
constexpr size_t WS_XB = WS_SPW + 8ull * 128 * 128 * 2;
constexpr size_t WS_YCAT = WS_XB + (size_t)NTOK * 1024 * 2;
constexpr size_t WS_SSQ = WS_YCAT + (size_t)NTOK * 1024 * 2;
constexpr size_t WS_Y = WS_SSQ + 5ull * NTOK * 16 * 4;
constexpr size_t WS_R1 = WS_Y + (size_t)NTOK * 512 * 4;
constexpr size_t WS_PROJB = WS_R1;
constexpr size_t WS_WDEC = WS_PROJB + (size_t)NTOK * LDB * 2;
constexpr size_t WS_AA = WS_WDEC + (size_t)NTOK * 512 * 4;
constexpr size_t WS_BAR = WS_AA + (size_t)NTOK * 512 * 2;
constexpr size_t WS_END = WS_BAR + 16384;
constexpr int LDS_MAIN = 147456;
constexpr int LDS_BYTES = LDS_MAIN + 16;

struct Params {
    const void* ptr[32];
    int ph_lo, ph_hi;
};
struct Ctx { int tid, bid, nblk, z; };
#define PIN(i) ((const float*)p.ptr[(i) + cx.z])
#define POUT ((float*)p.ptr[29 + cx.z])
#define PWS ((unsigned char*)p.ptr[30 + cx.z])
enum { I_XP = 0, I_XS, I_SCONV, I_SSHIFT, I_SWKV, I_SPOOL, I_NORMW, I_FNORMW, I_WINE, I_CONVW, I_MU, I_W0, I_W2, I_A0, I_A2, I_KK, I_KA, I_RK, I_GNG, I_GNB,
       I_WOUTE, I_WINO, I_POOLW, I_PSCALE, I_LNG, I_LNB, I_SPW, I_SPB, I_WOUTO };

__device__ __forceinline__ unsigned cvt_pk_bf16(float lo, float hi) { unsigned r; asm("v_cvt_pk_bf16_f32 %0, %1, %2" : "=v"(r) : "v"(lo), "v"(hi)); return r; }
__device__ __forceinline__ float bf_lo(unsigned u) { return __uint_as_float(u << 16); }
__device__ __forceinline__ float bf_hi(unsigned u) { return __uint_as_float(u & 0xffff0000u); }
__device__ __forceinline__ float bf2f(bf16_t b) { return __uint_as_float(((unsigned)b) << 16); }
__device__ __forceinline__ f32x4 cvt4(u32x2 u) { return (f32x4){bf_lo(u.x), bf_hi(u.x), bf_lo(u.y), bf_hi(u.y)}; }
__device__ __forceinline__ f32x4 ld_bf4(const bf16_t* p) { return cvt4(*(const u32x2*)p); }
__device__ __forceinline__ void st_bf4(bf16_t* p, f32x4 v) { u32x2 u; u.x = cvt_pk_bf16(v[0], v[1]); u.y = cvt_pk_bf16(v[2], v[3]); *(u32x2*)p = u; }
__device__ __forceinline__ float sigmoidf_(float x) { return 1.0f / (1.0f + __expf(-x)); }
__device__ __forceinline__ float siluf_(float x) { return x / (1.0f + __expf(-x)); }
template <int CTRL> __device__ __forceinline__ float dpp_f(float x) { return __builtin_bit_cast(float, __builtin_amdgcn_mov_dpp(__builtin_bit_cast(int, x), CTRL, 0xf, 0xf, true)); }
__device__ __forceinline__ float allsum16(float x) { x += dpp_f<0xB1>(x); x += dpp_f<0x4E>(x); x += dpp_f<0x141>(x); x += dpp_f<0x128>(x); return x; }
__device__ __forceinline__ float allsum4(float x) { x += dpp_f<0xB1>(x); x += dpp_f<0x4E>(x); return x; }
__device__ __forceinline__ float dot4(f32x4 a, f32x4 b) { return a[0] * b[0] + a[1] * b[1] + a[2] * b[2] + a[3] * b[3]; }

__device__ __forceinline__ float ssq_sum(const float* part) {
    const f32x4 a = *(const f32x4*)(part), b = *(const f32x4*)(part + 4), c = *(const f32x4*)(part + 8), d = *(const f32x4*)(part + 12);
    return ((a[0] + a[1]) + (a[2] + a[3])) + ((b[0] + b[1]) + (b[2] + b[3])) + ((c[0] + c[1]) + (c[2] + c[3])) + ((d[0] + d[1]) + (d[2] + d[3]));
}

namespace pg8 {
constexpr int BM = 256, BK = 64, HALF = 128, HTB = HALF * BK * 2, NXCD = 8, WGM = 8;
__device__ __forceinline__ int lds_byte(int r, int c) { const int st = (r >> 4) * 2 + (c >> 5), rr = r & 15, cc = c & 31, ob = rr * 64 + cc * 2; return st * 1024 + (ob ^ (((ob >> 9) & 1) << 5)); }
__device__ __forceinline__ void stage_rc(int b, int& R, int& C) { const int st = b / 1024, sb = b % 1024, swz = sb ^ (((sb >> 9) & 1) << 5); R = (st >> 1) * 16 + swz / 64; C = (st & 1) * 32 + (swz % 64) / 2; }
__device__ __forceinline__ int perm32(int rho) { const int n = rho >> 4, i = rho & 15; return 8 * (i >> 2) + 4 * n + (i & 3); }
struct Unit { int pm, pn; };
struct Gemm { const bf16_t* A; const bf16_t* Bt; int M, N, K; };
struct StaticOrder {
    int nM, nN, nwg, G, c;
    __device__ void init(int M, int N, int G_, int c_) { nM = M / BM; nN = N / BM; nwg = nM * nN; G = G_; c = c_; }
    __device__ bool next(int i, Unit& u) const {
        const long L = (long)i * G + c; if (L >= nwg) return false;
        int wgid = (int)L; { const int q = nwg / NXCD, r = nwg % NXCD, xcd = wgid % NXCD, off = wgid / NXCD; wgid = (xcd < r ? xcd * (q + 1) : r * (q + 1) + (xcd - r) * q) + off; }
        const int nig = WGM * nN, gid = wgid / nig, fm = gid * WGM, gsz = (nM - fm) < WGM ? (nM - fm) : WGM;
        u.pm = fm + ((wgid % nig) % gsz); u.pn = (wgid % nig) / gsz; return true;
    }
};

template <class Epi>
__device__ __forceinline__ void gemm_phase(const Ctx cx, LAS unsigned char* lds, const Gemm g, const StaticOrder& S, const Epi& E) {
    const int tid = cx.tid, wid = __builtin_amdgcn_readfirstlane(tid >> 6), lane = tid & 63, wr = wid >> 2, wc = wid & 3, fr = lane & 15, fq = lane >> 4;
    const int K = g.K, nt = K / BK;
    unsigned voffA[2], voffB[2];
#pragma unroll
    for (int i = 0; i < 2; ++i) { int R, C; stage_rc(tid * 16 + i * 8192, R, C); const int Rb = Epi::PERM ? ((R & ~31) + perm32(R & 31)) : R;
        voffA[i] = (unsigned)(R * K + C) * 2u; voffB[i] = (unsigned)(Rb * K + C) * 2u; }
    const size_t kstep = (size_t)(BK * 2);
    const size_t hstep = (size_t)HALF * K * 2;
    const size_t tstep = 2 * hstep;
    const unsigned ldsw = (unsigned)wid * 1024u;
    const int aoff = lds_byte(wr * 64 + fr, fq * 8), boff = lds_byte(wc * 32 + fr, fq * 8);
#define PG8_SA(b, h) (((b) * 2 + (h)) * HTB)
#define PG8_SB(b, h) ((4 + (b) * 2 + (h)) * HTB)
#define PG8_STAGE(bufoff, gbase, voff) do { _Pragma("unroll") for (int _i = 0; _i < 2; ++_i) \
        __builtin_amdgcn_global_load_lds((const unsigned*)((const char*)(gbase) + (voff)[_i]), (LAS unsigned*)(lds + (bufoff) + ldsw + _i * 8192), 16, 0, 0); } while (0)
#define PG8_LDA(dst, b, h) do { _Pragma("unroll") for (int m = 0; m < 4; ++m) _Pragma("unroll") for (int k = 0; k < 2; ++k) dst[m][k] = *(const LAS bf16x8*)(lds + PG8_SA(b, h) + aoff + m * 2048 + k * 1024); } while (0)
#define PG8_LDB(dst, b, h) do { _Pragma("unroll") for (int n = 0; n < 2; ++n) _Pragma("unroll") for (int k = 0; k < 2; ++k) dst[n][k] = *(const LAS bf16x8*)(lds + PG8_SB(b, h) + boff + n * 2048 + k * 1024); } while (0)
#define PG8_MMA(ai, bj, At, Bt) do { __builtin_amdgcn_s_setprio(1); _Pragma("unroll") for (int m = 0; m < 4; ++m) _Pragma("unroll") for (int n = 0; n < 2; ++n) _Pragma("unroll") for (int k = 0; k < 2; ++k) \
        acc[ai][bj][m][n] = __builtin_amdgcn_mfma_f32_16x16x32_bf16(Bt[n][k], At[m][k], acc[ai][bj][m][n], 0, 0, 0); __builtin_amdgcn_s_setprio(0); } while (0)
#define PG8_WAIT_V(n) asm volatile("s_waitcnt vmcnt(" #n ")" ::: "memory")
#define PG8_WAIT_L(n) asm volatile("s_waitcnt lgkmcnt(" #n ")" ::: "memory")
#define PG8_BAR __builtin_amdgcn_s_barrier()
#define PG8_SCHED __builtin_amdgcn_sched_barrier(0)
    Unit cur, nxt; int ui = 0;
    if (!S.next(0, cur)) return;
    f32x4 acc[2][2][4][2];
#pragma unroll
    for (int a = 0; a < 2; ++a)
#pragma unroll
        for (int b = 0; b < 2; ++b)
#pragma unroll
            for (int m = 0; m < 4; ++m)
#pragma unroll
                for (int n = 0; n < 2; ++n) acc[a][b][m][n] = (f32x4){0.f, 0.f, 0.f, 0.f};
    bf16x8 At[4][2], B0[2][2], B1[2][2];
    const char* cA = (const char*)g.A + (size_t)cur.pm * tstep; const char* cB = (const char*)g.Bt + (size_t)cur.pn * tstep;
    PG8_STAGE(PG8_SB(0, 0), cB, voffB); PG8_STAGE(PG8_SA(0, 0), cA, voffA); PG8_STAGE(PG8_SB(0, 1), cB + hstep, voffB); PG8_STAGE(PG8_SA(0, 1), cA + hstep, voffA);
    if (wr == 1) PG8_BAR;
    PG8_WAIT_V(4); PG8_BAR;
    PG8_STAGE(PG8_SB(1, 0), cB + kstep, voffB); PG8_STAGE(PG8_SA(1, 0), cA + kstep, voffA); PG8_STAGE(PG8_SB(1, 1), cB + hstep + kstep, voffB);
    PG8_WAIT_V(6); PG8_BAR;
    for (;;) {
        const bool has_next = S.next(ui + 1, nxt);
        const char* nA = has_next ? (const char*)g.A + (size_t)nxt.pm * tstep : cA; const char* nB = has_next ? (const char*)g.Bt + (size_t)nxt.pn * tstep : cB;
        for (int t = 0; t < nt; t += 2) {
            const bool last = (t == nt - 2);
            const char* a1 = cA + (size_t)(t + 1) * kstep;
            const char* a2 = last ? nA : cA + (size_t)(t + 2) * kstep; const char* b2 = last ? nB : cB + (size_t)(t + 2) * kstep;
            const char* a3 = a2 + kstep; const char* b3 = b2 + kstep;
            PG8_LDB(B0, 0, 0); PG8_SCHED; PG8_LDA(At, 0, 0); PG8_STAGE(PG8_SA(1, 1), a1 + hstep, voffA);
            PG8_WAIT_L(8); PG8_BAR; PG8_WAIT_L(0); PG8_MMA(0, 0, At, B0); PG8_BAR; PG8_SCHED;
            PG8_LDB(B1, 0, 1); PG8_STAGE(PG8_SB(0, 0), b2, voffB);
            PG8_BAR; PG8_WAIT_L(0); PG8_MMA(0, 1, At, B1); PG8_BAR;
            PG8_LDA(At, 0, 1); PG8_STAGE(PG8_SA(0, 0), a2, voffA);
            PG8_BAR; PG8_WAIT_L(0); PG8_MMA(1, 0, At, B0); PG8_BAR; PG8_SCHED;
            PG8_STAGE(PG8_SB(0, 1), b2 + hstep, voffB);
            PG8_WAIT_V(6); PG8_BAR; PG8_MMA(1, 1, At, B1); PG8_BAR;
            PG8_LDB(B0, 1, 0); PG8_SCHED; PG8_LDA(At, 1, 0); PG8_STAGE(PG8_SA(0, 1), a2 + hstep, voffA);
            PG8_WAIT_L(8); PG8_BAR; PG8_WAIT_L(0); PG8_MMA(0, 0, At, B0); PG8_BAR; PG8_SCHED;
            PG8_LDB(B1, 1, 1); PG8_STAGE(PG8_SB(1, 0), b3, voffB);
            PG8_BAR; PG8_WAIT_L(0); PG8_MMA(0, 1, At, B1); PG8_BAR;
            PG8_LDA(At, 1, 1); PG8_STAGE(PG8_SA(1, 0), a3, voffA);
            PG8_BAR; PG8_WAIT_L(0); PG8_MMA(1, 0, At, B0); PG8_BAR; PG8_SCHED;
            PG8_STAGE(PG8_SB(1, 1), b3 + hstep, voffB);
            PG8_WAIT_V(6); PG8_BAR; PG8_MMA(1, 1, At, B1); PG8_BAR;
        }
        E(acc, cur, wr, wc, fr, fq);
        if (!has_next) break;
#pragma unroll
        for (int a = 0; a < 2; ++a)
#pragma unroll
            for (int b = 0; b < 2; ++b)
#pragma unroll
                for (int m = 0; m < 4; ++m)
#pragma unroll
                    for (int n = 0; n < 2; ++n) acc[a][b][m][n] = (f32x4){0.f, 0.f, 0.f, 0.f};
        cur = nxt; cA = nA; cB = nB; ++ui;
    }
    PG8_WAIT_V(0);
    if (wr == 0) PG8_BAR;
    PG8_BAR;
#undef PG8_SA
#undef PG8_SB
#undef PG8_STAGE
#undef PG8_LDA
#undef PG8_LDB
#undef PG8_MMA
#undef PG8_WAIT_V
#undef PG8_WAIT_L
#undef PG8_BAR
#undef PG8_SCHED
}
}

struct EpiProj {
    static constexpr bool PERM = true;
    bf16_t* O; int ldc; LAS const float* rl; int pm0, pm1, pm2, pm3;
    __device__ __forceinline__ void operator()(const f32x4 (&acc)[2][2][4][2], const pg8::Unit& u, int wr, int wc, int fr, int fq) const {
        const int row0 = u.pm * 256 + wr * 64 + fr, col0 = u.pn * 256 + wc * 32 + 8 * fq;
        const int sel = u.pm == pm0 ? 0 : (u.pm == pm1 ? 1 : (u.pm == pm2 ? 2 : 3));
        LAS const float* rp = rl + sel * 256 + wr * 64 + fr;
#pragma unroll
        for (int ai = 0; ai < 2; ++ai)
#pragma unroll
            for (int m = 0; m < 4; ++m) {
                const int row = row0 + ai * 128 + m * 16;
                const float rstd = rp[ai * 128 + m * 16];
                bf16_t* rowp = O + (size_t)row * ldc + col0;
#pragma unroll
                for (int bj = 0; bj < 2; ++bj) {
                    const f32x4 v0 = acc[ai][bj][m][0] * rstd, v1 = acc[ai][bj][m][1] * rstd;
                    u32x4 w; w.x = cvt_pk_bf16(v0[0], v0[1]); w.y = cvt_pk_bf16(v0[2], v0[3]); w.z = cvt_pk_bf16(v1[0], v1[1]); w.w = cvt_pk_bf16(v1[2], v1[3]);
                    *(u32x4*)(rowp + bj * 128) = w;
                }
            }
    }
};
struct X8 { f32x4 lo, hi; };
template <bool FIRST> __device__ __forceinline__ X8 ld_x8(const float* __restrict__ s32, const bf16_t* __restrict__ s16, size_t o) {
    X8 r;
    if (FIRST) { r.lo = *(const f32x4*)(s32 + o); r.hi = *(const f32x4*)(s32 + o + 4); }
    else { const u32x4 u = *(const u32x4*)(s16 + o); r.lo = cvt4((u32x2){u.x, u.y}); r.hi = cvt4((u32x2){u.z, u.w}); }
    return r;
}
__device__ __forceinline__ void st_x8(bf16_t* p, f32x4 lo, f32x4 hi) { u32x4 w; w.x = cvt_pk_bf16(lo[0], lo[1]); w.y = cvt_pk_bf16(lo[2], lo[3]); w.z = cvt_pk_bf16(hi[0], hi[1]); w.w = cvt_pk_bf16(hi[2], hi[3]); *(u32x4*)p = w; }
template <bool FIRST>
__device__ __forceinline__ void epi_res_rows(const f32x4 (&acc)[2][2][4][2], const float* __restrict__ src32, const bf16_t* __restrict__ src16, bf16_t* __restrict__ Xb, float* __restrict__ ssqp,
                                             int row0, int col0, int slot, int fq) {
    if constexpr (FIRST) {
#pragma unroll
        for (int ai = 0; ai < 2; ++ai) {
            X8 x[4][2];
#pragma unroll
            for (int m = 0; m < 4; ++m)
#pragma unroll
                for (int bj = 0; bj < 2; ++bj) x[m][bj] = ld_x8<true>(src32, src16, (size_t)(row0 + ai * 128 + m * 16) * 1024 + col0 + bj * 128);
#pragma unroll
            for (int m = 0; m < 4; ++m) {
                const int row = row0 + ai * 128 + m * 16;
                float part = 0.f;
#pragma unroll
                for (int bj = 0; bj < 2; ++bj) {
                    const f32x4 lo = x[m][bj].lo + acc[ai][bj][m][0], hi = x[m][bj].hi + acc[ai][bj][m][1];
                    st_x8(Xb + (size_t)row * 1024 + col0 + bj * 128, lo, hi);
                    part += dot4(lo, lo) + dot4(hi, hi);
                }
                part += __shfl_xor(part, 16); part += __shfl_xor(part, 32);
                if (fq == 0) ssqp[(size_t)row * 16 + slot] = part;
            }
        }
    } else {
        u32x4 xr[2][4][2];
#pragma unroll
        for (int ai = 0; ai < 2; ++ai)
#pragma unroll
            for (int m = 0; m < 4; ++m)
#pragma unroll
                for (int bj = 0; bj < 2; ++bj) xr[ai][m][bj] = *(const u32x4*)(src16 + (size_t)(row0 + ai * 128 + m * 16) * 1024 + col0 + bj * 128);
#pragma unroll
        for (int ai = 0; ai < 2; ++ai)
#pragma unroll
            for (int m = 0; m < 4; ++m) {
                const int row = row0 + ai * 128 + m * 16;
                float part = 0.f;
#pragma unroll
                for (int bj = 0; bj < 2; ++bj) {
                    const u32x4 u = xr[ai][m][bj];
                    const f32x4 lo = cvt4((u32x2){u.x, u.y}) + acc[ai][bj][m][0], hi = cvt4((u32x2){u.z, u.w}) + acc[ai][bj][m][1];
                    st_x8(Xb + (size_t)row * 1024 + col0 + bj * 128, lo, hi);
                    part += dot4(lo, lo) + dot4(hi, hi);
                }
                part += __shfl_xor(part, 16); part += __shfl_xor(part, 32);
                if (fq == 0) ssqp[(size_t)row * 16 + slot] = part;
            }
    }
}
struct EpiRes {
    static constexpr bool PERM = true;
    const float* xp; const float* xs; bf16_t* Xb; float* ssq_next;
    __device__ __forceinline__ void operator()(const f32x4 (&acc)[2][2][4][2], const pg8::Unit& u, int wr, int wc, int fr, int fq) const {
        const int row0 = u.pm * 256 + wr * 64 + fr, col0 = u.pn * 256 + wc * 32 + 8 * fq;
        if (xp) epi_res_rows<true>(acc, row0 < NTP ? xp : xs - (size_t)NTP * 1024, nullptr, Xb, ssq_next, row0, col0, u.pn * 4 + wc, fq);
        else epi_res_rows<false>(acc, nullptr, Xb, Xb, ssq_next, row0, col0, u.pn * 4 + wc, fq);
    }
};

template <bool FIRST>
__device__ __forceinline__ void res_sample_tile(const Ctx cx, const bf16_t* __restrict__ A, const bf16_t* __restrict__ Bt, const float* __restrict__ xs, bf16_t* __restrict__ Xb, float* __restrict__ ssqp, int tile) {
    const int tid = cx.tid, wid = tid >> 6, lane = tid & 63, fr = lane & 15, fq = lane >> 4;
    const int tm = tile >> 3, tn = tile & 7;
    const int r0 = NTP + tm * 64 + (wid & 3) * 16, c0 = tn * 128 + (wid >> 2) * 64;
    const bf16_t* ap = A + (size_t)(r0 + fr) * 1024 + fq * 8;
    const bf16_t* bp = Bt + (size_t)(c0 + fr) * 1024 + fq * 8;
    f32x4 acc[4];
#pragma unroll
    for (int nt = 0; nt < 4; ++nt) acc[nt] = (f32x4){0.f, 0.f, 0.f, 0.f};
#pragma unroll 8
    for (int ks = 0; ks < 32; ++ks) {
        const bf16x8 af = *(const bf16x8*)(ap + ks * 32);
#pragma unroll
        for (int nt = 0; nt < 4; ++nt) {
            const bf16x8 bf = *(const bf16x8*)(bp + (size_t)nt * 16 * 1024 + ks * 32);
            acc[nt] = __builtin_amdgcn_mfma_f32_16x16x32_bf16(bf, af, acc[nt], 0, 0, 0);
        }
    }
    const int row = r0 + fr;
    float part = 0.f;
#pragma unroll
    for (int nt = 0; nt < 4; ++nt) {
        const int col = c0 + nt * 16 + fq * 4;
        const f32x4 xo = FIRST ? *(const f32x4*)(xs + (size_t)(row - NTP) * 1024 + col) : ld_bf4(Xb + (size_t)row * 1024 + col);
        const f32x4 v = xo + acc[nt];
        st_bf4(Xb + (size_t)row * 1024 + col, v);
        part += dot4(v, v);
    }
    part += __shfl_xor(part, 16); part += __shfl_xor(part, 32);
    if (fq == 0) ssqp[(size_t)row * 16 + (c0 >> 6)] = part;
}

struct TrJob { const float* src; int ld, col0, k0; bf16_t* dst; int Ktot, drow0; const float* scale; bool zero; };
__device__ __forceinline__ TrJob tr_decode(const Params& p, const Ctx cx, int job) {
    TrJob J; J.zero = false; J.scale = nullptr;
    int j = job;
    if (j < 2176) {
        const int i = j / 1088, r = j % 1088, nt = r / 16, kt = r % 16, n0 = nt * 64;
        int col0 = 0;
        if (n0 < 2048) col0 = n0; else if (n0 < 2560) col0 = 3712 + (n0 - 2048); else if (n0 < 4224) col0 = 2048 + (n0 - 2560); else J.zero = true;
        J.src = PIN(I_WINE) + (size_t)i * 1024 * 4224; J.ld = 4224; J.col0 = col0; J.k0 = kt * 64; J.dst = (bf16_t*)(PWS + WS_WINE) + (size_t)i * 4352 * 1024; J.Ktot = 1024; J.drow0 = n0; J.scale = PIN(I_NORMW) + (2 * i) * 1024;
        return J;
    }
    j -= 2176;
    if (j < 512) { const int i = j / 256, r = j % 256, nt = r / 16, kt = r % 16;
        J.src = PIN(I_WOUTE) + (size_t)i * 1024 * 1024; J.ld = 1024; J.col0 = nt * 64; J.k0 = kt * 64; J.dst = (bf16_t*)(PWS + WS_WOUTE) + (size_t)i * 1024 * 1024; J.Ktot = 1024; J.drow0 = nt * 64; return J; }
    j -= 512;
    if (j < 1280) { const int i = j / 640, r = j % 640, nt = r / 16, kt = r % 16;
        J.src = PIN(I_WINO) + (size_t)i * 1024 * 2560; J.ld = 2560; J.col0 = nt * 64; J.k0 = kt * 64; J.dst = (bf16_t*)(PWS + WS_WINO) + (size_t)i * 2560 * 1024; J.Ktot = 1024; J.drow0 = nt * 64; J.scale = PIN(I_NORMW) + (2 * i + 1) * 1024; return J; }
    j -= 1280;
    if (j < 512) { const int i = j / 256, r = j % 256, nt = r / 16, kt = r % 16;
        J.src = PIN(I_WOUTO) + (size_t)i * 1024 * 1024; J.ld = 1024; J.col0 = nt * 64; J.k0 = kt * 64; J.dst = (bf16_t*)(PWS + WS_WOUTO) + (size_t)i * 1024 * 1024; J.Ktot = 1024; J.drow0 = nt * 64; return J; }
    j -= 512;
    if (j < 16) { const int i = j / 8, nt = j % 8;
        J.src = PIN(I_W2) + (size_t)i * 64 * 512; J.ld = 512; J.col0 = nt * 64; J.k0 = 0; J.dst = (bf16_t*)(PWS + WS_W2T) + (size_t)i * 512 * 64; J.Ktot = 64; J.drow0 = nt * 64; return J; }
    j -= 16;
    if (j < 16) { const int i = j / 8, nt = j % 8;
        J.src = PIN(I_A2) + (size_t)i * 64 * 512; J.ld = 512; J.col0 = nt * 64; J.k0 = 0; J.dst = (bf16_t*)(PWS + WS_A2T) + (size_t)i * 512 * 64; J.Ktot = 64; J.drow0 = nt * 64; return J; }
    j -= 16;
    { const int ig = j / 4, r = j % 4, nt = r / 2, kt = r % 2;
        J.src = PIN(I_POOLW) + (size_t)ig * 128 * 128; J.ld = 128; J.col0 = nt * 64; J.k0 = kt * 64; J.dst = (bf16_t*)(PWS + WS_POOLWT) + (size_t)ig * 128 * 128; J.Ktot = 128; J.drow0 = nt * 64; }
    return J;
}
__device__ __forceinline__ void tr_load(const TrJob& J, int tid, f32x4& va, f32x4& vb) {
    const int nn = (tid & 15) * 4, ka = tid >> 4, kb = ka + 32;
    va = (f32x4){0.f, 0.f, 0.f, 0.f}; vb = va;
    if (!J.zero) {
        va = *(const f32x4*)(J.src + (size_t)(J.k0 + ka) * J.ld + J.col0 + nn); vb = *(const f32x4*)(J.src + (size_t)(J.k0 + kb) * J.ld + J.col0 + nn);
        if (J.scale) { va = va * J.scale[J.k0 + ka]; vb = vb * J.scale[J.k0 + kb]; }
    }
}

__device__ void phase_prepass(const Params& p, const Ctx cx, LAS unsigned char* lds) {
    LAS float* T = (LAS float*)lds;
    const int tid = cx.tid;
    {
        int job = cx.bid;
        f32x4 va = (f32x4){0.f, 0.f, 0.f, 0.f}, vb = va;
        if (job < 4544) { const TrJob J0 = tr_decode(p, cx, job); tr_load(J0, tid, va, vb); }
        for (; job < 4544; job += cx.nblk) {
            f32x4 na = va, nb = vb;
            if (job + (int)cx.nblk < 4544) { const TrJob Jn = tr_decode(p, cx, job + (int)cx.nblk); tr_load(Jn, tid, na, nb); }
            {
                const int nn = (tid & 15) * 4, ka = tid >> 4, kb = ka + 32;
                T[ka * 65 + nn] = va[0]; T[ka * 65 + nn + 1] = va[1]; T[ka * 65 + nn + 2] = va[2]; T[ka * 65 + nn + 3] = va[3];
                T[kb * 65 + nn] = vb[0]; T[kb * 65 + nn + 1] = vb[1]; T[kb * 65 + nn + 2] = vb[2]; T[kb * 65 + nn + 3] = vb[3];
            }
            __syncthreads();
            {
                const TrJob J = tr_decode(p, cx, job);
                const int n = tid >> 3, kc = (tid & 7) * 8;
                u32x4 w;
                w.x = cvt_pk_bf16(T[(kc + 0) * 65 + n], T[(kc + 1) * 65 + n]); w.y = cvt_pk_bf16(T[(kc + 2) * 65 + n], T[(kc + 3) * 65 + n]);
                w.z = cvt_pk_bf16(T[(kc + 4) * 65 + n], T[(kc + 5) * 65 + n]); w.w = cvt_pk_bf16(T[(kc + 6) * 65 + n], T[(kc + 7) * 65 + n]);
                *(u32x4*)(J.dst + (size_t)(J.drow0 + n) * J.Ktot + J.k0 + kc) = w;
            }
            __syncthreads();
            va = na; vb = nb;
        }
    }
    const int gtid = cx.bid * 512 + tid, gthreads = cx.nblk * 512;
    for (int e = gtid; e < 8 * 128 * 128; e += gthreads) {
        const int s = e & 127, t = (e >> 7) & 127;
        ((bf16_t*)(PWS + WS_SPW))[e] = (s <= t) ? (bf16_t)(cvt_pk_bf16(PIN(I_SPW)[e], 0.f) & 0xffffu) : (bf16_t)0;
    }
    const int wid = tid >> 6, lane = tid & 63;
    for (int row0 = cx.bid * 8 + wid; row0 < NTOK; row0 += cx.nblk * 8 * 3) {
        f32x4 v[3][4];
#pragma unroll
        for (int r = 0; r < 3; ++r) {
            const int row = row0 + r * cx.nblk * 8; const int rr = row < NTOK ? row : row0;
            const float* src = rr < NTP ? PIN(I_XP) + (size_t)rr * 1024 : PIN(I_XS) + (size_t)(rr - NTP) * 1024;
#pragma unroll
            for (int i = 0; i < 4; ++i) v[r][i] = *(const f32x4*)(src + i * 256 + lane * 4);
        }
#pragma unroll
        for (int r = 0; r < 3; ++r) {
            const int row = row0 + r * cx.nblk * 8;
            if (row < NTOK) {
                bf16_t* dst = (bf16_t*)(PWS + WS_XB) + (size_t)row * 1024;
                float ss = 0.f;
#pragma unroll
                for (int i = 0; i < 4; ++i) { ss += dot4(v[r][i], v[r][i]); st_bf4(dst + i * 256 + lane * 4, v[r][i]); }
#pragma unroll
                for (int o = 32; o >= 1; o >>= 1) ss += __shfl_xor(ss, o);
                if (lane < 16) ((float*)(PWS + WS_SSQ))[(size_t)row * 16 + lane] = (lane == 0) ? ss : 0.f;
            }
        }
    }
}

__device__ __forceinline__ f32x4 shift4(const bf16_t* cur, bool hp, const float* st, int col, const float* mu) {
    const f32x4 q = ld_bf4(cur + col);
    f32x4 pv;
    if (hp) pv = ld_bf4(cur - LDB + col); else if (st) pv = *(const f32x4*)(st + col); else pv = (f32x4){0.f, 0.f, 0.f, 0.f};
    const f32x4 m = *(const f32x4*)(mu + col);
    return q + m * (pv - q);
}

__device__ void phase_even_prep(const Params& p, const Ctx cx, int pair, LAS unsigned char* lds) {
    const int tid = cx.tid, wid = tid >> 6, lane = tid & 63, fr = lane & 15, fq = lane >> 4;
    const bf16_t* PB = (const bf16_t*)(PWS + WS_PROJB);
    float* Wdec = (float*)(PWS + WS_WDEC);
    bf16_t* Aa = (bf16_t*)(PWS + WS_AA);
    bf16_t* Ycat = (bf16_t*)(PWS + WS_YCAT);
    const float* mu_ = PIN(I_MU) + pair * 1664;
    const float* w0_ = PIN(I_W0) + pair * 512; const float* a0_ = PIN(I_A0) + pair * 512;
    const float* k_a_ = PIN(I_KA) + pair * 512; const float* r_k_ = PIN(I_RK) + pair * 512;
    constexpr int RS = 3344;
    constexpr int TB = 17 * RS;
    constexpr int NCH = 17 * 208;
    const int h = wid;
    bf16x8 wfr[4][2], afr[4][2];
    {
        const bf16_t* W2T = (const bf16_t*)(PWS + WS_W2T) + (size_t)pair * 512 * 64;
        const bf16_t* A2T = (const bf16_t*)(PWS + WS_A2T) + (size_t)pair * 512 * 64;
#pragma unroll
        for (int nt = 0; nt < 4; ++nt)
#pragma unroll
            for (int ks = 0; ks < 2; ++ks) {
                wfr[nt][ks] = *(const bf16x8*)(W2T + (size_t)(h * 64 + nt * 16 + fr) * 64 + ks * 32 + fq * 8);
                afr[nt][ks] = *(const bf16x8*)(A2T + (size_t)(h * 64 + nt * 16 + fr) * 64 + ks * 32 + fq * 8);
            }
    }
    constexpr int TBD = 56 * 1024;
    const int widu = __builtin_amdgcn_readfirstlane(tid >> 6);
#define PREP_DMA(tile_, b_, lane_) do { _Pragma("unroll") for (int i_ = 0; i_ < 7; ++i_) { const int k_ = widu * 7 + i_, q_ = k_ * 64 + (lane_); \
            int lr_ = q_ / 209, cc_ = q_ - lr_ * 209; if (lr_ > 16) { lr_ = 16; cc_ = 0; } if (cc_ > 207) cc_ = 0; \
            int gr_ = (tile_) * 16 - 1 + lr_; gr_ = gr_ < 0 ? 0 : gr_; \
            __builtin_amdgcn_global_load_lds((const unsigned*)(PB + (size_t)gr_ * LDB + cc_ * 8), (LAS unsigned*)(lds + (b_) * TBD + k_ * 1024), 16, 0, 0); } } while (0)
    int buf = 0;
    if ((int)cx.bid < NTOK / 16) PREP_DMA((int)cx.bid, 0, tid & 63);
    asm volatile("s_waitcnt vmcnt(0)" ::: "memory");
    __syncthreads();
    for (int tile = cx.bid; tile < NTOK / 16; tile += cx.nblk) {
        int zz; asm volatile("v_mov_b32 %0, 0" : "=v"(zz));
        const int tidv = tid + zz, fr = (tidv & 15), fq = (tidv >> 4) & 3;
        if (tile + (int)cx.nblk < NTOK / 16) PREP_DMA(tile + (int)cx.nblk, buf ^ 1, tidv & 63);
        {
            const int row = tile * 16 + fr;
            const bool samp = row >= NTP;
            int b, t; if (!samp) { b = row >> 11; t = row & 2047; } else { const int q = row - NTP; b = q >> 3; t = q & 7; }
            const bool hp = t > 0;
            const float* st = samp ? PIN(I_SSHIFT) + ((size_t)pair * 128 + b) * 1664 : nullptr;
            const float* mu = mu_ + zz; const float* w0 = w0_ + zz; const float* a0 = a0_ + zz; const float* k_a = k_a_ + zz; const float* r_k = r_k_ + zz;
            LAS const unsigned char* curL = lds + buf * TBD + (fr + 1) * RS;
            LAS const unsigned char* prvL = lds + buf * TBD + fr * RS;
            auto sh4 = [&](int col) -> f32x4 {
                const f32x4 q = cvt4(*(LAS const u32x2*)(curL + col * 2));
                f32x4 pv;
                if (hp) pv = cvt4(*(LAS const u32x2*)(prvL + col * 2)); else if (st) pv = *(const f32x4*)(st + col); else pv = (f32x4){0.f, 0.f, 0.f, 0.f};
                const f32x4 m = *(const f32x4*)(mu + col);
                return q + m * (pv - q);
            };
            bf16x8 Aw[2], Al[2];
#pragma unroll
            for (int ks = 0; ks < 2; ++ks) {
                const int cw = 1536 + ks * 32 + fq * 8, ca = 1600 + ks * 32 + fq * 8;
                const f32x4 w_lo = sh4(cw), w_hi = sh4(cw + 4), a_lo = sh4(ca), a_hi = sh4(ca + 4);
                u32x4 pw, pa;
                float th[8];
#pragma unroll
                for (int j = 0; j < 4; ++j) { th[j] = 2.0f * sigmoidf_(2.0f * w_lo[j]) - 1.0f; th[4 + j] = 2.0f * sigmoidf_(2.0f * w_hi[j]) - 1.0f; }
                pw.x = cvt_pk_bf16(th[0], th[1]); pw.y = cvt_pk_bf16(th[2], th[3]); pw.z = cvt_pk_bf16(th[4], th[5]); pw.w = cvt_pk_bf16(th[6], th[7]);
                pa.x = cvt_pk_bf16(a_lo[0], a_lo[1]); pa.y = cvt_pk_bf16(a_lo[2], a_lo[3]); pa.z = cvt_pk_bf16(a_hi[0], a_hi[1]); pa.w = cvt_pk_bf16(a_hi[2], a_hi[3]);
                Aw[ks] = __builtin_bit_cast(bf16x8, pw); Al[ks] = __builtin_bit_cast(bf16x8, pa);
            }
            float bon = 0.f;
#pragma unroll
            for (int nt = 0; nt < 4; ++nt) {
                f32x4 lw = (f32x4){0.f, 0.f, 0.f, 0.f}, la = (f32x4){0.f, 0.f, 0.f, 0.f};
#pragma unroll
                for (int ks = 0; ks < 2; ++ks) {
                    lw = __builtin_amdgcn_mfma_f32_16x16x32_bf16(wfr[nt][ks], Aw[ks], lw, 0, 0, 0);
                    la = __builtin_amdgcn_mfma_f32_16x16x32_bf16(afr[nt][ks], Al[ks], la, 0, 0, 0);
                }
                const int ch = h * 64 + nt * 16 + fq * 4;
                const f32x4 r4 = sh4(ch), k4 = sh4(512 + ch);
                const f32x4 w04 = *(const f32x4*)(w0 + ch), a04 = *(const f32x4*)(a0 + ch), ka4 = *(const f32x4*)(k_a + ch), rk4 = *(const f32x4*)(r_k + ch);
                f32x4 dec, av;
#pragma unroll
                for (int j = 0; j < 4; ++j) {
                    const float z_ = -(w04[j] + lw[j]);
                    const float wlog = -__logf(1.0f + __expf(z_)) - 0.5f;
                    dec[j] = __expf(-__expf(wlog));
                    av[j] = sigmoidf_(a04[j] + la[j]);
                    const float kp = k4[j] * (1.0f + (av[j] - 1.0f) * ka4[j]);
                    bon += r4[j] * kp * rk4[j];
                }
                *(f32x4*)(Wdec + (size_t)row * 512 + ch) = dec;
                st_bf4(Aa + (size_t)row * 512 + ch, av);
            }
            bon += __shfl_xor(bon, 16); bon += __shfl_xor(bon, 32);
#pragma unroll
            for (int nt = 0; nt < 4; ++nt) { const int ch = h * 64 + nt * 16 + fq * 4; st_bf4(Ycat + (size_t)row * 1024 + 512 + ch, sh4(1024 + ch) * bon); }
        }
        asm volatile("s_waitcnt vmcnt(0)" ::: "memory");
        __syncthreads();
        buf ^= 1;
    }
#undef PREP_DMA
    const int gtid = cx.bid * 512 + tid, gthreads = cx.nblk * 512;
    for (int e = gtid; e < 136 * 1664; e += gthreads) {
        const int sr = e / 1664, c = e % 1664;
        if (sr < 8) POUT[O_SHIFTP + ((size_t)pair * 8 + sr) * 1664 + c] = bf2f(PB[(size_t)(sr * 2048 + 2047) * LDB + c]);
        else { const int b = sr - 8; POUT[O_SHIFTS + ((size_t)pair * 128 + b) * 1664 + c] = bf2f(PB[(size_t)(NTP + b * 8 + 7) * LDB + c]); }
    }
}

typedef float f32x2 __attribute__((ext_vector_type(2)));
template <bool RED = true>
__device__ __forceinline__ void scan_step(f32x4& S, const f32x4 w, const f32x4 k, const f32x4 kk, const f32x4 nb, const f32x4 r, const float v, float& y) {
    const f32x2 S01 = {S[0], S[1]}, S23 = {S[2], S[3]};
    f32x2 pp = S01 * (f32x2){kk[0], kk[1]};
    pp = S23 * (f32x2){kk[2], kk[3]} + pp;
    float pd = pp[0] + pp[1];
    const f32x2 vv = {v, v};
    const f32x2 t01 = S01 * (f32x2){w[0], w[1]} + (f32x2){k[0], k[1]} * vv;
    const f32x2 t23 = S23 * (f32x2){w[2], w[3]} + (f32x2){k[2], k[3]} * vv;
    pd = allsum16(pd);
    const f32x2 pdv = {pd, pd};
    const f32x2 n01 = (f32x2){nb[0], nb[1]} * pdv + t01, n23 = (f32x2){nb[2], nb[3]} * pdv + t23;
    S = (f32x4){n01[0], n01[1], n23[0], n23[1]};
    f32x2 q = n01 * (f32x2){r[0], r[1]};
    q = n23 * (f32x2){r[2], r[3]} + q;
    y = RED ? allsum16(q[0] + q[1]) : (q[0] + q[1]);
}
__device__ __forceinline__ float reduce_scatter16(const float (&yp)[16], int cgi) {
    const bool b3 = cgi & 8, b2 = cgi & 4, b1 = cgi & 2, b0 = cgi & 1;
    float a[8], bq[4], c[2];
#pragma unroll
    for (int j = 0; j < 8; ++j) { const float keep = b3 ? yp[8 + j] : yp[j], send = b3 ? yp[j] : yp[8 + j]; a[j] = keep + dpp_f<0x128>(send); }
#pragma unroll
    for (int k = 0; k < 4; ++k) { const float keep = b2 ? a[4 + k] : a[k], send = b2 ? a[k] : a[4 + k]; bq[k] = keep + dpp_f<0x141>(send); }
#pragma unroll
    for (int m = 0; m < 2; ++m) { const float keep = b1 ? bq[2 + m] : bq[m], send = b1 ? bq[m] : bq[2 + m]; c[m] = keep + dpp_f<0x4E>(send); }
    const float keep = b0 ? c[1] : c[0], send = b0 ? c[0] : c[1];
    return keep + dpp_f<0xB1>(send);
}

__device__ void phase_scan(const Params& p, const Ctx cx, int pair, LAS unsigned char* lds) {
    const int tid = cx.tid, wid = tid >> 6, lane = tid & 63, rs = lane >> 4, cgi = lane & 15;
    const bf16_t* PB = (const bf16_t*)(PWS + WS_PROJB);
    const float* Wdec = (const float*)(PWS + WS_WDEC);
    const bf16_t* Aa = (const bf16_t*)(PWS + WS_AA);
    float* Y = (float*)(PWS + WS_Y);
    const float* mu = PIN(I_MU) + pair * 1664;
    const float* k_k = PIN(I_KK) + pair * 512; const float* k_a = PIN(I_KA) + pair * 512;
    {
        LAS float* vb = (LAS float*)lds + wid * 3072;
        for (int st = cx.bid * 8 + wid; st < 2048; st += cx.nblk * 8) {
            const int bh = st >> 1, half = st & 1, b = bh >> 3, h = bh & 7, ch = h * 64 + cgi * 4;
            const float* stp = PIN(I_SSHIFT) + ((size_t)pair * 128 + b) * 1664;
            const f32x4 kkc = *(const f32x4*)(k_k + ch), kac = *(const f32x4*)(k_a + ch);
            {
#pragma unroll
                for (int tt = 0; tt < 2; ++tt) {
                    const int t = rs + tt * 4;
                    const size_t row = NTP + b * 8 + t;
                    const bf16_t* cur = PB + row * LDB;
                    const f32x4 r = shift4(cur, t > 0, stp, ch, mu), k = shift4(cur, t > 0, stp, 512 + ch, mu), v = shift4(cur, t > 0, stp, 1024 + ch, mu);
                    const f32x4 a = ld_bf4(Aa + row * 512 + ch);
                    const f32x4 w = *(const f32x4*)(Wdec + row * 512 + ch);
                    const f32x4 kkv = k * kkc;
                    const float ss = allsum16(dot4(kkv, kkv));
                    const float inv = 1.0f / fmaxf(sqrtf(ss), 1e-12f);
                    const f32x4 kkn = kkv * inv;
                    LAS float* o = vb + t * 384 + cgi * 4;
                    *(LAS f32x4*)(o) = w; *(LAS f32x4*)(o + 64) = k * (1.0f + (a - 1.0f) * kac); *(LAS f32x4*)(o + 128) = kkn; *(LAS f32x4*)(o + 192) = -(kkn * a);
                    *(LAS f32x4*)(o + 256) = r; *(LAS f32x4*)(o + 320) = v;
                }
            }
            asm volatile("s_waitcnt lgkmcnt(0)" ::: "memory");
            __builtin_amdgcn_wave_barrier();
            const size_t so0 = ((((size_t)pair * 128 + b) * 8 + h) * 64 + half * 32 + rs) * 64 + cgi * 4;
            f32x4 Snext = *(const f32x4*)(PIN(I_SWKV) + so0);
#pragma unroll 1
            for (int rq = 0; rq < 8; ++rq) {
                const int ri = half * 32 + rq * 4 + rs;
                const size_t so = so0 + (size_t)rq * 256;
                f32x4 S = Snext;
                if (rq + 1 < 8) Snext = *(const f32x4*)(PIN(I_SWKV) + so + 256);
#pragma unroll
                for (int t = 0; t < 8; ++t) {
                    LAS const float* r0 = vb + t * 384 + cgi * 4;
                    float y; scan_step(S, *(LAS const f32x4*)(r0), *(LAS const f32x4*)(r0 + 64), *(LAS const f32x4*)(r0 + 128), *(LAS const f32x4*)(r0 + 192), *(LAS const f32x4*)(r0 + 256), vb[t * 384 + 320 + ri], y);
                    if (cgi == 0) Y[(size_t)(NTP + b * 8 + t) * 512 + h * 64 + ri] = y;
                }
                *(f32x4*)(POUT + O_WKVS + so) = S;
            }
            asm volatile("s_waitcnt lgkmcnt(0)" ::: "memory");
            __builtin_amdgcn_wave_barrier();
        }
    }
    __syncthreads();
    LAS float* rec = (LAS float*)lds;
    for (int pt = cx.bid; pt < 256; pt += cx.nblk) {
        const int xcd = pt & 7, slot = pt >> 3, bh = xcd * 8 + (slot >> 2), rg = slot & 3, b = bh >> 3, h = bh & 7;
        const int lt = tid - 256, ls = (lt >> 4) & 15, lcg = lt & 15, lch = h * 64 + lcg * 4;
        u32x2 qr = {0u, 0u}, qk = {0u, 0u}, qv = {0u, 0u}, pr = {0u, 0u}, pk = {0u, 0u}, pv = {0u, 0u}, qa = {0u, 0u};
        f32x4 qw = (f32x4){0.f, 0.f, 0.f, 0.f};
        f32x4 mur, muk, muv, kkc, kac;
        const int ri = rg * 16 + (wid & 3) * 4 + rs;
        f32x4 S = (f32x4){0.f, 0.f, 0.f, 0.f};
#define SCAN_ISSUE(c) do { const int t_ = (c) * 16 + ls; const size_t row_ = (size_t)b * 2048 + t_; const bf16_t* cur_ = PB + row_ * LDB; \
            qr = *(const u32x2*)(cur_ + lch); qk = *(const u32x2*)(cur_ + 512 + lch); qv = *(const u32x2*)(cur_ + 1024 + lch); \
            if (t_ > 0) { pr = *(const u32x2*)(cur_ - LDB + lch); pk = *(const u32x2*)(cur_ - LDB + 512 + lch); pv = *(const u32x2*)(cur_ - LDB + 1024 + lch); } \
            else { pr = (u32x2){0u, 0u}; pk = pr; pv = pr; } \
            qw = *(const f32x4*)(Wdec + row_ * 512 + lch); qa = *(const u32x2*)(Aa + row_ * 512 + lch); } while (0)
#define SCAN_PROCESS(buf) do { const f32x4 r0_ = cvt4(qr), k0_ = cvt4(qk), v0_ = cvt4(qv); \
            const f32x4 r_ = r0_ + mur * (cvt4(pr) - r0_), k_ = k0_ + muk * (cvt4(pk) - k0_), v_ = v0_ + muv * (cvt4(pv) - v0_), a_ = cvt4(qa); \
            const f32x4 kkv_ = k_ * kkc; const float ss_ = allsum16(dot4(kkv_, kkv_)); const float inv_ = __builtin_amdgcn_rsqf(fmaxf(ss_, 1e-24f)); \
            const f32x4 kkn_ = kkv_ * inv_; \
            LAS float* o_ = rec + (buf) * 6144 + ls * 384 + lcg * 4; \
            *(LAS f32x4*)(o_) = qw; *(LAS f32x4*)(o_ + 64) = k_ * (1.0f + (a_ - 1.0f) * kac); *(LAS f32x4*)(o_ + 128) = kkn_; *(LAS f32x4*)(o_ + 192) = -(kkn_ * a_); \
            *(LAS f32x4*)(o_ + 256) = r_; *(LAS f32x4*)(o_ + 320) = v_; } while (0)
        if (wid >= 4) {
            mur = *(const f32x4*)(mu + lch); muk = *(const f32x4*)(mu + 512 + lch); muv = *(const f32x4*)(mu + 1024 + lch);
            kkc = *(const f32x4*)(k_k + lch); kac = *(const f32x4*)(k_a + lch);
            SCAN_ISSUE(0); SCAN_PROCESS(0); SCAN_ISSUE(1);
        }
        __syncthreads();
        for (int c = 0; c < 128; ++c) {
            if (wid < 4) {
                LAS const float* rb = rec + (c & 1) * 6144 + cgi * 4;
                LAS const float* rv = rec + (c & 1) * 6144 + 320 + ri;
                float yp[16];
                f32x4 nw = *(LAS const f32x4*)(rb), nk = *(LAS const f32x4*)(rb + 64), nkk = *(LAS const f32x4*)(rb + 128), nb = *(LAS const f32x4*)(rb + 192), nr = *(LAS const f32x4*)(rb + 256);
                float nv = rv[0];
#pragma unroll
                for (int s = 0; s < 16; ++s) {
                    const f32x4 cw = nw, ck = nk, ckk = nkk, cb = nb, cr = nr; const float cv = nv;
                    if (s + 1 < 16) {
                        LAS const float* r1 = rb + (s + 1) * 384;
                        nw = *(LAS const f32x4*)(r1); nk = *(LAS const f32x4*)(r1 + 64); nkk = *(LAS const f32x4*)(r1 + 128); nb = *(LAS const f32x4*)(r1 + 192); nr = *(LAS const f32x4*)(r1 + 256);
                        nv = rv[(s + 1) * 384];
                    }
                    scan_step<false>(S, cw, ck, ckk, cb, cr, cv, yp[s]);
                }
                Y[((size_t)b * 2048 + c * 16 + cgi) * 512 + h * 64 + ri] = reduce_scatter16(yp, cgi);
            } else {
                if (c + 1 < 128) { SCAN_PROCESS((c + 1) & 1); if (c + 2 < 128) SCAN_ISSUE(c + 2); }
            }
            __syncthreads();
        }
        if (wid < 4) *(f32x4*)(POUT + O_WKVP + ((((size_t)pair * 8 + b) * 8 + h) * 64 + ri) * 64 + cgi * 4) = S;
#undef SCAN_ISSUE
#undef SCAN_PROCESS
    }
}

__device__ void phase_even_post(const Params& p, const Ctx cx, int pair) {
    const int gtid = cx.bid * 512 + cx.tid, gthreads = cx.nblk * 512;
    const bf16_t* PA = (const bf16_t*)(PWS + WS_R1);
    bf16_t* Ycat = (bf16_t*)(PWS + WS_YCAT);
    const float* Y = (const float*)(PWS + WS_Y);
    constexpr int NIT = NTOK * 128, UB = 4;
    const float* gn_g = PIN(I_GNG) + pair * 512; const float* gn_b = PIN(I_GNB) + pair * 512;
    for (int e0 = gtid; e0 < NIT; e0 += gthreads * UB) {
        f32x4 y[UB], bv[UB], bz[UB]; bool ok[UB];
#pragma unroll
        for (int u = 0; u < UB; ++u) {
            const int e = e0 + u * gthreads; ok[u] = e < NIT;
            const int ee = ok[u] ? e : e0; const int row = ee >> 7, ch = (ee & 127) * 4;
            y[u] = *(const f32x4*)(Y + (size_t)row * 512 + ch);
            bv[u] = ld_bf4(Ycat + (size_t)row * 1024 + 512 + ch);
            bz[u] = ld_bf4(PA + (size_t)row * LDA + 2048 + ch);
        }
#pragma unroll
        for (int u = 0; u < UB; ++u) {
            const int e = e0 + u * gthreads;
            const int ee = ok[u] ? e : e0; const int row = ee >> 7, ch = (ee & 127) * 4;
            const float mean = allsum16(y[u][0] + y[u][1] + y[u][2] + y[u][3]) * (1.0f / 64.0f);
            const f32x4 d = y[u] - mean;
            const float var = allsum16(dot4(d, d)) * (1.0f / 64.0f);
            const float rstd = rsqrtf(var + 64e-5f);
            const f32x4 g = *(const f32x4*)(gn_g + ch), bb = *(const f32x4*)(gn_b + ch);
            f32x4 o;
#pragma unroll
            for (int j = 0; j < 4; ++j) o[j] = (d[j] * rstd * g[j] + bb[j] + bv[u][j]) * siluf_(bz[u][j]);
            if (ok[u]) st_bf4(Ycat + (size_t)row * 1024 + 512 + ch, o);
        }
    }
    const float* cw = PIN(I_CONVW) + pair * 3 * 512;
    constexpr int NRUN = (NTOK / 8) * 128;
    for (int e = gtid; e < NRUN; e += gthreads) {
        const int run = e >> 7, ch = (e & 127) * 4, row0 = run * 8;
        const bool samp = row0 >= NTP;
        int b, t0, T; if (!samp) { b = row0 >> 11; t0 = row0 & 2047; T = 2048; } else { b = (row0 - NTP) >> 3; t0 = 0; T = 8; }
        const bf16_t* base = PA + (size_t)row0 * LDA + ch;
        u32x2 rh[10], rc[10], rb[8], rz[8];
#pragma unroll
        for (int k = 0; k < 10; ++k) {
            const bool have = (k >= 2) || (t0 > 0);
            const bf16_t* pr = have ? base + (ptrdiff_t)(k - 2) * LDA : base;
            rh[k] = *(const u32x2*)(pr); rc[k] = *(const u32x2*)(pr + 1024);
        }
#pragma unroll
        for (int k = 0; k < 8; ++k) { rb[k] = *(const u32x2*)(base + (size_t)k * LDA + 512); rz[k] = *(const u32x2*)(base + (size_t)k * LDA + 1536); }
        const f32x4 k0 = *(const f32x4*)(cw + ch), k1 = *(const f32x4*)(cw + 512 + ch), k2 = *(const f32x4*)(cw + 1024 + ch);
        f32x4 um2, um1;
        if (t0 > 0) { um2 = cvt4(rc[0]) * cvt4(rh[0]); um1 = cvt4(rc[1]) * cvt4(rh[1]); }
        else if (samp) { const float* hist = PIN(I_SCONV) + ((size_t)pair * 128 + b) * 2 * 512 + ch; um2 = *(const f32x4*)(hist); um1 = *(const f32x4*)(hist + 512); }
        else { um2 = (f32x4){0.f, 0.f, 0.f, 0.f}; um1 = um2; }
#pragma unroll
        for (int k = 0; k < 8; ++k) {
            const f32x4 u0 = cvt4(rc[k + 2]) * cvt4(rh[k + 2]);
            const f32x4 conv = k0 * um2 + k1 * um1 + k2 * u0;
            const f32x4 ab = cvt4(rb[k]), az = cvt4(rz[k]);
            f32x4 o;
#pragma unroll
            for (int j = 0; j < 4; ++j) o[j] = ab[j] * conv[j] * siluf_(az[j]);
            const int row = row0 + k, t = t0 + k;
            st_bf4(Ycat + (size_t)row * 1024 + ch, o);
            if (t >= T - 2) {
                float* dst = samp ? POUT + O_CONVS + (((size_t)pair * 128 + b) * 2 + (t - (T - 2))) * 512 + ch : POUT + O_CONVP + (((size_t)pair * 8 + b) * 2 + (t - (T - 2))) * 512 + ch;
                *(f32x4*)dst = u0;
            }
            um2 = um1; um1 = u0;
        }
    }
}

template <int W>
__device__ __forceinline__ void pool_sample_run(const float* __restrict__ hist, const bf16_t* __restrict__ cur, LAS bf16_t* out) {
    f32x4 ext[23];
#pragma unroll
    for (int k = 0; k < 15; ++k) ext[k] = (k >= 16 - W) ? *(const f32x4*)(hist + (size_t)k * 512) : (f32x4){0.f, 0.f, 0.f, 0.f};
#pragma unroll
    for (int k = 0; k < 8; ++k) ext[15 + k] = ld_bf4(cur + (size_t)k * LDA);
    f32x4 sum = (f32x4){0.f, 0.f, 0.f, 0.f};
#pragma unroll
    for (int d = 0; d < W; ++d) sum += ext[15 - d];
#pragma unroll
    for (int t = 0; t < 8; ++t) {
        if (t > 0) sum += ext[15 + t] - ext[15 + t - W];
        const f32x4 pooled = sum * (1.0f / (float)W) - ext[15 + t];
        u32x2 u; u.x = cvt_pk_bf16(pooled[0], pooled[1]); u.y = cvt_pk_bf16(pooled[2], pooled[3]);
        *(LAS u32x2*)(out + t * 136) = u;
    }
}

__device__ void phase_odd_mixer(const Params& p, const Ctx cx, int pair, LAS unsigned char* lds) {
    const int tid = cx.tid, wid = tid >> 6, lane = tid & 63, fr = lane & 15, fq = lane >> 4;
    const bf16_t* PO = (const bf16_t*)(PWS + WS_R1);
    bf16_t* Ycat = (bf16_t*)(PWS + WS_YCAT);
    LAS bf16_t* LA = (LAS bf16_t*)lds;
    LAS bf16_t* LB = (LAS bf16_t*)(lds + 128 * 136 * 2);
    LAS float* stat = (LAS float*)(lds + 2 * 128 * 136 * 2);
    LAS float* LE = (LAS float*)(lds + 128 * 136 * 2);
    LAS bf16_t* LW = (LAS bf16_t*)(lds + 128 * 136 * 2 + 143 * 128 * 4);
    for (int di = 0; di < 8; ++di) {
        int tile, g0, ng;
        if (cx.nblk == 256) {
            if (di == 0) { tile = cx.bid >> 1; g0 = (cx.bid & 1) * 2; ng = 2; }
            else if (di == 1 && cx.bid < 32) { tile = 128 + (cx.bid >> 2); g0 = cx.bid & 3; ng = 1; }
            else break;
        } else { tile = cx.bid + di * cx.nblk; g0 = 0; ng = 4; if (tile >= 136) break; }
        const int r0 = tile * 128;
        const bool samp = r0 >= NTP;
        const int tl_ = tid >> 2, q_ = tid & 3;
        {
            const bf16_t* vr = PO + (size_t)(r0 + tl_) * LDA + 1536 + q_ * 128;
            float s_ = 0.f, ss = 0.f;
#pragma unroll
            for (int i = 0; i < 16; ++i) { const u32x4 raw = *(const u32x4*)(vr + i * 8); const f32x4 v0 = cvt4((u32x2){raw.x, raw.y}), v1 = cvt4((u32x2){raw.z, raw.w});
                s_ += (v0[0] + v0[1]) + (v0[2] + v0[3]) + (v1[0] + v1[1]) + (v1[2] + v1[3]); ss += dot4(v0, v0) + dot4(v1, v1); }
            s_ = allsum4(s_); ss = allsum4(ss);
            const float mean = s_ * (1.0f / 512.0f);
            const float var = fmaxf(ss * (1.0f / 512.0f) - mean * mean, 0.f);
            if (q_ == 0) { stat[tl_ * 2] = mean; stat[tl_ * 2 + 1] = rsqrtf(var + 1e-5f); }
        }
        LAS float* lnw = stat + 512;
        lnw[tid] = PIN(I_LNG)[pair * 512 + tid]; lnw[512 + tid] = PIN(I_LNB)[pair * 512 + tid];
        u32x2 rv[8]; u32x4 rw[4];
#define MIX_LOAD_G(gg) do { const bf16_t* vr_ = PO + (size_t)(r0 + tl_) * LDA + 1536 + (gg) * 128 + q_ * 32; \
            _Pragma("unroll") for (int i = 0; i < 8; ++i) rv[i] = *(const u32x2*)(vr_ + i * 4); \
            if (!samp) { const bf16_t* Ws_ = (const bf16_t*)(PWS + WS_SPW) + ((size_t)pair * 4 + (gg)) * 128 * 128; \
                _Pragma("unroll") for (int i = 0; i < 4; ++i) { const int e = tid + i * 512; rw[i] = *(const u32x4*)(Ws_ + (e >> 4) * 128 + (e & 15) * 8); } } } while (0)
        MIX_LOAD_G(g0);
        __syncthreads();
#pragma unroll 1
        for (int g = g0; g < g0 + ng; ++g) {
            u32x2 ur[8], dzr[8];
#pragma unroll
            for (int nt = 0; nt < 8; ++nt) { const size_t o_ = (size_t)(r0 + wid * 16 + fr) * LDA + g * 128 + nt * 16 + fq * 4; ur[nt] = *(const u32x2*)(PO + o_ + 1024); dzr[nt] = *(const u32x2*)(PO + o_ + 2048); }
            {
                const int row = r0 + tl_;
                const float mean = stat[tl_ * 2], rstd = stat[tl_ * 2 + 1];
                LAS const float* lg = lnw + g * 128 + q_ * 32; LAS const float* lb = lnw + 512 + g * 128 + q_ * 32;
#pragma unroll
                for (int i = 0; i < 8; ++i) {
                    const f32x4 v = cvt4(rv[i]);
                    const f32x4 vn = (v - mean) * rstd * *(LAS const f32x4*)(lg + i * 4) + *(LAS const f32x4*)(lb + i * 4);
                    if (samp) *(f32x4*)(POUT + O_CHUNKV + ((size_t)pair * 1024 + (row - NTP)) * 512 + g * 128 + q_ * 32 + i * 4) = vn;
                    {
                        const float p0 = dpp_f<0x104>(vn[0]), p1 = dpp_f<0x104>(vn[1]);
                        const float p2 = dpp_f<0x114>(vn[2]), p3 = dpp_f<0x114>(vn[3]);
                        const bool odd = tl_ & 1;
                        const unsigned wa = odd ? cvt_pk_bf16(p2, vn[2]) : cvt_pk_bf16(vn[0], p0);
                        const unsigned wb = odd ? cvt_pk_bf16(p3, vn[3]) : cvt_pk_bf16(vn[1], p1);
                        const int cb = q_ * 32 + i * 4 + (odd ? 2 : 0), tb = tl_ & ~1;
                        *(LAS unsigned*)(LB + (cb) * 136 + tb) = wa;
                        *(LAS unsigned*)(LB + (cb + 1) * 136 + tb) = wb;
                    }
                }
            }
            if (!samp) {
#pragma unroll
                for (int i = 0; i < 4; ++i) { const int e = tid + i * 512; *(LAS u32x4*)(LA + (e >> 4) * 136 + (e & 15) * 8) = rw[i]; }
            } else {
                const float* Wsrc = PIN(I_SPW) + ((size_t)pair * 4 + g) * 128 * 128;
                LAS float* w8 = stat + 256;
                if (tid < 64) w8[tid] = Wsrc[(tid >> 3) * 128 + (tid & 7)];
                __syncthreads();
                for (int e = tid; e < 128 * 128; e += 512) { const int t = e >> 7, s2 = e & 127;
                    const float v = ((t >> 3) == (s2 >> 3) && (s2 & 7) <= (t & 7)) ? w8[(t & 7) * 8 + (s2 & 7)] : 0.f;
                    LA[t * 136 + s2] = (bf16_t)(cvt_pk_bf16(v, 0.f) & 0xffffu); }
            }
            if (g + 1 < g0 + ng) MIX_LOAD_G(g + 1);
            __syncthreads();
            {
                const int tl = wid * 16 + fr, row = r0 + tl;
                const float bias = PIN(I_SPB)[((size_t)pair * 4 + g) * 128 + (samp ? (tl & 7) : tl)];
                bf16x8 wf[4];
#pragma unroll
                for (int ks = 0; ks < 4; ++ks) wf[ks] = *(const LAS bf16x8*)(LA + tl * 136 + ks * 32 + fq * 8);
#pragma unroll
                for (int nt = 0; nt < 8; ++nt) {
                    f32x4 acc = (f32x4){0.f, 0.f, 0.f, 0.f};
#pragma unroll
                    for (int ks = 0; ks < 4; ++ks) {
                        if (ks * 32 <= wid * 16 + 15) {
                            const bf16x8 vf = *(const LAS bf16x8*)(LB + (nt * 16 + fr) * 136 + ks * 32 + fq * 8);
                            acc = __builtin_amdgcn_mfma_f32_16x16x32_bf16(vf, wf[ks], acc, 0, 0, 0);
                        }
                    }
                    const int c = g * 128 + nt * 16 + fq * 4;
                    const f32x4 u = cvt4(ur[nt]), dz = cvt4(dzr[nt]);
                    f32x4 o;
#pragma unroll
                    for (int j = 0; j < 4; ++j) o[j] = u[j] * (acc[j] + bias) * siluf_(dz[j]);
                    st_bf4(Ycat + (size_t)row * 1024 + 512 + c, o);
                }
            }
            __syncthreads();
        }
#undef MIX_LOAD_G
    }
    {
        int ci, cstride;
        if (cx.nblk == 256) { if (cx.bid < 32) { ci = 1 << 20; cstride = 1 << 20; } else { ci = cx.bid - 32; cstride = 224; } }
        else { ci = cx.bid; cstride = cx.nblk; }
        u32x4 pw[4]; u32x2 pe[9];
#define MIX_LOAD_C(cc) do { const int tile_ = (cc) >> 2, g_ = (cc) & 3, r0_ = tile_ * 128; \
            const bf16_t* Bw_ = (const bf16_t*)(PWS + WS_POOLWT) + ((size_t)pair * 4 + g_) * 128 * 128; \
            _Pragma("unroll") for (int i = 0; i < 4; ++i) { const int e = tid + i * 512; pw[i] = *(const u32x4*)(Bw_ + (e >> 4) * 128 + (e & 15) * 8); } \
            if (r0_ < NTP) { const int t0_ = r0_ & 2047; \
                _Pragma("unroll") for (int i = 0; i < 9; ++i) { const int e = tid + i * 512, er = e >> 5, c = (e & 31) * 4; pe[i] = (u32x2){0u, 0u}; \
                    if (e < 143 * 32 && t0_ + er - 15 >= 0) pe[i] = *(const u32x2*)(PO + (size_t)(r0_ + er - 15) * LDA + g_ * 128 + c); } } } while (0)
        if (ci < 544) MIX_LOAD_C(ci);
        for (; ci < 544; ci += cstride) {
            const int tile = ci >> 2, g = ci & 3, r0 = tile * 128;
            const bool samp = r0 >= NTP;
            const int w = 2 << g;
            const int row = r0 + wid * 16 + fr;
            u32x2 czr[8]; f32x4 psr[8];
#pragma unroll
            for (int nt = 0; nt < 8; ++nt) { const int d = g * 128 + nt * 16 + fq * 4; czr[nt] = *(const u32x2*)(PO + (size_t)row * LDA + 512 + d); psr[nt] = *(const f32x4*)(PIN(I_PSCALE) + pair * 512 + d); }
#pragma unroll
            for (int i = 0; i < 4; ++i) { const int e = tid + i * 512; *(LAS u32x4*)(LW + (e >> 4) * 136 + (e & 15) * 8) = pw[i]; }
            if (!samp) {
                const int t0 = r0 & 2047;
#pragma unroll
                for (int i = 0; i < 9; ++i) { const int e = tid + i * 512, er = e >> 5, c = (e & 31) * 4; if (e < 143 * 32) *(LAS f32x4*)(LE + er * 128 + c) = cvt4(pe[i]); }
                __syncthreads();
                {
                    const int c = (tid & 31) * 4, tl0 = (tid >> 5) * 8;
                    f32x4 sum = (f32x4){0.f, 0.f, 0.f, 0.f};
#pragma unroll 4
                    for (int d = 0; d < w; ++d) sum += *(LAS const f32x4*)(LE + (tl0 + 15 - d) * 128 + c);
#pragma unroll
                    for (int k = 0; k < 8; ++k) {
                        const int tl = tl0 + k;
                        const f32x4 pt = *(LAS const f32x4*)(LE + (tl + 15) * 128 + c);
                        if (k > 0) sum += pt - *(LAS const f32x4*)(LE + (tl + 15 - w) * 128 + c);
                        const float cnt = fminf((float)w, (float)(t0 + tl + 1));
                        const f32x4 pooled = sum * (1.0f / cnt) - pt;
                        u32x2 u; u.x = cvt_pk_bf16(pooled[0], pooled[1]); u.y = cvt_pk_bf16(pooled[2], pooled[3]);
                        *(LAS u32x2*)(LA + tl * 136 + c) = u;
                    }
                }
            } else {
                const int sq = tid >> 5, c = (tid & 31) * 4, bb = (r0 - NTP) / 8 + sq;
                const float* hist = PIN(I_SPOOL) + ((size_t)pair * 128 + bb) * 15 * 512 + g * 128 + c;
                const bf16_t* cur = PO + (size_t)(r0 + sq * 8) * LDA + g * 128 + c;
                LAS bf16_t* out = LA + (sq * 8) * 136 + c;
                if (g == 0) pool_sample_run<2>(hist, cur, out); else if (g == 1) pool_sample_run<4>(hist, cur, out);
                else if (g == 2) pool_sample_run<8>(hist, cur, out); else pool_sample_run<16>(hist, cur, out);
            }
            if (ci + cstride < 544) MIX_LOAD_C(ci + cstride);
            __syncthreads();
            bf16x8 af[4];
#pragma unroll
            for (int ks = 0; ks < 4; ++ks) af[ks] = *(const LAS bf16x8*)(LA + (wid * 16 + fr) * 136 + ks * 32 + fq * 8);
#pragma unroll
            for (int nt = 0; nt < 8; ++nt) {
                f32x4 acc = (f32x4){0.f, 0.f, 0.f, 0.f};
#pragma unroll
                for (int ks = 0; ks < 4; ++ks) {
                    const bf16x8 bf = *(const LAS bf16x8*)(LW + (nt * 16 + fr) * 136 + ks * 32 + fq * 8);
                    acc = __builtin_amdgcn_mfma_f32_16x16x32_bf16(bf, af[ks], acc, 0, 0, 0);
                }
                const int d = g * 128 + nt * 16 + fq * 4;
                const f32x4 cz = cvt4(czr[nt]), ps = psr[nt];
                f32x4 o;
#pragma unroll
                for (int j = 0; j < 4; ++j) o[j] = acc[j] * ps[j] * siluf_(cz[j]);
                st_bf4(Ycat + (size_t)row * 1024 + d, o);
            }
            __syncthreads();
        }
#undef MIX_LOAD_C
    }
    const int gtid = cx.bid * 512 + tid, gthreads = cx.nblk * 512;
    for (int e = gtid; e < 136 * 15 * 128; e += gthreads) {
        const int c = (e & 127) * 4, q = e >> 7, sr = q / 15, k = q - sr * 15;
        if (sr < 8) *(f32x4*)(POUT + O_POOLP + (((size_t)pair * 8 + sr) * 15 + k) * 512 + c) = ld_bf4(PO + (size_t)(sr * 2048 + 2033 + k) * LDA + c);
        else { const int b = sr - 8;
            *(f32x4*)(POUT + O_POOLS + (((size_t)pair * 128 + b) * 15 + k) * 512 + c) = (k < 7) ? *(const f32x4*)(PIN(I_SPOOL) + (((size_t)pair * 128 + b) * 15 + 8 + k) * 512 + c) : ld_bf4(PO + (size_t)(NTP + b * 8 + (k - 7)) * LDA + c); }
    }
}

__device__ void phase_final(const Params& p, const Ctx cx) {
    const int gtid = cx.bid * 512 + cx.tid, gthreads = cx.nblk * 512;
    const float* ssq = (const float*)(PWS + WS_SSQ) + (size_t)4 * NTOK * 16;
    const bf16_t* Xb = (const bf16_t*)(PWS + WS_XB);
    constexpr int NIT = NTOK * 256, UB = 4;
    for (int e0 = gtid; e0 < NIT; e0 += gthreads * UB) {
        f32x4 x[UB]; float sq[UB]; bool ok[UB];
#pragma unroll
        for (int u = 0; u < UB; ++u) { const int e = e0 + u * gthreads; ok[u] = e < NIT; const int ee = ok[u] ? e : e0; const int row = ee >> 8, c = (ee & 255) * 4;
            x[u] = ld_bf4(Xb + (size_t)row * 1024 + c); sq[u] = ssq_sum(ssq + (size_t)row * 16); }
#pragma unroll
        for (int u = 0; u < UB; ++u) { const int e = e0 + u * gthreads; const int ee = ok[u] ? e : e0; const int row = ee >> 8, c = (ee & 255) * 4;
            const float rstd = rsqrtf(sq[u] * (1.0f / 1024.0f) + 1e-6f);
            if (ok[u]) *(f32x4*)(POUT + (size_t)row * 1024 + c) = x[u] * rstd * *(const f32x4*)(PIN(I_FNORMW) + c); }
    }
}

#define XB_TMO      128
#define XB_XCNT(j)  (256  + 64 * (j))
#define XB_XSUB(j)  (1280 + 64 * (j))
#define XB_XGEN(j)  (2304 + 64 * (j))
#define XB_TOP      3328
#define XB_TOPGEN   3392
#define XCD_BAR_WORDS 3456
#define XB_SPIN_CAP (1u << 18)
__device__ __forceinline__ unsigned xb_ld(unsigned* p)              { return __hip_atomic_load(p, __ATOMIC_RELAXED, __HIP_MEMORY_SCOPE_AGENT); }
__device__ __forceinline__ unsigned xb_add(unsigned* p, unsigned v) { return __hip_atomic_fetch_add(p, v, __ATOMIC_RELAXED, __HIP_MEMORY_SCOPE_AGENT); }
__device__ __forceinline__ unsigned xb_xcc_id() { return (unsigned)__builtin_amdgcn_s_getreg((3 << 11) | 20) & 0xFu; }
#define XB_SPIN(cond, bar) do { unsigned _sp = 0; while (cond) { __builtin_amdgcn_s_sleep(1); \
    if ((++_sp & 255u) == 0u) { if (xb_ld(&(bar)[XB_TMO])) break; if (_sp > XB_SPIN_CAP) { atomicAdd(&(bar)[XB_TMO], 1u); break; } } } } while (0)
struct XcdBarrier { unsigned* bar; unsigned x; volatile LAS unsigned* st; };
__device__ __forceinline__ XcdBarrier xcd_barrier_post(unsigned* bar, volatile LAS unsigned* st) {
    XcdBarrier b; b.bar = bar; b.x = xb_xcc_id(); b.st = st;
    if (threadIdx.x == 0) (void)xb_add(&bar[XB_XCNT(b.x)], 1u);
    return b;
}
__device__ __forceinline__ void xcd_barrier_complete(unsigned* bar, unsigned x, unsigned& nloc, unsigned& nx) {
    const unsigned G = gridDim.x * gridDim.y * gridDim.z;
    unsigned sum, cnt, mine, sp = 0u;
    for (;;) {
        sum = 0u; cnt = 0u; mine = 0u;
#pragma unroll
        for (unsigned j = 0; j < 16; ++j) { const unsigned c = xb_ld(&bar[XB_XCNT(j)]); sum += c; cnt += (c > 0u) ? 1u : 0u; mine = (j == x) ? c : mine; }
        if (sum == G) break;
        __builtin_amdgcn_s_sleep(1);
        if ((++sp & 255u) == 0u) { if (xb_ld(&bar[XB_TMO])) break; if (sp > XB_SPIN_CAP) { atomicAdd(&bar[XB_TMO], 1u); break; } }
    }
    nloc = mine > 0u ? mine : 1u; nx = cnt > 0u ? cnt : 1u;
}
__device__ __forceinline__ void xcd_barrier(const XcdBarrier& b) {
    asm volatile("s_waitcnt vmcnt(0)" ::: "memory");
    __syncthreads();
    if (threadIdx.x == 0) {
        unsigned* bar = b.bar;
        __builtin_amdgcn_s_waitcnt(0);
        unsigned nloc = b.st[0], nx = b.st[1];
        if (nloc == 0u) { xcd_barrier_complete(bar, b.x, nloc, nx); b.st[0] = nloc; b.st[1] = nx; }
        const unsigned old = xb_add(&bar[XB_XSUB(b.x)], 1u);
        const unsigned gen = old / nloc;
        if (old + 1u == (gen + 1u) * nloc) {
            __builtin_amdgcn_fence(__ATOMIC_RELEASE, "agent");
            asm volatile("s_waitcnt vmcnt(0)" ::: "memory");
            const unsigned og = xb_add(&bar[XB_TOP], 1u);
            const unsigned tg = og / nx;
            if (og + 1u == (tg + 1u) * nx) xb_add(&bar[XB_TOPGEN], 1u);
            else XB_SPIN(xb_ld(&bar[XB_TOPGEN]) == tg, bar);
            __builtin_amdgcn_fence(__ATOMIC_ACQUIRE, "agent");
            xb_add(&bar[XB_XGEN(b.x)], 1u);
            asm volatile("s_waitcnt vmcnt(0)" ::: "memory");
        } else {
            XB_SPIN(xb_ld(&bar[XB_XGEN(b.x)]) == gen, bar);
            __builtin_amdgcn_fence(__ATOMIC_ACQUIRE, "agent");
            asm volatile("s_waitcnt vmcnt(0)" ::: "memory");
        }
    }
    __syncthreads();
}

__device__ void run_gemm_proj(const Params& p, const Ctx cx, LAS unsigned char* lds, const bf16_t* Bt, int N, bf16_t* O, int ldc, int layer) {
    pg8::Gemm g{(const bf16_t*)(PWS + WS_XB), Bt, NTOK, N, 1024};
    pg8::StaticOrder S; S.init(NTOK, N, (int)cx.nblk, (int)cx.bid);
    const float* ssq = (const float*)(PWS + WS_SSQ) + (size_t)layer * NTOK * 16;
    LAS float* rl = (LAS float*)(lds + 131072);
    int pm0 = -1, pm1 = -1, pm2 = -1, pm3 = -1, np = 0;
    for (int i = 0; i < 64; ++i) {
        pg8::Unit u; if (!S.next(i, u)) break;
        if (u.pm == pm0 || u.pm == pm1 || u.pm == pm2 || u.pm == pm3) continue;
        if (np == 0) pm0 = u.pm; else if (np == 1) pm1 = u.pm; else if (np == 2) pm2 = u.pm; else pm3 = u.pm;
        ++np;
    }
    for (int r = cx.tid; r < np * 256; r += 512) {
        const int i = r >> 8, pm = i == 0 ? pm0 : (i == 1 ? pm1 : (i == 2 ? pm2 : pm3));
        rl[r] = rsqrtf(ssq_sum(ssq + (size_t)(pm * 256 + (r & 255)) * 16) * (1.0f / 1024.0f) + 1e-6f);
    }
    __syncthreads();
    EpiProj E{O, ldc, rl, pm0, pm1, pm2, pm3};
    pg8::gemm_phase<EpiProj>(cx, lds, g, S, E);
}
__device__ void run_gemm_res(const Params& p, const Ctx cx, LAS unsigned char* lds, const bf16_t* Bt, int layer) {
    const bf16_t* A = (const bf16_t*)(PWS + WS_YCAT);
    bf16_t* Xb = (bf16_t*)(PWS + WS_XB);
    float* ssqn = (float*)(PWS + WS_SSQ) + (size_t)(layer + 1) * NTOK * 16;
    pg8::Gemm g{A, Bt, NTOK, 1024, 1024};
    pg8::StaticOrder S; S.init(NTOK, 1024, (int)cx.nblk, (int)cx.bid);
    EpiRes E{layer == 0 ? PIN(I_XP) : nullptr, PIN(I_XS), Xb, ssqn};
    pg8::gemm_phase<EpiRes>(cx, lds, g, S, E);
}

constexpr int N_PHASES = 20;
#ifndef PHMASK
#define PHMASK 0xffff
#endif
#define PHON(n) ((PHMASK >> ((n) % 16)) & 1)
__global__ void __launch_bounds__(512, 2) fwd_kernel(Params p) {
    extern __shared__ __attribute__((aligned(16))) unsigned char lds_raw[];
    LAS unsigned char* lds = (LAS unsigned char*)lds_raw;
    volatile LAS unsigned* bar_st = (volatile LAS unsigned*)(lds + LDS_MAIN);
    if (threadIdx.x < 4) bar_st[threadIdx.x] = 0u;
    __syncthreads();
    const XcdBarrier gbar = xcd_barrier_post((unsigned*)((unsigned char*)p.ptr[30] + WS_BAR), bar_st);
    if (p.ph_hi < 0) cg::this_grid().sync();
#define GRID_SYNC() xcd_barrier(gbar)
#ifdef SYNCPROBE
    for (int i = 0; i < SYNCPROBE; ++i) GRID_SYNC();
#endif
#ifdef REPMASK
    for (int pc = p.ph_lo * 2; pc < p.ph_hi * 2; ++pc) {
        const int ph = pc >> 1;
        { const int s_ = (ph == 0) ? 9 : (ph == N_PHASES - 1) ? 31 : (ph - 1) % 9; if ((pc & 1) && !((REPMASK >> s_) & 1)) continue; }
        if (pc > p.ph_lo * 2) GRID_SYNC();
#else
    for (int ph = p.ph_lo; ph < p.ph_hi; ++ph) {
        if (ph > p.ph_lo) GRID_SYNC();
#endif
        Ctx cx; cx.tid = threadIdx.x; cx.bid = blockIdx.x; cx.nblk = gridDim.x;
        asm volatile("s_mov_b32 %0, 0" : "=s"(cx.z));
        asm volatile("" : "+v"(cx.tid)); asm volatile("" : "+s"(cx.bid)); asm volatile("" : "+s"(cx.nblk));
        const int pair = (ph - 1) / 9, s = (ph == 0) ? 100 : (ph == N_PHASES - 1 ? 101 : (ph - 1) % 9);
        if (s == 0 || s == 3 || s == 6) {
#if PHON(0)
            const bf16_t* WinE = (const bf16_t*)(PWS + WS_WINE) + (size_t)pair * 4352 * 1024;
            const bf16_t* Bt = s == 0 ? WinE + (size_t)2560 * 1024 : (s == 3 ? WinE : (const bf16_t*)(PWS + WS_WINO) + (size_t)pair * 2560 * 1024);
            const int N = s == 0 ? 1792 : 2560;
            run_gemm_proj(p, cx, lds, Bt, N, (bf16_t*)(PWS + WS_R1), N, 2 * pair + (s == 6 ? 1 : 0));
#endif
        } else if (s == 5 || s == 8) {
#if PHON(5)
            const bf16_t* Bt = (const bf16_t*)(PWS + (s == 5 ? WS_WOUTE : WS_WOUTO)) + (size_t)pair * 1024 * 1024;
            run_gemm_res(p, cx, lds, Bt, 2 * pair + (s == 8 ? 1 : 0));
#endif
        } else if (s == 1) {
#if PHON(1)
            phase_even_prep(p, cx, pair, lds);
#endif
        } else if (s == 2) {
#if PHON(2)
            phase_scan(p, cx, pair, lds);
#endif
        } else if (s == 4) {
#if PHON(4)
            phase_even_post(p, cx, pair);
#endif
        } else if (s == 7) {
#if PHON(7)
            phase_odd_mixer(p, cx, pair, lds);
#endif
        } else if (s == 100) {
#if PHON(10)
            phase_prepass(p, cx, lds);
#endif
        } else {
#if PHON(11)
            phase_final(p, cx);
#endif
        }
    }
}

extern "C" void kernel_launch(void* const* d_in, const int* in_sizes, int n_in, void* d_out, int out_size, void* d_ws, size_t ws_size, hipStream_t stream) {
    static int grid = 0;
    if (grid == 0) {
        if (n_in != 29 || ws_size < WS_END) { fprintf(stderr, "kernel_launch: unexpected n_in %d / ws_size %zu (need %zu)\n", n_in, ws_size, (size_t)WS_END); grid = -1; return; }
        int dev = 0, cus = 0, per_cu = 0;
        hipGetDevice(&dev);
        hipDeviceGetAttribute(&cus, hipDeviceAttributeMultiprocessorCount, dev);
        if (hipFuncSetAttribute((const void*)fwd_kernel, hipFuncAttributeMaxDynamicSharedMemorySize, LDS_BYTES) != hipSuccess) { fprintf(stderr, "kernel_launch: hipFuncSetAttribute failed\n"); grid = -1; return; }
        if (hipOccupancyMaxActiveBlocksPerMultiprocessor(&per_cu, (const void*)fwd_kernel, 512, LDS_BYTES) != hipSuccess || per_cu < 1) { fprintf(stderr, "kernel_launch: occupancy query gave %d\n", per_cu); per_cu = 1; }
        (void)hipGetLastError();
        grid = cus * per_cu;
        if (grid > 256) grid = 256;
    }
    if (grid < 0) return;
    Params p{};
    for (int i = 0; i < 29; ++i) p.ptr[i] = d_in[i];
    p.ptr[29] = d_out; p.ptr[30] = d_ws; p.ptr[31] = nullptr;
    (void)hipMemsetAsync((unsigned char*)d_ws + WS_BAR, 0, 16384, stream);
#if ONE_LAUNCH
    p.ph_lo = 0; p.ph_hi = N_PHASES;
    void* args[] = {&p};
    hipError_t e = hipLaunchCooperativeKernel((const void*)fwd_kernel, dim3(grid), dim3(512), args, LDS_BYTES, stream);
    if (e != hipSuccess) fprintf(stderr, "cooperative launch failed: %s (grid %d)\n", hipGetErrorString(e), grid);
#else
    for (int ph = 0; ph < N_PHASES; ++ph) {
        p.ph_lo = ph; p.ph_hi = ph + 1;
        hipLaunchKernelGGL(fwd_kernel, dim3(grid), dim3(512), LDS_BYTES, stream, p);
    }
#endif
}
```

```cpp
#include <hip/hip_runtime.h>
#include <hip/hip_cooperative_groups.h>
#include <cstdio>
namespace cg = cooperative_groups;

#ifndef ONE_LAUNCH
#define ONE_LAUNCH 1
#endif

#define LAS __attribute__((address_space(3)))
typedef unsigned short bf16_t;
typedef short bf16x8 __attribute__((ext_vector_type(8)));
typedef float f32x4 __attribute__((ext_vector_type(4)));
typedef unsigned u32x4 __attribute__((ext_vector_type(4)));
typedef unsigned u32x2 __attribute__((ext_vector_type(2)));

constexpr int NTOK = 17408, NTP = 16384;
constexpr int LDB = 1792;
constexpr int LDA = 2560;
constexpr size_t O_CONVP = 17825792, O_CONVS = 17842176, O_SHIFTP = 18104320, O_SHIFTS = 18130944, O_WKVP = 18556928, O_WKVS = 19081216,
                 O_POOLP = 27469824, O_POOLS = 27592704, O_CHUNKV = 29558784;
constexpr size_t WS_WINE = 0;
constexpr size_t WS_WOUTE = WS_WINE + 2ull * 4352 * 1024 * 2;
constexpr size_t WS_WINO = WS_WOUTE + 2ull * 1024 * 1024 * 2;
constexpr size_t WS_WOUTO = WS_WINO + 2ull * 2560 * 1024 * 2;
constexpr size_t WS_W2T = WS_WOUTO + 2ull * 1024 * 1024 * 2;
constexpr size_t WS_A2T = WS_W2T + 2ull * 512 * 64 * 2;
constexpr size_t WS_POOLWT = WS_A2T + 2ull * 512 * 64 * 2;
constexpr size_t WS_SPW = WS_POOLWT + 8ull * 128 * 128 * 2;
constexpr size_t WS_XB = WS_SPW + 8ull * 128 * 128 * 2;
constexpr size_t WS_YCAT = WS_XB + (size_t)NTOK * 1024 * 2;
constexpr size_t WS_SSQ = WS_YCAT + (size_t)NTOK * 1024 * 2;
constexpr size_t WS_Y = WS_SSQ + 5ull * NTOK * 16 * 4;
constexpr size_t WS_R1 = WS_Y + (size_t)NTOK * 512 * 4;
constexpr size_t WS_PROJB = WS_R1;
constexpr size_t WS_WDEC = WS_PROJB + (size_t)NTOK * LDB * 2;
constexpr size_t WS_AA = WS_WDEC + (size_t)NTOK * 512 * 4;
constexpr size_t WS_BAR = WS_AA + (size_t)NTOK * 512 * 2;
constexpr size_t WS_END = WS_BAR + 16384;
constexpr int LDS_MAIN = 147456;
constexpr int LDS_BYTES = LDS_MAIN + 16;

struct Params {
    const void* ptr[32];
    int ph_lo, ph_hi;
};
struct Ctx { int tid, bid, nblk, z; };
#define PIN(i) ((const float*)p.ptr[(i) + cx.z])
#define POUT ((float*)p.ptr[29 + cx.z])
#define PWS ((unsigned char*)p.ptr[30 + cx.z])
enum { I_XP = 0, I_XS, I_SCONV, I_SSHIFT, I_SWKV, I_SPOOL, I_NORMW, I_FNORMW, I_WINE, I_CONVW, I_MU, I_W0, I_W2, I_A0, I_A2, I_KK, I_KA, I_RK, I_GNG, I_GNB,
       I_WOUTE, I_WINO, I_POOLW, I_PSCALE, I_LNG, I_LNB, I_SPW, I_SPB, I_WOUTO };

__device__ __forceinline__ unsigned cvt_pk_bf16(float lo, float hi) { unsigned r; asm("v_cvt_pk_bf16_f32 %0, %1, %2" : "=v"(r) : "v"(lo), "v"(hi)); return r; }
__device__ __forceinline__ float bf_lo(unsigned u) { return __uint_as_float(u << 16); }
__device__ __forceinline__ float bf_hi(unsigned u) { return __uint_as_float(u & 0xffff0000u); }
__device__ __forceinline__ float bf2f(bf16_t b) { return __uint_as_float(((unsigned)b) << 16); }
__device__ __forceinline__ f32x4 cvt4(u32x2 u) { return (f32x4){bf_lo(u.x), bf_hi(u.x), bf_lo(u.y), bf_hi(u.y)}; }
__device__ __forceinline__ f32x4 ld_bf4(const bf16_t* p) { return cvt4(*(const u32x2*)p); }
__device__ __forceinline__ void st_bf4(bf16_t* p, f32x4 v) { u32x2 u; u.x = cvt_pk_bf16(v[0], v[1]); u.y = cvt_pk_bf16(v[2], v[3]); *(u32x2*)p = u; }
__device__ __forceinline__ float sigmoidf_(float x) { return 1.0f / (1.0f + __expf(-x)); }
__device__ __forceinline__ float siluf_(float x) { return x / (1.0f + __expf(-x)); }
template <int CTRL> __device__ __forceinline__ float dpp_f(float x) { return __builtin_bit_cast(float, __builtin_amdgcn_mov_dpp(__builtin_bit_cast(int, x), CTRL, 0xf, 0xf, true)); }
__device__ __forceinline__ float allsum16(float x) { x += dpp_f<0xB1>(x); x += dpp_f<0x4E>(x); x += dpp_f<0x141>(x); x += dpp_f<0x128>(x); return x; }
__device__ __forceinline__ float allsum4(float x) { x += dpp_f<0xB1>(x); x += dpp_f<0x4E>(x); return x; }
__device__ __forceinline__ float dot4(f32x4 a, f32x4 b) { return a[0] * b[0] + a[1] * b[1] + a[2] * b[2] + a[3] * b[3]; }

__device__ __forceinline__ float ssq_sum(const float* part) {
    const f32x4 a = *(const f32x4*)(part), b = *(const f32x4*)(part + 4), c = *(const f32x4*)(part + 8), d = *(const f32x4*)(part + 12);
    return ((a[0] + a[1]) + (a[2] + a[3])) + ((b[0] + b[1]) + (b[2] + b[3])) + ((c[0] + c[1]) + (c[2] + c[3])) + ((d[0] + d[1]) + (d[2] + d[3]));
}

namespace pg8 {
constexpr int BM = 256, BK = 64, HALF = 128, HTB = HALF * BK * 2, NXCD = 8, WGM = 8;
__device__ __forceinline__ int lds_byte(int r, int c) { const int st = (r >> 4) * 2 + (c >> 5), rr = r & 15, cc = c & 31, ob = rr * 64 + cc * 2; return st * 1024 + (ob ^ (((ob >> 9) & 1) << 5)); }
__device__ __forceinline__ void stage_rc(int b, int& R, int& C) { const int st = b / 1024, sb = b % 1024, swz = sb ^ (((sb >> 9) & 1) << 5); R = (st >> 1) * 16 + swz / 64; C = (st & 1) * 32 + (swz % 64) / 2; }
__device__ __forceinline__ int perm32(int rho) { const int n = rho >> 4, i = rho & 15; return 8 * (i >> 2) + 4 * n + (i & 3); }
struct Unit { int pm, pn; };
struct Gemm { const bf16_t* A; const bf16_t* Bt; int M, N, K; };
struct StaticOrder {
    int nM, nN, nwg, G, c;
    __device__ void init(int M, int N, int G_, int c_) { nM = M / BM; nN = N / BM; nwg = nM * nN; G = G_; c = c_; }
    __device__ bool next(int i, Unit& u) const {
        const long L = (long)i * G + c; if (L >= nwg) return false;
        int wgid = (int)L; { const int q = nwg / NXCD, r = nwg % NXCD, xcd = wgid % NXCD, off = wgid / NXCD; wgid = (xcd < r ? xcd * (q + 1) : r * (q + 1) + (xcd - r) * q) + off; }
        const int nig = WGM * nN, gid = wgid / nig, fm = gid * WGM, gsz = (nM - fm) < WGM ? (nM - fm) : WGM;
        u.pm = fm + ((wgid % nig) % gsz); u.pn = (wgid % nig) / gsz; return true;
    }
};

template <class Epi>
__device__ __forceinline__ void gemm_phase(const Ctx cx, LAS unsigned char* lds, const Gemm g, const StaticOrder& S, const Epi& E) {
    const int tid = cx.tid, wid = __builtin_amdgcn_readfirstlane(tid >> 6), lane = tid & 63, wr = wid >> 2, wc = wid & 3, fr = lane & 15, fq = lane >> 4;
    const int K = g.K, nt = K / BK;
    unsigned voffA[2], voffB[2];
#pragma unroll
    for (int i = 0; i < 2; ++i) { int R, C; stage_rc(tid * 16 + i * 8192, R, C); const int Rb = Epi::PERM ? ((R & ~31) + perm32(R & 31)) : R;
        voffA[i] = (unsigned)(R * K + C) * 2u; voffB[i] = (unsigned)(Rb * K + C) * 2u; }
    const size_t kstep = (size_t)(BK * 2);
    const size_t hstep = (size_t)HALF * K * 2;
    const size_t tstep = 2 * hstep;
    const unsigned ldsw = (unsigned)wid * 1024u;
    const int aoff = lds_byte(wr * 64 + fr, fq * 8), boff = lds_byte(wc * 32 + fr, fq * 8);
#define PG8_SA(b, h) (((b) * 2 + (h)) * HTB)
#define PG8_SB(b, h) ((4 + (b) * 2 + (h)) * HTB)
#define PG8_STAGE(bufoff, gbase, voff) do { _Pragma("unroll") for (int _i = 0; _i < 2; ++_i) \
        __builtin_amdgcn_global_load_lds((const unsigned*)((const char*)(gbase) + (voff)[_i]), (LAS unsigned*)(lds + (bufoff) + ldsw + _i * 8192), 16, 0, 0); } while (0)
#define PG8_LDA(dst, b, h) do { _Pragma("unroll") for (int m = 0; m < 4; ++m) _Pragma("unroll") for (int k = 0; k < 2; ++k) dst[m][k] = *(const LAS bf16x8*)(lds + PG8_SA(b, h) + aoff + m * 2048 + k * 1024); } while (0)
#define PG8_LDB(dst, b, h) do { _Pragma("unroll") for (int n = 0; n < 2; ++n) _Pragma("unroll") for (int k = 0; k < 2; ++k) dst[n][k] = *(const LAS bf16x8*)(lds + PG8_SB(b, h) + boff + n * 2048 + k * 1024); } while (0)
#define PG8_MMA(ai, bj, At, Bt) do { __builtin_amdgcn_s_setprio(1); _Pragma("unroll") for (int m = 0; m < 4; ++m) _Pragma("unroll") for (int n = 0; n < 2; ++n) _Pragma("unroll") for (int k = 0; k < 2; ++k) \
        acc[ai][bj][m][n] = __builtin_amdgcn_mfma_f32_16x16x32_bf16(Bt[n][k], At[m][k], acc[ai][bj][m][n], 0, 0, 0); __builtin_amdgcn_s_setprio(0); } while (0)
#define PG8_WAIT_V(n) asm volatile("s_waitcnt vmcnt(" #n ")" ::: "memory")
#define PG8_WAIT_L(n) asm volatile("s_waitcnt lgkmcnt(" #n ")" ::: "memory")
#define PG8_BAR __builtin_amdgcn_s_barrier()
#define PG8_SCHED __builtin_amdgcn_sched_barrier(0)
    Unit cur, nxt; int ui = 0;
    if (!S.next(0, cur)) return;
    f32x4 acc[2][2][4][2];
#pragma unroll
    for (int a = 0; a < 2; ++a)
#pragma unroll
        for (int b = 0; b < 2; ++b)
#pragma unroll
            for (int m = 0; m < 4; ++m)
#pragma unroll
                for (int n = 0; n < 2; ++n) acc[a][b][m][n] = (f32x4){0.f, 0.f, 0.f, 0.f};
    bf16x8 At[4][2], B0[2][2], B1[2][2];
    const char* cA = (const char*)g.A + (size_t)cur.pm * tstep; const char* cB = (const char*)g.Bt + (size_t)cur.pn * tstep;
    PG8_STAGE(PG8_SB(0, 0), cB, voffB); PG8_STAGE(PG8_SA(0, 0), cA, voffA); PG8_STAGE(PG8_SB(0, 1), cB + hstep, voffB); PG8_STAGE(PG8_SA(0, 1), cA + hstep, voffA);
    if (wr == 1) PG8_BAR;
    PG8_WAIT_V(4); PG8_BAR;
    PG8_STAGE(PG8_SB(1, 0), cB + kstep, voffB); PG8_STAGE(PG8_SA(1, 0), cA + kstep, voffA); PG8_STAGE(PG8_SB(1, 1), cB + hstep + kstep, voffB);
    PG8_WAIT_V(6); PG8_BAR;
    for (;;) {
        const bool has_next = S.next(ui + 1, nxt);
        const char* nA = has_next ? (const char*)g.A + (size_t)nxt.pm * tstep : cA; const char* nB = has_next ? (const char*)g.Bt + (size_t)nxt.pn * tstep : cB;
        for (int t = 0; t < nt; t += 2) {
            const bool last = (t == nt - 2);
            const char* a1 = cA + (size_t)(t + 1) * kstep;
            const char* a2 = last ? nA : cA + (size_t)(t + 2) * kstep; const char* b2 = last ? nB : cB + (size_t)(t + 2) * kstep;
            const char* a3 = a2 + kstep; const char* b3 = b2 + kstep;
            PG8_LDB(B0, 0, 0); PG8_SCHED; PG8_LDA(At, 0, 0); PG8_STAGE(PG8_SA(1, 1), a1 + hstep, voffA);
            PG8_WAIT_L(8); PG8_BAR; PG8_WAIT_L(0); PG8_MMA(0, 0, At, B0); PG8_BAR; PG8_SCHED;
            PG8_LDB(B1, 0, 1); PG8_STAGE(PG8_SB(0, 0), b2, voffB);
            PG8_BAR; PG8_WAIT_L(0); PG8_MMA(0, 1, At, B1); PG8_BAR;
            PG8_LDA(At, 0, 1); PG8_STAGE(PG8_SA(0, 0), a2, voffA);
            PG8_BAR; PG8_WAIT_L(0); PG8_MMA(1, 0, At, B0); PG8_BAR; PG8_SCHED;
            PG8_STAGE(PG8_SB(0, 1), b2 + hstep, voffB);
            PG8_WAIT_V(6); PG8_BAR; PG8_MMA(1, 1, At, B1); PG8_BAR;
            PG8_LDB(B0, 1, 0); PG8_SCHED; PG8_LDA(At, 1, 0); PG8_STAGE(PG8_SA(0, 1), a2 + hstep, voffA);
            PG8_WAIT_L(8); PG8_BAR; PG8_WAIT_L(0); PG8_MMA(0, 0, At, B0); PG8_BAR; PG8_SCHED;
            PG8_LDB(B1, 1, 1); PG8_STAGE(PG8_SB(1, 0), b3, voffB);
            PG8_BAR; PG8_WAIT_L(0); PG8_MMA(0, 1, At, B1); PG8_BAR;
            PG8_LDA(At, 1, 1); PG8_STAGE(PG8_SA(1, 0), a3, voffA);
            PG8_BAR; PG8_WAIT_L(0); PG8_MMA(1, 0, At, B0); PG8_BAR; PG8_SCHED;
            PG8_STAGE(PG8_SB(1, 1), b3 + hstep, voffB);
            PG8_WAIT_V(6); PG8_BAR; PG8_MMA(1, 1, At, B1); PG8_BAR;
        }
        E(acc, cur, wr, wc, fr, fq);
        if (!has_next) break;
#pragma unroll
        for (int a = 0; a < 2; ++a)
#pragma unroll
            for (int b = 0; b < 2; ++b)
#pragma unroll
                for (int m = 0; m < 4; ++m)
#pragma unroll
                    for (int n = 0; n < 2; ++n) acc[a][b][m][n] = (f32x4){0.f, 0.f, 0.f, 0.f};
        cur = nxt; cA = nA; cB = nB; ++ui;
    }
    PG8_WAIT_V(0);
    if (wr == 0) PG8_BAR;
    PG8_BAR;
#undef PG8_SA
#undef PG8_SB
#undef PG8_STAGE
#undef PG8_LDA
#undef PG8_LDB
#undef PG8_MMA
#undef PG8_WAIT_V
#undef PG8_WAIT_L
#undef PG8_BAR
#undef PG8_SCHED
}
}

struct EpiProj {
    static constexpr bool PERM = true;
    bf16_t* O; int ldc; LAS const float* rl; int pm0, pm1, pm2, pm3;
    __device__ __forceinline__ void operator()(const f32x4 (&acc)[2][2][4][2], const pg8::Unit& u, int wr, int wc, int fr, int fq) const {
        const int row0 = u.pm * 256 + wr * 64 + fr, col0 = u.pn * 256 + wc * 32 + 8 * fq;
        const int sel = u.pm == pm0 ? 0 : (u.pm == pm1 ? 1 : (u.pm == pm2 ? 2 : 3));
        LAS const float* rp = rl + sel * 256 + wr * 64 + fr;
#pragma unroll
        for (int ai = 0; ai < 2; ++ai)
#pragma unroll
            for (int m = 0; m < 4; ++m) {
                const int row = row0 + ai * 128 + m * 16;
                const float rstd = rp[ai * 128 + m * 16];
                bf16_t* rowp = O + (size_t)row * ldc + col0;
#pragma unroll
                for (int bj = 0; bj < 2; ++bj) {
                    const f32x4 v0 = acc[ai][bj][m][0] * rstd, v1 = acc[ai][bj][m][1] * rstd;
                    u32x4 w; w.x = cvt_pk_bf16(v0[0], v0[1]); w.y = cvt_pk_bf16(v0[2], v0[3]); w.z = cvt_pk_bf16(v1[0], v1[1]); w.w = cvt_pk_bf16(v1[2], v1[3]);
                    *(u32x4*)(rowp + bj * 128) = w;
                }
            }
    }
};
struct X8 { f32x4 lo, hi; };
template <bool FIRST> __device__ __forceinline__ X8 ld_x8(const float* __restrict__ s32, const bf16_t* __restrict__ s16, size_t o) {
    X8 r;
    if (FIRST) { r.lo = *(const f32x4*)(s32 + o); r.hi = *(const f32x4*)(s32 + o + 4); }
    else { const u32x4 u = *(const u32x4*)(s16 + o); r.lo = cvt4((u32x2){u.x, u.y}); r.hi = cvt4((u32x2){u.z, u.w}); }
    return r;
}
__device__ __forceinline__ void st_x8(bf16_t* p, f32x4 lo, f32x4 hi) { u32x4 w; w.x = cvt_pk_bf16(lo[0], lo[1]); w.y = cvt_pk_bf16(lo[2], lo[3]); w.z = cvt_pk_bf16(hi[0], hi[1]); w.w = cvt_pk_bf16(hi[2], hi[3]); *(u32x4*)p = w; }
template <bool FIRST>
__device__ __forceinline__ void epi_res_rows(const f32x4 (&acc)[2][2][4][2], const float* __restrict__ src32, const bf16_t* __restrict__ src16, bf16_t* __restrict__ Xb, float* __restrict__ ssqp,
                                             int row0, int col0, int slot, int fq) {
    if constexpr (FIRST) {
#pragma unroll
        for (int ai = 0; ai < 2; ++ai) {
            X8 x[4][2];
#pragma unroll
            for (int m = 0; m < 4; ++m)
#pragma unroll
                for (int bj = 0; bj < 2; ++bj) x[m][bj] = ld_x8<true>(src32, src16, (size_t)(row0 + ai * 128 + m * 16) * 1024 + col0 + bj * 128);
#pragma unroll
            for (int m = 0; m < 4; ++m) {
                const int row = row0 + ai * 128 + m * 16;
                float part = 0.f;
#pragma unroll
                for (int bj = 0; bj < 2; ++bj) {
                    const f32x4 lo = x[m][bj].lo + acc[ai][bj][m][0], hi = x[m][bj].hi + acc[ai][bj][m][1];
                    st_x8(Xb + (size_t)row * 1024 + col0 + bj * 128, lo, hi);
                    part += dot4(lo, lo) + dot4(hi, hi);
                }
                part += __shfl_xor(part, 16); part += __shfl_xor(part, 32);
                if (fq == 0) ssqp[(size_t)row * 16 + slot] = part;
            }
        }
    } else {
        u32x4 xr[2][4][2];
#pragma unroll
        for (int ai = 0; ai < 2; ++ai)
#pragma unroll
            for (int m = 0; m < 4; ++m)
#pragma unroll
                for (int bj = 0; bj < 2; ++bj) xr[ai][m][bj] = *(const u32x4*)(src16 + (size_t)(row0 + ai * 128 + m * 16) * 1024 + col0 + bj * 128);
#pragma unroll
        for (int ai = 0; ai < 2; ++ai)
#pragma unroll
            for (int m = 0; m < 4; ++m) {
                const int row = row0 + ai * 128 + m * 16;
                float part = 0.f;
#pragma unroll
                for (int bj = 0; bj < 2; ++bj) {
                    const u32x4 u = xr[ai][m][bj];
                    const f32x4 lo = cvt4((u32x2){u.x, u.y}) + acc[ai][bj][m][0], hi = cvt4((u32x2){u.z, u.w}) + acc[ai][bj][m][1];
                    st_x8(Xb + (size_t)row * 1024 + col0 + bj * 128, lo, hi);
                    part += dot4(lo, lo) + dot4(hi, hi);
                }
                part += __shfl_xor(part, 16); part += __shfl_xor(part, 32);
                if (fq == 0) ssqp[(size_t)row * 16 + slot] = part;
            }
    }
}
struct EpiRes {
    static constexpr bool PERM = true;
    const float* xp; const float* xs; bf16_t* Xb; float* ssq_next;
    __device__ __forceinline__ void operator()(const f32x4 (&acc)[2][2][4][2], const pg8::Unit& u, int wr, int wc, int fr, int fq) const {
        const int row0 = u.pm * 256 + wr * 64 + fr, col0 = u.pn * 256 + wc * 32 + 8 * fq;
        if (xp) epi_res_rows<true>(acc, row0 < NTP ? xp : xs - (size_t)NTP * 1024, nullptr, Xb, ssq_next, row0, col0, u.pn * 4 + wc, fq);
        else epi_res_rows<false>(acc, nullptr, Xb, Xb, ssq_next, row0, col0, u.pn * 4 + wc, fq);
    }
};

template <bool FIRST>
__device__ __forceinline__ void res_sample_tile(const Ctx cx, const bf16_t* __restrict__ A, const bf16_t* __restrict__ Bt, const float* __restrict__ xs, bf16_t* __restrict__ Xb, float* __restrict__ ssqp, int tile) {
    const int tid = cx.tid, wid = tid >> 6, lane = tid & 63, fr = lane & 15, fq = lane >> 4;
    const int tm = tile >> 3, tn = tile & 7;
    const int r0 = NTP + tm * 64 + (wid & 3) * 16, c0 = tn * 128 + (wid >> 2) * 64;
    const bf16_t* ap = A + (size_t)(r0 + fr) * 1024 + fq * 8;
    const bf16_t* bp = Bt + (size_t)(c0 + fr) * 1024 + fq * 8;
    f32x4 acc[4];
#pragma unroll
    for (int nt = 0; nt < 4; ++nt) acc[nt] = (f32x4){0.f, 0.f, 0.f, 0.f};
#pragma unroll 8
    for (int ks = 0; ks < 32; ++ks) {
        const bf16x8 af = *(const bf16x8*)(ap + ks * 32);
#pragma unroll
        for (int nt = 0; nt < 4; ++nt) {
            const bf16x8 bf = *(const bf16x8*)(bp + (size_t)nt * 16 * 1024 + ks * 32);
            acc[nt] = __builtin_amdgcn_mfma_f32_16x16x32_bf16(bf, af, acc[nt], 0, 0, 0);
        }
    }
    const int row = r0 + fr;
    float part = 0.f;
#pragma unroll
    for (int nt = 0; nt < 4; ++nt) {
        const int col = c0 + nt * 16 + fq * 4;
        const f32x4 xo = FIRST ? *(const f32x4*)(xs + (size_t)(row - NTP) * 1024 + col) : ld_bf4(Xb + (size_t)row * 1024 + col);
        const f32x4 v = xo + acc[nt];
        st_bf4(Xb + (size_t)row * 1024 + col, v);
        part += dot4(v, v);
    }
    part += __shfl_xor(part, 16); part += __shfl_xor(part, 32);
    if (fq == 0) ssqp[(size_t)row * 16 + (c0 >> 6)] = part;
}

struct TrJob { const float* src; int ld, col0, k0; bf16_t* dst; int Ktot, drow0; const float* scale; bool zero; };
__device__ __forceinline__ TrJob tr_decode(const Params& p, const Ctx cx, int job) {
    TrJob J; J.zero = false; J.scale = nullptr;
    int j = job;
    if (j < 2176) {
        const int i = j / 1088, r = j % 1088, nt = r / 16, kt = r % 16, n0 = nt * 64;
        int col0 = 0;
        if (n0 < 2048) col0 = n0; else if (n0 < 2560) col0 = 3712 + (n0 - 2048); else if (n0 < 4224) col0 = 2048 + (n0 - 2560); else J.zero = true;
        J.src = PIN(I_WINE) + (size_t)i * 1024 * 4224; J.ld = 4224; J.col0 = col0; J.k0 = kt * 64; J.dst = (bf16_t*)(PWS + WS_WINE) + (size_t)i * 4352 * 1024; J.Ktot = 1024; J.drow0 = n0; J.scale = PIN(I_NORMW) + (2 * i) * 1024;
        return J;
    }
    j -= 2176;
    if (j < 512) { const int i = j / 256, r = j % 256, nt = r / 16, kt = r % 16;
        J.src = PIN(I_WOUTE) + (size_t)i * 1024 * 1024; J.ld = 1024; J.col0 = nt * 64; J.k0 = kt * 64; J.dst = (bf16_t*)(PWS + WS_WOUTE) + (size_t)i * 1024 * 1024; J.Ktot = 1024; J.drow0 = nt * 64; return J; }
    j -= 512;
    if (j < 1280) { const int i = j / 640, r = j % 640, nt = r / 16, kt = r % 16;
        J.src = PIN(I_WINO) + (size_t)i * 1024 * 2560; J.ld = 2560; J.col0 = nt * 64; J.k0 = kt * 64; J.dst = (bf16_t*)(PWS + WS_WINO) + (size_t)i * 2560 * 1024; J.Ktot = 1024; J.drow0 = nt * 64; J.scale = PIN(I_NORMW) + (2 * i + 1) * 1024; return J; }
    j -= 1280;
    if (j < 512) { const int i = j / 256, r = j % 256, nt = r / 16, kt = r % 16;
        J.src = PIN(I_WOUTO) + (size_t)i * 1024 * 1024; J.ld = 1024; J.col0 = nt * 64; J.k0 = kt * 64; J.dst = (bf16_t*)(PWS + WS_WOUTO) + (size_t)i * 1024 * 1024; J.Ktot = 1024; J.drow0 = nt * 64; return J; }
    j -= 512;
    if (j < 16) { const int i = j / 8, nt = j % 8;
        J.src = PIN(I_W2) + (size_t)i * 64 * 512; J.ld = 512; J.col0 = nt * 64; J.k0 = 0; J.dst = (bf16_t*)(PWS + WS_W2T) + (size_t)i * 512 * 64; J.Ktot = 64; J.drow0 = nt * 64; return J; }
    j -= 16;
    if (j < 16) { const int i = j / 8, nt = j % 8;
        J.src = PIN(I_A2) + (size_t)i * 64 * 512; J.ld = 512; J.col0 = nt * 64; J.k0 = 0; J.dst = (bf16_t*)(PWS + WS_A2T) + (size_t)i * 512 * 64; J.Ktot = 64; J.drow0 = nt * 64; return J; }
    j -= 16;
    { const int ig = j / 4, r = j % 4, nt = r / 2, kt = r % 2;
        J.src = PIN(I_POOLW) + (size_t)ig * 128 * 128; J.ld = 128; J.col0 = nt * 64; J.k0 = kt * 64; J.dst = (bf16_t*)(PWS + WS_POOLWT) + (size_t)ig * 128 * 128; J.Ktot = 128; J.drow0 = nt * 64; }
    return J;
}
__device__ __forceinline__ void tr_load(const TrJob& J, int tid, f32x4& va, f32x4& vb) {
    const int nn = (tid & 15) * 4, ka = tid >> 4, kb = ka + 32;
    va = (f32x4){0.f, 0.f, 0.f, 0.f}; vb = va;
    if (!J.zero) {
        va = *(const f32x4*)(J.src + (size_t)(J.k0 + ka) * J.ld + J.col0 + nn); vb = *(const f32x4*)(J.src + (size_t)(J.k0 + kb) * J.ld + J.col0 + nn);
        if (J.scale) { va = va * J.scale[J.k0 + ka]; vb = vb * J.scale[J.k0 + kb]; }
    }
}

__device__ void phase_prepass(const Params& p, const Ctx cx, LAS unsigned char* lds) {
    LAS float* T = (LAS float*)lds;
    const int tid = cx.tid;
    {
        int job = cx.bid;
        f32x4 va = (f32x4){0.f, 0.f, 0.f, 0.f}, vb = va;
        if (job < 4544) { const TrJob J0 = tr_decode(p, cx, job); tr_load(J0, tid, va, vb); }
        for (; job < 4544; job += cx.nblk) {
            f32x4 na = va, nb = vb;
            if (job + (int)cx.nblk < 4544) { const TrJob Jn = tr_decode(p, cx, job + (int)cx.nblk); tr_load(Jn, tid, na, nb); }
            {
                const int nn = (tid & 15) * 4, ka = tid >> 4, kb = ka + 32;
                T[ka * 65 + nn] = va[0]; T[ka * 65 + nn + 1] = va[1]; T[ka * 65 + nn + 2] = va[2]; T[ka * 65 + nn + 3] = va[3];
                T[kb * 65 + nn] = vb[0]; T[kb * 65 + nn + 1] = vb[1]; T[kb * 65 + nn + 2] = vb[2]; T[kb * 65 + nn + 3] = vb[3];
            }
            __syncthreads();
            {
                const TrJob J = tr_decode(p, cx, job);
                const int n = tid >> 3, kc = (tid & 7) * 8;
                u32x4 w;
                w.x = cvt_pk_bf16(T[(kc + 0) * 65 + n], T[(kc + 1) * 65 + n]); w.y = cvt_pk_bf16(T[(kc + 2) * 65 + n], T[(kc + 3) * 65 + n]);
                w.z = cvt_pk_bf16(T[(kc + 4) * 65 + n], T[(kc + 5) * 65 + n]); w.w = cvt_pk_bf16(T[(kc + 6) * 65 + n], T[(kc + 7) * 65 + n]);
                *(u32x4*)(J.dst + (size_t)(J.drow0 + n) * J.Ktot + J.k0 + kc) = w;
            }
            __syncthreads();
            va = na; vb = nb;
        }
    }
    const int gtid = cx.bid * 512 + tid, gthreads = cx.nblk * 512;
    for (int e = gtid; e < 8 * 128 * 128; e += gthreads) {
        const int s = e & 127, t = (e >> 7) & 127;
        ((bf16_t*)(PWS + WS_SPW))[e] = (s <= t) ? (bf16_t)(cvt_pk_bf16(PIN(I_SPW)[e], 0.f) & 0xffffu) : (bf16_t)0;
    }
    const int wid = tid >> 6, lane = tid & 63;
    for (int row0 = cx.bid * 8 + wid; row0 < NTOK; row0 += cx.nblk * 8 * 3) {
        f32x4 v[3][4];
#pragma unroll
        for (int r = 0; r < 3; ++r) {
            const int row = row0 + r * cx.nblk * 8; const int rr = row < NTOK ? row : row0;
            const float* src = rr < NTP ? PIN(I_XP) + (size_t)rr * 1024 : PIN(I_XS) + (size_t)(rr - NTP) * 1024;
#pragma unroll
            for (int i = 0; i < 4; ++i) v[r][i] = *(const f32x4*)(src + i * 256 + lane * 4);
        }
#pragma unroll
        for (int r = 0; r < 3; ++r) {
            const int row = row0 + r * cx.nblk * 8;
            if (row < NTOK) {
                bf16_t* dst = (bf16_t*)(PWS + WS_XB) + (size_t)row * 1024;
                float ss = 0.f;
#pragma unroll
                for (int i = 0; i < 4; ++i) { ss += dot4(v[r][i], v[r][i]); st_bf4(dst + i * 256 + lane * 4, v[r][i]); }
#pragma unroll
                for (int o = 32; o >= 1; o >>= 1) ss += __shfl_xor(ss, o);
                if (lane < 16) ((float*)(PWS + WS_SSQ))[(size_t)row * 16 + lane] = (lane == 0) ? ss : 0.f;
            }
        }
    }
}

__device__ __forceinline__ f32x4 shift4(const bf16_t* cur, bool hp, const float* st, int col, const float* mu) {
    const f32x4 q = ld_bf4(cur + col);
    f32x4 pv;
    if (hp) pv = ld_bf4(cur - LDB + col); else if (st) pv = *(const f32x4*)(st + col); else pv = (f32x4){0.f, 0.f, 0.f, 0.f};
    const f32x4 m = *(const f32x4*)(mu + col);
    return q + m * (pv - q);
}

__device__ void phase_even_prep(const Params& p, const Ctx cx, int pair, LAS unsigned char* lds) {
    const int tid = cx.tid, wid = tid >> 6, lane = tid & 63, fr = lane & 15, fq = lane >> 4;
    const bf16_t* PB = (const bf16_t*)(PWS + WS_PROJB);
    float* Wdec = (float*)(PWS + WS_WDEC);
    bf16_t* Aa = (bf16_t*)(PWS + WS_AA);
    bf16_t* Ycat = (bf16_t*)(PWS + WS_YCAT);
    const float* mu_ = PIN(I_MU) + pair * 1664;
    const float* w0_ = PIN(I_W0) + pair * 512; const float* a0_ = PIN(I_A0) + pair * 512;
    const float* k_a_ = PIN(I_KA) + pair * 512; const float* r_k_ = PIN(I_RK) + pair * 512;
    constexpr int RS = 3344;
    constexpr int TB = 17 * RS;
    constexpr int NCH = 17 * 208;
    const int h = wid;
    bf16x8 wfr[4][2], afr[4][2];
    {
        const bf16_t* W2T = (const bf16_t*)(PWS + WS_W2T) + (size_t)pair * 512 * 64;
        const bf16_t* A2T = (const bf16_t*)(PWS + WS_A2T) + (size_t)pair * 512 * 64;
#pragma unroll
        for (int nt = 0; nt < 4; ++nt)
#pragma unroll
            for (int ks = 0; ks < 2; ++ks) {
                wfr[nt][ks] = *(const bf16x8*)(W2T + (size_t)(h * 64 + nt * 16 + fr) * 64 + ks * 32 + fq * 8);
                afr[nt][ks] = *(const bf16x8*)(A2T + (size_t)(h * 64 + nt * 16 + fr) * 64 + ks * 32 + fq * 8);
            }
    }
    constexpr int TBD = 56 * 1024;
    const int widu = __builtin_amdgcn_readfirstlane(tid >> 6);
#define PREP_DMA(tile_, b_, lane_) do { _Pragma("unroll") for (int i_ = 0; i_ < 7; ++i_) { const int k_ = widu * 7 + i_, q_ = k_ * 64 + (lane_); \
            int lr_ = q_ / 209, cc_ = q_ - lr_ * 209; if (lr_ > 16) { lr_ = 16; cc_ = 0; } if (cc_ > 207) cc_ = 0; \
            int gr_ = (tile_) * 16 - 1 + lr_; gr_ = gr_ < 0 ? 0 : gr_; \
            __builtin_amdgcn_global_load_lds((const unsigned*)(PB + (size_t)gr_ * LDB + cc_ * 8), (LAS unsigned*)(lds + (b_) * TBD + k_ * 1024), 16, 0, 0); } } while (0)
    LAS float* CL = (LAS float*)(lds + 2 * TBD);
    {
        const float f0 = mu_[tid], f1 = mu_[tid + 512], f2 = mu_[tid + 1024], f3 = tid < 128 ? mu_[tid + 1536] : 0.f;
        const float f4 = w0_[tid], f5 = a0_[tid], f6 = k_a_[tid], f7 = r_k_[tid];
        CL[tid] = f0; CL[tid + 512] = f1; CL[tid + 1024] = f2; if (tid < 128) CL[tid + 1536] = f3;
        CL[1664 + tid] = f4; CL[2176 + tid] = f5; CL[2688 + tid] = f6; CL[3200 + tid] = f7;
    }
    int buf = 0;
    if ((int)cx.bid < NTOK / 16) PREP_DMA((int)cx.bid, 0, tid & 63);
    asm volatile("s_waitcnt vmcnt(0)" ::: "memory");
    __syncthreads();
    for (int tile = cx.bid; tile < NTOK / 16; tile += cx.nblk) {
        int zz; asm volatile("v_mov_b32 %0, 0" : "=v"(zz));
        const int tidv = tid + zz, fr = (tidv & 15), fq = (tidv >> 4) & 3;
        if (tile + (int)cx.nblk < NTOK / 16) PREP_DMA(tile + (int)cx.nblk, buf ^ 1, tidv & 63);
        {
            const int row = tile * 16 + fr;
            const bool samp = row >= NTP;
            int b, t; if (!samp) { b = row >> 11; t = row & 2047; } else { const int q = row - NTP; b = q >> 3; t = q & 7; }
            const bool hp = t > 0;
            const float* st = samp ? PIN(I_SSHIFT) + ((size_t)pair * 128 + b) * 1664 : nullptr;
            LAS const float* mu = CL; LAS const float* w0 = CL + 1664; LAS const float* a0 = CL + 2176; LAS const float* k_a = CL + 2688; LAS const float* r_k = CL + 3200;
            LAS const unsigned char* curL = lds + buf * TBD + (fr + 1) * RS;
            LAS const unsigned char* prvL = lds + buf * TBD + fr * RS;
            auto sh4 = [&](int col) -> f32x4 {
                const f32x4 q = cvt4(*(LAS const u32x2*)(curL + col * 2));
                f32x4 pv;
                if (hp) pv = cvt4(*(LAS const u32x2*)(prvL + col * 2)); else if (st) pv = *(const f32x4*)(st + col); else pv = (f32x4){0.f, 0.f, 0.f, 0.f};
                const f32x4 m = *(LAS const f32x4*)(mu + col);
                return q + m * (pv - q);
            };
            bf16x8 Aw[2], Al[2];
#pragma unroll
            for (int ks = 0; ks < 2; ++ks) {
                const int cw = 1536 + ks * 32 + fq * 8, ca = 1600 + ks * 32 + fq * 8;
                const f32x4 w_lo = sh4(cw), w_hi = sh4(cw + 4), a_lo = sh4(ca), a_hi = sh4(ca + 4);
                u32x4 pw, pa;
                float th[8];
#pragma unroll
                for (int j = 0; j < 4; ++j) { th[j] = 2.0f * sigmoidf_(2.0f * w_lo[j]) - 1.0f; th[4 + j] = 2.0f * sigmoidf_(2.0f * w_hi[j]) - 1.0f; }
                pw.x = cvt_pk_bf16(th[0], th[1]); pw.y = cvt_pk_bf16(th[2], th[3]); pw.z = cvt_pk_bf16(th[4], th[5]); pw.w = cvt_pk_bf16(th[6], th[7]);
                pa.x = cvt_pk_bf16(a_lo[0], a_lo[1]); pa.y = cvt_pk_bf16(a_lo[2], a_lo[3]); pa.z = cvt_pk_bf16(a_hi[0], a_hi[1]); pa.w = cvt_pk_bf16(a_hi[2], a_hi[3]);
                Aw[ks] = __builtin_bit_cast(bf16x8, pw); Al[ks] = __builtin_bit_cast(bf16x8, pa);
            }
            float bon = 0.f;
#pragma unroll
            for (int nt = 0; nt < 4; ++nt) {
                f32x4 lw = (f32x4){0.f, 0.f, 0.f, 0.f}, la = (f32x4){0.f, 0.f, 0.f, 0.f};
#pragma unroll
                for (int ks = 0; ks < 2; ++ks) {
                    lw = __builtin_amdgcn_mfma_f32_16x16x32_bf16(wfr[nt][ks], Aw[ks], lw, 0, 0, 0);
                    la = __builtin_amdgcn_mfma_f32_16x16x32_bf16(afr[nt][ks], Al[ks], la, 0, 0, 0);
                }
                const int ch = h * 64 + nt * 16 + fq * 4;
                const f32x4 r4 = sh4(ch), k4 = sh4(512 + ch);
                const f32x4 w04 = *(LAS const f32x4*)(w0 + ch), a04 = *(LAS const f32x4*)(a0 + ch), ka4 = *(LAS const f32x4*)(k_a + ch), rk4 = *(LAS const f32x4*)(r_k + ch);
                f32x4 dec, av;
#pragma unroll
                for (int j = 0; j < 4; ++j) {
                    const float z_ = -(w04[j] + lw[j]);
                    const float wlog = -__logf(1.0f + __expf(z_)) - 0.5f;
                    dec[j] = __expf(-__expf(wlog));
                    av[j] = sigmoidf_(a04[j] + la[j]);
                    const float kp = k4[j] * (1.0f + (av[j] - 1.0f) * ka4[j]);
                    bon += r4[j] * kp * rk4[j];
                }
                *(f32x4*)(Wdec + (size_t)row * 512 + ch) = dec;
                st_bf4(Aa + (size_t)row * 512 + ch, av);
            }
            bon += __shfl_xor(bon, 16); bon += __shfl_xor(bon, 32);
#pragma unroll
            for (int nt = 0; nt < 4; ++nt) { const int ch = h * 64 + nt * 16 + fq * 4; st_bf4(Ycat + (size_t)row * 1024 + 512 + ch, sh4(1024 + ch) * bon); }
        }
        asm volatile("s_waitcnt vmcnt(0)" ::: "memory");
        __syncthreads();
        buf ^= 1;
    }
#undef PREP_DMA
    const int gtid = cx.bid * 512 + tid, gthreads = cx.nblk * 512;
    for (int e = gtid; e < 136 * 1664; e += gthreads) {
        const int sr = e / 1664, c = e % 1664;
        if (sr < 8) POUT[O_SHIFTP + ((size_t)pair * 8 + sr) * 1664 + c] = bf2f(PB[(size_t)(sr * 2048 + 2047) * LDB + c]);
        else { const int b = sr - 8; POUT[O_SHIFTS + ((size_t)pair * 128 + b) * 1664 + c] = bf2f(PB[(size_t)(NTP + b * 8 + 7) * LDB + c]); }
    }
}

typedef float f32x2 __attribute__((ext_vector_type(2)));
template <bool RED = true>
__device__ __forceinline__ void scan_step(f32x4& S, const f32x4 w, const f32x4 k, const f32x4 kk, const f32x4 nb, const f32x4 r, const float v, float& y) {
    const f32x2 S01 = {S[0], S[1]}, S23 = {S[2], S[3]};
    f32x2 pp = S01 * (f32x2){kk[0], kk[1]};
    pp = S23 * (f32x2){kk[2], kk[3]} + pp;
    float pd = pp[0] + pp[1];
    const f32x2 vv = {v, v};
    const f32x2 t01 = S01 * (f32x2){w[0], w[1]} + (f32x2){k[0], k[1]} * vv;
    const f32x2 t23 = S23 * (f32x2){w[2], w[3]} + (f32x2){k[2], k[3]} * vv;
    pd = allsum16(pd);
    const f32x2 pdv = {pd, pd};
    const f32x2 n01 = (f32x2){nb[0], nb[1]} * pdv + t01, n23 = (f32x2){nb[2], nb[3]} * pdv + t23;
    S = (f32x4){n01[0], n01[1], n23[0], n23[1]};
    f32x2 q = n01 * (f32x2){r[0], r[1]};
    q = n23 * (f32x2){r[2], r[3]} + q;
    y = RED ? allsum16(q[0] + q[1]) : (q[0] + q[1]);
}
__device__ __forceinline__ float reduce_scatter16(const float (&yp)[16], int cgi) {
    const bool b3 = cgi & 8, b2 = cgi & 4, b1 = cgi & 2, b0 = cgi & 1;
    float a[8], bq[4], c[2];
#pragma unroll
    for (int j = 0; j < 8; ++j) { const float keep = b3 ? yp[8 + j] : yp[j], send = b3 ? yp[j] : yp[8 + j]; a[j] = keep + dpp_f<0x128>(send); }
#pragma unroll
    for (int k = 0; k < 4; ++k) { const float keep = b2 ? a[4 + k] : a[k], send = b2 ? a[k] : a[4 + k]; bq[k] = keep + dpp_f<0x141>(send); }
#pragma unroll
    for (int m = 0; m < 2; ++m) { const float keep = b1 ? bq[2 + m] : bq[m], send = b1 ? bq[m] : bq[2 + m]; c[m] = keep + dpp_f<0x4E>(send); }
    const float keep = b0 ? c[1] : c[0], send = b0 ? c[0] : c[1];
    return keep + dpp_f<0xB1>(send);
}

__device__ void phase_scan(const Params& p, const Ctx cx, int pair, LAS unsigned char* lds) {
    const int tid = cx.tid, wid = tid >> 6, lane = tid & 63, rs = lane >> 4, cgi = lane & 15;
    const bf16_t* PB = (const bf16_t*)(PWS + WS_PROJB);
    const float* Wdec = (const float*)(PWS + WS_WDEC);
    const bf16_t* Aa = (const bf16_t*)(PWS + WS_AA);
    float* Y = (float*)(PWS + WS_Y);
    const float* mu = PIN(I_MU) + pair * 1664;
    const float* k_k = PIN(I_KK) + pair * 512; const float* k_a = PIN(I_KA) + pair * 512;
    {
        LAS float* vb = (LAS float*)lds + wid * 3072;
        for (int st = cx.bid * 8 + wid; st < 2048; st += cx.nblk * 8) {
            const int bh = st >> 1, half = st & 1, b = bh >> 3, h = bh & 7, ch = h * 64 + cgi * 4;
            const float* stp = PIN(I_SSHIFT) + ((size_t)pair * 128 + b) * 1664;
            const f32x4 kkc = *(const f32x4*)(k_k + ch), kac = *(const f32x4*)(k_a + ch);
            {
#pragma unroll
                for (int tt = 0; tt < 2; ++tt) {
                    const int t = rs + tt * 4;
                    const size_t row = NTP + b * 8 + t;
                    const bf16_t* cur = PB + row * LDB;
                    const f32x4 r = shift4(cur, t > 0, stp, ch, mu), k = shift4(cur, t > 0, stp, 512 + ch, mu), v = shift4(cur, t > 0, stp, 1024 + ch, mu);
                    const f32x4 a = ld_bf4(Aa + row * 512 + ch);
                    const f32x4 w = *(const f32x4*)(Wdec + row * 512 + ch);
                    const f32x4 kkv = k * kkc;
                    const float ss = allsum16(dot4(kkv, kkv));
                    const float inv = 1.0f / fmaxf(sqrtf(ss), 1e-12f);
                    const f32x4 kkn = kkv * inv;
                    LAS float* o = vb + t * 384 + cgi * 4;
                    *(LAS f32x4*)(o) = w; *(LAS f32x4*)(o + 64) = k * (1.0f + (a - 1.0f) * kac); *(LAS f32x4*)(o + 128) = kkn; *(LAS f32x4*)(o + 192) = -(kkn * a);
                    *(LAS f32x4*)(o + 256) = r; *(LAS f32x4*)(o + 320) = v;
                }
            }
            asm volatile("s_waitcnt lgkmcnt(0)" ::: "memory");
            __builtin_amdgcn_wave_barrier();
            const size_t so0 = ((((size_t)pair * 128 + b) * 8 + h) * 64 + half * 32 + rs) * 64 + cgi * 4;
            f32x4 Snext = *(const f32x4*)(PIN(I_SWKV) + so0);
#pragma unroll 1
            for (int rq = 0; rq < 8; ++rq) {
                const int ri = half * 32 + rq * 4 + rs;
                const size_t so = so0 + (size_t)rq * 256;
                f32x4 S = Snext;
                if (rq + 1 < 8) Snext = *(const f32x4*)(PIN(I_SWKV) + so + 256);
#pragma unroll
                for (int t = 0; t < 8; ++t) {
                    LAS const float* r0 = vb + t * 384 + cgi * 4;
                    float y; scan_step(S, *(LAS const f32x4*)(r0), *(LAS const f32x4*)(r0 + 64), *(LAS const f32x4*)(r0 + 128), *(LAS const f32x4*)(r0 + 192), *(LAS const f32x4*)(r0 + 256), vb[t * 384 + 320 + ri], y);
                    if (cgi == 0) Y[(size_t)(NTP + b * 8 + t) * 512 + h * 64 + ri] = y;
                }
                *(f32x4*)(POUT + O_WKVS + so) = S;
            }
            asm volatile("s_waitcnt lgkmcnt(0)" ::: "memory");
            __builtin_amdgcn_wave_barrier();
        }
    }
    __syncthreads();
    LAS float* rec = (LAS float*)lds;
    for (int pt = cx.bid; pt < 256; pt += cx.nblk) {
        const int xcd = pt & 7, slot = pt >> 3, bh = xcd * 8 + (slot >> 2), rg = slot & 3, b = bh >> 3, h = bh & 7;
        const int lt = tid - 256, ls = (lt >> 4) & 15, lcg = lt & 15, lch = h * 64 + lcg * 4;
        u32x2 qr = {0u, 0u}, qk = {0u, 0u}, qv = {0u, 0u}, pr = {0u, 0u}, pk = {0u, 0u}, pv = {0u, 0u}, qa = {0u, 0u};
        f32x4 qw = (f32x4){0.f, 0.f, 0.f, 0.f};
        f32x4 mur, muk, muv, kkc, kac;
        const int ri = rg * 16 + (wid & 3) * 4 + rs;
        f32x4 S = (f32x4){0.f, 0.f, 0.f, 0.f};
#define SCAN_ISSUE(c) do { const int t_ = (c) * 16 + ls; const size_t row_ = (size_t)b * 2048 + t_; const bf16_t* cur_ = PB + row_ * LDB; \
            qr = *(const u32x2*)(cur_ + lch); qk = *(const u32x2*)(cur_ + 512 + lch); qv = *(const u32x2*)(cur_ + 1024 + lch); \
            if (t_ > 0) { pr = *(const u32x2*)(cur_ - LDB + lch); pk = *(const u32x2*)(cur_ - LDB + 512 + lch); pv = *(const u32x2*)(cur_ - LDB + 1024 + lch); } \
            else { pr = (u32x2){0u, 0u}; pk = pr; pv = pr; } \
            qw = *(const f32x4*)(Wdec + row_ * 512 + lch); qa = *(const u32x2*)(Aa + row_ * 512 + lch); } while (0)
#define SCAN_PROCESS(buf) do { const f32x4 r0_ = cvt4(qr), k0_ = cvt4(qk), v0_ = cvt4(qv); \
            const f32x4 r_ = r0_ + mur * (cvt4(pr) - r0_), k_ = k0_ + muk * (cvt4(pk) - k0_), v_ = v0_ + muv * (cvt4(pv) - v0_), a_ = cvt4(qa); \
            const f32x4 kkv_ = k_ * kkc; const float ss_ = allsum16(dot4(kkv_, kkv_)); const float inv_ = __builtin_amdgcn_rsqf(fmaxf(ss_, 1e-24f)); \
            const f32x4 kkn_ = kkv_ * inv_; \
            LAS float* o_ = rec + (buf) * 6144 + ls * 384 + lcg * 4; \
            *(LAS f32x4*)(o_) = qw; *(LAS f32x4*)(o_ + 64) = k_ * (1.0f + (a_ - 1.0f) * kac); *(LAS f32x4*)(o_ + 128) = kkn_; *(LAS f32x4*)(o_ + 192) = -(kkn_ * a_); \
            *(LAS f32x4*)(o_ + 256) = r_; *(LAS f32x4*)(o_ + 320) = v_; } while (0)
        if (wid >= 4) {
            mur = *(const f32x4*)(mu + lch); muk = *(const f32x4*)(mu + 512 + lch); muv = *(const f32x4*)(mu + 1024 + lch);
            kkc = *(const f32x4*)(k_k + lch); kac = *(const f32x4*)(k_a + lch);
            SCAN_ISSUE(0); SCAN_PROCESS(0); SCAN_ISSUE(1);
        }
        __syncthreads();
        for (int c = 0; c < 128; ++c) {
            if (wid < 4) {
                LAS const float* rb = rec + (c & 1) * 6144 + cgi * 4;
                LAS const float* rv = rec + (c & 1) * 6144 + 320 + ri;
                float yp[16];
                f32x4 nw = *(LAS const f32x4*)(rb), nk = *(LAS const f32x4*)(rb + 64), nkk = *(LAS const f32x4*)(rb + 128), nb = *(LAS const f32x4*)(rb + 192), nr = *(LAS const f32x4*)(rb + 256);
                float nv = rv[0];
#pragma unroll
                for (int s = 0; s < 16; ++s) {
                    const f32x4 cw = nw, ck = nk, ckk = nkk, cb = nb, cr = nr; const float cv = nv;
                    if (s + 1 < 16) {
                        LAS const float* r1 = rb + (s + 1) * 384;
                        nw = *(LAS const f32x4*)(r1); nk = *(LAS const f32x4*)(r1 + 64); nkk = *(LAS const f32x4*)(r1 + 128); nb = *(LAS const f32x4*)(r1 + 192); nr = *(LAS const f32x4*)(r1 + 256);
                        nv = rv[(s + 1) * 384];
                    }
                    scan_step<false>(S, cw, ck, ckk, cb, cr, cv, yp[s]);
                }
                Y[((size_t)b * 2048 + c * 16 + cgi) * 512 + h * 64 + ri] = reduce_scatter16(yp, cgi);
            } else {
                if (c + 1 < 128) { SCAN_PROCESS((c + 1) & 1); if (c + 2 < 128) SCAN_ISSUE(c + 2); }
            }
            __syncthreads();
        }
        if (wid < 4) *(f32x4*)(POUT + O_WKVP + ((((size_t)pair * 8 + b) * 8 + h) * 64 + ri) * 64 + cgi * 4) = S;
#undef SCAN_ISSUE
#undef SCAN_PROCESS
    }
}

__device__ void phase_even_post(const Params& p, const Ctx cx, int pair) {
    const int gtid = cx.bid * 512 + cx.tid, gthreads = cx.nblk * 512;
    const bf16_t* PA = (const bf16_t*)(PWS + WS_R1);
    bf16_t* Ycat = (bf16_t*)(PWS + WS_YCAT);
    const float* Y = (const float*)(PWS + WS_Y);
    constexpr int NIT = NTOK * 128, UB = 4;
    const float* gn_g = PIN(I_GNG) + pair * 512; const float* gn_b = PIN(I_GNB) + pair * 512;
    for (int e0 = gtid; e0 < NIT; e0 += gthreads * UB) {
        f32x4 y[UB], bv[UB], bz[UB]; bool ok[UB];
#pragma unroll
        for (int u = 0; u < UB; ++u) {
            const int e = e0 + u * gthreads; ok[u] = e < NIT;
            const int ee = ok[u] ? e : e0; const int row = ee >> 7, ch = (ee & 127) * 4;
            y[u] = *(const f32x4*)(Y + (size_t)row * 512 + ch);
            bv[u] = ld_bf4(Ycat + (size_t)row * 1024 + 512 + ch);
            bz[u] = ld_bf4(PA + (size_t)row * LDA + 2048 + ch);
        }
#pragma unroll
        for (int u = 0; u < UB; ++u) {
            const int e = e0 + u * gthreads;
            const int ee = ok[u] ? e : e0; const int row = ee >> 7, ch = (ee & 127) * 4;
            const float mean = allsum16(y[u][0] + y[u][1] + y[u][2] + y[u][3]) * (1.0f / 64.0f);
            const f32x4 d = y[u] - mean;
            const float var = allsum16(dot4(d, d)) * (1.0f / 64.0f);
            const float rstd = rsqrtf(var + 64e-5f);
            const f32x4 g = *(const f32x4*)(gn_g + ch), bb = *(const f32x4*)(gn_b + ch);
            f32x4 o;
#pragma unroll
            for (int j = 0; j < 4; ++j) o[j] = (d[j] * rstd * g[j] + bb[j] + bv[u][j]) * siluf_(bz[u][j]);
            if (ok[u]) st_bf4(Ycat + (size_t)row * 1024 + 512 + ch, o);
        }
    }
    const float* cw = PIN(I_CONVW) + pair * 3 * 512;
    constexpr int NRUN = (NTOK / 8) * 128;
    for (int e = gtid; e < NRUN; e += gthreads) {
        const int run = e >> 7, ch = (e & 127) * 4, row0 = run * 8;
        const bool samp = row0 >= NTP;
        int b, t0, T; if (!samp) { b = row0 >> 11; t0 = row0 & 2047; T = 2048; } else { b = (row0 - NTP) >> 3; t0 = 0; T = 8; }
        const bf16_t* base = PA + (size_t)row0 * LDA + ch;
        u32x2 rh[10], rc[10], rb[8], rz[8];
#pragma unroll
        for (int k = 0; k < 10; ++k) {
            const bool have = (k >= 2) || (t0 > 0);
            const bf16_t* pr = have ? base + (ptrdiff_t)(k - 2) * LDA : base;
            rh[k] = *(const u32x2*)(pr); rc[k] = *(const u32x2*)(pr + 1024);
        }
#pragma unroll
        for (int k = 0; k < 8; ++k) { rb[k] = *(const u32x2*)(base + (size_t)k * LDA + 512); rz[k] = *(const u32x2*)(base + (size_t)k * LDA + 1536); }
        const f32x4 k0 = *(const f32x4*)(cw + ch), k1 = *(const f32x4*)(cw + 512 + ch), k2 = *(const f32x4*)(cw + 1024 + ch);
        f32x4 um2, um1;
        if (t0 > 0) { um2 = cvt4(rc[0]) * cvt4(rh[0]); um1 = cvt4(rc[1]) * cvt4(rh[1]); }
        else if (samp) { const float* hist = PIN(I_SCONV) + ((size_t)pair * 128 + b) * 2 * 512 + ch; um2 = *(const f32x4*)(hist); um1 = *(const f32x4*)(hist + 512); }
        else { um2 = (f32x4){0.f, 0.f, 0.f, 0.f}; um1 = um2; }
#pragma unroll
        for (int k = 0; k < 8; ++k) {
            const f32x4 u0 = cvt4(rc[k + 2]) * cvt4(rh[k + 2]);
            const f32x4 conv = k0 * um2 + k1 * um1 + k2 * u0;
            const f32x4 ab = cvt4(rb[k]), az = cvt4(rz[k]);
            f32x4 o;
#pragma unroll
            for (int j = 0; j < 4; ++j) o[j] = ab[j] * conv[j] * siluf_(az[j]);
            const int row = row0 + k, t = t0 + k;
            st_bf4(Ycat + (size_t)row * 1024 + ch, o);
            if (t >= T - 2) {
                float* dst = samp ? POUT + O_CONVS + (((size_t)pair * 128 + b) * 2 + (t - (T - 2))) * 512 + ch : POUT + O_CONVP + (((size_t)pair * 8 + b) * 2 + (t - (T - 2))) * 512 + ch;
                *(f32x4*)dst = u0;
            }
            um2 = um1; um1 = u0;
        }
    }
}

template <int W>
__device__ __forceinline__ void pool_sample_run(const float* __restrict__ hist, const bf16_t* __restrict__ cur, LAS bf16_t* out) {
    f32x4 ext[23];
#pragma unroll
    for (int k = 0; k < 15; ++k) ext[k] = (k >= 16 - W) ? *(const f32x4*)(hist + (size_t)k * 512) : (f32x4){0.f, 0.f, 0.f, 0.f};
#pragma unroll
    for (int k = 0; k < 8; ++k) ext[15 + k] = ld_bf4(cur + (size_t)k * LDA);
    f32x4 sum = (f32x4){0.f, 0.f, 0.f, 0.f};
#pragma unroll
    for (int d = 0; d < W; ++d) sum += ext[15 - d];
#pragma unroll
    for (int t = 0; t < 8; ++t) {
        if (t > 0) sum += ext[15 + t] - ext[15 + t - W];
        const f32x4 pooled = sum * (1.0f / (float)W) - ext[15 + t];
        u32x2 u; u.x = cvt_pk_bf16(pooled[0], pooled[1]); u.y = cvt_pk_bf16(pooled[2], pooled[3]);
        *(LAS u32x2*)(out + t * 136) = u;
    }
}

__device__ void phase_odd_mixer(const Params& p, const Ctx cx, int pair, LAS unsigned char* lds) {
    const int tid = cx.tid, wid = tid >> 6, lane = tid & 63, fr = lane & 15, fq = lane >> 4;
    const bf16_t* PO = (const bf16_t*)(PWS + WS_R1);
    bf16_t* Ycat = (bf16_t*)(PWS + WS_YCAT);
    LAS bf16_t* LA = (LAS bf16_t*)lds;
    LAS bf16_t* LB = (LAS bf16_t*)(lds + 128 * 136 * 2);
    LAS float* stat = (LAS float*)(lds + 2 * 128 * 136 * 2);
    LAS float* LE = (LAS float*)(lds + 128 * 136 * 2);
    LAS bf16_t* LW = (LAS bf16_t*)(lds + 128 * 136 * 2 + 143 * 128 * 4);
    for (int di = 0; di < 8; ++di) {
        int tile, g0, ng;
        if (cx.nblk == 256) {
            if (di == 0) { tile = cx.bid >> 1; g0 = (cx.bid & 1) * 2; ng = 2; }
            else if (di == 1 && cx.bid < 32) { tile = 128 + (cx.bid >> 2); g0 = cx.bid & 3; ng = 1; }
            else break;
        } else { tile = cx.bid + di * cx.nblk; g0 = 0; ng = 4; if (tile >= 136) break; }
        const int r0 = tile * 128;
        const bool samp = r0 >= NTP;
        const int tl_ = tid >> 2, q_ = tid & 3;
        {
            const bf16_t* vr = PO + (size_t)(r0 + tl_) * LDA + 1536 + q_ * 128;
            float s_ = 0.f, ss = 0.f;
#pragma unroll
            for (int i = 0; i < 16; ++i) { const u32x4 raw = *(const u32x4*)(vr + i * 8); const f32x4 v0 = cvt4((u32x2){raw.x, raw.y}), v1 = cvt4((u32x2){raw.z, raw.w});
                s_ += (v0[0] + v0[1]) + (v0[2] + v0[3]) + (v1[0] + v1[1]) + (v1[2] + v1[3]); ss += dot4(v0, v0) + dot4(v1, v1); }
            s_ = allsum4(s_); ss = allsum4(ss);
            const float mean = s_ * (1.0f / 512.0f);
            const float var = fmaxf(ss * (1.0f / 512.0f) - mean * mean, 0.f);
            if (q_ == 0) { stat[tl_ * 2] = mean; stat[tl_ * 2 + 1] = rsqrtf(var + 1e-5f); }
        }
        LAS float* lnw = stat + 512;
        lnw[tid] = PIN(I_LNG)[pair * 512 + tid]; lnw[512 + tid] = PIN(I_LNB)[pair * 512 + tid];
        u32x2 rv[8]; u32x4 rw[4];
#define MIX_LOAD_G(gg) do { const bf16_t* vr_ = PO + (size_t)(r0 + tl_) * LDA + 1536 + (gg) * 128 + q_ * 32; \
            _Pragma("unroll") for (int i = 0; i < 8; ++i) rv[i] = *(const u32x2*)(vr_ + i * 4); \
            if (!samp) { const bf16_t* Ws_ = (const bf16_t*)(PWS + WS_SPW) + ((size_t)pair * 4 + (gg)) * 128 * 128; \
                _Pragma("unroll") for (int i = 0; i < 4; ++i) { const int e = tid + i * 512; rw[i] = *(const u32x4*)(Ws_ + (e >> 4) * 128 + (e & 15) * 8); } } } while (0)
        MIX_LOAD_G(g0);
        __syncthreads();
#pragma unroll 1
        for (int g = g0; g < g0 + ng; ++g) {
            u32x2 ur[8], dzr[8];
#pragma unroll
            for (int nt = 0; nt < 8; ++nt) { const size_t o_ = (size_t)(r0 + wid * 16 + fr) * LDA + g * 128 + nt * 16 + fq * 4; ur[nt] = *(const u32x2*)(PO + o_ + 1024); dzr[nt] = *(const u32x2*)(PO + o_ + 2048); }
            {
                const int row = r0 + tl_;
                const float mean = stat[tl_ * 2], rstd = stat[tl_ * 2 + 1];
                LAS const float* lg = lnw + g * 128 + q_ * 32; LAS const float* lb = lnw + 512 + g * 128 + q_ * 32;
#pragma unroll
                for (int i = 0; i < 8; ++i) {
                    const f32x4 v = cvt4(rv[i]);
                    const f32x4 vn = (v - mean) * rstd * *(LAS const f32x4*)(lg + i * 4) + *(LAS const f32x4*)(lb + i * 4);
                    if (samp) *(f32x4*)(POUT + O_CHUNKV + ((size_t)pair * 1024 + (row - NTP)) * 512 + g * 128 + q_ * 32 + i * 4) = vn;
                    {
                        const float p0 = dpp_f<0x104>(vn[0]), p1 = dpp_f<0x104>(vn[1]);
                        const float p2 = dpp_f<0x114>(vn[2]), p3 = dpp_f<0x114>(vn[3]);
                        const bool odd = tl_ & 1;
                        const unsigned wa = odd ? cvt_pk_bf16(p2, vn[2]) : cvt_pk_bf16(vn[0], p0);
                        const unsigned wb = odd ? cvt_pk_bf16(p3, vn[3]) : cvt_pk_bf16(vn[1], p1);
                        const int cb = q_ * 32 + i * 4 + (odd ? 2 : 0), tb = tl_ & ~1;
                        *(LAS unsigned*)(LB + (cb) * 136 + tb) = wa;
                        *(LAS unsigned*)(LB + (cb + 1) * 136 + tb) = wb;
                    }
                }
            }
            if (!samp) {
#pragma unroll
                for (int i = 0; i < 4; ++i) { const int e = tid + i * 512; *(LAS u32x4*)(LA + (e >> 4) * 136 + (e & 15) * 8) = rw[i]; }
            } else {
                const float* Wsrc = PIN(I_SPW) + ((size_t)pair * 4 + g) * 128 * 128;
                LAS float* w8 = stat + 256;
                if (tid < 64) w8[tid] = Wsrc[(tid >> 3) * 128 + (tid & 7)];
                __syncthreads();
                for (int e = tid; e < 128 * 128; e += 512) { const int t = e >> 7, s2 = e & 127;
                    const float v = ((t >> 3) == (s2 >> 3) && (s2 & 7) <= (t & 7)) ? w8[(t & 7) * 8 + (s2 & 7)] : 0.f;
                    LA[t * 136 + s2] = (bf16_t)(cvt_pk_bf16(v, 0.f) & 0xffffu); }
            }
            if (g + 1 < g0 + ng) MIX_LOAD_G(g + 1);
            __syncthreads();
            {
                const int tl = wid * 16 + fr, row = r0 + tl;
                const float bias = PIN(I_SPB)[((size_t)pair * 4 + g) * 128 + (samp ? (tl & 7) : tl)];
                bf16x8 wf[4];
#pragma unroll
                for (int ks = 0; ks < 4; ++ks) wf[ks] = *(const LAS bf16x8*)(LA + tl * 136 + ks * 32 + fq * 8);
#pragma unroll
                for (int nt = 0; nt < 8; ++nt) {
                    f32x4 acc = (f32x4){0.f, 0.f, 0.f, 0.f};
#pragma unroll
                    for (int ks = 0; ks < 4; ++ks) {
                        if (ks * 32 <= wid * 16 + 15) {
                            const bf16x8 vf = *(const LAS bf16x8*)(LB + (nt * 16 + fr) * 136 + ks * 32 + fq * 8);
                            acc = __builtin_amdgcn_mfma_f32_16x16x32_bf16(vf, wf[ks], acc, 0, 0, 0);
                        }
                    }
                    const int c = g * 128 + nt * 16 + fq * 4;
                    const f32x4 u = cvt4(ur[nt]), dz = cvt4(dzr[nt]);
                    f32x4 o;
#pragma unroll
                    for (int j = 0; j < 4; ++j) o[j] = u[j] * (acc[j] + bias) * siluf_(dz[j]);
                    st_bf4(Ycat + (size_t)row * 1024 + 512 + c, o);
                }
            }
            __syncthreads();
        }
#undef MIX_LOAD_G
    }
    {
        int ci, cstride;
        if (cx.nblk == 256) { if (cx.bid < 32) { ci = 1 << 20; cstride = 1 << 20; } else { ci = cx.bid - 32; cstride = 224; } }
        else { ci = cx.bid; cstride = cx.nblk; }
        u32x4 pw[4]; u32x2 pe[9];
#define MIX_LOAD_C(cc) do { const int tile_ = (cc) >> 2, g_ = (cc) & 3, r0_ = tile_ * 128; \
            const bf16_t* Bw_ = (const bf16_t*)(PWS + WS_POOLWT) + ((size_t)pair * 4 + g_) * 128 * 128; \
            _Pragma("unroll") for (int i = 0; i < 4; ++i) { const int e = tid + i * 512; pw[i] = *(const u32x4*)(Bw_ + (e >> 4) * 128 + (e & 15) * 8); } \
            if (r0_ < NTP) { const int t0_ = r0_ & 2047; \
                _Pragma("unroll") for (int i = 0; i < 9; ++i) { const int e = tid + i * 512, er = e >> 5, c = (e & 31) * 4; pe[i] = (u32x2){0u, 0u}; \
                    if (e < 143 * 32 && t0_ + er - 15 >= 0) pe[i] = *(const u32x2*)(PO + (size_t)(r0_ + er - 15) * LDA + g_ * 128 + c); } } } while (0)
        if (ci < 544) MIX_LOAD_C(ci);
        for (; ci < 544; ci += cstride) {
            const int tile = ci >> 2, g = ci & 3, r0 = tile * 128;
            const bool samp = r0 >= NTP;
            const int w = 2 << g;
            const int row = r0 + wid * 16 + fr;
            u32x2 czr[8]; f32x4 psr[8];
#pragma unroll
            for (int nt = 0; nt < 8; ++nt) { const int d = g * 128 + nt * 16 + fq * 4; czr[nt] = *(const u32x2*)(PO + (size_t)row * LDA + 512 + d); psr[nt] = *(const f32x4*)(PIN(I_PSCALE) + pair * 512 + d); }
#pragma unroll
            for (int i = 0; i < 4; ++i) { const int e = tid + i * 512; *(LAS u32x4*)(LW + (e >> 4) * 136 + (e & 15) * 8) = pw[i]; }
            if (!samp) {
                const int t0 = r0 & 2047;
#pragma unroll
                for (int i = 0; i < 9; ++i) { const int e = tid + i * 512, er = e >> 5, c = (e & 31) * 4; if (e < 143 * 32) *(LAS f32x4*)(LE + er * 128 + c) = cvt4(pe[i]); }
                __syncthreads();
                {
                    const int c = (tid & 31) * 4, tl0 = (tid >> 5) * 8;
                    f32x4 sum = (f32x4){0.f, 0.f, 0.f, 0.f};
#pragma unroll 4
                    for (int d = 0; d < w; ++d) sum += *(LAS const f32x4*)(LE + (tl0 + 15 - d) * 128 + c);
#pragma unroll
                    for (int k = 0; k < 8; ++k) {
                        const int tl = tl0 + k;
                        const f32x4 pt = *(LAS const f32x4*)(LE + (tl + 15) * 128 + c);
                        if (k > 0) sum += pt - *(LAS const f32x4*)(LE + (tl + 15 - w) * 128 + c);
                        const float cnt = fminf((float)w, (float)(t0 + tl + 1));
                        const f32x4 pooled = sum * (1.0f / cnt) - pt;
                        u32x2 u; u.x = cvt_pk_bf16(pooled[0], pooled[1]); u.y = cvt_pk_bf16(pooled[2], pooled[3]);
                        *(LAS u32x2*)(LA + tl * 136 + c) = u;
                    }
                }
            } else {
                const int sq = tid >> 5, c = (tid & 31) * 4, bb = (r0 - NTP) / 8 + sq;
                const float* hist = PIN(I_SPOOL) + ((size_t)pair * 128 + bb) * 15 * 512 + g * 128 + c;
                const bf16_t* cur = PO + (size_t)(r0 + sq * 8) * LDA + g * 128 + c;
                LAS bf16_t* out = LA + (sq * 8) * 136 + c;
                if (g == 0) pool_sample_run<2>(hist, cur, out); else if (g == 1) pool_sample_run<4>(hist, cur, out);
                else if (g == 2) pool_sample_run<8>(hist, cur, out); else pool_sample_run<16>(hist, cur, out);
            }
            if (ci + cstride < 544) MIX_LOAD_C(ci + cstride);
            __syncthreads();
            bf16x8 af[4];
#pragma unroll
            for (int ks = 0; ks < 4; ++ks) af[ks] = *(const LAS bf16x8*)(LA + (wid * 16 + fr) * 136 + ks * 32 + fq * 8);
#pragma unroll
            for (int nt = 0; nt < 8; ++nt) {
                f32x4 acc = (f32x4){0.f, 0.f, 0.f, 0.f};
#pragma unroll
                for (int ks = 0; ks < 4; ++ks) {
                    const bf16x8 bf = *(const LAS bf16x8*)(LW + (nt * 16 + fr) * 136 + ks * 32 + fq * 8);
                    acc = __builtin_amdgcn_mfma_f32_16x16x32_bf16(bf, af[ks], acc, 0, 0, 0);
                }
                const int d = g * 128 + nt * 16 + fq * 4;
                const f32x4 cz = cvt4(czr[nt]), ps = psr[nt];
                f32x4 o;
#pragma unroll
                for (int j = 0; j < 4; ++j) o[j] = acc[j] * ps[j] * siluf_(cz[j]);
                st_bf4(Ycat + (size_t)row * 1024 + d, o);
            }
            __syncthreads();
        }
#undef MIX_LOAD_C
    }
    const int gtid = cx.bid * 512 + tid, gthreads = cx.nblk * 512;
    for (int e = gtid; e < 136 * 15 * 128; e += gthreads) {
        const int c = (e & 127) * 4, q = e >> 7, sr = q / 15, k = q - sr * 15;
        if (sr < 8) *(f32x4*)(POUT + O_POOLP + (((size_t)pair * 8 + sr) * 15 + k) * 512 + c) = ld_bf4(PO + (size_t)(sr * 2048 + 2033 + k) * LDA + c);
        else { const int b = sr - 8;
            *(f32x4*)(POUT + O_POOLS + (((size_t)pair * 128 + b) * 15 + k) * 512 + c) = (k < 7) ? *(const f32x4*)(PIN(I_SPOOL) + (((size_t)pair * 128 + b) * 15 + 8 + k) * 512 + c) : ld_bf4(PO + (size_t)(NTP + b * 8 + (k - 7)) * LDA + c); }
    }
}

__device__ void phase_final(const Params& p, const Ctx cx) {
    const int gtid = cx.bid * 512 + cx.tid, gthreads = cx.nblk * 512;
    const float* ssq = (const float*)(PWS + WS_SSQ) + (size_t)4 * NTOK * 16;
    const bf16_t* Xb = (const bf16_t*)(PWS + WS_XB);
    constexpr int NIT = NTOK * 256, UB = 4;
    for (int e0 = gtid; e0 < NIT; e0 += gthreads * UB) {
        f32x4 x[UB]; float sq[UB]; bool ok[UB];
#pragma unroll
        for (int u = 0; u < UB; ++u) { const int e = e0 + u * gthreads; ok[u] = e < NIT; const int ee = ok[u] ? e : e0; const int row = ee >> 8, c = (ee & 255) * 4;
            x[u] = ld_bf4(Xb + (size_t)row * 1024 + c); sq[u] = ssq_sum(ssq + (size_t)row * 16); }
#pragma unroll
        for (int u = 0; u < UB; ++u) { const int e = e0 + u * gthreads; const int ee = ok[u] ? e : e0; const int row = ee >> 8, c = (ee & 255) * 4;
            const float rstd = rsqrtf(sq[u] * (1.0f / 1024.0f) + 1e-6f);
            if (ok[u]) *(f32x4*)(POUT + (size_t)row * 1024 + c) = x[u] * rstd * *(const f32x4*)(PIN(I_FNORMW) + c); }
    }
}

#define XB_TMO      128
#define XB_XCNT(j)  (256  + 64 * (j))
#define XB_XSUB(j)  (1280 + 64 * (j))
#define XB_XGEN(j)  (2304 + 64 * (j))
#define XB_TOP      3328
#define XB_TOPGEN   3392
#define XCD_BAR_WORDS 3456
#define XB_SPIN_CAP (1u << 18)
__device__ __forceinline__ unsigned xb_ld(unsigned* p)              { return __hip_atomic_load(p, __ATOMIC_RELAXED, __HIP_MEMORY_SCOPE_AGENT); }
__device__ __forceinline__ unsigned xb_add(unsigned* p, unsigned v) { return __hip_atomic_fetch_add(p, v, __ATOMIC_RELAXED, __HIP_MEMORY_SCOPE_AGENT); }
__device__ __forceinline__ unsigned xb_xcc_id() { return (unsigned)__builtin_amdgcn_s_getreg((3 << 11) | 20) & 0xFu; }
#define XB_SPIN(cond, bar) do { unsigned _sp = 0; while (cond) { __builtin_amdgcn_s_sleep(1); \
    if ((++_sp & 255u) == 0u) { if (xb_ld(&(bar)[XB_TMO])) break; if (_sp > XB_SPIN_CAP) { atomicAdd(&(bar)[XB_TMO], 1u); break; } } } } while (0)
struct XcdBarrier { unsigned* bar; unsigned x; volatile LAS unsigned* st; };
__device__ __forceinline__ XcdBarrier xcd_barrier_post(unsigned* bar, volatile LAS unsigned* st) {
    XcdBarrier b; b.bar = bar; b.x = xb_xcc_id(); b.st = st;
    if (threadIdx.x == 0) (void)xb_add(&bar[XB_XCNT(b.x)], 1u);
    return b;
}
__device__ __forceinline__ void xcd_barrier_complete(unsigned* bar, unsigned x, unsigned& nloc, unsigned& nx) {
    const unsigned G = gridDim.x * gridDim.y * gridDim.z;
    unsigned sum, cnt, mine, sp = 0u;
    for (;;) {
        sum = 0u; cnt = 0u; mine = 0u;
#pragma unroll
        for (unsigned j = 0; j < 16; ++j) { const unsigned c = xb_ld(&bar[XB_XCNT(j)]); sum += c; cnt += (c > 0u) ? 1u : 0u; mine = (j == x) ? c : mine; }
        if (sum == G) break;
        __builtin_amdgcn_s_sleep(1);
        if ((++sp & 255u) == 0u) { if (xb_ld(&bar[XB_TMO])) break; if (sp > XB_SPIN_CAP) { atomicAdd(&bar[XB_TMO], 1u); break; } }
    }
    nloc = mine > 0u ? mine : 1u; nx = cnt > 0u ? cnt : 1u;
}
__device__ __forceinline__ void xcd_barrier(const XcdBarrier& b) {
    asm volatile("s_waitcnt vmcnt(0)" ::: "memory");
    __syncthreads();
    if (threadIdx.x == 0) {
        unsigned* bar = b.bar;
        __builtin_amdgcn_s_waitcnt(0);
        unsigned nloc = b.st[0], nx = b.st[1];
        if (nloc == 0u) { xcd_barrier_complete(bar, b.x, nloc, nx); b.st[0] = nloc; b.st[1] = nx; }
        const unsigned old = xb_add(&bar[XB_XSUB(b.x)], 1u);
        const unsigned gen = old / nloc;
        if (old + 1u == (gen + 1u) * nloc) {
            __builtin_amdgcn_fence(__ATOMIC_RELEASE, "agent");
            asm volatile("s_waitcnt vmcnt(0)" ::: "memory");
            const unsigned og = xb_add(&bar[XB_TOP], 1u);
            const unsigned tg = og / nx;
            if (og + 1u == (tg + 1u) * nx) xb_add(&bar[XB_TOPGEN], 1u);
            else XB_SPIN(xb_ld(&bar[XB_TOPGEN]) == tg, bar);
            __builtin_amdgcn_fence(__ATOMIC_ACQUIRE, "agent");
            xb_add(&bar[XB_XGEN(b.x)], 1u);
            asm volatile("s_waitcnt vmcnt(0)" ::: "memory");
        } else {
            XB_SPIN(xb_ld(&bar[XB_XGEN(b.x)]) == gen, bar);
            __builtin_amdgcn_fence(__ATOMIC_ACQUIRE, "agent");
            asm volatile("s_waitcnt vmcnt(0)" ::: "memory");
        }
    }
    __syncthreads();
}

__device__ void run_gemm_proj(const Params& p, const Ctx cx, LAS unsigned char* lds, const bf16_t* Bt, int N, bf16_t* O, int ldc, int layer) {
    pg8::Gemm g{(const bf16_t*)(PWS + WS_XB), Bt, NTOK, N, 1024};
    pg8::StaticOrder S; S.init(NTOK, N, (int)cx.nblk, (int)cx.bid);
    const float* ssq = (const float*)(PWS + WS_SSQ) + (size_t)layer * NTOK * 16;
    LAS float* rl = (LAS float*)(lds + 131072);
    int pm0 = -1, pm1 = -1, pm2 = -1, pm3 = -1, np = 0;
    for (int i = 0; i < 64; ++i) {
        pg8::Unit u; if (!S.next(i, u)) break;
        if (u.pm == pm0 || u.pm == pm1 || u.pm == pm2 || u.pm == pm3) continue;
        if (np == 0) pm0 = u.pm; else if (np == 1) pm1 = u.pm; else if (np == 2) pm2 = u.pm; else pm3 = u.pm;
        ++np;
    }
    for (int r = cx.tid; r < np * 256; r += 512) {
        const int i = r >> 8, pm = i == 0 ? pm0 : (i == 1 ? pm1 : (i == 2 ? pm2 : pm3));
        rl[r] = rsqrtf(ssq_sum(ssq + (size_t)(pm * 256 + (r & 255)) * 16) * (1.0f / 1024.0f) + 1e-6f);
    }
    __syncthreads();
    EpiProj E{O, ldc, rl, pm0, pm1, pm2, pm3};
    pg8::gemm_phase<EpiProj>(cx, lds, g, S, E);
}
__device__ void run_gemm_res(const Params& p, const Ctx cx, LAS unsigned char* lds, const bf16_t* Bt, int layer) {
    const bf16_t* A = (const bf16_t*)(PWS + WS_YCAT);
    bf16_t* Xb = (bf16_t*)(PWS + WS_XB);
    float* ssqn = (float*)(PWS + WS_SSQ) + (size_t)(layer + 1) * NTOK * 16;
    pg8::Gemm g{A, Bt, NTOK, 1024, 1024};
    pg8::StaticOrder S; S.init(NTOK, 1024, (int)cx.nblk, (int)cx.bid);
    EpiRes E{layer == 0 ? PIN(I_XP) : nullptr, PIN(I_XS), Xb, ssqn};
    pg8::gemm_phase<EpiRes>(cx, lds, g, S, E);
}

constexpr int N_PHASES = 20;
#ifndef PHMASK
#define PHMASK 0xffff
#endif
#define PHON(n) ((PHMASK >> ((n) % 16)) & 1)
__global__ void __launch_bounds__(512, 2) fwd_kernel(Params p) {
    extern __shared__ __attribute__((aligned(16))) unsigned char lds_raw[];
    LAS unsigned char* lds = (LAS unsigned char*)lds_raw;
    volatile LAS unsigned* bar_st = (volatile LAS unsigned*)(lds + LDS_MAIN);
    if (threadIdx.x < 4) bar_st[threadIdx.x] = 0u;
    __syncthreads();
    const XcdBarrier gbar = xcd_barrier_post((unsigned*)((unsigned char*)p.ptr[30] + WS_BAR), bar_st);
    if (p.ph_hi < 0) cg::this_grid().sync();
#define GRID_SYNC() xcd_barrier(gbar)
#ifdef SYNCPROBE
    for (int i = 0; i < SYNCPROBE; ++i) GRID_SYNC();
#endif
#ifdef REPMASK
    for (int pc = p.ph_lo * 2; pc < p.ph_hi * 2; ++pc) {
        const int ph = pc >> 1;
        { const int s_ = (ph == 0) ? 9 : (ph == N_PHASES - 1) ? 31 : (ph - 1) % 9; if ((pc & 1) && !((REPMASK >> s_) & 1)) continue; }
        if (pc > p.ph_lo * 2) GRID_SYNC();
#else
    for (int ph = p.ph_lo; ph < p.ph_hi; ++ph) {
        if (ph > p.ph_lo) GRID_SYNC();
#endif
        Ctx cx; cx.tid = threadIdx.x; cx.bid = blockIdx.x; cx.nblk = gridDim.x;
        asm volatile("s_mov_b32 %0, 0" : "=s"(cx.z));
        asm volatile("" : "+v"(cx.tid)); asm volatile("" : "+s"(cx.bid)); asm volatile("" : "+s"(cx.nblk));
        const int pair = (ph - 1) / 9, s = (ph == 0) ? 100 : (ph == N_PHASES - 1 ? 101 : (ph - 1) % 9);
        if (s == 0 || s == 3 || s == 6) {
#if PHON(0)
            const bf16_t* WinE = (const bf16_t*)(PWS + WS_WINE) + (size_t)pair * 4352 * 1024;
            const bf16_t* Bt = s == 0 ? WinE + (size_t)2560 * 1024 : (s == 3 ? WinE : (const bf16_t*)(PWS + WS_WINO) + (size_t)pair * 2560 * 1024);
            const int N = s == 0 ? 1792 : 2560;
            run_gemm_proj(p, cx, lds, Bt, N, (bf16_t*)(PWS + WS_R1), N, 2 * pair + (s == 6 ? 1 : 0));
#endif
        } else if (s == 5 || s == 8) {
#if PHON(5)
            const bf16_t* Bt = (const bf16_t*)(PWS + (s == 5 ? WS_WOUTE : WS_WOUTO)) + (size_t)pair * 1024 * 1024;
            run_gemm_res(p, cx, lds, Bt, 2 * pair + (s == 8 ? 1 : 0));
#endif
        } else if (s == 1) {
#if PHON(1)
            phase_even_prep(p, cx, pair, lds);
#endif
        } else if (s == 2) {
#if PHON(2)
            phase_scan(p, cx, pair, lds);
#endif
        } else if (s == 4) {
#if PHON(4)
            phase_even_post(p, cx, pair);
#endif
        } else if (s == 7) {
#if PHON(7)
            phase_odd_mixer(p, cx, pair, lds);
#endif
        } else if (s == 100) {
#if PHON(10)
            phase_prepass(p, cx, lds);
#endif
        } else {
#if PHON(11)
            phase_final(p, cx);
#endif
        }
    }
}

extern "C" void kernel_launch(void* const* d_in, const int* in_sizes, int n_in, void* d_out, int out_size, void* d_ws, size_t ws_size, hipStream_t stream) {
    static int grid = 0;
    if (grid == 0) {
        if (n_in != 29 || ws_size < WS_END) { fprintf(stderr, "kernel_launch: unexpected n_in %d / ws_size %zu (need %zu)\n", n_in, ws_size, (size_t)WS_END); grid = -1; return; }
        int dev = 0, cus = 0, per_cu = 0;
        hipGetDevice(&dev);
        hipDeviceGetAttribute(&cus, hipDeviceAttributeMultiprocessorCount, dev);
        if (hipFuncSetAttribute((const void*)fwd_kernel, hipFuncAttributeMaxDynamicSharedMemorySize, LDS_BYTES) != hipSuccess) { fprintf(stderr, "kernel_launch: hipFuncSetAttribute failed\n"); grid = -1; return; }
        if (hipOccupancyMaxActiveBlocksPerMultiprocessor(&per_cu, (const void*)fwd_kernel, 512, LDS_BYTES) != hipSuccess || per_cu < 1) { fprintf(stderr, "kernel_launch: occupancy query gave %d\n", per_cu); per_cu = 1; }
        (void)hipGetLastError();
        grid = cus * per_cu;
        if (grid > 256) grid = 256;
    }
    if (grid < 0) return;
    Params p{};
    for (int i = 0; i < 29; ++i) p.ptr[i] = d_in[i];
    p.ptr[29] = d_out; p.ptr[30] = d_ws; p.ptr[31] = nullptr;
    (void)hipMemsetAsync((unsigned char*)d_ws + WS_BAR, 0, 16384, stream);
#if ONE_LAUNCH
    p.ph_lo = 0; p.ph_hi = N_PHASES;
    void* args[] = {&p};
    hipError_t e = hipLaunchCooperativeKernel((const void*)fwd_kernel, dim3(grid), dim3(512), args, LDS_BYTES, stream);
    if (e != hipSuccess) fprintf(stderr, "cooperative launch failed: %s (grid %d)\n", hipGetErrorString(e), grid);
#else
    for (int ph = 0; ph < N_PHASES; ++ph) {
        p.ph_lo = ph; p.ph_hi = ph + 1;
        hipLaunchKernelGGL(fwd_kernel, dim3(grid), dim3(512), LDS_BYTES, stream, p);
    }
#endif
}
```

```cpp
#include <hip/hip_runtime.h>
#include <hip/hip_cooperative_groups.h>
#include <cstdio>
namespace cg = cooperative_groups;

#ifndef ONE_LAUNCH
#define ONE_LAUNCH 1
#endif

#define LAS __attribute__((address_space(3)))
typedef unsigned short bf16_t;
typedef short bf16x8 __attribute__((ext_vector_type(8)));
typedef float f32x4 __attribute__((ext_vector_type(4)));
typedef unsigned u32x4 __attribute__((ext_vector_type(4)));
typedef unsigned u32x2 __attribute__((ext_vector_type(2)));

constexpr int NTOK = 17408, NTP = 16384;
constexpr int LDB = 1792;
constexpr int LDA = 2560;
constexpr size_t O_CONVP = 17825792, O_CONVS = 17842176, O_SHIFTP = 18104320, O_SHIFTS = 18130944, O_WKVP = 18556928, O_WKVS = 19081216,
                 O_POOLP = 27469824, O_POOLS = 27592704, O_CHUNKV = 29558784;
constexpr size_t WS_WINE = 0;
constexpr size_t WS_WOUTE = WS_WINE + 2ull * 4352 * 1024 * 2;
constexpr size_t WS_WINO = WS_WOUTE + 2ull * 1024 * 1024 * 2;
constexpr size_t WS_WOUTO = WS_WINO + 2ull * 2560 * 1024 * 2;
constexpr size_t WS_W2T = WS_WOUTO + 2ull * 1024 * 1024 * 2;
constexpr size_t WS_A2T = WS_W2T + 2ull * 512 * 64 * 2;
constexpr size_t WS_POOLWT = WS_A2T + 2ull * 512 * 64 * 2;
constexpr size_t WS_SPW = WS_POOLWT + 8ull * 128 * 128 * 2;
constexpr size_t WS_XB = WS_SPW + 8ull * 128 * 128 * 2;
constexpr size_t WS_YCAT = WS_XB + (size_t)NTOK * 1024 * 2;
constexpr size_t WS_SSQ = WS_YCAT + (size_t)NTOK * 1024 * 2;
constexpr size_t WS_Y = WS_SSQ + 5ull * NTOK * 16 * 4;
constexpr size_t WS_R1 = WS_Y + (size_t)NTOK * 512 * 4;
constexpr size_t WS_PROJB = WS_R1;
constexpr size_t WS_WDEC = WS_PROJB + (size_t)NTOK * LDB * 2;
constexpr size_t WS_AA = WS_WDEC + (size_t)NTOK * 512 * 4;
constexpr size_t WS_BAR = WS_AA + (size_t)NTOK * 512 * 2;
constexpr size_t WS_END = WS_BAR + 16384;
constexpr int LDS_MAIN = 147456;
constexpr int LDS_BYTES = LDS_MAIN + 16;

struct Params {
    const void* ptr[32];
    int ph_lo, ph_hi;
};
struct Ctx { int tid, bid, nblk, z; };
#define PIN(i) ((const float*)p.ptr[(i) + cx.z])
#define POUT ((float*)p.ptr[29 + cx.z])
#define PWS ((unsigned char*)p.ptr[30 + cx.z])
enum { I_XP = 0, I_XS, I_SCONV, I_SSHIFT, I_SWKV, I_SPOOL, I_NORMW, I_FNORMW, I_WINE, I_CONVW, I_MU, I_W0, I_W2, I_A0, I_A2, I_KK, I_KA, I_RK, I_GNG, I_GNB,
       I_WOUTE, I_WINO, I_POOLW, I_PSCALE, I_LNG, I_LNB, I_SPW, I_SPB, I_WOUTO };

__device__ __forceinline__ unsigned cvt_pk_bf16(float lo, float hi) { unsigned r; asm("v_cvt_pk_bf16_f32 %0, %1, %2" : "=v"(r) : "v"(lo), "v"(hi)); return r; }
__device__ __forceinline__ float bf_lo(unsigned u) { return __uint_as_float(u << 16); }
__device__ __forceinline__ float bf_hi(unsigned u) { return __uint_as_float(u & 0xffff0000u); }
__device__ __forceinline__ float bf2f(bf16_t b) { return __uint_as_float(((unsigned)b) << 16); }
__device__ __forceinline__ f32x4 cvt4(u32x2 u) { return (f32x4){bf_lo(u.x), bf_hi(u.x), bf_lo(u.y), bf_hi(u.y)}; }
__device__ __forceinline__ f32x4 ld_bf4(const bf16_t* p) { return cvt4(*(const u32x2*)p); }
__device__ __forceinline__ void st_bf4(bf16_t* p, f32x4 v) { u32x2 u; u.x = cvt_pk_bf16(v[0], v[1]); u.y = cvt_pk_bf16(v[2], v[3]); *(u32x2*)p = u; }
__device__ __forceinline__ float sigmoidf_(float x) { return 1.0f / (1.0f + __expf(-x)); }
__device__ __forceinline__ float siluf_(float x) { return x / (1.0f + __expf(-x)); }
template <int CTRL> __device__ __forceinline__ float dpp_f(float x) { return __builtin_bit_cast(float, __builtin_amdgcn_mov_dpp(__builtin_bit_cast(int, x), CTRL, 0xf, 0xf, true)); }
__device__ __forceinline__ float allsum16(float x) { x += dpp_f<0xB1>(x); x += dpp_f<0x4E>(x); x += dpp_f<0x141>(x); x += dpp_f<0x128>(x); return x; }
__device__ __forceinline__ float allsum4(float x) { x += dpp_f<0xB1>(x); x += dpp_f<0x4E>(x); return x; }
__device__ __forceinline__ float dot4(f32x4 a, f32x4 b) { return a[0] * b[0] + a[1] * b[1] + a[2] * b[2] + a[3] * b[3]; }

__device__ __forceinline__ float ssq_sum(const float* part) {
    const f32x4 a = *(const f32x4*)(part), b = *(const f32x4*)(part + 4), c = *(const f32x4*)(part + 8), d = *(const f32x4*)(part + 12);
    return ((a[0] + a[1]) + (a[2] + a[3])) + ((b[0] + b[1]) + (b[2] + b[3])) + ((c[0] + c[1]) + (c[2] + c[3])) + ((d[0] + d[1]) + (d[2] + d[3]));
}

namespace pg8 {
constexpr int BM = 256, BK = 64, HALF = 128, HTB = HALF * BK * 2, NXCD = 8, WGM = 8;
__device__ __forceinline__ int lds_byte(int r, int c) { const int st = (r >> 4) * 2 + (c >> 5), rr = r & 15, cc = c & 31, ob = rr * 64 + cc * 2; return st * 1024 + (ob ^ (((ob >> 9) & 1) << 5)); }
__device__ __forceinline__ void stage_rc(int b, int& R, int& C) { const int st = b / 1024, sb = b % 1024, swz = sb ^ (((sb >> 9) & 1) << 5); R = (st >> 1) * 16 + swz / 64; C = (st & 1) * 32 + (swz % 64) / 2; }
__device__ __forceinline__ int perm32(int rho) { const int n = rho >> 4, i = rho & 15; return 8 * (i >> 2) + 4 * n + (i & 3); }
struct Unit { int pm, pn; };
struct Gemm { const bf16_t* A; const bf16_t* Bt; int M, N, K; };
struct StaticOrder {
    int nM, nN, nwg, G, c;
    __device__ void init(int M, int N, int G_, int c_) { nM = M / BM; nN = N / BM; nwg = nM * nN; G = G_; c = c_; }
    __device__ bool next(int i, Unit& u) const {
        const long L = (long)i * G + c; if (L >= nwg) return false;
        int wgid = (int)L; { const int q = nwg / NXCD, r = nwg % NXCD, xcd = wgid % NXCD, off = wgid / NXCD; wgid = (xcd < r ? xcd * (q + 1) : r * (q + 1) + (xcd - r) * q) + off; }
        const int nig = WGM * nN, gid = wgid / nig, fm = gid * WGM, gsz = (nM - fm) < WGM ? (nM - fm) : WGM;
        u.pm = fm + ((wgid % nig) % gsz); u.pn = (wgid % nig) / gsz; return true;
    }
};

template <class Epi>
__device__ __forceinline__ void gemm_phase(const Ctx cx, LAS unsigned char* lds, const Gemm g, const StaticOrder& S, const Epi& E) {
    const int tid = cx.tid, wid = __builtin_amdgcn_readfirstlane(tid >> 6), lane = tid & 63, wr = wid >> 2, wc = wid & 3, fr = lane & 15, fq = lane >> 4;
    const int K = g.K, nt = K / BK;
    unsigned voffA[2], voffB[2];
#pragma unroll
    for (int i = 0; i < 2; ++i) { int R, C; stage_rc(tid * 16 + i * 8192, R, C); const int Rb = Epi::PERM ? ((R & ~31) + perm32(R & 31)) : R;
        voffA[i] = (unsigned)(R * K + C) * 2u; voffB[i] = (unsigned)(Rb * K + C) * 2u; }
    const size_t kstep = (size_t)(BK * 2);
    const size_t hstep = (size_t)HALF * K * 2;
    const size_t tstep = 2 * hstep;
    const unsigned ldsw = (unsigned)wid * 1024u;
    const int aoff = lds_byte(wr * 64 + fr, fq * 8), boff = lds_byte(wc * 32 + fr, fq * 8);
#define PG8_SA(b, h) (((b) * 2 + (h)) * HTB)
#define PG8_SB(b, h) ((4 + (b) * 2 + (h)) * HTB)
#define PG8_STAGE(bufoff, gbase, voff) do { _Pragma("unroll") for (int _i = 0; _i < 2; ++_i) \
        __builtin_amdgcn_global_load_lds((const unsigned*)((const char*)(gbase) + (voff)[_i]), (LAS unsigned*)(lds + (bufoff) + ldsw + _i * 8192), 16, 0, 0); } while (0)
#define PG8_LDA(dst, b, h) do { _Pragma("unroll") for (int m = 0; m < 4; ++m) _Pragma("unroll") for (int k = 0; k < 2; ++k) dst[m][k] = *(const LAS bf16x8*)(lds + PG8_SA(b, h) + aoff + m * 2048 + k * 1024); } while (0)
#define PG8_LDB(dst, b, h) do { _Pragma("unroll") for (int n = 0; n < 2; ++n) _Pragma("unroll") for (int k = 0; k < 2; ++k) dst[n][k] = *(const LAS bf16x8*)(lds + PG8_SB(b, h) + boff + n * 2048 + k * 1024); } while (0)
#define PG8_MMA(ai, bj, At, Bt) do { __builtin_amdgcn_s_setprio(1); _Pragma("unroll") for (int m = 0; m < 4; ++m) _Pragma("unroll") for (int n = 0; n < 2; ++n) _Pragma("unroll") for (int k = 0; k < 2; ++k) \
        acc[ai][bj][m][n] = __builtin_amdgcn_mfma_f32_16x16x32_bf16(Bt[n][k], At[m][k], acc[ai][bj][m][n], 0, 0, 0); __builtin_amdgcn_s_setprio(0); } while (0)
#define PG8_WAIT_V(n) asm volatile("s_waitcnt vmcnt(" #n ")" ::: "memory")
#define PG8_WAIT_L(n) asm volatile("s_waitcnt lgkmcnt(" #n ")" ::: "memory")
#define PG8_BAR __builtin_amdgcn_s_barrier()
#define PG8_SCHED __builtin_amdgcn_sched_barrier(0)
    Unit cur, nxt; int ui = 0;
    if (!S.next(0, cur)) return;
    f32x4 acc[2][2][4][2];
#pragma unroll
    for (int a = 0; a < 2; ++a)
#pragma unroll
        for (int b = 0; b < 2; ++b)
#pragma unroll
            for (int m = 0; m < 4; ++m)
#pragma unroll
                for (int n = 0; n < 2; ++n) acc[a][b][m][n] = (f32x4){0.f, 0.f, 0.f, 0.f};
    bf16x8 At[4][2], B0[2][2], B1[2][2];
    const char* cA = (const char*)g.A + (size_t)cur.pm * tstep; const char* cB = (const char*)g.Bt + (size_t)cur.pn * tstep;
    PG8_STAGE(PG8_SB(0, 0), cB, voffB); PG8_STAGE(PG8_SA(0, 0), cA, voffA); PG8_STAGE(PG8_SB(0, 1), cB + hstep, voffB); PG8_STAGE(PG8_SA(0, 1), cA + hstep, voffA);
    if (wr == 1) PG8_BAR;
    PG8_WAIT_V(4); PG8_BAR;
    PG8_STAGE(PG8_SB(1, 0), cB + kstep, voffB); PG8_STAGE(PG8_SA(1, 0), cA + kstep, voffA); PG8_STAGE(PG8_SB(1, 1), cB + hstep + kstep, voffB);
    PG8_WAIT_V(6); PG8_BAR;
    for (;;) {
        const bool has_next = S.next(ui + 1, nxt);
        const char* nA = has_next ? (const char*)g.A + (size_t)nxt.pm * tstep : cA; const char* nB = has_next ? (const char*)g.Bt + (size_t)nxt.pn * tstep : cB;
        for (int t = 0; t < nt; t += 2) {
            const bool last = (t == nt - 2);
            const char* a1 = cA + (size_t)(t + 1) * kstep;
            const char* a2 = last ? nA : cA + (size_t)(t + 2) * kstep; const char* b2 = last ? nB : cB + (size_t)(t + 2) * kstep;
            const char* a3 = a2 + kstep; const char* b3 = b2 + kstep;
            PG8_LDB(B0, 0, 0); PG8_SCHED; PG8_LDA(At, 0, 0); PG8_STAGE(PG8_SA(1, 1), a1 + hstep, voffA);
            PG8_WAIT_L(8); PG8_BAR; PG8_WAIT_L(0); PG8_MMA(0, 0, At, B0); PG8_BAR; PG8_SCHED;
            PG8_LDB(B1, 0, 1); PG8_STAGE(PG8_SB(0, 0), b2, voffB);
            PG8_BAR; PG8_WAIT_L(0); PG8_MMA(0, 1, At, B1); PG8_BAR;
            PG8_LDA(At, 0, 1); PG8_STAGE(PG8_SA(0, 0), a2, voffA);
            PG8_BAR; PG8_WAIT_L(0); PG8_MMA(1, 0, At, B0); PG8_BAR; PG8_SCHED;
            PG8_STAGE(PG8_SB(0, 1), b2 + hstep, voffB);
            PG8_WAIT_V(6); PG8_BAR; PG8_MMA(1, 1, At, B1); PG8_BAR;
            PG8_LDB(B0, 1, 0); PG8_SCHED; PG8_LDA(At, 1, 0); PG8_STAGE(PG8_SA(0, 1), a2 + hstep, voffA);
            PG8_WAIT_L(8); PG8_BAR; PG8_WAIT_L(0); PG8_MMA(0, 0, At, B0); PG8_BAR; PG8_SCHED;
            PG8_LDB(B1, 1, 1); PG8_STAGE(PG8_SB(1, 0), b3, voffB);
            PG8_BAR; PG8_WAIT_L(0); PG8_MMA(0, 1, At, B1); PG8_BAR;
            PG8_LDA(At, 1, 1); PG8_STAGE(PG8_SA(1, 0), a3, voffA);
            PG8_BAR; PG8_WAIT_L(0); PG8_MMA(1, 0, At, B0); PG8_BAR; PG8_SCHED;
            PG8_STAGE(PG8_SB(1, 1), b3 + hstep, voffB);
            PG8_WAIT_V(6); PG8_BAR; PG8_MMA(1, 1, At, B1); PG8_BAR;
        }
        E(acc, cur, wr, wc, fr, fq);
        if (!has_next) break;
#pragma unroll
        for (int a = 0; a < 2; ++a)
#pragma unroll
            for (int b = 0; b < 2; ++b)
#pragma unroll
                for (int m = 0; m < 4; ++m)
#pragma unroll
                    for (int n = 0; n < 2; ++n) acc[a][b][m][n] = (f32x4){0.f, 0.f, 0.f, 0.f};
        cur = nxt; cA = nA; cB = nB; ++ui;
    }
    PG8_WAIT_V(0);
    if (wr == 0) PG8_BAR;
    PG8_BAR;
#undef PG8_SA
#undef PG8_SB
#undef PG8_STAGE
#undef PG8_LDA
#undef PG8_LDB
#undef PG8_MMA
#undef PG8_WAIT_V
#undef PG8_WAIT_L
#undef PG8_BAR
#undef PG8_SCHED
}
}

struct EpiProj {
    static constexpr bool PERM = true;
    bf16_t* O; int ldc; LAS const float* rl; int pm0, pm1, pm2, pm3;
    __device__ __forceinline__ void operator()(const f32x4 (&acc)[2][2][4][2], const pg8::Unit& u, int wr, int wc, int fr, int fq) const {
        const int row0 = u.pm * 256 + wr * 64 + fr, col0 = u.pn * 256 + wc * 32 + 8 * fq;
        const int sel = u.pm == pm0 ? 0 : (u.pm == pm1 ? 1 : (u.pm == pm2 ? 2 : 3));
        LAS const float* rp = rl + sel * 256 + wr * 64 + fr;
#pragma unroll
        for (int ai = 0; ai < 2; ++ai)
#pragma unroll
            for (int m = 0; m < 4; ++m) {
                const int row = row0 + ai * 128 + m * 16;
                const float rstd = rp[ai * 128 + m * 16];
                bf16_t* rowp = O + (size_t)row * ldc + col0;
#pragma unroll
                for (int bj = 0; bj < 2; ++bj) {
                    const f32x4 v0 = acc[ai][bj][m][0] * rstd, v1 = acc[ai][bj][m][1] * rstd;
                    u32x4 w; w.x = cvt_pk_bf16(v0[0], v0[1]); w.y = cvt_pk_bf16(v0[2], v0[3]); w.z = cvt_pk_bf16(v1[0], v1[1]); w.w = cvt_pk_bf16(v1[2], v1[3]);
                    *(u32x4*)(rowp + bj * 128) = w;
                }
            }
    }
};
struct X8 { f32x4 lo, hi; };
template <bool FIRST> __device__ __forceinline__ X8 ld_x8(const float* __restrict__ s32, const bf16_t* __restrict__ s16, size_t o) {
    X8 r;
    if (FIRST) { r.lo = *(const f32x4*)(s32 + o); r.hi = *(const f32x4*)(s32 + o + 4); }
    else { const u32x4 u = *(const u32x4*)(s16 + o); r.lo = cvt4((u32x2){u.x, u.y}); r.hi = cvt4((u32x2){u.z, u.w}); }
    return r;
}
__device__ __forceinline__ void st_x8(bf16_t* p, f32x4 lo, f32x4 hi) { u32x4 w; w.x = cvt_pk_bf16(lo[0], lo[1]); w.y = cvt_pk_bf16(lo[2], lo[3]); w.z = cvt_pk_bf16(hi[0], hi[1]); w.w = cvt_pk_bf16(hi[2], hi[3]); *(u32x4*)p = w; }
template <bool FIRST>
__device__ __forceinline__ void epi_res_rows(const f32x4 (&acc)[2][2][4][2], const float* __restrict__ src32, const bf16_t* __restrict__ src16, bf16_t* __restrict__ Xb, float* __restrict__ ssqp,
                                             int row0, int col0, int slot, int fq) {
    if constexpr (FIRST) {
#pragma unroll
        for (int ai = 0; ai < 2; ++ai) {
            X8 x[4][2];
#pragma unroll
            for (int m = 0; m < 4; ++m)
#pragma unroll
                for (int bj = 0; bj < 2; ++bj) x[m][bj] = ld_x8<true>(src32, src16, (size_t)(row0 + ai * 128 + m * 16) * 1024 + col0 + bj * 128);
#pragma unroll
            for (int m = 0; m < 4; ++m) {
                const int row = row0 + ai * 128 + m * 16;
                float part = 0.f;
#pragma unroll
                for (int bj = 0; bj < 2; ++bj) {
                    const f32x4 lo = x[m][bj].lo + acc[ai][bj][m][0], hi = x[m][bj].hi + acc[ai][bj][m][1];
                    st_x8(Xb + (size_t)row * 1024 + col0 + bj * 128, lo, hi);
                    part += dot4(lo, lo) + dot4(hi, hi);
                }
                part += __shfl_xor(part, 16); part += __shfl_xor(part, 32);
                if (fq == 0) ssqp[(size_t)row * 16 + slot] = part;
            }
        }
    } else {
        u32x4 xr[2][4][2];
#pragma unroll
        for (int ai = 0; ai < 2; ++ai)
#pragma unroll
            for (int m = 0; m < 4; ++m)
#pragma unroll
                for (int bj = 0; bj < 2; ++bj) xr[ai][m][bj] = *(const u32x4*)(src16 + (size_t)(row0 + ai * 128 + m * 16) * 1024 + col0 + bj * 128);
#pragma unroll
        for (int ai = 0; ai < 2; ++ai)
#pragma unroll
            for (int m = 0; m < 4; ++m) {
                const int row = row0 + ai * 128 + m * 16;
                float part = 0.f;
#pragma unroll
                for (int bj = 0; bj < 2; ++bj) {
                    const u32x4 u = xr[ai][m][bj];
                    const f32x4 lo = cvt4((u32x2){u.x, u.y}) + acc[ai][bj][m][0], hi = cvt4((u32x2){u.z, u.w}) + acc[ai][bj][m][1];
                    st_x8(Xb + (size_t)row * 1024 + col0 + bj * 128, lo, hi);
                    part += dot4(lo, lo) + dot4(hi, hi);
                }
                part += __shfl_xor(part, 16); part += __shfl_xor(part, 32);
                if (fq == 0) ssqp[(size_t)row * 16 + slot] = part;
            }
    }
}
struct EpiRes {
    static constexpr bool PERM = true;
    const float* xp; const float* xs; bf16_t* Xb; float* ssq_next;
    __device__ __forceinline__ void operator()(const f32x4 (&acc)[2][2][4][2], const pg8::Unit& u, int wr, int wc, int fr, int fq) const {
        const int row0 = u.pm * 256 + wr * 64 + fr, col0 = u.pn * 256 + wc * 32 + 8 * fq;
        if (xp) epi_res_rows<true>(acc, row0 < NTP ? xp : xs - (size_t)NTP * 1024, nullptr, Xb, ssq_next, row0, col0, u.pn * 4 + wc, fq);
        else epi_res_rows<false>(acc, nullptr, Xb, Xb, ssq_next, row0, col0, u.pn * 4 + wc, fq);
    }
};

template <bool FIRST>
__device__ __forceinline__ void res_sample_tile(const Ctx cx, const bf16_t* __restrict__ A, const bf16_t* __restrict__ Bt, const float* __restrict__ xs, bf16_t* __restrict__ Xb, float* __restrict__ ssqp, int tile) {
    const int tid = cx.tid, wid = tid >> 6, lane = tid & 63, fr = lane & 15, fq = lane >> 4;
    const int tm = tile >> 3, tn = tile & 7;
    const int r0 = NTP + tm * 64 + (wid & 3) * 16, c0 = tn * 128 + (wid >> 2) * 64;
    const bf16_t* ap = A + (size_t)(r0 + fr) * 1024 + fq * 8;
    const bf16_t* bp = Bt + (size_t)(c0 + fr) * 1024 + fq * 8;
    f32x4 acc[4];
#pragma unroll
    for (int nt = 0; nt < 4; ++nt) acc[nt] = (f32x4){0.f, 0.f, 0.f, 0.f};
#pragma unroll 8
    for (int ks = 0; ks < 32; ++ks) {
        const bf16x8 af = *(const bf16x8*)(ap + ks * 32);
#pragma unroll
        for (int nt = 0; nt < 4; ++nt) {
            const bf16x8 bf = *(const bf16x8*)(bp + (size_t)nt * 16 * 1024 + ks * 32);
            acc[nt] = __builtin_amdgcn_mfma_f32_16x16x32_bf16(bf, af, acc[nt], 0, 0, 0);
        }
    }
    const int row = r0 + fr;
    float part = 0.f;
#pragma unroll
    for (int nt = 0; nt < 4; ++nt) {
        const int col = c0 + nt * 16 + fq * 4;
        const f32x4 xo = FIRST ? *(const f32x4*)(xs + (size_t)(row - NTP) * 1024 + col) : ld_bf4(Xb + (size_t)row * 1024 + col);
        const f32x4 v = xo + acc[nt];
        st_bf4(Xb + (size_t)row * 1024 + col, v);
        part += dot4(v, v);
    }
    part += __shfl_xor(part, 16); part += __shfl_xor(part, 32);
    if (fq == 0) ssqp[(size_t)row * 16 + (c0 >> 6)] = part;
}

struct TrJob { const float* src; int ld, col0, k0; bf16_t* dst; int Ktot, drow0; const float* scale; bool zero; };
__device__ __forceinline__ TrJob tr_decode(const Params& p, const Ctx cx, int job) {
    TrJob J; J.zero = false; J.scale = nullptr;
    int j = job;
    if (j < 2176) {
        const int i = j / 1088, r = j % 1088, nt = r / 16, kt = r % 16, n0 = nt * 64;
        int col0 = 0;
        if (n0 < 2048) col0 = n0; else if (n0 < 2560) col0 = 3712 + (n0 - 2048); else if (n0 < 4224) col0 = 2048 + (n0 - 2560); else J.zero = true;
        J.src = PIN(I_WINE) + (size_t)i * 1024 * 4224; J.ld = 4224; J.col0 = col0; J.k0 = kt * 64; J.dst = (bf16_t*)(PWS + WS_WINE) + (size_t)i * 4352 * 1024; J.Ktot = 1024; J.drow0 = n0; J.scale = PIN(I_NORMW) + (2 * i) * 1024;
        return J;
    }
    j -= 2176;
    if (j < 512) { const int i = j / 256, r = j % 256, nt = r / 16, kt = r % 16;
        J.src = PIN(I_WOUTE) + (size_t)i * 1024 * 1024; J.ld = 1024; J.col0 = nt * 64; J.k0 = kt * 64; J.dst = (bf16_t*)(PWS + WS_WOUTE) + (size_t)i * 1024 * 1024; J.Ktot = 1024; J.drow0 = nt * 64; return J; }
    j -= 512;
    if (j < 1280) { const int i = j / 640, r = j % 640, nt = r / 16, kt = r % 16;
        J.src = PIN(I_WINO) + (size_t)i * 1024 * 2560; J.ld = 2560; J.col0 = nt * 64; J.k0 = kt * 64; J.dst = (bf16_t*)(PWS + WS_WINO) + (size_t)i * 2560 * 1024; J.Ktot = 1024; J.drow0 = nt * 64; J.scale = PIN(I_NORMW) + (2 * i + 1) * 1024; return J; }
    j -= 1280;
    if (j < 512) { const int i = j / 256, r = j % 256, nt = r / 16, kt = r % 16;
        J.src = PIN(I_WOUTO) + (size_t)i * 1024 * 1024; J.ld = 1024; J.col0 = nt * 64; J.k0 = kt * 64; J.dst = (bf16_t*)(PWS + WS_WOUTO) + (size_t)i * 1024 * 1024; J.Ktot = 1024; J.drow0 = nt * 64; return J; }
    j -= 512;
    if (j < 16) { const int i = j / 8, nt = j % 8;
        J.src = PIN(I_W2) + (size_t)i * 64 * 512; J.ld = 512; J.col0 = nt * 64; J.k0 = 0; J.dst = (bf16_t*)(PWS + WS_W2T) + (size_t)i * 512 * 64; J.Ktot = 64; J.drow0 = nt * 64; return J; }
    j -= 16;
    if (j < 16) { const int i = j / 8, nt = j % 8;
        J.src = PIN(I_A2) + (size_t)i * 64 * 512; J.ld = 512; J.col0 = nt * 64; J.k0 = 0; J.dst = (bf16_t*)(PWS + WS_A2T) + (size_t)i * 512 * 64; J.Ktot = 64; J.drow0 = nt * 64; return J; }
    j -= 16;
    { const int ig = j / 4, r = j % 4, nt = r / 2, kt = r % 2;
        J.src = PIN(I_POOLW) + (size_t)ig * 128 * 128; J.ld = 128; J.col0 = nt * 64; J.k0 = kt * 64; J.dst = (bf16_t*)(PWS + WS_POOLWT) + (size_t)ig * 128 * 128; J.Ktot = 128; J.drow0 = nt * 64; }
    return J;
}
__device__ __forceinline__ void tr_load(const TrJob& J, int tid, f32x4& va, f32x4& vb) {
    const int nn = (tid & 15) * 4, ka = tid >> 4, kb = ka + 32;
    va = (f32x4){0.f, 0.f, 0.f, 0.f}; vb = va;
    if (!J.zero) {
        va = *(const f32x4*)(J.src + (size_t)(J.k0 + ka) * J.ld + J.col0 + nn); vb = *(const f32x4*)(J.src + (size_t)(J.k0 + kb) * J.ld + J.col0 + nn);
        if (J.scale) { va = va * J.scale[J.k0 + ka]; vb = vb * J.scale[J.k0 + kb]; }
    }
}

__device__ void phase_prepass(const Params& p, const Ctx cx, LAS unsigned char* lds) {
    LAS float* T = (LAS float*)lds;
    const int tid = cx.tid;
    {
        int job = cx.bid;
        f32x4 va = (f32x4){0.f, 0.f, 0.f, 0.f}, vb = va;
        if (job < 4544) { const TrJob J0 = tr_decode(p, cx, job); tr_load(J0, tid, va, vb); }
        for (; job < 4544; job += cx.nblk) {
            f32x4 na = va, nb = vb;
            if (job + (int)cx.nblk < 4544) { const TrJob Jn = tr_decode(p, cx, job + (int)cx.nblk); tr_load(Jn, tid, na, nb); }
            {
                const int nn = (tid & 15) * 4, ka = tid >> 4, kb = ka + 32;
                T[ka * 65 + nn] = va[0]; T[ka * 65 + nn + 1] = va[1]; T[ka * 65 + nn + 2] = va[2]; T[ka * 65 + nn + 3] = va[3];
                T[kb * 65 + nn] = vb[0]; T[kb * 65 + nn + 1] = vb[1]; T[kb * 65 + nn + 2] = vb[2]; T[kb * 65 + nn + 3] = vb[3];
            }
            __syncthreads();
            {
                const TrJob J = tr_decode(p, cx, job);
                const int n = tid >> 3, kc = (tid & 7) * 8;
                u32x4 w;
                w.x = cvt_pk_bf16(T[(kc + 0) * 65 + n], T[(kc + 1) * 65 + n]); w.y = cvt_pk_bf16(T[(kc + 2) * 65 + n], T[(kc + 3) * 65 + n]);
                w.z = cvt_pk_bf16(T[(kc + 4) * 65 + n], T[(kc + 5) * 65 + n]); w.w = cvt_pk_bf16(T[(kc + 6) * 65 + n], T[(kc + 7) * 65 + n]);
                *(u32x4*)(J.dst + (size_t)(J.drow0 + n) * J.Ktot + J.k0 + kc) = w;
            }
            __syncthreads();
            va = na; vb = nb;
        }
    }
    const int gtid = cx.bid * 512 + tid, gthreads = cx.nblk * 512;
    for (int e = gtid; e < 8 * 128 * 128; e += gthreads) {
        const int s = e & 127, t = (e >> 7) & 127;
        ((bf16_t*)(PWS + WS_SPW))[e] = (s <= t) ? (bf16_t)(cvt_pk_bf16(PIN(I_SPW)[e], 0.f) & 0xffffu) : (bf16_t)0;
    }
    const int wid = tid >> 6, lane = tid & 63;
    for (int row0 = cx.bid * 8 + wid; row0 < NTOK; row0 += cx.nblk * 8 * 3) {
        f32x4 v[3][4];
#pragma unroll
        for (int r = 0; r < 3; ++r) {
            const int row = row0 + r * cx.nblk * 8; const int rr = row < NTOK ? row : row0;
            const float* src = rr < NTP ? PIN(I_XP) + (size_t)rr * 1024 : PIN(I_XS) + (size_t)(rr - NTP) * 1024;
#pragma unroll
            for (int i = 0; i < 4; ++i) v[r][i] = *(const f32x4*)(src + i * 256 + lane * 4);
        }
#pragma unroll
        for (int r = 0; r < 3; ++r) {
            const int row = row0 + r * cx.nblk * 8;
            if (row < NTOK) {
                bf16_t* dst = (bf16_t*)(PWS + WS_XB) + (size_t)row * 1024;
                float ss = 0.f;
#pragma unroll
                for (int i = 0; i < 4; ++i) { ss += dot4(v[r][i], v[r][i]); st_bf4(dst + i * 256 + lane * 4, v[r][i]); }
#pragma unroll
                for (int o = 32; o >= 1; o >>= 1) ss += __shfl_xor(ss, o);
                if (lane < 16) ((float*)(PWS + WS_SSQ))[(size_t)row * 16 + lane] = (lane == 0) ? ss : 0.f;
            }
        }
    }
}

__device__ __forceinline__ f32x4 shift4(const bf16_t* cur, bool hp, const float* st, int col, const float* mu) {
    const f32x4 q = ld_bf4(cur + col);
    f32x4 pv;
    if (hp) pv = ld_bf4(cur - LDB + col); else if (st) pv = *(const f32x4*)(st + col); else pv = (f32x4){0.f, 0.f, 0.f, 0.f};
    const f32x4 m = *(const f32x4*)(mu + col);
    return q + m * (pv - q);
}

__device__ void phase_even_prep(const Params& p, const Ctx cx, int pair, LAS unsigned char* lds) {
    const int tid = cx.tid, wid = tid >> 6, lane = tid & 63, fr = lane & 15, fq = lane >> 4;
    const bf16_t* PB = (const bf16_t*)(PWS + WS_PROJB);
    float* Wdec = (float*)(PWS + WS_WDEC);
    bf16_t* Aa = (bf16_t*)(PWS + WS_AA);
    bf16_t* Ycat = (bf16_t*)(PWS + WS_YCAT);
    const float* mu_ = PIN(I_MU) + pair * 1664;
    const float* w0_ = PIN(I_W0) + pair * 512; const float* a0_ = PIN(I_A0) + pair * 512;
    const float* k_a_ = PIN(I_KA) + pair * 512; const float* r_k_ = PIN(I_RK) + pair * 512;
    constexpr int RS = 3344;
    constexpr int TB = 17 * RS;
    constexpr int NCH = 17 * 208;
    const int h = wid;
    bf16x8 wfr[4][2], afr[4][2];
    {
        const bf16_t* W2T = (const bf16_t*)(PWS + WS_W2T) + (size_t)pair * 512 * 64;
        const bf16_t* A2T = (const bf16_t*)(PWS + WS_A2T) + (size_t)pair * 512 * 64;
#pragma unroll
        for (int nt = 0; nt < 4; ++nt)
#pragma unroll
            for (int ks = 0; ks < 2; ++ks) {
                wfr[nt][ks] = *(const bf16x8*)(W2T + (size_t)(h * 64 + nt * 16 + fr) * 64 + ks * 32 + fq * 8);
                afr[nt][ks] = *(const bf16x8*)(A2T + (size_t)(h * 64 + nt * 16 + fr) * 64 + ks * 32 + fq * 8);
            }
    }
    constexpr int TBD = 56 * 1024;
    const int widu = __builtin_amdgcn_readfirstlane(tid >> 6);
#define PREP_DMA(tile_, b_, lane_) do { _Pragma("unroll") for (int i_ = 0; i_ < 7; ++i_) { const int k_ = widu * 7 + i_, q_ = k_ * 64 + (lane_); \
            int lr_ = q_ / 209, cc_ = q_ - lr_ * 209; if (lr_ > 16) { lr_ = 16; cc_ = 0; } if (cc_ > 207) cc_ = 0; \
            int gr_ = (tile_) * 16 - 1 + lr_; gr_ = gr_ < 0 ? 0 : gr_; \
            __builtin_amdgcn_global_load_lds((const unsigned*)(PB + (size_t)gr_ * LDB + cc_ * 8), (LAS unsigned*)(lds + (b_) * TBD + k_ * 1024), 16, 0, 0); } } while (0)
    LAS float* CL = (LAS float*)(lds + 2 * TBD);
    {
        const float f0 = mu_[tid], f1 = mu_[tid + 512], f2 = mu_[tid + 1024], f3 = tid < 128 ? mu_[tid + 1536] : 0.f;
        const float f4 = w0_[tid], f5 = a0_[tid], f6 = k_a_[tid], f7 = r_k_[tid];
        CL[tid] = f0; CL[tid + 512] = f1; CL[tid + 1024] = f2; if (tid < 128) CL[tid + 1536] = f3;
        CL[1664 + tid] = f4; CL[2176 + tid] = f5; CL[2688 + tid] = f6; CL[3200 + tid] = f7;
    }
    int buf = 0;
    if ((int)cx.bid < NTOK / 16) PREP_DMA((int)cx.bid, 0, tid & 63);
    asm volatile("s_waitcnt vmcnt(0)" ::: "memory");
    __syncthreads();
    for (int tile = cx.bid; tile < NTOK / 16; tile += cx.nblk) {
        int zz; asm volatile("v_mov_b32 %0, 0" : "=v"(zz));
        const int tidv = tid + zz, fr = (tidv & 15), fq = (tidv >> 4) & 3;
        if (tile + (int)cx.nblk < NTOK / 16) PREP_DMA(tile + (int)cx.nblk, buf ^ 1, tidv & 63);
        {
            const int row = tile * 16 + fr;
            const bool samp = row >= NTP;
            int b, t; if (!samp) { b = row >> 11; t = row & 2047; } else { const int q = row - NTP; b = q >> 3; t = q & 7; }
            const bool hp = t > 0;
            const float* st = samp ? PIN(I_SSHIFT) + ((size_t)pair * 128 + b) * 1664 : nullptr;
            LAS const float* mu = CL; LAS const float* w0 = CL + 1664; LAS const float* a0 = CL + 2176; LAS const float* k_a = CL + 2688; LAS const float* r_k = CL + 3200;
            LAS const unsigned char* curL = lds + buf * TBD + (fr + 1) * RS;
            LAS const unsigned char* prvL = lds + buf * TBD + fr * RS;
            auto sh4 = [&](int col) -> f32x4 {
                const f32x4 q = cvt4(*(LAS const u32x2*)(curL + col * 2));
                f32x4 pv;
                if (hp) pv = cvt4(*(LAS const u32x2*)(prvL + col * 2)); else if (st) pv = *(const f32x4*)(st + col); else pv = (f32x4){0.f, 0.f, 0.f, 0.f};
                const f32x4 m = *(LAS const f32x4*)(mu + col);
                return q + m * (pv - q);
            };
            bf16x8 Aw[2], Al[2];
#pragma unroll
            for (int ks = 0; ks < 2; ++ks) {
                const int cw = 1536 + ks * 32 + fq * 8, ca = 1600 + ks * 32 + fq * 8;
                const f32x4 w_lo = sh4(cw), w_hi = sh4(cw + 4), a_lo = sh4(ca), a_hi = sh4(ca + 4);
                u32x4 pw, pa;
                float th[8];
#pragma unroll
                for (int j = 0; j < 4; ++j) { th[j] = 2.0f * sigmoidf_(2.0f * w_lo[j]) - 1.0f; th[4 + j] = 2.0f * sigmoidf_(2.0f * w_hi[j]) - 1.0f; }
                pw.x = cvt_pk_bf16(th[0], th[1]); pw.y = cvt_pk_bf16(th[2], th[3]); pw.z = cvt_pk_bf16(th[4], th[5]); pw.w = cvt_pk_bf16(th[6], th[7]);
                pa.x = cvt_pk_bf16(a_lo[0], a_lo[1]); pa.y = cvt_pk_bf16(a_lo[2], a_lo[3]); pa.z = cvt_pk_bf16(a_hi[0], a_hi[1]); pa.w = cvt_pk_bf16(a_hi[2], a_hi[3]);
                Aw[ks] = __builtin_bit_cast(bf16x8, pw); Al[ks] = __builtin_bit_cast(bf16x8, pa);
            }
            float bon = 0.f;
#pragma unroll
            for (int nt = 0; nt < 4; ++nt) {
                f32x4 lw = (f32x4){0.f, 0.f, 0.f, 0.f}, la = (f32x4){0.f, 0.f, 0.f, 0.f};
#pragma unroll
                for (int ks = 0; ks < 2; ++ks) {
                    lw = __builtin_amdgcn_mfma_f32_16x16x32_bf16(wfr[nt][ks], Aw[ks], lw, 0, 0, 0);
                    la = __builtin_amdgcn_mfma_f32_16x16x32_bf16(afr[nt][ks], Al[ks], la, 0, 0, 0);
                }
                const int ch = h * 64 + nt * 16 + fq * 4;
                const f32x4 r4 = sh4(ch), k4 = sh4(512 + ch);
                const f32x4 w04 = *(LAS const f32x4*)(w0 + ch), a04 = *(LAS const f32x4*)(a0 + ch), ka4 = *(LAS const f32x4*)(k_a + ch), rk4 = *(LAS const f32x4*)(r_k + ch);
                f32x4 dec, av;
#pragma unroll
                for (int j = 0; j < 4; ++j) {
                    const float z_ = -(w04[j] + lw[j]);
                    const float wlog = -__logf(1.0f + __expf(z_)) - 0.5f;
                    dec[j] = __expf(-__expf(wlog));
                    av[j] = sigmoidf_(a04[j] + la[j]);
                    const float kp = k4[j] * (1.0f + (av[j] - 1.0f) * ka4[j]);
                    bon += r4[j] * kp * rk4[j];
                }
                *(f32x4*)(Wdec + (size_t)row * 512 + ch) = dec;
                st_bf4(Aa + (size_t)row * 512 + ch, av);
            }
            bon += __shfl_xor(bon, 16); bon += __shfl_xor(bon, 32);
#pragma unroll
            for (int nt = 0; nt < 4; ++nt) { const int ch = h * 64 + nt * 16 + fq * 4; st_bf4(Ycat + (size_t)row * 1024 + 512 + ch, sh4(1024 + ch) * bon); }
        }
        asm volatile("s_waitcnt vmcnt(0)" ::: "memory");
        __syncthreads();
        buf ^= 1;
    }
#undef PREP_DMA
    const int gtid = cx.bid * 512 + tid, gthreads = cx.nblk * 512;
    for (int e = gtid; e < 136 * 1664; e += gthreads) {
        const int sr = e / 1664, c = e % 1664;
        if (sr < 8) POUT[O_SHIFTP + ((size_t)pair * 8 + sr) * 1664 + c] = bf2f(PB[(size_t)(sr * 2048 + 2047) * LDB + c]);
        else { const int b = sr - 8; POUT[O_SHIFTS + ((size_t)pair * 128 + b) * 1664 + c] = bf2f(PB[(size_t)(NTP + b * 8 + 7) * LDB + c]); }
    }
}

typedef float f32x2 __attribute__((ext_vector_type(2)));
template <bool RED = true>
__device__ __forceinline__ void scan_step(f32x4& S, const f32x4 w, const f32x4 k, const f32x4 kk, const f32x4 nb, const f32x4 r, const float v, float& y) {
    const f32x2 S01 = {S[0], S[1]}, S23 = {S[2], S[3]};
    f32x2 pp = S01 * (f32x2){kk[0], kk[1]};
    pp = S23 * (f32x2){kk[2], kk[3]} + pp;
    float pd = pp[0] + pp[1];
    const f32x2 vv = {v, v};
    const f32x2 t01 = S01 * (f32x2){w[0], w[1]} + (f32x2){k[0], k[1]} * vv;
    const f32x2 t23 = S23 * (f32x2){w[2], w[3]} + (f32x2){k[2], k[3]} * vv;
    pd = allsum16(pd);
    const f32x2 pdv = {pd, pd};
    const f32x2 n01 = (f32x2){nb[0], nb[1]} * pdv + t01, n23 = (f32x2){nb[2], nb[3]} * pdv + t23;
    S = (f32x4){n01[0], n01[1], n23[0], n23[1]};
    f32x2 q = n01 * (f32x2){r[0], r[1]};
    q = n23 * (f32x2){r[2], r[3]} + q;
    y = RED ? allsum16(q[0] + q[1]) : (q[0] + q[1]);
}
__device__ __forceinline__ float reduce_scatter16(const float (&yp)[16], int cgi) {
    const bool b3 = cgi & 8, b2 = cgi & 4, b1 = cgi & 2, b0 = cgi & 1;
    float a[8], bq[4], c[2];
#pragma unroll
    for (int j = 0; j < 8; ++j) { const float keep = b3 ? yp[8 + j] : yp[j], send = b3 ? yp[j] : yp[8 + j]; a[j] = keep + dpp_f<0x128>(send); }
#pragma unroll
    for (int k = 0; k < 4; ++k) { const float keep = b2 ? a[4 + k] : a[k], send = b2 ? a[k] : a[4 + k]; bq[k] = keep + dpp_f<0x141>(send); }
#pragma unroll
    for (int m = 0; m < 2; ++m) { const float keep = b1 ? bq[2 + m] : bq[m], send = b1 ? bq[m] : bq[2 + m]; c[m] = keep + dpp_f<0x4E>(send); }
    const float keep = b0 ? c[1] : c[0], send = b0 ? c[0] : c[1];
    return keep + dpp_f<0xB1>(send);
}

__device__ void phase_scan(const Params& p, const Ctx cx, int pair, LAS unsigned char* lds) {
    const int tid = cx.tid, wid = tid >> 6, lane = tid & 63, rs = lane >> 4, cgi = lane & 15;
    const bf16_t* PB = (const bf16_t*)(PWS + WS_PROJB);
    const float* Wdec = (const float*)(PWS + WS_WDEC);
    const bf16_t* Aa = (const bf16_t*)(PWS + WS_AA);
    float* Y = (float*)(PWS + WS_Y);
    const float* mu = PIN(I_MU) + pair * 1664;
    const float* k_k = PIN(I_KK) + pair * 512; const float* k_a = PIN(I_KA) + pair * 512;
    {
        LAS float* vb = (LAS float*)lds + wid * 3072;
        for (int st = cx.bid * 8 + wid; st < 2048; st += cx.nblk * 8) {
            const int bh = st >> 1, half = st & 1, b = bh >> 3, h = bh & 7, ch = h * 64 + cgi * 4;
            const float* stp = PIN(I_SSHIFT) + ((size_t)pair * 128 + b) * 1664;
            const f32x4 kkc = *(const f32x4*)(k_k + ch), kac = *(const f32x4*)(k_a + ch);
            {
#pragma unroll
                for (int tt = 0; tt < 2; ++tt) {
                    const int t = rs + tt * 4;
                    const size_t row = NTP + b * 8 + t;
                    const bf16_t* cur = PB + row * LDB;
                    const f32x4 r = shift4(cur, t > 0, stp, ch, mu), k = shift4(cur, t > 0, stp, 512 + ch, mu), v = shift4(cur, t > 0, stp, 1024 + ch, mu);
                    const f32x4 a = ld_bf4(Aa + row * 512 + ch);
                    const f32x4 w = *(const f32x4*)(Wdec + row * 512 + ch);
                    const f32x4 kkv = k * kkc;
                    const float ss = allsum16(dot4(kkv, kkv));
                    const float inv = 1.0f / fmaxf(sqrtf(ss), 1e-12f);
                    const f32x4 kkn = kkv * inv;
                    LAS float* o = vb + t * 384 + cgi * 4;
                    *(LAS f32x4*)(o) = w; *(LAS f32x4*)(o + 64) = k * (1.0f + (a - 1.0f) * kac); *(LAS f32x4*)(o + 128) = kkn; *(LAS f32x4*)(o + 192) = -(kkn * a);
                    *(LAS f32x4*)(o + 256) = r; *(LAS f32x4*)(o + 320) = v;
                }
            }
            asm volatile("s_waitcnt lgkmcnt(0)" ::: "memory");
            __builtin_amdgcn_wave_barrier();
            const size_t so0 = ((((size_t)pair * 128 + b) * 8 + h) * 64 + half * 32 + rs) * 64 + cgi * 4;
            f32x4 Snext = *(const f32x4*)(PIN(I_SWKV) + so0);
#pragma unroll 1
            for (int rq = 0; rq < 8; ++rq) {
                const int ri = half * 32 + rq * 4 + rs;
                const size_t so = so0 + (size_t)rq * 256;
                f32x4 S = Snext;
                if (rq + 1 < 8) Snext = *(const f32x4*)(PIN(I_SWKV) + so + 256);
                float ykeep = 0.f;
#pragma unroll
                for (int t = 0; t < 8; ++t) {
                    LAS const float* r0 = vb + t * 384 + cgi * 4;
                    float y; scan_step(S, *(LAS const f32x4*)(r0), *(LAS const f32x4*)(r0 + 64), *(LAS const f32x4*)(r0 + 128), *(LAS const f32x4*)(r0 + 192), *(LAS const f32x4*)(r0 + 256), vb[t * 384 + 320 + ri], y);
                    ykeep = (cgi == t) ? y : ykeep;
                }
                if (cgi < 8) Y[(size_t)(NTP + b * 8 + cgi) * 512 + h * 64 + ri] = ykeep;
                *(f32x4*)(POUT + O_WKVS + so) = S;
            }
            asm volatile("s_waitcnt lgkmcnt(0)" ::: "memory");
            __builtin_amdgcn_wave_barrier();
        }
    }
    __syncthreads();
    LAS float* rec = (LAS float*)lds;
    for (int pt = cx.bid; pt < 256; pt += cx.nblk) {
        const int xcd = pt & 7, slot = pt >> 3, bh = xcd * 8 + (slot >> 2), rg = slot & 3, b = bh >> 3, h = bh & 7;
        const int lt = tid - 256, ls = (lt >> 4) & 15, lcg = lt & 15, lch = h * 64 + lcg * 4;
        u32x2 qr = {0u, 0u}, qk = {0u, 0u}, qv = {0u, 0u}, pr = {0u, 0u}, pk = {0u, 0u}, pv = {0u, 0u}, qa = {0u, 0u};
        f32x4 qw = (f32x4){0.f, 0.f, 0.f, 0.f};
        f32x4 mur, muk, muv, kkc, kac;
        const int ri = rg * 16 + (wid & 3) * 4 + rs;
        f32x4 S = (f32x4){0.f, 0.f, 0.f, 0.f};
#define SCAN_ISSUE(c) do { const int t_ = (c) * 16 + ls; const size_t row_ = (size_t)b * 2048 + t_; const bf16_t* cur_ = PB + row_ * LDB; \
            qr = *(const u32x2*)(cur_ + lch); qk = *(const u32x2*)(cur_ + 512 + lch); qv = *(const u32x2*)(cur_ + 1024 + lch); \
            if (t_ > 0) { pr = *(const u32x2*)(cur_ - LDB + lch); pk = *(const u32x2*)(cur_ - LDB + 512 + lch); pv = *(const u32x2*)(cur_ - LDB + 1024 + lch); } \
            else { pr = (u32x2){0u, 0u}; pk = pr; pv = pr; } \
            qw = *(const f32x4*)(Wdec + row_ * 512 + lch); qa = *(const u32x2*)(Aa + row_ * 512 + lch); } while (0)
#define SCAN_PROCESS(buf) do { const f32x4 r0_ = cvt4(qr), k0_ = cvt4(qk), v0_ = cvt4(qv); \
            const f32x4 r_ = r0_ + mur * (cvt4(pr) - r0_), k_ = k0_ + muk * (cvt4(pk) - k0_), v_ = v0_ + muv * (cvt4(pv) - v0_), a_ = cvt4(qa); \
            const f32x4 kkv_ = k_ * kkc; const float ss_ = allsum16(dot4(kkv_, kkv_)); const float inv_ = __builtin_amdgcn_rsqf(fmaxf(ss_, 1e-24f)); \
            const f32x4 kkn_ = kkv_ * inv_; \
            LAS float* o_ = rec + (buf) * 6144 + ls * 384 + lcg * 4; \
            *(LAS f32x4*)(o_) = qw; *(LAS f32x4*)(o_ + 64) = k_ * (1.0f + (a_ - 1.0f) * kac); *(LAS f32x4*)(o_ + 128) = kkn_; *(LAS f32x4*)(o_ + 192) = -(kkn_ * a_); \
            *(LAS f32x4*)(o_ + 256) = r_; *(LAS f32x4*)(o_ + 320) = v_; } while (0)
        if (wid >= 4) {
            mur = *(const f32x4*)(mu + lch); muk = *(const f32x4*)(mu + 512 + lch); muv = *(const f32x4*)(mu + 1024 + lch);
            kkc = *(const f32x4*)(k_k + lch); kac = *(const f32x4*)(k_a + lch);
            SCAN_ISSUE(0); SCAN_PROCESS(0); SCAN_ISSUE(1);
        }
        __syncthreads();
        for (int c = 0; c < 128; ++c) {
            if (wid < 4) {
                LAS const float* rb = rec + (c & 1) * 6144 + cgi * 4;
                LAS const float* rv = rec + (c & 1) * 6144 + 320 + ri;
                float yp[16];
                f32x4 nw = *(LAS const f32x4*)(rb), nk = *(LAS const f32x4*)(rb + 64), nkk = *(LAS const f32x4*)(rb + 128), nb = *(LAS const f32x4*)(rb + 192), nr = *(LAS const f32x4*)(rb + 256);
                float nv = rv[0];
#pragma unroll
                for (int s = 0; s < 16; ++s) {
                    const f32x4 cw = nw, ck = nk, ckk = nkk, cb = nb, cr = nr; const float cv = nv;
                    if (s + 1 < 16) {
                        LAS const float* r1 = rb + (s + 1) * 384;
                        nw = *(LAS const f32x4*)(r1); nk = *(LAS const f32x4*)(r1 + 64); nkk = *(LAS const f32x4*)(r1 + 128); nb = *(LAS const f32x4*)(r1 + 192); nr = *(LAS const f32x4*)(r1 + 256);
                        nv = rv[(s + 1) * 384];
                    }
                    scan_step<false>(S, cw, ck, ckk, cb, cr, cv, yp[s]);
                }
                Y[((size_t)b * 2048 + c * 16 + cgi) * 512 + h * 64 + ri] = reduce_scatter16(yp, cgi);
            } else {
                if (c + 1 < 128) { SCAN_PROCESS((c + 1) & 1); if (c + 2 < 128) SCAN_ISSUE(c + 2); }
            }
            __syncthreads();
        }
        if (wid < 4) *(f32x4*)(POUT + O_WKVP + ((((size_t)pair * 8 + b) * 8 + h) * 64 + ri) * 64 + cgi * 4) = S;
#undef SCAN_ISSUE
#undef SCAN_PROCESS
    }
}

__device__ void phase_even_post(const Params& p, const Ctx cx, int pair) {
    const int gtid = cx.bid * 512 + cx.tid, gthreads = cx.nblk * 512;
    const bf16_t* PA = (const bf16_t*)(PWS + WS_R1);
    bf16_t* Ycat = (bf16_t*)(PWS + WS_YCAT);
    const float* Y = (const float*)(PWS + WS_Y);
    constexpr int NIT = NTOK * 128, UB = 4;
    const float* gn_g = PIN(I_GNG) + pair * 512; const float* gn_b = PIN(I_GNB) + pair * 512;
    for (int e0 = gtid; e0 < NIT; e0 += gthreads * UB) {
        f32x4 y[UB], bv[UB], bz[UB], gg[UB], gb[UB]; bool ok[UB];
#pragma unroll
        for (int u = 0; u < UB; ++u) {
            const int e = e0 + u * gthreads; ok[u] = e < NIT;
            const int ee = ok[u] ? e : e0; const int row = ee >> 7, ch = (ee & 127) * 4;
            y[u] = *(const f32x4*)(Y + (size_t)row * 512 + ch);
            bv[u] = ld_bf4(Ycat + (size_t)row * 1024 + 512 + ch);
            bz[u] = ld_bf4(PA + (size_t)row * LDA + 2048 + ch);
            gg[u] = *(const f32x4*)(gn_g + ch); gb[u] = *(const f32x4*)(gn_b + ch);
        }
#pragma unroll
        for (int u = 0; u < UB; ++u) {
            const int e = e0 + u * gthreads;
            const int ee = ok[u] ? e : e0; const int row = ee >> 7, ch = (ee & 127) * 4;
            const float mean = allsum16(y[u][0] + y[u][1] + y[u][2] + y[u][3]) * (1.0f / 64.0f);
            const f32x4 d = y[u] - mean;
            const float var = allsum16(dot4(d, d)) * (1.0f / 64.0f);
            const float rstd = rsqrtf(var + 64e-5f);
            const f32x4 g = gg[u], bb = gb[u];
            f32x4 o;
#pragma unroll
            for (int j = 0; j < 4; ++j) o[j] = (d[j] * rstd * g[j] + bb[j] + bv[u][j]) * siluf_(bz[u][j]);
            if (ok[u]) st_bf4(Ycat + (size_t)row * 1024 + 512 + ch, o);
        }
    }
    const float* cw = PIN(I_CONVW) + pair * 3 * 512;
    constexpr int NRUN = (NTOK / 8) * 128;
    for (int e = gtid; e < NRUN; e += gthreads) {
        const int run = e >> 7, ch = (e & 127) * 4, row0 = run * 8;
        const bool samp = row0 >= NTP;
        int b, t0, T; if (!samp) { b = row0 >> 11; t0 = row0 & 2047; T = 2048; } else { b = (row0 - NTP) >> 3; t0 = 0; T = 8; }
        const bf16_t* base = PA + (size_t)row0 * LDA + ch;
        u32x2 rh[10], rc[10], rb[8], rz[8];
#pragma unroll
        for (int k = 0; k < 10; ++k) {
            const bool have = (k >= 2) || (t0 > 0);
            const bf16_t* pr = have ? base + (ptrdiff_t)(k - 2) * LDA : base;
            rh[k] = *(const u32x2*)(pr); rc[k] = *(const u32x2*)(pr + 1024);
        }
#pragma unroll
        for (int k = 0; k < 8; ++k) { rb[k] = *(const u32x2*)(base + (size_t)k * LDA + 512); rz[k] = *(const u32x2*)(base + (size_t)k * LDA + 1536); }
        const f32x4 k0 = *(const f32x4*)(cw + ch), k1 = *(const f32x4*)(cw + 512 + ch), k2 = *(const f32x4*)(cw + 1024 + ch);
        f32x4 um2, um1;
        if (t0 > 0) { um2 = cvt4(rc[0]) * cvt4(rh[0]); um1 = cvt4(rc[1]) * cvt4(rh[1]); }
        else if (samp) { const float* hist = PIN(I_SCONV) + ((size_t)pair * 128 + b) * 2 * 512 + ch; um2 = *(const f32x4*)(hist); um1 = *(const f32x4*)(hist + 512); }
        else { um2 = (f32x4){0.f, 0.f, 0.f, 0.f}; um1 = um2; }
#pragma unroll
        for (int k = 0; k < 8; ++k) {
            const f32x4 u0 = cvt4(rc[k + 2]) * cvt4(rh[k + 2]);
            const f32x4 conv = k0 * um2 + k1 * um1 + k2 * u0;
            const f32x4 ab = cvt4(rb[k]), az = cvt4(rz[k]);
            f32x4 o;
#pragma unroll
            for (int j = 0; j < 4; ++j) o[j] = ab[j] * conv[j] * siluf_(az[j]);
            const int row = row0 + k, t = t0 + k;
            st_bf4(Ycat + (size_t)row * 1024 + ch, o);
            if (t >= T - 2) {
                float* dst = samp ? POUT + O_CONVS + (((size_t)pair * 128 + b) * 2 + (t - (T - 2))) * 512 + ch : POUT + O_CONVP + (((size_t)pair * 8 + b) * 2 + (t - (T - 2))) * 512 + ch;
                *(f32x4*)dst = u0;
            }
            um2 = um1; um1 = u0;
        }
    }
}

template <int W>
__device__ __forceinline__ void pool_sample_run(const float* __restrict__ hist, const bf16_t* __restrict__ cur, LAS bf16_t* out) {
    f32x4 ext[23];
#pragma unroll
    for (int k = 0; k < 15; ++k) ext[k] = (k >= 16 - W) ? *(const f32x4*)(hist + (size_t)k * 512) : (f32x4){0.f, 0.f, 0.f, 0.f};
#pragma unroll
    for (int k = 0; k < 8; ++k) ext[15 + k] = ld_bf4(cur + (size_t)k * LDA);
    f32x4 sum = (f32x4){0.f, 0.f, 0.f, 0.f};
#pragma unroll
    for (int d = 0; d < W; ++d) sum += ext[15 - d];
#pragma unroll
    for (int t = 0; t < 8; ++t) {
        if (t > 0) sum += ext[15 + t] - ext[15 + t - W];
        const f32x4 pooled = sum * (1.0f / (float)W) - ext[15 + t];
        u32x2 u; u.x = cvt_pk_bf16(pooled[0], pooled[1]); u.y = cvt_pk_bf16(pooled[2], pooled[3]);
        *(LAS u32x2*)(out + t * 136) = u;
    }
}

__device__ void phase_odd_mixer(const Params& p, const Ctx cx, int pair, LAS unsigned char* lds) {
    const int tid = cx.tid, wid = tid >> 6, lane = tid & 63, fr = lane & 15, fq = lane >> 4;
    const bf16_t* PO = (const bf16_t*)(PWS + WS_R1);
    bf16_t* Ycat = (bf16_t*)(PWS + WS_YCAT);
    LAS bf16_t* LA = (LAS bf16_t*)lds;
    LAS bf16_t* LB = (LAS bf16_t*)(lds + 128 * 136 * 2);
    LAS float* stat = (LAS float*)(lds + 2 * 128 * 136 * 2);
    LAS float* LE = (LAS float*)(lds + 128 * 136 * 2);
    LAS bf16_t* LW = (LAS bf16_t*)(lds + 128 * 136 * 2 + 143 * 128 * 4);
    for (int di = 0; di < 8; ++di) {
        int tile, g0, ng;
        if (cx.nblk == 256) {
            if (di == 0) { tile = cx.bid >> 1; g0 = (cx.bid & 1) * 2; ng = 2; }
            else if (di == 1 && cx.bid < 32) { tile = 128 + (cx.bid >> 2); g0 = cx.bid & 3; ng = 1; }
            else break;
        } else { tile = cx.bid + di * cx.nblk; g0 = 0; ng = 4; if (tile >= 136) break; }
        const int r0 = tile * 128;
        const bool samp = r0 >= NTP;
        const int tl_ = tid >> 2, q_ = tid & 3;
        {
            const bf16_t* vr = PO + (size_t)(r0 + tl_) * LDA + 1536 + q_ * 128;
            float s_ = 0.f, ss = 0.f;
#pragma unroll
            for (int i = 0; i < 16; ++i) { const u32x4 raw = *(const u32x4*)(vr + i * 8); const f32x4 v0 = cvt4((u32x2){raw.x, raw.y}), v1 = cvt4((u32x2){raw.z, raw.w});
                s_ += (v0[0] + v0[1]) + (v0[2] + v0[3]) + (v1[0] + v1[1]) + (v1[2] + v1[3]); ss += dot4(v0, v0) + dot4(v1, v1); }
            s_ = allsum4(s_); ss = allsum4(ss);
            const float mean = s_ * (1.0f / 512.0f);
            const float var = fmaxf(ss * (1.0f / 512.0f) - mean * mean, 0.f);
            if (q_ == 0) { stat[tl_ * 2] = mean; stat[tl_ * 2 + 1] = rsqrtf(var + 1e-5f); }
        }
        LAS float* lnw = stat + 512;
        lnw[tid] = PIN(I_LNG)[pair * 512 + tid]; lnw[512 + tid] = PIN(I_LNB)[pair * 512 + tid];
        u32x2 rv[8]; u32x4 rw[4];
#define MIX_LOAD_G(gg) do { const bf16_t* vr_ = PO + (size_t)(r0 + tl_) * LDA + 1536 + (gg) * 128 + q_ * 32; \
            _Pragma("unroll") for (int i = 0; i < 8; ++i) rv[i] = *(const u32x2*)(vr_ + i * 4); \
            if (!samp) { const bf16_t* Ws_ = (const bf16_t*)(PWS + WS_SPW) + ((size_t)pair * 4 + (gg)) * 128 * 128; \
                _Pragma("unroll") for (int i = 0; i < 4; ++i) { const int e = tid + i * 512; rw[i] = *(const u32x4*)(Ws_ + (e >> 4) * 128 + (e & 15) * 8); } } } while (0)
        MIX_LOAD_G(g0);
        __syncthreads();
#pragma unroll 1
        for (int g = g0; g < g0 + ng; ++g) {
            u32x2 ur[8], dzr[8];
#pragma unroll
            for (int nt = 0; nt < 8; ++nt) { const size_t o_ = (size_t)(r0 + wid * 16 + fr) * LDA + g * 128 + nt * 16 + fq * 4; ur[nt] = *(const u32x2*)(PO + o_ + 1024); dzr[nt] = *(const u32x2*)(PO + o_ + 2048); }
            {
                const int row = r0 + tl_;
                const float mean = stat[tl_ * 2], rstd = stat[tl_ * 2 + 1];
                LAS const float* lg = lnw + g * 128 + q_ * 32; LAS const float* lb = lnw + 512 + g * 128 + q_ * 32;
#pragma unroll
                for (int i = 0; i < 8; ++i) {
                    const f32x4 v = cvt4(rv[i]);
                    const f32x4 vn = (v - mean) * rstd * *(LAS const f32x4*)(lg + i * 4) + *(LAS const f32x4*)(lb + i * 4);
                    if (samp) *(f32x4*)(POUT + O_CHUNKV + ((size_t)pair * 1024 + (row - NTP)) * 512 + g * 128 + q_ * 32 + i * 4) = vn;
                    {
                        const float p0 = dpp_f<0x104>(vn[0]), p1 = dpp_f<0x104>(vn[1]);
                        const float p2 = dpp_f<0x114>(vn[2]), p3 = dpp_f<0x114>(vn[3]);
                        const bool odd = tl_ & 1;
                        const unsigned wa = odd ? cvt_pk_bf16(p2, vn[2]) : cvt_pk_bf16(vn[0], p0);
                        const unsigned wb = odd ? cvt_pk_bf16(p3, vn[3]) : cvt_pk_bf16(vn[1], p1);
                        const int cb = q_ * 32 + i * 4 + (odd ? 2 : 0), tb = tl_ & ~1;
                        *(LAS unsigned*)(LB + (cb) * 136 + tb) = wa;
                        *(LAS unsigned*)(LB + (cb + 1) * 136 + tb) = wb;
                    }
                }
            }
            if (!samp) {
#pragma unroll
                for (int i = 0; i < 4; ++i) { const int e = tid + i * 512; *(LAS u32x4*)(LA + (e >> 4) * 136 + (e & 15) * 8) = rw[i]; }
            } else {
                const float* Wsrc = PIN(I_SPW) + ((size_t)pair * 4 + g) * 128 * 128;
                LAS float* w8 = stat + 256;
                if (tid < 64) w8[tid] = Wsrc[(tid >> 3) * 128 + (tid & 7)];
                __syncthreads();
                for (int e = tid; e < 128 * 128; e += 512) { const int t = e >> 7, s2 = e & 127;
                    const float v = ((t >> 3) == (s2 >> 3) && (s2 & 7) <= (t & 7)) ? w8[(t & 7) * 8 + (s2 & 7)] : 0.f;
                    LA[t * 136 + s2] = (bf16_t)(cvt_pk_bf16(v, 0.f) & 0xffffu); }
            }
            if (g + 1 < g0 + ng) MIX_LOAD_G(g + 1);
            __syncthreads();
            {
                const int tl = wid * 16 + fr, row = r0 + tl;
                const float bias = PIN(I_SPB)[((size_t)pair * 4 + g) * 128 + (samp ? (tl & 7) : tl)];
                bf16x8 wf[4];
#pragma unroll
                for (int ks = 0; ks < 4; ++ks) wf[ks] = *(const LAS bf16x8*)(LA + tl * 136 + ks * 32 + fq * 8);
#pragma unroll
                for (int nt = 0; nt < 8; ++nt) {
                    f32x4 acc = (f32x4){0.f, 0.f, 0.f, 0.f};
#pragma unroll
                    for (int ks = 0; ks < 4; ++ks) {
                        if (ks * 32 <= wid * 16 + 15) {
                            const bf16x8 vf = *(const LAS bf16x8*)(LB + (nt * 16 + fr) * 136 + ks * 32 + fq * 8);
                            acc = __builtin_amdgcn_mfma_f32_16x16x32_bf16(vf, wf[ks], acc, 0, 0, 0);
                        }
                    }
                    const int c = g * 128 + nt * 16 + fq * 4;
                    const f32x4 u = cvt4(ur[nt]), dz = cvt4(dzr[nt]);
                    f32x4 o;
#pragma unroll
                    for (int j = 0; j < 4; ++j) o[j] = u[j] * (acc[j] + bias) * siluf_(dz[j]);
                    st_bf4(Ycat + (size_t)row * 1024 + 512 + c, o);
                }
            }
            __syncthreads();
        }
#undef MIX_LOAD_G
    }
    {
        int ci, cstride;
        if (cx.nblk == 256) { if (cx.bid < 32) { ci = 1 << 20; cstride = 1 << 20; } else { ci = cx.bid - 32; cstride = 224; } }
        else { ci = cx.bid; cstride = cx.nblk; }
        u32x4 pw[4]; u32x2 pe[9];
#define MIX_LOAD_C(cc) do { const int tile_ = (cc) >> 2, g_ = (cc) & 3, r0_ = tile_ * 128; \
            const bf16_t* Bw_ = (const bf16_t*)(PWS + WS_POOLWT) + ((size_t)pair * 4 + g_) * 128 * 128; \
            _Pragma("unroll") for (int i = 0; i < 4; ++i) { const int e = tid + i * 512; pw[i] = *(const u32x4*)(Bw_ + (e >> 4) * 128 + (e & 15) * 8); } \
            if (r0_ < NTP) { const int t0_ = r0_ & 2047; \
                _Pragma("unroll") for (int i = 0; i < 9; ++i) { const int e = tid + i * 512, er = e >> 5, c = (e & 31) * 4; pe[i] = (u32x2){0u, 0u}; \
                    if (e < 143 * 32 && t0_ + er - 15 >= 0) pe[i] = *(const u32x2*)(PO + (size_t)(r0_ + er - 15) * LDA + g_ * 128 + c); } } } while (0)
        if (ci < 544) MIX_LOAD_C(ci);
        for (; ci < 544; ci += cstride) {
            const int tile = ci >> 2, g = ci & 3, r0 = tile * 128;
            const bool samp = r0 >= NTP;
            const int w = 2 << g;
            const int row = r0 + wid * 16 + fr;
            u32x2 czr[8]; f32x4 psr[8];
#pragma unroll
            for (int nt = 0; nt < 8; ++nt) { const int d = g * 128 + nt * 16 + fq * 4; czr[nt] = *(const u32x2*)(PO + (size_t)row * LDA + 512 + d); psr[nt] = *(const f32x4*)(PIN(I_PSCALE) + pair * 512 + d); }
#pragma unroll
            for (int i = 0; i < 4; ++i) { const int e = tid + i * 512; *(LAS u32x4*)(LW + (e >> 4) * 136 + (e & 15) * 8) = pw[i]; }
            if (!samp) {
                const int t0 = r0 & 2047;
#pragma unroll
                for (int i = 0; i < 9; ++i) { const int e = tid + i * 512, er = e >> 5, c = (e & 31) * 4; if (e < 143 * 32) *(LAS f32x4*)(LE + er * 128 + c) = cvt4(pe[i]); }
                __syncthreads();
                {
                    const int c = (tid & 31) * 4, tl0 = (tid >> 5) * 8;
                    f32x4 sum = (f32x4){0.f, 0.f, 0.f, 0.f};
#pragma unroll 4
                    for (int d = 0; d < w; ++d) sum += *(LAS const f32x4*)(LE + (tl0 + 15 - d) * 128 + c);
#pragma unroll
                    for (int k = 0; k < 8; ++k) {
                        const int tl = tl0 + k;
                        const f32x4 pt = *(LAS const f32x4*)(LE + (tl + 15) * 128 + c);
                        if (k > 0) sum += pt - *(LAS const f32x4*)(LE + (tl + 15 - w) * 128 + c);
                        const float cnt = fminf((float)w, (float)(t0 + tl + 1));
                        const f32x4 pooled = sum * (1.0f / cnt) - pt;
                        u32x2 u; u.x = cvt_pk_bf16(pooled[0], pooled[1]); u.y = cvt_pk_bf16(pooled[2], pooled[3]);
                        *(LAS u32x2*)(LA + tl * 136 + c) = u;
                    }
                }
            } else {
                const int sq = tid >> 5, c = (tid & 31) * 4, bb = (r0 - NTP) / 8 + sq;
                const float* hist = PIN(I_SPOOL) + ((size_t)pair * 128 + bb) * 15 * 512 + g * 128 + c;
                const bf16_t* cur = PO + (size_t)(r0 + sq * 8) * LDA + g * 128 + c;
                LAS bf16_t* out = LA + (sq * 8) * 136 + c;
                if (g == 0) pool_sample_run<2>(hist, cur, out); else if (g == 1) pool_sample_run<4>(hist, cur, out);
                else if (g == 2) pool_sample_run<8>(hist, cur, out); else pool_sample_run<16>(hist, cur, out);
            }
            if (ci + cstride < 544) MIX_LOAD_C(ci + cstride);
            __syncthreads();
            bf16x8 af[4];
#pragma unroll
            for (int ks = 0; ks < 4; ++ks) af[ks] = *(const LAS bf16x8*)(LA + (wid * 16 + fr) * 136 + ks * 32 + fq * 8);
#pragma unroll
            for (int nt = 0; nt < 8; ++nt) {
                f32x4 acc = (f32x4){0.f, 0.f, 0.f, 0.f};
#pragma unroll
                for (int ks = 0; ks < 4; ++ks) {
                    const bf16x8 bf = *(const LAS bf16x8*)(LW + (nt * 16 + fr) * 136 + ks * 32 + fq * 8);
                    acc = __builtin_amdgcn_mfma_f32_16x16x32_bf16(bf, af[ks], acc, 0, 0, 0);
                }
                const int d = g * 128 + nt * 16 + fq * 4;
                const f32x4 cz = cvt4(czr[nt]), ps = psr[nt];
                f32x4 o;
#pragma unroll
                for (int j = 0; j < 4; ++j) o[j] = acc[j] * ps[j] * siluf_(cz[j]);
                st_bf4(Ycat + (size_t)row * 1024 + d, o);
            }
            __syncthreads();
        }
#undef MIX_LOAD_C
    }
    const int gtid = cx.bid * 512 + tid, gthreads = cx.nblk * 512;
    for (int e = gtid; e < 136 * 15 * 128; e += gthreads) {
        const int c = (e & 127) * 4, q = e >> 7, sr = q / 15, k = q - sr * 15;
        if (sr < 8) *(f32x4*)(POUT + O_POOLP + (((size_t)pair * 8 + sr) * 15 + k) * 512 + c) = ld_bf4(PO + (size_t)(sr * 2048 + 2033 + k) * LDA + c);
        else { const int b = sr - 8;
            *(f32x4*)(POUT + O_POOLS + (((size_t)pair * 128 + b) * 15 + k) * 512 + c) = (k < 7) ? *(const f32x4*)(PIN(I_SPOOL) + (((size_t)pair * 128 + b) * 15 + 8 + k) * 512 + c) : ld_bf4(PO + (size_t)(NTP + b * 8 + (k - 7)) * LDA + c); }
    }
}

__device__ void phase_final(const Params& p, const Ctx cx) {
    const int gtid = cx.bid * 512 + cx.tid, gthreads = cx.nblk * 512;
    const float* ssq = (const float*)(PWS + WS_SSQ) + (size_t)4 * NTOK * 16;
    const bf16_t* Xb = (const bf16_t*)(PWS + WS_XB);
    constexpr int NIT = NTOK * 256, UB = 4;
    for (int e0 = gtid; e0 < NIT; e0 += gthreads * UB) {
        f32x4 x[UB], fw[UB]; float sq[UB]; bool ok[UB];
#pragma unroll
        for (int u = 0; u < UB; ++u) { const int e = e0 + u * gthreads; ok[u] = e < NIT; const int ee = ok[u] ? e : e0; const int row = ee >> 8, c = (ee & 255) * 4;
            x[u] = ld_bf4(Xb + (size_t)row * 1024 + c); sq[u] = ssq_sum(ssq + (size_t)row * 16); fw[u] = *(const f32x4*)(PIN(I_FNORMW) + c); }
#pragma unroll
        for (int u = 0; u < UB; ++u) { const int e = e0 + u * gthreads; const int ee = ok[u] ? e : e0; const int row = ee >> 8, c = (ee & 255) * 4;
            const float rstd = rsqrtf(sq[u] * (1.0f / 1024.0f) + 1e-6f);
            if (ok[u]) *(f32x4*)(POUT + (size_t)row * 1024 + c) = x[u] * rstd * fw[u]; }
    }
}

#define XB_TMO      128
#define XB_XCNT(j)  (256  + 64 * (j))
#define XB_XSUB(j)  (1280 + 64 * (j))
#define XB_XGEN(j)  (2304 + 64 * (j))
#define XB_TOP      3328
#define XB_TOPGEN   3392
#define XCD_BAR_WORDS 3456
#define XB_SPIN_CAP (1u << 18)
__device__ __forceinline__ unsigned xb_ld(unsigned* p)              { return __hip_atomic_load(p, __ATOMIC_RELAXED, __HIP_MEMORY_SCOPE_AGENT); }
__device__ __forceinline__ unsigned xb_add(unsigned* p, unsigned v) { return __hip_atomic_fetch_add(p, v, __ATOMIC_RELAXED, __HIP_MEMORY_SCOPE_AGENT); }
__device__ __forceinline__ unsigned xb_xcc_id() { return (unsigned)__builtin_amdgcn_s_getreg((3 << 11) | 20) & 0xFu; }
#define XB_SPIN(cond, bar) do { unsigned _sp = 0; while (cond) { __builtin_amdgcn_s_sleep(1); \
    if ((++_sp & 255u) == 0u) { if (xb_ld(&(bar)[XB_TMO])) break; if (_sp > XB_SPIN_CAP) { atomicAdd(&(bar)[XB_TMO], 1u); break; } } } } while (0)
struct XcdBarrier { unsigned* bar; unsigned x; volatile LAS unsigned* st; };
__device__ __forceinline__ XcdBarrier xcd_barrier_post(unsigned* bar, volatile LAS unsigned* st) {
    XcdBarrier b; b.bar = bar; b.x = xb_xcc_id(); b.st = st;
    if (threadIdx.x == 0) (void)xb_add(&bar[XB_XCNT(b.x)], 1u);
    return b;
}
__device__ __forceinline__ void xcd_barrier_complete(unsigned* bar, unsigned x, unsigned& nloc, unsigned& nx) {
    const unsigned G = gridDim.x * gridDim.y * gridDim.z;
    unsigned sum, cnt, mine, sp = 0u;
    for (;;) {
        sum = 0u; cnt = 0u; mine = 0u;
#pragma unroll
        for (unsigned j = 0; j < 16; ++j) { const unsigned c = xb_ld(&bar[XB_XCNT(j)]); sum += c; cnt += (c > 0u) ? 1u : 0u; mine = (j == x) ? c : mine; }
        if (sum == G) break;
        __builtin_amdgcn_s_sleep(1);
        if ((++sp & 255u) == 0u) { if (xb_ld(&bar[XB_TMO])) break; if (sp > XB_SPIN_CAP) { atomicAdd(&bar[XB_TMO], 1u); break; } }
    }
    nloc = mine > 0u ? mine : 1u; nx = cnt > 0u ? cnt : 1u;
}
__device__ __forceinline__ void xcd_barrier(const XcdBarrier& b) {
    asm volatile("s_waitcnt vmcnt(0)" ::: "memory");
    __syncthreads();
    if (threadIdx.x == 0) {
        unsigned* bar = b.bar;
        __builtin_amdgcn_s_waitcnt(0);
        unsigned nloc = b.st[0], nx = b.st[1];
        if (nloc == 0u) { xcd_barrier_complete(bar, b.x, nloc, nx); b.st[0] = nloc; b.st[1] = nx; }
        const unsigned old = xb_add(&bar[XB_XSUB(b.x)], 1u);
        const unsigned gen = old / nloc;
        if (old + 1u == (gen + 1u) * nloc) {
            __builtin_amdgcn_fence(__ATOMIC_RELEASE, "agent");
            asm volatile("s_waitcnt vmcnt(0)" ::: "memory");
            const unsigned og = xb_add(&bar[XB_TOP], 1u);
            const unsigned tg = og / nx;
            if (og + 1u == (tg + 1u) * nx) xb_add(&bar[XB_TOPGEN], 1u);
            else XB_SPIN(xb_ld(&bar[XB_TOPGEN]) == tg, bar);
            __builtin_amdgcn_fence(__ATOMIC_ACQUIRE, "agent");
            xb_add(&bar[XB_XGEN(b.x)], 1u);
            asm volatile("s_waitcnt vmcnt(0)" ::: "memory");
        } else {
            XB_SPIN(xb_ld(&bar[XB_XGEN(b.x)]) == gen, bar);
            __builtin_amdgcn_fence(__ATOMIC_ACQUIRE, "agent");
            asm volatile("s_waitcnt vmcnt(0)" ::: "memory");
        }
    }
    __syncthreads();
}

__device__ void run_gemm_proj(const Params& p, const Ctx cx, LAS unsigned char* lds, const bf16_t* Bt, int N, bf16_t* O, int ldc, int layer) {
    pg8::Gemm g{(const bf16_t*)(PWS + WS_XB), Bt, NTOK, N, 1024};
    pg8::StaticOrder S; S.init(NTOK, N, (int)cx.nblk, (int)cx.bid);
    const float* ssq = (const float*)(PWS + WS_SSQ) + (size_t)layer * NTOK * 16;
    LAS float* rl = (LAS float*)(lds + 131072);
    int pm0 = -1, pm1 = -1, pm2 = -1, pm3 = -1, np = 0;
    for (int i = 0; i < 64; ++i) {
        pg8::Unit u; if (!S.next(i, u)) break;
        if (u.pm == pm0 || u.pm == pm1 || u.pm == pm2 || u.pm == pm3) continue;
        if (np == 0) pm0 = u.pm; else if (np == 1) pm1 = u.pm; else if (np == 2) pm2 = u.pm; else pm3 = u.pm;
        ++np;
    }
    for (int r = cx.tid; r < np * 256; r += 512) {
        const int i = r >> 8, pm = i == 0 ? pm0 : (i == 1 ? pm1 : (i == 2 ? pm2 : pm3));
        rl[r] = rsqrtf(ssq_sum(ssq + (size_t)(pm * 256 + (r & 255)) * 16) * (1.0f / 1024.0f) + 1e-6f);
    }
    __syncthreads();
    EpiProj E{O, ldc, rl, pm0, pm1, pm2, pm3};
    pg8::gemm_phase<EpiProj>(cx, lds, g, S, E);
}
__device__ void run_gemm_res(const Params& p, const Ctx cx, LAS unsigned char* lds, const bf16_t* Bt, int layer) {
    const bf16_t* A = (const bf16_t*)(PWS + WS_YCAT);
    bf16_t* Xb = (bf16_t*)(PWS + WS_XB);
    float* ssqn = (float*)(PWS + WS_SSQ) + (size_t)(layer + 1) * NTOK * 16;
    pg8::Gemm g{A, Bt, NTOK, 1024, 1024};
    pg8::StaticOrder S; S.init(NTOK, 1024, (int)cx.nblk, (int)cx.bid);
    EpiRes E{layer == 0 ? PIN(I_XP) : nullptr, PIN(I_XS), Xb, ssqn};
    pg8::gemm_phase<EpiRes>(cx, lds, g, S, E);
}

constexpr int N_PHASES = 20;
#ifndef PHMASK
#define PHMASK 0xffff
#endif
#define PHON(n) ((PHMASK >> ((n) % 16)) & 1)
__global__ void __launch_bounds__(512, 2) fwd_kernel(Params p) {
    extern __shared__ __attribute__((aligned(16))) unsigned char lds_raw[];
    LAS unsigned char* lds = (LAS unsigned char*)lds_raw;
    volatile LAS unsigned* bar_st = (volatile LAS unsigned*)(lds + LDS_MAIN);
    if (threadIdx.x < 4) bar_st[threadIdx.x] = 0u;
    __syncthreads();
    const XcdBarrier gbar = xcd_barrier_post((unsigned*)((unsigned char*)p.ptr[30] + WS_BAR), bar_st);
    if (p.ph_hi < 0) cg::this_grid().sync();
#define GRID_SYNC() xcd_barrier(gbar)
#ifdef SYNCPROBE
    for (int i = 0; i < SYNCPROBE; ++i) GRID_SYNC();
#endif
#ifdef REPMASK
    for (int pc = p.ph_lo * 2; pc < p.ph_hi * 2; ++pc) {
        const int ph = pc >> 1;
        { const int s_ = (ph == 0) ? 9 : (ph == N_PHASES - 1) ? 31 : (ph - 1) % 9; if ((pc & 1) && !((REPMASK >> s_) & 1)) continue; }
        if (pc > p.ph_lo * 2) GRID_SYNC();
#else
    for (int ph = p.ph_lo; ph < p.ph_hi; ++ph) {
        if (ph > p.ph_lo) GRID_SYNC();
#endif
        Ctx cx; cx.tid = threadIdx.x; cx.bid = blockIdx.x; cx.nblk = gridDim.x;
        asm volatile("s_mov_b32 %0, 0" : "=s"(cx.z));
        asm volatile("" : "+v"(cx.tid)); asm volatile("" : "+s"(cx.bid)); asm volatile("" : "+s"(cx.nblk));
        const int pair = (ph - 1) / 9, s = (ph == 0) ? 100 : (ph == N_PHASES - 1 ? 101 : (ph - 1) % 9);
        if (s == 0 || s == 3 || s == 6) {
#if PHON(0)
            const bf16_t* WinE = (const bf16_t*)(PWS + WS_WINE) + (size_t)pair * 4352 * 1024;
            const bf16_t* Bt = s == 0 ? WinE + (size_t)2560 * 1024 : (s == 3 ? WinE : (const bf16_t*)(PWS + WS_WINO) + (size_t)pair * 2560 * 1024);
            const int N = s == 0 ? 1792 : 2560;
            run_gemm_proj(p, cx, lds, Bt, N, (bf16_t*)(PWS + WS_R1), N, 2 * pair + (s == 6 ? 1 : 0));
#endif
        } else if (s == 5 || s == 8) {
#if PHON(5)
            const bf16_t* Bt = (const bf16_t*)(PWS + (s == 5 ? WS_WOUTE : WS_WOUTO)) + (size_t)pair * 1024 * 1024;
            run_gemm_res(p, cx, lds, Bt, 2 * pair + (s == 8 ? 1 : 0));
#endif
        } else if (s == 1) {
#if PHON(1)
            phase_even_prep(p, cx, pair, lds);
#endif
        } else if (s == 2) {
#if PHON(2)
            phase_scan(p, cx, pair, lds);
#endif
        } else if (s == 4) {
#if PHON(4)
            phase_even_post(p, cx, pair);
#endif
        } else if (s == 7) {
#if PHON(7)
            phase_odd_mixer(p, cx, pair, lds);
#endif
        } else if (s == 100) {
#if PHON(10)
            phase_prepass(p, cx, lds);
#endif
        } else {
#if PHON(11)
            phase_final(p, cx);
#endif
        }
    }
}

extern "C" void kernel_launch(void* const* d_in, const int* in_sizes, int n_in, void* d_out, int out_size, void* d_ws, size_t ws_size, hipStream_t stream) {
    static int grid = 0;
    if (grid == 0) {
        if (n_in != 29 || ws_size < WS_END) { fprintf(stderr, "kernel_launch: unexpected n_in %d / ws_size %zu (need %zu)\n", n_in, ws_size, (size_t)WS_END); grid = -1; return; }
        int dev = 0, cus = 0, per_cu = 0;
        hipGetDevice(&dev);
        hipDeviceGetAttribute(&cus, hipDeviceAttributeMultiprocessorCount, dev);
        if (hipFuncSetAttribute((const void*)fwd_kernel, hipFuncAttributeMaxDynamicSharedMemorySize, LDS_BYTES) != hipSuccess) { fprintf(stderr, "kernel_launch: hipFuncSetAttribute failed\n"); grid = -1; return; }
        if (hipOccupancyMaxActiveBlocksPerMultiprocessor(&per_cu, (const void*)fwd_kernel, 512, LDS_BYTES) != hipSuccess || per_cu < 1) { fprintf(stderr, "kernel_launch: occupancy query gave %d\n", per_cu); per_cu = 1; }
        (void)hipGetLastError();
        grid = cus * per_cu;
        if (grid > 256) grid = 256;
    }
    if (grid < 0) return;
    Params p{};
    for (int i = 0; i < 29; ++i) p.ptr[i] = d_in[i];
    p.ptr[29] = d_out; p.ptr[30] = d_ws; p.ptr[31] = nullptr;
    (void)hipMemsetAsync((unsigned char*)d_ws + WS_BAR, 0, 16384, stream);
#if ONE_LAUNCH
    p.ph_lo = 0; p.ph_hi = N_PHASES;
    void* args[] = {&p};
    hipError_t e = hipLaunchCooperativeKernel((const void*)fwd_kernel, dim3(grid), dim3(512), args, LDS_BYTES, stream);
    if (e != hipSuccess) fprintf(stderr, "cooperative launch failed: %s (grid %d)\n", hipGetErrorString(e), grid);
#else
    for (int ph = 0; ph < N_PHASES; ++ph) {
        p.ph_lo = ph; p.ph_hi = ph + 1;
        hipLaunchKernelGGL(fwd_kernel, dim3(grid), dim3(512), LDS_BYTES, stream, p);
    }
#endif
}
```

```cpp
#include <hip/hip_runtime.h>
#include <hip/hip_cooperative_groups.h>
#include <cstdio>
namespace cg = cooperative_groups;

#ifndef ONE_LAUNCH
#define ONE_LAUNCH 1
#endif

#define LAS __attribute__((address_space(3)))
typedef unsigned short bf16_t;
typedef short bf16x8 __attribute__((ext_vector_type(8)));
typedef float f32x4 __attribute__((ext_vector_type(4)));
typedef unsigned u32x4 __attribute__((ext_vector_type(4)));
typedef unsigned u32x2 __attribute__((ext_vector_type(2)));

constexpr int NTOK = 17408, NTP = 16384;
constexpr int LDB = 1792;
constexpr int LDA = 2560;
constexpr size_t O_CONVP = 17825792, O_CONVS = 17842176, O_SHIFTP = 18104320, O_SHIFTS = 18130944, O_WKVP = 18556928, O_WKVS = 19081216,
                 O_POOLP = 27469824, O_POOLS = 27592704, O_CHUNKV = 29558784;
constexpr size_t WS_WINE = 0;
constexpr size_t WS_WOUTE = WS_WINE + 2ull * 4352 * 1024 * 2;
constexpr size_t WS_WINO = WS_WOUTE + 2ull * 1024 * 1024 * 2;
constexpr size_t WS_WOUTO = WS_WINO + 2ull * 2560 * 1024 * 2;
constexpr size_t WS_W2T = WS_WOUTO + 2ull * 1024 * 1024 * 2;
constexpr size_t WS_A2T = WS_W2T + 2ull * 512 * 64 * 2;
constexpr size_t WS_POOLWT = WS_A2T + 2ull * 512 * 64 * 2;
constexpr size_t WS_SPW = WS_POOLWT + 8ull * 128 * 128 * 2;
constexpr size_t WS_XB = WS_SPW + 8ull * 128 * 128 * 2;
constexpr size_t WS_YCAT = WS_XB + (size_t)NTOK * 1024 * 2;
constexpr size_t WS_SSQ = WS_YCAT + (size_t)NTOK * 1024 * 2;
constexpr size_t WS_Y = WS_SSQ + 5ull * NTOK * 16 * 4;
constexpr size_t WS_R1 = WS_Y + (size_t)NTOK * 512 * 4;
constexpr size_t WS_PROJB = WS_R1;
constexpr size_t WS_WDEC = WS_PROJB + (size_t)NTOK * LDB * 2;
constexpr size_t WS_AA = WS_WDEC + (size_t)NTOK * 512 * 4;
constexpr size_t WS_BAR = WS_AA + (size_t)NTOK * 512 * 2;
constexpr size_t WS_END = WS_BAR + 16384;
constexpr int LDS_MAIN = 147456;
constexpr int LDS_BYTES = LDS_MAIN + 16;

struct Params {
    const void* ptr[32];
    int ph_lo, ph_hi;
};
struct Ctx { int tid, bid, nblk, z; };
#define PIN(i) ((const float*)p.ptr[(i) + cx.z])
#define POUT ((float*)p.ptr[29 + cx.z])
#define PWS ((unsigned char*)p.ptr[30 + cx.z])
enum { I_XP = 0, I_XS, I_SCONV, I_SSHIFT, I_SWKV, I_SPOOL, I_NORMW, I_FNORMW, I_WINE, I_CONVW, I_MU, I_W0, I_W2, I_A0, I_A2, I_KK, I_KA, I_RK, I_GNG, I_GNB,
       I_WOUTE, I_WINO, I_POOLW, I_PSCALE, I_LNG, I_LNB, I_SPW, I_SPB, I_WOUTO };

__device__ __forceinline__ unsigned cvt_pk_bf16(float lo, float hi) { unsigned r; asm("v_cvt_pk_bf16_f32 %0, %1, %2" : "=v"(r) : "v"(lo), "v"(hi)); return r; }
__device__ __forceinline__ float bf_lo(unsigned u) { return __uint_as_float(u << 16); }
__device__ __forceinline__ float bf_hi(unsigned u) { return __uint_as_float(u & 0xffff0000u); }
__device__ __forceinline__ float bf2f(bf16_t b) { return __uint_as_float(((unsigned)b) << 16); }
__device__ __forceinline__ f32x4 cvt4(u32x2 u) { return (f32x4){bf_lo(u.x), bf_hi(u.x), bf_lo(u.y), bf_hi(u.y)}; }
__device__ __forceinline__ f32x4 ld_bf4(const bf16_t* p) { return cvt4(*(const u32x2*)p); }
__device__ __forceinline__ void st_bf4(bf16_t* p, f32x4 v) { u32x2 u; u.x = cvt_pk_bf16(v[0], v[1]); u.y = cvt_pk_bf16(v[2], v[3]); *(u32x2*)p = u; }
__device__ __forceinline__ float sigmoidf_(float x) { return 1.0f / (1.0f + __expf(-x)); }
__device__ __forceinline__ float siluf_(float x) { return x / (1.0f + __expf(-x)); }
template <int CTRL> __device__ __forceinline__ float dpp_f(float x) { return __builtin_bit_cast(float, __builtin_amdgcn_mov_dpp(__builtin_bit_cast(int, x), CTRL, 0xf, 0xf, true)); }
__device__ __forceinline__ float allsum16(float x) { x += dpp_f<0xB1>(x); x += dpp_f<0x4E>(x); x += dpp_f<0x141>(x); x += dpp_f<0x128>(x); return x; }
__device__ __forceinline__ float allsum4(float x) { x += dpp_f<0xB1>(x); x += dpp_f<0x4E>(x); return x; }
__device__ __forceinline__ float dot4(f32x4 a, f32x4 b) { return a[0] * b[0] + a[1] * b[1] + a[2] * b[2] + a[3] * b[3]; }

__device__ __forceinline__ float ssq_sum(const float* part) {
    const f32x4 a = *(const f32x4*)(part), b = *(const f32x4*)(part + 4), c = *(const f32x4*)(part + 8), d = *(const f32x4*)(part + 12);
    return ((a[0] + a[1]) + (a[2] + a[3])) + ((b[0] + b[1]) + (b[2] + b[3])) + ((c[0] + c[1]) + (c[2] + c[3])) + ((d[0] + d[1]) + (d[2] + d[3]));
}

namespace pg8 {
constexpr int BM = 256, BK = 64, HALF = 128, HTB = HALF * BK * 2, NXCD = 8, WGM = 8;
__device__ __forceinline__ int lds_byte(int r, int c) { const int st = (r >> 4) * 2 + (c >> 5), rr = r & 15, cc = c & 31, ob = rr * 64 + cc * 2; return st * 1024 + (ob ^ (((ob >> 9) & 1) << 5)); }
__device__ __forceinline__ void stage_rc(int b, int& R, int& C) { const int st = b / 1024, sb = b % 1024, swz = sb ^ (((sb >> 9) & 1) << 5); R = (st >> 1) * 16 + swz / 64; C = (st & 1) * 32 + (swz % 64) / 2; }
__device__ __forceinline__ int perm32(int rho) { const int n = rho >> 4, i = rho & 15; return 8 * (i >> 2) + 4 * n + (i & 3); }
struct Unit { int pm, pn; };
struct Gemm { const bf16_t* A; const bf16_t* Bt; int M, N, K; };
struct StaticOrder {
    int nM, nN, nwg, G, c;
    __device__ void init(int M, int N, int G_, int c_) { nM = M / BM; nN = N / BM; nwg = nM * nN; G = G_; c = c_; }
    __device__ bool next(int i, Unit& u) const {
        const long L = (long)i * G + c; if (L >= nwg) return false;
        int wgid = (int)L; { const int q = nwg / NXCD, r = nwg % NXCD, xcd = wgid % NXCD, off = wgid / NXCD; wgid = (xcd < r ? xcd * (q + 1) : r * (q + 1) + (xcd - r) * q) + off; }
        const int nig = WGM * nN, gid = wgid / nig, fm = gid * WGM, gsz = (nM - fm) < WGM ? (nM - fm) : WGM;
        u.pm = fm + ((wgid % nig) % gsz); u.pn = (wgid % nig) / gsz; return true;
    }
};

template <class Epi>
__device__ __forceinline__ void gemm_phase(const Ctx cx, LAS unsigned char* lds, const Gemm g, const StaticOrder& S, const Epi& E) {
    const int tid = cx.tid, wid = __builtin_amdgcn_readfirstlane(tid >> 6), lane = tid & 63, wr = wid >> 2, wc = wid & 3, fr = lane & 15, fq = lane >> 4;
    const int K = g.K, nt = K / BK;
    unsigned voffA[2], voffB[2];
#pragma unroll
    for (int i = 0; i < 2; ++i) { int R, C; stage_rc(tid * 16 + i * 8192, R, C); const int Rb = Epi::PERM ? ((R & ~31) + perm32(R & 31)) : R;
        voffA[i] = (unsigned)(R * K + C) * 2u; voffB[i] = (unsigned)(Rb * K + C) * 2u; }
    const size_t kstep = (size_t)(BK * 2);
    const size_t hstep = (size_t)HALF * K * 2;
    const size_t tstep = 2 * hstep;
    const unsigned ldsw = (unsigned)wid * 1024u;
    const int aoff = lds_byte(wr * 64 + fr, fq * 8), boff = lds_byte(wc * 32 + fr, fq * 8);
#define PG8_SA(b, h) (((b) * 2 + (h)) * HTB)
#define PG8_SB(b, h) ((4 + (b) * 2 + (h)) * HTB)
#define PG8_STAGE(bufoff, gbase, voff) do { _Pragma("unroll") for (int _i = 0; _i < 2; ++_i) \
        __builtin_amdgcn_global_load_lds((const unsigned*)((const char*)(gbase) + (voff)[_i]), (LAS unsigned*)(lds + (bufoff) + ldsw + _i * 8192), 16, 0, 0); } while (0)
#define PG8_LDA(dst, b, h) do { _Pragma("unroll") for (int m = 0; m < 4; ++m) _Pragma("unroll") for (int k = 0; k < 2; ++k) dst[m][k] = *(const LAS bf16x8*)(lds + PG8_SA(b, h) + aoff + m * 2048 + k * 1024); } while (0)
#define PG8_LDB(dst, b, h) do { _Pragma("unroll") for (int n = 0; n < 2; ++n) _Pragma("unroll") for (int k = 0; k < 2; ++k) dst[n][k] = *(const LAS bf16x8*)(lds + PG8_SB(b, h) + boff + n * 2048 + k * 1024); } while (0)
#define PG8_MMA(ai, bj, At, Bt) do { __builtin_amdgcn_s_setprio(1); _Pragma("unroll") for (int m = 0; m < 4; ++m) _Pragma("unroll") for (int n = 0; n < 2; ++n) _Pragma("unroll") for (int k = 0; k < 2; ++k) \
        acc[ai][bj][m][n] = __builtin_amdgcn_mfma_f32_16x16x32_bf16(Bt[n][k], At[m][k], acc[ai][bj][m][n], 0, 0, 0); __builtin_amdgcn_s_setprio(0); } while (0)
#define PG8_WAIT_V(n) asm volatile("s_waitcnt vmcnt(" #n ")" ::: "memory")
#define PG8_WAIT_L(n) asm volatile("s_waitcnt lgkmcnt(" #n ")" ::: "memory")
#define PG8_BAR __builtin_amdgcn_s_barrier()
#define PG8_SCHED __builtin_amdgcn_sched_barrier(0)
    Unit cur, nxt; int ui = 0;
    if (!S.next(0, cur)) return;
    f32x4 acc[2][2][4][2];
#pragma unroll
    for (int a = 0; a < 2; ++a)
#pragma unroll
        for (int b = 0; b < 2; ++b)
#pragma unroll
            for (int m = 0; m < 4; ++m)
#pragma unroll
                for (int n = 0; n < 2; ++n) acc[a][b][m][n] = (f32x4){0.f, 0.f, 0.f, 0.f};
    bf16x8 At[4][2], B0[2][2], B1[2][2];
    const char* cA = (const char*)g.A + (size_t)cur.pm * tstep; const char* cB = (const char*)g.Bt + (size_t)cur.pn * tstep;
    PG8_STAGE(PG8_SB(0, 0), cB, voffB); PG8_STAGE(PG8_SA(0, 0), cA, voffA); PG8_STAGE(PG8_SB(0, 1), cB + hstep, voffB); PG8_STAGE(PG8_SA(0, 1), cA + hstep, voffA);
    if (wr == 1) PG8_BAR;
    PG8_WAIT_V(4); PG8_BAR;
    PG8_STAGE(PG8_SB(1, 0), cB + kstep, voffB); PG8_STAGE(PG8_SA(1, 0), cA + kstep, voffA); PG8_STAGE(PG8_SB(1, 1), cB + hstep + kstep, voffB);
    PG8_WAIT_V(6); PG8_BAR;
    for (;;) {
        const bool has_next = S.next(ui + 1, nxt);
        const char* nA = has_next ? (const char*)g.A + (size_t)nxt.pm * tstep : cA; const char* nB = has_next ? (const char*)g.Bt + (size_t)nxt.pn * tstep : cB;
        for (int t = 0; t < nt; t += 2) {
            const bool last = (t == nt - 2);
            const char* a1 = cA + (size_t)(t + 1) * kstep;
            const char* a2 = last ? nA : cA + (size_t)(t + 2) * kstep; const char* b2 = last ? nB : cB + (size_t)(t + 2) * kstep;
            const char* a3 = a2 + kstep; const char* b3 = b2 + kstep;
            PG8_LDB(B0, 0, 0); PG8_SCHED; PG8_LDA(At, 0, 0); PG8_STAGE(PG8_SA(1, 1), a1 + hstep, voffA);
            PG8_WAIT_L(8); PG8_BAR; PG8_WAIT_L(0); PG8_MMA(0, 0, At, B0); PG8_BAR; PG8_SCHED;
            PG8_LDB(B1, 0, 1); PG8_STAGE(PG8_SB(0, 0), b2, voffB);
            PG8_BAR; PG8_WAIT_L(0); PG8_MMA(0, 1, At, B1); PG8_BAR;
            PG8_LDA(At, 0, 1); PG8_STAGE(PG8_SA(0, 0), a2, voffA);
            PG8_BAR; PG8_WAIT_L(0); PG8_MMA(1, 0, At, B0); PG8_BAR; PG8_SCHED;
            PG8_STAGE(PG8_SB(0, 1), b2 + hstep, voffB);
            PG8_WAIT_V(6); PG8_BAR; PG8_MMA(1, 1, At, B1); PG8_BAR;
            PG8_LDB(B0, 1, 0); PG8_SCHED; PG8_LDA(At, 1, 0); PG8_STAGE(PG8_SA(0, 1), a2 + hstep, voffA);
            PG8_WAIT_L(8); PG8_BAR; PG8_WAIT_L(0); PG8_MMA(0, 0, At, B0); PG8_BAR; PG8_SCHED;
            PG8_LDB(B1, 1, 1); PG8_STAGE(PG8_SB(1, 0), b3, voffB);
            PG8_BAR; PG8_WAIT_L(0); PG8_MMA(0, 1, At, B1); PG8_BAR;
            PG8_LDA(At, 1, 1); PG8_STAGE(PG8_SA(1, 0), a3, voffA);
            PG8_BAR; PG8_WAIT_L(0); PG8_MMA(1, 0, At, B0); PG8_BAR; PG8_SCHED;
            PG8_STAGE(PG8_SB(1, 1), b3 + hstep, voffB);
            PG8_WAIT_V(6); PG8_BAR; PG8_MMA(1, 1, At, B1); PG8_BAR;
        }
        E(acc, cur, wr, wc, fr, fq);
        if (!has_next) break;
#pragma unroll
        for (int a = 0; a < 2; ++a)
#pragma unroll
            for (int b = 0; b < 2; ++b)
#pragma unroll
                for (int m = 0; m < 4; ++m)
#pragma unroll
                    for (int n = 0; n < 2; ++n) acc[a][b][m][n] = (f32x4){0.f, 0.f, 0.f, 0.f};
        cur = nxt; cA = nA; cB = nB; ++ui;
    }
    PG8_WAIT_V(0);
    if (wr == 0) PG8_BAR;
    PG8_BAR;
#undef PG8_SA
#undef PG8_SB
#undef PG8_STAGE
#undef PG8_LDA
#undef PG8_LDB
#undef PG8_MMA
#undef PG8_WAIT_V
#undef PG8_WAIT_L
#undef PG8_BAR
#undef PG8_SCHED
}
}

struct EpiProj {
    static constexpr bool PERM = true;
    bf16_t* O; int ldc; LAS const float* rl; int pm0, pm1, pm2, pm3;
    __device__ __forceinline__ void operator()(const f32x4 (&acc)[2][2][4][2], const pg8::Unit& u, int wr, int wc, int fr, int fq) const {
        const int row0 = u.pm * 256 + wr * 64 + fr, col0 = u.pn * 256 + wc * 32 + 8 * fq;
        const int sel = u.pm == pm0 ? 0 : (u.pm == pm1 ? 1 : (u.pm == pm2 ? 2 : 3));
        LAS const float* rp = rl + sel * 256 + wr * 64 + fr;
#pragma unroll
        for (int ai = 0; ai < 2; ++ai)
#pragma unroll
            for (int m = 0; m < 4; ++m) {
                const int row = row0 + ai * 128 + m * 16;
                const float rstd = rp[ai * 128 + m * 16];
                bf16_t* rowp = O + (size_t)row * ldc + col0;
#pragma unroll
                for (int bj = 0; bj < 2; ++bj) {
                    const f32x4 v0 = acc[ai][bj][m][0] * rstd, v1 = acc[ai][bj][m][1] * rstd;
                    u32x4 w; w.x = cvt_pk_bf16(v0[0], v0[1]); w.y = cvt_pk_bf16(v0[2], v0[3]); w.z = cvt_pk_bf16(v1[0], v1[1]); w.w = cvt_pk_bf16(v1[2], v1[3]);
                    *(u32x4*)(rowp + bj * 128) = w;
                }
            }
    }
};
struct X8 { f32x4 lo, hi; };
template <bool FIRST> __device__ __forceinline__ X8 ld_x8(const float* __restrict__ s32, const bf16_t* __restrict__ s16, size_t o) {
    X8 r;
    if (FIRST) { r.lo = *(const f32x4*)(s32 + o); r.hi = *(const f32x4*)(s32 + o + 4); }
    else { const u32x4 u = *(const u32x4*)(s16 + o); r.lo = cvt4((u32x2){u.x, u.y}); r.hi = cvt4((u32x2){u.z, u.w}); }
    return r;
}
__device__ __forceinline__ void st_x8(bf16_t* p, f32x4 lo, f32x4 hi) { u32x4 w; w.x = cvt_pk_bf16(lo[0], lo[1]); w.y = cvt_pk_bf16(lo[2], lo[3]); w.z = cvt_pk_bf16(hi[0], hi[1]); w.w = cvt_pk_bf16(hi[2], hi[3]); *(u32x4*)p = w; }
template <bool FIRST>
__device__ __forceinline__ void epi_res_rows(const f32x4 (&acc)[2][2][4][2], const float* __restrict__ src32, const bf16_t* __restrict__ src16, bf16_t* __restrict__ Xb, float* __restrict__ ssqp,
                                             int row0, int col0, int slot, int fq) {
    if constexpr (FIRST) {
#pragma unroll
        for (int ai = 0; ai < 2; ++ai) {
            X8 x[4][2];
#pragma unroll
            for (int m = 0; m < 4; ++m)
#pragma unroll
                for (int bj = 0; bj < 2; ++bj) x[m][bj] = ld_x8<true>(src32, src16, (size_t)(row0 + ai * 128 + m * 16) * 1024 + col0 + bj * 128);
#pragma unroll
            for (int m = 0; m < 4; ++m) {
                const int row = row0 + ai * 128 + m * 16;
                float part = 0.f;
#pragma unroll
                for (int bj = 0; bj < 2; ++bj) {
                    const f32x4 lo = x[m][bj].lo + acc[ai][bj][m][0], hi = x[m][bj].hi + acc[ai][bj][m][1];
                    st_x8(Xb + (size_t)row * 1024 + col0 + bj * 128, lo, hi);
                    part += dot4(lo, lo) + dot4(hi, hi);
                }
                part += __shfl_xor(part, 16); part += __shfl_xor(part, 32);
                if (fq == 0) ssqp[(size_t)row * 16 + slot] = part;
            }
        }
    } else {
        u32x4 xr[2][4][2];
#pragma unroll
        for (int ai = 0; ai < 2; ++ai)
#pragma unroll
            for (int m = 0; m < 4; ++m)
#pragma unroll
                for (int bj = 0; bj < 2; ++bj) xr[ai][m][bj] = *(const u32x4*)(src16 + (size_t)(row0 + ai * 128 + m * 16) * 1024 + col0 + bj * 128);
#pragma unroll
        for (int ai = 0; ai < 2; ++ai)
#pragma unroll
            for (int m = 0; m < 4; ++m) {
                const int row = row0 + ai * 128 + m * 16;
                float part = 0.f;
#pragma unroll
                for (int bj = 0; bj < 2; ++bj) {
                    const u32x4 u = xr[ai][m][bj];
                    const f32x4 lo = cvt4((u32x2){u.x, u.y}) + acc[ai][bj][m][0], hi = cvt4((u32x2){u.z, u.w}) + acc[ai][bj][m][1];
                    st_x8(Xb + (size_t)row * 1024 + col0 + bj * 128, lo, hi);
                    part += dot4(lo, lo) + dot4(hi, hi);
                }
                part += __shfl_xor(part, 16); part += __shfl_xor(part, 32);
                if (fq == 0) ssqp[(size_t)row * 16 + slot] = part;
            }
    }
}
struct EpiRes {
    static constexpr bool PERM = true;
    const float* xp; const float* xs; bf16_t* Xb; float* ssq_next;
    __device__ __forceinline__ void operator()(const f32x4 (&acc)[2][2][4][2], const pg8::Unit& u, int wr, int wc, int fr, int fq) const {
        const int row0 = u.pm * 256 + wr * 64 + fr, col0 = u.pn * 256 + wc * 32 + 8 * fq;
        if (xp) epi_res_rows<true>(acc, row0 < NTP ? xp : xs - (size_t)NTP * 1024, nullptr, Xb, ssq_next, row0, col0, u.pn * 4 + wc, fq);
        else epi_res_rows<false>(acc, nullptr, Xb, Xb, ssq_next, row0, col0, u.pn * 4 + wc, fq);
    }
};

template <bool FIRST>
__device__ __forceinline__ void res_sample_tile(const Ctx cx, const bf16_t* __restrict__ A, const bf16_t* __restrict__ Bt, const float* __restrict__ xs, bf16_t* __restrict__ Xb, float* __restrict__ ssqp, int tile) {
    const int tid = cx.tid, wid = tid >> 6, lane = tid & 63, fr = lane & 15, fq = lane >> 4;
    const int tm = tile >> 3, tn = tile & 7;
    const int r0 = NTP + tm * 64 + (wid & 3) * 16, c0 = tn * 128 + (wid >> 2) * 64;
    const bf16_t* ap = A + (size_t)(r0 + fr) * 1024 + fq * 8;
    const bf16_t* bp = Bt + (size_t)(c0 + fr) * 1024 + fq * 8;
    f32x4 acc[4];
#pragma unroll
    for (int nt = 0; nt < 4; ++nt) acc[nt] = (f32x4){0.f, 0.f, 0.f, 0.f};
#pragma unroll 8
    for (int ks = 0; ks < 32; ++ks) {
        const bf16x8 af = *(const bf16x8*)(ap + ks * 32);
#pragma unroll
        for (int nt = 0; nt < 4; ++nt) {
            const bf16x8 bf = *(const bf16x8*)(bp + (size_t)nt * 16 * 1024 + ks * 32);
            acc[nt] = __builtin_amdgcn_mfma_f32_16x16x32_bf16(bf, af, acc[nt], 0, 0, 0);
        }
    }
    const int row = r0 + fr;
    float part = 0.f;
#pragma unroll
    for (int nt = 0; nt < 4; ++nt) {
        const int col = c0 + nt * 16 + fq * 4;
        const f32x4 xo = FIRST ? *(const f32x4*)(xs + (size_t)(row - NTP) * 1024 + col) : ld_bf4(Xb + (size_t)row * 1024 + col);
        const f32x4 v = xo + acc[nt];
        st_bf4(Xb + (size_t)row * 1024 + col, v);
        part += dot4(v, v);
    }
    part += __shfl_xor(part, 16); part += __shfl_xor(part, 32);
    if (fq == 0) ssqp[(size_t)row * 16 + (c0 >> 6)] = part;
}

struct TrJob { const float* src; int ld, col0, k0; bf16_t* dst; int Ktot, drow0; const float* scale; bool zero; };
__device__ __forceinline__ TrJob tr_decode(const Params& p, const Ctx cx, int job) {
    TrJob J; J.zero = false; J.scale = nullptr;
    int j = job;
    if (j < 2176) {
        const int i = j / 1088, r = j % 1088, nt = r / 16, kt = r % 16, n0 = nt * 64;
        int col0 = 0;
        if (n0 < 2048) col0 = n0; else if (n0 < 2560) col0 = 3712 + (n0 - 2048); else if (n0 < 4224) col0 = 2048 + (n0 - 2560); else J.zero = true;
        J.src = PIN(I_WINE) + (size_t)i * 1024 * 4224; J.ld = 4224; J.col0 = col0; J.k0 = kt * 64; J.dst = (bf16_t*)(PWS + WS_WINE) + (size_t)i * 4352 * 1024; J.Ktot = 1024; J.drow0 = n0; J.scale = PIN(I_NORMW) + (2 * i) * 1024;
        return J;
    }
    j -= 2176;
    if (j < 512) { const int i = j / 256, r = j % 256, nt = r / 16, kt = r % 16;
        J.src = PIN(I_WOUTE) + (size_t)i * 1024 * 1024; J.ld = 1024; J.col0 = nt * 64; J.k0 = kt * 64; J.dst = (bf16_t*)(PWS + WS_WOUTE) + (size_t)i * 1024 * 1024; J.Ktot = 1024; J.drow0 = nt * 64; return J; }
    j -= 512;
    if (j < 1280) { const int i = j / 640, r = j % 640, nt = r / 16, kt = r % 16;
        J.src = PIN(I_WINO) + (size_t)i * 1024 * 2560; J.ld = 2560; J.col0 = nt * 64; J.k0 = kt * 64; J.dst = (bf16_t*)(PWS + WS_WINO) + (size_t)i * 2560 * 1024; J.Ktot = 1024; J.drow0 = nt * 64; J.scale = PIN(I_NORMW) + (2 * i + 1) * 1024; return J; }
    j -= 1280;
    if (j < 512) { const int i = j / 256, r = j % 256, nt = r / 16, kt = r % 16;
        J.src = PIN(I_WOUTO) + (size_t)i * 1024 * 1024; J.ld = 1024; J.col0 = nt * 64; J.k0 = kt * 64; J.dst = (bf16_t*)(PWS + WS_WOUTO) + (size_t)i * 1024 * 1024; J.Ktot = 1024; J.drow0 = nt * 64; return J; }
    j -= 512;
    if (j < 16) { const int i = j / 8, nt = j % 8;
        J.src = PIN(I_W2) + (size_t)i * 64 * 512; J.ld = 512; J.col0 = nt * 64; J.k0 = 0; J.dst = (bf16_t*)(PWS + WS_W2T) + (size_t)i * 512 * 64; J.Ktot = 64; J.drow0 = nt * 64; return J; }
    j -= 16;
    if (j < 16) { const int i = j / 8, nt = j % 8;
        J.src = PIN(I_A2) + (size_t)i * 64 * 512; J.ld = 512; J.col0 = nt * 64; J.k0 = 0; J.dst = (bf16_t*)(PWS + WS_A2T) + (size_t)i * 512 * 64; J.Ktot = 64; J.drow0 = nt * 64; return J; }
    j -= 16;
    { const int ig = j / 4, r = j % 4, nt = r / 2, kt = r % 2;
        J.src = PIN(I_POOLW) + (size_t)ig * 128 * 128; J.ld = 128; J.col0 = nt * 64; J.k0 = kt * 64; J.dst = (bf16_t*)(PWS + WS_POOLWT) + (size_t)ig * 128 * 128; J.Ktot = 128; J.drow0 = nt * 64; }
    return J;
}
__device__ __forceinline__ void tr_load(const TrJob& J, int tid, f32x4& va, f32x4& vb) {
    const int nn = (tid & 15) * 4, ka = tid >> 4, kb = ka + 32;
    va = (f32x4){0.f, 0.f, 0.f, 0.f}; vb = va;
    if (!J.zero) {
        va = *(const f32x4*)(J.src + (size_t)(J.k0 + ka) * J.ld + J.col0 + nn); vb = *(const f32x4*)(J.src + (size_t)(J.k0 + kb) * J.ld + J.col0 + nn);
        if (J.scale) { va = va * J.scale[J.k0 + ka]; vb = vb * J.scale[J.k0 + kb]; }
    }
}

__device__ void phase_prepass(const Params& p, const Ctx cx, LAS unsigned char* lds) {
    LAS float* T = (LAS float*)lds;
    const int tid = cx.tid;
    {
        int job = cx.bid;
        f32x4 va = (f32x4){0.f, 0.f, 0.f, 0.f}, vb = va;
        if (job < 4544) { const TrJob J0 = tr_decode(p, cx, job); tr_load(J0, tid, va, vb); }
        for (; job < 4544; job += cx.nblk) {
            f32x4 na = va, nb = vb;
            if (job + (int)cx.nblk < 4544) { const TrJob Jn = tr_decode(p, cx, job + (int)cx.nblk); tr_load(Jn, tid, na, nb); }
            {
                const int nn = (tid & 15) * 4, ka = tid >> 4, kb = ka + 32;
                T[ka * 65 + nn] = va[0]; T[ka * 65 + nn + 1] = va[1]; T[ka * 65 + nn + 2] = va[2]; T[ka * 65 + nn + 3] = va[3];
                T[kb * 65 + nn] = vb[0]; T[kb * 65 + nn + 1] = vb[1]; T[kb * 65 + nn + 2] = vb[2]; T[kb * 65 + nn + 3] = vb[3];
            }
            __syncthreads();
            {
                const TrJob J = tr_decode(p, cx, job);
                const int n = tid >> 3, kc = (tid & 7) * 8;
                u32x4 w;
                w.x = cvt_pk_bf16(T[(kc + 0) * 65 + n], T[(kc + 1) * 65 + n]); w.y = cvt_pk_bf16(T[(kc + 2) * 65 + n], T[(kc + 3) * 65 + n]);
                w.z = cvt_pk_bf16(T[(kc + 4) * 65 + n], T[(kc + 5) * 65 + n]); w.w = cvt_pk_bf16(T[(kc + 6) * 65 + n], T[(kc + 7) * 65 + n]);
                *(u32x4*)(J.dst + (size_t)(J.drow0 + n) * J.Ktot + J.k0 + kc) = w;
            }
            __syncthreads();
            va = na; vb = nb;
        }
    }
    const int gtid = cx.bid * 512 + tid, gthreads = cx.nblk * 512;
    for (int e = gtid; e < 8 * 128 * 128; e += gthreads) {
        const int s = e & 127, t = (e >> 7) & 127;
        ((bf16_t*)(PWS + WS_SPW))[e] = (s <= t) ? (bf16_t)(cvt_pk_bf16(PIN(I_SPW)[e], 0.f) & 0xffffu) : (bf16_t)0;
    }
    const int wid = tid >> 6, lane = tid & 63;
    for (int row0 = cx.bid * 8 + wid; row0 < NTOK; row0 += cx.nblk * 8 * 3) {
        f32x4 v[3][4];
#pragma unroll
        for (int r = 0; r < 3; ++r) {
            const int row = row0 + r * cx.nblk * 8; const int rr = row < NTOK ? row : row0;
            const float* src = rr < NTP ? PIN(I_XP) + (size_t)rr * 1024 : PIN(I_XS) + (size_t)(rr - NTP) * 1024;
#pragma unroll
            for (int i = 0; i < 4; ++i) v[r][i] = *(const f32x4*)(src + i * 256 + lane * 4);
        }
#pragma unroll
        for (int r = 0; r < 3; ++r) {
            const int row = row0 + r * cx.nblk * 8;
            if (row < NTOK) {
                bf16_t* dst = (bf16_t*)(PWS + WS_XB) + (size_t)row * 1024;
                float ss = 0.f;
#pragma unroll
                for (int i = 0; i < 4; ++i) { ss += dot4(v[r][i], v[r][i]); st_bf4(dst + i * 256 + lane * 4, v[r][i]); }
#pragma unroll
                for (int o = 32; o >= 1; o >>= 1) ss += __shfl_xor(ss, o);
                if (lane < 16) ((float*)(PWS + WS_SSQ))[(size_t)row * 16 + lane] = (lane == 0) ? ss : 0.f;
            }
        }
    }
}

__device__ __forceinline__ f32x4 shift4(const bf16_t* cur, bool hp, const float* st, int col, const float* mu) {
    const f32x4 q = ld_bf4(cur + col);
    f32x4 pv;
    if (hp) pv = ld_bf4(cur - LDB + col); else if (st) pv = *(const f32x4*)(st + col); else pv = (f32x4){0.f, 0.f, 0.f, 0.f};
    const f32x4 m = *(const f32x4*)(mu + col);
    return q + m * (pv - q);
}

__device__ void phase_even_prep(const Params& p, const Ctx cx, int pair, LAS unsigned char* lds) {
    const int tid = cx.tid, wid = tid >> 6, lane = tid & 63, fr = lane & 15, fq = lane >> 4;
    const bf16_t* PB = (const bf16_t*)(PWS + WS_PROJB);
    float* Wdec = (float*)(PWS + WS_WDEC);
    bf16_t* Aa = (bf16_t*)(PWS + WS_AA);
    bf16_t* Ycat = (bf16_t*)(PWS + WS_YCAT);
    const float* mu_ = PIN(I_MU) + pair * 1664;
    const float* w0_ = PIN(I_W0) + pair * 512; const float* a0_ = PIN(I_A0) + pair * 512;
    const float* k_a_ = PIN(I_KA) + pair * 512; const float* r_k_ = PIN(I_RK) + pair * 512;
    constexpr int RS = 3344;
    constexpr int TB = 17 * RS;
    constexpr int NCH = 17 * 208;
    const int h = wid;
    bf16x8 wfr[4][2], afr[4][2];
    {
        const bf16_t* W2T = (const bf16_t*)(PWS + WS_W2T) + (size_t)pair * 512 * 64;
        const bf16_t* A2T = (const bf16_t*)(PWS + WS_A2T) + (size_t)pair * 512 * 64;
#pragma unroll
        for (int nt = 0; nt < 4; ++nt)
#pragma unroll
            for (int ks = 0; ks < 2; ++ks) {
                wfr[nt][ks] = *(const bf16x8*)(W2T + (size_t)(h * 64 + nt * 16 + fr) * 64 + ks * 32 + fq * 8);
                afr[nt][ks] = *(const bf16x8*)(A2T + (size_t)(h * 64 + nt * 16 + fr) * 64 + ks * 32 + fq * 8);
            }
    }
    constexpr int TBD = 56 * 1024;
    const int widu = __builtin_amdgcn_readfirstlane(tid >> 6);
#define PREP_DMA(tile_, b_, lane_) do { _Pragma("unroll") for (int i_ = 0; i_ < 7; ++i_) { const int k_ = widu * 7 + i_, q_ = k_ * 64 + (lane_); \
            int lr_ = q_ / 209, cc_ = q_ - lr_ * 209; if (lr_ > 16) { lr_ = 16; cc_ = 0; } if (cc_ > 207) cc_ = 0; \
            int gr_ = (tile_) * 16 - 1 + lr_; gr_ = gr_ < 0 ? 0 : gr_; \
            __builtin_amdgcn_global_load_lds((const unsigned*)(PB + (size_t)gr_ * LDB + cc_ * 8), (LAS unsigned*)(lds + (b_) * TBD + k_ * 1024), 16, 0, 0); } } while (0)
    LAS float* CL = (LAS float*)(lds + 2 * TBD);
    {
        const float f0 = mu_[tid], f1 = mu_[tid + 512], f2 = mu_[tid + 1024], f3 = tid < 128 ? mu_[tid + 1536] : 0.f;
        const float f4 = w0_[tid], f5 = a0_[tid], f6 = k_a_[tid], f7 = r_k_[tid];
        CL[tid] = f0; CL[tid + 512] = f1; CL[tid + 1024] = f2; if (tid < 128) CL[tid + 1536] = f3;
        CL[1664 + tid] = f4; CL[2176 + tid] = f5; CL[2688 + tid] = f6; CL[3200 + tid] = f7;
    }
    int buf = 0;
    if ((int)cx.bid < NTOK / 16) PREP_DMA((int)cx.bid, 0, tid & 63);
    asm volatile("s_waitcnt vmcnt(0)" ::: "memory");
    __syncthreads();
    for (int tile = cx.bid; tile < NTOK / 16; tile += cx.nblk) {
        int zz; asm volatile("v_mov_b32 %0, 0" : "=v"(zz));
        const int tidv = tid + zz, fr = (tidv & 15), fq = (tidv >> 4) & 3;
        if (tile + (int)cx.nblk < NTOK / 16) PREP_DMA(tile + (int)cx.nblk, buf ^ 1, tidv & 63);
        {
            const int row = tile * 16 + fr;
            const bool samp = row >= NTP;
            int b, t; if (!samp) { b = row >> 11; t = row & 2047; } else { const int q = row - NTP; b = q >> 3; t = q & 7; }
            const bool hp = t > 0;
            const float* st = samp ? PIN(I_SSHIFT) + ((size_t)pair * 128 + b) * 1664 : nullptr;
            LAS const float* mu = CL; LAS const float* w0 = CL + 1664; LAS const float* a0 = CL + 2176; LAS const float* k_a = CL + 2688; LAS const float* r_k = CL + 3200;
            LAS const unsigned char* curL = lds + buf * TBD + (fr + 1) * RS;
            LAS const unsigned char* prvL = lds + buf * TBD + fr * RS;
            auto sh4 = [&](int col) -> f32x4 {
                const f32x4 q = cvt4(*(LAS const u32x2*)(curL + col * 2));
                f32x4 pv;
                if (hp) pv = cvt4(*(LAS const u32x2*)(prvL + col * 2)); else if (st) pv = *(const f32x4*)(st + col); else pv = (f32x4){0.f, 0.f, 0.f, 0.f};
                const f32x4 m = *(LAS const f32x4*)(mu + col);
                return q + m * (pv - q);
            };
            bf16x8 Aw[2], Al[2];
#pragma unroll
            for (int ks = 0; ks < 2; ++ks) {
                const int cw = 1536 + ks * 32 + fq * 8, ca = 1600 + ks * 32 + fq * 8;
                const f32x4 w_lo = sh4(cw), w_hi = sh4(cw + 4), a_lo = sh4(ca), a_hi = sh4(ca + 4);
                u32x4 pw, pa;
                float th[8];
#pragma unroll
                for (int j = 0; j < 4; ++j) { th[j] = 2.0f * sigmoidf_(2.0f * w_lo[j]) - 1.0f; th[4 + j] = 2.0f * sigmoidf_(2.0f * w_hi[j]) - 1.0f; }
                pw.x = cvt_pk_bf16(th[0], th[1]); pw.y = cvt_pk_bf16(th[2], th[3]); pw.z = cvt_pk_bf16(th[4], th[5]); pw.w = cvt_pk_bf16(th[6], th[7]);
                pa.x = cvt_pk_bf16(a_lo[0], a_lo[1]); pa.y = cvt_pk_bf16(a_lo[2], a_lo[3]); pa.z = cvt_pk_bf16(a_hi[0], a_hi[1]); pa.w = cvt_pk_bf16(a_hi[2], a_hi[3]);
                Aw[ks] = __builtin_bit_cast(bf16x8, pw); Al[ks] = __builtin_bit_cast(bf16x8, pa);
            }
            float bon = 0.f;
#pragma unroll
            for (int nt = 0; nt < 4; ++nt) {
                f32x4 lw = (f32x4){0.f, 0.f, 0.f, 0.f}, la = (f32x4){0.f, 0.f, 0.f, 0.f};
#pragma unroll
                for (int ks = 0; ks < 2; ++ks) {
                    lw = __builtin_amdgcn_mfma_f32_16x16x32_bf16(wfr[nt][ks], Aw[ks], lw, 0, 0, 0);
                    la = __builtin_amdgcn_mfma_f32_16x16x32_bf16(afr[nt][ks], Al[ks], la, 0, 0, 0);
                }
                const int ch = h * 64 + nt * 16 + fq * 4;
                const f32x4 r4 = sh4(ch), k4 = sh4(512 + ch);
                const f32x4 w04 = *(LAS const f32x4*)(w0 + ch), a04 = *(LAS const f32x4*)(a0 + ch), ka4 = *(LAS const f32x4*)(k_a + ch), rk4 = *(LAS const f32x4*)(r_k + ch);
                f32x4 dec, av;
#pragma unroll
                for (int j = 0; j < 4; ++j) {
                    const float z_ = -(w04[j] + lw[j]);
                    const float wlog = -__logf(1.0f + __expf(z_)) - 0.5f;
                    dec[j] = __expf(-__expf(wlog));
                    av[j] = sigmoidf_(a04[j] + la[j]);
                    const float kp = k4[j] * (1.0f + (av[j] - 1.0f) * ka4[j]);
                    bon += r4[j] * kp * rk4[j];
                }
                *(f32x4*)(Wdec + (size_t)row * 512 + ch) = dec;
                st_bf4(Aa + (size_t)row * 512 + ch, av);
            }
            bon += __shfl_xor(bon, 16); bon += __shfl_xor(bon, 32);
#pragma unroll
            for (int nt = 0; nt < 4; ++nt) { const int ch = h * 64 + nt * 16 + fq * 4; st_bf4(Ycat + (size_t)row * 1024 + 512 + ch, sh4(1024 + ch) * bon); }
        }
        asm volatile("s_waitcnt vmcnt(0)" ::: "memory");
        __syncthreads();
        buf ^= 1;
    }
#undef PREP_DMA
    const int gtid = cx.bid * 512 + tid, gthreads = cx.nblk * 512;
    for (int e = gtid; e < 136 * 1664; e += gthreads) {
        const int sr = e / 1664, c = e % 1664;
        if (sr < 8) POUT[O_SHIFTP + ((size_t)pair * 8 + sr) * 1664 + c] = bf2f(PB[(size_t)(sr * 2048 + 2047) * LDB + c]);
        else { const int b = sr - 8; POUT[O_SHIFTS + ((size_t)pair * 128 + b) * 1664 + c] = bf2f(PB[(size_t)(NTP + b * 8 + 7) * LDB + c]); }
    }
}

typedef float f32x2 __attribute__((ext_vector_type(2)));
template <bool RED = true>
__device__ __forceinline__ void scan_step(f32x4& S, const f32x4 w, const f32x4 k, const f32x4 kk, const f32x4 nb, const f32x4 r, const float v, float& y) {
    const f32x2 S01 = {S[0], S[1]}, S23 = {S[2], S[3]};
    f32x2 pp = S01 * (f32x2){kk[0], kk[1]};
    pp = S23 * (f32x2){kk[2], kk[3]} + pp;
    float pd = pp[0] + pp[1];
    const f32x2 vv = {v, v};
    const f32x2 t01 = S01 * (f32x2){w[0], w[1]} + (f32x2){k[0], k[1]} * vv;
    const f32x2 t23 = S23 * (f32x2){w[2], w[3]} + (f32x2){k[2], k[3]} * vv;
    pd = allsum16(pd);
    const f32x2 pdv = {pd, pd};
    const f32x2 n01 = (f32x2){nb[0], nb[1]} * pdv + t01, n23 = (f32x2){nb[2], nb[3]} * pdv + t23;
    S = (f32x4){n01[0], n01[1], n23[0], n23[1]};
    f32x2 q = n01 * (f32x2){r[0], r[1]};
    q = n23 * (f32x2){r[2], r[3]} + q;
    y = RED ? allsum16(q[0] + q[1]) : (q[0] + q[1]);
}
__device__ __forceinline__ float reduce_scatter16(const float (&yp)[16], int cgi) {
    const bool b3 = cgi & 8, b2 = cgi & 4, b1 = cgi & 2, b0 = cgi & 1;
    float a[8], bq[4], c[2];
#pragma unroll
    for (int j = 0; j < 8; ++j) { const float keep = b3 ? yp[8 + j] : yp[j], send = b3 ? yp[j] : yp[8 + j]; a[j] = keep + dpp_f<0x128>(send); }
#pragma unroll
    for (int k = 0; k < 4; ++k) { const float keep = b2 ? a[4 + k] : a[k], send = b2 ? a[k] : a[4 + k]; bq[k] = keep + dpp_f<0x141>(send); }
#pragma unroll
    for (int m = 0; m < 2; ++m) { const float keep = b1 ? bq[2 + m] : bq[m], send = b1 ? bq[m] : bq[2 + m]; c[m] = keep + dpp_f<0x4E>(send); }
    const float keep = b0 ? c[1] : c[0], send = b0 ? c[0] : c[1];
    return keep + dpp_f<0xB1>(send);
}

__device__ void phase_scan(const Params& p, const Ctx cx, int pair, LAS unsigned char* lds) {
    const int tid = cx.tid, wid = tid >> 6, lane = tid & 63, rs = lane >> 4, cgi = lane & 15;
    const bf16_t* PB = (const bf16_t*)(PWS + WS_PROJB);
    const float* Wdec = (const float*)(PWS + WS_WDEC);
    const bf16_t* Aa = (const bf16_t*)(PWS + WS_AA);
    bf16_t* Y = (bf16_t*)(PWS + WS_Y);
    const float* mu = PIN(I_MU) + pair * 1664;
    const float* k_k = PIN(I_KK) + pair * 512; const float* k_a = PIN(I_KA) + pair * 512;
    {
        LAS float* vb = (LAS float*)lds + wid * 3072;
        for (int st = cx.bid * 8 + wid; st < 2048; st += cx.nblk * 8) {
            const int bh = st >> 1, half = st & 1, b = bh >> 3, h = bh & 7, ch = h * 64 + cgi * 4;
            const float* stp = PIN(I_SSHIFT) + ((size_t)pair * 128 + b) * 1664;
            const f32x4 kkc = *(const f32x4*)(k_k + ch), kac = *(const f32x4*)(k_a + ch);
            {
#pragma unroll
                for (int tt = 0; tt < 2; ++tt) {
                    const int t = rs + tt * 4;
                    const size_t row = NTP + b * 8 + t;
                    const bf16_t* cur = PB + row * LDB;
                    const f32x4 r = shift4(cur, t > 0, stp, ch, mu), k = shift4(cur, t > 0, stp, 512 + ch, mu), v = shift4(cur, t > 0, stp, 1024 + ch, mu);
                    const f32x4 a = ld_bf4(Aa + row * 512 + ch);
                    const f32x4 w = *(const f32x4*)(Wdec + row * 512 + ch);
                    const f32x4 kkv = k * kkc;
                    const float ss = allsum16(dot4(kkv, kkv));
                    const float inv = 1.0f / fmaxf(sqrtf(ss), 1e-12f);
                    const f32x4 kkn = kkv * inv;
                    LAS float* o = vb + t * 384 + cgi * 4;
                    *(LAS f32x4*)(o) = w; *(LAS f32x4*)(o + 64) = k * (1.0f + (a - 1.0f) * kac); *(LAS f32x4*)(o + 128) = kkn; *(LAS f32x4*)(o + 192) = -(kkn * a);
                    *(LAS f32x4*)(o + 256) = r; *(LAS f32x4*)(o + 320) = v;
                }
            }
            asm volatile("s_waitcnt lgkmcnt(0)" ::: "memory");
            __builtin_amdgcn_wave_barrier();
            const size_t so0 = ((((size_t)pair * 128 + b) * 8 + h) * 64 + half * 32 + rs) * 64 + cgi * 4;
            f32x4 Snext = *(const f32x4*)(PIN(I_SWKV) + so0);
#pragma unroll 1
            for (int rq = 0; rq < 8; ++rq) {
                const int ri = half * 32 + rq * 4 + rs;
                const size_t so = so0 + (size_t)rq * 256;
                f32x4 S = Snext;
                if (rq + 1 < 8) Snext = *(const f32x4*)(PIN(I_SWKV) + so + 256);
                float ykeep = 0.f;
#pragma unroll
                for (int t = 0; t < 8; ++t) {
                    LAS const float* r0 = vb + t * 384 + cgi * 4;
                    float y; scan_step(S, *(LAS const f32x4*)(r0), *(LAS const f32x4*)(r0 + 64), *(LAS const f32x4*)(r0 + 128), *(LAS const f32x4*)(r0 + 192), *(LAS const f32x4*)(r0 + 256), vb[t * 384 + 320 + ri], y);
                    ykeep = (cgi == t) ? y : ykeep;
                }
                if (cgi < 8) Y[(size_t)(NTP + b * 8 + cgi) * 512 + h * 64 + ri] = (bf16_t)(cvt_pk_bf16(ykeep, 0.f) & 0xffffu);
                *(f32x4*)(POUT + O_WKVS + so) = S;
            }
            asm volatile("s_waitcnt lgkmcnt(0)" ::: "memory");
            __builtin_amdgcn_wave_barrier();
        }
    }
    __syncthreads();
    LAS float* rec = (LAS float*)lds;
    for (int pt = cx.bid; pt < 256; pt += cx.nblk) {
        const int xcd = pt & 7, slot = pt >> 3, bh = xcd * 8 + (slot >> 2), rg = slot & 3, b = bh >> 3, h = bh & 7;
        const int lt = tid - 256, ls = (lt >> 4) & 15, lcg = lt & 15, lch = h * 64 + lcg * 4;
        u32x2 qr = {0u, 0u}, qk = {0u, 0u}, qv = {0u, 0u}, pr = {0u, 0u}, pk = {0u, 0u}, pv = {0u, 0u}, qa = {0u, 0u};
        f32x4 qw = (f32x4){0.f, 0.f, 0.f, 0.f};
        f32x4 mur, muk, muv, kkc, kac;
        const int ri = rg * 16 + (wid & 3) * 4 + rs;
        f32x4 S = (f32x4){0.f, 0.f, 0.f, 0.f};
#define SCAN_ISSUE(c) do { const int t_ = (c) * 16 + ls; const size_t row_ = (size_t)b * 2048 + t_; const bf16_t* cur_ = PB + row_ * LDB; \
            qr = *(const u32x2*)(cur_ + lch); qk = *(const u32x2*)(cur_ + 512 + lch); qv = *(const u32x2*)(cur_ + 1024 + lch); \
            if (t_ > 0) { pr = *(const u32x2*)(cur_ - LDB + lch); pk = *(const u32x2*)(cur_ - LDB + 512 + lch); pv = *(const u32x2*)(cur_ - LDB + 1024 + lch); } \
            else { pr = (u32x2){0u, 0u}; pk = pr; pv = pr; } \
            qw = *(const f32x4*)(Wdec + row_ * 512 + lch); qa = *(const u32x2*)(Aa + row_ * 512 + lch); } while (0)
#define SCAN_PROCESS(buf) do { const f32x4 r0_ = cvt4(qr), k0_ = cvt4(qk), v0_ = cvt4(qv); \
            const f32x4 r_ = r0_ + mur * (cvt4(pr) - r0_), k_ = k0_ + muk * (cvt4(pk) - k0_), v_ = v0_ + muv * (cvt4(pv) - v0_), a_ = cvt4(qa); \
            const f32x4 kkv_ = k_ * kkc; const float ss_ = allsum16(dot4(kkv_, kkv_)); const float inv_ = __builtin_amdgcn_rsqf(fmaxf(ss_, 1e-24f)); \
            const f32x4 kkn_ = kkv_ * inv_; \
            LAS float* o_ = rec + (buf) * 6144 + ls * 384 + lcg * 4; \
            *(LAS f32x4*)(o_) = qw; *(LAS f32x4*)(o_ + 64) = k_ * (1.0f + (a_ - 1.0f) * kac); *(LAS f32x4*)(o_ + 128) = kkn_; *(LAS f32x4*)(o_ + 192) = -(kkn_ * a_); \
            *(LAS f32x4*)(o_ + 256) = r_; *(LAS f32x4*)(o_ + 320) = v_; } while (0)
        if (wid >= 4) {
            mur = *(const f32x4*)(mu + lch); muk = *(const f32x4*)(mu + 512 + lch); muv = *(const f32x4*)(mu + 1024 + lch);
            kkc = *(const f32x4*)(k_k + lch); kac = *(const f32x4*)(k_a + lch);
            SCAN_ISSUE(0); SCAN_PROCESS(0); SCAN_ISSUE(1);
        }
        __syncthreads();
        for (int c = 0; c < 128; ++c) {
            if (wid < 4) {
                LAS const float* rb = rec + (c & 1) * 6144 + cgi * 4;
                LAS const float* rv = rec + (c & 1) * 6144 + 320 + ri;
                float yp[16];
                f32x4 nw = *(LAS const f32x4*)(rb), nk = *(LAS const f32x4*)(rb + 64), nkk = *(LAS const f32x4*)(rb + 128), nb = *(LAS const f32x4*)(rb + 192), nr = *(LAS const f32x4*)(rb + 256);
                float nv = rv[0];
#pragma unroll
                for (int s = 0; s < 16; ++s) {
                    const f32x4 cw = nw, ck = nk, ckk = nkk, cb = nb, cr = nr; const float cv = nv;
                    if (s + 1 < 16) {
                        LAS const float* r1 = rb + (s + 1) * 384;
                        nw = *(LAS const f32x4*)(r1); nk = *(LAS const f32x4*)(r1 + 64); nkk = *(LAS const f32x4*)(r1 + 128); nb = *(LAS const f32x4*)(r1 + 192); nr = *(LAS const f32x4*)(r1 + 256);
                        nv = rv[(s + 1) * 384];
                    }
                    scan_step<false>(S, cw, ck, ckk, cb, cr, cv, yp[s]);
                }
                Y[((size_t)b * 2048 + c * 16 + cgi) * 512 + h * 64 + ri] = (bf16_t)(cvt_pk_bf16(reduce_scatter16(yp, cgi), 0.f) & 0xffffu);
            } else {
                if (c + 1 < 128) { SCAN_PROCESS((c + 1) & 1); if (c + 2 < 128) SCAN_ISSUE(c + 2); }
            }
            __syncthreads();
        }
        if (wid < 4) *(f32x4*)(POUT + O_WKVP + ((((size_t)pair * 8 + b) * 8 + h) * 64 + ri) * 64 + cgi * 4) = S;
#undef SCAN_ISSUE
#undef SCAN_PROCESS
    }
}

__device__ void phase_even_post(const Params& p, const Ctx cx, int pair) {
    const int gtid = cx.bid * 512 + cx.tid, gthreads = cx.nblk * 512;
    const bf16_t* PA = (const bf16_t*)(PWS + WS_R1);
    bf16_t* Ycat = (bf16_t*)(PWS + WS_YCAT);
    const bf16_t* Y = (const bf16_t*)(PWS + WS_Y);
    constexpr int NIT = NTOK * 128, UB = 4;
    const float* gn_g = PIN(I_GNG) + pair * 512; const float* gn_b = PIN(I_GNB) + pair * 512;
    for (int e0 = gtid; e0 < NIT; e0 += gthreads * UB) {
        f32x4 y[UB], bv[UB], bz[UB], gg[UB], gb[UB]; bool ok[UB];
#pragma unroll
        for (int u = 0; u < UB; ++u) {
            const int e = e0 + u * gthreads; ok[u] = e < NIT;
            const int ee = ok[u] ? e : e0; const int row = ee >> 7, ch = (ee & 127) * 4;
            y[u] = ld_bf4(Y + (size_t)row * 512 + ch);
            bv[u] = ld_bf4(Ycat + (size_t)row * 1024 + 512 + ch);
            bz[u] = ld_bf4(PA + (size_t)row * LDA + 2048 + ch);
            gg[u] = *(const f32x4*)(gn_g + ch); gb[u] = *(const f32x4*)(gn_b + ch);
        }
#pragma unroll
        for (int u = 0; u < UB; ++u) {
            const int e = e0 + u * gthreads;
            const int ee = ok[u] ? e : e0; const int row = ee >> 7, ch = (ee & 127) * 4;
            const float mean = allsum16(y[u][0] + y[u][1] + y[u][2] + y[u][3]) * (1.0f / 64.0f);
            const f32x4 d = y[u] - mean;
            const float var = allsum16(dot4(d, d)) * (1.0f / 64.0f);
            const float rstd = rsqrtf(var + 64e-5f);
            const f32x4 g = gg[u], bb = gb[u];
            f32x4 o;
#pragma unroll
            for (int j = 0; j < 4; ++j) o[j] = (d[j] * rstd * g[j] + bb[j] + bv[u][j]) * siluf_(bz[u][j]);
            if (ok[u]) st_bf4(Ycat + (size_t)row * 1024 + 512 + ch, o);
        }
    }
    const float* cw = PIN(I_CONVW) + pair * 3 * 512;
    constexpr int NRUN = (NTOK / 8) * 128;
    for (int e = gtid; e < NRUN; e += gthreads) {
        const int run = e >> 7, ch = (e & 127) * 4, row0 = run * 8;
        const bool samp = row0 >= NTP;
        int b, t0, T; if (!samp) { b = row0 >> 11; t0 = row0 & 2047; T = 2048; } else { b = (row0 - NTP) >> 3; t0 = 0; T = 8; }
        const bf16_t* base = PA + (size_t)row0 * LDA + ch;
        u32x2 rh[10], rc[10], rb[8], rz[8];
#pragma unroll
        for (int k = 0; k < 10; ++k) {
            const bool have = (k >= 2) || (t0 > 0);
            const bf16_t* pr = have ? base + (ptrdiff_t)(k - 2) * LDA : base;
            rh[k] = *(const u32x2*)(pr); rc[k] = *(const u32x2*)(pr + 1024);
        }
#pragma unroll
        for (int k = 0; k < 8; ++k) { rb[k] = *(const u32x2*)(base + (size_t)k * LDA + 512); rz[k] = *(const u32x2*)(base + (size_t)k * LDA + 1536); }
        const f32x4 k0 = *(const f32x4*)(cw + ch), k1 = *(const f32x4*)(cw + 512 + ch), k2 = *(const f32x4*)(cw + 1024 + ch);
        f32x4 um2, um1;
        if (t0 > 0) { um2 = cvt4(rc[0]) * cvt4(rh[0]); um1 = cvt4(rc[1]) * cvt4(rh[1]); }
        else if (samp) { const float* hist = PIN(I_SCONV) + ((size_t)pair * 128 + b) * 2 * 512 + ch; um2 = *(const f32x4*)(hist); um1 = *(const f32x4*)(hist + 512); }
        else { um2 = (f32x4){0.f, 0.f, 0.f, 0.f}; um1 = um2; }
#pragma unroll
        for (int k = 0; k < 8; ++k) {
            const f32x4 u0 = cvt4(rc[k + 2]) * cvt4(rh[k + 2]);
            const f32x4 conv = k0 * um2 + k1 * um1 + k2 * u0;
            const f32x4 ab = cvt4(rb[k]), az = cvt4(rz[k]);
            f32x4 o;
#pragma unroll
            for (int j = 0; j < 4; ++j) o[j] = ab[j] * conv[j] * siluf_(az[j]);
            const int row = row0 + k, t = t0 + k;
            st_bf4(Ycat + (size_t)row * 1024 + ch, o);
            if (t >= T - 2) {
                float* dst = samp ? POUT + O_CONVS + (((size_t)pair * 128 + b) * 2 + (t - (T - 2))) * 512 + ch : POUT + O_CONVP + (((size_t)pair * 8 + b) * 2 + (t - (T - 2))) * 512 + ch;
                *(f32x4*)dst = u0;
            }
            um2 = um1; um1 = u0;
        }
    }
}

template <int W>
__device__ __forceinline__ void pool_sample_run(const float* __restrict__ hist, const bf16_t* __restrict__ cur, LAS bf16_t* out) {
    f32x4 ext[23];
#pragma unroll
    for (int k = 0; k < 15; ++k) ext[k] = (k >= 16 - W) ? *(const f32x4*)(hist + (size_t)k * 512) : (f32x4){0.f, 0.f, 0.f, 0.f};
#pragma unroll
    for (int k = 0; k < 8; ++k) ext[15 + k] = ld_bf4(cur + (size_t)k * LDA);
    f32x4 sum = (f32x4){0.f, 0.f, 0.f, 0.f};
#pragma unroll
    for (int d = 0; d < W; ++d) sum += ext[15 - d];
#pragma unroll
    for (int t = 0; t < 8; ++t) {
        if (t > 0) sum += ext[15 + t] - ext[15 + t - W];
        const f32x4 pooled = sum * (1.0f / (float)W) - ext[15 + t];
        u32x2 u; u.x = cvt_pk_bf16(pooled[0], pooled[1]); u.y = cvt_pk_bf16(pooled[2], pooled[3]);
        *(LAS u32x2*)(out + t * 136) = u;
    }
}

__device__ void phase_odd_mixer(const Params& p, const Ctx cx, int pair, LAS unsigned char* lds) {
    const int tid = cx.tid, wid = tid >> 6, lane = tid & 63, fr = lane & 15, fq = lane >> 4;
    const bf16_t* PO = (const bf16_t*)(PWS + WS_R1);
    bf16_t* Ycat = (bf16_t*)(PWS + WS_YCAT);
    LAS bf16_t* LA = (LAS bf16_t*)lds;
    LAS bf16_t* LB = (LAS bf16_t*)(lds + 128 * 136 * 2);
    LAS float* stat = (LAS float*)(lds + 2 * 128 * 136 * 2);
    LAS float* LE = (LAS float*)(lds + 128 * 136 * 2);
    LAS bf16_t* LW = (LAS bf16_t*)(lds + 128 * 136 * 2 + 143 * 128 * 4);
    for (int di = 0; di < 8; ++di) {
        int tile, g0, ng;
        if (cx.nblk == 256) {
            if (di == 0) { tile = cx.bid >> 1; g0 = (cx.bid & 1) * 2; ng = 2; }
            else if (di == 1 && cx.bid < 32) { tile = 128 + (cx.bid >> 2); g0 = cx.bid & 3; ng = 1; }
            else break;
        } else { tile = cx.bid + di * cx.nblk; g0 = 0; ng = 4; if (tile >= 136) break; }
        const int r0 = tile * 128;
        const bool samp = r0 >= NTP;
        const int tl_ = tid >> 2, q_ = tid & 3;
        {
            const bf16_t* vr = PO + (size_t)(r0 + tl_) * LDA + 1536 + q_ * 128;
            float s_ = 0.f, ss = 0.f;
#pragma unroll
            for (int i = 0; i < 16; ++i) { const u32x4 raw = *(const u32x4*)(vr + i * 8); const f32x4 v0 = cvt4((u32x2){raw.x, raw.y}), v1 = cvt4((u32x2){raw.z, raw.w});
                s_ += (v0[0] + v0[1]) + (v0[2] + v0[3]) + (v1[0] + v1[1]) + (v1[2] + v1[3]); ss += dot4(v0, v0) + dot4(v1, v1); }
            s_ = allsum4(s_); ss = allsum4(ss);
            const float mean = s_ * (1.0f / 512.0f);
            const float var = fmaxf(ss * (1.0f / 512.0f) - mean * mean, 0.f);
            if (q_ == 0) { stat[tl_ * 2] = mean; stat[tl_ * 2 + 1] = rsqrtf(var + 1e-5f); }
        }
        LAS float* lnw = stat + 512;
        lnw[tid] = PIN(I_LNG)[pair * 512 + tid]; lnw[512 + tid] = PIN(I_LNB)[pair * 512 + tid];
        u32x2 rv[8]; u32x4 rw[4];
#define MIX_LOAD_G(gg) do { const bf16_t* vr_ = PO + (size_t)(r0 + tl_) * LDA + 1536 + (gg) * 128 + q_ * 32; \
            _Pragma("unroll") for (int i = 0; i < 8; ++i) rv[i] = *(const u32x2*)(vr_ + i * 4); \
            if (!samp) { const bf16_t* Ws_ = (const bf16_t*)(PWS + WS_SPW) + ((size_t)pair * 4 + (gg)) * 128 * 128; \
                _Pragma("unroll") for (int i = 0; i < 4; ++i) { const int e = tid + i * 512; rw[i] = *(const u32x4*)(Ws_ + (e >> 4) * 128 + (e & 15) * 8); } } } while (0)
        MIX_LOAD_G(g0);
        __syncthreads();
#pragma unroll 1
        for (int g = g0; g < g0 + ng; ++g) {
            u32x2 ur[8], dzr[8];
#pragma unroll
            for (int nt = 0; nt < 8; ++nt) { const size_t o_ = (size_t)(r0 + wid * 16 + fr) * LDA + g * 128 + nt * 16 + fq * 4; ur[nt] = *(const u32x2*)(PO + o_ + 1024); dzr[nt] = *(const u32x2*)(PO + o_ + 2048); }
            {
                const int row = r0 + tl_;
                const float mean = stat[tl_ * 2], rstd = stat[tl_ * 2 + 1];
                LAS const float* lg = lnw + g * 128 + q_ * 32; LAS const float* lb = lnw + 512 + g * 128 + q_ * 32;
#pragma unroll
                for (int i = 0; i < 8; ++i) {
                    const f32x4 v = cvt4(rv[i]);
                    const f32x4 vn = (v - mean) * rstd * *(LAS const f32x4*)(lg + i * 4) + *(LAS const f32x4*)(lb + i * 4);
                    if (samp) *(f32x4*)(POUT + O_CHUNKV + ((size_t)pair * 1024 + (row - NTP)) * 512 + g * 128 + q_ * 32 + i * 4) = vn;
                    {
                        const float p0 = dpp_f<0x104>(vn[0]), p1 = dpp_f<0x104>(vn[1]);
                        const float p2 = dpp_f<0x114>(vn[2]), p3 = dpp_f<0x114>(vn[3]);
                        const bool odd = tl_ & 1;
                        const unsigned wa = odd ? cvt_pk_bf16(p2, vn[2]) : cvt_pk_bf16(vn[0], p0);
                        const unsigned wb = odd ? cvt_pk_bf16(p3, vn[3]) : cvt_pk_bf16(vn[1], p1);
                        const int cb = q_ * 32 + i * 4 + (odd ? 2 : 0), tb = tl_ & ~1;
                        *(LAS unsigned*)(LB + (cb) * 136 + tb) = wa;
                        *(LAS unsigned*)(LB + (cb + 1) * 136 + tb) = wb;
                    }
                }
            }
            if (!samp) {
#pragma unroll
                for (int i = 0; i < 4; ++i) { const int e = tid + i * 512; *(LAS u32x4*)(LA + (e >> 4) * 136 + (e & 15) * 8) = rw[i]; }
            } else {
                const float* Wsrc = PIN(I_SPW) + ((size_t)pair * 4 + g) * 128 * 128;
                LAS float* w8 = stat + 256;
                if (tid < 64) w8[tid] = Wsrc[(tid >> 3) * 128 + (tid & 7)];
                __syncthreads();
                for (int e = tid; e < 128 * 128; e += 512) { const int t = e >> 7, s2 = e & 127;
                    const float v = ((t >> 3) == (s2 >> 3) && (s2 & 7) <= (t & 7)) ? w8[(t & 7) * 8 + (s2 & 7)] : 0.f;
                    LA[t * 136 + s2] = (bf16_t)(cvt_pk_bf16(v, 0.f) & 0xffffu); }
            }
            if (g + 1 < g0 + ng) MIX_LOAD_G(g + 1);
            __syncthreads();
            {
                const int tl = wid * 16 + fr, row = r0 + tl;
                const float bias = PIN(I_SPB)[((size_t)pair * 4 + g) * 128 + (samp ? (tl & 7) : tl)];
                bf16x8 wf[4];
#pragma unroll
                for (int ks = 0; ks < 4; ++ks) wf[ks] = *(const LAS bf16x8*)(LA + tl * 136 + ks * 32 + fq * 8);
#pragma unroll
                for (int nt = 0; nt < 8; ++nt) {
                    f32x4 acc = (f32x4){0.f, 0.f, 0.f, 0.f};
#pragma unroll
                    for (int ks = 0; ks < 4; ++ks) {
                        if (ks * 32 <= wid * 16 + 15) {
                            const bf16x8 vf = *(const LAS bf16x8*)(LB + (nt * 16 + fr) * 136 + ks * 32 + fq * 8);
                            acc = __builtin_amdgcn_mfma_f32_16x16x32_bf16(vf, wf[ks], acc, 0, 0, 0);
                        }
                    }
                    const int c = g * 128 + nt * 16 + fq * 4;
                    const f32x4 u = cvt4(ur[nt]), dz = cvt4(dzr[nt]);
                    f32x4 o;
#pragma unroll
                    for (int j = 0; j < 4; ++j) o[j] = u[j] * (acc[j] + bias) * siluf_(dz[j]);
                    st_bf4(Ycat + (size_t)row * 1024 + 512 + c, o);
                }
            }
            __syncthreads();
        }
#undef MIX_LOAD_G
    }
    {
        int ci, cstride;
        if (cx.nblk == 256) { if (cx.bid < 32) { ci = 1 << 20; cstride = 1 << 20; } else { ci = cx.bid - 32; cstride = 224; } }
        else { ci = cx.bid; cstride = cx.nblk; }
        u32x4 pw[4]; u32x2 pe[9];
#define MIX_LOAD_C(cc) do { const int tile_ = (cc) >> 2, g_ = (cc) & 3, r0_ = tile_ * 128; \
            const bf16_t* Bw_ = (const bf16_t*)(PWS + WS_POOLWT) + ((size_t)pair * 4 + g_) * 128 * 128; \
            _Pragma("unroll") for (int i = 0; i < 4; ++i) { const int e = tid + i * 512; pw[i] = *(const u32x4*)(Bw_ + (e >> 4) * 128 + (e & 15) * 8); } \
            if (r0_ < NTP) { const int t0_ = r0_ & 2047; \
                _Pragma("unroll") for (int i = 0; i < 9; ++i) { const int e = tid + i * 512, er = e >> 5, c = (e & 31) * 4; pe[i] = (u32x2){0u, 0u}; \
                    if (e < 143 * 32 && t0_ + er - 15 >= 0) pe[i] = *(const u32x2*)(PO + (size_t)(r0_ + er - 15) * LDA + g_ * 128 + c); } } } while (0)
        if (ci < 544) MIX_LOAD_C(ci);
        for (; ci < 544; ci += cstride) {
            const int tile = ci >> 2, g = ci & 3, r0 = tile * 128;
            const bool samp = r0 >= NTP;
            const int w = 2 << g;
            const int row = r0 + wid * 16 + fr;
            u32x2 czr[8]; f32x4 psr[8];
#pragma unroll
            for (int nt = 0; nt < 8; ++nt) { const int d = g * 128 + nt * 16 + fq * 4; czr[nt] = *(const u32x2*)(PO + (size_t)row * LDA + 512 + d); psr[nt] = *(const f32x4*)(PIN(I_PSCALE) + pair * 512 + d); }
#pragma unroll
            for (int i = 0; i < 4; ++i) { const int e = tid + i * 512; *(LAS u32x4*)(LW + (e >> 4) * 136 + (e & 15) * 8) = pw[i]; }
            if (!samp) {
                const int t0 = r0 & 2047;
#pragma unroll
                for (int i = 0; i < 9; ++i) { const int e = tid + i * 512, er = e >> 5, c = (e & 31) * 4; if (e < 143 * 32) *(LAS f32x4*)(LE + er * 128 + c) = cvt4(pe[i]); }
                __syncthreads();
                {
                    const int c = (tid & 31) * 4, tl0 = (tid >> 5) * 8;
                    f32x4 sum = (f32x4){0.f, 0.f, 0.f, 0.f};
#pragma unroll 4
                    for (int d = 0; d < w; ++d) sum += *(LAS const f32x4*)(LE + (tl0 + 15 - d) * 128 + c);
#pragma unroll
                    for (int k = 0; k < 8; ++k) {
                        const int tl = tl0 + k;
                        const f32x4 pt = *(LAS const f32x4*)(LE + (tl + 15) * 128 + c);
                        if (k > 0) sum += pt - *(LAS const f32x4*)(LE + (tl + 15 - w) * 128 + c);
                        const float cnt = fminf((float)w, (float)(t0 + tl + 1));
                        const f32x4 pooled = sum * (1.0f / cnt) - pt;
                        u32x2 u; u.x = cvt_pk_bf16(pooled[0], pooled[1]); u.y = cvt_pk_bf16(pooled[2], pooled[3]);
                        *(LAS u32x2*)(LA + tl * 136 + c) = u;
                    }
                }
            } else {
                const int sq = tid >> 5, c = (tid & 31) * 4, bb = (r0 - NTP) / 8 + sq;
                const float* hist = PIN(I_SPOOL) + ((size_t)pair * 128 + bb) * 15 * 512 + g * 128 + c;
                const bf16_t* cur = PO + (size_t)(r0 + sq * 8) * LDA + g * 128 + c;
                LAS bf16_t* out = LA + (sq * 8) * 136 + c;
                if (g == 0) pool_sample_run<2>(hist, cur, out); else if (g == 1) pool_sample_run<4>(hist, cur, out);
                else if (g == 2) pool_sample_run<8>(hist, cur, out); else pool_sample_run<16>(hist, cur, out);
            }
            if (ci + cstride < 544) MIX_LOAD_C(ci + cstride);
            __syncthreads();
            bf16x8 af[4];
#pragma unroll
            for (int ks = 0; ks < 4; ++ks) af[ks] = *(const LAS bf16x8*)(LA + (wid * 16 + fr) * 136 + ks * 32 + fq * 8);
#pragma unroll
            for (int nt = 0; nt < 8; ++nt) {
                f32x4 acc = (f32x4){0.f, 0.f, 0.f, 0.f};
#pragma unroll
                for (int ks = 0; ks < 4; ++ks) {
                    const bf16x8 bf = *(const LAS bf16x8*)(LW + (nt * 16 + fr) * 136 + ks * 32 + fq * 8);
                    acc = __builtin_amdgcn_mfma_f32_16x16x32_bf16(bf, af[ks], acc, 0, 0, 0);
                }
                const int d = g * 128 + nt * 16 + fq * 4;
                const f32x4 cz = cvt4(czr[nt]), ps = psr[nt];
                f32x4 o;
#pragma unroll
                for (int j = 0; j < 4; ++j) o[j] = acc[j] * ps[j] * siluf_(cz[j]);
                st_bf4(Ycat + (size_t)row * 1024 + d, o);
            }
            __syncthreads();
        }
#undef MIX_LOAD_C
    }
    const int gtid = cx.bid * 512 + tid, gthreads = cx.nblk * 512;
    for (int e = gtid; e < 136 * 15 * 128; e += gthreads) {
        const int c = (e & 127) * 4, q = e >> 7, sr = q / 15, k = q - sr * 15;
        if (sr < 8) *(f32x4*)(POUT + O_POOLP + (((size_t)pair * 8 + sr) * 15 + k) * 512 + c) = ld_bf4(PO + (size_t)(sr * 2048 + 2033 + k) * LDA + c);
        else { const int b = sr - 8;
            *(f32x4*)(POUT + O_POOLS + (((size_t)pair * 128 + b) * 15 + k) * 512 + c) = (k < 7) ? *(const f32x4*)(PIN(I_SPOOL) + (((size_t)pair * 128 + b) * 15 + 8 + k) * 512 + c) : ld_bf4(PO + (size_t)(NTP + b * 8 + (k - 7)) * LDA + c); }
    }
}

__device__ void phase_final(const Params& p, const Ctx cx) {
    const int gtid = cx.bid * 512 + cx.tid, gthreads = cx.nblk * 512;
    const float* ssq = (const float*)(PWS + WS_SSQ) + (size_t)4 * NTOK * 16;
    const bf16_t* Xb = (const bf16_t*)(PWS + WS_XB);
    constexpr int NIT = NTOK * 256, UB = 4;
    for (int e0 = gtid; e0 < NIT; e0 += gthreads * UB) {
        f32x4 x[UB], fw[UB]; float sq[UB]; bool ok[UB];
#pragma unroll
        for (int u = 0; u < UB; ++u) { const int e = e0 + u * gthreads; ok[u] = e < NIT; const int ee = ok[u] ? e : e0; const int row = ee >> 8, c = (ee & 255) * 4;
            x[u] = ld_bf4(Xb + (size_t)row * 1024 + c); sq[u] = ssq_sum(ssq + (size_t)row * 16); fw[u] = *(const f32x4*)(PIN(I_FNORMW) + c); }
#pragma unroll
        for (int u = 0; u < UB; ++u) { const int e = e0 + u * gthreads; const int ee = ok[u] ? e : e0; const int row = ee >> 8, c = (ee & 255) * 4;
            const float rstd = rsqrtf(sq[u] * (1.0f / 1024.0f) + 1e-6f);
            if (ok[u]) *(f32x4*)(POUT + (size_t)row * 1024 + c) = x[u] * rstd * fw[u]; }
    }
}

#define XB_TMO      128
#define XB_XCNT(j)  (256  + 64 * (j))
#define XB_XSUB(j)  (1280 + 64 * (j))
#define XB_XGEN(j)  (2304 + 64 * (j))
#define XB_TOP      3328
#define XB_TOPGEN   3392
#define XCD_BAR_WORDS 3456
#define XB_SPIN_CAP (1u << 18)
__device__ __forceinline__ unsigned xb_ld(unsigned* p)              { return __hip_atomic_load(p, __ATOMIC_RELAXED, __HIP_MEMORY_SCOPE_AGENT); }
__device__ __forceinline__ unsigned xb_add(unsigned* p, unsigned v) { return __hip_atomic_fetch_add(p, v, __ATOMIC_RELAXED, __HIP_MEMORY_SCOPE_AGENT); }
__device__ __forceinline__ unsigned xb_xcc_id() { return (unsigned)__builtin_amdgcn_s_getreg((3 << 11) | 20) & 0xFu; }
#define XB_SPIN(cond, bar) do { unsigned _sp = 0; while (cond) { __builtin_amdgcn_s_sleep(1); \
    if ((++_sp & 255u) == 0u) { if (xb_ld(&(bar)[XB_TMO])) break; if (_sp > XB_SPIN_CAP) { atomicAdd(&(bar)[XB_TMO], 1u); break; } } } } while (0)
struct XcdBarrier { unsigned* bar; unsigned x; volatile LAS unsigned* st; };
__device__ __forceinline__ XcdBarrier xcd_barrier_post(unsigned* bar, volatile LAS unsigned* st) {
    XcdBarrier b; b.bar = bar; b.x = xb_xcc_id(); b.st = st;
    if (threadIdx.x == 0) (void)xb_add(&bar[XB_XCNT(b.x)], 1u);
    return b;
}
__device__ __forceinline__ void xcd_barrier_complete(unsigned* bar, unsigned x, unsigned& nloc, unsigned& nx) {
    const unsigned G = gridDim.x * gridDim.y * gridDim.z;
    unsigned sum, cnt, mine, sp = 0u;
    for (;;) {
        sum = 0u; cnt = 0u; mine = 0u;
#pragma unroll
        for (unsigned j = 0; j < 16; ++j) { const unsigned c = xb_ld(&bar[XB_XCNT(j)]); sum += c; cnt += (c > 0u) ? 1u : 0u; mine = (j == x) ? c : mine; }
        if (sum == G) break;
        __builtin_amdgcn_s_sleep(1);
        if ((++sp & 255u) == 0u) { if (xb_ld(&bar[XB_TMO])) break; if (sp > XB_SPIN_CAP) { atomicAdd(&bar[XB_TMO], 1u); break; } }
    }
    nloc = mine > 0u ? mine : 1u; nx = cnt > 0u ? cnt : 1u;
}
__device__ __forceinline__ void xcd_barrier(const XcdBarrier& b) {
    asm volatile("s_waitcnt vmcnt(0)" ::: "memory");
    __syncthreads();
    if (threadIdx.x == 0) {
        unsigned* bar = b.bar;
        __builtin_amdgcn_s_waitcnt(0);
        unsigned nloc = b.st[0], nx = b.st[1];
        if (nloc == 0u) { xcd_barrier_complete(bar, b.x, nloc, nx); b.st[0] = nloc; b.st[1] = nx; }
        const unsigned old = xb_add(&bar[XB_XSUB(b.x)], 1u);
        const unsigned gen = old / nloc;
        if (old + 1u == (gen + 1u) * nloc) {
            __builtin_amdgcn_fence(__ATOMIC_RELEASE, "agent");
            asm volatile("s_waitcnt vmcnt(0)" ::: "memory");
            const unsigned og = xb_add(&bar[XB_TOP], 1u);
            const unsigned tg = og / nx;
            if (og + 1u == (tg + 1u) * nx) xb_add(&bar[XB_TOPGEN], 1u);
            else XB_SPIN(xb_ld(&bar[XB_TOPGEN]) == tg, bar);
            __builtin_amdgcn_fence(__ATOMIC_ACQUIRE, "agent");
            xb_add(&bar[XB_XGEN(b.x)], 1u);
            asm volatile("s_waitcnt vmcnt(0)" ::: "memory");
        } else {
            XB_SPIN(xb_ld(&bar[XB_XGEN(b.x)]) == gen, bar);
            __builtin_amdgcn_fence(__ATOMIC_ACQUIRE, "agent");
            asm volatile("s_waitcnt vmcnt(0)" ::: "memory");
        }
    }
    __syncthreads();
}

__device__ void run_gemm_proj(const Params& p, const Ctx cx, LAS unsigned char* lds, const bf16_t* Bt, int N, bf16_t* O, int ldc, int layer) {
    pg8::Gemm g{(const bf16_t*)(PWS + WS_XB), Bt, NTOK, N, 1024};
    pg8::StaticOrder S; S.init(NTOK, N, (int)cx.nblk, (int)cx.bid);
    const float* ssq = (const float*)(PWS + WS_SSQ) + (size_t)layer * NTOK * 16;
    LAS float* rl = (LAS float*)(lds + 131072);
    int pm0 = -1, pm1 = -1, pm2 = -1, pm3 = -1, np = 0;
    for (int i = 0; i < 64; ++i) {
        pg8::Unit u; if (!S.next(i, u)) break;
        if (u.pm == pm0 || u.pm == pm1 || u.pm == pm2 || u.pm == pm3) continue;
        if (np == 0) pm0 = u.pm; else if (np == 1) pm1 = u.pm; else if (np == 2) pm2 = u.pm; else pm3 = u.pm;
        ++np;
    }
    for (int r = cx.tid; r < np * 256; r += 512) {
        const int i = r >> 8, pm = i == 0 ? pm0 : (i == 1 ? pm1 : (i == 2 ? pm2 : pm3));
        rl[r] = rsqrtf(ssq_sum(ssq + (size_t)(pm * 256 + (r & 255)) * 16) * (1.0f / 1024.0f) + 1e-6f);
    }
    __syncthreads();
    EpiProj E{O, ldc, rl, pm0, pm1, pm2, pm3};
    pg8::gemm_phase<EpiProj>(cx, lds, g, S, E);
}
__device__ void run_gemm_res(const Params& p, const Ctx cx, LAS unsigned char* lds, const bf16_t* Bt, int layer) {
    const bf16_t* A = (const bf16_t*)(PWS + WS_YCAT);
    bf16_t* Xb = (bf16_t*)(PWS + WS_XB);
    float* ssqn = (float*)(PWS + WS_SSQ) + (size_t)(layer + 1) * NTOK * 16;
    pg8::Gemm g{A, Bt, NTOK, 1024, 1024};
    pg8::StaticOrder S; S.init(NTOK, 1024, (int)cx.nblk, (int)cx.bid);
    EpiRes E{layer == 0 ? PIN(I_XP) : nullptr, PIN(I_XS), Xb, ssqn};
    pg8::gemm_phase<EpiRes>(cx, lds, g, S, E);
}

constexpr int N_PHASES = 20;
#ifndef PHMASK
#define PHMASK 0xffff
#endif
#define PHON(n) ((PHMASK >> ((n) % 16)) & 1)
__global__ void __launch_bounds__(512, 2) fwd_kernel(Params p) {
    extern __shared__ __attribute__((aligned(16))) unsigned char lds_raw[];
    LAS unsigned char* lds = (LAS unsigned char*)lds_raw;
    volatile LAS unsigned* bar_st = (volatile LAS unsigned*)(lds + LDS_MAIN);
    if (threadIdx.x < 4) bar_st[threadIdx.x] = 0u;
    __syncthreads();
    const XcdBarrier gbar = xcd_barrier_post((unsigned*)((unsigned char*)p.ptr[30] + WS_BAR), bar_st);
    if (p.ph_hi < 0) cg::this_grid().sync();
#define GRID_SYNC() xcd_barrier(gbar)
#ifdef SYNCPROBE
    for (int i = 0; i < SYNCPROBE; ++i) GRID_SYNC();
#endif
#ifdef REPMASK
    for (int pc = p.ph_lo * 2; pc < p.ph_hi * 2; ++pc) {
        const int ph = pc >> 1;
        { const int s_ = (ph == 0) ? 9 : (ph == N_PHASES - 1) ? 31 : (ph - 1) % 9; if ((pc & 1) && !((REPMASK >> s_) & 1)) continue; }
        if (pc > p.ph_lo * 2) GRID_SYNC();
#else
    for (int ph = p.ph_lo; ph < p.ph_hi; ++ph) {
        if (ph > p.ph_lo) GRID_SYNC();
#endif
        Ctx cx; cx.tid = threadIdx.x; cx.bid = blockIdx.x; cx.nblk = gridDim.x;
        asm volatile("s_mov_b32 %0, 0" : "=s"(cx.z));
        asm volatile("" : "+v"(cx.tid)); asm volatile("" : "+s"(cx.bid)); asm volatile("" : "+s"(cx.nblk));
        const int pair = (ph - 1) / 9, s = (ph == 0) ? 100 : (ph == N_PHASES - 1 ? 101 : (ph - 1) % 9);
        if (s == 0 || s == 3 || s == 6) {
#if PHON(0)
            const bf16_t* WinE = (const bf16_t*)(PWS + WS_WINE) + (size_t)pair * 4352 * 1024;
            const bf16_t* Bt = s == 0 ? WinE + (size_t)2560 * 1024 : (s == 3 ? WinE : (const bf16_t*)(PWS + WS_WINO) + (size_t)pair * 2560 * 1024);
            const int N = s == 0 ? 1792 : 2560;
            run_gemm_proj(p, cx, lds, Bt, N, (bf16_t*)(PWS + WS_R1), N, 2 * pair + (s == 6 ? 1 : 0));
#endif
        } else if (s == 5 || s == 8) {
#if PHON(5)
            const bf16_t* Bt = (const bf16_t*)(PWS + (s == 5 ? WS_WOUTE : WS_WOUTO)) + (size_t)pair * 1024 * 1024;
            run_gemm_res(p, cx, lds, Bt, 2 * pair + (s == 8 ? 1 : 0));
#endif
        } else if (s == 1) {
#if PHON(1)
            phase_even_prep(p, cx, pair, lds);
#endif
        } else if (s == 2) {
#if PHON(2)
            phase_scan(p, cx, pair, lds);
#endif
        } else if (s == 4) {
#if PHON(4)
            phase_even_post(p, cx, pair);
#endif
        } else if (s == 7) {
#if PHON(7)
            phase_odd_mixer(p, cx, pair, lds);
#endif
        } else if (s == 100) {
#if PHON(10)
            phase_prepass(p, cx, lds);
#endif
        } else {
#if PHON(11)
            phase_final(p, cx);
#endif
        }
    }
}

extern "C" void kernel_launch(void* const* d_in, const int* in_sizes, int n_in, void* d_out, int out_size, void* d_ws, size_t ws_size, hipStream_t stream) {
    static int grid = 0;
    if (grid == 0) {
        if (n_in != 29 || ws_size < WS_END) { fprintf(stderr, "kernel_launch: unexpected n_in %d / ws_size %zu (need %zu)\n", n_in, ws_size, (size_t)WS_END); grid = -1; return; }
        int dev = 0, cus = 0, per_cu = 0;
        hipGetDevice(&dev);
        hipDeviceGetAttribute(&cus, hipDeviceAttributeMultiprocessorCount, dev);
        if (hipFuncSetAttribute((const void*)fwd_kernel, hipFuncAttributeMaxDynamicSharedMemorySize, LDS_BYTES) != hipSuccess) { fprintf(stderr, "kernel_launch: hipFuncSetAttribute failed\n"); grid = -1; return; }
        if (hipOccupancyMaxActiveBlocksPerMultiprocessor(&per_cu, (const void*)fwd_kernel, 512, LDS_BYTES) != hipSuccess || per_cu < 1) { fprintf(stderr, "kernel_launch: occupancy query gave %d\n", per_cu); per_cu = 1; }
        (void)hipGetLastError();
        grid = cus * per_cu;
        if (grid > 256) grid = 256;
    }
    if (grid < 0) return;
    Params p{};
    for (int i = 0; i < 29; ++i) p.ptr[i] = d_in[i];
    p.ptr[29] = d_out; p.ptr[30] = d_ws; p.ptr[31] = nullptr;
    (void)hipMemsetAsync((unsigned char*)d_ws + WS_BAR, 0, 16384, stream);
#if ONE_LAUNCH
    p.ph_lo = 0; p.ph_hi = N_PHASES;
    void* args[] = {&p};
    hipError_t e = hipLaunchCooperativeKernel((const void*)fwd_kernel, dim3(grid), dim3(512), args, LDS_BYTES, stream);
    if (e != hipSuccess) fprintf(stderr, "cooperative launch failed: %s (grid %d)\n", hipGetErrorString(e), grid);
#else
    for (int ph = 0; ph < N_PHASES; ++ph) {
        p.ph_lo = ph; p.ph_hi = ph + 1;
        hipLaunchKernelGGL(fwd_kernel, dim3(grid), dim3(512), LDS_BYTES, stream, p);
    }
#endif
}
```

```cpp
#include <hip/hip_runtime.h>
#include <hip/hip_cooperative_groups.h>
#include <cstdio>
namespace cg = cooperative_groups;

#ifndef ONE_LAUNCH
#define ONE_LAUNCH 1
#endif

#define LAS __attribute__((address_space(3)))
typedef unsigned short bf16_t;
typedef short bf16x8 __attribute__((ext_vector_type(8)));
typedef float f32x4 __attribute__((ext_vector_type(4)));
typedef unsigned u32x4 __attribute__((ext_vector_type(4)));
typedef unsigned u32x2 __attribute__((ext_vector_type(2)));

constexpr int NTOK = 17408, NTP = 16384;
constexpr int LDB = 1792;
constexpr int LDA = 2560;
constexpr size_t O_CONVP = 17825792, O_CONVS = 17842176, O_SHIFTP = 18104320, O_SHIFTS = 18130944, O_WKVP = 18556928, O_WKVS = 19081216,
                 O_POOLP = 27469824, O_POOLS = 27592704, O_CHUNKV = 29558784;
constexpr size_t WS_WINE = 0;
constexpr size_t WS_WOUTE = WS_WINE + 2ull * 4352 * 1024 * 2;
constexpr size_t WS_WINO = WS_WOUTE + 2ull * 1024 * 1024 * 2;
constexpr size_t WS_WOUTO = WS_WINO + 2ull * 2560 * 1024 * 2;
constexpr size_t WS_W2T = WS_WOUTO + 2ull * 1024 * 1024 * 2;
constexpr size_t WS_A2T = WS_W2T + 2ull * 512 * 64 * 2;
constexpr size_t WS_POOLWT = WS_A2T + 2ull * 512 * 64 * 2;
constexpr size_t WS_SPW = WS_POOLWT + 8ull * 128 * 128 * 2;
constexpr size_t WS_XB = WS_SPW + 8ull * 128 * 128 * 2;
constexpr size_t WS_YCAT = WS_XB + (size_t)NTOK * 1024 * 2;
constexpr size_t WS_SSQ = WS_YCAT + (size_t)NTOK * 1024 * 2;
constexpr size_t WS_Y = WS_SSQ + 5ull * NTOK * 16 * 4;
constexpr size_t WS_R1 = WS_Y + (size_t)NTOK * 512 * 4;
constexpr size_t WS_PROJB = WS_R1;
constexpr size_t WS_WDEC = WS_PROJB + (size_t)NTOK * LDB * 2;
constexpr size_t WS_AA = WS_WDEC + (size_t)NTOK * 512 * 4;
constexpr size_t WS_BAR = WS_AA + (size_t)NTOK * 512 * 2;
constexpr size_t WS_END = WS_BAR + 16384;
constexpr int LDS_MAIN = 147456;
constexpr int LDS_BYTES = LDS_MAIN + 16;

struct Params {
    const void* ptr[32];
    int ph_lo, ph_hi;
};
struct Ctx { int tid, bid, nblk, z; };
#define PIN(i) ((const float*)p.ptr[(i) + cx.z])
#define POUT ((float*)p.ptr[29 + cx.z])
#define PWS ((unsigned char*)p.ptr[30 + cx.z])
enum { I_XP = 0, I_XS, I_SCONV, I_SSHIFT, I_SWKV, I_SPOOL, I_NORMW, I_FNORMW, I_WINE, I_CONVW, I_MU, I_W0, I_W2, I_A0, I_A2, I_KK, I_KA, I_RK, I_GNG, I_GNB,
       I_WOUTE, I_WINO, I_POOLW, I_PSCALE, I_LNG, I_LNB, I_SPW, I_SPB, I_WOUTO };

__device__ __forceinline__ unsigned cvt_pk_bf16(float lo, float hi) { unsigned r; asm("v_cvt_pk_bf16_f32 %0, %1, %2" : "=v"(r) : "v"(lo), "v"(hi)); return r; }
__device__ __forceinline__ float bf_lo(unsigned u) { return __uint_as_float(u << 16); }
__device__ __forceinline__ float bf_hi(unsigned u) { return __uint_as_float(u & 0xffff0000u); }
__device__ __forceinline__ float bf2f(bf16_t b) { return __uint_as_float(((unsigned)b) << 16); }
__device__ __forceinline__ f32x4 cvt4(u32x2 u) { return (f32x4){bf_lo(u.x), bf_hi(u.x), bf_lo(u.y), bf_hi(u.y)}; }
__device__ __forceinline__ f32x4 ld_bf4(const bf16_t* p) { return cvt4(*(const u32x2*)p); }
__device__ __forceinline__ void st_bf4(bf16_t* p, f32x4 v) { u32x2 u; u.x = cvt_pk_bf16(v[0], v[1]); u.y = cvt_pk_bf16(v[2], v[3]); *(u32x2*)p = u; }
__device__ __forceinline__ float sigmoidf_(float x) { return __builtin_amdgcn_rcpf(1.0f + __expf(-x)); }
__device__ __forceinline__ float siluf_(float x) { return x * __builtin_amdgcn_rcpf(1.0f + __expf(-x)); }
template <int CTRL> __device__ __forceinline__ float dpp_f(float x) { return __builtin_bit_cast(float, __builtin_amdgcn_mov_dpp(__builtin_bit_cast(int, x), CTRL, 0xf, 0xf, true)); }
__device__ __forceinline__ float allsum16(float x) { x += dpp_f<0xB1>(x); x += dpp_f<0x4E>(x); x += dpp_f<0x141>(x); x += dpp_f<0x128>(x); return x; }
__device__ __forceinline__ float allsum4(float x) { x += dpp_f<0xB1>(x); x += dpp_f<0x4E>(x); return x; }
__device__ __forceinline__ float dot4(f32x4 a, f32x4 b) { return a[0] * b[0] + a[1] * b[1] + a[2] * b[2] + a[3] * b[3]; }

__device__ __forceinline__ float ssq_sum(const float* part) {
    const f32x4 a = *(const f32x4*)(part), b = *(const f32x4*)(part + 4), c = *(const f32x4*)(part + 8), d = *(const f32x4*)(part + 12);
    return ((a[0] + a[1]) + (a[2] + a[3])) + ((b[0] + b[1]) + (b[2] + b[3])) + ((c[0] + c[1]) + (c[2] + c[3])) + ((d[0] + d[1]) + (d[2] + d[3]));
}

namespace pg8 {
constexpr int BM = 256, BK = 64, HALF = 128, HTB = HALF * BK * 2, NXCD = 8, WGM = 8;
__device__ __forceinline__ int lds_byte(int r, int c) { const int st = (r >> 4) * 2 + (c >> 5), rr = r & 15, cc = c & 31, ob = rr * 64 + cc * 2; return st * 1024 + (ob ^ (((ob >> 9) & 1) << 5)); }
__device__ __forceinline__ void stage_rc(int b, int& R, int& C) { const int st = b / 1024, sb = b % 1024, swz = sb ^ (((sb >> 9) & 1) << 5); R = (st >> 1) * 16 + swz / 64; C = (st & 1) * 32 + (swz % 64) / 2; }
__device__ __forceinline__ int perm32(int rho) { const int n = rho >> 4, i = rho & 15; return 8 * (i >> 2) + 4 * n + (i & 3); }
struct Unit { int pm, pn; };
struct Gemm { const bf16_t* A; const bf16_t* Bt; int M, N, K; };
struct StaticOrder {
    int nM, nN, nwg, G, c;
    __device__ void init(int M, int N, int G_, int c_) { nM = M / BM; nN = N / BM; nwg = nM * nN; G = G_; c = c_; }
    __device__ bool next(int i, Unit& u) const {
        const long L = (long)i * G + c; if (L >= nwg) return false;
        int wgid = (int)L; { const int q = nwg / NXCD, r = nwg % NXCD, xcd = wgid % NXCD, off = wgid / NXCD; wgid = (xcd < r ? xcd * (q + 1) : r * (q + 1) + (xcd - r) * q) + off; }
        const int nig = WGM * nN, gid = wgid / nig, fm = gid * WGM, gsz = (nM - fm) < WGM ? (nM - fm) : WGM;
        u.pm = fm + ((wgid % nig) % gsz); u.pn = (wgid % nig) / gsz; return true;
    }
};

template <class Epi>
__device__ __forceinline__ void gemm_phase(const Ctx cx, LAS unsigned char* lds, const Gemm g, const StaticOrder& S, const Epi& E) {
    const int tid = cx.tid, wid = __builtin_amdgcn_readfirstlane(tid >> 6), lane = tid & 63, wr = wid >> 2, wc = wid & 3, fr = lane & 15, fq = lane >> 4;
    const int K = g.K, nt = K / BK;
    unsigned voffA[2], voffB[2];
#pragma unroll
    for (int i = 0; i < 2; ++i) { int R, C; stage_rc(tid * 16 + i * 8192, R, C); const int Rb = Epi::PERM ? ((R & ~31) + perm32(R & 31)) : R;
        voffA[i] = (unsigned)(R * K + C) * 2u; voffB[i] = (unsigned)(Rb * K + C) * 2u; }
    const size_t kstep = (size_t)(BK * 2);
    const size_t hstep = (size_t)HALF * K * 2;
    const size_t tstep = 2 * hstep;
    const unsigned ldsw = (unsigned)wid * 1024u;
    const int aoff = lds_byte(wr * 64 + fr, fq * 8), boff = lds_byte(wc * 32 + fr, fq * 8);
#define PG8_SA(b, h) (((b) * 2 + (h)) * HTB)
#define PG8_SB(b, h) ((4 + (b) * 2 + (h)) * HTB)
#define PG8_STAGE(bufoff, gbase, voff) do { _Pragma("unroll") for (int _i = 0; _i < 2; ++_i) \
        __builtin_amdgcn_global_load_lds((const unsigned*)((const char*)(gbase) + (voff)[_i]), (LAS unsigned*)(lds + (bufoff) + ldsw + _i * 8192), 16, 0, 0); } while (0)
#define PG8_LDA(dst, b, h) do { _Pragma("unroll") for (int m = 0; m < 4; ++m) _Pragma("unroll") for (int k = 0; k < 2; ++k) dst[m][k] = *(const LAS bf16x8*)(lds + PG8_SA(b, h) + aoff + m * 2048 + k * 1024); } while (0)
#define PG8_LDB(dst, b, h) do { _Pragma("unroll") for (int n = 0; n < 2; ++n) _Pragma("unroll") for (int k = 0; k < 2; ++k) dst[n][k] = *(const LAS bf16x8*)(lds + PG8_SB(b, h) + boff + n * 2048 + k * 1024); } while (0)
#define PG8_MMA(ai, bj, At, Bt) do { __builtin_amdgcn_s_setprio(1); _Pragma("unroll") for (int m = 0; m < 4; ++m) _Pragma("unroll") for (int n = 0; n < 2; ++n) _Pragma("unroll") for (int k = 0; k < 2; ++k) \
        acc[ai][bj][m][n] = __builtin_amdgcn_mfma_f32_16x16x32_bf16(Bt[n][k], At[m][k], acc[ai][bj][m][n], 0, 0, 0); __builtin_amdgcn_s_setprio(0); } while (0)
#define PG8_WAIT_V(n) asm volatile("s_waitcnt vmcnt(" #n ")" ::: "memory")
#define PG8_WAIT_L(n) asm volatile("s_waitcnt lgkmcnt(" #n ")" ::: "memory")
#define PG8_BAR __builtin_amdgcn_s_barrier()
#define PG8_SCHED __builtin_amdgcn_sched_barrier(0)
    Unit cur, nxt; int ui = 0;
    if (!S.next(0, cur)) return;
    f32x4 acc[2][2][4][2];
#pragma unroll
    for (int a = 0; a < 2; ++a)
#pragma unroll
        for (int b = 0; b < 2; ++b)
#pragma unroll
            for (int m = 0; m < 4; ++m)
#pragma unroll
                for (int n = 0; n < 2; ++n) acc[a][b][m][n] = (f32x4){0.f, 0.f, 0.f, 0.f};
    bf16x8 At[4][2], B0[2][2], B1[2][2];
    const char* cA = (const char*)g.A + (size_t)cur.pm * tstep; const char* cB = (const char*)g.Bt + (size_t)cur.pn * tstep;
    PG8_STAGE(PG8_SB(0, 0), cB, voffB); PG8_STAGE(PG8_SA(0, 0), cA, voffA); PG8_STAGE(PG8_SB(0, 1), cB + hstep, voffB); PG8_STAGE(PG8_SA(0, 1), cA + hstep, voffA);
    if (wr == 1) PG8_BAR;
    PG8_WAIT_V(4); PG8_BAR;
    PG8_STAGE(PG8_SB(1, 0), cB + kstep, voffB); PG8_STAGE(PG8_SA(1, 0), cA + kstep, voffA); PG8_STAGE(PG8_SB(1, 1), cB + hstep + kstep, voffB);
    PG8_WAIT_V(6); PG8_BAR;
    for (;;) {
        const bool has_next = S.next(ui + 1, nxt);
        const char* nA = has_next ? (const char*)g.A + (size_t)nxt.pm * tstep : cA; const char* nB = has_next ? (const char*)g.Bt + (size_t)nxt.pn * tstep : cB;
        for (int t = 0; t < nt; t += 2) {
            const bool last = (t == nt - 2);
            const char* a1 = cA + (size_t)(t + 1) * kstep;
            const char* a2 = last ? nA : cA + (size_t)(t + 2) * kstep; const char* b2 = last ? nB : cB + (size_t)(t + 2) * kstep;
            const char* a3 = a2 + kstep; const char* b3 = b2 + kstep;
            PG8_LDB(B0, 0, 0); PG8_SCHED; PG8_LDA(At, 0, 0); PG8_STAGE(PG8_SA(1, 1), a1 + hstep, voffA);
            PG8_WAIT_L(8); PG8_BAR; PG8_WAIT_L(0); PG8_MMA(0, 0, At, B0); PG8_BAR; PG8_SCHED;
            PG8_LDB(B1, 0, 1); PG8_STAGE(PG8_SB(0, 0), b2, voffB);
            PG8_BAR; PG8_WAIT_L(0); PG8_MMA(0, 1, At, B1); PG8_BAR;
            PG8_LDA(At, 0, 1); PG8_STAGE(PG8_SA(0, 0), a2, voffA);
            PG8_BAR; PG8_WAIT_L(0); PG8_MMA(1, 0, At, B0); PG8_BAR; PG8_SCHED;
            PG8_STAGE(PG8_SB(0, 1), b2 + hstep, voffB);
            PG8_WAIT_V(6); PG8_BAR; PG8_MMA(1, 1, At, B1); PG8_BAR;
            PG8_LDB(B0, 1, 0); PG8_SCHED; PG8_LDA(At, 1, 0); PG8_STAGE(PG8_SA(0, 1), a2 + hstep, voffA);
            PG8_WAIT_L(8); PG8_BAR; PG8_WAIT_L(0); PG8_MMA(0, 0, At, B0); PG8_BAR; PG8_SCHED;
            PG8_LDB(B1, 1, 1); PG8_STAGE(PG8_SB(1, 0), b3, voffB);
            PG8_BAR; PG8_WAIT_L(0); PG8_MMA(0, 1, At, B1); PG8_BAR;
            PG8_LDA(At, 1, 1); PG8_STAGE(PG8_SA(1, 0), a3, voffA);
            PG8_BAR; PG8_WAIT_L(0); PG8_MMA(1, 0, At, B0); PG8_BAR; PG8_SCHED;
            PG8_STAGE(PG8_SB(1, 1), b3 + hstep, voffB);
            PG8_WAIT_V(6); PG8_BAR; PG8_MMA(1, 1, At, B1); PG8_BAR;
        }
        E(acc, cur, wr, wc, fr, fq);
        if (!has_next) break;
#pragma unroll
        for (int a = 0; a < 2; ++a)
#pragma unroll
            for (int b = 0; b < 2; ++b)
#pragma unroll
                for (int m = 0; m < 4; ++m)
#pragma unroll
                    for (int n = 0; n < 2; ++n) acc[a][b][m][n] = (f32x4){0.f, 0.f, 0.f, 0.f};
        cur = nxt; cA = nA; cB = nB; ++ui;
    }
    PG8_WAIT_V(0);
    if (wr == 0) PG8_BAR;
    PG8_BAR;
#undef PG8_SA
#undef PG8_SB
#undef PG8_STAGE
#undef PG8_LDA
#undef PG8_LDB
#undef PG8_MMA
#undef PG8_WAIT_V
#undef PG8_WAIT_L
#undef PG8_BAR
#undef PG8_SCHED
}
}

struct EpiProj {
    static constexpr bool PERM = true;
    bf16_t* O; int ldc; LAS const float* rl; int pm0, pm1, pm2, pm3;
    __device__ __forceinline__ void operator()(const f32x4 (&acc)[2][2][4][2], const pg8::Unit& u, int wr, int wc, int fr, int fq) const {
        const int row0 = u.pm * 256 + wr * 64 + fr, col0 = u.pn * 256 + wc * 32 + 8 * fq;
        const int sel = u.pm == pm0 ? 0 : (u.pm == pm1 ? 1 : (u.pm == pm2 ? 2 : 3));
        LAS const float* rp = rl + sel * 256 + wr * 64 + fr;
#pragma unroll
        for (int ai = 0; ai < 2; ++ai)
#pragma unroll
            for (int m = 0; m < 4; ++m) {
                const int row = row0 + ai * 128 + m * 16;
                const float rstd = rp[ai * 128 + m * 16];
                bf16_t* rowp = O + (size_t)row * ldc + col0;
#pragma unroll
                for (int bj = 0; bj < 2; ++bj) {
                    const f32x4 v0 = acc[ai][bj][m][0] * rstd, v1 = acc[ai][bj][m][1] * rstd;
                    u32x4 w; w.x = cvt_pk_bf16(v0[0], v0[1]); w.y = cvt_pk_bf16(v0[2], v0[3]); w.z = cvt_pk_bf16(v1[0], v1[1]); w.w = cvt_pk_bf16(v1[2], v1[3]);
                    *(u32x4*)(rowp + bj * 128) = w;
                }
            }
    }
};
struct X8 { f32x4 lo, hi; };
template <bool FIRST> __device__ __forceinline__ X8 ld_x8(const float* __restrict__ s32, const bf16_t* __restrict__ s16, size_t o) {
    X8 r;
    if (FIRST) { r.lo = *(const f32x4*)(s32 + o); r.hi = *(const f32x4*)(s32 + o + 4); }
    else { const u32x4 u = *(const u32x4*)(s16 + o); r.lo = cvt4((u32x2){u.x, u.y}); r.hi = cvt4((u32x2){u.z, u.w}); }
    return r;
}
__device__ __forceinline__ void st_x8(bf16_t* p, f32x4 lo, f32x4 hi) { u32x4 w; w.x = cvt_pk_bf16(lo[0], lo[1]); w.y = cvt_pk_bf16(lo[2], lo[3]); w.z = cvt_pk_bf16(hi[0], hi[1]); w.w = cvt_pk_bf16(hi[2], hi[3]); *(u32x4*)p = w; }
template <bool FIRST>
__device__ __forceinline__ void epi_res_rows(const f32x4 (&acc)[2][2][4][2], const float* __restrict__ src32, const bf16_t* __restrict__ src16, bf16_t* __restrict__ Xb, float* __restrict__ ssqp,
                                             int row0, int col0, int slot, int fq) {
    if constexpr (FIRST) {
#pragma unroll
        for (int ai = 0; ai < 2; ++ai) {
            X8 x[4][2];
#pragma unroll
            for (int m = 0; m < 4; ++m)
#pragma unroll
                for (int bj = 0; bj < 2; ++bj) x[m][bj] = ld_x8<true>(src32, src16, (size_t)(row0 + ai * 128 + m * 16) * 1024 + col0 + bj * 128);
#pragma unroll
            for (int m = 0; m < 4; ++m) {
                const int row = row0 + ai * 128 + m * 16;
                float part = 0.f;
#pragma unroll
                for (int bj = 0; bj < 2; ++bj) {
                    const f32x4 lo = x[m][bj].lo + acc[ai][bj][m][0], hi = x[m][bj].hi + acc[ai][bj][m][1];
                    st_x8(Xb + (size_t)row * 1024 + col0 + bj * 128, lo, hi);
                    part += dot4(lo, lo) + dot4(hi, hi);
                }
                part += __shfl_xor(part, 16); part += __shfl_xor(part, 32);
                if (fq == 0) ssqp[(size_t)row * 16 + slot] = part;
            }
        }
    } else {
        u32x4 xr[2][4][2];
#pragma unroll
        for (int ai = 0; ai < 2; ++ai)
#pragma unroll
            for (int m = 0; m < 4; ++m)
#pragma unroll
                for (int bj = 0; bj < 2; ++bj) xr[ai][m][bj] = *(const u32x4*)(src16 + (size_t)(row0 + ai * 128 + m * 16) * 1024 + col0 + bj * 128);
#pragma unroll
        for (int ai = 0; ai < 2; ++ai)
#pragma unroll
            for (int m = 0; m < 4; ++m) {
                const int row = row0 + ai * 128 + m * 16;
                float part = 0.f;
#pragma unroll
                for (int bj = 0; bj < 2; ++bj) {
                    const u32x4 u = xr[ai][m][bj];
                    const f32x4 lo = cvt4((u32x2){u.x, u.y}) + acc[ai][bj][m][0], hi = cvt4((u32x2){u.z, u.w}) + acc[ai][bj][m][1];
                    st_x8(Xb + (size_t)row * 1024 + col0 + bj * 128, lo, hi);
                    part += dot4(lo, lo) + dot4(hi, hi);
                }
                part += __shfl_xor(part, 16); part += __shfl_xor(part, 32);
                if (fq == 0) ssqp[(size_t)row * 16 + slot] = part;
            }
    }
}
struct EpiRes {
    static constexpr bool PERM = true;
    const float* xp; const float* xs; bf16_t* Xb; float* ssq_next;
    __device__ __forceinline__ void operator()(const f32x4 (&acc)[2][2][4][2], const pg8::Unit& u, int wr, int wc, int fr, int fq) const {
        const int row0 = u.pm * 256 + wr * 64 + fr, col0 = u.pn * 256 + wc * 32 + 8 * fq;
        if (xp) epi_res_rows<true>(acc, row0 < NTP ? xp : xs - (size_t)NTP * 1024, nullptr, Xb, ssq_next, row0, col0, u.pn * 4 + wc, fq);
        else epi_res_rows<false>(acc, nullptr, Xb, Xb, ssq_next, row0, col0, u.pn * 4 + wc, fq);
    }
};

template <bool FIRST>
__device__ __forceinline__ void res_sample_tile(const Ctx cx, const bf16_t* __restrict__ A, const bf16_t* __restrict__ Bt, const float* __restrict__ xs, bf16_t* __restrict__ Xb, float* __restrict__ ssqp, int tile) {
    const int tid = cx.tid, wid = tid >> 6, lane = tid & 63, fr = lane & 15, fq = lane >> 4;
    const int tm = tile >> 3, tn = tile & 7;
    const int r0 = NTP + tm * 64 + (wid & 3) * 16, c0 = tn * 128 + (wid >> 2) * 64;
    const bf16_t* ap = A + (size_t)(r0 + fr) * 1024 + fq * 8;
    const bf16_t* bp = Bt + (size_t)(c0 + fr) * 1024 + fq * 8;
    f32x4 acc[4];
#pragma unroll
    for (int nt = 0; nt < 4; ++nt) acc[nt] = (f32x4){0.f, 0.f, 0.f, 0.f};
#pragma unroll 8
    for (int ks = 0; ks < 32; ++ks) {
        const bf16x8 af = *(const bf16x8*)(ap + ks * 32);
#pragma unroll
        for (int nt = 0; nt < 4; ++nt) {
            const bf16x8 bf = *(const bf16x8*)(bp + (size_t)nt * 16 * 1024 + ks * 32);
            acc[nt] = __builtin_amdgcn_mfma_f32_16x16x32_bf16(bf, af, acc[nt], 0, 0, 0);
        }
    }
    const int row = r0 + fr;
    float part = 0.f;
#pragma unroll
    for (int nt = 0; nt < 4; ++nt) {
        const int col = c0 + nt * 16 + fq * 4;
        const f32x4 xo = FIRST ? *(const f32x4*)(xs + (size_t)(row - NTP) * 1024 + col) : ld_bf4(Xb + (size_t)row * 1024 + col);
        const f32x4 v = xo + acc[nt];
        st_bf4(Xb + (size_t)row * 1024 + col, v);
        part += dot4(v, v);
    }
    part += __shfl_xor(part, 16); part += __shfl_xor(part, 32);
    if (fq == 0) ssqp[(size_t)row * 16 + (c0 >> 6)] = part;
}

struct TrJob { const float* src; int ld, col0, k0; bf16_t* dst; int Ktot, drow0; const float* scale; bool zero; };
__device__ __forceinline__ TrJob tr_decode(const Params& p, const Ctx cx, int job) {
    TrJob J; J.zero = false; J.scale = nullptr;
    int j = job;
    if (j < 2176) {
        const int i = j / 1088, r = j % 1088, nt = r / 16, kt = r % 16, n0 = nt * 64;
        int col0 = 0;
        if (n0 < 2048) col0 = n0; else if (n0 < 2560) col0 = 3712 + (n0 - 2048); else if (n0 < 4224) col0 = 2048 + (n0 - 2560); else J.zero = true;
        J.src = PIN(I_WINE) + (size_t)i * 1024 * 4224; J.ld = 4224; J.col0 = col0; J.k0 = kt * 64; J.dst = (bf16_t*)(PWS + WS_WINE) + (size_t)i * 4352 * 1024; J.Ktot = 1024; J.drow0 = n0; J.scale = PIN(I_NORMW) + (2 * i) * 1024;
        return J;
    }
    j -= 2176;
    if (j < 512) { const int i = j / 256, r = j % 256, nt = r / 16, kt = r % 16;
        J.src = PIN(I_WOUTE) + (size_t)i * 1024 * 1024; J.ld = 1024; J.col0 = nt * 64; J.k0 = kt * 64; J.dst = (bf16_t*)(PWS + WS_WOUTE) + (size_t)i * 1024 * 1024; J.Ktot = 1024; J.drow0 = nt * 64; return J; }
    j -= 512;
    if (j < 1280) { const int i = j / 640, r = j % 640, nt = r / 16, kt = r % 16;
        J.src = PIN(I_WINO) + (size_t)i * 1024 * 2560; J.ld = 2560; J.col0 = nt * 64; J.k0 = kt * 64; J.dst = (bf16_t*)(PWS + WS_WINO) + (size_t)i * 2560 * 1024; J.Ktot = 1024; J.drow0 = nt * 64; J.scale = PIN(I_NORMW) + (2 * i + 1) * 1024; return J; }
    j -= 1280;
    if (j < 512) { const int i = j / 256, r = j % 256, nt = r / 16, kt = r % 16;
        J.src = PIN(I_WOUTO) + (size_t)i * 1024 * 1024; J.ld = 1024; J.col0 = nt * 64; J.k0 = kt * 64; J.dst = (bf16_t*)(PWS + WS_WOUTO) + (size_t)i * 1024 * 1024; J.Ktot = 1024; J.drow0 = nt * 64; return J; }
    j -= 512;
    if (j < 16) { const int i = j / 8, nt = j % 8;
        J.src = PIN(I_W2) + (size_t)i * 64 * 512; J.ld = 512; J.col0 = nt * 64; J.k0 = 0; J.dst = (bf16_t*)(PWS + WS_W2T) + (size_t)i * 512 * 64; J.Ktot = 64; J.drow0 = nt * 64; return J; }
    j -= 16;
    if (j < 16) { const int i = j / 8, nt = j % 8;
        J.src = PIN(I_A2) + (size_t)i * 64 * 512; J.ld = 512; J.col0 = nt * 64; J.k0 = 0; J.dst = (bf16_t*)(PWS + WS_A2T) + (size_t)i * 512 * 64; J.Ktot = 64; J.drow0 = nt * 64; return J; }
    j -= 16;
    { const int ig = j / 4, r = j % 4, nt = r / 2, kt = r % 2;
        J.src = PIN(I_POOLW) + (size_t)ig * 128 * 128; J.ld = 128; J.col0 = nt * 64; J.k0 = kt * 64; J.dst = (bf16_t*)(PWS + WS_POOLWT) + (size_t)ig * 128 * 128; J.Ktot = 128; J.drow0 = nt * 64; }
    return J;
}
__device__ __forceinline__ void tr_load(const TrJob& J, int tid, f32x4& va, f32x4& vb) {
    const int nn = (tid & 15) * 4, ka = tid >> 4, kb = ka + 32;
    va = (f32x4){0.f, 0.f, 0.f, 0.f}; vb = va;
    if (!J.zero) {
        va = *(const f32x4*)(J.src + (size_t)(J.k0 + ka) * J.ld + J.col0 + nn); vb = *(const f32x4*)(J.src + (size_t)(J.k0 + kb) * J.ld + J.col0 + nn);
        if (J.scale) { va = va * J.scale[J.k0 + ka]; vb = vb * J.scale[J.k0 + kb]; }
    }
}

__device__ void phase_prepass(const Params& p, const Ctx cx, LAS unsigned char* lds) {
    LAS float* T = (LAS float*)lds;
    const int tid = cx.tid;
    {
        int job = cx.bid;
        f32x4 va = (f32x4){0.f, 0.f, 0.f, 0.f}, vb = va;
        if (job < 4544) { const TrJob J0 = tr_decode(p, cx, job); tr_load(J0, tid, va, vb); }
        for (; job < 4544; job += cx.nblk) {
            f32x4 na = va, nb = vb;
            if (job + (int)cx.nblk < 4544) { const TrJob Jn = tr_decode(p, cx, job + (int)cx.nblk); tr_load(Jn, tid, na, nb); }
            {
                const int nn = (tid & 15) * 4, ka = tid >> 4, kb = ka + 32;
                T[ka * 65 + nn] = va[0]; T[ka * 65 + nn + 1] = va[1]; T[ka * 65 + nn + 2] = va[2]; T[ka * 65 + nn + 3] = va[3];
                T[kb * 65 + nn] = vb[0]; T[kb * 65 + nn + 1] = vb[1]; T[kb * 65 + nn + 2] = vb[2]; T[kb * 65 + nn + 3] = vb[3];
            }
            __syncthreads();
            {
                const TrJob J = tr_decode(p, cx, job);
                const int n = tid >> 3, kc = (tid & 7) * 8;
                u32x4 w;
                w.x = cvt_pk_bf16(T[(kc + 0) * 65 + n], T[(kc + 1) * 65 + n]); w.y = cvt_pk_bf16(T[(kc + 2) * 65 + n], T[(kc + 3) * 65 + n]);
                w.z = cvt_pk_bf16(T[(kc + 4) * 65 + n], T[(kc + 5) * 65 + n]); w.w = cvt_pk_bf16(T[(kc + 6) * 65 + n], T[(kc + 7) * 65 + n]);
                *(u32x4*)(J.dst + (size_t)(J.drow0 + n) * J.Ktot + J.k0 + kc) = w;
            }
            __syncthreads();
            va = na; vb = nb;
        }
    }
    const int gtid = cx.bid * 512 + tid, gthreads = cx.nblk * 512;
    for (int e = gtid; e < 8 * 128 * 128; e += gthreads) {
        const int s = e & 127, t = (e >> 7) & 127;
        ((bf16_t*)(PWS + WS_SPW))[e] = (s <= t) ? (bf16_t)(cvt_pk_bf16(PIN(I_SPW)[e], 0.f) & 0xffffu) : (bf16_t)0;
    }
    const int wid = tid >> 6, lane = tid & 63;
    for (int row0 = cx.bid * 8 + wid; row0 < NTOK; row0 += cx.nblk * 8 * 3) {
        f32x4 v[3][4];
#pragma unroll
        for (int r = 0; r < 3; ++r) {
            const int row = row0 + r * cx.nblk * 8; const int rr = row < NTOK ? row : row0;
            const float* src = rr < NTP ? PIN(I_XP) + (size_t)rr * 1024 : PIN(I_XS) + (size_t)(rr - NTP) * 1024;
#pragma unroll
            for (int i = 0; i < 4; ++i) v[r][i] = *(const f32x4*)(src + i * 256 + lane * 4);
        }
#pragma unroll
        for (int r = 0; r < 3; ++r) {
            const int row = row0 + r * cx.nblk * 8;
            if (row < NTOK) {
                bf16_t* dst = (bf16_t*)(PWS + WS_XB) + (size_t)row * 1024;
                float ss = 0.f;
#pragma unroll
                for (int i = 0; i < 4; ++i) { ss += dot4(v[r][i], v[r][i]); st_bf4(dst + i * 256 + lane * 4, v[r][i]); }
#pragma unroll
                for (int o = 32; o >= 1; o >>= 1) ss += __shfl_xor(ss, o);
                if (lane < 16) ((float*)(PWS + WS_SSQ))[(size_t)row * 16 + lane] = (lane == 0) ? ss : 0.f;
            }
        }
    }
}

__device__ __forceinline__ f32x4 shift4(const bf16_t* cur, bool hp, const float* st, int col, const float* mu) {
    const f32x4 q = ld_bf4(cur + col);
    f32x4 pv;
    if (hp) pv = ld_bf4(cur - LDB + col); else if (st) pv = *(const f32x4*)(st + col); else pv = (f32x4){0.f, 0.f, 0.f, 0.f};
    const f32x4 m = *(const f32x4*)(mu + col);
    return q + m * (pv - q);
}

__device__ void phase_even_prep(const Params& p, const Ctx cx, int pair, LAS unsigned char* lds) {
    const int tid = cx.tid, wid = tid >> 6, lane = tid & 63, fr = lane & 15, fq = lane >> 4;
    const bf16_t* PB = (const bf16_t*)(PWS + WS_PROJB);
    float* Wdec = (float*)(PWS + WS_WDEC);
    bf16_t* Aa = (bf16_t*)(PWS + WS_AA);
    bf16_t* Ycat = (bf16_t*)(PWS + WS_YCAT);
    const float* mu_ = PIN(I_MU) + pair * 1664;
    const float* w0_ = PIN(I_W0) + pair * 512; const float* a0_ = PIN(I_A0) + pair * 512;
    const float* k_a_ = PIN(I_KA) + pair * 512; const float* r_k_ = PIN(I_RK) + pair * 512;
    constexpr int RS = 3344;
    constexpr int TB = 17 * RS;
    constexpr int NCH = 17 * 208;
    const int h = wid;
    bf16x8 wfr[4][2], afr[4][2];
    {
        const bf16_t* W2T = (const bf16_t*)(PWS + WS_W2T) + (size_t)pair * 512 * 64;
        const bf16_t* A2T = (const bf16_t*)(PWS + WS_A2T) + (size_t)pair * 512 * 64;
#pragma unroll
        for (int nt = 0; nt < 4; ++nt)
#pragma unroll
            for (int ks = 0; ks < 2; ++ks) {
                wfr[nt][ks] = *(const bf16x8*)(W2T + (size_t)(h * 64 + nt * 16 + fr) * 64 + ks * 32 + fq * 8);
                afr[nt][ks] = *(const bf16x8*)(A2T + (size_t)(h * 64 + nt * 16 + fr) * 64 + ks * 32 + fq * 8);
            }
    }
    constexpr int TBD = 56 * 1024;
    const int widu = __builtin_amdgcn_readfirstlane(tid >> 6);
#define PREP_DMA(tile_, b_, lane_) do { _Pragma("unroll") for (int i_ = 0; i_ < 7; ++i_) { const int k_ = widu * 7 + i_, q_ = k_ * 64 + (lane_); \
            int lr_ = q_ / 209, cc_ = q_ - lr_ * 209; if (lr_ > 16) { lr_ = 16; cc_ = 0; } if (cc_ > 207) cc_ = 0; \
            int gr_ = (tile_) * 16 - 1 + lr_; gr_ = gr_ < 0 ? 0 : gr_; \
            __builtin_amdgcn_global_load_lds((const unsigned*)(PB + (size_t)gr_ * LDB + cc_ * 8), (LAS unsigned*)(lds + (b_) * TBD + k_ * 1024), 16, 0, 0); } } while (0)
    LAS float* CL = (LAS float*)(lds + 2 * TBD);
    {
        const float f0 = mu_[tid], f1 = mu_[tid + 512], f2 = mu_[tid + 1024], f3 = tid < 128 ? mu_[tid + 1536] : 0.f;
        const float f4 = w0_[tid], f5 = a0_[tid], f6 = k_a_[tid], f7 = r_k_[tid];
        CL[tid] = f0; CL[tid + 512] = f1; CL[tid + 1024] = f2; if (tid < 128) CL[tid + 1536] = f3;
        CL[1664 + tid] = f4; CL[2176 + tid] = f5; CL[2688 + tid] = f6; CL[3200 + tid] = f7;
    }
    int buf = 0;
    if ((int)cx.bid < NTOK / 16) PREP_DMA((int)cx.bid, 0, tid & 63);
    asm volatile("s_waitcnt vmcnt(0)" ::: "memory");
    __syncthreads();
    for (int tile = cx.bid; tile < NTOK / 16; tile += cx.nblk) {
        int zz; asm volatile("v_mov_b32 %0, 0" : "=v"(zz));
        const int tidv = tid + zz, fr = (tidv & 15), fq = (tidv >> 4) & 3;
        if (tile + (int)cx.nblk < NTOK / 16) PREP_DMA(tile + (int)cx.nblk, buf ^ 1, tidv & 63);
        {
            const int row = tile * 16 + fr;
            const bool samp = row >= NTP;
            int b, t; if (!samp) { b = row >> 11; t = row & 2047; } else { const int q = row - NTP; b = q >> 3; t = q & 7; }
            const bool hp = t > 0;
            const float* st = samp ? PIN(I_SSHIFT) + ((size_t)pair * 128 + b) * 1664 : nullptr;
            LAS const float* mu = CL; LAS const float* w0 = CL + 1664; LAS const float* a0 = CL + 2176; LAS const float* k_a = CL + 2688; LAS const float* r_k = CL + 3200;
            LAS const unsigned char* curL = lds + buf * TBD + (fr + 1) * RS;
            LAS const unsigned char* prvL = lds + buf * TBD + fr * RS;
            auto sh4 = [&](int col) -> f32x4 {
                const f32x4 q = cvt4(*(LAS const u32x2*)(curL + col * 2));
                f32x4 pv;
                if (hp) pv = cvt4(*(LAS const u32x2*)(prvL + col * 2)); else if (st) pv = *(const f32x4*)(st + col); else pv = (f32x4){0.f, 0.f, 0.f, 0.f};
                const f32x4 m = *(LAS const f32x4*)(mu + col);
                return q + m * (pv - q);
            };
            bf16x8 Aw[2], Al[2];
#pragma unroll
            for (int ks = 0; ks < 2; ++ks) {
                const int cw = 1536 + ks * 32 + fq * 8, ca = 1600 + ks * 32 + fq * 8;
                const f32x4 w_lo = sh4(cw), w_hi = sh4(cw + 4), a_lo = sh4(ca), a_hi = sh4(ca + 4);
                u32x4 pw, pa;
                float th[8];
#pragma unroll
                for (int j = 0; j < 4; ++j) { th[j] = 2.0f * sigmoidf_(2.0f * w_lo[j]) - 1.0f; th[4 + j] = 2.0f * sigmoidf_(2.0f * w_hi[j]) - 1.0f; }
                pw.x = cvt_pk_bf16(th[0], th[1]); pw.y = cvt_pk_bf16(th[2], th[3]); pw.z = cvt_pk_bf16(th[4], th[5]); pw.w = cvt_pk_bf16(th[6], th[7]);
                pa.x = cvt_pk_bf16(a_lo[0], a_lo[1]); pa.y = cvt_pk_bf16(a_lo[2], a_lo[3]); pa.z = cvt_pk_bf16(a_hi[0], a_hi[1]); pa.w = cvt_pk_bf16(a_hi[2], a_hi[3]);
                Aw[ks] = __builtin_bit_cast(bf16x8, pw); Al[ks] = __builtin_bit_cast(bf16x8, pa);
            }
            float bon = 0.f;
#pragma unroll
            for (int nt = 0; nt < 4; ++nt) {
                f32x4 lw = (f32x4){0.f, 0.f, 0.f, 0.f}, la = (f32x4){0.f, 0.f, 0.f, 0.f};
#pragma unroll
                for (int ks = 0; ks < 2; ++ks) {
                    lw = __builtin_amdgcn_mfma_f32_16x16x32_bf16(wfr[nt][ks], Aw[ks], lw, 0, 0, 0);
                    la = __builtin_amdgcn_mfma_f32_16x16x32_bf16(afr[nt][ks], Al[ks], la, 0, 0, 0);
                }
                const int ch = h * 64 + nt * 16 + fq * 4;
                const f32x4 r4 = sh4(ch), k4 = sh4(512 + ch);
                const f32x4 w04 = *(LAS const f32x4*)(w0 + ch), a04 = *(LAS const f32x4*)(a0 + ch), ka4 = *(LAS const f32x4*)(k_a + ch), rk4 = *(LAS const f32x4*)(r_k + ch);
                f32x4 dec, av;
#pragma unroll
                for (int j = 0; j < 4; ++j) {
                    const float z_ = -(w04[j] + lw[j]);
                    const float wlog = -__logf(1.0f + __expf(z_)) - 0.5f;
                    dec[j] = __expf(-__expf(wlog));
                    av[j] = sigmoidf_(a04[j] + la[j]);
                    const float kp = k4[j] * (1.0f + (av[j] - 1.0f) * ka4[j]);
                    bon += r4[j] * kp * rk4[j];
                }
                *(f32x4*)(Wdec + (size_t)row * 512 + ch) = dec;
                st_bf4(Aa + (size_t)row * 512 + ch, av);
            }
            bon += __shfl_xor(bon, 16); bon += __shfl_xor(bon, 32);
#pragma unroll
            for (int nt = 0; nt < 4; ++nt) { const int ch = h * 64 + nt * 16 + fq * 4; st_bf4(Ycat + (size_t)row * 1024 + 512 + ch, sh4(1024 + ch) * bon); }
        }
        asm volatile("s_waitcnt vmcnt(0)" ::: "memory");
        __syncthreads();
        buf ^= 1;
    }
#undef PREP_DMA
    const int gtid = cx.bid * 512 + tid, gthreads = cx.nblk * 512;
    for (int e = gtid; e < 136 * 1664; e += gthreads) {
        const int sr = e / 1664, c = e % 1664;
        if (sr < 8) POUT[O_SHIFTP + ((size_t)pair * 8 + sr) * 1664 + c] = bf2f(PB[(size_t)(sr * 2048 + 2047) * LDB + c]);
        else { const int b = sr - 8; POUT[O_SHIFTS + ((size_t)pair * 128 + b) * 1664 + c] = bf2f(PB[(size_t)(NTP + b * 8 + 7) * LDB + c]); }
    }
}

typedef float f32x2 __attribute__((ext_vector_type(2)));
template <bool RED = true>
__device__ __forceinline__ void scan_step(f32x4& S, const f32x4 w, const f32x4 k, const f32x4 kk, const f32x4 nb, const f32x4 r, const float v, float& y) {
    const f32x2 S01 = {S[0], S[1]}, S23 = {S[2], S[3]};
    f32x2 pp = S01 * (f32x2){kk[0], kk[1]};
    pp = S23 * (f32x2){kk[2], kk[3]} + pp;
    float pd = pp[0] + pp[1];
    const f32x2 vv = {v, v};
    const f32x2 t01 = S01 * (f32x2){w[0], w[1]} + (f32x2){k[0], k[1]} * vv;
    const f32x2 t23 = S23 * (f32x2){w[2], w[3]} + (f32x2){k[2], k[3]} * vv;
    pd = allsum16(pd);
    const f32x2 pdv = {pd, pd};
    const f32x2 n01 = (f32x2){nb[0], nb[1]} * pdv + t01, n23 = (f32x2){nb[2], nb[3]} * pdv + t23;
    S = (f32x4){n01[0], n01[1], n23[0], n23[1]};
    f32x2 q = n01 * (f32x2){r[0], r[1]};
    q = n23 * (f32x2){r[2], r[3]} + q;
    y = RED ? allsum16(q[0] + q[1]) : (q[0] + q[1]);
}
__device__ __forceinline__ float reduce_scatter16(const float (&yp)[16], int cgi) {
    const bool b3 = cgi & 8, b2 = cgi & 4, b1 = cgi & 2, b0 = cgi & 1;
    float a[8], bq[4], c[2];
#pragma unroll
    for (int j = 0; j < 8; ++j) { const float keep = b3 ? yp[8 + j] : yp[j], send = b3 ? yp[j] : yp[8 + j]; a[j] = keep + dpp_f<0x128>(send); }
#pragma unroll
    for (int k = 0; k < 4; ++k) { const float keep = b2 ? a[4 + k] : a[k], send = b2 ? a[k] : a[4 + k]; bq[k] = keep + dpp_f<0x141>(send); }
#pragma unroll
    for (int m = 0; m < 2; ++m) { const float keep = b1 ? bq[2 + m] : bq[m], send = b1 ? bq[m] : bq[2 + m]; c[m] = keep + dpp_f<0x4E>(send); }
    const float keep = b0 ? c[1] : c[0], send = b0 ? c[0] : c[1];
    return keep + dpp_f<0xB1>(send);
}

__device__ void phase_scan(const Params& p, const Ctx cx, int pair, LAS unsigned char* lds) {
    const int tid = cx.tid, wid = tid >> 6, lane = tid & 63, rs = lane >> 4, cgi = lane & 15;
    const bf16_t* PB = (const bf16_t*)(PWS + WS_PROJB);
    const float* Wdec = (const float*)(PWS + WS_WDEC);
    const bf16_t* Aa = (const bf16_t*)(PWS + WS_AA);
    bf16_t* Y = (bf16_t*)(PWS + WS_Y);
    const float* mu = PIN(I_MU) + pair * 1664;
    const float* k_k = PIN(I_KK) + pair * 512; const float* k_a = PIN(I_KA) + pair * 512;
    {
        LAS float* vb = (LAS float*)lds + wid * 3072;
        for (int st = cx.bid * 8 + wid; st < 2048; st += cx.nblk * 8) {
            const int bh = st >> 1, half = st & 1, b = bh >> 3, h = bh & 7, ch = h * 64 + cgi * 4;
            const float* stp = PIN(I_SSHIFT) + ((size_t)pair * 128 + b) * 1664;
            const f32x4 kkc = *(const f32x4*)(k_k + ch), kac = *(const f32x4*)(k_a + ch);
            {
#pragma unroll
                for (int tt = 0; tt < 2; ++tt) {
                    const int t = rs + tt * 4;
                    const size_t row = NTP + b * 8 + t;
                    const bf16_t* cur = PB + row * LDB;
                    const f32x4 r = shift4(cur, t > 0, stp, ch, mu), k = shift4(cur, t > 0, stp, 512 + ch, mu), v = shift4(cur, t > 0, stp, 1024 + ch, mu);
                    const f32x4 a = ld_bf4(Aa + row * 512 + ch);
                    const f32x4 w = *(const f32x4*)(Wdec + row * 512 + ch);
                    const f32x4 kkv = k * kkc;
                    const float ss = allsum16(dot4(kkv, kkv));
                    const float inv = __builtin_amdgcn_rsqf(fmaxf(ss, 1e-24f));
                    const f32x4 kkn = kkv * inv;
                    LAS float* o = vb + t * 384 + cgi * 4;
                    *(LAS f32x4*)(o) = w; *(LAS f32x4*)(o + 64) = k * (1.0f + (a - 1.0f) * kac); *(LAS f32x4*)(o + 128) = kkn; *(LAS f32x4*)(o + 192) = -(kkn * a);
                    *(LAS f32x4*)(o + 256) = r; *(LAS f32x4*)(o + 320) = v;
                }
            }
            asm volatile("s_waitcnt lgkmcnt(0)" ::: "memory");
            __builtin_amdgcn_wave_barrier();
            const size_t so0 = ((((size_t)pair * 128 + b) * 8 + h) * 64 + half * 32 + rs) * 64 + cgi * 4;
            f32x4 Snext = *(const f32x4*)(PIN(I_SWKV) + so0);
#pragma unroll 1
            for (int rq = 0; rq < 8; ++rq) {
                const int ri = half * 32 + rq * 4 + rs;
                const size_t so = so0 + (size_t)rq * 256;
                f32x4 S = Snext;
                if (rq + 1 < 8) Snext = *(const f32x4*)(PIN(I_SWKV) + so + 256);
                float ykeep = 0.f;
#pragma unroll
                for (int t = 0; t < 8; ++t) {
                    LAS const float* r0 = vb + t * 384 + cgi * 4;
                    float y; scan_step(S, *(LAS const f32x4*)(r0), *(LAS const f32x4*)(r0 + 64), *(LAS const f32x4*)(r0 + 128), *(LAS const f32x4*)(r0 + 192), *(LAS const f32x4*)(r0 + 256), vb[t * 384 + 320 + ri], y);
                    ykeep = (cgi == t) ? y : ykeep;
                }
                if (cgi < 8) Y[(size_t)(NTP + b * 8 + cgi) * 512 + h * 64 + ri] = (bf16_t)(cvt_pk_bf16(ykeep, 0.f) & 0xffffu);
                *(f32x4*)(POUT + O_WKVS + so) = S;
            }
            asm volatile("s_waitcnt lgkmcnt(0)" ::: "memory");
            __builtin_amdgcn_wave_barrier();
        }
    }
    __syncthreads();
    LAS float* rec = (LAS float*)lds;
    for (int pt = cx.bid; pt < 256; pt += cx.nblk) {
        const int xcd = pt & 7, slot = pt >> 3, bh = xcd * 8 + (slot >> 2), rg = slot & 3, b = bh >> 3, h = bh & 7;
        const int lt = tid - 256, ls = (lt >> 4) & 15, lcg = lt & 15, lch = h * 64 + lcg * 4;
        u32x2 qr = {0u, 0u}, qk = {0u, 0u}, qv = {0u, 0u}, pr = {0u, 0u}, pk = {0u, 0u}, pv = {0u, 0u}, qa = {0u, 0u};
        f32x4 qw = (f32x4){0.f, 0.f, 0.f, 0.f};
        f32x4 mur, muk, muv, kkc, kac;
        const int ri = rg * 16 + (wid & 3) * 4 + rs;
        f32x4 S = (f32x4){0.f, 0.f, 0.f, 0.f};
#define SCAN_ISSUE(c) do { const int t_ = (c) * 16 + ls; const size_t row_ = (size_t)b * 2048 + t_; const bf16_t* cur_ = PB + row_ * LDB; \
            qr = *(const u32x2*)(cur_ + lch); qk = *(const u32x2*)(cur_ + 512 + lch); qv = *(const u32x2*)(cur_ + 1024 + lch); \
            if (t_ > 0) { pr = *(const u32x2*)(cur_ - LDB + lch); pk = *(const u32x2*)(cur_ - LDB + 512 + lch); pv = *(const u32x2*)(cur_ - LDB + 1024 + lch); } \
            else { pr = (u32x2){0u, 0u}; pk = pr; pv = pr; } \
            qw = *(const f32x4*)(Wdec + row_ * 512 + lch); qa = *(const u32x2*)(Aa + row_ * 512 + lch); } while (0)
#define SCAN_PROCESS(buf) do { const f32x4 r0_ = cvt4(qr), k0_ = cvt4(qk), v0_ = cvt4(qv); \
            const f32x4 r_ = r0_ + mur * (cvt4(pr) - r0_), k_ = k0_ + muk * (cvt4(pk) - k0_), v_ = v0_ + muv * (cvt4(pv) - v0_), a_ = cvt4(qa); \
            const f32x4 kkv_ = k_ * kkc; const float ss_ = allsum16(dot4(kkv_, kkv_)); const float inv_ = __builtin_amdgcn_rsqf(fmaxf(ss_, 1e-24f)); \
            const f32x4 kkn_ = kkv_ * inv_; \
            LAS float* o_ = rec + (buf) * 6144 + ls * 384 + lcg * 4; \
            *(LAS f32x4*)(o_) = qw; *(LAS f32x4*)(o_ + 64) = k_ * (1.0f + (a_ - 1.0f) * kac); *(LAS f32x4*)(o_ + 128) = kkn_; *(LAS f32x4*)(o_ + 192) = -(kkn_ * a_); \
            *(LAS f32x4*)(o_ + 256) = r_; *(LAS f32x4*)(o_ + 320) = v_; } while (0)
        if (wid >= 4) {
            mur = *(const f32x4*)(mu + lch); muk = *(const f32x4*)(mu + 512 + lch); muv = *(const f32x4*)(mu + 1024 + lch);
            kkc = *(const f32x4*)(k_k + lch); kac = *(const f32x4*)(k_a + lch);
            SCAN_ISSUE(0); SCAN_PROCESS(0); SCAN_ISSUE(1);
        }
        __syncthreads();
        for (int c = 0; c < 128; ++c) {
            if (wid < 4) {
                LAS const float* rb = rec + (c & 1) * 6144 + cgi * 4;
                LAS const float* rv = rec + (c & 1) * 6144 + 320 + ri;
                float yp[16];
                f32x4 nw = *(LAS const f32x4*)(rb), nk = *(LAS const f32x4*)(rb + 64), nkk = *(LAS const f32x4*)(rb + 128), nb = *(LAS const f32x4*)(rb + 192), nr = *(LAS const f32x4*)(rb + 256);
                float nv = rv[0];
#pragma unroll
                for (int s = 0; s < 16; ++s) {
                    const f32x4 cw = nw, ck = nk, ckk = nkk, cb = nb, cr = nr; const float cv = nv;
                    if (s + 1 < 16) {
                        LAS const float* r1 = rb + (s + 1) * 384;
                        nw = *(LAS const f32x4*)(r1); nk = *(LAS const f32x4*)(r1 + 64); nkk = *(LAS const f32x4*)(r1 + 128); nb = *(LAS const f32x4*)(r1 + 192); nr = *(LAS const f32x4*)(r1 + 256);
                        nv = rv[(s + 1) * 384];
                    }
                    scan_step<false>(S, cw, ck, ckk, cb, cr, cv, yp[s]);
                }
                Y[((size_t)b * 2048 + c * 16 + cgi) * 512 + h * 64 + ri] = (bf16_t)(cvt_pk_bf16(reduce_scatter16(yp, cgi), 0.f) & 0xffffu);
            } else {
                if (c + 1 < 128) { SCAN_PROCESS((c + 1) & 1); if (c + 2 < 128) SCAN_ISSUE(c + 2); }
            }
            __syncthreads();
        }
        if (wid < 4) *(f32x4*)(POUT + O_WKVP + ((((size_t)pair * 8 + b) * 8 + h) * 64 + ri) * 64 + cgi * 4) = S;
#undef SCAN_ISSUE
#undef SCAN_PROCESS
    }
}

__device__ void phase_even_post(const Params& p, const Ctx cx, int pair) {
    const int gtid = cx.bid * 512 + cx.tid, gthreads = cx.nblk * 512;
    const bf16_t* PA = (const bf16_t*)(PWS + WS_R1);
    bf16_t* Ycat = (bf16_t*)(PWS + WS_YCAT);
    const bf16_t* Y = (const bf16_t*)(PWS + WS_Y);
    constexpr int NIT = NTOK * 128, UB = 4;
    const float* gn_g = PIN(I_GNG) + pair * 512; const float* gn_b = PIN(I_GNB) + pair * 512;
    for (int e0 = gtid; e0 < NIT; e0 += gthreads * UB) {
        f32x4 y[UB], bv[UB], bz[UB], gg[UB], gb[UB]; bool ok[UB];
#pragma unroll
        for (int u = 0; u < UB; ++u) {
            const int e = e0 + u * gthreads; ok[u] = e < NIT;
            const int ee = ok[u] ? e : e0; const int row = ee >> 7, ch = (ee & 127) * 4;
            y[u] = ld_bf4(Y + (size_t)row * 512 + ch);
            bv[u] = ld_bf4(Ycat + (size_t)row * 1024 + 512 + ch);
            bz[u] = ld_bf4(PA + (size_t)row * LDA + 2048 + ch);
            gg[u] = *(const f32x4*)(gn_g + ch); gb[u] = *(const f32x4*)(gn_b + ch);
        }
#pragma unroll
        for (int u = 0; u < UB; ++u) {
            const int e = e0 + u * gthreads;
            const int ee = ok[u] ? e : e0; const int row = ee >> 7, ch = (ee & 127) * 4;
            const float mean = allsum16(y[u][0] + y[u][1] + y[u][2] + y[u][3]) * (1.0f / 64.0f);
            const f32x4 d = y[u] - mean;
            const float var = allsum16(dot4(d, d)) * (1.0f / 64.0f);
            const float rstd = rsqrtf(var + 64e-5f);
            const f32x4 g = gg[u], bb = gb[u];
            f32x4 o;
#pragma unroll
            for (int j = 0; j < 4; ++j) o[j] = (d[j] * rstd * g[j] + bb[j] + bv[u][j]) * siluf_(bz[u][j]);
            if (ok[u]) st_bf4(Ycat + (size_t)row * 1024 + 512 + ch, o);
        }
    }
    const float* cw = PIN(I_CONVW) + pair * 3 * 512;
    constexpr int NRUN = (NTOK / 8) * 128;
    for (int e = gtid; e < NRUN; e += gthreads) {
        const int run = e >> 7, ch = (e & 127) * 4, row0 = run * 8;
        const bool samp = row0 >= NTP;
        int b, t0, T; if (!samp) { b = row0 >> 11; t0 = row0 & 2047; T = 2048; } else { b = (row0 - NTP) >> 3; t0 = 0; T = 8; }
        const bf16_t* base = PA + (size_t)row0 * LDA + ch;
        u32x2 rh[10], rc[10], rb[8], rz[8];
#pragma unroll
        for (int k = 0; k < 10; ++k) {
            const bool have = (k >= 2) || (t0 > 0);
            const bf16_t* pr = have ? base + (ptrdiff_t)(k - 2) * LDA : base;
            rh[k] = *(const u32x2*)(pr); rc[k] = *(const u32x2*)(pr + 1024);
        }
#pragma unroll
        for (int k = 0; k < 8; ++k) { rb[k] = *(const u32x2*)(base + (size_t)k * LDA + 512); rz[k] = *(const u32x2*)(base + (size_t)k * LDA + 1536); }
        const f32x4 k0 = *(const f32x4*)(cw + ch), k1 = *(const f32x4*)(cw + 512 + ch), k2 = *(const f32x4*)(cw + 1024 + ch);
        f32x4 um2, um1;
        if (t0 > 0) { um2 = cvt4(rc[0]) * cvt4(rh[0]); um1 = cvt4(rc[1]) * cvt4(rh[1]); }
        else if (samp) { const float* hist = PIN(I_SCONV) + ((size_t)pair * 128 + b) * 2 * 512 + ch; um2 = *(const f32x4*)(hist); um1 = *(const f32x4*)(hist + 512); }
        else { um2 = (f32x4){0.f, 0.f, 0.f, 0.f}; um1 = um2; }
#pragma unroll
        for (int k = 0; k < 8; ++k) {
            const f32x4 u0 = cvt4(rc[k + 2]) * cvt4(rh[k + 2]);
            const f32x4 conv = k0 * um2 + k1 * um1 + k2 * u0;
            const f32x4 ab = cvt4(rb[k]), az = cvt4(rz[k]);
            f32x4 o;
#pragma unroll
            for (int j = 0; j < 4; ++j) o[j] = ab[j] * conv[j] * siluf_(az[j]);
            const int row = row0 + k, t = t0 + k;
            st_bf4(Ycat + (size_t)row * 1024 + ch, o);
            if (t >= T - 2) {
                float* dst = samp ? POUT + O_CONVS + (((size_t)pair * 128 + b) * 2 + (t - (T - 2))) * 512 + ch : POUT + O_CONVP + (((size_t)pair * 8 + b) * 2 + (t - (T - 2))) * 512 + ch;
                *(f32x4*)dst = u0;
            }
            um2 = um1; um1 = u0;
        }
    }
}

template <int W>
__device__ __forceinline__ void pool_sample_run(const float* __restrict__ hist, const bf16_t* __restrict__ cur, LAS bf16_t* out) {
    f32x4 ext[23];
#pragma unroll
    for (int k = 0; k < 15; ++k) ext[k] = (k >= 16 - W) ? *(const f32x4*)(hist + (size_t)k * 512) : (f32x4){0.f, 0.f, 0.f, 0.f};
#pragma unroll
    for (int k = 0; k < 8; ++k) ext[15 + k] = ld_bf4(cur + (size_t)k * LDA);
    f32x4 sum = (f32x4){0.f, 0.f, 0.f, 0.f};
#pragma unroll
    for (int d = 0; d < W; ++d) sum += ext[15 - d];
#pragma unroll
    for (int t = 0; t < 8; ++t) {
        if (t > 0) sum += ext[15 + t] - ext[15 + t - W];
        const f32x4 pooled = sum * (1.0f / (float)W) - ext[15 + t];
        u32x2 u; u.x = cvt_pk_bf16(pooled[0], pooled[1]); u.y = cvt_pk_bf16(pooled[2], pooled[3]);
        *(LAS u32x2*)(out + t * 136) = u;
    }
}

__device__ void phase_odd_mixer(const Params& p, const Ctx cx, int pair, LAS unsigned char* lds) {
    const int tid = cx.tid, wid = tid >> 6, lane = tid & 63, fr = lane & 15, fq = lane >> 4;
    const bf16_t* PO = (const bf16_t*)(PWS + WS_R1);
    bf16_t* Ycat = (bf16_t*)(PWS + WS_YCAT);
    LAS bf16_t* LA = (LAS bf16_t*)lds;
    LAS bf16_t* LB = (LAS bf16_t*)(lds + 128 * 136 * 2);
    LAS float* stat = (LAS float*)(lds + 2 * 128 * 136 * 2);
    LAS float* LE = (LAS float*)(lds + 128 * 136 * 2);
    LAS bf16_t* LW = (LAS bf16_t*)(lds + 128 * 136 * 2 + 143 * 128 * 4);
    for (int di = 0; di < 8; ++di) {
        int tile, g0, ng;
        if (cx.nblk == 256) {
            if (di == 0) { tile = cx.bid >> 1; g0 = (cx.bid & 1) * 2; ng = 2; }
            else if (di == 1 && cx.bid < 32) { tile = 128 + (cx.bid >> 2); g0 = cx.bid & 3; ng = 1; }
            else break;
        } else { tile = cx.bid + di * cx.nblk; g0 = 0; ng = 4; if (tile >= 136) break; }
        const int r0 = tile * 128;
        const bool samp = r0 >= NTP;
        const int tl_ = tid >> 2, q_ = tid & 3;
        {
            const bf16_t* vr = PO + (size_t)(r0 + tl_) * LDA + 1536 + q_ * 128;
            float s_ = 0.f, ss = 0.f;
#pragma unroll
            for (int i = 0; i < 16; ++i) { const u32x4 raw = *(const u32x4*)(vr + i * 8); const f32x4 v0 = cvt4((u32x2){raw.x, raw.y}), v1 = cvt4((u32x2){raw.z, raw.w});
                s_ += (v0[0] + v0[1]) + (v0[2] + v0[3]) + (v1[0] + v1[1]) + (v1[2] + v1[3]); ss += dot4(v0, v0) + dot4(v1, v1); }
            s_ = allsum4(s_); ss = allsum4(ss);
            const float mean = s_ * (1.0f / 512.0f);
            const float var = fmaxf(ss * (1.0f / 512.0f) - mean * mean, 0.f);
            if (q_ == 0) { stat[tl_ * 2] = mean; stat[tl_ * 2 + 1] = rsqrtf(var + 1e-5f); }
        }
        LAS float* lnw = stat + 512;
        lnw[tid] = PIN(I_LNG)[pair * 512 + tid]; lnw[512 + tid] = PIN(I_LNB)[pair * 512 + tid];
        u32x2 rv[8]; u32x4 rw[4];
#define MIX_LOAD_G(gg) do { const bf16_t* vr_ = PO + (size_t)(r0 + tl_) * LDA + 1536 + (gg) * 128 + q_ * 32; \
            _Pragma("unroll") for (int i = 0; i < 8; ++i) rv[i] = *(const u32x2*)(vr_ + i * 4); \
            if (!samp) { const bf16_t* Ws_ = (const bf16_t*)(PWS + WS_SPW) + ((size_t)pair * 4 + (gg)) * 128 * 128; \
                _Pragma("unroll") for (int i = 0; i < 4; ++i) { const int e = tid + i * 512; rw[i] = *(const u32x4*)(Ws_ + (e >> 4) * 128 + (e & 15) * 8); } } } while (0)
        MIX_LOAD_G(g0);
        __syncthreads();
#pragma unroll 1
        for (int g = g0; g < g0 + ng; ++g) {
            u32x2 ur[8], dzr[8];
#pragma unroll
            for (int nt = 0; nt < 8; ++nt) { const size_t o_ = (size_t)(r0 + wid * 16 + fr) * LDA + g * 128 + nt * 16 + fq * 4; ur[nt] = *(const u32x2*)(PO + o_ + 1024); dzr[nt] = *(const u32x2*)(PO + o_ + 2048); }
            {
                const int row = r0 + tl_;
                const float mean = stat[tl_ * 2], rstd = stat[tl_ * 2 + 1];
                LAS const float* lg = lnw + g * 128 + q_ * 32; LAS const float* lb = lnw + 512 + g * 128 + q_ * 32;
#pragma unroll
                for (int i = 0; i < 8; ++i) {
                    const f32x4 v = cvt4(rv[i]);
                    const f32x4 vn = (v - mean) * rstd * *(LAS const f32x4*)(lg + i * 4) + *(LAS const f32x4*)(lb + i * 4);
                    if (samp) *(f32x4*)(POUT + O_CHUNKV + ((size_t)pair * 1024 + (row - NTP)) * 512 + g * 128 + q_ * 32 + i * 4) = vn;
                    {
                        const float p0 = dpp_f<0x104>(vn[0]), p1 = dpp_f<0x104>(vn[1]);
                        const float p2 = dpp_f<0x114>(vn[2]), p3 = dpp_f<0x114>(vn[3]);
                        const bool odd = tl_ & 1;
                        const unsigned wa = odd ? cvt_pk_bf16(p2, vn[2]) : cvt_pk_bf16(vn[0], p0);
                        const unsigned wb = odd ? cvt_pk_bf16(p3, vn[3]) : cvt_pk_bf16(vn[1], p1);
                        const int cb = q_ * 32 + i * 4 + (odd ? 2 : 0), tb = tl_ & ~1;
                        *(LAS unsigned*)(LB + (cb) * 136 + tb) = wa;
                        *(LAS unsigned*)(LB + (cb + 1) * 136 + tb) = wb;
                    }
                }
            }
            if (!samp) {
#pragma unroll
                for (int i = 0; i < 4; ++i) { const int e = tid + i * 512; *(LAS u32x4*)(LA + (e >> 4) * 136 + (e & 15) * 8) = rw[i]; }
            } else {
                const float* Wsrc = PIN(I_SPW) + ((size_t)pair * 4 + g) * 128 * 128;
                LAS float* w8 = stat + 256;
                if (tid < 64) w8[tid] = Wsrc[(tid >> 3) * 128 + (tid & 7)];
                __syncthreads();
                for (int e = tid; e < 128 * 128; e += 512) { const int t = e >> 7, s2 = e & 127;
                    const float v = ((t >> 3) == (s2 >> 3) && (s2 & 7) <= (t & 7)) ? w8[(t & 7) * 8 + (s2 & 7)] : 0.f;
                    LA[t * 136 + s2] = (bf16_t)(cvt_pk_bf16(v, 0.f) & 0xffffu); }
            }
            if (g + 1 < g0 + ng) MIX_LOAD_G(g + 1);
            __syncthreads();
            {
                const int tl = wid * 16 + fr, row = r0 + tl;
                const float bias = PIN(I_SPB)[((size_t)pair * 4 + g) * 128 + (samp ? (tl & 7) : tl)];
                bf16x8 wf[4];
#pragma unroll
                for (int ks = 0; ks < 4; ++ks) wf[ks] = *(const LAS bf16x8*)(LA + tl * 136 + ks * 32 + fq * 8);
#pragma unroll
                for (int nt = 0; nt < 8; ++nt) {
                    f32x4 acc = (f32x4){0.f, 0.f, 0.f, 0.f};
#pragma unroll
                    for (int ks = 0; ks < 4; ++ks) {
                        if (ks * 32 <= wid * 16 + 15) {
                            const bf16x8 vf = *(const LAS bf16x8*)(LB + (nt * 16 + fr) * 136 + ks * 32 + fq * 8);
                            acc = __builtin_amdgcn_mfma_f32_16x16x32_bf16(vf, wf[ks], acc, 0, 0, 0);
                        }
                    }
                    const int c = g * 128 + nt * 16 + fq * 4;
                    const f32x4 u = cvt4(ur[nt]), dz = cvt4(dzr[nt]);
                    f32x4 o;
#pragma unroll
                    for (int j = 0; j < 4; ++j) o[j] = u[j] * (acc[j] + bias) * siluf_(dz[j]);
                    st_bf4(Ycat + (size_t)row * 1024 + 512 + c, o);
                }
            }
            __syncthreads();
        }
#undef MIX_LOAD_G
    }
    {
        int ci, cstride;
        if (cx.nblk == 256) { if (cx.bid < 32) { ci = 1 << 20; cstride = 1 << 20; } else { ci = cx.bid - 32; cstride = 224; } }
        else { ci = cx.bid; cstride = cx.nblk; }
        u32x4 pw[4]; u32x2 pe[9];
#define MIX_LOAD_C(cc) do { const int tile_ = (cc) >> 2, g_ = (cc) & 3, r0_ = tile_ * 128; \
            const bf16_t* Bw_ = (const bf16_t*)(PWS + WS_POOLWT) + ((size_t)pair * 4 + g_) * 128 * 128; \
            _Pragma("unroll") for (int i = 0; i < 4; ++i) { const int e = tid + i * 512; pw[i] = *(const u32x4*)(Bw_ + (e >> 4) * 128 + (e & 15) * 8); } \
            if (r0_ < NTP) { const int t0_ = r0_ & 2047; \
                _Pragma("unroll") for (int i = 0; i < 9; ++i) { const int e = tid + i * 512, er = e >> 5, c = (e & 31) * 4; pe[i] = (u32x2){0u, 0u}; \
                    if (e < 143 * 32 && t0_ + er - 15 >= 0) pe[i] = *(const u32x2*)(PO + (size_t)(r0_ + er - 15) * LDA + g_ * 128 + c); } } } while (0)
        if (ci < 544) MIX_LOAD_C(ci);
        for (; ci < 544; ci += cstride) {
            const int tile = ci >> 2, g = ci & 3, r0 = tile * 128;
            const bool samp = r0 >= NTP;
            const int w = 2 << g;
            const int row = r0 + wid * 16 + fr;
            u32x2 czr[8]; f32x4 psr[8];
#pragma unroll
            for (int nt = 0; nt < 8; ++nt) { const int d = g * 128 + nt * 16 + fq * 4; czr[nt] = *(const u32x2*)(PO + (size_t)row * LDA + 512 + d); psr[nt] = *(const f32x4*)(PIN(I_PSCALE) + pair * 512 + d); }
#pragma unroll
            for (int i = 0; i < 4; ++i) { const int e = tid + i * 512; *(LAS u32x4*)(LW + (e >> 4) * 136 + (e & 15) * 8) = pw[i]; }
            if (!samp) {
                const int t0 = r0 & 2047;
#pragma unroll
                for (int i = 0; i < 9; ++i) { const int e = tid + i * 512, er = e >> 5, c = (e & 31) * 4; if (e < 143 * 32) *(LAS f32x4*)(LE + er * 128 + c) = cvt4(pe[i]); }
                __syncthreads();
                {
                    const int c = (tid & 31) * 4, tl0 = (tid >> 5) * 8;
                    f32x4 sum = (f32x4){0.f, 0.f, 0.f, 0.f};
#pragma unroll 4
                    for (int d = 0; d < w; ++d) sum += *(LAS const f32x4*)(LE + (tl0 + 15 - d) * 128 + c);
#pragma unroll
                    for (int k = 0; k < 8; ++k) {
                        const int tl = tl0 + k;
                        const f32x4 pt = *(LAS const f32x4*)(LE + (tl + 15) * 128 + c);
                        if (k > 0) sum += pt - *(LAS const f32x4*)(LE + (tl + 15 - w) * 128 + c);
                        const float cnt = fminf((float)w, (float)(t0 + tl + 1));
                        const f32x4 pooled = sum * (1.0f / cnt) - pt;
                        u32x2 u; u.x = cvt_pk_bf16(pooled[0], pooled[1]); u.y = cvt_pk_bf16(pooled[2], pooled[3]);
                        *(LAS u32x2*)(LA + tl * 136 + c) = u;
                    }
                }
            } else {
                const int sq = tid >> 5, c = (tid & 31) * 4, bb = (r0 - NTP) / 8 + sq;
                const float* hist = PIN(I_SPOOL) + ((size_t)pair * 128 + bb) * 15 * 512 + g * 128 + c;
                const bf16_t* cur = PO + (size_t)(r0 + sq * 8) * LDA + g * 128 + c;
                LAS bf16_t* out = LA + (sq * 8) * 136 + c;
                if (g == 0) pool_sample_run<2>(hist, cur, out); else if (g == 1) pool_sample_run<4>(hist, cur, out);
                else if (g == 2) pool_sample_run<8>(hist, cur, out); else pool_sample_run<16>(hist, cur, out);
            }
            if (ci + cstride < 544) MIX_LOAD_C(ci + cstride);
            __syncthreads();
            bf16x8 af[4];
#pragma unroll
            for (int ks = 0; ks < 4; ++ks) af[ks] = *(const LAS bf16x8*)(LA + (wid * 16 + fr) * 136 + ks * 32 + fq * 8);
#pragma unroll
            for (int nt = 0; nt < 8; ++nt) {
                f32x4 acc = (f32x4){0.f, 0.f, 0.f, 0.f};
#pragma unroll
                for (int ks = 0; ks < 4; ++ks) {
                    const bf16x8 bf = *(const LAS bf16x8*)(LW + (nt * 16 + fr) * 136 + ks * 32 + fq * 8);
                    acc = __builtin_amdgcn_mfma_f32_16x16x32_bf16(bf, af[ks], acc, 0, 0, 0);
                }
                const int d = g * 128 + nt * 16 + fq * 4;
                const f32x4 cz = cvt4(czr[nt]), ps = psr[nt];
                f32x4 o;
#pragma unroll
                for (int j = 0; j < 4; ++j) o[j] = acc[j] * ps[j] * siluf_(cz[j]);
                st_bf4(Ycat + (size_t)row * 1024 + d, o);
            }
            __syncthreads();
        }
#undef MIX_LOAD_C
    }
    const int gtid = cx.bid * 512 + tid, gthreads = cx.nblk * 512;
    for (int e = gtid; e < 136 * 15 * 128; e += gthreads) {
        const int c = (e & 127) * 4, q = e >> 7, sr = q / 15, k = q - sr * 15;
        if (sr < 8) *(f32x4*)(POUT + O_POOLP + (((size_t)pair * 8 + sr) * 15 + k) * 512 + c) = ld_bf4(PO + (size_t)(sr * 2048 + 2033 + k) * LDA + c);
        else { const int b = sr - 8;
            *(f32x4*)(POUT + O_POOLS + (((size_t)pair * 128 + b) * 15 + k) * 512 + c) = (k < 7) ? *(const f32x4*)(PIN(I_SPOOL) + (((size_t)pair * 128 + b) * 15 + 8 + k) * 512 + c) : ld_bf4(PO + (size_t)(NTP + b * 8 + (k - 7)) * LDA + c); }
    }
}

__device__ void phase_final(const Params& p, const Ctx cx) {
    const int gtid = cx.bid * 512 + cx.tid, gthreads = cx.nblk * 512;
    const float* ssq = (const float*)(PWS + WS_SSQ) + (size_t)4 * NTOK * 16;
    const bf16_t* Xb = (const bf16_t*)(PWS + WS_XB);
    constexpr int NIT = NTOK * 256, UB = 4;
    for (int e0 = gtid; e0 < NIT; e0 += gthreads * UB) {
        f32x4 x[UB], fw[UB]; float sq[UB]; bool ok[UB];
#pragma unroll
        for (int u = 0; u < UB; ++u) { const int e = e0 + u * gthreads; ok[u] = e < NIT; const int ee = ok[u] ? e : e0; const int row = ee >> 8, c = (ee & 255) * 4;
            x[u] = ld_bf4(Xb + (size_t)row * 1024 + c); sq[u] = ssq_sum(ssq + (size_t)row * 16); fw[u] = *(const f32x4*)(PIN(I_FNORMW) + c); }
#pragma unroll
        for (int u = 0; u < UB; ++u) { const int e = e0 + u * gthreads; const int ee = ok[u] ? e : e0; const int row = ee >> 8, c = (ee & 255) * 4;
            const float rstd = rsqrtf(sq[u] * (1.0f / 1024.0f) + 1e-6f);
            if (ok[u]) *(f32x4*)(POUT + (size_t)row * 1024 + c) = x[u] * rstd * fw[u]; }
    }
}

#define XB_TMO      128
#define XB_XCNT(j)  (256  + 64 * (j))
#define XB_XSUB(j)  (1280 + 64 * (j))
#define XB_XGEN(j)  (2304 + 64 * (j))
#define XB_TOP      3328
#define XB_TOPGEN   3392
#define XCD_BAR_WORDS 3456
#define XB_SPIN_CAP (1u << 18)
__device__ __forceinline__ unsigned xb_ld(unsigned* p)              { return __hip_atomic_load(p, __ATOMIC_RELAXED, __HIP_MEMORY_SCOPE_AGENT); }
__device__ __forceinline__ unsigned xb_add(unsigned* p, unsigned v) { return __hip_atomic_fetch_add(p, v, __ATOMIC_RELAXED, __HIP_MEMORY_SCOPE_AGENT); }
__device__ __forceinline__ unsigned xb_xcc_id() { return (unsigned)__builtin_amdgcn_s_getreg((3 << 11) | 20) & 0xFu; }
#define XB_SPIN(cond, bar) do { unsigned _sp = 0; while (cond) { __builtin_amdgcn_s_sleep(1); \
    if ((++_sp & 255u) == 0u) { if (xb_ld(&(bar)[XB_TMO])) break; if (_sp > XB_SPIN_CAP) { atomicAdd(&(bar)[XB_TMO], 1u); break; } } } } while (0)
struct XcdBarrier { unsigned* bar; unsigned x; volatile LAS unsigned* st; };
__device__ __forceinline__ XcdBarrier xcd_barrier_post(unsigned* bar, volatile LAS unsigned* st) {
    XcdBarrier b; b.bar = bar; b.x = xb_xcc_id(); b.st = st;
    if (threadIdx.x == 0) (void)xb_add(&bar[XB_XCNT(b.x)], 1u);
    return b;
}
__device__ __forceinline__ void xcd_barrier_complete(unsigned* bar, unsigned x, unsigned& nloc, unsigned& nx) {
    const unsigned G = gridDim.x * gridDim.y * gridDim.z;
    unsigned sum, cnt, mine, sp = 0u;
    for (;;) {
        sum = 0u; cnt = 0u; mine = 0u;
#pragma unroll
        for (unsigned j = 0; j < 16; ++j) { const unsigned c = xb_ld(&bar[XB_XCNT(j)]); sum += c; cnt += (c > 0u) ? 1u : 0u; mine = (j == x) ? c : mine; }
        if (sum == G) break;
        __builtin_amdgcn_s_sleep(1);
        if ((++sp & 255u) == 0u) { if (xb_ld(&bar[XB_TMO])) break; if (sp > XB_SPIN_CAP) { atomicAdd(&bar[XB_TMO], 1u); break; } }
    }
    nloc = mine > 0u ? mine : 1u; nx = cnt > 0u ? cnt : 1u;
}
__device__ __forceinline__ void xcd_barrier(const XcdBarrier& b) {
    asm volatile("s_waitcnt vmcnt(0)" ::: "memory");
    __syncthreads();
    if (threadIdx.x == 0) {
        unsigned* bar = b.bar;
        __builtin_amdgcn_s_waitcnt(0);
        unsigned nloc = b.st[0], nx = b.st[1];
        if (nloc == 0u) { xcd_barrier_complete(bar, b.x, nloc, nx); b.st[0] = nloc; b.st[1] = nx; }
        const unsigned old = xb_add(&bar[XB_XSUB(b.x)], 1u);
        const unsigned gen = old / nloc;
        if (old + 1u == (gen + 1u) * nloc) {
            __builtin_amdgcn_fence(__ATOMIC_RELEASE, "agent");
            asm volatile("s_waitcnt vmcnt(0)" ::: "memory");
            const unsigned og = xb_add(&bar[XB_TOP], 1u);
            const unsigned tg = og / nx;
            if (og + 1u == (tg + 1u) * nx) xb_add(&bar[XB_TOPGEN], 1u);
            else XB_SPIN(xb_ld(&bar[XB_TOPGEN]) == tg, bar);
            __builtin_amdgcn_fence(__ATOMIC_ACQUIRE, "agent");
            xb_add(&bar[XB_XGEN(b.x)], 1u);
            asm volatile("s_waitcnt vmcnt(0)" ::: "memory");
        } else {
            XB_SPIN(xb_ld(&bar[XB_XGEN(b.x)]) == gen, bar);
            __builtin_amdgcn_fence(__ATOMIC_ACQUIRE, "agent");
            asm volatile("s_waitcnt vmcnt(0)" ::: "memory");
        }
    }
    __syncthreads();
}

__device__ void run_gemm_proj(const Params& p, const Ctx cx, LAS unsigned char* lds, const bf16_t* Bt, int N, bf16_t* O, int ldc, int layer) {
    pg8::Gemm g{(const bf16_t*)(PWS + WS_XB), Bt, NTOK, N, 1024};
    pg8::StaticOrder S; S.init(NTOK, N, (int)cx.nblk, (int)cx.bid);
    const float* ssq = (const float*)(PWS + WS_SSQ) + (size_t)layer * NTOK * 16;
    LAS float* rl = (LAS float*)(lds + 131072);
    int pm0 = -1, pm1 = -1, pm2 = -1, pm3 = -1, np = 0;
    for (int i = 0; i < 64; ++i) {
        pg8::Unit u; if (!S.next(i, u)) break;
        if (u.pm == pm0 || u.pm == pm1 || u.pm == pm2 || u.pm == pm3) continue;
        if (np == 0) pm0 = u.pm; else if (np == 1) pm1 = u.pm; else if (np == 2) pm2 = u.pm; else pm3 = u.pm;
        ++np;
    }
    for (int r = cx.tid; r < np * 256; r += 512) {
        const int i = r >> 8, pm = i == 0 ? pm0 : (i == 1 ? pm1 : (i == 2 ? pm2 : pm3));
        rl[r] = rsqrtf(ssq_sum(ssq + (size_t)(pm * 256 + (r & 255)) * 16) * (1.0f / 1024.0f) + 1e-6f);
    }
    __syncthreads();
    EpiProj E{O, ldc, rl, pm0, pm1, pm2, pm3};
    pg8::gemm_phase<EpiProj>(cx, lds, g, S, E);
}
__device__ void run_gemm_res(const Params& p, const Ctx cx, LAS unsigned char* lds, const bf16_t* Bt, int layer) {
    const bf16_t* A = (const bf16_t*)(PWS + WS_YCAT);
    bf16_t* Xb = (bf16_t*)(PWS + WS_XB);
    float* ssqn = (float*)(PWS + WS_SSQ) + (size_t)(layer + 1) * NTOK * 16;
    pg8::Gemm g{A, Bt, NTOK, 1024, 1024};
    pg8::StaticOrder S; S.init(NTOK, 1024, (int)cx.nblk, (int)cx.bid);
    EpiRes E{layer == 0 ? PIN(I_XP) : nullptr, PIN(I_XS), Xb, ssqn};
    pg8::gemm_phase<EpiRes>(cx, lds, g, S, E);
}

constexpr int N_PHASES = 20;
#ifndef PHMASK
#define PHMASK 0xffff
#endif
#define PHON(n) ((PHMASK >> ((n) % 16)) & 1)
__global__ void __launch_bounds__(512, 2) fwd_kernel(Params p) {
    extern __shared__ __attribute__((aligned(16))) unsigned char lds_raw[];
    LAS unsigned char* lds = (LAS unsigned char*)lds_raw;
    volatile LAS unsigned* bar_st = (volatile LAS unsigned*)(lds + LDS_MAIN);
    if (threadIdx.x < 4) bar_st[threadIdx.x] = 0u;
    __syncthreads();
    const XcdBarrier gbar = xcd_barrier_post((unsigned*)((unsigned char*)p.ptr[30] + WS_BAR), bar_st);
    if (p.ph_hi < 0) cg::this_grid().sync();
#define GRID_SYNC() xcd_barrier(gbar)
#ifdef SYNCPROBE
    for (int i = 0; i < SYNCPROBE; ++i) GRID_SYNC();
#endif
#ifdef REPMASK
    for (int pc = p.ph_lo * 2; pc < p.ph_hi * 2; ++pc) {
        const int ph = pc >> 1;
        { const int s_ = (ph == 0) ? 9 : (ph == N_PHASES - 1) ? 31 : (ph - 1) % 9; if ((pc & 1) && !((REPMASK >> s_) & 1)) continue; }
        if (pc > p.ph_lo * 2) GRID_SYNC();
#else
    for (int ph = p.ph_lo; ph < p.ph_hi; ++ph) {
        if (ph > p.ph_lo) GRID_SYNC();
#endif
        Ctx cx; cx.tid = threadIdx.x; cx.bid = blockIdx.x; cx.nblk = gridDim.x;
        asm volatile("s_mov_b32 %0, 0" : "=s"(cx.z));
        asm volatile("" : "+v"(cx.tid)); asm volatile("" : "+s"(cx.bid)); asm volatile("" : "+s"(cx.nblk));
        const int pair = (ph - 1) / 9, s = (ph == 0) ? 100 : (ph == N_PHASES - 1 ? 101 : (ph - 1) % 9);
        if (s == 0 || s == 3 || s == 6) {
#if PHON(0)
            const bf16_t* WinE = (const bf16_t*)(PWS + WS_WINE) + (size_t)pair * 4352 * 1024;
            const bf16_t* Bt = s == 0 ? WinE + (size_t)2560 * 1024 : (s == 3 ? WinE : (const bf16_t*)(PWS + WS_WINO) + (size_t)pair * 2560 * 1024);
            const int N = s == 0 ? 1792 : 2560;
            run_gemm_proj(p, cx, lds, Bt, N, (bf16_t*)(PWS + WS_R1), N, 2 * pair + (s == 6 ? 1 : 0));
#endif
        } else if (s == 5 || s == 8) {
#if PHON(5)
            const bf16_t* Bt = (const bf16_t*)(PWS + (s == 5 ? WS_WOUTE : WS_WOUTO)) + (size_t)pair * 1024 * 1024;
            run_gemm_res(p, cx, lds, Bt, 2 * pair + (s == 8 ? 1 : 0));
#endif
        } else if (s == 1) {
#if PHON(1)
            phase_even_prep(p, cx, pair, lds);
#endif
        } else if (s == 2) {
#if PHON(2)
            phase_scan(p, cx, pair, lds);
#endif
        } else if (s == 4) {
#if PHON(4)
            phase_even_post(p, cx, pair);
#endif
        } else if (s == 7) {
#if PHON(7)
            phase_odd_mixer(p, cx, pair, lds);
#endif
        } else if (s == 100) {
#if PHON(10)
            phase_prepass(p, cx, lds);
#endif
        } else {
#if PHON(11)
            phase_final(p, cx);
#endif
        }
    }
}

extern "C" void kernel_launch(void* const* d_in, const int* in_sizes, int n_in, void* d_out, int out_size, void* d_ws, size_t ws_size, hipStream_t stream) {
    static int grid = 0;
    if (grid == 0) {
        if (n_in != 29 || ws_size < WS_END) { fprintf(stderr, "kernel_launch: unexpected n_in %d / ws_size %zu (need %zu)\n", n_in, ws_size, (size_t)WS_END); grid = -1; return; }
        int dev = 0, cus = 0, per_cu = 0;
        hipGetDevice(&dev);
        hipDeviceGetAttribute(&cus, hipDeviceAttributeMultiprocessorCount, dev);
        if (hipFuncSetAttribute((const void*)fwd_kernel, hipFuncAttributeMaxDynamicSharedMemorySize, LDS_BYTES) != hipSuccess) { fprintf(stderr, "kernel_launch: hipFuncSetAttribute failed\n"); grid = -1; return; }
        if (hipOccupancyMaxActiveBlocksPerMultiprocessor(&per_cu, (const void*)fwd_kernel, 512, LDS_BYTES) != hipSuccess || per_cu < 1) { fprintf(stderr, "kernel_launch: occupancy query gave %d\n", per_cu); per_cu = 1; }
        (void)hipGetLastError();
        grid = cus * per_cu;
        if (grid > 256) grid = 256;
    }
    if (grid < 0) return;
    Params p{};
    for (int i = 0; i < 29; ++i) p.ptr[i] = d_in[i];
    p.ptr[29] = d_out; p.ptr[30] = d_ws; p.ptr[31] = nullptr;
    (void)hipMemsetAsync((unsigned char*)d_ws + WS_BAR, 0, 16384, stream);
#if ONE_LAUNCH
    p.ph_lo = 0; p.ph_hi = N_PHASES;
    void* args[] = {&p};
    hipError_t e = hipLaunchCooperativeKernel((const void*)fwd_kernel, dim3(grid), dim3(512), args, LDS_BYTES, stream);
    if (e != hipSuccess) fprintf(stderr, "cooperative launch failed: %s (grid %d)\n", hipGetErrorString(e), grid);
#else
    for (int ph = 0; ph < N_PHASES; ++ph) {
        p.ph_lo = ph; p.ph_hi = ph + 1;
        hipLaunchKernelGGL(fwd_kernel, dim3(grid), dim3(512), LDS_BYTES, stream, p);
    }
#endif
}
```

```cpp
#include <hip/hip_runtime.h>
#include <hip/hip_cooperative_groups.h>
#include <cstdio>
namespace cg = cooperative_groups;

#ifndef ONE_LAUNCH
#define ONE_LAUNCH 1
#endif

#define LAS __attribute__((address_space(3)))
typedef unsigned short bf16_t;
typedef short bf16x8 __attribute__((ext_vector_type(8)));
typedef float f32x4 __attribute__((ext_vector_type(4)));
typedef unsigned u32x4 __attribute__((ext_vector_type(4)));
typedef unsigned u32x2 __attribute__((ext_vector_type(2)));

constexpr int NTOK = 17408, NTP = 16384;
constexpr int LDB = 1792;
constexpr int LDA = 2560;
constexpr size_t O_CONVP = 17825792, O_CONVS = 17842176, O_SHIFTP = 18104320, O_SHIFTS = 18130944, O_WKVP = 18556928, O_WKVS = 19081216,
                 O_POOLP = 27469824, O_POOLS = 27592704, O_CHUNKV = 29558784;
constexpr size_t WS_WINE = 0;
constexpr size_t WS_WOUTE = WS_WINE + 2ull * 4352 * 1024 * 2;
constexpr size_t WS_WINO = WS_WOUTE + 2ull * 1024 * 1024 * 2;
constexpr size_t WS_WOUTO = WS_WINO + 2ull * 2560 * 1024 * 2;
constexpr size_t WS_W2T = WS_WOUTO + 2ull * 1024 * 1024 * 2;
constexpr size_t WS_A2T = WS_W2T + 2ull * 512 * 64 * 2;
constexpr size_t WS_POOLWT = WS_A2T + 2ull * 512 * 64 * 2;
constexpr size_t WS_SPW = WS_POOLWT + 8ull * 128 * 128 * 2;
constexpr size_t WS_XB = WS_SPW + 8ull * 128 * 128 * 2;
constexpr size_t WS_YCAT = WS_XB + (size_t)NTOK * 1024 * 2;
constexpr size_t WS_SSQ = WS_YCAT + (size_t)NTOK * 1024 * 2;
constexpr size_t WS_Y = WS_SSQ + 5ull * NTOK * 16 * 4;
constexpr size_t WS_R1 = WS_Y + (size_t)NTOK * 512 * 4;
constexpr size_t WS_PROJB = WS_R1;
constexpr size_t WS_WDEC = WS_PROJB + (size_t)NTOK * LDB * 2;
constexpr size_t WS_AA = WS_WDEC + (size_t)NTOK * 512 * 4;
constexpr size_t WS_BAR = WS_AA + (size_t)NTOK * 512 * 2;
constexpr size_t WS_END = WS_BAR + 16384;
constexpr int LDS_MAIN = 147456;
constexpr int LDS_BYTES = LDS_MAIN + 16;

struct Params {
    const void* ptr[32];
    int ph_lo, ph_hi;
};
struct Ctx { int tid, bid, nblk, z; };
#define PIN(i) ((const float*)p.ptr[(i) + cx.z])
#define POUT ((float*)p.ptr[29 + cx.z])
#define PWS ((unsigned char*)p.ptr[30 + cx.z])
enum { I_XP = 0, I_XS, I_SCONV, I_SSHIFT, I_SWKV, I_SPOOL, I_NORMW, I_FNORMW, I_WINE, I_CONVW, I_MU, I_W0, I_W2, I_A0, I_A2, I_KK, I_KA, I_RK, I_GNG, I_GNB,
       I_WOUTE, I_WINO, I_POOLW, I_PSCALE, I_LNG, I_LNB, I_SPW, I_SPB, I_WOUTO };

__device__ __forceinline__ unsigned cvt_pk_bf16(float lo, float hi) { unsigned r; asm("v_cvt_pk_bf16_f32 %0, %1, %2" : "=v"(r) : "v"(lo), "v"(hi)); return r; }
__device__ __forceinline__ float bf_lo(unsigned u) { return __uint_as_float(u << 16); }
__device__ __forceinline__ float bf_hi(unsigned u) { return __uint_as_float(u & 0xffff0000u); }
__device__ __forceinline__ float bf2f(bf16_t b) { return __uint_as_float(((unsigned)b) << 16); }
__device__ __forceinline__ f32x4 cvt4(u32x2 u) { return (f32x4){bf_lo(u.x), bf_hi(u.x), bf_lo(u.y), bf_hi(u.y)}; }
__device__ __forceinline__ f32x4 ld_bf4(const bf16_t* p) { return cvt4(*(const u32x2*)p); }
__device__ __forceinline__ void st_bf4(bf16_t* p, f32x4 v) { u32x2 u; u.x = cvt_pk_bf16(v[0], v[1]); u.y = cvt_pk_bf16(v[2], v[3]); *(u32x2*)p = u; }
__device__ __forceinline__ float sigmoidf_(float x) { return __builtin_amdgcn_rcpf(1.0f + __expf(-x)); }
__device__ __forceinline__ float siluf_(float x) { return x * __builtin_amdgcn_rcpf(1.0f + __expf(-x)); }
template <int CTRL> __device__ __forceinline__ float dpp_f(float x) { return __builtin_bit_cast(float, __builtin_amdgcn_mov_dpp(__builtin_bit_cast(int, x), CTRL, 0xf, 0xf, true)); }
__device__ __forceinline__ float allsum16(float x) { x += dpp_f<0xB1>(x); x += dpp_f<0x4E>(x); x += dpp_f<0x141>(x); x += dpp_f<0x128>(x); return x; }
__device__ __forceinline__ float allsum4(float x) { x += dpp_f<0xB1>(x); x += dpp_f<0x4E>(x); return x; }
__device__ __forceinline__ float dot4(f32x4 a, f32x4 b) { return a[0] * b[0] + a[1] * b[1] + a[2] * b[2] + a[3] * b[3]; }

__device__ __forceinline__ float ssq_sum(const float* part) {
    const f32x4 a = *(const f32x4*)(part), b = *(const f32x4*)(part + 4), c = *(const f32x4*)(part + 8), d = *(const f32x4*)(part + 12);
    return ((a[0] + a[1]) + (a[2] + a[3])) + ((b[0] + b[1]) + (b[2] + b[3])) + ((c[0] + c[1]) + (c[2] + c[3])) + ((d[0] + d[1]) + (d[2] + d[3]));
}

namespace pg8 {
constexpr int BM = 256, BK = 64, HALF = 128, HTB = HALF * BK * 2, NXCD = 8, WGM = 8;
__device__ __forceinline__ int lds_byte(int r, int c) { const int st = (r >> 4) * 2 + (c >> 5), rr = r & 15, cc = c & 31, ob = rr * 64 + cc * 2; return st * 1024 + (ob ^ (((ob >> 9) & 1) << 5)); }
__device__ __forceinline__ void stage_rc(int b, int& R, int& C) { const int st = b / 1024, sb = b % 1024, swz = sb ^ (((sb >> 9) & 1) << 5); R = (st >> 1) * 16 + swz / 64; C = (st & 1) * 32 + (swz % 64) / 2; }
__device__ __forceinline__ int perm32(int rho) { const int n = rho >> 4, i = rho & 15; return 8 * (i >> 2) + 4 * n + (i & 3); }
struct Unit { int pm, pn; };
struct Gemm { const bf16_t* A; const bf16_t* Bt; int M, N, K; };
struct StaticOrder {
    int nM, nN, nwg, G, c;
    __device__ void init(int M, int N, int G_, int c_) { nM = M / BM; nN = N / BM; nwg = nM * nN; G = G_; c = c_; }
    __device__ bool next(int i, Unit& u) const {
        const long L = (long)i * G + c; if (L >= nwg) return false;
        int wgid = (int)L; { const int q = nwg / NXCD, r = nwg % NXCD, xcd = wgid % NXCD, off = wgid / NXCD; wgid = (xcd < r ? xcd * (q + 1) : r * (q + 1) + (xcd - r) * q) + off; }
        const int nig = WGM * nN, gid = wgid / nig, fm = gid * WGM, gsz = (nM - fm) < WGM ? (nM - fm) : WGM;
        u.pm = fm + ((wgid % nig) % gsz); u.pn = (wgid % nig) / gsz; return true;
    }
};

template <class Epi>
__device__ __forceinline__ void gemm_phase(const Ctx cx, LAS unsigned char* lds, const Gemm g, const StaticOrder& S, const Epi& E) {
    const int tid = cx.tid, wid = __builtin_amdgcn_readfirstlane(tid >> 6), lane = tid & 63, wr = wid >> 2, wc = wid & 3, fr = lane & 15, fq = lane >> 4;
    const int K = g.K, nt = K / BK;
    unsigned voffA[2], voffB[2];
#pragma unroll
    for (int i = 0; i < 2; ++i) { int R, C; stage_rc(tid * 16 + i * 8192, R, C); const int Rb = Epi::PERM ? ((R & ~31) + perm32(R & 31)) : R;
        voffA[i] = (unsigned)(R * K + C) * 2u; voffB[i] = (unsigned)(Rb * K + C) * 2u; }
    const size_t kstep = (size_t)(BK * 2);
    const size_t hstep = (size_t)HALF * K * 2;
    const size_t tstep = 2 * hstep;
    const unsigned ldsw = (unsigned)wid * 1024u;
    const int aoff = lds_byte(wr * 64 + fr, fq * 8), boff = lds_byte(wc * 32 + fr, fq * 8);
#define PG8_SA(b, h) (((b) * 2 + (h)) * HTB)
#define PG8_SB(b, h) ((4 + (b) * 2 + (h)) * HTB)
#define PG8_STAGE(bufoff, gbase, voff) do { _Pragma("unroll") for (int _i = 0; _i < 2; ++_i) \
        __builtin_amdgcn_global_load_lds((const unsigned*)((const char*)(gbase) + (voff)[_i]), (LAS unsigned*)(lds + (bufoff) + ldsw + _i * 8192), 16, 0, 0); } while (0)
#define PG8_LDA(dst, b, h) do { _Pragma("unroll") for (int m = 0; m < 4; ++m) _Pragma("unroll") for (int k = 0; k < 2; ++k) dst[m][k] = *(const LAS bf16x8*)(lds + PG8_SA(b, h) + aoff + m * 2048 + k * 1024); } while (0)
#define PG8_LDB(dst, b, h) do { _Pragma("unroll") for (int n = 0; n < 2; ++n) _Pragma("unroll") for (int k = 0; k < 2; ++k) dst[n][k] = *(const LAS bf16x8*)(lds + PG8_SB(b, h) + boff + n * 2048 + k * 1024); } while (0)
#define PG8_MMA(ai, bj, At, Bt) do { __builtin_amdgcn_s_setprio(1); _Pragma("unroll") for (int m = 0; m < 4; ++m) _Pragma("unroll") for (int n = 0; n < 2; ++n) _Pragma("unroll") for (int k = 0; k < 2; ++k) \
        acc[ai][bj][m][n] = __builtin_amdgcn_mfma_f32_16x16x32_bf16(Bt[n][k], At[m][k], acc[ai][bj][m][n], 0, 0, 0); __builtin_amdgcn_s_setprio(0); } while (0)
#define PG8_WAIT_V(n) asm volatile("s_waitcnt vmcnt(" #n ")" ::: "memory")
#define PG8_WAIT_L(n) asm volatile("s_waitcnt lgkmcnt(" #n ")" ::: "memory")
#define PG8_BAR __builtin_amdgcn_s_barrier()
#define PG8_SCHED __builtin_amdgcn_sched_barrier(0)
    Unit cur, nxt; int ui = 0;
    if (!S.next(0, cur)) return;
    f32x4 acc[2][2][4][2];
#pragma unroll
    for (int a = 0; a < 2; ++a)
#pragma unroll
        for (int b = 0; b < 2; ++b)
#pragma unroll
            for (int m = 0; m < 4; ++m)
#pragma unroll
                for (int n = 0; n < 2; ++n) acc[a][b][m][n] = (f32x4){0.f, 0.f, 0.f, 0.f};
    bf16x8 At[4][2], B0[2][2], B1[2][2];
    const char* cA = (const char*)g.A + (size_t)cur.pm * tstep; const char* cB = (const char*)g.Bt + (size_t)cur.pn * tstep;
    PG8_STAGE(PG8_SB(0, 0), cB, voffB); PG8_STAGE(PG8_SA(0, 0), cA, voffA); PG8_STAGE(PG8_SB(0, 1), cB + hstep, voffB); PG8_STAGE(PG8_SA(0, 1), cA + hstep, voffA);
    if (wr == 1) PG8_BAR;
    PG8_WAIT_V(4); PG8_BAR;
    PG8_STAGE(PG8_SB(1, 0), cB + kstep, voffB); PG8_STAGE(PG8_SA(1, 0), cA + kstep, voffA); PG8_STAGE(PG8_SB(1, 1), cB + hstep + kstep, voffB);
    PG8_WAIT_V(6); PG8_BAR;
    for (;;) {
        const bool has_next = S.next(ui + 1, nxt);
        const char* nA = has_next ? (const char*)g.A + (size_t)nxt.pm * tstep : cA; const char* nB = has_next ? (const char*)g.Bt + (size_t)nxt.pn * tstep : cB;
        for (int t = 0; t < nt; t += 2) {
            const bool last = (t == nt - 2);
            const char* a1 = cA + (size_t)(t + 1) * kstep;
            const char* a2 = last ? nA : cA + (size_t)(t + 2) * kstep; const char* b2 = last ? nB : cB + (size_t)(t + 2) * kstep;
            const char* a3 = a2 + kstep; const char* b3 = b2 + kstep;
            PG8_LDB(B0, 0, 0); PG8_SCHED; PG8_LDA(At, 0, 0); PG8_STAGE(PG8_SA(1, 1), a1 + hstep, voffA);
            PG8_WAIT_L(8); PG8_BAR; PG8_WAIT_L(0); PG8_MMA(0, 0, At, B0); PG8_BAR; PG8_SCHED;
            PG8_LDB(B1, 0, 1); PG8_STAGE(PG8_SB(0, 0), b2, voffB);
            PG8_BAR; PG8_WAIT_L(0); PG8_MMA(0, 1, At, B1); PG8_BAR;
            PG8_LDA(At, 0, 1); PG8_STAGE(PG8_SA(0, 0), a2, voffA);
            PG8_BAR; PG8_WAIT_L(0); PG8_MMA(1, 0, At, B0); PG8_BAR; PG8_SCHED;
            PG8_STAGE(PG8_SB(0, 1), b2 + hstep, voffB);
            PG8_WAIT_V(6); PG8_BAR; PG8_MMA(1, 1, At, B1); PG8_BAR;
            PG8_LDB(B0, 1, 0); PG8_SCHED; PG8_LDA(At, 1, 0); PG8_STAGE(PG8_SA(0, 1), a2 + hstep, voffA);
            PG8_WAIT_L(8); PG8_BAR; PG8_WAIT_L(0); PG8_MMA(0, 0, At, B0); PG8_BAR; PG8_SCHED;
            PG8_LDB(B1, 1, 1); PG8_STAGE(PG8_SB(1, 0), b3, voffB);
            PG8_BAR; PG8_WAIT_L(0); PG8_MMA(0, 1, At, B1); PG8_BAR;
            PG8_LDA(At, 1, 1); PG8_STAGE(PG8_SA(1, 0), a3, voffA);
            PG8_BAR; PG8_WAIT_L(0); PG8_MMA(1, 0, At, B0); PG8_BAR; PG8_SCHED;
            PG8_STAGE(PG8_SB(1, 1), b3 + hstep, voffB);
            PG8_WAIT_V(6); PG8_BAR; PG8_MMA(1, 1, At, B1); PG8_BAR;
        }
        E(acc, cur, wr, wc, fr, fq);
        if (!has_next) break;
#pragma unroll
        for (int a = 0; a < 2; ++a)
#pragma unroll
            for (int b = 0; b < 2; ++b)
#pragma unroll
                for (int m = 0; m < 4; ++m)
#pragma unroll
                    for (int n = 0; n < 2; ++n) acc[a][b][m][n] = (f32x4){0.f, 0.f, 0.f, 0.f};
        cur = nxt; cA = nA; cB = nB; ++ui;
    }
    PG8_WAIT_V(0);
    if (wr == 0) PG8_BAR;
    PG8_BAR;
#undef PG8_SA
#undef PG8_SB
#undef PG8_STAGE
#undef PG8_LDA
#undef PG8_LDB
#undef PG8_MMA
#undef PG8_WAIT_V
#undef PG8_WAIT_L
#undef PG8_BAR
#undef PG8_SCHED
}
}

struct EpiProj {
    static constexpr bool PERM = true;
    bf16_t* O; int ldc; LAS const float* rl; int pm0, pm1, pm2, pm3;
    __device__ __forceinline__ void operator()(const f32x4 (&acc)[2][2][4][2], const pg8::Unit& u, int wr, int wc, int fr, int fq) const {
        const int row0 = u.pm * 256 + wr * 64 + fr, col0 = u.pn * 256 + wc * 32 + 8 * fq;
        const int sel = u.pm == pm0 ? 0 : (u.pm == pm1 ? 1 : (u.pm == pm2 ? 2 : 3));
        LAS const float* rp = rl + sel * 256 + wr * 64 + fr;
#pragma unroll
        for (int ai = 0; ai < 2; ++ai)
#pragma unroll
            for (int m = 0; m < 4; ++m) {
                const int row = row0 + ai * 128 + m * 16;
                const float rstd = rp[ai * 128 + m * 16];
                bf16_t* rowp = O + (size_t)row * ldc + col0;
#pragma unroll
                for (int bj = 0; bj < 2; ++bj) {
                    const f32x4 v0 = acc[ai][bj][m][0] * rstd, v1 = acc[ai][bj][m][1] * rstd;
                    u32x4 w; w.x = cvt_pk_bf16(v0[0], v0[1]); w.y = cvt_pk_bf16(v0[2], v0[3]); w.z = cvt_pk_bf16(v1[0], v1[1]); w.w = cvt_pk_bf16(v1[2], v1[3]);
                    *(u32x4*)(rowp + bj * 128) = w;
                }
            }
    }
};
struct X8 { f32x4 lo, hi; };
template <bool FIRST> __device__ __forceinline__ X8 ld_x8(const float* __restrict__ s32, const bf16_t* __restrict__ s16, size_t o) {
    X8 r;
    if (FIRST) { r.lo = *(const f32x4*)(s32 + o); r.hi = *(const f32x4*)(s32 + o + 4); }
    else { const u32x4 u = *(const u32x4*)(s16 + o); r.lo = cvt4((u32x2){u.x, u.y}); r.hi = cvt4((u32x2){u.z, u.w}); }
    return r;
}
__device__ __forceinline__ void st_x8(bf16_t* p, f32x4 lo, f32x4 hi) { u32x4 w; w.x = cvt_pk_bf16(lo[0], lo[1]); w.y = cvt_pk_bf16(lo[2], lo[3]); w.z = cvt_pk_bf16(hi[0], hi[1]); w.w = cvt_pk_bf16(hi[2], hi[3]); *(u32x4*)p = w; }
template <bool FIRST>
__device__ __forceinline__ void epi_res_rows(const f32x4 (&acc)[2][2][4][2], const float* __restrict__ src32, const bf16_t* __restrict__ src16, bf16_t* __restrict__ Xb, float* __restrict__ ssqp,
                                             int row0, int col0, int slot, int fq) {
    if constexpr (FIRST) {
#pragma unroll
        for (int ai = 0; ai < 2; ++ai) {
            X8 x[4][2];
#pragma unroll
            for (int m = 0; m < 4; ++m)
#pragma unroll
                for (int bj = 0; bj < 2; ++bj) x[m][bj] = ld_x8<true>(src32, src16, (size_t)(row0 + ai * 128 + m * 16) * 1024 + col0 + bj * 128);
#pragma unroll
            for (int m = 0; m < 4; ++m) {
                const int row = row0 + ai * 128 + m * 16;
                float part = 0.f;
#pragma unroll
                for (int bj = 0; bj < 2; ++bj) {
                    const f32x4 lo = x[m][bj].lo + acc[ai][bj][m][0], hi = x[m][bj].hi + acc[ai][bj][m][1];
                    st_x8(Xb + (size_t)row * 1024 + col0 + bj * 128, lo, hi);
                    part += dot4(lo, lo) + dot4(hi, hi);
                }
                part += __shfl_xor(part, 16); part += __shfl_xor(part, 32);
                if (fq == 0) ssqp[(size_t)row * 16 + slot] = part;
            }
        }
    } else {
        u32x4 xr[2][4][2];
#pragma unroll
        for (int ai = 0; ai < 2; ++ai)
#pragma unroll
            for (int m = 0; m < 4; ++m)
#pragma unroll
                for (int bj = 0; bj < 2; ++bj) xr[ai][m][bj] = *(const u32x4*)(src16 + (size_t)(row0 + ai * 128 + m * 16) * 1024 + col0 + bj * 128);
#pragma unroll
        for (int ai = 0; ai < 2; ++ai)
#pragma unroll
            for (int m = 0; m < 4; ++m) {
                const int row = row0 + ai * 128 + m * 16;
                float part = 0.f;
#pragma unroll
                for (int bj = 0; bj < 2; ++bj) {
                    const u32x4 u = xr[ai][m][bj];
                    const f32x4 lo = cvt4((u32x2){u.x, u.y}) + acc[ai][bj][m][0], hi = cvt4((u32x2){u.z, u.w}) + acc[ai][bj][m][1];
                    st_x8(Xb + (size_t)row * 1024 + col0 + bj * 128, lo, hi);
                    part += dot4(lo, lo) + dot4(hi, hi);
                }
                part += __shfl_xor(part, 16); part += __shfl_xor(part, 32);
                if (fq == 0) ssqp[(size_t)row * 16 + slot] = part;
            }
    }
}
struct EpiRes {
    static constexpr bool PERM = true;
    const float* xp; const float* xs; bf16_t* Xb; float* ssq_next;
    __device__ __forceinline__ void operator()(const f32x4 (&acc)[2][2][4][2], const pg8::Unit& u, int wr, int wc, int fr, int fq) const {
        const int row0 = u.pm * 256 + wr * 64 + fr, col0 = u.pn * 256 + wc * 32 + 8 * fq;
        if (xp) epi_res_rows<true>(acc, row0 < NTP ? xp : xs - (size_t)NTP * 1024, nullptr, Xb, ssq_next, row0, col0, u.pn * 4 + wc, fq);
        else epi_res_rows<false>(acc, nullptr, Xb, Xb, ssq_next, row0, col0, u.pn * 4 + wc, fq);
    }
};

template <bool FIRST>
__device__ __forceinline__ void res_sample_tile(const Ctx cx, const bf16_t* __restrict__ A, const bf16_t* __restrict__ Bt, const float* __restrict__ xs, bf16_t* __restrict__ Xb, float* __restrict__ ssqp, int tile) {
    const int tid = cx.tid, wid = tid >> 6, lane = tid & 63, fr = lane & 15, fq = lane >> 4;
    const int tm = tile >> 3, tn = tile & 7;
    const int r0 = NTP + tm * 64 + (wid & 3) * 16, c0 = tn * 128 + (wid >> 2) * 64;
    const bf16_t* ap = A + (size_t)(r0 + fr) * 1024 + fq * 8;
    const bf16_t* bp = Bt + (size_t)(c0 + fr) * 1024 + fq * 8;
    f32x4 acc[4];
#pragma unroll
    for (int nt = 0; nt < 4; ++nt) acc[nt] = (f32x4){0.f, 0.f, 0.f, 0.f};
#pragma unroll 8
    for (int ks = 0; ks < 32; ++ks) {
        const bf16x8 af = *(const bf16x8*)(ap + ks * 32);
#pragma unroll
        for (int nt = 0; nt < 4; ++nt) {
            const bf16x8 bf = *(const bf16x8*)(bp + (size_t)nt * 16 * 1024 + ks * 32);
            acc[nt] = __builtin_amdgcn_mfma_f32_16x16x32_bf16(bf, af, acc[nt], 0, 0, 0);
        }
    }
    const int row = r0 + fr;
    float part = 0.f;
#pragma unroll
    for (int nt = 0; nt < 4; ++nt) {
        const int col = c0 + nt * 16 + fq * 4;
        const f32x4 xo = FIRST ? *(const f32x4*)(xs + (size_t)(row - NTP) * 1024 + col) : ld_bf4(Xb + (size_t)row * 1024 + col);
        const f32x4 v = xo + acc[nt];
        st_bf4(Xb + (size_t)row * 1024 + col, v);
        part += dot4(v, v);
    }
    part += __shfl_xor(part, 16); part += __shfl_xor(part, 32);
    if (fq == 0) ssqp[(size_t)row * 16 + (c0 >> 6)] = part;
}

struct TrJob { const float* src; int ld, col0, k0; bf16_t* dst; int Ktot, drow0; const float* scale; bool zero; };
__device__ __forceinline__ TrJob tr_decode(const Params& p, const Ctx cx, int job) {
    TrJob J; J.zero = false; J.scale = nullptr;
    int j = job;
    if (j < 2176) {
        const int i = j / 1088, r = j % 1088, nt = r / 16, kt = r % 16, n0 = nt * 64;
        int col0 = 0;
        if (n0 < 2048) col0 = n0; else if (n0 < 2560) col0 = 3712 + (n0 - 2048); else if (n0 < 4224) col0 = 2048 + (n0 - 2560); else J.zero = true;
        J.src = PIN(I_WINE) + (size_t)i * 1024 * 4224; J.ld = 4224; J.col0 = col0; J.k0 = kt * 64; J.dst = (bf16_t*)(PWS + WS_WINE) + (size_t)i * 4352 * 1024; J.Ktot = 1024; J.drow0 = n0; J.scale = PIN(I_NORMW) + (2 * i) * 1024;
        return J;
    }
    j -= 2176;
    if (j < 512) { const int i = j / 256, r = j % 256, nt = r / 16, kt = r % 16;
        J.src = PIN(I_WOUTE) + (size_t)i * 1024 * 1024; J.ld = 1024; J.col0 = nt * 64; J.k0 = kt * 64; J.dst = (bf16_t*)(PWS + WS_WOUTE) + (size_t)i * 1024 * 1024; J.Ktot = 1024; J.drow0 = nt * 64; return J; }
    j -= 512;
    if (j < 1280) { const int i = j / 640, r = j % 640, nt = r / 16, kt = r % 16;
        J.src = PIN(I_WINO) + (size_t)i * 1024 * 2560; J.ld = 2560; J.col0 = nt * 64; J.k0 = kt * 64; J.dst = (bf16_t*)(PWS + WS_WINO) + (size_t)i * 2560 * 1024; J.Ktot = 1024; J.drow0 = nt * 64; J.scale = PIN(I_NORMW) + (2 * i + 1) * 1024; return J; }
    j -= 1280;
    if (j < 512) { const int i = j / 256, r = j % 256, nt = r / 16, kt = r % 16;
        J.src = PIN(I_WOUTO) + (size_t)i * 1024 * 1024; J.ld = 1024; J.col0 = nt * 64; J.k0 = kt * 64; J.dst = (bf16_t*)(PWS + WS_WOUTO) + (size_t)i * 1024 * 1024; J.Ktot = 1024; J.drow0 = nt * 64; return J; }
    j -= 512;
    if (j < 16) { const int i = j / 8, nt = j % 8;
        J.src = PIN(I_W2) + (size_t)i * 64 * 512; J.ld = 512; J.col0 = nt * 64; J.k0 = 0; J.dst = (bf16_t*)(PWS + WS_W2T) + (size_t)i * 512 * 64; J.Ktot = 64; J.drow0 = nt * 64; return J; }
    j -= 16;
    if (j < 16) { const int i = j / 8, nt = j % 8;
        J.src = PIN(I_A2) + (size_t)i * 64 * 512; J.ld = 512; J.col0 = nt * 64; J.k0 = 0; J.dst = (bf16_t*)(PWS + WS_A2T) + (size_t)i * 512 * 64; J.Ktot = 64; J.drow0 = nt * 64; return J; }
    j -= 16;
    { const int ig = j / 4, r = j % 4, nt = r / 2, kt = r % 2;
        J.src = PIN(I_POOLW) + (size_t)ig * 128 * 128; J.ld = 128; J.col0 = nt * 64; J.k0 = kt * 64; J.dst = (bf16_t*)(PWS + WS_POOLWT) + (size_t)ig * 128 * 128; J.Ktot = 128; J.drow0 = nt * 64; }
    return J;
}
__device__ __forceinline__ void tr_load(const TrJob& J, int tid, f32x4& va, f32x4& vb) {
    const int nn = (tid & 15) * 4, ka = tid >> 4, kb = ka + 32;
    va = (f32x4){0.f, 0.f, 0.f, 0.f}; vb = va;
    if (!J.zero) {
        va = *(const f32x4*)(J.src + (size_t)(J.k0 + ka) * J.ld + J.col0 + nn); vb = *(const f32x4*)(J.src + (size_t)(J.k0 + kb) * J.ld + J.col0 + nn);
        if (J.scale) { va = va * J.scale[J.k0 + ka]; vb = vb * J.scale[J.k0 + kb]; }
    }
}

__device__ void phase_prepass(const Params& p, const Ctx cx, LAS unsigned char* lds) {
    LAS float* T = (LAS float*)lds;
    const int tid = cx.tid;
    {
        int job = cx.bid;
        f32x4 va = (f32x4){0.f, 0.f, 0.f, 0.f}, vb = va;
        if (job < 4544) { const TrJob J0 = tr_decode(p, cx, job); tr_load(J0, tid, va, vb); }
        for (; job < 4544; job += cx.nblk) {
            f32x4 na = va, nb = vb;
            if (job + (int)cx.nblk < 4544) { const TrJob Jn = tr_decode(p, cx, job + (int)cx.nblk); tr_load(Jn, tid, na, nb); }
            {
                const int nn = (tid & 15) * 4, ka = tid >> 4, kb = ka + 32;
                T[ka * 65 + nn] = va[0]; T[ka * 65 + nn + 1] = va[1]; T[ka * 65 + nn + 2] = va[2]; T[ka * 65 + nn + 3] = va[3];
                T[kb * 65 + nn] = vb[0]; T[kb * 65 + nn + 1] = vb[1]; T[kb * 65 + nn + 2] = vb[2]; T[kb * 65 + nn + 3] = vb[3];
            }
            __syncthreads();
            {
                const TrJob J = tr_decode(p, cx, job);
                const int n = tid >> 3, kc = (tid & 7) * 8;
                u32x4 w;
                w.x = cvt_pk_bf16(T[(kc + 0) * 65 + n], T[(kc + 1) * 65 + n]); w.y = cvt_pk_bf16(T[(kc + 2) * 65 + n], T[(kc + 3) * 65 + n]);
                w.z = cvt_pk_bf16(T[(kc + 4) * 65 + n], T[(kc + 5) * 65 + n]); w.w = cvt_pk_bf16(T[(kc + 6) * 65 + n], T[(kc + 7) * 65 + n]);
                *(u32x4*)(J.dst + (size_t)(J.drow0 + n) * J.Ktot + J.k0 + kc) = w;
            }
            __syncthreads();
            va = na; vb = nb;
        }
    }
    const int gtid = cx.bid * 512 + tid, gthreads = cx.nblk * 512;
    for (int e = gtid; e < 8 * 128 * 128; e += gthreads) {
        const int s = e & 127, t = (e >> 7) & 127;
        ((bf16_t*)(PWS + WS_SPW))[e] = (s <= t) ? (bf16_t)(cvt_pk_bf16(PIN(I_SPW)[e], 0.f) & 0xffffu) : (bf16_t)0;
    }
    const int wid = tid >> 6, lane = tid & 63;
    for (int row0 = cx.bid * 8 + wid; row0 < NTOK; row0 += cx.nblk * 8 * 3) {
        f32x4 v[3][4];
#pragma unroll
        for (int r = 0; r < 3; ++r) {
            const int row = row0 + r * cx.nblk * 8; const int rr = row < NTOK ? row : row0;
            const float* src = rr < NTP ? PIN(I_XP) + (size_t)rr * 1024 : PIN(I_XS) + (size_t)(rr - NTP) * 1024;
#pragma unroll
            for (int i = 0; i < 4; ++i) v[r][i] = *(const f32x4*)(src + i * 256 + lane * 4);
        }
#pragma unroll
        for (int r = 0; r < 3; ++r) {
            const int row = row0 + r * cx.nblk * 8;
            if (row < NTOK) {
                bf16_t* dst = (bf16_t*)(PWS + WS_XB) + (size_t)row * 1024;
                float ss = 0.f;
#pragma unroll
                for (int i = 0; i < 4; ++i) { ss += dot4(v[r][i], v[r][i]); st_bf4(dst + i * 256 + lane * 4, v[r][i]); }
#pragma unroll
                for (int o = 32; o >= 1; o >>= 1) ss += __shfl_xor(ss, o);
                if (lane < 16) ((float*)(PWS + WS_SSQ))[(size_t)row * 16 + lane] = (lane == 0) ? ss : 0.f;
            }
        }
    }
}

__device__ __forceinline__ f32x4 shift4(const bf16_t* cur, bool hp, const float* st, int col, const float* mu) {
    const f32x4 q = ld_bf4(cur + col);
    f32x4 pv;
    if (hp) pv = ld_bf4(cur - LDB + col); else if (st) pv = *(const f32x4*)(st + col); else pv = (f32x4){0.f, 0.f, 0.f, 0.f};
    const f32x4 m = *(const f32x4*)(mu + col);
    return q + m * (pv - q);
}

__device__ void phase_even_prep(const Params& p, const Ctx cx, int pair, LAS unsigned char* lds) {
    const int tid = cx.tid, wid = tid >> 6, lane = tid & 63, fr = lane & 15, fq = lane >> 4;
    const bf16_t* PB = (const bf16_t*)(PWS + WS_PROJB);
    float* Wdec = (float*)(PWS + WS_WDEC);
    bf16_t* Aa = (bf16_t*)(PWS + WS_AA);
    bf16_t* Ycat = (bf16_t*)(PWS + WS_YCAT);
    const float* mu_ = PIN(I_MU) + pair * 1664;
    const float* w0_ = PIN(I_W0) + pair * 512; const float* a0_ = PIN(I_A0) + pair * 512;
    const float* k_a_ = PIN(I_KA) + pair * 512; const float* r_k_ = PIN(I_RK) + pair * 512;
    constexpr int RS = 3344;
    constexpr int TB = 17 * RS;
    constexpr int NCH = 17 * 208;
    const int h = wid;
    bf16x8 wfr[4][2], afr[4][2];
    {
        const bf16_t* W2T = (const bf16_t*)(PWS + WS_W2T) + (size_t)pair * 512 * 64;
        const bf16_t* A2T = (const bf16_t*)(PWS + WS_A2T) + (size_t)pair * 512 * 64;
#pragma unroll
        for (int nt = 0; nt < 4; ++nt)
#pragma unroll
            for (int ks = 0; ks < 2; ++ks) {
                wfr[nt][ks] = *(const bf16x8*)(W2T + (size_t)(h * 64 + nt * 16 + fr) * 64 + ks * 32 + fq * 8);
                afr[nt][ks] = *(const bf16x8*)(A2T + (size_t)(h * 64 + nt * 16 + fr) * 64 + ks * 32 + fq * 8);
            }
    }
    constexpr int TBD = 56 * 1024;
    const int widu = __builtin_amdgcn_readfirstlane(tid >> 6);
#define PREP_DMA(tile_, b_, lane_) do { _Pragma("unroll") for (int i_ = 0; i_ < 7; ++i_) { const int k_ = widu * 7 + i_, q_ = k_ * 64 + (lane_); \
            int lr_ = q_ / 209, cc_ = q_ - lr_ * 209; if (lr_ > 16) { lr_ = 16; cc_ = 0; } if (cc_ > 207) cc_ = 0; \
            int gr_ = (tile_) * 16 - 1 + lr_; gr_ = gr_ < 0 ? 0 : gr_; \
            __builtin_amdgcn_global_load_lds((const unsigned*)(PB + (size_t)gr_ * LDB + cc_ * 8), (LAS unsigned*)(lds + (b_) * TBD + k_ * 1024), 16, 0, 0); } } while (0)
    LAS float* CL = (LAS float*)(lds + 2 * TBD);
    {
        const float f0 = mu_[tid], f1 = mu_[tid + 512], f2 = mu_[tid + 1024], f3 = tid < 128 ? mu_[tid + 1536] : 0.f;
        const float f4 = w0_[tid], f5 = a0_[tid], f6 = k_a_[tid], f7 = r_k_[tid];
        CL[tid] = f0; CL[tid + 512] = f1; CL[tid + 1024] = f2; if (tid < 128) CL[tid + 1536] = f3;
        CL[1664 + tid] = f4; CL[2176 + tid] = f5; CL[2688 + tid] = f6; CL[3200 + tid] = f7;
    }
    int buf = 0;
    if ((int)cx.bid < NTOK / 16) PREP_DMA((int)cx.bid, 0, tid & 63);
    asm volatile("s_waitcnt vmcnt(0)" ::: "memory");
    __syncthreads();
    for (int tile = cx.bid; tile < NTOK / 16; tile += cx.nblk) {
        int zz; asm volatile("v_mov_b32 %0, 0" : "=v"(zz));
        const int tidv = tid + zz, fr = (tidv & 15), fq = (tidv >> 4) & 3;
        if (tile + (int)cx.nblk < NTOK / 16) PREP_DMA(tile + (int)cx.nblk, buf ^ 1, tidv & 63);
        {
            const int row = tile * 16 + fr;
            const bool samp = row >= NTP;
            int b, t; if (!samp) { b = row >> 11; t = row & 2047; } else { const int q = row - NTP; b = q >> 3; t = q & 7; }
            const bool hp = t > 0;
            const float* st = samp ? PIN(I_SSHIFT) + ((size_t)pair * 128 + b) * 1664 : nullptr;
            LAS const float* mu = CL; LAS const float* w0 = CL + 1664; LAS const float* a0 = CL + 2176; LAS const float* k_a = CL + 2688; LAS const float* r_k = CL + 3200;
            LAS const unsigned char* curL = lds + buf * TBD + (fr + 1) * RS;
            LAS const unsigned char* prvL = lds + buf * TBD + fr * RS;
            auto sh4 = [&](int col) -> f32x4 {
                const f32x4 q = cvt4(*(LAS const u32x2*)(curL + col * 2));
                f32x4 pv;
                if (hp) pv = cvt4(*(LAS const u32x2*)(prvL + col * 2)); else if (st) pv = *(const f32x4*)(st + col); else pv = (f32x4){0.f, 0.f, 0.f, 0.f};
                const f32x4 m = *(LAS const f32x4*)(mu + col);
                return q + m * (pv - q);
            };
            bf16x8 Aw[2], Al[2];
#pragma unroll
            for (int ks = 0; ks < 2; ++ks) {
                const int cw = 1536 + ks * 32 + fq * 8, ca = 1600 + ks * 32 + fq * 8;
                const f32x4 w_lo = sh4(cw), w_hi = sh4(cw + 4), a_lo = sh4(ca), a_hi = sh4(ca + 4);
                u32x4 pw, pa;
                float th[8];
#pragma unroll
                for (int j = 0; j < 4; ++j) { th[j] = 2.0f * sigmoidf_(2.0f * w_lo[j]) - 1.0f; th[4 + j] = 2.0f * sigmoidf_(2.0f * w_hi[j]) - 1.0f; }
                pw.x = cvt_pk_bf16(th[0], th[1]); pw.y = cvt_pk_bf16(th[2], th[3]); pw.z = cvt_pk_bf16(th[4], th[5]); pw.w = cvt_pk_bf16(th[6], th[7]);
                pa.x = cvt_pk_bf16(a_lo[0], a_lo[1]); pa.y = cvt_pk_bf16(a_lo[2], a_lo[3]); pa.z = cvt_pk_bf16(a_hi[0], a_hi[1]); pa.w = cvt_pk_bf16(a_hi[2], a_hi[3]);
                Aw[ks] = __builtin_bit_cast(bf16x8, pw); Al[ks] = __builtin_bit_cast(bf16x8, pa);
            }
            float bon = 0.f;
#pragma unroll
            for (int nt = 0; nt < 4; ++nt) {
                f32x4 lw = (f32x4){0.f, 0.f, 0.f, 0.f}, la = (f32x4){0.f, 0.f, 0.f, 0.f};
#pragma unroll
                for (int ks = 0; ks < 2; ++ks) {
                    lw = __builtin_amdgcn_mfma_f32_16x16x32_bf16(wfr[nt][ks], Aw[ks], lw, 0, 0, 0);
                    la = __builtin_amdgcn_mfma_f32_16x16x32_bf16(afr[nt][ks], Al[ks], la, 0, 0, 0);
                }
                const int ch = h * 64 + nt * 16 + fq * 4;
                const f32x4 r4 = sh4(ch), k4 = sh4(512 + ch);
                const f32x4 w04 = *(LAS const f32x4*)(w0 + ch), a04 = *(LAS const f32x4*)(a0 + ch), ka4 = *(LAS const f32x4*)(k_a + ch), rk4 = *(LAS const f32x4*)(r_k + ch);
                f32x4 dec, av;
#pragma unroll
                for (int j = 0; j < 4; ++j) {
                    const float z_ = -(w04[j] + lw[j]);
                    dec[j] = __expf(-0.60653066f * __builtin_amdgcn_rcpf(1.0f + __expf(z_)));
                    av[j] = sigmoidf_(a04[j] + la[j]);
                    const float kp = k4[j] * (1.0f + (av[j] - 1.0f) * ka4[j]);
                    bon += r4[j] * kp * rk4[j];
                }
                *(f32x4*)(Wdec + (size_t)row * 512 + ch) = dec;
                st_bf4(Aa + (size_t)row * 512 + ch, av);
            }
            bon += __shfl_xor(bon, 16); bon += __shfl_xor(bon, 32);
#pragma unroll
            for (int nt = 0; nt < 4; ++nt) { const int ch = h * 64 + nt * 16 + fq * 4; st_bf4(Ycat + (size_t)row * 1024 + 512 + ch, sh4(1024 + ch) * bon); }
        }
        asm volatile("s_waitcnt vmcnt(0)" ::: "memory");
        __syncthreads();
        buf ^= 1;
    }
#undef PREP_DMA
    const int gtid = cx.bid * 512 + tid, gthreads = cx.nblk * 512;
    for (int e = gtid; e < 136 * 1664; e += gthreads) {
        const int sr = e / 1664, c = e % 1664;
        if (sr < 8) POUT[O_SHIFTP + ((size_t)pair * 8 + sr) * 1664 + c] = bf2f(PB[(size_t)(sr * 2048 + 2047) * LDB + c]);
        else { const int b = sr - 8; POUT[O_SHIFTS + ((size_t)pair * 128 + b) * 1664 + c] = bf2f(PB[(size_t)(NTP + b * 8 + 7) * LDB + c]); }
    }
}

typedef float f32x2 __attribute__((ext_vector_type(2)));
template <bool RED = true>
__device__ __forceinline__ void scan_step(f32x4& S, const f32x4 w, const f32x4 k, const f32x4 kk, const f32x4 nb, const f32x4 r, const float v, float& y) {
    const f32x2 S01 = {S[0], S[1]}, S23 = {S[2], S[3]};
    f32x2 pp = S01 * (f32x2){kk[0], kk[1]};
    pp = S23 * (f32x2){kk[2], kk[3]} + pp;
    float pd = pp[0] + pp[1];
    const f32x2 vv = {v, v};
    const f32x2 t01 = S01 * (f32x2){w[0], w[1]} + (f32x2){k[0], k[1]} * vv;
    const f32x2 t23 = S23 * (f32x2){w[2], w[3]} + (f32x2){k[2], k[3]} * vv;
    pd = allsum16(pd);
    const f32x2 pdv = {pd, pd};
    const f32x2 n01 = (f32x2){nb[0], nb[1]} * pdv + t01, n23 = (f32x2){nb[2], nb[3]} * pdv + t23;
    S = (f32x4){n01[0], n01[1], n23[0], n23[1]};
    f32x2 q = n01 * (f32x2){r[0], r[1]};
    q = n23 * (f32x2){r[2], r[3]} + q;
    y = RED ? allsum16(q[0] + q[1]) : (q[0] + q[1]);
}
__device__ __forceinline__ float reduce_scatter16(const float (&yp)[16], int cgi) {
    const bool b3 = cgi & 8, b2 = cgi & 4, b1 = cgi & 2, b0 = cgi & 1;
    float a[8], bq[4], c[2];
#pragma unroll
    for (int j = 0; j < 8; ++j) { const float keep = b3 ? yp[8 + j] : yp[j], send = b3 ? yp[j] : yp[8 + j]; a[j] = keep + dpp_f<0x128>(send); }
#pragma unroll
    for (int k = 0; k < 4; ++k) { const float keep = b2 ? a[4 + k] : a[k], send = b2 ? a[k] : a[4 + k]; bq[k] = keep + dpp_f<0x141>(send); }
#pragma unroll
    for (int m = 0; m < 2; ++m) { const float keep = b1 ? bq[2 + m] : bq[m], send = b1 ? bq[m] : bq[2 + m]; c[m] = keep + dpp_f<0x4E>(send); }
    const float keep = b0 ? c[1] : c[0], send = b0 ? c[0] : c[1];
    return keep + dpp_f<0xB1>(send);
}

__device__ void phase_scan(const Params& p, const Ctx cx, int pair, LAS unsigned char* lds) {
    const int tid = cx.tid, wid = tid >> 6, lane = tid & 63, rs = lane >> 4, cgi = lane & 15;
    const bf16_t* PB = (const bf16_t*)(PWS + WS_PROJB);
    const float* Wdec = (const float*)(PWS + WS_WDEC);
    const bf16_t* Aa = (const bf16_t*)(PWS + WS_AA);
    bf16_t* Y = (bf16_t*)(PWS + WS_Y);
    const float* mu = PIN(I_MU) + pair * 1664;
    const float* k_k = PIN(I_KK) + pair * 512; const float* k_a = PIN(I_KA) + pair * 512;
    {
        LAS float* vb = (LAS float*)lds + wid * 3072;
        for (int st = cx.bid * 8 + wid; st < 2048; st += cx.nblk * 8) {
            const int bh = st >> 1, half = st & 1, b = bh >> 3, h = bh & 7, ch = h * 64 + cgi * 4;
            const float* stp = PIN(I_SSHIFT) + ((size_t)pair * 128 + b) * 1664;
            const f32x4 kkc = *(const f32x4*)(k_k + ch), kac = *(const f32x4*)(k_a + ch);
            {
#pragma unroll
                for (int tt = 0; tt < 2; ++tt) {
                    const int t = rs + tt * 4;
                    const size_t row = NTP + b * 8 + t;
                    const bf16_t* cur = PB + row * LDB;
                    const f32x4 r = shift4(cur, t > 0, stp, ch, mu), k = shift4(cur, t > 0, stp, 512 + ch, mu), v = shift4(cur, t > 0, stp, 1024 + ch, mu);
                    const f32x4 a = ld_bf4(Aa + row * 512 + ch);
                    const f32x4 w = *(const f32x4*)(Wdec + row * 512 + ch);
                    const f32x4 kkv = k * kkc;
                    const float ss = allsum16(dot4(kkv, kkv));
                    const float inv = __builtin_amdgcn_rsqf(fmaxf(ss, 1e-24f));
                    const f32x4 kkn = kkv * inv;
                    LAS float* o = vb + t * 384 + cgi * 4;
                    *(LAS f32x4*)(o) = w; *(LAS f32x4*)(o + 64) = k * (1.0f + (a - 1.0f) * kac); *(LAS f32x4*)(o + 128) = kkn; *(LAS f32x4*)(o + 192) = -(kkn * a);
                    *(LAS f32x4*)(o + 256) = r; *(LAS f32x4*)(o + 320) = v;
                }
            }
            asm volatile("s_waitcnt lgkmcnt(0)" ::: "memory");
            __builtin_amdgcn_wave_barrier();
            const size_t so0 = ((((size_t)pair * 128 + b) * 8 + h) * 64 + half * 32 + rs) * 64 + cgi * 4;
            f32x4 Snext = *(const f32x4*)(PIN(I_SWKV) + so0);
#pragma unroll 1
            for (int rq = 0; rq < 8; ++rq) {
                const int ri = half * 32 + rq * 4 + rs;
                const size_t so = so0 + (size_t)rq * 256;
                f32x4 S = Snext;
                if (rq + 1 < 8) Snext = *(const f32x4*)(PIN(I_SWKV) + so + 256);
                float ykeep = 0.f;
#pragma unroll
                for (int t = 0; t < 8; ++t) {
                    LAS const float* r0 = vb + t * 384 + cgi * 4;
                    float y; scan_step(S, *(LAS const f32x4*)(r0), *(LAS const f32x4*)(r0 + 64), *(LAS const f32x4*)(r0 + 128), *(LAS const f32x4*)(r0 + 192), *(LAS const f32x4*)(r0 + 256), vb[t * 384 + 320 + ri], y);
                    ykeep = (cgi == t) ? y : ykeep;
                }
                if (cgi < 8) Y[(size_t)(NTP + b * 8 + cgi) * 512 + h * 64 + ri] = (bf16_t)(cvt_pk_bf16(ykeep, 0.f) & 0xffffu);
                *(f32x4*)(POUT + O_WKVS + so) = S;
            }
            asm volatile("s_waitcnt lgkmcnt(0)" ::: "memory");
            __builtin_amdgcn_wave_barrier();
        }
    }
    __syncthreads();
    LAS float* rec = (LAS float*)lds;
    for (int pt = cx.bid; pt < 256; pt += cx.nblk) {
        const int xcd = pt & 7, slot = pt >> 3, bh = xcd * 8 + (slot >> 2), rg = slot & 3, b = bh >> 3, h = bh & 7;
        const int lt = tid - 256, ls = (lt >> 4) & 15, lcg = lt & 15, lch = h * 64 + lcg * 4;
        u32x2 qr = {0u, 0u}, qk = {0u, 0u}, qv = {0u, 0u}, pr = {0u, 0u}, pk = {0u, 0u}, pv = {0u, 0u}, qa = {0u, 0u};
        f32x4 qw = (f32x4){0.f, 0.f, 0.f, 0.f};
        f32x4 mur, muk, muv, kkc, kac;
        const int ri = rg * 16 + (wid & 3) * 4 + rs;
        f32x4 S = (f32x4){0.f, 0.f, 0.f, 0.f};
#define SCAN_ISSUE(c) do { const int t_ = (c) * 16 + ls; const size_t row_ = (size_t)b * 2048 + t_; const bf16_t* cur_ = PB + row_ * LDB; \
            qr = *(const u32x2*)(cur_ + lch); qk = *(const u32x2*)(cur_ + 512 + lch); qv = *(const u32x2*)(cur_ + 1024 + lch); \
            if (t_ > 0) { pr = *(const u32x2*)(cur_ - LDB + lch); pk = *(const u32x2*)(cur_ - LDB + 512 + lch); pv = *(const u32x2*)(cur_ - LDB + 1024 + lch); } \
            else { pr = (u32x2){0u, 0u}; pk = pr; pv = pr; } \
            qw = *(const f32x4*)(Wdec + row_ * 512 + lch); qa = *(const u32x2*)(Aa + row_ * 512 + lch); } while (0)
#define SCAN_PROCESS(buf) do { const f32x4 r0_ = cvt4(qr), k0_ = cvt4(qk), v0_ = cvt4(qv); \
            const f32x4 r_ = r0_ + mur * (cvt4(pr) - r0_), k_ = k0_ + muk * (cvt4(pk) - k0_), v_ = v0_ + muv * (cvt4(pv) - v0_), a_ = cvt4(qa); \
            const f32x4 kkv_ = k_ * kkc; const float ss_ = allsum16(dot4(kkv_, kkv_)); const float inv_ = __builtin_amdgcn_rsqf(fmaxf(ss_, 1e-24f)); \
            const f32x4 kkn_ = kkv_ * inv_; \
            LAS float* o_ = rec + (buf) * 6144 + ls * 384 + lcg * 4; \
            *(LAS f32x4*)(o_) = qw; *(LAS f32x4*)(o_ + 64) = k_ * (1.0f + (a_ - 1.0f) * kac); *(LAS f32x4*)(o_ + 128) = kkn_; *(LAS f32x4*)(o_ + 192) = -(kkn_ * a_); \
            *(LAS f32x4*)(o_ + 256) = r_; *(LAS f32x4*)(o_ + 320) = v_; } while (0)
        if (wid >= 4) {
            mur = *(const f32x4*)(mu + lch); muk = *(const f32x4*)(mu + 512 + lch); muv = *(const f32x4*)(mu + 1024 + lch);
            kkc = *(const f32x4*)(k_k + lch); kac = *(const f32x4*)(k_a + lch);
            SCAN_ISSUE(0); SCAN_PROCESS(0); SCAN_ISSUE(1);
        }
        __syncthreads();
        for (int c = 0; c < 128; ++c) {
            if (wid < 4) {
                LAS const float* rb = rec + (c & 1) * 6144 + cgi * 4;
                LAS const float* rv = rec + (c & 1) * 6144 + 320 + ri;
                float yp[16];
                f32x4 nw = *(LAS const f32x4*)(rb), nk = *(LAS const f32x4*)(rb + 64), nkk = *(LAS const f32x4*)(rb + 128), nb = *(LAS const f32x4*)(rb + 192), nr = *(LAS const f32x4*)(rb + 256);
                float nv = rv[0];
#pragma unroll
                for (int s = 0; s < 16; ++s) {
                    const f32x4 cw = nw, ck = nk, ckk = nkk, cb = nb, cr = nr; const float cv = nv;
                    if (s + 1 < 16) {
                        LAS const float* r1 = rb + (s + 1) * 384;
                        nw = *(LAS const f32x4*)(r1); nk = *(LAS const f32x4*)(r1 + 64); nkk = *(LAS const f32x4*)(r1 + 128); nb = *(LAS const f32x4*)(r1 + 192); nr = *(LAS const f32x4*)(r1 + 256);
                        nv = rv[(s + 1) * 384];
                    }
                    scan_step<false>(S, cw, ck, ckk, cb, cr, cv, yp[s]);
                }
                Y[((size_t)b * 2048 + c * 16 + cgi) * 512 + h * 64 + ri] = (bf16_t)(cvt_pk_bf16(reduce_scatter16(yp, cgi), 0.f) & 0xffffu);
            } else {
                if (c + 1 < 128) { SCAN_PROCESS((c + 1) & 1); if (c + 2 < 128) SCAN_ISSUE(c + 2); }
            }
            __syncthreads();
        }
        if (wid < 4) *(f32x4*)(POUT + O_WKVP + ((((size_t)pair * 8 + b) * 8 + h) * 64 + ri) * 64 + cgi * 4) = S;
#undef SCAN_ISSUE
#undef SCAN_PROCESS
    }
}

__device__ void phase_even_post(const Params& p, const Ctx cx, int pair) {
    const int gtid = cx.bid * 512 + cx.tid, gthreads = cx.nblk * 512;
    const bf16_t* PA = (const bf16_t*)(PWS + WS_R1);
    bf16_t* Ycat = (bf16_t*)(PWS + WS_YCAT);
    const bf16_t* Y = (const bf16_t*)(PWS + WS_Y);
    constexpr int NIT = NTOK * 128, UB = 4;
    const float* gn_g = PIN(I_GNG) + pair * 512; const float* gn_b = PIN(I_GNB) + pair * 512;
    for (int e0 = gtid; e0 < NIT; e0 += gthreads * UB) {
        f32x4 y[UB], bv[UB], bz[UB], gg[UB], gb[UB]; bool ok[UB];
#pragma unroll
        for (int u = 0; u < UB; ++u) {
            const int e = e0 + u * gthreads; ok[u] = e < NIT;
            const int ee = ok[u] ? e : e0; const int row = ee >> 7, ch = (ee & 127) * 4;
            y[u] = ld_bf4(Y + (size_t)row * 512 + ch);
            bv[u] = ld_bf4(Ycat + (size_t)row * 1024 + 512 + ch);
            bz[u] = ld_bf4(PA + (size_t)row * LDA + 2048 + ch);
            gg[u] = *(const f32x4*)(gn_g + ch); gb[u] = *(const f32x4*)(gn_b + ch);
        }
#pragma unroll
        for (int u = 0; u < UB; ++u) {
            const int e = e0 + u * gthreads;
            const int ee = ok[u] ? e : e0; const int row = ee >> 7, ch = (ee & 127) * 4;
            const float mean = allsum16(y[u][0] + y[u][1] + y[u][2] + y[u][3]) * (1.0f / 64.0f);
            const f32x4 d = y[u] - mean;
            const float var = allsum16(dot4(d, d)) * (1.0f / 64.0f);
            const float rstd = rsqrtf(var + 64e-5f);
            const f32x4 g = gg[u], bb = gb[u];
            f32x4 o;
#pragma unroll
            for (int j = 0; j < 4; ++j) o[j] = (d[j] * rstd * g[j] + bb[j] + bv[u][j]) * siluf_(bz[u][j]);
            if (ok[u]) st_bf4(Ycat + (size_t)row * 1024 + 512 + ch, o);
        }
    }
    const float* cw = PIN(I_CONVW) + pair * 3 * 512;
    constexpr int NRUN = (NTOK / 8) * 128;
    for (int e = gtid; e < NRUN; e += gthreads) {
        const int run = e >> 7, ch = (e & 127) * 4, row0 = run * 8;
        const bool samp = row0 >= NTP;
        int b, t0, T; if (!samp) { b = row0 >> 11; t0 = row0 & 2047; T = 2048; } else { b = (row0 - NTP) >> 3; t0 = 0; T = 8; }
        const bf16_t* base = PA + (size_t)row0 * LDA + ch;
        u32x2 rh[10], rc[10], rb[8], rz[8];
#pragma unroll
        for (int k = 0; k < 10; ++k) {
            const bool have = (k >= 2) || (t0 > 0);
            const bf16_t* pr = have ? base + (ptrdiff_t)(k - 2) * LDA : base;
            rh[k] = *(const u32x2*)(pr); rc[k] = *(const u32x2*)(pr + 1024);
        }
#pragma unroll
        for (int k = 0; k < 8; ++k) { rb[k] = *(const u32x2*)(base + (size_t)k * LDA + 512); rz[k] = *(const u32x2*)(base + (size_t)k * LDA + 1536); }
        const f32x4 k0 = *(const f32x4*)(cw + ch), k1 = *(const f32x4*)(cw + 512 + ch), k2 = *(const f32x4*)(cw + 1024 + ch);
        f32x4 um2, um1;
        if (t0 > 0) { um2 = cvt4(rc[0]) * cvt4(rh[0]); um1 = cvt4(rc[1]) * cvt4(rh[1]); }
        else if (samp) { const float* hist = PIN(I_SCONV) + ((size_t)pair * 128 + b) * 2 * 512 + ch; um2 = *(const f32x4*)(hist); um1 = *(const f32x4*)(hist + 512); }
        else { um2 = (f32x4){0.f, 0.f, 0.f, 0.f}; um1 = um2; }
#pragma unroll
        for (int k = 0; k < 8; ++k) {
            const f32x4 u0 = cvt4(rc[k + 2]) * cvt4(rh[k + 2]);
            const f32x4 conv = k0 * um2 + k1 * um1 + k2 * u0;
            const f32x4 ab = cvt4(rb[k]), az = cvt4(rz[k]);
            f32x4 o;
#pragma unroll
            for (int j = 0; j < 4; ++j) o[j] = ab[j] * conv[j] * siluf_(az[j]);
            const int row = row0 + k, t = t0 + k;
            st_bf4(Ycat + (size_t)row * 1024 + ch, o);
            if (t >= T - 2) {
                float* dst = samp ? POUT + O_CONVS + (((size_t)pair * 128 + b) * 2 + (t - (T - 2))) * 512 + ch : POUT + O_CONVP + (((size_t)pair * 8 + b) * 2 + (t - (T - 2))) * 512 + ch;
                *(f32x4*)dst = u0;
            }
            um2 = um1; um1 = u0;
        }
    }
}

template <int W>
__device__ __forceinline__ void pool_sample_run(const float* __restrict__ hist, const bf16_t* __restrict__ cur, LAS bf16_t* out) {
    f32x4 ext[23];
#pragma unroll
    for (int k = 0; k < 15; ++k) ext[k] = (k >= 16 - W) ? *(const f32x4*)(hist + (size_t)k * 512) : (f32x4){0.f, 0.f, 0.f, 0.f};
#pragma unroll
    for (int k = 0; k < 8; ++k) ext[15 + k] = ld_bf4(cur + (size_t)k * LDA);
    f32x4 sum = (f32x4){0.f, 0.f, 0.f, 0.f};
#pragma unroll
    for (int d = 0; d < W; ++d) sum += ext[15 - d];
#pragma unroll
    for (int t = 0; t < 8; ++t) {
        if (t > 0) sum += ext[15 + t] - ext[15 + t - W];
        const f32x4 pooled = sum * (1.0f / (float)W) - ext[15 + t];
        u32x2 u; u.x = cvt_pk_bf16(pooled[0], pooled[1]); u.y = cvt_pk_bf16(pooled[2], pooled[3]);
        *(LAS u32x2*)(out + t * 136) = u;
    }
}

__device__ void phase_odd_mixer(const Params& p, const Ctx cx, int pair, LAS unsigned char* lds) {
    const int tid = cx.tid, wid = tid >> 6, lane = tid & 63, fr = lane & 15, fq = lane >> 4;
    const bf16_t* PO = (const bf16_t*)(PWS + WS_R1);
    bf16_t* Ycat = (bf16_t*)(PWS + WS_YCAT);
    LAS bf16_t* LA = (LAS bf16_t*)lds;
    LAS bf16_t* LB = (LAS bf16_t*)(lds + 128 * 136 * 2);
    LAS float* stat = (LAS float*)(lds + 2 * 128 * 136 * 2);
    LAS float* LE = (LAS float*)(lds + 128 * 136 * 2);
    LAS bf16_t* LW = (LAS bf16_t*)(lds + 128 * 136 * 2 + 143 * 128 * 4);
    for (int di = 0; di < 8; ++di) {
        int tile, g0, ng;
        if (cx.nblk == 256) {
            if (di == 0) { tile = cx.bid >> 1; g0 = (cx.bid & 1) * 2; ng = 2; }
            else if (di == 1 && cx.bid < 32) { tile = 128 + (cx.bid >> 2); g0 = cx.bid & 3; ng = 1; }
            else break;
        } else { tile = cx.bid + di * cx.nblk; g0 = 0; ng = 4; if (tile >= 136) break; }
        const int r0 = tile * 128;
        const bool samp = r0 >= NTP;
        const int tl_ = tid >> 2, q_ = tid & 3;
        {
            const bf16_t* vr = PO + (size_t)(r0 + tl_) * LDA + 1536 + q_ * 128;
            float s_ = 0.f, ss = 0.f;
#pragma unroll
            for (int i = 0; i < 16; ++i) { const u32x4 raw = *(const u32x4*)(vr + i * 8); const f32x4 v0 = cvt4((u32x2){raw.x, raw.y}), v1 = cvt4((u32x2){raw.z, raw.w});
                s_ += (v0[0] + v0[1]) + (v0[2] + v0[3]) + (v1[0] + v1[1]) + (v1[2] + v1[3]); ss += dot4(v0, v0) + dot4(v1, v1); }
            s_ = allsum4(s_); ss = allsum4(ss);
            const float mean = s_ * (1.0f / 512.0f);
            const float var = fmaxf(ss * (1.0f / 512.0f) - mean * mean, 0.f);
            if (q_ == 0) { stat[tl_ * 2] = mean; stat[tl_ * 2 + 1] = rsqrtf(var + 1e-5f); }
        }
        LAS float* lnw = stat + 512;
        lnw[tid] = PIN(I_LNG)[pair * 512 + tid]; lnw[512 + tid] = PIN(I_LNB)[pair * 512 + tid];
        u32x2 rv[8]; u32x4 rw[4];
#define MIX_LOAD_G(gg) do { const bf16_t* vr_ = PO + (size_t)(r0 + tl_) * LDA + 1536 + (gg) * 128 + q_ * 32; \
            _Pragma("unroll") for (int i = 0; i < 8; ++i) rv[i] = *(const u32x2*)(vr_ + i * 4); \
            if (!samp) { const bf16_t* Ws_ = (const bf16_t*)(PWS + WS_SPW) + ((size_t)pair * 4 + (gg)) * 128 * 128; \
                _Pragma("unroll") for (int i = 0; i < 4; ++i) { const int e = tid + i * 512; rw[i] = *(const u32x4*)(Ws_ + (e >> 4) * 128 + (e & 15) * 8); } } } while (0)
        MIX_LOAD_G(g0);
        __syncthreads();
#pragma unroll 1
        for (int g = g0; g < g0 + ng; ++g) {
            u32x2 ur[8], dzr[8];
#pragma unroll
            for (int nt = 0; nt < 8; ++nt) { const size_t o_ = (size_t)(r0 + wid * 16 + fr) * LDA + g * 128 + nt * 16 + fq * 4; ur[nt] = *(const u32x2*)(PO + o_ + 1024); dzr[nt] = *(const u32x2*)(PO + o_ + 2048); }
            {
                const int row = r0 + tl_;
                const float mean = stat[tl_ * 2], rstd = stat[tl_ * 2 + 1];
                LAS const float* lg = lnw + g * 128 + q_ * 32; LAS const float* lb = lnw + 512 + g * 128 + q_ * 32;
#pragma unroll
                for (int i = 0; i < 8; ++i) {
                    const f32x4 v = cvt4(rv[i]);
                    const f32x4 vn = (v - mean) * rstd * *(LAS const f32x4*)(lg + i * 4) + *(LAS const f32x4*)(lb + i * 4);
                    if (samp) *(f32x4*)(POUT + O_CHUNKV + ((size_t)pair * 1024 + (row - NTP)) * 512 + g * 128 + q_ * 32 + i * 4) = vn;
                    {
                        const float p0 = dpp_f<0x104>(vn[0]), p1 = dpp_f<0x104>(vn[1]);
                        const float p2 = dpp_f<0x114>(vn[2]), p3 = dpp_f<0x114>(vn[3]);
                        const bool odd = tl_ & 1;
                        const unsigned wa = odd ? cvt_pk_bf16(p2, vn[2]) : cvt_pk_bf16(vn[0], p0);
                        const unsigned wb = odd ? cvt_pk_bf16(p3, vn[3]) : cvt_pk_bf16(vn[1], p1);
                        const int cb = q_ * 32 + i * 4 + (odd ? 2 : 0), tb = tl_ & ~1;
                        *(LAS unsigned*)(LB + (cb) * 136 + tb) = wa;
                        *(LAS unsigned*)(LB + (cb + 1) * 136 + tb) = wb;
                    }
                }
            }
            if (!samp) {
#pragma unroll
                for (int i = 0; i < 4; ++i) { const int e = tid + i * 512; *(LAS u32x4*)(LA + (e >> 4) * 136 + (e & 15) * 8) = rw[i]; }
            } else {
                const float* Wsrc = PIN(I_SPW) + ((size_t)pair * 4 + g) * 128 * 128;
                LAS float* w8 = stat + 256;
                if (tid < 64) w8[tid] = Wsrc[(tid >> 3) * 128 + (tid & 7)];
                __syncthreads();
                for (int e = tid; e < 128 * 128; e += 512) { const int t = e >> 7, s2 = e & 127;
                    const float v = ((t >> 3) == (s2 >> 3) && (s2 & 7) <= (t & 7)) ? w8[(t & 7) * 8 + (s2 & 7)] : 0.f;
                    LA[t * 136 + s2] = (bf16_t)(cvt_pk_bf16(v, 0.f) & 0xffffu); }
            }
            if (g + 1 < g0 + ng) MIX_LOAD_G(g + 1);
            __syncthreads();
            {
                const int tl = wid * 16 + fr, row = r0 + tl;
                const float bias = PIN(I_SPB)[((size_t)pair * 4 + g) * 128 + (samp ? (tl & 7) : tl)];
                bf16x8 wf[4];
#pragma unroll
                for (int ks = 0; ks < 4; ++ks) wf[ks] = *(const LAS bf16x8*)(LA + tl * 136 + ks * 32 + fq * 8);
#pragma unroll
                for (int nt = 0; nt < 8; ++nt) {
                    f32x4 acc = (f32x4){0.f, 0.f, 0.f, 0.f};
#pragma unroll
                    for (int ks = 0; ks < 4; ++ks) {
                        if (ks * 32 <= wid * 16 + 15) {
                            const bf16x8 vf = *(const LAS bf16x8*)(LB + (nt * 16 + fr) * 136 + ks * 32 + fq * 8);
                            acc = __builtin_amdgcn_mfma_f32_16x16x32_bf16(vf, wf[ks], acc, 0, 0, 0);
                        }
                    }
                    const int c = g * 128 + nt * 16 + fq * 4;
                    const f32x4 u = cvt4(ur[nt]), dz = cvt4(dzr[nt]);
                    f32x4 o;
#pragma unroll
                    for (int j = 0; j < 4; ++j) o[j] = u[j] * (acc[j] + bias) * siluf_(dz[j]);
                    st_bf4(Ycat + (size_t)row * 1024 + 512 + c, o);
                }
            }
            __syncthreads();
        }
#undef MIX_LOAD_G
    }
    {
        int ci, cstride;
        if (cx.nblk == 256) { if (cx.bid < 32) { ci = 1 << 20; cstride = 1 << 20; } else { ci = cx.bid - 32; cstride = 224; } }
        else { ci = cx.bid; cstride = cx.nblk; }
        u32x4 pw[4]; u32x2 pe[9];
#define MIX_LOAD_C(cc) do { const int tile_ = (cc) >> 2, g_ = (cc) & 3, r0_ = tile_ * 128; \
            const bf16_t* Bw_ = (const bf16_t*)(PWS + WS_POOLWT) + ((size_t)pair * 4 + g_) * 128 * 128; \
            _Pragma("unroll") for (int i = 0; i < 4; ++i) { const int e = tid + i * 512; pw[i] = *(const u32x4*)(Bw_ + (e >> 4) * 128 + (e & 15) * 8); } \
            if (r0_ < NTP) { const int t0_ = r0_ & 2047; \
                _Pragma("unroll") for (int i = 0; i < 9; ++i) { const int e = tid + i * 512, er = e >> 5, c = (e & 31) * 4; pe[i] = (u32x2){0u, 0u}; \
                    if (e < 143 * 32 && t0_ + er - 15 >= 0) pe[i] = *(const u32x2*)(PO + (size_t)(r0_ + er - 15) * LDA + g_ * 128 + c); } } } while (0)
        if (ci < 544) MIX_LOAD_C(ci);
        for (; ci < 544; ci += cstride) {
            const int tile = ci >> 2, g = ci & 3, r0 = tile * 128;
            const bool samp = r0 >= NTP;
            const int w = 2 << g;
            const int row = r0 + wid * 16 + fr;
            u32x2 czr[8]; f32x4 psr[8];
#pragma unroll
            for (int nt = 0; nt < 8; ++nt) { const int d = g * 128 + nt * 16 + fq * 4; czr[nt] = *(const u32x2*)(PO + (size_t)row * LDA + 512 + d); psr[nt] = *(const f32x4*)(PIN(I_PSCALE) + pair * 512 + d); }
#pragma unroll
            for (int i = 0; i < 4; ++i) { const int e = tid + i * 512; *(LAS u32x4*)(LW + (e >> 4) * 136 + (e & 15) * 8) = pw[i]; }
            if (!samp) {
                const int t0 = r0 & 2047;
#pragma unroll
                for (int i = 0; i < 9; ++i) { const int e = tid + i * 512, er = e >> 5, c = (e & 31) * 4; if (e < 143 * 32) *(LAS f32x4*)(LE + er * 128 + c) = cvt4(pe[i]); }
                __syncthreads();
                {
                    const int c = (tid & 31) * 4, tl0 = (tid >> 5) * 8;
                    f32x4 sum = (f32x4){0.f, 0.f, 0.f, 0.f};
#pragma unroll 4
                    for (int d = 0; d < w; ++d) sum += *(LAS const f32x4*)(LE + (tl0 + 15 - d) * 128 + c);
#pragma unroll
                    for (int k = 0; k < 8; ++k) {
                        const int tl = tl0 + k;
                        const f32x4 pt = *(LAS const f32x4*)(LE + (tl + 15) * 128 + c);
                        if (k > 0) sum += pt - *(LAS const f32x4*)(LE + (tl + 15 - w) * 128 + c);
                        const float cnt = fminf((float)w, (float)(t0 + tl + 1));
                        const f32x4 pooled = sum * __builtin_amdgcn_rcpf(cnt) - pt;
                        u32x2 u; u.x = cvt_pk_bf16(pooled[0], pooled[1]); u.y = cvt_pk_bf16(pooled[2], pooled[3]);
                        *(LAS u32x2*)(LA + tl * 136 + c) = u;
                    }
                }
            } else {
                const int sq = tid >> 5, c = (tid & 31) * 4, bb = (r0 - NTP) / 8 + sq;
                const float* hist = PIN(I_SPOOL) + ((size_t)pair * 128 + bb) * 15 * 512 + g * 128 + c;
                const bf16_t* cur = PO + (size_t)(r0 + sq * 8) * LDA + g * 128 + c;
                LAS bf16_t* out = LA + (sq * 8) * 136 + c;
                if (g == 0) pool_sample_run<2>(hist, cur, out); else if (g == 1) pool_sample_run<4>(hist, cur, out);
                else if (g == 2) pool_sample_run<8>(hist, cur, out); else pool_sample_run<16>(hist, cur, out);
            }
            if (ci + cstride < 544) MIX_LOAD_C(ci + cstride);
            __syncthreads();
            bf16x8 af[4];
#pragma unroll
            for (int ks = 0; ks < 4; ++ks) af[ks] = *(const LAS bf16x8*)(LA + (wid * 16 + fr) * 136 + ks * 32 + fq * 8);
#pragma unroll
            for (int nt = 0; nt < 8; ++nt) {
                f32x4 acc = (f32x4){0.f, 0.f, 0.f, 0.f};
#pragma unroll
                for (int ks = 0; ks < 4; ++ks) {
                    const bf16x8 bf = *(const LAS bf16x8*)(LW + (nt * 16 + fr) * 136 + ks * 32 + fq * 8);
                    acc = __builtin_amdgcn_mfma_f32_16x16x32_bf16(bf, af[ks], acc, 0, 0, 0);
                }
                const int d = g * 128 + nt * 16 + fq * 4;
                const f32x4 cz = cvt4(czr[nt]), ps = psr[nt];
                f32x4 o;
#pragma unroll
                for (int j = 0; j < 4; ++j) o[j] = acc[j] * ps[j] * siluf_(cz[j]);
                st_bf4(Ycat + (size_t)row * 1024 + d, o);
            }
            __syncthreads();
        }
#undef MIX_LOAD_C
    }
    const int gtid = cx.bid * 512 + tid, gthreads = cx.nblk * 512;
    for (int e = gtid; e < 136 * 15 * 128; e += gthreads) {
        const int c = (e & 127) * 4, q = e >> 7, sr = q / 15, k = q - sr * 15;
        if (sr < 8) *(f32x4*)(POUT + O_POOLP + (((size_t)pair * 8 + sr) * 15 + k) * 512 + c) = ld_bf4(PO + (size_t)(sr * 2048 + 2033 + k) * LDA + c);
        else { const int b = sr - 8;
            *(f32x4*)(POUT + O_POOLS + (((size_t)pair * 128 + b) * 15 + k) * 512 + c) = (k < 7) ? *(const f32x4*)(PIN(I_SPOOL) + (((size_t)pair * 128 + b) * 15 + 8 + k) * 512 + c) : ld_bf4(PO + (size_t)(NTP + b * 8 + (k - 7)) * LDA + c); }
    }
}

__device__ void phase_final(const Params& p, const Ctx cx) {
    const int gtid = cx.bid * 512 + cx.tid, gthreads = cx.nblk * 512;
    const float* ssq = (const float*)(PWS + WS_SSQ) + (size_t)4 * NTOK * 16;
    const bf16_t* Xb = (const bf16_t*)(PWS + WS_XB);
    constexpr int NIT = NTOK * 256, UB = 4;
    for (int e0 = gtid; e0 < NIT; e0 += gthreads * UB) {
        f32x4 x[UB], fw[UB]; float sq[UB]; bool ok[UB];
#pragma unroll
        for (int u = 0; u < UB; ++u) { const int e = e0 + u * gthreads; ok[u] = e < NIT; const int ee = ok[u] ? e : e0; const int row = ee >> 8, c = (ee & 255) * 4;
            x[u] = ld_bf4(Xb + (size_t)row * 1024 + c); sq[u] = ssq_sum(ssq + (size_t)row * 16); fw[u] = *(const f32x4*)(PIN(I_FNORMW) + c); }
#pragma unroll
        for (int u = 0; u < UB; ++u) { const int e = e0 + u * gthreads; const int ee = ok[u] ? e : e0; const int row = ee >> 8, c = (ee & 255) * 4;
            const float rstd = rsqrtf(sq[u] * (1.0f / 1024.0f) + 1e-6f);
            if (ok[u]) *(f32x4*)(POUT + (size_t)row * 1024 + c) = x[u] * rstd * fw[u]; }
    }
}

#define XB_TMO      128
#define XB_XCNT(j)  (256  + 64 * (j))
#define XB_XSUB(j)  (1280 + 64 * (j))
#define XB_XGEN(j)  (2304 + 64 * (j))
#define XB_TOP      3328
#define XB_TOPGEN   3392
#define XCD_BAR_WORDS 3456
#define XB_SPIN_CAP (1u << 18)
__device__ __forceinline__ unsigned xb_ld(unsigned* p)              { return __hip_atomic_load(p, __ATOMIC_RELAXED, __HIP_MEMORY_SCOPE_AGENT); }
__device__ __forceinline__ unsigned xb_add(unsigned* p, unsigned v) { return __hip_atomic_fetch_add(p, v, __ATOMIC_RELAXED, __HIP_MEMORY_SCOPE_AGENT); }
__device__ __forceinline__ unsigned xb_xcc_id() { return (unsigned)__builtin_amdgcn_s_getreg((3 << 11) | 20) & 0xFu; }
#define XB_SPIN(cond, bar) do { unsigned _sp = 0; while (cond) { __builtin_amdgcn_s_sleep(1); \
    if ((++_sp & 255u) == 0u) { if (xb_ld(&(bar)[XB_TMO])) break; if (_sp > XB_SPIN_CAP) { atomicAdd(&(bar)[XB_TMO], 1u); break; } } } } while (0)
struct XcdBarrier { unsigned* bar; unsigned x; volatile LAS unsigned* st; };
__device__ __forceinline__ XcdBarrier xcd_barrier_post(unsigned* bar, volatile LAS unsigned* st) {
    XcdBarrier b; b.bar = bar; b.x = xb_xcc_id(); b.st = st;
    if (threadIdx.x == 0) (void)xb_add(&bar[XB_XCNT(b.x)], 1u);
    return b;
}
__device__ __forceinline__ void xcd_barrier_complete(unsigned* bar, unsigned x, unsigned& nloc, unsigned& nx) {
    const unsigned G = gridDim.x * gridDim.y * gridDim.z;
    unsigned sum, cnt, mine, sp = 0u;
    for (;;) {
        sum = 0u; cnt = 0u; mine = 0u;
#pragma unroll
        for (unsigned j = 0; j < 16; ++j) { const unsigned c = xb_ld(&bar[XB_XCNT(j)]); sum += c; cnt += (c > 0u) ? 1u : 0u; mine = (j == x) ? c : mine; }
        if (sum == G) break;
        __builtin_amdgcn_s_sleep(1);
        if ((++sp & 255u) == 0u) { if (xb_ld(&bar[XB_TMO])) break; if (sp > XB_SPIN_CAP) { atomicAdd(&bar[XB_TMO], 1u); break; } }
    }
    nloc = mine > 0u ? mine : 1u; nx = cnt > 0u ? cnt : 1u;
}
__device__ __forceinline__ void xcd_barrier(const XcdBarrier& b) {
    asm volatile("s_waitcnt vmcnt(0)" ::: "memory");
    __syncthreads();
    if (threadIdx.x == 0) {
        unsigned* bar = b.bar;
        __builtin_amdgcn_s_waitcnt(0);
        unsigned nloc = b.st[0], nx = b.st[1];
        if (nloc == 0u) { xcd_barrier_complete(bar, b.x, nloc, nx); b.st[0] = nloc; b.st[1] = nx; }
        const unsigned old = xb_add(&bar[XB_XSUB(b.x)], 1u);
        const unsigned gen = old / nloc;
        if (old + 1u == (gen + 1u) * nloc) {
            __builtin_amdgcn_fence(__ATOMIC_RELEASE, "agent");
            asm volatile("s_waitcnt vmcnt(0)" ::: "memory");
            const unsigned og = xb_add(&bar[XB_TOP], 1u);
            const unsigned tg = og / nx;
            if (og + 1u == (tg + 1u) * nx) xb_add(&bar[XB_TOPGEN], 1u);
            else XB_SPIN(xb_ld(&bar[XB_TOPGEN]) == tg, bar);
            __builtin_amdgcn_fence(__ATOMIC_ACQUIRE, "agent");
            xb_add(&bar[XB_XGEN(b.x)], 1u);
            asm volatile("s_waitcnt vmcnt(0)" ::: "memory");
        } else {
            XB_SPIN(xb_ld(&bar[XB_XGEN(b.x)]) == gen, bar);
            __builtin_amdgcn_fence(__ATOMIC_ACQUIRE, "agent");
            asm volatile("s_waitcnt vmcnt(0)" ::: "memory");
        }
    }
    __syncthreads();
}

__device__ void run_gemm_proj(const Params& p, const Ctx cx, LAS unsigned char* lds, const bf16_t* Bt, int N, bf16_t* O, int ldc, int layer) {
    pg8::Gemm g{(const bf16_t*)(PWS + WS_XB), Bt, NTOK, N, 1024};
    pg8::StaticOrder S; S.init(NTOK, N, (int)cx.nblk, (int)cx.bid);
    const float* ssq = (const float*)(PWS + WS_SSQ) + (size_t)layer * NTOK * 16;
    LAS float* rl = (LAS float*)(lds + 131072);
    int pm0 = -1, pm1 = -1, pm2 = -1, pm3 = -1, np = 0;
    for (int i = 0; i < 64; ++i) {
        pg8::Unit u; if (!S.next(i, u)) break;
        if (u.pm == pm0 || u.pm == pm1 || u.pm == pm2 || u.pm == pm3) continue;
        if (np == 0) pm0 = u.pm; else if (np == 1) pm1 = u.pm; else if (np == 2) pm2 = u.pm; else pm3 = u.pm;
        ++np;
    }
    for (int r = cx.tid; r < np * 256; r += 512) {
        const int i = r >> 8, pm = i == 0 ? pm0 : (i == 1 ? pm1 : (i == 2 ? pm2 : pm3));
        rl[r] = rsqrtf(ssq_sum(ssq + (size_t)(pm * 256 + (r & 255)) * 16) * (1.0f / 1024.0f) + 1e-6f);
    }
    __syncthreads();
    EpiProj E{O, ldc, rl, pm0, pm1, pm2, pm3};
    pg8::gemm_phase<EpiProj>(cx, lds, g, S, E);
}
__device__ void run_gemm_res(const Params& p, const Ctx cx, LAS unsigned char* lds, const bf16_t* Bt, int layer) {
    const bf16_t* A = (const bf16_t*)(PWS + WS_YCAT);
    bf16_t* Xb = (bf16_t*)(PWS + WS_XB);
    float* ssqn = (float*)(PWS + WS_SSQ) + (size_t)(layer + 1) * NTOK * 16;
    pg8::Gemm g{A, Bt, NTOK, 1024, 1024};
    pg8::StaticOrder S; S.init(NTOK, 1024, (int)cx.nblk, (int)cx.bid);
    EpiRes E{layer == 0 ? PIN(I_XP) : nullptr, PIN(I_XS), Xb, ssqn};
    pg8::gemm_phase<EpiRes>(cx, lds, g, S, E);
}

constexpr int N_PHASES = 20;
#ifndef PHMASK
#define PHMASK 0xffff
#endif
#define PHON(n) ((PHMASK >> ((n) % 16)) & 1)
__global__ void __launch_bounds__(512, 2) fwd_kernel(Params p) {
    extern __shared__ __attribute__((aligned(16))) unsigned char lds_raw[];
    LAS unsigned char* lds = (LAS unsigned char*)lds_raw;
    volatile LAS unsigned* bar_st = (volatile LAS unsigned*)(lds + LDS_MAIN);
    if (threadIdx.x < 4) bar_st[threadIdx.x] = 0u;
    __syncthreads();
    const XcdBarrier gbar = xcd_barrier_post((unsigned*)((unsigned char*)p.ptr[30] + WS_BAR), bar_st);
    if (p.ph_hi < 0) cg::this_grid().sync();
#define GRID_SYNC() xcd_barrier(gbar)
#ifdef SYNCPROBE
    for (int i = 0; i < SYNCPROBE; ++i) GRID_SYNC();
#endif
#ifdef REPMASK
    for (int pc = p.ph_lo * 2; pc < p.ph_hi * 2; ++pc) {
        const int ph = pc >> 1;
        { const int s_ = (ph == 0) ? 9 : (ph == N_PHASES - 1) ? 31 : (ph - 1) % 9; if ((pc & 1) && !((REPMASK >> s_) & 1)) continue; }
        if (pc > p.ph_lo * 2) GRID_SYNC();
#else
    for (int ph = p.ph_lo; ph < p.ph_hi; ++ph) {
        if (ph > p.ph_lo) GRID_SYNC();
#endif
        Ctx cx; cx.tid = threadIdx.x; cx.bid = blockIdx.x; cx.nblk = gridDim.x;
        asm volatile("s_mov_b32 %0, 0" : "=s"(cx.z));
        asm volatile("" : "+v"(cx.tid)); asm volatile("" : "+s"(cx.bid)); asm volatile("" : "+s"(cx.nblk));
        const int pair = (ph - 1) / 9, s = (ph == 0) ? 100 : (ph == N_PHASES - 1 ? 101 : (ph - 1) % 9);
        if (s == 0 || s == 3 || s == 6) {
#if PHON(0)
            const bf16_t* WinE = (const bf16_t*)(PWS + WS_WINE) + (size_t)pair * 4352 * 1024;
            const bf16_t* Bt = s == 0 ? WinE + (size_t)2560 * 1024 : (s == 3 ? WinE : (const bf16_t*)(PWS + WS_WINO) + (size_t)pair * 2560 * 1024);
            const int N = s == 0 ? 1792 : 2560;
            run_gemm_proj(p, cx, lds, Bt, N, (bf16_t*)(PWS + WS_R1), N, 2 * pair + (s == 6 ? 1 : 0));
#endif
        } else if (s == 5 || s == 8) {
#if PHON(5)
            const bf16_t* Bt = (const bf16_t*)(PWS + (s == 5 ? WS_WOUTE : WS_WOUTO)) + (size_t)pair * 1024 * 1024;
            run_gemm_res(p, cx, lds, Bt, 2 * pair + (s == 8 ? 1 : 0));
#endif
        } else if (s == 1) {
#if PHON(1)
            phase_even_prep(p, cx, pair, lds);
#endif
        } else if (s == 2) {
#if PHON(2)
            phase_scan(p, cx, pair, lds);
#endif
        } else if (s == 4) {
#if PHON(4)
            phase_even_post(p, cx, pair);
#endif
        } else if (s == 7) {
#if PHON(7)
            phase_odd_mixer(p, cx, pair, lds);
#endif
        } else if (s == 100) {
#if PHON(10)
            phase_prepass(p, cx, lds);
#endif
        } else {
#if PHON(11)
            phase_final(p, cx);
#endif
        }
    }
}

extern "C" void kernel_launch(void* const* d_in, const int* in_sizes, int n_in, void* d_out, int out_size, void* d_ws, size_t ws_size, hipStream_t stream) {
    static int grid = 0;
    if (grid == 0) {
        if (n_in != 29 || ws_size < WS_END) { fprintf(stderr, "kernel_launch: unexpected n_in %d / ws_size %zu (need %zu)\n", n_in, ws_size, (size_t)WS_END); grid = -1; return; }
        int dev = 0, cus = 0, per_cu = 0;
        hipGetDevice(&dev);
        hipDeviceGetAttribute(&cus, hipDeviceAttributeMultiprocessorCount, dev);
        if (hipFuncSetAttribute((const void*)fwd_kernel, hipFuncAttributeMaxDynamicSharedMemorySize, LDS_BYTES) != hipSuccess) { fprintf(stderr, "kernel_launch: hipFuncSetAttribute failed\n"); grid = -1; return; }
        if (hipOccupancyMaxActiveBlocksPerMultiprocessor(&per_cu, (const void*)fwd_kernel, 512, LDS_BYTES) != hipSuccess || per_cu < 1) { fprintf(stderr, "kernel_launch: occupancy query gave %d\n", per_cu); per_cu = 1; }
        (void)hipGetLastError();
        grid = cus * per_cu;
        if (grid > 256) grid = 256;
    }
    if (grid < 0) return;
    Params p{};
    for (int i = 0; i < 29; ++i) p.ptr[i] = d_in[i];
    p.ptr[29] = d_out; p.ptr[30] = d_ws; p.ptr[31] = nullptr;
    (void)hipMemsetAsync((unsigned char*)d_ws + WS_BAR, 0, 16384, stream);
#if ONE_LAUNCH
    p.ph_lo = 0; p.ph_hi = N_PHASES;
    void* args[] = {&p};
    hipError_t e = hipLaunchCooperativeKernel((const void*)fwd_kernel, dim3(grid), dim3(512), args, LDS_BYTES, stream);
    if (e != hipSuccess) fprintf(stderr, "cooperative launch failed: %s (grid %d)\n", hipGetErrorString(e), grid);
#else
    for (int ph = 0; ph < N_PHASES; ++ph) {
        p.ph_lo = ph; p.ph_hi = ph + 1;
        hipLaunchKernelGGL(fwd_kernel, dim3(grid), dim3(512), LDS_BYTES, stream, p);
    }
#endif
}
```

```cpp
#include <hip/hip_runtime.h>
#include <hip/hip_cooperative_groups.h>
#include <cstdio>
namespace cg = cooperative_groups;

#ifndef ONE_LAUNCH
#define ONE_LAUNCH 1
#endif

#define LAS __attribute__((address_space(3)))
typedef unsigned short bf16_t;
typedef short bf16x8 __attribute__((ext_vector_type(8)));
typedef float f32x4 __attribute__((ext_vector_type(4)));
typedef unsigned u32x4 __attribute__((ext_vector_type(4)));
typedef unsigned u32x2 __attribute__((ext_vector_type(2)));

constexpr int NTOK = 17408, NTP = 16384;
constexpr int LDB = 1792;
constexpr int LDA = 2560;
constexpr size_t O_CONVP = 17825792, O_CONVS = 17842176, O_SHIFTP = 18104320, O_SHIFTS = 18130944, O_WKVP = 18556928, O_WKVS = 19081216,
                 O_POOLP = 27469824, O_POOLS = 27592704, O_CHUNKV = 29558784;
constexpr size_t WS_WINE = 0;
constexpr size_t WS_WOUTE = WS_WINE + 2ull * 4352 * 1024 * 2;
constexpr size_t WS_WINO = WS_WOUTE + 2ull * 1024 * 1024 * 2;
constexpr size_t WS_WOUTO = WS_WINO + 2ull * 2560 * 1024 * 2;
constexpr size_t WS_W2T = WS_WOUTO + 2ull * 1024 * 1024 * 2;
constexpr size_t WS_A2T = WS_W2T + 2ull * 512 * 64 * 2;
constexpr size_t WS_POOLWT = WS_A2T + 2ull * 512 * 64 * 2;
constexpr size_t WS_SPW = WS_POOLWT + 8ull * 128 * 128 * 2;
constexpr size_t WS_XB = WS_SPW + 8ull * 128 * 128 * 2;
constexpr size_t WS_YCAT = WS_XB + (size_t)NTOK * 1024 * 2;
constexpr size_t WS_SSQ = WS_YCAT + (size_t)NTOK * 1024 * 2;
constexpr size_t WS_Y = WS_SSQ + 5ull * NTOK * 16 * 4;
constexpr size_t WS_R1 = WS_Y + (size_t)NTOK * 512 * 4;
constexpr size_t WS_PROJB = WS_R1;
constexpr size_t WS_WDEC = WS_PROJB + (size_t)NTOK * LDB * 2;
constexpr size_t WS_AA = WS_WDEC + (size_t)NTOK * 512 * 4;
constexpr size_t WS_BAR = WS_AA + (size_t)NTOK * 512 * 2;
constexpr size_t WS_END = WS_BAR + 16384;
constexpr int LDS_MAIN = 147456;
constexpr int LDS_BYTES = LDS_MAIN + 16;

struct Params {
    const void* ptr[32];
    int ph_lo, ph_hi;
};
struct Ctx { int tid, bid, nblk, z; };
#define PIN(i) ((const float*)p.ptr[(i) + cx.z])
#define POUT ((float*)p.ptr[29 + cx.z])
#define PWS ((unsigned char*)p.ptr[30 + cx.z])
enum { I_XP = 0, I_XS, I_SCONV, I_SSHIFT, I_SWKV, I_SPOOL, I_NORMW, I_FNORMW, I_WINE, I_CONVW, I_MU, I_W0, I_W2, I_A0, I_A2, I_KK, I_KA, I_RK, I_GNG, I_GNB,
       I_WOUTE, I_WINO, I_POOLW, I_PSCALE, I_LNG, I_LNB, I_SPW, I_SPB, I_WOUTO };

__device__ __forceinline__ unsigned cvt_pk_bf16(float lo, float hi) { unsigned r; asm("v_cvt_pk_bf16_f32 %0, %1, %2" : "=v"(r) : "v"(lo), "v"(hi)); return r; }
__device__ __forceinline__ float bf_lo(unsigned u) { return __uint_as_float(u << 16); }
__device__ __forceinline__ float bf_hi(unsigned u) { return __uint_as_float(u & 0xffff0000u); }
__device__ __forceinline__ float bf2f(bf16_t b) { return __uint_as_float(((unsigned)b) << 16); }
__device__ __forceinline__ f32x4 cvt4(u32x2 u) { return (f32x4){bf_lo(u.x), bf_hi(u.x), bf_lo(u.y), bf_hi(u.y)}; }
__device__ __forceinline__ f32x4 ld_bf4(const bf16_t* p) { return cvt4(*(const u32x2*)p); }
__device__ __forceinline__ void st_bf4(bf16_t* p, f32x4 v) { u32x2 u; u.x = cvt_pk_bf16(v[0], v[1]); u.y = cvt_pk_bf16(v[2], v[3]); *(u32x2*)p = u; }
__device__ __forceinline__ float sigmoidf_(float x) { return __builtin_amdgcn_rcpf(1.0f + __expf(-x)); }
__device__ __forceinline__ float siluf_(float x) { return x * __builtin_amdgcn_rcpf(1.0f + __expf(-x)); }
template <int CTRL> __device__ __forceinline__ float dpp_f(float x) { return __builtin_bit_cast(float, __builtin_amdgcn_mov_dpp(__builtin_bit_cast(int, x), CTRL, 0xf, 0xf, true)); }
__device__ __forceinline__ float allsum16(float x) { x += dpp_f<0xB1>(x); x += dpp_f<0x4E>(x); x += dpp_f<0x141>(x); x += dpp_f<0x128>(x); return x; }
__device__ __forceinline__ float allsum4(float x) { x += dpp_f<0xB1>(x); x += dpp_f<0x4E>(x); return x; }
__device__ __forceinline__ float dot4(f32x4 a, f32x4 b) { return a[0] * b[0] + a[1] * b[1] + a[2] * b[2] + a[3] * b[3]; }

__device__ __forceinline__ float ssq_sum(const float* part) {
    const f32x4 a = *(const f32x4*)(part), b = *(const f32x4*)(part + 4), c = *(const f32x4*)(part + 8), d = *(const f32x4*)(part + 12);
    return ((a[0] + a[1]) + (a[2] + a[3])) + ((b[0] + b[1]) + (b[2] + b[3])) + ((c[0] + c[1]) + (c[2] + c[3])) + ((d[0] + d[1]) + (d[2] + d[3]));
}

namespace pg8 {
constexpr int BM = 256, BK = 64, HALF = 128, HTB = HALF * BK * 2, NXCD = 8, WGM = 8;
__device__ __forceinline__ int lds_byte(int r, int c) { const int st = (r >> 4) * 2 + (c >> 5), rr = r & 15, cc = c & 31, ob = rr * 64 + cc * 2; return st * 1024 + (ob ^ (((ob >> 9) & 1) << 5)); }
__device__ __forceinline__ void stage_rc(int b, int& R, int& C) { const int st = b / 1024, sb = b % 1024, swz = sb ^ (((sb >> 9) & 1) << 5); R = (st >> 1) * 16 + swz / 64; C = (st & 1) * 32 + (swz % 64) / 2; }
__device__ __forceinline__ int perm32(int rho) { const int n = rho >> 4, i = rho & 15; return 8 * (i >> 2) + 4 * n + (i & 3); }
struct Unit { int pm, pn; };
struct Gemm { const bf16_t* A; const bf16_t* Bt; int M, N, K; };
struct StaticOrder {
    int nM, nN, nwg, G, c;
    __device__ void init(int M, int N, int G_, int c_) { nM = M / BM; nN = N / BM; nwg = nM * nN; G = G_; c = c_; }
    __device__ bool next(int i, Unit& u) const {
        const long L = (long)i * G + c; if (L >= nwg) return false;
        int wgid = (int)L; { const int q = nwg / NXCD, r = nwg % NXCD, xcd = wgid % NXCD, off = wgid / NXCD; wgid = (xcd < r ? xcd * (q + 1) : r * (q + 1) + (xcd - r) * q) + off; }
        const int nig = WGM * nN, gid = wgid / nig, fm = gid * WGM, gsz = (nM - fm) < WGM ? (nM - fm) : WGM;
        u.pm = fm + ((wgid % nig) % gsz); u.pn = (wgid % nig) / gsz; return true;
    }
};

template <class Epi>
__device__ __forceinline__ void gemm_phase(const Ctx cx, LAS unsigned char* lds, const Gemm g, const StaticOrder& S, const Epi& E) {
    const int tid = cx.tid, wid = __builtin_amdgcn_readfirstlane(tid >> 6), lane = tid & 63, wr = wid >> 2, wc = wid & 3, fr = lane & 15, fq = lane >> 4;
    const int K = g.K, nt = K / BK;
    unsigned voffA[2], voffB[2];
#pragma unroll
    for (int i = 0; i < 2; ++i) { int R, C; stage_rc(tid * 16 + i * 8192, R, C); const int Rb = Epi::PERM ? ((R & ~31) + perm32(R & 31)) : R;
        voffA[i] = (unsigned)(R * K + C) * 2u; voffB[i] = (unsigned)(Rb * K + C) * 2u; }
    const size_t kstep = (size_t)(BK * 2);
    const size_t hstep = (size_t)HALF * K * 2;
    const size_t tstep = 2 * hstep;
    const unsigned ldsw = (unsigned)wid * 1024u;
    const int aoff = lds_byte(wr * 64 + fr, fq * 8), boff = lds_byte(wc * 32 + fr, fq * 8);
#define PG8_SA(b, h) (((b) * 2 + (h)) * HTB)
#define PG8_SB(b, h) ((4 + (b) * 2 + (h)) * HTB)
#define PG8_STAGE(bufoff, gbase, voff) do { _Pragma("unroll") for (int _i = 0; _i < 2; ++_i) \
        __builtin_amdgcn_global_load_lds((const unsigned*)((const char*)(gbase) + (voff)[_i]), (LAS unsigned*)(lds + (bufoff) + ldsw + _i * 8192), 16, 0, 0); } while (0)
#define PG8_LDA(dst, b, h) do { _Pragma("unroll") for (int m = 0; m < 4; ++m) _Pragma("unroll") for (int k = 0; k < 2; ++k) dst[m][k] = *(const LAS bf16x8*)(lds + PG8_SA(b, h) + aoff + m * 2048 + k * 1024); } while (0)
#define PG8_LDB(dst, b, h) do { _Pragma("unroll") for (int n = 0; n < 2; ++n) _Pragma("unroll") for (int k = 0; k < 2; ++k) dst[n][k] = *(const LAS bf16x8*)(lds + PG8_SB(b, h) + boff + n * 2048 + k * 1024); } while (0)
#define PG8_MMA(ai, bj, At, Bt) do { __builtin_amdgcn_s_setprio(1); _Pragma("unroll") for (int m = 0; m < 4; ++m) _Pragma("unroll") for (int n = 0; n < 2; ++n) _Pragma("unroll") for (int k = 0; k < 2; ++k) \
        acc[ai][bj][m][n] = __builtin_amdgcn_mfma_f32_16x16x32_bf16(Bt[n][k], At[m][k], acc[ai][bj][m][n], 0, 0, 0); __builtin_amdgcn_s_setprio(0); } while (0)
#define PG8_WAIT_V(n) asm volatile("s_waitcnt vmcnt(" #n ")" ::: "memory")
#define PG8_WAIT_L(n) asm volatile("s_waitcnt lgkmcnt(" #n ")" ::: "memory")
#define PG8_BAR __builtin_amdgcn_s_barrier()
#define PG8_SCHED __builtin_amdgcn_sched_barrier(0)
    Unit cur, nxt; int ui = 0;
    if (!S.next(0, cur)) return;
    f32x4 acc[2][2][4][2];
#pragma unroll
    for (int a = 0; a < 2; ++a)
#pragma unroll
        for (int b = 0; b < 2; ++b)
#pragma unroll
            for (int m = 0; m < 4; ++m)
#pragma unroll
                for (int n = 0; n < 2; ++n) acc[a][b][m][n] = (f32x4){0.f, 0.f, 0.f, 0.f};
    bf16x8 At[4][2], B0[2][2], B1[2][2];
    const char* cA = (const char*)g.A + (size_t)cur.pm * tstep; const char* cB = (const char*)g.Bt + (size_t)cur.pn * tstep;
    PG8_STAGE(PG8_SB(0, 0), cB, voffB); PG8_STAGE(PG8_SA(0, 0), cA, voffA); PG8_STAGE(PG8_SB(0, 1), cB + hstep, voffB); PG8_STAGE(PG8_SA(0, 1), cA + hstep, voffA);
    if (wr == 1) PG8_BAR;
    PG8_WAIT_V(4); PG8_BAR;
    PG8_STAGE(PG8_SB(1, 0), cB + kstep, voffB); PG8_STAGE(PG8_SA(1, 0), cA + kstep, voffA); PG8_STAGE(PG8_SB(1, 1), cB + hstep + kstep, voffB);
    PG8_WAIT_V(6); PG8_BAR;
    for (;;) {
        const bool has_next = S.next(ui + 1, nxt);
        const char* nA = has_next ? (const char*)g.A + (size_t)nxt.pm * tstep : cA; const char* nB = has_next ? (const char*)g.Bt + (size_t)nxt.pn * tstep : cB;
        for (int t = 0; t < nt; t += 2) {
            const bool last = (t == nt - 2);
            const char* a1 = cA + (size_t)(t + 1) * kstep;
            const char* a2 = last ? nA : cA + (size_t)(t + 2) * kstep; const char* b2 = last ? nB : cB + (size_t)(t + 2) * kstep;
            const char* a3 = a2 + kstep; const char* b3 = b2 + kstep;
            PG8_LDB(B0, 0, 0); PG8_SCHED; PG8_LDA(At, 0, 0); PG8_STAGE(PG8_SA(1, 1), a1 + hstep, voffA);
            PG8_WAIT_L(8); PG8_BAR; PG8_WAIT_L(0); PG8_MMA(0, 0, At, B0); PG8_BAR; PG8_SCHED;
            PG8_LDB(B1, 0, 1); PG8_STAGE(PG8_SB(0, 0), b2, voffB);
            PG8_BAR; PG8_WAIT_L(0); PG8_MMA(0, 1, At, B1); PG8_BAR;
            PG8_LDA(At, 0, 1); PG8_STAGE(PG8_SA(0, 0), a2, voffA);
            PG8_BAR; PG8_WAIT_L(0); PG8_MMA(1, 0, At, B0); PG8_BAR; PG8_SCHED;
            PG8_STAGE(PG8_SB(0, 1), b2 + hstep, voffB);
            PG8_WAIT_V(6); PG8_BAR; PG8_MMA(1, 1, At, B1); PG8_BAR;
            PG8_LDB(B0, 1, 0); PG8_SCHED; PG8_LDA(At, 1, 0); PG8_STAGE(PG8_SA(0, 1), a2 + hstep, voffA);
            PG8_WAIT_L(8); PG8_BAR; PG8_WAIT_L(0); PG8_MMA(0, 0, At, B0); PG8_BAR; PG8_SCHED;
            PG8_LDB(B1, 1, 1); PG8_STAGE(PG8_SB(1, 0), b3, voffB);
            PG8_BAR; PG8_WAIT_L(0); PG8_MMA(0, 1, At, B1); PG8_BAR;
            PG8_LDA(At, 1, 1); PG8_STAGE(PG8_SA(1, 0), a3, voffA);
            PG8_BAR; PG8_WAIT_L(0); PG8_MMA(1, 0, At, B0); PG8_BAR; PG8_SCHED;
            PG8_STAGE(PG8_SB(1, 1), b3 + hstep, voffB);
            PG8_WAIT_V(6); PG8_BAR; PG8_MMA(1, 1, At, B1); PG8_BAR;
        }
        E(acc, cur, wr, wc, fr, fq);
        if (!has_next) break;
#pragma unroll
        for (int a = 0; a < 2; ++a)
#pragma unroll
            for (int b = 0; b < 2; ++b)
#pragma unroll
                for (int m = 0; m < 4; ++m)
#pragma unroll
                    for (int n = 0; n < 2; ++n) acc[a][b][m][n] = (f32x4){0.f, 0.f, 0.f, 0.f};
        cur = nxt; cA = nA; cB = nB; ++ui;
    }
    PG8_WAIT_V(0);
    if (wr == 0) PG8_BAR;
    PG8_BAR;
#undef PG8_SA
#undef PG8_SB
#undef PG8_STAGE
#undef PG8_LDA
#undef PG8_LDB
#undef PG8_MMA
#undef PG8_WAIT_V
#undef PG8_WAIT_L
#undef PG8_BAR
#undef PG8_SCHED
}
}

struct EpiProj {
    static constexpr bool PERM = true;
    bf16_t* O; int ldc; LAS const float* rl; int pm0, pm1, pm2, pm3;
    __device__ __forceinline__ void operator()(const f32x4 (&acc)[2][2][4][2], const pg8::Unit& u, int wr, int wc, int fr, int fq) const {
        const int row0 = u.pm * 256 + wr * 64 + fr, col0 = u.pn * 256 + wc * 32 + 8 * fq;
        const int sel = u.pm == pm0 ? 0 : (u.pm == pm1 ? 1 : (u.pm == pm2 ? 2 : 3));
        LAS const float* rp = rl + sel * 256 + wr * 64 + fr;
#pragma unroll
        for (int ai = 0; ai < 2; ++ai)
#pragma unroll
            for (int m = 0; m < 4; ++m) {
                const int row = row0 + ai * 128 + m * 16;
                const float rstd = rp[ai * 128 + m * 16];
                bf16_t* rowp = O + (size_t)row * ldc + col0;
#pragma unroll
                for (int bj = 0; bj < 2; ++bj) {
                    const f32x4 v0 = acc[ai][bj][m][0] * rstd, v1 = acc[ai][bj][m][1] * rstd;
                    u32x4 w; w.x = cvt_pk_bf16(v0[0], v0[1]); w.y = cvt_pk_bf16(v0[2], v0[3]); w.z = cvt_pk_bf16(v1[0], v1[1]); w.w = cvt_pk_bf16(v1[2], v1[3]);
                    *(u32x4*)(rowp + bj * 128) = w;
                }
            }
    }
};
struct X8 { f32x4 lo, hi; };
template <bool FIRST> __device__ __forceinline__ X8 ld_x8(const float* __restrict__ s32, const bf16_t* __restrict__ s16, size_t o) {
    X8 r;
    if (FIRST) { r.lo = *(const f32x4*)(s32 + o); r.hi = *(const f32x4*)(s32 + o + 4); }
    else { const u32x4 u = *(const u32x4*)(s16 + o); r.lo = cvt4((u32x2){u.x, u.y}); r.hi = cvt4((u32x2){u.z, u.w}); }
    return r;
}
__device__ __forceinline__ void st_x8(bf16_t* p, f32x4 lo, f32x4 hi) { u32x4 w; w.x = cvt_pk_bf16(lo[0], lo[1]); w.y = cvt_pk_bf16(lo[2], lo[3]); w.z = cvt_pk_bf16(hi[0], hi[1]); w.w = cvt_pk_bf16(hi[2], hi[3]); *(u32x4*)p = w; }
template <bool FIRST>
__device__ __forceinline__ void epi_res_rows(const f32x4 (&acc)[2][2][4][2], const float* __restrict__ src32, const bf16_t* __restrict__ src16, bf16_t* __restrict__ Xb, float* __restrict__ ssqp,
                                             int row0, int col0, int slot, int fq) {
    if constexpr (FIRST) {
#pragma unroll
        for (int ai = 0; ai < 2; ++ai) {
            X8 x[4][2];
#pragma unroll
            for (int m = 0; m < 4; ++m)
#pragma unroll
                for (int bj = 0; bj < 2; ++bj) x[m][bj] = ld_x8<true>(src32, src16, (size_t)(row0 + ai * 128 + m * 16) * 1024 + col0 + bj * 128);
#pragma unroll
            for (int m = 0; m < 4; ++m) {
                const int row = row0 + ai * 128 + m * 16;
                float part = 0.f;
#pragma unroll
                for (int bj = 0; bj < 2; ++bj) {
                    const f32x4 lo = x[m][bj].lo + acc[ai][bj][m][0], hi = x[m][bj].hi + acc[ai][bj][m][1];
                    st_x8(Xb + (size_t)row * 1024 + col0 + bj * 128, lo, hi);
                    part += dot4(lo, lo) + dot4(hi, hi);
                }
                part += __shfl_xor(part, 16); part += __shfl_xor(part, 32);
                if (fq == 0) ssqp[(size_t)row * 16 + slot] = part;
            }
        }
    } else {
        u32x4 xr[2][4][2];
#pragma unroll
        for (int ai = 0; ai < 2; ++ai)
#pragma unroll
            for (int m = 0; m < 4; ++m)
#pragma unroll
                for (int bj = 0; bj < 2; ++bj) xr[ai][m][bj] = *(const u32x4*)(src16 + (size_t)(row0 + ai * 128 + m * 16) * 1024 + col0 + bj * 128);
#pragma unroll
        for (int ai = 0; ai < 2; ++ai)
#pragma unroll
            for (int m = 0; m < 4; ++m) {
                const int row = row0 + ai * 128 + m * 16;
                float part = 0.f;
#pragma unroll
                for (int bj = 0; bj < 2; ++bj) {
                    const u32x4 u = xr[ai][m][bj];
                    const f32x4 lo = cvt4((u32x2){u.x, u.y}) + acc[ai][bj][m][0], hi = cvt4((u32x2){u.z, u.w}) + acc[ai][bj][m][1];
                    st_x8(Xb + (size_t)row * 1024 + col0 + bj * 128, lo, hi);
                    part += dot4(lo, lo) + dot4(hi, hi);
                }
                part += __shfl_xor(part, 16); part += __shfl_xor(part, 32);
                if (fq == 0) ssqp[(size_t)row * 16 + slot] = part;
            }
    }
}
struct EpiRes {
    static constexpr bool PERM = true;
    const float* xp; const float* xs; bf16_t* Xb; float* ssq_next;
    __device__ __forceinline__ void operator()(const f32x4 (&acc)[2][2][4][2], const pg8::Unit& u, int wr, int wc, int fr, int fq) const {
        const int row0 = u.pm * 256 + wr * 64 + fr, col0 = u.pn * 256 + wc * 32 + 8 * fq;
        if (xp) epi_res_rows<true>(acc, row0 < NTP ? xp : xs - (size_t)NTP * 1024, nullptr, Xb, ssq_next, row0, col0, u.pn * 4 + wc, fq);
        else epi_res_rows<false>(acc, nullptr, Xb, Xb, ssq_next, row0, col0, u.pn * 4 + wc, fq);
    }
};

template <bool FIRST>
__device__ __forceinline__ void res_sample_tile(const Ctx cx, const bf16_t* __restrict__ A, const bf16_t* __restrict__ Bt, const float* __restrict__ xs, bf16_t* __restrict__ Xb, float* __restrict__ ssqp, int tile) {
    const int tid = cx.tid, wid = tid >> 6, lane = tid & 63, fr = lane & 15, fq = lane >> 4;
    const int tm = tile >> 3, tn = tile & 7;
    const int r0 = NTP + tm * 64 + (wid & 3) * 16, c0 = tn * 128 + (wid >> 2) * 64;
    const bf16_t* ap = A + (size_t)(r0 + fr) * 1024 + fq * 8;
    const bf16_t* bp = Bt + (size_t)(c0 + fr) * 1024 + fq * 8;
    f32x4 acc[4];
#pragma unroll
    for (int nt = 0; nt < 4; ++nt) acc[nt] = (f32x4){0.f, 0.f, 0.f, 0.f};
#pragma unroll 8
    for (int ks = 0; ks < 32; ++ks) {
        const bf16x8 af = *(const bf16x8*)(ap + ks * 32);
#pragma unroll
        for (int nt = 0; nt < 4; ++nt) {
            const bf16x8 bf = *(const bf16x8*)(bp + (size_t)nt * 16 * 1024 + ks * 32);
            acc[nt] = __builtin_amdgcn_mfma_f32_16x16x32_bf16(bf, af, acc[nt], 0, 0, 0);
        }
    }
    const int row = r0 + fr;
    float part = 0.f;
#pragma unroll
    for (int nt = 0; nt < 4; ++nt) {
        const int col = c0 + nt * 16 + fq * 4;
        const f32x4 xo = FIRST ? *(const f32x4*)(xs + (size_t)(row - NTP) * 1024 + col) : ld_bf4(Xb + (size_t)row * 1024 + col);
        const f32x4 v = xo + acc[nt];
        st_bf4(Xb + (size_t)row * 1024 + col, v);
        part += dot4(v, v);
    }
    part += __shfl_xor(part, 16); part += __shfl_xor(part, 32);
    if (fq == 0) ssqp[(size_t)row * 16 + (c0 >> 6)] = part;
}

struct TrJob { const float* src; int ld, col0, k0; bf16_t* dst; int Ktot, drow0; const float* scale; bool zero; };
__device__ __forceinline__ TrJob tr_decode(const Params& p, const Ctx cx, int job) {
    TrJob J; J.zero = false; J.scale = nullptr;
    int j = job;
    if (j < 2176) {
        const int i = j / 1088, r = j % 1088, nt = r / 16, kt = r % 16, n0 = nt * 64;
        int col0 = 0;
        if (n0 < 2048) col0 = n0; else if (n0 < 2560) col0 = 3712 + (n0 - 2048); else if (n0 < 4224) col0 = 2048 + (n0 - 2560); else J.zero = true;
        J.src = PIN(I_WINE) + (size_t)i * 1024 * 4224; J.ld = 4224; J.col0 = col0; J.k0 = kt * 64; J.dst = (bf16_t*)(PWS + WS_WINE) + (size_t)i * 4352 * 1024; J.Ktot = 1024; J.drow0 = n0; J.scale = PIN(I_NORMW) + (2 * i) * 1024;
        return J;
    }
    j -= 2176;
    if (j < 512) { const int i = j / 256, r = j % 256, nt = r / 16, kt = r % 16;
        J.src = PIN(I_WOUTE) + (size_t)i * 1024 * 1024; J.ld = 1024; J.col0 = nt * 64; J.k0 = kt * 64; J.dst = (bf16_t*)(PWS + WS_WOUTE) + (size_t)i * 1024 * 1024; J.Ktot = 1024; J.drow0 = nt * 64; return J; }
    j -= 512;
    if (j < 1280) { const int i = j / 640, r = j % 640, nt = r / 16, kt = r % 16;
        J.src = PIN(I_WINO) + (size_t)i * 1024 * 2560; J.ld = 2560; J.col0 = nt * 64; J.k0 = kt * 64; J.dst = (bf16_t*)(PWS + WS_WINO) + (size_t)i * 2560 * 1024; J.Ktot = 1024; J.drow0 = nt * 64; J.scale = PIN(I_NORMW) + (2 * i + 1) * 1024; return J; }
    j -= 1280;
    if (j < 512) { const int i = j / 256, r = j % 256, nt = r / 16, kt = r % 16;
        J.src = PIN(I_WOUTO) + (size_t)i * 1024 * 1024; J.ld = 1024; J.col0 = nt * 64; J.k0 = kt * 64; J.dst = (bf16_t*)(PWS + WS_WOUTO) + (size_t)i * 1024 * 1024; J.Ktot = 1024; J.drow0 = nt * 64; return J; }
    j -= 512;
    if (j < 16) { const int i = j / 8, nt = j % 8;
        J.src = PIN(I_W2) + (size_t)i * 64 * 512; J.ld = 512; J.col0 = nt * 64; J.k0 = 0; J.dst = (bf16_t*)(PWS + WS_W2T) + (size_t)i * 512 * 64; J.Ktot = 64; J.drow0 = nt * 64; return J; }
    j -= 16;
    if (j < 16) { const int i = j / 8, nt = j % 8;
        J.src = PIN(I_A2) + (size_t)i * 64 * 512; J.ld = 512; J.col0 = nt * 64; J.k0 = 0; J.dst = (bf16_t*)(PWS + WS_A2T) + (size_t)i * 512 * 64; J.Ktot = 64; J.drow0 = nt * 64; return J; }
    j -= 16;
    { const int ig = j / 4, r = j % 4, nt = r / 2, kt = r % 2;
        J.src = PIN(I_POOLW) + (size_t)ig * 128 * 128; J.ld = 128; J.col0 = nt * 64; J.k0 = kt * 64; J.dst = (bf16_t*)(PWS + WS_POOLWT) + (size_t)ig * 128 * 128; J.Ktot = 128; J.drow0 = nt * 64; }
    return J;
}
__device__ __forceinline__ void tr_load(const TrJob& J, int tid, f32x4& va, f32x4& vb) {
    const int nn = (tid & 15) * 4, ka = tid >> 4, kb = ka + 32;
    va = (f32x4){0.f, 0.f, 0.f, 0.f}; vb = va;
    if (!J.zero) {
        va = __builtin_nontemporal_load((const f32x4*)(J.src + (size_t)(J.k0 + ka) * J.ld + J.col0 + nn)); vb = __builtin_nontemporal_load((const f32x4*)(J.src + (size_t)(J.k0 + kb) * J.ld + J.col0 + nn));
        if (J.scale) { va = va * J.scale[J.k0 + ka]; vb = vb * J.scale[J.k0 + kb]; }
    }
}

__device__ void phase_prepass(const Params& p, const Ctx cx, LAS unsigned char* lds) {
    LAS float* T = (LAS float*)lds;
    const int tid = cx.tid;
    {
        int job = cx.bid;
        f32x4 va = (f32x4){0.f, 0.f, 0.f, 0.f}, vb = va;
        if (job < 4544) { const TrJob J0 = tr_decode(p, cx, job); tr_load(J0, tid, va, vb); }
        for (; job < 4544; job += cx.nblk) {
            f32x4 na = va, nb = vb;
            if (job + (int)cx.nblk < 4544) { const TrJob Jn = tr_decode(p, cx, job + (int)cx.nblk); tr_load(Jn, tid, na, nb); }
            {
                const int nn = (tid & 15) * 4, ka = tid >> 4, kb = ka + 32;
                T[ka * 65 + nn] = va[0]; T[ka * 65 + nn + 1] = va[1]; T[ka * 65 + nn + 2] = va[2]; T[ka * 65 + nn + 3] = va[3];
                T[kb * 65 + nn] = vb[0]; T[kb * 65 + nn + 1] = vb[1]; T[kb * 65 + nn + 2] = vb[2]; T[kb * 65 + nn + 3] = vb[3];
            }
            __syncthreads();
            {
                const TrJob J = tr_decode(p, cx, job);
                const int n = tid >> 3, kc = (tid & 7) * 8;
                u32x4 w;
                w.x = cvt_pk_bf16(T[(kc + 0) * 65 + n], T[(kc + 1) * 65 + n]); w.y = cvt_pk_bf16(T[(kc + 2) * 65 + n], T[(kc + 3) * 65 + n]);
                w.z = cvt_pk_bf16(T[(kc + 4) * 65 + n], T[(kc + 5) * 65 + n]); w.w = cvt_pk_bf16(T[(kc + 6) * 65 + n], T[(kc + 7) * 65 + n]);
                *(u32x4*)(J.dst + (size_t)(J.drow0 + n) * J.Ktot + J.k0 + kc) = w;
            }
            __syncthreads();
            va = na; vb = nb;
        }
    }
    const int gtid = cx.bid * 512 + tid, gthreads = cx.nblk * 512;
    for (int e = gtid; e < 8 * 128 * 128; e += gthreads) {
        const int s = e & 127, t = (e >> 7) & 127;
        ((bf16_t*)(PWS + WS_SPW))[e] = (s <= t) ? (bf16_t)(cvt_pk_bf16(PIN(I_SPW)[e], 0.f) & 0xffffu) : (bf16_t)0;
    }
    const int wid = tid >> 6, lane = tid & 63;
    for (int row0 = cx.bid * 8 + wid; row0 < NTOK; row0 += cx.nblk * 8 * 3) {
        f32x4 v[3][4];
#pragma unroll
        for (int r = 0; r < 3; ++r) {
            const int row = row0 + r * cx.nblk * 8; const int rr = row < NTOK ? row : row0;
            const float* src = rr < NTP ? PIN(I_XP) + (size_t)rr * 1024 : PIN(I_XS) + (size_t)(rr - NTP) * 1024;
#pragma unroll
            for (int i = 0; i < 4; ++i) v[r][i] = __builtin_nontemporal_load((const f32x4*)(src + i * 256 + lane * 4));
        }
#pragma unroll
        for (int r = 0; r < 3; ++r) {
            const int row = row0 + r * cx.nblk * 8;
            if (row < NTOK) {
                bf16_t* dst = (bf16_t*)(PWS + WS_XB) + (size_t)row * 1024;
                float ss = 0.f;
#pragma unroll
                for (int i = 0; i < 4; ++i) { ss += dot4(v[r][i], v[r][i]); st_bf4(dst + i * 256 + lane * 4, v[r][i]); }
#pragma unroll
                for (int o = 32; o >= 1; o >>= 1) ss += __shfl_xor(ss, o);
                if (lane < 16) ((float*)(PWS + WS_SSQ))[(size_t)row * 16 + lane] = (lane == 0) ? ss : 0.f;
            }
        }
    }
}

__device__ __forceinline__ f32x4 shift4(const bf16_t* cur, bool hp, const float* st, int col, const float* mu) {
    const f32x4 q = ld_bf4(cur + col);
    f32x4 pv;
    if (hp) pv = ld_bf4(cur - LDB + col); else if (st) pv = *(const f32x4*)(st + col); else pv = (f32x4){0.f, 0.f, 0.f, 0.f};
    const f32x4 m = *(const f32x4*)(mu + col);
    return q + m * (pv - q);
}

__device__ void phase_even_prep(const Params& p, const Ctx cx, int pair, LAS unsigned char* lds) {
    const int tid = cx.tid, wid = tid >> 6, lane = tid & 63, fr = lane & 15, fq = lane >> 4;
    const bf16_t* PB = (const bf16_t*)(PWS + WS_PROJB);
    float* Wdec = (float*)(PWS + WS_WDEC);
    bf16_t* Aa = (bf16_t*)(PWS + WS_AA);
    bf16_t* Ycat = (bf16_t*)(PWS + WS_YCAT);
    const float* mu_ = PIN(I_MU) + pair * 1664;
    const float* w0_ = PIN(I_W0) + pair * 512; const float* a0_ = PIN(I_A0) + pair * 512;
    const float* k_a_ = PIN(I_KA) + pair * 512; const float* r_k_ = PIN(I_RK) + pair * 512;
    constexpr int RS = 3344;
    constexpr int TB = 17 * RS;
    constexpr int NCH = 17 * 208;
    const int h = wid;
    bf16x8 wfr[4][2], afr[4][2];
    {
        const bf16_t* W2T = (const bf16_t*)(PWS + WS_W2T) + (size_t)pair * 512 * 64;
        const bf16_t* A2T = (const bf16_t*)(PWS + WS_A2T) + (size_t)pair * 512 * 64;
#pragma unroll
        for (int nt = 0; nt < 4; ++nt)
#pragma unroll
            for (int ks = 0; ks < 2; ++ks) {
                wfr[nt][ks] = *(const bf16x8*)(W2T + (size_t)(h * 64 + nt * 16 + fr) * 64 + ks * 32 + fq * 8);
                afr[nt][ks] = *(const bf16x8*)(A2T + (size_t)(h * 64 + nt * 16 + fr) * 64 + ks * 32 + fq * 8);
            }
    }
    constexpr int TBD = 56 * 1024;
    const int widu = __builtin_amdgcn_readfirstlane(tid >> 6);
#define PREP_DMA(tile_, b_, lane_) do { _Pragma("unroll") for (int i_ = 0; i_ < 7; ++i_) { const int k_ = widu * 7 + i_, q_ = k_ * 64 + (lane_); \
            int lr_ = q_ / 209, cc_ = q_ - lr_ * 209; if (lr_ > 16) { lr_ = 16; cc_ = 0; } if (cc_ > 207) cc_ = 0; \
            int gr_ = (tile_) * 16 - 1 + lr_; gr_ = gr_ < 0 ? 0 : gr_; \
            __builtin_amdgcn_global_load_lds((const unsigned*)(PB + (size_t)gr_ * LDB + cc_ * 8), (LAS unsigned*)(lds + (b_) * TBD + k_ * 1024), 16, 0, 0); } } while (0)
    LAS float* CL = (LAS float*)(lds + 2 * TBD);
    {
        const float f0 = mu_[tid], f1 = mu_[tid + 512], f2 = mu_[tid + 1024], f3 = tid < 128 ? mu_[tid + 1536] : 0.f;
        const float f4 = w0_[tid], f5 = a0_[tid], f6 = k_a_[tid], f7 = r_k_[tid];
        CL[tid] = f0; CL[tid + 512] = f1; CL[tid + 1024] = f2; if (tid < 128) CL[tid + 1536] = f3;
        CL[1664 + tid] = f4; CL[2176 + tid] = f5; CL[2688 + tid] = f6; CL[3200 + tid] = f7;
    }
    int buf = 0;
    if ((int)cx.bid < NTOK / 16) PREP_DMA((int)cx.bid, 0, tid & 63);
    asm volatile("s_waitcnt vmcnt(0)" ::: "memory");
    __syncthreads();
    for (int tile = cx.bid; tile < NTOK / 16; tile += cx.nblk) {
        int zz; asm volatile("v_mov_b32 %0, 0" : "=v"(zz));
        const int tidv = tid + zz, fr = (tidv & 15), fq = (tidv >> 4) & 3;
        if (tile + (int)cx.nblk < NTOK / 16) PREP_DMA(tile + (int)cx.nblk, buf ^ 1, tidv & 63);
        {
            const int row = tile * 16 + fr;
            const bool samp = row >= NTP;
            int b, t; if (!samp) { b = row >> 11; t = row & 2047; } else { const int q = row - NTP; b = q >> 3; t = q & 7; }
            const bool hp = t > 0;
            const float* st = samp ? PIN(I_SSHIFT) + ((size_t)pair * 128 + b) * 1664 : nullptr;
            LAS const float* mu = CL; LAS const float* w0 = CL + 1664; LAS const float* a0 = CL + 2176; LAS const float* k_a = CL + 2688; LAS const float* r_k = CL + 3200;
            LAS const unsigned char* curL = lds + buf * TBD + (fr + 1) * RS;
            LAS const unsigned char* prvL = lds + buf * TBD + fr * RS;
            auto sh4 = [&](int col) -> f32x4 {
                const f32x4 q = cvt4(*(LAS const u32x2*)(curL + col * 2));
                f32x4 pv;
                if (hp) pv = cvt4(*(LAS const u32x2*)(prvL + col * 2)); else if (st) pv = *(const f32x4*)(st + col); else pv = (f32x4){0.f, 0.f, 0.f, 0.f};
                const f32x4 m = *(LAS const f32x4*)(mu + col);
                return q + m * (pv - q);
            };
            bf16x8 Aw[2], Al[2];
#pragma unroll
            for (int ks = 0; ks < 2; ++ks) {
                const int cw = 1536 + ks * 32 + fq * 8, ca = 1600 + ks * 32 + fq * 8;
                const f32x4 w_lo = sh4(cw), w_hi = sh4(cw + 4), a_lo = sh4(ca), a_hi = sh4(ca + 4);
                u32x4 pw, pa;
                float th[8];
#pragma unroll
                for (int j = 0; j < 4; ++j) { th[j] = 2.0f * sigmoidf_(2.0f * w_lo[j]) - 1.0f; th[4 + j] = 2.0f * sigmoidf_(2.0f * w_hi[j]) - 1.0f; }
                pw.x = cvt_pk_bf16(th[0], th[1]); pw.y = cvt_pk_bf16(th[2], th[3]); pw.z = cvt_pk_bf16(th[4], th[5]); pw.w = cvt_pk_bf16(th[6], th[7]);
                pa.x = cvt_pk_bf16(a_lo[0], a_lo[1]); pa.y = cvt_pk_bf16(a_lo[2], a_lo[3]); pa.z = cvt_pk_bf16(a_hi[0], a_hi[1]); pa.w = cvt_pk_bf16(a_hi[2], a_hi[3]);
                Aw[ks] = __builtin_bit_cast(bf16x8, pw); Al[ks] = __builtin_bit_cast(bf16x8, pa);
            }
            float bon = 0.f;
#pragma unroll
            for (int nt = 0; nt < 4; ++nt) {
                f32x4 lw = (f32x4){0.f, 0.f, 0.f, 0.f}, la = (f32x4){0.f, 0.f, 0.f, 0.f};
#pragma unroll
                for (int ks = 0; ks < 2; ++ks) {
                    lw = __builtin_amdgcn_mfma_f32_16x16x32_bf16(wfr[nt][ks], Aw[ks], lw, 0, 0, 0);
                    la = __builtin_amdgcn_mfma_f32_16x16x32_bf16(afr[nt][ks], Al[ks], la, 0, 0, 0);
                }
                const int ch = h * 64 + nt * 16 + fq * 4;
                const f32x4 r4 = sh4(ch), k4 = sh4(512 + ch);
                const f32x4 w04 = *(LAS const f32x4*)(w0 + ch), a04 = *(LAS const f32x4*)(a0 + ch), ka4 = *(LAS const f32x4*)(k_a + ch), rk4 = *(LAS const f32x4*)(r_k + ch);
                f32x4 dec, av;
#pragma unroll
                for (int j = 0; j < 4; ++j) {
                    const float z_ = -(w04[j] + lw[j]);
                    dec[j] = __expf(-0.60653066f * __builtin_amdgcn_rcpf(1.0f + __expf(z_)));
                    av[j] = sigmoidf_(a04[j] + la[j]);
                    const float kp = k4[j] * (1.0f + (av[j] - 1.0f) * ka4[j]);
                    bon += r4[j] * kp * rk4[j];
                }
                *(f32x4*)(Wdec + (size_t)row * 512 + ch) = dec;
                st_bf4(Aa + (size_t)row * 512 + ch, av);
            }
            bon += __shfl_xor(bon, 16); bon += __shfl_xor(bon, 32);
#pragma unroll
            for (int nt = 0; nt < 4; ++nt) { const int ch = h * 64 + nt * 16 + fq * 4; st_bf4(Ycat + (size_t)row * 1024 + 512 + ch, sh4(1024 + ch) * bon); }
        }
        asm volatile("s_waitcnt vmcnt(0)" ::: "memory");
        __syncthreads();
        buf ^= 1;
    }
#undef PREP_DMA
    const int gtid = cx.bid * 512 + tid, gthreads = cx.nblk * 512;
    for (int e = gtid; e < 136 * 1664; e += gthreads) {
        const int sr = e / 1664, c = e % 1664;
        if (sr < 8) POUT[O_SHIFTP + ((size_t)pair * 8 + sr) * 1664 + c] = bf2f(PB[(size_t)(sr * 2048 + 2047) * LDB + c]);
        else { const int b = sr - 8; POUT[O_SHIFTS + ((size_t)pair * 128 + b) * 1664 + c] = bf2f(PB[(size_t)(NTP + b * 8 + 7) * LDB + c]); }
    }
}

typedef float f32x2 __attribute__((ext_vector_type(2)));
template <bool RED = true>
__device__ __forceinline__ void scan_step(f32x4& S, const f32x4 w, const f32x4 k, const f32x4 kk, const f32x4 nb, const f32x4 r, const float v, float& y) {
    const f32x2 S01 = {S[0], S[1]}, S23 = {S[2], S[3]};
    f32x2 pp = S01 * (f32x2){kk[0], kk[1]};
    pp = S23 * (f32x2){kk[2], kk[3]} + pp;
    float pd = pp[0] + pp[1];
    const f32x2 vv = {v, v};
    const f32x2 t01 = S01 * (f32x2){w[0], w[1]} + (f32x2){k[0], k[1]} * vv;
    const f32x2 t23 = S23 * (f32x2){w[2], w[3]} + (f32x2){k[2], k[3]} * vv;
    pd = allsum16(pd);
    const f32x2 pdv = {pd, pd};
    const f32x2 n01 = (f32x2){nb[0], nb[1]} * pdv + t01, n23 = (f32x2){nb[2], nb[3]} * pdv + t23;
    S = (f32x4){n01[0], n01[1], n23[0], n23[1]};
    f32x2 q = n01 * (f32x2){r[0], r[1]};
    q = n23 * (f32x2){r[2], r[3]} + q;
    y = RED ? allsum16(q[0] + q[1]) : (q[0] + q[1]);
}
__device__ __forceinline__ float reduce_scatter16(const float (&yp)[16], int cgi) {
    const bool b3 = cgi & 8, b2 = cgi & 4, b1 = cgi & 2, b0 = cgi & 1;
    float a[8], bq[4], c[2];
#pragma unroll
    for (int j = 0; j < 8; ++j) { const float keep = b3 ? yp[8 + j] : yp[j], send = b3 ? yp[j] : yp[8 + j]; a[j] = keep + dpp_f<0x128>(send); }
#pragma unroll
    for (int k = 0; k < 4; ++k) { const float keep = b2 ? a[4 + k] : a[k], send = b2 ? a[k] : a[4 + k]; bq[k] = keep + dpp_f<0x141>(send); }
#pragma unroll
    for (int m = 0; m < 2; ++m) { const float keep = b1 ? bq[2 + m] : bq[m], send = b1 ? bq[m] : bq[2 + m]; c[m] = keep + dpp_f<0x4E>(send); }
    const float keep = b0 ? c[1] : c[0], send = b0 ? c[0] : c[1];
    return keep + dpp_f<0xB1>(send);
}

__device__ void phase_scan(const Params& p, const Ctx cx, int pair, LAS unsigned char* lds) {
    const int tid = cx.tid, wid = tid >> 6, lane = tid & 63, rs = lane >> 4, cgi = lane & 15;
    const bf16_t* PB = (const bf16_t*)(PWS + WS_PROJB);
    const float* Wdec = (const float*)(PWS + WS_WDEC);
    const bf16_t* Aa = (const bf16_t*)(PWS + WS_AA);
    bf16_t* Y = (bf16_t*)(PWS + WS_Y);
    const float* mu = PIN(I_MU) + pair * 1664;
    const float* k_k = PIN(I_KK) + pair * 512; const float* k_a = PIN(I_KA) + pair * 512;
    {
        LAS float* vb = (LAS float*)lds + wid * 3072;
        for (int st = cx.bid * 8 + wid; st < 2048; st += cx.nblk * 8) {
            const int bh = st >> 1, half = st & 1, b = bh >> 3, h = bh & 7, ch = h * 64 + cgi * 4;
            const float* stp = PIN(I_SSHIFT) + ((size_t)pair * 128 + b) * 1664;
            const f32x4 kkc = *(const f32x4*)(k_k + ch), kac = *(const f32x4*)(k_a + ch);
            {
#pragma unroll
                for (int tt = 0; tt < 2; ++tt) {
                    const int t = rs + tt * 4;
                    const size_t row = NTP + b * 8 + t;
                    const bf16_t* cur = PB + row * LDB;
                    const f32x4 r = shift4(cur, t > 0, stp, ch, mu), k = shift4(cur, t > 0, stp, 512 + ch, mu), v = shift4(cur, t > 0, stp, 1024 + ch, mu);
                    const f32x4 a = ld_bf4(Aa + row * 512 + ch);
                    const f32x4 w = *(const f32x4*)(Wdec + row * 512 + ch);
                    const f32x4 kkv = k * kkc;
                    const float ss = allsum16(dot4(kkv, kkv));
                    const float inv = __builtin_amdgcn_rsqf(fmaxf(ss, 1e-24f));
                    const f32x4 kkn = kkv * inv;
                    LAS float* o = vb + t * 384 + cgi * 4;
                    *(LAS f32x4*)(o) = w; *(LAS f32x4*)(o + 64) = k * (1.0f + (a - 1.0f) * kac); *(LAS f32x4*)(o + 128) = kkn; *(LAS f32x4*)(o + 192) = -(kkn * a);
                    *(LAS f32x4*)(o + 256) = r; *(LAS f32x4*)(o + 320) = v;
                }
            }
            asm volatile("s_waitcnt lgkmcnt(0)" ::: "memory");
            __builtin_amdgcn_wave_barrier();
            const size_t so0 = ((((size_t)pair * 128 + b) * 8 + h) * 64 + half * 32 + rs) * 64 + cgi * 4;
            f32x4 Snext = *(const f32x4*)(PIN(I_SWKV) + so0);
#pragma unroll 1
            for (int rq = 0; rq < 8; ++rq) {
                const int ri = half * 32 + rq * 4 + rs;
                const size_t so = so0 + (size_t)rq * 256;
                f32x4 S = Snext;
                if (rq + 1 < 8) Snext = *(const f32x4*)(PIN(I_SWKV) + so + 256);
                float ykeep = 0.f;
#pragma unroll
                for (int t = 0; t < 8; ++t) {
                    LAS const float* r0 = vb + t * 384 + cgi * 4;
                    float y; scan_step(S, *(LAS const f32x4*)(r0), *(LAS const f32x4*)(r0 + 64), *(LAS const f32x4*)(r0 + 128), *(LAS const f32x4*)(r0 + 192), *(LAS const f32x4*)(r0 + 256), vb[t * 384 + 320 + ri], y);
                    ykeep = (cgi == t) ? y : ykeep;
                }
                if (cgi < 8) Y[(size_t)(NTP + b * 8 + cgi) * 512 + h * 64 + ri] = (bf16_t)(cvt_pk_bf16(ykeep, 0.f) & 0xffffu);
                *(f32x4*)(POUT + O_WKVS + so) = S;
            }
            asm volatile("s_waitcnt lgkmcnt(0)" ::: "memory");
            __builtin_amdgcn_wave_barrier();
        }
    }
    __syncthreads();
    LAS float* rec = (LAS float*)lds;
    for (int pt = cx.bid; pt < 256; pt += cx.nblk) {
        const int xcd = pt & 7, slot = pt >> 3, bh = xcd * 8 + (slot >> 2), rg = slot & 3, b = bh >> 3, h = bh & 7;
        const int lt = tid - 256, ls = (lt >> 4) & 15, lcg = lt & 15, lch = h * 64 + lcg * 4;
        u32x2 qr = {0u, 0u}, qk = {0u, 0u}, qv = {0u, 0u}, pr = {0u, 0u}, pk = {0u, 0u}, pv = {0u, 0u}, qa = {0u, 0u};
        f32x4 qw = (f32x4){0.f, 0.f, 0.f, 0.f};
        f32x4 mur, muk, muv, kkc, kac;
        const int ri = rg * 16 + (wid & 3) * 4 + rs;
        f32x4 S = (f32x4){0.f, 0.f, 0.f, 0.f};
#define SCAN_ISSUE(c) do { const int t_ = (c) * 16 + ls; const size_t row_ = (size_t)b * 2048 + t_; const bf16_t* cur_ = PB + row_ * LDB; \
            qr = *(const u32x2*)(cur_ + lch); qk = *(const u32x2*)(cur_ + 512 + lch); qv = *(const u32x2*)(cur_ + 1024 + lch); \
            if (t_ > 0) { pr = *(const u32x2*)(cur_ - LDB + lch); pk = *(const u32x2*)(cur_ - LDB + 512 + lch); pv = *(const u32x2*)(cur_ - LDB + 1024 + lch); } \
            else { pr = (u32x2){0u, 0u}; pk = pr; pv = pr; } \
            qw = *(const f32x4*)(Wdec + row_ * 512 + lch); qa = *(const u32x2*)(Aa + row_ * 512 + lch); } while (0)
#define SCAN_PROCESS(buf) do { const f32x4 r0_ = cvt4(qr), k0_ = cvt4(qk), v0_ = cvt4(qv); \
            const f32x4 r_ = r0_ + mur * (cvt4(pr) - r0_), k_ = k0_ + muk * (cvt4(pk) - k0_), v_ = v0_ + muv * (cvt4(pv) - v0_), a_ = cvt4(qa); \
            const f32x4 kkv_ = k_ * kkc; const float ss_ = allsum16(dot4(kkv_, kkv_)); const float inv_ = __builtin_amdgcn_rsqf(fmaxf(ss_, 1e-24f)); \
            const f32x4 kkn_ = kkv_ * inv_; \
            LAS float* o_ = rec + (buf) * 6144 + ls * 384 + lcg * 4; \
            *(LAS f32x4*)(o_) = qw; *(LAS f32x4*)(o_ + 64) = k_ * (1.0f + (a_ - 1.0f) * kac); *(LAS f32x4*)(o_ + 128) = kkn_; *(LAS f32x4*)(o_ + 192) = -(kkn_ * a_); \
            *(LAS f32x4*)(o_ + 256) = r_; *(LAS f32x4*)(o_ + 320) = v_; } while (0)
        if (wid >= 4) {
            mur = *(const f32x4*)(mu + lch); muk = *(const f32x4*)(mu + 512 + lch); muv = *(const f32x4*)(mu + 1024 + lch);
            kkc = *(const f32x4*)(k_k + lch); kac = *(const f32x4*)(k_a + lch);
            SCAN_ISSUE(0); SCAN_PROCESS(0); SCAN_ISSUE(1);
        }
        __syncthreads();
        for (int c = 0; c < 128; ++c) {
            if (wid < 4) {
                LAS const float* rb = rec + (c & 1) * 6144 + cgi * 4;
                LAS const float* rv = rec + (c & 1) * 6144 + 320 + ri;
                float yp[16];
                f32x4 nw = *(LAS const f32x4*)(rb), nk = *(LAS const f32x4*)(rb + 64), nkk = *(LAS const f32x4*)(rb + 128), nb = *(LAS const f32x4*)(rb + 192), nr = *(LAS const f32x4*)(rb + 256);
                float nv = rv[0];
#pragma unroll
                for (int s = 0; s < 16; ++s) {
                    const f32x4 cw = nw, ck = nk, ckk = nkk, cb = nb, cr = nr; const float cv = nv;
                    if (s + 1 < 16) {
                        LAS const float* r1 = rb + (s + 1) * 384;
                        nw = *(LAS const f32x4*)(r1); nk = *(LAS const f32x4*)(r1 + 64); nkk = *(LAS const f32x4*)(r1 + 128); nb = *(LAS const f32x4*)(r1 + 192); nr = *(LAS const f32x4*)(r1 + 256);
                        nv = rv[(s + 1) * 384];
                    }
                    scan_step<false>(S, cw, ck, ckk, cb, cr, cv, yp[s]);
                }
                Y[((size_t)b * 2048 + c * 16 + cgi) * 512 + h * 64 + ri] = (bf16_t)(cvt_pk_bf16(reduce_scatter16(yp, cgi), 0.f) & 0xffffu);
            } else {
                if (c + 1 < 128) { SCAN_PROCESS((c + 1) & 1); if (c + 2 < 128) SCAN_ISSUE(c + 2); }
            }
            __syncthreads();
        }
        if (wid < 4) *(f32x4*)(POUT + O_WKVP + ((((size_t)pair * 8 + b) * 8 + h) * 64 + ri) * 64 + cgi * 4) = S;
#undef SCAN_ISSUE
#undef SCAN_PROCESS
    }
}

__device__ void phase_even_post(const Params& p, const Ctx cx, int pair) {
    const int gtid = cx.bid * 512 + cx.tid, gthreads = cx.nblk * 512;
    const bf16_t* PA = (const bf16_t*)(PWS + WS_R1);
    bf16_t* Ycat = (bf16_t*)(PWS + WS_YCAT);
    const bf16_t* Y = (const bf16_t*)(PWS + WS_Y);
    constexpr int NIT = NTOK * 128, UB = 4;
    const float* gn_g = PIN(I_GNG) + pair * 512; const float* gn_b = PIN(I_GNB) + pair * 512;
    for (int e0 = gtid; e0 < NIT; e0 += gthreads * UB) {
        f32x4 y[UB], bv[UB], bz[UB], gg[UB], gb[UB]; bool ok[UB];
#pragma unroll
        for (int u = 0; u < UB; ++u) {
            const int e = e0 + u * gthreads; ok[u] = e < NIT;
            const int ee = ok[u] ? e : e0; const int row = ee >> 7, ch = (ee & 127) * 4;
            y[u] = ld_bf4(Y + (size_t)row * 512 + ch);
            bv[u] = ld_bf4(Ycat + (size_t)row * 1024 + 512 + ch);
            bz[u] = ld_bf4(PA + (size_t)row * LDA + 2048 + ch);
            gg[u] = *(const f32x4*)(gn_g + ch); gb[u] = *(const f32x4*)(gn_b + ch);
        }
#pragma unroll
        for (int u = 0; u < UB; ++u) {
            const int e = e0 + u * gthreads;
            const int ee = ok[u] ? e : e0; const int row = ee >> 7, ch = (ee & 127) * 4;
            const float mean = allsum16(y[u][0] + y[u][1] + y[u][2] + y[u][3]) * (1.0f / 64.0f);
            const f32x4 d = y[u] - mean;
            const float var = allsum16(dot4(d, d)) * (1.0f / 64.0f);
            const float rstd = rsqrtf(var + 64e-5f);
            const f32x4 g = gg[u], bb = gb[u];
            f32x4 o;
#pragma unroll
            for (int j = 0; j < 4; ++j) o[j] = (d[j] * rstd * g[j] + bb[j] + bv[u][j]) * siluf_(bz[u][j]);
            if (ok[u]) st_bf4(Ycat + (size_t)row * 1024 + 512 + ch, o);
        }
    }
    const float* cw = PIN(I_CONVW) + pair * 3 * 512;
    constexpr int NRUN = (NTOK / 8) * 128;
    for (int e = gtid; e < NRUN; e += gthreads) {
        const int run = e >> 7, ch = (e & 127) * 4, row0 = run * 8;
        const bool samp = row0 >= NTP;
        int b, t0, T; if (!samp) { b = row0 >> 11; t0 = row0 & 2047; T = 2048; } else { b = (row0 - NTP) >> 3; t0 = 0; T = 8; }
        const bf16_t* base = PA + (size_t)row0 * LDA + ch;
        u32x2 rh[10], rc[10], rb[8], rz[8];
#pragma unroll
        for (int k = 0; k < 10; ++k) {
            const bool have = (k >= 2) || (t0 > 0);
            const bf16_t* pr = have ? base + (ptrdiff_t)(k - 2) * LDA : base;
            rh[k] = *(const u32x2*)(pr); rc[k] = *(const u32x2*)(pr + 1024);
        }
#pragma unroll
        for (int k = 0; k < 8; ++k) { rb[k] = *(const u32x2*)(base + (size_t)k * LDA + 512); rz[k] = *(const u32x2*)(base + (size_t)k * LDA + 1536); }
        const f32x4 k0 = *(const f32x4*)(cw + ch), k1 = *(const f32x4*)(cw + 512 + ch), k2 = *(const f32x4*)(cw + 1024 + ch);
        f32x4 um2, um1;
        if (t0 > 0) { um2 = cvt4(rc[0]) * cvt4(rh[0]); um1 = cvt4(rc[1]) * cvt4(rh[1]); }
        else if (samp) { const float* hist = PIN(I_SCONV) + ((size_t)pair * 128 + b) * 2 * 512 + ch; um2 = *(const f32x4*)(hist); um1 = *(const f32x4*)(hist + 512); }
        else { um2 = (f32x4){0.f, 0.f, 0.f, 0.f}; um1 = um2; }
#pragma unroll
        for (int k = 0; k < 8; ++k) {
            const f32x4 u0 = cvt4(rc[k + 2]) * cvt4(rh[k + 2]);
            const f32x4 conv = k0 * um2 + k1 * um1 + k2 * u0;
            const f32x4 ab = cvt4(rb[k]), az = cvt4(rz[k]);
            f32x4 o;
#pragma unroll
            for (int j = 0; j < 4; ++j) o[j] = ab[j] * conv[j] * siluf_(az[j]);
            const int row = row0 + k, t = t0 + k;
            st_bf4(Ycat + (size_t)row * 1024 + ch, o);
            if (t >= T - 2) {
                float* dst = samp ? POUT + O_CONVS + (((size_t)pair * 128 + b) * 2 + (t - (T - 2))) * 512 + ch : POUT + O_CONVP + (((size_t)pair * 8 + b) * 2 + (t - (T - 2))) * 512 + ch;
                *(f32x4*)dst = u0;
            }
            um2 = um1; um1 = u0;
        }
    }
}

template <int W>
__device__ __forceinline__ void pool_sample_run(const float* __restrict__ hist, const bf16_t* __restrict__ cur, LAS bf16_t* out) {
    f32x4 ext[23];
#pragma unroll
    for (int k = 0; k < 15; ++k) ext[k] = (k >= 16 - W) ? *(const f32x4*)(hist + (size_t)k * 512) : (f32x4){0.f, 0.f, 0.f, 0.f};
#pragma unroll
    for (int k = 0; k < 8; ++k) ext[15 + k] = ld_bf4(cur + (size_t)k * LDA);
    f32x4 sum = (f32x4){0.f, 0.f, 0.f, 0.f};
#pragma unroll
    for (int d = 0; d < W; ++d) sum += ext[15 - d];
#pragma unroll
    for (int t = 0; t < 8; ++t) {
        if (t > 0) sum += ext[15 + t] - ext[15 + t - W];
        const f32x4 pooled = sum * (1.0f / (float)W) - ext[15 + t];
        u32x2 u; u.x = cvt_pk_bf16(pooled[0], pooled[1]); u.y = cvt_pk_bf16(pooled[2], pooled[3]);
        *(LAS u32x2*)(out + t * 136) = u;
    }
}

__device__ void phase_odd_mixer(const Params& p, const Ctx cx, int pair, LAS unsigned char* lds) {
    const int tid = cx.tid, wid = tid >> 6, lane = tid & 63, fr = lane & 15, fq = lane >> 4;
    const bf16_t* PO = (const bf16_t*)(PWS + WS_R1);
    bf16_t* Ycat = (bf16_t*)(PWS + WS_YCAT);
    LAS bf16_t* LA = (LAS bf16_t*)lds;
    LAS bf16_t* LB = (LAS bf16_t*)(lds + 128 * 136 * 2);
    LAS float* stat = (LAS float*)(lds + 2 * 128 * 136 * 2);
    LAS float* LE = (LAS float*)(lds + 128 * 136 * 2);
    LAS bf16_t* LW = (LAS bf16_t*)(lds + 128 * 136 * 2 + 143 * 128 * 4);
    for (int di = 0; di < 8; ++di) {
        int tile, g0, ng;
        if (cx.nblk == 256) {
            if (di == 0) { tile = cx.bid >> 1; g0 = (cx.bid & 1) * 2; ng = 2; }
            else if (di == 1 && cx.bid < 32) { tile = 128 + (cx.bid >> 2); g0 = cx.bid & 3; ng = 1; }
            else break;
        } else { tile = cx.bid + di * cx.nblk; g0 = 0; ng = 4; if (tile >= 136) break; }
        const int r0 = tile * 128;
        const bool samp = r0 >= NTP;
        const int tl_ = tid >> 2, q_ = tid & 3;
        {
            const bf16_t* vr = PO + (size_t)(r0 + tl_) * LDA + 1536 + q_ * 128;
            float s_ = 0.f, ss = 0.f;
#pragma unroll
            for (int i = 0; i < 16; ++i) { const u32x4 raw = *(const u32x4*)(vr + i * 8); const f32x4 v0 = cvt4((u32x2){raw.x, raw.y}), v1 = cvt4((u32x2){raw.z, raw.w});
                s_ += (v0[0] + v0[1]) + (v0[2] + v0[3]) + (v1[0] + v1[1]) + (v1[2] + v1[3]); ss += dot4(v0, v0) + dot4(v1, v1); }
            s_ = allsum4(s_); ss = allsum4(ss);
            const float mean = s_ * (1.0f / 512.0f);
            const float var = fmaxf(ss * (1.0f / 512.0f) - mean * mean, 0.f);
            if (q_ == 0) { stat[tl_ * 2] = mean; stat[tl_ * 2 + 1] = rsqrtf(var + 1e-5f); }
        }
        LAS float* lnw = stat + 512;
        lnw[tid] = PIN(I_LNG)[pair * 512 + tid]; lnw[512 + tid] = PIN(I_LNB)[pair * 512 + tid];
        u32x2 rv[8]; u32x4 rw[4];
#define MIX_LOAD_G(gg) do { const bf16_t* vr_ = PO + (size_t)(r0 + tl_) * LDA + 1536 + (gg) * 128 + q_ * 32; \
            _Pragma("unroll") for (int i = 0; i < 8; ++i) rv[i] = *(const u32x2*)(vr_ + i * 4); \
            if (!samp) { const bf16_t* Ws_ = (const bf16_t*)(PWS + WS_SPW) + ((size_t)pair * 4 + (gg)) * 128 * 128; \
                _Pragma("unroll") for (int i = 0; i < 4; ++i) { const int e = tid + i * 512; rw[i] = *(const u32x4*)(Ws_ + (e >> 4) * 128 + (e & 15) * 8); } } } while (0)
        MIX_LOAD_G(g0);
        __syncthreads();
#pragma unroll 1
        for (int g = g0; g < g0 + ng; ++g) {
            u32x2 ur[8], dzr[8];
#pragma unroll
            for (int nt = 0; nt < 8; ++nt) { const size_t o_ = (size_t)(r0 + wid * 16 + fr) * LDA + g * 128 + nt * 16 + fq * 4; ur[nt] = *(const u32x2*)(PO + o_ + 1024); dzr[nt] = *(const u32x2*)(PO + o_ + 2048); }
            {
                const int row = r0 + tl_;
                const float mean = stat[tl_ * 2], rstd = stat[tl_ * 2 + 1];
                LAS const float* lg = lnw + g * 128 + q_ * 32; LAS const float* lb = lnw + 512 + g * 128 + q_ * 32;
#pragma unroll
                for (int i = 0; i < 8; ++i) {
                    const f32x4 v = cvt4(rv[i]);
                    const f32x4 vn = (v - mean) * rstd * *(LAS const f32x4*)(lg + i * 4) + *(LAS const f32x4*)(lb + i * 4);
                    if (samp) *(f32x4*)(POUT + O_CHUNKV + ((size_t)pair * 1024 + (row - NTP)) * 512 + g * 128 + q_ * 32 + i * 4) = vn;
                    {
                        const float p0 = dpp_f<0x104>(vn[0]), p1 = dpp_f<0x104>(vn[1]);
                        const float p2 = dpp_f<0x114>(vn[2]), p3 = dpp_f<0x114>(vn[3]);
                        const bool odd = tl_ & 1;
                        const unsigned wa = odd ? cvt_pk_bf16(p2, vn[2]) : cvt_pk_bf16(vn[0], p0);
                        const unsigned wb = odd ? cvt_pk_bf16(p3, vn[3]) : cvt_pk_bf16(vn[1], p1);
                        const int cb = q_ * 32 + i * 4 + (odd ? 2 : 0), tb = tl_ & ~1;
                        *(LAS unsigned*)(LB + (cb) * 136 + tb) = wa;
                        *(LAS unsigned*)(LB + (cb + 1) * 136 + tb) = wb;
                    }
                }
            }
            if (!samp) {
#pragma unroll
                for (int i = 0; i < 4; ++i) { const int e = tid + i * 512; *(LAS u32x4*)(LA + (e >> 4) * 136 + (e & 15) * 8) = rw[i]; }
            } else {
                const float* Wsrc = PIN(I_SPW) + ((size_t)pair * 4 + g) * 128 * 128;
                LAS float* w8 = stat + 256;
                if (tid < 64) w8[tid] = Wsrc[(tid >> 3) * 128 + (tid & 7)];
                __syncthreads();
                for (int e = tid; e < 128 * 128; e += 512) { const int t = e >> 7, s2 = e & 127;
                    const float v = ((t >> 3) == (s2 >> 3) && (s2 & 7) <= (t & 7)) ? w8[(t & 7) * 8 + (s2 & 7)] : 0.f;
                    LA[t * 136 + s2] = (bf16_t)(cvt_pk_bf16(v, 0.f) & 0xffffu); }
            }
            if (g + 1 < g0 + ng) MIX_LOAD_G(g + 1);
            __syncthreads();
            {
                const int tl = wid * 16 + fr, row = r0 + tl;
                const float bias = PIN(I_SPB)[((size_t)pair * 4 + g) * 128 + (samp ? (tl & 7) : tl)];
                bf16x8 wf[4];
#pragma unroll
                for (int ks = 0; ks < 4; ++ks) wf[ks] = *(const LAS bf16x8*)(LA + tl * 136 + ks * 32 + fq * 8);
#pragma unroll
                for (int nt = 0; nt < 8; ++nt) {
                    f32x4 acc = (f32x4){0.f, 0.f, 0.f, 0.f};
#pragma unroll
                    for (int ks = 0; ks < 4; ++ks) {
                        if (ks * 32 <= wid * 16 + 15) {
                            const bf16x8 vf = *(const LAS bf16x8*)(LB + (nt * 16 + fr) * 136 + ks * 32 + fq * 8);
                            acc = __builtin_amdgcn_mfma_f32_16x16x32_bf16(vf, wf[ks], acc, 0, 0, 0);
                        }
                    }
                    const int c = g * 128 + nt * 16 + fq * 4;
                    const f32x4 u = cvt4(ur[nt]), dz = cvt4(dzr[nt]);
                    f32x4 o;
#pragma unroll
                    for (int j = 0; j < 4; ++j) o[j] = u[j] * (acc[j] + bias) * siluf_(dz[j]);
                    st_bf4(Ycat + (size_t)row * 1024 + 512 + c, o);
                }
            }
            __syncthreads();
        }
#undef MIX_LOAD_G
    }
    {
        int ci, cstride;
        if (cx.nblk == 256) { if (cx.bid < 32) { ci = 1 << 20; cstride = 1 << 20; } else { ci = cx.bid - 32; cstride = 224; } }
        else { ci = cx.bid; cstride = cx.nblk; }
        u32x4 pw[4]; u32x2 pe[9];
#define MIX_LOAD_C(cc) do { const int tile_ = (cc) >> 2, g_ = (cc) & 3, r0_ = tile_ * 128; \
            const bf16_t* Bw_ = (const bf16_t*)(PWS + WS_POOLWT) + ((size_t)pair * 4 + g_) * 128 * 128; \
            _Pragma("unroll") for (int i = 0; i < 4; ++i) { const int e = tid + i * 512; pw[i] = *(const u32x4*)(Bw_ + (e >> 4) * 128 + (e & 15) * 8); } \
            if (r0_ < NTP) { const int t0_ = r0_ & 2047; \
                _Pragma("unroll") for (int i = 0; i < 9; ++i) { const int e = tid + i * 512, er = e >> 5, c = (e & 31) * 4; pe[i] = (u32x2){0u, 0u}; \
                    if (e < 143 * 32 && t0_ + er - 15 >= 0) pe[i] = *(const u32x2*)(PO + (size_t)(r0_ + er - 15) * LDA + g_ * 128 + c); } } } while (0)
        if (ci < 544) MIX_LOAD_C(ci);
        for (; ci < 544; ci += cstride) {
            const int tile = ci >> 2, g = ci & 3, r0 = tile * 128;
            const bool samp = r0 >= NTP;
            const int w = 2 << g;
            const int row = r0 + wid * 16 + fr;
            u32x2 czr[8]; f32x4 psr[8];
#pragma unroll
            for (int nt = 0; nt < 8; ++nt) { const int d = g * 128 + nt * 16 + fq * 4; czr[nt] = *(const u32x2*)(PO + (size_t)row * LDA + 512 + d); psr[nt] = *(const f32x4*)(PIN(I_PSCALE) + pair * 512 + d); }
#pragma unroll
            for (int i = 0; i < 4; ++i) { const int e = tid + i * 512; *(LAS u32x4*)(LW + (e >> 4) * 136 + (e & 15) * 8) = pw[i]; }
            if (!samp) {
                const int t0 = r0 & 2047;
#pragma unroll
                for (int i = 0; i < 9; ++i) { const int e = tid + i * 512, er = e >> 5, c = (e & 31) * 4; if (e < 143 * 32) *(LAS f32x4*)(LE + er * 128 + c) = cvt4(pe[i]); }
                __syncthreads();
                {
                    const int c = (tid & 31) * 4, tl0 = (tid >> 5) * 8;
                    f32x4 sum = (f32x4){0.f, 0.f, 0.f, 0.f};
#pragma unroll 4
                    for (int d = 0; d < w; ++d) sum += *(LAS const f32x4*)(LE + (tl0 + 15 - d) * 128 + c);
#pragma unroll
                    for (int k = 0; k < 8; ++k) {
                        const int tl = tl0 + k;
                        const f32x4 pt = *(LAS const f32x4*)(LE + (tl + 15) * 128 + c);
                        if (k > 0) sum += pt - *(LAS const f32x4*)(LE + (tl + 15 - w) * 128 + c);
                        const float cnt = fminf((float)w, (float)(t0 + tl + 1));
                        const f32x4 pooled = sum * __builtin_amdgcn_rcpf(cnt) - pt;
                        u32x2 u; u.x = cvt_pk_bf16(pooled[0], pooled[1]); u.y = cvt_pk_bf16(pooled[2], pooled[3]);
                        *(LAS u32x2*)(LA + tl * 136 + c) = u;
                    }
                }
            } else {
                const int sq = tid >> 5, c = (tid & 31) * 4, bb = (r0 - NTP) / 8 + sq;
                const float* hist = PIN(I_SPOOL) + ((size_t)pair * 128 + bb) * 15 * 512 + g * 128 + c;
                const bf16_t* cur = PO + (size_t)(r0 + sq * 8) * LDA + g * 128 + c;
                LAS bf16_t* out = LA + (sq * 8) * 136 + c;
                if (g == 0) pool_sample_run<2>(hist, cur, out); else if (g == 1) pool_sample_run<4>(hist, cur, out);
                else if (g == 2) pool_sample_run<8>(hist, cur, out); else pool_sample_run<16>(hist, cur, out);
            }
            if (ci + cstride < 544) MIX_LOAD_C(ci + cstride);
            __syncthreads();
            bf16x8 af[4];
#pragma unroll
            for (int ks = 0; ks < 4; ++ks) af[ks] = *(const LAS bf16x8*)(LA + (wid * 16 + fr) * 136 + ks * 32 + fq * 8);
#pragma unroll
            for (int nt = 0; nt < 8; ++nt) {
                f32x4 acc = (f32x4){0.f, 0.f, 0.f, 0.f};
#pragma unroll
                for (int ks = 0; ks < 4; ++ks) {
                    const bf16x8 bf = *(const LAS bf16x8*)(LW + (nt * 16 + fr) * 136 + ks * 32 + fq * 8);
                    acc = __builtin_amdgcn_mfma_f32_16x16x32_bf16(bf, af[ks], acc, 0, 0, 0);
                }
                const int d = g * 128 + nt * 16 + fq * 4;
                const f32x4 cz = cvt4(czr[nt]), ps = psr[nt];
                f32x4 o;
#pragma unroll
                for (int j = 0; j < 4; ++j) o[j] = acc[j] * ps[j] * siluf_(cz[j]);
                st_bf4(Ycat + (size_t)row * 1024 + d, o);
            }
            __syncthreads();
        }
#undef MIX_LOAD_C
    }
    const int gtid = cx.bid * 512 + tid, gthreads = cx.nblk * 512;
    for (int e = gtid; e < 136 * 15 * 128; e += gthreads) {
        const int c = (e & 127) * 4, q = e >> 7, sr = q / 15, k = q - sr * 15;
        if (sr < 8) *(f32x4*)(POUT + O_POOLP + (((size_t)pair * 8 + sr) * 15 + k) * 512 + c) = ld_bf4(PO + (size_t)(sr * 2048 + 2033 + k) * LDA + c);
        else { const int b = sr - 8;
            *(f32x4*)(POUT + O_POOLS + (((size_t)pair * 128 + b) * 15 + k) * 512 + c) = (k < 7) ? *(const f32x4*)(PIN(I_SPOOL) + (((size_t)pair * 128 + b) * 15 + 8 + k) * 512 + c) : ld_bf4(PO + (size_t)(NTP + b * 8 + (k - 7)) * LDA + c); }
    }
}

__device__ void phase_final(const Params& p, const Ctx cx) {
    const int gtid = cx.bid * 512 + cx.tid, gthreads = cx.nblk * 512;
    const float* ssq = (const float*)(PWS + WS_SSQ) + (size_t)4 * NTOK * 16;
    const bf16_t* Xb = (const bf16_t*)(PWS + WS_XB);
    constexpr int NIT = NTOK * 256, UB = 4;
    for (int e0 = gtid; e0 < NIT; e0 += gthreads * UB) {
        f32x4 x[UB], fw[UB]; float sq[UB]; bool ok[UB];
#pragma unroll
        for (int u = 0; u < UB; ++u) { const int e = e0 + u * gthreads; ok[u] = e < NIT; const int ee = ok[u] ? e : e0; const int row = ee >> 8, c = (ee & 255) * 4;
            x[u] = ld_bf4(Xb + (size_t)row * 1024 + c); sq[u] = ssq_sum(ssq + (size_t)row * 16); fw[u] = *(const f32x4*)(PIN(I_FNORMW) + c); }
#pragma unroll
        for (int u = 0; u < UB; ++u) { const int e = e0 + u * gthreads; const int ee = ok[u] ? e : e0; const int row = ee >> 8, c = (ee & 255) * 4;
            const float rstd = rsqrtf(sq[u] * (1.0f / 1024.0f) + 1e-6f);
            if (ok[u]) __builtin_nontemporal_store(x[u] * rstd * fw[u], (f32x4*)(POUT + (size_t)row * 1024 + c)); }
    }
}

#define XB_TMO      128
#define XB_XCNT(j)  (256  + 64 * (j))
#define XB_XSUB(j)  (1280 + 64 * (j))
#define XB_XGEN(j)  (2304 + 64 * (j))
#define XB_TOP      3328
#define XB_TOPGEN   3392
#define XCD_BAR_WORDS 3456
#define XB_SPIN_CAP (1u << 18)
__device__ __forceinline__ unsigned xb_ld(unsigned* p)              { return __hip_atomic_load(p, __ATOMIC_RELAXED, __HIP_MEMORY_SCOPE_AGENT); }
__device__ __forceinline__ unsigned xb_add(unsigned* p, unsigned v) { return __hip_atomic_fetch_add(p, v, __ATOMIC_RELAXED, __HIP_MEMORY_SCOPE_AGENT); }
__device__ __forceinline__ unsigned xb_xcc_id() { return (unsigned)__builtin_amdgcn_s_getreg((3 << 11) | 20) & 0xFu; }
#define XB_SPIN(cond, bar) do { unsigned _sp = 0; while (cond) { __builtin_amdgcn_s_sleep(1); \
    if ((++_sp & 255u) == 0u) { if (xb_ld(&(bar)[XB_TMO])) break; if (_sp > XB_SPIN_CAP) { atomicAdd(&(bar)[XB_TMO], 1u); break; } } } } while (0)
struct XcdBarrier { unsigned* bar; unsigned x; volatile LAS unsigned* st; };
__device__ __forceinline__ XcdBarrier xcd_barrier_post(unsigned* bar, volatile LAS unsigned* st) {
    XcdBarrier b; b.bar = bar; b.x = xb_xcc_id(); b.st = st;
    if (threadIdx.x == 0) (void)xb_add(&bar[XB_XCNT(b.x)], 1u);
    return b;
}
__device__ __forceinline__ void xcd_barrier_complete(unsigned* bar, unsigned x, unsigned& nloc, unsigned& nx) {
    const unsigned G = gridDim.x * gridDim.y * gridDim.z;
    unsigned sum, cnt, mine, sp = 0u;
    for (;;) {
        sum = 0u; cnt = 0u; mine = 0u;
#pragma unroll
        for (unsigned j = 0; j < 16; ++j) { const unsigned c = xb_ld(&bar[XB_XCNT(j)]); sum += c; cnt += (c > 0u) ? 1u : 0u; mine = (j == x) ? c : mine; }
        if (sum == G) break;
        __builtin_amdgcn_s_sleep(1);
        if ((++sp & 255u) == 0u) { if (xb_ld(&bar[XB_TMO])) break; if (sp > XB_SPIN_CAP) { atomicAdd(&bar[XB_TMO], 1u); break; } }
    }
    nloc = mine > 0u ? mine : 1u; nx = cnt > 0u ? cnt : 1u;
}
__device__ __forceinline__ void xcd_barrier(const XcdBarrier& b) {
    asm volatile("s_waitcnt vmcnt(0)" ::: "memory");
    __syncthreads();
    if (threadIdx.x == 0) {
        unsigned* bar = b.bar;
        __builtin_amdgcn_s_waitcnt(0);
        unsigned nloc = b.st[0], nx = b.st[1];
        if (nloc == 0u) { xcd_barrier_complete(bar, b.x, nloc, nx); b.st[0] = nloc; b.st[1] = nx; }
        const unsigned old = xb_add(&bar[XB_XSUB(b.x)], 1u);
        const unsigned gen = old / nloc;
        if (old + 1u == (gen + 1u) * nloc) {
            __builtin_amdgcn_fence(__ATOMIC_RELEASE, "agent");
            asm volatile("s_waitcnt vmcnt(0)" ::: "memory");
            const unsigned og = xb_add(&bar[XB_TOP], 1u);
            const unsigned tg = og / nx;
            if (og + 1u == (tg + 1u) * nx) xb_add(&bar[XB_TOPGEN], 1u);
            else XB_SPIN(xb_ld(&bar[XB_TOPGEN]) == tg, bar);
            __builtin_amdgcn_fence(__ATOMIC_ACQUIRE, "agent");
            xb_add(&bar[XB_XGEN(b.x)], 1u);
            asm volatile("s_waitcnt vmcnt(0)" ::: "memory");
        } else {
            XB_SPIN(xb_ld(&bar[XB_XGEN(b.x)]) == gen, bar);
            __builtin_amdgcn_fence(__ATOMIC_ACQUIRE, "agent");
            asm volatile("s_waitcnt vmcnt(0)" ::: "memory");
        }
    }
    __syncthreads();
}

__device__ void run_gemm_proj(const Params& p, const Ctx cx, LAS unsigned char* lds, const bf16_t* Bt, int N, bf16_t* O, int ldc, int layer) {
    pg8::Gemm g{(const bf16_t*)(PWS + WS_XB), Bt, NTOK, N, 1024};
    pg8::StaticOrder S; S.init(NTOK, N, (int)cx.nblk, (int)cx.bid);
    const float* ssq = (const float*)(PWS + WS_SSQ) + (size_t)layer * NTOK * 16;
    LAS float* rl = (LAS float*)(lds + 131072);
    int pm0 = -1, pm1 = -1, pm2 = -1, pm3 = -1, np = 0;
    for (int i = 0; i < 64; ++i) {
        pg8::Unit u; if (!S.next(i, u)) break;
        if (u.pm == pm0 || u.pm == pm1 || u.pm == pm2 || u.pm == pm3) continue;
        if (np == 0) pm0 = u.pm; else if (np == 1) pm1 = u.pm; else if (np == 2) pm2 = u.pm; else pm3 = u.pm;
        ++np;
    }
    for (int r = cx.tid; r < np * 256; r += 512) {
        const int i = r >> 8, pm = i == 0 ? pm0 : (i == 1 ? pm1 : (i == 2 ? pm2 : pm3));
        rl[r] = rsqrtf(ssq_sum(ssq + (size_t)(pm * 256 + (r & 255)) * 16) * (1.0f / 1024.0f) + 1e-6f);
    }
    __syncthreads();
    EpiProj E{O, ldc, rl, pm0, pm1, pm2, pm3};
    pg8::gemm_phase<EpiProj>(cx, lds, g, S, E);
}
__device__ void run_gemm_res(const Params& p, const Ctx cx, LAS unsigned char* lds, const bf16_t* Bt, int layer) {
    const bf16_t* A = (const bf16_t*)(PWS + WS_YCAT);
    bf16_t* Xb = (bf16_t*)(PWS + WS_XB);
    float* ssqn = (float*)(PWS + WS_SSQ) + (size_t)(layer + 1) * NTOK * 16;
    pg8::Gemm g{A, Bt, NTOK, 1024, 1024};
    pg8::StaticOrder S; S.init(NTOK, 1024, (int)cx.nblk, (int)cx.bid);
    EpiRes E{layer == 0 ? PIN(I_XP) : nullptr, PIN(I_XS), Xb, ssqn};
    pg8::gemm_phase<EpiRes>(cx, lds, g, S, E);
}

constexpr int N_PHASES = 20;
#ifndef PHMASK
#define PHMASK 0xffff
#endif
#define PHON(n) ((PHMASK >> ((n) % 16)) & 1)
__global__ void __launch_bounds__(512, 2) fwd_kernel(Params p) {
    extern __shared__ __attribute__((aligned(16))) unsigned char lds_raw[];
    LAS unsigned char* lds = (LAS unsigned char*)lds_raw;
    volatile LAS unsigned* bar_st = (volatile LAS unsigned*)(lds + LDS_MAIN);
    if (threadIdx.x < 4) bar_st[threadIdx.x] = 0u;
    __syncthreads();
    const XcdBarrier gbar = xcd_barrier_post((unsigned*)((unsigned char*)p.ptr[30] + WS_BAR), bar_st);
    if (p.ph_hi < 0) cg::this_grid().sync();
#define GRID_SYNC() xcd_barrier(gbar)
#ifdef SYNCPROBE
    for (int i = 0; i < SYNCPROBE; ++i) GRID_SYNC();
#endif
#ifdef REPMASK
    for (int pc = p.ph_lo * 2; pc < p.ph_hi * 2; ++pc) {
        const int ph = pc >> 1;
        { const int s_ = (ph == 0) ? 9 : (ph == N_PHASES - 1) ? 31 : (ph - 1) % 9; if ((pc & 1) && !((REPMASK >> s_) & 1)) continue; }
        if (pc > p.ph_lo * 2) GRID_SYNC();
#else
    for (int ph = p.ph_lo; ph < p.ph_hi; ++ph) {
        if (ph > p.ph_lo) GRID_SYNC();
#endif
        Ctx cx; cx.tid = threadIdx.x; cx.bid = blockIdx.x; cx.nblk = gridDim.x;
        asm volatile("s_mov_b32 %0, 0" : "=s"(cx.z));
        asm volatile("" : "+v"(cx.tid)); asm volatile("" : "+s"(cx.bid)); asm volatile("" : "+s"(cx.nblk));
        const int pair = (ph - 1) / 9, s = (ph == 0) ? 100 : (ph == N_PHASES - 1 ? 101 : (ph - 1) % 9);
        if (s == 0 || s == 3 || s == 6) {
#if PHON(0)
            const bf16_t* WinE = (const bf16_t*)(PWS + WS_WINE) + (size_t)pair * 4352 * 1024;
            const bf16_t* Bt = s == 0 ? WinE + (size_t)2560 * 1024 : (s == 3 ? WinE : (const bf16_t*)(PWS + WS_WINO) + (size_t)pair * 2560 * 1024);
            const int N = s == 0 ? 1792 : 2560;
            run_gemm_proj(p, cx, lds, Bt, N, (bf16_t*)(PWS + WS_R1), N, 2 * pair + (s == 6 ? 1 : 0));
#endif
        } else if (s == 5 || s == 8) {
#if PHON(5)
            const bf16_t* Bt = (const bf16_t*)(PWS + (s == 5 ? WS_WOUTE : WS_WOUTO)) + (size_t)pair * 1024 * 1024;
            run_gemm_res(p, cx, lds, Bt, 2 * pair + (s == 8 ? 1 : 0));
#endif
        } else if (s == 1) {
#if PHON(1)
            phase_even_prep(p, cx, pair, lds);
#endif
        } else if (s == 2) {
#if PHON(2)
            phase_scan(p, cx, pair, lds);
#endif
        } else if (s == 4) {
#if PHON(4)
            phase_even_post(p, cx, pair);
#endif
        } else if (s == 7) {
#if PHON(7)
            phase_odd_mixer(p, cx, pair, lds);
#endif
        } else if (s == 100) {
#if PHON(10)
            phase_prepass(p, cx, lds);
#endif
        } else {
#if PHON(11)
            phase_final(p, cx);
#endif
        }
    }
}

extern "C" void kernel_launch(void* const* d_in, const int* in_sizes, int n_in, void* d_out, int out_size, void* d_ws, size_t ws_size, hipStream_t stream) {
    static int grid = 0;
    if (grid == 0) {
        if (n_in != 29 || ws_size < WS_END) { fprintf(stderr, "kernel_launch: unexpected n_in %d / ws_size %zu (need %zu)\n", n_in, ws_size, (size_t)WS_END); grid = -1; return; }
        int dev = 0, cus = 0, per_cu = 0;
        hipGetDevice(&dev);
        hipDeviceGetAttribute(&cus, hipDeviceAttributeMultiprocessorCount, dev);
        if (hipFuncSetAttribute((const void*)fwd_kernel, hipFuncAttributeMaxDynamicSharedMemorySize, LDS_BYTES) != hipSuccess) { fprintf(stderr, "kernel_launch: hipFuncSetAttribute failed\n"); grid = -1; return; }
        if (hipOccupancyMaxActiveBlocksPerMultiprocessor(&per_cu, (const void*)fwd_kernel, 512, LDS_BYTES) != hipSuccess || per_cu < 1) { fprintf(stderr, "kernel_launch: occupancy query gave %d\n", per_cu); per_cu = 1; }
        (void)hipGetLastError();
        grid = cus * per_cu;
        if (grid > 256) grid = 256;
    }
    if (grid < 0) return;
    Params p{};
    for (int i = 0; i < 29; ++i) p.ptr[i] = d_in[i];
    p.ptr[29] = d_out; p.ptr[30] = d_ws; p.ptr[31] = nullptr;
    (void)hipMemsetAsync((unsigned char*)d_ws + WS_BAR, 0, 16384, stream);
#if ONE_LAUNCH
    p.ph_lo = 0; p.ph_hi = N_PHASES;
    void* args[] = {&p};
    hipError_t e = hipLaunchCooperativeKernel((const void*)fwd_kernel, dim3(grid), dim3(512), args, LDS_BYTES, stream);
    if (e != hipSuccess) fprintf(stderr, "cooperative launch failed: %s (grid %d)\n", hipGetErrorString(e), grid);
#else
    for (int ph = 0; ph < N_PHASES; ++ph) {
        p.ph_lo = ph; p.ph_hi = ph + 1;
        hipLaunchKernelGGL(fwd_kernel, dim3(grid), dim3(512), LDS_BYTES, stream, p);
    }
#endif
}
```
